# Optimizing an MI355X kernel written in HIP

```python
import jax, jax.numpy as jnp
from jax import lax
import numpy as np

D_MODEL = 2048
BATCH = 2
SEQ = 4096
DEPTH = 1

GLA_HEADS = 4
GLA_DK = 128
GLA_DV = 256
GLA_GATE_RANK = 16
GLA_TAU = 16.0
GLA_CHUNK = 64

MLA_HEADS = 8
Q_LORA = 512
KV_LORA = 512
QK_NOPE = 128
QK_ROPE = 64
V_DIM = 128
ROPE_THETA = 10000.0
Q_BLOCK = 128

MIX_WIDTH = GLA_HEADS * GLA_DV + MLA_HEADS * V_DIM
IN_SIZES = (GLA_HEADS * GLA_DK,
            GLA_HEADS * GLA_DK,
            GLA_HEADS * GLA_DV,
            GLA_HEADS * GLA_DV,
            GLA_GATE_RANK,
            Q_LORA,
            KV_LORA,
            QK_ROPE)
IN_COLS = sum(IN_SIZES)

N_EXPERTS = 32
TOP_K = 4
D_FF = 2048
SWIGLU_LIMIT = 7.0
SWIGLU_ALPHA = 1.702
MOE_BLOCK = 128
EPS = 1e-6

kernel_name = "hymba_gla_mla_moe_block"


def rms_norm(x, g):
    xf = x.astype(jnp.float32)
    y = xf * lax.rsqrt(jnp.mean(xf * xf, axis=-1, keepdims=True) + EPS)
    return (y * g.astype(jnp.float32)).astype(x.dtype)


def split_cols(t, sizes):
    return jnp.split(t, np.cumsum(sizes)[:-1].tolist(), axis=-1)


def apply_rope(t, cos, sin):
    tf = t.astype(jnp.float32)
    t1, t2 = jnp.split(tf, 2, axis=-1)
    return jnp.concatenate([t1 * cos - t2 * sin, t1 * sin + t2 * cos], axis=-1)


def gla_chunked(q, k, v, log_a):
    B, S, H, dk = q.shape
    dv = v.shape[-1]
    N = S // GLA_CHUNK

    def chunks(t):
        return t.astype(jnp.float32).reshape(B, N, GLA_CHUNK, H, -1).transpose(0, 3, 1, 2, 4)

    qc = chunks(q) * (dk ** -0.5)
    kc, vc, gc = chunks(k), chunks(v), chunks(log_a)
    b = jnp.cumsum(gc, axis=3)
    b_last = b[:, :, :, -1:, :]
    q_dec = qc * jnp.exp(b)
    k_intra = kc * jnp.exp(-b)
    k_state = kc * jnp.exp(b_last - b)
    attn = jnp.einsum('bhnid,bhnjd->bhnij', q_dec, k_intra)
    causal = jnp.tril(jnp.ones((GLA_CHUNK, GLA_CHUNK), dtype=bool))
    attn = jnp.where(causal, attn, 0.0)
    o_intra = jnp.einsum('bhnij,bhnjv->bhniv', attn, vc)
    kv_chunk = jnp.einsum('bhnjd,bhnjv->bhndv', k_state, vc)
    decay = jnp.exp(b_last[:, :, :, 0, :])

    def step(state, inp):
        kv_c, dec = inp
        return dec[..., None] * state + kv_c, state

    _, s_prev = lax.scan(step, jnp.zeros((B, H, dk, dv), jnp.float32),
                         (jnp.moveaxis(kv_chunk, 2, 0), jnp.moveaxis(decay, 2, 0)))
    s_prev = jnp.moveaxis(s_prev, 0, 2)
    o = o_intra + jnp.einsum('bhnid,bhndv->bhniv', q_dec, s_prev)
    return o.transpose(0, 2, 3, 1, 4).reshape(B, S, H, dv).astype(v.dtype)


def mla_attention(q_lat, kv_lat, k_rope, cos, sin, q_norm, w_uq, kv_norm, w_ukv):
    B, S, _ = q_lat.shape
    H = MLA_HEADS
    q = (rms_norm(q_lat, q_norm) @ w_uq).reshape(B, S, H, QK_NOPE + QK_ROPE)
    kv = (rms_norm(kv_lat, kv_norm) @ w_ukv).reshape(B, S, H, QK_NOPE + V_DIM)
    q_pe = apply_rope(q[..., QK_NOPE:], cos, sin)
    k_pe = apply_rope(k_rope[:, :, None, :], cos, sin)
    scale = (QK_NOPE + QK_ROPE) ** -0.5
    qf = jnp.concatenate([q[..., :QK_NOPE].astype(jnp.float32), q_pe], axis=-1) * scale
    kf = jnp.concatenate([kv[..., :QK_NOPE].astype(jnp.float32),
                          jnp.broadcast_to(k_pe, (B, S, H, QK_ROPE))], axis=-1)
    vf = kv[..., QK_NOPE:].astype(jnp.float32)
    nqb = S // Q_BLOCK
    qb = qf.reshape(B, nqb, Q_BLOCK, H, QK_NOPE + QK_ROPE).transpose(1, 0, 2, 3, 4)
    key_pos = jnp.arange(S)

    def attend(args):
        qblk, i = args
        s = jnp.einsum('bqhd,bkhd->bhqk', qblk, kf)
        qpos = i * Q_BLOCK + jnp.arange(Q_BLOCK)
        s = jnp.where(key_pos[None, :] <= qpos[:, None], s, -jnp.inf)
        p = jax.nn.softmax(s, axis=-1)
        return jnp.einsum('bhqk,bkhv->bqhv', p, vf)

    out = lax.map(attend, (qb, jnp.arange(nqb)))
    return out.transpose(1, 0, 2, 3, 4).reshape(B, S, H * V_DIM).astype(q_lat.dtype)


def moe_ffn(h, router_w, router_b, w_gu, b_gu, w_dn, b_dn):
    B, S, D = h.shape
    T = B * S
    A = T * TOP_K
    hf = h.reshape(T, D)
    logits = (hf @ router_w + router_b).astype(jnp.float32)
    top_val, top_idx = lax.top_k(logits, TOP_K)
    gates = jax.nn.softmax(top_val, axis=-1)
    e_flat = top_idx.reshape(A)
    tok_flat = jnp.repeat(jnp.arange(T, dtype=jnp.int32), TOP_K)
    g_flat = gates.reshape(A)
    order = jnp.argsort(e_flat)
    e_sorted, tok_sorted, g_sorted = e_flat[order], tok_flat[order], g_flat[order]
    counts = jnp.bincount(e_flat, length=N_EXPERTS)
    padded = (counts + MOE_BLOCK - 1) // MOE_BLOCK * MOE_BLOCK
    start = jnp.cumsum(counts) - counts
    pend = jnp.cumsum(padded)
    pstart = pend - padded
    dest = pstart[e_sorted] + (jnp.arange(A) - start[e_sorted])
    n_blocks = -(-(A + N_EXPERTS * (MOE_BLOCK - 1)) // MOE_BLOCK)
    P = n_blocks * MOE_BLOCK
    tok_buf = jnp.zeros((P,), jnp.int32).at[dest].set(tok_sorted)
    gate_buf = jnp.zeros((P,), jnp.float32).at[dest].set(g_sorted)
    block_expert = jnp.clip(jnp.searchsorted(pend, jnp.arange(n_blocks) * MOE_BLOCK, side='right'),
                            0, N_EXPERTS - 1)

    def expert_block(args):
        toks, e = args
        xb = hf[toks]
        gu = xb @ w_gu[e] + b_gu[e]
        gate, up = gu[:, :D_FF], gu[:, D_FF:]
        gate = jnp.minimum(gate, SWIGLU_LIMIT)
        up = jnp.clip(up, -SWIGLU_LIMIT, SWIGLU_LIMIT)
        act = (up + 1.0) * (gate * jax.nn.sigmoid(gate * SWIGLU_ALPHA))
        return act @ w_dn[e] + b_dn[e]

    y = lax.map(expert_block, (tok_buf.reshape(n_blocks, MOE_BLOCK), block_expert))
    y = y.reshape(P, D) * gate_buf[:, None].astype(y.dtype)
    out = jax.ops.segment_sum(y, tok_buf, num_segments=T)
    return out.reshape(B, S, D).astype(h.dtype)


def setup_inputs(seed: int = 0) -> dict:
    key = jax.random.key(seed)
    ks = jax.random.split(key, 24)
    f32 = jnp.float32
    nrm = lambda k, shape, s: jax.random.normal(k, shape, f32) * s
    L = DEPTH
    x = jax.random.normal(ks[0], (BATCH, SEQ, D_MODEL), f32)
    offsets = jax.random.randint(ks[1], (BATCH, 1), 0, 1024, dtype=jnp.int32)
    positions = offsets + jnp.arange(SEQ, dtype=jnp.int32)[None, :]
    gain = lambda k, shape: 1.0 + nrm(k, shape, 0.02)
    return {
        "x": x,
        "positions": positions,
        "attn_norm": gain(ks[2], (L, D_MODEL)),
        "w_in": nrm(ks[3], (L, D_MODEL, IN_COLS), D_MODEL ** -0.5),
        "gla_gate_up": nrm(ks[4], (L, GLA_GATE_RANK, GLA_HEADS * GLA_DK), GLA_GATE_RANK ** -0.5),
        "gla_gate_bias": nrm(ks[5], (L, GLA_HEADS * GLA_DK), 0.1),
        "gla_out_norm": gain(ks[6], (L, GLA_DV)),
        "mla_q_norm": gain(ks[7], (L, Q_LORA)),
        "w_uq": nrm(ks[8], (L, Q_LORA, MLA_HEADS * (QK_NOPE + QK_ROPE)), Q_LORA ** -0.5),
        "mla_kv_norm": gain(ks[9], (L, KV_LORA)),
        "w_ukv": nrm(ks[10], (L, KV_LORA, MLA_HEADS * (QK_NOPE + V_DIM)), KV_LORA ** -0.5),
        "mla_out_norm": gain(ks[11], (L, MLA_HEADS * V_DIM)),
        "w_out": nrm(ks[12], (L, MIX_WIDTH, D_MODEL), MIX_WIDTH ** -0.5),
        "ffn_norm": gain(ks[13], (L, D_MODEL)),
        "router_w": nrm(ks[14], (L, D_MODEL, N_EXPERTS), D_MODEL ** -0.5),
        "router_b": nrm(ks[15], (L, N_EXPERTS), 0.01),
        "w_gate_up": nrm(ks[16], (L, N_EXPERTS, D_MODEL, 2 * D_FF), D_MODEL ** -0.5),
        "b_gate_up": nrm(ks[17], (L, N_EXPERTS, 2 * D_FF), 0.01),
        "w_down": nrm(ks[18], (L, N_EXPERTS, D_FF, D_MODEL), D_FF ** -0.5),
        "b_down": nrm(ks[19], (L, N_EXPERTS, D_MODEL), 0.01),
        "final_norm": gain(ks[20], (D_MODEL,)),
    }


def reference(x, positions, attn_norm, w_in, gla_gate_up, gla_gate_bias, gla_out_norm,
              mla_q_norm, w_uq, mla_kv_norm, w_ukv, mla_out_norm, w_out, ffn_norm,
              router_w, router_b, w_gate_up, b_gate_up, w_down, b_down, final_norm):
    B, S, _ = x.shape
    inv_freq = 1.0 / (ROPE_THETA ** (jnp.arange(0, QK_ROPE, 2, dtype=jnp.float32) / QK_ROPE))
    ang = positions.astype(jnp.float32)[..., None] * inv_freq
    cos = jnp.cos(ang)[:, :, None, :]
    sin = jnp.sin(ang)[:, :, None, :]
    for l in range(DEPTH):
        h = rms_norm(x, attn_norm[l])
        proj = h @ w_in[l]
        gq, gk, gv, gr, gdown, mq, mkv, mkr = split_cols(proj, IN_SIZES)
        log_a = jax.nn.log_sigmoid((gdown @ gla_gate_up[l] + gla_gate_bias[l]).astype(jnp.float32)) / GLA_TAU
        o = gla_chunked(gq.reshape(B, S, GLA_HEADS, GLA_DK), gk.reshape(B, S, GLA_HEADS, GLA_DK),
                        gv.reshape(B, S, GLA_HEADS, GLA_DV), log_a.reshape(B, S, GLA_HEADS, GLA_DK))
        o = rms_norm(o, gla_out_norm[l]) * jax.nn.silu(gr).reshape(B, S, GLA_HEADS, GLA_DV)
        o_gla = o.reshape(B, S, GLA_HEADS * GLA_DV)
        o_mla = mla_attention(mq, mkv, mkr, cos, sin, mla_q_norm[l], w_uq[l], mla_kv_norm[l], w_ukv[l])
        o_mla = rms_norm(o_mla, mla_out_norm[l])
        mix = jnp.concatenate([o_gla.astype(x.dtype), o_mla.astype(x.dtype)], axis=-1)
        x = x + mix @ w_out[l]
        h = rms_norm(x, ffn_norm[l])
        x = x + moe_ffn(h, router_w[l], router_b[l], w_gate_up[l], b_gate_up[l], w_down[l], b_down[l])
    return rms_norm(x, final_norm)
```

```cpp
#include <hip/hip_runtime.h>
#include <hip/hip_bf16.h>
#include <stdint.h>

#define T_      8192
#define SEQ_    4096
#define D_      2048
#define NC_     4176
#define C_GQ    0
#define C_GK    512
#define C_GV    1024
#define C_GR    2048
#define C_GD    3072
#define C_MQ    3088
#define C_MKV   3600
#define C_MKR   4112
#define NE_     32
#define DFF_    2048
#define EPS_    1e-6f

__device__ __forceinline__ float block_sum_256(float v, float* red) {
  for (int o = 32; o > 0; o >>= 1) v += __shfl_xor(v, o);
  __syncthreads();
  if ((threadIdx.x & 63) == 0) red[threadIdx.x >> 6] = v;
  __syncthreads();
  float r = red[0] + red[1] + red[2] + red[3];
  __syncthreads();
  return r;
}
__device__ __forceinline__ float block_max_256(float v, float* red) {
  for (int o = 32; o > 0; o >>= 1) v = fmaxf(v, __shfl_xor(v, o));
  __syncthreads();
  if ((threadIdx.x & 63) == 0) red[threadIdx.x >> 6] = v;
  __syncthreads();
  float r = fmaxf(fmaxf(red[0], red[1]), fmaxf(red[2], red[3]));
  __syncthreads();
  return r;
}

__global__ void __launch_bounds__(256) nv_rmsnorm(const float* in, int ldi, const float* g, float* out, int ldo, int cols) {
  __shared__ float red[4];
  const float* p = in + (long)blockIdx.x * ldi;
  float ss = 0.f;
  for (int c = threadIdx.x; c < cols; c += 256) { float v = p[c]; ss += v * v; }
  ss = block_sum_256(ss, red);
  float r = rsqrtf(ss / cols + EPS_);
  float* o = out + (long)blockIdx.x * ldo;
  for (int c = threadIdx.x; c < cols; c += 256) o[c] = p[c] * r * g[c];
}

struct GP {
  const float* A; int lda; const int* rowidx; int rowidx_zs;
  const int* Mptr; int M;
  const float* B; int ldb; long Bzs;
  const float* bias; int bias_zs;
  const float* resid; int ldr;
  float* C; int ldc; const int* crow0; int a_from_crow0;
  int N, K;
};
__global__ void __launch_bounds__(256) nv_gemm(GP p) {
  __shared__ float As[16][65];
  __shared__ float Bs[16][64];
  const int z = blockIdx.z;
  const int M = p.Mptr ? p.Mptr[z] : p.M;
  const int m0 = blockIdx.y * 64, n0 = blockIdx.x * 64;
  if (m0 >= M) return;
  const int crow0 = p.crow0 ? p.crow0[z] : 0;
  const float* B = p.B + (long)z * p.Bzs;
  const int* ridx = p.rowidx ? p.rowidx + (long)z * p.rowidx_zs : nullptr;
  const int tx = threadIdx.x & 15, ty = threadIdx.x >> 4;
  float acc[4][4];
  for (int i = 0; i < 4; ++i) for (int j = 0; j < 4; ++j) acc[i][j] = 0.f;
  const int ar = threadIdx.x >> 2, ak = (threadIdx.x & 3) * 4;
  long arow = -1;
  if (m0 + ar < M) {
    int m = m0 + ar;
    arow = ridx ? ridx[m] : (p.a_from_crow0 ? crow0 + m : m);
  }
  const int bk = threadIdx.x >> 4, bn = (threadIdx.x & 15) * 4;
  for (int k0 = 0; k0 < p.K; k0 += 16) {
    float4 av = make_float4(0.f, 0.f, 0.f, 0.f);
    if (arow >= 0) av = *(const float4*)(p.A + arow * p.lda + k0 + ak);
    As[ak + 0][ar] = av.x; As[ak + 1][ar] = av.y; As[ak + 2][ar] = av.z; As[ak + 3][ar] = av.w;
    float bv[4];
    for (int j = 0; j < 4; ++j) { int n = n0 + bn + j; bv[j] = (n < p.N) ? B[(long)(k0 + bk) * p.ldb + n] : 0.f; }
    Bs[bk][bn + 0] = bv[0]; Bs[bk][bn + 1] = bv[1]; Bs[bk][bn + 2] = bv[2]; Bs[bk][bn + 3] = bv[3];
    __syncthreads();
#pragma unroll
    for (int k = 0; k < 16; ++k) {
      float a[4], b[4];
      for (int i = 0; i < 4; ++i) a[i] = As[k][ty * 4 + i];
      for (int j = 0; j < 4; ++j) b[j] = Bs[k][tx * 4 + j];
      for (int i = 0; i < 4; ++i) for (int j = 0; j < 4; ++j) acc[i][j] = fmaf(a[i], b[j], acc[i][j]);
    }
    __syncthreads();
  }
  const float* bias = p.bias ? p.bias + (long)z * p.bias_zs : nullptr;
  for (int i = 0; i < 4; ++i) {
    int m = m0 + ty * 4 + i;
    if (m >= M) continue;
    for (int j = 0; j < 4; ++j) {
      int n = n0 + tx * 4 + j;
      if (n >= p.N) continue;
      float v = acc[i][j];
      if (bias) v += bias[n];
      if (p.resid) v += p.resid[(long)m * p.ldr + n];
      p.C[(long)(crow0 + m) * p.ldc + n] = v;
    }
  }
}

__global__ void nv_loga(float* z, long n) {
  long i = (long)blockIdx.x * blockDim.x + threadIdx.x;
  if (i >= n) return;
  float v = z[i];
  float ls = fminf(v, 0.f) - log1pf(expf(-fabsf(v)));
  z[i] = ls * (1.0f / 16.0f);
}

__global__ void __launch_bounds__(256) nv_gla(const float* proj, const float* loga, float* o  ) {
  __shared__ float sq[128], sk[128], sa[128];
  const int b = blockIdx.x >> 2, h = blockIdx.x & 3, dv = threadIdx.x;
  float S[128];
#pragma unroll
  for (int i = 0; i < 128; ++i) S[i] = 0.f;
  const float scale = 0.08838834764831845f;
  for (int s = 0; s < SEQ_; ++s) {
    const long t = (long)b * SEQ_ + s;
    const float* pr = proj + t * NC_;
    if (threadIdx.x < 128) {
      sq[threadIdx.x] = pr[C_GQ + h * 128 + threadIdx.x] * scale;
      sk[threadIdx.x] = pr[C_GK + h * 128 + threadIdx.x];
    } else {
      sa[threadIdx.x - 128] = expf(loga[t * 512 + h * 128 + (threadIdx.x - 128)]);
    }
    __syncthreads();
    const float v = pr[C_GV + h * 256 + dv];
    float acc = 0.f;
#pragma unroll
    for (int i = 0; i < 128; ++i) {
      S[i] = fmaf(sa[i], S[i], sk[i] * v);
      acc = fmaf(sq[i], S[i], acc);
    }
    o[t * 1024 + h * 256 + dv] = acc;
    __syncthreads();
  }
}

__global__ void __launch_bounds__(256) nv_gla_out(const float* o, const float* proj, const float* g, float* mix) {
  __shared__ float red[4];
  const long t = blockIdx.x >> 2; const int h = blockIdx.x & 3, dv = threadIdx.x;
  float v = o[t * 1024 + h * 256 + dv];
  float ss = block_sum_256(v * v, red);
  float r = rsqrtf(ss / 256.f + EPS_);
  float gr = proj[t * NC_ + C_GR + h * 256 + dv];
  float si = gr / (1.f + expf(-gr));
  mix[t * 2048 + h * 256 + dv] = v * r * g[dv] * si;
}

__global__ void nv_cs(const int* pos, float2* cs) {
  int i = blockIdx.x * blockDim.x + threadIdx.x;
  if (i >= T_ * 32) return;
  int t = i >> 5, f = i & 31;
  float inv = 1.0f / powf(10000.0f, (float)(2 * f) / 64.0f);
  float ang = (float)pos[t] * inv;
  double a = (double)ang;
  double k = rint(a * 0.15915494309189535);
  double r = fma(-k, 6.283185307179586, a);
  float rf = (float)r;
  cs[i] = make_float2(__cosf(rf), __sinf(rf));
}

__global__ void nv_rope_q(float* q, const float2* cs) {
  long i = (long)blockIdx.x * blockDim.x + threadIdx.x;
  if (i >= (long)T_ * 8 * 32) return;
  int f = i & 31; long th = i >> 5; long t = th >> 3;
  float* p = q + th * 192 + 128;
  float2 c = cs[t * 32 + f];
  float t1 = p[f], t2 = p[f + 32];
  p[f] = t1 * c.x - t2 * c.y;
  p[f + 32] = t1 * c.y + t2 * c.x;
}
__global__ void nv_rope_k(const float* proj, const float2* cs, float* kpe) {
  int i = blockIdx.x * blockDim.x + threadIdx.x;
  if (i >= T_ * 32) return;
  int f = i & 31, t = i >> 5;
  const float* p = proj + (long)t * NC_ + C_MKR;
  float2 c = cs[i];
  float t1 = p[f], t2 = p[f + 32];
  kpe[t * 64 + f] = t1 * c.x - t2 * c.y;
  kpe[t * 64 + f + 32] = t1 * c.y + t2 * c.x;
}

__global__ void __launch_bounds__(256) nv_attn(const float* q, const float* kv, const float* kpe, float* o) {
  __shared__ float sq[192];
  __shared__ float sc[SEQ_];
  __shared__ float red[4];
  __shared__ float so[128];
  const int qi = blockIdx.x % SEQ_; const int bh = blockIdx.x / SEQ_; const int h = bh & 7, b = bh >> 3;
  const long tq = (long)b * SEQ_ + qi;
  const float scale = 0.07216878364870322f;
  if (threadIdx.x < 192) sq[threadIdx.x] = q[(tq * 8 + h) * 192 + threadIdx.x] * scale;
  __syncthreads();
  float mx = -1e30f;
  for (int j = threadIdx.x; j <= qi; j += 256) {
    const long tk = (long)b * SEQ_ + j;
    const float* kn = kv + (tk * 8 + h) * 256;
    const float* kp = kpe + tk * 64;
    float s = 0.f;
    for (int d = 0; d < 128; ++d) s = fmaf(sq[d], kn[d], s);
    for (int d = 0; d < 64; ++d) s = fmaf(sq[128 + d], kp[d], s);
    sc[j] = s; mx = fmaxf(mx, s);
  }
  mx = block_max_256(mx, red);
  float sum = 0.f;
  for (int j = threadIdx.x; j <= qi; j += 256) { float e = expf(sc[j] - mx); sc[j] = e; sum += e; }
  sum = block_sum_256(sum, red);
  const int dv = threadIdx.x & 127, g = threadIdx.x >> 7;
  float acc = 0.f;
  for (int j = g; j <= qi; j += 2) acc = fmaf(sc[j], kv[(((long)b * SEQ_ + j) * 8 + h) * 256 + 128 + dv], acc);
  if (g == 1) so[dv] = acc;
  __syncthreads();
  if (g == 0) o[tq * 1024 + h * 128 + dv] = (acc + so[dv]) / sum;
}

__global__ void __launch_bounds__(256) nv_router(const float* h2, const float* rw, const float* rb, int* counts, int* list,
                                                 int* asg_e, int* asg_slot, float* asg_g) {
  __shared__ float part[8][32];
  __shared__ float lg[32];
  const int t = blockIdx.x;
  const int e = threadIdx.x & 31, seg = threadIdx.x >> 5;
  float acc = 0.f;
  const float* hp = h2 + (long)t * 2048;
  for (int k = seg * 256; k < seg * 256 + 256; ++k) acc = fmaf(hp[k], rw[k * 32 + e], acc);
  part[seg][e] = acc;
  __syncthreads();
  if (threadIdx.x < 32) {
    float s = rb[e];
    for (int i = 0; i < 8; ++i) s += part[i][e];
    lg[e] = s;
  }
  __syncthreads();
  if (threadIdx.x == 0) {
    int idx[4]; float val[4];
    unsigned used = 0;
    for (int k = 0; k < 4; ++k) {
      int bi = -1; float bv = 0.f;
      for (int i = 0; i < 32; ++i) {
        if (used & (1u << i)) continue;
        if (bi < 0 || lg[i] > bv) { bi = i; bv = lg[i]; }
      }
      used |= 1u << bi; idx[k] = bi; val[k] = bv;
    }
    float m = val[0];
    float ex[4], s = 0.f;
    for (int k = 0; k < 4; ++k) { ex[k] = expf(val[k] - m); s += ex[k]; }
    for (int k = 0; k < 4; ++k) {
      int slot = atomicAdd(&counts[idx[k]], 1);
      list[idx[k] * T_ + slot] = t;
      asg_e[t * 4 + k] = idx[k]; asg_slot[t * 4 + k] = slot; asg_g[t * 4 + k] = ex[k] / s;
    }
  }
}
__global__ void nv_zero_counts(int* counts) { if (threadIdx.x < 64) counts[threadIdx.x] = 0; }
__global__ void nv_base(const int* counts, int* base) {
  if (threadIdx.x == 0) { int s = 0; for (int e = 0; e < NE_; ++e) { base[e] = s; s += counts[e]; } }
}
__global__ void nv_act(const float* gu, float* act, long rows) {
  long i = (long)blockIdx.x * blockDim.x + threadIdx.x;
  if (i >= rows * 2048) return;
  long r = i >> 11; int j = i & 2047;
  float g = fminf(gu[r * 4096 + j], 7.0f);
  float u = fminf(fmaxf(gu[r * 4096 + 2048 + j], -7.0f), 7.0f);
  act[i] = (u + 1.0f) * (g / (1.0f + expf(-1.702f * g)));
}
__global__ void __launch_bounds__(256) nv_final(const float* x1, const float* y, const int* base, const int* asg_e, const int* asg_slot,
                                                const float* asg_g, const float* fg, float* out) {
  __shared__ float red[4];
  const long t = blockIdx.x;
  float v[8]; float ss = 0.f;
  long rows[4]; float gg[4];
  for (int k = 0; k < 4; ++k) { rows[k] = base[asg_e[t * 4 + k]] + asg_slot[t * 4 + k]; gg[k] = asg_g[t * 4 + k]; }
  for (int i = 0; i < 8; ++i) {
    int c = threadIdx.x + i * 256;
    float a = x1[t * 2048 + c];
    for (int k = 0; k < 4; ++k) a += gg[k] * y[rows[k] * 2048 + c];
    v[i] = a; ss += a * a;
  }
  ss = block_sum_256(ss, red);
  float r = rsqrtf(ss / 2048.f + EPS_);
  for (int i = 0; i < 8; ++i) { int c = threadIdx.x + i * 256; out[t * 2048 + c] = v[i] * r * fg[c]; }
}

static void launch_gemm(hipStream_t st, GP p, int Mmax, int nz) {
  dim3 grid((p.N + 63) / 64, (Mmax + 63) / 64, nz);
  nv_gemm<<<grid, 256, 0, st>>>(p);
}

extern "C" void kernel_launch(void* const* d_in, const int* in_sizes, int n_in,
                              void* d_out, int out_size, void* d_ws, size_t ws_size,
                              hipStream_t stream) {
  const float* x = (const float*)d_in[0];
  const int* pos = (const int*)d_in[1];
  const float* attn_norm = (const float*)d_in[2];
  const float* w_in = (const float*)d_in[3];
  const float* gate_up = (const float*)d_in[4];
  const float* gate_bias = (const float*)d_in[5];
  const float* gla_out_norm = (const float*)d_in[6];
  const float* q_norm = (const float*)d_in[7];
  const float* w_uq = (const float*)d_in[8];
  const float* kv_norm = (const float*)d_in[9];
  const float* w_ukv = (const float*)d_in[10];
  const float* mla_out_norm = (const float*)d_in[11];
  const float* w_out = (const float*)d_in[12];
  const float* ffn_norm = (const float*)d_in[13];
  const float* router_w = (const float*)d_in[14];
  const float* router_b = (const float*)d_in[15];
  const float* w_gu = (const float*)d_in[16];
  const float* b_gu = (const float*)d_in[17];
  const float* w_dn = (const float*)d_in[18];
  const float* b_dn = (const float*)d_in[19];
  const float* final_norm = (const float*)d_in[20];
  float* out = (float*)d_out;

  char* w = (char*)d_ws; size_t off = 0;
  auto alloc = [&](size_t bytes) { void* p = w + off; off += (bytes + 255) & ~(size_t)255; return p; };
  float* h1 = (float*)alloc((size_t)T_ * 2048 * 4);
  float* proj = (float*)alloc((size_t)T_ * NC_ * 4);
  float* loga = (float*)alloc((size_t)T_ * 512 * 4);
  float* ogla = (float*)alloc((size_t)T_ * 1024 * 4);
  float* mix = (float*)alloc((size_t)T_ * 2048 * 4);
  float2* cs = (float2*)alloc((size_t)T_ * 32 * 8);
  float* nq = (float*)alloc((size_t)T_ * 512 * 4);
  float* nkv = (float*)alloc((size_t)T_ * 512 * 4);
  float* q = (float*)alloc((size_t)T_ * 1536 * 4);
  float* kv = (float*)alloc((size_t)T_ * 2048 * 4);
  float* kpe = (float*)alloc((size_t)T_ * 64 * 4);
  float* omla = (float*)alloc((size_t)T_ * 1024 * 4);
  float* x1 = (float*)alloc((size_t)T_ * 2048 * 4);
  float* h2 = (float*)alloc((size_t)T_ * 2048 * 4);
  int* counts = (int*)alloc(256);
  int* base = (int*)alloc(256);
  int* list = (int*)alloc((size_t)NE_ * T_ * 4);
  int* asg_e = (int*)alloc((size_t)T_ * 4 * 4);
  int* asg_slot = (int*)alloc((size_t)T_ * 4 * 4);
  float* asg_g = (float*)alloc((size_t)T_ * 4 * 4);
  float* gu = (float*)alloc((size_t)T_ * 4 * 4096 * 4);
  float* act = (float*)alloc((size_t)T_ * 4 * 2048 * 4);
  float* y = (float*)alloc((size_t)T_ * 4 * 2048 * 4);

  nv_rmsnorm<<<T_, 256, 0, stream>>>(x, 2048, attn_norm, h1, 2048, 2048);
  { GP p{}; p.A = h1; p.lda = 2048; p.M = T_; p.B = w_in; p.ldb = NC_; p.C = proj; p.ldc = NC_; p.N = NC_; p.K = 2048; launch_gemm(stream, p, T_, 1); }
  { GP p{}; p.A = proj + C_GD; p.lda = NC_; p.M = T_; p.B = gate_up; p.ldb = 512; p.bias = gate_bias; p.C = loga; p.ldc = 512; p.N = 512; p.K = 16; launch_gemm(stream, p, T_, 1); }
  nv_loga<<<(T_ * 512 + 255) / 256, 256, 0, stream>>>(loga, (long)T_ * 512);
  nv_gla<<<8, 256, 0, stream>>>(proj, loga, ogla);
  nv_gla_out<<<T_ * 4, 256, 0, stream>>>(ogla, proj, gla_out_norm, mix);
  nv_cs<<<(T_ * 32 + 255) / 256, 256, 0, stream>>>(pos, cs);
  nv_rmsnorm<<<T_, 256, 0, stream>>>(proj + C_MQ, NC_, q_norm, nq, 512, 512);
  nv_rmsnorm<<<T_, 256, 0, stream>>>(proj + C_MKV, NC_, kv_norm, nkv, 512, 512);
  { GP p{}; p.A = nq; p.lda = 512; p.M = T_; p.B = w_uq; p.ldb = 1536; p.C = q; p.ldc = 1536; p.N = 1536; p.K = 512; launch_gemm(stream, p, T_, 1); }
  { GP p{}; p.A = nkv; p.lda = 512; p.M = T_; p.B = w_ukv; p.ldb = 2048; p.C = kv; p.ldc = 2048; p.N = 2048; p.K = 512; launch_gemm(stream, p, T_, 1); }
  nv_rope_q<<<(T_ * 8 * 32 + 255) / 256, 256, 0, stream>>>(q, cs);
  nv_rope_k<<<(T_ * 32 + 255) / 256, 256, 0, stream>>>(proj, cs, kpe);
  nv_attn<<<T_ * 8, 256, 0, stream>>>(q, kv, kpe, omla);
  nv_rmsnorm<<<T_, 256, 0, stream>>>(omla, 1024, mla_out_norm, mix + 1024, 2048, 1024);
  { GP p{}; p.A = mix; p.lda = 2048; p.M = T_; p.B = w_out; p.ldb = 2048; p.resid = x; p.ldr = 2048; p.C = x1; p.ldc = 2048; p.N = 2048; p.K = 2048; launch_gemm(stream, p, T_, 1); }
  nv_rmsnorm<<<T_, 256, 0, stream>>>(x1, 2048, ffn_norm, h2, 2048, 2048);
  nv_zero_counts<<<1, 64, 0, stream>>>(counts);
  nv_router<<<T_, 256, 0, stream>>>(h2, router_w, router_b, counts, list, asg_e, asg_slot, asg_g);
  nv_base<<<1, 64, 0, stream>>>(counts, base);
  { GP p{}; p.A = h2; p.lda = 2048; p.rowidx = list; p.rowidx_zs = T_; p.Mptr = counts; p.B = w_gu; p.ldb = 4096; p.Bzs = (long)2048 * 4096;
    p.bias = b_gu; p.bias_zs = 4096; p.C = gu; p.ldc = 4096; p.crow0 = base; p.N = 4096; p.K = 2048; launch_gemm(stream, p, T_, NE_); }
  nv_act<<<(int)(((long)T_ * 4 * 2048 + 255) / 256), 256, 0, stream>>>(gu, act, (long)T_ * 4);
  { GP p{}; p.A = act; p.lda = 2048; p.a_from_crow0 = 1; p.Mptr = counts; p.B = w_dn; p.ldb = 2048; p.Bzs = (long)2048 * 2048;
    p.bias = b_dn; p.bias_zs = 2048; p.C = y; p.ldc = 2048; p.crow0 = base; p.N = 2048; p.K = 2048; launch_gemm(stream, p, T_, NE_); }
  nv_final<<<T_, 256, 0, stream>>>(x1, y, base, asg_e, asg_slot, asg_g, final_norm, out);
}
```

```cpp
#define STAGE 5
#include <hip/hip_runtime.h>
#include <hip/hip_bf16.h>
#include <stdint.h>

#define T_      8192
#define SEQ_    4096
#define D_      2048
#define NC_     4176
#define C_GQ    0
#define C_GK    512
#define C_GV    1024
#define C_GR    2048
#define C_GD    3072
#define C_MQ    3088
#define C_MKV   3600
#define C_MKR   4112
#define NE_     32
#define DFF_    2048
#define EPS_    1e-6f

__device__ __forceinline__ float block_sum_256(float v, float* red) {
  for (int o = 32; o > 0; o >>= 1) v += __shfl_xor(v, o);
  __syncthreads();
  if ((threadIdx.x & 63) == 0) red[threadIdx.x >> 6] = v;
  __syncthreads();
  float r = red[0] + red[1] + red[2] + red[3];
  __syncthreads();
  return r;
}
__device__ __forceinline__ float block_max_256(float v, float* red) {
  for (int o = 32; o > 0; o >>= 1) v = fmaxf(v, __shfl_xor(v, o));
  __syncthreads();
  if ((threadIdx.x & 63) == 0) red[threadIdx.x >> 6] = v;
  __syncthreads();
  float r = fmaxf(fmaxf(red[0], red[1]), fmaxf(red[2], red[3]));
  __syncthreads();
  return r;
}

__global__ void __launch_bounds__(256) nv_rmsnorm(const float* in, int ldi, const float* g, float* out, int ldo, int cols) {
  __shared__ float red[4];
  const float* p = in + (long)blockIdx.x * ldi;
  float ss = 0.f;
  for (int c = threadIdx.x; c < cols; c += 256) { float v = p[c]; ss += v * v; }
  ss = block_sum_256(ss, red);
  float r = rsqrtf(ss / cols + EPS_);
  float* o = out + (long)blockIdx.x * ldo;
  for (int c = threadIdx.x; c < cols; c += 256) o[c] = p[c] * r * g[c];
}

struct GP {
  const float* A; int lda; const int* rowidx; int rowidx_zs;
  const int* Mptr; int M;
  const float* B; int ldb; long Bzs;
  const float* bias; int bias_zs;
  const float* resid; int ldr;
  float* C; int ldc; const int* crow0; int a_from_crow0;
  int N, K;
};
__global__ void __launch_bounds__(256) nv_gemm(GP p) {
  __shared__ float As[16][65];
  __shared__ float Bs[16][64];
  const int z = blockIdx.z;
  const int M = p.Mptr ? p.Mptr[z] : p.M;
  const int m0 = blockIdx.y * 64, n0 = blockIdx.x * 64;
  if (m0 >= M) return;
  const int crow0 = p.crow0 ? p.crow0[z] : 0;
  const float* B = p.B + (long)z * p.Bzs;
  const int* ridx = p.rowidx ? p.rowidx + (long)z * p.rowidx_zs : nullptr;
  const int tx = threadIdx.x & 15, ty = threadIdx.x >> 4;
  float acc[4][4];
  for (int i = 0; i < 4; ++i) for (int j = 0; j < 4; ++j) acc[i][j] = 0.f;
  const int ar = threadIdx.x >> 2, ak = (threadIdx.x & 3) * 4;
  long arow = -1;
  if (m0 + ar < M) {
    int m = m0 + ar;
    arow = ridx ? ridx[m] : (p.a_from_crow0 ? crow0 + m : m);
  }
  const int bk = threadIdx.x >> 4, bn = (threadIdx.x & 15) * 4;
  for (int k0 = 0; k0 < p.K; k0 += 16) {
    float4 av = make_float4(0.f, 0.f, 0.f, 0.f);
    if (arow >= 0) av = *(const float4*)(p.A + arow * p.lda + k0 + ak);
    As[ak + 0][ar] = av.x; As[ak + 1][ar] = av.y; As[ak + 2][ar] = av.z; As[ak + 3][ar] = av.w;
    float bv[4];
    for (int j = 0; j < 4; ++j) { int n = n0 + bn + j; bv[j] = (n < p.N) ? B[(long)(k0 + bk) * p.ldb + n] : 0.f; }
    Bs[bk][bn + 0] = bv[0]; Bs[bk][bn + 1] = bv[1]; Bs[bk][bn + 2] = bv[2]; Bs[bk][bn + 3] = bv[3];
    __syncthreads();
#pragma unroll
    for (int k = 0; k < 16; ++k) {
      float a[4], b[4];
      for (int i = 0; i < 4; ++i) a[i] = As[k][ty * 4 + i];
      for (int j = 0; j < 4; ++j) b[j] = Bs[k][tx * 4 + j];
      for (int i = 0; i < 4; ++i) for (int j = 0; j < 4; ++j) acc[i][j] = fmaf(a[i], b[j], acc[i][j]);
    }
    __syncthreads();
  }
  const float* bias = p.bias ? p.bias + (long)z * p.bias_zs : nullptr;
  for (int i = 0; i < 4; ++i) {
    int m = m0 + ty * 4 + i;
    if (m >= M) continue;
    for (int j = 0; j < 4; ++j) {
      int n = n0 + tx * 4 + j;
      if (n >= p.N) continue;
      float v = acc[i][j];
      if (bias) v += bias[n];
      if (p.resid) v += p.resid[(long)m * p.ldr + n];
      p.C[(long)(crow0 + m) * p.ldc + n] = v;
    }
  }
}

__global__ void nv_loga(float* z, long n) {
  long i = (long)blockIdx.x * blockDim.x + threadIdx.x;
  if (i >= n) return;
  float v = z[i];
  float ls = fminf(v, 0.f) - log1pf(expf(-fabsf(v)));
  z[i] = ls * (1.0f / 16.0f);
}

__global__ void __launch_bounds__(256) nv_gla(const float* proj, const float* loga, float* o  ) {
  __shared__ float sq[128], sk[128], sa[128];
  const int b = blockIdx.x >> 2, h = blockIdx.x & 3, dv = threadIdx.x;
  float S[128];
#pragma unroll
  for (int i = 0; i < 128; ++i) S[i] = 0.f;
  const float scale = 0.08838834764831845f;
  for (int s = 0; s < SEQ_; ++s) {
    const long t = (long)b * SEQ_ + s;
    const float* pr = proj + t * NC_;
    if (threadIdx.x < 128) {
      sq[threadIdx.x] = pr[C_GQ + h * 128 + threadIdx.x] * scale;
      sk[threadIdx.x] = pr[C_GK + h * 128 + threadIdx.x];
    } else {
      sa[threadIdx.x - 128] = expf(loga[t * 512 + h * 128 + (threadIdx.x - 128)]);
    }
    __syncthreads();
    const float v = pr[C_GV + h * 256 + dv];
    float acc = 0.f;
#pragma unroll
    for (int i = 0; i < 128; ++i) {
      S[i] = fmaf(sa[i], S[i], sk[i] * v);
      acc = fmaf(sq[i], S[i], acc);
    }
    o[t * 1024 + h * 256 + dv] = acc;
    __syncthreads();
  }
}

__global__ void __launch_bounds__(256) nv_gla_out(const float* o, const float* proj, const float* g, float* mix) {
  __shared__ float red[4];
  const long t = blockIdx.x >> 2; const int h = blockIdx.x & 3, dv = threadIdx.x;
  float v = o[t * 1024 + h * 256 + dv];
  float ss = block_sum_256(v * v, red);
  float r = rsqrtf(ss / 256.f + EPS_);
  float gr = proj[t * NC_ + C_GR + h * 256 + dv];
  float si = gr / (1.f + expf(-gr));
  mix[t * 2048 + h * 256 + dv] = v * r * g[dv] * si;
}

__global__ void nv_cs(const int* pos, float2* cs) {
  int i = blockIdx.x * blockDim.x + threadIdx.x;
  if (i >= T_ * 32) return;
  int t = i >> 5, f = i & 31;
  float inv = 1.0f / powf(10000.0f, (float)(2 * f) / 64.0f);
  float ang = (float)pos[t] * inv;
  double a = (double)ang;
  double k = rint(a * 0.15915494309189535);
  double r = fma(-k, 6.283185307179586, a);
  float rf = (float)r;
  cs[i] = make_float2(__cosf(rf), __sinf(rf));
}

__global__ void nv_rope_q(float* q, const float2* cs) {
  long i = (long)blockIdx.x * blockDim.x + threadIdx.x;
  if (i >= (long)T_ * 8 * 32) return;
  int f = i & 31; long th = i >> 5; long t = th >> 3;
  float* p = q + th * 192 + 128;
  float2 c = cs[t * 32 + f];
  float t1 = p[f], t2 = p[f + 32];
  p[f] = t1 * c.x - t2 * c.y;
  p[f + 32] = t1 * c.y + t2 * c.x;
}
__global__ void nv_rope_k(const float* proj, const float2* cs, float* kpe) {
  int i = blockIdx.x * blockDim.x + threadIdx.x;
  if (i >= T_ * 32) return;
  int f = i & 31, t = i >> 5;
  const float* p = proj + (long)t * NC_ + C_MKR;
  float2 c = cs[i];
  float t1 = p[f], t2 = p[f + 32];
  kpe[t * 64 + f] = t1 * c.x - t2 * c.y;
  kpe[t * 64 + f + 32] = t1 * c.y + t2 * c.x;
}

__global__ void __launch_bounds__(256) nv_attn(const float* q, const float* kv, const float* kpe, float* o) {
  __shared__ float sq[192];
  __shared__ float sc[SEQ_];
  __shared__ float red[4];
  __shared__ float so[128];
  const int qi = blockIdx.x % SEQ_; const int bh = blockIdx.x / SEQ_; const int h = bh & 7, b = bh >> 3;
  const long tq = (long)b * SEQ_ + qi;
  const float scale = 0.07216878364870322f;
  if (threadIdx.x < 192) sq[threadIdx.x] = q[(tq * 8 + h) * 192 + threadIdx.x] * scale;
  __syncthreads();
  float mx = -1e30f;
  for (int j = threadIdx.x; j <= qi; j += 256) {
    const long tk = (long)b * SEQ_ + j;
    const float* kn = kv + (tk * 8 + h) * 256;
    const float* kp = kpe + tk * 64;
    float s = 0.f;
    for (int d = 0; d < 128; ++d) s = fmaf(sq[d], kn[d], s);
    for (int d = 0; d < 64; ++d) s = fmaf(sq[128 + d], kp[d], s);
    sc[j] = s; mx = fmaxf(mx, s);
  }
  mx = block_max_256(mx, red);
  float sum = 0.f;
  for (int j = threadIdx.x; j <= qi; j += 256) { float e = expf(sc[j] - mx); sc[j] = e; sum += e; }
  sum = block_sum_256(sum, red);
  const int dv = threadIdx.x & 127, g = threadIdx.x >> 7;
  float acc = 0.f;
  for (int j = g; j <= qi; j += 2) acc = fmaf(sc[j], kv[(((long)b * SEQ_ + j) * 8 + h) * 256 + 128 + dv], acc);
  if (g == 1) so[dv] = acc;
  __syncthreads();
  if (g == 0) o[tq * 1024 + h * 128 + dv] = (acc + so[dv]) / sum;
}

__global__ void __launch_bounds__(256) nv_router(const float* h2, const float* rw, const float* rb, int* counts, int* list,
                                                 int* asg_e, int* asg_slot, float* asg_g) {
  __shared__ float part[8][32];
  __shared__ float lg[32];
  const int t = blockIdx.x;
  const int e = threadIdx.x & 31, seg = threadIdx.x >> 5;
  float acc = 0.f;
  const float* hp = h2 + (long)t * 2048;
  for (int k = seg * 256; k < seg * 256 + 256; ++k) acc = fmaf(hp[k], rw[k * 32 + e], acc);
  part[seg][e] = acc;
  __syncthreads();
  if (threadIdx.x < 32) {
    float s = rb[e];
    for (int i = 0; i < 8; ++i) s += part[i][e];
    lg[e] = s;
  }
  __syncthreads();
  if (threadIdx.x == 0) {
    int idx[4]; float val[4];
    unsigned used = 0;
    for (int k = 0; k < 4; ++k) {
      int bi = -1; float bv = 0.f;
      for (int i = 0; i < 32; ++i) {
        if (used & (1u << i)) continue;
        if (bi < 0 || lg[i] > bv) { bi = i; bv = lg[i]; }
      }
      used |= 1u << bi; idx[k] = bi; val[k] = bv;
    }
    float m = val[0];
    float ex[4], s = 0.f;
    for (int k = 0; k < 4; ++k) { ex[k] = expf(val[k] - m); s += ex[k]; }
    for (int k = 0; k < 4; ++k) {
      int slot = atomicAdd(&counts[idx[k]], 1);
      list[idx[k] * T_ + slot] = t;
      asg_e[t * 4 + k] = idx[k]; asg_slot[t * 4 + k] = slot; asg_g[t * 4 + k] = ex[k] / s;
    }
  }
}
__global__ void nv_zero_counts(int* counts) { if (threadIdx.x < 64) counts[threadIdx.x] = 0; }
__global__ void nv_base(const int* counts, int* base) {
  if (threadIdx.x == 0) { int s = 0; for (int e = 0; e < NE_; ++e) { base[e] = s; s += counts[e]; } }
}
__global__ void nv_act(const float* gu, float* act, long rows) {
  long i = (long)blockIdx.x * blockDim.x + threadIdx.x;
  if (i >= rows * 2048) return;
  long r = i >> 11; int j = i & 2047;
  float g = fminf(gu[r * 4096 + j], 7.0f);
  float u = fminf(fmaxf(gu[r * 4096 + 2048 + j], -7.0f), 7.0f);
  act[i] = (u + 1.0f) * (g / (1.0f + expf(-1.702f * g)));
}
__global__ void __launch_bounds__(256) nv_final(const float* x1, const float* y, const int* base, const int* asg_e, const int* asg_slot,
                                                const float* asg_g, const float* fg, float* out) {
  __shared__ float red[4];
  const long t = blockIdx.x;
  float v[8]; float ss = 0.f;
  long rows[4]; float gg[4];
  for (int k = 0; k < 4; ++k) { rows[k] = base[asg_e[t * 4 + k]] + asg_slot[t * 4 + k]; gg[k] = asg_g[t * 4 + k]; }
  for (int i = 0; i < 8; ++i) {
    int c = threadIdx.x + i * 256;
    float a = x1[t * 2048 + c];
    for (int k = 0; k < 4; ++k) a += gg[k] * y[rows[k] * 2048 + c];
    v[i] = a; ss += a * a;
  }
  ss = block_sum_256(ss, red);
  float r = rsqrtf(ss / 2048.f + EPS_);
  for (int i = 0; i < 8; ++i) { int c = threadIdx.x + i * 256; out[t * 2048 + c] = v[i] * r * fg[c]; }
}

typedef short bf16x8 __attribute__((ext_vector_type(8)));
typedef short s16x4 __attribute__((ext_vector_type(4)));
typedef float f32x16 __attribute__((ext_vector_type(16)));
typedef float f32x4 __attribute__((ext_vector_type(4)));
typedef float f32x2 __attribute__((ext_vector_type(2)));
typedef unsigned short u16;
typedef unsigned u32x4 __attribute__((ext_vector_type(4)));
typedef unsigned u32x2 __attribute__((ext_vector_type(2)));
#define LAS3 __attribute__((address_space(3)))
#define OPAQUE(x) asm volatile("" : "+v"(x))
#define NTHR 256

__device__ __forceinline__ unsigned pack_bf16(float a, float b) {
  typedef __bf16 bf2 __attribute__((ext_vector_type(2)));
  typedef float f2 __attribute__((ext_vector_type(2)));
  f2 v = {a, b};
  bf2 r = __builtin_convertvector(v, bf2);
  return *(unsigned*)&r;
}
__device__ __forceinline__ float bf_lo(unsigned w) { return __uint_as_float(w << 16); }
__device__ __forceinline__ float bf_hi(unsigned w) { return __uint_as_float(w & 0xffff0000u); }
__device__ __forceinline__ float bf16_to_f32(u16 v) { return __uint_as_float(((unsigned)v) << 16); }
__device__ __forceinline__ u16 f32_to_bf16(float f) { return (u16)(pack_bf16(f, 0.f) & 0xffffu); }
__device__ __forceinline__ float wave_sum(float v) {
#pragma unroll
  for (int o = 32; o > 0; o >>= 1) v += __shfl_xor(v, o);
  return v;
}
__device__ __forceinline__ unsigned off_b(unsigned row, unsigned ch) { return 256u * row + 16u * (ch ^ (((row & 3u) << 2) | ((row >> 2) & 3u))); }
__device__ __forceinline__ unsigned tr_addr(unsigned lane, unsigned c, unsigned row0  ) {
  const unsigned blk = (lane >> 4) & 1u, q = (lane & 15u) >> 2, p = lane & 3u;
  return off_b(row0 + q, 4u * c + 2u * blk + (p >> 1)) + 8u * (p & 1u);
}
__device__ __forceinline__ bf16x8 tr_frag(const char* img, unsigned lane, unsigned c, unsigned row_a, unsigned row_b) {
  s16x4 v0 = __builtin_amdgcn_ds_read_tr16_b64_v4i16((LAS3 s16x4*)(img + tr_addr(lane, c, row_a)));
  s16x4 v1 = __builtin_amdgcn_ds_read_tr16_b64_v4i16((LAS3 s16x4*)(img + tr_addr(lane, c, row_b)));
  return (bf16x8){v0[0], v0[1], v0[2], v0[3], v1[0], v1[1], v1[2], v1[3]};
}

struct Params {
  const float *x; const int* pos;
  const float *attn_norm, *w_in, *gate_up, *gate_bias, *gla_out_norm, *q_norm, *w_uq, *kv_norm, *w_ukv, *mla_out_norm, *w_out,
              *ffn_norm, *router_w, *router_b, *w_gu, *b_gu, *w_dn, *b_dn, *final_norm;
  float* out;
  u16 *h1, *proj, *q, *kv, *kpe, *mix, *omla, *h2, *act, *ybuf, *kvc, *sprev;
  float *bcum, *rq, *rkv, *x1, *dec, *asg_g;
  float2* cs;
  int *counts, *list, *asg_e, *asg_slot;
  unsigned* bar;
};
#define G_A_OFF(s)  ((s) * 65536)
#define G_B_OFF(s)  ((s) * 65536 + 32768)
#define G_LDS_BYTES 131072

struct GemmTile {
  const u16* A; int lda;
  const int* aidx;
  int m0, mvalid;
  const float* B0; const float* B1;
  int ldb; int nv0, nv1;
  const float* kscale;
  int K;
};

template <int NB, bool KSCALE>
__device__ __forceinline__ void gemm_tile_256(const GemmTile& t, char* smem, f32x16 (&acc)[4][4]) {
  int tz0 = threadIdx.x; asm volatile("" : "+v"(tz0));
  const int tid = tz0, lane = tid & 63, wid = tid >> 6, wr = wid >> 1, wc = wid & 1;
  const int l31 = lane & 31, hh = lane >> 5;
#pragma unroll
  for (int i = 0; i < 4; ++i)
#pragma unroll
    for (int j = 0; j < 4; ++j)
#pragma unroll
      for (int r = 0; r < 16; ++r) acc[i][j][r] = 0.f;

  const int a_c = (tid & 7) ^ ((tid >> 4) & 7);
  const u16* a_src[8];
#pragma unroll
  for (int i = 0; i < 8; ++i) {
    int r = (tid >> 3) + 32 * i;
    int rr = r < t.mvalid ? r : 0;
    long grow = t.aidx ? (long)t.aidx[rr] : (long)(t.m0 + rr);
    a_src[i] = t.A + grow * t.lda + a_c * 8;
  }
  const int b_n8 = tid & 31, b_k = tid >> 5;
  const int b_img = b_n8 >> 4, b_ch = b_n8 & 15;
  const bool b_ok = (b_ch * 8) < (b_img ? t.nv1 : t.nv0);
  const float* b_src = b_ok ? ((b_img ? t.B1 : t.B0) + b_ch * 8) : t.B0;
  f32x4 breg[16];

  auto issue_a = [&](int kt, int s) {
#pragma unroll
    for (int i = 0; i < 8; ++i)
      __builtin_amdgcn_global_load_lds((const void*)(a_src[i] + kt * 64), (LAS3 void*)(smem + G_A_OFF(s) + i * 4096 + tid * 16), 16, 0, 0);
  };
  auto issue_b = [&](int kt) {
#pragma unroll
    for (int j = 0; j < 8; ++j) {
      const float* p = b_src + (long)(kt * 64 + b_k + 8 * j) * t.ldb;
      breg[2 * j] = *(const f32x4*)p; breg[2 * j + 1] = *(const f32x4*)(p + 4);
    }
  };
  auto write_b = [&](int kt, int s) {
#pragma unroll
    for (int j = 0; j < 8; ++j) {
      const int k = b_k + 8 * j;
      f32x4 lo = breg[2 * j], hi = breg[2 * j + 1];
      if (KSCALE) { float sc = t.kscale[kt * 64 + k]; lo *= sc; hi *= sc; }
      if (!b_ok) { lo = (f32x4){0.f, 0.f, 0.f, 0.f}; hi = lo; }
      u32x4 w = {pack_bf16(lo[0], lo[1]), pack_bf16(lo[2], lo[3]), pack_bf16(hi[0], hi[1]), pack_bf16(hi[2], hi[3])};
      *(u32x4*)(smem + G_B_OFF(s) + b_img * 16384 + off_b(k, b_ch)) = w;
    }
  };
  unsigned a_rd[4], b_rd[2][2];
#pragma unroll
  for (int ks = 0; ks < 4; ++ks) { const int row = wr * 128 + l31; a_rd[ks] = row * 128 + (((2 * ks + hh) ^ ((row >> 1) & 7)) * 16); }
#pragma unroll
  for (int tt = 0; tt < 2; ++tt)
#pragma unroll
    for (int nl = 0; nl < 2; ++nl) b_rd[tt][nl] = tr_addr(lane, wc * 2 + nl, 8 * hh + 4 * tt);
  auto compute = [&](int s) {
    const char* As = smem + G_A_OFF(s);
    const char* Bs = smem + G_B_OFF(s);
#pragma unroll
    for (int ks = 0; ks < 4; ++ks) {
      bf16x8 af[4], bfr[NB];
#pragma unroll
      for (int mb = 0; mb < 4; ++mb) af[mb] = *(const bf16x8*)(As + a_rd[ks] + mb * 4096);
#pragma unroll
      for (int nb = 0; nb < NB; ++nb) {
        const char* bi = Bs + (nb >> 1) * 16384 + ks * 4096;
        s16x4 v0 = __builtin_amdgcn_ds_read_tr16_b64_v4i16((LAS3 s16x4*)(bi + b_rd[0][nb & 1]));
        s16x4 v1 = __builtin_amdgcn_ds_read_tr16_b64_v4i16((LAS3 s16x4*)(bi + b_rd[1][nb & 1]));
        bfr[nb] = (bf16x8){v0[0], v0[1], v0[2], v0[3], v1[0], v1[1], v1[2], v1[3]};
      }
#pragma unroll
      for (int mb = 0; mb < 4; ++mb)
#pragma unroll
        for (int nb = 0; nb < NB; ++nb)
          acc[mb][nb] = __builtin_amdgcn_mfma_f32_32x32x16_bf16(af[mb], bfr[nb], acc[mb][nb], 0, 0, 0);
    }
  };

  const int nk = t.K >> 6;
  __syncthreads();
  issue_b(0); issue_a(0, 0);
  asm volatile("s_waitcnt vmcnt(8)" ::: "memory");
  write_b(0, 0);
  if (nk > 1) { issue_b(1); asm volatile("s_waitcnt vmcnt(16)" ::: "memory"); }
  else asm volatile("s_waitcnt vmcnt(0)" ::: "memory");
  __syncthreads();
  if (nk > 1) issue_a(1, 1);
  for (int kt = 0; kt < nk; ++kt) {
    const int s = kt & 1;
    compute(s);
    if (kt + 1 < nk) {
      asm volatile("s_waitcnt vmcnt(0)" ::: "memory");
      write_b(kt + 1, s ^ 1);
      if (kt + 2 < nk) issue_b(kt + 2);
      __syncthreads();
      if (kt + 2 < nk) issue_a(kt + 2, s);
    }
  }
}
template <int NB, class F>
__device__ __forceinline__ void acc_foreach_row(f32x16 (&acc)[4][4], F f) {
  int tz = threadIdx.x; asm volatile("" : "+v"(tz));
  const int lane = tz & 63, wid = tz >> 6, wr = wid >> 1, wc = wid & 1;
  const int l31 = lane & 31, hh = lane >> 5;
#pragma unroll
  for (int mb = 0; mb < 4; ++mb)
#pragma unroll
    for (int reg = 0; reg < 16; ++reg) {
      const int rowl = wr * 128 + mb * 32 + (reg & 3) + 8 * (reg >> 2) + 4 * hh;
      float v[NB];
#pragma unroll
      for (int nb = 0; nb < NB; ++nb) v[nb] = acc[mb][nb][reg];
      f(rowl, wc * 64 + l31, v);
      asm volatile("" ::: "memory");
    }
}
__device__ __forceinline__ void ph_prep0(const Params& p) {
  const int lane = threadIdx.x & 63, wid = threadIdx.x >> 6;
  if (blockIdx.x == 0 && threadIdx.x < 64) p.counts[threadIdx.x] = 0;
  for (int t = blockIdx.x * 4 + wid; t < T_; t += gridDim.x * 4) {
    const float* xr = p.x + (long)t * 2048;
    f32x4 v[8]; float ss = 0.f;
#pragma unroll
    for (int j = 0; j < 8; ++j) { v[j] = *(const f32x4*)(xr + j * 256 + lane * 4); ss += v[j][0] * v[j][0] + v[j][1] * v[j][1] + v[j][2] * v[j][2] + v[j][3] * v[j][3]; }
    ss = wave_sum(ss);
    const float r = rsqrtf(ss * (1.0f / 2048.0f) + EPS_);
#pragma unroll
    for (int j = 0; j < 8; ++j) {
      f32x4 g = *(const f32x4*)(p.attn_norm + j * 256 + lane * 4);
      u32x2 w = {pack_bf16(v[j][0] * r * g[0], v[j][1] * r * g[1]), pack_bf16(v[j][2] * r * g[2], v[j][3] * r * g[3])};
      *(u32x2*)(p.h1 + (long)t * 2048 + j * 256 + lane * 4) = w;
    }
    if (lane < 32) {
      float inv = 1.0f / powf(10000.0f, (float)(2 * lane) / 64.0f);
      float ang = (float)p.pos[t] * inv;
      double a = (double)ang;
      double k = rint(a * 0.15915494309189535);
      float rf = (float)fma(-k, 6.283185307179586, a);
      p.cs[t * 32 + lane] = make_float2(__cosf(rf), __sinf(rf));
    }
  }
}

template <int NB>
__device__ __forceinline__ void win_tile(const Params& p, char* smem, int mt, int nt) {
  f32x16 acc[4][4];
  GemmTile t{};
  t.A = p.h1; t.lda = 2048; t.aidx = nullptr; t.m0 = mt * 256; t.mvalid = 256;
  t.B0 = p.w_in + nt * 256; t.B1 = t.B0 + 128; t.ldb = NC_;
  const int rem = NC_ - nt * 256;
  t.nv0 = rem >= 128 ? 128 : rem; t.nv1 = rem >= 256 ? 128 : (rem > 128 ? rem - 128 : 0);
  t.kscale = nullptr; t.K = 2048;
  gemm_tile_256<NB, false>(t, smem, acc);
  u16* base = p.proj + (long)(mt * 256) * NC_ + nt * 256;
  const int nv0 = t.nv0, nv1 = t.nv1;
  acc_foreach_row<NB>(acc, [&](int rowl, int coll, float (&v)[NB]) {
    u16* rp = base + (long)rowl * NC_ + coll;
    OPAQUE(rp);
#pragma unroll
    for (int nb = 0; nb < NB; ++nb) {
      const int c = (nb & 1) * 32 + coll;
      const int lim = (nb >> 1) ? nv1 : nv0;
      if (c < lim) rp[(nb >> 1) * 128 + (nb & 1) * 32] = f32_to_bf16(v[nb]);
    }
  });
}
__device__ __forceinline__ void ph_win(const Params& p, char* smem) {
  const int x = blockIdx.x & 7, slot = blockIdx.x >> 3;
  for (int j = slot; j < 64; j += 32) win_tile<4>(p, smem, 4 * x + (j & 3), j >> 2);
  if (slot < 4) win_tile<2>(p, smem, 4 * x + slot, 16);
}

__device__ __forceinline__ void ph_prep1(const Params& p, char* smem) {
  float* gds = (float*)smem;
  float* cums = (float*)(smem + 4096);
  const int tid = threadIdx.x, lane = tid & 63, wid = tid >> 6;
  for (int u = blockIdx.x; u < 512; u += gridDim.x) {
    const int ch = u >> 2, h = u & 3; const int t0 = ch * 64;
    __syncthreads();
    {
      const int tl = tid >> 2, r4 = (tid & 3) * 4;
      u32x2 w = *(const u32x2*)(p.proj + (long)(t0 + tl) * NC_ + C_GD + r4);
      gds[tl * 16 + r4 + 0] = bf_lo(w[0]); gds[tl * 16 + r4 + 1] = bf_hi(w[0]);
      gds[tl * 16 + r4 + 2] = bf_lo(w[1]); gds[tl * 16 + r4 + 3] = bf_hi(w[1]);
    }
    const int c = tid & 127, half = tid >> 7;
    float gu[16];
#pragma unroll
    for (int r = 0; r < 16; ++r) gu[r] = p.gate_up[r * 512 + h * 128 + c];
    const float bias = p.gate_bias[h * 128 + c];
    __syncthreads();
    float run = 0.f;
    for (int i = 0; i < 32; ++i) {
      const int tl = half * 32 + i;
      float z = bias;
#pragma unroll
      for (int r = 0; r < 16; ++r) z = fmaf(gds[tl * 16 + r], gu[r], z);
      const float ls = fminf(z, 0.f) - log1pf(__expf(-fabsf(z)));
      run += ls * (1.0f / 16.0f);
      cums[tl * 128 + c] = run;
    }
    __syncthreads();
    {
      const float add = cums[31 * 128 + c];
      for (int i = 0; i < 32; ++i) {
        const int tl = half * 32 + i;
        float v = cums[tl * 128 + c] + (half ? add : 0.f);
        p.bcum[(long)(t0 + tl) * 512 + h * 128 + c] = v;
      }
    }
    for (int i = 0; i < 4; ++i) {
      const long t = t0 + h * 16 + wid * 4 + i;
      const u16* pr = p.proj + t * NC_;
      u32x4 a = *(const u32x4*)(pr + C_MQ + lane * 8);
      u32x4 b = *(const u32x4*)(pr + C_MKV + lane * 8);
      float sa = 0.f, sb = 0.f;
#pragma unroll
      for (int k = 0; k < 4; ++k) { float l = bf_lo(a[k]), hgh = bf_hi(a[k]); sa += l * l + hgh * hgh; l = bf_lo(b[k]); hgh = bf_hi(b[k]); sb += l * l + hgh * hgh; }
      sa = wave_sum(sa); sb = wave_sum(sb);
      if (lane == 0) { p.rq[t] = rsqrtf(sa * (1.0f / 512.0f) + EPS_); p.rkv[t] = rsqrtf(sb * (1.0f / 512.0f) + EPS_); }
      if (lane < 32) {
        const float t1 = bf16_to_f32(pr[C_MKR + lane]), t2 = bf16_to_f32(pr[C_MKR + lane + 32]);
        const float2 cs = p.cs[t * 32 + lane];
        p.kpe[t * 64 + lane] = f32_to_bf16(t1 * cs.x - t2 * cs.y);
        p.kpe[t * 64 + lane + 32] = f32_to_bf16(t1 * cs.y + t2 * cs.x);
      }
    }
  }
}

#define QSCALE_ (0.07216878364870322f * 1.4426950408889634f)
__device__ __forceinline__ void upq_tile(const Params& p, char* smem, int mt, int nt) {
  f32x16 acc[4][4];
  GemmTile t{};
  t.A = p.proj + C_MQ; t.lda = NC_; t.aidx = nullptr; t.m0 = mt * 256; t.mvalid = 256;
  t.B0 = p.w_uq + nt * 256; t.B1 = t.B0 + 128; t.ldb = 1536; t.nv0 = 128; t.nv1 = 128; t.kscale = p.q_norm; t.K = 512;
  gemm_tile_256<4, true>(t, smem, acc);
  u16* base = p.q + (long)(mt * 256) * 1536 + nt * 256;
  const float* rq = p.rq + mt * 256;
  acc_foreach_row<4>(acc, [&](int rowl, int coll, float (&v)[4]) {
    u16* rp = base + (long)rowl * 1536 + coll;
    OPAQUE(rp);
    const float s = rq[rowl] * QSCALE_;
#pragma unroll
    for (int nb = 0; nb < 4; ++nb) rp[(nb >> 1) * 128 + (nb & 1) * 32] = f32_to_bf16(v[nb] * s);
  });
}
__device__ __forceinline__ void upkv_tile(const Params& p, char* smem, int mt, int nt) {
  f32x16 acc[4][4];
  GemmTile t{};
  t.A = p.proj + C_MKV; t.lda = NC_; t.aidx = nullptr; t.m0 = mt * 256; t.mvalid = 256;
  t.B0 = p.w_ukv + nt * 256; t.B1 = t.B0 + 128; t.ldb = 2048; t.nv0 = 128; t.nv1 = 128; t.kscale = p.kv_norm; t.K = 512;
  gemm_tile_256<4, true>(t, smem, acc);
  u16* base = p.kv + (long)(mt * 256) * 2048 + nt * 256;
  const float* rk = p.rkv + mt * 256;
  acc_foreach_row<4>(acc, [&](int rowl, int coll, float (&v)[4]) {
    u16* rp = base + (long)rowl * 2048 + coll;
    OPAQUE(rp);
    const float s = rk[rowl];
#pragma unroll
    for (int nb = 0; nb < 4; ++nb) rp[(nb >> 1) * 128 + (nb & 1) * 32] = f32_to_bf16(v[nb] * s);
  });
}
#define AT_KSTRIDE 400
#define AT_KBYTES  (64 * AT_KSTRIDE)
#define AT_STAGE   (AT_KBYTES + 16384)
#define AT_LDS_BYTES (2 * AT_STAGE)

__device__ __forceinline__ void attn_unit(const Params& p, char* smem, int b, int h, int qb) {
  const int tid = threadIdx.x, lane = tid & 63, wid = tid >> 6, l31 = lane & 31, hh = lane >> 5;
  const long tq = (long)b * SEQ_ + qb * 128 + wid * 32 + l31;
  bf16x8 qf[12];
  {
    const u16* qp = p.q + (tq * 8 + h) * 192 + 8 * hh;
#pragma unroll
    for (int ks = 0; ks < 12; ++ks) qf[ks] = *(const bf16x8*)(qp + 16 * ks);
#pragma unroll
    for (int s = 0; s < 2; ++s) {
      const float2* cp = p.cs + tq * 32 + 16 * s + 8 * hh;
      bf16x8 lo = qf[8 + s], hi = qf[10 + s], nlo, nhi;
#pragma unroll
      for (int j = 0; j < 8; j += 2) {
        float2 c0 = cp[j], c1 = cp[j + 1];
        float a0 = bf16_to_f32((u16)lo[j]), a1 = bf16_to_f32((u16)lo[j + 1]);
        float b0 = bf16_to_f32((u16)hi[j]), b1 = bf16_to_f32((u16)hi[j + 1]);
        unsigned wl = pack_bf16(a0 * c0.x - b0 * c0.y, a1 * c1.x - b1 * c1.y);
        unsigned wh = pack_bf16(a0 * c0.y + b0 * c0.x, a1 * c1.y + b1 * c1.x);
        nlo[j] = (short)(wl & 0xffff); nlo[j + 1] = (short)(wl >> 16);
        nhi[j] = (short)(wh & 0xffff); nhi[j + 1] = (short)(wh >> 16);
      }
      qf[8 + s] = nlo; qf[10 + s] = nhi;
    }
  }
  int k_key[6], k_c[6];
#pragma unroll
  for (int i = 0; i < 6; ++i) { int pp = i * 256 + tid; k_key[i] = pp / 24; k_c[i] = pp % 24; }
  u32x4 kreg[6], vreg[4];
  const long tk0 = (long)b * SEQ_;
  auto load_tile = [&](int kt) {
#pragma unroll
    for (int i = 0; i < 6; ++i) {
      const long t = tk0 + kt * 64 + k_key[i];
      const u16* src = (k_c[i] < 16) ? (p.kv + (t * 8 + h) * 256 + k_c[i] * 8) : (p.kpe + t * 64 + (k_c[i] - 16) * 8);
      kreg[i] = *(const u32x4*)src;
    }
#pragma unroll
    for (int i = 0; i < 4; ++i) {
      const int pp = i * 256 + tid; const int key = pp >> 4, c = pp & 15;
      vreg[i] = *(const u32x4*)(p.kv + ((tk0 + kt * 64 + key) * 8 + h) * 256 + 128 + c * 8);
    }
  };
  auto store_tile = [&](int s) {
    char* Ks = smem + s * AT_STAGE; char* Vs = Ks + AT_KBYTES;
#pragma unroll
    for (int i = 0; i < 6; ++i) *(u32x4*)(Ks + k_key[i] * AT_KSTRIDE + k_c[i] * 16) = kreg[i];
#pragma unroll
    for (int i = 0; i < 4; ++i) { const int pp = i * 256 + tid; *(u32x4*)(Vs + off_b(pp >> 4, pp & 15)) = vreg[i]; }
  };

  f32x16 o[4];
#pragma unroll
  for (int c = 0; c < 4; ++c)
#pragma unroll
    for (int r = 0; r < 16; ++r) o[c][r] = 0.f;
  float m = -1e30f, l = 0.f;
  const int nt = 2 * qb + 2;
  const int qpos = qb * 128 + wid * 32 + l31;

  __syncthreads();
  load_tile(0);
  store_tile(0);
  if (nt > 1) load_tile(1);
  __syncthreads();
  for (int kt = 0; kt < nt; ++kt) {
    const int s = kt & 1;
    const char* Ks = smem + s * AT_STAGE; const char* Vs = Ks + AT_KBYTES;
    const bool active = (kt * 64) <= (qb * 128 + wid * 32 + 31);
    if (active) {
      f32x16 sc[2];
#pragma unroll
      for (int kb = 0; kb < 2; ++kb) {
#pragma unroll
        for (int r = 0; r < 16; ++r) sc[kb][r] = 0.f;
#pragma unroll
        for (int ks = 0; ks < 12; ++ks) {
          bf16x8 a = *(const bf16x8*)(Ks + (kb * 32 + l31) * AT_KSTRIDE + (2 * ks + hh) * 16);
          sc[kb] = __builtin_amdgcn_mfma_f32_32x32x16_bf16(a, qf[ks], sc[kb], 0, 0, 0);
        }
      }
      if (kt >= 2 * qb) {
#pragma unroll
        for (int kb = 0; kb < 2; ++kb)
#pragma unroll
          for (int r = 0; r < 16; ++r) {
            const int key = kt * 64 + kb * 32 + (r & 3) + 8 * (r >> 2) + 4 * hh;
            if (key > qpos) sc[kb][r] = -1e30f;
          }
      }
      float mx = sc[0][0];
#pragma unroll
      for (int kb = 0; kb < 2; ++kb)
#pragma unroll
        for (int r = 0; r < 16; ++r) mx = fmaxf(mx, sc[kb][r]);
      mx = fmaxf(mx, __shfl_xor(mx, 32));
      const float mn = fmaxf(m, mx);
      const float alpha = exp2f(m - mn);
      m = mn;
      float ps = 0.f;
      bf16x8 pf[4];
#pragma unroll
      for (int kb = 0; kb < 2; ++kb)
#pragma unroll
        for (int s2 = 0; s2 < 2; ++s2) {
          float e[8];
#pragma unroll
          for (int j = 0; j < 8; ++j) { e[j] = exp2f(sc[kb][8 * s2 + j] - mn); ps += e[j]; }
          unsigned w0 = pack_bf16(e[0], e[1]), w1 = pack_bf16(e[2], e[3]), w2 = pack_bf16(e[4], e[5]), w3 = pack_bf16(e[6], e[7]);
          u32x4 w = {w0, w1, w2, w3};
          pf[kb * 2 + s2] = *(bf16x8*)&w;
        }
      l = l * alpha + ps;
#pragma unroll
      for (int c = 0; c < 4; ++c)
#pragma unroll
        for (int r = 0; r < 16; ++r) o[c][r] *= alpha;
#pragma unroll
      for (int c = 0; c < 4; ++c)
#pragma unroll
        for (int kk = 0; kk < 4; ++kk) {
          const unsigned rbase = 32 * (kk >> 1) + 16 * (kk & 1) + 4 * hh;
          bf16x8 a = tr_frag(Vs, lane, c, rbase, rbase + 8);
          o[c] = __builtin_amdgcn_mfma_f32_32x32x16_bf16(a, pf[kk], o[c], 0, 0, 0);
        }
    }
    if (kt + 1 < nt) {
      store_tile(s ^ 1);
      if (kt + 2 < nt) load_tile(kt + 2);
      __syncthreads();
    }
  }
  l = l + __shfl_xor(l, 32);
  const float inv = 1.0f / l;
  u16* op = p.omla + tq * 1024 + h * 128 + 4 * hh;
#pragma unroll
  for (int c = 0; c < 4; ++c)
#pragma unroll
    for (int rg = 0; rg < 4; ++rg) {
      u32x2 w = {pack_bf16(o[c][4 * rg] * inv, o[c][4 * rg + 1] * inv), pack_bf16(o[c][4 * rg + 2] * inv, o[c][4 * rg + 3] * inv)};
      *(u32x2*)(op + 32 * c + 8 * rg) = w;
    }
}

#define G1_LDS_BYTES 49152
__device__ __forceinline__ void gla_g1_unit(const Params& p, char* smem, int u) {
  const int tid = threadIdx.x, lane = tid & 63, wid = tid >> 6, l31 = lane & 31, hh = lane >> 5;
  const int bh = u >> 6, n = u & 63, b = bh >> 2, h = bh & 3;
  const long t0 = (long)b * SEQ_ + n * 64;
  char* Ks = smem; char* Vs = smem + 16384;
  __syncthreads();
  {
    const int ch = tid & 15;
    const float* bl = p.bcum + (t0 + 63) * 512 + h * 128 + ch * 8;
    f32x4 bl0 = *(const f32x4*)bl, bl1 = *(const f32x4*)(bl + 4);
    if (tid < 128) p.dec[(long)u * 128 + tid] = __expf(p.bcum[(t0 + 63) * 512 + h * 128 + tid]);
#pragma unroll
    for (int i = 0; i < 4; ++i) {
      const int tok = (i * 256 + tid) >> 4;
      u32x4 kw = *(const u32x4*)(p.proj + (t0 + tok) * NC_ + C_GK + h * 128 + ch * 8);
      const float* bp = p.bcum + (t0 + tok) * 512 + h * 128 + ch * 8;
      f32x4 b0 = *(const f32x4*)bp, b1 = *(const f32x4*)(bp + 4);
      u32x4 w;
      w[0] = pack_bf16(bf_lo(kw[0]) * __expf(bl0[0] - b0[0]), bf_hi(kw[0]) * __expf(bl0[1] - b0[1]));
      w[1] = pack_bf16(bf_lo(kw[1]) * __expf(bl0[2] - b0[2]), bf_hi(kw[1]) * __expf(bl0[3] - b0[3]));
      w[2] = pack_bf16(bf_lo(kw[2]) * __expf(bl1[0] - b1[0]), bf_hi(kw[2]) * __expf(bl1[1] - b1[1]));
      w[3] = pack_bf16(bf_lo(kw[3]) * __expf(bl1[2] - b1[2]), bf_hi(kw[3]) * __expf(bl1[3] - b1[3]));
      *(u32x4*)(Ks + off_b(tok, ch)) = w;
    }
#pragma unroll
    for (int i = 0; i < 8; ++i) {
      const int pp = i * 256 + tid; const int tok = pp >> 5, c32 = pp & 31;
      u32x4 vw = *(const u32x4*)(p.proj + (t0 + tok) * NC_ + C_GV + h * 256 + c32 * 8);
      *(u32x4*)(Vs + (c32 >> 4) * 16384 + off_b(tok, c32 & 15)) = vw;
    }
  }
  __syncthreads();
  f32x16 acc[4][2];
#pragma unroll
  for (int mb = 0; mb < 4; ++mb)
#pragma unroll
    for (int nb = 0; nb < 2; ++nb)
#pragma unroll
      for (int r = 0; r < 16; ++r) acc[mb][nb][r] = 0.f;
  const char* Vimg = Vs + (wid >> 1) * 16384;
#pragma unroll
  for (int ks = 0; ks < 4; ++ks) {
    bf16x8 af[4], bfr[2];
    const unsigned r0 = 16 * ks + 8 * hh;
#pragma unroll
    for (int mb = 0; mb < 4; ++mb) af[mb] = tr_frag(Ks, lane, mb, r0, r0 + 4);
#pragma unroll
    for (int nb = 0; nb < 2; ++nb) bfr[nb] = tr_frag(Vimg, lane, 2 * (wid & 1) + nb, r0, r0 + 4);
#pragma unroll
    for (int mb = 0; mb < 4; ++mb)
#pragma unroll
      for (int nb = 0; nb < 2; ++nb) acc[mb][nb] = __builtin_amdgcn_mfma_f32_32x32x16_bf16(af[mb], bfr[nb], acc[mb][nb], 0, 0, 0);
  }
  u16* base = p.kvc + (long)u * 32768 + wid * 64 + l31;
#pragma unroll
  for (int mb = 0; mb < 4; ++mb)
#pragma unroll
    for (int r = 0; r < 16; ++r) {
      const int dk = mb * 32 + (r & 3) + 8 * (r >> 2) + 4 * hh;
      u16* rp = base + dk * 256;
      rp[0] = f32_to_bf16(acc[mb][0][r]);
      rp[32] = f32_to_bf16(acc[mb][1][r]);
    }
}

__device__ __forceinline__ void gla_g2_unit(const Params& p, int u) {
  const int tid = threadIdx.x;
  const int bh = u >> 5, part = u & 31;
  const int dk = part * 4 + (tid >> 6), dv = (tid & 63) * 4;
  float s0 = 0.f, s1 = 0.f, s2 = 0.f, s3 = 0.f;
  const long ebase = (long)dk * 256 + dv;
#pragma unroll 8
  for (int n = 0; n < 64; ++n) {
    const long un = (long)(bh * 64 + n);
    u32x2 kw = *(const u32x2*)(p.kvc + un * 32768 + ebase);
    const float d = p.dec[un * 128 + dk];
    u32x2 w = {pack_bf16(s0, s1), pack_bf16(s2, s3)};
    *(u32x2*)(p.sprev + un * 32768 + ebase) = w;
    s0 = fmaf(d, s0, bf_lo(kw[0])); s1 = fmaf(d, s1, bf_hi(kw[0]));
    s2 = fmaf(d, s2, bf_lo(kw[1])); s3 = fmaf(d, s3, bf_hi(kw[1]));
  }
}

#define G3_LDS_BYTES (16384 + 16384 + 32768 + 65536 + 1024)
__device__ __forceinline__ void gla_g3_unit(const Params& p, char* smem, int u) {
  const int tid = threadIdx.x, lane = tid & 63, wid = tid >> 6, l31 = lane & 31, hh = lane >> 5;
  const int bh = u >> 6, n = u & 63, b = bh >> 2, h = bh & 3;
  const long t0 = (long)b * SEQ_ + n * 64;
  char* Qd = smem; char* Ki = smem + 16384; char* Vs = smem + 32768; char* Sp = smem + 65536; float* red = (float*)(smem + 131072);
  __syncthreads();
  {
    const int ch = tid & 15;
    const float qs = 0.08838834764831845f;
#pragma unroll
    for (int i = 0; i < 4; ++i) {
      const int tok = (i * 256 + tid) >> 4;
      const u16* pr = p.proj + (t0 + tok) * NC_ + h * 128 + ch * 8;
      u32x4 qw = *(const u32x4*)(pr + C_GQ), kw = *(const u32x4*)(pr + C_GK);
      const float* bp = p.bcum + (t0 + tok) * 512 + h * 128 + ch * 8;
      f32x4 b0 = *(const f32x4*)bp, b1 = *(const f32x4*)(bp + 4);
      float e[8] = {__expf(b0[0]), __expf(b0[1]), __expf(b0[2]), __expf(b0[3]), __expf(b1[0]), __expf(b1[1]), __expf(b1[2]), __expf(b1[3])};
      u32x4 wq, wk;
#pragma unroll
      for (int k = 0; k < 4; ++k) {
        wq[k] = pack_bf16(bf_lo(qw[k]) * qs * e[2 * k], bf_hi(qw[k]) * qs * e[2 * k + 1]);
        wk[k] = pack_bf16(bf_lo(kw[k]) / e[2 * k], bf_hi(kw[k]) / e[2 * k + 1]);
      }
      *(u32x4*)(Qd + off_b(tok, ch)) = wq;
      *(u32x4*)(Ki + off_b(tok, ch)) = wk;
    }
#pragma unroll
    for (int i = 0; i < 8; ++i) {
      const int pp = i * 256 + tid; const int tok = pp >> 5, c32 = pp & 31;
      u32x4 vw = *(const u32x4*)(p.proj + (t0 + tok) * NC_ + C_GV + h * 256 + c32 * 8);
      *(u32x4*)(Vs + (c32 >> 4) * 16384 + off_b(tok, c32 & 15)) = vw;
    }
#pragma unroll
    for (int i = 0; i < 16; ++i) {
      const int pp = i * 256 + tid; const int dk = pp >> 5, c32 = pp & 31;
      u32x4 sw = *(const u32x4*)(p.sprev + (long)u * 32768 + dk * 256 + c32 * 8);
      *(u32x4*)(Sp + (c32 >> 4) * 32768 + off_b(dk, c32 & 15)) = sw;
    }
  }
  __syncthreads();
  const int ib = wid & 1, dvh = wid >> 1;
  f32x16 sc[2];
#pragma unroll
  for (int jb = 0; jb < 2; ++jb) {
#pragma unroll
    for (int r = 0; r < 16; ++r) sc[jb][r] = 0.f;
    if (jb <= ib) {
#pragma unroll
      for (int ks = 0; ks < 8; ++ks) {
        bf16x8 a = *(const bf16x8*)(Ki + off_b(jb * 32 + l31, 2 * ks + hh));
        bf16x8 bq = *(const bf16x8*)(Qd + off_b(ib * 32 + l31, 2 * ks + hh));
        sc[jb] = __builtin_amdgcn_mfma_f32_32x32x16_bf16(a, bq, sc[jb], 0, 0, 0);
      }
#pragma unroll
      for (int r = 0; r < 16; ++r) {
        const int j = jb * 32 + (r & 3) + 8 * (r >> 2) + 4 * hh, i = ib * 32 + l31;
        if (j > i) sc[jb][r] = 0.f;
      }
    }
  }
  bf16x8 pf[4];
#pragma unroll
  for (int jb = 0; jb < 2; ++jb)
#pragma unroll
    for (int s2 = 0; s2 < 2; ++s2) {
      u32x4 w = {pack_bf16(sc[jb][8 * s2 + 0], sc[jb][8 * s2 + 1]), pack_bf16(sc[jb][8 * s2 + 2], sc[jb][8 * s2 + 3]),
                 pack_bf16(sc[jb][8 * s2 + 4], sc[jb][8 * s2 + 5]), pack_bf16(sc[jb][8 * s2 + 6], sc[jb][8 * s2 + 7])};
      pf[jb * 2 + s2] = *(bf16x8*)&w;
    }
  f32x16 o[4];
#pragma unroll
  for (int c = 0; c < 4; ++c)
#pragma unroll
    for (int r = 0; r < 16; ++r) o[c][r] = 0.f;
  const char* Vimg = Vs + dvh * 16384;
  const char* Simg = Sp + dvh * 32768;
#pragma unroll
  for (int c = 0; c < 4; ++c) {
#pragma unroll
    for (int kk = 0; kk < 4; ++kk) {
      if ((kk >> 1) <= ib) {
        const unsigned rbase = 32 * (kk >> 1) + 16 * (kk & 1) + 4 * hh;
        bf16x8 a = tr_frag(Vimg, lane, c, rbase, rbase + 8);
        o[c] = __builtin_amdgcn_mfma_f32_32x32x16_bf16(a, pf[kk], o[c], 0, 0, 0);
      }
    }
#pragma unroll
    for (int ks = 0; ks < 8; ++ks) {
      const unsigned r0 = 16 * ks + 8 * hh;
      bf16x8 a = tr_frag(Simg, lane, c, r0, r0 + 4);
      bf16x8 bq = *(const bf16x8*)(Qd + off_b(ib * 32 + l31, 2 * ks + hh));
      o[c] = __builtin_amdgcn_mfma_f32_32x32x16_bf16(a, bq, o[c], 0, 0, 0);
    }
  }
  float ss = 0.f;
#pragma unroll
  for (int c = 0; c < 4; ++c)
#pragma unroll
    for (int r = 0; r < 16; ++r) ss += o[c][r] * o[c][r];
  ss += __shfl_xor(ss, 32);
  if (hh == 0) red[dvh * 64 + ib * 32 + l31] = ss;
  __syncthreads();
  const float tot = red[ib * 32 + l31] + red[64 + ib * 32 + l31];
  const float rn = rsqrtf(tot * (1.0f / 256.0f) + EPS_);
  const long t = t0 + ib * 32 + l31;
  const u16* grp = p.proj + t * NC_ + C_GR + h * 256 + dvh * 128 + 4 * hh;
  u16* op = p.mix + t * 2048 + h * 256 + dvh * 128 + 4 * hh;
  const float* gp = p.gla_out_norm + dvh * 128 + 4 * hh;
#pragma unroll
  for (int c = 0; c < 4; ++c)
#pragma unroll
    for (int rg = 0; rg < 4; ++rg) {
      u32x2 gw = *(const u32x2*)(grp + 32 * c + 8 * rg);
      f32x4 g = *(const f32x4*)(gp + 32 * c + 8 * rg);
      float gr[4] = {bf_lo(gw[0]), bf_hi(gw[0]), bf_lo(gw[1]), bf_hi(gw[1])};
      float ov[4];
#pragma unroll
      for (int k = 0; k < 4; ++k) { float si = gr[k] / (1.0f + __expf(-gr[k])); ov[k] = o[c][4 * rg + k] * rn * g[k] * si; }
      u32x2 w = {pack_bf16(ov[0], ov[1]), pack_bf16(ov[2], ov[3])};
      *(u32x2*)(op + 32 * c + 8 * rg) = w;
    }
}

__device__ __forceinline__ void mla_norm_tokens(const Params& p) {
  const int lane = threadIdx.x & 63, wid = threadIdx.x >> 6;
  for (int t = blockIdx.x * 4 + wid; t < T_; t += gridDim.x * 4) {
    const u16* src = p.omla + (long)t * 1024;
    u32x4 a = *(const u32x4*)(src + lane * 8), b = *(const u32x4*)(src + 512 + lane * 8);
    float ss = 0.f;
#pragma unroll
    for (int k = 0; k < 4; ++k) { float x0 = bf_lo(a[k]), x1 = bf_hi(a[k]), y0 = bf_lo(b[k]), y1 = bf_hi(b[k]); ss += x0 * x0 + x1 * x1 + y0 * y0 + y1 * y1; }
    ss = wave_sum(ss);
    const float r = rsqrtf(ss * (1.0f / 1024.0f) + EPS_);
    const float* g = p.mla_out_norm;
    u32x4 wa, wb;
#pragma unroll
    for (int k = 0; k < 4; ++k) {
      wa[k] = pack_bf16(bf_lo(a[k]) * r * g[lane * 8 + 2 * k], bf_hi(a[k]) * r * g[lane * 8 + 2 * k + 1]);
      wb[k] = pack_bf16(bf_lo(b[k]) * r * g[512 + lane * 8 + 2 * k], bf_hi(b[k]) * r * g[512 + lane * 8 + 2 * k + 1]);
    }
    *(u32x4*)(p.mix + (long)t * 2048 + 1024 + lane * 8) = wa;
    *(u32x4*)(p.mix + (long)t * 2048 + 1024 + 512 + lane * 8) = wb;
  }
}
__device__ __forceinline__ void wout_tile(const Params& p, char* smem, int mt, int nt) {
  f32x16 acc[4][4];
  GemmTile t{};
  t.A = p.mix; t.lda = 2048; t.aidx = nullptr; t.m0 = mt * 256; t.mvalid = 256;
  t.B0 = p.w_out + nt * 256; t.B1 = t.B0 + 128; t.ldb = 2048; t.nv0 = 128; t.nv1 = 128; t.kscale = nullptr; t.K = 2048;
  gemm_tile_256<4, false>(t, smem, acc);
  const long boff = (long)(mt * 256) * 2048 + nt * 256;
  acc_foreach_row<4>(acc, [&](int rowl, int coll, float (&v)[4]) {
    long o = boff + (long)rowl * 2048 + coll;
    OPAQUE(o);
    const float* xr = p.x + o; float* yr = p.x1 + o;
#pragma unroll
    for (int nb = 0; nb < 4; ++nb) { const int c = (nb >> 1) * 128 + (nb & 1) * 32; yr[c] = xr[c] + v[nb]; }
  });
}

#define P7_LDS_BYTES (33280 + 32768 + 4224 + 128)
__device__ __forceinline__ void ffn_prep_unit(const Params& p, char* smem, int u) {
  float* hs = (float*)smem; float* rws = (float*)(smem + 33280); float* lg = (float*)(smem + 33280 + 32768); float* rs = lg + 32 * 33;
  const int tid = threadIdx.x;
  const int tl = tid >> 3, seg = tid & 7;
  const long t = (long)u * 32 + tl;
  const float* xr = p.x1 + t * 2048;
  float acc0 = 0.f, acc1 = 0.f, acc2 = 0.f, acc3 = 0.f, ss = 0.f;
  for (int kc = 0; kc < 8; ++kc) {
    __syncthreads();
#pragma unroll
    for (int i = 0; i < 8; ++i) {
      const int kk = i * 32 + seg * 4;
      f32x4 v = *(const f32x4*)(xr + kc * 256 + kk);
      f32x4 g = *(const f32x4*)(p.ffn_norm + kc * 256 + kk);
      ss += v[0] * v[0] + v[1] * v[1] + v[2] * v[2] + v[3] * v[3];
      *(f32x4*)(hs + tl * 260 + kk) = v * g;
    }
#pragma unroll
    for (int i = 0; i < 8; ++i) {
      const int kk = (tid >> 3) + 32 * i;
      *(f32x4*)(rws + kk * 32 + seg * 4) = *(const f32x4*)(p.router_w + (long)(kc * 256 + kk) * 32 + seg * 4);
    }
    __syncthreads();
#pragma unroll 8
    for (int kk = 0; kk < 256; ++kk) {
      const float hv = hs[tl * 260 + kk];
      const f32x4 w = *(const f32x4*)(rws + kk * 32 + seg * 4);
      acc0 = fmaf(hv, w[0], acc0); acc1 = fmaf(hv, w[1], acc1); acc2 = fmaf(hv, w[2], acc2); acc3 = fmaf(hv, w[3], acc3);
    }
  }
  ss += __shfl_xor(ss, 1); ss += __shfl_xor(ss, 2); ss += __shfl_xor(ss, 4);
  const float r = rsqrtf(ss * (1.0f / 2048.0f) + EPS_);
  lg[tl * 33 + seg * 4 + 0] = acc0 * r + p.router_b[seg * 4 + 0];
  lg[tl * 33 + seg * 4 + 1] = acc1 * r + p.router_b[seg * 4 + 1];
  lg[tl * 33 + seg * 4 + 2] = acc2 * r + p.router_b[seg * 4 + 2];
  lg[tl * 33 + seg * 4 + 3] = acc3 * r + p.router_b[seg * 4 + 3];
  if (seg == 0) rs[tl] = r;
  __syncthreads();
  if (tid < 32) {
    const long tt = (long)u * 32 + tid;
    const float* L = lg + tid * 33;
    unsigned used = 0u; int i0 = 0, i1 = 0, i2 = 0, i3 = 0; float v0 = 0.f, v1 = 0.f, v2 = 0.f, v3 = 0.f;
#pragma unroll
    for (int k = 0; k < 4; ++k) {
      int bi = -1; float bv = 0.f;
      for (int i = 0; i < 32; ++i) {
        const float x = L[i];
        const bool take = !((used >> i) & 1u) && (bi < 0 || x > bv);
        bi = take ? i : bi; bv = take ? x : bv;
      }
      used |= 1u << bi;
      if (k == 0) { i0 = bi; v0 = bv; } else if (k == 1) { i1 = bi; v1 = bv; } else if (k == 2) { i2 = bi; v2 = bv; } else { i3 = bi; v3 = bv; }
    }
    const float e0 = 1.0f, e1 = __expf(v1 - v0), e2 = __expf(v2 - v0), e3 = __expf(v3 - v0);
    const float inv = 1.0f / (e0 + e1 + e2 + e3);
    const int s0 = atomicAdd(&p.counts[i0], 1), s1 = atomicAdd(&p.counts[i1], 1), s2 = atomicAdd(&p.counts[i2], 1), s3 = atomicAdd(&p.counts[i3], 1);
    p.list[i0 * T_ + s0] = (int)tt; p.list[i1 * T_ + s1] = (int)tt; p.list[i2 * T_ + s2] = (int)tt; p.list[i3 * T_ + s3] = (int)tt;
    p.asg_e[tt * 4 + 0] = i0; p.asg_e[tt * 4 + 1] = i1; p.asg_e[tt * 4 + 2] = i2; p.asg_e[tt * 4 + 3] = i3;
    p.asg_slot[tt * 4 + 0] = s0; p.asg_slot[tt * 4 + 1] = s1; p.asg_slot[tt * 4 + 2] = s2; p.asg_slot[tt * 4 + 3] = s3;
    p.asg_g[tt * 4 + 0] = e0 * inv; p.asg_g[tt * 4 + 1] = e1 * inv; p.asg_g[tt * 4 + 2] = e2 * inv; p.asg_g[tt * 4 + 3] = e3 * inv;
  }
  {
    const float rr = rs[tl];
#pragma unroll
    for (int kc = 0; kc < 8; ++kc)
#pragma unroll
      for (int i = 0; i < 4; ++i) {
        const int kk = kc * 256 + i * 64 + seg * 8;
        f32x4 v0 = *(const f32x4*)(xr + kk), v1 = *(const f32x4*)(xr + kk + 4);
        f32x4 g0 = *(const f32x4*)(p.ffn_norm + kk), g1 = *(const f32x4*)(p.ffn_norm + kk + 4);
        u32x4 w = {pack_bf16(v0[0] * rr * g0[0], v0[1] * rr * g0[1]), pack_bf16(v0[2] * rr * g0[2], v0[3] * rr * g0[3]),
                   pack_bf16(v1[0] * rr * g1[0], v1[1] * rr * g1[1]), pack_bf16(v1[2] * rr * g1[2], v1[3] * rr * g1[3])};
        *(u32x4*)(p.h2 + t * 2048 + kk) = w;
      }
  }
}

__device__ __forceinline__ void moe_setup(const Params& p, int* mo) {
  __syncthreads();
  if (threadIdx.x == 0) {
    int s = 0;
    for (int e = 0; e < NE_; ++e) { mo[e] = s; s += (p.counts[e] + 255) >> 8; }
    mo[NE_] = s;
  }
  __syncthreads();
}
__device__ __forceinline__ int xcd_unit(int round) { return round * 256 + (blockIdx.x & 7) * 32 + (blockIdx.x >> 3); }

__device__ __forceinline__ void moe1_tile(const Params& p, char* smem, const int* mo, int e, int nt, int mt) {
  f32x16 acc[4][4];
  GemmTile t{};
  const int cnt = p.counts[e];
  t.A = p.h2; t.lda = 2048; t.aidx = p.list + e * T_ + mt * 256; t.m0 = 0; t.mvalid = min(256, cnt - mt * 256);
  t.B0 = p.w_gu + (long)e * 2048 * 4096 + nt * 128; t.B1 = t.B0 + 2048; t.ldb = 4096; t.nv0 = 128; t.nv1 = 128; t.kscale = nullptr; t.K = 2048;
  gemm_tile_256<4, false>(t, smem, acc);
  u16* base = p.act + (long)(mo[e] * 256 + mt * 256) * 2048 + nt * 128;
  const float* bg = p.b_gu + e * 4096 + nt * 128; const float* bu = bg + 2048;
  const int cl = (threadIdx.x >> 6 & 1) * 64 + (threadIdx.x & 31);
  const float bgv[2] = {bg[cl], bg[cl + 32]}, buv[2] = {bu[cl], bu[cl + 32]};
  acc_foreach_row<4>(acc, [&](int rowl, int coll, float (&v)[4]) {
    u16* rp = base + (long)rowl * 2048 + coll;
    OPAQUE(rp);
#pragma unroll
    for (int nb = 0; nb < 2; ++nb) {
      const int c = nb * 32;
      float g = fminf(v[nb] + bgv[nb], 7.0f);
      float uu = fminf(fmaxf(v[nb + 2] + buv[nb], -7.0f), 7.0f);
      float a = (uu + 1.0f) * (g / (1.0f + __expf(-1.702f * g)));
      rp[c] = f32_to_bf16(a);
    }
  });
}
__device__ __forceinline__ void moe2_tile(const Params& p, char* smem, const int* mo, int e, int nt, int mt) {
  f32x16 acc[4][4];
  GemmTile t{};
  t.A = p.act; t.lda = 2048; t.aidx = nullptr; t.m0 = mo[e] * 256 + mt * 256; t.mvalid = 256;
  t.B0 = p.w_dn + (long)e * 2048 * 2048 + nt * 256; t.B1 = t.B0 + 128; t.ldb = 2048; t.nv0 = 128; t.nv1 = 128; t.kscale = nullptr; t.K = 2048;
  gemm_tile_256<4, false>(t, smem, acc);
  u16* base = p.ybuf + (long)t.m0 * 2048 + nt * 256;
  const float* bd = p.b_dn + e * 2048 + nt * 256;
  const int cl = (threadIdx.x >> 6 & 1) * 64 + (threadIdx.x & 31);
  const float bdv[4] = {bd[cl], bd[cl + 32], bd[cl + 128], bd[cl + 160]};
  acc_foreach_row<4>(acc, [&](int rowl, int coll, float (&v)[4]) {
    u16* rp = base + (long)rowl * 2048 + coll;
    OPAQUE(rp);
#pragma unroll
    for (int nb = 0; nb < 4; ++nb) { const int c = (nb >> 1) * 128 + (nb & 1) * 32; rp[c] = f32_to_bf16(v[nb] + bdv[nb]); }
  });
}
template <int WHICH>
__device__ __forceinline__ void ph_moe(const Params& p, char* smem) {
  int* mo = (int*)(smem + G_LDS_BYTES);
  moe_setup(p, mo);
  const int NT = (WHICH == 1) ? 16 : 8;
  const int total = mo[NE_] * NT;
  for (int round = 0;; ++round) {
    const int u = xcd_unit(round);
    if (round * 256 >= total) break;
    if (u >= total) continue;
    int e = 0;
    while (mo[e + 1] * NT <= u) ++e;
    const int local = u - mo[e] * NT, me = mo[e + 1] - mo[e];
    const int nt = local / me, mt = local - nt * me;
    if (WHICH == 1) moe1_tile(p, smem, mo, e, nt, mt); else moe2_tile(p, smem, mo, e, nt, mt);
  }
}

__device__ __forceinline__ void ph_final(const Params& p, char* smem) {
  int* mo = (int*)(smem + G_LDS_BYTES);
  moe_setup(p, mo);
  const int lane = threadIdx.x & 63, wid = threadIdx.x >> 6;
  for (int t = blockIdx.x * 4 + wid; t < T_; t += gridDim.x * 4) {
    long rows[4]; float gg[4];
#pragma unroll
    for (int k = 0; k < 4; ++k) { rows[k] = (long)(mo[p.asg_e[t * 4 + k]] * 256 + p.asg_slot[t * 4 + k]) * 2048; gg[k] = p.asg_g[t * 4 + k]; }
    f32x4 v[8]; float ss = 0.f;
#pragma unroll
    for (int j = 0; j < 8; ++j) {
      const int c = j * 256 + lane * 4;
      f32x4 a = *(const f32x4*)(p.x1 + (long)t * 2048 + c);
#pragma unroll
      for (int k = 0; k < 4; ++k) {
        u32x2 w = *(const u32x2*)(p.ybuf + rows[k] + c);
        a[0] += gg[k] * bf_lo(w[0]); a[1] += gg[k] * bf_hi(w[0]); a[2] += gg[k] * bf_lo(w[1]); a[3] += gg[k] * bf_hi(w[1]);
      }
      v[j] = a; ss += a[0] * a[0] + a[1] * a[1] + a[2] * a[2] + a[3] * a[3];
    }
    ss = wave_sum(ss);
    const float r = rsqrtf(ss * (1.0f / 2048.0f) + EPS_);
#pragma unroll
    for (int j = 0; j < 8; ++j) {
      const int c = j * 256 + lane * 4;
      f32x4 g = *(const f32x4*)(p.final_norm + c);
      f32x4 o = {v[j][0] * r * g[0], v[j][1] * r * g[1], v[j][2] * r * g[2], v[j][3] * r * g[3]};
      *(f32x4*)(p.out + (long)t * 2048 + c) = o;
    }
  }
}
#define LDS_MAX 143360
template <int PH>
__global__ void __launch_bounds__(256, 1) k_phase(Params p) {
  extern __shared__ __attribute__((aligned(16))) char smem[];
  if (PH == 0) ph_prep0(p);
  if (PH == 1) ph_win(p, smem);
  if (PH == 2) ph_prep1(p, smem);
  if (PH == 3) {
    upkv_tile(p, smem, blockIdx.x >> 3, blockIdx.x & 7);
    if (blockIdx.x < 192) upq_tile(p, smem, blockIdx.x / 6, blockIdx.x % 6);
    if (blockIdx.x < 192) gla_g1_unit(p, smem, blockIdx.x);
    else for (int i = 0; i < 5; ++i) gla_g1_unit(p, smem, 192 + (blockIdx.x - 192) * 5 + i);
  }
  if (PH == 4) {
    gla_g2_unit(p, blockIdx.x);
    const int bh = blockIdx.x >> 4, qa = blockIdx.x & 15;
    attn_unit(p, smem, bh >> 3, bh & 7, 31 - qa);
    attn_unit(p, smem, bh >> 3, bh & 7, qa);
  }
  if (PH == 5) {
    for (int u = blockIdx.x; u < 512; u += gridDim.x) gla_g3_unit(p, smem, u);
    mla_norm_tokens(p);
  }
  if (PH == 6) wout_tile(p, smem, blockIdx.x >> 3, blockIdx.x & 7);
  if (PH == 7) ffn_prep_unit(p, smem, blockIdx.x);
  if (PH == 8) ph_moe<1>(p, smem);
  if (PH == 9) ph_moe<2>(p, smem);
  if (PH == 10) ph_final(p, smem);
}

__global__ void cv_bf16_f32(const u16* in, float* out, long n) {
  long i = (long)blockIdx.x * blockDim.x + threadIdx.x;
  if (i < n) out[i] = bf16_to_f32(in[i]);
}
__global__ void cv_bf16_f32_2d(const u16* in, int ldi, float* out, int ldo, int cols, long rows) {
  long i = (long)blockIdx.x * blockDim.x + threadIdx.x;
  if (i >= rows * cols) return;
  long r = i / cols; int c = (int)(i % cols);
  out[r * ldo + c] = bf16_to_f32(in[r * ldi + c]);
}

#ifndef STAGE
#define STAGE 5
#endif

template <int PH> static void launch_phase(const Params& p, hipStream_t st) {
  hipFuncSetAttribute((const void*)k_phase<PH>, hipFuncAttributeMaxDynamicSharedMemorySize, LDS_MAX);
  k_phase<PH><<<256, 256, LDS_MAX, st>>>(p);
}
static void launch_gemm(hipStream_t st, GP p, int Mmax, int nz) {
  dim3 grid((p.N + 63) / 64, (Mmax + 63) / 64, nz);
  nv_gemm<<<grid, 256, 0, st>>>(p);
}

extern "C" void kernel_launch(void* const* d_in, const int* in_sizes, int n_in,
                              void* d_out, int out_size, void* d_ws, size_t ws_size,
                              hipStream_t stream) {
  Params P{};
  P.x = (const float*)d_in[0]; P.pos = (const int*)d_in[1];
  P.attn_norm = (const float*)d_in[2]; P.w_in = (const float*)d_in[3]; P.gate_up = (const float*)d_in[4]; P.gate_bias = (const float*)d_in[5];
  P.gla_out_norm = (const float*)d_in[6]; P.q_norm = (const float*)d_in[7]; P.w_uq = (const float*)d_in[8]; P.kv_norm = (const float*)d_in[9];
  P.w_ukv = (const float*)d_in[10]; P.mla_out_norm = (const float*)d_in[11]; P.w_out = (const float*)d_in[12]; P.ffn_norm = (const float*)d_in[13];
  P.router_w = (const float*)d_in[14]; P.router_b = (const float*)d_in[15]; P.w_gu = (const float*)d_in[16]; P.b_gu = (const float*)d_in[17];
  P.w_dn = (const float*)d_in[18]; P.b_dn = (const float*)d_in[19]; P.final_norm = (const float*)d_in[20];
  P.out = (float*)d_out;

  char* w = (char*)d_ws; size_t off = 0;
  auto alloc = [&](size_t bytes) { void* q = w + off; off += (bytes + 255) & ~(size_t)255; return q; };
  P.bar = (unsigned*)alloc(16384);
  P.counts = (int*)alloc(256);
  P.h1 = (u16*)alloc((size_t)T_ * 2048 * 2);
  P.proj = (u16*)alloc((size_t)T_ * NC_ * 2);
  P.cs = (float2*)alloc((size_t)T_ * 32 * 8);
  P.rq = (float*)alloc((size_t)T_ * 4); P.rkv = (float*)alloc((size_t)T_ * 4);
  P.bcum = (float*)alloc((size_t)T_ * 512 * 4);
  P.q = (u16*)alloc((size_t)T_ * 1536 * 2);
  P.kv = (u16*)alloc((size_t)T_ * 2048 * 2);
  P.kpe = (u16*)alloc((size_t)T_ * 64 * 2);
  P.kvc = (u16*)alloc((size_t)512 * 32768 * 2);
  P.dec = (float*)alloc((size_t)512 * 128 * 4);
  P.sprev = (u16*)alloc((size_t)512 * 32768 * 2);
  P.mix = (u16*)alloc((size_t)T_ * 2048 * 2);
  P.omla = (u16*)alloc((size_t)T_ * 1024 * 2);
  P.x1 = (float*)alloc((size_t)T_ * 2048 * 4);
  P.h2 = (u16*)alloc((size_t)T_ * 2048 * 2);
  P.list = (int*)alloc((size_t)NE_ * T_ * 4);
  P.asg_e = (int*)alloc((size_t)T_ * 4 * 4); P.asg_slot = (int*)alloc((size_t)T_ * 4 * 4); P.asg_g = (float*)alloc((size_t)T_ * 4 * 4);
  const size_t PROWS = (size_t)T_ * 4 + NE_ * 256;
  P.act = (u16*)alloc(PROWS * 2048 * 2);
  P.ybuf = (u16*)alloc(PROWS * 2048 * 2);
#if STAGE < 5
  float* proj_f = (float*)alloc((size_t)T_ * NC_ * 4);
  float* loga = (float*)alloc((size_t)T_ * 512 * 4);
  float* ogla = (float*)alloc((size_t)T_ * 1024 * 4);
  float* mix_f = (float*)alloc((size_t)T_ * 2048 * 4);
  float* nq = (float*)alloc((size_t)T_ * 512 * 4);
  float* nkv = (float*)alloc((size_t)T_ * 512 * 4);
  float* q_f = (float*)alloc((size_t)T_ * 1536 * 4);
  float* kv_f = (float*)alloc((size_t)T_ * 2048 * 4);
  float* kpe_f = (float*)alloc((size_t)T_ * 64 * 4);
  float* omla_f = (float*)alloc((size_t)T_ * 1024 * 4);
  float* x1_f = (float*)alloc((size_t)T_ * 2048 * 4);
  float* h2_f = (float*)alloc((size_t)T_ * 2048 * 4);
  int* base = (int*)alloc(256);
  int* counts_n = (int*)alloc(256);
  float* gu = (float*)alloc((size_t)T_ * 4 * 4096 * 4);
  float* act_f = (float*)alloc((size_t)T_ * 4 * 2048 * 4);
  float* y_f = (float*)alloc((size_t)T_ * 4 * 2048 * 4);
#endif

  launch_phase<0>(P, stream);
  launch_phase<1>(P, stream);
#if STAGE >= 2
  launch_phase<2>(P, stream);
  launch_phase<3>(P, stream);
  launch_phase<4>(P, stream);
  launch_phase<5>(P, stream);
#endif
#if STAGE >= 4
  launch_phase<6>(P, stream);
#endif
#if STAGE >= 5
  launch_phase<7>(P, stream);
  launch_phase<8>(P, stream);
  launch_phase<9>(P, stream);
  launch_phase<10>(P, stream);
#else
  {
    const long n = (long)T_ * NC_;
    cv_bf16_f32<<<(int)((n + 255) / 256), 256, 0, stream>>>(P.proj, proj_f, n);
  }
  const float* x1_src;
#if STAGE <= 3
#if STAGE <= 2
  { GP p{}; p.A = proj_f + C_GD; p.lda = NC_; p.M = T_; p.B = P.gate_up; p.ldb = 512; p.bias = P.gate_bias; p.C = loga; p.ldc = 512; p.N = 512; p.K = 16; launch_gemm(stream, p, T_, 1); }
  nv_loga<<<(T_ * 512 + 255) / 256, 256, 0, stream>>>(loga, (long)T_ * 512);
  nv_gla<<<8, 256, 0, stream>>>(proj_f, loga, ogla);
  nv_gla_out<<<T_ * 4, 256, 0, stream>>>(ogla, proj_f, P.gla_out_norm, mix_f);
#else
  cv_bf16_f32_2d<<<(int)(((long)T_ * 1024 + 255) / 256), 256, 0, stream>>>(P.mix, 2048, mix_f, 2048, 1024, T_);
#endif
#if STAGE <= 1
  nv_rmsnorm<<<T_, 256, 0, stream>>>(proj_f + C_MQ, NC_, P.q_norm, nq, 512, 512);
  nv_rmsnorm<<<T_, 256, 0, stream>>>(proj_f + C_MKV, NC_, P.kv_norm, nkv, 512, 512);
  { GP p{}; p.A = nq; p.lda = 512; p.M = T_; p.B = P.w_uq; p.ldb = 1536; p.C = q_f; p.ldc = 1536; p.N = 1536; p.K = 512; launch_gemm(stream, p, T_, 1); }
  { GP p{}; p.A = nkv; p.lda = 512; p.M = T_; p.B = P.w_ukv; p.ldb = 2048; p.C = kv_f; p.ldc = 2048; p.N = 2048; p.K = 512; launch_gemm(stream, p, T_, 1); }
  nv_rope_q<<<(T_ * 8 * 32 + 255) / 256, 256, 0, stream>>>(q_f, P.cs);
  nv_rope_k<<<(T_ * 32 + 255) / 256, 256, 0, stream>>>(proj_f, P.cs, kpe_f);
  nv_attn<<<T_ * 8, 256, 0, stream>>>(q_f, kv_f, kpe_f, omla_f);
  nv_rmsnorm<<<T_, 256, 0, stream>>>(omla_f, 1024, P.mla_out_norm, mix_f + 1024, 2048, 1024);
#else
  cv_bf16_f32_2d<<<(int)(((long)T_ * 1024 + 255) / 256), 256, 0, stream>>>(P.mix + 1024, 2048, mix_f + 1024, 2048, 1024, T_);
#endif
  { GP p{}; p.A = mix_f; p.lda = 2048; p.M = T_; p.B = P.w_out; p.ldb = 2048; p.resid = P.x; p.ldr = 2048; p.C = x1_f; p.ldc = 2048; p.N = 2048; p.K = 2048; launch_gemm(stream, p, T_, 1); }
  x1_src = x1_f;
#else
  x1_src = P.x1;
#endif
  nv_rmsnorm<<<T_, 256, 0, stream>>>(x1_src, 2048, P.ffn_norm, h2_f, 2048, 2048);
  nv_zero_counts<<<1, 64, 0, stream>>>(counts_n);
  nv_router<<<T_, 256, 0, stream>>>(h2_f, P.router_w, P.router_b, counts_n, P.list, P.asg_e, P.asg_slot, P.asg_g);
  nv_base<<<1, 64, 0, stream>>>(counts_n, base);
  { GP p{}; p.A = h2_f; p.lda = 2048; p.rowidx = P.list; p.rowidx_zs = T_; p.Mptr = counts_n; p.B = P.w_gu; p.ldb = 4096; p.Bzs = (long)2048 * 4096;
    p.bias = P.b_gu; p.bias_zs = 4096; p.C = gu; p.ldc = 4096; p.crow0 = base; p.N = 4096; p.K = 2048; launch_gemm(stream, p, T_, NE_); }
  nv_act<<<(int)(((long)T_ * 4 * 2048 + 255) / 256), 256, 0, stream>>>(gu, act_f, (long)T_ * 4);
  { GP p{}; p.A = act_f; p.lda = 2048; p.a_from_crow0 = 1; p.Mptr = counts_n; p.B = P.w_dn; p.ldb = 2048; p.Bzs = (long)2048 * 2048;
    p.bias = P.b_dn; p.bias_zs = 2048; p.C = y_f; p.ldc = 2048; p.crow0 = base; p.N = 2048; p.K = 2048; launch_gemm(stream, p, T_, NE_); }
  nv_final<<<T_, 256, 0, stream>>>(x1_src, y_f, base, P.asg_e, P.asg_slot, P.asg_g, P.final_norm, P.out);
#endif
}
```

```cpp
#include <hip/hip_runtime.h>
#include <hip/hip_bf16.h>
#include <stdint.h>
#define T_      8192
#define SEQ_    4096
#define D_      2048
#define NC_     4176
#define C_GQ    0
#define C_GK    512
#define C_GV    1024
#define C_GR    2048
#define C_GD    3072
#define C_MQ    3088
#define C_MKV   3600
#define C_MKR   4112
#define NE_     32
#define DFF_    2048
#define EPS_    1e-6f
typedef short bf16x8 __attribute__((ext_vector_type(8)));
typedef short s16x4 __attribute__((ext_vector_type(4)));
typedef float f32x16 __attribute__((ext_vector_type(16)));
typedef float f32x4 __attribute__((ext_vector_type(4)));
typedef float f32x2 __attribute__((ext_vector_type(2)));
typedef unsigned short u16;
typedef unsigned u32x4 __attribute__((ext_vector_type(4)));
typedef unsigned u32x2 __attribute__((ext_vector_type(2)));
#define LAS3 __attribute__((address_space(3)))
#define OPAQUE(x) asm volatile("" : "+v"(x))
#define NTHR 256
__device__ __forceinline__ int opaque_tid() { int t = threadIdx.x; asm volatile("" : "+v"(t)); return t; }

__device__ __forceinline__ unsigned pack_bf16(float a, float b) {
  typedef __bf16 bf2 __attribute__((ext_vector_type(2)));
  typedef float f2 __attribute__((ext_vector_type(2)));
  f2 v = {a, b};
  bf2 r = __builtin_convertvector(v, bf2);
  return *(unsigned*)&r;
}
__device__ __forceinline__ float bf_lo(unsigned w) { return __uint_as_float(w << 16); }
__device__ __forceinline__ float bf_hi(unsigned w) { return __uint_as_float(w & 0xffff0000u); }
__device__ __forceinline__ float bf16_to_f32(u16 v) { return __uint_as_float(((unsigned)v) << 16); }
__device__ __forceinline__ u16 f32_to_bf16(float f) { return (u16)(pack_bf16(f, 0.f) & 0xffffu); }
__device__ __forceinline__ float wave_sum(float v) {
#pragma unroll
  for (int o = 32; o > 0; o >>= 1) v += __shfl_xor(v, o);
  return v;
}
__device__ __forceinline__ unsigned off_b(unsigned row, unsigned ch) { return 256u * row + 16u * (ch ^ (((row & 3u) << 2) | ((row >> 2) & 3u))); }
__device__ __forceinline__ unsigned tr_addr(unsigned lane, unsigned c, unsigned row0  ) {
  const unsigned blk = (lane >> 4) & 1u, q = (lane & 15u) >> 2, p = lane & 3u;
  return off_b(row0 + q, 4u * c + 2u * blk + (p >> 1)) + 8u * (p & 1u);
}
__device__ __forceinline__ bf16x8 tr_frag(const char* img, unsigned lane, unsigned c, unsigned row_a, unsigned row_b) {
  s16x4 v0 = __builtin_amdgcn_ds_read_tr16_b64_v4i16((LAS3 s16x4*)(img + tr_addr(lane, c, row_a)));
  s16x4 v1 = __builtin_amdgcn_ds_read_tr16_b64_v4i16((LAS3 s16x4*)(img + tr_addr(lane, c, row_b)));
  return (bf16x8){v0[0], v0[1], v0[2], v0[3], v1[0], v1[1], v1[2], v1[3]};
}

struct Params {
  const float *x; const int* pos;
  const float *attn_norm, *w_in, *gate_up, *gate_bias, *gla_out_norm, *q_norm, *w_uq, *kv_norm, *w_ukv, *mla_out_norm, *w_out,
              *ffn_norm, *router_w, *router_b, *w_gu, *b_gu, *w_dn, *b_dn, *final_norm;
  float* out;
  u16 *h1, *proj, *q, *kv, *kpe, *mix, *omla, *h2, *act, *ybuf, *kvc, *sprev;
  float *bcum, *rq, *rkv, *x1, *dec, *asg_g;
  float2* cs;
  int *counts, *list, *asg_e, *asg_slot;
  unsigned* bar;
};
#define XB_TMO      128
#define XB_XCNT(j)  (256  + 64 * (j))
#define XB_XSUB(j)  (1280 + 64 * (j))
#define XB_XGEN(j)  (2304 + 64 * (j))
#define XB_TOP      3328
#define XB_TOPGEN   3392
#define XCD_BAR_WORDS 3456
#define XB_SPIN_CAP (1u << 18)
#define LAS __attribute__((address_space(3)))

__device__ __forceinline__ unsigned xb_ld(unsigned* p)              { return __hip_atomic_load(p, __ATOMIC_RELAXED, __HIP_MEMORY_SCOPE_AGENT); }
__device__ __forceinline__ unsigned xb_add(unsigned* p, unsigned v) { return __hip_atomic_fetch_add(p, v, __ATOMIC_RELAXED, __HIP_MEMORY_SCOPE_AGENT); }
__device__ __forceinline__ unsigned xb_xcc_id() { return (unsigned)__builtin_amdgcn_s_getreg((3 << 11) | 20) & 0xFu; }
#define XB_SPIN(cond, bar) do { unsigned _sp = 0; while (cond) { __builtin_amdgcn_s_sleep(1); \
    if ((++_sp & 255u) == 0u) { if (xb_ld(&(bar)[XB_TMO])) break; if (_sp > XB_SPIN_CAP) { atomicAdd(&(bar)[XB_TMO], 1u); break; } } } } while (0)

struct XcdBarrier {
    unsigned* bar; unsigned x;
    volatile LAS unsigned* st;
};

__device__ __forceinline__ XcdBarrier xcd_barrier_post(unsigned* bar, volatile LAS unsigned* st) {
    XcdBarrier b; b.bar = bar; b.x = xb_xcc_id(); b.st = st;
    if (threadIdx.x == 0) (void)xb_add(&bar[XB_XCNT(b.x)], 1u);
    return b;
}
__device__ __forceinline__ void xcd_barrier_complete(unsigned* bar, unsigned x, unsigned& nloc, unsigned& nx) {
    const unsigned G = gridDim.x * gridDim.y * gridDim.z;
    unsigned sum, cnt, mine, sp = 0u;
    for (;;) {
        sum = 0u; cnt = 0u; mine = 0u;
#pragma unroll
        for (unsigned j = 0; j < 16; ++j) { const unsigned c = xb_ld(&bar[XB_XCNT(j)]); sum += c; cnt += (c > 0u) ? 1u : 0u; mine = (j == x) ? c : mine; }
        if (sum == G) break;
        __builtin_amdgcn_s_sleep(1);
        if ((++sp & 255u) == 0u) { if (xb_ld(&bar[XB_TMO])) break; if (sp > XB_SPIN_CAP) { atomicAdd(&bar[XB_TMO], 1u); break; } }
    }
    nloc = mine > 0u ? mine : 1u; nx = cnt > 0u ? cnt : 1u;
}

__device__ __forceinline__ void xcd_barrier(const XcdBarrier& b) {
    asm volatile("s_waitcnt vmcnt(0)" ::: "memory");
    __syncthreads();
    if (threadIdx.x == 0) {
        unsigned* bar = b.bar;
        __builtin_amdgcn_s_waitcnt(0);
        unsigned nloc = b.st[0], nx = b.st[1];
        if (nloc == 0u) { xcd_barrier_complete(bar, b.x, nloc, nx); b.st[0] = nloc; b.st[1] = nx; }
        const unsigned old = xb_add(&bar[XB_XSUB(b.x)], 1u);
        const unsigned gen = old / nloc;
        if (old + 1u == (gen + 1u) * nloc) {
            __builtin_amdgcn_fence(__ATOMIC_RELEASE, "agent");
            asm volatile("s_waitcnt vmcnt(0)" ::: "memory");
            const unsigned og = xb_add(&bar[XB_TOP], 1u);
            const unsigned tg = og / nx;
            if (og + 1u == (tg + 1u) * nx) xb_add(&bar[XB_TOPGEN], 1u);
            else XB_SPIN(xb_ld(&bar[XB_TOPGEN]) == tg, bar);
            __builtin_amdgcn_fence(__ATOMIC_ACQUIRE, "agent");
            xb_add(&bar[XB_XGEN(b.x)], 1u);
            asm volatile("s_waitcnt vmcnt(0)" ::: "memory");
        } else {
            XB_SPIN(xb_ld(&bar[XB_XGEN(b.x)]) == gen, bar);
            __builtin_amdgcn_fence(__ATOMIC_ACQUIRE, "agent");
            asm volatile("s_waitcnt vmcnt(0)" ::: "memory");
        }
    }
    __syncthreads();
}

#define G_A_OFF(s)  ((s) * 65536)
#define G_B_OFF(s)  ((s) * 65536 + 32768)
#define G_LDS_BYTES 131072

struct GemmTile {
  const u16* A; int lda;
  const int* aidx;
  int m0, mvalid;
  const float* B0; const float* B1;
  int ldb; int nv0, nv1;
  const float* kscale;
  int K;
};

template <int NB, bool KSCALE>
__device__ __forceinline__ void gemm_tile_256(const GemmTile& t, char* smem, f32x16 (&acc)[4][4]) {
  int tz0 = threadIdx.x; asm volatile("" : "+v"(tz0));
  const int tid = tz0, lane = tid & 63, wid = tid >> 6, wr = wid >> 1, wc = wid & 1;
  const int l31 = lane & 31, hh = lane >> 5;
#pragma unroll
  for (int i = 0; i < 4; ++i)
#pragma unroll
    for (int j = 0; j < 4; ++j)
#pragma unroll
      for (int r = 0; r < 16; ++r) acc[i][j][r] = 0.f;

  const int a_c = (tid & 7) ^ ((tid >> 4) & 7);
  const u16* a_src[8];
#pragma unroll
  for (int i = 0; i < 8; ++i) {
    int r = (tid >> 3) + 32 * i;
    int rr = r < t.mvalid ? r : 0;
    long grow = t.aidx ? (long)t.aidx[rr] : (long)(t.m0 + rr);
    a_src[i] = t.A + grow * t.lda + a_c * 8;
  }
  const int b_n8 = tid & 31, b_k = tid >> 5;
  const int b_img = b_n8 >> 4, b_ch = b_n8 & 15;
  const bool b_ok = (b_ch * 8) < (b_img ? t.nv1 : t.nv0);
  const float* b_src = b_ok ? ((b_img ? t.B1 : t.B0) + b_ch * 8) : t.B0;
  f32x4 breg[16];

  auto issue_a = [&](int kt, int s) {
#pragma unroll
    for (int i = 0; i < 8; ++i)
      __builtin_amdgcn_global_load_lds((const void*)(a_src[i] + kt * 64), (LAS3 void*)(smem + G_A_OFF(s) + i * 4096 + tid * 16), 16, 0, 0);
  };
  auto issue_b = [&](int kt) {
#pragma unroll
    for (int j = 0; j < 8; ++j) {
      const float* p = b_src + (long)(kt * 64 + b_k + 8 * j) * t.ldb;
      breg[2 * j] = *(const f32x4*)p; breg[2 * j + 1] = *(const f32x4*)(p + 4);
    }
  };
  auto write_b = [&](int kt, int s) {
#pragma unroll
    for (int j = 0; j < 8; ++j) {
      const int k = b_k + 8 * j;
      f32x4 lo = breg[2 * j], hi = breg[2 * j + 1];
      if (KSCALE) { float sc = t.kscale[kt * 64 + k]; lo *= sc; hi *= sc; }
      if (!b_ok) { lo = (f32x4){0.f, 0.f, 0.f, 0.f}; hi = lo; }
      u32x4 w = {pack_bf16(lo[0], lo[1]), pack_bf16(lo[2], lo[3]), pack_bf16(hi[0], hi[1]), pack_bf16(hi[2], hi[3])};
      *(u32x4*)(smem + G_B_OFF(s) + b_img * 16384 + off_b(k, b_ch)) = w;
    }
  };
  unsigned a_rd[4], b_rd[2][2];
#pragma unroll
  for (int ks = 0; ks < 4; ++ks) { const int row = wr * 128 + l31; a_rd[ks] = row * 128 + (((2 * ks + hh) ^ ((row >> 1) & 7)) * 16); }
#pragma unroll
  for (int tt = 0; tt < 2; ++tt)
#pragma unroll
    for (int nl = 0; nl < 2; ++nl) b_rd[tt][nl] = tr_addr(lane, wc * 2 + nl, 8 * hh + 4 * tt);
  auto compute = [&](int s) {
    const char* As = smem + G_A_OFF(s);
    const char* Bs = smem + G_B_OFF(s);
#pragma unroll
    for (int ks = 0; ks < 4; ++ks) {
      bf16x8 af[4], bfr[NB];
#pragma unroll
      for (int mb = 0; mb < 4; ++mb) af[mb] = *(const bf16x8*)(As + a_rd[ks] + mb * 4096);
#pragma unroll
      for (int nb = 0; nb < NB; ++nb) {
        const char* bi = Bs + (nb >> 1) * 16384 + ks * 4096;
        s16x4 v0 = __builtin_amdgcn_ds_read_tr16_b64_v4i16((LAS3 s16x4*)(bi + b_rd[0][nb & 1]));
        s16x4 v1 = __builtin_amdgcn_ds_read_tr16_b64_v4i16((LAS3 s16x4*)(bi + b_rd[1][nb & 1]));
        bfr[nb] = (bf16x8){v0[0], v0[1], v0[2], v0[3], v1[0], v1[1], v1[2], v1[3]};
      }
#pragma unroll
      for (int mb = 0; mb < 4; ++mb)
#pragma unroll
        for (int nb = 0; nb < NB; ++nb)
          acc[mb][nb] = __builtin_amdgcn_mfma_f32_32x32x16_bf16(af[mb], bfr[nb], acc[mb][nb], 0, 0, 0);
    }
  };

  const int nk = t.K >> 6;
  __syncthreads();
  issue_b(0); issue_a(0, 0);
  asm volatile("s_waitcnt vmcnt(8)" ::: "memory");
  write_b(0, 0);
  if (nk > 1) { issue_b(1); asm volatile("s_waitcnt vmcnt(16)" ::: "memory"); }
  else asm volatile("s_waitcnt vmcnt(0)" ::: "memory");
  __syncthreads();
  if (nk > 1) issue_a(1, 1);
  for (int kt = 0; kt < nk; ++kt) {
    const int s = kt & 1;
    compute(s);
    if (kt + 1 < nk) {
      asm volatile("s_waitcnt vmcnt(0)" ::: "memory");
      write_b(kt + 1, s ^ 1);
      if (kt + 2 < nk) issue_b(kt + 2);
      __syncthreads();
      if (kt + 2 < nk) issue_a(kt + 2, s);
    }
  }
}
template <int NB, class F>
__device__ __forceinline__ void acc_foreach_row(f32x16 (&acc)[4][4], F f) {
  int tz = threadIdx.x; asm volatile("" : "+v"(tz));
  const int lane = tz & 63, wid = tz >> 6, wr = wid >> 1, wc = wid & 1;
  const int l31 = lane & 31, hh = lane >> 5;
#pragma unroll
  for (int mb = 0; mb < 4; ++mb)
#pragma unroll
    for (int reg = 0; reg < 16; ++reg) {
      const int rowl = wr * 128 + mb * 32 + (reg & 3) + 8 * (reg >> 2) + 4 * hh;
      float v[NB];
#pragma unroll
      for (int nb = 0; nb < NB; ++nb) v[nb] = acc[mb][nb][reg];
      f(rowl, wc * 64 + l31, v);
      asm volatile("" ::: "memory");
    }
}
__device__ __forceinline__ void ph_prep0(const Params& p) {
  const int tid_ = opaque_tid(); const int lane = tid_ & 63, wid = tid_ >> 6;
  if (blockIdx.x == 0 && tid_ < 64) p.counts[tid_] = 0;
  for (int t = blockIdx.x * 4 + wid; t < T_; t += gridDim.x * 4) {
    const float* xr = p.x + (long)t * 2048;
    f32x4 v[8]; float ss = 0.f;
#pragma unroll
    for (int j = 0; j < 8; ++j) { v[j] = *(const f32x4*)(xr + j * 256 + lane * 4); ss += v[j][0] * v[j][0] + v[j][1] * v[j][1] + v[j][2] * v[j][2] + v[j][3] * v[j][3]; }
    ss = wave_sum(ss);
    const float r = rsqrtf(ss * (1.0f / 2048.0f) + EPS_);
#pragma unroll
    for (int j = 0; j < 8; ++j) {
      f32x4 g = *(const f32x4*)(p.attn_norm + j * 256 + lane * 4);
      u32x2 w = {pack_bf16(v[j][0] * r * g[0], v[j][1] * r * g[1]), pack_bf16(v[j][2] * r * g[2], v[j][3] * r * g[3])};
      *(u32x2*)(p.h1 + (long)t * 2048 + j * 256 + lane * 4) = w;
    }
    if (lane < 32) {
      float inv = 1.0f / powf(10000.0f, (float)(2 * lane) / 64.0f);
      float ang = (float)p.pos[t] * inv;
      double a = (double)ang;
      double k = rint(a * 0.15915494309189535);
      float rf = (float)fma(-k, 6.283185307179586, a);
      p.cs[t * 32 + lane] = make_float2(__cosf(rf), __sinf(rf));
    }
  }
}

template <int NB>
__device__ __forceinline__ void win_tile(const Params& p, char* smem, int mt, int nt) {
  f32x16 acc[4][4];
  GemmTile t{};
  t.A = p.h1; t.lda = 2048; t.aidx = nullptr; t.m0 = mt * 256; t.mvalid = 256;
  t.B0 = p.w_in + nt * 256; t.B1 = t.B0 + 128; t.ldb = NC_;
  const int rem = NC_ - nt * 256;
  t.nv0 = rem >= 128 ? 128 : rem; t.nv1 = rem >= 256 ? 128 : (rem > 128 ? rem - 128 : 0);
  t.kscale = nullptr; t.K = 2048;
  gemm_tile_256<NB, false>(t, smem, acc);
  u16* base = p.proj + (long)(mt * 256) * NC_ + nt * 256;
  const int nv0 = t.nv0, nv1 = t.nv1;
  acc_foreach_row<NB>(acc, [&](int rowl, int coll, float (&v)[NB]) {
    u16* rp = base + (long)rowl * NC_ + coll;
    OPAQUE(rp);
#pragma unroll
    for (int nb = 0; nb < NB; ++nb) {
      const int c = (nb & 1) * 32 + coll;
      const int lim = (nb >> 1) ? nv1 : nv0;
      if (c < lim) rp[(nb >> 1) * 128 + (nb & 1) * 32] = f32_to_bf16(v[nb]);
    }
  });
}
__device__ __forceinline__ void ph_win(const Params& p, char* smem) {
  const int x = blockIdx.x & 7, slot = blockIdx.x >> 3;
  for (int j = slot; j < 64; j += 32) win_tile<4>(p, smem, 4 * x + (j & 3), j >> 2);
  if (slot < 4) win_tile<2>(p, smem, 4 * x + slot, 16);
}

__device__ __forceinline__ void ph_prep1(const Params& p, char* smem) {
  float* gds = (float*)smem;
  float* cums = (float*)(smem + 4096);
  const int tid = opaque_tid(), lane = tid & 63, wid = tid >> 6;
  for (int u = blockIdx.x; u < 512; u += gridDim.x) {
    const int ch = u >> 2, h = u & 3; const int t0 = ch * 64;
    __syncthreads();
    {
      const int tl = tid >> 2, r4 = (tid & 3) * 4;
      u32x2 w = *(const u32x2*)(p.proj + (long)(t0 + tl) * NC_ + C_GD + r4);
      gds[tl * 16 + r4 + 0] = bf_lo(w[0]); gds[tl * 16 + r4 + 1] = bf_hi(w[0]);
      gds[tl * 16 + r4 + 2] = bf_lo(w[1]); gds[tl * 16 + r4 + 3] = bf_hi(w[1]);
    }
    const int c = tid & 127, half = tid >> 7;
    float gu[16];
#pragma unroll
    for (int r = 0; r < 16; ++r) gu[r] = p.gate_up[r * 512 + h * 128 + c];
    const float bias = p.gate_bias[h * 128 + c];
    __syncthreads();
    float run = 0.f;
    for (int i = 0; i < 32; ++i) {
      const int tl = half * 32 + i;
      float z = bias;
#pragma unroll
      for (int r = 0; r < 16; ++r) z = fmaf(gds[tl * 16 + r], gu[r], z);
      const float ls = fminf(z, 0.f) - log1pf(__expf(-fabsf(z)));
      run += ls * (1.0f / 16.0f);
      cums[tl * 128 + c] = run;
    }
    __syncthreads();
    {
      const float add = cums[31 * 128 + c];
      for (int i = 0; i < 32; ++i) {
        const int tl = half * 32 + i;
        float v = cums[tl * 128 + c] + (half ? add : 0.f);
        p.bcum[(long)(t0 + tl) * 512 + h * 128 + c] = v;
      }
    }
    for (int i = 0; i < 4; ++i) {
      const long t = t0 + h * 16 + wid * 4 + i;
      const u16* pr = p.proj + t * NC_;
      u32x4 a = *(const u32x4*)(pr + C_MQ + lane * 8);
      u32x4 b = *(const u32x4*)(pr + C_MKV + lane * 8);
      float sa = 0.f, sb = 0.f;
#pragma unroll
      for (int k = 0; k < 4; ++k) { float l = bf_lo(a[k]), hgh = bf_hi(a[k]); sa += l * l + hgh * hgh; l = bf_lo(b[k]); hgh = bf_hi(b[k]); sb += l * l + hgh * hgh; }
      sa = wave_sum(sa); sb = wave_sum(sb);
      if (lane == 0) { p.rq[t] = rsqrtf(sa * (1.0f / 512.0f) + EPS_); p.rkv[t] = rsqrtf(sb * (1.0f / 512.0f) + EPS_); }
      if (lane < 32) {
        const float t1 = bf16_to_f32(pr[C_MKR + lane]), t2 = bf16_to_f32(pr[C_MKR + lane + 32]);
        const float2 cs = p.cs[t * 32 + lane];
        p.kpe[t * 64 + lane] = f32_to_bf16(t1 * cs.x - t2 * cs.y);
        p.kpe[t * 64 + lane + 32] = f32_to_bf16(t1 * cs.y + t2 * cs.x);
      }
    }
  }
}

#define QSCALE_ (0.07216878364870322f * 1.4426950408889634f)
__device__ __forceinline__ void upq_tile(const Params& p, char* smem, int mt, int nt) {
  f32x16 acc[4][4];
  GemmTile t{};
  t.A = p.proj + C_MQ; t.lda = NC_; t.aidx = nullptr; t.m0 = mt * 256; t.mvalid = 256;
  t.B0 = p.w_uq + nt * 256; t.B1 = t.B0 + 128; t.ldb = 1536; t.nv0 = 128; t.nv1 = 128; t.kscale = p.q_norm; t.K = 512;
  gemm_tile_256<4, true>(t, smem, acc);
  u16* base = p.q + (long)(mt * 256) * 1536 + nt * 256;
  const float* rq = p.rq + mt * 256;
  acc_foreach_row<4>(acc, [&](int rowl, int coll, float (&v)[4]) {
    u16* rp = base + (long)rowl * 1536 + coll;
    OPAQUE(rp);
    const float s = rq[rowl] * QSCALE_;
#pragma unroll
    for (int nb = 0; nb < 4; ++nb) rp[(nb >> 1) * 128 + (nb & 1) * 32] = f32_to_bf16(v[nb] * s);
  });
}
__device__ __forceinline__ void upkv_tile(const Params& p, char* smem, int mt, int nt) {
  f32x16 acc[4][4];
  GemmTile t{};
  t.A = p.proj + C_MKV; t.lda = NC_; t.aidx = nullptr; t.m0 = mt * 256; t.mvalid = 256;
  t.B0 = p.w_ukv + nt * 256; t.B1 = t.B0 + 128; t.ldb = 2048; t.nv0 = 128; t.nv1 = 128; t.kscale = p.kv_norm; t.K = 512;
  gemm_tile_256<4, true>(t, smem, acc);
  u16* base = p.kv + (long)(mt * 256) * 2048 + nt * 256;
  const float* rk = p.rkv + mt * 256;
  acc_foreach_row<4>(acc, [&](int rowl, int coll, float (&v)[4]) {
    u16* rp = base + (long)rowl * 2048 + coll;
    OPAQUE(rp);
    const float s = rk[rowl];
#pragma unroll
    for (int nb = 0; nb < 4; ++nb) rp[(nb >> 1) * 128 + (nb & 1) * 32] = f32_to_bf16(v[nb] * s);
  });
}
#define AT_KSTRIDE 400
#define AT_KBYTES  (64 * AT_KSTRIDE)
#define AT_STAGE   (AT_KBYTES + 16384)
#define AT_LDS_BYTES (2 * AT_STAGE)

__device__ __forceinline__ void attn_unit(const Params& p, char* smem, int b, int h, int qb) {
  const int tid = opaque_tid(), lane = tid & 63, wid = tid >> 6, l31 = lane & 31, hh = lane >> 5;
  const long tq = (long)b * SEQ_ + qb * 128 + wid * 32 + l31;
  bf16x8 qf[12];
  {
    const u16* qp = p.q + (tq * 8 + h) * 192 + 8 * hh;
#pragma unroll
    for (int ks = 0; ks < 12; ++ks) qf[ks] = *(const bf16x8*)(qp + 16 * ks);
#pragma unroll
    for (int s = 0; s < 2; ++s) {
      const float2* cp = p.cs + tq * 32 + 16 * s + 8 * hh;
      bf16x8 lo = qf[8 + s], hi = qf[10 + s], nlo, nhi;
#pragma unroll
      for (int j = 0; j < 8; j += 2) {
        float2 c0 = cp[j], c1 = cp[j + 1];
        float a0 = bf16_to_f32((u16)lo[j]), a1 = bf16_to_f32((u16)lo[j + 1]);
        float b0 = bf16_to_f32((u16)hi[j]), b1 = bf16_to_f32((u16)hi[j + 1]);
        unsigned wl = pack_bf16(a0 * c0.x - b0 * c0.y, a1 * c1.x - b1 * c1.y);
        unsigned wh = pack_bf16(a0 * c0.y + b0 * c0.x, a1 * c1.y + b1 * c1.x);
        nlo[j] = (short)(wl & 0xffff); nlo[j + 1] = (short)(wl >> 16);
        nhi[j] = (short)(wh & 0xffff); nhi[j + 1] = (short)(wh >> 16);
      }
      qf[8 + s] = nlo; qf[10 + s] = nhi;
    }
  }
  int k_key[6], k_c[6];
#pragma unroll
  for (int i = 0; i < 6; ++i) { int pp = i * 256 + tid; k_key[i] = pp / 24; k_c[i] = pp % 24; }
  u32x4 kreg[6], vreg[4];
  const long tk0 = (long)b * SEQ_;
  auto load_tile = [&](int kt) {
#pragma unroll
    for (int i = 0; i < 6; ++i) {
      const long t = tk0 + kt * 64 + k_key[i];
      const u16* src = (k_c[i] < 16) ? (p.kv + (t * 8 + h) * 256 + k_c[i] * 8) : (p.kpe + t * 64 + (k_c[i] - 16) * 8);
      kreg[i] = *(const u32x4*)src;
    }
#pragma unroll
    for (int i = 0; i < 4; ++i) {
      const int pp = i * 256 + tid; const int key = pp >> 4, c = pp & 15;
      vreg[i] = *(const u32x4*)(p.kv + ((tk0 + kt * 64 + key) * 8 + h) * 256 + 128 + c * 8);
    }
  };
  auto store_tile = [&](int s) {
    char* Ks = smem + s * AT_STAGE; char* Vs = Ks + AT_KBYTES;
#pragma unroll
    for (int i = 0; i < 6; ++i) *(u32x4*)(Ks + k_key[i] * AT_KSTRIDE + k_c[i] * 16) = kreg[i];
#pragma unroll
    for (int i = 0; i < 4; ++i) { const int pp = i * 256 + tid; *(u32x4*)(Vs + off_b(pp >> 4, pp & 15)) = vreg[i]; }
  };

  f32x16 o[4];
#pragma unroll
  for (int c = 0; c < 4; ++c)
#pragma unroll
    for (int r = 0; r < 16; ++r) o[c][r] = 0.f;
  float m = -1e30f, l = 0.f;
  const int nt = 2 * qb + 2;
  const int qpos = qb * 128 + wid * 32 + l31;

  __syncthreads();
  load_tile(0);
  store_tile(0);
  if (nt > 1) load_tile(1);
  __syncthreads();
  for (int kt = 0; kt < nt; ++kt) {
    const int s = kt & 1;
    const char* Ks = smem + s * AT_STAGE; const char* Vs = Ks + AT_KBYTES;
    const bool active = (kt * 64) <= (qb * 128 + wid * 32 + 31);
    if (active) {
      f32x16 sc[2];
#pragma unroll
      for (int kb = 0; kb < 2; ++kb) {
#pragma unroll
        for (int r = 0; r < 16; ++r) sc[kb][r] = 0.f;
#pragma unroll
        for (int ks = 0; ks < 12; ++ks) {
          bf16x8 a = *(const bf16x8*)(Ks + (kb * 32 + l31) * AT_KSTRIDE + (2 * ks + hh) * 16);
          sc[kb] = __builtin_amdgcn_mfma_f32_32x32x16_bf16(a, qf[ks], sc[kb], 0, 0, 0);
        }
      }
      if (kt >= 2 * qb) {
#pragma unroll
        for (int kb = 0; kb < 2; ++kb)
#pragma unroll
          for (int r = 0; r < 16; ++r) {
            const int key = kt * 64 + kb * 32 + (r & 3) + 8 * (r >> 2) + 4 * hh;
            if (key > qpos) sc[kb][r] = -1e30f;
          }
      }
      float mx = sc[0][0];
#pragma unroll
      for (int kb = 0; kb < 2; ++kb)
#pragma unroll
        for (int r = 0; r < 16; ++r) mx = fmaxf(mx, sc[kb][r]);
      mx = fmaxf(mx, __shfl_xor(mx, 32));
      const float mn = fmaxf(m, mx);
      const float alpha = exp2f(m - mn);
      m = mn;
      float ps = 0.f;
      bf16x8 pf[4];
#pragma unroll
      for (int kb = 0; kb < 2; ++kb)
#pragma unroll
        for (int s2 = 0; s2 < 2; ++s2) {
          float e[8];
#pragma unroll
          for (int j = 0; j < 8; ++j) { e[j] = exp2f(sc[kb][8 * s2 + j] - mn); ps += e[j]; }
          unsigned w0 = pack_bf16(e[0], e[1]), w1 = pack_bf16(e[2], e[3]), w2 = pack_bf16(e[4], e[5]), w3 = pack_bf16(e[6], e[7]);
          u32x4 w = {w0, w1, w2, w3};
          pf[kb * 2 + s2] = *(bf16x8*)&w;
        }
      l = l * alpha + ps;
#pragma unroll
      for (int c = 0; c < 4; ++c)
#pragma unroll
        for (int r = 0; r < 16; ++r) o[c][r] *= alpha;
#pragma unroll
      for (int c = 0; c < 4; ++c)
#pragma unroll
        for (int kk = 0; kk < 4; ++kk) {
          const unsigned rbase = 32 * (kk >> 1) + 16 * (kk & 1) + 4 * hh;
          bf16x8 a = tr_frag(Vs, lane, c, rbase, rbase + 8);
          o[c] = __builtin_amdgcn_mfma_f32_32x32x16_bf16(a, pf[kk], o[c], 0, 0, 0);
        }
    }
    if (kt + 1 < nt) {
      store_tile(s ^ 1);
      if (kt + 2 < nt) load_tile(kt + 2);
      __syncthreads();
    }
  }
  l = l + __shfl_xor(l, 32);
  const float inv = 1.0f / l;
  u16* op = p.omla + tq * 1024 + h * 128 + 4 * hh;
#pragma unroll
  for (int c = 0; c < 4; ++c)
#pragma unroll
    for (int rg = 0; rg < 4; ++rg) {
      u32x2 w = {pack_bf16(o[c][4 * rg] * inv, o[c][4 * rg + 1] * inv), pack_bf16(o[c][4 * rg + 2] * inv, o[c][4 * rg + 3] * inv)};
      *(u32x2*)(op + 32 * c + 8 * rg) = w;
    }
}

#define G1_LDS_BYTES 49152
__device__ __forceinline__ void gla_g1_unit(const Params& p, char* smem, int u) {
  const int tid = opaque_tid(), lane = tid & 63, wid = tid >> 6, l31 = lane & 31, hh = lane >> 5;
  const int bh = u >> 6, n = u & 63, b = bh >> 2, h = bh & 3;
  const long t0 = (long)b * SEQ_ + n * 64;
  char* Ks = smem; char* Vs = smem + 16384;
  __syncthreads();
  {
    const int ch = tid & 15;
    const float* bl = p.bcum + (t0 + 63) * 512 + h * 128 + ch * 8;
    f32x4 bl0 = *(const f32x4*)bl, bl1 = *(const f32x4*)(bl + 4);
    if (tid < 128) p.dec[(long)u * 128 + tid] = __expf(p.bcum[(t0 + 63) * 512 + h * 128 + tid]);
#pragma unroll
    for (int i = 0; i < 4; ++i) {
      const int tok = (i * 256 + tid) >> 4;
      u32x4 kw = *(const u32x4*)(p.proj + (t0 + tok) * NC_ + C_GK + h * 128 + ch * 8);
      const float* bp = p.bcum + (t0 + tok) * 512 + h * 128 + ch * 8;
      f32x4 b0 = *(const f32x4*)bp, b1 = *(const f32x4*)(bp + 4);
      u32x4 w;
      w[0] = pack_bf16(bf_lo(kw[0]) * __expf(bl0[0] - b0[0]), bf_hi(kw[0]) * __expf(bl0[1] - b0[1]));
      w[1] = pack_bf16(bf_lo(kw[1]) * __expf(bl0[2] - b0[2]), bf_hi(kw[1]) * __expf(bl0[3] - b0[3]));
      w[2] = pack_bf16(bf_lo(kw[2]) * __expf(bl1[0] - b1[0]), bf_hi(kw[2]) * __expf(bl1[1] - b1[1]));
      w[3] = pack_bf16(bf_lo(kw[3]) * __expf(bl1[2] - b1[2]), bf_hi(kw[3]) * __expf(bl1[3] - b1[3]));
      *(u32x4*)(Ks + off_b(tok, ch)) = w;
    }
#pragma unroll
    for (int i = 0; i < 8; ++i) {
      const int pp = i * 256 + tid; const int tok = pp >> 5, c32 = pp & 31;
      u32x4 vw = *(const u32x4*)(p.proj + (t0 + tok) * NC_ + C_GV + h * 256 + c32 * 8);
      *(u32x4*)(Vs + (c32 >> 4) * 16384 + off_b(tok, c32 & 15)) = vw;
    }
  }
  __syncthreads();
  f32x16 acc[4][2];
#pragma unroll
  for (int mb = 0; mb < 4; ++mb)
#pragma unroll
    for (int nb = 0; nb < 2; ++nb)
#pragma unroll
      for (int r = 0; r < 16; ++r) acc[mb][nb][r] = 0.f;
  const char* Vimg = Vs + (wid >> 1) * 16384;
#pragma unroll
  for (int ks = 0; ks < 4; ++ks) {
    bf16x8 af[4], bfr[2];
    const unsigned r0 = 16 * ks + 8 * hh;
#pragma unroll
    for (int mb = 0; mb < 4; ++mb) af[mb] = tr_frag(Ks, lane, mb, r0, r0 + 4);
#pragma unroll
    for (int nb = 0; nb < 2; ++nb) bfr[nb] = tr_frag(Vimg, lane, 2 * (wid & 1) + nb, r0, r0 + 4);
#pragma unroll
    for (int mb = 0; mb < 4; ++mb)
#pragma unroll
      for (int nb = 0; nb < 2; ++nb) acc[mb][nb] = __builtin_amdgcn_mfma_f32_32x32x16_bf16(af[mb], bfr[nb], acc[mb][nb], 0, 0, 0);
  }
  u16* base = p.kvc + (long)u * 32768 + wid * 64 + l31;
#pragma unroll
  for (int mb = 0; mb < 4; ++mb)
#pragma unroll
    for (int r = 0; r < 16; ++r) {
      const int dk = mb * 32 + (r & 3) + 8 * (r >> 2) + 4 * hh;
      u16* rp = base + dk * 256;
      rp[0] = f32_to_bf16(acc[mb][0][r]);
      rp[32] = f32_to_bf16(acc[mb][1][r]);
    }
}

__device__ __forceinline__ void gla_g2_unit(const Params& p, int u) {
  const int tid = opaque_tid();
  const int bh = u >> 5, part = u & 31;
  const int dk = part * 4 + (tid >> 6), dv = (tid & 63) * 4;
  float s0 = 0.f, s1 = 0.f, s2 = 0.f, s3 = 0.f;
  const long ebase = (long)dk * 256 + dv;
#pragma unroll 8
  for (int n = 0; n < 64; ++n) {
    const long un = (long)(bh * 64 + n);
    u32x2 kw = *(const u32x2*)(p.kvc + un * 32768 + ebase);
    const float d = p.dec[un * 128 + dk];
    u32x2 w = {pack_bf16(s0, s1), pack_bf16(s2, s3)};
    *(u32x2*)(p.sprev + un * 32768 + ebase) = w;
    s0 = fmaf(d, s0, bf_lo(kw[0])); s1 = fmaf(d, s1, bf_hi(kw[0]));
    s2 = fmaf(d, s2, bf_lo(kw[1])); s3 = fmaf(d, s3, bf_hi(kw[1]));
  }
}

#define G3_LDS_BYTES (16384 + 16384 + 32768 + 65536 + 1024)
__device__ __forceinline__ void gla_g3_unit(const Params& p, char* smem, int u) {
  const int tid = opaque_tid(), lane = tid & 63, wid = tid >> 6, l31 = lane & 31, hh = lane >> 5;
  const int bh = u >> 6, n = u & 63, b = bh >> 2, h = bh & 3;
  const long t0 = (long)b * SEQ_ + n * 64;
  char* Qd = smem; char* Ki = smem + 16384; char* Vs = smem + 32768; char* Sp = smem + 65536; float* red = (float*)(smem + 131072);
  __syncthreads();
  {
    const int ch = tid & 15;
    const float qs = 0.08838834764831845f;
#pragma unroll
    for (int i = 0; i < 4; ++i) {
      const int tok = (i * 256 + tid) >> 4;
      const u16* pr = p.proj + (t0 + tok) * NC_ + h * 128 + ch * 8;
      u32x4 qw = *(const u32x4*)(pr + C_GQ), kw = *(const u32x4*)(pr + C_GK);
      const float* bp = p.bcum + (t0 + tok) * 512 + h * 128 + ch * 8;
      f32x4 b0 = *(const f32x4*)bp, b1 = *(const f32x4*)(bp + 4);
      float e[8] = {__expf(b0[0]), __expf(b0[1]), __expf(b0[2]), __expf(b0[3]), __expf(b1[0]), __expf(b1[1]), __expf(b1[2]), __expf(b1[3])};
      u32x4 wq, wk;
#pragma unroll
      for (int k = 0; k < 4; ++k) {
        wq[k] = pack_bf16(bf_lo(qw[k]) * qs * e[2 * k], bf_hi(qw[k]) * qs * e[2 * k + 1]);
        wk[k] = pack_bf16(bf_lo(kw[k]) / e[2 * k], bf_hi(kw[k]) / e[2 * k + 1]);
      }
      *(u32x4*)(Qd + off_b(tok, ch)) = wq;
      *(u32x4*)(Ki + off_b(tok, ch)) = wk;
    }
#pragma unroll
    for (int i = 0; i < 8; ++i) {
      const int pp = i * 256 + tid; const int tok = pp >> 5, c32 = pp & 31;
      u32x4 vw = *(const u32x4*)(p.proj + (t0 + tok) * NC_ + C_GV + h * 256 + c32 * 8);
      *(u32x4*)(Vs + (c32 >> 4) * 16384 + off_b(tok, c32 & 15)) = vw;
    }
#pragma unroll
    for (int i = 0; i < 16; ++i) {
      const int pp = i * 256 + tid; const int dk = pp >> 5, c32 = pp & 31;
      u32x4 sw = *(const u32x4*)(p.sprev + (long)u * 32768 + dk * 256 + c32 * 8);
      *(u32x4*)(Sp + (c32 >> 4) * 32768 + off_b(dk, c32 & 15)) = sw;
    }
  }
  __syncthreads();
  const int ib = wid & 1, dvh = wid >> 1;
  f32x16 sc[2];
#pragma unroll
  for (int jb = 0; jb < 2; ++jb) {
#pragma unroll
    for (int r = 0; r < 16; ++r) sc[jb][r] = 0.f;
    if (jb <= ib) {
#pragma unroll
      for (int ks = 0; ks < 8; ++ks) {
        bf16x8 a = *(const bf16x8*)(Ki + off_b(jb * 32 + l31, 2 * ks + hh));
        bf16x8 bq = *(const bf16x8*)(Qd + off_b(ib * 32 + l31, 2 * ks + hh));
        sc[jb] = __builtin_amdgcn_mfma_f32_32x32x16_bf16(a, bq, sc[jb], 0, 0, 0);
      }
#pragma unroll
      for (int r = 0; r < 16; ++r) {
        const int j = jb * 32 + (r & 3) + 8 * (r >> 2) + 4 * hh, i = ib * 32 + l31;
        if (j > i) sc[jb][r] = 0.f;
      }
    }
  }
  bf16x8 pf[4];
#pragma unroll
  for (int jb = 0; jb < 2; ++jb)
#pragma unroll
    for (int s2 = 0; s2 < 2; ++s2) {
      u32x4 w = {pack_bf16(sc[jb][8 * s2 + 0], sc[jb][8 * s2 + 1]), pack_bf16(sc[jb][8 * s2 + 2], sc[jb][8 * s2 + 3]),
                 pack_bf16(sc[jb][8 * s2 + 4], sc[jb][8 * s2 + 5]), pack_bf16(sc[jb][8 * s2 + 6], sc[jb][8 * s2 + 7])};
      pf[jb * 2 + s2] = *(bf16x8*)&w;
    }
  f32x16 o[4];
#pragma unroll
  for (int c = 0; c < 4; ++c)
#pragma unroll
    for (int r = 0; r < 16; ++r) o[c][r] = 0.f;
  const char* Vimg = Vs + dvh * 16384;
  const char* Simg = Sp + dvh * 32768;
#pragma unroll
  for (int c = 0; c < 4; ++c) {
#pragma unroll
    for (int kk = 0; kk < 4; ++kk) {
      if ((kk >> 1) <= ib) {
        const unsigned rbase = 32 * (kk >> 1) + 16 * (kk & 1) + 4 * hh;
        bf16x8 a = tr_frag(Vimg, lane, c, rbase, rbase + 8);
        o[c] = __builtin_amdgcn_mfma_f32_32x32x16_bf16(a, pf[kk], o[c], 0, 0, 0);
      }
    }
#pragma unroll
    for (int ks = 0; ks < 8; ++ks) {
      const unsigned r0 = 16 * ks + 8 * hh;
      bf16x8 a = tr_frag(Simg, lane, c, r0, r0 + 4);
      bf16x8 bq = *(const bf16x8*)(Qd + off_b(ib * 32 + l31, 2 * ks + hh));
      o[c] = __builtin_amdgcn_mfma_f32_32x32x16_bf16(a, bq, o[c], 0, 0, 0);
    }
  }
  float ss = 0.f;
#pragma unroll
  for (int c = 0; c < 4; ++c)
#pragma unroll
    for (int r = 0; r < 16; ++r) ss += o[c][r] * o[c][r];
  ss += __shfl_xor(ss, 32);
  if (hh == 0) red[dvh * 64 + ib * 32 + l31] = ss;
  __syncthreads();
  const float tot = red[ib * 32 + l31] + red[64 + ib * 32 + l31];
  const float rn = rsqrtf(tot * (1.0f / 256.0f) + EPS_);
  const long t = t0 + ib * 32 + l31;
  const u16* grp = p.proj + t * NC_ + C_GR + h * 256 + dvh * 128 + 4 * hh;
  u16* op = p.mix + t * 2048 + h * 256 + dvh * 128 + 4 * hh;
  const float* gp = p.gla_out_norm + dvh * 128 + 4 * hh;
#pragma unroll
  for (int c = 0; c < 4; ++c)
#pragma unroll
    for (int rg = 0; rg < 4; ++rg) {
      u32x2 gw = *(const u32x2*)(grp + 32 * c + 8 * rg);
      f32x4 g = *(const f32x4*)(gp + 32 * c + 8 * rg);
      float gr[4] = {bf_lo(gw[0]), bf_hi(gw[0]), bf_lo(gw[1]), bf_hi(gw[1])};
      float ov[4];
#pragma unroll
      for (int k = 0; k < 4; ++k) { float si = gr[k] / (1.0f + __expf(-gr[k])); ov[k] = o[c][4 * rg + k] * rn * g[k] * si; }
      u32x2 w = {pack_bf16(ov[0], ov[1]), pack_bf16(ov[2], ov[3])};
      *(u32x2*)(op + 32 * c + 8 * rg) = w;
    }
}

__device__ __forceinline__ void mla_norm_tokens(const Params& p) {
  const int tid_ = opaque_tid(); const int lane = tid_ & 63, wid = tid_ >> 6;
  for (int t = blockIdx.x * 4 + wid; t < T_; t += gridDim.x * 4) {
    const u16* src = p.omla + (long)t * 1024;
    u32x4 a = *(const u32x4*)(src + lane * 8), b = *(const u32x4*)(src + 512 + lane * 8);
    float ss = 0.f;
#pragma unroll
    for (int k = 0; k < 4; ++k) { float x0 = bf_lo(a[k]), x1 = bf_hi(a[k]), y0 = bf_lo(b[k]), y1 = bf_hi(b[k]); ss += x0 * x0 + x1 * x1 + y0 * y0 + y1 * y1; }
    ss = wave_sum(ss);
    const float r = rsqrtf(ss * (1.0f / 1024.0f) + EPS_);
    const float* g = p.mla_out_norm;
    u32x4 wa, wb;
#pragma unroll
    for (int k = 0; k < 4; ++k) {
      wa[k] = pack_bf16(bf_lo(a[k]) * r * g[lane * 8 + 2 * k], bf_hi(a[k]) * r * g[lane * 8 + 2 * k + 1]);
      wb[k] = pack_bf16(bf_lo(b[k]) * r * g[512 + lane * 8 + 2 * k], bf_hi(b[k]) * r * g[512 + lane * 8 + 2 * k + 1]);
    }
    *(u32x4*)(p.mix + (long)t * 2048 + 1024 + lane * 8) = wa;
    *(u32x4*)(p.mix + (long)t * 2048 + 1024 + 512 + lane * 8) = wb;
  }
}
__device__ __forceinline__ void wout_tile(const Params& p, char* smem, int mt, int nt) {
  f32x16 acc[4][4];
  GemmTile t{};
  t.A = p.mix; t.lda = 2048; t.aidx = nullptr; t.m0 = mt * 256; t.mvalid = 256;
  t.B0 = p.w_out + nt * 256; t.B1 = t.B0 + 128; t.ldb = 2048; t.nv0 = 128; t.nv1 = 128; t.kscale = nullptr; t.K = 2048;
  gemm_tile_256<4, false>(t, smem, acc);
  const long boff = (long)(mt * 256) * 2048 + nt * 256;
  acc_foreach_row<4>(acc, [&](int rowl, int coll, float (&v)[4]) {
    long o = boff + (long)rowl * 2048 + coll;
    OPAQUE(o);
    const float* xr = p.x + o; float* yr = p.x1 + o;
#pragma unroll
    for (int nb = 0; nb < 4; ++nb) { const int c = (nb >> 1) * 128 + (nb & 1) * 32; yr[c] = xr[c] + v[nb]; }
  });
}

#define P7_LDS_BYTES (33280 + 32768 + 4224 + 128)
__device__ __forceinline__ void ffn_prep_unit(const Params& p, char* smem, int u) {
  float* hs = (float*)smem; float* rws = (float*)(smem + 33280); float* lg = (float*)(smem + 33280 + 32768); float* rs = lg + 32 * 33;
  const int tid = opaque_tid();
  const int tl = tid >> 3, seg = tid & 7;
  const long t = (long)u * 32 + tl;
  const float* xr = p.x1 + t * 2048;
  float acc0 = 0.f, acc1 = 0.f, acc2 = 0.f, acc3 = 0.f, ss = 0.f;
  for (int kc = 0; kc < 8; ++kc) {
    __syncthreads();
#pragma unroll
    for (int i = 0; i < 8; ++i) {
      const int kk = i * 32 + seg * 4;
      f32x4 v = *(const f32x4*)(xr + kc * 256 + kk);
      f32x4 g = *(const f32x4*)(p.ffn_norm + kc * 256 + kk);
      ss += v[0] * v[0] + v[1] * v[1] + v[2] * v[2] + v[3] * v[3];
      *(f32x4*)(hs + tl * 260 + kk) = v * g;
    }
#pragma unroll
    for (int i = 0; i < 8; ++i) {
      const int kk = (tid >> 3) + 32 * i;
      *(f32x4*)(rws + kk * 32 + seg * 4) = *(const f32x4*)(p.router_w + (long)(kc * 256 + kk) * 32 + seg * 4);
    }
    __syncthreads();
#pragma unroll 8
    for (int kk = 0; kk < 256; ++kk) {
      const float hv = hs[tl * 260 + kk];
      const f32x4 w = *(const f32x4*)(rws + kk * 32 + seg * 4);
      acc0 = fmaf(hv, w[0], acc0); acc1 = fmaf(hv, w[1], acc1); acc2 = fmaf(hv, w[2], acc2); acc3 = fmaf(hv, w[3], acc3);
    }
  }
  ss += __shfl_xor(ss, 1); ss += __shfl_xor(ss, 2); ss += __shfl_xor(ss, 4);
  const float r = rsqrtf(ss * (1.0f / 2048.0f) + EPS_);
  lg[tl * 33 + seg * 4 + 0] = acc0 * r + p.router_b[seg * 4 + 0];
  lg[tl * 33 + seg * 4 + 1] = acc1 * r + p.router_b[seg * 4 + 1];
  lg[tl * 33 + seg * 4 + 2] = acc2 * r + p.router_b[seg * 4 + 2];
  lg[tl * 33 + seg * 4 + 3] = acc3 * r + p.router_b[seg * 4 + 3];
  if (seg == 0) rs[tl] = r;
  __syncthreads();
  if (tid < 32) {
    const long tt = (long)u * 32 + tid;
    const float* L = lg + tid * 33;
    unsigned used = 0u; int i0 = 0, i1 = 0, i2 = 0, i3 = 0; float v0 = 0.f, v1 = 0.f, v2 = 0.f, v3 = 0.f;
#pragma unroll
    for (int k = 0; k < 4; ++k) {
      int bi = -1; float bv = 0.f;
      for (int i = 0; i < 32; ++i) {
        const float x = L[i];
        const bool take = !((used >> i) & 1u) && (bi < 0 || x > bv);
        bi = take ? i : bi; bv = take ? x : bv;
      }
      used |= 1u << bi;
      if (k == 0) { i0 = bi; v0 = bv; } else if (k == 1) { i1 = bi; v1 = bv; } else if (k == 2) { i2 = bi; v2 = bv; } else { i3 = bi; v3 = bv; }
    }
    const float e0 = 1.0f, e1 = __expf(v1 - v0), e2 = __expf(v2 - v0), e3 = __expf(v3 - v0);
    const float inv = 1.0f / (e0 + e1 + e2 + e3);
    const int s0 = atomicAdd(&p.counts[i0], 1), s1 = atomicAdd(&p.counts[i1], 1), s2 = atomicAdd(&p.counts[i2], 1), s3 = atomicAdd(&p.counts[i3], 1);
    p.list[i0 * T_ + s0] = (int)tt; p.list[i1 * T_ + s1] = (int)tt; p.list[i2 * T_ + s2] = (int)tt; p.list[i3 * T_ + s3] = (int)tt;
    p.asg_e[tt * 4 + 0] = i0; p.asg_e[tt * 4 + 1] = i1; p.asg_e[tt * 4 + 2] = i2; p.asg_e[tt * 4 + 3] = i3;
    p.asg_slot[tt * 4 + 0] = s0; p.asg_slot[tt * 4 + 1] = s1; p.asg_slot[tt * 4 + 2] = s2; p.asg_slot[tt * 4 + 3] = s3;
    p.asg_g[tt * 4 + 0] = e0 * inv; p.asg_g[tt * 4 + 1] = e1 * inv; p.asg_g[tt * 4 + 2] = e2 * inv; p.asg_g[tt * 4 + 3] = e3 * inv;
  }
  {
    const float rr = rs[tl];
#pragma unroll
    for (int kc = 0; kc < 8; ++kc)
#pragma unroll
      for (int i = 0; i < 4; ++i) {
        const int kk = kc * 256 + i * 64 + seg * 8;
        f32x4 v0 = *(const f32x4*)(xr + kk), v1 = *(const f32x4*)(xr + kk + 4);
        f32x4 g0 = *(const f32x4*)(p.ffn_norm + kk), g1 = *(const f32x4*)(p.ffn_norm + kk + 4);
        u32x4 w = {pack_bf16(v0[0] * rr * g0[0], v0[1] * rr * g0[1]), pack_bf16(v0[2] * rr * g0[2], v0[3] * rr * g0[3]),
                   pack_bf16(v1[0] * rr * g1[0], v1[1] * rr * g1[1]), pack_bf16(v1[2] * rr * g1[2], v1[3] * rr * g1[3])};
        *(u32x4*)(p.h2 + t * 2048 + kk) = w;
      }
  }
}

__device__ __forceinline__ void moe_setup(const Params& p, int* mo) {
  __syncthreads();
  if (threadIdx.x == 0) {
    int s = 0;
    for (int e = 0; e < NE_; ++e) { mo[e] = s; s += (p.counts[e] + 255) >> 8; }
    mo[NE_] = s;
  }
  __syncthreads();
}
__device__ __forceinline__ int xcd_unit(int round) { return round * 256 + (blockIdx.x & 7) * 32 + (blockIdx.x >> 3); }

__device__ __forceinline__ void moe1_tile(const Params& p, char* smem, const int* mo, int e, int nt, int mt) {
  f32x16 acc[4][4];
  GemmTile t{};
  const int cnt = p.counts[e];
  t.A = p.h2; t.lda = 2048; t.aidx = p.list + e * T_ + mt * 256; t.m0 = 0; t.mvalid = min(256, cnt - mt * 256);
  t.B0 = p.w_gu + (long)e * 2048 * 4096 + nt * 128; t.B1 = t.B0 + 2048; t.ldb = 4096; t.nv0 = 128; t.nv1 = 128; t.kscale = nullptr; t.K = 2048;
  gemm_tile_256<4, false>(t, smem, acc);
  u16* base = p.act + (long)(mo[e] * 256 + mt * 256) * 2048 + nt * 128;
  const float* bg = p.b_gu + e * 4096 + nt * 128; const float* bu = bg + 2048;
  const int tq_ = opaque_tid(); const int cl = (tq_ >> 6 & 1) * 64 + (tq_ & 31);
  const float bgv[2] = {bg[cl], bg[cl + 32]}, buv[2] = {bu[cl], bu[cl + 32]};
  acc_foreach_row<4>(acc, [&](int rowl, int coll, float (&v)[4]) {
    u16* rp = base + (long)rowl * 2048 + coll;
    OPAQUE(rp);
#pragma unroll
    for (int nb = 0; nb < 2; ++nb) {
      const int c = nb * 32;
      float g = fminf(v[nb] + bgv[nb], 7.0f);
      float uu = fminf(fmaxf(v[nb + 2] + buv[nb], -7.0f), 7.0f);
      float a = (uu + 1.0f) * (g / (1.0f + __expf(-1.702f * g)));
      rp[c] = f32_to_bf16(a);
    }
  });
}
__device__ __forceinline__ void moe2_tile(const Params& p, char* smem, const int* mo, int e, int nt, int mt) {
  f32x16 acc[4][4];
  GemmTile t{};
  t.A = p.act; t.lda = 2048; t.aidx = nullptr; t.m0 = mo[e] * 256 + mt * 256; t.mvalid = 256;
  t.B0 = p.w_dn + (long)e * 2048 * 2048 + nt * 256; t.B1 = t.B0 + 128; t.ldb = 2048; t.nv0 = 128; t.nv1 = 128; t.kscale = nullptr; t.K = 2048;
  gemm_tile_256<4, false>(t, smem, acc);
  u16* base = p.ybuf + (long)t.m0 * 2048 + nt * 256;
  const float* bd = p.b_dn + e * 2048 + nt * 256;
  const int tq_ = opaque_tid(); const int cl = (tq_ >> 6 & 1) * 64 + (tq_ & 31);
  const float bdv[4] = {bd[cl], bd[cl + 32], bd[cl + 128], bd[cl + 160]};
  acc_foreach_row<4>(acc, [&](int rowl, int coll, float (&v)[4]) {
    u16* rp = base + (long)rowl * 2048 + coll;
    OPAQUE(rp);
#pragma unroll
    for (int nb = 0; nb < 4; ++nb) { const int c = (nb >> 1) * 128 + (nb & 1) * 32; rp[c] = f32_to_bf16(v[nb] + bdv[nb]); }
  });
}
template <int WHICH>
__device__ __forceinline__ void ph_moe(const Params& p, char* smem) {
  int* mo = (int*)(smem + G_LDS_BYTES);
  moe_setup(p, mo);
  const int NT = (WHICH == 1) ? 16 : 8;
  const int total = mo[NE_] * NT;
  for (int round = 0;; ++round) {
    const int u = xcd_unit(round);
    if (round * 256 >= total) break;
    if (u >= total) continue;
    int e = 0;
    while (mo[e + 1] * NT <= u) ++e;
    const int local = u - mo[e] * NT, me = mo[e + 1] - mo[e];
    const int nt = local / me, mt = local - nt * me;
    if (WHICH == 1) moe1_tile(p, smem, mo, e, nt, mt); else moe2_tile(p, smem, mo, e, nt, mt);
  }
}

__device__ __forceinline__ void ph_final(const Params& p, char* smem) {
  int* mo = (int*)(smem + G_LDS_BYTES);
  moe_setup(p, mo);
  const int tid_ = opaque_tid(); const int lane = tid_ & 63, wid = tid_ >> 6;
  for (int t = blockIdx.x * 4 + wid; t < T_; t += gridDim.x * 4) {
    long rows[4]; float gg[4];
#pragma unroll
    for (int k = 0; k < 4; ++k) { rows[k] = (long)(mo[p.asg_e[t * 4 + k]] * 256 + p.asg_slot[t * 4 + k]) * 2048; gg[k] = p.asg_g[t * 4 + k]; }
    f32x4 v[8]; float ss = 0.f;
#pragma unroll
    for (int j = 0; j < 8; ++j) {
      const int c = j * 256 + lane * 4;
      f32x4 a = *(const f32x4*)(p.x1 + (long)t * 2048 + c);
#pragma unroll
      for (int k = 0; k < 4; ++k) {
        u32x2 w = *(const u32x2*)(p.ybuf + rows[k] + c);
        a[0] += gg[k] * bf_lo(w[0]); a[1] += gg[k] * bf_hi(w[0]); a[2] += gg[k] * bf_lo(w[1]); a[3] += gg[k] * bf_hi(w[1]);
      }
      v[j] = a; ss += a[0] * a[0] + a[1] * a[1] + a[2] * a[2] + a[3] * a[3];
    }
    ss = wave_sum(ss);
    const float r = rsqrtf(ss * (1.0f / 2048.0f) + EPS_);
#pragma unroll
    for (int j = 0; j < 8; ++j) {
      const int c = j * 256 + lane * 4;
      f32x4 g = *(const f32x4*)(p.final_norm + c);
      f32x4 o = {v[j][0] * r * g[0], v[j][1] * r * g[1], v[j][2] * r * g[2], v[j][3] * r * g[3]};
      *(f32x4*)(p.out + (long)t * 2048 + c) = o;
    }
  }
}
#define LDS_MAX 143360
__global__ void __launch_bounds__(256, 1) mega(Params p) {
  extern __shared__ __attribute__((aligned(16))) char smem[];
  volatile LAS unsigned* xbw = (volatile LAS unsigned*)(smem + LDS_MAX - 16);
  if (threadIdx.x == 0) { xbw[0] = 0u; xbw[1] = 0u; xbw[2] = 0u; xbw[3] = 0u; }
  __syncthreads();
  XcdBarrier bar = xcd_barrier_post(p.bar, xbw);
  ph_prep0(p);
  xcd_barrier(bar);
  ph_win(p, smem);
  xcd_barrier(bar);
  ph_prep1(p, smem);
  xcd_barrier(bar);
  upkv_tile(p, smem, blockIdx.x >> 3, blockIdx.x & 7);
  if (blockIdx.x < 192) upq_tile(p, smem, blockIdx.x / 6, blockIdx.x % 6);
  if (blockIdx.x < 192) gla_g1_unit(p, smem, blockIdx.x);
  else for (int i = 0; i < 5; ++i) gla_g1_unit(p, smem, 192 + (blockIdx.x - 192) * 5 + i);
  xcd_barrier(bar);
  gla_g2_unit(p, blockIdx.x);
  {
    const int bh = blockIdx.x >> 4, qa = blockIdx.x & 15;
    attn_unit(p, smem, bh >> 3, bh & 7, 31 - qa);
    attn_unit(p, smem, bh >> 3, bh & 7, qa);
  }
  xcd_barrier(bar);
  for (int u = blockIdx.x; u < 512; u += gridDim.x) gla_g3_unit(p, smem, u);
  mla_norm_tokens(p);
  xcd_barrier(bar);
  wout_tile(p, smem, blockIdx.x >> 3, blockIdx.x & 7);
  xcd_barrier(bar);
  ffn_prep_unit(p, smem, blockIdx.x);
  xcd_barrier(bar);
  ph_moe<1>(p, smem);
  xcd_barrier(bar);
  ph_moe<2>(p, smem);
  xcd_barrier(bar);
  ph_final(p, smem);
}

extern "C" void kernel_launch(void* const* d_in, const int* in_sizes, int n_in,
                              void* d_out, int out_size, void* d_ws, size_t ws_size,
                              hipStream_t stream) {
  Params P{};
  P.x = (const float*)d_in[0]; P.pos = (const int*)d_in[1];
  P.attn_norm = (const float*)d_in[2]; P.w_in = (const float*)d_in[3]; P.gate_up = (const float*)d_in[4]; P.gate_bias = (const float*)d_in[5];
  P.gla_out_norm = (const float*)d_in[6]; P.q_norm = (const float*)d_in[7]; P.w_uq = (const float*)d_in[8]; P.kv_norm = (const float*)d_in[9];
  P.w_ukv = (const float*)d_in[10]; P.mla_out_norm = (const float*)d_in[11]; P.w_out = (const float*)d_in[12]; P.ffn_norm = (const float*)d_in[13];
  P.router_w = (const float*)d_in[14]; P.router_b = (const float*)d_in[15]; P.w_gu = (const float*)d_in[16]; P.b_gu = (const float*)d_in[17];
  P.w_dn = (const float*)d_in[18]; P.b_dn = (const float*)d_in[19]; P.final_norm = (const float*)d_in[20];
  P.out = (float*)d_out;

  char* w = (char*)d_ws; size_t off = 0;
  auto alloc = [&](size_t bytes) { void* q = w + off; off += (bytes + 255) & ~(size_t)255; return q; };
  P.bar = (unsigned*)alloc(16384);
  P.counts = (int*)alloc(256);
  P.h1 = (u16*)alloc((size_t)T_ * 2048 * 2);
  P.proj = (u16*)alloc((size_t)T_ * NC_ * 2);
  P.cs = (float2*)alloc((size_t)T_ * 32 * 8);
  P.rq = (float*)alloc((size_t)T_ * 4); P.rkv = (float*)alloc((size_t)T_ * 4);
  P.bcum = (float*)alloc((size_t)T_ * 512 * 4);
  P.q = (u16*)alloc((size_t)T_ * 1536 * 2);
  P.kv = (u16*)alloc((size_t)T_ * 2048 * 2);
  P.kpe = (u16*)alloc((size_t)T_ * 64 * 2);
  P.kvc = (u16*)alloc((size_t)512 * 32768 * 2);
  P.dec = (float*)alloc((size_t)512 * 128 * 4);
  P.sprev = (u16*)alloc((size_t)512 * 32768 * 2);
  P.mix = (u16*)alloc((size_t)T_ * 2048 * 2);
  P.omla = (u16*)alloc((size_t)T_ * 1024 * 2);
  P.x1 = (float*)alloc((size_t)T_ * 2048 * 4);
  P.h2 = (u16*)alloc((size_t)T_ * 2048 * 2);
  P.list = (int*)alloc((size_t)NE_ * T_ * 4);
  P.asg_e = (int*)alloc((size_t)T_ * 4 * 4); P.asg_slot = (int*)alloc((size_t)T_ * 4 * 4); P.asg_g = (float*)alloc((size_t)T_ * 4 * 4);
  const size_t PROWS = (size_t)T_ * 4 + NE_ * 256;
  P.act = (u16*)alloc(PROWS * 2048 * 2);
  P.ybuf = (u16*)alloc(PROWS * 2048 * 2);

  hipFuncSetAttribute((const void*)mega, hipFuncAttributeMaxDynamicSharedMemorySize, LDS_MAX);
  hipMemsetAsync(P.bar, 0, XCD_BAR_WORDS * sizeof(unsigned), stream);
  mega<<<256, 256, LDS_MAX, stream>>>(P);
}
```

```cpp
#define DUP 0
#define MOEQ 2
#define TSTAMP 0
#include <hip/hip_runtime.h>
#include <hip/hip_bf16.h>
#include <stdint.h>
#include <type_traits>
#define T_      8192
#define SEQ_    4096
#define D_      2048
#define NC_     4176
#define C_GQ    0
#define C_GK    512
#define C_GV    1024
#define C_GR    2048
#define C_GD    3072
#define C_MQ    3088
#define C_MKV   3600
#define C_MKR   4112
#define NE_     32
#define DFF_    2048
#define EPS_    1e-6f
typedef short bf16x8 __attribute__((ext_vector_type(8)));
typedef short s16x4 __attribute__((ext_vector_type(4)));
typedef float f32x16 __attribute__((ext_vector_type(16)));
typedef float f32x4 __attribute__((ext_vector_type(4)));
typedef float f32x2 __attribute__((ext_vector_type(2)));
typedef unsigned short u16;
typedef unsigned u32x4 __attribute__((ext_vector_type(4)));
typedef unsigned u32x2 __attribute__((ext_vector_type(2)));
#define LAS3 __attribute__((address_space(3)))
#define OPAQUE(x) asm volatile("" : "+v"(x))
#define NTHR 256
__device__ __forceinline__ int opaque_tid() { int t = threadIdx.x; asm volatile("" : "+v"(t)); return t; }

__device__ __forceinline__ unsigned pack_bf16(float a, float b) {
  typedef __bf16 bf2 __attribute__((ext_vector_type(2)));
  typedef float f2 __attribute__((ext_vector_type(2)));
  f2 v = {a, b};
  bf2 r = __builtin_convertvector(v, bf2);
  return *(unsigned*)&r;
}
__device__ __forceinline__ float bf_lo(unsigned w) { return __uint_as_float(w << 16); }
__device__ __forceinline__ float bf_hi(unsigned w) { return __uint_as_float(w & 0xffff0000u); }
__device__ __forceinline__ float bf16_to_f32(u16 v) { return __uint_as_float(((unsigned)v) << 16); }
__device__ __forceinline__ u16 f32_to_bf16(float f) { return (u16)(pack_bf16(f, 0.f) & 0xffffu); }
__device__ __forceinline__ float wave_sum(float v) {
#pragma unroll
  for (int o = 32; o > 0; o >>= 1) v += __shfl_xor(v, o);
  return v;
}
__device__ __forceinline__ unsigned off_b(unsigned row, unsigned ch) { return 256u * row + 16u * (ch ^ (((row & 3u) << 2) | ((row >> 2) & 3u))); }
__device__ __forceinline__ unsigned tr_addr(unsigned lane, unsigned c, unsigned row0  ) {
  const unsigned blk = (lane >> 4) & 1u, q = (lane & 15u) >> 2, p = lane & 3u;
  return off_b(row0 + q, 4u * c + 2u * blk + (p >> 1)) + 8u * (p & 1u);
}
__device__ __forceinline__ bf16x8 tr_frag(const char* img, unsigned lane, unsigned c, unsigned row_a, unsigned row_b) {
  s16x4 v0 = __builtin_amdgcn_ds_read_tr16_b64_v4i16((LAS3 s16x4*)(img + tr_addr(lane, c, row_a)));
  s16x4 v1 = __builtin_amdgcn_ds_read_tr16_b64_v4i16((LAS3 s16x4*)(img + tr_addr(lane, c, row_b)));
  return (bf16x8){v0[0], v0[1], v0[2], v0[3], v1[0], v1[1], v1[2], v1[3]};
}

__device__ __forceinline__ void glds16_asm(const void* gsrc, unsigned lds_dst) {
  unsigned keep;
  asm volatile("s_mov_b32 %0, m0\n\ts_mov_b32 m0, %2\n\ts_nop 0\n\tglobal_load_lds_dwordx4 %1, off\n\ts_mov_b32 m0, %0" : "=&s"(keep) : "v"(gsrc), "s"(lds_dst) : "memory");
}
struct Params {
  const float *x; const int* pos;
  const float *attn_norm, *w_in, *gate_up, *gate_bias, *gla_out_norm, *q_norm, *w_uq, *kv_norm, *w_ukv, *mla_out_norm, *w_out,
              *ffn_norm, *router_w, *router_b, *w_gu, *b_gu, *w_dn, *b_dn, *final_norm;
  float* out;
  char* ws;
  __device__ __forceinline__ unsigned* bar() const { return (unsigned*)(ws + 0ull); }
  __device__ __forceinline__ int* counts() const { return (int*)(ws + 16384ull); }
  __device__ __forceinline__ u16* h1() const { return (u16*)(ws + 16640ull); }
  __device__ __forceinline__ u16* proj() const { return (u16*)(ws + 33571072ull); }
  __device__ __forceinline__ float2* cs() const { return (float2*)(ws + 101990656ull); }
  __device__ __forceinline__ float* rq() const { return (float*)(ws + 104087808ull); }
  __device__ __forceinline__ float* rkv() const { return (float*)(ws + 104120576ull); }
  __device__ __forceinline__ float* bcum() const { return (float*)(ws + 104153344ull); }
  __device__ __forceinline__ u16* q() const { return (u16*)(ws + 120930560ull); }
  __device__ __forceinline__ u16* kv() const { return (u16*)(ws + 146096384ull); }
  __device__ __forceinline__ u16* kpe() const { return (u16*)(ws + 179650816ull); }
  __device__ __forceinline__ u16* kvc() const { return (u16*)(ws + 180699392ull); }
  __device__ __forceinline__ float* dec() const { return (float*)(ws + 214253824ull); }
  __device__ __forceinline__ u16* sprev() const { return (u16*)(ws + 214515968ull); }
  __device__ __forceinline__ u16* mix() const { return (u16*)(ws + 248070400ull); }
  __device__ __forceinline__ u16* omla() const { return (u16*)(ws + 281624832ull); }
  __device__ __forceinline__ float* x1() const { return (float*)(ws + 298402048ull); }
  __device__ __forceinline__ u16* h2() const { return (u16*)(ws + 365510912ull); }
  __device__ __forceinline__ int* list() const { return (int*)(ws + 399065344ull); }
  __device__ __forceinline__ int* asg_e() const { return (int*)(ws + 400113920ull); }
  __device__ __forceinline__ int* asg_slot() const { return (int*)(ws + 400244992ull); }
  __device__ __forceinline__ float* asg_g() const { return (float*)(ws + 400376064ull); }
  __device__ __forceinline__ u16* act() const { return (u16*)(ws + 400507136ull); }
  __device__ __forceinline__ u16* ybuf() const { return (u16*)(ws + 568279296ull); }
  __device__ __forceinline__ unsigned char* wq_gu() const { return (unsigned char*)(ws + 736051456ull); }
  __device__ __forceinline__ unsigned char* wq_dn() const { return (unsigned char*)(ws + 1004486912ull); }
  __device__ __forceinline__ unsigned char* h2q() const { return (unsigned char*)(ws + 1138704640ull); }
  __device__ __forceinline__ unsigned char* actq() const { return (unsigned char*)(ws + 1155481856ull); }
  __device__ __forceinline__ u16* wb_in() const { return (u16*)(ws + 1239367936ull); }
  __device__ __forceinline__ u16* wb_uq() const { return (u16*)(ws + 1257193728ull); }
  __device__ __forceinline__ u16* wb_ukv() const { return (u16*)(ws + 1258766592ull); }
  __device__ __forceinline__ u16* wb_out() const { return (u16*)(ws + 1260863744ull); }
};
#define WS_BYTES_USED 1269252352ull

#define XB_TMO      128
#define XB_XCNT(j)  (256  + 64 * (j))
#define XB_XSUB(j)  (1280 + 64 * (j))
#define XB_XGEN(j)  (2304 + 64 * (j))
#define XB_TOP      3328
#define XB_TOPGEN   3392
#define XCD_BAR_WORDS 3456
#define XB_SPIN_CAP (1u << 18)
#define LAS __attribute__((address_space(3)))

__device__ __forceinline__ unsigned xb_ld(unsigned* p)              { return __hip_atomic_load(p, __ATOMIC_RELAXED, __HIP_MEMORY_SCOPE_AGENT); }
__device__ __forceinline__ unsigned xb_add(unsigned* p, unsigned v) { return __hip_atomic_fetch_add(p, v, __ATOMIC_RELAXED, __HIP_MEMORY_SCOPE_AGENT); }
__device__ __forceinline__ unsigned xb_xcc_id() { return (unsigned)__builtin_amdgcn_s_getreg((3 << 11) | 20) & 0xFu; }
#define XB_SPIN(cond, bar) do { unsigned _sp = 0; while (cond) { __builtin_amdgcn_s_sleep(1); \
    if ((++_sp & 255u) == 0u) { if (xb_ld(&(bar)[XB_TMO])) break; if (_sp > XB_SPIN_CAP) { atomicAdd(&(bar)[XB_TMO], 1u); break; } } } } while (0)

struct XcdBarrier {
    unsigned* bar; unsigned x;
    volatile LAS unsigned* st;
};

__device__ __forceinline__ XcdBarrier xcd_barrier_post(unsigned* bar, volatile LAS unsigned* st) {
    XcdBarrier b; b.bar = bar; b.x = xb_xcc_id(); b.st = st;
    if (threadIdx.x == 0) (void)xb_add(&bar[XB_XCNT(b.x)], 1u);
    return b;
}
__device__ __forceinline__ void xcd_barrier_complete(unsigned* bar, unsigned x, unsigned& nloc, unsigned& nx) {
    const unsigned G = gridDim.x * gridDim.y * gridDim.z;
    unsigned sum, cnt, mine, sp = 0u;
    for (;;) {
        sum = 0u; cnt = 0u; mine = 0u;
#pragma unroll
        for (unsigned j = 0; j < 16; ++j) { const unsigned c = xb_ld(&bar[XB_XCNT(j)]); sum += c; cnt += (c > 0u) ? 1u : 0u; mine = (j == x) ? c : mine; }
        if (sum == G) break;
        __builtin_amdgcn_s_sleep(1);
        if ((++sp & 255u) == 0u) { if (xb_ld(&bar[XB_TMO])) break; if (sp > XB_SPIN_CAP) { atomicAdd(&bar[XB_TMO], 1u); break; } }
    }
    nloc = mine > 0u ? mine : 1u; nx = cnt > 0u ? cnt : 1u;
}

__device__ __forceinline__ void xcd_barrier(const XcdBarrier& b) {
    asm volatile("s_waitcnt vmcnt(0)" ::: "memory");
    __syncthreads();
    if (threadIdx.x == 0) {
        unsigned* bar = b.bar;
        __builtin_amdgcn_s_waitcnt(0);
        unsigned nloc = b.st[0], nx = b.st[1];
        if (nloc == 0u) { xcd_barrier_complete(bar, b.x, nloc, nx); b.st[0] = nloc; b.st[1] = nx; }
        const unsigned old = xb_add(&bar[XB_XSUB(b.x)], 1u);
        const unsigned gen = old / nloc;
        if (old + 1u == (gen + 1u) * nloc) {
            __builtin_amdgcn_fence(__ATOMIC_RELEASE, "agent");
            asm volatile("s_waitcnt vmcnt(0)" ::: "memory");
            const unsigned og = xb_add(&bar[XB_TOP], 1u);
            const unsigned tg = og / nx;
            if (og + 1u == (tg + 1u) * nx) xb_add(&bar[XB_TOPGEN], 1u);
            else XB_SPIN(xb_ld(&bar[XB_TOPGEN]) == tg, bar);
            __builtin_amdgcn_fence(__ATOMIC_ACQUIRE, "agent");
            xb_add(&bar[XB_XGEN(b.x)], 1u);
            asm volatile("s_waitcnt vmcnt(0)" ::: "memory");
        } else {
            XB_SPIN(xb_ld(&bar[XB_XGEN(b.x)]) == gen, bar);
            __builtin_amdgcn_fence(__ATOMIC_ACQUIRE, "agent");
            asm volatile("s_waitcnt vmcnt(0)" ::: "memory");
        }
    }
    __syncthreads();
}

#define G_A_OFF(s)  ((s) * 65536)
#define G_B_OFF(s)  ((s) * 65536 + 32768)
#define G_LDS_BYTES 131072

struct GemmTile {
  const u16* A; int lda;
  const int* aidx;
  int m0, mvalid;
  const float* B0; const float* B1;
  int ldb; int nv0, nv1;
  const float* kscale;
  int K;
};

template <int NB, bool KSCALE, bool GATHER>
__device__ __forceinline__ void gemm_tile_256(const GemmTile& t, char* smem, f32x16 (&acc)[4][4]) {
  int tz0 = threadIdx.x; asm volatile("" : "+v"(tz0));
  const int tid = tz0, lane = tid & 63, wid = tid >> 6, wr = wid >> 1, wc = wid & 1;
  const int l31 = lane & 31, hh = lane >> 5;
#pragma unroll
  for (int i = 0; i < 4; ++i)
#pragma unroll
    for (int j = 0; j < 4; ++j)
#pragma unroll
      for (int r = 0; r < 16; ++r) acc[i][j][r] = 0.f;

  const int a_c = (tid & 7) ^ ((tid >> 4) & 7);
  const u16* a_src[GATHER ? 8 : 1];
  if (GATHER) {
#pragma unroll
    for (int i = 0; i < (GATHER ? 8 : 1); ++i) {
      int r = (tid >> 3) + 32 * i;
      int rr = r < t.mvalid ? r : 0;
      a_src[i] = t.A + (long)t.aidx[rr] * t.lda + a_c * 8;
    }
  } else {
    a_src[0] = t.A + (long)(t.m0 + (tid >> 3)) * t.lda + a_c * 8;
  }
  const long a_step = 32L * t.lda;
  const int b_n4 = tid & 63, b_k = tid >> 6;
  const int b_k_u = __builtin_amdgcn_readfirstlane(b_k);
  const int b_img = b_n4 >> 5, b_ch = (b_n4 >> 1) & 15, b_half = b_n4 & 1;
  const bool b_ok = ((b_n4 & 31) * 4) < (b_img ? t.nv1 : t.nv0);
  const int b_loff = (b_ok ? ((b_img ? (int)(t.B1 - t.B0) : 0) + (b_n4 & 31) * 4) : 0) + b_k * t.ldb;
  f32x4 breg[16];

  const unsigned a_lds0 = (unsigned)(size_t)smem + (unsigned)__builtin_amdgcn_readfirstlane(wid) * 1024u;
  auto issue_a = [&](int kt, int s, int i) {
    glds16_asm((const void*)((GATHER ? a_src[GATHER ? i : 0] : a_src[0] + i * a_step) + kt * 64), a_lds0 + G_A_OFF(s) + i * 4096);
  };
  auto issue_b = [&](int kt, int j) {
    const float* ptr = t.B0 + (long)(kt * 64 + 4 * j) * t.ldb + b_loff;
    asm volatile("global_load_dwordx4 %0, %1, off" : "=v"(breg[j]) : "v"(ptr) : "memory");
  };
  auto write_b = [&](int kt, int s, int j) {
    const int k = b_k + 4 * j;
    f32x4 v = breg[j];
    if (KSCALE) { float sc = t.kscale[kt * 64 + b_k_u + 4 * j]; v *= sc; }
    if (!b_ok) v = (f32x4){0.f, 0.f, 0.f, 0.f};
    u32x2 w = {pack_bf16(v[0], v[1]), pack_bf16(v[2], v[3])};
    *(u32x2*)(smem + G_B_OFF(s) + b_img * 16384 + off_b(k, b_ch) + 8 * b_half) = w;
  };
#define WAITQ(N, g) asm volatile("s_waitcnt vmcnt(" #N ")" : "+v"(breg[4 * (g)]), "+v"(breg[4 * (g) + 1]), "+v"(breg[4 * (g) + 2]), "+v"(breg[4 * (g) + 3]) :: "memory")

  unsigned a_rd[4], b_rd[2][2];
#pragma unroll
  for (int ks = 0; ks < 4; ++ks) { const int row = wr * 128 + l31; a_rd[ks] = row * 128 + (((2 * ks + hh) ^ ((row >> 1) & 7)) * 16); }
#pragma unroll
  for (int tt = 0; tt < 2; ++tt)
#pragma unroll
    for (int nl = 0; nl < 2; ++nl) b_rd[tt][nl] = tr_addr(lane, wc * 2 + nl, 8 * hh + 4 * tt);
  auto load_a = [&](const char* As, int ks, bf16x8 (&af)[4]) {
#pragma unroll
    for (int mb = 0; mb < 4; ++mb) af[mb] = *(const bf16x8*)(As + a_rd[ks] + mb * 4096);
  };
  auto load_b1 = [&](const char* Bs, int ks, int nb, bf16x8& bfr) {
    const char* bi = Bs + (nb >> 1) * 16384 + ks * 4096;
    s16x4 v0 = __builtin_amdgcn_ds_read_tr16_b64_v4i16((LAS3 s16x4*)(bi + b_rd[0][nb & 1]));
    s16x4 v1 = __builtin_amdgcn_ds_read_tr16_b64_v4i16((LAS3 s16x4*)(bi + b_rd[1][nb & 1]));
    bfr = (bf16x8){v0[0], v0[1], v0[2], v0[3], v1[0], v1[1], v1[2], v1[3]};
  };

  auto kstep = [&](int kt, auto mode_tag, bool has1, bool has2) {
    constexpr int MODE = decltype(mode_tag)::value;
    const int s = kt & 1;
    const char* As = smem + G_A_OFF(s);
    const char* Bs = smem + G_B_OFF(s);
    bf16x8 a0[4], a1[4], bq[NB];
    load_a(As, 0, a0);
#pragma unroll
    for (int nb = 0; nb < NB; ++nb) load_b1(Bs, 0, nb, bq[nb]);
    __builtin_amdgcn_sched_barrier(0);
#pragma unroll
    for (int g = 0; g < 4; ++g) {
      bf16x8 (&ac)[4] = (g & 1) ? a1 : a0;
      bf16x8 (&an)[4] = (g & 1) ? a0 : a1;
      if (g < 3) load_a(As, g + 1, an);
      __builtin_amdgcn_sched_barrier(0);
#pragma unroll
      for (int nb = 0; nb < NB; ++nb) {
#pragma unroll
        for (int mb = 0; mb < 4; ++mb)
          acc[mb][nb] = __builtin_amdgcn_mfma_f32_32x32x16_bf16(ac[mb], bq[nb], acc[mb][nb], 0, 0, 0);
        __builtin_amdgcn_sched_barrier(0);
        if (g < 3) load_b1(Bs, g + 1, nb, bq[nb]);
        if (nb == 0 && g < 2 && has1) { issue_a(kt + 1, s ^ 1, 4 * g + 0); issue_a(kt + 1, s ^ 1, 4 * g + 1); }
        if (nb == 1 % NB && g < 2 && has1 && NB > 1) { issue_a(kt + 1, s ^ 1, 4 * g + 2); issue_a(kt + 1, s ^ 1, 4 * g + 3); }
        if (NB == 1 && nb == 0 && g < 2 && has1) { issue_a(kt + 1, s ^ 1, 4 * g + 2); issue_a(kt + 1, s ^ 1, 4 * g + 3); }
        if (nb == NB - 1 && has1) {
          if (MODE == 2) { if (g == 0) WAITQ(20, 0); else if (g == 1) WAITQ(20, 1); else if (g == 2) WAITQ(20, 2); else WAITQ(20, 3); }
          else if (MODE == 1) { if (g == 0) WAITQ(16, 0); else if (g == 1) WAITQ(20, 1); else if (g == 2) WAITQ(20, 2); else WAITQ(20, 3); }
          else { if (g == 0) WAITQ(0, 0); else if (g == 1) WAITQ(0, 1); else if (g == 2) WAITQ(0, 2); else WAITQ(0, 3); }
#pragma unroll
          for (int i = 0; i < 4; ++i) write_b(kt + 1, s ^ 1, 4 * g + i);
          if (has2) {
#pragma unroll
            for (int i = 0; i < 4; ++i) issue_b(kt + 2, 4 * g + i);
          }
        }
        __builtin_amdgcn_sched_barrier(0);
      }
    }
    if (has1) {
      if (MODE == 0) asm volatile("s_waitcnt vmcnt(0)" ::: "memory");
      else asm volatile("s_waitcnt vmcnt(12)" ::: "memory");
      __syncthreads();
    }
  };

  const int nk = t.K >> 6;
  __syncthreads();
#pragma unroll
  for (int j = 0; j < 16; ++j) issue_b(0, j);
#pragma unroll
  for (int i = 0; i < 8; ++i) issue_a(0, 0, i);
  WAITQ(8, 0); WAITQ(8, 1); WAITQ(8, 2); WAITQ(8, 3);
#pragma unroll
  for (int j = 0; j < 16; ++j) write_b(0, 0, j);
#pragma unroll
  for (int j = 0; j < 16; ++j) issue_b(1, j);
  asm volatile("s_waitcnt vmcnt(16)" ::: "memory");
  __syncthreads();
  kstep(0, std::integral_constant<int, 1>{}, true, true);
  for (int kt = 1; kt < nk - 2; ++kt) kstep(kt, std::integral_constant<int, 2>{}, true, true);
  kstep(nk - 2, std::integral_constant<int, 0>{}, true, false);
  kstep(nk - 1, std::integral_constant<int, 0>{}, false, false);
#undef WAITQ
}
template <int NB, class F>
__device__ __forceinline__ void acc_foreach_row(f32x16 (&acc)[4][4], F f) {
  int tz = threadIdx.x; asm volatile("" : "+v"(tz));
  const int lane = tz & 63, wid = tz >> 6, wr = wid >> 1, wc = wid & 1;
  const int l31 = lane & 31, hh = lane >> 5;
#pragma unroll
  for (int mb = 0; mb < 4; ++mb)
#pragma unroll
    for (int reg = 0; reg < 16; ++reg) {
      const int rowl = wr * 128 + mb * 32 + (reg & 3) + 8 * (reg >> 2) + 4 * hh;
      float v[NB];
#pragma unroll
      for (int nb = 0; nb < NB; ++nb) v[nb] = acc[mb][nb][reg];
      f(rowl, wc * 64 + l31, v);
      asm volatile("" ::: "memory");
    }
}
__device__ __forceinline__ void ph_prep0(const Params& p) {
  const int tid_ = opaque_tid(); const int lane = tid_ & 63, wid = tid_ >> 6;
  if (blockIdx.x == 0 && tid_ < 64) p.counts()[tid_] = 0;
  for (int t = blockIdx.x * 4 + wid; t < T_; t += gridDim.x * 4) {
    const float* xr = p.x + (long)t * 2048;
    f32x4 v[8]; float ss = 0.f;
#pragma unroll
    for (int j = 0; j < 8; ++j) { v[j] = *(const f32x4*)(xr + j * 256 + lane * 4); ss += v[j][0] * v[j][0] + v[j][1] * v[j][1] + v[j][2] * v[j][2] + v[j][3] * v[j][3]; }
    ss = wave_sum(ss);
    const float r = rsqrtf(ss * (1.0f / 2048.0f) + EPS_);
#pragma unroll
    for (int j = 0; j < 8; ++j) {
      f32x4 g = *(const f32x4*)(p.attn_norm + j * 256 + lane * 4);
      u32x2 w = {pack_bf16(v[j][0] * r * g[0], v[j][1] * r * g[1]), pack_bf16(v[j][2] * r * g[2], v[j][3] * r * g[3])};
      *(u32x2*)(p.h1() + (long)t * 2048 + j * 256 + lane * 4) = w;
    }
    if (lane < 32) {
      float inv = 1.0f / powf(10000.0f, (float)(2 * lane) / 64.0f);
      float ang = (float)p.pos[t] * inv;
      double a = (double)ang;
      double k = rint(a * 0.15915494309189535);
      float rf = (float)fma(-k, 6.283185307179586, a);
      p.cs()[t * 32 + lane] = make_float2(__cosf(rf), __sinf(rf));
    }
  }
}

template <int NB>
__device__ __forceinline__ void win_tile(const Params& p, char* smem, int mt, int nt) {
  f32x16 acc[4][4];
  GemmTile t{};
  t.A = p.h1(); t.lda = 2048; t.aidx = nullptr; t.m0 = mt * 256; t.mvalid = 256;
  t.B0 = p.w_in + nt * 256; t.B1 = t.B0 + 128; t.ldb = NC_;
  const int rem = NC_ - nt * 256;
  t.nv0 = rem >= 128 ? 128 : rem; t.nv1 = rem >= 256 ? 128 : (rem > 128 ? rem - 128 : 0);
  t.kscale = nullptr; t.K = 2048;
  gemm_tile_256<NB, false, false>(t, smem, acc);
  u16* base = p.proj() + (long)(mt * 256) * NC_ + nt * 256;
  const int nv0 = t.nv0, nv1 = t.nv1;
  acc_foreach_row<NB>(acc, [&](int rowl, int coll, float (&v)[NB]) {
    u16* rp = base + (long)rowl * NC_ + coll;
    OPAQUE(rp);
#pragma unroll
    for (int nb = 0; nb < NB; ++nb) {
      const int c = (nb & 1) * 32 + coll;
      const int lim = (nb >> 1) ? nv1 : nv0;
      if (c < lim) rp[(nb >> 1) * 128 + (nb & 1) * 32] = f32_to_bf16(v[nb]);
    }
  });
}
__device__ __forceinline__ void ph_win(const Params& p, char* smem) {
  const int x = blockIdx.x & 7, slot = blockIdx.x >> 3;
  for (int j = slot; j < 64; j += 32) win_tile<4>(p, smem, 4 * x + (j & 3), j >> 2);
  if (slot < 4) win_tile<2>(p, smem, 4 * x + slot, 16);
}

__device__ __forceinline__ void ph_prep1(const Params& p, char* smem) {
  float* gds = (float*)smem;
  float* cums = (float*)(smem + 4096);
  const int tid = opaque_tid(), lane = tid & 63, wid = tid >> 6;
  for (int u = blockIdx.x; u < 512; u += gridDim.x) {
    const int ch = u >> 2, h = u & 3; const int t0 = ch * 64;
    __syncthreads();
    {
      const int tl = tid >> 2, r4 = (tid & 3) * 4;
      u32x2 w = *(const u32x2*)(p.proj() + (long)(t0 + tl) * NC_ + C_GD + r4);
      gds[tl * 16 + r4 + 0] = bf_lo(w[0]); gds[tl * 16 + r4 + 1] = bf_hi(w[0]);
      gds[tl * 16 + r4 + 2] = bf_lo(w[1]); gds[tl * 16 + r4 + 3] = bf_hi(w[1]);
    }
    const int c = tid & 127, half = tid >> 7;
    float gu[16];
#pragma unroll
    for (int r = 0; r < 16; ++r) gu[r] = p.gate_up[r * 512 + h * 128 + c];
    const float bias = p.gate_bias[h * 128 + c];
    __syncthreads();
    float run = 0.f;
    for (int i = 0; i < 32; ++i) {
      const int tl = half * 32 + i;
      float z = bias;
#pragma unroll
      for (int r = 0; r < 16; ++r) z = fmaf(gds[tl * 16 + r], gu[r], z);
      const float ls = fminf(z, 0.f) - log1pf(__expf(-fabsf(z)));
      run += ls * (1.0f / 16.0f);
      cums[tl * 128 + c] = run;
    }
    __syncthreads();
    {
      const float add = cums[31 * 128 + c];
      for (int i = 0; i < 32; ++i) {
        const int tl = half * 32 + i;
        float v = cums[tl * 128 + c] + (half ? add : 0.f);
        p.bcum()[(long)(t0 + tl) * 512 + h * 128 + c] = v;
      }
    }
    for (int i = 0; i < 4; ++i) {
      const long t = t0 + h * 16 + wid * 4 + i;
      const u16* pr = p.proj() + t * NC_;
      u32x4 a = *(const u32x4*)(pr + C_MQ + lane * 8);
      u32x4 b = *(const u32x4*)(pr + C_MKV + lane * 8);
      float sa = 0.f, sb = 0.f;
#pragma unroll
      for (int k = 0; k < 4; ++k) { float l = bf_lo(a[k]), hgh = bf_hi(a[k]); sa += l * l + hgh * hgh; l = bf_lo(b[k]); hgh = bf_hi(b[k]); sb += l * l + hgh * hgh; }
      sa = wave_sum(sa); sb = wave_sum(sb);
      if (lane == 0) { p.rq()[t] = rsqrtf(sa * (1.0f / 512.0f) + EPS_); p.rkv()[t] = rsqrtf(sb * (1.0f / 512.0f) + EPS_); }
      if (lane < 32) {
        const float t1 = bf16_to_f32(pr[C_MKR + lane]), t2 = bf16_to_f32(pr[C_MKR + lane + 32]);
        const float2 cs = p.cs()[t * 32 + lane];
        p.kpe()[t * 64 + lane] = f32_to_bf16(t1 * cs.x - t2 * cs.y);
        p.kpe()[t * 64 + lane + 32] = f32_to_bf16(t1 * cs.y + t2 * cs.x);
      }
    }
  }
}

#define QSCALE_ (0.07216878364870322f * 1.4426950408889634f)
__device__ __forceinline__ void upq_tile(const Params& p, char* smem, int mt, int nt) {
  f32x16 acc[4][4];
  GemmTile t{};
  t.A = p.proj() + C_MQ; t.lda = NC_; t.aidx = nullptr; t.m0 = mt * 256; t.mvalid = 256;
  t.B0 = p.w_uq + nt * 256; t.B1 = t.B0 + 128; t.ldb = 1536; t.nv0 = 128; t.nv1 = 128; t.kscale = p.q_norm; t.K = 512;
  gemm_tile_256<4, true, false>(t, smem, acc);
  u16* base = p.q() + (long)(mt * 256) * 1536 + nt * 256;
  const float* rq = p.rq() + mt * 256;
  acc_foreach_row<4>(acc, [&](int rowl, int coll, float (&v)[4]) {
    u16* rp = base + (long)rowl * 1536 + coll;
    OPAQUE(rp);
    const float s = rq[rowl] * QSCALE_;
#pragma unroll
    for (int nb = 0; nb < 4; ++nb) rp[(nb >> 1) * 128 + (nb & 1) * 32] = f32_to_bf16(v[nb] * s);
  });
}
__device__ __forceinline__ void upkv_tile(const Params& p, char* smem, int mt, int nt) {
  f32x16 acc[4][4];
  GemmTile t{};
  t.A = p.proj() + C_MKV; t.lda = NC_; t.aidx = nullptr; t.m0 = mt * 256; t.mvalid = 256;
  t.B0 = p.w_ukv + nt * 256; t.B1 = t.B0 + 128; t.ldb = 2048; t.nv0 = 128; t.nv1 = 128; t.kscale = p.kv_norm; t.K = 512;
  gemm_tile_256<4, true, false>(t, smem, acc);
  u16* base = p.kv() + (long)(mt * 256) * 2048 + nt * 256;
  const float* rk = p.rkv() + mt * 256;
  acc_foreach_row<4>(acc, [&](int rowl, int coll, float (&v)[4]) {
    u16* rp = base + (long)rowl * 2048 + coll;
    OPAQUE(rp);
    const float s = rk[rowl];
#pragma unroll
    for (int nb = 0; nb < 4; ++nb) rp[(nb >> 1) * 128 + (nb & 1) * 32] = f32_to_bf16(v[nb] * s);
  });
}
#define AT_KSTRIDE 400
#define AT_KBYTES  (64 * AT_KSTRIDE)
#define AT_STAGE   (AT_KBYTES + 16384)
#define AT_LDS_BYTES (2 * AT_STAGE)

__device__ __forceinline__ void attn_unit(const Params& p, char* smem, int b, int h, int qb) {
  const int tid = opaque_tid(), lane = tid & 63, wid = tid >> 6, l31 = lane & 31, hh = lane >> 5;
  const long tq = (long)b * SEQ_ + qb * 128 + wid * 32 + l31;
  bf16x8 qf[12];
  {
    const u16* qp = p.q() + (tq * 8 + h) * 192 + 8 * hh;
#pragma unroll
    for (int ks = 0; ks < 12; ++ks) qf[ks] = *(const bf16x8*)(qp + 16 * ks);
#pragma unroll
    for (int s = 0; s < 2; ++s) {
      const float2* cp = p.cs() + tq * 32 + 16 * s + 8 * hh;
      bf16x8 lo = qf[8 + s], hi = qf[10 + s], nlo, nhi;
#pragma unroll
      for (int j = 0; j < 8; j += 2) {
        float2 c0 = cp[j], c1 = cp[j + 1];
        float a0 = bf16_to_f32((u16)lo[j]), a1 = bf16_to_f32((u16)lo[j + 1]);
        float b0 = bf16_to_f32((u16)hi[j]), b1 = bf16_to_f32((u16)hi[j + 1]);
        unsigned wl = pack_bf16(a0 * c0.x - b0 * c0.y, a1 * c1.x - b1 * c1.y);
        unsigned wh = pack_bf16(a0 * c0.y + b0 * c0.x, a1 * c1.y + b1 * c1.x);
        nlo[j] = (short)(wl & 0xffff); nlo[j + 1] = (short)(wl >> 16);
        nhi[j] = (short)(wh & 0xffff); nhi[j + 1] = (short)(wh >> 16);
      }
      qf[8 + s] = nlo; qf[10 + s] = nhi;
    }
  }
  int k_key[6], k_c[6];
#pragma unroll
  for (int i = 0; i < 6; ++i) { int pp = i * 256 + tid; k_key[i] = pp / 24; k_c[i] = pp % 24; }
  u32x4 kreg[6], vreg[4];
  const long tk0 = (long)b * SEQ_;
  auto load_tile = [&](int kt) {
#pragma unroll
    for (int i = 0; i < 6; ++i) {
      const long t = tk0 + kt * 64 + k_key[i];
      const u16* src = (k_c[i] < 16) ? (p.kv() + (t * 8 + h) * 256 + k_c[i] * 8) : (p.kpe() + t * 64 + (k_c[i] - 16) * 8);
      kreg[i] = *(const u32x4*)src;
    }
#pragma unroll
    for (int i = 0; i < 4; ++i) {
      const int pp = i * 256 + tid; const int key = pp >> 4, c = pp & 15;
      vreg[i] = *(const u32x4*)(p.kv() + ((tk0 + kt * 64 + key) * 8 + h) * 256 + 128 + c * 8);
    }
  };
  auto store_tile = [&](int s) {
    char* Ks = smem + s * AT_STAGE; char* Vs = Ks + AT_KBYTES;
#pragma unroll
    for (int i = 0; i < 6; ++i) *(u32x4*)(Ks + k_key[i] * AT_KSTRIDE + k_c[i] * 16) = kreg[i];
#pragma unroll
    for (int i = 0; i < 4; ++i) { const int pp = i * 256 + tid; *(u32x4*)(Vs + off_b(pp >> 4, pp & 15)) = vreg[i]; }
  };

  f32x16 o[4];
#pragma unroll
  for (int c = 0; c < 4; ++c)
#pragma unroll
    for (int r = 0; r < 16; ++r) o[c][r] = 0.f;
  float m = -1e30f, l = 0.f;
  const int nt = 2 * qb + 2;
  const int qpos = qb * 128 + wid * 32 + l31;

  __syncthreads();
  load_tile(0);
  store_tile(0);
  if (nt > 1) load_tile(1);
  __syncthreads();
  for (int kt = 0; kt < nt; ++kt) {
    const int s = kt & 1;
    const char* Ks = smem + s * AT_STAGE; const char* Vs = Ks + AT_KBYTES;
    const bool active = (kt * 64) <= (qb * 128 + wid * 32 + 31);
    if (active) {
      f32x16 sc[2];
#pragma unroll
      for (int kb = 0; kb < 2; ++kb) {
#pragma unroll
        for (int r = 0; r < 16; ++r) sc[kb][r] = 0.f;
#pragma unroll
        for (int ks = 0; ks < 12; ++ks) {
          bf16x8 a = *(const bf16x8*)(Ks + (kb * 32 + l31) * AT_KSTRIDE + (2 * ks + hh) * 16);
          sc[kb] = __builtin_amdgcn_mfma_f32_32x32x16_bf16(a, qf[ks], sc[kb], 0, 0, 0);
        }
      }
      if (kt >= 2 * qb) {
#pragma unroll
        for (int kb = 0; kb < 2; ++kb)
#pragma unroll
          for (int r = 0; r < 16; ++r) {
            const int key = kt * 64 + kb * 32 + (r & 3) + 8 * (r >> 2) + 4 * hh;
            if (key > qpos) sc[kb][r] = -1e30f;
          }
      }
      float mx = sc[0][0];
#pragma unroll
      for (int kb = 0; kb < 2; ++kb)
#pragma unroll
        for (int r = 0; r < 16; ++r) mx = fmaxf(mx, sc[kb][r]);
      mx = fmaxf(mx, __shfl_xor(mx, 32));
      const float mn = fmaxf(m, mx);
      const float alpha = exp2f(m - mn);
      m = mn;
      float ps = 0.f;
      bf16x8 pf[4];
#pragma unroll
      for (int kb = 0; kb < 2; ++kb)
#pragma unroll
        for (int s2 = 0; s2 < 2; ++s2) {
          float e[8];
#pragma unroll
          for (int j = 0; j < 8; ++j) { e[j] = exp2f(sc[kb][8 * s2 + j] - mn); ps += e[j]; }
          unsigned w0 = pack_bf16(e[0], e[1]), w1 = pack_bf16(e[2], e[3]), w2 = pack_bf16(e[4], e[5]), w3 = pack_bf16(e[6], e[7]);
          u32x4 w = {w0, w1, w2, w3};
          pf[kb * 2 + s2] = *(bf16x8*)&w;
        }
      l = l * alpha + ps;
#pragma unroll
      for (int c = 0; c < 4; ++c)
#pragma unroll
        for (int r = 0; r < 16; ++r) o[c][r] *= alpha;
#pragma unroll
      for (int c = 0; c < 4; ++c)
#pragma unroll
        for (int kk = 0; kk < 4; ++kk) {
          const unsigned rbase = 32 * (kk >> 1) + 16 * (kk & 1) + 4 * hh;
          bf16x8 a = tr_frag(Vs, lane, c, rbase, rbase + 8);
          o[c] = __builtin_amdgcn_mfma_f32_32x32x16_bf16(a, pf[kk], o[c], 0, 0, 0);
        }
    }
    if (kt + 1 < nt) {
      store_tile(s ^ 1);
      if (kt + 2 < nt) load_tile(kt + 2);
      __syncthreads();
    }
  }
  l = l + __shfl_xor(l, 32);
  const float inv = 1.0f / l;
  u16* op = p.omla() + tq * 1024 + h * 128 + 4 * hh;
#pragma unroll
  for (int c = 0; c < 4; ++c)
#pragma unroll
    for (int rg = 0; rg < 4; ++rg) {
      u32x2 w = {pack_bf16(o[c][4 * rg] * inv, o[c][4 * rg + 1] * inv), pack_bf16(o[c][4 * rg + 2] * inv, o[c][4 * rg + 3] * inv)};
      *(u32x2*)(op + 32 * c + 8 * rg) = w;
    }
}

#define G1_LDS_BYTES 49152
__device__ __forceinline__ void gla_g1_unit(const Params& p, char* smem, int u) {
  const int tid = opaque_tid(), lane = tid & 63, wid = tid >> 6, l31 = lane & 31, hh = lane >> 5;
  const int bh = u >> 6, n = u & 63, b = bh >> 2, h = bh & 3;
  const long t0 = (long)b * SEQ_ + n * 64;
  char* Ks = smem; char* Vs = smem + 16384;
  __syncthreads();
  {
    const int ch = tid & 15;
    const float* bl = p.bcum() + (t0 + 63) * 512 + h * 128 + ch * 8;
    f32x4 bl0 = *(const f32x4*)bl, bl1 = *(const f32x4*)(bl + 4);
    if (tid < 128) p.dec()[(long)u * 128 + tid] = __expf(p.bcum()[(t0 + 63) * 512 + h * 128 + tid]);
#pragma unroll
    for (int i = 0; i < 4; ++i) {
      const int tok = (i * 256 + tid) >> 4;
      u32x4 kw = *(const u32x4*)(p.proj() + (t0 + tok) * NC_ + C_GK + h * 128 + ch * 8);
      const float* bp = p.bcum() + (t0 + tok) * 512 + h * 128 + ch * 8;
      f32x4 b0 = *(const f32x4*)bp, b1 = *(const f32x4*)(bp + 4);
      u32x4 w;
      w[0] = pack_bf16(bf_lo(kw[0]) * __expf(bl0[0] - b0[0]), bf_hi(kw[0]) * __expf(bl0[1] - b0[1]));
      w[1] = pack_bf16(bf_lo(kw[1]) * __expf(bl0[2] - b0[2]), bf_hi(kw[1]) * __expf(bl0[3] - b0[3]));
      w[2] = pack_bf16(bf_lo(kw[2]) * __expf(bl1[0] - b1[0]), bf_hi(kw[2]) * __expf(bl1[1] - b1[1]));
      w[3] = pack_bf16(bf_lo(kw[3]) * __expf(bl1[2] - b1[2]), bf_hi(kw[3]) * __expf(bl1[3] - b1[3]));
      *(u32x4*)(Ks + off_b(tok, ch)) = w;
    }
#pragma unroll
    for (int i = 0; i < 8; ++i) {
      const int pp = i * 256 + tid; const int tok = pp >> 5, c32 = pp & 31;
      u32x4 vw = *(const u32x4*)(p.proj() + (t0 + tok) * NC_ + C_GV + h * 256 + c32 * 8);
      *(u32x4*)(Vs + (c32 >> 4) * 16384 + off_b(tok, c32 & 15)) = vw;
    }
  }
  __syncthreads();
  f32x16 acc[4][2];
#pragma unroll
  for (int mb = 0; mb < 4; ++mb)
#pragma unroll
    for (int nb = 0; nb < 2; ++nb)
#pragma unroll
      for (int r = 0; r < 16; ++r) acc[mb][nb][r] = 0.f;
  const char* Vimg = Vs + (wid >> 1) * 16384;
#pragma unroll
  for (int ks = 0; ks < 4; ++ks) {
    bf16x8 af[4], bfr[2];
    const unsigned r0 = 16 * ks + 8 * hh;
#pragma unroll
    for (int mb = 0; mb < 4; ++mb) af[mb] = tr_frag(Ks, lane, mb, r0, r0 + 4);
#pragma unroll
    for (int nb = 0; nb < 2; ++nb) bfr[nb] = tr_frag(Vimg, lane, 2 * (wid & 1) + nb, r0, r0 + 4);
#pragma unroll
    for (int mb = 0; mb < 4; ++mb)
#pragma unroll
      for (int nb = 0; nb < 2; ++nb) acc[mb][nb] = __builtin_amdgcn_mfma_f32_32x32x16_bf16(af[mb], bfr[nb], acc[mb][nb], 0, 0, 0);
  }
  u16* base = p.kvc() + (long)u * 32768 + wid * 64 + l31;
#pragma unroll
  for (int mb = 0; mb < 4; ++mb)
#pragma unroll
    for (int r = 0; r < 16; ++r) {
      const int dk = mb * 32 + (r & 3) + 8 * (r >> 2) + 4 * hh;
      u16* rp = base + dk * 256;
      rp[0] = f32_to_bf16(acc[mb][0][r]);
      rp[32] = f32_to_bf16(acc[mb][1][r]);
    }
}

__device__ __forceinline__ void gla_g2_unit(const Params& p, int u) {
  const int tid = opaque_tid();
  const int bh = u >> 5, part = u & 31;
  const int dk = part * 4 + (tid >> 6), dv = (tid & 63) * 4;
  float s0 = 0.f, s1 = 0.f, s2 = 0.f, s3 = 0.f;
  const long ebase = (long)dk * 256 + dv;
#pragma unroll 8
  for (int n = 0; n < 64; ++n) {
    const long un = (long)(bh * 64 + n);
    u32x2 kw = *(const u32x2*)(p.kvc() + un * 32768 + ebase);
    const float d = p.dec()[un * 128 + dk];
    u32x2 w = {pack_bf16(s0, s1), pack_bf16(s2, s3)};
    *(u32x2*)(p.sprev() + un * 32768 + ebase) = w;
    s0 = fmaf(d, s0, bf_lo(kw[0])); s1 = fmaf(d, s1, bf_hi(kw[0]));
    s2 = fmaf(d, s2, bf_lo(kw[1])); s3 = fmaf(d, s3, bf_hi(kw[1]));
  }
}

#define G3_LDS_BYTES (16384 + 16384 + 32768 + 65536 + 1024)
__device__ __forceinline__ void gla_g3_unit(const Params& p, char* smem, int u) {
  const int tid = opaque_tid(), lane = tid & 63, wid = tid >> 6, l31 = lane & 31, hh = lane >> 5;
  const int bh = u >> 6, n = u & 63, b = bh >> 2, h = bh & 3;
  const long t0 = (long)b * SEQ_ + n * 64;
  char* Qd = smem; char* Ki = smem + 16384; char* Vs = smem + 32768; char* Sp = smem + 65536; float* red = (float*)(smem + 131072);
  __syncthreads();
  {
    const int ch = tid & 15;
    const float qs = 0.08838834764831845f;
#pragma unroll
    for (int i = 0; i < 4; ++i) {
      const int tok = (i * 256 + tid) >> 4;
      const u16* pr = p.proj() + (t0 + tok) * NC_ + h * 128 + ch * 8;
      u32x4 qw = *(const u32x4*)(pr + C_GQ), kw = *(const u32x4*)(pr + C_GK);
      const float* bp = p.bcum() + (t0 + tok) * 512 + h * 128 + ch * 8;
      f32x4 b0 = *(const f32x4*)bp, b1 = *(const f32x4*)(bp + 4);
      float e[8] = {__expf(b0[0]), __expf(b0[1]), __expf(b0[2]), __expf(b0[3]), __expf(b1[0]), __expf(b1[1]), __expf(b1[2]), __expf(b1[3])};
      u32x4 wq, wk;
#pragma unroll
      for (int k = 0; k < 4; ++k) {
        wq[k] = pack_bf16(bf_lo(qw[k]) * qs * e[2 * k], bf_hi(qw[k]) * qs * e[2 * k + 1]);
        wk[k] = pack_bf16(bf_lo(kw[k]) / e[2 * k], bf_hi(kw[k]) / e[2 * k + 1]);
      }
      *(u32x4*)(Qd + off_b(tok, ch)) = wq;
      *(u32x4*)(Ki + off_b(tok, ch)) = wk;
    }
#pragma unroll
    for (int i = 0; i < 8; ++i) {
      const int pp = i * 256 + tid; const int tok = pp >> 5, c32 = pp & 31;
      u32x4 vw = *(const u32x4*)(p.proj() + (t0 + tok) * NC_ + C_GV + h * 256 + c32 * 8);
      *(u32x4*)(Vs + (c32 >> 4) * 16384 + off_b(tok, c32 & 15)) = vw;
    }
#pragma unroll
    for (int i = 0; i < 16; ++i) {
      const int pp = i * 256 + tid; const int dk = pp >> 5, c32 = pp & 31;
      u32x4 sw = *(const u32x4*)(p.sprev() + (long)u * 32768 + dk * 256 + c32 * 8);
      *(u32x4*)(Sp + (c32 >> 4) * 32768 + off_b(dk, c32 & 15)) = sw;
    }
  }
  __syncthreads();
  const int ib = wid & 1, dvh = wid >> 1;
  f32x16 sc[2];
#pragma unroll
  for (int jb = 0; jb < 2; ++jb) {
#pragma unroll
    for (int r = 0; r < 16; ++r) sc[jb][r] = 0.f;
    if (jb <= ib) {
#pragma unroll
      for (int ks = 0; ks < 8; ++ks) {
        bf16x8 a = *(const bf16x8*)(Ki + off_b(jb * 32 + l31, 2 * ks + hh));
        bf16x8 bq = *(const bf16x8*)(Qd + off_b(ib * 32 + l31, 2 * ks + hh));
        sc[jb] = __builtin_amdgcn_mfma_f32_32x32x16_bf16(a, bq, sc[jb], 0, 0, 0);
      }
#pragma unroll
      for (int r = 0; r < 16; ++r) {
        const int j = jb * 32 + (r & 3) + 8 * (r >> 2) + 4 * hh, i = ib * 32 + l31;
        if (j > i) sc[jb][r] = 0.f;
      }
    }
  }
  bf16x8 pf[4];
#pragma unroll
  for (int jb = 0; jb < 2; ++jb)
#pragma unroll
    for (int s2 = 0; s2 < 2; ++s2) {
      u32x4 w = {pack_bf16(sc[jb][8 * s2 + 0], sc[jb][8 * s2 + 1]), pack_bf16(sc[jb][8 * s2 + 2], sc[jb][8 * s2 + 3]),
                 pack_bf16(sc[jb][8 * s2 + 4], sc[jb][8 * s2 + 5]), pack_bf16(sc[jb][8 * s2 + 6], sc[jb][8 * s2 + 7])};
      pf[jb * 2 + s2] = *(bf16x8*)&w;
    }
  f32x16 o[4];
#pragma unroll
  for (int c = 0; c < 4; ++c)
#pragma unroll
    for (int r = 0; r < 16; ++r) o[c][r] = 0.f;
  const char* Vimg = Vs + dvh * 16384;
  const char* Simg = Sp + dvh * 32768;
#pragma unroll
  for (int c = 0; c < 4; ++c) {
#pragma unroll
    for (int kk = 0; kk < 4; ++kk) {
      if ((kk >> 1) <= ib) {
        const unsigned rbase = 32 * (kk >> 1) + 16 * (kk & 1) + 4 * hh;
        bf16x8 a = tr_frag(Vimg, lane, c, rbase, rbase + 8);
        o[c] = __builtin_amdgcn_mfma_f32_32x32x16_bf16(a, pf[kk], o[c], 0, 0, 0);
      }
    }
#pragma unroll
    for (int ks = 0; ks < 8; ++ks) {
      const unsigned r0 = 16 * ks + 8 * hh;
      bf16x8 a = tr_frag(Simg, lane, c, r0, r0 + 4);
      bf16x8 bq = *(const bf16x8*)(Qd + off_b(ib * 32 + l31, 2 * ks + hh));
      o[c] = __builtin_amdgcn_mfma_f32_32x32x16_bf16(a, bq, o[c], 0, 0, 0);
    }
  }
  float ss = 0.f;
#pragma unroll
  for (int c = 0; c < 4; ++c)
#pragma unroll
    for (int r = 0; r < 16; ++r) ss += o[c][r] * o[c][r];
  ss += __shfl_xor(ss, 32);
  if (hh == 0) red[dvh * 64 + ib * 32 + l31] = ss;
  __syncthreads();
  const float tot = red[ib * 32 + l31] + red[64 + ib * 32 + l31];
  const float rn = rsqrtf(tot * (1.0f / 256.0f) + EPS_);
  const long t = t0 + ib * 32 + l31;
  const u16* grp = p.proj() + t * NC_ + C_GR + h * 256 + dvh * 128 + 4 * hh;
  u16* op = p.mix() + t * 2048 + h * 256 + dvh * 128 + 4 * hh;
  const float* gp = p.gla_out_norm + dvh * 128 + 4 * hh;
#pragma unroll
  for (int c = 0; c < 4; ++c)
#pragma unroll
    for (int rg = 0; rg < 4; ++rg) {
      u32x2 gw = *(const u32x2*)(grp + 32 * c + 8 * rg);
      f32x4 g = *(const f32x4*)(gp + 32 * c + 8 * rg);
      float gr[4] = {bf_lo(gw[0]), bf_hi(gw[0]), bf_lo(gw[1]), bf_hi(gw[1])};
      float ov[4];
#pragma unroll
      for (int k = 0; k < 4; ++k) { float si = gr[k] / (1.0f + __expf(-gr[k])); ov[k] = o[c][4 * rg + k] * rn * g[k] * si; }
      u32x2 w = {pack_bf16(ov[0], ov[1]), pack_bf16(ov[2], ov[3])};
      *(u32x2*)(op + 32 * c + 8 * rg) = w;
    }
}

__device__ __forceinline__ void mla_norm_tokens(const Params& p) {
  const int tid_ = opaque_tid(); const int lane = tid_ & 63, wid = tid_ >> 6;
  for (int t = blockIdx.x * 4 + wid; t < T_; t += gridDim.x * 4) {
    const u16* src = p.omla() + (long)t * 1024;
    u32x4 a = *(const u32x4*)(src + lane * 8), b = *(const u32x4*)(src + 512 + lane * 8);
    float ss = 0.f;
#pragma unroll
    for (int k = 0; k < 4; ++k) { float x0 = bf_lo(a[k]), x1 = bf_hi(a[k]), y0 = bf_lo(b[k]), y1 = bf_hi(b[k]); ss += x0 * x0 + x1 * x1 + y0 * y0 + y1 * y1; }
    ss = wave_sum(ss);
    const float r = rsqrtf(ss * (1.0f / 1024.0f) + EPS_);
    const float* g = p.mla_out_norm;
    u32x4 wa, wb;
#pragma unroll
    for (int k = 0; k < 4; ++k) {
      wa[k] = pack_bf16(bf_lo(a[k]) * r * g[lane * 8 + 2 * k], bf_hi(a[k]) * r * g[lane * 8 + 2 * k + 1]);
      wb[k] = pack_bf16(bf_lo(b[k]) * r * g[512 + lane * 8 + 2 * k], bf_hi(b[k]) * r * g[512 + lane * 8 + 2 * k + 1]);
    }
    *(u32x4*)(p.mix() + (long)t * 2048 + 1024 + lane * 8) = wa;
    *(u32x4*)(p.mix() + (long)t * 2048 + 1024 + 512 + lane * 8) = wb;
  }
}
__device__ __forceinline__ void wout_tile(const Params& p, char* smem, int mt, int nt) {
  f32x16 acc[4][4];
  GemmTile t{};
  t.A = p.mix(); t.lda = 2048; t.aidx = nullptr; t.m0 = mt * 256; t.mvalid = 256;
  t.B0 = p.w_out + nt * 256; t.B1 = t.B0 + 128; t.ldb = 2048; t.nv0 = 128; t.nv1 = 128; t.kscale = nullptr; t.K = 2048;
  gemm_tile_256<4, false, false>(t, smem, acc);
  const long boff = (long)(mt * 256) * 2048 + nt * 256;
  acc_foreach_row<4>(acc, [&](int rowl, int coll, float (&v)[4]) {
    long o = boff + (long)rowl * 2048 + coll;
    OPAQUE(o);
    const float* xr = p.x + o; float* yr = p.x1() + o;
#pragma unroll
    for (int nb = 0; nb < 4; ++nb) { const int c = (nb >> 1) * 128 + (nb & 1) * 32; yr[c] = xr[c] + v[nb]; }
  });
}

#define P7_LDS_BYTES (4 * 32 * 33 * 4 + 4 * 64 * 4 + 32 * 33 * 4 + 128)
template <int DRY = 0>
__device__ __forceinline__ void ffn_prep_unit(const Params& p, char* smem, int u) {
  float* part = (float*)smem; float* ssq = part + 4 * 32 * 33; float* lg = ssq + 256; float* rs = lg + 32 * 33;
  const int tid = opaque_tid(), lane = tid & 63, wid = tid >> 6, l31 = lane & 31, hh = lane >> 5;
  __syncthreads();
  {
    const long t = (long)u * 32 + l31;
    const float* xr = p.x1() + t * 2048 + wid * 512;
    const float* gp = p.ffn_norm + wid * 512;
    const float* wp = p.router_w + (long)(wid * 512 + hh) * 32 + l31;
    f32x16 acc;
#pragma unroll
    for (int r = 0; r < 16; ++r) acc[r] = 0.f;
    float ss = 0.f;
#pragma unroll 4
    for (int m = 0; m < 128; ++m) {
      const f32x4 xv = *(const f32x4*)(xr + 4 * m);
      const f32x4 gv = *(const f32x4*)(gp + 4 * m);
      const float a0 = hh ? xv[1] : xv[0], a1 = hh ? xv[3] : xv[2];
      const float g0 = hh ? gv[1] : gv[0], g1 = hh ? gv[3] : gv[2];
      const float b0 = wp[(4 * m) * 32], b1 = wp[(4 * m + 2) * 32];
      ss += a0 * a0 + a1 * a1;
      acc = __builtin_amdgcn_mfma_f32_32x32x2f32(a0 * g0, b0, acc, 0, 0, 0);
      acc = __builtin_amdgcn_mfma_f32_32x32x2f32(a1 * g1, b1, acc, 0, 0, 0);
    }
#pragma unroll
    for (int r = 0; r < 16; ++r) part[(wid * 32 + (r & 3) + 8 * (r >> 2) + 4 * hh) * 33 + l31] = acc[r];
    ssq[wid * 64 + lane] = ss;
  }
  __syncthreads();
  {
    const int tl = tid >> 3, seg = tid & 7;
    if (seg == 0) {
      float s = 0.f;
#pragma unroll
      for (int w = 0; w < 4; ++w) s += ssq[w * 64 + tl] + ssq[w * 64 + 32 + tl];
      rs[tl] = rsqrtf(s * (1.0f / 2048.0f) + EPS_);
    }
  }
  __syncthreads();
  {
    const int tl = tid >> 3, seg = tid & 7;
    const float r = rs[tl];
#pragma unroll
    for (int c = 0; c < 4; ++c) {
      const int e = seg * 4 + c;
      const float s = part[(0 * 32 + tl) * 33 + e] + part[(1 * 32 + tl) * 33 + e] + part[(2 * 32 + tl) * 33 + e] + part[(3 * 32 + tl) * 33 + e];
      lg[tl * 33 + e] = s * r + p.router_b[e];
    }
  }
  __syncthreads();
  if (tid < 32 && !DRY) {
    const long tt = (long)u * 32 + tid;
    const float* L = lg + tid * 33;
    unsigned used = 0u; int i0 = 0, i1 = 0, i2 = 0, i3 = 0; float v0 = 0.f, v1 = 0.f, v2 = 0.f, v3 = 0.f;
#pragma unroll
    for (int k = 0; k < 4; ++k) {
      int bi = -1; float bv = 0.f;
      for (int i = 0; i < 32; ++i) {
        const float x = L[i];
        const bool take = !((used >> i) & 1u) && (bi < 0 || x > bv);
        bi = take ? i : bi; bv = take ? x : bv;
      }
      used |= 1u << bi;
      if (k == 0) { i0 = bi; v0 = bv; } else if (k == 1) { i1 = bi; v1 = bv; } else if (k == 2) { i2 = bi; v2 = bv; } else { i3 = bi; v3 = bv; }
    }
    const float e0 = 1.0f, e1 = __expf(v1 - v0), e2 = __expf(v2 - v0), e3 = __expf(v3 - v0);
    const float inv = 1.0f / (e0 + e1 + e2 + e3);
    const int s0 = atomicAdd(&p.counts()[i0], 1), s1 = atomicAdd(&p.counts()[i1], 1), s2 = atomicAdd(&p.counts()[i2], 1), s3 = atomicAdd(&p.counts()[i3], 1);
    p.list()[i0 * T_ + s0] = (int)tt; p.list()[i1 * T_ + s1] = (int)tt; p.list()[i2 * T_ + s2] = (int)tt; p.list()[i3 * T_ + s3] = (int)tt;
    p.asg_e()[tt * 4 + 0] = i0; p.asg_e()[tt * 4 + 1] = i1; p.asg_e()[tt * 4 + 2] = i2; p.asg_e()[tt * 4 + 3] = i3;
    p.asg_slot()[tt * 4 + 0] = s0; p.asg_slot()[tt * 4 + 1] = s1; p.asg_slot()[tt * 4 + 2] = s2; p.asg_slot()[tt * 4 + 3] = s3;
    p.asg_g()[tt * 4 + 0] = e0 * inv; p.asg_g()[tt * 4 + 1] = e1 * inv; p.asg_g()[tt * 4 + 2] = e2 * inv; p.asg_g()[tt * 4 + 3] = e3 * inv;
  }
  {
    const int tl = tid >> 3, seg = tid & 7;
    const long t = (long)u * 32 + tl;
    const float* xr = p.x1() + t * 2048;
    const float rr = rs[tl];
#pragma unroll 8
    for (int it = 0; it < 32; ++it) {
      const int kk = it * 64 + seg * 8;
      f32x4 v0 = *(const f32x4*)(xr + kk), v1 = *(const f32x4*)(xr + kk + 4);
      f32x4 g0 = *(const f32x4*)(p.ffn_norm + kk), g1 = *(const f32x4*)(p.ffn_norm + kk + 4);
      v0 = v0 * g0 * rr; v1 = v1 * g1 * rr;
#if MOEQ == 0
      u32x4 w = {pack_bf16(v0[0], v0[1]), pack_bf16(v0[2], v0[3]), pack_bf16(v1[0], v1[1]), pack_bf16(v1[2], v1[3])};
      *(u32x4*)(p.h2() + t * 2048 + kk) = w;
#else
      int q0 = 0, q1 = 0;
      q0 = __builtin_amdgcn_cvt_pk_fp8_f32(v0[0], v0[1], q0, false);
      q0 = __builtin_amdgcn_cvt_pk_fp8_f32(v0[2], v0[3], q0, true);
      q1 = __builtin_amdgcn_cvt_pk_fp8_f32(v1[0], v1[1], q1, false);
      q1 = __builtin_amdgcn_cvt_pk_fp8_f32(v1[2], v1[3], q1, true);
      u32x2 wq = {(unsigned)q0, (unsigned)q1};
      *(u32x2*)(p.h2q() + t * 2048 + kk) = wq;
#endif
    }
  }
}

__device__ __forceinline__ void moe_setup(const Params& p, int* mo) {
  __syncthreads();
  if (threadIdx.x == 0) {
    int s = 0;
    for (int e = 0; e < NE_; ++e) { mo[e] = s; s += (p.counts()[e] + 255) >> 8; }
    mo[NE_] = s;
  }
  __syncthreads();
}
#ifndef MAPV
#define MAPV 0
#endif
__device__ __forceinline__ int xcd_unit(int round) { return MAPV ? (round * 256 + blockIdx.x) : (round * 256 + (blockIdx.x & 7) * 32 + (blockIdx.x >> 3)); }

__device__ __forceinline__ void moe1_tile(const Params& p, char* smem, const int* mo, int e, int nt, int mt) {
  f32x16 acc[4][4];
  GemmTile t{};
  const int cnt = p.counts()[e];
  t.A = p.h2(); t.lda = 2048; t.aidx = p.list() + e * T_ + mt * 256; t.m0 = 0; t.mvalid = min(256, cnt - mt * 256);
  t.B0 = p.w_gu + (long)e * 2048 * 4096 + nt * 128; t.B1 = t.B0 + 2048; t.ldb = 4096; t.nv0 = 128; t.nv1 = 128; t.kscale = nullptr; t.K = 2048;
  gemm_tile_256<4, false, true>(t, smem, acc);
  u16* base = p.act() + (long)(mo[e] * 256 + mt * 256) * 2048 + nt * 128;
  const float* bg = p.b_gu + e * 4096 + nt * 128; const float* bu = bg + 2048;
  const int tq_ = opaque_tid(); const int cl = (tq_ >> 6 & 1) * 64 + (tq_ & 31);
  const float bgv[2] = {bg[cl], bg[cl + 32]}, buv[2] = {bu[cl], bu[cl + 32]};
  acc_foreach_row<4>(acc, [&](int rowl, int coll, float (&v)[4]) {
    u16* rp = base + (long)rowl * 2048 + coll;
    OPAQUE(rp);
#pragma unroll
    for (int nb = 0; nb < 2; ++nb) {
      const int c = nb * 32;
      float g = fminf(v[nb] + bgv[nb], 7.0f);
      float uu = fminf(fmaxf(v[nb + 2] + buv[nb], -7.0f), 7.0f);
      float a = (uu + 1.0f) * (g / (1.0f + __expf(-1.702f * g)));
      rp[c] = f32_to_bf16(a);
    }
  });
}
__device__ __forceinline__ void moe2_tile(const Params& p, char* smem, const int* mo, int e, int nt, int mt) {
  f32x16 acc[4][4];
  GemmTile t{};
  t.A = p.act(); t.lda = 2048; t.aidx = nullptr; t.m0 = mo[e] * 256 + mt * 256; t.mvalid = 256;
  t.B0 = p.w_dn + (long)e * 2048 * 2048 + nt * 256; t.B1 = t.B0 + 128; t.ldb = 2048; t.nv0 = 128; t.nv1 = 128; t.kscale = nullptr; t.K = 2048;
  gemm_tile_256<4, false, false>(t, smem, acc);
  u16* base = p.ybuf() + (long)t.m0 * 2048 + nt * 256;
  const float* bd = p.b_dn + e * 2048 + nt * 256;
  const int tq_ = opaque_tid(); const int cl = (tq_ >> 6 & 1) * 64 + (tq_ & 31);
  const float bdv[4] = {bd[cl], bd[cl + 32], bd[cl + 128], bd[cl + 160]};
  acc_foreach_row<4>(acc, [&](int rowl, int coll, float (&v)[4]) {
    u16* rp = base + (long)rowl * 2048 + coll;
    OPAQUE(rp);
#pragma unroll
    for (int nb = 0; nb < 4; ++nb) { const int c = (nb >> 1) * 128 + (nb & 1) * 32; rp[c] = f32_to_bf16(v[nb] + bdv[nb]); }
  });
}
template <int WHICH, int HALF = 0>
__device__ __forceinline__ void ph_moe(const Params& p, char* smem) {
  int* mo = (int*)(smem + G_LDS_BYTES);
  moe_setup(p, mo);
  const int NT = (WHICH == 1) ? 16 : 8;
  const int total = mo[NE_] * NT;
  if (HALF && ((blockIdx.x >> 3) & 1)) return;
  const int W = HALF ? 128 : 256;
  for (int round = 0;; ++round) {
    const int u = HALF ? (round * 128 + (blockIdx.x & 7) * 16 + (blockIdx.x >> 4)) : xcd_unit(round);
    if (round * W >= total) break;
    if (u >= total) continue;
    int e = 0;
    while (mo[e + 1] * NT <= u) ++e;
    const int local = u - mo[e] * NT, me = mo[e + 1] - mo[e];
    const int nt = local / me, mt = local - nt * me;
    if (WHICH == 1) moe1_tile(p, smem, mo, e, nt, mt); else moe2_tile(p, smem, mo, e, nt, mt);
  }
}

__device__ __forceinline__ void ph_final(const Params& p, char* smem, float dbg_scale = 1.0f) {
  int* mo = (int*)(smem + G_LDS_BYTES);
  moe_setup(p, mo);
  const int tid_ = opaque_tid(); const int lane = tid_ & 63, wid = tid_ >> 6;
  for (int t = blockIdx.x * 4 + wid; t < T_; t += gridDim.x * 4) {
    long rows[4]; float gg[4];
#pragma unroll
    for (int k = 0; k < 4; ++k) { rows[k] = (long)(mo[p.asg_e()[t * 4 + k]] * 256 + p.asg_slot()[t * 4 + k]) * 2048; gg[k] = p.asg_g()[t * 4 + k]; }
    f32x4 v[8]; float ss = 0.f;
#pragma unroll
    for (int j = 0; j < 8; ++j) {
      const int c = j * 256 + lane * 4;
      f32x4 a = *(const f32x4*)(p.x1() + (long)t * 2048 + c);
#pragma unroll
      for (int k = 0; k < 4; ++k) {
        u32x2 w = *(const u32x2*)(p.ybuf() + rows[k] + c);
        a[0] += gg[k] * bf_lo(w[0]); a[1] += gg[k] * bf_hi(w[0]); a[2] += gg[k] * bf_lo(w[1]); a[3] += gg[k] * bf_hi(w[1]);
      }
      v[j] = a; ss += a[0] * a[0] + a[1] * a[1] + a[2] * a[2] + a[3] * a[3];
    }
    ss = wave_sum(ss);
    const float r = rsqrtf(ss * (1.0f / 2048.0f) + EPS_);
#pragma unroll
    for (int j = 0; j < 8; ++j) {
      const int c = j * 256 + lane * 4;
      f32x4 g = *(const f32x4*)(p.final_norm + c);
      f32x4 o = {v[j][0] * r * g[0] * dbg_scale, v[j][1] * r * g[1] * dbg_scale, v[j][2] * r * g[2] * dbg_scale, v[j][3] * r * g[3] * dbg_scale};
      *(f32x4*)(p.out + (long)t * 2048 + c) = o;
    }
  }
}
#define WSCALE_  128.0f
#define WISCALE_ 0.0078125f
typedef unsigned char u8;

__device__ __forceinline__ void cvt8_tile(const float* W, int ldn, u8* out  , char* T) {
  const int tid = opaque_tid();
  const int kq = tid & 7, n4 = tid >> 3;
  f32x4 v[16];
  const float* src = W + (long)(kq * 16) * ldn + n4 * 4;
#pragma unroll
  for (int j = 0; j < 16; ++j) v[j] = *(const f32x4*)(src + (long)j * ldn);
  __syncthreads();
#pragma unroll
  for (int c = 0; c < 4; ++c) {
    u32x4 w;
#pragma unroll
    for (int q = 0; q < 4; ++q) {
      int x = 0;
      x = __builtin_amdgcn_cvt_pk_fp8_f32(v[4 * q][c] * WSCALE_, v[4 * q + 1][c] * WSCALE_, x, false);
      x = __builtin_amdgcn_cvt_pk_fp8_f32(v[4 * q + 2][c] * WSCALE_, v[4 * q + 3][c] * WSCALE_, x, true);
      w[q] = (unsigned)x;
    }
    *(u32x4*)(T + (n4 * 4 + c) * 128 + kq * 16) = w;
  }
  __syncthreads();
#pragma unroll
  for (int i = 0; i < 4; ++i) {
    const int n = (tid >> 3) + 32 * i, ch = tid & 7;
    *(u32x4*)(out + (long)n * 2048 + ch * 16) = *(const u32x4*)(T + n * 128 + ch * 16);
  }
}
__device__ __forceinline__ void ph_convert(const Params& p, char* smem) {
  for (int u = blockIdx.x; u < 24576; u += gridDim.x) {
    if (u < 16384) {
      const int e = u >> 9, kt = (u >> 5) & 15, nt = u & 31;
      cvt8_tile(p.w_gu + (long)e * 2048 * 4096 + (long)(kt * 128) * 4096 + nt * 128, 4096,
                p.wq_gu() + ((long)e * 4096 + nt * 128) * 2048 + kt * 128, smem);
    } else {
      const int v = u - 16384; const int e = v >> 8, kt = (v >> 4) & 15, nt = v & 15;
      cvt8_tile(p.w_dn + (long)e * 2048 * 2048 + (long)(kt * 128) * 2048 + nt * 128, 2048,
                p.wq_dn() + ((long)e * 2048 + nt * 128) * 2048 + kt * 128, smem);
    }
  }
}

#define R_STAGE 32768
struct GemmRTile {
  const u8* A; int lda; const int* aidx; int m0, mvalid;
  const u8* B; long brow0, brow1; int ldb;
  int KB;
};
template <bool FP8, bool GATHER>
__device__ __forceinline__ void gemmr_tile_256(const GemmRTile& t, char* smem, f32x16 (&acc)[4][4]) {
  int tz0 = threadIdx.x; asm volatile("" : "+v"(tz0));
  const int tid = tz0, lane = tid & 63, wid = tid >> 6, wr = wid >> 1, wc = wid & 1;
  const int l31 = lane & 31, hh = lane >> 5;
#pragma unroll
  for (int i = 0; i < 4; ++i)
#pragma unroll
    for (int j = 0; j < 4; ++j)
#pragma unroll
      for (int r = 0; r < 16; ++r) acc[i][j][r] = 0.f;
  const int c_src = (tid & 3) ^ ((tid >> 4) & 3);
  const u8* a_src[GATHER ? 4 : 1];
  if (GATHER) {
#pragma unroll
    for (int i = 0; i < (GATHER ? 4 : 1); ++i) {
      int r = (tid >> 2) + 64 * i;
      int rr = r < t.mvalid ? r : 0;
      a_src[i] = t.A + (long)t.aidx[rr] * t.lda + c_src * 16;
    }
  } else {
    a_src[0] = t.A + (long)(t.m0 + (tid >> 2)) * t.lda + c_src * 16;
  }
  const long a_step = 64L * t.lda, b_step = 64L * t.ldb;
  const u8* b_src0 = t.B + (t.brow0 + (tid >> 2)) * t.ldb + c_src * 16;
  const u8* b_src1 = t.B + (t.brow1 + (tid >> 2)) * t.ldb + c_src * 16;
  const unsigned lds0 = (unsigned)(size_t)smem + (unsigned)__builtin_amdgcn_readfirstlane(wid) * 1024u;
  auto issue = [&](int kt, int sl, int q) {
    if (q < 4) glds16_asm((const void*)((GATHER ? a_src[GATHER ? q : 0] : a_src[0] + q * a_step) + kt * 64), lds0 + sl * R_STAGE + q * 4096);
    else { const int i = q - 4; glds16_asm((const void*)((i < 2 ? b_src0 + i * b_step : b_src1 + (i - 2) * b_step) + kt * 64), lds0 + sl * R_STAGE + 16384 + i * 4096); }
  };
  unsigned a_rd[2], b_rd[2];
#pragma unroll
  for (int s2 = 0; s2 < 2; ++s2) {
    const int ra = wr * 128 + l31, rb = wc * 64 + l31;
    a_rd[s2] = ra * 64 + (((2 * s2 + hh) ^ ((ra >> 2) & 3)) * 16);
    b_rd[s2] = rb * 64 + (((2 * s2 + hh) ^ ((rb >> 2) & 3)) * 16);
  }
  auto load_frags = [&](const char* St, int s2, u32x4 (&af)[4], u32x4 (&bf)[4]) {
#pragma unroll
    for (int mb = 0; mb < 4; ++mb) af[mb] = *(const u32x4*)(St + a_rd[s2] + mb * 2048);
#pragma unroll
    for (int nb = 0; nb < 4; ++nb) bf[nb] = *(const u32x4*)(St + 16384 + b_rd[s2] + (nb >> 1) * 8192 + (nb & 1) * 2048);
  };
  auto mma = [&](u32x4 (&ac)[4], u32x4 (&bc)[4], int nb) {
    if (FP8) {
#pragma unroll
      for (int u = 0; u < 2; ++u) {
        const long bl = (long)(((unsigned long long)bc[nb][2 * u + 1] << 32) | bc[nb][2 * u]);
#pragma unroll
        for (int mb = 0; mb < 4; ++mb) {
          const long al = (long)(((unsigned long long)ac[mb][2 * u + 1] << 32) | ac[mb][2 * u]);
          acc[mb][nb] = __builtin_amdgcn_mfma_f32_32x32x16_fp8_fp8(al, bl, acc[mb][nb], 0, 0, 0);
        }
      }
    } else {
      const bf16x8 bb = *(const bf16x8*)&bc[nb];
#pragma unroll
      for (int mb = 0; mb < 4; ++mb) acc[mb][nb] = __builtin_amdgcn_mfma_f32_32x32x16_bf16(*(const bf16x8*)&ac[mb], bb, acc[mb][nb], 0, 0, 0);
    }
  };
  u32x4 a0[4], b0[4], a1[4], b1[4];
  auto half0 = [&](int kt, bool issueA) {
    const char* St = smem + (kt & 3) * R_STAGE;
    load_frags(St, 1, a1, b1);
    __builtin_amdgcn_sched_barrier(0);
#pragma unroll
    for (int nb = 0; nb < 4; ++nb) {
      mma(a0, b0, nb);
      __builtin_amdgcn_sched_barrier(0);
      if (issueA) issue(kt + 2, (kt + 2) & 3, 4 + nb);
      __builtin_amdgcn_sched_barrier(0);
    }
  };
  auto half1 = [&](int kt, bool has1, bool issueB) {
    const char* Sn = smem + ((kt + 1) & 3) * R_STAGE;
    if (has1) load_frags(Sn, 0, a0, b0);
    __builtin_amdgcn_sched_barrier(0);
#pragma unroll
    for (int nb = 0; nb < 4; ++nb) {
      mma(a1, b1, nb);
      __builtin_amdgcn_sched_barrier(0);
      if (issueB) issue(kt + 3, (kt + 3) & 3, nb);
      __builtin_amdgcn_sched_barrier(0);
    }
  };
  const int nk = t.KB >> 6;
  __syncthreads();
#pragma unroll
  for (int q = 0; q < 8; ++q) issue(0, 0, q);
#pragma unroll
  for (int q = 0; q < 8; ++q) issue(1, 1, q);
#pragma unroll
  for (int q = 0; q < 4; ++q) issue(2, 2, q);
  asm volatile("s_waitcnt vmcnt(12)" ::: "memory");
  __syncthreads();
  load_frags(smem, 0, a0, b0);
  for (int kt = 0; kt < nk - 3; ++kt) {
    half0(kt, true);
    asm volatile("s_waitcnt vmcnt(8)" ::: "memory");
    __syncthreads();
    half1(kt, true, true);
  }
  half0(nk - 3, true);
  asm volatile("s_waitcnt vmcnt(8)" ::: "memory");
  __syncthreads();
  half1(nk - 3, true, false);
  half0(nk - 2, false);
  asm volatile("s_waitcnt vmcnt(0)" ::: "memory");
  __syncthreads();
  half1(nk - 2, true, false);
  half0(nk - 1, false);
  half1(nk - 1, false, false);
}


typedef int i32x8 __attribute__((ext_vector_type(8)));
template <bool GATHER>
__device__ __forceinline__ void gemmrs_tile_256(const GemmRTile& t, char* smem, f32x16 (&acc)[4][4]) {
  int tz0 = threadIdx.x; asm volatile("" : "+v"(tz0));
  const int tid = tz0, lane = tid & 63, wid = tid >> 6, wr = wid >> 1, wc = wid & 1;
  const int l31 = lane & 31, hh = lane >> 5;
#pragma unroll
  for (int i = 0; i < 4; ++i)
#pragma unroll
    for (int j = 0; j < 4; ++j)
#pragma unroll
      for (int r = 0; r < 16; ++r) acc[i][j][r] = 0.f;
  const int c_src = (tid & 3) ^ ((tid >> 4) & 3);
  const u8* a_src[GATHER ? 4 : 1];
  if (GATHER) {
#pragma unroll
    for (int i = 0; i < (GATHER ? 4 : 1); ++i) {
      int r = (tid >> 2) + 64 * i;
      int rr = r < t.mvalid ? r : 0;
      a_src[i] = t.A + (long)t.aidx[rr] * t.lda + c_src * 16;
    }
  } else {
    a_src[0] = t.A + (long)(t.m0 + (tid >> 2)) * t.lda + c_src * 16;
  }
  const long a_step = 64L * t.lda, b_step = 64L * t.ldb;
  const u8* b_src0 = t.B + (t.brow0 + (tid >> 2)) * t.ldb + c_src * 16;
  const u8* b_src1 = t.B + (t.brow1 + (tid >> 2)) * t.ldb + c_src * 16;
  const unsigned lds0 = (unsigned)(size_t)smem + (unsigned)__builtin_amdgcn_readfirstlane(wid) * 1024u;
  auto issue = [&](int kt, int sl, int q) {
    if (q < 4) glds16_asm((const void*)((GATHER ? a_src[GATHER ? q : 0] : a_src[0] + q * a_step) + kt * 64), lds0 + sl * R_STAGE + q * 4096);
    else { const int i = q - 4; glds16_asm((const void*)((i < 2 ? b_src0 + i * b_step : b_src1 + (i - 2) * b_step) + kt * 64), lds0 + sl * R_STAGE + 16384 + i * 4096); }
  };
  unsigned a_rd[2], b_rd[2];
#pragma unroll
  for (int c = 0; c < 2; ++c) {
    const int ra = wr * 128 + l31, rb = wc * 64 + l31;
    a_rd[c] = ra * 64 + (((2 * hh + c) ^ ((ra >> 2) & 3)) * 16);
    b_rd[c] = rb * 64 + (((2 * hh + c) ^ ((rb >> 2) & 3)) * 16);
  }
  auto load_a = [&](const char* St, i32x8 (&af)[4]) {
#pragma unroll
    for (int mb = 0; mb < 4; ++mb) {
      const u32x4 lo = *(const u32x4*)(St + a_rd[0] + mb * 2048), hi = *(const u32x4*)(St + a_rd[1] + mb * 2048);
      af[mb] = (i32x8){(int)lo[0], (int)lo[1], (int)lo[2], (int)lo[3], (int)hi[0], (int)hi[1], (int)hi[2], (int)hi[3]};
    }
  };
  auto load_b = [&](const char* St, int nb, i32x8& bf) {
    const char* bp = St + 16384 + (nb >> 1) * 8192 + (nb & 1) * 2048;
    const u32x4 lo = *(const u32x4*)(bp + b_rd[0]), hi = *(const u32x4*)(bp + b_rd[1]);
    bf = (i32x8){(int)lo[0], (int)lo[1], (int)lo[2], (int)lo[3], (int)hi[0], (int)hi[1], (int)hi[2], (int)hi[3]};
  };
  auto mma4 = [&](i32x8 (&af)[4], i32x8& bf, int nb) {
#pragma unroll
    for (int mb = 0; mb < 4; ++mb)
      acc[mb][nb] = __builtin_amdgcn_mfma_scale_f32_32x32x64_f8f6f4(af[mb], bf, acc[mb][nb], 0, 0, 0, 0x7f7f7f7f, 0, 0x7f7f7f7f);
  };
  i32x8 aA[4], aB[4], bq[4];
  auto half0 = [&](int kt, i32x8 (&ac)[4], bool issueA) {
    const char* St = smem + (kt & 3) * R_STAGE;
    load_b(St, 2, bq[2]); load_b(St, 3, bq[3]);
    __builtin_amdgcn_sched_barrier(0);
#pragma unroll
    for (int nb = 0; nb < 2; ++nb) {
      mma4(ac, bq[nb], nb);
      __builtin_amdgcn_sched_barrier(0);
      if (issueA) { issue(kt + 2, (kt + 2) & 3, 4 + 2 * nb); issue(kt + 2, (kt + 2) & 3, 5 + 2 * nb); }
      __builtin_amdgcn_sched_barrier(0);
    }
  };
  auto half1 = [&](int kt, i32x8 (&ac)[4], i32x8 (&an)[4], bool has1, bool issueB) {
    const char* Sn = smem + ((kt + 1) & 3) * R_STAGE;
    if (has1) { load_a(Sn, an); load_b(Sn, 0, bq[0]); load_b(Sn, 1, bq[1]); }
    __builtin_amdgcn_sched_barrier(0);
#pragma unroll
    for (int nb = 2; nb < 4; ++nb) {
      mma4(ac, bq[nb], nb);
      __builtin_amdgcn_sched_barrier(0);
      if (issueB) { issue(kt + 3, (kt + 3) & 3, 2 * (nb - 2)); issue(kt + 3, (kt + 3) & 3, 2 * (nb - 2) + 1); }
      __builtin_amdgcn_sched_barrier(0);
    }
  };
  const int nk = t.KB >> 6;
  __syncthreads();
#pragma unroll
  for (int q = 0; q < 8; ++q) issue(0, 0, q);
#pragma unroll
  for (int q = 0; q < 8; ++q) issue(1, 1, q);
#pragma unroll
  for (int q = 0; q < 4; ++q) issue(2, 2, q);
  asm volatile("s_waitcnt vmcnt(12)" ::: "memory");
  __syncthreads();
  load_a(smem, aA); load_b(smem, 0, bq[0]); load_b(smem, 1, bq[1]);
  for (int kt = 0; kt < nk - 4; kt += 2) {
    half0(kt, aA, true);
    asm volatile("s_waitcnt vmcnt(8)" ::: "memory"); __syncthreads();
    half1(kt, aA, aB, true, true);
    half0(kt + 1, aB, true);
    asm volatile("s_waitcnt vmcnt(8)" ::: "memory"); __syncthreads();
    half1(kt + 1, aB, aA, true, true);
  }
  half0(nk - 4, aA, true);
  asm volatile("s_waitcnt vmcnt(8)" ::: "memory"); __syncthreads();
  half1(nk - 4, aA, aB, true, true);
  half0(nk - 3, aB, true);
  asm volatile("s_waitcnt vmcnt(8)" ::: "memory"); __syncthreads();
  half1(nk - 3, aB, aA, true, false);
  half0(nk - 2, aA, false);
  asm volatile("s_waitcnt vmcnt(0)" ::: "memory"); __syncthreads();
  half1(nk - 2, aA, aB, true, false);
  half0(nk - 1, aB, false);
  half1(nk - 1, aB, aA, false, false);
}

__device__ __forceinline__ void cvt16_tile(const float* W, int col0, int ldn, int nvalid  , const float* kgain,
                                           u16* out  , int ldk, char* T) {
  const int tid = opaque_tid();
  const int kq = tid & 7, n4 = tid >> 3;
  f32x4 v[16];
  const bool ok = (n4 * 4) < nvalid;
  const float* src = W + (long)(kq * 16) * ldn + (ok ? n4 * 4 : -col0);
#pragma unroll
  for (int j = 0; j < 16; ++j) v[j] = *(const f32x4*)(src + (long)j * ldn);
  if (kgain) {
#pragma unroll
    for (int j = 0; j < 16; ++j) v[j] *= kgain[kq * 16 + j];
  }
  if (!ok) {
#pragma unroll
    for (int j = 0; j < 16; ++j) v[j] = (f32x4){0.f, 0.f, 0.f, 0.f};
  }
  __syncthreads();
#pragma unroll
  for (int c = 0; c < 4; ++c) {
    u32x4 w0, w1;
#pragma unroll
    for (int q = 0; q < 4; ++q) { w0[q] = pack_bf16(v[2 * q][c], v[2 * q + 1][c]); w1[q] = pack_bf16(v[8 + 2 * q][c], v[8 + 2 * q + 1][c]); }
    *(u32x4*)(T + (n4 * 4 + c) * 256 + kq * 32) = w0;
    *(u32x4*)(T + (n4 * 4 + c) * 256 + kq * 32 + 16) = w1;
  }
  __syncthreads();
#pragma unroll
  for (int i = 0; i < 8; ++i) {
    const int n = (tid >> 4) + 16 * i, ch = tid & 15;
    *(u32x4*)((char*)(out + (long)n * ldk) + ch * 16) = *(const u32x4*)(T + n * 256 + ch * 16);
  }
}
__device__ __forceinline__ void ph_convert_dense(const Params& p, char* smem) {
  for (int u = blockIdx.x; u < 912; u += gridDim.x) {
    if (u < 544) { const int kt = u / 34, nt = u % 34; const int nv = NC_ - nt * 128;
      cvt16_tile(p.w_in + (long)(kt * 128) * NC_ + nt * 128, nt * 128, NC_, nv < 0 ? 0 : nv, nullptr, p.wb_in() + (long)(nt * 128) * 2048 + kt * 128, 2048, smem);
    } else if (u < 592) { const int v = u - 544; const int kt = v / 12, nt = v % 12;
      cvt16_tile(p.w_uq + (long)(kt * 128) * 1536 + nt * 128, nt * 128, 1536, 128, p.q_norm + kt * 128, p.wb_uq() + (long)(nt * 128) * 512 + kt * 128, 512, smem);
    } else if (u < 656) { const int v = u - 592; const int kt = v >> 4, nt = v & 15;
      cvt16_tile(p.w_ukv + (long)(kt * 128) * 2048 + nt * 128, nt * 128, 2048, 128, p.kv_norm + kt * 128, p.wb_ukv() + (long)(nt * 128) * 512 + kt * 128, 512, smem);
    } else { const int v = u - 656; const int kt = v >> 4, nt = v & 15;
      cvt16_tile(p.w_out + (long)(kt * 128) * 2048 + nt * 128, nt * 128, 2048, 128, nullptr, p.wb_out() + (long)(nt * 128) * 2048 + kt * 128, 2048, smem);
    }
  }
}

template <int NBV>
__device__ __forceinline__ void win_tile_r(const Params& p, char* smem, int mt, int nt) {
  f32x16 acc[4][4];
  GemmRTile t{};
  t.A = (const u8*)p.h1(); t.lda = 4096; t.aidx = nullptr; t.m0 = mt * 256; t.mvalid = 256;
  t.B = (const u8*)p.wb_in(); t.brow0 = nt * 256; t.brow1 = nt * 256 + 128; t.ldb = 4096; t.KB = 4096;
  gemmr_tile_256<false, false>(t, smem, acc);
  const int rem = NC_ - nt * 256;
  const int nv0 = rem >= 128 ? 128 : rem, nv1 = rem >= 256 ? 128 : (rem > 128 ? rem - 128 : 0);
  u16* base = p.proj() + (long)(mt * 256) * NC_ + nt * 256;
  acc_foreach_row<4>(acc, [&](int rowl, int coll, float (&v)[4]) {
    u16* rp = base + (long)rowl * NC_ + coll;
    OPAQUE(rp);
#pragma unroll
    for (int nb = 0; nb < 4; ++nb) {
      const int c = (nb & 1) * 32 + coll;
      const int lim = (nb >> 1) ? nv1 : nv0;
      if (c < lim) rp[(nb >> 1) * 128 + (nb & 1) * 32] = f32_to_bf16(v[nb]);
    }
  });
}
__device__ __forceinline__ void ph_win_r(const Params& p, char* smem) {
  const int x = blockIdx.x & 7, slot = blockIdx.x >> 3;
  for (int j = slot; j < 68; j += 32) win_tile_r<4>(p, smem, 4 * x + (j & 3), j >> 2);
}
__device__ __forceinline__ void upq_tile_r(const Params& p, char* smem, int mt, int nt) {
  f32x16 acc[4][4];
  GemmRTile t{};
  t.A = (const u8*)(p.proj() + C_MQ); t.lda = NC_ * 2; t.aidx = nullptr; t.m0 = mt * 256; t.mvalid = 256;
  t.B = (const u8*)p.wb_uq(); t.brow0 = nt * 256; t.brow1 = nt * 256 + 128; t.ldb = 1024; t.KB = 1024;
  gemmr_tile_256<false, false>(t, smem, acc);
  u16* base = p.q() + (long)(mt * 256) * 1536 + nt * 256;
  const float* rq = p.rq() + mt * 256;
  acc_foreach_row<4>(acc, [&](int rowl, int coll, float (&v)[4]) {
    u16* rp = base + (long)rowl * 1536 + coll;
    OPAQUE(rp);
    const float s = rq[rowl] * QSCALE_;
#pragma unroll
    for (int nb = 0; nb < 4; ++nb) rp[(nb >> 1) * 128 + (nb & 1) * 32] = f32_to_bf16(v[nb] * s);
  });
}
__device__ __forceinline__ void upkv_tile_r(const Params& p, char* smem, int mt, int nt) {
  f32x16 acc[4][4];
  GemmRTile t{};
  t.A = (const u8*)(p.proj() + C_MKV); t.lda = NC_ * 2; t.aidx = nullptr; t.m0 = mt * 256; t.mvalid = 256;
  t.B = (const u8*)p.wb_ukv(); t.brow0 = nt * 256; t.brow1 = nt * 256 + 128; t.ldb = 1024; t.KB = 1024;
  gemmr_tile_256<false, false>(t, smem, acc);
  u16* base = p.kv() + (long)(mt * 256) * 2048 + nt * 256;
  const float* rk = p.rkv() + mt * 256;
  acc_foreach_row<4>(acc, [&](int rowl, int coll, float (&v)[4]) {
    u16* rp = base + (long)rowl * 2048 + coll;
    OPAQUE(rp);
    const float s = rk[rowl];
#pragma unroll
    for (int nb = 0; nb < 4; ++nb) rp[(nb >> 1) * 128 + (nb & 1) * 32] = f32_to_bf16(v[nb] * s);
  });
}
__device__ __forceinline__ void wout_tile_r(const Params& p, char* smem, int mt, int nt) {
  f32x16 acc[4][4];
  GemmRTile t{};
  t.A = (const u8*)p.mix(); t.lda = 4096; t.aidx = nullptr; t.m0 = mt * 256; t.mvalid = 256;
  t.B = (const u8*)p.wb_out(); t.brow0 = nt * 256; t.brow1 = nt * 256 + 128; t.ldb = 4096; t.KB = 4096;
  gemmr_tile_256<false, false>(t, smem, acc);
  const long boff = (long)(mt * 256) * 2048 + nt * 256;
  acc_foreach_row<4>(acc, [&](int rowl, int coll, float (&v)[4]) {
    long o = boff + (long)rowl * 2048 + coll;
    OPAQUE(o);
    const float* xr = p.x + o; float* yr = p.x1() + o;
#pragma unroll
    for (int nb = 0; nb < 4; ++nb) { const int c = (nb >> 1) * 128 + (nb & 1) * 32; yr[c] = xr[c] + v[nb]; }
  });
}

__device__ __forceinline__ void moe1q_tile(const Params& p, char* smem, const int* mo, int e, int nt, int mt) {
  f32x16 acc[4][4];
  GemmRTile t{};
  const int cnt = p.counts()[e];
  t.A = p.h2q(); t.lda = 2048; t.aidx = p.list() + e * T_ + mt * 256; t.m0 = 0; t.mvalid = min(256, cnt - mt * 256);
  t.B = p.wq_gu(); t.brow0 = (long)e * 4096 + nt * 128; t.brow1 = t.brow0 + 2048; t.ldb = 2048; t.KB = 2048;
#if MOEQ == 2
  gemmrs_tile_256<true>(t, smem, acc);
#else
  gemmr_tile_256<true, true>(t, smem, acc);
#endif
  u8* base = p.actq() + (long)(mo[e] * 256 + mt * 256) * 2048 + nt * 128;
  const float* bg = p.b_gu + e * 4096 + nt * 128; const float* bu = bg + 2048;
  const int tq_ = opaque_tid(); const int cl = (tq_ >> 6 & 1) * 64 + (tq_ & 31);
  const float bgv[2] = {bg[cl], bg[cl + 32]}, buv[2] = {bu[cl], bu[cl + 32]};
  acc_foreach_row<4>(acc, [&](int rowl, int coll, float (&v)[4]) {
    u8* rp = base + (long)rowl * 2048 + coll;
    OPAQUE(rp);
#pragma unroll
    for (int nb = 0; nb < 2; ++nb) {
      float g = fminf(v[nb] * WISCALE_ + bgv[nb], 7.0f);
      float uu = fminf(fmaxf(v[nb + 2] * WISCALE_ + buv[nb], -7.0f), 7.0f);
      float a = (uu + 1.0f) * (g / (1.0f + __expf(-1.702f * g)));
      rp[nb * 32] = (u8)(__builtin_amdgcn_cvt_pk_fp8_f32(a, a, 0, false) & 0xff);
    }
  });
}
__device__ __forceinline__ void moe2q_tile(const Params& p, char* smem, const int* mo, int e, int nt, int mt) {
  f32x16 acc[4][4];
  GemmRTile t{};
  t.A = p.actq(); t.lda = 2048; t.aidx = nullptr; t.m0 = mo[e] * 256 + mt * 256; t.mvalid = 256;
  t.B = p.wq_dn(); t.brow0 = (long)e * 2048 + nt * 256; t.brow1 = t.brow0 + 128; t.ldb = 2048; t.KB = 2048;
#if MOEQ == 2
  gemmrs_tile_256<false>(t, smem, acc);
#else
  gemmr_tile_256<true, false>(t, smem, acc);
#endif
  u16* base = p.ybuf() + (long)t.m0 * 2048 + nt * 256;
  const float* bd = p.b_dn + e * 2048 + nt * 256;
  const int tq_ = opaque_tid(); const int cl = (tq_ >> 6 & 1) * 64 + (tq_ & 31);
  const float bdv[4] = {bd[cl], bd[cl + 32], bd[cl + 128], bd[cl + 160]};
  acc_foreach_row<4>(acc, [&](int rowl, int coll, float (&v)[4]) {
    u16* rp = base + (long)rowl * 2048 + coll;
    OPAQUE(rp);
#pragma unroll
    for (int nb = 0; nb < 4; ++nb) { const int c = (nb >> 1) * 128 + (nb & 1) * 32; rp[c] = f32_to_bf16(v[nb] * WISCALE_ + bdv[nb]); }
  });
}
template <int WHICH>
__device__ __forceinline__ void ph_moeq(const Params& p, char* smem) {
  int* mo = (int*)(smem + G_LDS_BYTES);
  moe_setup(p, mo);
  const int NT = (WHICH == 1) ? 16 : 8;
  const int total = mo[NE_] * NT;
  for (int round = 0;; ++round) {
    const int u = xcd_unit(round);
    if (round * 256 >= total) break;
    if (u >= total) continue;
    int e = 0;
    while (mo[e + 1] * NT <= u) ++e;
    const int local = u - mo[e] * NT, me = mo[e + 1] - mo[e];
    const int nt = local / me, mt = local - nt * me;
    if (WHICH == 1) moe1q_tile(p, smem, mo, e, nt, mt); else moe2q_tile(p, smem, mo, e, nt, mt);
  }
}
#define LDS_MAX 143360
#ifndef DUP
#define DUP 0
#endif
#ifndef MOEQ
#define MOEQ 1
#endif
#ifndef TSTAMP
#define TSTAMP 0
#endif
#ifndef DENSER
#define DENSER 1
#endif
__global__ void __launch_bounds__(256, 1) mega(Params p) {
  extern __shared__ __attribute__((aligned(16))) char smem[];
  volatile LAS unsigned* xbw = (volatile LAS unsigned*)(smem + LDS_MAX - 16);
  if (threadIdx.x == 0) { xbw[0] = 0u; xbw[1] = 0u; xbw[2] = 0u; xbw[3] = 0u; }
  __syncthreads();
  XcdBarrier bar = xcd_barrier_post(p.bar(), xbw);
#if TSTAMP
  unsigned long long ts0 = wall_clock64();
  int bar_no = 0;
#define XBAR() do { xcd_barrier(bar); ++bar_no; if (bar_no == TSTAMP && blockIdx.x == 0 && threadIdx.x == 0) { ((float*)p.counts())[48] = (float)(wall_clock64() - ts0) * (1.0f / 100.0f); } } while (0)
#else
#define XBAR() xcd_barrier(bar)
#endif
  ph_prep0(p);
#if DUP == 30
  ph_prep0(p);
#endif
#if DENSER
  ph_convert_dense(p, smem);
#endif
#if MOEQ >= 1
  ph_convert(p, smem);
#if DUP == 20
  ph_convert(p, smem);
#endif
#endif
  XBAR();
#if DENSER
  ph_win_r(p, smem);
#else
  ph_win(p, smem);
#endif
#if DUP == 1
#if DENSER
  ph_win_r(p, smem);
#else
  ph_win(p, smem);
#endif
#endif
  XBAR();
  ph_prep1(p, smem);
#if DUP == 2
  ph_prep1(p, smem);
#endif
  XBAR();
#if DENSER
  upkv_tile_r(p, smem, blockIdx.x >> 3, blockIdx.x & 7);
  if (blockIdx.x < 192) upq_tile_r(p, smem, blockIdx.x / 6, blockIdx.x % 6);
#else
  upkv_tile(p, smem, blockIdx.x >> 3, blockIdx.x & 7);
  if (blockIdx.x < 192) upq_tile(p, smem, blockIdx.x / 6, blockIdx.x % 6);
#endif
  if (blockIdx.x < 192) gla_g1_unit(p, smem, blockIdx.x);
  else for (int i = 0; i < 5; ++i) gla_g1_unit(p, smem, 192 + (blockIdx.x - 192) * 5 + i);
#if DUP == 3
  upkv_tile(p, smem, blockIdx.x >> 3, blockIdx.x & 7);
  if (blockIdx.x < 192) upq_tile(p, smem, blockIdx.x / 6, blockIdx.x % 6);
  if (blockIdx.x < 192) gla_g1_unit(p, smem, blockIdx.x);
  else for (int i = 0; i < 5; ++i) gla_g1_unit(p, smem, 192 + (blockIdx.x - 192) * 5 + i);
#endif
  XBAR();
  gla_g2_unit(p, blockIdx.x);
#if DUP == 31
  gla_g2_unit(p, blockIdx.x);
#endif
  {
    const int bh = blockIdx.x >> 4, qa = blockIdx.x & 15;
    attn_unit(p, smem, bh >> 3, bh & 7, 31 - qa);
    attn_unit(p, smem, bh >> 3, bh & 7, qa);
#if DUP == 4
    attn_unit(p, smem, bh >> 3, bh & 7, 31 - qa);
    attn_unit(p, smem, bh >> 3, bh & 7, qa);
#endif
  }
  XBAR();
  for (int u = blockIdx.x; u < 512; u += gridDim.x) gla_g3_unit(p, smem, u);
  mla_norm_tokens(p);
#if DUP == 5
  for (int u = blockIdx.x; u < 512; u += gridDim.x) gla_g3_unit(p, smem, u);
  mla_norm_tokens(p);
#endif
  XBAR();
#if DENSER
  wout_tile_r(p, smem, blockIdx.x >> 3, blockIdx.x & 7);
#else
  wout_tile(p, smem, blockIdx.x >> 3, blockIdx.x & 7);
#endif
#if DUP == 6
  wout_tile(p, smem, blockIdx.x >> 3, blockIdx.x & 7);
#endif
  XBAR();
  ffn_prep_unit(p, smem, blockIdx.x);
#if DUP == 7
  ffn_prep_unit<1>(p, smem, blockIdx.x);
#endif
  XBAR();
#if MOEQ >= 1
  ph_moeq<1>(p, smem);
#if DUP == 8
  ph_moeq<1>(p, smem);
#endif
#else
  ph_moe<1>(p, smem);
#endif
  XBAR();
#if MOEQ >= 1
  ph_moeq<2>(p, smem);
#else
  ph_moe<2>(p, smem);
#endif
#if DUP == 9
  ph_moeq<2>(p, smem);
#endif
#if DUP == 89
  XBAR();
  ph_moeq<1>(p, smem);
  XBAR();
  ph_moeq<2>(p, smem);
#endif
#if DUP == 19
  ph_moe<2, 1>(p, smem);
#endif
  XBAR();
#if TSTAMP
  {
    const float us = ((const float*)p.counts())[48];
    const float scl = 1.0f + us * (1.0f / 4000.0f);
    ph_final(p, smem, scl);
  }
#else
  ph_final(p, smem);
#endif
#if DUP == 10
  ph_final(p, smem);
#endif
#if DUP == 11
  for (int i = 0; i < 10; ++i) xcd_barrier(bar);
#endif
}

extern "C" void kernel_launch(void* const* d_in, const int* in_sizes, int n_in,
                              void* d_out, int out_size, void* d_ws, size_t ws_size,
                              hipStream_t stream) {
  Params P{};
  P.x = (const float*)d_in[0]; P.pos = (const int*)d_in[1];
  P.attn_norm = (const float*)d_in[2]; P.w_in = (const float*)d_in[3]; P.gate_up = (const float*)d_in[4]; P.gate_bias = (const float*)d_in[5];
  P.gla_out_norm = (const float*)d_in[6]; P.q_norm = (const float*)d_in[7]; P.w_uq = (const float*)d_in[8]; P.kv_norm = (const float*)d_in[9];
  P.w_ukv = (const float*)d_in[10]; P.mla_out_norm = (const float*)d_in[11]; P.w_out = (const float*)d_in[12]; P.ffn_norm = (const float*)d_in[13];
  P.router_w = (const float*)d_in[14]; P.router_b = (const float*)d_in[15]; P.w_gu = (const float*)d_in[16]; P.b_gu = (const float*)d_in[17];
  P.w_dn = (const float*)d_in[18]; P.b_dn = (const float*)d_in[19]; P.final_norm = (const float*)d_in[20];
  P.out = (float*)d_out;

  P.ws = (char*)d_ws;

  hipFuncSetAttribute((const void*)mega, hipFuncAttributeMaxDynamicSharedMemorySize, LDS_MAX);
  hipMemsetAsync(d_ws, 0, XCD_BAR_WORDS * sizeof(unsigned), stream);
  mega<<<256, 256, LDS_MAX, stream>>>(P);
}
```

```cpp
#define DUP 0
#define MOEQ 2
#define TSTAMP 0
#define CVT_SPLIT 1
#define CVT_IN_P4 1
#include <hip/hip_runtime.h>
#include <hip/hip_bf16.h>
#include <stdint.h>
#include <type_traits>
#define T_      8192
#define SEQ_    4096
#define D_      2048
#define NC_     4176
#define C_GQ    0
#define C_GK    512
#define C_GV    1024
#define C_GR    2048
#define C_GD    3072
#define C_MQ    3088
#define C_MKV   3600
#define C_MKR   4112
#define NE_     32
#define DFF_    2048
#define EPS_    1e-6f
typedef short bf16x8 __attribute__((ext_vector_type(8)));
typedef short s16x4 __attribute__((ext_vector_type(4)));
typedef float f32x16 __attribute__((ext_vector_type(16)));
typedef float f32x4 __attribute__((ext_vector_type(4)));
typedef float f32x2 __attribute__((ext_vector_type(2)));
typedef unsigned short u16;
typedef unsigned u32x4 __attribute__((ext_vector_type(4)));
typedef unsigned u32x2 __attribute__((ext_vector_type(2)));
#define LAS3 __attribute__((address_space(3)))
#define OPAQUE(x) asm volatile("" : "+v"(x))
#define NTHR 256
__device__ __forceinline__ int opaque_tid() { int t = threadIdx.x; asm volatile("" : "+v"(t)); return t; }

__device__ __forceinline__ unsigned pack_bf16(float a, float b) {
  typedef __bf16 bf2 __attribute__((ext_vector_type(2)));
  typedef float f2 __attribute__((ext_vector_type(2)));
  f2 v = {a, b};
  bf2 r = __builtin_convertvector(v, bf2);
  return *(unsigned*)&r;
}
__device__ __forceinline__ float bf_lo(unsigned w) { return __uint_as_float(w << 16); }
__device__ __forceinline__ float bf_hi(unsigned w) { return __uint_as_float(w & 0xffff0000u); }
__device__ __forceinline__ float bf16_to_f32(u16 v) { return __uint_as_float(((unsigned)v) << 16); }
__device__ __forceinline__ u16 f32_to_bf16(float f) { return (u16)(pack_bf16(f, 0.f) & 0xffffu); }
__device__ __forceinline__ float shflx(float v, int k) {
  int t = threadIdx.x; asm volatile("" : "+v"(t));
  return __int_as_float(__builtin_amdgcn_ds_bpermute((((t & 63) ^ k) << 2), __float_as_int(v)));
}
__device__ __forceinline__ float wave_sum(float v) {
#pragma unroll
  for (int o = 32; o > 0; o >>= 1) v += shflx(v, o);
  return v;
}
__device__ __forceinline__ unsigned off_b(unsigned row, unsigned ch) { return 256u * row + 16u * (ch ^ (((row & 3u) << 2) | ((row >> 2) & 3u))); }
__device__ __forceinline__ unsigned tr_addr(unsigned lane, unsigned c, unsigned row0  ) {
  const unsigned blk = (lane >> 4) & 1u, q = (lane & 15u) >> 2, p = lane & 3u;
  return off_b(row0 + q, 4u * c + 2u * blk + (p >> 1)) + 8u * (p & 1u);
}
__device__ __forceinline__ bf16x8 tr_frag(const char* img, unsigned lane, unsigned c, unsigned row_a, unsigned row_b) {
  s16x4 v0 = __builtin_amdgcn_ds_read_tr16_b64_v4i16((LAS3 s16x4*)(img + tr_addr(lane, c, row_a)));
  s16x4 v1 = __builtin_amdgcn_ds_read_tr16_b64_v4i16((LAS3 s16x4*)(img + tr_addr(lane, c, row_b)));
  return (bf16x8){v0[0], v0[1], v0[2], v0[3], v1[0], v1[1], v1[2], v1[3]};
}

__device__ __forceinline__ void glds16_asm(const void* gsrc, unsigned lds_dst) {
  unsigned keep;
  asm volatile("s_mov_b32 %0, m0\n\ts_mov_b32 m0, %2\n\ts_nop 0\n\tglobal_load_lds_dwordx4 %1, off\n\ts_mov_b32 m0, %0" : "=&s"(keep) : "v"(gsrc), "s"(lds_dst) : "memory");
}
struct Params {
  const float *x; const int* pos;
  const float *attn_norm, *w_in, *gate_up, *gate_bias, *gla_out_norm, *q_norm, *w_uq, *kv_norm, *w_ukv, *mla_out_norm, *w_out,
              *ffn_norm, *router_w, *router_b, *w_gu, *b_gu, *w_dn, *b_dn, *final_norm;
  float* out;
  char* ws;
  __device__ __forceinline__ unsigned* bar() const { return (unsigned*)(ws + 0ull); }
  __device__ __forceinline__ int* counts() const { return (int*)(ws + 16384ull); }
  __device__ __forceinline__ u16* h1() const { return (u16*)(ws + 16640ull); }
  __device__ __forceinline__ u16* proj() const { return (u16*)(ws + 33571072ull); }
  __device__ __forceinline__ float2* cs() const { return (float2*)(ws + 101990656ull); }
  __device__ __forceinline__ float* rq() const { return (float*)(ws + 104087808ull); }
  __device__ __forceinline__ float* rkv() const { return (float*)(ws + 104120576ull); }
  __device__ __forceinline__ float* bcum() const { return (float*)(ws + 104153344ull); }
  __device__ __forceinline__ u16* q() const { return (u16*)(ws + 120930560ull); }
  __device__ __forceinline__ u16* kv() const { return (u16*)(ws + 146096384ull); }
  __device__ __forceinline__ u16* kpe() const { return (u16*)(ws + 179650816ull); }
  __device__ __forceinline__ u16* kvc() const { return (u16*)(ws + 180699392ull); }
  __device__ __forceinline__ float* dec() const { return (float*)(ws + 214253824ull); }
  __device__ __forceinline__ u16* sprev() const { return (u16*)(ws + 214515968ull); }
  __device__ __forceinline__ u16* mix() const { return (u16*)(ws + 248070400ull); }
  __device__ __forceinline__ u16* omla() const { return (u16*)(ws + 281624832ull); }
  __device__ __forceinline__ float* x1() const { return (float*)(ws + 298402048ull); }
  __device__ __forceinline__ u16* h2() const { return (u16*)(ws + 365510912ull); }
  __device__ __forceinline__ int* list() const { return (int*)(ws + 399065344ull); }
  __device__ __forceinline__ int* asg_e() const { return (int*)(ws + 400113920ull); }
  __device__ __forceinline__ int* asg_slot() const { return (int*)(ws + 400244992ull); }
  __device__ __forceinline__ float* asg_g() const { return (float*)(ws + 400376064ull); }
  __device__ __forceinline__ u16* act() const { return (u16*)(ws + 400507136ull); }
  __device__ __forceinline__ u16* ybuf() const { return (u16*)(ws + 568279296ull); }
  __device__ __forceinline__ unsigned char* wq_gu() const { return (unsigned char*)(ws + 736051456ull); }
  __device__ __forceinline__ unsigned char* wq_dn() const { return (unsigned char*)(ws + 1004486912ull); }
  __device__ __forceinline__ unsigned char* h2q() const { return (unsigned char*)(ws + 1138704640ull); }
  __device__ __forceinline__ unsigned char* actq() const { return (unsigned char*)(ws + 1155481856ull); }
  __device__ __forceinline__ u16* wb_in() const { return (u16*)(ws + 1239367936ull); }
  __device__ __forceinline__ u16* wb_uq() const { return (u16*)(ws + 1257193728ull); }
  __device__ __forceinline__ u16* wb_ukv() const { return (u16*)(ws + 1258766592ull); }
  __device__ __forceinline__ u16* wb_out() const { return (u16*)(ws + 1260863744ull); }
};
#define WS_BYTES_USED 1269252352ull

#define XB_TMO      128
#define XB_XCNT(j)  (256  + 64 * (j))
#define XB_XSUB(j)  (1280 + 64 * (j))
#define XB_XGEN(j)  (2304 + 64 * (j))
#define XB_TOP      3328
#define XB_TOPGEN   3392
#define XCD_BAR_WORDS 3456
#define XB_SPIN_CAP (1u << 18)
#define LAS __attribute__((address_space(3)))

__device__ __forceinline__ unsigned xb_ld(unsigned* p)              { return __hip_atomic_load(p, __ATOMIC_RELAXED, __HIP_MEMORY_SCOPE_AGENT); }
__device__ __forceinline__ unsigned xb_add(unsigned* p, unsigned v) { return __hip_atomic_fetch_add(p, v, __ATOMIC_RELAXED, __HIP_MEMORY_SCOPE_AGENT); }
__device__ __forceinline__ unsigned xb_xcc_id() { return (unsigned)__builtin_amdgcn_s_getreg((3 << 11) | 20) & 0xFu; }
#define XB_SPIN(cond, bar) do { unsigned _sp = 0; while (cond) { __builtin_amdgcn_s_sleep(1); \
    if ((++_sp & 255u) == 0u) { if (xb_ld(&(bar)[XB_TMO])) break; if (_sp > XB_SPIN_CAP) { atomicAdd(&(bar)[XB_TMO], 1u); break; } } } } while (0)

struct XcdBarrier {
    unsigned* bar; unsigned x;
    volatile LAS unsigned* st;
};

__device__ __forceinline__ XcdBarrier xcd_barrier_post(unsigned* bar, volatile LAS unsigned* st) {
    XcdBarrier b; b.bar = bar; b.x = xb_xcc_id(); b.st = st;
    if (threadIdx.x == 0) (void)xb_add(&bar[XB_XCNT(b.x)], 1u);
    return b;
}
__device__ __forceinline__ void xcd_barrier_complete(unsigned* bar, unsigned x, unsigned& nloc, unsigned& nx) {
    const unsigned G = gridDim.x * gridDim.y * gridDim.z;
    unsigned sum, cnt, mine, sp = 0u;
    for (;;) {
        sum = 0u; cnt = 0u; mine = 0u;
#pragma unroll
        for (unsigned j = 0; j < 16; ++j) { const unsigned c = xb_ld(&bar[XB_XCNT(j)]); sum += c; cnt += (c > 0u) ? 1u : 0u; mine = (j == x) ? c : mine; }
        if (sum == G) break;
        __builtin_amdgcn_s_sleep(1);
        if ((++sp & 255u) == 0u) { if (xb_ld(&bar[XB_TMO])) break; if (sp > XB_SPIN_CAP) { atomicAdd(&bar[XB_TMO], 1u); break; } }
    }
    nloc = mine > 0u ? mine : 1u; nx = cnt > 0u ? cnt : 1u;
}

__device__ __forceinline__ void xcd_barrier(const XcdBarrier& b) {
    asm volatile("s_waitcnt vmcnt(0)" ::: "memory");
    __syncthreads();
    if (threadIdx.x == 0) {
        unsigned* bar = b.bar;
        __builtin_amdgcn_s_waitcnt(0);
        unsigned nloc = b.st[0], nx = b.st[1];
        if (nloc == 0u) { xcd_barrier_complete(bar, b.x, nloc, nx); b.st[0] = nloc; b.st[1] = nx; }
        const unsigned old = xb_add(&bar[XB_XSUB(b.x)], 1u);
        const unsigned gen = old / nloc;
        if (old + 1u == (gen + 1u) * nloc) {
            __builtin_amdgcn_fence(__ATOMIC_RELEASE, "agent");
            asm volatile("s_waitcnt vmcnt(0)" ::: "memory");
            const unsigned og = xb_add(&bar[XB_TOP], 1u);
            const unsigned tg = og / nx;
            if (og + 1u == (tg + 1u) * nx) xb_add(&bar[XB_TOPGEN], 1u);
            else XB_SPIN(xb_ld(&bar[XB_TOPGEN]) == tg, bar);
            __builtin_amdgcn_fence(__ATOMIC_ACQUIRE, "agent");
            xb_add(&bar[XB_XGEN(b.x)], 1u);
            asm volatile("s_waitcnt vmcnt(0)" ::: "memory");
        } else {
            XB_SPIN(xb_ld(&bar[XB_XGEN(b.x)]) == gen, bar);
            __builtin_amdgcn_fence(__ATOMIC_ACQUIRE, "agent");
            asm volatile("s_waitcnt vmcnt(0)" ::: "memory");
        }
    }
    __syncthreads();
}

#define G_A_OFF(s)  ((s) * 65536)
#define G_B_OFF(s)  ((s) * 65536 + 32768)
#define G_LDS_BYTES 131072

struct GemmTile {
  const u16* A; int lda;
  const int* aidx;
  int m0, mvalid;
  const float* B0; const float* B1;
  int ldb; int nv0, nv1;
  const float* kscale;
  int K;
};

template <int NB, bool KSCALE, bool GATHER>
__device__ __forceinline__ void gemm_tile_256(const GemmTile& t, char* smem, f32x16 (&acc)[4][4]) {
  int tz0 = threadIdx.x; asm volatile("" : "+v"(tz0));
  const int tid = tz0, lane = tid & 63, wid = tid >> 6, wr = wid >> 1, wc = wid & 1;
  const int l31 = lane & 31, hh = lane >> 5;
#pragma unroll
  for (int i = 0; i < 4; ++i)
#pragma unroll
    for (int j = 0; j < 4; ++j)
#pragma unroll
      for (int r = 0; r < 16; ++r) acc[i][j][r] = 0.f;

  const int a_c = (tid & 7) ^ ((tid >> 4) & 7);
  const u16* a_src[GATHER ? 8 : 1];
  if (GATHER) {
#pragma unroll
    for (int i = 0; i < (GATHER ? 8 : 1); ++i) {
      int r = (tid >> 3) + 32 * i;
      int rr = r < t.mvalid ? r : 0;
      a_src[i] = t.A + (long)t.aidx[rr] * t.lda + a_c * 8;
    }
  } else {
    a_src[0] = t.A + (long)(t.m0 + (tid >> 3)) * t.lda + a_c * 8;
  }
  const long a_step = 32L * t.lda;
  const int b_n4 = tid & 63, b_k = tid >> 6;
  const int b_k_u = __builtin_amdgcn_readfirstlane(b_k);
  const int b_img = b_n4 >> 5, b_ch = (b_n4 >> 1) & 15, b_half = b_n4 & 1;
  const bool b_ok = ((b_n4 & 31) * 4) < (b_img ? t.nv1 : t.nv0);
  const int b_loff = (b_ok ? ((b_img ? (int)(t.B1 - t.B0) : 0) + (b_n4 & 31) * 4) : 0) + b_k * t.ldb;
  f32x4 breg[16];

  const unsigned a_lds0 = (unsigned)(size_t)smem + (unsigned)__builtin_amdgcn_readfirstlane(wid) * 1024u;
  auto issue_a = [&](int kt, int s, int i) {
    glds16_asm((const void*)((GATHER ? a_src[GATHER ? i : 0] : a_src[0] + i * a_step) + kt * 64), a_lds0 + G_A_OFF(s) + i * 4096);
  };
  auto issue_b = [&](int kt, int j) {
    const float* ptr = t.B0 + (long)(kt * 64 + 4 * j) * t.ldb + b_loff;
    asm volatile("global_load_dwordx4 %0, %1, off" : "=v"(breg[j]) : "v"(ptr) : "memory");
  };
  auto write_b = [&](int kt, int s, int j) {
    const int k = b_k + 4 * j;
    f32x4 v = breg[j];
    if (KSCALE) { float sc = t.kscale[kt * 64 + b_k_u + 4 * j]; v *= sc; }
    if (!b_ok) v = (f32x4){0.f, 0.f, 0.f, 0.f};
    u32x2 w = {pack_bf16(v[0], v[1]), pack_bf16(v[2], v[3])};
    *(u32x2*)(smem + G_B_OFF(s) + b_img * 16384 + off_b(k, b_ch) + 8 * b_half) = w;
  };
#define WAITQ(N, g) asm volatile("s_waitcnt vmcnt(" #N ")" : "+v"(breg[4 * (g)]), "+v"(breg[4 * (g) + 1]), "+v"(breg[4 * (g) + 2]), "+v"(breg[4 * (g) + 3]) :: "memory")

  unsigned a_rd[4], b_rd[2][2];
#pragma unroll
  for (int ks = 0; ks < 4; ++ks) { const int row = wr * 128 + l31; a_rd[ks] = row * 128 + (((2 * ks + hh) ^ ((row >> 1) & 7)) * 16); }
#pragma unroll
  for (int tt = 0; tt < 2; ++tt)
#pragma unroll
    for (int nl = 0; nl < 2; ++nl) b_rd[tt][nl] = tr_addr(lane, wc * 2 + nl, 8 * hh + 4 * tt);
  auto load_a = [&](const char* As, int ks, bf16x8 (&af)[4]) {
#pragma unroll
    for (int mb = 0; mb < 4; ++mb) af[mb] = *(const bf16x8*)(As + a_rd[ks] + mb * 4096);
  };
  auto load_b1 = [&](const char* Bs, int ks, int nb, bf16x8& bfr) {
    const char* bi = Bs + (nb >> 1) * 16384 + ks * 4096;
    s16x4 v0 = __builtin_amdgcn_ds_read_tr16_b64_v4i16((LAS3 s16x4*)(bi + b_rd[0][nb & 1]));
    s16x4 v1 = __builtin_amdgcn_ds_read_tr16_b64_v4i16((LAS3 s16x4*)(bi + b_rd[1][nb & 1]));
    bfr = (bf16x8){v0[0], v0[1], v0[2], v0[3], v1[0], v1[1], v1[2], v1[3]};
  };

  auto kstep = [&](int kt, auto mode_tag, bool has1, bool has2) {
    constexpr int MODE = decltype(mode_tag)::value;
    const int s = kt & 1;
    const char* As = smem + G_A_OFF(s);
    const char* Bs = smem + G_B_OFF(s);
    bf16x8 a0[4], a1[4], bq[NB];
    load_a(As, 0, a0);
#pragma unroll
    for (int nb = 0; nb < NB; ++nb) load_b1(Bs, 0, nb, bq[nb]);
    __builtin_amdgcn_sched_barrier(0);
#pragma unroll
    for (int g = 0; g < 4; ++g) {
      bf16x8 (&ac)[4] = (g & 1) ? a1 : a0;
      bf16x8 (&an)[4] = (g & 1) ? a0 : a1;
      if (g < 3) load_a(As, g + 1, an);
      __builtin_amdgcn_sched_barrier(0);
#pragma unroll
      for (int nb = 0; nb < NB; ++nb) {
#pragma unroll
        for (int mb = 0; mb < 4; ++mb)
          acc[mb][nb] = __builtin_amdgcn_mfma_f32_32x32x16_bf16(ac[mb], bq[nb], acc[mb][nb], 0, 0, 0);
        __builtin_amdgcn_sched_barrier(0);
        if (g < 3) load_b1(Bs, g + 1, nb, bq[nb]);
        if (nb == 0 && g < 2 && has1) { issue_a(kt + 1, s ^ 1, 4 * g + 0); issue_a(kt + 1, s ^ 1, 4 * g + 1); }
        if (nb == 1 % NB && g < 2 && has1 && NB > 1) { issue_a(kt + 1, s ^ 1, 4 * g + 2); issue_a(kt + 1, s ^ 1, 4 * g + 3); }
        if (NB == 1 && nb == 0 && g < 2 && has1) { issue_a(kt + 1, s ^ 1, 4 * g + 2); issue_a(kt + 1, s ^ 1, 4 * g + 3); }
        if (nb == NB - 1 && has1) {
          if (MODE == 2) { if (g == 0) WAITQ(20, 0); else if (g == 1) WAITQ(20, 1); else if (g == 2) WAITQ(20, 2); else WAITQ(20, 3); }
          else if (MODE == 1) { if (g == 0) WAITQ(16, 0); else if (g == 1) WAITQ(20, 1); else if (g == 2) WAITQ(20, 2); else WAITQ(20, 3); }
          else { if (g == 0) WAITQ(0, 0); else if (g == 1) WAITQ(0, 1); else if (g == 2) WAITQ(0, 2); else WAITQ(0, 3); }
#pragma unroll
          for (int i = 0; i < 4; ++i) write_b(kt + 1, s ^ 1, 4 * g + i);
          if (has2) {
#pragma unroll
            for (int i = 0; i < 4; ++i) issue_b(kt + 2, 4 * g + i);
          }
        }
        __builtin_amdgcn_sched_barrier(0);
      }
    }
    if (has1) {
      if (MODE == 0) asm volatile("s_waitcnt vmcnt(0)" ::: "memory");
      else asm volatile("s_waitcnt vmcnt(12)" ::: "memory");
      __syncthreads();
    }
  };

  const int nk = t.K >> 6;
  __syncthreads();
#pragma unroll
  for (int j = 0; j < 16; ++j) issue_b(0, j);
#pragma unroll
  for (int i = 0; i < 8; ++i) issue_a(0, 0, i);
  WAITQ(8, 0); WAITQ(8, 1); WAITQ(8, 2); WAITQ(8, 3);
#pragma unroll
  for (int j = 0; j < 16; ++j) write_b(0, 0, j);
#pragma unroll
  for (int j = 0; j < 16; ++j) issue_b(1, j);
  asm volatile("s_waitcnt vmcnt(16)" ::: "memory");
  __syncthreads();
  kstep(0, std::integral_constant<int, 1>{}, true, true);
  for (int kt = 1; kt < nk - 2; ++kt) kstep(kt, std::integral_constant<int, 2>{}, true, true);
  kstep(nk - 2, std::integral_constant<int, 0>{}, true, false);
  kstep(nk - 1, std::integral_constant<int, 0>{}, false, false);
#undef WAITQ
}
template <int NB, class F>
__device__ __forceinline__ void acc_foreach_row(f32x16 (&acc)[4][4], F f) {
  int tz = threadIdx.x; asm volatile("" : "+v"(tz));
  const int lane = tz & 63, wid = tz >> 6, wr = wid >> 1, wc = wid & 1;
  const int l31 = lane & 31, hh = lane >> 5;
#pragma unroll
  for (int mb = 0; mb < 4; ++mb)
#pragma unroll
    for (int reg = 0; reg < 16; ++reg) {
      const int rowl = wr * 128 + mb * 32 + (reg & 3) + 8 * (reg >> 2) + 4 * hh;
      float v[NB];
#pragma unroll
      for (int nb = 0; nb < NB; ++nb) v[nb] = acc[mb][nb][reg];
      f(rowl, wc * 64 + l31, v);
      asm volatile("" ::: "memory");
    }
}
__device__ __forceinline__ void ph_prep0(const Params& p) {
  const int tid_ = opaque_tid(); const int lane = tid_ & 63, wid = tid_ >> 6;
  if (blockIdx.x == 0 && tid_ < 64) p.counts()[tid_] = 0;
  for (int t = blockIdx.x * 4 + wid; t < T_; t += gridDim.x * 4) {
    const float* xr = p.x + (long)t * 2048;
    f32x4 v[8]; float ss = 0.f;
#pragma unroll
    for (int j = 0; j < 8; ++j) { v[j] = *(const f32x4*)(xr + j * 256 + lane * 4); ss += v[j][0] * v[j][0] + v[j][1] * v[j][1] + v[j][2] * v[j][2] + v[j][3] * v[j][3]; }
    ss = wave_sum(ss);
    const float r = rsqrtf(ss * (1.0f / 2048.0f) + EPS_);
#pragma unroll
    for (int j = 0; j < 8; ++j) {
      f32x4 g = *(const f32x4*)(p.attn_norm + j * 256 + lane * 4);
      u32x2 w = {pack_bf16(v[j][0] * r * g[0], v[j][1] * r * g[1]), pack_bf16(v[j][2] * r * g[2], v[j][3] * r * g[3])};
      *(u32x2*)(p.h1() + (long)t * 2048 + j * 256 + lane * 4) = w;
    }
    if (lane < 32) {
      float inv = 1.0f / powf(10000.0f, (float)(2 * lane) / 64.0f);
      float ang = (float)p.pos[t] * inv;
      double a = (double)ang;
      double k = rint(a * 0.15915494309189535);
      float rf = (float)fma(-k, 6.283185307179586, a);
      p.cs()[t * 32 + lane] = make_float2(__cosf(rf), __sinf(rf));
    }
  }
}

template <int NB>
__device__ __forceinline__ void win_tile(const Params& p, char* smem, int mt, int nt) {
  f32x16 acc[4][4];
  GemmTile t{};
  t.A = p.h1(); t.lda = 2048; t.aidx = nullptr; t.m0 = mt * 256; t.mvalid = 256;
  t.B0 = p.w_in + nt * 256; t.B1 = t.B0 + 128; t.ldb = NC_;
  const int rem = NC_ - nt * 256;
  t.nv0 = rem >= 128 ? 128 : rem; t.nv1 = rem >= 256 ? 128 : (rem > 128 ? rem - 128 : 0);
  t.kscale = nullptr; t.K = 2048;
  gemm_tile_256<NB, false, false>(t, smem, acc);
  u16* base = p.proj() + (long)(mt * 256) * NC_ + nt * 256;
  const int nv0 = t.nv0, nv1 = t.nv1;
  acc_foreach_row<NB>(acc, [&](int rowl, int coll, float (&v)[NB]) {
    u16* rp = base + (long)rowl * NC_ + coll;
    OPAQUE(rp);
#pragma unroll
    for (int nb = 0; nb < NB; ++nb) {
      const int c = (nb & 1) * 32 + coll;
      const int lim = (nb >> 1) ? nv1 : nv0;
      if (c < lim) rp[(nb >> 1) * 128 + (nb & 1) * 32] = f32_to_bf16(v[nb]);
    }
  });
}
__device__ __forceinline__ void ph_win(const Params& p, char* smem) {
  const int x = blockIdx.x & 7, slot = blockIdx.x >> 3;
  for (int j = slot; j < 64; j += 32) win_tile<4>(p, smem, 4 * x + (j & 3), j >> 2);
  if (slot < 4) win_tile<2>(p, smem, 4 * x + slot, 16);
}

__device__ __forceinline__ void ph_prep1(const Params& p, char* smem) {
  float* gds = (float*)smem;
  float* cums = (float*)(smem + 4096);
  const int tid = opaque_tid(), lane = tid & 63, wid = tid >> 6;
  for (int u = blockIdx.x; u < 512; u += gridDim.x) {
    const int ch = u >> 2, h = u & 3; const int t0 = ch * 64;
    __syncthreads();
    {
      const int tl = tid >> 2, r4 = (tid & 3) * 4;
      u32x2 w = *(const u32x2*)(p.proj() + (long)(t0 + tl) * NC_ + C_GD + r4);
      gds[tl * 16 + r4 + 0] = bf_lo(w[0]); gds[tl * 16 + r4 + 1] = bf_hi(w[0]);
      gds[tl * 16 + r4 + 2] = bf_lo(w[1]); gds[tl * 16 + r4 + 3] = bf_hi(w[1]);
    }
    const int c = tid & 127, half = tid >> 7;
    float gu[16];
#pragma unroll
    for (int r = 0; r < 16; ++r) gu[r] = p.gate_up[r * 512 + h * 128 + c];
    const float bias = p.gate_bias[h * 128 + c];
    __syncthreads();
    float run = 0.f;
    for (int i = 0; i < 32; ++i) {
      const int tl = half * 32 + i;
      float z = bias;
#pragma unroll
      for (int r = 0; r < 16; ++r) z = fmaf(gds[tl * 16 + r], gu[r], z);
      const float ls = fminf(z, 0.f) - log1pf(__expf(-fabsf(z)));
      run += ls * (1.0f / 16.0f);
      cums[tl * 128 + c] = run;
    }
    __syncthreads();
    {
      const float add = cums[31 * 128 + c];
      for (int i = 0; i < 32; ++i) {
        const int tl = half * 32 + i;
        float v = cums[tl * 128 + c] + (half ? add : 0.f);
        p.bcum()[(long)(t0 + tl) * 512 + h * 128 + c] = v;
      }
    }
    for (int i = 0; i < 4; ++i) {
      const long t = t0 + h * 16 + wid * 4 + i;
      const u16* pr = p.proj() + t * NC_;
      u32x4 a = *(const u32x4*)(pr + C_MQ + lane * 8);
      u32x4 b = *(const u32x4*)(pr + C_MKV + lane * 8);
      float sa = 0.f, sb = 0.f;
#pragma unroll
      for (int k = 0; k < 4; ++k) { float l = bf_lo(a[k]), hgh = bf_hi(a[k]); sa += l * l + hgh * hgh; l = bf_lo(b[k]); hgh = bf_hi(b[k]); sb += l * l + hgh * hgh; }
      sa = wave_sum(sa); sb = wave_sum(sb);
      if (lane == 0) { p.rq()[t] = rsqrtf(sa * (1.0f / 512.0f) + EPS_); p.rkv()[t] = rsqrtf(sb * (1.0f / 512.0f) + EPS_); }
      if (lane < 32) {
        const float t1 = bf16_to_f32(pr[C_MKR + lane]), t2 = bf16_to_f32(pr[C_MKR + lane + 32]);
        const float2 cs = p.cs()[t * 32 + lane];
        p.kpe()[t * 64 + lane] = f32_to_bf16(t1 * cs.x - t2 * cs.y);
        p.kpe()[t * 64 + lane + 32] = f32_to_bf16(t1 * cs.y + t2 * cs.x);
      }
    }
  }
}

#define QSCALE_ (0.07216878364870322f * 1.4426950408889634f)
__device__ __forceinline__ void upq_tile(const Params& p, char* smem, int mt, int nt) {
  f32x16 acc[4][4];
  GemmTile t{};
  t.A = p.proj() + C_MQ; t.lda = NC_; t.aidx = nullptr; t.m0 = mt * 256; t.mvalid = 256;
  t.B0 = p.w_uq + nt * 256; t.B1 = t.B0 + 128; t.ldb = 1536; t.nv0 = 128; t.nv1 = 128; t.kscale = p.q_norm; t.K = 512;
  gemm_tile_256<4, true, false>(t, smem, acc);
  u16* base = p.q() + (long)(mt * 256) * 1536 + nt * 256;
  const float* rq = p.rq() + mt * 256;
  acc_foreach_row<4>(acc, [&](int rowl, int coll, float (&v)[4]) {
    u16* rp = base + (long)rowl * 1536 + coll;
    OPAQUE(rp);
    const float s = rq[rowl] * QSCALE_;
#pragma unroll
    for (int nb = 0; nb < 4; ++nb) rp[(nb >> 1) * 128 + (nb & 1) * 32] = f32_to_bf16(v[nb] * s);
  });
}
__device__ __forceinline__ void upkv_tile(const Params& p, char* smem, int mt, int nt) {
  f32x16 acc[4][4];
  GemmTile t{};
  t.A = p.proj() + C_MKV; t.lda = NC_; t.aidx = nullptr; t.m0 = mt * 256; t.mvalid = 256;
  t.B0 = p.w_ukv + nt * 256; t.B1 = t.B0 + 128; t.ldb = 2048; t.nv0 = 128; t.nv1 = 128; t.kscale = p.kv_norm; t.K = 512;
  gemm_tile_256<4, true, false>(t, smem, acc);
  u16* base = p.kv() + (long)(mt * 256) * 2048 + nt * 256;
  const float* rk = p.rkv() + mt * 256;
  acc_foreach_row<4>(acc, [&](int rowl, int coll, float (&v)[4]) {
    u16* rp = base + (long)rowl * 2048 + coll;
    OPAQUE(rp);
    const float s = rk[rowl];
#pragma unroll
    for (int nb = 0; nb < 4; ++nb) rp[(nb >> 1) * 128 + (nb & 1) * 32] = f32_to_bf16(v[nb] * s);
  });
}
#define AT_KSTRIDE 400
#define AT_KBYTES  (64 * AT_KSTRIDE)
#define AT_STAGE   (AT_KBYTES + 16384)
#define AT_LDS_BYTES (2 * AT_STAGE)

__device__ __forceinline__ void attn_unit(const Params& p, char* smem, int b, int h, int qb) {
  const int tid = opaque_tid(), lane = tid & 63, wid = tid >> 6, l31 = lane & 31, hh = lane >> 5;
  const long tq = (long)b * SEQ_ + qb * 128 + wid * 32 + l31;
  bf16x8 qf[12];
  {
    const u16* qp = p.q() + (tq * 8 + h) * 192 + 8 * hh;
#pragma unroll
    for (int ks = 0; ks < 12; ++ks) qf[ks] = *(const bf16x8*)(qp + 16 * ks);
#pragma unroll
    for (int s = 0; s < 2; ++s) {
      const float2* cp = p.cs() + tq * 32 + 16 * s + 8 * hh;
      bf16x8 lo = qf[8 + s], hi = qf[10 + s], nlo, nhi;
#pragma unroll
      for (int j = 0; j < 8; j += 2) {
        float2 c0 = cp[j], c1 = cp[j + 1];
        float a0 = bf16_to_f32((u16)lo[j]), a1 = bf16_to_f32((u16)lo[j + 1]);
        float b0 = bf16_to_f32((u16)hi[j]), b1 = bf16_to_f32((u16)hi[j + 1]);
        unsigned wl = pack_bf16(a0 * c0.x - b0 * c0.y, a1 * c1.x - b1 * c1.y);
        unsigned wh = pack_bf16(a0 * c0.y + b0 * c0.x, a1 * c1.y + b1 * c1.x);
        nlo[j] = (short)(wl & 0xffff); nlo[j + 1] = (short)(wl >> 16);
        nhi[j] = (short)(wh & 0xffff); nhi[j + 1] = (short)(wh >> 16);
      }
      qf[8 + s] = nlo; qf[10 + s] = nhi;
    }
  }
  u32x4 kregA[6], vregA[4], kregB[6], vregB[4];
  const long tk0 = (long)b * SEQ_;
  auto load_tile = [&](int kt, u32x4 (&kreg)[6], u32x4 (&vreg)[4]) {
    const long tb = tk0 + kt * 64;
#pragma unroll
    for (int i = 0; i < 4; ++i) {
      const int pp = i * 256 + tid; const int key = pp >> 4, c = pp & 15;
      const u16* rowp = p.kv() + ((tb + key) * 8 + h) * 256 + c * 8;
      kreg[i] = *(const u32x4*)rowp;
      vreg[i] = *(const u32x4*)(rowp + 128);
    }
#pragma unroll
    for (int i = 0; i < 2; ++i) {
      const int pp = i * 256 + tid; const int key = pp >> 3, c = pp & 7;
      kreg[4 + i] = *(const u32x4*)(p.kpe() + (tb + key) * 64 + c * 8);
    }
  };
  auto store_tile = [&](int s, u32x4 (&kreg)[6], u32x4 (&vreg)[4]) {
    char* Ks = smem + s * AT_STAGE; char* Vs = Ks + AT_KBYTES;
#pragma unroll
    for (int i = 0; i < 4; ++i) {
      const int pp = i * 256 + tid; const int key = pp >> 4, c = pp & 15;
      *(u32x4*)(Ks + key * AT_KSTRIDE + c * 16) = kreg[i];
      *(u32x4*)(Vs + off_b(key, c)) = vreg[i];
    }
#pragma unroll
    for (int i = 0; i < 2; ++i) {
      const int pp = i * 256 + tid; const int key = pp >> 3, c = pp & 7;
      *(u32x4*)(Ks + key * AT_KSTRIDE + (16 + c) * 16) = kreg[4 + i];
    }
  };

  f32x16 o[4];
#pragma unroll
  for (int c = 0; c < 4; ++c)
#pragma unroll
    for (int r = 0; r < 16; ++r) o[c][r] = 0.f;
  float m = -1e30f, l = 0.f;
  const int nt = 2 * qb + 2;
  const int qpos = qb * 128 + wid * 32 + l31;

  __syncthreads();
  load_tile(0, kregA, vregA);
  store_tile(0, kregA, vregA);
  load_tile(1, kregB, vregB);
  if (nt > 2) load_tile(2, kregA, vregA);
  __syncthreads();
  auto tile_body = [&](int kt, int s) {
    const char* Ks = smem + s * AT_STAGE; const char* Vs = Ks + AT_KBYTES;
    const bool active = (kt * 64) <= (qb * 128 + wid * 32 + 31);
    if (active) {
      f32x16 sc[2];
#pragma unroll
      for (int kb = 0; kb < 2; ++kb) {
#pragma unroll
        for (int r = 0; r < 16; ++r) sc[kb][r] = 0.f;
#pragma unroll
        for (int ks = 0; ks < 12; ++ks) {
          bf16x8 a = *(const bf16x8*)(Ks + (kb * 32 + l31) * AT_KSTRIDE + (2 * ks + hh) * 16);
          sc[kb] = __builtin_amdgcn_mfma_f32_32x32x16_bf16(a, qf[ks], sc[kb], 0, 0, 0);
        }
      }
      if (kt >= 2 * qb) {
#pragma unroll
        for (int kb = 0; kb < 2; ++kb)
#pragma unroll
          for (int r = 0; r < 16; ++r) {
            const int key = kt * 64 + kb * 32 + (r & 3) + 8 * (r >> 2) + 4 * hh;
            if (key > qpos) sc[kb][r] = -1e30f;
          }
      }
      float mx = sc[0][0];
#pragma unroll
      for (int kb = 0; kb < 2; ++kb)
#pragma unroll
        for (int r = 0; r < 16; ++r) mx = fmaxf(mx, sc[kb][r]);
      mx = fmaxf(mx, shflx(mx, 32));
      const float mn = fmaxf(m, mx);
      const float alpha = exp2f(m - mn);
      m = mn;
      float ps = 0.f;
      bf16x8 pf[4];
#pragma unroll
      for (int kb = 0; kb < 2; ++kb)
#pragma unroll
        for (int s2 = 0; s2 < 2; ++s2) {
          float e[8];
#pragma unroll
          for (int j = 0; j < 8; ++j) { e[j] = exp2f(sc[kb][8 * s2 + j] - mn); ps += e[j]; }
          unsigned w0 = pack_bf16(e[0], e[1]), w1 = pack_bf16(e[2], e[3]), w2 = pack_bf16(e[4], e[5]), w3 = pack_bf16(e[6], e[7]);
          u32x4 w = {w0, w1, w2, w3};
          pf[kb * 2 + s2] = *(bf16x8*)&w;
        }
      l = l * alpha + ps;
#pragma unroll
      for (int c = 0; c < 4; ++c)
#pragma unroll
        for (int r = 0; r < 16; ++r) o[c][r] *= alpha;
#pragma unroll
      for (int c = 0; c < 4; ++c)
#pragma unroll
        for (int kk = 0; kk < 4; ++kk) {
          const unsigned rbase = 32 * (kk >> 1) + 16 * (kk & 1) + 4 * hh;
          bf16x8 a = tr_frag(Vs, lane, c, rbase, rbase + 8);
          o[c] = __builtin_amdgcn_mfma_f32_32x32x16_bf16(a, pf[kk], o[c], 0, 0, 0);
        }
    }
  };
  for (int kt = 0; kt < nt; kt += 2) {
    tile_body(kt, 0);
    store_tile(1, kregB, vregB);
    if (kt + 3 < nt) load_tile(kt + 3, kregB, vregB);
    __syncthreads();
    tile_body(kt + 1, 1);
    if (kt + 2 < nt) {
      store_tile(0, kregA, vregA);
      if (kt + 4 < nt) load_tile(kt + 4, kregA, vregA);
      __syncthreads();
    }
  }
  l = l + shflx(l, 32);
  const float inv = 1.0f / l;
  u16* op = p.omla() + tq * 1024 + h * 128 + 4 * hh;
#pragma unroll
  for (int c = 0; c < 4; ++c)
#pragma unroll
    for (int rg = 0; rg < 4; ++rg) {
      u32x2 w = {pack_bf16(o[c][4 * rg] * inv, o[c][4 * rg + 1] * inv), pack_bf16(o[c][4 * rg + 2] * inv, o[c][4 * rg + 3] * inv)};
      *(u32x2*)(op + 32 * c + 8 * rg) = w;
    }
}

#define G1_LDS_BYTES 49152
__device__ __forceinline__ void gla_g1_unit(const Params& p, char* smem, int u) {
  const int tid = opaque_tid(), lane = tid & 63, wid = tid >> 6, l31 = lane & 31, hh = lane >> 5;
  const int bh = u >> 6, n = u & 63, b = bh >> 2, h = bh & 3;
  const long t0 = (long)b * SEQ_ + n * 64;
  char* Ks = smem; char* Vs = smem + 16384;
  __syncthreads();
  {
    const int ch = tid & 15;
    const float* bl = p.bcum() + (t0 + 63) * 512 + h * 128 + ch * 8;
    f32x4 bl0 = *(const f32x4*)bl, bl1 = *(const f32x4*)(bl + 4);
    if (tid < 128) p.dec()[(long)u * 128 + tid] = __expf(p.bcum()[(t0 + 63) * 512 + h * 128 + tid]);
#pragma unroll
    for (int i = 0; i < 4; ++i) {
      const int tok = (i * 256 + tid) >> 4;
      u32x4 kw = *(const u32x4*)(p.proj() + (t0 + tok) * NC_ + C_GK + h * 128 + ch * 8);
      const float* bp = p.bcum() + (t0 + tok) * 512 + h * 128 + ch * 8;
      f32x4 b0 = *(const f32x4*)bp, b1 = *(const f32x4*)(bp + 4);
      u32x4 w;
      w[0] = pack_bf16(bf_lo(kw[0]) * __expf(bl0[0] - b0[0]), bf_hi(kw[0]) * __expf(bl0[1] - b0[1]));
      w[1] = pack_bf16(bf_lo(kw[1]) * __expf(bl0[2] - b0[2]), bf_hi(kw[1]) * __expf(bl0[3] - b0[3]));
      w[2] = pack_bf16(bf_lo(kw[2]) * __expf(bl1[0] - b1[0]), bf_hi(kw[2]) * __expf(bl1[1] - b1[1]));
      w[3] = pack_bf16(bf_lo(kw[3]) * __expf(bl1[2] - b1[2]), bf_hi(kw[3]) * __expf(bl1[3] - b1[3]));
      *(u32x4*)(Ks + off_b(tok, ch)) = w;
    }
#pragma unroll
    for (int i = 0; i < 8; ++i) {
      const int pp = i * 256 + tid; const int tok = pp >> 5, c32 = pp & 31;
      u32x4 vw = *(const u32x4*)(p.proj() + (t0 + tok) * NC_ + C_GV + h * 256 + c32 * 8);
      *(u32x4*)(Vs + (c32 >> 4) * 16384 + off_b(tok, c32 & 15)) = vw;
    }
  }
  __syncthreads();
  f32x16 acc[4][2];
#pragma unroll
  for (int mb = 0; mb < 4; ++mb)
#pragma unroll
    for (int nb = 0; nb < 2; ++nb)
#pragma unroll
      for (int r = 0; r < 16; ++r) acc[mb][nb][r] = 0.f;
  const char* Vimg = Vs + (wid >> 1) * 16384;
#pragma unroll
  for (int ks = 0; ks < 4; ++ks) {
    bf16x8 af[4], bfr[2];
    const unsigned r0 = 16 * ks + 8 * hh;
#pragma unroll
    for (int mb = 0; mb < 4; ++mb) af[mb] = tr_frag(Ks, lane, mb, r0, r0 + 4);
#pragma unroll
    for (int nb = 0; nb < 2; ++nb) bfr[nb] = tr_frag(Vimg, lane, 2 * (wid & 1) + nb, r0, r0 + 4);
#pragma unroll
    for (int mb = 0; mb < 4; ++mb)
#pragma unroll
      for (int nb = 0; nb < 2; ++nb) acc[mb][nb] = __builtin_amdgcn_mfma_f32_32x32x16_bf16(af[mb], bfr[nb], acc[mb][nb], 0, 0, 0);
  }
  u16* base = p.kvc() + (long)u * 32768 + wid * 64 + l31;
#pragma unroll
  for (int mb = 0; mb < 4; ++mb)
#pragma unroll
    for (int r = 0; r < 16; ++r) {
      const int dk = mb * 32 + (r & 3) + 8 * (r >> 2) + 4 * hh;
      u16* rp = base + dk * 256;
      rp[0] = f32_to_bf16(acc[mb][0][r]);
      rp[32] = f32_to_bf16(acc[mb][1][r]);
    }
}

__device__ __forceinline__ void gla_g2_unit(const Params& p, int u) {
  const int tid = opaque_tid();
  const int bh = u >> 5, part = u & 31;
  const int dk = part * 4 + (tid >> 6), dv = (tid & 63) * 4;
  float s0 = 0.f, s1 = 0.f, s2 = 0.f, s3 = 0.f;
  const long ebase = (long)dk * 256 + dv;
#pragma unroll 8
  for (int n = 0; n < 64; ++n) {
    const long un = (long)(bh * 64 + n);
    u32x2 kw = *(const u32x2*)(p.kvc() + un * 32768 + ebase);
    const float d = p.dec()[un * 128 + dk];
    u32x2 w = {pack_bf16(s0, s1), pack_bf16(s2, s3)};
    *(u32x2*)(p.sprev() + un * 32768 + ebase) = w;
    s0 = fmaf(d, s0, bf_lo(kw[0])); s1 = fmaf(d, s1, bf_hi(kw[0]));
    s2 = fmaf(d, s2, bf_lo(kw[1])); s3 = fmaf(d, s3, bf_hi(kw[1]));
  }
}

#define G3_LDS_BYTES (16384 + 16384 + 32768 + 65536 + 1024)
__device__ __forceinline__ void gla_g3_unit(const Params& p, char* smem, int u) {
  const int tid = opaque_tid(), lane = tid & 63, wid = tid >> 6, l31 = lane & 31, hh = lane >> 5;
  const int bh = u >> 6, n = u & 63, b = bh >> 2, h = bh & 3;
  const long t0 = (long)b * SEQ_ + n * 64;
  char* Qd = smem; char* Ki = smem + 16384; char* Vs = smem + 32768; char* Sp = smem + 65536; float* red = (float*)(smem + 131072);
  __syncthreads();
  {
    const int ch = tid & 15;
    const float qs = 0.08838834764831845f;
#pragma unroll
    for (int i = 0; i < 4; ++i) {
      const int tok = (i * 256 + tid) >> 4;
      const u16* pr = p.proj() + (t0 + tok) * NC_ + h * 128 + ch * 8;
      u32x4 qw = *(const u32x4*)(pr + C_GQ), kw = *(const u32x4*)(pr + C_GK);
      const float* bp = p.bcum() + (t0 + tok) * 512 + h * 128 + ch * 8;
      f32x4 b0 = *(const f32x4*)bp, b1 = *(const f32x4*)(bp + 4);
      float e[8] = {__expf(b0[0]), __expf(b0[1]), __expf(b0[2]), __expf(b0[3]), __expf(b1[0]), __expf(b1[1]), __expf(b1[2]), __expf(b1[3])};
      u32x4 wq, wk;
#pragma unroll
      for (int k = 0; k < 4; ++k) {
        wq[k] = pack_bf16(bf_lo(qw[k]) * qs * e[2 * k], bf_hi(qw[k]) * qs * e[2 * k + 1]);
        wk[k] = pack_bf16(bf_lo(kw[k]) / e[2 * k], bf_hi(kw[k]) / e[2 * k + 1]);
      }
      *(u32x4*)(Qd + off_b(tok, ch)) = wq;
      *(u32x4*)(Ki + off_b(tok, ch)) = wk;
    }
#pragma unroll
    for (int i = 0; i < 8; ++i) {
      const int pp = i * 256 + tid; const int tok = pp >> 5, c32 = pp & 31;
      u32x4 vw = *(const u32x4*)(p.proj() + (t0 + tok) * NC_ + C_GV + h * 256 + c32 * 8);
      *(u32x4*)(Vs + (c32 >> 4) * 16384 + off_b(tok, c32 & 15)) = vw;
    }
#pragma unroll
    for (int i = 0; i < 16; ++i) {
      const int pp = i * 256 + tid; const int dk = pp >> 5, c32 = pp & 31;
      u32x4 sw = *(const u32x4*)(p.sprev() + (long)u * 32768 + dk * 256 + c32 * 8);
      *(u32x4*)(Sp + (c32 >> 4) * 32768 + off_b(dk, c32 & 15)) = sw;
    }
  }
  __syncthreads();
  const int ib = wid & 1, dvh = wid >> 1;
  f32x16 sc[2];
#pragma unroll
  for (int jb = 0; jb < 2; ++jb) {
#pragma unroll
    for (int r = 0; r < 16; ++r) sc[jb][r] = 0.f;
    if (jb <= ib) {
#pragma unroll
      for (int ks = 0; ks < 8; ++ks) {
        bf16x8 a = *(const bf16x8*)(Ki + off_b(jb * 32 + l31, 2 * ks + hh));
        bf16x8 bq = *(const bf16x8*)(Qd + off_b(ib * 32 + l31, 2 * ks + hh));
        sc[jb] = __builtin_amdgcn_mfma_f32_32x32x16_bf16(a, bq, sc[jb], 0, 0, 0);
      }
#pragma unroll
      for (int r = 0; r < 16; ++r) {
        const int j = jb * 32 + (r & 3) + 8 * (r >> 2) + 4 * hh, i = ib * 32 + l31;
        if (j > i) sc[jb][r] = 0.f;
      }
    }
  }
  bf16x8 pf[4];
#pragma unroll
  for (int jb = 0; jb < 2; ++jb)
#pragma unroll
    for (int s2 = 0; s2 < 2; ++s2) {
      u32x4 w = {pack_bf16(sc[jb][8 * s2 + 0], sc[jb][8 * s2 + 1]), pack_bf16(sc[jb][8 * s2 + 2], sc[jb][8 * s2 + 3]),
                 pack_bf16(sc[jb][8 * s2 + 4], sc[jb][8 * s2 + 5]), pack_bf16(sc[jb][8 * s2 + 6], sc[jb][8 * s2 + 7])};
      pf[jb * 2 + s2] = *(bf16x8*)&w;
    }
  f32x16 o[4];
#pragma unroll
  for (int c = 0; c < 4; ++c)
#pragma unroll
    for (int r = 0; r < 16; ++r) o[c][r] = 0.f;
  const char* Vimg = Vs + dvh * 16384;
  const char* Simg = Sp + dvh * 32768;
#pragma unroll
  for (int c = 0; c < 4; ++c) {
#pragma unroll
    for (int kk = 0; kk < 4; ++kk) {
      if ((kk >> 1) <= ib) {
        const unsigned rbase = 32 * (kk >> 1) + 16 * (kk & 1) + 4 * hh;
        bf16x8 a = tr_frag(Vimg, lane, c, rbase, rbase + 8);
        o[c] = __builtin_amdgcn_mfma_f32_32x32x16_bf16(a, pf[kk], o[c], 0, 0, 0);
      }
    }
#pragma unroll
    for (int ks = 0; ks < 8; ++ks) {
      const unsigned r0 = 16 * ks + 8 * hh;
      bf16x8 a = tr_frag(Simg, lane, c, r0, r0 + 4);
      bf16x8 bq = *(const bf16x8*)(Qd + off_b(ib * 32 + l31, 2 * ks + hh));
      o[c] = __builtin_amdgcn_mfma_f32_32x32x16_bf16(a, bq, o[c], 0, 0, 0);
    }
  }
  float ss = 0.f;
#pragma unroll
  for (int c = 0; c < 4; ++c)
#pragma unroll
    for (int r = 0; r < 16; ++r) ss += o[c][r] * o[c][r];
  ss += shflx(ss, 32);
  if (hh == 0) red[dvh * 64 + ib * 32 + l31] = ss;
  __syncthreads();
  const float tot = red[ib * 32 + l31] + red[64 + ib * 32 + l31];
  const float rn = rsqrtf(tot * (1.0f / 256.0f) + EPS_);
  const long t = t0 + ib * 32 + l31;
  const u16* grp = p.proj() + t * NC_ + C_GR + h * 256 + dvh * 128 + 4 * hh;
  u16* op = p.mix() + t * 2048 + h * 256 + dvh * 128 + 4 * hh;
  const float* gp = p.gla_out_norm + dvh * 128 + 4 * hh;
#pragma unroll
  for (int c = 0; c < 4; ++c)
#pragma unroll
    for (int rg = 0; rg < 4; ++rg) {
      u32x2 gw = *(const u32x2*)(grp + 32 * c + 8 * rg);
      f32x4 g = *(const f32x4*)(gp + 32 * c + 8 * rg);
      float gr[4] = {bf_lo(gw[0]), bf_hi(gw[0]), bf_lo(gw[1]), bf_hi(gw[1])};
      float ov[4];
#pragma unroll
      for (int k = 0; k < 4; ++k) { float si = gr[k] / (1.0f + __expf(-gr[k])); ov[k] = o[c][4 * rg + k] * rn * g[k] * si; }
      u32x2 w = {pack_bf16(ov[0], ov[1]), pack_bf16(ov[2], ov[3])};
      *(u32x2*)(op + 32 * c + 8 * rg) = w;
    }
}

__device__ __forceinline__ void mla_norm_tokens(const Params& p) {
  const int tid_ = opaque_tid(); const int lane = tid_ & 63, wid = tid_ >> 6;
  for (int t = blockIdx.x * 4 + wid; t < T_; t += gridDim.x * 4) {
    const u16* src = p.omla() + (long)t * 1024;
    u32x4 a = *(const u32x4*)(src + lane * 8), b = *(const u32x4*)(src + 512 + lane * 8);
    float ss = 0.f;
#pragma unroll
    for (int k = 0; k < 4; ++k) { float x0 = bf_lo(a[k]), x1 = bf_hi(a[k]), y0 = bf_lo(b[k]), y1 = bf_hi(b[k]); ss += x0 * x0 + x1 * x1 + y0 * y0 + y1 * y1; }
    ss = wave_sum(ss);
    const float r = rsqrtf(ss * (1.0f / 1024.0f) + EPS_);
    const float* g = p.mla_out_norm;
    u32x4 wa, wb;
#pragma unroll
    for (int k = 0; k < 4; ++k) {
      wa[k] = pack_bf16(bf_lo(a[k]) * r * g[lane * 8 + 2 * k], bf_hi(a[k]) * r * g[lane * 8 + 2 * k + 1]);
      wb[k] = pack_bf16(bf_lo(b[k]) * r * g[512 + lane * 8 + 2 * k], bf_hi(b[k]) * r * g[512 + lane * 8 + 2 * k + 1]);
    }
    *(u32x4*)(p.mix() + (long)t * 2048 + 1024 + lane * 8) = wa;
    *(u32x4*)(p.mix() + (long)t * 2048 + 1024 + 512 + lane * 8) = wb;
  }
}
__device__ __forceinline__ void wout_tile(const Params& p, char* smem, int mt, int nt) {
  f32x16 acc[4][4];
  GemmTile t{};
  t.A = p.mix(); t.lda = 2048; t.aidx = nullptr; t.m0 = mt * 256; t.mvalid = 256;
  t.B0 = p.w_out + nt * 256; t.B1 = t.B0 + 128; t.ldb = 2048; t.nv0 = 128; t.nv1 = 128; t.kscale = nullptr; t.K = 2048;
  gemm_tile_256<4, false, false>(t, smem, acc);
  const long boff = (long)(mt * 256) * 2048 + nt * 256;
  acc_foreach_row<4>(acc, [&](int rowl, int coll, float (&v)[4]) {
    long o = boff + (long)rowl * 2048 + coll;
    OPAQUE(o);
    const float* xr = p.x + o; float* yr = p.x1() + o;
#pragma unroll
    for (int nb = 0; nb < 4; ++nb) { const int c = (nb >> 1) * 128 + (nb & 1) * 32; yr[c] = xr[c] + v[nb]; }
  });
}

#define P7_LDS_BYTES (4 * 32 * 33 * 4 + 4 * 64 * 4 + 32 * 33 * 4 + 128)
template <int DRY = 0>
__device__ __forceinline__ void ffn_prep_unit(const Params& p, char* smem, int u) {
  float* part = (float*)smem; float* ssq = part + 4 * 32 * 33; float* lg = ssq + 256; float* rs = lg + 32 * 33;
  const int tid = opaque_tid(), lane = tid & 63, wid = tid >> 6, l31 = lane & 31, hh = lane >> 5;
  __syncthreads();
  {
    const long t = (long)u * 32 + l31;
    const float* xr = p.x1() + t * 2048 + wid * 512;
    const float* gp = p.ffn_norm + wid * 512;
    const float* wp = p.router_w + (long)(wid * 512 + hh) * 32 + l31;
    f32x16 acc;
#pragma unroll
    for (int r = 0; r < 16; ++r) acc[r] = 0.f;
    float ss = 0.f;
#pragma unroll 4
    for (int m = 0; m < 128; ++m) {
      const f32x4 xv = *(const f32x4*)(xr + 4 * m);
      const f32x4 gv = *(const f32x4*)(gp + 4 * m);
      const float a0 = hh ? xv[1] : xv[0], a1 = hh ? xv[3] : xv[2];
      const float g0 = hh ? gv[1] : gv[0], g1 = hh ? gv[3] : gv[2];
      const float b0 = wp[(4 * m) * 32], b1 = wp[(4 * m + 2) * 32];
      ss += a0 * a0 + a1 * a1;
      acc = __builtin_amdgcn_mfma_f32_32x32x2f32(a0 * g0, b0, acc, 0, 0, 0);
      acc = __builtin_amdgcn_mfma_f32_32x32x2f32(a1 * g1, b1, acc, 0, 0, 0);
    }
#pragma unroll
    for (int r = 0; r < 16; ++r) part[(wid * 32 + (r & 3) + 8 * (r >> 2) + 4 * hh) * 33 + l31] = acc[r];
    ssq[wid * 64 + lane] = ss;
  }
  __syncthreads();
  {
    const int tl = tid >> 3, seg = tid & 7;
    if (seg == 0) {
      float s = 0.f;
#pragma unroll
      for (int w = 0; w < 4; ++w) s += ssq[w * 64 + tl] + ssq[w * 64 + 32 + tl];
      rs[tl] = rsqrtf(s * (1.0f / 2048.0f) + EPS_);
    }
  }
  __syncthreads();
  {
    const int tl = tid >> 3, seg = tid & 7;
    const float r = rs[tl];
#pragma unroll
    for (int c = 0; c < 4; ++c) {
      const int e = seg * 4 + c;
      const float s = part[(0 * 32 + tl) * 33 + e] + part[(1 * 32 + tl) * 33 + e] + part[(2 * 32 + tl) * 33 + e] + part[(3 * 32 + tl) * 33 + e];
      lg[tl * 33 + e] = s * r + p.router_b[e];
    }
  }
  __syncthreads();
  if (tid < 32 && !DRY) {
    const long tt = (long)u * 32 + tid;
    const float* L = lg + tid * 33;
    unsigned used = 0u; int i0 = 0, i1 = 0, i2 = 0, i3 = 0; float v0 = 0.f, v1 = 0.f, v2 = 0.f, v3 = 0.f;
#pragma unroll
    for (int k = 0; k < 4; ++k) {
      int bi = -1; float bv = 0.f;
      for (int i = 0; i < 32; ++i) {
        const float x = L[i];
        const bool take = !((used >> i) & 1u) && (bi < 0 || x > bv);
        bi = take ? i : bi; bv = take ? x : bv;
      }
      used |= 1u << bi;
      if (k == 0) { i0 = bi; v0 = bv; } else if (k == 1) { i1 = bi; v1 = bv; } else if (k == 2) { i2 = bi; v2 = bv; } else { i3 = bi; v3 = bv; }
    }
    const float e0 = 1.0f, e1 = __expf(v1 - v0), e2 = __expf(v2 - v0), e3 = __expf(v3 - v0);
    const float inv = 1.0f / (e0 + e1 + e2 + e3);
    const int s0 = atomicAdd(&p.counts()[i0], 1), s1 = atomicAdd(&p.counts()[i1], 1), s2 = atomicAdd(&p.counts()[i2], 1), s3 = atomicAdd(&p.counts()[i3], 1);
    p.list()[i0 * T_ + s0] = (int)tt; p.list()[i1 * T_ + s1] = (int)tt; p.list()[i2 * T_ + s2] = (int)tt; p.list()[i3 * T_ + s3] = (int)tt;
    p.asg_e()[tt * 4 + 0] = i0; p.asg_e()[tt * 4 + 1] = i1; p.asg_e()[tt * 4 + 2] = i2; p.asg_e()[tt * 4 + 3] = i3;
    p.asg_slot()[tt * 4 + 0] = s0; p.asg_slot()[tt * 4 + 1] = s1; p.asg_slot()[tt * 4 + 2] = s2; p.asg_slot()[tt * 4 + 3] = s3;
    p.asg_g()[tt * 4 + 0] = e0 * inv; p.asg_g()[tt * 4 + 1] = e1 * inv; p.asg_g()[tt * 4 + 2] = e2 * inv; p.asg_g()[tt * 4 + 3] = e3 * inv;
  }
  {
    const int tl = tid >> 3, seg = tid & 7;
    const long t = (long)u * 32 + tl;
    const float* xr = p.x1() + t * 2048;
    const float rr = rs[tl];
#pragma unroll 8
    for (int it = 0; it < 32; ++it) {
      const int kk = it * 64 + seg * 8;
      f32x4 v0 = *(const f32x4*)(xr + kk), v1 = *(const f32x4*)(xr + kk + 4);
      f32x4 g0 = *(const f32x4*)(p.ffn_norm + kk), g1 = *(const f32x4*)(p.ffn_norm + kk + 4);
      v0 = v0 * g0 * rr; v1 = v1 * g1 * rr;
#if MOEQ == 0
      u32x4 w = {pack_bf16(v0[0], v0[1]), pack_bf16(v0[2], v0[3]), pack_bf16(v1[0], v1[1]), pack_bf16(v1[2], v1[3])};
      *(u32x4*)(p.h2() + t * 2048 + kk) = w;
#else
      int q0 = 0, q1 = 0;
      q0 = __builtin_amdgcn_cvt_pk_fp8_f32(v0[0], v0[1], q0, false);
      q0 = __builtin_amdgcn_cvt_pk_fp8_f32(v0[2], v0[3], q0, true);
      q1 = __builtin_amdgcn_cvt_pk_fp8_f32(v1[0], v1[1], q1, false);
      q1 = __builtin_amdgcn_cvt_pk_fp8_f32(v1[2], v1[3], q1, true);
      u32x2 wq = {(unsigned)q0, (unsigned)q1};
      *(u32x2*)(p.h2q() + t * 2048 + kk) = wq;
#endif
    }
  }
}

__device__ __forceinline__ void moe_setup(const Params& p, int* mo) {
  __syncthreads();
  if (threadIdx.x == 0) {
    int s = 0;
    for (int e = 0; e < NE_; ++e) { mo[e] = s; s += (p.counts()[e] + 255) >> 8; }
    mo[NE_] = s;
  }
  __syncthreads();
}
#ifndef MAPV
#define MAPV 0
#endif
__device__ __forceinline__ int xcd_unit(int round) { return MAPV ? (round * 256 + blockIdx.x) : (round * 256 + (blockIdx.x & 7) * 32 + (blockIdx.x >> 3)); }

__device__ __forceinline__ void moe1_tile(const Params& p, char* smem, const int* mo, int e, int nt, int mt) {
  f32x16 acc[4][4];
  GemmTile t{};
  const int cnt = p.counts()[e];
  t.A = p.h2(); t.lda = 2048; t.aidx = p.list() + e * T_ + mt * 256; t.m0 = 0; t.mvalid = min(256, cnt - mt * 256);
  t.B0 = p.w_gu + (long)e * 2048 * 4096 + nt * 128; t.B1 = t.B0 + 2048; t.ldb = 4096; t.nv0 = 128; t.nv1 = 128; t.kscale = nullptr; t.K = 2048;
  gemm_tile_256<4, false, true>(t, smem, acc);
  u16* base = p.act() + (long)(mo[e] * 256 + mt * 256) * 2048 + nt * 128;
  const float* bg = p.b_gu + e * 4096 + nt * 128; const float* bu = bg + 2048;
  const int tq_ = opaque_tid(); const int cl = (tq_ >> 6 & 1) * 64 + (tq_ & 31);
  const float bgv[2] = {bg[cl], bg[cl + 32]}, buv[2] = {bu[cl], bu[cl + 32]};
  acc_foreach_row<4>(acc, [&](int rowl, int coll, float (&v)[4]) {
    u16* rp = base + (long)rowl * 2048 + coll;
    OPAQUE(rp);
#pragma unroll
    for (int nb = 0; nb < 2; ++nb) {
      const int c = nb * 32;
      float g = fminf(v[nb] + bgv[nb], 7.0f);
      float uu = fminf(fmaxf(v[nb + 2] + buv[nb], -7.0f), 7.0f);
      float a = (uu + 1.0f) * (g / (1.0f + __expf(-1.702f * g)));
      rp[c] = f32_to_bf16(a);
    }
  });
}
__device__ __forceinline__ void moe2_tile(const Params& p, char* smem, const int* mo, int e, int nt, int mt) {
  f32x16 acc[4][4];
  GemmTile t{};
  t.A = p.act(); t.lda = 2048; t.aidx = nullptr; t.m0 = mo[e] * 256 + mt * 256; t.mvalid = 256;
  t.B0 = p.w_dn + (long)e * 2048 * 2048 + nt * 256; t.B1 = t.B0 + 128; t.ldb = 2048; t.nv0 = 128; t.nv1 = 128; t.kscale = nullptr; t.K = 2048;
  gemm_tile_256<4, false, false>(t, smem, acc);
  u16* base = p.ybuf() + (long)t.m0 * 2048 + nt * 256;
  const float* bd = p.b_dn + e * 2048 + nt * 256;
  const int tq_ = opaque_tid(); const int cl = (tq_ >> 6 & 1) * 64 + (tq_ & 31);
  const float bdv[4] = {bd[cl], bd[cl + 32], bd[cl + 128], bd[cl + 160]};
  acc_foreach_row<4>(acc, [&](int rowl, int coll, float (&v)[4]) {
    u16* rp = base + (long)rowl * 2048 + coll;
    OPAQUE(rp);
#pragma unroll
    for (int nb = 0; nb < 4; ++nb) { const int c = (nb >> 1) * 128 + (nb & 1) * 32; rp[c] = f32_to_bf16(v[nb] + bdv[nb]); }
  });
}
template <int WHICH, int HALF = 0>
__device__ __forceinline__ void ph_moe(const Params& p, char* smem) {
  int* mo = (int*)(smem + G_LDS_BYTES);
  moe_setup(p, mo);
  const int NT = (WHICH == 1) ? 16 : 8;
  const int total = mo[NE_] * NT;
  if (HALF && ((blockIdx.x >> 3) & 1)) return;
  const int W = HALF ? 128 : 256;
  for (int round = 0;; ++round) {
    const int u = HALF ? (round * 128 + (blockIdx.x & 7) * 16 + (blockIdx.x >> 4)) : xcd_unit(round);
    if (round * W >= total) break;
    if (u >= total) continue;
    int e = 0;
    while (mo[e + 1] * NT <= u) ++e;
    const int local = u - mo[e] * NT, me = mo[e + 1] - mo[e];
    const int nt = local / me, mt = local - nt * me;
    if (WHICH == 1) moe1_tile(p, smem, mo, e, nt, mt); else moe2_tile(p, smem, mo, e, nt, mt);
  }
}

__device__ __forceinline__ void ph_final(const Params& p, char* smem, float dbg_scale = 1.0f) {
  int* mo = (int*)(smem + G_LDS_BYTES);
  moe_setup(p, mo);
  const int tid_ = opaque_tid(); const int lane = tid_ & 63, wid = tid_ >> 6;
  for (int t = blockIdx.x * 4 + wid; t < T_; t += gridDim.x * 4) {
    long rows[4]; float gg[4];
#pragma unroll
    for (int k = 0; k < 4; ++k) { rows[k] = (long)(mo[p.asg_e()[t * 4 + k]] * 256 + p.asg_slot()[t * 4 + k]) * 2048; gg[k] = p.asg_g()[t * 4 + k]; }
    f32x4 v[8]; float ss = 0.f;
#pragma unroll
    for (int j = 0; j < 8; ++j) {
      const int c = j * 256 + lane * 4;
      f32x4 a = *(const f32x4*)(p.x1() + (long)t * 2048 + c);
#pragma unroll
      for (int k = 0; k < 4; ++k) {
        u32x2 w = *(const u32x2*)(p.ybuf() + rows[k] + c);
        a[0] += gg[k] * bf_lo(w[0]); a[1] += gg[k] * bf_hi(w[0]); a[2] += gg[k] * bf_lo(w[1]); a[3] += gg[k] * bf_hi(w[1]);
      }
      v[j] = a; ss += a[0] * a[0] + a[1] * a[1] + a[2] * a[2] + a[3] * a[3];
    }
    ss = wave_sum(ss);
    const float r = rsqrtf(ss * (1.0f / 2048.0f) + EPS_);
#pragma unroll
    for (int j = 0; j < 8; ++j) {
      const int c = j * 256 + lane * 4;
      f32x4 g = *(const f32x4*)(p.final_norm + c);
      f32x4 o = {v[j][0] * r * g[0] * dbg_scale, v[j][1] * r * g[1] * dbg_scale, v[j][2] * r * g[2] * dbg_scale, v[j][3] * r * g[3] * dbg_scale};
      *(f32x4*)(p.out + (long)t * 2048 + c) = o;
    }
  }
}
#define WSCALE_  128.0f
#define WISCALE_ 0.0078125f
typedef unsigned char u8;

struct CvtUnit { const float* src; u8* dst; int ldn; };
__device__ __forceinline__ CvtUnit cvt8_decode(const Params& p, int u) {
  CvtUnit c;
  if (u < 16384) {
    const int e = u >> 9, kt = (u >> 5) & 15, nt = u & 31;
    c.src = p.w_gu + (long)e * 2048 * 4096 + (long)(kt * 128) * 4096 + nt * 128; c.ldn = 4096;
    c.dst = p.wq_gu() + ((long)e * 4096 + nt * 128) * 2048 + kt * 256;
  } else {
    const int v = u - 16384; const int e = v >> 8, kt = (v >> 4) & 15, nt = v & 15;
    c.src = p.w_dn + (long)e * 2048 * 2048 + (long)(kt * 128) * 2048 + nt * 128; c.ldn = 2048;
    c.dst = p.wq_dn() + ((long)e * 2048 + nt * 128) * 2048 + kt * 256;
  }
  return c;
}
__device__ __forceinline__ void cvt8_load(const CvtUnit& c, int kq, int n4, f32x4 (&v)[16]) {
  const float* src = c.src + (long)(kq * 16) * c.ldn + n4 * 4;
#pragma unroll
  for (int j = 0; j < 16; ++j) {
    const float* ptr = src + (long)j * c.ldn;
    asm volatile("global_load_dwordx4 %0, %1, off" : "=v"(v[j]) : "v"(ptr) : "memory");
  }
}
#define CVT_WAIT(N, v) asm volatile("s_waitcnt vmcnt(%16)" : "+v"(v[0]), "+v"(v[1]), "+v"(v[2]), "+v"(v[3]), "+v"(v[4]), "+v"(v[5]), "+v"(v[6]), "+v"(v[7]), \
    "+v"(v[8]), "+v"(v[9]), "+v"(v[10]), "+v"(v[11]), "+v"(v[12]), "+v"(v[13]), "+v"(v[14]), "+v"(v[15]) : "n"(N) : "memory")
__device__ __forceinline__ void cvt8_emit(const CvtUnit& c, int tid, int kq, int n4, f32x4 (&v)[16], char* T) {
  const int lane = tid & 63, w = tid >> 6;
  char* Tw = T + w * 4096;
#pragma unroll
  for (int cc = 0; cc < 4; ++cc) {
    u32x4 x4;
#pragma unroll
    for (int q = 0; q < 4; ++q) {
      int x = 0;
      x = __builtin_amdgcn_cvt_pk_fp8_f32(v[4 * q][cc] * WSCALE_, v[4 * q + 1][cc] * WSCALE_, x, false);
      x = __builtin_amdgcn_cvt_pk_fp8_f32(v[4 * q + 2][cc] * WSCALE_, v[4 * q + 3][cc] * WSCALE_, x, true);
      x4[q] = (unsigned)x;
    }
    *(u32x4*)(Tw + (((n4 & 7) * 4 + cc) * 128) + kq * 16) = x4;
  }
#pragma unroll
  for (int i = 0; i < 4; ++i) {
    const int rl = (lane >> 3) + 8 * i, ch = lane & 7;
    const int n = 32 * w + rl;
    *(u32x4*)(c.dst + (long)(n >> 1) * 4096 + (ch >> 2) * 128 + (n & 1) * 64 + (ch & 3) * 16) = *(const u32x4*)(Tw + rl * 128 + ch * 16);
  }
}
__device__ __forceinline__ void convert_units(const Params& p, char* smem, int first, int stride, int count) {
  const int tid = opaque_tid();
  const int kq = tid & 7, n4 = tid >> 3;
  if (count <= 0) return;
  f32x4 va[16], vb[16], vc[16];
  CvtUnit ca = cvt8_decode(p, first), cb = cvt8_decode(p, first + stride), cc = cvt8_decode(p, first + 2 * stride);
  cvt8_load(ca, kq, n4, va);
  cvt8_load(cb, kq, n4, vb);
  cvt8_load(cc, kq, n4, vc);
  CVT_WAIT(32, va); cvt8_emit(ca, tid, kq, n4, va, smem); ca = cvt8_decode(p, first + 3 * stride); cvt8_load(ca, kq, n4, va);
  CVT_WAIT(36, vb); cvt8_emit(cb, tid, kq, n4, vb, smem); cb = cvt8_decode(p, first + 4 * stride); cvt8_load(cb, kq, n4, vb);
  CVT_WAIT(40, vc); cvt8_emit(cc, tid, kq, n4, vc, smem); cc = cvt8_decode(p, first + 5 * stride); cvt8_load(cc, kq, n4, vc);
  for (int i = 3; i + 3 < count; i += 3) {
    CVT_WAIT(40, va); cvt8_emit(ca, tid, kq, n4, va, smem); ca = cvt8_decode(p, first + (i + 3) * stride); cvt8_load(ca, kq, n4, va);
    CVT_WAIT(40, vb); cvt8_emit(cb, tid, kq, n4, vb, smem); cb = cvt8_decode(p, first + (i + 4) * stride); cvt8_load(cb, kq, n4, vb);
    CVT_WAIT(40, vc); cvt8_emit(cc, tid, kq, n4, vc, smem); cc = cvt8_decode(p, first + (i + 5) * stride); cvt8_load(cc, kq, n4, vc);
  }
  CVT_WAIT(0, va); cvt8_emit(ca, tid, kq, n4, va, smem);
  CVT_WAIT(0, vb); cvt8_emit(cb, tid, kq, n4, vb, smem);
  CVT_WAIT(0, vc); cvt8_emit(cc, tid, kq, n4, vc, smem);
}
__device__ __forceinline__ void convert_one(const Params& p, char* smem, int u) {
  const int tid = opaque_tid();
  const int kq = tid & 7, n4 = tid >> 3;
  f32x4 va[16];
  CvtUnit ca = cvt8_decode(p, u);
  cvt8_load(ca, kq, n4, va);
  CVT_WAIT(0, va); cvt8_emit(ca, tid, kq, n4, va, smem);
}
__device__ __forceinline__ void ph_convert(const Params& p, char* smem) {
  convert_units(p, smem, blockIdx.x, gridDim.x, 24576 / 256);
}
__device__ __forceinline__ void ph_convert_gu(const Params& p, char* smem, int part, int nparts) {
  (void)part; (void)nparts;
  convert_units(p, smem, blockIdx.x, 256, 63);
  convert_one(p, smem, blockIdx.x + 63 * 256);
}
__device__ __forceinline__ void ph_convert_dn(const Params& p, char* smem) {
  convert_units(p, smem, 16384 + blockIdx.x, 256, 30);
  convert_one(p, smem, 16384 + blockIdx.x + 30 * 256);
  convert_one(p, smem, 16384 + blockIdx.x + 31 * 256);
}

#define R_STAGE 32768
struct GemmRTile {
  const u8* A; int lda; const int* aidx; int m0, mvalid;
  const u8* B; long brow0, brow1; int ldb;
  int pairb;
  int paira;
  int KB;
};
template <bool FP8, bool GATHER>
__device__ __forceinline__ void gemmr_tile_256(const GemmRTile& t, char* smem, f32x16 (&acc)[4][4]) {
  int tz0 = threadIdx.x; asm volatile("" : "+v"(tz0));
  const int tid = tz0, lane = tid & 63, wid = tid >> 6, wr = wid >> 1, wc = wid & 1;
  const int l31 = lane & 31, hh = lane >> 5;
#pragma unroll
  for (int i = 0; i < 4; ++i)
#pragma unroll
    for (int j = 0; j < 4; ++j)
#pragma unroll
      for (int r = 0; r < 16; ++r) acc[i][j][r] = 0.f;
  const int c_src = (tid & 3) ^ ((tid >> 4) & 3);
  const u8* a_src[GATHER ? 4 : 1];
  if (GATHER) {
#pragma unroll
    for (int i = 0; i < (GATHER ? 4 : 1); ++i) {
      int r = (tid >> 2) + 64 * i;
      int rr = r < t.mvalid ? r : 0;
      a_src[i] = t.A + (long)t.aidx[rr] * t.lda + c_src * 16;
    }
  } else {
    a_src[0] = t.A + (long)(t.m0 + (tid >> 2)) * t.lda + c_src * 16;
  }
  const long a_step = 64L * t.lda, b_step = 64L * t.ldb;
  const u8* b_src0 = t.B + (t.brow0 + (tid >> 2)) * t.ldb + c_src * 16;
  const u8* b_src1 = t.B + (t.brow1 + (tid >> 2)) * t.ldb + c_src * 16;
  const unsigned lds0 = (unsigned)(size_t)smem + (unsigned)__builtin_amdgcn_readfirstlane(wid) * 1024u;
  auto issue = [&](int kt, int sl, int q) {
    if (q < 4) glds16_asm((const void*)((GATHER ? a_src[GATHER ? q : 0] : a_src[0] + q * a_step) + kt * 64), lds0 + sl * R_STAGE + q * 4096);
    else { const int i = q - 4; glds16_asm((const void*)((i < 2 ? b_src0 + i * b_step : b_src1 + (i - 2) * b_step) + kt * 64), lds0 + sl * R_STAGE + 16384 + i * 4096); }
  };
  unsigned a_rd[2], b_rd[2];
#pragma unroll
  for (int s2 = 0; s2 < 2; ++s2) {
    const int ra = wr * 128 + l31, rb = wc * 64 + l31;
    a_rd[s2] = ra * 64 + (((2 * s2 + hh) ^ ((ra >> 2) & 3)) * 16);
    b_rd[s2] = rb * 64 + (((2 * s2 + hh) ^ ((rb >> 2) & 3)) * 16);
  }
  auto load_frags = [&](const char* St, int s2, u32x4 (&af)[4], u32x4 (&bf)[4]) {
#pragma unroll
    for (int mb = 0; mb < 4; ++mb) af[mb] = *(const u32x4*)(St + a_rd[s2] + mb * 2048);
#pragma unroll
    for (int nb = 0; nb < 4; ++nb) bf[nb] = *(const u32x4*)(St + 16384 + b_rd[s2] + (nb >> 1) * 8192 + (nb & 1) * 2048);
  };
  auto mma = [&](u32x4 (&ac)[4], u32x4 (&bc)[4], int nb) {
    if (FP8) {
#pragma unroll
      for (int u = 0; u < 2; ++u) {
        const long bl = (long)(((unsigned long long)bc[nb][2 * u + 1] << 32) | bc[nb][2 * u]);
#pragma unroll
        for (int mb = 0; mb < 4; ++mb) {
          const long al = (long)(((unsigned long long)ac[mb][2 * u + 1] << 32) | ac[mb][2 * u]);
          acc[mb][nb] = __builtin_amdgcn_mfma_f32_32x32x16_fp8_fp8(al, bl, acc[mb][nb], 0, 0, 0);
        }
      }
    } else {
      const bf16x8 bb = *(const bf16x8*)&bc[nb];
#pragma unroll
      for (int mb = 0; mb < 4; ++mb) acc[mb][nb] = __builtin_amdgcn_mfma_f32_32x32x16_bf16(*(const bf16x8*)&ac[mb], bb, acc[mb][nb], 0, 0, 0);
    }
  };
  u32x4 a0[4], b0[4], a1[4], b1[4];
  auto half0 = [&](int kt, bool issueA) {
    const char* St = smem + (kt & 3) * R_STAGE;
    load_frags(St, 1, a1, b1);
    __builtin_amdgcn_sched_barrier(0);
#pragma unroll
    for (int nb = 0; nb < 4; ++nb) {
      mma(a0, b0, nb);
      __builtin_amdgcn_sched_barrier(0);
      if (issueA) issue(kt + 2, (kt + 2) & 3, 4 + nb);
      __builtin_amdgcn_sched_barrier(0);
    }
  };
  auto half1 = [&](int kt, bool has1, bool issueB) {
    const char* Sn = smem + ((kt + 1) & 3) * R_STAGE;
    if (has1) load_frags(Sn, 0, a0, b0);
    __builtin_amdgcn_sched_barrier(0);
#pragma unroll
    for (int nb = 0; nb < 4; ++nb) {
      mma(a1, b1, nb);
      __builtin_amdgcn_sched_barrier(0);
      if (issueB) issue(kt + 3, (kt + 3) & 3, nb);
      __builtin_amdgcn_sched_barrier(0);
    }
  };
  const int nk = t.KB >> 6;
  __syncthreads();
#pragma unroll
  for (int q = 0; q < 8; ++q) issue(0, 0, q);
#pragma unroll
  for (int q = 0; q < 8; ++q) issue(1, 1, q);
#pragma unroll
  for (int q = 0; q < 4; ++q) issue(2, 2, q);
  asm volatile("s_waitcnt vmcnt(12)" ::: "memory");
  __syncthreads();
  load_frags(smem, 0, a0, b0);
  for (int kt = 0; kt < nk - 3; ++kt) {
    half0(kt, true);
    asm volatile("s_waitcnt vmcnt(8)" ::: "memory");
    __syncthreads();
    half1(kt, true, true);
  }
  half0(nk - 3, true);
  asm volatile("s_waitcnt vmcnt(8)" ::: "memory");
  __syncthreads();
  half1(nk - 3, true, false);
  half0(nk - 2, false);
  asm volatile("s_waitcnt vmcnt(0)" ::: "memory");
  __syncthreads();
  half1(nk - 2, true, false);
  half0(nk - 1, false);
  half1(nk - 1, false, false);
}


typedef int i32x8 __attribute__((ext_vector_type(8)));
template <bool GATHER>
__device__ __forceinline__ void gemmrs_tile_256(const GemmRTile& t, char* smem, f32x16 (&acc)[4][4]) {
  int tz0 = threadIdx.x; asm volatile("" : "+v"(tz0));
  const int tid = tz0, lane = tid & 63, wid = tid >> 6, wr = wid >> 1, wc = wid & 1;
  const int l31 = lane & 31, hh = lane >> 5;
#pragma unroll
  for (int i = 0; i < 4; ++i)
#pragma unroll
    for (int j = 0; j < 4; ++j)
#pragma unroll
      for (int r = 0; r < 16; ++r) acc[i][j][r] = 0.f;
  const int c_src = (tid & 3) ^ ((tid >> 4) & 3);
  const u8* a_src[GATHER ? 4 : 1];
  if (GATHER) {
#pragma unroll
    for (int i = 0; i < (GATHER ? 4 : 1); ++i) {
      int r = (tid >> 2) + 64 * i;
      int rr = r < t.mvalid ? r : 0;
      a_src[i] = t.A + (long)t.aidx[rr] * t.lda + c_src * 16;
    }
  } else {
    a_src[0] = t.A + ((long)(t.m0 + (tid >> 2)) >> 1) * 4096 + ((tid >> 2) & 1) * 64 + c_src * 16;
  }
  const long a_step = GATHER ? 64L * t.lda : 32L * 4096, b_step = 32L * 4096;
  const int a_kstep = GATHER ? 64 : 128;
  const int brl = tid >> 2;
  const u8* b_src0 = t.B + ((t.brow0 + brl) >> 1) * 4096 + (brl & 1) * 64 + c_src * 16;
  const u8* b_src1 = t.B + ((t.brow1 + brl) >> 1) * 4096 + (brl & 1) * 64 + c_src * 16;
  const unsigned lds0 = (unsigned)(size_t)smem + (unsigned)__builtin_amdgcn_readfirstlane(wid) * 1024u;
  auto issue = [&](int kt, int sl, int q) {
    if (q < 4) glds16_asm((const void*)((GATHER ? a_src[GATHER ? q : 0] : a_src[0] + q * a_step) + kt * a_kstep), lds0 + sl * R_STAGE + q * 4096);
    else { const int i = q - 4; glds16_asm((const void*)((i < 2 ? b_src0 + i * b_step : b_src1 + (i - 2) * b_step) + kt * 128), lds0 + sl * R_STAGE + 16384 + i * 4096); }
  };
  unsigned a_rd[2], b_rd[2];
#pragma unroll
  for (int c = 0; c < 2; ++c) {
    const int ra = wr * 128 + l31, rb = wc * 64 + l31;
    a_rd[c] = ra * 64 + (((2 * hh + c) ^ ((ra >> 2) & 3)) * 16);
    b_rd[c] = rb * 64 + (((2 * hh + c) ^ ((rb >> 2) & 3)) * 16);
  }
  auto load_a = [&](const char* St, i32x8 (&af)[4]) {
#pragma unroll
    for (int mb = 0; mb < 4; ++mb) {
      const u32x4 lo = *(const u32x4*)(St + a_rd[0] + mb * 2048), hi = *(const u32x4*)(St + a_rd[1] + mb * 2048);
      af[mb] = (i32x8){(int)lo[0], (int)lo[1], (int)lo[2], (int)lo[3], (int)hi[0], (int)hi[1], (int)hi[2], (int)hi[3]};
    }
  };
  auto load_b = [&](const char* St, int nb, i32x8& bf) {
    const char* bp = St + 16384 + (nb >> 1) * 8192 + (nb & 1) * 2048;
    const u32x4 lo = *(const u32x4*)(bp + b_rd[0]), hi = *(const u32x4*)(bp + b_rd[1]);
    bf = (i32x8){(int)lo[0], (int)lo[1], (int)lo[2], (int)lo[3], (int)hi[0], (int)hi[1], (int)hi[2], (int)hi[3]};
  };
  auto mma4 = [&](i32x8 (&af)[4], i32x8& bf, int nb) {
#pragma unroll
    for (int mb = 0; mb < 4; ++mb)
      acc[mb][nb] = __builtin_amdgcn_mfma_scale_f32_32x32x64_f8f6f4(af[mb], bf, acc[mb][nb], 0, 0, 0, 0x7f7f7f7f, 0, 0x7f7f7f7f);
  };
  i32x8 aA[4], aB[4], bq[4];
  auto half0 = [&](int kt, i32x8 (&ac)[4], bool issueA) {
    const char* St = smem + (kt & 3) * R_STAGE;
    load_b(St, 2, bq[2]); load_b(St, 3, bq[3]);
    __builtin_amdgcn_sched_barrier(0);
#pragma unroll
    for (int nb = 0; nb < 2; ++nb) {
      mma4(ac, bq[nb], nb);
      __builtin_amdgcn_sched_barrier(0);
      if (issueA) { issue(kt + 2, (kt + 2) & 3, 4 + 2 * nb); issue(kt + 2, (kt + 2) & 3, 5 + 2 * nb); }
      __builtin_amdgcn_sched_barrier(0);
    }
  };
  auto half1 = [&](int kt, i32x8 (&ac)[4], i32x8 (&an)[4], bool has1, bool issueB) {
    const char* Sn = smem + ((kt + 1) & 3) * R_STAGE;
    if (has1) { load_a(Sn, an); load_b(Sn, 0, bq[0]); load_b(Sn, 1, bq[1]); }
    __builtin_amdgcn_sched_barrier(0);
#pragma unroll
    for (int nb = 2; nb < 4; ++nb) {
      mma4(ac, bq[nb], nb);
      __builtin_amdgcn_sched_barrier(0);
      if (issueB) { issue(kt + 3, (kt + 3) & 3, 2 * (nb - 2)); issue(kt + 3, (kt + 3) & 3, 2 * (nb - 2) + 1); }
      __builtin_amdgcn_sched_barrier(0);
    }
  };
  const int nk = t.KB >> 6;
  __syncthreads();
#pragma unroll
  for (int q = 0; q < 8; ++q) issue(0, 0, q);
#pragma unroll
  for (int q = 0; q < 8; ++q) issue(1, 1, q);
#pragma unroll
  for (int q = 0; q < 4; ++q) issue(2, 2, q);
  asm volatile("s_waitcnt vmcnt(12)" ::: "memory");
  __syncthreads();
  load_a(smem, aA); load_b(smem, 0, bq[0]); load_b(smem, 1, bq[1]);
  for (int kt = 0; kt < nk - 4; kt += 2) {
    half0(kt, aA, true);
    asm volatile("s_waitcnt vmcnt(8)" ::: "memory"); __syncthreads();
    half1(kt, aA, aB, true, true);
    half0(kt + 1, aB, true);
    asm volatile("s_waitcnt vmcnt(8)" ::: "memory"); __syncthreads();
    half1(kt + 1, aB, aA, true, true);
  }
  half0(nk - 4, aA, true);
  asm volatile("s_waitcnt vmcnt(8)" ::: "memory"); __syncthreads();
  half1(nk - 4, aA, aB, true, true);
  half0(nk - 3, aB, true);
  asm volatile("s_waitcnt vmcnt(8)" ::: "memory"); __syncthreads();
  half1(nk - 3, aB, aA, true, false);
  half0(nk - 2, aA, false);
  asm volatile("s_waitcnt vmcnt(0)" ::: "memory"); __syncthreads();
  half1(nk - 2, aA, aB, true, false);
  half0(nk - 1, aB, false);
  half1(nk - 1, aB, aA, false, false);
}

__device__ __forceinline__ void cvt16_tile(const float* W, int col0, int ldn, int nvalid  , const float* kgain,
                                           u16* out  , int ldk, char* T) {
  const int tid = opaque_tid();
  const int kq = tid & 7, n4 = tid >> 3;
  f32x4 v[16];
  const bool ok = (n4 * 4) < nvalid;
  const float* src = W + (long)(kq * 16) * ldn + (ok ? n4 * 4 : -col0);
#pragma unroll
  for (int j = 0; j < 16; ++j) v[j] = *(const f32x4*)(src + (long)j * ldn);
  if (kgain) {
#pragma unroll
    for (int j = 0; j < 16; ++j) v[j] *= kgain[kq * 16 + j];
  }
  if (!ok) {
#pragma unroll
    for (int j = 0; j < 16; ++j) v[j] = (f32x4){0.f, 0.f, 0.f, 0.f};
  }
  __syncthreads();
#pragma unroll
  for (int c = 0; c < 4; ++c) {
    u32x4 w0, w1;
#pragma unroll
    for (int q = 0; q < 4; ++q) { w0[q] = pack_bf16(v[2 * q][c], v[2 * q + 1][c]); w1[q] = pack_bf16(v[8 + 2 * q][c], v[8 + 2 * q + 1][c]); }
    *(u32x4*)(T + (n4 * 4 + c) * 256 + kq * 32) = w0;
    *(u32x4*)(T + (n4 * 4 + c) * 256 + kq * 32 + 16) = w1;
  }
  __syncthreads();
#pragma unroll
  for (int i = 0; i < 8; ++i) {
    const int n = (tid >> 4) + 16 * i, ch = tid & 15;
    *(u32x4*)((char*)(out + (long)n * ldk) + ch * 16) = *(const u32x4*)(T + n * 256 + ch * 16);
  }
}
__device__ __forceinline__ void ph_convert_dense(const Params& p, char* smem) {
  for (int u = blockIdx.x; u < 912; u += gridDim.x) {
    if (u < 544) { const int kt = u / 34, nt = u % 34; const int nv = NC_ - nt * 128;
      cvt16_tile(p.w_in + (long)(kt * 128) * NC_ + nt * 128, nt * 128, NC_, nv < 0 ? 0 : nv, nullptr, p.wb_in() + (long)(nt * 128) * 2048 + kt * 128, 2048, smem);
    } else if (u < 592) { const int v = u - 544; const int kt = v / 12, nt = v % 12;
      cvt16_tile(p.w_uq + (long)(kt * 128) * 1536 + nt * 128, nt * 128, 1536, 128, p.q_norm + kt * 128, p.wb_uq() + (long)(nt * 128) * 512 + kt * 128, 512, smem);
    } else if (u < 656) { const int v = u - 592; const int kt = v >> 4, nt = v & 15;
      cvt16_tile(p.w_ukv + (long)(kt * 128) * 2048 + nt * 128, nt * 128, 2048, 128, p.kv_norm + kt * 128, p.wb_ukv() + (long)(nt * 128) * 512 + kt * 128, 512, smem);
    } else { const int v = u - 656; const int kt = v >> 4, nt = v & 15;
      cvt16_tile(p.w_out + (long)(kt * 128) * 2048 + nt * 128, nt * 128, 2048, 128, nullptr, p.wb_out() + (long)(nt * 128) * 2048 + kt * 128, 2048, smem);
    }
  }
}


template <class F>
__device__ __forceinline__ void epi_store_bf16(f32x16 (&acc)[4][4], char* smem, u16* gbase  , int ld, int ncols0, int ncols1, F f) {
  int tz = threadIdx.x; asm volatile("" : "+v"(tz));
  const int lane = tz & 63, wid = tz >> 6, wr = wid >> 1, wc = wid & 1, l31 = lane & 31, hh = lane >> 5;
  __syncthreads();
  char* st = smem + wid * 32768;
#pragma unroll
  for (int mb = 0; mb < 4; ++mb)
#pragma unroll
    for (int reg = 0; reg < 16; ++reg) {
      const int r = mb * 32 + (reg & 3) + 8 * (reg >> 2) + 4 * hh;
      float v[4] = {acc[mb][0][reg], acc[mb][1][reg], acc[mb][2][reg], acc[mb][3][reg]};
      f(wr * 128 + r, wc * 64 + l31, v);
#pragma unroll
      for (int nb = 0; nb < 4; ++nb) *(u16*)(st + r * 256 + (nb * 32 + l31) * 2) = f32_to_bf16(v[nb]);
    }
  const int ch = lane & 15, span = ch >> 3;
  const int gcol = span * 128 + wc * 64 + (ch & 7) * 8;
  const bool ok = ((wc * 64 + (ch & 7) * 8) < (span ? ncols1 : ncols0));
#pragma unroll 8
  for (int it = 0; it < 32; ++it) {
    const int r = it * 4 + (lane >> 4);
    const u32x4 w = *(const u32x4*)(st + r * 256 + ch * 16);
    if (ok) *(u32x4*)(gbase + (long)(wr * 128 + r) * ld + gcol) = w;
  }
}
template <class F>
__device__ __forceinline__ void epi_store_act8(f32x16 (&acc)[4][4], char* smem, u8* gbase  , long row0, int cb0, F f) {
  int tz = threadIdx.x; asm volatile("" : "+v"(tz));
  const int lane = tz & 63, wid = tz >> 6, wr = wid >> 1, wc = wid & 1, l31 = lane & 31, hh = lane >> 5;
  __syncthreads();
  char* st = smem + wid * 32768;
#pragma unroll
  for (int mb = 0; mb < 4; ++mb)
#pragma unroll
    for (int reg = 0; reg < 16; ++reg) {
      const int r = mb * 32 + (reg & 3) + 8 * (reg >> 2) + 4 * hh;
      float v[4] = {acc[mb][0][reg], acc[mb][1][reg], acc[mb][2][reg], acc[mb][3][reg]};
      f(wr * 128 + r, wc * 64 + l31, v);
      const int q = __builtin_amdgcn_cvt_pk_fp8_f32(v[0], v[1], 0, false);
      *(u8*)(st + r * 64 + l31) = (u8)(q & 0xff);
      *(u8*)(st + r * 64 + 32 + l31) = (u8)((q >> 8) & 0xff);
    }
  const int ch = lane & 3;
#pragma unroll 8
  for (int it = 0; it < 8; ++it) {
    const int r = it * 16 + (lane >> 2);
    const u32x4 w = *(const u32x4*)(st + r * 64 + ch * 16);
    const long rg = row0 + wr * 128 + r;
    *(u32x4*)(gbase + (rg >> 1) * 4096 + (long)(cb0 + wc) * 128 + (rg & 1) * 64 + ch * 16) = w;
  }
}
__device__ __forceinline__ void epi_store_f32_resid(f32x16 (&acc)[4][4], char* smem, const float* resid, float* out, int ld) {
  int tz = threadIdx.x; asm volatile("" : "+v"(tz));
  const int lane = tz & 63, wid = tz >> 6, wr = wid >> 1, wc = wid & 1, l31 = lane & 31, hh = lane >> 5;
  __syncthreads();
  char* st = smem + wid * 32768;
#pragma unroll
  for (int half = 0; half < 2; ++half) {
#pragma unroll
    for (int m2 = 0; m2 < 2; ++m2)
#pragma unroll
      for (int reg = 0; reg < 16; ++reg) {
        const int mb = half * 2 + m2;
        const int r = m2 * 32 + (reg & 3) + 8 * (reg >> 2) + 4 * hh;
#pragma unroll
        for (int nb = 0; nb < 4; ++nb) *(float*)(st + r * 512 + (nb * 32 + l31) * 4) = acc[mb][nb][reg];
      }
    const int ch = lane & 31, span = ch >> 4;
    const int gcol = span * 128 + wc * 64 + (ch & 15) * 4;
#pragma unroll 8
    for (int it = 0; it < 32; ++it) {
      const int r = it * 2 + (lane >> 5);
      const f32x4 a = *(const f32x4*)(st + r * 512 + ch * 16);
      const long o = (long)(wr * 128 + half * 64 + r) * ld + gcol;
      const f32x4 x = *(const f32x4*)(resid + o);
      *(f32x4*)(out + o) = a + x;
    }
  }
}

template <int NBV>
__device__ __forceinline__ void win_tile_r(const Params& p, char* smem, int mt, int nt) {
  f32x16 acc[4][4];
  GemmRTile t{};
  t.A = (const u8*)p.h1(); t.lda = 4096; t.aidx = nullptr; t.m0 = mt * 256; t.mvalid = 256;
  t.B = (const u8*)p.wb_in(); t.brow0 = nt * 256; t.brow1 = nt * 256 + 128; t.ldb = 4096; t.KB = 4096;
  gemmr_tile_256<false, false>(t, smem, acc);
  const int rem = NC_ - nt * 256;
  const int nv0 = rem >= 128 ? 128 : rem, nv1 = rem >= 256 ? 128 : (rem > 128 ? rem - 128 : 0);
  epi_store_bf16(acc, smem, p.proj() + (long)(mt * 256) * NC_ + nt * 256, NC_, nv0, nv1, [&](int, int, float (&)[4]) {});
}
__device__ __forceinline__ void ph_win_r(const Params& p, char* smem) {
  const int x = blockIdx.x & 7, slot = blockIdx.x >> 3;
  for (int j = slot; j < 68; j += 32) win_tile_r<4>(p, smem, 4 * x + (j & 3), j >> 2);
}
__device__ __forceinline__ void upq_tile_r(const Params& p, char* smem, int mt, int nt) {
  f32x16 acc[4][4];
  GemmRTile t{};
  t.A = (const u8*)(p.proj() + C_MQ); t.lda = NC_ * 2; t.aidx = nullptr; t.m0 = mt * 256; t.mvalid = 256;
  t.B = (const u8*)p.wb_uq(); t.brow0 = nt * 256; t.brow1 = nt * 256 + 128; t.ldb = 1024; t.KB = 1024;
  gemmr_tile_256<false, false>(t, smem, acc);
  const float* rq = p.rq() + mt * 256;
  epi_store_bf16(acc, smem, p.q() + (long)(mt * 256) * 1536 + nt * 256, 1536, 128, 128, [&](int rowl, int, float (&v)[4]) {
    const float s = rq[rowl] * QSCALE_;
#pragma unroll
    for (int nb = 0; nb < 4; ++nb) v[nb] *= s;
  });
}
__device__ __forceinline__ void upkv_tile_r(const Params& p, char* smem, int mt, int nt) {
  f32x16 acc[4][4];
  GemmRTile t{};
  t.A = (const u8*)(p.proj() + C_MKV); t.lda = NC_ * 2; t.aidx = nullptr; t.m0 = mt * 256; t.mvalid = 256;
  t.B = (const u8*)p.wb_ukv(); t.brow0 = nt * 256; t.brow1 = nt * 256 + 128; t.ldb = 1024; t.KB = 1024;
  gemmr_tile_256<false, false>(t, smem, acc);
  const float* rk = p.rkv() + mt * 256;
  epi_store_bf16(acc, smem, p.kv() + (long)(mt * 256) * 2048 + nt * 256, 2048, 128, 128, [&](int rowl, int, float (&v)[4]) {
    const float s = rk[rowl];
#pragma unroll
    for (int nb = 0; nb < 4; ++nb) v[nb] *= s;
  });
}
__device__ __forceinline__ void wout_tile_r(const Params& p, char* smem, int mt, int nt) {
  f32x16 acc[4][4];
  GemmRTile t{};
  t.A = (const u8*)p.mix(); t.lda = 4096; t.aidx = nullptr; t.m0 = mt * 256; t.mvalid = 256;
  t.B = (const u8*)p.wb_out(); t.brow0 = nt * 256; t.brow1 = nt * 256 + 128; t.ldb = 4096; t.KB = 4096;
  gemmr_tile_256<false, false>(t, smem, acc);
  const long boff = (long)(mt * 256) * 2048 + nt * 256;
  epi_store_f32_resid(acc, smem, p.x + boff, p.x1() + boff, 2048);
}

__device__ __forceinline__ void moe1q_tile(const Params& p, char* smem, const int* mo, int e, int nt, int mt) {
  f32x16 acc[4][4];
  GemmRTile t{};
  const int cnt = p.counts()[e];
  t.A = p.h2q(); t.lda = 2048; t.aidx = p.list() + e * T_ + mt * 256; t.m0 = 0; t.mvalid = min(256, cnt - mt * 256);
  t.B = p.wq_gu(); t.brow0 = (long)e * 4096 + nt * 128; t.brow1 = t.brow0 + 2048; t.ldb = 2048; t.KB = 2048;
#if MOEQ == 2
  gemmrs_tile_256<true>(t, smem, acc);
#else
  gemmr_tile_256<true, true>(t, smem, acc);
#endif
  const float* bg = p.b_gu + e * 4096 + nt * 128; const float* bu = bg + 2048;
  const int tq_ = opaque_tid(); const int cl = (tq_ >> 6 & 1) * 64 + (tq_ & 31);
  const float bgv[2] = {bg[cl], bg[cl + 32]}, buv[2] = {bu[cl], bu[cl + 32]};
  epi_store_act8(acc, smem, p.actq(), (long)(mo[e] * 256 + mt * 256), nt * 2, [&](int, int, float (&v)[4]) {
#pragma unroll
    for (int nb = 0; nb < 2; ++nb) {
      float g = fminf(v[nb] * WISCALE_ + bgv[nb], 7.0f);
      float uu = fminf(fmaxf(v[nb + 2] * WISCALE_ + buv[nb], -7.0f), 7.0f);
      v[nb] = (uu + 1.0f) * (g / (1.0f + __expf(-1.702f * g)));
    }
  });
}
__device__ __forceinline__ void moe2q_tile(const Params& p, char* smem, const int* mo, int e, int nt, int mt) {
  f32x16 acc[4][4];
  GemmRTile t{};
  t.A = p.actq(); t.lda = 2048; t.aidx = nullptr; t.m0 = mo[e] * 256 + mt * 256; t.mvalid = 256;
  t.B = p.wq_dn(); t.brow0 = (long)e * 2048 + nt * 256; t.brow1 = t.brow0 + 128; t.ldb = 2048; t.KB = 2048;
#if MOEQ == 2
  gemmrs_tile_256<false>(t, smem, acc);
#else
  gemmr_tile_256<true, false>(t, smem, acc);
#endif
  const float* bd = p.b_dn + e * 2048 + nt * 256;
  const int tq_ = opaque_tid(); const int cl = (tq_ >> 6 & 1) * 64 + (tq_ & 31);
  const float bdv[4] = {bd[cl], bd[cl + 32], bd[cl + 128], bd[cl + 160]};
  epi_store_bf16(acc, smem, p.ybuf() + (long)t.m0 * 2048 + nt * 256, 2048, 128, 128, [&](int, int, float (&v)[4]) {
#pragma unroll
    for (int nb = 0; nb < 4; ++nb) v[nb] = v[nb] * WISCALE_ + bdv[nb];
  });
}
template <int WHICH>
__device__ __forceinline__ void ph_moeq(const Params& p, char* smem) {
  int* mo = (int*)(smem + G_LDS_BYTES);
#if CVT_SPLIT
  const bool dn_first = ((blockIdx.x >> 3) & 1) != 0;
  if (WHICH == 1 && dn_first) ph_convert_dn(p, smem);
#endif
  moe_setup(p, mo);
  const int NT = (WHICH == 1) ? 16 : 8;
  const int total = mo[NE_] * NT;
  for (int round = 0;; ++round) {
    const int u = xcd_unit(round);
    if (round * 256 >= total) break;
    if (u >= total) continue;
    int e = 0;
    while (mo[e + 1] * NT <= u) ++e;
    const int local = u - mo[e] * NT, me = mo[e + 1] - mo[e];
    const int nt = local / me, mt = local - nt * me;
    if (WHICH == 1) moe1q_tile(p, smem, mo, e, nt, mt); else moe2q_tile(p, smem, mo, e, nt, mt);
  }
#if CVT_SPLIT
  if (WHICH == 1 && !dn_first) ph_convert_dn(p, smem);
#endif
}
#define LDS_MAX 143360
#ifndef DUP
#define DUP 0
#endif
#ifndef MOEQ
#define MOEQ 1
#endif
#ifndef CVT_SPLIT
#define CVT_SPLIT 1
#endif
#ifndef CVT_IN_P4
#define CVT_IN_P4 1
#endif
#ifndef TSTAMP
#define TSTAMP 0
#endif
#ifndef DENSER
#define DENSER 1
#endif
__global__ void __launch_bounds__(256, 1) mega(Params p) {
  extern __shared__ __attribute__((aligned(16))) char smem[];
  volatile LAS unsigned* xbw = (volatile LAS unsigned*)(smem + LDS_MAX - 16);
  if (threadIdx.x == 0) { xbw[0] = 0u; xbw[1] = 0u; xbw[2] = 0u; xbw[3] = 0u; }
  __syncthreads();
  (void)xcd_barrier_post(p.bar(), xbw);
#if TSTAMP
  unsigned long long ts0 = wall_clock64();
  int bar_no = 0;
#define XBAR() do { XcdBarrier bar_; bar_.bar = p.bar(); bar_.x = xb_xcc_id(); bar_.st = (volatile LAS unsigned*)(smem + LDS_MAX - 16); xcd_barrier(bar_); ++bar_no; if (bar_no == TSTAMP && blockIdx.x == 0 && threadIdx.x == 0) { ((float*)p.counts())[48] = (float)(wall_clock64() - ts0) * (1.0f / 100.0f); } } while (0)
#else
#define XBAR() do { XcdBarrier bar_; bar_.bar = p.bar(); bar_.x = xb_xcc_id(); bar_.st = (volatile LAS unsigned*)(smem + LDS_MAX - 16); xcd_barrier(bar_); } while (0)
#endif
#if DUP == 100
  for (int rep_ = 0; rep_ < 2; ++rep_) {
  if (rep_) XBAR();
#endif
  ph_prep0(p);
#if DUP == 30
  ph_prep0(p);
#endif
#if DENSER
  ph_convert_dense(p, smem);
#endif
#if MOEQ >= 1 && CVT_IN_P4 == 0
  ph_convert(p, smem);
#if DUP == 20
  ph_convert(p, smem);
#endif
#endif
  XBAR();
#if DENSER
  ph_win_r(p, smem);
#else
  ph_win(p, smem);
#endif
#if DUP == 1
#if DENSER
  ph_win_r(p, smem);
#else
  ph_win(p, smem);
#endif
#endif
  XBAR();
  ph_prep1(p, smem);
#if DUP == 2
  ph_prep1(p, smem);
#endif
  XBAR();
#if DENSER
  upkv_tile_r(p, smem, blockIdx.x >> 3, blockIdx.x & 7);
  if (blockIdx.x < 192) upq_tile_r(p, smem, blockIdx.x / 6, blockIdx.x % 6);
#else
  upkv_tile(p, smem, blockIdx.x >> 3, blockIdx.x & 7);
  if (blockIdx.x < 192) upq_tile(p, smem, blockIdx.x / 6, blockIdx.x % 6);
#endif
  if (blockIdx.x < 192) gla_g1_unit(p, smem, blockIdx.x);
  else for (int i = 0; i < 5; ++i) gla_g1_unit(p, smem, 192 + (blockIdx.x - 192) * 5 + i);
#if DUP == 3
  upkv_tile(p, smem, blockIdx.x >> 3, blockIdx.x & 7);
  if (blockIdx.x < 192) upq_tile(p, smem, blockIdx.x / 6, blockIdx.x % 6);
  if (blockIdx.x < 192) gla_g1_unit(p, smem, blockIdx.x);
  else for (int i = 0; i < 5; ++i) gla_g1_unit(p, smem, 192 + (blockIdx.x - 192) * 5 + i);
#endif
  XBAR();
  gla_g2_unit(p, blockIdx.x);
#if DUP == 31
  gla_g2_unit(p, blockIdx.x);
#endif
  {
    const int bh = blockIdx.x >> 4, qa = blockIdx.x & 15;
#if MOEQ >= 1 && CVT_IN_P4
    const bool cvt_first = ((blockIdx.x >> 3) & 1) != 0;
    if (cvt_first) { if (CVT_SPLIT) ph_convert_gu(p, smem, 0, 1); else ph_convert(p, smem); }
#endif
    attn_unit(p, smem, bh >> 3, bh & 7, 31 - qa);
    attn_unit(p, smem, bh >> 3, bh & 7, qa);
#if MOEQ >= 1 && CVT_IN_P4
    if (!cvt_first) { if (CVT_SPLIT) ph_convert_gu(p, smem, 0, 1); else ph_convert(p, smem); }
#endif
#if DUP == 44
    if (cvt_first) ph_convert(p, smem);
    attn_unit(p, smem, bh >> 3, bh & 7, 31 - qa);
    attn_unit(p, smem, bh >> 3, bh & 7, qa);
    if (!cvt_first) ph_convert(p, smem);
#endif
#if DUP == 4
    attn_unit(p, smem, bh >> 3, bh & 7, 31 - qa);
    attn_unit(p, smem, bh >> 3, bh & 7, qa);
#endif
  }
  XBAR();
  for (int u = blockIdx.x; u < 512; u += gridDim.x) gla_g3_unit(p, smem, u);
  mla_norm_tokens(p);
#if DUP == 5
  for (int u = blockIdx.x; u < 512; u += gridDim.x) gla_g3_unit(p, smem, u);
  mla_norm_tokens(p);
#endif
  XBAR();
#if DENSER
  wout_tile_r(p, smem, (blockIdx.x & 7) * 4 + ((blockIdx.x >> 3) & 3), blockIdx.x >> 5);
#else
  wout_tile(p, smem, blockIdx.x >> 3, blockIdx.x & 7);
#endif
#if DUP == 6
  wout_tile(p, smem, blockIdx.x >> 3, blockIdx.x & 7);
#endif
  XBAR();
  ffn_prep_unit(p, smem, blockIdx.x);
#if DUP == 7
  ffn_prep_unit<1>(p, smem, blockIdx.x);
#endif
  XBAR();
#if MOEQ >= 1
  ph_moeq<1>(p, smem);
#if DUP == 8
  ph_moeq<1>(p, smem);
#endif
#else
  ph_moe<1>(p, smem);
#endif
  XBAR();
#if MOEQ >= 1
  ph_moeq<2>(p, smem);
#else
  ph_moe<2>(p, smem);
#endif
#if DUP == 9
  ph_moeq<2>(p, smem);
#endif
#if DUP == 89
  XBAR();
  ph_moeq<1>(p, smem);
  XBAR();
  ph_moeq<2>(p, smem);
#endif
#if DUP == 19
  ph_moe<2, 1>(p, smem);
#endif
  XBAR();
#if DUP == 100
  ph_final(p, smem);
  }
#endif
#if TSTAMP
  {
    const float us = ((const float*)p.counts())[48];
    const float scl = 1.0f + us * (1.0f / 4000.0f);
    ph_final(p, smem, scl);
  }
#else
  ph_final(p, smem);
#endif
#if DUP == 10
  ph_final(p, smem);
#endif
#if DUP == 11
  for (int i = 0; i < 10; ++i) XBAR();
#endif
}

extern "C" void kernel_launch(void* const* d_in, const int* in_sizes, int n_in,
                              void* d_out, int out_size, void* d_ws, size_t ws_size,
                              hipStream_t stream) {
  Params P{};
  P.x = (const float*)d_in[0]; P.pos = (const int*)d_in[1];
  P.attn_norm = (const float*)d_in[2]; P.w_in = (const float*)d_in[3]; P.gate_up = (const float*)d_in[4]; P.gate_bias = (const float*)d_in[5];
  P.gla_out_norm = (const float*)d_in[6]; P.q_norm = (const float*)d_in[7]; P.w_uq = (const float*)d_in[8]; P.kv_norm = (const float*)d_in[9];
  P.w_ukv = (const float*)d_in[10]; P.mla_out_norm = (const float*)d_in[11]; P.w_out = (const float*)d_in[12]; P.ffn_norm = (const float*)d_in[13];
  P.router_w = (const float*)d_in[14]; P.router_b = (const float*)d_in[15]; P.w_gu = (const float*)d_in[16]; P.b_gu = (const float*)d_in[17];
  P.w_dn = (const float*)d_in[18]; P.b_dn = (const float*)d_in[19]; P.final_norm = (const float*)d_in[20];
  P.out = (float*)d_out;

  P.ws = (char*)d_ws;

  hipFuncSetAttribute((const void*)mega, hipFuncAttributeMaxDynamicSharedMemorySize, LDS_MAX);
  hipMemsetAsync(d_ws, 0, XCD_BAR_WORDS * sizeof(unsigned), stream);
  mega<<<256, 256, LDS_MAX, stream>>>(P);
}
```

```cpp
#define DUP 0
#define MOEQ 2
#define TSTAMP 0
#define CVT_SPLIT 1
#define CVT_IN_P4 1
#define WOUTQ 0
#define SKEW 0
#define CVT_STAGGER 1
#include <hip/hip_runtime.h>
#include <hip/hip_bf16.h>
#include <stdint.h>
#include <type_traits>
#define T_      8192
#define SEQ_    4096
#define D_      2048
#define NC_     4176
#define C_GQ    0
#define C_GK    512
#define C_GV    1024
#define C_GR    2048
#define C_GD    3072
#define C_MQ    3088
#define C_MKV   3600
#define C_MKR   4112
#define NE_     32
#define DFF_    2048
#define EPS_    1e-6f
typedef short bf16x8 __attribute__((ext_vector_type(8)));
typedef short s16x4 __attribute__((ext_vector_type(4)));
typedef float f32x16 __attribute__((ext_vector_type(16)));
typedef float f32x4 __attribute__((ext_vector_type(4)));
typedef float f32x2 __attribute__((ext_vector_type(2)));
typedef unsigned short u16;
typedef unsigned u32x4 __attribute__((ext_vector_type(4)));
typedef unsigned u32x2 __attribute__((ext_vector_type(2)));
#define LAS3 __attribute__((address_space(3)))
#define OPAQUE(x) asm volatile("" : "+v"(x))
#define NTHR 256
__device__ __forceinline__ int opaque_tid() { int t = threadIdx.x; asm volatile("" : "+v"(t)); return t; }

__device__ __forceinline__ unsigned pack_bf16(float a, float b) {
  typedef __bf16 bf2 __attribute__((ext_vector_type(2)));
  typedef float f2 __attribute__((ext_vector_type(2)));
  f2 v = {a, b};
  bf2 r = __builtin_convertvector(v, bf2);
  return *(unsigned*)&r;
}
__device__ __forceinline__ float bf_lo(unsigned w) { return __uint_as_float(w << 16); }
__device__ __forceinline__ float bf_hi(unsigned w) { return __uint_as_float(w & 0xffff0000u); }
__device__ __forceinline__ float bf16_to_f32(u16 v) { return __uint_as_float(((unsigned)v) << 16); }
__device__ __forceinline__ u16 f32_to_bf16(float f) { return (u16)(pack_bf16(f, 0.f) & 0xffffu); }
__device__ __forceinline__ float shflx(float v, int k) {
  int t = threadIdx.x; asm volatile("" : "+v"(t));
  return __int_as_float(__builtin_amdgcn_ds_bpermute((((t & 63) ^ k) << 2), __float_as_int(v)));
}
__device__ __forceinline__ float wave_sum(float v) {
#pragma unroll
  for (int o = 32; o > 0; o >>= 1) v += shflx(v, o);
  return v;
}
__device__ __forceinline__ unsigned off_b(unsigned row, unsigned ch) { return 256u * row + 16u * (ch ^ (((row & 3u) << 2) | ((row >> 2) & 3u))); }
__device__ __forceinline__ unsigned tr_addr(unsigned lane, unsigned c, unsigned row0  ) {
  const unsigned blk = (lane >> 4) & 1u, q = (lane & 15u) >> 2, p = lane & 3u;
  return off_b(row0 + q, 4u * c + 2u * blk + (p >> 1)) + 8u * (p & 1u);
}
__device__ __forceinline__ bf16x8 tr_frag(const char* img, unsigned lane, unsigned c, unsigned row_a, unsigned row_b) {
  s16x4 v0 = __builtin_amdgcn_ds_read_tr16_b64_v4i16((LAS3 s16x4*)(img + tr_addr(lane, c, row_a)));
  s16x4 v1 = __builtin_amdgcn_ds_read_tr16_b64_v4i16((LAS3 s16x4*)(img + tr_addr(lane, c, row_b)));
  return (bf16x8){v0[0], v0[1], v0[2], v0[3], v1[0], v1[1], v1[2], v1[3]};
}

__device__ __forceinline__ void glds16_asm(const void* gsrc, unsigned lds_dst) {
  unsigned keep;
  asm volatile("s_mov_b32 %0, m0\n\ts_mov_b32 m0, %2\n\ts_nop 0\n\tglobal_load_lds_dwordx4 %1, off\n\ts_mov_b32 m0, %0" : "=&s"(keep) : "v"(gsrc), "s"(lds_dst) : "memory");
}
struct Params {
  const float *x; const int* pos;
  const float *attn_norm, *w_in, *gate_up, *gate_bias, *gla_out_norm, *q_norm, *w_uq, *kv_norm, *w_ukv, *mla_out_norm, *w_out,
              *ffn_norm, *router_w, *router_b, *w_gu, *b_gu, *w_dn, *b_dn, *final_norm;
  float* out;
  char* ws;
  __device__ __forceinline__ unsigned* bar() const { return (unsigned*)(ws + 0ull); }
  __device__ __forceinline__ int* counts() const { return (int*)(ws + 16384ull); }
  __device__ __forceinline__ u16* h1() const { return (u16*)(ws + 16640ull); }
  __device__ __forceinline__ u16* proj() const { return (u16*)(ws + 33571072ull); }
  __device__ __forceinline__ float2* cs() const { return (float2*)(ws + 101990656ull); }
  __device__ __forceinline__ float* rq() const { return (float*)(ws + 104087808ull); }
  __device__ __forceinline__ float* rkv() const { return (float*)(ws + 104120576ull); }
  __device__ __forceinline__ float* bcum() const { return (float*)(ws + 104153344ull); }
  __device__ __forceinline__ u16* q() const { return (u16*)(ws + 120930560ull); }
  __device__ __forceinline__ u16* kv() const { return (u16*)(ws + 146096384ull); }
  __device__ __forceinline__ u16* kpe() const { return (u16*)(ws + 179650816ull); }
  __device__ __forceinline__ u16* kvc() const { return (u16*)(ws + 180699392ull); }
  __device__ __forceinline__ float* dec() const { return (float*)(ws + 214253824ull); }
  __device__ __forceinline__ u16* sprev() const { return (u16*)(ws + 214515968ull); }
  __device__ __forceinline__ u16* mix() const { return (u16*)(ws + 248070400ull); }
  __device__ __forceinline__ u16* omla() const { return (u16*)(ws + 281624832ull); }
  __device__ __forceinline__ float* x1() const { return (float*)(ws + 298402048ull); }
  __device__ __forceinline__ u16* h2() const { return (u16*)(ws + 365510912ull); }
  __device__ __forceinline__ int* list() const { return (int*)(ws + 399065344ull); }
  __device__ __forceinline__ int* asg_e() const { return (int*)(ws + 400113920ull); }
  __device__ __forceinline__ int* asg_slot() const { return (int*)(ws + 400244992ull); }
  __device__ __forceinline__ float* asg_g() const { return (float*)(ws + 400376064ull); }
  __device__ __forceinline__ u16* act() const { return (u16*)(ws + 400507136ull); }
  __device__ __forceinline__ u16* ybuf() const { return (u16*)(ws + 568279296ull); }
  __device__ __forceinline__ unsigned char* wq_gu() const { return (unsigned char*)(ws + 736051456ull); }
  __device__ __forceinline__ unsigned char* wq_dn() const { return (unsigned char*)(ws + 1004486912ull); }
  __device__ __forceinline__ unsigned char* h2q() const { return (unsigned char*)(ws + 1138704640ull); }
  __device__ __forceinline__ unsigned char* actq() const { return (unsigned char*)(ws + 1155481856ull); }
  __device__ __forceinline__ u16* wb_in() const { return (u16*)(ws + 1239367936ull); }
  __device__ __forceinline__ u16* wb_uq() const { return (u16*)(ws + 1257193728ull); }
  __device__ __forceinline__ u16* wb_ukv() const { return (u16*)(ws + 1258766592ull); }
  __device__ __forceinline__ u16* wb_out() const { return (u16*)(ws + 1260863744ull); }
  __device__ __forceinline__ unsigned char* mixq() const { return (unsigned char*)(ws + 1269252352ull); }
  __device__ __forceinline__ unsigned char* wq_out() const { return (unsigned char*)(ws + 1286029568ull); }
};
#define WS_BYTES_USED 1290223872ull

#define XB_TMO      128
#define XB_XCNT(j)  (256  + 64 * (j))
#define XB_XSUB(j)  (1280 + 64 * (j))
#define XB_XGEN(j)  (2304 + 64 * (j))
#define XB_TOP      3328
#define XB_TOPGEN   3392
#define XCD_BAR_WORDS 3456
#define XB_SPIN_CAP (1u << 18)
#define LAS __attribute__((address_space(3)))

__device__ __forceinline__ unsigned xb_ld(unsigned* p)              { return __hip_atomic_load(p, __ATOMIC_RELAXED, __HIP_MEMORY_SCOPE_AGENT); }
__device__ __forceinline__ unsigned xb_add(unsigned* p, unsigned v) { return __hip_atomic_fetch_add(p, v, __ATOMIC_RELAXED, __HIP_MEMORY_SCOPE_AGENT); }
__device__ __forceinline__ unsigned xb_xcc_id() { return (unsigned)__builtin_amdgcn_s_getreg((3 << 11) | 20) & 0xFu; }
#define XB_SPIN(cond, bar) do { unsigned _sp = 0; while (cond) { __builtin_amdgcn_s_sleep(1); \
    if ((++_sp & 255u) == 0u) { if (xb_ld(&(bar)[XB_TMO])) break; if (_sp > XB_SPIN_CAP) { atomicAdd(&(bar)[XB_TMO], 1u); break; } } } } while (0)

struct XcdBarrier {
    unsigned* bar; unsigned x;
    volatile LAS unsigned* st;
};

__device__ __forceinline__ XcdBarrier xcd_barrier_post(unsigned* bar, volatile LAS unsigned* st) {
    XcdBarrier b; b.bar = bar; b.x = xb_xcc_id(); b.st = st;
    if (threadIdx.x == 0) (void)xb_add(&bar[XB_XCNT(b.x)], 1u);
    return b;
}
__device__ __forceinline__ void xcd_barrier_complete(unsigned* bar, unsigned x, unsigned& nloc, unsigned& nx) {
    const unsigned G = gridDim.x * gridDim.y * gridDim.z;
    unsigned sum, cnt, mine, sp = 0u;
    for (;;) {
        sum = 0u; cnt = 0u; mine = 0u;
#pragma unroll
        for (unsigned j = 0; j < 16; ++j) { const unsigned c = xb_ld(&bar[XB_XCNT(j)]); sum += c; cnt += (c > 0u) ? 1u : 0u; mine = (j == x) ? c : mine; }
        if (sum == G) break;
        __builtin_amdgcn_s_sleep(1);
        if ((++sp & 255u) == 0u) { if (xb_ld(&bar[XB_TMO])) break; if (sp > XB_SPIN_CAP) { atomicAdd(&bar[XB_TMO], 1u); break; } }
    }
    nloc = mine > 0u ? mine : 1u; nx = cnt > 0u ? cnt : 1u;
}

__device__ __forceinline__ void xcd_barrier(const XcdBarrier& b) {
    asm volatile("s_waitcnt vmcnt(0)" ::: "memory");
    __syncthreads();
    if (threadIdx.x == 0) {
        unsigned* bar = b.bar;
        __builtin_amdgcn_s_waitcnt(0);
        unsigned nloc = b.st[0], nx = b.st[1];
        if (nloc == 0u) { xcd_barrier_complete(bar, b.x, nloc, nx); b.st[0] = nloc; b.st[1] = nx; }
        const unsigned old = xb_add(&bar[XB_XSUB(b.x)], 1u);
        const unsigned gen = old / nloc;
        if (old + 1u == (gen + 1u) * nloc) {
            __builtin_amdgcn_fence(__ATOMIC_RELEASE, "agent");
            asm volatile("s_waitcnt vmcnt(0)" ::: "memory");
            const unsigned og = xb_add(&bar[XB_TOP], 1u);
            const unsigned tg = og / nx;
            if (og + 1u == (tg + 1u) * nx) xb_add(&bar[XB_TOPGEN], 1u);
            else XB_SPIN(xb_ld(&bar[XB_TOPGEN]) == tg, bar);
            __builtin_amdgcn_fence(__ATOMIC_ACQUIRE, "agent");
            xb_add(&bar[XB_XGEN(b.x)], 1u);
            asm volatile("s_waitcnt vmcnt(0)" ::: "memory");
        } else {
            XB_SPIN(xb_ld(&bar[XB_XGEN(b.x)]) == gen, bar);
            __builtin_amdgcn_fence(__ATOMIC_ACQUIRE, "agent");
            asm volatile("s_waitcnt vmcnt(0)" ::: "memory");
        }
    }
    __syncthreads();
}

#define G_A_OFF(s)  ((s) * 65536)
#define G_B_OFF(s)  ((s) * 65536 + 32768)
#define G_LDS_BYTES 131072

struct GemmTile {
  const u16* A; int lda;
  const int* aidx;
  int m0, mvalid;
  const float* B0; const float* B1;
  int ldb; int nv0, nv1;
  const float* kscale;
  int K;
};

template <int NB, bool KSCALE, bool GATHER>
__device__ __forceinline__ void gemm_tile_256(const GemmTile& t, char* smem, f32x16 (&acc)[4][4]) {
  int tz0 = threadIdx.x; asm volatile("" : "+v"(tz0));
  const int tid = tz0, lane = tid & 63, wid = tid >> 6, wr = wid >> 1, wc = wid & 1;
  const int l31 = lane & 31, hh = lane >> 5;
#pragma unroll
  for (int i = 0; i < 4; ++i)
#pragma unroll
    for (int j = 0; j < 4; ++j)
#pragma unroll
      for (int r = 0; r < 16; ++r) acc[i][j][r] = 0.f;

  const int a_c = (tid & 7) ^ ((tid >> 4) & 7);
  const u16* a_src[GATHER ? 8 : 1];
  if (GATHER) {
#pragma unroll
    for (int i = 0; i < (GATHER ? 8 : 1); ++i) {
      int r = (tid >> 3) + 32 * i;
      int rr = r < t.mvalid ? r : 0;
      a_src[i] = t.A + (long)t.aidx[rr] * t.lda + a_c * 8;
    }
  } else {
    a_src[0] = t.A + (long)(t.m0 + (tid >> 3)) * t.lda + a_c * 8;
  }
  const long a_step = 32L * t.lda;
  const int b_n4 = tid & 63, b_k = tid >> 6;
  const int b_k_u = __builtin_amdgcn_readfirstlane(b_k);
  const int b_img = b_n4 >> 5, b_ch = (b_n4 >> 1) & 15, b_half = b_n4 & 1;
  const bool b_ok = ((b_n4 & 31) * 4) < (b_img ? t.nv1 : t.nv0);
  const int b_loff = (b_ok ? ((b_img ? (int)(t.B1 - t.B0) : 0) + (b_n4 & 31) * 4) : 0) + b_k * t.ldb;
  f32x4 breg[16];

  const unsigned a_lds0 = (unsigned)(size_t)smem + (unsigned)__builtin_amdgcn_readfirstlane(wid) * 1024u;
  auto issue_a = [&](int kt, int s, int i) {
    glds16_asm((const void*)((GATHER ? a_src[GATHER ? i : 0] : a_src[0] + i * a_step) + kt * 64), a_lds0 + G_A_OFF(s) + i * 4096);
  };
  auto issue_b = [&](int kt, int j) {
    const float* ptr = t.B0 + (long)(kt * 64 + 4 * j) * t.ldb + b_loff;
    asm volatile("global_load_dwordx4 %0, %1, off" : "=v"(breg[j]) : "v"(ptr) : "memory");
  };
  auto write_b = [&](int kt, int s, int j) {
    const int k = b_k + 4 * j;
    f32x4 v = breg[j];
    if (KSCALE) { float sc = t.kscale[kt * 64 + b_k_u + 4 * j]; v *= sc; }
    if (!b_ok) v = (f32x4){0.f, 0.f, 0.f, 0.f};
    u32x2 w = {pack_bf16(v[0], v[1]), pack_bf16(v[2], v[3])};
    *(u32x2*)(smem + G_B_OFF(s) + b_img * 16384 + off_b(k, b_ch) + 8 * b_half) = w;
  };
#define WAITQ(N, g) asm volatile("s_waitcnt vmcnt(" #N ")" : "+v"(breg[4 * (g)]), "+v"(breg[4 * (g) + 1]), "+v"(breg[4 * (g) + 2]), "+v"(breg[4 * (g) + 3]) :: "memory")

  unsigned a_rd[4], b_rd[2][2];
#pragma unroll
  for (int ks = 0; ks < 4; ++ks) { const int row = wr * 128 + l31; a_rd[ks] = row * 128 + (((2 * ks + hh) ^ ((row >> 1) & 7)) * 16); }
#pragma unroll
  for (int tt = 0; tt < 2; ++tt)
#pragma unroll
    for (int nl = 0; nl < 2; ++nl) b_rd[tt][nl] = tr_addr(lane, wc * 2 + nl, 8 * hh + 4 * tt);
  auto load_a = [&](const char* As, int ks, bf16x8 (&af)[4]) {
#pragma unroll
    for (int mb = 0; mb < 4; ++mb) af[mb] = *(const bf16x8*)(As + a_rd[ks] + mb * 4096);
  };
  auto load_b1 = [&](const char* Bs, int ks, int nb, bf16x8& bfr) {
    const char* bi = Bs + (nb >> 1) * 16384 + ks * 4096;
    s16x4 v0 = __builtin_amdgcn_ds_read_tr16_b64_v4i16((LAS3 s16x4*)(bi + b_rd[0][nb & 1]));
    s16x4 v1 = __builtin_amdgcn_ds_read_tr16_b64_v4i16((LAS3 s16x4*)(bi + b_rd[1][nb & 1]));
    bfr = (bf16x8){v0[0], v0[1], v0[2], v0[3], v1[0], v1[1], v1[2], v1[3]};
  };

  auto kstep = [&](int kt, auto mode_tag, bool has1, bool has2) {
    constexpr int MODE = decltype(mode_tag)::value;
    const int s = kt & 1;
    const char* As = smem + G_A_OFF(s);
    const char* Bs = smem + G_B_OFF(s);
    bf16x8 a0[4], a1[4], bq[NB];
    load_a(As, 0, a0);
#pragma unroll
    for (int nb = 0; nb < NB; ++nb) load_b1(Bs, 0, nb, bq[nb]);
    __builtin_amdgcn_sched_barrier(0);
#pragma unroll
    for (int g = 0; g < 4; ++g) {
      bf16x8 (&ac)[4] = (g & 1) ? a1 : a0;
      bf16x8 (&an)[4] = (g & 1) ? a0 : a1;
      if (g < 3) load_a(As, g + 1, an);
      __builtin_amdgcn_sched_barrier(0);
#pragma unroll
      for (int nb = 0; nb < NB; ++nb) {
#pragma unroll
        for (int mb = 0; mb < 4; ++mb)
          acc[mb][nb] = __builtin_amdgcn_mfma_f32_32x32x16_bf16(ac[mb], bq[nb], acc[mb][nb], 0, 0, 0);
        __builtin_amdgcn_sched_barrier(0);
        if (g < 3) load_b1(Bs, g + 1, nb, bq[nb]);
        if (nb == 0 && g < 2 && has1) { issue_a(kt + 1, s ^ 1, 4 * g + 0); issue_a(kt + 1, s ^ 1, 4 * g + 1); }
        if (nb == 1 % NB && g < 2 && has1 && NB > 1) { issue_a(kt + 1, s ^ 1, 4 * g + 2); issue_a(kt + 1, s ^ 1, 4 * g + 3); }
        if (NB == 1 && nb == 0 && g < 2 && has1) { issue_a(kt + 1, s ^ 1, 4 * g + 2); issue_a(kt + 1, s ^ 1, 4 * g + 3); }
        if (nb == NB - 1 && has1) {
          if (MODE == 2) { if (g == 0) WAITQ(20, 0); else if (g == 1) WAITQ(20, 1); else if (g == 2) WAITQ(20, 2); else WAITQ(20, 3); }
          else if (MODE == 1) { if (g == 0) WAITQ(16, 0); else if (g == 1) WAITQ(20, 1); else if (g == 2) WAITQ(20, 2); else WAITQ(20, 3); }
          else { if (g == 0) WAITQ(0, 0); else if (g == 1) WAITQ(0, 1); else if (g == 2) WAITQ(0, 2); else WAITQ(0, 3); }
#pragma unroll
          for (int i = 0; i < 4; ++i) write_b(kt + 1, s ^ 1, 4 * g + i);
          if (has2) {
#pragma unroll
            for (int i = 0; i < 4; ++i) issue_b(kt + 2, 4 * g + i);
          }
        }
        __builtin_amdgcn_sched_barrier(0);
      }
    }
    if (has1) {
      if (MODE == 0) asm volatile("s_waitcnt vmcnt(0)" ::: "memory");
      else asm volatile("s_waitcnt vmcnt(12)" ::: "memory");
      __syncthreads();
    }
  };

  const int nk = t.K >> 6;
  __syncthreads();
#pragma unroll
  for (int j = 0; j < 16; ++j) issue_b(0, j);
#pragma unroll
  for (int i = 0; i < 8; ++i) issue_a(0, 0, i);
  WAITQ(8, 0); WAITQ(8, 1); WAITQ(8, 2); WAITQ(8, 3);
#pragma unroll
  for (int j = 0; j < 16; ++j) write_b(0, 0, j);
#pragma unroll
  for (int j = 0; j < 16; ++j) issue_b(1, j);
  asm volatile("s_waitcnt vmcnt(16)" ::: "memory");
  __syncthreads();
  kstep(0, std::integral_constant<int, 1>{}, true, true);
  for (int kt = 1; kt < nk - 2; ++kt) kstep(kt, std::integral_constant<int, 2>{}, true, true);
  kstep(nk - 2, std::integral_constant<int, 0>{}, true, false);
  kstep(nk - 1, std::integral_constant<int, 0>{}, false, false);
#undef WAITQ
}
template <int NB, class F>
__device__ __forceinline__ void acc_foreach_row(f32x16 (&acc)[4][4], F f) {
  int tz = threadIdx.x; asm volatile("" : "+v"(tz));
  const int lane = tz & 63, wid = tz >> 6, wr = wid >> 1, wc = wid & 1;
  const int l31 = lane & 31, hh = lane >> 5;
#pragma unroll
  for (int mb = 0; mb < 4; ++mb)
#pragma unroll
    for (int reg = 0; reg < 16; ++reg) {
      const int rowl = wr * 128 + mb * 32 + (reg & 3) + 8 * (reg >> 2) + 4 * hh;
      float v[NB];
#pragma unroll
      for (int nb = 0; nb < NB; ++nb) v[nb] = acc[mb][nb][reg];
      f(rowl, wc * 64 + l31, v);
      asm volatile("" ::: "memory");
    }
}
__device__ __forceinline__ void ph_prep0(const Params& p) {
  const int tid_ = opaque_tid(); const int lane = tid_ & 63, wid = tid_ >> 6;
  if (blockIdx.x == 0 && tid_ < 64) p.counts()[tid_] = 0;
  for (int t = blockIdx.x * 4 + wid; t < T_; t += gridDim.x * 4) {
    const float* xr = p.x + (long)t * 2048;
    f32x4 v[8]; float ss = 0.f;
#pragma unroll
    for (int j = 0; j < 8; ++j) { v[j] = *(const f32x4*)(xr + j * 256 + lane * 4); ss += v[j][0] * v[j][0] + v[j][1] * v[j][1] + v[j][2] * v[j][2] + v[j][3] * v[j][3]; }
    ss = wave_sum(ss);
    const float r = rsqrtf(ss * (1.0f / 2048.0f) + EPS_);
#pragma unroll
    for (int j = 0; j < 8; ++j) {
      f32x4 g = *(const f32x4*)(p.attn_norm + j * 256 + lane * 4);
      u32x2 w = {pack_bf16(v[j][0] * r * g[0], v[j][1] * r * g[1]), pack_bf16(v[j][2] * r * g[2], v[j][3] * r * g[3])};
      *(u32x2*)(p.h1() + (long)t * 2048 + j * 256 + lane * 4) = w;
    }
    if (lane < 32) {
      float inv = 1.0f / powf(10000.0f, (float)(2 * lane) / 64.0f);
      float ang = (float)p.pos[t] * inv;
      double a = (double)ang;
      double k = rint(a * 0.15915494309189535);
      float rf = (float)fma(-k, 6.283185307179586, a);
      p.cs()[t * 32 + lane] = make_float2(__cosf(rf), __sinf(rf));
    }
  }
}

template <int NB>
__device__ __forceinline__ void win_tile(const Params& p, char* smem, int mt, int nt) {
  f32x16 acc[4][4];
  GemmTile t{};
  t.A = p.h1(); t.lda = 2048; t.aidx = nullptr; t.m0 = mt * 256; t.mvalid = 256;
  t.B0 = p.w_in + nt * 256; t.B1 = t.B0 + 128; t.ldb = NC_;
  const int rem = NC_ - nt * 256;
  t.nv0 = rem >= 128 ? 128 : rem; t.nv1 = rem >= 256 ? 128 : (rem > 128 ? rem - 128 : 0);
  t.kscale = nullptr; t.K = 2048;
  gemm_tile_256<NB, false, false>(t, smem, acc);
  u16* base = p.proj() + (long)(mt * 256) * NC_ + nt * 256;
  const int nv0 = t.nv0, nv1 = t.nv1;
  acc_foreach_row<NB>(acc, [&](int rowl, int coll, float (&v)[NB]) {
    u16* rp = base + (long)rowl * NC_ + coll;
    OPAQUE(rp);
#pragma unroll
    for (int nb = 0; nb < NB; ++nb) {
      const int c = (nb & 1) * 32 + coll;
      const int lim = (nb >> 1) ? nv1 : nv0;
      if (c < lim) rp[(nb >> 1) * 128 + (nb & 1) * 32] = f32_to_bf16(v[nb]);
    }
  });
}
__device__ __forceinline__ void ph_win(const Params& p, char* smem) {
  const int x = blockIdx.x & 7, slot = blockIdx.x >> 3;
  for (int j = slot; j < 64; j += 32) win_tile<4>(p, smem, 4 * x + (j & 3), j >> 2);
  if (slot < 4) win_tile<2>(p, smem, 4 * x + slot, 16);
}

__device__ __forceinline__ void ph_prep1(const Params& p, char* smem) {
  float* gds = (float*)smem;
  float* cums = (float*)(smem + 4096);
  const int tid = opaque_tid(), lane = tid & 63, wid = tid >> 6;
  for (int u = blockIdx.x; u < 512; u += gridDim.x) {
    const int ch = u >> 2, h = u & 3; const int t0 = ch * 64;
    __syncthreads();
    {
      const int tl = tid >> 2, r4 = (tid & 3) * 4;
      u32x2 w = *(const u32x2*)(p.proj() + (long)(t0 + tl) * NC_ + C_GD + r4);
      gds[tl * 16 + r4 + 0] = bf_lo(w[0]); gds[tl * 16 + r4 + 1] = bf_hi(w[0]);
      gds[tl * 16 + r4 + 2] = bf_lo(w[1]); gds[tl * 16 + r4 + 3] = bf_hi(w[1]);
    }
    const int c = tid & 127, half = tid >> 7;
    float gu[16];
#pragma unroll
    for (int r = 0; r < 16; ++r) gu[r] = p.gate_up[r * 512 + h * 128 + c];
    const float bias = p.gate_bias[h * 128 + c];
    __syncthreads();
    float run = 0.f;
    for (int i = 0; i < 32; ++i) {
      const int tl = half * 32 + i;
      float z = bias;
#pragma unroll
      for (int r = 0; r < 16; ++r) z = fmaf(gds[tl * 16 + r], gu[r], z);
      const float ls = fminf(z, 0.f) - log1pf(__expf(-fabsf(z)));
      run += ls * (1.0f / 16.0f);
      cums[tl * 128 + c] = run;
    }
    __syncthreads();
    {
      const float add = cums[31 * 128 + c];
      for (int i = 0; i < 32; ++i) {
        const int tl = half * 32 + i;
        float v = cums[tl * 128 + c] + (half ? add : 0.f);
        p.bcum()[(long)(t0 + tl) * 512 + h * 128 + c] = v;
      }
    }
    for (int i = 0; i < 4; ++i) {
      const long t = t0 + h * 16 + wid * 4 + i;
      const u16* pr = p.proj() + t * NC_;
      u32x4 a = *(const u32x4*)(pr + C_MQ + lane * 8);
      u32x4 b = *(const u32x4*)(pr + C_MKV + lane * 8);
      float sa = 0.f, sb = 0.f;
#pragma unroll
      for (int k = 0; k < 4; ++k) { float l = bf_lo(a[k]), hgh = bf_hi(a[k]); sa += l * l + hgh * hgh; l = bf_lo(b[k]); hgh = bf_hi(b[k]); sb += l * l + hgh * hgh; }
      sa = wave_sum(sa); sb = wave_sum(sb);
      if (lane == 0) { p.rq()[t] = rsqrtf(sa * (1.0f / 512.0f) + EPS_); p.rkv()[t] = rsqrtf(sb * (1.0f / 512.0f) + EPS_); }
      if (lane < 32) {
        const float t1 = bf16_to_f32(pr[C_MKR + lane]), t2 = bf16_to_f32(pr[C_MKR + lane + 32]);
        const float2 cs = p.cs()[t * 32 + lane];
        p.kpe()[t * 64 + lane] = f32_to_bf16(t1 * cs.x - t2 * cs.y);
        p.kpe()[t * 64 + lane + 32] = f32_to_bf16(t1 * cs.y + t2 * cs.x);
      }
    }
  }
}

#define QSCALE_ (0.07216878364870322f * 1.4426950408889634f)
__device__ __forceinline__ void upq_tile(const Params& p, char* smem, int mt, int nt) {
  f32x16 acc[4][4];
  GemmTile t{};
  t.A = p.proj() + C_MQ; t.lda = NC_; t.aidx = nullptr; t.m0 = mt * 256; t.mvalid = 256;
  t.B0 = p.w_uq + nt * 256; t.B1 = t.B0 + 128; t.ldb = 1536; t.nv0 = 128; t.nv1 = 128; t.kscale = p.q_norm; t.K = 512;
  gemm_tile_256<4, true, false>(t, smem, acc);
  u16* base = p.q() + (long)(mt * 256) * 1536 + nt * 256;
  const float* rq = p.rq() + mt * 256;
  acc_foreach_row<4>(acc, [&](int rowl, int coll, float (&v)[4]) {
    u16* rp = base + (long)rowl * 1536 + coll;
    OPAQUE(rp);
    const float s = rq[rowl] * QSCALE_;
#pragma unroll
    for (int nb = 0; nb < 4; ++nb) rp[(nb >> 1) * 128 + (nb & 1) * 32] = f32_to_bf16(v[nb] * s);
  });
}
__device__ __forceinline__ void upkv_tile(const Params& p, char* smem, int mt, int nt) {
  f32x16 acc[4][4];
  GemmTile t{};
  t.A = p.proj() + C_MKV; t.lda = NC_; t.aidx = nullptr; t.m0 = mt * 256; t.mvalid = 256;
  t.B0 = p.w_ukv + nt * 256; t.B1 = t.B0 + 128; t.ldb = 2048; t.nv0 = 128; t.nv1 = 128; t.kscale = p.kv_norm; t.K = 512;
  gemm_tile_256<4, true, false>(t, smem, acc);
  u16* base = p.kv() + (long)(mt * 256) * 2048 + nt * 256;
  const float* rk = p.rkv() + mt * 256;
  acc_foreach_row<4>(acc, [&](int rowl, int coll, float (&v)[4]) {
    u16* rp = base + (long)rowl * 2048 + coll;
    OPAQUE(rp);
    const float s = rk[rowl];
#pragma unroll
    for (int nb = 0; nb < 4; ++nb) rp[(nb >> 1) * 128 + (nb & 1) * 32] = f32_to_bf16(v[nb] * s);
  });
}
#define AT_KSTRIDE 400
#define AT_KBYTES  (64 * AT_KSTRIDE)
#define AT_STAGE   (AT_KBYTES + 16384)
#define AT_LDS_BYTES (2 * AT_STAGE)

__device__ __forceinline__ void attn_unit(const Params& p, char* smem, int b, int h, int qb) {
  const int tid = opaque_tid(), lane = tid & 63, wid = tid >> 6, l31 = lane & 31, hh = lane >> 5;
  const long tq = (long)b * SEQ_ + qb * 128 + wid * 32 + l31;
  bf16x8 qf[12];
  {
    const u16* qp = p.q() + (tq * 8 + h) * 192 + 8 * hh;
#pragma unroll
    for (int ks = 0; ks < 12; ++ks) qf[ks] = *(const bf16x8*)(qp + 16 * ks);
#pragma unroll
    for (int s = 0; s < 2; ++s) {
      const float2* cp = p.cs() + tq * 32 + 16 * s + 8 * hh;
      bf16x8 lo = qf[8 + s], hi = qf[10 + s], nlo, nhi;
#pragma unroll
      for (int j = 0; j < 8; j += 2) {
        float2 c0 = cp[j], c1 = cp[j + 1];
        float a0 = bf16_to_f32((u16)lo[j]), a1 = bf16_to_f32((u16)lo[j + 1]);
        float b0 = bf16_to_f32((u16)hi[j]), b1 = bf16_to_f32((u16)hi[j + 1]);
        unsigned wl = pack_bf16(a0 * c0.x - b0 * c0.y, a1 * c1.x - b1 * c1.y);
        unsigned wh = pack_bf16(a0 * c0.y + b0 * c0.x, a1 * c1.y + b1 * c1.x);
        nlo[j] = (short)(wl & 0xffff); nlo[j + 1] = (short)(wl >> 16);
        nhi[j] = (short)(wh & 0xffff); nhi[j + 1] = (short)(wh >> 16);
      }
      qf[8 + s] = nlo; qf[10 + s] = nhi;
    }
  }
  u32x4 kregA[6], vregA[4], kregB[6], vregB[4];
  const long tk0 = (long)b * SEQ_;
  auto load_tile = [&](int kt, u32x4 (&kreg)[6], u32x4 (&vreg)[4]) {
    const long tb = tk0 + kt * 64;
#pragma unroll
    for (int i = 0; i < 4; ++i) {
      const int pp = i * 256 + tid; const int key = pp >> 4, c = pp & 15;
      const u16* rowp = p.kv() + ((tb + key) * 8 + h) * 256 + c * 8;
      kreg[i] = *(const u32x4*)rowp;
      vreg[i] = *(const u32x4*)(rowp + 128);
    }
#pragma unroll
    for (int i = 0; i < 2; ++i) {
      const int pp = i * 256 + tid; const int key = pp >> 3, c = pp & 7;
      kreg[4 + i] = *(const u32x4*)(p.kpe() + (tb + key) * 64 + c * 8);
    }
  };
  auto store_tile = [&](int s, u32x4 (&kreg)[6], u32x4 (&vreg)[4]) {
    char* Ks = smem + s * AT_STAGE; char* Vs = Ks + AT_KBYTES;
#pragma unroll
    for (int i = 0; i < 4; ++i) {
      const int pp = i * 256 + tid; const int key = pp >> 4, c = pp & 15;
      *(u32x4*)(Ks + key * AT_KSTRIDE + c * 16) = kreg[i];
      *(u32x4*)(Vs + off_b(key, c)) = vreg[i];
    }
#pragma unroll
    for (int i = 0; i < 2; ++i) {
      const int pp = i * 256 + tid; const int key = pp >> 3, c = pp & 7;
      *(u32x4*)(Ks + key * AT_KSTRIDE + (16 + c) * 16) = kreg[4 + i];
    }
  };

  f32x16 o[4];
#pragma unroll
  for (int c = 0; c < 4; ++c)
#pragma unroll
    for (int r = 0; r < 16; ++r) o[c][r] = 0.f;
  float m = -1e30f, l = 0.f;
  const int nt = 2 * qb + 2;
  const int qpos = qb * 128 + wid * 32 + l31;

  __syncthreads();
  load_tile(0, kregA, vregA);
  store_tile(0, kregA, vregA);
  load_tile(1, kregB, vregB);
  if (nt > 2) load_tile(2, kregA, vregA);
  __syncthreads();
  auto tile_body = [&](int kt, int s) {
    const char* Ks = smem + s * AT_STAGE; const char* Vs = Ks + AT_KBYTES;
    const bool active = (kt * 64) <= (qb * 128 + wid * 32 + 31);
    if (active) {
      f32x16 sc[2];
#pragma unroll
      for (int kb = 0; kb < 2; ++kb) {
#pragma unroll
        for (int r = 0; r < 16; ++r) sc[kb][r] = 0.f;
#pragma unroll
        for (int ks = 0; ks < 12; ++ks) {
          bf16x8 a = *(const bf16x8*)(Ks + (kb * 32 + l31) * AT_KSTRIDE + (2 * ks + hh) * 16);
          sc[kb] = __builtin_amdgcn_mfma_f32_32x32x16_bf16(a, qf[ks], sc[kb], 0, 0, 0);
        }
      }
      if (kt >= 2 * qb) {
#pragma unroll
        for (int kb = 0; kb < 2; ++kb)
#pragma unroll
          for (int r = 0; r < 16; ++r) {
            const int key = kt * 64 + kb * 32 + (r & 3) + 8 * (r >> 2) + 4 * hh;
            if (key > qpos) sc[kb][r] = -1e30f;
          }
      }
      float mx = sc[0][0];
#pragma unroll
      for (int kb = 0; kb < 2; ++kb)
#pragma unroll
        for (int r = 0; r < 16; ++r) mx = fmaxf(mx, sc[kb][r]);
      mx = fmaxf(mx, shflx(mx, 32));
      const float mn = fmaxf(m, mx);
      const float alpha = exp2f(m - mn);
      m = mn;
      float ps = 0.f;
      bf16x8 pf[4];
#pragma unroll
      for (int kb = 0; kb < 2; ++kb)
#pragma unroll
        for (int s2 = 0; s2 < 2; ++s2) {
          float e[8];
#pragma unroll
          for (int j = 0; j < 8; ++j) { e[j] = exp2f(sc[kb][8 * s2 + j] - mn); ps += e[j]; }
          unsigned w0 = pack_bf16(e[0], e[1]), w1 = pack_bf16(e[2], e[3]), w2 = pack_bf16(e[4], e[5]), w3 = pack_bf16(e[6], e[7]);
          u32x4 w = {w0, w1, w2, w3};
          pf[kb * 2 + s2] = *(bf16x8*)&w;
        }
      l = l * alpha + ps;
#pragma unroll
      for (int c = 0; c < 4; ++c)
#pragma unroll
        for (int r = 0; r < 16; ++r) o[c][r] *= alpha;
#pragma unroll
      for (int c = 0; c < 4; ++c)
#pragma unroll
        for (int kk = 0; kk < 4; ++kk) {
          const unsigned rbase = 32 * (kk >> 1) + 16 * (kk & 1) + 4 * hh;
          bf16x8 a = tr_frag(Vs, lane, c, rbase, rbase + 8);
          o[c] = __builtin_amdgcn_mfma_f32_32x32x16_bf16(a, pf[kk], o[c], 0, 0, 0);
        }
    }
  };
  for (int kt = 0; kt < nt; kt += 2) {
    tile_body(kt, 0);
    store_tile(1, kregB, vregB);
    if (kt + 3 < nt) load_tile(kt + 3, kregB, vregB);
    __syncthreads();
    tile_body(kt + 1, 1);
    if (kt + 2 < nt) {
      store_tile(0, kregA, vregA);
      if (kt + 4 < nt) load_tile(kt + 4, kregA, vregA);
      __syncthreads();
    }
  }
  l = l + shflx(l, 32);
  const float inv = 1.0f / l;
  u16* op = p.omla() + tq * 1024 + h * 128 + 4 * hh;
#pragma unroll
  for (int c = 0; c < 4; ++c)
#pragma unroll
    for (int rg = 0; rg < 4; ++rg) {
      u32x2 w = {pack_bf16(o[c][4 * rg] * inv, o[c][4 * rg + 1] * inv), pack_bf16(o[c][4 * rg + 2] * inv, o[c][4 * rg + 3] * inv)};
      *(u32x2*)(op + 32 * c + 8 * rg) = w;
    }
}

#define G1_LDS_BYTES 49152
__device__ __forceinline__ void gla_g1_unit(const Params& p, char* smem, int u) {
  const int tid = opaque_tid(), lane = tid & 63, wid = tid >> 6, l31 = lane & 31, hh = lane >> 5;
  const int bh = u >> 6, n = u & 63, b = bh >> 2, h = bh & 3;
  const long t0 = (long)b * SEQ_ + n * 64;
  char* Ks = smem; char* Vs = smem + 16384;
  __syncthreads();
  {
    const int ch = tid & 15;
    const float* bl = p.bcum() + (t0 + 63) * 512 + h * 128 + ch * 8;
    f32x4 bl0 = *(const f32x4*)bl, bl1 = *(const f32x4*)(bl + 4);
    if (tid < 128) p.dec()[(long)u * 128 + tid] = __expf(p.bcum()[(t0 + 63) * 512 + h * 128 + tid]);
#pragma unroll
    for (int i = 0; i < 4; ++i) {
      const int tok = (i * 256 + tid) >> 4;
      u32x4 kw = *(const u32x4*)(p.proj() + (t0 + tok) * NC_ + C_GK + h * 128 + ch * 8);
      const float* bp = p.bcum() + (t0 + tok) * 512 + h * 128 + ch * 8;
      f32x4 b0 = *(const f32x4*)bp, b1 = *(const f32x4*)(bp + 4);
      u32x4 w;
      w[0] = pack_bf16(bf_lo(kw[0]) * __expf(bl0[0] - b0[0]), bf_hi(kw[0]) * __expf(bl0[1] - b0[1]));
      w[1] = pack_bf16(bf_lo(kw[1]) * __expf(bl0[2] - b0[2]), bf_hi(kw[1]) * __expf(bl0[3] - b0[3]));
      w[2] = pack_bf16(bf_lo(kw[2]) * __expf(bl1[0] - b1[0]), bf_hi(kw[2]) * __expf(bl1[1] - b1[1]));
      w[3] = pack_bf16(bf_lo(kw[3]) * __expf(bl1[2] - b1[2]), bf_hi(kw[3]) * __expf(bl1[3] - b1[3]));
      *(u32x4*)(Ks + off_b(tok, ch)) = w;
    }
#pragma unroll
    for (int i = 0; i < 8; ++i) {
      const int pp = i * 256 + tid; const int tok = pp >> 5, c32 = pp & 31;
      u32x4 vw = *(const u32x4*)(p.proj() + (t0 + tok) * NC_ + C_GV + h * 256 + c32 * 8);
      *(u32x4*)(Vs + (c32 >> 4) * 16384 + off_b(tok, c32 & 15)) = vw;
    }
  }
  __syncthreads();
  f32x16 acc[4][2];
#pragma unroll
  for (int mb = 0; mb < 4; ++mb)
#pragma unroll
    for (int nb = 0; nb < 2; ++nb)
#pragma unroll
      for (int r = 0; r < 16; ++r) acc[mb][nb][r] = 0.f;
  const char* Vimg = Vs + (wid >> 1) * 16384;
#pragma unroll
  for (int ks = 0; ks < 4; ++ks) {
    bf16x8 af[4], bfr[2];
    const unsigned r0 = 16 * ks + 8 * hh;
#pragma unroll
    for (int mb = 0; mb < 4; ++mb) af[mb] = tr_frag(Ks, lane, mb, r0, r0 + 4);
#pragma unroll
    for (int nb = 0; nb < 2; ++nb) bfr[nb] = tr_frag(Vimg, lane, 2 * (wid & 1) + nb, r0, r0 + 4);
#pragma unroll
    for (int mb = 0; mb < 4; ++mb)
#pragma unroll
      for (int nb = 0; nb < 2; ++nb) acc[mb][nb] = __builtin_amdgcn_mfma_f32_32x32x16_bf16(af[mb], bfr[nb], acc[mb][nb], 0, 0, 0);
  }
  __syncthreads();
  {
    char* st = smem + wid * 16384;
#pragma unroll
    for (int mb = 0; mb < 4; ++mb)
#pragma unroll
      for (int r = 0; r < 16; ++r) {
        const int dk = mb * 32 + (r & 3) + 8 * (r >> 2) + 4 * hh;
        *(u16*)(st + dk * 128 + l31 * 2) = f32_to_bf16(acc[mb][0][r]);
        *(u16*)(st + dk * 128 + (32 + l31) * 2) = f32_to_bf16(acc[mb][1][r]);
      }
    u16* gb = p.kvc() + (long)u * 32768 + wid * 64;
#pragma unroll 4
    for (int it = 0; it < 16; ++it) {
      const int dk = it * 8 + (lane >> 3), ch = lane & 7;
      *(u32x4*)(gb + dk * 256 + ch * 8) = *(const u32x4*)(st + dk * 128 + ch * 16);
    }
  }
}

__device__ __forceinline__ void gla_g2_unit(const Params& p, int u) {
  const int tid = opaque_tid();
  const int bh = u >> 5, part = u & 31;
  const int dk = part * 4 + (tid >> 6), dv = (tid & 63) * 4;
  float s0 = 0.f, s1 = 0.f, s2 = 0.f, s3 = 0.f;
  const long ebase = (long)dk * 256 + dv;
#pragma unroll 8
  for (int n = 0; n < 64; ++n) {
    const long un = (long)(bh * 64 + n);
    u32x2 kw = *(const u32x2*)(p.kvc() + un * 32768 + ebase);
    const float d = p.dec()[un * 128 + dk];
    u32x2 w = {pack_bf16(s0, s1), pack_bf16(s2, s3)};
    *(u32x2*)(p.sprev() + un * 32768 + ebase) = w;
    s0 = fmaf(d, s0, bf_lo(kw[0])); s1 = fmaf(d, s1, bf_hi(kw[0]));
    s2 = fmaf(d, s2, bf_lo(kw[1])); s3 = fmaf(d, s3, bf_hi(kw[1]));
  }
}

#define G3_LDS_BYTES (16384 + 16384 + 32768 + 65536 + 1024)
__device__ __forceinline__ void gla_g3_unit(const Params& p, char* smem, int u) {
  const int tid = opaque_tid(), lane = tid & 63, wid = tid >> 6, l31 = lane & 31, hh = lane >> 5;
  const int bh = u >> 6, n = u & 63, b = bh >> 2, h = bh & 3;
  const long t0 = (long)b * SEQ_ + n * 64;
  char* Qd = smem; char* Ki = smem + 16384; char* Vs = smem + 32768; char* Sp = smem + 65536; float* red = (float*)(smem + 131072);
  __syncthreads();
  {
    const int ch = tid & 15;
    const float qs = 0.08838834764831845f;
#pragma unroll
    for (int i = 0; i < 4; ++i) {
      const int tok = (i * 256 + tid) >> 4;
      const u16* pr = p.proj() + (t0 + tok) * NC_ + h * 128 + ch * 8;
      u32x4 qw = *(const u32x4*)(pr + C_GQ), kw = *(const u32x4*)(pr + C_GK);
      const float* bp = p.bcum() + (t0 + tok) * 512 + h * 128 + ch * 8;
      f32x4 b0 = *(const f32x4*)bp, b1 = *(const f32x4*)(bp + 4);
      float e[8] = {__expf(b0[0]), __expf(b0[1]), __expf(b0[2]), __expf(b0[3]), __expf(b1[0]), __expf(b1[1]), __expf(b1[2]), __expf(b1[3])};
      u32x4 wq, wk;
#pragma unroll
      for (int k = 0; k < 4; ++k) {
        wq[k] = pack_bf16(bf_lo(qw[k]) * qs * e[2 * k], bf_hi(qw[k]) * qs * e[2 * k + 1]);
        wk[k] = pack_bf16(bf_lo(kw[k]) / e[2 * k], bf_hi(kw[k]) / e[2 * k + 1]);
      }
      *(u32x4*)(Qd + off_b(tok, ch)) = wq;
      *(u32x4*)(Ki + off_b(tok, ch)) = wk;
    }
#pragma unroll
    for (int i = 0; i < 8; ++i) {
      const int pp = i * 256 + tid; const int tok = pp >> 5, c32 = pp & 31;
      u32x4 vw = *(const u32x4*)(p.proj() + (t0 + tok) * NC_ + C_GV + h * 256 + c32 * 8);
      *(u32x4*)(Vs + (c32 >> 4) * 16384 + off_b(tok, c32 & 15)) = vw;
    }
#pragma unroll
    for (int i = 0; i < 16; ++i) {
      const int pp = i * 256 + tid; const int dk = pp >> 5, c32 = pp & 31;
      u32x4 sw = *(const u32x4*)(p.sprev() + (long)u * 32768 + dk * 256 + c32 * 8);
      *(u32x4*)(Sp + (c32 >> 4) * 32768 + off_b(dk, c32 & 15)) = sw;
    }
  }
  __syncthreads();
  const int ib = wid & 1, dvh = wid >> 1;
  f32x16 sc[2];
#pragma unroll
  for (int jb = 0; jb < 2; ++jb) {
#pragma unroll
    for (int r = 0; r < 16; ++r) sc[jb][r] = 0.f;
    if (jb <= ib) {
#pragma unroll
      for (int ks = 0; ks < 8; ++ks) {
        bf16x8 a = *(const bf16x8*)(Ki + off_b(jb * 32 + l31, 2 * ks + hh));
        bf16x8 bq = *(const bf16x8*)(Qd + off_b(ib * 32 + l31, 2 * ks + hh));
        sc[jb] = __builtin_amdgcn_mfma_f32_32x32x16_bf16(a, bq, sc[jb], 0, 0, 0);
      }
#pragma unroll
      for (int r = 0; r < 16; ++r) {
        const int j = jb * 32 + (r & 3) + 8 * (r >> 2) + 4 * hh, i = ib * 32 + l31;
        if (j > i) sc[jb][r] = 0.f;
      }
    }
  }
  bf16x8 pf[4];
#pragma unroll
  for (int jb = 0; jb < 2; ++jb)
#pragma unroll
    for (int s2 = 0; s2 < 2; ++s2) {
      u32x4 w = {pack_bf16(sc[jb][8 * s2 + 0], sc[jb][8 * s2 + 1]), pack_bf16(sc[jb][8 * s2 + 2], sc[jb][8 * s2 + 3]),
                 pack_bf16(sc[jb][8 * s2 + 4], sc[jb][8 * s2 + 5]), pack_bf16(sc[jb][8 * s2 + 6], sc[jb][8 * s2 + 7])};
      pf[jb * 2 + s2] = *(bf16x8*)&w;
    }
  f32x16 o[4];
#pragma unroll
  for (int c = 0; c < 4; ++c)
#pragma unroll
    for (int r = 0; r < 16; ++r) o[c][r] = 0.f;
  const char* Vimg = Vs + dvh * 16384;
  const char* Simg = Sp + dvh * 32768;
#pragma unroll
  for (int c = 0; c < 4; ++c) {
#pragma unroll
    for (int kk = 0; kk < 4; ++kk) {
      if ((kk >> 1) <= ib) {
        const unsigned rbase = 32 * (kk >> 1) + 16 * (kk & 1) + 4 * hh;
        bf16x8 a = tr_frag(Vimg, lane, c, rbase, rbase + 8);
        o[c] = __builtin_amdgcn_mfma_f32_32x32x16_bf16(a, pf[kk], o[c], 0, 0, 0);
      }
    }
#pragma unroll
    for (int ks = 0; ks < 8; ++ks) {
      const unsigned r0 = 16 * ks + 8 * hh;
      bf16x8 a = tr_frag(Simg, lane, c, r0, r0 + 4);
      bf16x8 bq = *(const bf16x8*)(Qd + off_b(ib * 32 + l31, 2 * ks + hh));
      o[c] = __builtin_amdgcn_mfma_f32_32x32x16_bf16(a, bq, o[c], 0, 0, 0);
    }
  }
  float ss = 0.f;
#pragma unroll
  for (int c = 0; c < 4; ++c)
#pragma unroll
    for (int r = 0; r < 16; ++r) ss += o[c][r] * o[c][r];
  ss += shflx(ss, 32);
  if (hh == 0) red[dvh * 64 + ib * 32 + l31] = ss;
  __syncthreads();
  const float tot = red[ib * 32 + l31] + red[64 + ib * 32 + l31];
  const float rn = rsqrtf(tot * (1.0f / 256.0f) + EPS_);
  const long t = t0 + ib * 32 + l31;
  const u16* grp = p.proj() + t * NC_ + C_GR + h * 256 + dvh * 128 + 4 * hh;
  u16* op = p.mix() + t * 2048 + h * 256 + dvh * 128 + 4 * hh;
  const float* gp = p.gla_out_norm + dvh * 128 + 4 * hh;
#pragma unroll
  for (int c = 0; c < 4; ++c)
#pragma unroll
    for (int rg = 0; rg < 4; ++rg) {
      u32x2 gw = *(const u32x2*)(grp + 32 * c + 8 * rg);
      f32x4 g = *(const f32x4*)(gp + 32 * c + 8 * rg);
      float gr[4] = {bf_lo(gw[0]), bf_hi(gw[0]), bf_lo(gw[1]), bf_hi(gw[1])};
      float ov[4];
#pragma unroll
      for (int k = 0; k < 4; ++k) { float si = gr[k] / (1.0f + __expf(-gr[k])); ov[k] = o[c][4 * rg + k] * rn * g[k] * si; }
#if WOUTQ
      {
        int q8 = 0;
        q8 = __builtin_amdgcn_cvt_pk_fp8_f32(ov[0], ov[1], q8, false);
        q8 = __builtin_amdgcn_cvt_pk_fp8_f32(ov[2], ov[3], q8, true);
        const int col = h * 256 + dvh * 128 + 4 * hh + 32 * c + 8 * rg;
        *(unsigned*)(p.mixq() + (t >> 1) * 4096 + (col >> 6) * 128 + (t & 1) * 64 + (col & 63)) = (unsigned)q8;
      }
#else
      u32x2 w = {pack_bf16(ov[0], ov[1]), pack_bf16(ov[2], ov[3])};
      *(u32x2*)(op + 32 * c + 8 * rg) = w;
#endif
    }
}

__device__ __forceinline__ void mla_norm_tokens(const Params& p) {
  const int tid_ = opaque_tid(); const int lane = tid_ & 63, wid = tid_ >> 6;
  for (int t = blockIdx.x * 4 + wid; t < T_; t += gridDim.x * 4) {
    const u16* src = p.omla() + (long)t * 1024;
    u32x4 a = *(const u32x4*)(src + lane * 8), b = *(const u32x4*)(src + 512 + lane * 8);
    float ss = 0.f;
#pragma unroll
    for (int k = 0; k < 4; ++k) { float x0 = bf_lo(a[k]), x1 = bf_hi(a[k]), y0 = bf_lo(b[k]), y1 = bf_hi(b[k]); ss += x0 * x0 + x1 * x1 + y0 * y0 + y1 * y1; }
    ss = wave_sum(ss);
    const float r = rsqrtf(ss * (1.0f / 1024.0f) + EPS_);
    const float* g = p.mla_out_norm;
    u32x4 wa, wb;
#pragma unroll
    for (int k = 0; k < 4; ++k) {
      wa[k] = pack_bf16(bf_lo(a[k]) * r * g[lane * 8 + 2 * k], bf_hi(a[k]) * r * g[lane * 8 + 2 * k + 1]);
      wb[k] = pack_bf16(bf_lo(b[k]) * r * g[512 + lane * 8 + 2 * k], bf_hi(b[k]) * r * g[512 + lane * 8 + 2 * k + 1]);
    }
#if WOUTQ
    {
      int qa0 = 0, qa1 = 0, qb0 = 0, qb1 = 0;
      qa0 = __builtin_amdgcn_cvt_pk_fp8_f32(bf_lo(wa[0]), bf_hi(wa[0]), qa0, false); qa0 = __builtin_amdgcn_cvt_pk_fp8_f32(bf_lo(wa[1]), bf_hi(wa[1]), qa0, true);
      qa1 = __builtin_amdgcn_cvt_pk_fp8_f32(bf_lo(wa[2]), bf_hi(wa[2]), qa1, false); qa1 = __builtin_amdgcn_cvt_pk_fp8_f32(bf_lo(wa[3]), bf_hi(wa[3]), qa1, true);
      qb0 = __builtin_amdgcn_cvt_pk_fp8_f32(bf_lo(wb[0]), bf_hi(wb[0]), qb0, false); qb0 = __builtin_amdgcn_cvt_pk_fp8_f32(bf_lo(wb[1]), bf_hi(wb[1]), qb0, true);
      qb1 = __builtin_amdgcn_cvt_pk_fp8_f32(bf_lo(wb[2]), bf_hi(wb[2]), qb1, false); qb1 = __builtin_amdgcn_cvt_pk_fp8_f32(bf_lo(wb[3]), bf_hi(wb[3]), qb1, true);
      const int ca = 1024 + lane * 8, cb = 1536 + lane * 8;
      const long tt = t;
      u32x2 va = {(unsigned)qa0, (unsigned)qa1}, vb = {(unsigned)qb0, (unsigned)qb1};
      *(u32x2*)(p.mixq() + (tt >> 1) * 4096 + (ca >> 6) * 128 + (tt & 1) * 64 + (ca & 63)) = va;
      *(u32x2*)(p.mixq() + (tt >> 1) * 4096 + (cb >> 6) * 128 + (tt & 1) * 64 + (cb & 63)) = vb;
    }
#else
    *(u32x4*)(p.mix() + (long)t * 2048 + 1024 + lane * 8) = wa;
    *(u32x4*)(p.mix() + (long)t * 2048 + 1024 + 512 + lane * 8) = wb;
#endif
  }
}
__device__ __forceinline__ void wout_tile(const Params& p, char* smem, int mt, int nt) {
  f32x16 acc[4][4];
  GemmTile t{};
  t.A = p.mix(); t.lda = 2048; t.aidx = nullptr; t.m0 = mt * 256; t.mvalid = 256;
  t.B0 = p.w_out + nt * 256; t.B1 = t.B0 + 128; t.ldb = 2048; t.nv0 = 128; t.nv1 = 128; t.kscale = nullptr; t.K = 2048;
  gemm_tile_256<4, false, false>(t, smem, acc);
  const long boff = (long)(mt * 256) * 2048 + nt * 256;
  acc_foreach_row<4>(acc, [&](int rowl, int coll, float (&v)[4]) {
    long o = boff + (long)rowl * 2048 + coll;
    OPAQUE(o);
    const float* xr = p.x + o; float* yr = p.x1() + o;
#pragma unroll
    for (int nb = 0; nb < 4; ++nb) { const int c = (nb >> 1) * 128 + (nb & 1) * 32; yr[c] = xr[c] + v[nb]; }
  });
}

#define P7_LDS_BYTES (4 * 32 * 33 * 4 + 4 * 64 * 4 + 32 * 33 * 4 + 128)
template <int DRY = 0>
__device__ __forceinline__ void ffn_prep_unit(const Params& p, char* smem, int u) {
  float* part = (float*)smem; float* ssq = part + 4 * 32 * 33; float* lg = ssq + 256; float* rs = lg + 32 * 33;
  const int tid = opaque_tid(), lane = tid & 63, wid = tid >> 6, l31 = lane & 31, hh = lane >> 5;
  __syncthreads();
  {
    const long t = (long)u * 32 + l31;
    const float* xr = p.x1() + t * 2048 + wid * 512;
    const float* gp = p.ffn_norm + wid * 512;
    const float* wp = p.router_w + (long)(wid * 512 + hh) * 32 + l31;
    f32x16 acc;
#pragma unroll
    for (int r = 0; r < 16; ++r) acc[r] = 0.f;
    float ss = 0.f;
#pragma unroll 4
    for (int m = 0; m < 128; ++m) {
      const f32x4 xv = *(const f32x4*)(xr + 4 * m);
      const f32x4 gv = *(const f32x4*)(gp + 4 * m);
      const float a0 = hh ? xv[1] : xv[0], a1 = hh ? xv[3] : xv[2];
      const float g0 = hh ? gv[1] : gv[0], g1 = hh ? gv[3] : gv[2];
      const float b0 = wp[(4 * m) * 32], b1 = wp[(4 * m + 2) * 32];
      ss += a0 * a0 + a1 * a1;
      acc = __builtin_amdgcn_mfma_f32_32x32x2f32(a0 * g0, b0, acc, 0, 0, 0);
      acc = __builtin_amdgcn_mfma_f32_32x32x2f32(a1 * g1, b1, acc, 0, 0, 0);
    }
#pragma unroll
    for (int r = 0; r < 16; ++r) part[(wid * 32 + (r & 3) + 8 * (r >> 2) + 4 * hh) * 33 + l31] = acc[r];
    ssq[wid * 64 + lane] = ss;
  }
  __syncthreads();
  {
    const int tl = tid >> 3, seg = tid & 7;
    if (seg == 0) {
      float s = 0.f;
#pragma unroll
      for (int w = 0; w < 4; ++w) s += ssq[w * 64 + tl] + ssq[w * 64 + 32 + tl];
      rs[tl] = rsqrtf(s * (1.0f / 2048.0f) + EPS_);
    }
  }
  __syncthreads();
  {
    const int tl = tid >> 3, seg = tid & 7;
    const float r = rs[tl];
#pragma unroll
    for (int c = 0; c < 4; ++c) {
      const int e = seg * 4 + c;
      const float s = part[(0 * 32 + tl) * 33 + e] + part[(1 * 32 + tl) * 33 + e] + part[(2 * 32 + tl) * 33 + e] + part[(3 * 32 + tl) * 33 + e];
      lg[tl * 33 + e] = s * r + p.router_b[e];
    }
  }
  __syncthreads();
  if (tid < 32 && !DRY) {
    const long tt = (long)u * 32 + tid;
    const float* L = lg + tid * 33;
    unsigned used = 0u; int i0 = 0, i1 = 0, i2 = 0, i3 = 0; float v0 = 0.f, v1 = 0.f, v2 = 0.f, v3 = 0.f;
#pragma unroll
    for (int k = 0; k < 4; ++k) {
      int bi = -1; float bv = 0.f;
      for (int i = 0; i < 32; ++i) {
        const float x = L[i];
        const bool take = !((used >> i) & 1u) && (bi < 0 || x > bv);
        bi = take ? i : bi; bv = take ? x : bv;
      }
      used |= 1u << bi;
      if (k == 0) { i0 = bi; v0 = bv; } else if (k == 1) { i1 = bi; v1 = bv; } else if (k == 2) { i2 = bi; v2 = bv; } else { i3 = bi; v3 = bv; }
    }
    const float e0 = 1.0f, e1 = __expf(v1 - v0), e2 = __expf(v2 - v0), e3 = __expf(v3 - v0);
    const float inv = 1.0f / (e0 + e1 + e2 + e3);
    const int s0 = atomicAdd(&p.counts()[i0], 1), s1 = atomicAdd(&p.counts()[i1], 1), s2 = atomicAdd(&p.counts()[i2], 1), s3 = atomicAdd(&p.counts()[i3], 1);
    p.list()[i0 * T_ + s0] = (int)tt; p.list()[i1 * T_ + s1] = (int)tt; p.list()[i2 * T_ + s2] = (int)tt; p.list()[i3 * T_ + s3] = (int)tt;
    p.asg_e()[tt * 4 + 0] = i0; p.asg_e()[tt * 4 + 1] = i1; p.asg_e()[tt * 4 + 2] = i2; p.asg_e()[tt * 4 + 3] = i3;
    p.asg_slot()[tt * 4 + 0] = s0; p.asg_slot()[tt * 4 + 1] = s1; p.asg_slot()[tt * 4 + 2] = s2; p.asg_slot()[tt * 4 + 3] = s3;
    p.asg_g()[tt * 4 + 0] = e0 * inv; p.asg_g()[tt * 4 + 1] = e1 * inv; p.asg_g()[tt * 4 + 2] = e2 * inv; p.asg_g()[tt * 4 + 3] = e3 * inv;
  }
  {
    const int tl = tid >> 3, seg = tid & 7;
    const long t = (long)u * 32 + tl;
    const float* xr = p.x1() + t * 2048;
    const float rr = rs[tl];
#pragma unroll 8
    for (int it = 0; it < 32; ++it) {
      const int kk = it * 64 + seg * 8;
      f32x4 v0 = *(const f32x4*)(xr + kk), v1 = *(const f32x4*)(xr + kk + 4);
      f32x4 g0 = *(const f32x4*)(p.ffn_norm + kk), g1 = *(const f32x4*)(p.ffn_norm + kk + 4);
      v0 = v0 * g0 * rr; v1 = v1 * g1 * rr;
#if MOEQ == 0
      u32x4 w = {pack_bf16(v0[0], v0[1]), pack_bf16(v0[2], v0[3]), pack_bf16(v1[0], v1[1]), pack_bf16(v1[2], v1[3])};
      *(u32x4*)(p.h2() + t * 2048 + kk) = w;
#else
      int q0 = 0, q1 = 0;
      q0 = __builtin_amdgcn_cvt_pk_fp8_f32(v0[0], v0[1], q0, false);
      q0 = __builtin_amdgcn_cvt_pk_fp8_f32(v0[2], v0[3], q0, true);
      q1 = __builtin_amdgcn_cvt_pk_fp8_f32(v1[0], v1[1], q1, false);
      q1 = __builtin_amdgcn_cvt_pk_fp8_f32(v1[2], v1[3], q1, true);
      u32x2 wq = {(unsigned)q0, (unsigned)q1};
      *(u32x2*)(p.h2q() + t * 2048 + kk) = wq;
#endif
    }
  }
}

__device__ __forceinline__ void moe_setup(const Params& p, int* mo) {
  __syncthreads();
  if (threadIdx.x == 0) {
    int s = 0;
    for (int e = 0; e < NE_; ++e) { mo[e] = s; s += (p.counts()[e] + 255) >> 8; }
    mo[NE_] = s;
  }
  __syncthreads();
}
#ifndef MAPV
#define MAPV 0
#endif
__device__ __forceinline__ int xcd_unit(int round) { return MAPV ? (round * 256 + blockIdx.x) : (round * 256 + (blockIdx.x & 7) * 32 + (blockIdx.x >> 3)); }

__device__ __forceinline__ void moe1_tile(const Params& p, char* smem, const int* mo, int e, int nt, int mt) {
  f32x16 acc[4][4];
  GemmTile t{};
  const int cnt = p.counts()[e];
  t.A = p.h2(); t.lda = 2048; t.aidx = p.list() + e * T_ + mt * 256; t.m0 = 0; t.mvalid = min(256, cnt - mt * 256);
  t.B0 = p.w_gu + (long)e * 2048 * 4096 + nt * 128; t.B1 = t.B0 + 2048; t.ldb = 4096; t.nv0 = 128; t.nv1 = 128; t.kscale = nullptr; t.K = 2048;
  gemm_tile_256<4, false, true>(t, smem, acc);
  u16* base = p.act() + (long)(mo[e] * 256 + mt * 256) * 2048 + nt * 128;
  const float* bg = p.b_gu + e * 4096 + nt * 128; const float* bu = bg + 2048;
  const int tq_ = opaque_tid(); const int cl = (tq_ >> 6 & 1) * 64 + (tq_ & 31);
  const float bgv[2] = {bg[cl], bg[cl + 32]}, buv[2] = {bu[cl], bu[cl + 32]};
  acc_foreach_row<4>(acc, [&](int rowl, int coll, float (&v)[4]) {
    u16* rp = base + (long)rowl * 2048 + coll;
    OPAQUE(rp);
#pragma unroll
    for (int nb = 0; nb < 2; ++nb) {
      const int c = nb * 32;
      float g = fminf(v[nb] + bgv[nb], 7.0f);
      float uu = fminf(fmaxf(v[nb + 2] + buv[nb], -7.0f), 7.0f);
      float a = (uu + 1.0f) * (g / (1.0f + __expf(-1.702f * g)));
      rp[c] = f32_to_bf16(a);
    }
  });
}
__device__ __forceinline__ void moe2_tile(const Params& p, char* smem, const int* mo, int e, int nt, int mt) {
  f32x16 acc[4][4];
  GemmTile t{};
  t.A = p.act(); t.lda = 2048; t.aidx = nullptr; t.m0 = mo[e] * 256 + mt * 256; t.mvalid = 256;
  t.B0 = p.w_dn + (long)e * 2048 * 2048 + nt * 256; t.B1 = t.B0 + 128; t.ldb = 2048; t.nv0 = 128; t.nv1 = 128; t.kscale = nullptr; t.K = 2048;
  gemm_tile_256<4, false, false>(t, smem, acc);
  u16* base = p.ybuf() + (long)t.m0 * 2048 + nt * 256;
  const float* bd = p.b_dn + e * 2048 + nt * 256;
  const int tq_ = opaque_tid(); const int cl = (tq_ >> 6 & 1) * 64 + (tq_ & 31);
  const float bdv[4] = {bd[cl], bd[cl + 32], bd[cl + 128], bd[cl + 160]};
  acc_foreach_row<4>(acc, [&](int rowl, int coll, float (&v)[4]) {
    u16* rp = base + (long)rowl * 2048 + coll;
    OPAQUE(rp);
#pragma unroll
    for (int nb = 0; nb < 4; ++nb) { const int c = (nb >> 1) * 128 + (nb & 1) * 32; rp[c] = f32_to_bf16(v[nb] + bdv[nb]); }
  });
}
template <int WHICH, int HALF = 0>
__device__ __forceinline__ void ph_moe(const Params& p, char* smem) {
  int* mo = (int*)(smem + G_LDS_BYTES);
  moe_setup(p, mo);
  const int NT = (WHICH == 1) ? 16 : 8;
  const int total = mo[NE_] * NT;
  if (HALF && ((blockIdx.x >> 3) & 1)) return;
  const int W = HALF ? 128 : 256;
  for (int round = 0;; ++round) {
    const int u = HALF ? (round * 128 + (blockIdx.x & 7) * 16 + (blockIdx.x >> 4)) : xcd_unit(round);
    if (round * W >= total) break;
    if (u >= total) continue;
    int e = 0;
    while (mo[e + 1] * NT <= u) ++e;
    const int local = u - mo[e] * NT, me = mo[e + 1] - mo[e];
    const int nt = local / me, mt = local - nt * me;
    if (WHICH == 1) moe1_tile(p, smem, mo, e, nt, mt); else moe2_tile(p, smem, mo, e, nt, mt);
  }
}

__device__ __forceinline__ void ph_final(const Params& p, char* smem, float dbg_scale = 1.0f) {
  int* mo = (int*)(smem + G_LDS_BYTES);
  moe_setup(p, mo);
  const int tid_ = opaque_tid(); const int lane = tid_ & 63, wid = tid_ >> 6;
  for (int t = blockIdx.x * 4 + wid; t < T_; t += gridDim.x * 4) {
    long rows[4]; float gg[4];
#pragma unroll
    for (int k = 0; k < 4; ++k) { rows[k] = (long)(mo[p.asg_e()[t * 4 + k]] * 256 + p.asg_slot()[t * 4 + k]) * 2048; gg[k] = p.asg_g()[t * 4 + k]; }
    f32x4 v[8]; float ss = 0.f;
#pragma unroll
    for (int j = 0; j < 8; ++j) {
      const int c = j * 256 + lane * 4;
      f32x4 a = *(const f32x4*)(p.x1() + (long)t * 2048 + c);
#pragma unroll
      for (int k = 0; k < 4; ++k) {
        u32x2 w = *(const u32x2*)(p.ybuf() + rows[k] + c);
        a[0] += gg[k] * bf_lo(w[0]); a[1] += gg[k] * bf_hi(w[0]); a[2] += gg[k] * bf_lo(w[1]); a[3] += gg[k] * bf_hi(w[1]);
      }
      v[j] = a; ss += a[0] * a[0] + a[1] * a[1] + a[2] * a[2] + a[3] * a[3];
    }
    ss = wave_sum(ss);
    const float r = rsqrtf(ss * (1.0f / 2048.0f) + EPS_);
#pragma unroll
    for (int j = 0; j < 8; ++j) {
      const int c = j * 256 + lane * 4;
      f32x4 g = *(const f32x4*)(p.final_norm + c);
      f32x4 o = {v[j][0] * r * g[0] * dbg_scale, v[j][1] * r * g[1] * dbg_scale, v[j][2] * r * g[2] * dbg_scale, v[j][3] * r * g[3] * dbg_scale};
      *(f32x4*)(p.out + (long)t * 2048 + c) = o;
    }
  }
}
#define WSCALE_  128.0f
#define WISCALE_ 0.0078125f
typedef unsigned char u8;

struct CvtUnit { const float* src; u8* dst; int ldn; };
__device__ __forceinline__ CvtUnit cvt8_decode(const Params& p, int u) {
  CvtUnit c;
  if (u < 16384) {
    const int e = u >> 9, kt = (u >> 5) & 15, nt = u & 31;
    c.src = p.w_gu + (long)e * 2048 * 4096 + (long)(kt * 128) * 4096 + nt * 128; c.ldn = 4096;
    c.dst = p.wq_gu() + ((long)e * 4096 + nt * 128) * 2048 + kt * 256;
  } else if (u >= 24576) {
    const int v = u - 24576; const int kt = (v >> 4) & 15, nt = v & 15;
    c.src = p.w_out + (long)(kt * 128) * 2048 + nt * 128; c.ldn = 2048;
    c.dst = p.wq_out() + ((long)nt * 128) * 2048 + kt * 256;
  } else {
    const int v = u - 16384; const int e = v >> 8, kt = (v >> 4) & 15, nt = v & 15;
    c.src = p.w_dn + (long)e * 2048 * 2048 + (long)(kt * 128) * 2048 + nt * 128; c.ldn = 2048;
    c.dst = p.wq_dn() + ((long)e * 2048 + nt * 128) * 2048 + kt * 256;
  }
  return c;
}
__device__ __forceinline__ void cvt8_load(const CvtUnit& c, int kq, int n4, f32x4 (&v)[16]) {
  const float* src = c.src + (long)(kq * 16) * c.ldn + n4 * 4;
#pragma unroll
  for (int j = 0; j < 16; ++j) {
    const float* ptr = src + (long)j * c.ldn;
    asm volatile("global_load_dwordx4 %0, %1, off" : "=v"(v[j]) : "v"(ptr) : "memory");
  }
}
#define CVT_WAIT(N, v) asm volatile("s_waitcnt vmcnt(%16)" : "+v"(v[0]), "+v"(v[1]), "+v"(v[2]), "+v"(v[3]), "+v"(v[4]), "+v"(v[5]), "+v"(v[6]), "+v"(v[7]), \
    "+v"(v[8]), "+v"(v[9]), "+v"(v[10]), "+v"(v[11]), "+v"(v[12]), "+v"(v[13]), "+v"(v[14]), "+v"(v[15]) : "n"(N) : "memory")
__device__ __forceinline__ void cvt8_emit(const CvtUnit& c, int tid, int kq, int n4, f32x4 (&v)[16], char* T) {
  const int lane = tid & 63, w = tid >> 6;
  char* Tw = T + w * 4096;
#pragma unroll
  for (int cc = 0; cc < 4; ++cc) {
    u32x4 x4;
#pragma unroll
    for (int q = 0; q < 4; ++q) {
      int x = 0;
      x = __builtin_amdgcn_cvt_pk_fp8_f32(v[4 * q][cc] * WSCALE_, v[4 * q + 1][cc] * WSCALE_, x, false);
      x = __builtin_amdgcn_cvt_pk_fp8_f32(v[4 * q + 2][cc] * WSCALE_, v[4 * q + 3][cc] * WSCALE_, x, true);
      x4[q] = (unsigned)x;
    }
    *(u32x4*)(Tw + (((n4 & 7) * 4 + cc) * 128) + kq * 16) = x4;
  }
#pragma unroll
  for (int i = 0; i < 4; ++i) {
    const int rl = (lane >> 3) + 8 * i, ch = lane & 7;
    const int n = 32 * w + rl;
    *(u32x4*)(c.dst + (long)(n >> 1) * 4096 + (ch >> 2) * 128 + (n & 1) * 64 + (ch & 3) * 16) = *(const u32x4*)(Tw + rl * 128 + ch * 16);
  }
}
__device__ __forceinline__ void convert_units(const Params& p, char* smem, int first, int stride, int count) {
  const int tid = opaque_tid();
  const int kq = tid & 7, n4 = tid >> 3;
  if (count <= 0) return;
  f32x4 va[16], vb[16], vc[16];
  CvtUnit ca = cvt8_decode(p, first), cb = cvt8_decode(p, first + stride), cc = cvt8_decode(p, first + 2 * stride);
  cvt8_load(ca, kq, n4, va);
  cvt8_load(cb, kq, n4, vb);
  cvt8_load(cc, kq, n4, vc);
  CVT_WAIT(32, va); cvt8_emit(ca, tid, kq, n4, va, smem); ca = cvt8_decode(p, first + 3 * stride); cvt8_load(ca, kq, n4, va);
  CVT_WAIT(36, vb); cvt8_emit(cb, tid, kq, n4, vb, smem); cb = cvt8_decode(p, first + 4 * stride); cvt8_load(cb, kq, n4, vb);
  CVT_WAIT(40, vc); cvt8_emit(cc, tid, kq, n4, vc, smem); cc = cvt8_decode(p, first + 5 * stride); cvt8_load(cc, kq, n4, vc);
  for (int i = 3; i + 3 < count; i += 3) {
    CVT_WAIT(40, va); cvt8_emit(ca, tid, kq, n4, va, smem); ca = cvt8_decode(p, first + (i + 3) * stride); cvt8_load(ca, kq, n4, va);
    CVT_WAIT(40, vb); cvt8_emit(cb, tid, kq, n4, vb, smem); cb = cvt8_decode(p, first + (i + 4) * stride); cvt8_load(cb, kq, n4, vb);
    CVT_WAIT(40, vc); cvt8_emit(cc, tid, kq, n4, vc, smem); cc = cvt8_decode(p, first + (i + 5) * stride); cvt8_load(cc, kq, n4, vc);
  }
  CVT_WAIT(0, va); cvt8_emit(ca, tid, kq, n4, va, smem);
  CVT_WAIT(0, vb); cvt8_emit(cb, tid, kq, n4, vb, smem);
  CVT_WAIT(0, vc); cvt8_emit(cc, tid, kq, n4, vc, smem);
}
__device__ __forceinline__ void convert_one(const Params& p, char* smem, int u) {
  const int tid = opaque_tid();
  const int kq = tid & 7, n4 = tid >> 3;
  f32x4 va[16];
  CvtUnit ca = cvt8_decode(p, u);
  cvt8_load(ca, kq, n4, va);
  CVT_WAIT(0, va); cvt8_emit(ca, tid, kq, n4, va, smem);
}
__device__ __forceinline__ void ph_convert(const Params& p, char* smem) {
  convert_units(p, smem, blockIdx.x, gridDim.x, 24576 / 256);
}
__device__ __forceinline__ void ph_convert_gu(const Params& p, char* smem, int part, int nparts) {
  (void)part; (void)nparts;
  convert_units(p, smem, blockIdx.x, 256, 63);
  convert_one(p, smem, blockIdx.x + 63 * 256);
}
__device__ __forceinline__ void ph_convert_dn(const Params& p, char* smem) {
  convert_units(p, smem, 16384 + blockIdx.x, 256, 30);
  convert_one(p, smem, 16384 + blockIdx.x + 30 * 256);
  convert_one(p, smem, 16384 + blockIdx.x + 31 * 256);
}

#define R_STAGE 32768
struct GemmRTile {
  const u8* A; int lda; const int* aidx; int m0, mvalid;
  const u8* B; long brow0, brow1; int ldb;
  int pairb;
  int paira;
  int KB;
};
template <bool FP8, bool GATHER>
__device__ __forceinline__ void gemmr_tile_256(const GemmRTile& t, char* smem, f32x16 (&acc)[4][4]) {
  int tz0 = threadIdx.x; asm volatile("" : "+v"(tz0));
  const int tid = tz0, lane = tid & 63, wid = tid >> 6, wr = wid >> 1, wc = wid & 1;
  const int l31 = lane & 31, hh = lane >> 5;
#pragma unroll
  for (int i = 0; i < 4; ++i)
#pragma unroll
    for (int j = 0; j < 4; ++j)
#pragma unroll
      for (int r = 0; r < 16; ++r) acc[i][j][r] = 0.f;
  const int c_src = (tid & 3) ^ ((tid >> 4) & 3);
  const u8* a_src[GATHER ? 4 : 1];
  if (GATHER) {
#pragma unroll
    for (int i = 0; i < (GATHER ? 4 : 1); ++i) {
      int r = (tid >> 2) + 64 * i;
      int rr = r < t.mvalid ? r : 0;
      a_src[i] = t.A + (long)t.aidx[rr] * t.lda + c_src * 16;
    }
  } else {
    a_src[0] = t.A + (long)(t.m0 + (tid >> 2)) * t.lda + c_src * 16;
  }
  const long a_step = 64L * t.lda, b_step = 64L * t.ldb;
  const u8* b_src0 = t.B + (t.brow0 + (tid >> 2)) * t.ldb + c_src * 16;
  const u8* b_src1 = t.B + (t.brow1 + (tid >> 2)) * t.ldb + c_src * 16;
  const unsigned lds0 = (unsigned)(size_t)smem + (unsigned)__builtin_amdgcn_readfirstlane(wid) * 1024u;
  auto issue = [&](int kt, int sl, int q) {
    if (q < 4) glds16_asm((const void*)((GATHER ? a_src[GATHER ? q : 0] : a_src[0] + q * a_step) + kt * 64), lds0 + sl * R_STAGE + q * 4096);
    else { const int i = q - 4; glds16_asm((const void*)((i < 2 ? b_src0 + i * b_step : b_src1 + (i - 2) * b_step) + kt * 64), lds0 + sl * R_STAGE + 16384 + i * 4096); }
  };
  unsigned a_rd[2], b_rd[2];
#pragma unroll
  for (int s2 = 0; s2 < 2; ++s2) {
    const int ra = wr * 128 + l31, rb = wc * 64 + l31;
    a_rd[s2] = ra * 64 + (((2 * s2 + hh) ^ ((ra >> 2) & 3)) * 16);
    b_rd[s2] = rb * 64 + (((2 * s2 + hh) ^ ((rb >> 2) & 3)) * 16);
  }
  auto load_frags = [&](const char* St, int s2, u32x4 (&af)[4], u32x4 (&bf)[4]) {
#pragma unroll
    for (int mb = 0; mb < 4; ++mb) af[mb] = *(const u32x4*)(St + a_rd[s2] + mb * 2048);
#pragma unroll
    for (int nb = 0; nb < 4; ++nb) bf[nb] = *(const u32x4*)(St + 16384 + b_rd[s2] + (nb >> 1) * 8192 + (nb & 1) * 2048);
  };
  auto mma = [&](u32x4 (&ac)[4], u32x4 (&bc)[4], int nb) {
    if (FP8) {
#pragma unroll
      for (int u = 0; u < 2; ++u) {
        const long bl = (long)(((unsigned long long)bc[nb][2 * u + 1] << 32) | bc[nb][2 * u]);
#pragma unroll
        for (int mb = 0; mb < 4; ++mb) {
          const long al = (long)(((unsigned long long)ac[mb][2 * u + 1] << 32) | ac[mb][2 * u]);
          acc[mb][nb] = __builtin_amdgcn_mfma_f32_32x32x16_fp8_fp8(al, bl, acc[mb][nb], 0, 0, 0);
        }
      }
    } else {
      const bf16x8 bb = *(const bf16x8*)&bc[nb];
#pragma unroll
      for (int mb = 0; mb < 4; ++mb) acc[mb][nb] = __builtin_amdgcn_mfma_f32_32x32x16_bf16(*(const bf16x8*)&ac[mb], bb, acc[mb][nb], 0, 0, 0);
    }
  };
  u32x4 a0[4], b0[4], a1[4], b1[4];
  auto half0 = [&](int kt, bool issueA) {
    const char* St = smem + (kt & 3) * R_STAGE;
    load_frags(St, 1, a1, b1);
    __builtin_amdgcn_sched_barrier(0);
#pragma unroll
    for (int nb = 0; nb < 4; ++nb) {
      mma(a0, b0, nb);
      __builtin_amdgcn_sched_barrier(0);
      if (issueA) issue(kt + 2, (kt + 2) & 3, 4 + nb);
      __builtin_amdgcn_sched_barrier(0);
    }
  };
  auto half1 = [&](int kt, bool has1, bool issueB) {
    const char* Sn = smem + ((kt + 1) & 3) * R_STAGE;
    if (has1) load_frags(Sn, 0, a0, b0);
    __builtin_amdgcn_sched_barrier(0);
#pragma unroll
    for (int nb = 0; nb < 4; ++nb) {
      mma(a1, b1, nb);
      __builtin_amdgcn_sched_barrier(0);
      if (issueB) issue(kt + 3, (kt + 3) & 3, nb);
      __builtin_amdgcn_sched_barrier(0);
    }
  };
  const int nk = t.KB >> 6;
  __syncthreads();
#pragma unroll
  for (int q = 0; q < 8; ++q) issue(0, 0, q);
#pragma unroll
  for (int q = 0; q < 8; ++q) issue(1, 1, q);
#pragma unroll
  for (int q = 0; q < 4; ++q) issue(2, 2, q);
  asm volatile("s_waitcnt vmcnt(12)" ::: "memory");
  __syncthreads();
  load_frags(smem, 0, a0, b0);
  for (int kt = 0; kt < nk - 3; ++kt) {
    half0(kt, true);
    asm volatile("s_waitcnt vmcnt(8)" ::: "memory");
    __syncthreads();
    half1(kt, true, true);
  }
  half0(nk - 3, true);
  asm volatile("s_waitcnt vmcnt(8)" ::: "memory");
  __syncthreads();
  half1(nk - 3, true, false);
  half0(nk - 2, false);
  asm volatile("s_waitcnt vmcnt(0)" ::: "memory");
  __syncthreads();
  half1(nk - 2, true, false);
  half0(nk - 1, false);
  half1(nk - 1, false, false);
}


typedef int i32x8 __attribute__((ext_vector_type(8)));
template <bool GATHER>
__device__ __forceinline__ void gemmrs_tile_256(const GemmRTile& t, char* smem, f32x16 (&acc)[4][4]) {
  int tz0 = threadIdx.x; asm volatile("" : "+v"(tz0));
  const int tid = tz0, lane = tid & 63, wid = tid >> 6, wr = wid >> 1, wc = wid & 1;
  const int l31 = lane & 31, hh = lane >> 5;
#pragma unroll
  for (int i = 0; i < 4; ++i)
#pragma unroll
    for (int j = 0; j < 4; ++j)
#pragma unroll
      for (int r = 0; r < 16; ++r) acc[i][j][r] = 0.f;
  const int c_src = (tid & 3) ^ ((tid >> 4) & 3);
  const u8* a_src[GATHER ? 4 : 1];
  if (GATHER) {
#pragma unroll
    for (int i = 0; i < (GATHER ? 4 : 1); ++i) {
      int r = (tid >> 2) + 64 * i;
      int rr = r < t.mvalid ? r : 0;
      a_src[i] = t.A + (long)t.aidx[rr] * t.lda + c_src * 16;
    }
  } else {
    a_src[0] = t.A + ((long)(t.m0 + (tid >> 2)) >> 1) * 4096 + ((tid >> 2) & 1) * 64 + c_src * 16;
  }
  const long a_step = GATHER ? 64L * t.lda : 32L * 4096, b_step = 32L * 4096;
  const int a_kstep = GATHER ? 64 : 128;
  const int brl = tid >> 2;
  const u8* b_src0 = t.B + ((t.brow0 + brl) >> 1) * 4096 + (brl & 1) * 64 + c_src * 16;
  const u8* b_src1 = t.B + ((t.brow1 + brl) >> 1) * 4096 + (brl & 1) * 64 + c_src * 16;
  const unsigned lds0 = (unsigned)(size_t)smem + (unsigned)__builtin_amdgcn_readfirstlane(wid) * 1024u;
  auto issue = [&](int kt, int sl, int q) {
    if (q < 4) glds16_asm((const void*)((GATHER ? a_src[GATHER ? q : 0] : a_src[0] + q * a_step) + kt * a_kstep), lds0 + sl * R_STAGE + q * 4096);
    else { const int i = q - 4; glds16_asm((const void*)((i < 2 ? b_src0 + i * b_step : b_src1 + (i - 2) * b_step) + kt * 128), lds0 + sl * R_STAGE + 16384 + i * 4096); }
  };
  unsigned a_rd[2], b_rd[2];
#pragma unroll
  for (int c = 0; c < 2; ++c) {
    const int ra = wr * 128 + l31, rb = wc * 64 + l31;
    a_rd[c] = ra * 64 + (((2 * hh + c) ^ ((ra >> 2) & 3)) * 16);
    b_rd[c] = rb * 64 + (((2 * hh + c) ^ ((rb >> 2) & 3)) * 16);
  }
  auto load_a = [&](const char* St, i32x8 (&af)[4]) {
#pragma unroll
    for (int mb = 0; mb < 4; ++mb) {
      const u32x4 lo = *(const u32x4*)(St + a_rd[0] + mb * 2048), hi = *(const u32x4*)(St + a_rd[1] + mb * 2048);
      af[mb] = (i32x8){(int)lo[0], (int)lo[1], (int)lo[2], (int)lo[3], (int)hi[0], (int)hi[1], (int)hi[2], (int)hi[3]};
    }
  };
  auto load_b = [&](const char* St, int nb, i32x8& bf) {
    const char* bp = St + 16384 + (nb >> 1) * 8192 + (nb & 1) * 2048;
    const u32x4 lo = *(const u32x4*)(bp + b_rd[0]), hi = *(const u32x4*)(bp + b_rd[1]);
    bf = (i32x8){(int)lo[0], (int)lo[1], (int)lo[2], (int)lo[3], (int)hi[0], (int)hi[1], (int)hi[2], (int)hi[3]};
  };
  auto mma4 = [&](i32x8 (&af)[4], i32x8& bf, int nb) {
#pragma unroll
    for (int mb = 0; mb < 4; ++mb)
      acc[mb][nb] = __builtin_amdgcn_mfma_scale_f32_32x32x64_f8f6f4(af[mb], bf, acc[mb][nb], 0, 0, 0, 0x7f7f7f7f, 0, 0x7f7f7f7f);
  };
  i32x8 aA[4], aB[4], bq[4];
  auto half0 = [&](int kt, i32x8 (&ac)[4], bool issueA) {
    const char* St = smem + (kt & 3) * R_STAGE;
    load_b(St, 2, bq[2]); load_b(St, 3, bq[3]);
    __builtin_amdgcn_sched_barrier(0);
#pragma unroll
    for (int nb = 0; nb < 2; ++nb) {
      mma4(ac, bq[nb], nb);
      __builtin_amdgcn_sched_barrier(0);
      if (issueA) { issue(kt + 2, (kt + 2) & 3, 4 + 2 * nb); issue(kt + 2, (kt + 2) & 3, 5 + 2 * nb); }
      __builtin_amdgcn_sched_barrier(0);
    }
  };
  auto half1 = [&](int kt, i32x8 (&ac)[4], i32x8 (&an)[4], bool has1, bool issueB) {
    const char* Sn = smem + ((kt + 1) & 3) * R_STAGE;
    if (has1) { load_a(Sn, an); load_b(Sn, 0, bq[0]); load_b(Sn, 1, bq[1]); }
    __builtin_amdgcn_sched_barrier(0);
#pragma unroll
    for (int nb = 2; nb < 4; ++nb) {
      mma4(ac, bq[nb], nb);
      __builtin_amdgcn_sched_barrier(0);
      if (issueB) { issue(kt + 3, (kt + 3) & 3, 2 * (nb - 2)); issue(kt + 3, (kt + 3) & 3, 2 * (nb - 2) + 1); }
      __builtin_amdgcn_sched_barrier(0);
    }
  };
  const int nk = t.KB >> 6;
  __syncthreads();
#pragma unroll
  for (int q = 0; q < 8; ++q) issue(0, 0, q);
#pragma unroll
  for (int q = 0; q < 8; ++q) issue(1, 1, q);
#pragma unroll
  for (int q = 0; q < 4; ++q) issue(2, 2, q);
  asm volatile("s_waitcnt vmcnt(12)" ::: "memory");
  __syncthreads();
  load_a(smem, aA); load_b(smem, 0, bq[0]); load_b(smem, 1, bq[1]);
  for (int kt = 0; kt < nk - 4; kt += 2) {
    half0(kt, aA, true);
    asm volatile("s_waitcnt vmcnt(8)" ::: "memory"); __syncthreads();
    half1(kt, aA, aB, true, true);
    half0(kt + 1, aB, true);
    asm volatile("s_waitcnt vmcnt(8)" ::: "memory"); __syncthreads();
    half1(kt + 1, aB, aA, true, true);
  }
  half0(nk - 4, aA, true);
  asm volatile("s_waitcnt vmcnt(8)" ::: "memory"); __syncthreads();
  half1(nk - 4, aA, aB, true, true);
  half0(nk - 3, aB, true);
  asm volatile("s_waitcnt vmcnt(8)" ::: "memory"); __syncthreads();
  half1(nk - 3, aB, aA, true, false);
  half0(nk - 2, aA, false);
  asm volatile("s_waitcnt vmcnt(0)" ::: "memory"); __syncthreads();
  half1(nk - 2, aA, aB, true, false);
  half0(nk - 1, aB, false);
  half1(nk - 1, aB, aA, false, false);
}

template <bool GATHER>
__device__ __forceinline__ void gemmrv_tile_256(const GemmRTile& t, char* smem, f32x16 (&acc)[4][4]) {
  int tz0 = threadIdx.x; asm volatile("" : "+v"(tz0));
  const int tid = tz0, lane = tid & 63, wid = tid >> 6, wr = wid >> 1, wc = wid & 1;
  const int l31 = lane & 31, hh = lane >> 5;
#pragma unroll
  for (int i = 0; i < 4; ++i)
#pragma unroll
    for (int j = 0; j < 4; ++j)
#pragma unroll
      for (int r = 0; r < 16; ++r) acc[i][j][r] = 0.f;
  const int c_src = (tid & 3) ^ ((tid >> 4) & 3);
  const u8* a_src[GATHER ? 4 : 1];
  if (GATHER) {
#pragma unroll
    for (int i = 0; i < (GATHER ? 4 : 1); ++i) {
      int r = (tid >> 2) + 64 * i;
      int rr = r < t.mvalid ? r : 0;
      a_src[i] = t.A + (long)t.aidx[rr] * t.lda + c_src * 16;
    }
  } else {
    a_src[0] = t.A + ((long)(t.m0 + (tid >> 2)) >> 1) * 4096 + ((tid >> 2) & 1) * 64 + c_src * 16;
  }
  const long a_step = GATHER ? 64L * t.lda : 32L * 4096, b_step = 32L * 4096;
  const int a_kstep = GATHER ? 64 : 128;
  const int brl = tid >> 2;
  const u8* b_src0 = t.B + ((t.brow0 + brl) >> 1) * 4096 + (brl & 1) * 64 + c_src * 16;
  const u8* b_src1 = t.B + ((t.brow1 + brl) >> 1) * 4096 + (brl & 1) * 64 + c_src * 16;
  u32x4 rs0[8], rs1[8];
  auto ldg = [&](int kt, int q, u32x4& dst) {
    const u8* ptr = (q < 4) ? ((GATHER ? a_src[GATHER ? q : 0] : a_src[0] + q * a_step) + kt * a_kstep)
                            : (((q - 4) < 2 ? b_src0 + (q - 4) * b_step : b_src1 + (q - 6) * b_step) + kt * 128);
    asm volatile("global_load_dwordx4 %0, %1, off" : "=v"(dst) : "v"(ptr) : "memory");
  };
  auto stw = [&](int sl, int q, const u32x4& src) {
    *(u32x4*)(smem + sl * R_STAGE + (q < 4 ? q * 4096 : 16384 + (q - 4) * 4096) + tid * 16) = src;
  };
#define RV_WAIT(N, r) asm volatile("s_waitcnt vmcnt(%8)" : "+v"(r[0]), "+v"(r[1]), "+v"(r[2]), "+v"(r[3]), "+v"(r[4]), "+v"(r[5]), "+v"(r[6]), "+v"(r[7]) : "n"(N) : "memory")
  unsigned a_rd[2], b_rd[2];
#pragma unroll
  for (int c = 0; c < 2; ++c) {
    const int ra = wr * 128 + l31, rb = wc * 64 + l31;
    a_rd[c] = ra * 64 + (((2 * hh + c) ^ ((ra >> 2) & 3)) * 16);
    b_rd[c] = rb * 64 + (((2 * hh + c) ^ ((rb >> 2) & 3)) * 16);
  }
  auto load_a = [&](const char* St, i32x8 (&af)[4]) {
#pragma unroll
    for (int mb = 0; mb < 4; ++mb) {
      const u32x4 lo = *(const u32x4*)(St + a_rd[0] + mb * 2048), hi = *(const u32x4*)(St + a_rd[1] + mb * 2048);
      af[mb] = (i32x8){(int)lo[0], (int)lo[1], (int)lo[2], (int)lo[3], (int)hi[0], (int)hi[1], (int)hi[2], (int)hi[3]};
    }
  };
  auto load_b = [&](const char* St, int nb, i32x8& bf) {
    const char* bp = St + 16384 + (nb >> 1) * 8192 + (nb & 1) * 2048;
    const u32x4 lo = *(const u32x4*)(bp + b_rd[0]), hi = *(const u32x4*)(bp + b_rd[1]);
    bf = (i32x8){(int)lo[0], (int)lo[1], (int)lo[2], (int)lo[3], (int)hi[0], (int)hi[1], (int)hi[2], (int)hi[3]};
  };
  auto mma4 = [&](i32x8 (&af)[4], i32x8& bf, int nb) {
#pragma unroll
    for (int mb = 0; mb < 4; ++mb)
      acc[mb][nb] = __builtin_amdgcn_mfma_scale_f32_32x32x64_f8f6f4(af[mb], bf, acc[mb][nb], 0, 0, 0, 0x7f7f7f7f, 0, 0x7f7f7f7f);
  };
  i32x8 aA[4], aB[4], bq[4];
  auto half0 = [&](int kt, i32x8 (&ac)[4]) {
    const char* St = smem + (kt & 1) * R_STAGE;
    load_b(St, 2, bq[2]); load_b(St, 3, bq[3]);
    __builtin_amdgcn_sched_barrier(0);
    mma4(ac, bq[0], 0);
    __builtin_amdgcn_sched_barrier(0);
    mma4(ac, bq[1], 1);
    __builtin_amdgcn_sched_barrier(0);
  };
  auto commit = [&](int kt, u32x4 (&rn)[8], auto wtag, bool has1, bool has3) {
    constexpr int W = decltype(wtag)::value;
    if (has1) {
      RV_WAIT(W, rn);
#pragma unroll
      for (int q = 0; q < 8; ++q) stw((kt + 1) & 1, q, rn[q]);
      if (has3) {
#pragma unroll
        for (int q = 0; q < 8; ++q) ldg(kt + 3, q, rn[q]);
      }
      __syncthreads();
    }
  };
  auto half1 = [&](int kt, i32x8 (&ac)[4], i32x8 (&an)[4], bool has1) {
    const char* Sn = smem + ((kt + 1) & 1) * R_STAGE;
    if (has1) { load_a(Sn, an); load_b(Sn, 0, bq[0]); load_b(Sn, 1, bq[1]); }
    __builtin_amdgcn_sched_barrier(0);
    mma4(ac, bq[2], 2);
    __builtin_amdgcn_sched_barrier(0);
    mma4(ac, bq[3], 3);
    __builtin_amdgcn_sched_barrier(0);
  };
#define IC(n) std::integral_constant<int, n>{}
  const int nk = t.KB >> 6;
  __syncthreads();
#pragma unroll
  for (int q = 0; q < 8; ++q) ldg(0, q, rs0[q]);
#pragma unroll
  for (int q = 0; q < 8; ++q) ldg(1, q, rs1[q]);
  RV_WAIT(8, rs0);
#pragma unroll
  for (int q = 0; q < 8; ++q) stw(0, q, rs0[q]);
#pragma unroll
  for (int q = 0; q < 8; ++q) ldg(2, q, rs0[q]);
  __syncthreads();
  load_a(smem, aA); load_b(smem, 0, bq[0]); load_b(smem, 1, bq[1]);
  for (int kt = 0; kt < nk - 4; kt += 2) {
    half0(kt, aA);      commit(kt, rs1, IC(8), true, true);      half1(kt, aA, aB, true);
    half0(kt + 1, aB);  commit(kt + 1, rs0, IC(8), true, true);  half1(kt + 1, aB, aA, true);
  }
  half0(nk - 4, aA);  commit(nk - 4, rs1, IC(8), true, true);   half1(nk - 4, aA, aB, true);
  half0(nk - 3, aB);  commit(nk - 3, rs0, IC(8), true, false);  half1(nk - 3, aB, aA, true);
  half0(nk - 2, aA);  commit(nk - 2, rs1, IC(0), true, false);  half1(nk - 2, aA, aB, true);
  half0(nk - 1, aB);                                            half1(nk - 1, aB, aA, false);
#undef IC
#undef RV_WAIT
}

__device__ __forceinline__ void cvt16_tile(const float* W, int col0, int ldn, int nvalid  , const float* kgain,
                                           u16* out  , int ldk, char* T) {
  const int tid = opaque_tid();
  const int kq = tid & 7, n4 = tid >> 3;
  f32x4 v[16];
  const bool ok = (n4 * 4) < nvalid;
  const float* src = W + (long)(kq * 16) * ldn + (ok ? n4 * 4 : -col0);
#pragma unroll
  for (int j = 0; j < 16; ++j) v[j] = *(const f32x4*)(src + (long)j * ldn);
  if (kgain) {
#pragma unroll
    for (int j = 0; j < 16; ++j) v[j] *= kgain[kq * 16 + j];
  }
  if (!ok) {
#pragma unroll
    for (int j = 0; j < 16; ++j) v[j] = (f32x4){0.f, 0.f, 0.f, 0.f};
  }
  __syncthreads();
#pragma unroll
  for (int c = 0; c < 4; ++c) {
    u32x4 w0, w1;
#pragma unroll
    for (int q = 0; q < 4; ++q) { w0[q] = pack_bf16(v[2 * q][c], v[2 * q + 1][c]); w1[q] = pack_bf16(v[8 + 2 * q][c], v[8 + 2 * q + 1][c]); }
    *(u32x4*)(T + (n4 * 4 + c) * 256 + kq * 32) = w0;
    *(u32x4*)(T + (n4 * 4 + c) * 256 + kq * 32 + 16) = w1;
  }
  __syncthreads();
#pragma unroll
  for (int i = 0; i < 8; ++i) {
    const int n = (tid >> 4) + 16 * i, ch = tid & 15;
    *(u32x4*)((char*)(out + (long)n * ldk) + ch * 16) = *(const u32x4*)(T + n * 256 + ch * 16);
  }
}
__device__ __forceinline__ void convert_one(const Params& p, char* smem, int u);
__device__ __forceinline__ void ph_convert_dense(const Params& p, char* smem) {
#if WOUTQ
  convert_one(p, smem, 24576 + blockIdx.x);
#endif
  for (int u = blockIdx.x; u < 912; u += gridDim.x) {
    if (u < 544) { const int kt = u / 34, nt = u % 34; const int nv = NC_ - nt * 128;
      cvt16_tile(p.w_in + (long)(kt * 128) * NC_ + nt * 128, nt * 128, NC_, nv < 0 ? 0 : nv, nullptr, p.wb_in() + (long)(nt * 128) * 2048 + kt * 128, 2048, smem);
    } else if (u < 592) { const int v = u - 544; const int kt = v / 12, nt = v % 12;
      cvt16_tile(p.w_uq + (long)(kt * 128) * 1536 + nt * 128, nt * 128, 1536, 128, p.q_norm + kt * 128, p.wb_uq() + (long)(nt * 128) * 512 + kt * 128, 512, smem);
    } else if (u < 656) { const int v = u - 592; const int kt = v >> 4, nt = v & 15;
      cvt16_tile(p.w_ukv + (long)(kt * 128) * 2048 + nt * 128, nt * 128, 2048, 128, p.kv_norm + kt * 128, p.wb_ukv() + (long)(nt * 128) * 512 + kt * 128, 512, smem);
    } else if (!WOUTQ) { const int v = u - 656; const int kt = v >> 4, nt = v & 15;
      cvt16_tile(p.w_out + (long)(kt * 128) * 2048 + nt * 128, nt * 128, 2048, 128, nullptr, p.wb_out() + (long)(nt * 128) * 2048 + kt * 128, 2048, smem);
    }
  }
}


template <class F>
__device__ __forceinline__ void epi_store_bf16(f32x16 (&acc)[4][4], char* smem, u16* gbase  , int ld, int ncols0, int ncols1, F f) {
  int tz = threadIdx.x; asm volatile("" : "+v"(tz));
  const int lane = tz & 63, wid = tz >> 6, wr = wid >> 1, wc = wid & 1, l31 = lane & 31, hh = lane >> 5;
  __syncthreads();
  char* st = smem + wid * 32768;
#pragma unroll
  for (int mb = 0; mb < 4; ++mb)
#pragma unroll
    for (int reg = 0; reg < 16; ++reg) {
      const int r = mb * 32 + (reg & 3) + 8 * (reg >> 2) + 4 * hh;
      float v[4] = {acc[mb][0][reg], acc[mb][1][reg], acc[mb][2][reg], acc[mb][3][reg]};
      f(wr * 128 + r, wc * 64 + l31, v);
#pragma unroll
      for (int nb = 0; nb < 4; ++nb) *(u16*)(st + r * 256 + (nb * 32 + l31) * 2) = f32_to_bf16(v[nb]);
    }
  const int ch = lane & 15, span = ch >> 3;
  const int gcol = span * 128 + wc * 64 + (ch & 7) * 8;
  const bool ok = ((wc * 64 + (ch & 7) * 8) < (span ? ncols1 : ncols0));
#pragma unroll 8
  for (int it = 0; it < 32; ++it) {
    const int r = it * 4 + (lane >> 4);
    const u32x4 w = *(const u32x4*)(st + r * 256 + ch * 16);
    if (ok) *(u32x4*)(gbase + (long)(wr * 128 + r) * ld + gcol) = w;
  }
}
template <class F>
__device__ __forceinline__ void epi_store_act8(f32x16 (&acc)[4][4], char* smem, u8* gbase  , long row0, int cb0, F f) {
  int tz = threadIdx.x; asm volatile("" : "+v"(tz));
  const int lane = tz & 63, wid = tz >> 6, wr = wid >> 1, wc = wid & 1, l31 = lane & 31, hh = lane >> 5;
  __syncthreads();
  char* st = smem + wid * 32768;
#pragma unroll
  for (int mb = 0; mb < 4; ++mb)
#pragma unroll
    for (int reg = 0; reg < 16; ++reg) {
      const int r = mb * 32 + (reg & 3) + 8 * (reg >> 2) + 4 * hh;
      float v[4] = {acc[mb][0][reg], acc[mb][1][reg], acc[mb][2][reg], acc[mb][3][reg]};
      f(wr * 128 + r, wc * 64 + l31, v);
      const int q = __builtin_amdgcn_cvt_pk_fp8_f32(v[0], v[1], 0, false);
      *(u8*)(st + r * 64 + l31) = (u8)(q & 0xff);
      *(u8*)(st + r * 64 + 32 + l31) = (u8)((q >> 8) & 0xff);
    }
  const int ch = lane & 3;
#pragma unroll 8
  for (int it = 0; it < 8; ++it) {
    const int r = it * 16 + (lane >> 2);
    const u32x4 w = *(const u32x4*)(st + r * 64 + ch * 16);
    const long rg = row0 + wr * 128 + r;
    *(u32x4*)(gbase + (rg >> 1) * 4096 + (long)(cb0 + wc) * 128 + (rg & 1) * 64 + ch * 16) = w;
  }
}
__device__ __forceinline__ void epi_store_f32_resid(f32x16 (&acc)[4][4], char* smem, const float* resid, float* out, int ld, float osc) {
  int tz = threadIdx.x; asm volatile("" : "+v"(tz));
  const int lane = tz & 63, wid = tz >> 6, wr = wid >> 1, wc = wid & 1, l31 = lane & 31, hh = lane >> 5;
  __syncthreads();
  char* st = smem + wid * 32768;
#pragma unroll
  for (int half = 0; half < 2; ++half) {
#pragma unroll
    for (int m2 = 0; m2 < 2; ++m2)
#pragma unroll
      for (int reg = 0; reg < 16; ++reg) {
        const int mb = half * 2 + m2;
        const int r = m2 * 32 + (reg & 3) + 8 * (reg >> 2) + 4 * hh;
#pragma unroll
        for (int nb = 0; nb < 4; ++nb) *(float*)(st + r * 512 + (nb * 32 + l31) * 4) = acc[mb][nb][reg];
      }
    const int ch = lane & 31, span = ch >> 4;
    const int gcol = span * 128 + wc * 64 + (ch & 15) * 4;
#pragma unroll 8
    for (int it = 0; it < 32; ++it) {
      const int r = it * 2 + (lane >> 5);
      const f32x4 a = *(const f32x4*)(st + r * 512 + ch * 16);
      const long o = (long)(wr * 128 + half * 64 + r) * ld + gcol;
      const f32x4 x = *(const f32x4*)(resid + o);
      *(f32x4*)(out + o) = a * osc + x;
    }
  }
}

template <int NBV>
__device__ __forceinline__ void win_tile_r(const Params& p, char* smem, int mt, int nt) {
  f32x16 acc[4][4];
  GemmRTile t{};
  t.A = (const u8*)p.h1(); t.lda = 4096; t.aidx = nullptr; t.m0 = mt * 256; t.mvalid = 256;
  t.B = (const u8*)p.wb_in(); t.brow0 = nt * 256; t.brow1 = nt * 256 + 128; t.ldb = 4096; t.KB = 4096;
  gemmr_tile_256<false, false>(t, smem, acc);
  const int rem = NC_ - nt * 256;
  const int nv0 = rem >= 128 ? 128 : rem, nv1 = rem >= 256 ? 128 : (rem > 128 ? rem - 128 : 0);
  epi_store_bf16(acc, smem, p.proj() + (long)(mt * 256) * NC_ + nt * 256, NC_, nv0, nv1, [&](int, int, float (&)[4]) {});
}
__device__ __forceinline__ void ph_win_r(const Params& p, char* smem) {
  const int x = blockIdx.x & 7, slot = blockIdx.x >> 3;
  for (int j = slot; j < 68; j += 32) win_tile_r<4>(p, smem, 4 * x + (j & 3), j >> 2);
}
__device__ __forceinline__ void upq_tile_r(const Params& p, char* smem, int mt, int nt) {
  f32x16 acc[4][4];
  GemmRTile t{};
  t.A = (const u8*)(p.proj() + C_MQ); t.lda = NC_ * 2; t.aidx = nullptr; t.m0 = mt * 256; t.mvalid = 256;
  t.B = (const u8*)p.wb_uq(); t.brow0 = nt * 256; t.brow1 = nt * 256 + 128; t.ldb = 1024; t.KB = 1024;
  gemmr_tile_256<false, false>(t, smem, acc);
  const float* rq = p.rq() + mt * 256;
  epi_store_bf16(acc, smem, p.q() + (long)(mt * 256) * 1536 + nt * 256, 1536, 128, 128, [&](int rowl, int, float (&v)[4]) {
    const float s = rq[rowl] * QSCALE_;
#pragma unroll
    for (int nb = 0; nb < 4; ++nb) v[nb] *= s;
  });
}
__device__ __forceinline__ void upkv_tile_r(const Params& p, char* smem, int mt, int nt) {
  f32x16 acc[4][4];
  GemmRTile t{};
  t.A = (const u8*)(p.proj() + C_MKV); t.lda = NC_ * 2; t.aidx = nullptr; t.m0 = mt * 256; t.mvalid = 256;
  t.B = (const u8*)p.wb_ukv(); t.brow0 = nt * 256; t.brow1 = nt * 256 + 128; t.ldb = 1024; t.KB = 1024;
  gemmr_tile_256<false, false>(t, smem, acc);
  const float* rk = p.rkv() + mt * 256;
  epi_store_bf16(acc, smem, p.kv() + (long)(mt * 256) * 2048 + nt * 256, 2048, 128, 128, [&](int rowl, int, float (&v)[4]) {
    const float s = rk[rowl];
#pragma unroll
    for (int nb = 0; nb < 4; ++nb) v[nb] *= s;
  });
}
__device__ __forceinline__ void wout_tile_r(const Params& p, char* smem, int mt, int nt) {
  f32x16 acc[4][4];
  GemmRTile t{};
#if WOUTQ
  t.A = p.mixq(); t.lda = 2048; t.aidx = nullptr; t.m0 = mt * 256; t.mvalid = 256;
  t.B = p.wq_out(); t.brow0 = nt * 256; t.brow1 = nt * 256 + 128; t.ldb = 2048; t.KB = 2048;
  gemmrs_tile_256<false>(t, smem, acc);
  const float osc = WISCALE_;
#else
  t.A = (const u8*)p.mix(); t.lda = 4096; t.aidx = nullptr; t.m0 = mt * 256; t.mvalid = 256;
  t.B = (const u8*)p.wb_out(); t.brow0 = nt * 256; t.brow1 = nt * 256 + 128; t.ldb = 4096; t.KB = 4096;
  gemmr_tile_256<false, false>(t, smem, acc);
  const float osc = 1.0f;
#endif
  const long boff = (long)(mt * 256) * 2048 + nt * 256;
  epi_store_f32_resid(acc, smem, p.x + boff, p.x1() + boff, 2048, osc);
}

__device__ __forceinline__ void moe1q_tile(const Params& p, char* smem, const int* mo, int e, int nt, int mt) {
  f32x16 acc[4][4];
  GemmRTile t{};
  const int cnt = p.counts()[e];
  t.A = p.h2q(); t.lda = 2048; t.aidx = p.list() + e * T_ + mt * 256; t.m0 = 0; t.mvalid = min(256, cnt - mt * 256);
  t.B = p.wq_gu(); t.brow0 = (long)e * 4096 + nt * 128; t.brow1 = t.brow0 + 2048; t.ldb = 2048; t.KB = 2048;
#if MOEQ == 3
  gemmrv_tile_256<true>(t, smem, acc);
#elif MOEQ == 2
  gemmrs_tile_256<true>(t, smem, acc);
#else
  gemmr_tile_256<true, true>(t, smem, acc);
#endif
  const float* bg = p.b_gu + e * 4096 + nt * 128; const float* bu = bg + 2048;
  const int tq_ = opaque_tid(); const int cl = (tq_ >> 6 & 1) * 64 + (tq_ & 31);
  const float bgv[2] = {bg[cl], bg[cl + 32]}, buv[2] = {bu[cl], bu[cl + 32]};
  epi_store_act8(acc, smem, p.actq(), (long)(mo[e] * 256 + mt * 256), nt * 2, [&](int, int, float (&v)[4]) {
#pragma unroll
    for (int nb = 0; nb < 2; ++nb) {
      float g = fminf(v[nb] * WISCALE_ + bgv[nb], 7.0f);
      float uu = fminf(fmaxf(v[nb + 2] * WISCALE_ + buv[nb], -7.0f), 7.0f);
      v[nb] = (uu + 1.0f) * (g / (1.0f + __expf(-1.702f * g)));
    }
  });
}
__device__ __forceinline__ void moe2q_tile(const Params& p, char* smem, const int* mo, int e, int nt, int mt) {
  f32x16 acc[4][4];
  GemmRTile t{};
  t.A = p.actq(); t.lda = 2048; t.aidx = nullptr; t.m0 = mo[e] * 256 + mt * 256; t.mvalid = 256;
  t.B = p.wq_dn(); t.brow0 = (long)e * 2048 + nt * 256; t.brow1 = t.brow0 + 128; t.ldb = 2048; t.KB = 2048;
#if MOEQ == 3
  gemmrv_tile_256<false>(t, smem, acc);
#elif MOEQ == 2
  gemmrs_tile_256<false>(t, smem, acc);
#else
  gemmr_tile_256<true, false>(t, smem, acc);
#endif
  const float* bd = p.b_dn + e * 2048 + nt * 256;
  const int tq_ = opaque_tid(); const int cl = (tq_ >> 6 & 1) * 64 + (tq_ & 31);
  const float bdv[4] = {bd[cl], bd[cl + 32], bd[cl + 128], bd[cl + 160]};
  epi_store_bf16(acc, smem, p.ybuf() + (long)t.m0 * 2048 + nt * 256, 2048, 128, 128, [&](int, int, float (&v)[4]) {
#pragma unroll
    for (int nb = 0; nb < 4; ++nb) v[nb] = v[nb] * WISCALE_ + bdv[nb];
  });
}
template <int WHICH>
__device__ __forceinline__ void ph_moeq(const Params& p, char* smem) {
  int* mo = (int*)(smem + G_LDS_BYTES);
#if CVT_SPLIT
  const bool dn_first = ((blockIdx.x >> 3) & 1) != 0;
  if (WHICH == 1 && dn_first) ph_convert_dn(p, smem);
#endif
  moe_setup(p, mo);
  const int NT = (WHICH == 1) ? 16 : 8;
  const int total = mo[NE_] * NT;
#if SKEW
  { const int sl = (blockIdx.x >> 3) % 5; for (int i = 0; i < sl; ++i) __builtin_amdgcn_s_sleep(SKEW); }
#endif
  for (int round = 0;; ++round) {
    const int u = xcd_unit(round);
    if (round * 256 >= total) break;
    if (u >= total) continue;
    int e = 0;
    while (mo[e + 1] * NT <= u) ++e;
    const int local = u - mo[e] * NT, me = mo[e + 1] - mo[e];
    const int nt = local / me, mt = local - nt * me;
    if (WHICH == 1) moe1q_tile(p, smem, mo, e, nt, mt); else moe2q_tile(p, smem, mo, e, nt, mt);
  }
#if CVT_SPLIT
  if (WHICH == 1 && !dn_first) ph_convert_dn(p, smem);
#endif
}
#define LDS_MAX 143360
#ifndef DUP
#define DUP 0
#endif
#ifndef MOEQ
#define MOEQ 1
#endif
#ifndef CVT_SPLIT
#define CVT_SPLIT 1
#endif
#ifndef CVT_STAGGER
#define CVT_STAGGER 1
#endif
#ifndef CVT_IN_P4
#define CVT_IN_P4 1
#endif
#ifndef TSTAMP
#define TSTAMP 0
#endif
#ifndef DENSER
#define DENSER 1
#endif
__global__ void __launch_bounds__(256, 1) mega(Params p) {
  extern __shared__ __attribute__((aligned(16))) char smem[];
  volatile LAS unsigned* xbw = (volatile LAS unsigned*)(smem + LDS_MAX - 16);
  if (threadIdx.x == 0) { xbw[0] = 0u; xbw[1] = 0u; xbw[2] = 0u; xbw[3] = 0u; }
  __syncthreads();
  (void)xcd_barrier_post(p.bar(), xbw);
#if TSTAMP
  unsigned long long ts0 = wall_clock64();
  int bar_no = 0;
#define XBAR() do { XcdBarrier bar_; bar_.bar = p.bar(); bar_.x = xb_xcc_id(); bar_.st = (volatile LAS unsigned*)(smem + LDS_MAX - 16); xcd_barrier(bar_); ++bar_no; if (bar_no == TSTAMP && blockIdx.x == 0 && threadIdx.x == 0) { ((float*)p.counts())[48] = (float)(wall_clock64() - ts0) * (1.0f / 100.0f); } } while (0)
#else
#define XBAR() do { XcdBarrier bar_; bar_.bar = p.bar(); bar_.x = xb_xcc_id(); bar_.st = (volatile LAS unsigned*)(smem + LDS_MAX - 16); xcd_barrier(bar_); } while (0)
#endif
#if DUP == 100
  for (int rep_ = 0; rep_ < 2; ++rep_) {
  if (rep_) XBAR();
#endif
  ph_prep0(p);
#if DUP == 33
  if (blockIdx.x < 192) gla_g1_unit(p, smem, blockIdx.x);
  else for (int i = 0; i < 5; ++i) gla_g1_unit(p, smem, 192 + (blockIdx.x - 192) * 5 + i);
#endif
#if DUP == 30
  ph_prep0(p);
#endif
#if DENSER
  ph_convert_dense(p, smem);
#endif
#if MOEQ >= 1 && CVT_IN_P4 == 0
  ph_convert(p, smem);
#if DUP == 20
  ph_convert(p, smem);
#endif
#endif
  XBAR();
#if DENSER
  ph_win_r(p, smem);
#else
  ph_win(p, smem);
#endif
#if DUP == 1
#if DENSER
  ph_win_r(p, smem);
#else
  ph_win(p, smem);
#endif
#endif
  XBAR();
  ph_prep1(p, smem);
#if DUP == 2
  ph_prep1(p, smem);
#endif
  XBAR();
#if DENSER
  upkv_tile_r(p, smem, blockIdx.x >> 3, blockIdx.x & 7);
  if (blockIdx.x < 192) upq_tile_r(p, smem, blockIdx.x / 6, blockIdx.x % 6);
#else
  upkv_tile(p, smem, blockIdx.x >> 3, blockIdx.x & 7);
  if (blockIdx.x < 192) upq_tile(p, smem, blockIdx.x / 6, blockIdx.x % 6);
#endif
  if (blockIdx.x < 192) gla_g1_unit(p, smem, blockIdx.x);
  else for (int i = 0; i < 4; ++i) gla_g1_unit(p, smem, 192 + (blockIdx.x - 192) * 4 + i);
  if (blockIdx.x < 64) gla_g1_unit(p, smem, 448 + blockIdx.x);
#if DUP == 3
  upkv_tile(p, smem, blockIdx.x >> 3, blockIdx.x & 7);
  if (blockIdx.x < 192) upq_tile(p, smem, blockIdx.x / 6, blockIdx.x % 6);
  if (blockIdx.x < 192) gla_g1_unit(p, smem, blockIdx.x);
  else for (int i = 0; i < 5; ++i) gla_g1_unit(p, smem, 192 + (blockIdx.x - 192) * 5 + i);
#endif
  XBAR();
  gla_g2_unit(p, blockIdx.x);
#if DUP == 31
  gla_g2_unit(p, blockIdx.x);
#endif
  {
    const int bh = blockIdx.x >> 4, qa = blockIdx.x & 15;
#if MOEQ >= 1 && CVT_IN_P4
    const bool cvt_first = CVT_STAGGER ? (((blockIdx.x >> 3) & 1) != 0) : false;
    if (cvt_first) { if (CVT_SPLIT) ph_convert_gu(p, smem, 0, 1); else ph_convert(p, smem); }
#endif
    attn_unit(p, smem, bh >> 3, bh & 7, 31 - qa);
    attn_unit(p, smem, bh >> 3, bh & 7, qa);
#if MOEQ >= 1 && CVT_IN_P4
    if (!cvt_first) { if (CVT_SPLIT) ph_convert_gu(p, smem, 0, 1); else ph_convert(p, smem); }
#endif
#if DUP == 44
    if (cvt_first) ph_convert(p, smem);
    attn_unit(p, smem, bh >> 3, bh & 7, 31 - qa);
    attn_unit(p, smem, bh >> 3, bh & 7, qa);
    if (!cvt_first) ph_convert(p, smem);
#endif
#if DUP == 4
    attn_unit(p, smem, bh >> 3, bh & 7, 31 - qa);
    attn_unit(p, smem, bh >> 3, bh & 7, qa);
#endif
  }
  XBAR();
  for (int u = blockIdx.x; u < 512; u += gridDim.x) gla_g3_unit(p, smem, u);
  mla_norm_tokens(p);
#if DUP == 5
  for (int u = blockIdx.x; u < 512; u += gridDim.x) gla_g3_unit(p, smem, u);
  mla_norm_tokens(p);
#endif
  XBAR();
#if DENSER
  wout_tile_r(p, smem, (blockIdx.x & 7) * 4 + ((blockIdx.x >> 3) & 3), blockIdx.x >> 5);
#else
  wout_tile(p, smem, blockIdx.x >> 3, blockIdx.x & 7);
#endif
#if DUP == 6
  wout_tile(p, smem, blockIdx.x >> 3, blockIdx.x & 7);
#endif
  XBAR();
  ffn_prep_unit(p, smem, blockIdx.x);
#if DUP == 7
  ffn_prep_unit<1>(p, smem, blockIdx.x);
#endif
  XBAR();
#if MOEQ >= 1
  ph_moeq<1>(p, smem);
#if DUP == 8
  ph_moeq<1>(p, smem);
#endif
#else
  ph_moe<1>(p, smem);
#endif
  XBAR();
#if MOEQ >= 1
  ph_moeq<2>(p, smem);
#else
  ph_moe<2>(p, smem);
#endif
#if DUP == 9
  ph_moeq<2>(p, smem);
#endif
#if DUP == 89
  XBAR();
  ph_moeq<1>(p, smem);
  XBAR();
  ph_moeq<2>(p, smem);
#endif
#if DUP == 19
  ph_moe<2, 1>(p, smem);
#endif
  XBAR();
#if DUP == 100
  ph_final(p, smem);
  }
#endif
#if TSTAMP
  {
    const float us = ((const float*)p.counts())[48];
    const float scl = 1.0f + us * (1.0f / 4000.0f);
    ph_final(p, smem, scl);
  }
#else
  ph_final(p, smem);
#endif
#if DUP == 10
  ph_final(p, smem);
#endif
#if DUP == 11
  for (int i = 0; i < 10; ++i) XBAR();
#endif
}

extern "C" void kernel_launch(void* const* d_in, const int* in_sizes, int n_in,
                              void* d_out, int out_size, void* d_ws, size_t ws_size,
                              hipStream_t stream) {
  Params P{};
  P.x = (const float*)d_in[0]; P.pos = (const int*)d_in[1];
  P.attn_norm = (const float*)d_in[2]; P.w_in = (const float*)d_in[3]; P.gate_up = (const float*)d_in[4]; P.gate_bias = (const float*)d_in[5];
  P.gla_out_norm = (const float*)d_in[6]; P.q_norm = (const float*)d_in[7]; P.w_uq = (const float*)d_in[8]; P.kv_norm = (const float*)d_in[9];
  P.w_ukv = (const float*)d_in[10]; P.mla_out_norm = (const float*)d_in[11]; P.w_out = (const float*)d_in[12]; P.ffn_norm = (const float*)d_in[13];
  P.router_w = (const float*)d_in[14]; P.router_b = (const float*)d_in[15]; P.w_gu = (const float*)d_in[16]; P.b_gu = (const float*)d_in[17];
  P.w_dn = (const float*)d_in[18]; P.b_dn = (const float*)d_in[19]; P.final_norm = (const float*)d_in[20];
  P.out = (float*)d_out;

  P.ws = (char*)d_ws;

  hipFuncSetAttribute((const void*)mega, hipFuncAttributeMaxDynamicSharedMemorySize, LDS_MAX);
  hipMemsetAsync(d_ws, 0, XCD_BAR_WORDS * sizeof(unsigned), stream);
  mega<<<256, 256, LDS_MAX, stream>>>(P);
}
```

```cpp
#define DUP 0
#define MOEQ 2
#define TSTAMP 0
#define CVT_SPLIT 1
#define CVT_IN_P4 1
#define LOOK1 1
#define LOOK2 0
#define WOUTQ 0
#define SKEW 0
#define CVT_STAGGER 1
#include <hip/hip_runtime.h>
#include <hip/hip_bf16.h>
#include <stdint.h>
#include <type_traits>
#define T_      8192
#define SEQ_    4096
#define D_      2048
#define NC_     4176
#define C_GQ    0
#define C_GK    512
#define C_GV    1024
#define C_GR    2048
#define C_GD    3072
#define C_MQ    3088
#define C_MKV   3600
#define C_MKR   4112
#define NE_     32
#define DFF_    2048
#define EPS_    1e-6f
typedef short bf16x8 __attribute__((ext_vector_type(8)));
typedef short s16x4 __attribute__((ext_vector_type(4)));
typedef float f32x16 __attribute__((ext_vector_type(16)));
typedef float f32x4 __attribute__((ext_vector_type(4)));
typedef float f32x2 __attribute__((ext_vector_type(2)));
typedef unsigned short u16;
typedef unsigned u32x4 __attribute__((ext_vector_type(4)));
typedef unsigned u32x2 __attribute__((ext_vector_type(2)));
#define LAS3 __attribute__((address_space(3)))
#define OPAQUE(x) asm volatile("" : "+v"(x))
#define NTHR 256
__device__ __forceinline__ int opaque_tid() { int t = threadIdx.x; asm volatile("" : "+v"(t)); return t; }

__device__ __forceinline__ unsigned pack_bf16(float a, float b) {
  typedef __bf16 bf2 __attribute__((ext_vector_type(2)));
  typedef float f2 __attribute__((ext_vector_type(2)));
  f2 v = {a, b};
  bf2 r = __builtin_convertvector(v, bf2);
  return *(unsigned*)&r;
}
__device__ __forceinline__ float bf_lo(unsigned w) { return __uint_as_float(w << 16); }
__device__ __forceinline__ float bf_hi(unsigned w) { return __uint_as_float(w & 0xffff0000u); }
__device__ __forceinline__ float bf16_to_f32(u16 v) { return __uint_as_float(((unsigned)v) << 16); }
__device__ __forceinline__ u16 f32_to_bf16(float f) { return (u16)(pack_bf16(f, 0.f) & 0xffffu); }
__device__ __forceinline__ float shflx(float v, int k) {
  int t = threadIdx.x; asm volatile("" : "+v"(t));
  return __int_as_float(__builtin_amdgcn_ds_bpermute((((t & 63) ^ k) << 2), __float_as_int(v)));
}
__device__ __forceinline__ float wave_sum(float v) {
#pragma unroll
  for (int o = 32; o > 0; o >>= 1) v += shflx(v, o);
  return v;
}
__device__ __forceinline__ unsigned off_b(unsigned row, unsigned ch) { return 256u * row + 16u * (ch ^ (((row & 3u) << 2) | ((row >> 2) & 3u))); }
__device__ __forceinline__ unsigned tr_addr(unsigned lane, unsigned c, unsigned row0  ) {
  const unsigned blk = (lane >> 4) & 1u, q = (lane & 15u) >> 2, p = lane & 3u;
  return off_b(row0 + q, 4u * c + 2u * blk + (p >> 1)) + 8u * (p & 1u);
}
__device__ __forceinline__ bf16x8 tr_frag(const char* img, unsigned lane, unsigned c, unsigned row_a, unsigned row_b) {
  s16x4 v0 = __builtin_amdgcn_ds_read_tr16_b64_v4i16((LAS3 s16x4*)(img + tr_addr(lane, c, row_a)));
  s16x4 v1 = __builtin_amdgcn_ds_read_tr16_b64_v4i16((LAS3 s16x4*)(img + tr_addr(lane, c, row_b)));
  return (bf16x8){v0[0], v0[1], v0[2], v0[3], v1[0], v1[1], v1[2], v1[3]};
}

__device__ __forceinline__ void glds16_asm(const void* gsrc, unsigned lds_dst) {
  unsigned keep;
  asm volatile("s_mov_b32 %0, m0\n\ts_mov_b32 m0, %2\n\ts_nop 0\n\tglobal_load_lds_dwordx4 %1, off\n\ts_mov_b32 m0, %0" : "=&s"(keep) : "v"(gsrc), "s"(lds_dst) : "memory");
}
struct Params {
  const float *x; const int* pos;
  const float *attn_norm, *w_in, *gate_up, *gate_bias, *gla_out_norm, *q_norm, *w_uq, *kv_norm, *w_ukv, *mla_out_norm, *w_out,
              *ffn_norm, *router_w, *router_b, *w_gu, *b_gu, *w_dn, *b_dn, *final_norm;
  float* out;
  char* ws;
  __device__ __forceinline__ unsigned* bar() const { return (unsigned*)(ws + 0ull); }
  __device__ __forceinline__ int* counts() const { return (int*)(ws + 16384ull); }
  __device__ __forceinline__ u16* h1() const { return (u16*)(ws + 16640ull); }
  __device__ __forceinline__ u16* proj() const { return (u16*)(ws + 33571072ull); }
  __device__ __forceinline__ float2* cs() const { return (float2*)(ws + 101990656ull); }
  __device__ __forceinline__ float* rq() const { return (float*)(ws + 104087808ull); }
  __device__ __forceinline__ float* rkv() const { return (float*)(ws + 104120576ull); }
  __device__ __forceinline__ float* bcum() const { return (float*)(ws + 104153344ull); }
  __device__ __forceinline__ u16* q() const { return (u16*)(ws + 120930560ull); }
  __device__ __forceinline__ u16* kv() const { return (u16*)(ws + 146096384ull); }
  __device__ __forceinline__ u16* kpe() const { return (u16*)(ws + 179650816ull); }
  __device__ __forceinline__ u16* kvc() const { return (u16*)(ws + 180699392ull); }
  __device__ __forceinline__ float* dec() const { return (float*)(ws + 214253824ull); }
  __device__ __forceinline__ u16* sprev() const { return (u16*)(ws + 214515968ull); }
  __device__ __forceinline__ u16* mix() const { return (u16*)(ws + 248070400ull); }
  __device__ __forceinline__ u16* omla() const { return (u16*)(ws + 281624832ull); }
  __device__ __forceinline__ float* x1() const { return (float*)(ws + 298402048ull); }
  __device__ __forceinline__ u16* h2() const { return (u16*)(ws + 365510912ull); }
  __device__ __forceinline__ int* list() const { return (int*)(ws + 399065344ull); }
  __device__ __forceinline__ int* asg_e() const { return (int*)(ws + 400113920ull); }
  __device__ __forceinline__ int* asg_slot() const { return (int*)(ws + 400244992ull); }
  __device__ __forceinline__ float* asg_g() const { return (float*)(ws + 400376064ull); }
  __device__ __forceinline__ u16* act() const { return (u16*)(ws + 400507136ull); }
  __device__ __forceinline__ u16* ybuf() const { return (u16*)(ws + 568279296ull); }
  __device__ __forceinline__ unsigned char* wq_gu() const { return (unsigned char*)(ws + 736051456ull); }
  __device__ __forceinline__ unsigned char* wq_dn() const { return (unsigned char*)(ws + 1004486912ull); }
  __device__ __forceinline__ unsigned char* h2q() const { return (unsigned char*)(ws + 1138704640ull); }
  __device__ __forceinline__ unsigned char* actq() const { return (unsigned char*)(ws + 1155481856ull); }
  __device__ __forceinline__ u16* wb_in() const { return (u16*)(ws + 1239367936ull); }
  __device__ __forceinline__ u16* wb_uq() const { return (u16*)(ws + 1257193728ull); }
  __device__ __forceinline__ u16* wb_ukv() const { return (u16*)(ws + 1258766592ull); }
  __device__ __forceinline__ u16* wb_out() const { return (u16*)(ws + 1260863744ull); }
  __device__ __forceinline__ unsigned char* mixq() const { return (unsigned char*)(ws + 1269252352ull); }
  __device__ __forceinline__ unsigned char* wq_out() const { return (unsigned char*)(ws + 1286029568ull); }
};
#define WS_BYTES_USED 1290223872ull

#define XB_TMO      128
#define XB_XCNT(j)  (256  + 64 * (j))
#define XB_XSUB(j)  (1280 + 64 * (j))
#define XB_XGEN(j)  (2304 + 64 * (j))
#define XB_TOP      3328
#define XB_TOPGEN   3392
#define XCD_BAR_WORDS 3456
#define XB_SPIN_CAP (1u << 18)
#define LAS __attribute__((address_space(3)))

__device__ __forceinline__ unsigned xb_ld(unsigned* p)              { return __hip_atomic_load(p, __ATOMIC_RELAXED, __HIP_MEMORY_SCOPE_AGENT); }
__device__ __forceinline__ unsigned xb_add(unsigned* p, unsigned v) { return __hip_atomic_fetch_add(p, v, __ATOMIC_RELAXED, __HIP_MEMORY_SCOPE_AGENT); }
__device__ __forceinline__ unsigned xb_xcc_id() { return (unsigned)__builtin_amdgcn_s_getreg((3 << 11) | 20) & 0xFu; }
#define XB_SPIN(cond, bar) do { unsigned _sp = 0; while (cond) { __builtin_amdgcn_s_sleep(1); \
    if ((++_sp & 255u) == 0u) { if (xb_ld(&(bar)[XB_TMO])) break; if (_sp > XB_SPIN_CAP) { atomicAdd(&(bar)[XB_TMO], 1u); break; } } } } while (0)

struct XcdBarrier {
    unsigned* bar; unsigned x;
    volatile LAS unsigned* st;
};

__device__ __forceinline__ XcdBarrier xcd_barrier_post(unsigned* bar, volatile LAS unsigned* st) {
    XcdBarrier b; b.bar = bar; b.x = xb_xcc_id(); b.st = st;
    if (threadIdx.x == 0) (void)xb_add(&bar[XB_XCNT(b.x)], 1u);
    return b;
}
__device__ __forceinline__ void xcd_barrier_complete(unsigned* bar, unsigned x, unsigned& nloc, unsigned& nx) {
    const unsigned G = gridDim.x * gridDim.y * gridDim.z;
    unsigned sum, cnt, mine, sp = 0u;
    for (;;) {
        sum = 0u; cnt = 0u; mine = 0u;
#pragma unroll
        for (unsigned j = 0; j < 16; ++j) { const unsigned c = xb_ld(&bar[XB_XCNT(j)]); sum += c; cnt += (c > 0u) ? 1u : 0u; mine = (j == x) ? c : mine; }
        if (sum == G) break;
        __builtin_amdgcn_s_sleep(1);
        if ((++sp & 255u) == 0u) { if (xb_ld(&bar[XB_TMO])) break; if (sp > XB_SPIN_CAP) { atomicAdd(&bar[XB_TMO], 1u); break; } }
    }
    nloc = mine > 0u ? mine : 1u; nx = cnt > 0u ? cnt : 1u;
}

__device__ __forceinline__ void xcd_barrier(const XcdBarrier& b) {
    asm volatile("s_waitcnt vmcnt(0)" ::: "memory");
    __syncthreads();
    if (threadIdx.x == 0) {
        unsigned* bar = b.bar;
        __builtin_amdgcn_s_waitcnt(0);
        unsigned nloc = b.st[0], nx = b.st[1];
        if (nloc == 0u) { xcd_barrier_complete(bar, b.x, nloc, nx); b.st[0] = nloc; b.st[1] = nx; }
        const unsigned old = xb_add(&bar[XB_XSUB(b.x)], 1u);
        const unsigned gen = old / nloc;
        if (old + 1u == (gen + 1u) * nloc) {
            __builtin_amdgcn_fence(__ATOMIC_RELEASE, "agent");
            asm volatile("s_waitcnt vmcnt(0)" ::: "memory");
            const unsigned og = xb_add(&bar[XB_TOP], 1u);
            const unsigned tg = og / nx;
            if (og + 1u == (tg + 1u) * nx) xb_add(&bar[XB_TOPGEN], 1u);
            else XB_SPIN(xb_ld(&bar[XB_TOPGEN]) == tg, bar);
            __builtin_amdgcn_fence(__ATOMIC_ACQUIRE, "agent");
            xb_add(&bar[XB_XGEN(b.x)], 1u);
            asm volatile("s_waitcnt vmcnt(0)" ::: "memory");
        } else {
            XB_SPIN(xb_ld(&bar[XB_XGEN(b.x)]) == gen, bar);
            __builtin_amdgcn_fence(__ATOMIC_ACQUIRE, "agent");
            asm volatile("s_waitcnt vmcnt(0)" ::: "memory");
        }
    }
    __syncthreads();
}

#define G_A_OFF(s)  ((s) * 65536)
#define G_B_OFF(s)  ((s) * 65536 + 32768)
#define G_LDS_BYTES 131072

struct GemmTile {
  const u16* A; int lda;
  const int* aidx;
  int m0, mvalid;
  const float* B0; const float* B1;
  int ldb; int nv0, nv1;
  const float* kscale;
  int K;
};

template <int NB, bool KSCALE, bool GATHER>
__device__ __forceinline__ void gemm_tile_256(const GemmTile& t, char* smem, f32x16 (&acc)[4][4]) {
  int tz0 = threadIdx.x; asm volatile("" : "+v"(tz0));
  const int tid = tz0, lane = tid & 63, wid = tid >> 6, wr = wid >> 1, wc = wid & 1;
  const int l31 = lane & 31, hh = lane >> 5;
#pragma unroll
  for (int i = 0; i < 4; ++i)
#pragma unroll
    for (int j = 0; j < 4; ++j)
#pragma unroll
      for (int r = 0; r < 16; ++r) acc[i][j][r] = 0.f;

  const int a_c = (tid & 7) ^ ((tid >> 4) & 7);
  const u16* a_src[GATHER ? 8 : 1];
  if (GATHER) {
#pragma unroll
    for (int i = 0; i < (GATHER ? 8 : 1); ++i) {
      int r = (tid >> 3) + 32 * i;
      int rr = r < t.mvalid ? r : 0;
      a_src[i] = t.A + (long)t.aidx[rr] * t.lda + a_c * 8;
    }
  } else {
    a_src[0] = t.A + (long)(t.m0 + (tid >> 3)) * t.lda + a_c * 8;
  }
  const long a_step = 32L * t.lda;
  const int b_n4 = tid & 63, b_k = tid >> 6;
  const int b_k_u = __builtin_amdgcn_readfirstlane(b_k);
  const int b_img = b_n4 >> 5, b_ch = (b_n4 >> 1) & 15, b_half = b_n4 & 1;
  const bool b_ok = ((b_n4 & 31) * 4) < (b_img ? t.nv1 : t.nv0);
  const int b_loff = (b_ok ? ((b_img ? (int)(t.B1 - t.B0) : 0) + (b_n4 & 31) * 4) : 0) + b_k * t.ldb;
  f32x4 breg[16];

  const unsigned a_lds0 = (unsigned)(size_t)smem + (unsigned)__builtin_amdgcn_readfirstlane(wid) * 1024u;
  auto issue_a = [&](int kt, int s, int i) {
    glds16_asm((const void*)((GATHER ? a_src[GATHER ? i : 0] : a_src[0] + i * a_step) + kt * 64), a_lds0 + G_A_OFF(s) + i * 4096);
  };
  auto issue_b = [&](int kt, int j) {
    const float* ptr = t.B0 + (long)(kt * 64 + 4 * j) * t.ldb + b_loff;
    asm volatile("global_load_dwordx4 %0, %1, off" : "=v"(breg[j]) : "v"(ptr) : "memory");
  };
  auto write_b = [&](int kt, int s, int j) {
    const int k = b_k + 4 * j;
    f32x4 v = breg[j];
    if (KSCALE) { float sc = t.kscale[kt * 64 + b_k_u + 4 * j]; v *= sc; }
    if (!b_ok) v = (f32x4){0.f, 0.f, 0.f, 0.f};
    u32x2 w = {pack_bf16(v[0], v[1]), pack_bf16(v[2], v[3])};
    *(u32x2*)(smem + G_B_OFF(s) + b_img * 16384 + off_b(k, b_ch) + 8 * b_half) = w;
  };
#define WAITQ(N, g) asm volatile("s_waitcnt vmcnt(" #N ")" : "+v"(breg[4 * (g)]), "+v"(breg[4 * (g) + 1]), "+v"(breg[4 * (g) + 2]), "+v"(breg[4 * (g) + 3]) :: "memory")

  unsigned a_rd[4], b_rd[2][2];
#pragma unroll
  for (int ks = 0; ks < 4; ++ks) { const int row = wr * 128 + l31; a_rd[ks] = row * 128 + (((2 * ks + hh) ^ ((row >> 1) & 7)) * 16); }
#pragma unroll
  for (int tt = 0; tt < 2; ++tt)
#pragma unroll
    for (int nl = 0; nl < 2; ++nl) b_rd[tt][nl] = tr_addr(lane, wc * 2 + nl, 8 * hh + 4 * tt);
  auto load_a = [&](const char* As, int ks, bf16x8 (&af)[4]) {
#pragma unroll
    for (int mb = 0; mb < 4; ++mb) af[mb] = *(const bf16x8*)(As + a_rd[ks] + mb * 4096);
  };
  auto load_b1 = [&](const char* Bs, int ks, int nb, bf16x8& bfr) {
    const char* bi = Bs + (nb >> 1) * 16384 + ks * 4096;
    s16x4 v0 = __builtin_amdgcn_ds_read_tr16_b64_v4i16((LAS3 s16x4*)(bi + b_rd[0][nb & 1]));
    s16x4 v1 = __builtin_amdgcn_ds_read_tr16_b64_v4i16((LAS3 s16x4*)(bi + b_rd[1][nb & 1]));
    bfr = (bf16x8){v0[0], v0[1], v0[2], v0[3], v1[0], v1[1], v1[2], v1[3]};
  };

  auto kstep = [&](int kt, auto mode_tag, bool has1, bool has2) {
    constexpr int MODE = decltype(mode_tag)::value;
    const int s = kt & 1;
    const char* As = smem + G_A_OFF(s);
    const char* Bs = smem + G_B_OFF(s);
    bf16x8 a0[4], a1[4], bq[NB];
    load_a(As, 0, a0);
#pragma unroll
    for (int nb = 0; nb < NB; ++nb) load_b1(Bs, 0, nb, bq[nb]);
    __builtin_amdgcn_sched_barrier(0);
#pragma unroll
    for (int g = 0; g < 4; ++g) {
      bf16x8 (&ac)[4] = (g & 1) ? a1 : a0;
      bf16x8 (&an)[4] = (g & 1) ? a0 : a1;
      if (g < 3) load_a(As, g + 1, an);
      __builtin_amdgcn_sched_barrier(0);
#pragma unroll
      for (int nb = 0; nb < NB; ++nb) {
#pragma unroll
        for (int mb = 0; mb < 4; ++mb)
          acc[mb][nb] = __builtin_amdgcn_mfma_f32_32x32x16_bf16(ac[mb], bq[nb], acc[mb][nb], 0, 0, 0);
        __builtin_amdgcn_sched_barrier(0);
        if (g < 3) load_b1(Bs, g + 1, nb, bq[nb]);
        if (nb == 0 && g < 2 && has1) { issue_a(kt + 1, s ^ 1, 4 * g + 0); issue_a(kt + 1, s ^ 1, 4 * g + 1); }
        if (nb == 1 % NB && g < 2 && has1 && NB > 1) { issue_a(kt + 1, s ^ 1, 4 * g + 2); issue_a(kt + 1, s ^ 1, 4 * g + 3); }
        if (NB == 1 && nb == 0 && g < 2 && has1) { issue_a(kt + 1, s ^ 1, 4 * g + 2); issue_a(kt + 1, s ^ 1, 4 * g + 3); }
        if (nb == NB - 1 && has1) {
          if (MODE == 2) { if (g == 0) WAITQ(20, 0); else if (g == 1) WAITQ(20, 1); else if (g == 2) WAITQ(20, 2); else WAITQ(20, 3); }
          else if (MODE == 1) { if (g == 0) WAITQ(16, 0); else if (g == 1) WAITQ(20, 1); else if (g == 2) WAITQ(20, 2); else WAITQ(20, 3); }
          else { if (g == 0) WAITQ(0, 0); else if (g == 1) WAITQ(0, 1); else if (g == 2) WAITQ(0, 2); else WAITQ(0, 3); }
#pragma unroll
          for (int i = 0; i < 4; ++i) write_b(kt + 1, s ^ 1, 4 * g + i);
          if (has2) {
#pragma unroll
            for (int i = 0; i < 4; ++i) issue_b(kt + 2, 4 * g + i);
          }
        }
        __builtin_amdgcn_sched_barrier(0);
      }
    }
    if (has1) {
      if (MODE == 0) asm volatile("s_waitcnt vmcnt(0)" ::: "memory");
      else asm volatile("s_waitcnt vmcnt(12)" ::: "memory");
      __syncthreads();
    }
  };

  const int nk = t.K >> 6;
  __syncthreads();
#pragma unroll
  for (int j = 0; j < 16; ++j) issue_b(0, j);
#pragma unroll
  for (int i = 0; i < 8; ++i) issue_a(0, 0, i);
  WAITQ(8, 0); WAITQ(8, 1); WAITQ(8, 2); WAITQ(8, 3);
#pragma unroll
  for (int j = 0; j < 16; ++j) write_b(0, 0, j);
#pragma unroll
  for (int j = 0; j < 16; ++j) issue_b(1, j);
  asm volatile("s_waitcnt vmcnt(16)" ::: "memory");
  __syncthreads();
  kstep(0, std::integral_constant<int, 1>{}, true, true);
  for (int kt = 1; kt < nk - 2; ++kt) kstep(kt, std::integral_constant<int, 2>{}, true, true);
  kstep(nk - 2, std::integral_constant<int, 0>{}, true, false);
  kstep(nk - 1, std::integral_constant<int, 0>{}, false, false);
#undef WAITQ
}
template <int NB, class F>
__device__ __forceinline__ void acc_foreach_row(f32x16 (&acc)[4][4], F f) {
  int tz = threadIdx.x; asm volatile("" : "+v"(tz));
  const int lane = tz & 63, wid = tz >> 6, wr = wid >> 1, wc = wid & 1;
  const int l31 = lane & 31, hh = lane >> 5;
#pragma unroll
  for (int mb = 0; mb < 4; ++mb)
#pragma unroll
    for (int reg = 0; reg < 16; ++reg) {
      const int rowl = wr * 128 + mb * 32 + (reg & 3) + 8 * (reg >> 2) + 4 * hh;
      float v[NB];
#pragma unroll
      for (int nb = 0; nb < NB; ++nb) v[nb] = acc[mb][nb][reg];
      f(rowl, wc * 64 + l31, v);
      asm volatile("" ::: "memory");
    }
}
__device__ __forceinline__ void ph_prep0(const Params& p) {
  const int tid_ = opaque_tid(); const int lane = tid_ & 63, wid = tid_ >> 6;
  if (blockIdx.x == 0 && tid_ < 64) p.counts()[tid_] = 0;
  for (int t = blockIdx.x * 4 + wid; t < T_; t += gridDim.x * 4) {
    const float* xr = p.x + (long)t * 2048;
    f32x4 v[8]; float ss = 0.f;
#pragma unroll
    for (int j = 0; j < 8; ++j) { v[j] = *(const f32x4*)(xr + j * 256 + lane * 4); ss += v[j][0] * v[j][0] + v[j][1] * v[j][1] + v[j][2] * v[j][2] + v[j][3] * v[j][3]; }
    ss = wave_sum(ss);
    const float r = rsqrtf(ss * (1.0f / 2048.0f) + EPS_);
#pragma unroll
    for (int j = 0; j < 8; ++j) {
      f32x4 g = *(const f32x4*)(p.attn_norm + j * 256 + lane * 4);
      u32x2 w = {pack_bf16(v[j][0] * r * g[0], v[j][1] * r * g[1]), pack_bf16(v[j][2] * r * g[2], v[j][3] * r * g[3])};
      *(u32x2*)(p.h1() + (long)t * 2048 + j * 256 + lane * 4) = w;
    }
    if (lane < 32) {
      float inv = 1.0f / powf(10000.0f, (float)(2 * lane) / 64.0f);
      float ang = (float)p.pos[t] * inv;
      double a = (double)ang;
      double k = rint(a * 0.15915494309189535);
      float rf = (float)fma(-k, 6.283185307179586, a);
      p.cs()[t * 32 + lane] = make_float2(__cosf(rf), __sinf(rf));
    }
  }
}

template <int NB>
__device__ __forceinline__ void win_tile(const Params& p, char* smem, int mt, int nt) {
  f32x16 acc[4][4];
  GemmTile t{};
  t.A = p.h1(); t.lda = 2048; t.aidx = nullptr; t.m0 = mt * 256; t.mvalid = 256;
  t.B0 = p.w_in + nt * 256; t.B1 = t.B0 + 128; t.ldb = NC_;
  const int rem = NC_ - nt * 256;
  t.nv0 = rem >= 128 ? 128 : rem; t.nv1 = rem >= 256 ? 128 : (rem > 128 ? rem - 128 : 0);
  t.kscale = nullptr; t.K = 2048;
  gemm_tile_256<NB, false, false>(t, smem, acc);
  u16* base = p.proj() + (long)(mt * 256) * NC_ + nt * 256;
  const int nv0 = t.nv0, nv1 = t.nv1;
  acc_foreach_row<NB>(acc, [&](int rowl, int coll, float (&v)[NB]) {
    u16* rp = base + (long)rowl * NC_ + coll;
    OPAQUE(rp);
#pragma unroll
    for (int nb = 0; nb < NB; ++nb) {
      const int c = (nb & 1) * 32 + coll;
      const int lim = (nb >> 1) ? nv1 : nv0;
      if (c < lim) rp[(nb >> 1) * 128 + (nb & 1) * 32] = f32_to_bf16(v[nb]);
    }
  });
}
__device__ __forceinline__ void ph_win(const Params& p, char* smem) {
  const int x = blockIdx.x & 7, slot = blockIdx.x >> 3;
  for (int j = slot; j < 64; j += 32) win_tile<4>(p, smem, 4 * x + (j & 3), j >> 2);
  if (slot < 4) win_tile<2>(p, smem, 4 * x + slot, 16);
}

__device__ __forceinline__ void ph_prep1(const Params& p, char* smem) {
  float* gds = (float*)smem;
  float* cums = (float*)(smem + 4096);
  const int tid = opaque_tid(), lane = tid & 63, wid = tid >> 6;
  for (int u = blockIdx.x; u < 512; u += gridDim.x) {
    const int ch = u >> 2, h = u & 3; const int t0 = ch * 64;
    __syncthreads();
    {
      const int tl = tid >> 2, r4 = (tid & 3) * 4;
      u32x2 w = *(const u32x2*)(p.proj() + (long)(t0 + tl) * NC_ + C_GD + r4);
      gds[tl * 16 + r4 + 0] = bf_lo(w[0]); gds[tl * 16 + r4 + 1] = bf_hi(w[0]);
      gds[tl * 16 + r4 + 2] = bf_lo(w[1]); gds[tl * 16 + r4 + 3] = bf_hi(w[1]);
    }
    const int c = tid & 127, half = tid >> 7;
    float gu[16];
#pragma unroll
    for (int r = 0; r < 16; ++r) gu[r] = p.gate_up[r * 512 + h * 128 + c];
    const float bias = p.gate_bias[h * 128 + c];
    __syncthreads();
    float run = 0.f;
    for (int i = 0; i < 32; ++i) {
      const int tl = half * 32 + i;
      float z = bias;
#pragma unroll
      for (int r = 0; r < 16; ++r) z = fmaf(gds[tl * 16 + r], gu[r], z);
      const float ls = fminf(z, 0.f) - log1pf(__expf(-fabsf(z)));
      run += ls * (1.0f / 16.0f);
      cums[tl * 128 + c] = run;
    }
    __syncthreads();
    {
      const float add = cums[31 * 128 + c];
      for (int i = 0; i < 32; ++i) {
        const int tl = half * 32 + i;
        float v = cums[tl * 128 + c] + (half ? add : 0.f);
        p.bcum()[(long)(t0 + tl) * 512 + h * 128 + c] = v;
      }
    }
    for (int i = 0; i < 4; ++i) {
      const long t = t0 + h * 16 + wid * 4 + i;
      const u16* pr = p.proj() + t * NC_;
      u32x4 a = *(const u32x4*)(pr + C_MQ + lane * 8);
      u32x4 b = *(const u32x4*)(pr + C_MKV + lane * 8);
      float sa = 0.f, sb = 0.f;
#pragma unroll
      for (int k = 0; k < 4; ++k) { float l = bf_lo(a[k]), hgh = bf_hi(a[k]); sa += l * l + hgh * hgh; l = bf_lo(b[k]); hgh = bf_hi(b[k]); sb += l * l + hgh * hgh; }
      sa = wave_sum(sa); sb = wave_sum(sb);
      if (lane == 0) { p.rq()[t] = rsqrtf(sa * (1.0f / 512.0f) + EPS_); p.rkv()[t] = rsqrtf(sb * (1.0f / 512.0f) + EPS_); }
      if (lane < 32) {
        const float t1 = bf16_to_f32(pr[C_MKR + lane]), t2 = bf16_to_f32(pr[C_MKR + lane + 32]);
        const float2 cs = p.cs()[t * 32 + lane];
        p.kpe()[t * 64 + lane] = f32_to_bf16(t1 * cs.x - t2 * cs.y);
        p.kpe()[t * 64 + lane + 32] = f32_to_bf16(t1 * cs.y + t2 * cs.x);
      }
    }
  }
}

#define QSCALE_ (0.07216878364870322f * 1.4426950408889634f)
__device__ __forceinline__ void upq_tile(const Params& p, char* smem, int mt, int nt) {
  f32x16 acc[4][4];
  GemmTile t{};
  t.A = p.proj() + C_MQ; t.lda = NC_; t.aidx = nullptr; t.m0 = mt * 256; t.mvalid = 256;
  t.B0 = p.w_uq + nt * 256; t.B1 = t.B0 + 128; t.ldb = 1536; t.nv0 = 128; t.nv1 = 128; t.kscale = p.q_norm; t.K = 512;
  gemm_tile_256<4, true, false>(t, smem, acc);
  u16* base = p.q() + (long)(mt * 256) * 1536 + nt * 256;
  const float* rq = p.rq() + mt * 256;
  acc_foreach_row<4>(acc, [&](int rowl, int coll, float (&v)[4]) {
    u16* rp = base + (long)rowl * 1536 + coll;
    OPAQUE(rp);
    const float s = rq[rowl] * QSCALE_;
#pragma unroll
    for (int nb = 0; nb < 4; ++nb) rp[(nb >> 1) * 128 + (nb & 1) * 32] = f32_to_bf16(v[nb] * s);
  });
}
__device__ __forceinline__ void upkv_tile(const Params& p, char* smem, int mt, int nt) {
  f32x16 acc[4][4];
  GemmTile t{};
  t.A = p.proj() + C_MKV; t.lda = NC_; t.aidx = nullptr; t.m0 = mt * 256; t.mvalid = 256;
  t.B0 = p.w_ukv + nt * 256; t.B1 = t.B0 + 128; t.ldb = 2048; t.nv0 = 128; t.nv1 = 128; t.kscale = p.kv_norm; t.K = 512;
  gemm_tile_256<4, true, false>(t, smem, acc);
  u16* base = p.kv() + (long)(mt * 256) * 2048 + nt * 256;
  const float* rk = p.rkv() + mt * 256;
  acc_foreach_row<4>(acc, [&](int rowl, int coll, float (&v)[4]) {
    u16* rp = base + (long)rowl * 2048 + coll;
    OPAQUE(rp);
    const float s = rk[rowl];
#pragma unroll
    for (int nb = 0; nb < 4; ++nb) rp[(nb >> 1) * 128 + (nb & 1) * 32] = f32_to_bf16(v[nb] * s);
  });
}
#define AT_KSTRIDE 400
#define AT_KBYTES  (64 * AT_KSTRIDE)
#define AT_STAGE   (AT_KBYTES + 16384)
#define AT_LDS_BYTES (2 * AT_STAGE)

__device__ __forceinline__ void attn_unit(const Params& p, char* smem, int b, int h, int qb) {
  const int tid = opaque_tid(), lane = tid & 63, wid = tid >> 6, l31 = lane & 31, hh = lane >> 5;
  const long tq = (long)b * SEQ_ + qb * 128 + wid * 32 + l31;
  bf16x8 qf[12];
  {
    const u16* qp = p.q() + (tq * 8 + h) * 192 + 8 * hh;
#pragma unroll
    for (int ks = 0; ks < 12; ++ks) qf[ks] = *(const bf16x8*)(qp + 16 * ks);
#pragma unroll
    for (int s = 0; s < 2; ++s) {
      const float2* cp = p.cs() + tq * 32 + 16 * s + 8 * hh;
      bf16x8 lo = qf[8 + s], hi = qf[10 + s], nlo, nhi;
#pragma unroll
      for (int j = 0; j < 8; j += 2) {
        float2 c0 = cp[j], c1 = cp[j + 1];
        float a0 = bf16_to_f32((u16)lo[j]), a1 = bf16_to_f32((u16)lo[j + 1]);
        float b0 = bf16_to_f32((u16)hi[j]), b1 = bf16_to_f32((u16)hi[j + 1]);
        unsigned wl = pack_bf16(a0 * c0.x - b0 * c0.y, a1 * c1.x - b1 * c1.y);
        unsigned wh = pack_bf16(a0 * c0.y + b0 * c0.x, a1 * c1.y + b1 * c1.x);
        nlo[j] = (short)(wl & 0xffff); nlo[j + 1] = (short)(wl >> 16);
        nhi[j] = (short)(wh & 0xffff); nhi[j + 1] = (short)(wh >> 16);
      }
      qf[8 + s] = nlo; qf[10 + s] = nhi;
    }
  }
  u32x4 kregA[6], vregA[4], kregB[6], vregB[4];
  const long tk0 = (long)b * SEQ_;
  auto load_tile = [&](int kt, u32x4 (&kreg)[6], u32x4 (&vreg)[4]) {
    const long tb = tk0 + kt * 64;
#pragma unroll
    for (int i = 0; i < 4; ++i) {
      const int pp = i * 256 + tid; const int key = pp >> 4, c = pp & 15;
      const u16* rowp = p.kv() + ((tb + key) * 8 + h) * 256 + c * 8;
      kreg[i] = *(const u32x4*)rowp;
      vreg[i] = *(const u32x4*)(rowp + 128);
    }
#pragma unroll
    for (int i = 0; i < 2; ++i) {
      const int pp = i * 256 + tid; const int key = pp >> 3, c = pp & 7;
      kreg[4 + i] = *(const u32x4*)(p.kpe() + (tb + key) * 64 + c * 8);
    }
  };
  auto store_tile = [&](int s, u32x4 (&kreg)[6], u32x4 (&vreg)[4]) {
    char* Ks = smem + s * AT_STAGE; char* Vs = Ks + AT_KBYTES;
#pragma unroll
    for (int i = 0; i < 4; ++i) {
      const int pp = i * 256 + tid; const int key = pp >> 4, c = pp & 15;
      *(u32x4*)(Ks + key * AT_KSTRIDE + c * 16) = kreg[i];
      *(u32x4*)(Vs + off_b(key, c)) = vreg[i];
    }
#pragma unroll
    for (int i = 0; i < 2; ++i) {
      const int pp = i * 256 + tid; const int key = pp >> 3, c = pp & 7;
      *(u32x4*)(Ks + key * AT_KSTRIDE + (16 + c) * 16) = kreg[4 + i];
    }
  };

  f32x16 o[4];
#pragma unroll
  for (int c = 0; c < 4; ++c)
#pragma unroll
    for (int r = 0; r < 16; ++r) o[c][r] = 0.f;
  float m = -1e30f, l = 0.f;
  const int nt = 2 * qb + 2;
  const int qpos = qb * 128 + wid * 32 + l31;

  __syncthreads();
  load_tile(0, kregA, vregA);
  store_tile(0, kregA, vregA);
  load_tile(1, kregB, vregB);
  if (nt > 2) load_tile(2, kregA, vregA);
  __syncthreads();
  auto tile_body = [&](int kt, int s) {
    const char* Ks = smem + s * AT_STAGE; const char* Vs = Ks + AT_KBYTES;
    const bool active = (kt * 64) <= (qb * 128 + wid * 32 + 31);
    if (active) {
      f32x16 sc[2];
#pragma unroll
      for (int kb = 0; kb < 2; ++kb) {
#pragma unroll
        for (int r = 0; r < 16; ++r) sc[kb][r] = 0.f;
#pragma unroll
        for (int ks = 0; ks < 12; ++ks) {
          bf16x8 a = *(const bf16x8*)(Ks + (kb * 32 + l31) * AT_KSTRIDE + (2 * ks + hh) * 16);
          sc[kb] = __builtin_amdgcn_mfma_f32_32x32x16_bf16(a, qf[ks], sc[kb], 0, 0, 0);
        }
      }
      if (kt >= 2 * qb) {
#pragma unroll
        for (int kb = 0; kb < 2; ++kb)
#pragma unroll
          for (int r = 0; r < 16; ++r) {
            const int key = kt * 64 + kb * 32 + (r & 3) + 8 * (r >> 2) + 4 * hh;
            if (key > qpos) sc[kb][r] = -1e30f;
          }
      }
      float mx = sc[0][0];
#pragma unroll
      for (int kb = 0; kb < 2; ++kb)
#pragma unroll
        for (int r = 0; r < 16; ++r) mx = fmaxf(mx, sc[kb][r]);
      mx = fmaxf(mx, shflx(mx, 32));
      const float mn = fmaxf(m, mx);
      const float alpha = __builtin_amdgcn_exp2f(m - mn);
      m = mn;
      float ps = 0.f;
      bf16x8 pf[4];
#pragma unroll
      for (int kb = 0; kb < 2; ++kb)
#pragma unroll
        for (int s2 = 0; s2 < 2; ++s2) {
          float e[8];
#pragma unroll
          for (int j = 0; j < 8; ++j) { e[j] = __builtin_amdgcn_exp2f(sc[kb][8 * s2 + j] - mn); ps += e[j]; }
          unsigned w0 = pack_bf16(e[0], e[1]), w1 = pack_bf16(e[2], e[3]), w2 = pack_bf16(e[4], e[5]), w3 = pack_bf16(e[6], e[7]);
          u32x4 w = {w0, w1, w2, w3};
          pf[kb * 2 + s2] = *(bf16x8*)&w;
        }
      l = l * alpha + ps;
#pragma unroll
      for (int c = 0; c < 4; ++c)
#pragma unroll
        for (int r = 0; r < 16; ++r) o[c][r] *= alpha;
#pragma unroll
      for (int c = 0; c < 4; ++c)
#pragma unroll
        for (int kk = 0; kk < 4; ++kk) {
          const unsigned rbase = 32 * (kk >> 1) + 16 * (kk & 1) + 4 * hh;
          bf16x8 a = tr_frag(Vs, lane, c, rbase, rbase + 8);
          o[c] = __builtin_amdgcn_mfma_f32_32x32x16_bf16(a, pf[kk], o[c], 0, 0, 0);
        }
    }
  };
  for (int kt = 0; kt < nt; kt += 2) {
    tile_body(kt, 0);
    store_tile(1, kregB, vregB);
    if (kt + 3 < nt) load_tile(kt + 3, kregB, vregB);
    __syncthreads();
    tile_body(kt + 1, 1);
    if (kt + 2 < nt) {
      store_tile(0, kregA, vregA);
      if (kt + 4 < nt) load_tile(kt + 4, kregA, vregA);
      __syncthreads();
    }
  }
  l = l + shflx(l, 32);
  const float inv = 1.0f / l;
  u16* op = p.omla() + tq * 1024 + h * 128 + 4 * hh;
#pragma unroll
  for (int c = 0; c < 4; ++c)
#pragma unroll
    for (int rg = 0; rg < 4; ++rg) {
      u32x2 w = {pack_bf16(o[c][4 * rg] * inv, o[c][4 * rg + 1] * inv), pack_bf16(o[c][4 * rg + 2] * inv, o[c][4 * rg + 3] * inv)};
      *(u32x2*)(op + 32 * c + 8 * rg) = w;
    }
}

#define G1_LDS_BYTES 49152
__device__ __forceinline__ void gla_g1_unit(const Params& p, char* smem, int u) {
  const int tid = opaque_tid(), lane = tid & 63, wid = tid >> 6, l31 = lane & 31, hh = lane >> 5;
  const int bh = u >> 6, n = u & 63, b = bh >> 2, h = bh & 3;
  const long t0 = (long)b * SEQ_ + n * 64;
  char* Ks = smem; char* Vs = smem + 16384;
  __syncthreads();
  {
    const int ch = tid & 15;
    const float* bl = p.bcum() + (t0 + 63) * 512 + h * 128 + ch * 8;
    f32x4 bl0 = *(const f32x4*)bl, bl1 = *(const f32x4*)(bl + 4);
    if (tid < 128) p.dec()[(long)u * 128 + tid] = __expf(p.bcum()[(t0 + 63) * 512 + h * 128 + tid]);
#pragma unroll
    for (int i = 0; i < 4; ++i) {
      const int tok = (i * 256 + tid) >> 4;
      u32x4 kw = *(const u32x4*)(p.proj() + (t0 + tok) * NC_ + C_GK + h * 128 + ch * 8);
      const float* bp = p.bcum() + (t0 + tok) * 512 + h * 128 + ch * 8;
      f32x4 b0 = *(const f32x4*)bp, b1 = *(const f32x4*)(bp + 4);
      u32x4 w;
      w[0] = pack_bf16(bf_lo(kw[0]) * __expf(bl0[0] - b0[0]), bf_hi(kw[0]) * __expf(bl0[1] - b0[1]));
      w[1] = pack_bf16(bf_lo(kw[1]) * __expf(bl0[2] - b0[2]), bf_hi(kw[1]) * __expf(bl0[3] - b0[3]));
      w[2] = pack_bf16(bf_lo(kw[2]) * __expf(bl1[0] - b1[0]), bf_hi(kw[2]) * __expf(bl1[1] - b1[1]));
      w[3] = pack_bf16(bf_lo(kw[3]) * __expf(bl1[2] - b1[2]), bf_hi(kw[3]) * __expf(bl1[3] - b1[3]));
      *(u32x4*)(Ks + off_b(tok, ch)) = w;
    }
#pragma unroll
    for (int i = 0; i < 8; ++i) {
      const int pp = i * 256 + tid; const int tok = pp >> 5, c32 = pp & 31;
      u32x4 vw = *(const u32x4*)(p.proj() + (t0 + tok) * NC_ + C_GV + h * 256 + c32 * 8);
      *(u32x4*)(Vs + (c32 >> 4) * 16384 + off_b(tok, c32 & 15)) = vw;
    }
  }
  __syncthreads();
  f32x16 acc[4][2];
#pragma unroll
  for (int mb = 0; mb < 4; ++mb)
#pragma unroll
    for (int nb = 0; nb < 2; ++nb)
#pragma unroll
      for (int r = 0; r < 16; ++r) acc[mb][nb][r] = 0.f;
  const char* Vimg = Vs + (wid >> 1) * 16384;
#pragma unroll
  for (int ks = 0; ks < 4; ++ks) {
    bf16x8 af[4], bfr[2];
    const unsigned r0 = 16 * ks + 8 * hh;
#pragma unroll
    for (int mb = 0; mb < 4; ++mb) af[mb] = tr_frag(Ks, lane, mb, r0, r0 + 4);
#pragma unroll
    for (int nb = 0; nb < 2; ++nb) bfr[nb] = tr_frag(Vimg, lane, 2 * (wid & 1) + nb, r0, r0 + 4);
#pragma unroll
    for (int mb = 0; mb < 4; ++mb)
#pragma unroll
      for (int nb = 0; nb < 2; ++nb) acc[mb][nb] = __builtin_amdgcn_mfma_f32_32x32x16_bf16(af[mb], bfr[nb], acc[mb][nb], 0, 0, 0);
  }
  __syncthreads();
  {
    char* st = smem + wid * 16384;
#pragma unroll
    for (int mb = 0; mb < 4; ++mb)
#pragma unroll
      for (int r = 0; r < 16; ++r) {
        const int dk = mb * 32 + (r & 3) + 8 * (r >> 2) + 4 * hh;
        *(u16*)(st + dk * 128 + l31 * 2) = f32_to_bf16(acc[mb][0][r]);
        *(u16*)(st + dk * 128 + (32 + l31) * 2) = f32_to_bf16(acc[mb][1][r]);
      }
    u16* gb = p.kvc() + (long)u * 32768 + wid * 64;
#pragma unroll 4
    for (int it = 0; it < 16; ++it) {
      const int dk = it * 8 + (lane >> 3), ch = lane & 7;
      *(u32x4*)(gb + dk * 256 + ch * 8) = *(const u32x4*)(st + dk * 128 + ch * 16);
    }
  }
}

__device__ __forceinline__ void gla_g2_unit(const Params& p, int u) {
  const int tid = opaque_tid();
  const int bh = u >> 5, part = u & 31;
  const int dk = part * 4 + (tid >> 6), dv = (tid & 63) * 4;
  float s0 = 0.f, s1 = 0.f, s2 = 0.f, s3 = 0.f;
  const long ebase = (long)dk * 256 + dv;
#pragma unroll 8
  for (int n = 0; n < 64; ++n) {
    const long un = (long)(bh * 64 + n);
    u32x2 kw = *(const u32x2*)(p.kvc() + un * 32768 + ebase);
    const float d = p.dec()[un * 128 + dk];
    u32x2 w = {pack_bf16(s0, s1), pack_bf16(s2, s3)};
    *(u32x2*)(p.sprev() + un * 32768 + ebase) = w;
    s0 = fmaf(d, s0, bf_lo(kw[0])); s1 = fmaf(d, s1, bf_hi(kw[0]));
    s2 = fmaf(d, s2, bf_lo(kw[1])); s3 = fmaf(d, s3, bf_hi(kw[1]));
  }
}

#define G3_LDS_BYTES (16384 + 16384 + 32768 + 65536 + 1024)
__device__ __forceinline__ void gla_g3_unit(const Params& p, char* smem, int u) {
  const int tid = opaque_tid(), lane = tid & 63, wid = tid >> 6, l31 = lane & 31, hh = lane >> 5;
  const int bh = u >> 6, n = u & 63, b = bh >> 2, h = bh & 3;
  const long t0 = (long)b * SEQ_ + n * 64;
  char* Qd = smem; char* Ki = smem + 16384; char* Vs = smem + 32768; char* Sp = smem + 65536; float* red = (float*)(smem + 131072);
  __syncthreads();
  {
    const int ch = tid & 15;
    const float qs = 0.08838834764831845f;
#pragma unroll
    for (int i = 0; i < 4; ++i) {
      const int tok = (i * 256 + tid) >> 4;
      const u16* pr = p.proj() + (t0 + tok) * NC_ + h * 128 + ch * 8;
      u32x4 qw = *(const u32x4*)(pr + C_GQ), kw = *(const u32x4*)(pr + C_GK);
      const float* bp = p.bcum() + (t0 + tok) * 512 + h * 128 + ch * 8;
      f32x4 b0 = *(const f32x4*)bp, b1 = *(const f32x4*)(bp + 4);
      float e[8] = {__expf(b0[0]), __expf(b0[1]), __expf(b0[2]), __expf(b0[3]), __expf(b1[0]), __expf(b1[1]), __expf(b1[2]), __expf(b1[3])};
      u32x4 wq, wk;
#pragma unroll
      for (int k = 0; k < 4; ++k) {
        wq[k] = pack_bf16(bf_lo(qw[k]) * qs * e[2 * k], bf_hi(qw[k]) * qs * e[2 * k + 1]);
        wk[k] = pack_bf16(bf_lo(kw[k]) / e[2 * k], bf_hi(kw[k]) / e[2 * k + 1]);
      }
      *(u32x4*)(Qd + off_b(tok, ch)) = wq;
      *(u32x4*)(Ki + off_b(tok, ch)) = wk;
    }
#pragma unroll
    for (int i = 0; i < 8; ++i) {
      const int pp = i * 256 + tid; const int tok = pp >> 5, c32 = pp & 31;
      u32x4 vw = *(const u32x4*)(p.proj() + (t0 + tok) * NC_ + C_GV + h * 256 + c32 * 8);
      *(u32x4*)(Vs + (c32 >> 4) * 16384 + off_b(tok, c32 & 15)) = vw;
    }
#pragma unroll
    for (int i = 0; i < 16; ++i) {
      const int pp = i * 256 + tid; const int dk = pp >> 5, c32 = pp & 31;
      u32x4 sw = *(const u32x4*)(p.sprev() + (long)u * 32768 + dk * 256 + c32 * 8);
      *(u32x4*)(Sp + (c32 >> 4) * 32768 + off_b(dk, c32 & 15)) = sw;
    }
  }
  __syncthreads();
  const int ib = wid & 1, dvh = wid >> 1;
  f32x16 sc[2];
#pragma unroll
  for (int jb = 0; jb < 2; ++jb) {
#pragma unroll
    for (int r = 0; r < 16; ++r) sc[jb][r] = 0.f;
    if (jb <= ib) {
#pragma unroll
      for (int ks = 0; ks < 8; ++ks) {
        bf16x8 a = *(const bf16x8*)(Ki + off_b(jb * 32 + l31, 2 * ks + hh));
        bf16x8 bq = *(const bf16x8*)(Qd + off_b(ib * 32 + l31, 2 * ks + hh));
        sc[jb] = __builtin_amdgcn_mfma_f32_32x32x16_bf16(a, bq, sc[jb], 0, 0, 0);
      }
#pragma unroll
      for (int r = 0; r < 16; ++r) {
        const int j = jb * 32 + (r & 3) + 8 * (r >> 2) + 4 * hh, i = ib * 32 + l31;
        if (j > i) sc[jb][r] = 0.f;
      }
    }
  }
  bf16x8 pf[4];
#pragma unroll
  for (int jb = 0; jb < 2; ++jb)
#pragma unroll
    for (int s2 = 0; s2 < 2; ++s2) {
      u32x4 w = {pack_bf16(sc[jb][8 * s2 + 0], sc[jb][8 * s2 + 1]), pack_bf16(sc[jb][8 * s2 + 2], sc[jb][8 * s2 + 3]),
                 pack_bf16(sc[jb][8 * s2 + 4], sc[jb][8 * s2 + 5]), pack_bf16(sc[jb][8 * s2 + 6], sc[jb][8 * s2 + 7])};
      pf[jb * 2 + s2] = *(bf16x8*)&w;
    }
  f32x16 o[4];
#pragma unroll
  for (int c = 0; c < 4; ++c)
#pragma unroll
    for (int r = 0; r < 16; ++r) o[c][r] = 0.f;
  const char* Vimg = Vs + dvh * 16384;
  const char* Simg = Sp + dvh * 32768;
#pragma unroll
  for (int c = 0; c < 4; ++c) {
#pragma unroll
    for (int kk = 0; kk < 4; ++kk) {
      if ((kk >> 1) <= ib) {
        const unsigned rbase = 32 * (kk >> 1) + 16 * (kk & 1) + 4 * hh;
        bf16x8 a = tr_frag(Vimg, lane, c, rbase, rbase + 8);
        o[c] = __builtin_amdgcn_mfma_f32_32x32x16_bf16(a, pf[kk], o[c], 0, 0, 0);
      }
    }
#pragma unroll
    for (int ks = 0; ks < 8; ++ks) {
      const unsigned r0 = 16 * ks + 8 * hh;
      bf16x8 a = tr_frag(Simg, lane, c, r0, r0 + 4);
      bf16x8 bq = *(const bf16x8*)(Qd + off_b(ib * 32 + l31, 2 * ks + hh));
      o[c] = __builtin_amdgcn_mfma_f32_32x32x16_bf16(a, bq, o[c], 0, 0, 0);
    }
  }
  float ss = 0.f;
#pragma unroll
  for (int c = 0; c < 4; ++c)
#pragma unroll
    for (int r = 0; r < 16; ++r) ss += o[c][r] * o[c][r];
  ss += shflx(ss, 32);
  if (hh == 0) red[dvh * 64 + ib * 32 + l31] = ss;
  __syncthreads();
  const float tot = red[ib * 32 + l31] + red[64 + ib * 32 + l31];
  const float rn = rsqrtf(tot * (1.0f / 256.0f) + EPS_);
  const long t = t0 + ib * 32 + l31;
  const u16* grp = p.proj() + t * NC_ + C_GR + h * 256 + dvh * 128 + 4 * hh;
  u16* op = p.mix() + t * 2048 + h * 256 + dvh * 128 + 4 * hh;
  const float* gp = p.gla_out_norm + dvh * 128 + 4 * hh;
#pragma unroll
  for (int c = 0; c < 4; ++c)
#pragma unroll
    for (int rg = 0; rg < 4; ++rg) {
      u32x2 gw = *(const u32x2*)(grp + 32 * c + 8 * rg);
      f32x4 g = *(const f32x4*)(gp + 32 * c + 8 * rg);
      float gr[4] = {bf_lo(gw[0]), bf_hi(gw[0]), bf_lo(gw[1]), bf_hi(gw[1])};
      float ov[4];
#pragma unroll
      for (int k = 0; k < 4; ++k) { float si = gr[k] / (1.0f + __expf(-gr[k])); ov[k] = o[c][4 * rg + k] * rn * g[k] * si; }
#if WOUTQ
      {
        int q8 = 0;
        q8 = __builtin_amdgcn_cvt_pk_fp8_f32(ov[0], ov[1], q8, false);
        q8 = __builtin_amdgcn_cvt_pk_fp8_f32(ov[2], ov[3], q8, true);
        const int col = h * 256 + dvh * 128 + 4 * hh + 32 * c + 8 * rg;
        *(unsigned*)(p.mixq() + (t >> 1) * 4096 + (col >> 6) * 128 + (t & 1) * 64 + (col & 63)) = (unsigned)q8;
      }
#else
      u32x2 w = {pack_bf16(ov[0], ov[1]), pack_bf16(ov[2], ov[3])};
      *(u32x2*)(op + 32 * c + 8 * rg) = w;
#endif
    }
}

__device__ __forceinline__ void mla_norm_tokens(const Params& p) {
  const int tid_ = opaque_tid(); const int lane = tid_ & 63, wid = tid_ >> 6;
  for (int t = blockIdx.x * 4 + wid; t < T_; t += gridDim.x * 4) {
    const u16* src = p.omla() + (long)t * 1024;
    u32x4 a = *(const u32x4*)(src + lane * 8), b = *(const u32x4*)(src + 512 + lane * 8);
    float ss = 0.f;
#pragma unroll
    for (int k = 0; k < 4; ++k) { float x0 = bf_lo(a[k]), x1 = bf_hi(a[k]), y0 = bf_lo(b[k]), y1 = bf_hi(b[k]); ss += x0 * x0 + x1 * x1 + y0 * y0 + y1 * y1; }
    ss = wave_sum(ss);
    const float r = rsqrtf(ss * (1.0f / 1024.0f) + EPS_);
    const float* g = p.mla_out_norm;
    u32x4 wa, wb;
#pragma unroll
    for (int k = 0; k < 4; ++k) {
      wa[k] = pack_bf16(bf_lo(a[k]) * r * g[lane * 8 + 2 * k], bf_hi(a[k]) * r * g[lane * 8 + 2 * k + 1]);
      wb[k] = pack_bf16(bf_lo(b[k]) * r * g[512 + lane * 8 + 2 * k], bf_hi(b[k]) * r * g[512 + lane * 8 + 2 * k + 1]);
    }
#if WOUTQ
    {
      int qa0 = 0, qa1 = 0, qb0 = 0, qb1 = 0;
      qa0 = __builtin_amdgcn_cvt_pk_fp8_f32(bf_lo(wa[0]), bf_hi(wa[0]), qa0, false); qa0 = __builtin_amdgcn_cvt_pk_fp8_f32(bf_lo(wa[1]), bf_hi(wa[1]), qa0, true);
      qa1 = __builtin_amdgcn_cvt_pk_fp8_f32(bf_lo(wa[2]), bf_hi(wa[2]), qa1, false); qa1 = __builtin_amdgcn_cvt_pk_fp8_f32(bf_lo(wa[3]), bf_hi(wa[3]), qa1, true);
      qb0 = __builtin_amdgcn_cvt_pk_fp8_f32(bf_lo(wb[0]), bf_hi(wb[0]), qb0, false); qb0 = __builtin_amdgcn_cvt_pk_fp8_f32(bf_lo(wb[1]), bf_hi(wb[1]), qb0, true);
      qb1 = __builtin_amdgcn_cvt_pk_fp8_f32(bf_lo(wb[2]), bf_hi(wb[2]), qb1, false); qb1 = __builtin_amdgcn_cvt_pk_fp8_f32(bf_lo(wb[3]), bf_hi(wb[3]), qb1, true);
      const int ca = 1024 + lane * 8, cb = 1536 + lane * 8;
      const long tt = t;
      u32x2 va = {(unsigned)qa0, (unsigned)qa1}, vb = {(unsigned)qb0, (unsigned)qb1};
      *(u32x2*)(p.mixq() + (tt >> 1) * 4096 + (ca >> 6) * 128 + (tt & 1) * 64 + (ca & 63)) = va;
      *(u32x2*)(p.mixq() + (tt >> 1) * 4096 + (cb >> 6) * 128 + (tt & 1) * 64 + (cb & 63)) = vb;
    }
#else
    *(u32x4*)(p.mix() + (long)t * 2048 + 1024 + lane * 8) = wa;
    *(u32x4*)(p.mix() + (long)t * 2048 + 1024 + 512 + lane * 8) = wb;
#endif
  }
}
__device__ __forceinline__ void wout_tile(const Params& p, char* smem, int mt, int nt) {
  f32x16 acc[4][4];
  GemmTile t{};
  t.A = p.mix(); t.lda = 2048; t.aidx = nullptr; t.m0 = mt * 256; t.mvalid = 256;
  t.B0 = p.w_out + nt * 256; t.B1 = t.B0 + 128; t.ldb = 2048; t.nv0 = 128; t.nv1 = 128; t.kscale = nullptr; t.K = 2048;
  gemm_tile_256<4, false, false>(t, smem, acc);
  const long boff = (long)(mt * 256) * 2048 + nt * 256;
  acc_foreach_row<4>(acc, [&](int rowl, int coll, float (&v)[4]) {
    long o = boff + (long)rowl * 2048 + coll;
    OPAQUE(o);
    const float* xr = p.x + o; float* yr = p.x1() + o;
#pragma unroll
    for (int nb = 0; nb < 4; ++nb) { const int c = (nb >> 1) * 128 + (nb & 1) * 32; yr[c] = xr[c] + v[nb]; }
  });
}

#define P7_LDS_BYTES (4 * 32 * 33 * 4 + 4 * 64 * 4 + 32 * 33 * 4 + 128)
template <int DRY = 0>
__device__ __forceinline__ void ffn_prep_unit(const Params& p, char* smem, int u) {
  float* part = (float*)smem; float* ssq = part + 4 * 32 * 33; float* lg = ssq + 256; float* rs = lg + 32 * 33;
  const int tid = opaque_tid(), lane = tid & 63, wid = tid >> 6, l31 = lane & 31, hh = lane >> 5;
  __syncthreads();
  {
    const long t = (long)u * 32 + l31;
    const float* xr = p.x1() + t * 2048 + wid * 512;
    const float* gp = p.ffn_norm + wid * 512;
    const float* wp = p.router_w + (long)(wid * 512 + hh) * 32 + l31;
    f32x16 acc;
#pragma unroll
    for (int r = 0; r < 16; ++r) acc[r] = 0.f;
    float ss = 0.f;
#pragma unroll 4
    for (int m = 0; m < 128; ++m) {
      const f32x4 xv = *(const f32x4*)(xr + 4 * m);
      const f32x4 gv = *(const f32x4*)(gp + 4 * m);
      const float a0 = hh ? xv[1] : xv[0], a1 = hh ? xv[3] : xv[2];
      const float g0 = hh ? gv[1] : gv[0], g1 = hh ? gv[3] : gv[2];
      const float b0 = wp[(4 * m) * 32], b1 = wp[(4 * m + 2) * 32];
      ss += a0 * a0 + a1 * a1;
      acc = __builtin_amdgcn_mfma_f32_32x32x2f32(a0 * g0, b0, acc, 0, 0, 0);
      acc = __builtin_amdgcn_mfma_f32_32x32x2f32(a1 * g1, b1, acc, 0, 0, 0);
    }
#pragma unroll
    for (int r = 0; r < 16; ++r) part[(wid * 32 + (r & 3) + 8 * (r >> 2) + 4 * hh) * 33 + l31] = acc[r];
    ssq[wid * 64 + lane] = ss;
  }
  __syncthreads();
  {
    const int tl = tid >> 3, seg = tid & 7;
    if (seg == 0) {
      float s = 0.f;
#pragma unroll
      for (int w = 0; w < 4; ++w) s += ssq[w * 64 + tl] + ssq[w * 64 + 32 + tl];
      rs[tl] = rsqrtf(s * (1.0f / 2048.0f) + EPS_);
    }
  }
  __syncthreads();
  {
    const int tl = tid >> 3, seg = tid & 7;
    const float r = rs[tl];
#pragma unroll
    for (int c = 0; c < 4; ++c) {
      const int e = seg * 4 + c;
      const float s = part[(0 * 32 + tl) * 33 + e] + part[(1 * 32 + tl) * 33 + e] + part[(2 * 32 + tl) * 33 + e] + part[(3 * 32 + tl) * 33 + e];
      lg[tl * 33 + e] = s * r + p.router_b[e];
    }
  }
  __syncthreads();
  if (tid < 32 && !DRY) {
    const long tt = (long)u * 32 + tid;
    const float* L = lg + tid * 33;
    unsigned used = 0u; int i0 = 0, i1 = 0, i2 = 0, i3 = 0; float v0 = 0.f, v1 = 0.f, v2 = 0.f, v3 = 0.f;
#pragma unroll
    for (int k = 0; k < 4; ++k) {
      int bi = -1; float bv = 0.f;
      for (int i = 0; i < 32; ++i) {
        const float x = L[i];
        const bool take = !((used >> i) & 1u) && (bi < 0 || x > bv);
        bi = take ? i : bi; bv = take ? x : bv;
      }
      used |= 1u << bi;
      if (k == 0) { i0 = bi; v0 = bv; } else if (k == 1) { i1 = bi; v1 = bv; } else if (k == 2) { i2 = bi; v2 = bv; } else { i3 = bi; v3 = bv; }
    }
    const float e0 = 1.0f, e1 = __expf(v1 - v0), e2 = __expf(v2 - v0), e3 = __expf(v3 - v0);
    const float inv = 1.0f / (e0 + e1 + e2 + e3);
    const int s0 = atomicAdd(&p.counts()[i0], 1), s1 = atomicAdd(&p.counts()[i1], 1), s2 = atomicAdd(&p.counts()[i2], 1), s3 = atomicAdd(&p.counts()[i3], 1);
    p.list()[i0 * T_ + s0] = (int)tt; p.list()[i1 * T_ + s1] = (int)tt; p.list()[i2 * T_ + s2] = (int)tt; p.list()[i3 * T_ + s3] = (int)tt;
    p.asg_e()[tt * 4 + 0] = i0; p.asg_e()[tt * 4 + 1] = i1; p.asg_e()[tt * 4 + 2] = i2; p.asg_e()[tt * 4 + 3] = i3;
    p.asg_slot()[tt * 4 + 0] = s0; p.asg_slot()[tt * 4 + 1] = s1; p.asg_slot()[tt * 4 + 2] = s2; p.asg_slot()[tt * 4 + 3] = s3;
    p.asg_g()[tt * 4 + 0] = e0 * inv; p.asg_g()[tt * 4 + 1] = e1 * inv; p.asg_g()[tt * 4 + 2] = e2 * inv; p.asg_g()[tt * 4 + 3] = e3 * inv;
  }
  {
    const int tl = tid >> 3, seg = tid & 7;
    const long t = (long)u * 32 + tl;
    const float* xr = p.x1() + t * 2048;
    const float rr = rs[tl];
#pragma unroll 8
    for (int it = 0; it < 32; ++it) {
      const int kk = it * 64 + seg * 8;
      f32x4 v0 = *(const f32x4*)(xr + kk), v1 = *(const f32x4*)(xr + kk + 4);
      f32x4 g0 = *(const f32x4*)(p.ffn_norm + kk), g1 = *(const f32x4*)(p.ffn_norm + kk + 4);
      v0 = v0 * g0 * rr; v1 = v1 * g1 * rr;
#if MOEQ == 0
      u32x4 w = {pack_bf16(v0[0], v0[1]), pack_bf16(v0[2], v0[3]), pack_bf16(v1[0], v1[1]), pack_bf16(v1[2], v1[3])};
      *(u32x4*)(p.h2() + t * 2048 + kk) = w;
#else
      int q0 = 0, q1 = 0;
      q0 = __builtin_amdgcn_cvt_pk_fp8_f32(v0[0], v0[1], q0, false);
      q0 = __builtin_amdgcn_cvt_pk_fp8_f32(v0[2], v0[3], q0, true);
      q1 = __builtin_amdgcn_cvt_pk_fp8_f32(v1[0], v1[1], q1, false);
      q1 = __builtin_amdgcn_cvt_pk_fp8_f32(v1[2], v1[3], q1, true);
      u32x2 wq = {(unsigned)q0, (unsigned)q1};
      *(u32x2*)(p.h2q() + t * 2048 + kk) = wq;
#endif
    }
  }
}

__device__ __forceinline__ void moe_setup(const Params& p, int* mo) {
  __syncthreads();
  if (threadIdx.x == 0) {
    int s = 0;
    for (int e = 0; e < NE_; ++e) { mo[e] = s; s += (p.counts()[e] + 255) >> 8; }
    mo[NE_] = s;
  }
  __syncthreads();
}
#ifndef MAPV
#define MAPV 0
#endif
__device__ __forceinline__ int xcd_unit(int round) { return MAPV ? (round * 256 + blockIdx.x) : (round * 256 + (blockIdx.x & 7) * 32 + (blockIdx.x >> 3)); }

__device__ __forceinline__ void moe1_tile(const Params& p, char* smem, const int* mo, int e, int nt, int mt) {
  f32x16 acc[4][4];
  GemmTile t{};
  const int cnt = p.counts()[e];
  t.A = p.h2(); t.lda = 2048; t.aidx = p.list() + e * T_ + mt * 256; t.m0 = 0; t.mvalid = min(256, cnt - mt * 256);
  t.B0 = p.w_gu + (long)e * 2048 * 4096 + nt * 128; t.B1 = t.B0 + 2048; t.ldb = 4096; t.nv0 = 128; t.nv1 = 128; t.kscale = nullptr; t.K = 2048;
  gemm_tile_256<4, false, true>(t, smem, acc);
  u16* base = p.act() + (long)(mo[e] * 256 + mt * 256) * 2048 + nt * 128;
  const float* bg = p.b_gu + e * 4096 + nt * 128; const float* bu = bg + 2048;
  const int tq_ = opaque_tid(); const int cl = (tq_ >> 6 & 1) * 64 + (tq_ & 31);
  const float bgv[2] = {bg[cl], bg[cl + 32]}, buv[2] = {bu[cl], bu[cl + 32]};
  acc_foreach_row<4>(acc, [&](int rowl, int coll, float (&v)[4]) {
    u16* rp = base + (long)rowl * 2048 + coll;
    OPAQUE(rp);
#pragma unroll
    for (int nb = 0; nb < 2; ++nb) {
      const int c = nb * 32;
      float g = fminf(v[nb] + bgv[nb], 7.0f);
      float uu = fminf(fmaxf(v[nb + 2] + buv[nb], -7.0f), 7.0f);
      float a = (uu + 1.0f) * (g / (1.0f + __expf(-1.702f * g)));
      rp[c] = f32_to_bf16(a);
    }
  });
}
__device__ __forceinline__ void moe2_tile(const Params& p, char* smem, const int* mo, int e, int nt, int mt) {
  f32x16 acc[4][4];
  GemmTile t{};
  t.A = p.act(); t.lda = 2048; t.aidx = nullptr; t.m0 = mo[e] * 256 + mt * 256; t.mvalid = 256;
  t.B0 = p.w_dn + (long)e * 2048 * 2048 + nt * 256; t.B1 = t.B0 + 128; t.ldb = 2048; t.nv0 = 128; t.nv1 = 128; t.kscale = nullptr; t.K = 2048;
  gemm_tile_256<4, false, false>(t, smem, acc);
  u16* base = p.ybuf() + (long)t.m0 * 2048 + nt * 256;
  const float* bd = p.b_dn + e * 2048 + nt * 256;
  const int tq_ = opaque_tid(); const int cl = (tq_ >> 6 & 1) * 64 + (tq_ & 31);
  const float bdv[4] = {bd[cl], bd[cl + 32], bd[cl + 128], bd[cl + 160]};
  acc_foreach_row<4>(acc, [&](int rowl, int coll, float (&v)[4]) {
    u16* rp = base + (long)rowl * 2048 + coll;
    OPAQUE(rp);
#pragma unroll
    for (int nb = 0; nb < 4; ++nb) { const int c = (nb >> 1) * 128 + (nb & 1) * 32; rp[c] = f32_to_bf16(v[nb] + bdv[nb]); }
  });
}
template <int WHICH, int HALF = 0>
__device__ __forceinline__ void ph_moe(const Params& p, char* smem) {
  int* mo = (int*)(smem + G_LDS_BYTES);
  moe_setup(p, mo);
  const int NT = (WHICH == 1) ? 16 : 8;
  const int total = mo[NE_] * NT;
  if (HALF && ((blockIdx.x >> 3) & 1)) return;
  const int W = HALF ? 128 : 256;
  for (int round = 0;; ++round) {
    const int u = HALF ? (round * 128 + (blockIdx.x & 7) * 16 + (blockIdx.x >> 4)) : xcd_unit(round);
    if (round * W >= total) break;
    if (u >= total) continue;
    int e = 0;
    while (mo[e + 1] * NT <= u) ++e;
    const int local = u - mo[e] * NT, me = mo[e + 1] - mo[e];
    const int nt = local / me, mt = local - nt * me;
    if (WHICH == 1) moe1_tile(p, smem, mo, e, nt, mt); else moe2_tile(p, smem, mo, e, nt, mt);
  }
}

__device__ __forceinline__ void ph_final(const Params& p, char* smem, float dbg_scale = 1.0f) {
  int* mo = (int*)(smem + G_LDS_BYTES);
  moe_setup(p, mo);
  const int tid_ = opaque_tid(); const int lane = tid_ & 63, wid = tid_ >> 6;
  for (int t = blockIdx.x * 4 + wid; t < T_; t += gridDim.x * 4) {
    long rows[4]; float gg[4];
#pragma unroll
    for (int k = 0; k < 4; ++k) { rows[k] = (long)(mo[p.asg_e()[t * 4 + k]] * 256 + p.asg_slot()[t * 4 + k]) * 2048; gg[k] = p.asg_g()[t * 4 + k]; }
    f32x4 v[8]; float ss = 0.f;
#pragma unroll
    for (int j = 0; j < 8; ++j) {
      const int c = j * 256 + lane * 4;
      f32x4 a = *(const f32x4*)(p.x1() + (long)t * 2048 + c);
#pragma unroll
      for (int k = 0; k < 4; ++k) {
        u32x2 w = *(const u32x2*)(p.ybuf() + rows[k] + c);
        a[0] += gg[k] * bf_lo(w[0]); a[1] += gg[k] * bf_hi(w[0]); a[2] += gg[k] * bf_lo(w[1]); a[3] += gg[k] * bf_hi(w[1]);
      }
      v[j] = a; ss += a[0] * a[0] + a[1] * a[1] + a[2] * a[2] + a[3] * a[3];
    }
    ss = wave_sum(ss);
    const float r = rsqrtf(ss * (1.0f / 2048.0f) + EPS_);
#pragma unroll
    for (int j = 0; j < 8; ++j) {
      const int c = j * 256 + lane * 4;
      f32x4 g = *(const f32x4*)(p.final_norm + c);
      f32x4 o = {v[j][0] * r * g[0] * dbg_scale, v[j][1] * r * g[1] * dbg_scale, v[j][2] * r * g[2] * dbg_scale, v[j][3] * r * g[3] * dbg_scale};
      *(f32x4*)(p.out + (long)t * 2048 + c) = o;
    }
  }
}
#define WSCALE_  128.0f
#define WISCALE_ 0.0078125f
typedef unsigned char u8;

struct CvtUnit { const float* src; u8* dst; int ldn; };
__device__ __forceinline__ CvtUnit cvt8_decode(const Params& p, int u) {
  CvtUnit c;
  if (u < 16384) {
    const int e = u >> 9, kb = (u >> 4) & 31, nt = u & 15;
    c.src = p.w_gu + (long)e * 2048 * 4096 + (long)(kb * 64) * 4096 + nt * 256; c.ldn = 4096;
    c.dst = p.wq_gu() + ((long)e * 4096 + nt * 256) * 2048 + kb * 128;
  } else {
    const int v = u - 16384; const int e = v >> 8, kb = (v >> 3) & 31, nt = v & 7;
    c.src = p.w_dn + (long)e * 2048 * 2048 + (long)(kb * 64) * 2048 + nt * 256; c.ldn = 2048;
    c.dst = p.wq_dn() + ((long)e * 2048 + nt * 256) * 2048 + kb * 128;
  }
  return c;
}
__device__ __forceinline__ void cvt8_load(const CvtUnit& c, int w, int lane, f32x4 (&v)[16]) {
  const float* src = c.src + (long)(w * 16) * c.ldn + lane * 4;
#pragma unroll
  for (int j = 0; j < 16; ++j) {
    const float* ptr = src + (long)j * c.ldn;
    asm volatile("global_load_dwordx4 %0, %1, off" : "=v"(v[j]) : "v"(ptr) : "memory");
  }
}
#define CVT_WAIT(N, v) asm volatile("s_waitcnt vmcnt(%16)" : "+v"(v[0]), "+v"(v[1]), "+v"(v[2]), "+v"(v[3]), "+v"(v[4]), "+v"(v[5]), "+v"(v[6]), "+v"(v[7]), \
    "+v"(v[8]), "+v"(v[9]), "+v"(v[10]), "+v"(v[11]), "+v"(v[12]), "+v"(v[13]), "+v"(v[14]), "+v"(v[15]) : "n"(N) : "memory")
__device__ __forceinline__ void cvt8_emit(const CvtUnit& c, int tid, int w, int lane, f32x4 (&v)[16], char* T) {
  __syncthreads();
#pragma unroll
  for (int cc = 0; cc < 4; ++cc) {
    u32x4 x4;
#pragma unroll
    for (int q = 0; q < 4; ++q) {
      int x = 0;
      x = __builtin_amdgcn_cvt_pk_fp8_f32(v[4 * q][cc] * WSCALE_, v[4 * q + 1][cc] * WSCALE_, x, false);
      x = __builtin_amdgcn_cvt_pk_fp8_f32(v[4 * q + 2][cc] * WSCALE_, v[4 * q + 3][cc] * WSCALE_, x, true);
      x4[q] = (unsigned)x;
    }
    *(u32x4*)(T + (lane * 4 + cc) * 64 + w * 16) = x4;
  }
  __syncthreads();
#pragma unroll
  for (int i = 0; i < 4; ++i) {
    const int n = (tid >> 2) + 64 * i, ch = tid & 3;
    *(u32x4*)(c.dst + (long)(n >> 1) * 4096 + (n & 1) * 64 + ch * 16) = *(const u32x4*)(T + n * 64 + ch * 16);
  }
}
__device__ __forceinline__ void convert_units(const Params& p, char* smem, int first, int stride, int count) {
  const int tid = opaque_tid();
  const int w = tid >> 6, lane = tid & 63;
  if (count <= 0) return;
  f32x4 va[16], vb[16], vc[16];
  CvtUnit ca = cvt8_decode(p, first), cb = cvt8_decode(p, first + stride), cc = cvt8_decode(p, first + 2 * stride);
  cvt8_load(ca, w, lane, va);
  cvt8_load(cb, w, lane, vb);
  cvt8_load(cc, w, lane, vc);
  CVT_WAIT(32, va); cvt8_emit(ca, tid, w, lane, va, smem); ca = cvt8_decode(p, first + 3 * stride); cvt8_load(ca, w, lane, va);
  CVT_WAIT(36, vb); cvt8_emit(cb, tid, w, lane, vb, smem); cb = cvt8_decode(p, first + 4 * stride); cvt8_load(cb, w, lane, vb);
  CVT_WAIT(40, vc); cvt8_emit(cc, tid, w, lane, vc, smem); cc = cvt8_decode(p, first + 5 * stride); cvt8_load(cc, w, lane, vc);
  for (int i = 3; i + 3 < count; i += 3) {
    CVT_WAIT(40, va); cvt8_emit(ca, tid, w, lane, va, smem); ca = cvt8_decode(p, first + (i + 3) * stride); cvt8_load(ca, w, lane, va);
    CVT_WAIT(40, vb); cvt8_emit(cb, tid, w, lane, vb, smem); cb = cvt8_decode(p, first + (i + 4) * stride); cvt8_load(cb, w, lane, vb);
    CVT_WAIT(40, vc); cvt8_emit(cc, tid, w, lane, vc, smem); cc = cvt8_decode(p, first + (i + 5) * stride); cvt8_load(cc, w, lane, vc);
  }
  CVT_WAIT(0, va); cvt8_emit(ca, tid, w, lane, va, smem);
  CVT_WAIT(0, vb); cvt8_emit(cb, tid, w, lane, vb, smem);
  CVT_WAIT(0, vc); cvt8_emit(cc, tid, w, lane, vc, smem);
}
__device__ __forceinline__ void convert_one(const Params& p, char* smem, int u) {
  const int tid = opaque_tid();
  const int w = tid >> 6, lane = tid & 63;
  f32x4 va[16];
  CvtUnit ca = cvt8_decode(p, u);
  cvt8_load(ca, w, lane, va);
  CVT_WAIT(0, va); cvt8_emit(ca, tid, w, lane, va, smem);
}
__device__ __forceinline__ void ph_convert(const Params& p, char* smem) {
  convert_units(p, smem, blockIdx.x, gridDim.x, 24576 / 256);
}
__device__ __forceinline__ void ph_convert_gu(const Params& p, char* smem, int part, int nparts) {
  (void)part; (void)nparts;
  convert_units(p, smem, blockIdx.x, 256, 63);
  convert_one(p, smem, blockIdx.x + 63 * 256);
}
__device__ __forceinline__ void ph_convert_dn(const Params& p, char* smem) {
  convert_units(p, smem, 16384 + blockIdx.x, 256, 30);
  convert_one(p, smem, 16384 + blockIdx.x + 30 * 256);
  convert_one(p, smem, 16384 + blockIdx.x + 31 * 256);
}

#define R_STAGE 32768
struct GemmRTile {
  const u8* A; int lda; const int* aidx; int m0, mvalid;
  const u8* B; long brow0, brow1; int ldb;
  int pairb;
  int paira;
  int KB;
};
template <bool FP8, bool GATHER>
__device__ __forceinline__ void gemmr_tile_256(const GemmRTile& t, char* smem, f32x16 (&acc)[4][4]) {
  int tz0 = threadIdx.x; asm volatile("" : "+v"(tz0));
  const int tid = tz0, lane = tid & 63, wid = tid >> 6, wr = wid >> 1, wc = wid & 1;
  const int l31 = lane & 31, hh = lane >> 5;
#pragma unroll
  for (int i = 0; i < 4; ++i)
#pragma unroll
    for (int j = 0; j < 4; ++j)
#pragma unroll
      for (int r = 0; r < 16; ++r) acc[i][j][r] = 0.f;
  const int c_src = (tid & 3) ^ ((tid >> 4) & 3);
  const u8* a_src[GATHER ? 4 : 1];
  if (GATHER) {
#pragma unroll
    for (int i = 0; i < (GATHER ? 4 : 1); ++i) {
      int r = (tid >> 2) + 64 * i;
      int rr = r < t.mvalid ? r : 0;
      a_src[i] = t.A + (long)t.aidx[rr] * t.lda + c_src * 16;
    }
  } else {
    a_src[0] = t.A + (long)(t.m0 + (tid >> 2)) * t.lda + c_src * 16;
  }
  const long a_step = 64L * t.lda, b_step = 64L * t.ldb;
  const u8* b_src0 = t.B + (t.brow0 + (tid >> 2)) * t.ldb + c_src * 16;
  const u8* b_src1 = t.B + (t.brow1 + (tid >> 2)) * t.ldb + c_src * 16;
  const unsigned lds0 = (unsigned)(size_t)smem + (unsigned)__builtin_amdgcn_readfirstlane(wid) * 1024u;
  auto issue = [&](int kt, int sl, int q) {
    if (q < 4) glds16_asm((const void*)((GATHER ? a_src[GATHER ? q : 0] : a_src[0] + q * a_step) + kt * 64), lds0 + sl * R_STAGE + q * 4096);
    else { const int i = q - 4; glds16_asm((const void*)((i < 2 ? b_src0 + i * b_step : b_src1 + (i - 2) * b_step) + kt * 64), lds0 + sl * R_STAGE + 16384 + i * 4096); }
  };
  unsigned a_rd[2], b_rd[2];
#pragma unroll
  for (int s2 = 0; s2 < 2; ++s2) {
    const int ra = wr * 128 + l31, rb = wc * 64 + l31;
    a_rd[s2] = ra * 64 + (((2 * s2 + hh) ^ ((ra >> 2) & 3)) * 16);
    b_rd[s2] = rb * 64 + (((2 * s2 + hh) ^ ((rb >> 2) & 3)) * 16);
  }
  auto load_frags = [&](const char* St, int s2, u32x4 (&af)[4], u32x4 (&bf)[4]) {
#pragma unroll
    for (int mb = 0; mb < 4; ++mb) af[mb] = *(const u32x4*)(St + a_rd[s2] + mb * 2048);
#pragma unroll
    for (int nb = 0; nb < 4; ++nb) bf[nb] = *(const u32x4*)(St + 16384 + b_rd[s2] + (nb >> 1) * 8192 + (nb & 1) * 2048);
  };
  auto mma = [&](u32x4 (&ac)[4], u32x4 (&bc)[4], int nb) {
    if (FP8) {
#pragma unroll
      for (int u = 0; u < 2; ++u) {
        const long bl = (long)(((unsigned long long)bc[nb][2 * u + 1] << 32) | bc[nb][2 * u]);
#pragma unroll
        for (int mb = 0; mb < 4; ++mb) {
          const long al = (long)(((unsigned long long)ac[mb][2 * u + 1] << 32) | ac[mb][2 * u]);
          acc[mb][nb] = __builtin_amdgcn_mfma_f32_32x32x16_fp8_fp8(al, bl, acc[mb][nb], 0, 0, 0);
        }
      }
    } else {
      const bf16x8 bb = *(const bf16x8*)&bc[nb];
#pragma unroll
      for (int mb = 0; mb < 4; ++mb) acc[mb][nb] = __builtin_amdgcn_mfma_f32_32x32x16_bf16(*(const bf16x8*)&ac[mb], bb, acc[mb][nb], 0, 0, 0);
    }
  };
  u32x4 a0[4], b0[4], a1[4], b1[4];
  auto half0 = [&](int kt, bool issueA) {
    const char* St = smem + (kt & 3) * R_STAGE;
    load_frags(St, 1, a1, b1);
    __builtin_amdgcn_sched_barrier(0);
#pragma unroll
    for (int nb = 0; nb < 4; ++nb) {
      mma(a0, b0, nb);
      __builtin_amdgcn_sched_barrier(0);
      if (issueA) issue(kt + 2, (kt + 2) & 3, 4 + nb);
      __builtin_amdgcn_sched_barrier(0);
    }
  };
  auto half1 = [&](int kt, bool has1, bool issueB) {
    const char* Sn = smem + ((kt + 1) & 3) * R_STAGE;
    if (has1) load_frags(Sn, 0, a0, b0);
    __builtin_amdgcn_sched_barrier(0);
#pragma unroll
    for (int nb = 0; nb < 4; ++nb) {
      mma(a1, b1, nb);
      __builtin_amdgcn_sched_barrier(0);
      if (issueB) issue(kt + 3, (kt + 3) & 3, nb);
      __builtin_amdgcn_sched_barrier(0);
    }
  };
  const int nk = t.KB >> 6;
  __syncthreads();
#pragma unroll
  for (int q = 0; q < 8; ++q) issue(0, 0, q);
#pragma unroll
  for (int q = 0; q < 8; ++q) issue(1, 1, q);
#pragma unroll
  for (int q = 0; q < 4; ++q) issue(2, 2, q);
  asm volatile("s_waitcnt vmcnt(12)" ::: "memory");
  __syncthreads();
  load_frags(smem, 0, a0, b0);
  for (int kt = 0; kt < nk - 3; ++kt) {
    half0(kt, true);
    asm volatile("s_waitcnt vmcnt(8)" ::: "memory");
    __syncthreads();
    half1(kt, true, true);
  }
  half0(nk - 3, true);
  asm volatile("s_waitcnt vmcnt(8)" ::: "memory");
  __syncthreads();
  half1(nk - 3, true, false);
  half0(nk - 2, false);
  asm volatile("s_waitcnt vmcnt(0)" ::: "memory");
  __syncthreads();
  half1(nk - 2, true, false);
  half0(nk - 1, false);
  half1(nk - 1, false, false);
}


typedef int i32x8 __attribute__((ext_vector_type(8)));
template <bool GATHER>
__device__ __forceinline__ void gemmrs_tile_256(const GemmRTile& t, char* smem, f32x16 (&acc)[4][4]) {
  int tz0 = threadIdx.x; asm volatile("" : "+v"(tz0));
  const int tid = tz0, lane = tid & 63, wid = tid >> 6, wr = wid >> 1, wc = wid & 1;
  const int l31 = lane & 31, hh = lane >> 5;
#pragma unroll
  for (int i = 0; i < 4; ++i)
#pragma unroll
    for (int j = 0; j < 4; ++j)
#pragma unroll
      for (int r = 0; r < 16; ++r) acc[i][j][r] = 0.f;
  const int c_src = (tid & 3) ^ ((tid >> 4) & 3);
  const u8* a_src[GATHER ? 4 : 1];
  if (GATHER) {
#pragma unroll
    for (int i = 0; i < (GATHER ? 4 : 1); ++i) {
      int r = (tid >> 2) + 64 * i;
      int rr = r < t.mvalid ? r : 0;
      a_src[i] = t.A + (long)t.aidx[rr] * t.lda + c_src * 16;
    }
  } else {
    a_src[0] = t.A + ((long)(t.m0 + (tid >> 2)) >> 1) * 4096 + ((tid >> 2) & 1) * 64 + c_src * 16;
  }
  const long a_step = GATHER ? 64L * t.lda : 32L * 4096, b_step = 32L * 4096;
  const int a_kstep = GATHER ? 64 : 128;
  const int brl = tid >> 2;
  const u8* b_src0 = t.B + ((t.brow0 + brl) >> 1) * 4096 + (brl & 1) * 64 + c_src * 16;
  const u8* b_src1 = t.B + ((t.brow1 + brl) >> 1) * 4096 + (brl & 1) * 64 + c_src * 16;
  const unsigned lds0 = (unsigned)(size_t)smem + (unsigned)__builtin_amdgcn_readfirstlane(wid) * 1024u;
  auto issue = [&](int kt, int sl, int q) {
    if (q < 4) glds16_asm((const void*)((GATHER ? a_src[GATHER ? q : 0] : a_src[0] + q * a_step) + kt * a_kstep), lds0 + sl * R_STAGE + q * 4096);
    else { const int i = q - 4; glds16_asm((const void*)((i < 2 ? b_src0 + i * b_step : b_src1 + (i - 2) * b_step) + kt * 128), lds0 + sl * R_STAGE + 16384 + i * 4096); }
  };
  unsigned a_rd[2], b_rd[2];
#pragma unroll
  for (int c = 0; c < 2; ++c) {
    const int ra = wr * 128 + l31, rb = wc * 64 + l31;
    a_rd[c] = ra * 64 + (((2 * hh + c) ^ ((ra >> 2) & 3)) * 16);
    b_rd[c] = rb * 64 + (((2 * hh + c) ^ ((rb >> 2) & 3)) * 16);
  }
  auto load_a = [&](const char* St, i32x8 (&af)[4]) {
#pragma unroll
    for (int mb = 0; mb < 4; ++mb) {
      const u32x4 lo = *(const u32x4*)(St + a_rd[0] + mb * 2048), hi = *(const u32x4*)(St + a_rd[1] + mb * 2048);
      af[mb] = (i32x8){(int)lo[0], (int)lo[1], (int)lo[2], (int)lo[3], (int)hi[0], (int)hi[1], (int)hi[2], (int)hi[3]};
    }
  };
  auto load_b = [&](const char* St, int nb, i32x8& bf) {
    const char* bp = St + 16384 + (nb >> 1) * 8192 + (nb & 1) * 2048;
    const u32x4 lo = *(const u32x4*)(bp + b_rd[0]), hi = *(const u32x4*)(bp + b_rd[1]);
    bf = (i32x8){(int)lo[0], (int)lo[1], (int)lo[2], (int)lo[3], (int)hi[0], (int)hi[1], (int)hi[2], (int)hi[3]};
  };
  auto mma4 = [&](i32x8 (&af)[4], i32x8& bf, int nb) {
#pragma unroll
    for (int mb = 0; mb < 4; ++mb)
      acc[mb][nb] = __builtin_amdgcn_mfma_scale_f32_32x32x64_f8f6f4(af[mb], bf, acc[mb][nb], 0, 0, 0, 0x7f7f7f7f, 0, 0x7f7f7f7f);
  };
  i32x8 aA[4], aB[4], bq[4];
  auto half0 = [&](int kt, i32x8 (&ac)[4], bool issueA) {
    const char* St = smem + (kt & 3) * R_STAGE;
    load_b(St, 2, bq[2]); load_b(St, 3, bq[3]);
    __builtin_amdgcn_sched_barrier(0);
#pragma unroll
    for (int nb = 0; nb < 2; ++nb) {
      mma4(ac, bq[nb], nb);
      __builtin_amdgcn_sched_barrier(0);
      if (issueA) { issue(kt + 2, (kt + 2) & 3, 4 + 2 * nb); issue(kt + 2, (kt + 2) & 3, 5 + 2 * nb); }
      __builtin_amdgcn_sched_barrier(0);
    }
  };
  auto half1 = [&](int kt, i32x8 (&ac)[4], i32x8 (&an)[4], bool has1, bool issueB) {
    const char* Sn = smem + ((kt + 1) & 3) * R_STAGE;
    if (has1) { load_a(Sn, an); load_b(Sn, 0, bq[0]); load_b(Sn, 1, bq[1]); }
    __builtin_amdgcn_sched_barrier(0);
#pragma unroll
    for (int nb = 2; nb < 4; ++nb) {
      mma4(ac, bq[nb], nb);
      __builtin_amdgcn_sched_barrier(0);
      if (issueB) { issue(kt + 3, (kt + 3) & 3, 2 * (nb - 2)); issue(kt + 3, (kt + 3) & 3, 2 * (nb - 2) + 1); }
      __builtin_amdgcn_sched_barrier(0);
    }
  };
  const int nk = t.KB >> 6;
  __syncthreads();
#pragma unroll
  for (int q = 0; q < 8; ++q) issue(0, 0, q);
#pragma unroll
  for (int q = 0; q < 8; ++q) issue(1, 1, q);
#pragma unroll
  for (int q = 0; q < 4; ++q) issue(2, 2, q);
  asm volatile("s_waitcnt vmcnt(12)" ::: "memory");
  __syncthreads();
  load_a(smem, aA); load_b(smem, 0, bq[0]); load_b(smem, 1, bq[1]);
  for (int kt = 0; kt < nk - 4; kt += 2) {
    half0(kt, aA, true);
    asm volatile("s_waitcnt vmcnt(8)" ::: "memory"); __syncthreads();
    half1(kt, aA, aB, true, true);
    half0(kt + 1, aB, true);
    asm volatile("s_waitcnt vmcnt(8)" ::: "memory"); __syncthreads();
    half1(kt + 1, aB, aA, true, true);
  }
  half0(nk - 4, aA, true);
  asm volatile("s_waitcnt vmcnt(8)" ::: "memory"); __syncthreads();
  half1(nk - 4, aA, aB, true, true);
  half0(nk - 3, aB, true);
  asm volatile("s_waitcnt vmcnt(8)" ::: "memory"); __syncthreads();
  half1(nk - 3, aB, aA, true, false);
  half0(nk - 2, aA, false);
  asm volatile("s_waitcnt vmcnt(0)" ::: "memory"); __syncthreads();
  half1(nk - 2, aA, aB, true, false);
  half0(nk - 1, aB, false);
  half1(nk - 1, aB, aA, false, false);
}

template <bool GATHER>
__device__ __forceinline__ void gemmrv_tile_256(const GemmRTile& t, char* smem, f32x16 (&acc)[4][4]) {
  int tz0 = threadIdx.x; asm volatile("" : "+v"(tz0));
  const int tid = tz0, lane = tid & 63, wid = tid >> 6, wr = wid >> 1, wc = wid & 1;
  const int l31 = lane & 31, hh = lane >> 5;
#pragma unroll
  for (int i = 0; i < 4; ++i)
#pragma unroll
    for (int j = 0; j < 4; ++j)
#pragma unroll
      for (int r = 0; r < 16; ++r) acc[i][j][r] = 0.f;
  const int c_src = (tid & 3) ^ ((tid >> 4) & 3);
  const u8* a_src[GATHER ? 4 : 1];
  if (GATHER) {
#pragma unroll
    for (int i = 0; i < (GATHER ? 4 : 1); ++i) {
      int r = (tid >> 2) + 64 * i;
      int rr = r < t.mvalid ? r : 0;
      a_src[i] = t.A + (long)t.aidx[rr] * t.lda + c_src * 16;
    }
  } else {
    a_src[0] = t.A + ((long)(t.m0 + (tid >> 2)) >> 1) * 4096 + ((tid >> 2) & 1) * 64 + c_src * 16;
  }
  const long a_step = GATHER ? 64L * t.lda : 32L * 4096, b_step = 32L * 4096;
  const int a_kstep = GATHER ? 64 : 128;
  const int brl = tid >> 2;
  const u8* b_src0 = t.B + ((t.brow0 + brl) >> 1) * 4096 + (brl & 1) * 64 + c_src * 16;
  const u8* b_src1 = t.B + ((t.brow1 + brl) >> 1) * 4096 + (brl & 1) * 64 + c_src * 16;
  u32x4 rs0[8], rs1[8];
  auto ldg = [&](int kt, int q, u32x4& dst) {
    const u8* ptr = (q < 4) ? ((GATHER ? a_src[GATHER ? q : 0] : a_src[0] + q * a_step) + kt * a_kstep)
                            : (((q - 4) < 2 ? b_src0 + (q - 4) * b_step : b_src1 + (q - 6) * b_step) + kt * 128);
    asm volatile("global_load_dwordx4 %0, %1, off" : "=v"(dst) : "v"(ptr) : "memory");
  };
  auto stw = [&](int sl, int q, const u32x4& src) {
    *(u32x4*)(smem + sl * R_STAGE + (q < 4 ? q * 4096 : 16384 + (q - 4) * 4096) + tid * 16) = src;
  };
#define RV_WAIT(N, r) asm volatile("s_waitcnt vmcnt(%8)" : "+v"(r[0]), "+v"(r[1]), "+v"(r[2]), "+v"(r[3]), "+v"(r[4]), "+v"(r[5]), "+v"(r[6]), "+v"(r[7]) : "n"(N) : "memory")
  unsigned a_rd[2], b_rd[2];
#pragma unroll
  for (int c = 0; c < 2; ++c) {
    const int ra = wr * 128 + l31, rb = wc * 64 + l31;
    a_rd[c] = ra * 64 + (((2 * hh + c) ^ ((ra >> 2) & 3)) * 16);
    b_rd[c] = rb * 64 + (((2 * hh + c) ^ ((rb >> 2) & 3)) * 16);
  }
  auto load_a = [&](const char* St, i32x8 (&af)[4]) {
#pragma unroll
    for (int mb = 0; mb < 4; ++mb) {
      const u32x4 lo = *(const u32x4*)(St + a_rd[0] + mb * 2048), hi = *(const u32x4*)(St + a_rd[1] + mb * 2048);
      af[mb] = (i32x8){(int)lo[0], (int)lo[1], (int)lo[2], (int)lo[3], (int)hi[0], (int)hi[1], (int)hi[2], (int)hi[3]};
    }
  };
  auto load_b = [&](const char* St, int nb, i32x8& bf) {
    const char* bp = St + 16384 + (nb >> 1) * 8192 + (nb & 1) * 2048;
    const u32x4 lo = *(const u32x4*)(bp + b_rd[0]), hi = *(const u32x4*)(bp + b_rd[1]);
    bf = (i32x8){(int)lo[0], (int)lo[1], (int)lo[2], (int)lo[3], (int)hi[0], (int)hi[1], (int)hi[2], (int)hi[3]};
  };
  auto mma4 = [&](i32x8 (&af)[4], i32x8& bf, int nb) {
#pragma unroll
    for (int mb = 0; mb < 4; ++mb)
      acc[mb][nb] = __builtin_amdgcn_mfma_scale_f32_32x32x64_f8f6f4(af[mb], bf, acc[mb][nb], 0, 0, 0, 0x7f7f7f7f, 0, 0x7f7f7f7f);
  };
  i32x8 aA[4], aB[4], bq[4];
  auto half0 = [&](int kt, i32x8 (&ac)[4]) {
    const char* St = smem + (kt & 1) * R_STAGE;
    load_b(St, 2, bq[2]); load_b(St, 3, bq[3]);
    __builtin_amdgcn_sched_barrier(0);
    mma4(ac, bq[0], 0);
    __builtin_amdgcn_sched_barrier(0);
    mma4(ac, bq[1], 1);
    __builtin_amdgcn_sched_barrier(0);
  };
  auto commit = [&](int kt, u32x4 (&rn)[8], auto wtag, bool has1, bool has3) {
    constexpr int W = decltype(wtag)::value;
    if (has1) {
      RV_WAIT(W, rn);
#pragma unroll
      for (int q = 0; q < 8; ++q) stw((kt + 1) & 1, q, rn[q]);
      if (has3) {
#pragma unroll
        for (int q = 0; q < 8; ++q) ldg(kt + 3, q, rn[q]);
      }
      __syncthreads();
    }
  };
  auto half1 = [&](int kt, i32x8 (&ac)[4], i32x8 (&an)[4], bool has1) {
    const char* Sn = smem + ((kt + 1) & 1) * R_STAGE;
    if (has1) { load_a(Sn, an); load_b(Sn, 0, bq[0]); load_b(Sn, 1, bq[1]); }
    __builtin_amdgcn_sched_barrier(0);
    mma4(ac, bq[2], 2);
    __builtin_amdgcn_sched_barrier(0);
    mma4(ac, bq[3], 3);
    __builtin_amdgcn_sched_barrier(0);
  };
#define IC(n) std::integral_constant<int, n>{}
  const int nk = t.KB >> 6;
  __syncthreads();
#pragma unroll
  for (int q = 0; q < 8; ++q) ldg(0, q, rs0[q]);
#pragma unroll
  for (int q = 0; q < 8; ++q) ldg(1, q, rs1[q]);
  RV_WAIT(8, rs0);
#pragma unroll
  for (int q = 0; q < 8; ++q) stw(0, q, rs0[q]);
#pragma unroll
  for (int q = 0; q < 8; ++q) ldg(2, q, rs0[q]);
  __syncthreads();
  load_a(smem, aA); load_b(smem, 0, bq[0]); load_b(smem, 1, bq[1]);
  for (int kt = 0; kt < nk - 4; kt += 2) {
    half0(kt, aA);      commit(kt, rs1, IC(8), true, true);      half1(kt, aA, aB, true);
    half0(kt + 1, aB);  commit(kt + 1, rs0, IC(8), true, true);  half1(kt + 1, aB, aA, true);
  }
  half0(nk - 4, aA);  commit(nk - 4, rs1, IC(8), true, true);   half1(nk - 4, aA, aB, true);
  half0(nk - 3, aB);  commit(nk - 3, rs0, IC(8), true, false);  half1(nk - 3, aB, aA, true);
  half0(nk - 2, aA);  commit(nk - 2, rs1, IC(0), true, false);  half1(nk - 2, aA, aB, true);
  half0(nk - 1, aB);                                            half1(nk - 1, aB, aA, false);
#undef IC
#undef RV_WAIT
}

__device__ __forceinline__ void cvt16_tile(const float* W, int col0, int ldn, int nvalid  , const float* kgain,
                                           u16* out  , int ldk, char* T) {
  const int tid = opaque_tid();
  const int kq = tid & 7, n4 = tid >> 3;
  f32x4 v[16];
  const bool ok = (n4 * 4) < nvalid;
  const float* src = W + (long)(kq * 16) * ldn + (ok ? n4 * 4 : -col0);
#pragma unroll
  for (int j = 0; j < 16; ++j) v[j] = *(const f32x4*)(src + (long)j * ldn);
  if (kgain) {
#pragma unroll
    for (int j = 0; j < 16; ++j) v[j] *= kgain[kq * 16 + j];
  }
  if (!ok) {
#pragma unroll
    for (int j = 0; j < 16; ++j) v[j] = (f32x4){0.f, 0.f, 0.f, 0.f};
  }
  __syncthreads();
#pragma unroll
  for (int c = 0; c < 4; ++c) {
    u32x4 w0, w1;
#pragma unroll
    for (int q = 0; q < 4; ++q) { w0[q] = pack_bf16(v[2 * q][c], v[2 * q + 1][c]); w1[q] = pack_bf16(v[8 + 2 * q][c], v[8 + 2 * q + 1][c]); }
    *(u32x4*)(T + (n4 * 4 + c) * 256 + kq * 32) = w0;
    *(u32x4*)(T + (n4 * 4 + c) * 256 + kq * 32 + 16) = w1;
  }
  __syncthreads();
#pragma unroll
  for (int i = 0; i < 8; ++i) {
    const int n = (tid >> 4) + 16 * i, ch = tid & 15;
    *(u32x4*)((char*)(out + (long)n * ldk) + ch * 16) = *(const u32x4*)(T + n * 256 + ch * 16);
  }
}
__device__ __forceinline__ void convert_one(const Params& p, char* smem, int u);
__device__ __forceinline__ void ph_convert_dense(const Params& p, char* smem) {
#if WOUTQ
  convert_one(p, smem, 24576 + blockIdx.x);
#endif
  for (int u = blockIdx.x; u < 912; u += gridDim.x) {
    if (u < 544) { const int kt = u / 34, nt = u % 34; const int nv = NC_ - nt * 128;
      cvt16_tile(p.w_in + (long)(kt * 128) * NC_ + nt * 128, nt * 128, NC_, nv < 0 ? 0 : nv, nullptr, p.wb_in() + (long)(nt * 128) * 2048 + kt * 128, 2048, smem);
    } else if (u < 592) { const int v = u - 544; const int kt = v / 12, nt = v % 12;
      cvt16_tile(p.w_uq + (long)(kt * 128) * 1536 + nt * 128, nt * 128, 1536, 128, p.q_norm + kt * 128, p.wb_uq() + (long)(nt * 128) * 512 + kt * 128, 512, smem);
    } else if (u < 656) { const int v = u - 592; const int kt = v >> 4, nt = v & 15;
      cvt16_tile(p.w_ukv + (long)(kt * 128) * 2048 + nt * 128, nt * 128, 2048, 128, p.kv_norm + kt * 128, p.wb_ukv() + (long)(nt * 128) * 512 + kt * 128, 512, smem);
    } else if (!WOUTQ) { const int v = u - 656; const int kt = v >> 4, nt = v & 15;
      cvt16_tile(p.w_out + (long)(kt * 128) * 2048 + nt * 128, nt * 128, 2048, 128, nullptr, p.wb_out() + (long)(nt * 128) * 2048 + kt * 128, 2048, smem);
    }
  }
}


template <class F>
__device__ __forceinline__ void epi_store_bf16(f32x16 (&acc)[4][4], char* smem, u16* gbase  , int ld, int ncols0, int ncols1, F f) {
  int tz = threadIdx.x; asm volatile("" : "+v"(tz));
  const int lane = tz & 63, wid = tz >> 6, wr = wid >> 1, wc = wid & 1, l31 = lane & 31, hh = lane >> 5;
  __syncthreads();
  char* st = smem + wid * 32768;
#pragma unroll
  for (int mb = 0; mb < 4; ++mb)
#pragma unroll
    for (int reg = 0; reg < 16; ++reg) {
      const int r = mb * 32 + (reg & 3) + 8 * (reg >> 2) + 4 * hh;
      float v[4] = {acc[mb][0][reg], acc[mb][1][reg], acc[mb][2][reg], acc[mb][3][reg]};
      f(wr * 128 + r, wc * 64 + l31, v);
#pragma unroll
      for (int nb = 0; nb < 4; ++nb) *(u16*)(st + r * 256 + (nb * 32 + l31) * 2) = f32_to_bf16(v[nb]);
    }
  const int ch = lane & 15, span = ch >> 3;
  const int gcol = span * 128 + wc * 64 + (ch & 7) * 8;
  const bool ok = ((wc * 64 + (ch & 7) * 8) < (span ? ncols1 : ncols0));
#pragma unroll 8
  for (int it = 0; it < 32; ++it) {
    const int r = it * 4 + (lane >> 4);
    const u32x4 w = *(const u32x4*)(st + r * 256 + ch * 16);
    if (ok) *(u32x4*)(gbase + (long)(wr * 128 + r) * ld + gcol) = w;
  }
}
template <class F>
__device__ __forceinline__ void epi_store_act8(f32x16 (&acc)[4][4], char* smem, u8* gbase  , long row0, int cb0, F f) {
  int tz = threadIdx.x; asm volatile("" : "+v"(tz));
  const int lane = tz & 63, wid = tz >> 6, wr = wid >> 1, wc = wid & 1, l31 = lane & 31, hh = lane >> 5;
  __syncthreads();
  char* st = smem + wid * 32768;
#pragma unroll
  for (int mb = 0; mb < 4; ++mb)
#pragma unroll
    for (int reg = 0; reg < 16; ++reg) {
      const int r = mb * 32 + (reg & 3) + 8 * (reg >> 2) + 4 * hh;
      float v[4] = {acc[mb][0][reg], acc[mb][1][reg], acc[mb][2][reg], acc[mb][3][reg]};
      f(wr * 128 + r, wc * 64 + l31, v);
      const int q = __builtin_amdgcn_cvt_pk_fp8_f32(v[0], v[1], 0, false);
      *(u8*)(st + r * 64 + l31) = (u8)(q & 0xff);
      *(u8*)(st + r * 64 + 32 + l31) = (u8)((q >> 8) & 0xff);
    }
  const int ch = lane & 3;
#pragma unroll 8
  for (int it = 0; it < 8; ++it) {
    const int r = it * 16 + (lane >> 2);
    const u32x4 w = *(const u32x4*)(st + r * 64 + ch * 16);
    const long rg = row0 + wr * 128 + r;
    *(u32x4*)(gbase + (rg >> 1) * 4096 + (long)(cb0 + wc) * 128 + (rg & 1) * 64 + ch * 16) = w;
  }
}
__device__ __forceinline__ void epi_store_f32_resid(f32x16 (&acc)[4][4], char* smem, const float* resid, float* out, int ld, float osc) {
  int tz = threadIdx.x; asm volatile("" : "+v"(tz));
  const int lane = tz & 63, wid = tz >> 6, wr = wid >> 1, wc = wid & 1, l31 = lane & 31, hh = lane >> 5;
  __syncthreads();
  char* st = smem + wid * 32768;
#pragma unroll
  for (int half = 0; half < 2; ++half) {
#pragma unroll
    for (int m2 = 0; m2 < 2; ++m2)
#pragma unroll
      for (int reg = 0; reg < 16; ++reg) {
        const int mb = half * 2 + m2;
        const int r = m2 * 32 + (reg & 3) + 8 * (reg >> 2) + 4 * hh;
#pragma unroll
        for (int nb = 0; nb < 4; ++nb) *(float*)(st + r * 512 + (nb * 32 + l31) * 4) = acc[mb][nb][reg];
      }
    const int ch = lane & 31, span = ch >> 4;
    const int gcol = span * 128 + wc * 64 + (ch & 15) * 4;
#pragma unroll 8
    for (int it = 0; it < 32; ++it) {
      const int r = it * 2 + (lane >> 5);
      const f32x4 a = *(const f32x4*)(st + r * 512 + ch * 16);
      const long o = (long)(wr * 128 + half * 64 + r) * ld + gcol;
      const f32x4 x = *(const f32x4*)(resid + o);
      *(f32x4*)(out + o) = a * osc + x;
    }
  }
}

template <int NBV>
__device__ __forceinline__ void win_tile_r(const Params& p, char* smem, int mt, int nt) {
  f32x16 acc[4][4];
  GemmRTile t{};
  t.A = (const u8*)p.h1(); t.lda = 4096; t.aidx = nullptr; t.m0 = mt * 256; t.mvalid = 256;
  t.B = (const u8*)p.wb_in(); t.brow0 = nt * 256; t.brow1 = nt * 256 + 128; t.ldb = 4096; t.KB = 4096;
  gemmr_tile_256<false, false>(t, smem, acc);
  const int rem = NC_ - nt * 256;
  const int nv0 = rem >= 128 ? 128 : rem, nv1 = rem >= 256 ? 128 : (rem > 128 ? rem - 128 : 0);
  epi_store_bf16(acc, smem, p.proj() + (long)(mt * 256) * NC_ + nt * 256, NC_, nv0, nv1, [&](int, int, float (&)[4]) {});
}
__device__ __forceinline__ void ph_win_r(const Params& p, char* smem) {
  const int x = blockIdx.x & 7, slot = blockIdx.x >> 3;
  for (int j = slot; j < 68; j += 32) win_tile_r<4>(p, smem, 4 * x + (j & 3), j >> 2);
}
__device__ __forceinline__ void upq_tile_r(const Params& p, char* smem, int mt, int nt) {
  f32x16 acc[4][4];
  GemmRTile t{};
  t.A = (const u8*)(p.proj() + C_MQ); t.lda = NC_ * 2; t.aidx = nullptr; t.m0 = mt * 256; t.mvalid = 256;
  t.B = (const u8*)p.wb_uq(); t.brow0 = nt * 256; t.brow1 = nt * 256 + 128; t.ldb = 1024; t.KB = 1024;
  gemmr_tile_256<false, false>(t, smem, acc);
  const float* rq = p.rq() + mt * 256;
  epi_store_bf16(acc, smem, p.q() + (long)(mt * 256) * 1536 + nt * 256, 1536, 128, 128, [&](int rowl, int, float (&v)[4]) {
    const float s = rq[rowl] * QSCALE_;
#pragma unroll
    for (int nb = 0; nb < 4; ++nb) v[nb] *= s;
  });
}
__device__ __forceinline__ void upkv_tile_r(const Params& p, char* smem, int mt, int nt) {
  f32x16 acc[4][4];
  GemmRTile t{};
  t.A = (const u8*)(p.proj() + C_MKV); t.lda = NC_ * 2; t.aidx = nullptr; t.m0 = mt * 256; t.mvalid = 256;
  t.B = (const u8*)p.wb_ukv(); t.brow0 = nt * 256; t.brow1 = nt * 256 + 128; t.ldb = 1024; t.KB = 1024;
  gemmr_tile_256<false, false>(t, smem, acc);
  const float* rk = p.rkv() + mt * 256;
  epi_store_bf16(acc, smem, p.kv() + (long)(mt * 256) * 2048 + nt * 256, 2048, 128, 128, [&](int rowl, int, float (&v)[4]) {
    const float s = rk[rowl];
#pragma unroll
    for (int nb = 0; nb < 4; ++nb) v[nb] *= s;
  });
}
__device__ __forceinline__ void wout_tile_r(const Params& p, char* smem, int mt, int nt) {
  f32x16 acc[4][4];
  GemmRTile t{};
#if WOUTQ
  t.A = p.mixq(); t.lda = 2048; t.aidx = nullptr; t.m0 = mt * 256; t.mvalid = 256;
  t.B = p.wq_out(); t.brow0 = nt * 256; t.brow1 = nt * 256 + 128; t.ldb = 2048; t.KB = 2048;
  gemmrs_tile_256<false>(t, smem, acc);
  const float osc = WISCALE_;
#else
  t.A = (const u8*)p.mix(); t.lda = 4096; t.aidx = nullptr; t.m0 = mt * 256; t.mvalid = 256;
  t.B = (const u8*)p.wb_out(); t.brow0 = nt * 256; t.brow1 = nt * 256 + 128; t.ldb = 4096; t.KB = 4096;
  gemmr_tile_256<false, false>(t, smem, acc);
  const float osc = 1.0f;
#endif
  const long boff = (long)(mt * 256) * 2048 + nt * 256;
  epi_store_f32_resid(acc, smem, p.x + boff, p.x1() + boff, 2048, osc);
}

__device__ __forceinline__ void moe1q_tile(const Params& p, char* smem, const int* mo, int e, int nt, int mt) {
  f32x16 acc[4][4];
  GemmRTile t{};
  const int cnt = p.counts()[e];
  t.A = p.h2q(); t.lda = 2048; t.aidx = p.list() + e * T_ + mt * 256; t.m0 = 0; t.mvalid = min(256, cnt - mt * 256);
  t.B = p.wq_gu(); t.brow0 = (long)e * 4096 + nt * 128; t.brow1 = t.brow0 + 2048; t.ldb = 2048; t.KB = 2048;
#if MOEQ == 3
  gemmrv_tile_256<true>(t, smem, acc);
#elif MOEQ == 2
  gemmrs_tile_256<true>(t, smem, acc);
#else
  gemmr_tile_256<true, true>(t, smem, acc);
#endif
  const float* bg = p.b_gu + e * 4096 + nt * 128; const float* bu = bg + 2048;
  const int tq_ = opaque_tid(); const int cl = (tq_ >> 6 & 1) * 64 + (tq_ & 31);
  const float bgv[2] = {bg[cl], bg[cl + 32]}, buv[2] = {bu[cl], bu[cl + 32]};
  epi_store_act8(acc, smem, p.actq(), (long)(mo[e] * 256 + mt * 256), nt * 2, [&](int, int, float (&v)[4]) {
#pragma unroll
    for (int nb = 0; nb < 2; ++nb) {
      float g = fminf(v[nb] * WISCALE_ + bgv[nb], 7.0f);
      float uu = fminf(fmaxf(v[nb + 2] * WISCALE_ + buv[nb], -7.0f), 7.0f);
      v[nb] = (uu + 1.0f) * (g / (1.0f + __expf(-1.702f * g)));
    }
  });
}
__device__ __forceinline__ void moe2q_tile(const Params& p, char* smem, const int* mo, int e, int nt, int mt) {
  f32x16 acc[4][4];
  GemmRTile t{};
  t.A = p.actq(); t.lda = 2048; t.aidx = nullptr; t.m0 = mo[e] * 256 + mt * 256; t.mvalid = 256;
  t.B = p.wq_dn(); t.brow0 = (long)e * 2048 + nt * 256; t.brow1 = t.brow0 + 128; t.ldb = 2048; t.KB = 2048;
#if MOEQ == 3
  gemmrv_tile_256<false>(t, smem, acc);
#elif MOEQ == 2
  gemmrs_tile_256<false>(t, smem, acc);
#else
  gemmr_tile_256<true, false>(t, smem, acc);
#endif
  const float* bd = p.b_dn + e * 2048 + nt * 256;
  const int tq_ = opaque_tid(); const int cl = (tq_ >> 6 & 1) * 64 + (tq_ & 31);
  const float bdv[4] = {bd[cl], bd[cl + 32], bd[cl + 128], bd[cl + 160]};
  epi_store_bf16(acc, smem, p.ybuf() + (long)t.m0 * 2048 + nt * 256, 2048, 128, 128, [&](int, int, float (&v)[4]) {
#pragma unroll
    for (int nb = 0; nb < 4; ++nb) v[nb] = v[nb] * WISCALE_ + bdv[nb];
  });
}
template <int WHICH>
__device__ __forceinline__ void ph_moeq(const Params& p, char* smem) {
  int* mo = (int*)(smem + G_LDS_BYTES);
#if CVT_SPLIT
  const bool dn_first = ((blockIdx.x >> 3) & 1) != 0;
  if (WHICH == 1 && dn_first) ph_convert_dn(p, smem);
#endif
  moe_setup(p, mo);
  const int NT = (WHICH == 1) ? 16 : 8;
  const int total = mo[NE_] * NT;
#if SKEW
  { const int sl = (blockIdx.x >> 3) % 5; for (int i = 0; i < sl; ++i) __builtin_amdgcn_s_sleep(SKEW); }
#endif
  for (int round = 0;; ++round) {
    const int u = xcd_unit(round);
    if (round * 256 >= total) break;
    if (u >= total) continue;
    int e = 0;
    while (mo[e + 1] * NT <= u) ++e;
    const int local = u - mo[e] * NT, me = mo[e + 1] - mo[e];
    const int nt = local / me, mt = local - nt * me;
    if (WHICH == 1) moe1q_tile(p, smem, mo, e, nt, mt); else moe2q_tile(p, smem, mo, e, nt, mt);
  }
#if CVT_SPLIT
  if (WHICH == 1 && !dn_first) ph_convert_dn(p, smem);
#endif
}
#define LDS_MAX 143360
#ifndef DUP
#define DUP 0
#endif
#ifndef MOEQ
#define MOEQ 1
#endif
#ifndef CVT_SPLIT
#define CVT_SPLIT 1
#endif
#ifndef CVT_STAGGER
#define CVT_STAGGER 1
#endif
#ifndef CVT_IN_P4
#define CVT_IN_P4 1
#endif
#ifndef TSTAMP
#define TSTAMP 0
#endif
#ifndef DENSER
#define DENSER 1
#endif
__global__ void __launch_bounds__(256, 1) mega(Params p) {
  extern __shared__ __attribute__((aligned(16))) char smem[];
  volatile LAS unsigned* xbw = (volatile LAS unsigned*)(smem + LDS_MAX - 16);
  if (threadIdx.x == 0) { xbw[0] = 0u; xbw[1] = 0u; xbw[2] = 0u; xbw[3] = 0u; }
  __syncthreads();
  (void)xcd_barrier_post(p.bar(), xbw);
#if TSTAMP
  unsigned long long ts0 = wall_clock64();
  int bar_no = 0;
#define XBAR() do { XcdBarrier bar_; bar_.bar = p.bar(); bar_.x = xb_xcc_id(); bar_.st = (volatile LAS unsigned*)(smem + LDS_MAX - 16); xcd_barrier(bar_); ++bar_no; if (bar_no == TSTAMP && blockIdx.x == 0 && threadIdx.x == 0) { ((float*)p.counts())[48] = (float)(wall_clock64() - ts0) * (1.0f / 100.0f); } } while (0)
#else
#define XBAR() do { XcdBarrier bar_; bar_.bar = p.bar(); bar_.x = xb_xcc_id(); bar_.st = (volatile LAS unsigned*)(smem + LDS_MAX - 16); xcd_barrier(bar_); } while (0)
#endif
#if DUP == 100
  for (int rep_ = 0; rep_ < 2; ++rep_) {
  if (rep_) XBAR();
#endif
  ph_prep0(p);
#if DUP == 33
  if (blockIdx.x < 192) gla_g1_unit(p, smem, blockIdx.x);
  else for (int i = 0; i < 5; ++i) gla_g1_unit(p, smem, 192 + (blockIdx.x - 192) * 5 + i);
#endif
#if DUP == 30
  ph_prep0(p);
#endif
#if DENSER
  ph_convert_dense(p, smem);
#endif
#if MOEQ >= 1 && CVT_IN_P4 == 0
  ph_convert(p, smem);
#if DUP == 20
  ph_convert(p, smem);
#endif
#endif
  XBAR();
#if DENSER
  ph_win_r(p, smem);
#else
  ph_win(p, smem);
#endif
#if DUP == 1
#if DENSER
  ph_win_r(p, smem);
#else
  ph_win(p, smem);
#endif
#endif
  XBAR();
  ph_prep1(p, smem);
#if DUP == 2
  ph_prep1(p, smem);
#endif
  XBAR();
#if DENSER
  upkv_tile_r(p, smem, blockIdx.x >> 3, blockIdx.x & 7);
  if (blockIdx.x < 192) upq_tile_r(p, smem, blockIdx.x / 6, blockIdx.x % 6);
#else
  upkv_tile(p, smem, blockIdx.x >> 3, blockIdx.x & 7);
  if (blockIdx.x < 192) upq_tile(p, smem, blockIdx.x / 6, blockIdx.x % 6);
#endif
  if (blockIdx.x < 192) gla_g1_unit(p, smem, blockIdx.x);
  else for (int i = 0; i < 4; ++i) gla_g1_unit(p, smem, 192 + (blockIdx.x - 192) * 4 + i);
  if (blockIdx.x < 64) gla_g1_unit(p, smem, 448 + blockIdx.x);
#if DUP == 3
  upkv_tile(p, smem, blockIdx.x >> 3, blockIdx.x & 7);
  if (blockIdx.x < 192) upq_tile(p, smem, blockIdx.x / 6, blockIdx.x % 6);
  if (blockIdx.x < 192) gla_g1_unit(p, smem, blockIdx.x);
  else for (int i = 0; i < 5; ++i) gla_g1_unit(p, smem, 192 + (blockIdx.x - 192) * 5 + i);
#endif
  XBAR();
  gla_g2_unit(p, blockIdx.x);
#if DUP == 31
  gla_g2_unit(p, blockIdx.x);
#endif
  {
    const int bh = blockIdx.x >> 4, qa = blockIdx.x & 15;
#if MOEQ >= 1 && CVT_IN_P4
    const bool cvt_first = CVT_STAGGER ? (((blockIdx.x >> 3) & 1) != 0) : false;
    if (cvt_first) { if (CVT_SPLIT) ph_convert_gu(p, smem, 0, 1); else ph_convert(p, smem); }
#endif
    attn_unit(p, smem, bh >> 3, bh & 7, 31 - qa);
    attn_unit(p, smem, bh >> 3, bh & 7, qa);
#if MOEQ >= 1 && CVT_IN_P4
    if (!cvt_first) { if (CVT_SPLIT) ph_convert_gu(p, smem, 0, 1); else ph_convert(p, smem); }
#endif
#if DUP == 44
    if (cvt_first) ph_convert(p, smem);
    attn_unit(p, smem, bh >> 3, bh & 7, 31 - qa);
    attn_unit(p, smem, bh >> 3, bh & 7, qa);
    if (!cvt_first) ph_convert(p, smem);
#endif
#if DUP == 4
    attn_unit(p, smem, bh >> 3, bh & 7, 31 - qa);
    attn_unit(p, smem, bh >> 3, bh & 7, qa);
#endif
  }
  XBAR();
  for (int u = blockIdx.x; u < 512; u += gridDim.x) gla_g3_unit(p, smem, u);
  mla_norm_tokens(p);
#if DUP == 5
  for (int u = blockIdx.x; u < 512; u += gridDim.x) gla_g3_unit(p, smem, u);
  mla_norm_tokens(p);
#endif
  XBAR();
#if DENSER
  wout_tile_r(p, smem, (blockIdx.x & 7) * 4 + ((blockIdx.x >> 3) & 3), blockIdx.x >> 5);
#else
  wout_tile(p, smem, blockIdx.x >> 3, blockIdx.x & 7);
#endif
#if DUP == 6
  wout_tile(p, smem, blockIdx.x >> 3, blockIdx.x & 7);
#endif
  XBAR();
  ffn_prep_unit(p, smem, blockIdx.x);
#if DUP == 7
  ffn_prep_unit<1>(p, smem, blockIdx.x);
#endif
  XBAR();
#if MOEQ >= 1
  ph_moeq<1>(p, smem);
#if DUP == 8
  ph_moeq<1>(p, smem);
#endif
#else
  ph_moe<1>(p, smem);
#endif
  XBAR();
#if MOEQ >= 1
  ph_moeq<2>(p, smem);
#else
  ph_moe<2>(p, smem);
#endif
#if DUP == 9
  ph_moeq<2>(p, smem);
#endif
#if DUP == 89
  XBAR();
  ph_moeq<1>(p, smem);
  XBAR();
  ph_moeq<2>(p, smem);
#endif
#if DUP == 19
  ph_moe<2, 1>(p, smem);
#endif
  XBAR();
#if DUP == 100
  ph_final(p, smem);
  }
#endif
#if TSTAMP
  {
    const float us = ((const float*)p.counts())[48];
    const float scl = 1.0f + us * (1.0f / 4000.0f);
    ph_final(p, smem, scl);
  }
#else
  ph_final(p, smem);
#endif
#if DUP == 10
  ph_final(p, smem);
#endif
#if DUP == 11
  for (int i = 0; i < 10; ++i) XBAR();
#endif
}

extern "C" void kernel_launch(void* const* d_in, const int* in_sizes, int n_in,
                              void* d_out, int out_size, void* d_ws, size_t ws_size,
                              hipStream_t stream) {
  Params P{};
  P.x = (const float*)d_in[0]; P.pos = (const int*)d_in[1];
  P.attn_norm = (const float*)d_in[2]; P.w_in = (const float*)d_in[3]; P.gate_up = (const float*)d_in[4]; P.gate_bias = (const float*)d_in[5];
  P.gla_out_norm = (const float*)d_in[6]; P.q_norm = (const float*)d_in[7]; P.w_uq = (const float*)d_in[8]; P.kv_norm = (const float*)d_in[9];
  P.w_ukv = (const float*)d_in[10]; P.mla_out_norm = (const float*)d_in[11]; P.w_out = (const float*)d_in[12]; P.ffn_norm = (const float*)d_in[13];
  P.router_w = (const float*)d_in[14]; P.router_b = (const float*)d_in[15]; P.w_gu = (const float*)d_in[16]; P.b_gu = (const float*)d_in[17];
  P.w_dn = (const float*)d_in[18]; P.b_dn = (const float*)d_in[19]; P.final_norm = (const float*)d_in[20];
  P.out = (float*)d_out;

  P.ws = (char*)d_ws;

  hipFuncSetAttribute((const void*)mega, hipFuncAttributeMaxDynamicSharedMemorySize, LDS_MAX);
  hipMemsetAsync(d_ws, 0, XCD_BAR_WORDS * sizeof(unsigned), stream);
  mega<<<256, 256, LDS_MAX, stream>>>(P);
}
```

```cpp
#define DUP 0
#define MOEQ 2
#define TSTAMP 0
#define CVT_SPLIT 1
#define CVT_IN_P4 1
#define BNT 1
#define UORD 0
#define LOOK1 1
#define LOOK2 0
#define WOUTQ 0
#define SKEW 0
#define CVT_STAGGER 1
#include <hip/hip_runtime.h>
#include <hip/hip_bf16.h>
#include <stdint.h>
#include <type_traits>
#define T_      8192
#define SEQ_    4096
#define D_      2048
#define NC_     4176
#define C_GQ    0
#define C_GK    512
#define C_GV    1024
#define C_GR    2048
#define C_GD    3072
#define C_MQ    3088
#define C_MKV   3600
#define C_MKR   4112
#define NE_     32
#define DFF_    2048
#define EPS_    1e-6f
typedef short bf16x8 __attribute__((ext_vector_type(8)));
typedef short s16x4 __attribute__((ext_vector_type(4)));
typedef float f32x16 __attribute__((ext_vector_type(16)));
typedef float f32x4 __attribute__((ext_vector_type(4)));
typedef float f32x2 __attribute__((ext_vector_type(2)));
typedef unsigned short u16;
typedef unsigned u32x4 __attribute__((ext_vector_type(4)));
typedef unsigned u32x2 __attribute__((ext_vector_type(2)));
#define LAS3 __attribute__((address_space(3)))
#define OPAQUE(x) asm volatile("" : "+v"(x))
#define NTHR 256
__device__ __forceinline__ int opaque_tid() { int t = threadIdx.x; asm volatile("" : "+v"(t)); return t; }

__device__ __forceinline__ unsigned pack_bf16(float a, float b) {
  typedef __bf16 bf2 __attribute__((ext_vector_type(2)));
  typedef float f2 __attribute__((ext_vector_type(2)));
  f2 v = {a, b};
  bf2 r = __builtin_convertvector(v, bf2);
  return *(unsigned*)&r;
}
__device__ __forceinline__ float bf_lo(unsigned w) { return __uint_as_float(w << 16); }
__device__ __forceinline__ float bf_hi(unsigned w) { return __uint_as_float(w & 0xffff0000u); }
__device__ __forceinline__ float bf16_to_f32(u16 v) { return __uint_as_float(((unsigned)v) << 16); }
__device__ __forceinline__ u16 f32_to_bf16(float f) { return (u16)(pack_bf16(f, 0.f) & 0xffffu); }
__device__ __forceinline__ float shflx(float v, int k) {
  int t = threadIdx.x; asm volatile("" : "+v"(t));
  return __int_as_float(__builtin_amdgcn_ds_bpermute((((t & 63) ^ k) << 2), __float_as_int(v)));
}
__device__ __forceinline__ float wave_sum(float v) {
#pragma unroll
  for (int o = 32; o > 0; o >>= 1) v += shflx(v, o);
  return v;
}
__device__ __forceinline__ unsigned off_b(unsigned row, unsigned ch) { return 256u * row + 16u * (ch ^ (((row & 3u) << 2) | ((row >> 2) & 3u))); }
__device__ __forceinline__ unsigned tr_addr(unsigned lane, unsigned c, unsigned row0  ) {
  const unsigned blk = (lane >> 4) & 1u, q = (lane & 15u) >> 2, p = lane & 3u;
  return off_b(row0 + q, 4u * c + 2u * blk + (p >> 1)) + 8u * (p & 1u);
}
__device__ __forceinline__ bf16x8 tr_frag(const char* img, unsigned lane, unsigned c, unsigned row_a, unsigned row_b) {
  s16x4 v0 = __builtin_amdgcn_ds_read_tr16_b64_v4i16((LAS3 s16x4*)(img + tr_addr(lane, c, row_a)));
  s16x4 v1 = __builtin_amdgcn_ds_read_tr16_b64_v4i16((LAS3 s16x4*)(img + tr_addr(lane, c, row_b)));
  return (bf16x8){v0[0], v0[1], v0[2], v0[3], v1[0], v1[1], v1[2], v1[3]};
}

__device__ __forceinline__ void glds16_asm(const void* gsrc, unsigned lds_dst) {
  unsigned keep;
  asm volatile("s_mov_b32 %0, m0\n\ts_mov_b32 m0, %2\n\ts_nop 0\n\tglobal_load_lds_dwordx4 %1, off\n\ts_mov_b32 m0, %0" : "=&s"(keep) : "v"(gsrc), "s"(lds_dst) : "memory");
}
__device__ __forceinline__ void glds16_asm_nt(const void* gsrc, unsigned lds_dst) {
  unsigned keep;
  asm volatile("s_mov_b32 %0, m0\n\ts_mov_b32 m0, %2\n\ts_nop 0\n\tglobal_load_lds_dwordx4 %1, off nt\n\ts_mov_b32 m0, %0" : "=&s"(keep) : "v"(gsrc), "s"(lds_dst) : "memory");
}
struct Params {
  const float *x; const int* pos;
  const float *attn_norm, *w_in, *gate_up, *gate_bias, *gla_out_norm, *q_norm, *w_uq, *kv_norm, *w_ukv, *mla_out_norm, *w_out,
              *ffn_norm, *router_w, *router_b, *w_gu, *b_gu, *w_dn, *b_dn, *final_norm;
  float* out;
  char* ws;
  __device__ __forceinline__ unsigned* bar() const { return (unsigned*)(ws + 0ull); }
  __device__ __forceinline__ int* counts() const { return (int*)(ws + 16384ull); }
  __device__ __forceinline__ u16* h1() const { return (u16*)(ws + 16640ull); }
  __device__ __forceinline__ u16* proj() const { return (u16*)(ws + 33571072ull); }
  __device__ __forceinline__ float2* cs() const { return (float2*)(ws + 101990656ull); }
  __device__ __forceinline__ float* rq() const { return (float*)(ws + 104087808ull); }
  __device__ __forceinline__ float* rkv() const { return (float*)(ws + 104120576ull); }
  __device__ __forceinline__ float* bcum() const { return (float*)(ws + 104153344ull); }
  __device__ __forceinline__ u16* q() const { return (u16*)(ws + 120930560ull); }
  __device__ __forceinline__ u16* kv() const { return (u16*)(ws + 146096384ull); }
  __device__ __forceinline__ u16* kpe() const { return (u16*)(ws + 179650816ull); }
  __device__ __forceinline__ u16* kvc() const { return (u16*)(ws + 180699392ull); }
  __device__ __forceinline__ float* dec() const { return (float*)(ws + 214253824ull); }
  __device__ __forceinline__ u16* sprev() const { return (u16*)(ws + 214515968ull); }
  __device__ __forceinline__ u16* mix() const { return (u16*)(ws + 248070400ull); }
  __device__ __forceinline__ u16* omla() const { return (u16*)(ws + 281624832ull); }
  __device__ __forceinline__ float* x1() const { return (float*)(ws + 298402048ull); }
  __device__ __forceinline__ u16* h2() const { return (u16*)(ws + 365510912ull); }
  __device__ __forceinline__ int* list() const { return (int*)(ws + 399065344ull); }
  __device__ __forceinline__ int* asg_e() const { return (int*)(ws + 400113920ull); }
  __device__ __forceinline__ int* asg_slot() const { return (int*)(ws + 400244992ull); }
  __device__ __forceinline__ float* asg_g() const { return (float*)(ws + 400376064ull); }
  __device__ __forceinline__ u16* act() const { return (u16*)(ws + 400507136ull); }
  __device__ __forceinline__ u16* ybuf() const { return (u16*)(ws + 568279296ull); }
  __device__ __forceinline__ unsigned char* wq_gu() const { return (unsigned char*)(ws + 736051456ull); }
  __device__ __forceinline__ unsigned char* wq_dn() const { return (unsigned char*)(ws + 1004486912ull); }
  __device__ __forceinline__ unsigned char* h2q() const { return (unsigned char*)(ws + 1138704640ull); }
  __device__ __forceinline__ unsigned char* actq() const { return (unsigned char*)(ws + 1155481856ull); }
  __device__ __forceinline__ u16* wb_in() const { return (u16*)(ws + 1239367936ull); }
  __device__ __forceinline__ u16* wb_uq() const { return (u16*)(ws + 1257193728ull); }
  __device__ __forceinline__ u16* wb_ukv() const { return (u16*)(ws + 1258766592ull); }
  __device__ __forceinline__ u16* wb_out() const { return (u16*)(ws + 1260863744ull); }
  __device__ __forceinline__ unsigned char* mixq() const { return (unsigned char*)(ws + 1269252352ull); }
  __device__ __forceinline__ unsigned char* wq_out() const { return (unsigned char*)(ws + 1286029568ull); }
};
#define WS_BYTES_USED 1290223872ull

#define XB_TMO      128
#define XB_XCNT(j)  (256  + 64 * (j))
#define XB_XSUB(j)  (1280 + 64 * (j))
#define XB_XGEN(j)  (2304 + 64 * (j))
#define XB_TOP      3328
#define XB_TOPGEN   3392
#define XCD_BAR_WORDS 3456
#define XB_SPIN_CAP (1u << 18)
#define LAS __attribute__((address_space(3)))

__device__ __forceinline__ unsigned xb_ld(unsigned* p)              { return __hip_atomic_load(p, __ATOMIC_RELAXED, __HIP_MEMORY_SCOPE_AGENT); }
__device__ __forceinline__ unsigned xb_add(unsigned* p, unsigned v) { return __hip_atomic_fetch_add(p, v, __ATOMIC_RELAXED, __HIP_MEMORY_SCOPE_AGENT); }
__device__ __forceinline__ unsigned xb_xcc_id() { return (unsigned)__builtin_amdgcn_s_getreg((3 << 11) | 20) & 0xFu; }
#define XB_SPIN(cond, bar) do { unsigned _sp = 0; while (cond) { __builtin_amdgcn_s_sleep(1); \
    if ((++_sp & 255u) == 0u) { if (xb_ld(&(bar)[XB_TMO])) break; if (_sp > XB_SPIN_CAP) { atomicAdd(&(bar)[XB_TMO], 1u); break; } } } } while (0)

struct XcdBarrier {
    unsigned* bar; unsigned x;
    volatile LAS unsigned* st;
};

__device__ __forceinline__ XcdBarrier xcd_barrier_post(unsigned* bar, volatile LAS unsigned* st) {
    XcdBarrier b; b.bar = bar; b.x = xb_xcc_id(); b.st = st;
    if (threadIdx.x == 0) (void)xb_add(&bar[XB_XCNT(b.x)], 1u);
    return b;
}
__device__ __forceinline__ void xcd_barrier_complete(unsigned* bar, unsigned x, unsigned& nloc, unsigned& nx) {
    const unsigned G = gridDim.x * gridDim.y * gridDim.z;
    unsigned sum, cnt, mine, sp = 0u;
    for (;;) {
        sum = 0u; cnt = 0u; mine = 0u;
#pragma unroll
        for (unsigned j = 0; j < 16; ++j) { const unsigned c = xb_ld(&bar[XB_XCNT(j)]); sum += c; cnt += (c > 0u) ? 1u : 0u; mine = (j == x) ? c : mine; }
        if (sum == G) break;
        __builtin_amdgcn_s_sleep(1);
        if ((++sp & 255u) == 0u) { if (xb_ld(&bar[XB_TMO])) break; if (sp > XB_SPIN_CAP) { atomicAdd(&bar[XB_TMO], 1u); break; } }
    }
    nloc = mine > 0u ? mine : 1u; nx = cnt > 0u ? cnt : 1u;
}

__device__ __forceinline__ void xcd_barrier(const XcdBarrier& b) {
    asm volatile("s_waitcnt vmcnt(0)" ::: "memory");
    __syncthreads();
    if (threadIdx.x == 0) {
        unsigned* bar = b.bar;
        __builtin_amdgcn_s_waitcnt(0);
        unsigned nloc = b.st[0], nx = b.st[1];
        if (nloc == 0u) { xcd_barrier_complete(bar, b.x, nloc, nx); b.st[0] = nloc; b.st[1] = nx; }
        const unsigned old = xb_add(&bar[XB_XSUB(b.x)], 1u);
        const unsigned gen = old / nloc;
        if (old + 1u == (gen + 1u) * nloc) {
            __builtin_amdgcn_fence(__ATOMIC_RELEASE, "agent");
            asm volatile("s_waitcnt vmcnt(0)" ::: "memory");
            const unsigned og = xb_add(&bar[XB_TOP], 1u);
            const unsigned tg = og / nx;
            if (og + 1u == (tg + 1u) * nx) xb_add(&bar[XB_TOPGEN], 1u);
            else XB_SPIN(xb_ld(&bar[XB_TOPGEN]) == tg, bar);
            __builtin_amdgcn_fence(__ATOMIC_ACQUIRE, "agent");
            xb_add(&bar[XB_XGEN(b.x)], 1u);
            asm volatile("s_waitcnt vmcnt(0)" ::: "memory");
        } else {
            XB_SPIN(xb_ld(&bar[XB_XGEN(b.x)]) == gen, bar);
            __builtin_amdgcn_fence(__ATOMIC_ACQUIRE, "agent");
            asm volatile("s_waitcnt vmcnt(0)" ::: "memory");
        }
    }
    __syncthreads();
}

#define G_A_OFF(s)  ((s) * 65536)
#define G_B_OFF(s)  ((s) * 65536 + 32768)
#define G_LDS_BYTES 131072

struct GemmTile {
  const u16* A; int lda;
  const int* aidx;
  int m0, mvalid;
  const float* B0; const float* B1;
  int ldb; int nv0, nv1;
  const float* kscale;
  int K;
};

template <int NB, bool KSCALE, bool GATHER>
__device__ __forceinline__ void gemm_tile_256(const GemmTile& t, char* smem, f32x16 (&acc)[4][4]) {
  int tz0 = threadIdx.x; asm volatile("" : "+v"(tz0));
  const int tid = tz0, lane = tid & 63, wid = tid >> 6, wr = wid >> 1, wc = wid & 1;
  const int l31 = lane & 31, hh = lane >> 5;
#pragma unroll
  for (int i = 0; i < 4; ++i)
#pragma unroll
    for (int j = 0; j < 4; ++j)
#pragma unroll
      for (int r = 0; r < 16; ++r) acc[i][j][r] = 0.f;

  const int a_c = (tid & 7) ^ ((tid >> 4) & 7);
  const u16* a_src[GATHER ? 8 : 1];
  if (GATHER) {
#pragma unroll
    for (int i = 0; i < (GATHER ? 8 : 1); ++i) {
      int r = (tid >> 3) + 32 * i;
      int rr = r < t.mvalid ? r : 0;
      a_src[i] = t.A + (long)t.aidx[rr] * t.lda + a_c * 8;
    }
  } else {
    a_src[0] = t.A + (long)(t.m0 + (tid >> 3)) * t.lda + a_c * 8;
  }
  const long a_step = 32L * t.lda;
  const int b_n4 = tid & 63, b_k = tid >> 6;
  const int b_k_u = __builtin_amdgcn_readfirstlane(b_k);
  const int b_img = b_n4 >> 5, b_ch = (b_n4 >> 1) & 15, b_half = b_n4 & 1;
  const bool b_ok = ((b_n4 & 31) * 4) < (b_img ? t.nv1 : t.nv0);
  const int b_loff = (b_ok ? ((b_img ? (int)(t.B1 - t.B0) : 0) + (b_n4 & 31) * 4) : 0) + b_k * t.ldb;
  f32x4 breg[16];

  const unsigned a_lds0 = (unsigned)(size_t)smem + (unsigned)__builtin_amdgcn_readfirstlane(wid) * 1024u;
  auto issue_a = [&](int kt, int s, int i) {
    glds16_asm((const void*)((GATHER ? a_src[GATHER ? i : 0] : a_src[0] + i * a_step) + kt * 64), a_lds0 + G_A_OFF(s) + i * 4096);
  };
  auto issue_b = [&](int kt, int j) {
    const float* ptr = t.B0 + (long)(kt * 64 + 4 * j) * t.ldb + b_loff;
    asm volatile("global_load_dwordx4 %0, %1, off" : "=v"(breg[j]) : "v"(ptr) : "memory");
  };
  auto write_b = [&](int kt, int s, int j) {
    const int k = b_k + 4 * j;
    f32x4 v = breg[j];
    if (KSCALE) { float sc = t.kscale[kt * 64 + b_k_u + 4 * j]; v *= sc; }
    if (!b_ok) v = (f32x4){0.f, 0.f, 0.f, 0.f};
    u32x2 w = {pack_bf16(v[0], v[1]), pack_bf16(v[2], v[3])};
    *(u32x2*)(smem + G_B_OFF(s) + b_img * 16384 + off_b(k, b_ch) + 8 * b_half) = w;
  };
#define WAITQ(N, g) asm volatile("s_waitcnt vmcnt(" #N ")" : "+v"(breg[4 * (g)]), "+v"(breg[4 * (g) + 1]), "+v"(breg[4 * (g) + 2]), "+v"(breg[4 * (g) + 3]) :: "memory")

  unsigned a_rd[4], b_rd[2][2];
#pragma unroll
  for (int ks = 0; ks < 4; ++ks) { const int row = wr * 128 + l31; a_rd[ks] = row * 128 + (((2 * ks + hh) ^ ((row >> 1) & 7)) * 16); }
#pragma unroll
  for (int tt = 0; tt < 2; ++tt)
#pragma unroll
    for (int nl = 0; nl < 2; ++nl) b_rd[tt][nl] = tr_addr(lane, wc * 2 + nl, 8 * hh + 4 * tt);
  auto load_a = [&](const char* As, int ks, bf16x8 (&af)[4]) {
#pragma unroll
    for (int mb = 0; mb < 4; ++mb) af[mb] = *(const bf16x8*)(As + a_rd[ks] + mb * 4096);
  };
  auto load_b1 = [&](const char* Bs, int ks, int nb, bf16x8& bfr) {
    const char* bi = Bs + (nb >> 1) * 16384 + ks * 4096;
    s16x4 v0 = __builtin_amdgcn_ds_read_tr16_b64_v4i16((LAS3 s16x4*)(bi + b_rd[0][nb & 1]));
    s16x4 v1 = __builtin_amdgcn_ds_read_tr16_b64_v4i16((LAS3 s16x4*)(bi + b_rd[1][nb & 1]));
    bfr = (bf16x8){v0[0], v0[1], v0[2], v0[3], v1[0], v1[1], v1[2], v1[3]};
  };

  auto kstep = [&](int kt, auto mode_tag, bool has1, bool has2) {
    constexpr int MODE = decltype(mode_tag)::value;
    const int s = kt & 1;
    const char* As = smem + G_A_OFF(s);
    const char* Bs = smem + G_B_OFF(s);
    bf16x8 a0[4], a1[4], bq[NB];
    load_a(As, 0, a0);
#pragma unroll
    for (int nb = 0; nb < NB; ++nb) load_b1(Bs, 0, nb, bq[nb]);
    __builtin_amdgcn_sched_barrier(0);
#pragma unroll
    for (int g = 0; g < 4; ++g) {
      bf16x8 (&ac)[4] = (g & 1) ? a1 : a0;
      bf16x8 (&an)[4] = (g & 1) ? a0 : a1;
      if (g < 3) load_a(As, g + 1, an);
      __builtin_amdgcn_sched_barrier(0);
#pragma unroll
      for (int nb = 0; nb < NB; ++nb) {
#pragma unroll
        for (int mb = 0; mb < 4; ++mb)
          acc[mb][nb] = __builtin_amdgcn_mfma_f32_32x32x16_bf16(ac[mb], bq[nb], acc[mb][nb], 0, 0, 0);
        __builtin_amdgcn_sched_barrier(0);
        if (g < 3) load_b1(Bs, g + 1, nb, bq[nb]);
        if (nb == 0 && g < 2 && has1) { issue_a(kt + 1, s ^ 1, 4 * g + 0); issue_a(kt + 1, s ^ 1, 4 * g + 1); }
        if (nb == 1 % NB && g < 2 && has1 && NB > 1) { issue_a(kt + 1, s ^ 1, 4 * g + 2); issue_a(kt + 1, s ^ 1, 4 * g + 3); }
        if (NB == 1 && nb == 0 && g < 2 && has1) { issue_a(kt + 1, s ^ 1, 4 * g + 2); issue_a(kt + 1, s ^ 1, 4 * g + 3); }
        if (nb == NB - 1 && has1) {
          if (MODE == 2) { if (g == 0) WAITQ(20, 0); else if (g == 1) WAITQ(20, 1); else if (g == 2) WAITQ(20, 2); else WAITQ(20, 3); }
          else if (MODE == 1) { if (g == 0) WAITQ(16, 0); else if (g == 1) WAITQ(20, 1); else if (g == 2) WAITQ(20, 2); else WAITQ(20, 3); }
          else { if (g == 0) WAITQ(0, 0); else if (g == 1) WAITQ(0, 1); else if (g == 2) WAITQ(0, 2); else WAITQ(0, 3); }
#pragma unroll
          for (int i = 0; i < 4; ++i) write_b(kt + 1, s ^ 1, 4 * g + i);
          if (has2) {
#pragma unroll
            for (int i = 0; i < 4; ++i) issue_b(kt + 2, 4 * g + i);
          }
        }
        __builtin_amdgcn_sched_barrier(0);
      }
    }
    if (has1) {
      if (MODE == 0) asm volatile("s_waitcnt vmcnt(0)" ::: "memory");
      else asm volatile("s_waitcnt vmcnt(12)" ::: "memory");
      __syncthreads();
    }
  };

  const int nk = t.K >> 6;
  __syncthreads();
#pragma unroll
  for (int j = 0; j < 16; ++j) issue_b(0, j);
#pragma unroll
  for (int i = 0; i < 8; ++i) issue_a(0, 0, i);
  WAITQ(8, 0); WAITQ(8, 1); WAITQ(8, 2); WAITQ(8, 3);
#pragma unroll
  for (int j = 0; j < 16; ++j) write_b(0, 0, j);
#pragma unroll
  for (int j = 0; j < 16; ++j) issue_b(1, j);
  asm volatile("s_waitcnt vmcnt(16)" ::: "memory");
  __syncthreads();
  kstep(0, std::integral_constant<int, 1>{}, true, true);
  for (int kt = 1; kt < nk - 2; ++kt) kstep(kt, std::integral_constant<int, 2>{}, true, true);
  kstep(nk - 2, std::integral_constant<int, 0>{}, true, false);
  kstep(nk - 1, std::integral_constant<int, 0>{}, false, false);
#undef WAITQ
}
template <int NB, class F>
__device__ __forceinline__ void acc_foreach_row(f32x16 (&acc)[4][4], F f) {
  int tz = threadIdx.x; asm volatile("" : "+v"(tz));
  const int lane = tz & 63, wid = tz >> 6, wr = wid >> 1, wc = wid & 1;
  const int l31 = lane & 31, hh = lane >> 5;
#pragma unroll
  for (int mb = 0; mb < 4; ++mb)
#pragma unroll
    for (int reg = 0; reg < 16; ++reg) {
      const int rowl = wr * 128 + mb * 32 + (reg & 3) + 8 * (reg >> 2) + 4 * hh;
      float v[NB];
#pragma unroll
      for (int nb = 0; nb < NB; ++nb) v[nb] = acc[mb][nb][reg];
      f(rowl, wc * 64 + l31, v);
      asm volatile("" ::: "memory");
    }
}
__device__ __forceinline__ void ph_prep0(const Params& p) {
  const int tid_ = opaque_tid(); const int lane = tid_ & 63, wid = tid_ >> 6;
  if (blockIdx.x == 0 && tid_ < 64) p.counts()[tid_] = 0;
  for (int t = blockIdx.x * 4 + wid; t < T_; t += gridDim.x * 4) {
    const float* xr = p.x + (long)t * 2048;
    f32x4 v[8]; float ss = 0.f;
#pragma unroll
    for (int j = 0; j < 8; ++j) { v[j] = __builtin_nontemporal_load((const f32x4*)(xr + j * 256 + lane * 4)); ss += v[j][0] * v[j][0] + v[j][1] * v[j][1] + v[j][2] * v[j][2] + v[j][3] * v[j][3]; }
    ss = wave_sum(ss);
    const float r = rsqrtf(ss * (1.0f / 2048.0f) + EPS_);
#pragma unroll
    for (int j = 0; j < 8; ++j) {
      f32x4 g = *(const f32x4*)(p.attn_norm + j * 256 + lane * 4);
      u32x2 w = {pack_bf16(v[j][0] * r * g[0], v[j][1] * r * g[1]), pack_bf16(v[j][2] * r * g[2], v[j][3] * r * g[3])};
      *(u32x2*)(p.h1() + (long)t * 2048 + j * 256 + lane * 4) = w;
    }
    if (lane < 32) {
      float inv = 1.0f / powf(10000.0f, (float)(2 * lane) / 64.0f);
      float ang = (float)p.pos[t] * inv;
      double a = (double)ang;
      double k = rint(a * 0.15915494309189535);
      float rf = (float)fma(-k, 6.283185307179586, a);
      p.cs()[t * 32 + lane] = make_float2(__cosf(rf), __sinf(rf));
    }
  }
}

template <int NB>
__device__ __forceinline__ void win_tile(const Params& p, char* smem, int mt, int nt) {
  f32x16 acc[4][4];
  GemmTile t{};
  t.A = p.h1(); t.lda = 2048; t.aidx = nullptr; t.m0 = mt * 256; t.mvalid = 256;
  t.B0 = p.w_in + nt * 256; t.B1 = t.B0 + 128; t.ldb = NC_;
  const int rem = NC_ - nt * 256;
  t.nv0 = rem >= 128 ? 128 : rem; t.nv1 = rem >= 256 ? 128 : (rem > 128 ? rem - 128 : 0);
  t.kscale = nullptr; t.K = 2048;
  gemm_tile_256<NB, false, false>(t, smem, acc);
  u16* base = p.proj() + (long)(mt * 256) * NC_ + nt * 256;
  const int nv0 = t.nv0, nv1 = t.nv1;
  acc_foreach_row<NB>(acc, [&](int rowl, int coll, float (&v)[NB]) {
    u16* rp = base + (long)rowl * NC_ + coll;
    OPAQUE(rp);
#pragma unroll
    for (int nb = 0; nb < NB; ++nb) {
      const int c = (nb & 1) * 32 + coll;
      const int lim = (nb >> 1) ? nv1 : nv0;
      if (c < lim) rp[(nb >> 1) * 128 + (nb & 1) * 32] = f32_to_bf16(v[nb]);
    }
  });
}
__device__ __forceinline__ void ph_win(const Params& p, char* smem) {
  const int x = blockIdx.x & 7, slot = blockIdx.x >> 3;
  for (int j = slot; j < 64; j += 32) win_tile<4>(p, smem, 4 * x + (j & 3), j >> 2);
  if (slot < 4) win_tile<2>(p, smem, 4 * x + slot, 16);
}

__device__ __forceinline__ void ph_prep1(const Params& p, char* smem) {
  float* gds = (float*)smem;
  float* cums = (float*)(smem + 4096);
  const int tid = opaque_tid(), lane = tid & 63, wid = tid >> 6;
  for (int u = blockIdx.x; u < 512; u += gridDim.x) {
    const int ch = u >> 2, h = u & 3; const int t0 = ch * 64;
    __syncthreads();
    {
      const int tl = tid >> 2, r4 = (tid & 3) * 4;
      u32x2 w = *(const u32x2*)(p.proj() + (long)(t0 + tl) * NC_ + C_GD + r4);
      gds[tl * 16 + r4 + 0] = bf_lo(w[0]); gds[tl * 16 + r4 + 1] = bf_hi(w[0]);
      gds[tl * 16 + r4 + 2] = bf_lo(w[1]); gds[tl * 16 + r4 + 3] = bf_hi(w[1]);
    }
    const int c = tid & 127, half = tid >> 7;
    float gu[16];
#pragma unroll
    for (int r = 0; r < 16; ++r) gu[r] = p.gate_up[r * 512 + h * 128 + c];
    const float bias = p.gate_bias[h * 128 + c];
    __syncthreads();
    float run = 0.f;
    for (int i = 0; i < 32; ++i) {
      const int tl = half * 32 + i;
      float z = bias;
#pragma unroll
      for (int r = 0; r < 16; ++r) z = fmaf(gds[tl * 16 + r], gu[r], z);
      const float ls = fminf(z, 0.f) - log1pf(__expf(-fabsf(z)));
      run += ls * (1.0f / 16.0f);
      cums[tl * 128 + c] = run;
    }
    __syncthreads();
    {
      const float add = cums[31 * 128 + c];
      for (int i = 0; i < 32; ++i) {
        const int tl = half * 32 + i;
        float v = cums[tl * 128 + c] + (half ? add : 0.f);
        p.bcum()[(long)(t0 + tl) * 512 + h * 128 + c] = v;
      }
    }
    for (int i = 0; i < 4; ++i) {
      const long t = t0 + h * 16 + wid * 4 + i;
      const u16* pr = p.proj() + t * NC_;
      u32x4 a = *(const u32x4*)(pr + C_MQ + lane * 8);
      u32x4 b = *(const u32x4*)(pr + C_MKV + lane * 8);
      float sa = 0.f, sb = 0.f;
#pragma unroll
      for (int k = 0; k < 4; ++k) { float l = bf_lo(a[k]), hgh = bf_hi(a[k]); sa += l * l + hgh * hgh; l = bf_lo(b[k]); hgh = bf_hi(b[k]); sb += l * l + hgh * hgh; }
      sa = wave_sum(sa); sb = wave_sum(sb);
      if (lane == 0) { p.rq()[t] = rsqrtf(sa * (1.0f / 512.0f) + EPS_); p.rkv()[t] = rsqrtf(sb * (1.0f / 512.0f) + EPS_); }
      if (lane < 32) {
        const float t1 = bf16_to_f32(pr[C_MKR + lane]), t2 = bf16_to_f32(pr[C_MKR + lane + 32]);
        const float2 cs = p.cs()[t * 32 + lane];
        p.kpe()[t * 64 + lane] = f32_to_bf16(t1 * cs.x - t2 * cs.y);
        p.kpe()[t * 64 + lane + 32] = f32_to_bf16(t1 * cs.y + t2 * cs.x);
      }
    }
  }
}

#define QSCALE_ (0.07216878364870322f * 1.4426950408889634f)
__device__ __forceinline__ void upq_tile(const Params& p, char* smem, int mt, int nt) {
  f32x16 acc[4][4];
  GemmTile t{};
  t.A = p.proj() + C_MQ; t.lda = NC_; t.aidx = nullptr; t.m0 = mt * 256; t.mvalid = 256;
  t.B0 = p.w_uq + nt * 256; t.B1 = t.B0 + 128; t.ldb = 1536; t.nv0 = 128; t.nv1 = 128; t.kscale = p.q_norm; t.K = 512;
  gemm_tile_256<4, true, false>(t, smem, acc);
  u16* base = p.q() + (long)(mt * 256) * 1536 + nt * 256;
  const float* rq = p.rq() + mt * 256;
  acc_foreach_row<4>(acc, [&](int rowl, int coll, float (&v)[4]) {
    u16* rp = base + (long)rowl * 1536 + coll;
    OPAQUE(rp);
    const float s = rq[rowl] * QSCALE_;
#pragma unroll
    for (int nb = 0; nb < 4; ++nb) rp[(nb >> 1) * 128 + (nb & 1) * 32] = f32_to_bf16(v[nb] * s);
  });
}
__device__ __forceinline__ void upkv_tile(const Params& p, char* smem, int mt, int nt) {
  f32x16 acc[4][4];
  GemmTile t{};
  t.A = p.proj() + C_MKV; t.lda = NC_; t.aidx = nullptr; t.m0 = mt * 256; t.mvalid = 256;
  t.B0 = p.w_ukv + nt * 256; t.B1 = t.B0 + 128; t.ldb = 2048; t.nv0 = 128; t.nv1 = 128; t.kscale = p.kv_norm; t.K = 512;
  gemm_tile_256<4, true, false>(t, smem, acc);
  u16* base = p.kv() + (long)(mt * 256) * 2048 + nt * 256;
  const float* rk = p.rkv() + mt * 256;
  acc_foreach_row<4>(acc, [&](int rowl, int coll, float (&v)[4]) {
    u16* rp = base + (long)rowl * 2048 + coll;
    OPAQUE(rp);
    const float s = rk[rowl];
#pragma unroll
    for (int nb = 0; nb < 4; ++nb) rp[(nb >> 1) * 128 + (nb & 1) * 32] = f32_to_bf16(v[nb] * s);
  });
}
#define AT_KSTRIDE 400
#define AT_KBYTES  (64 * AT_KSTRIDE)
#define AT_STAGE   (AT_KBYTES + 16384)
#define AT_LDS_BYTES (2 * AT_STAGE)

__device__ __forceinline__ void attn_unit(const Params& p, char* smem, int b, int h, int qb) {
  const int tid = opaque_tid(), lane = tid & 63, wid = tid >> 6, l31 = lane & 31, hh = lane >> 5;
  const long tq = (long)b * SEQ_ + qb * 128 + wid * 32 + l31;
  bf16x8 qf[12];
  {
    const u16* qp = p.q() + (tq * 8 + h) * 192 + 8 * hh;
#pragma unroll
    for (int ks = 0; ks < 12; ++ks) qf[ks] = *(const bf16x8*)(qp + 16 * ks);
#pragma unroll
    for (int s = 0; s < 2; ++s) {
      const float2* cp = p.cs() + tq * 32 + 16 * s + 8 * hh;
      bf16x8 lo = qf[8 + s], hi = qf[10 + s], nlo, nhi;
#pragma unroll
      for (int j = 0; j < 8; j += 2) {
        float2 c0 = cp[j], c1 = cp[j + 1];
        float a0 = bf16_to_f32((u16)lo[j]), a1 = bf16_to_f32((u16)lo[j + 1]);
        float b0 = bf16_to_f32((u16)hi[j]), b1 = bf16_to_f32((u16)hi[j + 1]);
        unsigned wl = pack_bf16(a0 * c0.x - b0 * c0.y, a1 * c1.x - b1 * c1.y);
        unsigned wh = pack_bf16(a0 * c0.y + b0 * c0.x, a1 * c1.y + b1 * c1.x);
        nlo[j] = (short)(wl & 0xffff); nlo[j + 1] = (short)(wl >> 16);
        nhi[j] = (short)(wh & 0xffff); nhi[j + 1] = (short)(wh >> 16);
      }
      qf[8 + s] = nlo; qf[10 + s] = nhi;
    }
  }
  u32x4 kregA[6], vregA[4], kregB[6], vregB[4];
  const long tk0 = (long)b * SEQ_;
  auto load_tile = [&](int kt, u32x4 (&kreg)[6], u32x4 (&vreg)[4]) {
    const long tb = tk0 + kt * 64;
#pragma unroll
    for (int i = 0; i < 4; ++i) {
      const int pp = i * 256 + tid; const int key = pp >> 4, c = pp & 15;
      const u16* rowp = p.kv() + ((tb + key) * 8 + h) * 256 + c * 8;
      kreg[i] = *(const u32x4*)rowp;
      vreg[i] = *(const u32x4*)(rowp + 128);
    }
#pragma unroll
    for (int i = 0; i < 2; ++i) {
      const int pp = i * 256 + tid; const int key = pp >> 3, c = pp & 7;
      kreg[4 + i] = *(const u32x4*)(p.kpe() + (tb + key) * 64 + c * 8);
    }
  };
  auto store_tile = [&](int s, u32x4 (&kreg)[6], u32x4 (&vreg)[4]) {
    char* Ks = smem + s * AT_STAGE; char* Vs = Ks + AT_KBYTES;
#pragma unroll
    for (int i = 0; i < 4; ++i) {
      const int pp = i * 256 + tid; const int key = pp >> 4, c = pp & 15;
      *(u32x4*)(Ks + key * AT_KSTRIDE + c * 16) = kreg[i];
      *(u32x4*)(Vs + off_b(key, c)) = vreg[i];
    }
#pragma unroll
    for (int i = 0; i < 2; ++i) {
      const int pp = i * 256 + tid; const int key = pp >> 3, c = pp & 7;
      *(u32x4*)(Ks + key * AT_KSTRIDE + (16 + c) * 16) = kreg[4 + i];
    }
  };

  f32x16 o[4];
#pragma unroll
  for (int c = 0; c < 4; ++c)
#pragma unroll
    for (int r = 0; r < 16; ++r) o[c][r] = 0.f;
  float m = -1e30f, l = 0.f;
  const int nt = 2 * qb + 2;
  const int qpos = qb * 128 + wid * 32 + l31;

  __syncthreads();
  load_tile(0, kregA, vregA);
  store_tile(0, kregA, vregA);
  load_tile(1, kregB, vregB);
  if (nt > 2) load_tile(2, kregA, vregA);
  __syncthreads();
  auto tile_body = [&](int kt, int s) {
    const char* Ks = smem + s * AT_STAGE; const char* Vs = Ks + AT_KBYTES;
    const bool active = (kt * 64) <= (qb * 128 + wid * 32 + 31);
    if (active) {
      f32x16 sc[2];
#pragma unroll
      for (int kb = 0; kb < 2; ++kb) {
#pragma unroll
        for (int r = 0; r < 16; ++r) sc[kb][r] = 0.f;
#pragma unroll
        for (int ks = 0; ks < 12; ++ks) {
          bf16x8 a = *(const bf16x8*)(Ks + (kb * 32 + l31) * AT_KSTRIDE + (2 * ks + hh) * 16);
          sc[kb] = __builtin_amdgcn_mfma_f32_32x32x16_bf16(a, qf[ks], sc[kb], 0, 0, 0);
        }
      }
      if (kt >= 2 * qb) {
#pragma unroll
        for (int kb = 0; kb < 2; ++kb)
#pragma unroll
          for (int r = 0; r < 16; ++r) {
            const int key = kt * 64 + kb * 32 + (r & 3) + 8 * (r >> 2) + 4 * hh;
            if (key > qpos) sc[kb][r] = -1e30f;
          }
      }
      float mx = sc[0][0];
#pragma unroll
      for (int kb = 0; kb < 2; ++kb)
#pragma unroll
        for (int r = 0; r < 16; ++r) mx = fmaxf(mx, sc[kb][r]);
      mx = fmaxf(mx, shflx(mx, 32));
      const float mn = fmaxf(m, mx);
      const float alpha = __builtin_amdgcn_exp2f(m - mn);
      m = mn;
      float ps = 0.f;
      bf16x8 pf[4];
#pragma unroll
      for (int kb = 0; kb < 2; ++kb)
#pragma unroll
        for (int s2 = 0; s2 < 2; ++s2) {
          float e[8];
#pragma unroll
          for (int j = 0; j < 8; ++j) { e[j] = __builtin_amdgcn_exp2f(sc[kb][8 * s2 + j] - mn); ps += e[j]; }
          unsigned w0 = pack_bf16(e[0], e[1]), w1 = pack_bf16(e[2], e[3]), w2 = pack_bf16(e[4], e[5]), w3 = pack_bf16(e[6], e[7]);
          u32x4 w = {w0, w1, w2, w3};
          pf[kb * 2 + s2] = *(bf16x8*)&w;
        }
      l = l * alpha + ps;
#pragma unroll
      for (int c = 0; c < 4; ++c)
#pragma unroll
        for (int r = 0; r < 16; ++r) o[c][r] *= alpha;
#pragma unroll
      for (int c = 0; c < 4; ++c)
#pragma unroll
        for (int kk = 0; kk < 4; ++kk) {
          const unsigned rbase = 32 * (kk >> 1) + 16 * (kk & 1) + 4 * hh;
          bf16x8 a = tr_frag(Vs, lane, c, rbase, rbase + 8);
          o[c] = __builtin_amdgcn_mfma_f32_32x32x16_bf16(a, pf[kk], o[c], 0, 0, 0);
        }
    }
  };
  for (int kt = 0; kt < nt; kt += 2) {
    tile_body(kt, 0);
    store_tile(1, kregB, vregB);
    if (kt + 3 < nt) load_tile(kt + 3, kregB, vregB);
    __syncthreads();
    tile_body(kt + 1, 1);
    if (kt + 2 < nt) {
      store_tile(0, kregA, vregA);
      if (kt + 4 < nt) load_tile(kt + 4, kregA, vregA);
      __syncthreads();
    }
  }
  l = l + shflx(l, 32);
  const float inv = 1.0f / l;
  u16* op = p.omla() + tq * 1024 + h * 128 + 4 * hh;
#pragma unroll
  for (int c = 0; c < 4; ++c)
#pragma unroll
    for (int rg = 0; rg < 4; ++rg) {
      u32x2 w = {pack_bf16(o[c][4 * rg] * inv, o[c][4 * rg + 1] * inv), pack_bf16(o[c][4 * rg + 2] * inv, o[c][4 * rg + 3] * inv)};
      *(u32x2*)(op + 32 * c + 8 * rg) = w;
    }
}

#define G1_LDS_BYTES 49152
__device__ __forceinline__ void gla_g1_unit(const Params& p, char* smem, int u) {
  const int tid = opaque_tid(), lane = tid & 63, wid = tid >> 6, l31 = lane & 31, hh = lane >> 5;
  const int bh = u >> 6, n = u & 63, b = bh >> 2, h = bh & 3;
  const long t0 = (long)b * SEQ_ + n * 64;
  char* Ks = smem; char* Vs = smem + 16384;
  __syncthreads();
  {
    const int ch = tid & 15;
    const float* bl = p.bcum() + (t0 + 63) * 512 + h * 128 + ch * 8;
    f32x4 bl0 = *(const f32x4*)bl, bl1 = *(const f32x4*)(bl + 4);
    if (tid < 128) p.dec()[(long)u * 128 + tid] = __expf(p.bcum()[(t0 + 63) * 512 + h * 128 + tid]);
#pragma unroll
    for (int i = 0; i < 4; ++i) {
      const int tok = (i * 256 + tid) >> 4;
      u32x4 kw = *(const u32x4*)(p.proj() + (t0 + tok) * NC_ + C_GK + h * 128 + ch * 8);
      const float* bp = p.bcum() + (t0 + tok) * 512 + h * 128 + ch * 8;
      f32x4 b0 = *(const f32x4*)bp, b1 = *(const f32x4*)(bp + 4);
      u32x4 w;
      w[0] = pack_bf16(bf_lo(kw[0]) * __expf(bl0[0] - b0[0]), bf_hi(kw[0]) * __expf(bl0[1] - b0[1]));
      w[1] = pack_bf16(bf_lo(kw[1]) * __expf(bl0[2] - b0[2]), bf_hi(kw[1]) * __expf(bl0[3] - b0[3]));
      w[2] = pack_bf16(bf_lo(kw[2]) * __expf(bl1[0] - b1[0]), bf_hi(kw[2]) * __expf(bl1[1] - b1[1]));
      w[3] = pack_bf16(bf_lo(kw[3]) * __expf(bl1[2] - b1[2]), bf_hi(kw[3]) * __expf(bl1[3] - b1[3]));
      *(u32x4*)(Ks + off_b(tok, ch)) = w;
    }
#pragma unroll
    for (int i = 0; i < 8; ++i) {
      const int pp = i * 256 + tid; const int tok = pp >> 5, c32 = pp & 31;
      u32x4 vw = *(const u32x4*)(p.proj() + (t0 + tok) * NC_ + C_GV + h * 256 + c32 * 8);
      *(u32x4*)(Vs + (c32 >> 4) * 16384 + off_b(tok, c32 & 15)) = vw;
    }
  }
  __syncthreads();
  f32x16 acc[4][2];
#pragma unroll
  for (int mb = 0; mb < 4; ++mb)
#pragma unroll
    for (int nb = 0; nb < 2; ++nb)
#pragma unroll
      for (int r = 0; r < 16; ++r) acc[mb][nb][r] = 0.f;
  const char* Vimg = Vs + (wid >> 1) * 16384;
#pragma unroll
  for (int ks = 0; ks < 4; ++ks) {
    bf16x8 af[4], bfr[2];
    const unsigned r0 = 16 * ks + 8 * hh;
#pragma unroll
    for (int mb = 0; mb < 4; ++mb) af[mb] = tr_frag(Ks, lane, mb, r0, r0 + 4);
#pragma unroll
    for (int nb = 0; nb < 2; ++nb) bfr[nb] = tr_frag(Vimg, lane, 2 * (wid & 1) + nb, r0, r0 + 4);
#pragma unroll
    for (int mb = 0; mb < 4; ++mb)
#pragma unroll
      for (int nb = 0; nb < 2; ++nb) acc[mb][nb] = __builtin_amdgcn_mfma_f32_32x32x16_bf16(af[mb], bfr[nb], acc[mb][nb], 0, 0, 0);
  }
  __syncthreads();
  {
    char* st = smem + wid * 16384;
#pragma unroll
    for (int mb = 0; mb < 4; ++mb)
#pragma unroll
      for (int r = 0; r < 16; ++r) {
        const int dk = mb * 32 + (r & 3) + 8 * (r >> 2) + 4 * hh;
        *(u16*)(st + dk * 128 + l31 * 2) = f32_to_bf16(acc[mb][0][r]);
        *(u16*)(st + dk * 128 + (32 + l31) * 2) = f32_to_bf16(acc[mb][1][r]);
      }
    u16* gb = p.kvc() + (long)u * 32768 + wid * 64;
#pragma unroll 4
    for (int it = 0; it < 16; ++it) {
      const int dk = it * 8 + (lane >> 3), ch = lane & 7;
      *(u32x4*)(gb + dk * 256 + ch * 8) = *(const u32x4*)(st + dk * 128 + ch * 16);
    }
  }
}

__device__ __forceinline__ void gla_g2_unit(const Params& p, int u) {
  const int tid = opaque_tid();
  const int bh = u >> 5, part = u & 31;
  const int dk = part * 4 + (tid >> 6), dv = (tid & 63) * 4;
  float s0 = 0.f, s1 = 0.f, s2 = 0.f, s3 = 0.f;
  const long ebase = (long)dk * 256 + dv;
#pragma unroll 8
  for (int n = 0; n < 64; ++n) {
    const long un = (long)(bh * 64 + n);
    u32x2 kw = *(const u32x2*)(p.kvc() + un * 32768 + ebase);
    const float d = p.dec()[un * 128 + dk];
    u32x2 w = {pack_bf16(s0, s1), pack_bf16(s2, s3)};
    *(u32x2*)(p.sprev() + un * 32768 + ebase) = w;
    s0 = fmaf(d, s0, bf_lo(kw[0])); s1 = fmaf(d, s1, bf_hi(kw[0]));
    s2 = fmaf(d, s2, bf_lo(kw[1])); s3 = fmaf(d, s3, bf_hi(kw[1]));
  }
}

#define G3_LDS_BYTES (16384 + 16384 + 32768 + 65536 + 1024)
__device__ __forceinline__ void gla_g3_unit(const Params& p, char* smem, int u) {
  const int tid = opaque_tid(), lane = tid & 63, wid = tid >> 6, l31 = lane & 31, hh = lane >> 5;
  const int bh = u >> 6, n = u & 63, b = bh >> 2, h = bh & 3;
  const long t0 = (long)b * SEQ_ + n * 64;
  char* Qd = smem; char* Ki = smem + 16384; char* Vs = smem + 32768; char* Sp = smem + 65536; float* red = (float*)(smem + 131072);
  __syncthreads();
  {
    const int ch = tid & 15;
    const float qs = 0.08838834764831845f;
#pragma unroll
    for (int i = 0; i < 4; ++i) {
      const int tok = (i * 256 + tid) >> 4;
      const u16* pr = p.proj() + (t0 + tok) * NC_ + h * 128 + ch * 8;
      u32x4 qw = *(const u32x4*)(pr + C_GQ), kw = *(const u32x4*)(pr + C_GK);
      const float* bp = p.bcum() + (t0 + tok) * 512 + h * 128 + ch * 8;
      f32x4 b0 = *(const f32x4*)bp, b1 = *(const f32x4*)(bp + 4);
      float e[8] = {__expf(b0[0]), __expf(b0[1]), __expf(b0[2]), __expf(b0[3]), __expf(b1[0]), __expf(b1[1]), __expf(b1[2]), __expf(b1[3])};
      u32x4 wq, wk;
#pragma unroll
      for (int k = 0; k < 4; ++k) {
        wq[k] = pack_bf16(bf_lo(qw[k]) * qs * e[2 * k], bf_hi(qw[k]) * qs * e[2 * k + 1]);
        wk[k] = pack_bf16(bf_lo(kw[k]) / e[2 * k], bf_hi(kw[k]) / e[2 * k + 1]);
      }
      *(u32x4*)(Qd + off_b(tok, ch)) = wq;
      *(u32x4*)(Ki + off_b(tok, ch)) = wk;
    }
#pragma unroll
    for (int i = 0; i < 8; ++i) {
      const int pp = i * 256 + tid; const int tok = pp >> 5, c32 = pp & 31;
      u32x4 vw = *(const u32x4*)(p.proj() + (t0 + tok) * NC_ + C_GV + h * 256 + c32 * 8);
      *(u32x4*)(Vs + (c32 >> 4) * 16384 + off_b(tok, c32 & 15)) = vw;
    }
#pragma unroll
    for (int i = 0; i < 16; ++i) {
      const int pp = i * 256 + tid; const int dk = pp >> 5, c32 = pp & 31;
      u32x4 sw = *(const u32x4*)(p.sprev() + (long)u * 32768 + dk * 256 + c32 * 8);
      *(u32x4*)(Sp + (c32 >> 4) * 32768 + off_b(dk, c32 & 15)) = sw;
    }
  }
  __syncthreads();
  const int ib = wid & 1, dvh = wid >> 1;
  f32x16 sc[2];
#pragma unroll
  for (int jb = 0; jb < 2; ++jb) {
#pragma unroll
    for (int r = 0; r < 16; ++r) sc[jb][r] = 0.f;
    if (jb <= ib) {
#pragma unroll
      for (int ks = 0; ks < 8; ++ks) {
        bf16x8 a = *(const bf16x8*)(Ki + off_b(jb * 32 + l31, 2 * ks + hh));
        bf16x8 bq = *(const bf16x8*)(Qd + off_b(ib * 32 + l31, 2 * ks + hh));
        sc[jb] = __builtin_amdgcn_mfma_f32_32x32x16_bf16(a, bq, sc[jb], 0, 0, 0);
      }
#pragma unroll
      for (int r = 0; r < 16; ++r) {
        const int j = jb * 32 + (r & 3) + 8 * (r >> 2) + 4 * hh, i = ib * 32 + l31;
        if (j > i) sc[jb][r] = 0.f;
      }
    }
  }
  bf16x8 pf[4];
#pragma unroll
  for (int jb = 0; jb < 2; ++jb)
#pragma unroll
    for (int s2 = 0; s2 < 2; ++s2) {
      u32x4 w = {pack_bf16(sc[jb][8 * s2 + 0], sc[jb][8 * s2 + 1]), pack_bf16(sc[jb][8 * s2 + 2], sc[jb][8 * s2 + 3]),
                 pack_bf16(sc[jb][8 * s2 + 4], sc[jb][8 * s2 + 5]), pack_bf16(sc[jb][8 * s2 + 6], sc[jb][8 * s2 + 7])};
      pf[jb * 2 + s2] = *(bf16x8*)&w;
    }
  f32x16 o[4];
#pragma unroll
  for (int c = 0; c < 4; ++c)
#pragma unroll
    for (int r = 0; r < 16; ++r) o[c][r] = 0.f;
  const char* Vimg = Vs + dvh * 16384;
  const char* Simg = Sp + dvh * 32768;
#pragma unroll
  for (int c = 0; c < 4; ++c) {
#pragma unroll
    for (int kk = 0; kk < 4; ++kk) {
      if ((kk >> 1) <= ib) {
        const unsigned rbase = 32 * (kk >> 1) + 16 * (kk & 1) + 4 * hh;
        bf16x8 a = tr_frag(Vimg, lane, c, rbase, rbase + 8);
        o[c] = __builtin_amdgcn_mfma_f32_32x32x16_bf16(a, pf[kk], o[c], 0, 0, 0);
      }
    }
#pragma unroll
    for (int ks = 0; ks < 8; ++ks) {
      const unsigned r0 = 16 * ks + 8 * hh;
      bf16x8 a = tr_frag(Simg, lane, c, r0, r0 + 4);
      bf16x8 bq = *(const bf16x8*)(Qd + off_b(ib * 32 + l31, 2 * ks + hh));
      o[c] = __builtin_amdgcn_mfma_f32_32x32x16_bf16(a, bq, o[c], 0, 0, 0);
    }
  }
  float ss = 0.f;
#pragma unroll
  for (int c = 0; c < 4; ++c)
#pragma unroll
    for (int r = 0; r < 16; ++r) ss += o[c][r] * o[c][r];
  ss += shflx(ss, 32);
  if (hh == 0) red[dvh * 64 + ib * 32 + l31] = ss;
  __syncthreads();
  const float tot = red[ib * 32 + l31] + red[64 + ib * 32 + l31];
  const float rn = rsqrtf(tot * (1.0f / 256.0f) + EPS_);
  const long t = t0 + ib * 32 + l31;
  const u16* grp = p.proj() + t * NC_ + C_GR + h * 256 + dvh * 128 + 4 * hh;
  u16* op = p.mix() + t * 2048 + h * 256 + dvh * 128 + 4 * hh;
  const float* gp = p.gla_out_norm + dvh * 128 + 4 * hh;
#pragma unroll
  for (int c = 0; c < 4; ++c)
#pragma unroll
    for (int rg = 0; rg < 4; ++rg) {
      u32x2 gw = *(const u32x2*)(grp + 32 * c + 8 * rg);
      f32x4 g = *(const f32x4*)(gp + 32 * c + 8 * rg);
      float gr[4] = {bf_lo(gw[0]), bf_hi(gw[0]), bf_lo(gw[1]), bf_hi(gw[1])};
      float ov[4];
#pragma unroll
      for (int k = 0; k < 4; ++k) { float si = gr[k] / (1.0f + __expf(-gr[k])); ov[k] = o[c][4 * rg + k] * rn * g[k] * si; }
#if WOUTQ
      {
        int q8 = 0;
        q8 = __builtin_amdgcn_cvt_pk_fp8_f32(ov[0], ov[1], q8, false);
        q8 = __builtin_amdgcn_cvt_pk_fp8_f32(ov[2], ov[3], q8, true);
        const int col = h * 256 + dvh * 128 + 4 * hh + 32 * c + 8 * rg;
        *(unsigned*)(p.mixq() + (t >> 1) * 4096 + (col >> 6) * 128 + (t & 1) * 64 + (col & 63)) = (unsigned)q8;
      }
#else
      u32x2 w = {pack_bf16(ov[0], ov[1]), pack_bf16(ov[2], ov[3])};
      *(u32x2*)(op + 32 * c + 8 * rg) = w;
#endif
    }
}

__device__ __forceinline__ void mla_norm_tokens(const Params& p) {
  const int tid_ = opaque_tid(); const int lane = tid_ & 63, wid = tid_ >> 6;
  for (int t = blockIdx.x * 4 + wid; t < T_; t += gridDim.x * 4) {
    const u16* src = p.omla() + (long)t * 1024;
    u32x4 a = *(const u32x4*)(src + lane * 8), b = *(const u32x4*)(src + 512 + lane * 8);
    float ss = 0.f;
#pragma unroll
    for (int k = 0; k < 4; ++k) { float x0 = bf_lo(a[k]), x1 = bf_hi(a[k]), y0 = bf_lo(b[k]), y1 = bf_hi(b[k]); ss += x0 * x0 + x1 * x1 + y0 * y0 + y1 * y1; }
    ss = wave_sum(ss);
    const float r = rsqrtf(ss * (1.0f / 1024.0f) + EPS_);
    const float* g = p.mla_out_norm;
    u32x4 wa, wb;
#pragma unroll
    for (int k = 0; k < 4; ++k) {
      wa[k] = pack_bf16(bf_lo(a[k]) * r * g[lane * 8 + 2 * k], bf_hi(a[k]) * r * g[lane * 8 + 2 * k + 1]);
      wb[k] = pack_bf16(bf_lo(b[k]) * r * g[512 + lane * 8 + 2 * k], bf_hi(b[k]) * r * g[512 + lane * 8 + 2 * k + 1]);
    }
#if WOUTQ
    {
      int qa0 = 0, qa1 = 0, qb0 = 0, qb1 = 0;
      qa0 = __builtin_amdgcn_cvt_pk_fp8_f32(bf_lo(wa[0]), bf_hi(wa[0]), qa0, false); qa0 = __builtin_amdgcn_cvt_pk_fp8_f32(bf_lo(wa[1]), bf_hi(wa[1]), qa0, true);
      qa1 = __builtin_amdgcn_cvt_pk_fp8_f32(bf_lo(wa[2]), bf_hi(wa[2]), qa1, false); qa1 = __builtin_amdgcn_cvt_pk_fp8_f32(bf_lo(wa[3]), bf_hi(wa[3]), qa1, true);
      qb0 = __builtin_amdgcn_cvt_pk_fp8_f32(bf_lo(wb[0]), bf_hi(wb[0]), qb0, false); qb0 = __builtin_amdgcn_cvt_pk_fp8_f32(bf_lo(wb[1]), bf_hi(wb[1]), qb0, true);
      qb1 = __builtin_amdgcn_cvt_pk_fp8_f32(bf_lo(wb[2]), bf_hi(wb[2]), qb1, false); qb1 = __builtin_amdgcn_cvt_pk_fp8_f32(bf_lo(wb[3]), bf_hi(wb[3]), qb1, true);
      const int ca = 1024 + lane * 8, cb = 1536 + lane * 8;
      const long tt = t;
      u32x2 va = {(unsigned)qa0, (unsigned)qa1}, vb = {(unsigned)qb0, (unsigned)qb1};
      *(u32x2*)(p.mixq() + (tt >> 1) * 4096 + (ca >> 6) * 128 + (tt & 1) * 64 + (ca & 63)) = va;
      *(u32x2*)(p.mixq() + (tt >> 1) * 4096 + (cb >> 6) * 128 + (tt & 1) * 64 + (cb & 63)) = vb;
    }
#else
    *(u32x4*)(p.mix() + (long)t * 2048 + 1024 + lane * 8) = wa;
    *(u32x4*)(p.mix() + (long)t * 2048 + 1024 + 512 + lane * 8) = wb;
#endif
  }
}
__device__ __forceinline__ void wout_tile(const Params& p, char* smem, int mt, int nt) {
  f32x16 acc[4][4];
  GemmTile t{};
  t.A = p.mix(); t.lda = 2048; t.aidx = nullptr; t.m0 = mt * 256; t.mvalid = 256;
  t.B0 = p.w_out + nt * 256; t.B1 = t.B0 + 128; t.ldb = 2048; t.nv0 = 128; t.nv1 = 128; t.kscale = nullptr; t.K = 2048;
  gemm_tile_256<4, false, false>(t, smem, acc);
  const long boff = (long)(mt * 256) * 2048 + nt * 256;
  acc_foreach_row<4>(acc, [&](int rowl, int coll, float (&v)[4]) {
    long o = boff + (long)rowl * 2048 + coll;
    OPAQUE(o);
    const float* xr = p.x + o; float* yr = p.x1() + o;
#pragma unroll
    for (int nb = 0; nb < 4; ++nb) { const int c = (nb >> 1) * 128 + (nb & 1) * 32; yr[c] = xr[c] + v[nb]; }
  });
}

#define P7_LDS_BYTES (4 * 32 * 33 * 4 + 4 * 64 * 4 + 32 * 33 * 4 + 128)
template <int DRY = 0>
__device__ __forceinline__ void ffn_prep_unit(const Params& p, char* smem, int u) {
  float* part = (float*)smem; float* ssq = part + 4 * 32 * 33; float* lg = ssq + 256; float* rs = lg + 32 * 33;
  const int tid = opaque_tid(), lane = tid & 63, wid = tid >> 6, l31 = lane & 31, hh = lane >> 5;
  __syncthreads();
  {
    const long t = (long)u * 32 + l31;
    const float* xr = p.x1() + t * 2048 + wid * 512;
    const float* gp = p.ffn_norm + wid * 512;
    const float* wp = p.router_w + (long)(wid * 512 + hh) * 32 + l31;
    f32x16 acc;
#pragma unroll
    for (int r = 0; r < 16; ++r) acc[r] = 0.f;
    float ss = 0.f;
#pragma unroll 4
    for (int m = 0; m < 128; ++m) {
      const f32x4 xv = *(const f32x4*)(xr + 4 * m);
      const f32x4 gv = *(const f32x4*)(gp + 4 * m);
      const float a0 = hh ? xv[1] : xv[0], a1 = hh ? xv[3] : xv[2];
      const float g0 = hh ? gv[1] : gv[0], g1 = hh ? gv[3] : gv[2];
      const float b0 = wp[(4 * m) * 32], b1 = wp[(4 * m + 2) * 32];
      ss += a0 * a0 + a1 * a1;
      acc = __builtin_amdgcn_mfma_f32_32x32x2f32(a0 * g0, b0, acc, 0, 0, 0);
      acc = __builtin_amdgcn_mfma_f32_32x32x2f32(a1 * g1, b1, acc, 0, 0, 0);
    }
#pragma unroll
    for (int r = 0; r < 16; ++r) part[(wid * 32 + (r & 3) + 8 * (r >> 2) + 4 * hh) * 33 + l31] = acc[r];
    ssq[wid * 64 + lane] = ss;
  }
  __syncthreads();
  {
    const int tl = tid >> 3, seg = tid & 7;
    if (seg == 0) {
      float s = 0.f;
#pragma unroll
      for (int w = 0; w < 4; ++w) s += ssq[w * 64 + tl] + ssq[w * 64 + 32 + tl];
      rs[tl] = rsqrtf(s * (1.0f / 2048.0f) + EPS_);
    }
  }
  __syncthreads();
  {
    const int tl = tid >> 3, seg = tid & 7;
    const float r = rs[tl];
#pragma unroll
    for (int c = 0; c < 4; ++c) {
      const int e = seg * 4 + c;
      const float s = part[(0 * 32 + tl) * 33 + e] + part[(1 * 32 + tl) * 33 + e] + part[(2 * 32 + tl) * 33 + e] + part[(3 * 32 + tl) * 33 + e];
      lg[tl * 33 + e] = s * r + p.router_b[e];
    }
  }
  __syncthreads();
  if (tid < 32 && !DRY) {
    const long tt = (long)u * 32 + tid;
    const float* L = lg + tid * 33;
    unsigned used = 0u; int i0 = 0, i1 = 0, i2 = 0, i3 = 0; float v0 = 0.f, v1 = 0.f, v2 = 0.f, v3 = 0.f;
#pragma unroll
    for (int k = 0; k < 4; ++k) {
      int bi = -1; float bv = 0.f;
      for (int i = 0; i < 32; ++i) {
        const float x = L[i];
        const bool take = !((used >> i) & 1u) && (bi < 0 || x > bv);
        bi = take ? i : bi; bv = take ? x : bv;
      }
      used |= 1u << bi;
      if (k == 0) { i0 = bi; v0 = bv; } else if (k == 1) { i1 = bi; v1 = bv; } else if (k == 2) { i2 = bi; v2 = bv; } else { i3 = bi; v3 = bv; }
    }
    const float e0 = 1.0f, e1 = __expf(v1 - v0), e2 = __expf(v2 - v0), e3 = __expf(v3 - v0);
    const float inv = 1.0f / (e0 + e1 + e2 + e3);
    const int s0 = atomicAdd(&p.counts()[i0], 1), s1 = atomicAdd(&p.counts()[i1], 1), s2 = atomicAdd(&p.counts()[i2], 1), s3 = atomicAdd(&p.counts()[i3], 1);
    p.list()[i0 * T_ + s0] = (int)tt; p.list()[i1 * T_ + s1] = (int)tt; p.list()[i2 * T_ + s2] = (int)tt; p.list()[i3 * T_ + s3] = (int)tt;
    p.asg_e()[tt * 4 + 0] = i0; p.asg_e()[tt * 4 + 1] = i1; p.asg_e()[tt * 4 + 2] = i2; p.asg_e()[tt * 4 + 3] = i3;
    p.asg_slot()[tt * 4 + 0] = s0; p.asg_slot()[tt * 4 + 1] = s1; p.asg_slot()[tt * 4 + 2] = s2; p.asg_slot()[tt * 4 + 3] = s3;
    p.asg_g()[tt * 4 + 0] = e0 * inv; p.asg_g()[tt * 4 + 1] = e1 * inv; p.asg_g()[tt * 4 + 2] = e2 * inv; p.asg_g()[tt * 4 + 3] = e3 * inv;
  }
  {
    const int tl = tid >> 3, seg = tid & 7;
    const long t = (long)u * 32 + tl;
    const float* xr = p.x1() + t * 2048;
    const float rr = rs[tl];
#pragma unroll 8
    for (int it = 0; it < 32; ++it) {
      const int kk = it * 64 + seg * 8;
      f32x4 v0 = *(const f32x4*)(xr + kk), v1 = *(const f32x4*)(xr + kk + 4);
      f32x4 g0 = *(const f32x4*)(p.ffn_norm + kk), g1 = *(const f32x4*)(p.ffn_norm + kk + 4);
      v0 = v0 * g0 * rr; v1 = v1 * g1 * rr;
#if MOEQ == 0
      u32x4 w = {pack_bf16(v0[0], v0[1]), pack_bf16(v0[2], v0[3]), pack_bf16(v1[0], v1[1]), pack_bf16(v1[2], v1[3])};
      *(u32x4*)(p.h2() + t * 2048 + kk) = w;
#else
      int q0 = 0, q1 = 0;
      q0 = __builtin_amdgcn_cvt_pk_fp8_f32(v0[0], v0[1], q0, false);
      q0 = __builtin_amdgcn_cvt_pk_fp8_f32(v0[2], v0[3], q0, true);
      q1 = __builtin_amdgcn_cvt_pk_fp8_f32(v1[0], v1[1], q1, false);
      q1 = __builtin_amdgcn_cvt_pk_fp8_f32(v1[2], v1[3], q1, true);
      u32x2 wq = {(unsigned)q0, (unsigned)q1};
      *(u32x2*)(p.h2q() + t * 2048 + kk) = wq;
#endif
    }
  }
}

__device__ __forceinline__ void moe_setup(const Params& p, int* mo) {
  __syncthreads();
  if (threadIdx.x == 0) {
    int s = 0;
    for (int e = 0; e < NE_; ++e) { mo[e] = s; s += (p.counts()[e] + 255) >> 8; }
    mo[NE_] = s;
  }
  __syncthreads();
}
#ifndef MAPV
#define MAPV 0
#endif
__device__ __forceinline__ int xcd_unit(int round) { return MAPV ? (round * 256 + blockIdx.x) : (round * 256 + (blockIdx.x & 7) * 32 + (blockIdx.x >> 3)); }

__device__ __forceinline__ void moe1_tile(const Params& p, char* smem, const int* mo, int e, int nt, int mt) {
  f32x16 acc[4][4];
  GemmTile t{};
  const int cnt = p.counts()[e];
  t.A = p.h2(); t.lda = 2048; t.aidx = p.list() + e * T_ + mt * 256; t.m0 = 0; t.mvalid = min(256, cnt - mt * 256);
  t.B0 = p.w_gu + (long)e * 2048 * 4096 + nt * 128; t.B1 = t.B0 + 2048; t.ldb = 4096; t.nv0 = 128; t.nv1 = 128; t.kscale = nullptr; t.K = 2048;
  gemm_tile_256<4, false, true>(t, smem, acc);
  u16* base = p.act() + (long)(mo[e] * 256 + mt * 256) * 2048 + nt * 128;
  const float* bg = p.b_gu + e * 4096 + nt * 128; const float* bu = bg + 2048;
  const int tq_ = opaque_tid(); const int cl = (tq_ >> 6 & 1) * 64 + (tq_ & 31);
  const float bgv[2] = {bg[cl], bg[cl + 32]}, buv[2] = {bu[cl], bu[cl + 32]};
  acc_foreach_row<4>(acc, [&](int rowl, int coll, float (&v)[4]) {
    u16* rp = base + (long)rowl * 2048 + coll;
    OPAQUE(rp);
#pragma unroll
    for (int nb = 0; nb < 2; ++nb) {
      const int c = nb * 32;
      float g = fminf(v[nb] + bgv[nb], 7.0f);
      float uu = fminf(fmaxf(v[nb + 2] + buv[nb], -7.0f), 7.0f);
      float a = (uu + 1.0f) * (g / (1.0f + __expf(-1.702f * g)));
      rp[c] = f32_to_bf16(a);
    }
  });
}
__device__ __forceinline__ void moe2_tile(const Params& p, char* smem, const int* mo, int e, int nt, int mt) {
  f32x16 acc[4][4];
  GemmTile t{};
  t.A = p.act(); t.lda = 2048; t.aidx = nullptr; t.m0 = mo[e] * 256 + mt * 256; t.mvalid = 256;
  t.B0 = p.w_dn + (long)e * 2048 * 2048 + nt * 256; t.B1 = t.B0 + 128; t.ldb = 2048; t.nv0 = 128; t.nv1 = 128; t.kscale = nullptr; t.K = 2048;
  gemm_tile_256<4, false, false>(t, smem, acc);
  u16* base = p.ybuf() + (long)t.m0 * 2048 + nt * 256;
  const float* bd = p.b_dn + e * 2048 + nt * 256;
  const int tq_ = opaque_tid(); const int cl = (tq_ >> 6 & 1) * 64 + (tq_ & 31);
  const float bdv[4] = {bd[cl], bd[cl + 32], bd[cl + 128], bd[cl + 160]};
  acc_foreach_row<4>(acc, [&](int rowl, int coll, float (&v)[4]) {
    u16* rp = base + (long)rowl * 2048 + coll;
    OPAQUE(rp);
#pragma unroll
    for (int nb = 0; nb < 4; ++nb) { const int c = (nb >> 1) * 128 + (nb & 1) * 32; rp[c] = f32_to_bf16(v[nb] + bdv[nb]); }
  });
}
template <int WHICH, int HALF = 0>
__device__ __forceinline__ void ph_moe(const Params& p, char* smem) {
  int* mo = (int*)(smem + G_LDS_BYTES);
  moe_setup(p, mo);
  const int NT = (WHICH == 1) ? 16 : 8;
  const int total = mo[NE_] * NT;
  if (HALF && ((blockIdx.x >> 3) & 1)) return;
  const int W = HALF ? 128 : 256;
  for (int round = 0;; ++round) {
    const int u = HALF ? (round * 128 + (blockIdx.x & 7) * 16 + (blockIdx.x >> 4)) : xcd_unit(round);
    if (round * W >= total) break;
    if (u >= total) continue;
    int e = 0;
    while (mo[e + 1] * NT <= u) ++e;
    const int local = u - mo[e] * NT, me = mo[e + 1] - mo[e];
    const int nt = local / me, mt = local - nt * me;
    if (WHICH == 1) moe1_tile(p, smem, mo, e, nt, mt); else moe2_tile(p, smem, mo, e, nt, mt);
  }
}

__device__ __forceinline__ void ph_final(const Params& p, char* smem, float dbg_scale = 1.0f) {
  int* mo = (int*)(smem + G_LDS_BYTES);
  moe_setup(p, mo);
  const int tid_ = opaque_tid(); const int lane = tid_ & 63, wid = tid_ >> 6;
  for (int t = blockIdx.x * 4 + wid; t < T_; t += gridDim.x * 4) {
    long rows[4]; float gg[4];
#pragma unroll
    for (int k = 0; k < 4; ++k) { rows[k] = (long)(mo[p.asg_e()[t * 4 + k]] * 256 + p.asg_slot()[t * 4 + k]) * 2048; gg[k] = p.asg_g()[t * 4 + k]; }
    f32x4 v[8]; float ss = 0.f;
#pragma unroll
    for (int j = 0; j < 8; ++j) {
      const int c = j * 256 + lane * 4;
      f32x4 a = *(const f32x4*)(p.x1() + (long)t * 2048 + c);
#pragma unroll
      for (int k = 0; k < 4; ++k) {
        u32x2 w = *(const u32x2*)(p.ybuf() + rows[k] + c);
        a[0] += gg[k] * bf_lo(w[0]); a[1] += gg[k] * bf_hi(w[0]); a[2] += gg[k] * bf_lo(w[1]); a[3] += gg[k] * bf_hi(w[1]);
      }
      v[j] = a; ss += a[0] * a[0] + a[1] * a[1] + a[2] * a[2] + a[3] * a[3];
    }
    ss = wave_sum(ss);
    const float r = rsqrtf(ss * (1.0f / 2048.0f) + EPS_);
#pragma unroll
    for (int j = 0; j < 8; ++j) {
      const int c = j * 256 + lane * 4;
      f32x4 g = *(const f32x4*)(p.final_norm + c);
      f32x4 o = {v[j][0] * r * g[0] * dbg_scale, v[j][1] * r * g[1] * dbg_scale, v[j][2] * r * g[2] * dbg_scale, v[j][3] * r * g[3] * dbg_scale};
      __builtin_nontemporal_store(o, (f32x4*)(p.out + (long)t * 2048 + c));
    }
  }
}
#define WSCALE_  128.0f
#define WISCALE_ 0.0078125f
typedef unsigned char u8;

struct CvtUnit { const float* src; u8* dst; int ldn; };
__device__ __forceinline__ CvtUnit cvt8_decode(const Params& p, int u) {
  CvtUnit c;
  if (u < 16384) {
    const int e = u >> 9, kb = (u >> 4) & 31, nt = u & 15;
    c.src = p.w_gu + (long)e * 2048 * 4096 + (long)(kb * 64) * 4096 + nt * 256; c.ldn = 4096;
    c.dst = p.wq_gu() + ((long)e * 4096 + nt * 256) * 2048 + kb * 128;
  } else {
    const int v = u - 16384; const int e = v >> 8, kb = (v >> 3) & 31, nt = v & 7;
    c.src = p.w_dn + (long)e * 2048 * 2048 + (long)(kb * 64) * 2048 + nt * 256; c.ldn = 2048;
    c.dst = p.wq_dn() + ((long)e * 2048 + nt * 256) * 2048 + kb * 128;
  }
  return c;
}
__device__ __forceinline__ void cvt8_load(const CvtUnit& c, int w, int lane, f32x4 (&v)[16]) {
  const float* src = c.src + (long)(w * 16) * c.ldn + lane * 4;
#pragma unroll
  for (int j = 0; j < 16; ++j) {
    const float* ptr = src + (long)j * c.ldn;
    asm volatile("global_load_dwordx4 %0, %1, off nt" : "=v"(v[j]) : "v"(ptr) : "memory");
  }
}
#define CVT_WAIT(N, v) asm volatile("s_waitcnt vmcnt(%16)" : "+v"(v[0]), "+v"(v[1]), "+v"(v[2]), "+v"(v[3]), "+v"(v[4]), "+v"(v[5]), "+v"(v[6]), "+v"(v[7]), \
    "+v"(v[8]), "+v"(v[9]), "+v"(v[10]), "+v"(v[11]), "+v"(v[12]), "+v"(v[13]), "+v"(v[14]), "+v"(v[15]) : "n"(N) : "memory")
__device__ __forceinline__ void cvt8_emit(const CvtUnit& c, int tid, int w, int lane, f32x4 (&v)[16], char* T) {
  __syncthreads();
#pragma unroll
  for (int cc = 0; cc < 4; ++cc) {
    u32x4 x4;
#pragma unroll
    for (int q = 0; q < 4; ++q) {
      int x = 0;
      x = __builtin_amdgcn_cvt_pk_fp8_f32(v[4 * q][cc] * WSCALE_, v[4 * q + 1][cc] * WSCALE_, x, false);
      x = __builtin_amdgcn_cvt_pk_fp8_f32(v[4 * q + 2][cc] * WSCALE_, v[4 * q + 3][cc] * WSCALE_, x, true);
      x4[q] = (unsigned)x;
    }
    *(u32x4*)(T + (lane * 4 + cc) * 64 + w * 16) = x4;
  }
  __syncthreads();
#pragma unroll
  for (int i = 0; i < 4; ++i) {
    const int n = (tid >> 2) + 64 * i, ch = tid & 3;
    __builtin_nontemporal_store(*(const u32x4*)(T + n * 64 + ch * 16), (u32x4*)(c.dst + (long)(n >> 1) * 4096 + (n & 1) * 64 + ch * 16));
  }
}
__device__ __forceinline__ void convert_units(const Params& p, char* smem, int first, int stride, int count) {
  const int tid = opaque_tid();
  const int w = tid >> 6, lane = tid & 63;
  if (count <= 0) return;
  f32x4 va[16], vb[16], vc[16];
  CvtUnit ca = cvt8_decode(p, first), cb = cvt8_decode(p, first + stride), cc = cvt8_decode(p, first + 2 * stride);
  cvt8_load(ca, w, lane, va);
  cvt8_load(cb, w, lane, vb);
  cvt8_load(cc, w, lane, vc);
  CVT_WAIT(32, va); cvt8_emit(ca, tid, w, lane, va, smem); ca = cvt8_decode(p, first + 3 * stride); cvt8_load(ca, w, lane, va);
  CVT_WAIT(36, vb); cvt8_emit(cb, tid, w, lane, vb, smem); cb = cvt8_decode(p, first + 4 * stride); cvt8_load(cb, w, lane, vb);
  CVT_WAIT(40, vc); cvt8_emit(cc, tid, w, lane, vc, smem); cc = cvt8_decode(p, first + 5 * stride); cvt8_load(cc, w, lane, vc);
  for (int i = 3; i + 3 < count; i += 3) {
    CVT_WAIT(40, va); cvt8_emit(ca, tid, w, lane, va, smem); ca = cvt8_decode(p, first + (i + 3) * stride); cvt8_load(ca, w, lane, va);
    CVT_WAIT(40, vb); cvt8_emit(cb, tid, w, lane, vb, smem); cb = cvt8_decode(p, first + (i + 4) * stride); cvt8_load(cb, w, lane, vb);
    CVT_WAIT(40, vc); cvt8_emit(cc, tid, w, lane, vc, smem); cc = cvt8_decode(p, first + (i + 5) * stride); cvt8_load(cc, w, lane, vc);
  }
  CVT_WAIT(0, va); cvt8_emit(ca, tid, w, lane, va, smem);
  CVT_WAIT(0, vb); cvt8_emit(cb, tid, w, lane, vb, smem);
  CVT_WAIT(0, vc); cvt8_emit(cc, tid, w, lane, vc, smem);
}
__device__ __forceinline__ void convert_one(const Params& p, char* smem, int u) {
  const int tid = opaque_tid();
  const int w = tid >> 6, lane = tid & 63;
  f32x4 va[16];
  CvtUnit ca = cvt8_decode(p, u);
  cvt8_load(ca, w, lane, va);
  CVT_WAIT(0, va); cvt8_emit(ca, tid, w, lane, va, smem);
}
__device__ __forceinline__ void ph_convert(const Params& p, char* smem) {
  convert_units(p, smem, blockIdx.x, gridDim.x, 24576 / 256);
}
__device__ __forceinline__ void ph_convert_gu(const Params& p, char* smem, int part, int nparts) {
  (void)part; (void)nparts;
  convert_units(p, smem, blockIdx.x, 256, 63);
  convert_one(p, smem, blockIdx.x + 63 * 256);
}
__device__ __forceinline__ void ph_convert_dn(const Params& p, char* smem) {
  convert_units(p, smem, 16384 + blockIdx.x, 256, 30);
  convert_one(p, smem, 16384 + blockIdx.x + 30 * 256);
  convert_one(p, smem, 16384 + blockIdx.x + 31 * 256);
}

#define R_STAGE 32768
struct GemmRTile {
  const u8* A; int lda; const int* aidx; int m0, mvalid;
  const u8* B; long brow0, brow1; int ldb;
  int pairb;
  int paira;
  int KB;
};
template <bool FP8, bool GATHER>
__device__ __forceinline__ void gemmr_tile_256(const GemmRTile& t, char* smem, f32x16 (&acc)[4][4]) {
  int tz0 = threadIdx.x; asm volatile("" : "+v"(tz0));
  const int tid = tz0, lane = tid & 63, wid = tid >> 6, wr = wid >> 1, wc = wid & 1;
  const int l31 = lane & 31, hh = lane >> 5;
#pragma unroll
  for (int i = 0; i < 4; ++i)
#pragma unroll
    for (int j = 0; j < 4; ++j)
#pragma unroll
      for (int r = 0; r < 16; ++r) acc[i][j][r] = 0.f;
  const int c_src = (tid & 3) ^ ((tid >> 4) & 3);
  const u8* a_src[GATHER ? 4 : 1];
  if (GATHER) {
#pragma unroll
    for (int i = 0; i < (GATHER ? 4 : 1); ++i) {
      int r = (tid >> 2) + 64 * i;
      int rr = r < t.mvalid ? r : 0;
      a_src[i] = t.A + (long)t.aidx[rr] * t.lda + c_src * 16;
    }
  } else {
    a_src[0] = t.A + (long)(t.m0 + (tid >> 2)) * t.lda + c_src * 16;
  }
  const long a_step = 64L * t.lda, b_step = 64L * t.ldb;
  const u8* b_src0 = t.B + (t.brow0 + (tid >> 2)) * t.ldb + c_src * 16;
  const u8* b_src1 = t.B + (t.brow1 + (tid >> 2)) * t.ldb + c_src * 16;
  const unsigned lds0 = (unsigned)(size_t)smem + (unsigned)__builtin_amdgcn_readfirstlane(wid) * 1024u;
  auto issue = [&](int kt, int sl, int q) {
    if (q < 4) glds16_asm((const void*)((GATHER ? a_src[GATHER ? q : 0] : a_src[0] + q * a_step) + kt * 64), lds0 + sl * R_STAGE + q * 4096);
    else { const int i = q - 4; glds16_asm((const void*)((i < 2 ? b_src0 + i * b_step : b_src1 + (i - 2) * b_step) + kt * 64), lds0 + sl * R_STAGE + 16384 + i * 4096); }
  };
  unsigned a_rd[2], b_rd[2];
#pragma unroll
  for (int s2 = 0; s2 < 2; ++s2) {
    const int ra = wr * 128 + l31, rb = wc * 64 + l31;
    a_rd[s2] = ra * 64 + (((2 * s2 + hh) ^ ((ra >> 2) & 3)) * 16);
    b_rd[s2] = rb * 64 + (((2 * s2 + hh) ^ ((rb >> 2) & 3)) * 16);
  }
  auto load_frags = [&](const char* St, int s2, u32x4 (&af)[4], u32x4 (&bf)[4]) {
#pragma unroll
    for (int mb = 0; mb < 4; ++mb) af[mb] = *(const u32x4*)(St + a_rd[s2] + mb * 2048);
#pragma unroll
    for (int nb = 0; nb < 4; ++nb) bf[nb] = *(const u32x4*)(St + 16384 + b_rd[s2] + (nb >> 1) * 8192 + (nb & 1) * 2048);
  };
  auto mma = [&](u32x4 (&ac)[4], u32x4 (&bc)[4], int nb) {
    if (FP8) {
#pragma unroll
      for (int u = 0; u < 2; ++u) {
        const long bl = (long)(((unsigned long long)bc[nb][2 * u + 1] << 32) | bc[nb][2 * u]);
#pragma unroll
        for (int mb = 0; mb < 4; ++mb) {
          const long al = (long)(((unsigned long long)ac[mb][2 * u + 1] << 32) | ac[mb][2 * u]);
          acc[mb][nb] = __builtin_amdgcn_mfma_f32_32x32x16_fp8_fp8(al, bl, acc[mb][nb], 0, 0, 0);
        }
      }
    } else {
      const bf16x8 bb = *(const bf16x8*)&bc[nb];
#pragma unroll
      for (int mb = 0; mb < 4; ++mb) acc[mb][nb] = __builtin_amdgcn_mfma_f32_32x32x16_bf16(*(const bf16x8*)&ac[mb], bb, acc[mb][nb], 0, 0, 0);
    }
  };
  u32x4 a0[4], b0[4], a1[4], b1[4];
  auto half0 = [&](int kt, bool issueA) {
    const char* St = smem + (kt & 3) * R_STAGE;
    load_frags(St, 1, a1, b1);
    __builtin_amdgcn_sched_barrier(0);
#pragma unroll
    for (int nb = 0; nb < 4; ++nb) {
      mma(a0, b0, nb);
      __builtin_amdgcn_sched_barrier(0);
      if (issueA) issue(kt + 2, (kt + 2) & 3, 4 + nb);
      __builtin_amdgcn_sched_barrier(0);
    }
  };
  auto half1 = [&](int kt, bool has1, bool issueB) {
    const char* Sn = smem + ((kt + 1) & 3) * R_STAGE;
    if (has1) load_frags(Sn, 0, a0, b0);
    __builtin_amdgcn_sched_barrier(0);
#pragma unroll
    for (int nb = 0; nb < 4; ++nb) {
      mma(a1, b1, nb);
      __builtin_amdgcn_sched_barrier(0);
      if (issueB) issue(kt + 3, (kt + 3) & 3, nb);
      __builtin_amdgcn_sched_barrier(0);
    }
  };
  const int nk = t.KB >> 6;
  __syncthreads();
#pragma unroll
  for (int q = 0; q < 8; ++q) issue(0, 0, q);
#pragma unroll
  for (int q = 0; q < 8; ++q) issue(1, 1, q);
#pragma unroll
  for (int q = 0; q < 4; ++q) issue(2, 2, q);
  asm volatile("s_waitcnt vmcnt(12)" ::: "memory");
  __syncthreads();
  load_frags(smem, 0, a0, b0);
  for (int kt = 0; kt < nk - 3; ++kt) {
    half0(kt, true);
    asm volatile("s_waitcnt vmcnt(8)" ::: "memory");
    __syncthreads();
    half1(kt, true, true);
  }
  half0(nk - 3, true);
  asm volatile("s_waitcnt vmcnt(8)" ::: "memory");
  __syncthreads();
  half1(nk - 3, true, false);
  half0(nk - 2, false);
  asm volatile("s_waitcnt vmcnt(0)" ::: "memory");
  __syncthreads();
  half1(nk - 2, true, false);
  half0(nk - 1, false);
  half1(nk - 1, false, false);
}


typedef int i32x8 __attribute__((ext_vector_type(8)));
template <bool GATHER>
__device__ __forceinline__ void gemmrs_tile_256(const GemmRTile& t, char* smem, f32x16 (&acc)[4][4]) {
  int tz0 = threadIdx.x; asm volatile("" : "+v"(tz0));
  const int tid = tz0, lane = tid & 63, wid = tid >> 6, wr = wid >> 1, wc = wid & 1;
  const int l31 = lane & 31, hh = lane >> 5;
#pragma unroll
  for (int i = 0; i < 4; ++i)
#pragma unroll
    for (int j = 0; j < 4; ++j)
#pragma unroll
      for (int r = 0; r < 16; ++r) acc[i][j][r] = 0.f;
  const int c_src = (tid & 3) ^ ((tid >> 4) & 3);
  const u8* a_src[GATHER ? 4 : 1];
  if (GATHER) {
#pragma unroll
    for (int i = 0; i < (GATHER ? 4 : 1); ++i) {
      int r = (tid >> 2) + 64 * i;
      int rr = r < t.mvalid ? r : 0;
      a_src[i] = t.A + (long)t.aidx[rr] * t.lda + c_src * 16;
    }
  } else {
    a_src[0] = t.A + ((long)(t.m0 + (tid >> 2)) >> 1) * 4096 + ((tid >> 2) & 1) * 64 + c_src * 16;
  }
  const long a_step = GATHER ? 64L * t.lda : 32L * 4096, b_step = 32L * 4096;
  const int a_kstep = GATHER ? 64 : 128;
  const int brl = tid >> 2;
  const u8* b_src0 = t.B + ((t.brow0 + brl) >> 1) * 4096 + (brl & 1) * 64 + c_src * 16;
  const u8* b_src1 = t.B + ((t.brow1 + brl) >> 1) * 4096 + (brl & 1) * 64 + c_src * 16;
  const unsigned lds0 = (unsigned)(size_t)smem + (unsigned)__builtin_amdgcn_readfirstlane(wid) * 1024u;
  auto issue = [&](int kt, int sl, int q) {
    if (q < 4) glds16_asm((const void*)((GATHER ? a_src[GATHER ? q : 0] : a_src[0] + q * a_step) + kt * a_kstep), lds0 + sl * R_STAGE + q * 4096);
    else { const int i = q - 4;
      if (BNT) glds16_asm_nt((const void*)((i < 2 ? b_src0 + i * b_step : b_src1 + (i - 2) * b_step) + kt * 128), lds0 + sl * R_STAGE + 16384 + i * 4096);
      else glds16_asm((const void*)((i < 2 ? b_src0 + i * b_step : b_src1 + (i - 2) * b_step) + kt * 128), lds0 + sl * R_STAGE + 16384 + i * 4096); }
  };
  unsigned a_rd[2], b_rd[2];
#pragma unroll
  for (int c = 0; c < 2; ++c) {
    const int ra = wr * 128 + l31, rb = wc * 64 + l31;
    a_rd[c] = ra * 64 + (((2 * hh + c) ^ ((ra >> 2) & 3)) * 16);
    b_rd[c] = rb * 64 + (((2 * hh + c) ^ ((rb >> 2) & 3)) * 16);
  }
  auto load_a = [&](const char* St, i32x8 (&af)[4]) {
#pragma unroll
    for (int mb = 0; mb < 4; ++mb) {
      const u32x4 lo = *(const u32x4*)(St + a_rd[0] + mb * 2048), hi = *(const u32x4*)(St + a_rd[1] + mb * 2048);
      af[mb] = (i32x8){(int)lo[0], (int)lo[1], (int)lo[2], (int)lo[3], (int)hi[0], (int)hi[1], (int)hi[2], (int)hi[3]};
    }
  };
  auto load_b = [&](const char* St, int nb, i32x8& bf) {
    const char* bp = St + 16384 + (nb >> 1) * 8192 + (nb & 1) * 2048;
    const u32x4 lo = *(const u32x4*)(bp + b_rd[0]), hi = *(const u32x4*)(bp + b_rd[1]);
    bf = (i32x8){(int)lo[0], (int)lo[1], (int)lo[2], (int)lo[3], (int)hi[0], (int)hi[1], (int)hi[2], (int)hi[3]};
  };
  auto mma4 = [&](i32x8 (&af)[4], i32x8& bf, int nb) {
#pragma unroll
    for (int mb = 0; mb < 4; ++mb)
      acc[mb][nb] = __builtin_amdgcn_mfma_scale_f32_32x32x64_f8f6f4(af[mb], bf, acc[mb][nb], 0, 0, 0, 0x7f7f7f7f, 0, 0x7f7f7f7f);
  };
  i32x8 aA[4], aB[4], bq[4];
  auto half0 = [&](int kt, i32x8 (&ac)[4], bool issueA) {
    const char* St = smem + (kt & 3) * R_STAGE;
    load_b(St, 2, bq[2]); load_b(St, 3, bq[3]);
    __builtin_amdgcn_sched_barrier(0);
#pragma unroll
    for (int nb = 0; nb < 2; ++nb) {
      mma4(ac, bq[nb], nb);
      __builtin_amdgcn_sched_barrier(0);
      if (issueA) { issue(kt + 2, (kt + 2) & 3, 4 + 2 * nb); issue(kt + 2, (kt + 2) & 3, 5 + 2 * nb); }
      __builtin_amdgcn_sched_barrier(0);
    }
  };
  auto half1 = [&](int kt, i32x8 (&ac)[4], i32x8 (&an)[4], bool has1, bool issueB) {
    const char* Sn = smem + ((kt + 1) & 3) * R_STAGE;
    if (has1) { load_a(Sn, an); load_b(Sn, 0, bq[0]); load_b(Sn, 1, bq[1]); }
    __builtin_amdgcn_sched_barrier(0);
#pragma unroll
    for (int nb = 2; nb < 4; ++nb) {
      mma4(ac, bq[nb], nb);
      __builtin_amdgcn_sched_barrier(0);
      if (issueB) { issue(kt + 3, (kt + 3) & 3, 2 * (nb - 2)); issue(kt + 3, (kt + 3) & 3, 2 * (nb - 2) + 1); }
      __builtin_amdgcn_sched_barrier(0);
    }
  };
  const int nk = t.KB >> 6;
  __syncthreads();
#pragma unroll
  for (int q = 0; q < 8; ++q) issue(0, 0, q);
#pragma unroll
  for (int q = 0; q < 8; ++q) issue(1, 1, q);
#pragma unroll
  for (int q = 0; q < 4; ++q) issue(2, 2, q);
  asm volatile("s_waitcnt vmcnt(12)" ::: "memory");
  __syncthreads();
  load_a(smem, aA); load_b(smem, 0, bq[0]); load_b(smem, 1, bq[1]);
  for (int kt = 0; kt < nk - 4; kt += 2) {
    half0(kt, aA, true);
    asm volatile("s_waitcnt vmcnt(8)" ::: "memory"); __syncthreads();
    half1(kt, aA, aB, true, true);
    half0(kt + 1, aB, true);
    asm volatile("s_waitcnt vmcnt(8)" ::: "memory"); __syncthreads();
    half1(kt + 1, aB, aA, true, true);
  }
  half0(nk - 4, aA, true);
  asm volatile("s_waitcnt vmcnt(8)" ::: "memory"); __syncthreads();
  half1(nk - 4, aA, aB, true, true);
  half0(nk - 3, aB, true);
  asm volatile("s_waitcnt vmcnt(8)" ::: "memory"); __syncthreads();
  half1(nk - 3, aB, aA, true, false);
  half0(nk - 2, aA, false);
  asm volatile("s_waitcnt vmcnt(0)" ::: "memory"); __syncthreads();
  half1(nk - 2, aA, aB, true, false);
  half0(nk - 1, aB, false);
  half1(nk - 1, aB, aA, false, false);
}

template <bool GATHER>
__device__ __forceinline__ void gemmrv_tile_256(const GemmRTile& t, char* smem, f32x16 (&acc)[4][4]) {
  int tz0 = threadIdx.x; asm volatile("" : "+v"(tz0));
  const int tid = tz0, lane = tid & 63, wid = tid >> 6, wr = wid >> 1, wc = wid & 1;
  const int l31 = lane & 31, hh = lane >> 5;
#pragma unroll
  for (int i = 0; i < 4; ++i)
#pragma unroll
    for (int j = 0; j < 4; ++j)
#pragma unroll
      for (int r = 0; r < 16; ++r) acc[i][j][r] = 0.f;
  const int c_src = (tid & 3) ^ ((tid >> 4) & 3);
  const u8* a_src[GATHER ? 4 : 1];
  if (GATHER) {
#pragma unroll
    for (int i = 0; i < (GATHER ? 4 : 1); ++i) {
      int r = (tid >> 2) + 64 * i;
      int rr = r < t.mvalid ? r : 0;
      a_src[i] = t.A + (long)t.aidx[rr] * t.lda + c_src * 16;
    }
  } else {
    a_src[0] = t.A + ((long)(t.m0 + (tid >> 2)) >> 1) * 4096 + ((tid >> 2) & 1) * 64 + c_src * 16;
  }
  const long a_step = GATHER ? 64L * t.lda : 32L * 4096, b_step = 32L * 4096;
  const int a_kstep = GATHER ? 64 : 128;
  const int brl = tid >> 2;
  const u8* b_src0 = t.B + ((t.brow0 + brl) >> 1) * 4096 + (brl & 1) * 64 + c_src * 16;
  const u8* b_src1 = t.B + ((t.brow1 + brl) >> 1) * 4096 + (brl & 1) * 64 + c_src * 16;
  u32x4 rs0[8], rs1[8];
  auto ldg = [&](int kt, int q, u32x4& dst) {
    const u8* ptr = (q < 4) ? ((GATHER ? a_src[GATHER ? q : 0] : a_src[0] + q * a_step) + kt * a_kstep)
                            : (((q - 4) < 2 ? b_src0 + (q - 4) * b_step : b_src1 + (q - 6) * b_step) + kt * 128);
    asm volatile("global_load_dwordx4 %0, %1, off" : "=v"(dst) : "v"(ptr) : "memory");
  };
  auto stw = [&](int sl, int q, const u32x4& src) {
    *(u32x4*)(smem + sl * R_STAGE + (q < 4 ? q * 4096 : 16384 + (q - 4) * 4096) + tid * 16) = src;
  };
#define RV_WAIT(N, r) asm volatile("s_waitcnt vmcnt(%8)" : "+v"(r[0]), "+v"(r[1]), "+v"(r[2]), "+v"(r[3]), "+v"(r[4]), "+v"(r[5]), "+v"(r[6]), "+v"(r[7]) : "n"(N) : "memory")
  unsigned a_rd[2], b_rd[2];
#pragma unroll
  for (int c = 0; c < 2; ++c) {
    const int ra = wr * 128 + l31, rb = wc * 64 + l31;
    a_rd[c] = ra * 64 + (((2 * hh + c) ^ ((ra >> 2) & 3)) * 16);
    b_rd[c] = rb * 64 + (((2 * hh + c) ^ ((rb >> 2) & 3)) * 16);
  }
  auto load_a = [&](const char* St, i32x8 (&af)[4]) {
#pragma unroll
    for (int mb = 0; mb < 4; ++mb) {
      const u32x4 lo = *(const u32x4*)(St + a_rd[0] + mb * 2048), hi = *(const u32x4*)(St + a_rd[1] + mb * 2048);
      af[mb] = (i32x8){(int)lo[0], (int)lo[1], (int)lo[2], (int)lo[3], (int)hi[0], (int)hi[1], (int)hi[2], (int)hi[3]};
    }
  };
  auto load_b = [&](const char* St, int nb, i32x8& bf) {
    const char* bp = St + 16384 + (nb >> 1) * 8192 + (nb & 1) * 2048;
    const u32x4 lo = *(const u32x4*)(bp + b_rd[0]), hi = *(const u32x4*)(bp + b_rd[1]);
    bf = (i32x8){(int)lo[0], (int)lo[1], (int)lo[2], (int)lo[3], (int)hi[0], (int)hi[1], (int)hi[2], (int)hi[3]};
  };
  auto mma4 = [&](i32x8 (&af)[4], i32x8& bf, int nb) {
#pragma unroll
    for (int mb = 0; mb < 4; ++mb)
      acc[mb][nb] = __builtin_amdgcn_mfma_scale_f32_32x32x64_f8f6f4(af[mb], bf, acc[mb][nb], 0, 0, 0, 0x7f7f7f7f, 0, 0x7f7f7f7f);
  };
  i32x8 aA[4], aB[4], bq[4];
  auto half0 = [&](int kt, i32x8 (&ac)[4]) {
    const char* St = smem + (kt & 1) * R_STAGE;
    load_b(St, 2, bq[2]); load_b(St, 3, bq[3]);
    __builtin_amdgcn_sched_barrier(0);
    mma4(ac, bq[0], 0);
    __builtin_amdgcn_sched_barrier(0);
    mma4(ac, bq[1], 1);
    __builtin_amdgcn_sched_barrier(0);
  };
  auto commit = [&](int kt, u32x4 (&rn)[8], auto wtag, bool has1, bool has3) {
    constexpr int W = decltype(wtag)::value;
    if (has1) {
      RV_WAIT(W, rn);
#pragma unroll
      for (int q = 0; q < 8; ++q) stw((kt + 1) & 1, q, rn[q]);
      if (has3) {
#pragma unroll
        for (int q = 0; q < 8; ++q) ldg(kt + 3, q, rn[q]);
      }
      __syncthreads();
    }
  };
  auto half1 = [&](int kt, i32x8 (&ac)[4], i32x8 (&an)[4], bool has1) {
    const char* Sn = smem + ((kt + 1) & 1) * R_STAGE;
    if (has1) { load_a(Sn, an); load_b(Sn, 0, bq[0]); load_b(Sn, 1, bq[1]); }
    __builtin_amdgcn_sched_barrier(0);
    mma4(ac, bq[2], 2);
    __builtin_amdgcn_sched_barrier(0);
    mma4(ac, bq[3], 3);
    __builtin_amdgcn_sched_barrier(0);
  };
#define IC(n) std::integral_constant<int, n>{}
  const int nk = t.KB >> 6;
  __syncthreads();
#pragma unroll
  for (int q = 0; q < 8; ++q) ldg(0, q, rs0[q]);
#pragma unroll
  for (int q = 0; q < 8; ++q) ldg(1, q, rs1[q]);
  RV_WAIT(8, rs0);
#pragma unroll
  for (int q = 0; q < 8; ++q) stw(0, q, rs0[q]);
#pragma unroll
  for (int q = 0; q < 8; ++q) ldg(2, q, rs0[q]);
  __syncthreads();
  load_a(smem, aA); load_b(smem, 0, bq[0]); load_b(smem, 1, bq[1]);
  for (int kt = 0; kt < nk - 4; kt += 2) {
    half0(kt, aA);      commit(kt, rs1, IC(8), true, true);      half1(kt, aA, aB, true);
    half0(kt + 1, aB);  commit(kt + 1, rs0, IC(8), true, true);  half1(kt + 1, aB, aA, true);
  }
  half0(nk - 4, aA);  commit(nk - 4, rs1, IC(8), true, true);   half1(nk - 4, aA, aB, true);
  half0(nk - 3, aB);  commit(nk - 3, rs0, IC(8), true, false);  half1(nk - 3, aB, aA, true);
  half0(nk - 2, aA);  commit(nk - 2, rs1, IC(0), true, false);  half1(nk - 2, aA, aB, true);
  half0(nk - 1, aB);                                            half1(nk - 1, aB, aA, false);
#undef IC
#undef RV_WAIT
}

__device__ __forceinline__ void cvt16_tile(const float* W, int col0, int ldn, int nvalid  , const float* kgain,
                                           u16* out  , int ldk, char* T) {
  const int tid = opaque_tid();
  const int kq = tid & 7, n4 = tid >> 3;
  f32x4 v[16];
  const bool ok = (n4 * 4) < nvalid;
  const float* src = W + (long)(kq * 16) * ldn + (ok ? n4 * 4 : -col0);
#pragma unroll
  for (int j = 0; j < 16; ++j) v[j] = *(const f32x4*)(src + (long)j * ldn);
  if (kgain) {
#pragma unroll
    for (int j = 0; j < 16; ++j) v[j] *= kgain[kq * 16 + j];
  }
  if (!ok) {
#pragma unroll
    for (int j = 0; j < 16; ++j) v[j] = (f32x4){0.f, 0.f, 0.f, 0.f};
  }
  __syncthreads();
#pragma unroll
  for (int c = 0; c < 4; ++c) {
    u32x4 w0, w1;
#pragma unroll
    for (int q = 0; q < 4; ++q) { w0[q] = pack_bf16(v[2 * q][c], v[2 * q + 1][c]); w1[q] = pack_bf16(v[8 + 2 * q][c], v[8 + 2 * q + 1][c]); }
    *(u32x4*)(T + (n4 * 4 + c) * 256 + kq * 32) = w0;
    *(u32x4*)(T + (n4 * 4 + c) * 256 + kq * 32 + 16) = w1;
  }
  __syncthreads();
#pragma unroll
  for (int i = 0; i < 8; ++i) {
    const int n = (tid >> 4) + 16 * i, ch = tid & 15;
    *(u32x4*)((char*)(out + (long)n * ldk) + ch * 16) = *(const u32x4*)(T + n * 256 + ch * 16);
  }
}
__device__ __forceinline__ void convert_one(const Params& p, char* smem, int u);
__device__ __forceinline__ void ph_convert_dense(const Params& p, char* smem) {
#if WOUTQ
  convert_one(p, smem, 24576 + blockIdx.x);
#endif
  for (int u = blockIdx.x; u < 912; u += gridDim.x) {
    if (u < 544) { const int kt = u / 34, nt = u % 34; const int nv = NC_ - nt * 128;
      cvt16_tile(p.w_in + (long)(kt * 128) * NC_ + nt * 128, nt * 128, NC_, nv < 0 ? 0 : nv, nullptr, p.wb_in() + (long)(nt * 128) * 2048 + kt * 128, 2048, smem);
    } else if (u < 592) { const int v = u - 544; const int kt = v / 12, nt = v % 12;
      cvt16_tile(p.w_uq + (long)(kt * 128) * 1536 + nt * 128, nt * 128, 1536, 128, p.q_norm + kt * 128, p.wb_uq() + (long)(nt * 128) * 512 + kt * 128, 512, smem);
    } else if (u < 656) { const int v = u - 592; const int kt = v >> 4, nt = v & 15;
      cvt16_tile(p.w_ukv + (long)(kt * 128) * 2048 + nt * 128, nt * 128, 2048, 128, p.kv_norm + kt * 128, p.wb_ukv() + (long)(nt * 128) * 512 + kt * 128, 512, smem);
    } else if (!WOUTQ) { const int v = u - 656; const int kt = v >> 4, nt = v & 15;
      cvt16_tile(p.w_out + (long)(kt * 128) * 2048 + nt * 128, nt * 128, 2048, 128, nullptr, p.wb_out() + (long)(nt * 128) * 2048 + kt * 128, 2048, smem);
    }
  }
}


template <class F>
__device__ __forceinline__ void epi_store_bf16(f32x16 (&acc)[4][4], char* smem, u16* gbase  , int ld, int ncols0, int ncols1, F f) {
  int tz = threadIdx.x; asm volatile("" : "+v"(tz));
  const int lane = tz & 63, wid = tz >> 6, wr = wid >> 1, wc = wid & 1, l31 = lane & 31, hh = lane >> 5;
  __syncthreads();
  char* st = smem + wid * 32768;
#pragma unroll
  for (int mb = 0; mb < 4; ++mb)
#pragma unroll
    for (int reg = 0; reg < 16; ++reg) {
      const int r = mb * 32 + (reg & 3) + 8 * (reg >> 2) + 4 * hh;
      float v[4] = {acc[mb][0][reg], acc[mb][1][reg], acc[mb][2][reg], acc[mb][3][reg]};
      f(wr * 128 + r, wc * 64 + l31, v);
#pragma unroll
      for (int nb = 0; nb < 4; ++nb) *(u16*)(st + r * 256 + (nb * 32 + l31) * 2) = f32_to_bf16(v[nb]);
    }
  const int ch = lane & 15, span = ch >> 3;
  const int gcol = span * 128 + wc * 64 + (ch & 7) * 8;
  const bool ok = ((wc * 64 + (ch & 7) * 8) < (span ? ncols1 : ncols0));
#pragma unroll 8
  for (int it = 0; it < 32; ++it) {
    const int r = it * 4 + (lane >> 4);
    const u32x4 w = *(const u32x4*)(st + r * 256 + ch * 16);
    if (ok) *(u32x4*)(gbase + (long)(wr * 128 + r) * ld + gcol) = w;
  }
}
template <class F>
__device__ __forceinline__ void epi_store_act8(f32x16 (&acc)[4][4], char* smem, u8* gbase  , long row0, int cb0, F f) {
  int tz = threadIdx.x; asm volatile("" : "+v"(tz));
  const int lane = tz & 63, wid = tz >> 6, wr = wid >> 1, wc = wid & 1, l31 = lane & 31, hh = lane >> 5;
  __syncthreads();
  char* st = smem + wid * 32768;
#pragma unroll
  for (int mb = 0; mb < 4; ++mb)
#pragma unroll
    for (int reg = 0; reg < 16; ++reg) {
      const int r = mb * 32 + (reg & 3) + 8 * (reg >> 2) + 4 * hh;
      float v[4] = {acc[mb][0][reg], acc[mb][1][reg], acc[mb][2][reg], acc[mb][3][reg]};
      f(wr * 128 + r, wc * 64 + l31, v);
      const int q = __builtin_amdgcn_cvt_pk_fp8_f32(v[0], v[1], 0, false);
      *(u8*)(st + r * 64 + l31) = (u8)(q & 0xff);
      *(u8*)(st + r * 64 + 32 + l31) = (u8)((q >> 8) & 0xff);
    }
  const int ch = lane & 3;
#pragma unroll 8
  for (int it = 0; it < 8; ++it) {
    const int r = it * 16 + (lane >> 2);
    const u32x4 w = *(const u32x4*)(st + r * 64 + ch * 16);
    const long rg = row0 + wr * 128 + r;
    *(u32x4*)(gbase + (rg >> 1) * 4096 + (long)(cb0 + wc) * 128 + (rg & 1) * 64 + ch * 16) = w;
  }
}
__device__ __forceinline__ void epi_store_f32_resid(f32x16 (&acc)[4][4], char* smem, const float* resid, float* out, int ld, float osc) {
  int tz = threadIdx.x; asm volatile("" : "+v"(tz));
  const int lane = tz & 63, wid = tz >> 6, wr = wid >> 1, wc = wid & 1, l31 = lane & 31, hh = lane >> 5;
  __syncthreads();
  char* st = smem + wid * 32768;
#pragma unroll
  for (int half = 0; half < 2; ++half) {
#pragma unroll
    for (int m2 = 0; m2 < 2; ++m2)
#pragma unroll
      for (int reg = 0; reg < 16; ++reg) {
        const int mb = half * 2 + m2;
        const int r = m2 * 32 + (reg & 3) + 8 * (reg >> 2) + 4 * hh;
#pragma unroll
        for (int nb = 0; nb < 4; ++nb) *(float*)(st + r * 512 + (nb * 32 + l31) * 4) = acc[mb][nb][reg];
      }
    const int ch = lane & 31, span = ch >> 4;
    const int gcol = span * 128 + wc * 64 + (ch & 15) * 4;
#pragma unroll 8
    for (int it = 0; it < 32; ++it) {
      const int r = it * 2 + (lane >> 5);
      const f32x4 a = *(const f32x4*)(st + r * 512 + ch * 16);
      const long o = (long)(wr * 128 + half * 64 + r) * ld + gcol;
      const f32x4 x = __builtin_nontemporal_load((const f32x4*)(resid + o));
      *(f32x4*)(out + o) = a * osc + x;
    }
  }
}

template <int NBV>
__device__ __forceinline__ void win_tile_r(const Params& p, char* smem, int mt, int nt) {
  f32x16 acc[4][4];
  GemmRTile t{};
  t.A = (const u8*)p.h1(); t.lda = 4096; t.aidx = nullptr; t.m0 = mt * 256; t.mvalid = 256;
  t.B = (const u8*)p.wb_in(); t.brow0 = nt * 256; t.brow1 = nt * 256 + 128; t.ldb = 4096; t.KB = 4096;
  gemmr_tile_256<false, false>(t, smem, acc);
  const int rem = NC_ - nt * 256;
  const int nv0 = rem >= 128 ? 128 : rem, nv1 = rem >= 256 ? 128 : (rem > 128 ? rem - 128 : 0);
  epi_store_bf16(acc, smem, p.proj() + (long)(mt * 256) * NC_ + nt * 256, NC_, nv0, nv1, [&](int, int, float (&)[4]) {});
}
__device__ __forceinline__ void ph_win_r(const Params& p, char* smem) {
  const int x = blockIdx.x & 7, slot = blockIdx.x >> 3;
  for (int j = slot; j < 68; j += 32) win_tile_r<4>(p, smem, 4 * x + (j & 3), j >> 2);
}
__device__ __forceinline__ void upq_tile_r(const Params& p, char* smem, int mt, int nt) {
  f32x16 acc[4][4];
  GemmRTile t{};
  t.A = (const u8*)(p.proj() + C_MQ); t.lda = NC_ * 2; t.aidx = nullptr; t.m0 = mt * 256; t.mvalid = 256;
  t.B = (const u8*)p.wb_uq(); t.brow0 = nt * 256; t.brow1 = nt * 256 + 128; t.ldb = 1024; t.KB = 1024;
  gemmr_tile_256<false, false>(t, smem, acc);
  const float* rq = p.rq() + mt * 256;
  epi_store_bf16(acc, smem, p.q() + (long)(mt * 256) * 1536 + nt * 256, 1536, 128, 128, [&](int rowl, int, float (&v)[4]) {
    const float s = rq[rowl] * QSCALE_;
#pragma unroll
    for (int nb = 0; nb < 4; ++nb) v[nb] *= s;
  });
}
__device__ __forceinline__ void upkv_tile_r(const Params& p, char* smem, int mt, int nt) {
  f32x16 acc[4][4];
  GemmRTile t{};
  t.A = (const u8*)(p.proj() + C_MKV); t.lda = NC_ * 2; t.aidx = nullptr; t.m0 = mt * 256; t.mvalid = 256;
  t.B = (const u8*)p.wb_ukv(); t.brow0 = nt * 256; t.brow1 = nt * 256 + 128; t.ldb = 1024; t.KB = 1024;
  gemmr_tile_256<false, false>(t, smem, acc);
  const float* rk = p.rkv() + mt * 256;
  epi_store_bf16(acc, smem, p.kv() + (long)(mt * 256) * 2048 + nt * 256, 2048, 128, 128, [&](int rowl, int, float (&v)[4]) {
    const float s = rk[rowl];
#pragma unroll
    for (int nb = 0; nb < 4; ++nb) v[nb] *= s;
  });
}
__device__ __forceinline__ void wout_tile_r(const Params& p, char* smem, int mt, int nt) {
  f32x16 acc[4][4];
  GemmRTile t{};
#if WOUTQ
  t.A = p.mixq(); t.lda = 2048; t.aidx = nullptr; t.m0 = mt * 256; t.mvalid = 256;
  t.B = p.wq_out(); t.brow0 = nt * 256; t.brow1 = nt * 256 + 128; t.ldb = 2048; t.KB = 2048;
  gemmrs_tile_256<false>(t, smem, acc);
  const float osc = WISCALE_;
#else
  t.A = (const u8*)p.mix(); t.lda = 4096; t.aidx = nullptr; t.m0 = mt * 256; t.mvalid = 256;
  t.B = (const u8*)p.wb_out(); t.brow0 = nt * 256; t.brow1 = nt * 256 + 128; t.ldb = 4096; t.KB = 4096;
  gemmr_tile_256<false, false>(t, smem, acc);
  const float osc = 1.0f;
#endif
  const long boff = (long)(mt * 256) * 2048 + nt * 256;
  epi_store_f32_resid(acc, smem, p.x + boff, p.x1() + boff, 2048, osc);
}

__device__ __forceinline__ void moe1q_tile(const Params& p, char* smem, const int* mo, int e, int nt, int mt) {
  f32x16 acc[4][4];
  GemmRTile t{};
  const int cnt = p.counts()[e];
  t.A = p.h2q(); t.lda = 2048; t.aidx = p.list() + e * T_ + mt * 256; t.m0 = 0; t.mvalid = min(256, cnt - mt * 256);
  t.B = p.wq_gu(); t.brow0 = (long)e * 4096 + nt * 128; t.brow1 = t.brow0 + 2048; t.ldb = 2048; t.KB = 2048;
#if MOEQ == 3
  gemmrv_tile_256<true>(t, smem, acc);
#elif MOEQ == 2
  gemmrs_tile_256<true>(t, smem, acc);
#else
  gemmr_tile_256<true, true>(t, smem, acc);
#endif
  const float* bg = p.b_gu + e * 4096 + nt * 128; const float* bu = bg + 2048;
  const int tq_ = opaque_tid(); const int cl = (tq_ >> 6 & 1) * 64 + (tq_ & 31);
  const float bgv[2] = {bg[cl], bg[cl + 32]}, buv[2] = {bu[cl], bu[cl + 32]};
  epi_store_act8(acc, smem, p.actq(), (long)(mo[e] * 256 + mt * 256), nt * 2, [&](int, int, float (&v)[4]) {
#pragma unroll
    for (int nb = 0; nb < 2; ++nb) {
      float g = fminf(v[nb] * WISCALE_ + bgv[nb], 7.0f);
      float uu = fminf(fmaxf(v[nb + 2] * WISCALE_ + buv[nb], -7.0f), 7.0f);
      v[nb] = (uu + 1.0f) * (g / (1.0f + __expf(-1.702f * g)));
    }
  });
}
__device__ __forceinline__ void moe2q_tile(const Params& p, char* smem, const int* mo, int e, int nt, int mt) {
  f32x16 acc[4][4];
  GemmRTile t{};
  t.A = p.actq(); t.lda = 2048; t.aidx = nullptr; t.m0 = mo[e] * 256 + mt * 256; t.mvalid = 256;
  t.B = p.wq_dn(); t.brow0 = (long)e * 2048 + nt * 256; t.brow1 = t.brow0 + 128; t.ldb = 2048; t.KB = 2048;
#if MOEQ == 3
  gemmrv_tile_256<false>(t, smem, acc);
#elif MOEQ == 2
  gemmrs_tile_256<false>(t, smem, acc);
#else
  gemmr_tile_256<true, false>(t, smem, acc);
#endif
  const float* bd = p.b_dn + e * 2048 + nt * 256;
  const int tq_ = opaque_tid(); const int cl = (tq_ >> 6 & 1) * 64 + (tq_ & 31);
  const float bdv[4] = {bd[cl], bd[cl + 32], bd[cl + 128], bd[cl + 160]};
  epi_store_bf16(acc, smem, p.ybuf() + (long)t.m0 * 2048 + nt * 256, 2048, 128, 128, [&](int, int, float (&v)[4]) {
#pragma unroll
    for (int nb = 0; nb < 4; ++nb) v[nb] = v[nb] * WISCALE_ + bdv[nb];
  });
}
template <int WHICH>
__device__ __forceinline__ void ph_moeq(const Params& p, char* smem) {
  int* mo = (int*)(smem + G_LDS_BYTES);
#if CVT_SPLIT
  const bool dn_first = ((blockIdx.x >> 3) & 1) != 0;
  if (WHICH == 1 && dn_first) ph_convert_dn(p, smem);
#endif
  moe_setup(p, mo);
  const int NT = (WHICH == 1) ? 16 : 8;
  const int total = mo[NE_] * NT;
#if SKEW
  { const int sl = (blockIdx.x >> 3) % 5; for (int i = 0; i < sl; ++i) __builtin_amdgcn_s_sleep(SKEW); }
#endif
  for (int round = 0;; ++round) {
    const int u = xcd_unit(round);
    if (round * 256 >= total) break;
    if (u >= total) continue;
    int e = 0;
    while (mo[e + 1] * NT <= u) ++e;
    const int local = u - mo[e] * NT, me = mo[e + 1] - mo[e];
    const int nt = UORD ? (local % NT) : (local / me), mt = UORD ? (local / NT) : (local - (local / me) * me);
    if (WHICH == 1) moe1q_tile(p, smem, mo, e, nt, mt); else moe2q_tile(p, smem, mo, e, nt, mt);
  }
#if CVT_SPLIT
  if (WHICH == 1 && !dn_first) ph_convert_dn(p, smem);
#endif
}
#define LDS_MAX 143360
#ifndef DUP
#define DUP 0
#endif
#ifndef MOEQ
#define MOEQ 1
#endif
#ifndef CVT_SPLIT
#define CVT_SPLIT 1
#endif
#ifndef CVT_STAGGER
#define CVT_STAGGER 1
#endif
#ifndef CVT_IN_P4
#define CVT_IN_P4 1
#endif
#ifndef TSTAMP
#define TSTAMP 0
#endif
#ifndef DENSER
#define DENSER 1
#endif
__global__ void __launch_bounds__(256, 1) mega(Params p) {
  extern __shared__ __attribute__((aligned(16))) char smem[];
  volatile LAS unsigned* xbw = (volatile LAS unsigned*)(smem + LDS_MAX - 16);
  if (threadIdx.x == 0) { xbw[0] = 0u; xbw[1] = 0u; xbw[2] = 0u; xbw[3] = 0u; }
  __syncthreads();
  (void)xcd_barrier_post(p.bar(), xbw);
#if TSTAMP
  unsigned long long ts0 = wall_clock64();
  int bar_no = 0;
#define XBAR() do { XcdBarrier bar_; bar_.bar = p.bar(); bar_.x = xb_xcc_id(); bar_.st = (volatile LAS unsigned*)(smem + LDS_MAX - 16); xcd_barrier(bar_); ++bar_no; if (bar_no == TSTAMP && blockIdx.x == 0 && threadIdx.x == 0) { ((float*)p.counts())[48] = (float)(wall_clock64() - ts0) * (1.0f / 100.0f); } } while (0)
#else
#define XBAR() do { XcdBarrier bar_; bar_.bar = p.bar(); bar_.x = xb_xcc_id(); bar_.st = (volatile LAS unsigned*)(smem + LDS_MAX - 16); xcd_barrier(bar_); } while (0)
#endif
#if DUP == 100
  for (int rep_ = 0; rep_ < 2; ++rep_) {
  if (rep_) XBAR();
#endif
  ph_prep0(p);
#if DUP == 33
  if (blockIdx.x < 192) gla_g1_unit(p, smem, blockIdx.x);
  else for (int i = 0; i < 5; ++i) gla_g1_unit(p, smem, 192 + (blockIdx.x - 192) * 5 + i);
#endif
#if DUP == 30
  ph_prep0(p);
#endif
#if DENSER
  ph_convert_dense(p, smem);
#endif
#if MOEQ >= 1 && CVT_IN_P4 == 0
  ph_convert(p, smem);
#if DUP == 20
  ph_convert(p, smem);
#endif
#endif
  XBAR();
#if DENSER
  ph_win_r(p, smem);
#else
  ph_win(p, smem);
#endif
#if DUP == 1
#if DENSER
  ph_win_r(p, smem);
#else
  ph_win(p, smem);
#endif
#endif
  XBAR();
  ph_prep1(p, smem);
#if DUP == 2
  ph_prep1(p, smem);
#endif
  XBAR();
#if DENSER
  upkv_tile_r(p, smem, blockIdx.x >> 3, blockIdx.x & 7);
  if (blockIdx.x < 192) upq_tile_r(p, smem, blockIdx.x / 6, blockIdx.x % 6);
#else
  upkv_tile(p, smem, blockIdx.x >> 3, blockIdx.x & 7);
  if (blockIdx.x < 192) upq_tile(p, smem, blockIdx.x / 6, blockIdx.x % 6);
#endif
  if (blockIdx.x < 192) gla_g1_unit(p, smem, blockIdx.x);
  else for (int i = 0; i < 4; ++i) gla_g1_unit(p, smem, 192 + (blockIdx.x - 192) * 4 + i);
  if (blockIdx.x < 64) gla_g1_unit(p, smem, 448 + blockIdx.x);
#if DUP == 3
  upkv_tile(p, smem, blockIdx.x >> 3, blockIdx.x & 7);
  if (blockIdx.x < 192) upq_tile(p, smem, blockIdx.x / 6, blockIdx.x % 6);
  if (blockIdx.x < 192) gla_g1_unit(p, smem, blockIdx.x);
  else for (int i = 0; i < 5; ++i) gla_g1_unit(p, smem, 192 + (blockIdx.x - 192) * 5 + i);
#endif
  XBAR();
  gla_g2_unit(p, blockIdx.x);
#if DUP == 31
  gla_g2_unit(p, blockIdx.x);
#endif
  {
    const int bh = blockIdx.x >> 4, qa = blockIdx.x & 15;
#if MOEQ >= 1 && CVT_IN_P4
    const bool cvt_first = CVT_STAGGER ? (((blockIdx.x >> 3) & 1) != 0) : false;
    if (cvt_first) { if (CVT_SPLIT) ph_convert_gu(p, smem, 0, 1); else ph_convert(p, smem); }
#endif
    attn_unit(p, smem, bh >> 3, bh & 7, 31 - qa);
    attn_unit(p, smem, bh >> 3, bh & 7, qa);
#if MOEQ >= 1 && CVT_IN_P4
    if (!cvt_first) { if (CVT_SPLIT) ph_convert_gu(p, smem, 0, 1); else ph_convert(p, smem); }
#endif
#if DUP == 44
    if (cvt_first) ph_convert(p, smem);
    attn_unit(p, smem, bh >> 3, bh & 7, 31 - qa);
    attn_unit(p, smem, bh >> 3, bh & 7, qa);
    if (!cvt_first) ph_convert(p, smem);
#endif
#if DUP == 4
    attn_unit(p, smem, bh >> 3, bh & 7, 31 - qa);
    attn_unit(p, smem, bh >> 3, bh & 7, qa);
#endif
  }
  XBAR();
  for (int u = blockIdx.x; u < 512; u += gridDim.x) gla_g3_unit(p, smem, u);
  mla_norm_tokens(p);
#if DUP == 5
  for (int u = blockIdx.x; u < 512; u += gridDim.x) gla_g3_unit(p, smem, u);
  mla_norm_tokens(p);
#endif
  XBAR();
#if DENSER
  wout_tile_r(p, smem, (blockIdx.x & 7) * 4 + ((blockIdx.x >> 3) & 3), blockIdx.x >> 5);
#else
  wout_tile(p, smem, blockIdx.x >> 3, blockIdx.x & 7);
#endif
#if DUP == 6
  wout_tile(p, smem, blockIdx.x >> 3, blockIdx.x & 7);
#endif
  XBAR();
  ffn_prep_unit(p, smem, blockIdx.x);
#if DUP == 7
  ffn_prep_unit<1>(p, smem, blockIdx.x);
#endif
  XBAR();
#if MOEQ >= 1
  ph_moeq<1>(p, smem);
#if DUP == 8
  ph_moeq<1>(p, smem);
#endif
#else
  ph_moe<1>(p, smem);
#endif
  XBAR();
#if MOEQ >= 1
  ph_moeq<2>(p, smem);
#else
  ph_moe<2>(p, smem);
#endif
#if DUP == 9
  ph_moeq<2>(p, smem);
#endif
#if DUP == 89
  XBAR();
  ph_moeq<1>(p, smem);
  XBAR();
  ph_moeq<2>(p, smem);
#endif
#if DUP == 19
  ph_moe<2, 1>(p, smem);
#endif
  XBAR();
#if DUP == 100
  ph_final(p, smem);
  }
#endif
#if TSTAMP
  {
    const float us = ((const float*)p.counts())[48];
    const float scl = 1.0f + us * (1.0f / 4000.0f);
    ph_final(p, smem, scl);
  }
#else
  ph_final(p, smem);
#endif
#if DUP == 10
  ph_final(p, smem);
#endif
#if DUP == 11
  for (int i = 0; i < 10; ++i) XBAR();
#endif
}

extern "C" void kernel_launch(void* const* d_in, const int* in_sizes, int n_in,
                              void* d_out, int out_size, void* d_ws, size_t ws_size,
                              hipStream_t stream) {
  Params P{};
  P.x = (const float*)d_in[0]; P.pos = (const int*)d_in[1];
  P.attn_norm = (const float*)d_in[2]; P.w_in = (const float*)d_in[3]; P.gate_up = (const float*)d_in[4]; P.gate_bias = (const float*)d_in[5];
  P.gla_out_norm = (const float*)d_in[6]; P.q_norm = (const float*)d_in[7]; P.w_uq = (const float*)d_in[8]; P.kv_norm = (const float*)d_in[9];
  P.w_ukv = (const float*)d_in[10]; P.mla_out_norm = (const float*)d_in[11]; P.w_out = (const float*)d_in[12]; P.ffn_norm = (const float*)d_in[13];
  P.router_w = (const float*)d_in[14]; P.router_b = (const float*)d_in[15]; P.w_gu = (const float*)d_in[16]; P.b_gu = (const float*)d_in[17];
  P.w_dn = (const float*)d_in[18]; P.b_dn = (const float*)d_in[19]; P.final_norm = (const float*)d_in[20];
  P.out = (float*)d_out;

  P.ws = (char*)d_ws;

  hipFuncSetAttribute((const void*)mega, hipFuncAttributeMaxDynamicSharedMemorySize, LDS_MAX);
  hipMemsetAsync(d_ws, 0, XCD_BAR_WORDS * sizeof(unsigned), stream);
  mega<<<256, 256, LDS_MAX, stream>>>(P);
}
```

```cpp
#define DUP 0
#define MOEQ 2
#define TSTAMP 0
#define CVT_SPLIT 1
#define CVT_IN_P4 1
#define YNT 1
#define ANT 0
#define BNT 1
#define UORD 0
#define LOOK1 1
#define LOOK2 0
#define WOUTQ 0
#define SKEW 0
#define CVT_STAGGER 1
#include <hip/hip_runtime.h>
#include <hip/hip_bf16.h>
#include <stdint.h>
#include <type_traits>
#define T_      8192
#define SEQ_    4096
#define D_      2048
#define NC_     4176
#define C_GQ    0
#define C_GK    512
#define C_GV    1024
#define C_GR    2048
#define C_GD    3072
#define C_MQ    3088
#define C_MKV   3600
#define C_MKR   4112
#define NE_     32
#define DFF_    2048
#define EPS_    1e-6f
typedef short bf16x8 __attribute__((ext_vector_type(8)));
typedef short s16x4 __attribute__((ext_vector_type(4)));
typedef float f32x16 __attribute__((ext_vector_type(16)));
typedef float f32x4 __attribute__((ext_vector_type(4)));
typedef float f32x2 __attribute__((ext_vector_type(2)));
typedef unsigned short u16;
typedef unsigned u32x4 __attribute__((ext_vector_type(4)));
typedef unsigned u32x2 __attribute__((ext_vector_type(2)));
#define LAS3 __attribute__((address_space(3)))
#define OPAQUE(x) asm volatile("" : "+v"(x))
#define NTHR 256
__device__ __forceinline__ int opaque_tid() { int t = threadIdx.x; asm volatile("" : "+v"(t)); return t; }

__device__ __forceinline__ unsigned pack_bf16(float a, float b) {
  typedef __bf16 bf2 __attribute__((ext_vector_type(2)));
  typedef float f2 __attribute__((ext_vector_type(2)));
  f2 v = {a, b};
  bf2 r = __builtin_convertvector(v, bf2);
  return *(unsigned*)&r;
}
__device__ __forceinline__ float bf_lo(unsigned w) { return __uint_as_float(w << 16); }
__device__ __forceinline__ float bf_hi(unsigned w) { return __uint_as_float(w & 0xffff0000u); }
__device__ __forceinline__ float bf16_to_f32(u16 v) { return __uint_as_float(((unsigned)v) << 16); }
__device__ __forceinline__ u16 f32_to_bf16(float f) { return (u16)(pack_bf16(f, 0.f) & 0xffffu); }
__device__ __forceinline__ float shflx(float v, int k) {
  int t = threadIdx.x; asm volatile("" : "+v"(t));
  return __int_as_float(__builtin_amdgcn_ds_bpermute((((t & 63) ^ k) << 2), __float_as_int(v)));
}
__device__ __forceinline__ float wave_sum(float v) {
#pragma unroll
  for (int o = 32; o > 0; o >>= 1) v += shflx(v, o);
  return v;
}
__device__ __forceinline__ unsigned off_b(unsigned row, unsigned ch) { return 256u * row + 16u * (ch ^ (((row & 3u) << 2) | ((row >> 2) & 3u))); }
__device__ __forceinline__ unsigned tr_addr(unsigned lane, unsigned c, unsigned row0  ) {
  const unsigned blk = (lane >> 4) & 1u, q = (lane & 15u) >> 2, p = lane & 3u;
  return off_b(row0 + q, 4u * c + 2u * blk + (p >> 1)) + 8u * (p & 1u);
}
__device__ __forceinline__ bf16x8 tr_frag(const char* img, unsigned lane, unsigned c, unsigned row_a, unsigned row_b) {
  s16x4 v0 = __builtin_amdgcn_ds_read_tr16_b64_v4i16((LAS3 s16x4*)(img + tr_addr(lane, c, row_a)));
  s16x4 v1 = __builtin_amdgcn_ds_read_tr16_b64_v4i16((LAS3 s16x4*)(img + tr_addr(lane, c, row_b)));
  return (bf16x8){v0[0], v0[1], v0[2], v0[3], v1[0], v1[1], v1[2], v1[3]};
}

__device__ __forceinline__ void glds16_asm(const void* gsrc, unsigned lds_dst) {
  unsigned keep;
  asm volatile("s_mov_b32 %0, m0\n\ts_mov_b32 m0, %2\n\ts_nop 0\n\tglobal_load_lds_dwordx4 %1, off\n\ts_mov_b32 m0, %0" : "=&s"(keep) : "v"(gsrc), "s"(lds_dst) : "memory");
}
__device__ __forceinline__ void glds16_asm_nt(const void* gsrc, unsigned lds_dst) {
  unsigned keep;
  asm volatile("s_mov_b32 %0, m0\n\ts_mov_b32 m0, %2\n\ts_nop 0\n\tglobal_load_lds_dwordx4 %1, off nt\n\ts_mov_b32 m0, %0" : "=&s"(keep) : "v"(gsrc), "s"(lds_dst) : "memory");
}
struct Params {
  const float *x; const int* pos;
  const float *attn_norm, *w_in, *gate_up, *gate_bias, *gla_out_norm, *q_norm, *w_uq, *kv_norm, *w_ukv, *mla_out_norm, *w_out,
              *ffn_norm, *router_w, *router_b, *w_gu, *b_gu, *w_dn, *b_dn, *final_norm;
  float* out;
  char* ws;
  __device__ __forceinline__ unsigned* bar() const { return (unsigned*)(ws + 0ull); }
  __device__ __forceinline__ int* counts() const { return (int*)(ws + 16384ull); }
  __device__ __forceinline__ u16* h1() const { return (u16*)(ws + 16640ull); }
  __device__ __forceinline__ u16* proj() const { return (u16*)(ws + 33571072ull); }
  __device__ __forceinline__ float2* cs() const { return (float2*)(ws + 101990656ull); }
  __device__ __forceinline__ float* rq() const { return (float*)(ws + 104087808ull); }
  __device__ __forceinline__ float* rkv() const { return (float*)(ws + 104120576ull); }
  __device__ __forceinline__ float* bcum() const { return (float*)(ws + 104153344ull); }
  __device__ __forceinline__ u16* q() const { return (u16*)(ws + 120930560ull); }
  __device__ __forceinline__ u16* kv() const { return (u16*)(ws + 146096384ull); }
  __device__ __forceinline__ u16* kpe() const { return (u16*)(ws + 179650816ull); }
  __device__ __forceinline__ u16* kvc() const { return (u16*)(ws + 180699392ull); }
  __device__ __forceinline__ float* dec() const { return (float*)(ws + 214253824ull); }
  __device__ __forceinline__ u16* sprev() const { return (u16*)(ws + 214515968ull); }
  __device__ __forceinline__ u16* mix() const { return (u16*)(ws + 248070400ull); }
  __device__ __forceinline__ u16* omla() const { return (u16*)(ws + 281624832ull); }
  __device__ __forceinline__ float* x1() const { return (float*)(ws + 298402048ull); }
  __device__ __forceinline__ u16* h2() const { return (u16*)(ws + 365510912ull); }
  __device__ __forceinline__ int* list() const { return (int*)(ws + 399065344ull); }
  __device__ __forceinline__ int* asg_e() const { return (int*)(ws + 400113920ull); }
  __device__ __forceinline__ int* asg_slot() const { return (int*)(ws + 400244992ull); }
  __device__ __forceinline__ float* asg_g() const { return (float*)(ws + 400376064ull); }
  __device__ __forceinline__ u16* act() const { return (u16*)(ws + 400507136ull); }
  __device__ __forceinline__ u16* ybuf() const { return (u16*)(ws + 568279296ull); }
  __device__ __forceinline__ unsigned char* wq_gu() const { return (unsigned char*)(ws + 736051456ull); }
  __device__ __forceinline__ unsigned char* wq_dn() const { return (unsigned char*)(ws + 1004486912ull); }
  __device__ __forceinline__ unsigned char* h2q() const { return (unsigned char*)(ws + 1138704640ull); }
  __device__ __forceinline__ unsigned char* actq() const { return (unsigned char*)(ws + 1155481856ull); }
  __device__ __forceinline__ u16* wb_in() const { return (u16*)(ws + 1239367936ull); }
  __device__ __forceinline__ u16* wb_uq() const { return (u16*)(ws + 1257193728ull); }
  __device__ __forceinline__ u16* wb_ukv() const { return (u16*)(ws + 1258766592ull); }
  __device__ __forceinline__ u16* wb_out() const { return (u16*)(ws + 1260863744ull); }
  __device__ __forceinline__ unsigned char* mixq() const { return (unsigned char*)(ws + 1269252352ull); }
  __device__ __forceinline__ unsigned char* wq_out() const { return (unsigned char*)(ws + 1286029568ull); }
};
#define WS_BYTES_USED 1290223872ull

#define XB_TMO      128
#define XB_XCNT(j)  (256  + 64 * (j))
#define XB_XSUB(j)  (1280 + 64 * (j))
#define XB_XGEN(j)  (2304 + 64 * (j))
#define XB_TOP      3328
#define XB_TOPGEN   3392
#define XCD_BAR_WORDS 3456
#define XB_SPIN_CAP (1u << 18)
#define LAS __attribute__((address_space(3)))

__device__ __forceinline__ unsigned xb_ld(unsigned* p)              { return __hip_atomic_load(p, __ATOMIC_RELAXED, __HIP_MEMORY_SCOPE_AGENT); }
__device__ __forceinline__ unsigned xb_add(unsigned* p, unsigned v) { return __hip_atomic_fetch_add(p, v, __ATOMIC_RELAXED, __HIP_MEMORY_SCOPE_AGENT); }
__device__ __forceinline__ unsigned xb_xcc_id() { return (unsigned)__builtin_amdgcn_s_getreg((3 << 11) | 20) & 0xFu; }
#define XB_SPIN(cond, bar) do { unsigned _sp = 0; while (cond) { __builtin_amdgcn_s_sleep(1); \
    if ((++_sp & 255u) == 0u) { if (xb_ld(&(bar)[XB_TMO])) break; if (_sp > XB_SPIN_CAP) { atomicAdd(&(bar)[XB_TMO], 1u); break; } } } } while (0)

struct XcdBarrier {
    unsigned* bar; unsigned x;
    volatile LAS unsigned* st;
};

__device__ __forceinline__ XcdBarrier xcd_barrier_post(unsigned* bar, volatile LAS unsigned* st) {
    XcdBarrier b; b.bar = bar; b.x = xb_xcc_id(); b.st = st;
    if (threadIdx.x == 0) (void)xb_add(&bar[XB_XCNT(b.x)], 1u);
    return b;
}
__device__ __forceinline__ void xcd_barrier_complete(unsigned* bar, unsigned x, unsigned& nloc, unsigned& nx) {
    const unsigned G = gridDim.x * gridDim.y * gridDim.z;
    unsigned sum, cnt, mine, sp = 0u;
    for (;;) {
        sum = 0u; cnt = 0u; mine = 0u;
#pragma unroll
        for (unsigned j = 0; j < 16; ++j) { const unsigned c = xb_ld(&bar[XB_XCNT(j)]); sum += c; cnt += (c > 0u) ? 1u : 0u; mine = (j == x) ? c : mine; }
        if (sum == G) break;
        __builtin_amdgcn_s_sleep(1);
        if ((++sp & 255u) == 0u) { if (xb_ld(&bar[XB_TMO])) break; if (sp > XB_SPIN_CAP) { atomicAdd(&bar[XB_TMO], 1u); break; } }
    }
    nloc = mine > 0u ? mine : 1u; nx = cnt > 0u ? cnt : 1u;
}

__device__ __forceinline__ void xcd_barrier(const XcdBarrier& b) {
    asm volatile("s_waitcnt vmcnt(0)" ::: "memory");
    __syncthreads();
    if (threadIdx.x == 0) {
        unsigned* bar = b.bar;
        __builtin_amdgcn_s_waitcnt(0);
        unsigned nloc = b.st[0], nx = b.st[1];
        if (nloc == 0u) { xcd_barrier_complete(bar, b.x, nloc, nx); b.st[0] = nloc; b.st[1] = nx; }
        const unsigned old = xb_add(&bar[XB_XSUB(b.x)], 1u);
        const unsigned gen = old / nloc;
        if (old + 1u == (gen + 1u) * nloc) {
            __builtin_amdgcn_fence(__ATOMIC_RELEASE, "agent");
            asm volatile("s_waitcnt vmcnt(0)" ::: "memory");
            const unsigned og = xb_add(&bar[XB_TOP], 1u);
            const unsigned tg = og / nx;
            if (og + 1u == (tg + 1u) * nx) xb_add(&bar[XB_TOPGEN], 1u);
            else XB_SPIN(xb_ld(&bar[XB_TOPGEN]) == tg, bar);
            __builtin_amdgcn_fence(__ATOMIC_ACQUIRE, "agent");
            xb_add(&bar[XB_XGEN(b.x)], 1u);
            asm volatile("s_waitcnt vmcnt(0)" ::: "memory");
        } else {
            XB_SPIN(xb_ld(&bar[XB_XGEN(b.x)]) == gen, bar);
            __builtin_amdgcn_fence(__ATOMIC_ACQUIRE, "agent");
            asm volatile("s_waitcnt vmcnt(0)" ::: "memory");
        }
    }
    __syncthreads();
}

#define G_A_OFF(s)  ((s) * 65536)
#define G_B_OFF(s)  ((s) * 65536 + 32768)
#define G_LDS_BYTES 131072

struct GemmTile {
  const u16* A; int lda;
  const int* aidx;
  int m0, mvalid;
  const float* B0; const float* B1;
  int ldb; int nv0, nv1;
  const float* kscale;
  int K;
};

template <int NB, bool KSCALE, bool GATHER>
__device__ __forceinline__ void gemm_tile_256(const GemmTile& t, char* smem, f32x16 (&acc)[4][4]) {
  int tz0 = threadIdx.x; asm volatile("" : "+v"(tz0));
  const int tid = tz0, lane = tid & 63, wid = tid >> 6, wr = wid >> 1, wc = wid & 1;
  const int l31 = lane & 31, hh = lane >> 5;
#pragma unroll
  for (int i = 0; i < 4; ++i)
#pragma unroll
    for (int j = 0; j < 4; ++j)
#pragma unroll
      for (int r = 0; r < 16; ++r) acc[i][j][r] = 0.f;

  const int a_c = (tid & 7) ^ ((tid >> 4) & 7);
  const u16* a_src[GATHER ? 8 : 1];
  if (GATHER) {
#pragma unroll
    for (int i = 0; i < (GATHER ? 8 : 1); ++i) {
      int r = (tid >> 3) + 32 * i;
      int rr = r < t.mvalid ? r : 0;
      a_src[i] = t.A + (long)t.aidx[rr] * t.lda + a_c * 8;
    }
  } else {
    a_src[0] = t.A + (long)(t.m0 + (tid >> 3)) * t.lda + a_c * 8;
  }
  const long a_step = 32L * t.lda;
  const int b_n4 = tid & 63, b_k = tid >> 6;
  const int b_k_u = __builtin_amdgcn_readfirstlane(b_k);
  const int b_img = b_n4 >> 5, b_ch = (b_n4 >> 1) & 15, b_half = b_n4 & 1;
  const bool b_ok = ((b_n4 & 31) * 4) < (b_img ? t.nv1 : t.nv0);
  const int b_loff = (b_ok ? ((b_img ? (int)(t.B1 - t.B0) : 0) + (b_n4 & 31) * 4) : 0) + b_k * t.ldb;
  f32x4 breg[16];

  const unsigned a_lds0 = (unsigned)(size_t)smem + (unsigned)__builtin_amdgcn_readfirstlane(wid) * 1024u;
  auto issue_a = [&](int kt, int s, int i) {
    glds16_asm((const void*)((GATHER ? a_src[GATHER ? i : 0] : a_src[0] + i * a_step) + kt * 64), a_lds0 + G_A_OFF(s) + i * 4096);
  };
  auto issue_b = [&](int kt, int j) {
    const float* ptr = t.B0 + (long)(kt * 64 + 4 * j) * t.ldb + b_loff;
    asm volatile("global_load_dwordx4 %0, %1, off" : "=v"(breg[j]) : "v"(ptr) : "memory");
  };
  auto write_b = [&](int kt, int s, int j) {
    const int k = b_k + 4 * j;
    f32x4 v = breg[j];
    if (KSCALE) { float sc = t.kscale[kt * 64 + b_k_u + 4 * j]; v *= sc; }
    if (!b_ok) v = (f32x4){0.f, 0.f, 0.f, 0.f};
    u32x2 w = {pack_bf16(v[0], v[1]), pack_bf16(v[2], v[3])};
    *(u32x2*)(smem + G_B_OFF(s) + b_img * 16384 + off_b(k, b_ch) + 8 * b_half) = w;
  };
#define WAITQ(N, g) asm volatile("s_waitcnt vmcnt(" #N ")" : "+v"(breg[4 * (g)]), "+v"(breg[4 * (g) + 1]), "+v"(breg[4 * (g) + 2]), "+v"(breg[4 * (g) + 3]) :: "memory")

  unsigned a_rd[4], b_rd[2][2];
#pragma unroll
  for (int ks = 0; ks < 4; ++ks) { const int row = wr * 128 + l31; a_rd[ks] = row * 128 + (((2 * ks + hh) ^ ((row >> 1) & 7)) * 16); }
#pragma unroll
  for (int tt = 0; tt < 2; ++tt)
#pragma unroll
    for (int nl = 0; nl < 2; ++nl) b_rd[tt][nl] = tr_addr(lane, wc * 2 + nl, 8 * hh + 4 * tt);
  auto load_a = [&](const char* As, int ks, bf16x8 (&af)[4]) {
#pragma unroll
    for (int mb = 0; mb < 4; ++mb) af[mb] = *(const bf16x8*)(As + a_rd[ks] + mb * 4096);
  };
  auto load_b1 = [&](const char* Bs, int ks, int nb, bf16x8& bfr) {
    const char* bi = Bs + (nb >> 1) * 16384 + ks * 4096;
    s16x4 v0 = __builtin_amdgcn_ds_read_tr16_b64_v4i16((LAS3 s16x4*)(bi + b_rd[0][nb & 1]));
    s16x4 v1 = __builtin_amdgcn_ds_read_tr16_b64_v4i16((LAS3 s16x4*)(bi + b_rd[1][nb & 1]));
    bfr = (bf16x8){v0[0], v0[1], v0[2], v0[3], v1[0], v1[1], v1[2], v1[3]};
  };

  auto kstep = [&](int kt, auto mode_tag, bool has1, bool has2) {
    constexpr int MODE = decltype(mode_tag)::value;
    const int s = kt & 1;
    const char* As = smem + G_A_OFF(s);
    const char* Bs = smem + G_B_OFF(s);
    bf16x8 a0[4], a1[4], bq[NB];
    load_a(As, 0, a0);
#pragma unroll
    for (int nb = 0; nb < NB; ++nb) load_b1(Bs, 0, nb, bq[nb]);
    __builtin_amdgcn_sched_barrier(0);
#pragma unroll
    for (int g = 0; g < 4; ++g) {
      bf16x8 (&ac)[4] = (g & 1) ? a1 : a0;
      bf16x8 (&an)[4] = (g & 1) ? a0 : a1;
      if (g < 3) load_a(As, g + 1, an);
      __builtin_amdgcn_sched_barrier(0);
#pragma unroll
      for (int nb = 0; nb < NB; ++nb) {
#pragma unroll
        for (int mb = 0; mb < 4; ++mb)
          acc[mb][nb] = __builtin_amdgcn_mfma_f32_32x32x16_bf16(ac[mb], bq[nb], acc[mb][nb], 0, 0, 0);
        __builtin_amdgcn_sched_barrier(0);
        if (g < 3) load_b1(Bs, g + 1, nb, bq[nb]);
        if (nb == 0 && g < 2 && has1) { issue_a(kt + 1, s ^ 1, 4 * g + 0); issue_a(kt + 1, s ^ 1, 4 * g + 1); }
        if (nb == 1 % NB && g < 2 && has1 && NB > 1) { issue_a(kt + 1, s ^ 1, 4 * g + 2); issue_a(kt + 1, s ^ 1, 4 * g + 3); }
        if (NB == 1 && nb == 0 && g < 2 && has1) { issue_a(kt + 1, s ^ 1, 4 * g + 2); issue_a(kt + 1, s ^ 1, 4 * g + 3); }
        if (nb == NB - 1 && has1) {
          if (MODE == 2) { if (g == 0) WAITQ(20, 0); else if (g == 1) WAITQ(20, 1); else if (g == 2) WAITQ(20, 2); else WAITQ(20, 3); }
          else if (MODE == 1) { if (g == 0) WAITQ(16, 0); else if (g == 1) WAITQ(20, 1); else if (g == 2) WAITQ(20, 2); else WAITQ(20, 3); }
          else { if (g == 0) WAITQ(0, 0); else if (g == 1) WAITQ(0, 1); else if (g == 2) WAITQ(0, 2); else WAITQ(0, 3); }
#pragma unroll
          for (int i = 0; i < 4; ++i) write_b(kt + 1, s ^ 1, 4 * g + i);
          if (has2) {
#pragma unroll
            for (int i = 0; i < 4; ++i) issue_b(kt + 2, 4 * g + i);
          }
        }
        __builtin_amdgcn_sched_barrier(0);
      }
    }
    if (has1) {
      if (MODE == 0) asm volatile("s_waitcnt vmcnt(0)" ::: "memory");
      else asm volatile("s_waitcnt vmcnt(12)" ::: "memory");
      __syncthreads();
    }
  };

  const int nk = t.K >> 6;
  __syncthreads();
#pragma unroll
  for (int j = 0; j < 16; ++j) issue_b(0, j);
#pragma unroll
  for (int i = 0; i < 8; ++i) issue_a(0, 0, i);
  WAITQ(8, 0); WAITQ(8, 1); WAITQ(8, 2); WAITQ(8, 3);
#pragma unroll
  for (int j = 0; j < 16; ++j) write_b(0, 0, j);
#pragma unroll
  for (int j = 0; j < 16; ++j) issue_b(1, j);
  asm volatile("s_waitcnt vmcnt(16)" ::: "memory");
  __syncthreads();
  kstep(0, std::integral_constant<int, 1>{}, true, true);
  for (int kt = 1; kt < nk - 2; ++kt) kstep(kt, std::integral_constant<int, 2>{}, true, true);
  kstep(nk - 2, std::integral_constant<int, 0>{}, true, false);
  kstep(nk - 1, std::integral_constant<int, 0>{}, false, false);
#undef WAITQ
}
template <int NB, class F>
__device__ __forceinline__ void acc_foreach_row(f32x16 (&acc)[4][4], F f) {
  int tz = threadIdx.x; asm volatile("" : "+v"(tz));
  const int lane = tz & 63, wid = tz >> 6, wr = wid >> 1, wc = wid & 1;
  const int l31 = lane & 31, hh = lane >> 5;
#pragma unroll
  for (int mb = 0; mb < 4; ++mb)
#pragma unroll
    for (int reg = 0; reg < 16; ++reg) {
      const int rowl = wr * 128 + mb * 32 + (reg & 3) + 8 * (reg >> 2) + 4 * hh;
      float v[NB];
#pragma unroll
      for (int nb = 0; nb < NB; ++nb) v[nb] = acc[mb][nb][reg];
      f(rowl, wc * 64 + l31, v);
      asm volatile("" ::: "memory");
    }
}
__device__ __forceinline__ void ph_prep0(const Params& p) {
  const int tid_ = opaque_tid(); const int lane = tid_ & 63, wid = tid_ >> 6;
  if (blockIdx.x == 0 && tid_ < 64) p.counts()[tid_] = 0;
  for (int t = blockIdx.x * 4 + wid; t < T_; t += gridDim.x * 4) {
    const float* xr = p.x + (long)t * 2048;
    f32x4 v[8]; float ss = 0.f;
#pragma unroll
    for (int j = 0; j < 8; ++j) { v[j] = __builtin_nontemporal_load((const f32x4*)(xr + j * 256 + lane * 4)); ss += v[j][0] * v[j][0] + v[j][1] * v[j][1] + v[j][2] * v[j][2] + v[j][3] * v[j][3]; }
    ss = wave_sum(ss);
    const float r = rsqrtf(ss * (1.0f / 2048.0f) + EPS_);
#pragma unroll
    for (int j = 0; j < 8; ++j) {
      f32x4 g = *(const f32x4*)(p.attn_norm + j * 256 + lane * 4);
      u32x2 w = {pack_bf16(v[j][0] * r * g[0], v[j][1] * r * g[1]), pack_bf16(v[j][2] * r * g[2], v[j][3] * r * g[3])};
      *(u32x2*)(p.h1() + (long)t * 2048 + j * 256 + lane * 4) = w;
    }
    if (lane < 32) {
      float inv = 1.0f / powf(10000.0f, (float)(2 * lane) / 64.0f);
      float ang = (float)p.pos[t] * inv;
      double a = (double)ang;
      double k = rint(a * 0.15915494309189535);
      float rf = (float)fma(-k, 6.283185307179586, a);
      p.cs()[t * 32 + lane] = make_float2(__cosf(rf), __sinf(rf));
    }
  }
}

template <int NB>
__device__ __forceinline__ void win_tile(const Params& p, char* smem, int mt, int nt) {
  f32x16 acc[4][4];
  GemmTile t{};
  t.A = p.h1(); t.lda = 2048; t.aidx = nullptr; t.m0 = mt * 256; t.mvalid = 256;
  t.B0 = p.w_in + nt * 256; t.B1 = t.B0 + 128; t.ldb = NC_;
  const int rem = NC_ - nt * 256;
  t.nv0 = rem >= 128 ? 128 : rem; t.nv1 = rem >= 256 ? 128 : (rem > 128 ? rem - 128 : 0);
  t.kscale = nullptr; t.K = 2048;
  gemm_tile_256<NB, false, false>(t, smem, acc);
  u16* base = p.proj() + (long)(mt * 256) * NC_ + nt * 256;
  const int nv0 = t.nv0, nv1 = t.nv1;
  acc_foreach_row<NB>(acc, [&](int rowl, int coll, float (&v)[NB]) {
    u16* rp = base + (long)rowl * NC_ + coll;
    OPAQUE(rp);
#pragma unroll
    for (int nb = 0; nb < NB; ++nb) {
      const int c = (nb & 1) * 32 + coll;
      const int lim = (nb >> 1) ? nv1 : nv0;
      if (c < lim) rp[(nb >> 1) * 128 + (nb & 1) * 32] = f32_to_bf16(v[nb]);
    }
  });
}
__device__ __forceinline__ void ph_win(const Params& p, char* smem) {
  const int x = blockIdx.x & 7, slot = blockIdx.x >> 3;
  for (int j = slot; j < 64; j += 32) win_tile<4>(p, smem, 4 * x + (j & 3), j >> 2);
  if (slot < 4) win_tile<2>(p, smem, 4 * x + slot, 16);
}

__device__ __forceinline__ void ph_prep1(const Params& p, char* smem) {
  float* gds = (float*)smem;
  float* cums = (float*)(smem + 4096);
  const int tid = opaque_tid(), lane = tid & 63, wid = tid >> 6;
  for (int u = blockIdx.x; u < 512; u += gridDim.x) {
    const int ch = u >> 2, h = u & 3; const int t0 = ch * 64;
    __syncthreads();
    {
      const int tl = tid >> 2, r4 = (tid & 3) * 4;
      u32x2 w = *(const u32x2*)(p.proj() + (long)(t0 + tl) * NC_ + C_GD + r4);
      gds[tl * 16 + r4 + 0] = bf_lo(w[0]); gds[tl * 16 + r4 + 1] = bf_hi(w[0]);
      gds[tl * 16 + r4 + 2] = bf_lo(w[1]); gds[tl * 16 + r4 + 3] = bf_hi(w[1]);
    }
    const int c = tid & 127, half = tid >> 7;
    float gu[16];
#pragma unroll
    for (int r = 0; r < 16; ++r) gu[r] = p.gate_up[r * 512 + h * 128 + c];
    const float bias = p.gate_bias[h * 128 + c];
    __syncthreads();
    float run = 0.f;
    for (int i = 0; i < 32; ++i) {
      const int tl = half * 32 + i;
      float z = bias;
#pragma unroll
      for (int r = 0; r < 16; ++r) z = fmaf(gds[tl * 16 + r], gu[r], z);
      const float ls = fminf(z, 0.f) - log1pf(__expf(-fabsf(z)));
      run += ls * (1.0f / 16.0f);
      cums[tl * 128 + c] = run;
    }
    __syncthreads();
    {
      const float add = cums[31 * 128 + c];
      for (int i = 0; i < 32; ++i) {
        const int tl = half * 32 + i;
        float v = cums[tl * 128 + c] + (half ? add : 0.f);
        p.bcum()[(long)(t0 + tl) * 512 + h * 128 + c] = v;
      }
    }
    for (int i = 0; i < 4; ++i) {
      const long t = t0 + h * 16 + wid * 4 + i;
      const u16* pr = p.proj() + t * NC_;
      u32x4 a = *(const u32x4*)(pr + C_MQ + lane * 8);
      u32x4 b = *(const u32x4*)(pr + C_MKV + lane * 8);
      float sa = 0.f, sb = 0.f;
#pragma unroll
      for (int k = 0; k < 4; ++k) { float l = bf_lo(a[k]), hgh = bf_hi(a[k]); sa += l * l + hgh * hgh; l = bf_lo(b[k]); hgh = bf_hi(b[k]); sb += l * l + hgh * hgh; }
      sa = wave_sum(sa); sb = wave_sum(sb);
      if (lane == 0) { p.rq()[t] = rsqrtf(sa * (1.0f / 512.0f) + EPS_); p.rkv()[t] = rsqrtf(sb * (1.0f / 512.0f) + EPS_); }
      if (lane < 32) {
        const float t1 = bf16_to_f32(pr[C_MKR + lane]), t2 = bf16_to_f32(pr[C_MKR + lane + 32]);
        const float2 cs = p.cs()[t * 32 + lane];
        p.kpe()[t * 64 + lane] = f32_to_bf16(t1 * cs.x - t2 * cs.y);
        p.kpe()[t * 64 + lane + 32] = f32_to_bf16(t1 * cs.y + t2 * cs.x);
      }
    }
  }
}

#define QSCALE_ (0.07216878364870322f * 1.4426950408889634f)
__device__ __forceinline__ void upq_tile(const Params& p, char* smem, int mt, int nt) {
  f32x16 acc[4][4];
  GemmTile t{};
  t.A = p.proj() + C_MQ; t.lda = NC_; t.aidx = nullptr; t.m0 = mt * 256; t.mvalid = 256;
  t.B0 = p.w_uq + nt * 256; t.B1 = t.B0 + 128; t.ldb = 1536; t.nv0 = 128; t.nv1 = 128; t.kscale = p.q_norm; t.K = 512;
  gemm_tile_256<4, true, false>(t, smem, acc);
  u16* base = p.q() + (long)(mt * 256) * 1536 + nt * 256;
  const float* rq = p.rq() + mt * 256;
  acc_foreach_row<4>(acc, [&](int rowl, int coll, float (&v)[4]) {
    u16* rp = base + (long)rowl * 1536 + coll;
    OPAQUE(rp);
    const float s = rq[rowl] * QSCALE_;
#pragma unroll
    for (int nb = 0; nb < 4; ++nb) rp[(nb >> 1) * 128 + (nb & 1) * 32] = f32_to_bf16(v[nb] * s);
  });
}
__device__ __forceinline__ void upkv_tile(const Params& p, char* smem, int mt, int nt) {
  f32x16 acc[4][4];
  GemmTile t{};
  t.A = p.proj() + C_MKV; t.lda = NC_; t.aidx = nullptr; t.m0 = mt * 256; t.mvalid = 256;
  t.B0 = p.w_ukv + nt * 256; t.B1 = t.B0 + 128; t.ldb = 2048; t.nv0 = 128; t.nv1 = 128; t.kscale = p.kv_norm; t.K = 512;
  gemm_tile_256<4, true, false>(t, smem, acc);
  u16* base = p.kv() + (long)(mt * 256) * 2048 + nt * 256;
  const float* rk = p.rkv() + mt * 256;
  acc_foreach_row<4>(acc, [&](int rowl, int coll, float (&v)[4]) {
    u16* rp = base + (long)rowl * 2048 + coll;
    OPAQUE(rp);
    const float s = rk[rowl];
#pragma unroll
    for (int nb = 0; nb < 4; ++nb) rp[(nb >> 1) * 128 + (nb & 1) * 32] = f32_to_bf16(v[nb] * s);
  });
}
#define AT_KSTRIDE 400
#define AT_KBYTES  (64 * AT_KSTRIDE)
#define AT_STAGE   (AT_KBYTES + 16384)
#define AT_LDS_BYTES (2 * AT_STAGE)

__device__ __forceinline__ void attn_unit(const Params& p, char* smem, int b, int h, int qb) {
  const int tid = opaque_tid(), lane = tid & 63, wid = tid >> 6, l31 = lane & 31, hh = lane >> 5;
  const long tq = (long)b * SEQ_ + qb * 128 + wid * 32 + l31;
  bf16x8 qf[12];
  {
    const u16* qp = p.q() + (tq * 8 + h) * 192 + 8 * hh;
#pragma unroll
    for (int ks = 0; ks < 12; ++ks) qf[ks] = *(const bf16x8*)(qp + 16 * ks);
#pragma unroll
    for (int s = 0; s < 2; ++s) {
      const float2* cp = p.cs() + tq * 32 + 16 * s + 8 * hh;
      bf16x8 lo = qf[8 + s], hi = qf[10 + s], nlo, nhi;
#pragma unroll
      for (int j = 0; j < 8; j += 2) {
        float2 c0 = cp[j], c1 = cp[j + 1];
        float a0 = bf16_to_f32((u16)lo[j]), a1 = bf16_to_f32((u16)lo[j + 1]);
        float b0 = bf16_to_f32((u16)hi[j]), b1 = bf16_to_f32((u16)hi[j + 1]);
        unsigned wl = pack_bf16(a0 * c0.x - b0 * c0.y, a1 * c1.x - b1 * c1.y);
        unsigned wh = pack_bf16(a0 * c0.y + b0 * c0.x, a1 * c1.y + b1 * c1.x);
        nlo[j] = (short)(wl & 0xffff); nlo[j + 1] = (short)(wl >> 16);
        nhi[j] = (short)(wh & 0xffff); nhi[j + 1] = (short)(wh >> 16);
      }
      qf[8 + s] = nlo; qf[10 + s] = nhi;
    }
  }
  u32x4 kregA[6], vregA[4], kregB[6], vregB[4];
  const long tk0 = (long)b * SEQ_;
  auto load_tile = [&](int kt, u32x4 (&kreg)[6], u32x4 (&vreg)[4]) {
    const long tb = tk0 + kt * 64;
#pragma unroll
    for (int i = 0; i < 4; ++i) {
      const int pp = i * 256 + tid; const int key = pp >> 4, c = pp & 15;
      const u16* rowp = p.kv() + ((tb + key) * 8 + h) * 256 + c * 8;
      kreg[i] = *(const u32x4*)rowp;
      vreg[i] = *(const u32x4*)(rowp + 128);
    }
#pragma unroll
    for (int i = 0; i < 2; ++i) {
      const int pp = i * 256 + tid; const int key = pp >> 3, c = pp & 7;
      kreg[4 + i] = *(const u32x4*)(p.kpe() + (tb + key) * 64 + c * 8);
    }
  };
  auto store_tile = [&](int s, u32x4 (&kreg)[6], u32x4 (&vreg)[4]) {
    char* Ks = smem + s * AT_STAGE; char* Vs = Ks + AT_KBYTES;
#pragma unroll
    for (int i = 0; i < 4; ++i) {
      const int pp = i * 256 + tid; const int key = pp >> 4, c = pp & 15;
      *(u32x4*)(Ks + key * AT_KSTRIDE + c * 16) = kreg[i];
      *(u32x4*)(Vs + off_b(key, c)) = vreg[i];
    }
#pragma unroll
    for (int i = 0; i < 2; ++i) {
      const int pp = i * 256 + tid; const int key = pp >> 3, c = pp & 7;
      *(u32x4*)(Ks + key * AT_KSTRIDE + (16 + c) * 16) = kreg[4 + i];
    }
  };

  f32x16 o[4];
#pragma unroll
  for (int c = 0; c < 4; ++c)
#pragma unroll
    for (int r = 0; r < 16; ++r) o[c][r] = 0.f;
  float m = -1e30f, l = 0.f;
  const int nt = 2 * qb + 2;
  const int qpos = qb * 128 + wid * 32 + l31;

  __syncthreads();
  load_tile(0, kregA, vregA);
  store_tile(0, kregA, vregA);
  load_tile(1, kregB, vregB);
  if (nt > 2) load_tile(2, kregA, vregA);
  __syncthreads();
  auto tile_body = [&](int kt, int s) {
    const char* Ks = smem + s * AT_STAGE; const char* Vs = Ks + AT_KBYTES;
    const bool active = (kt * 64) <= (qb * 128 + wid * 32 + 31);
    if (active) {
      f32x16 sc[2];
#pragma unroll
      for (int kb = 0; kb < 2; ++kb) {
#pragma unroll
        for (int r = 0; r < 16; ++r) sc[kb][r] = 0.f;
#pragma unroll
        for (int ks = 0; ks < 12; ++ks) {
          bf16x8 a = *(const bf16x8*)(Ks + (kb * 32 + l31) * AT_KSTRIDE + (2 * ks + hh) * 16);
          sc[kb] = __builtin_amdgcn_mfma_f32_32x32x16_bf16(a, qf[ks], sc[kb], 0, 0, 0);
        }
      }
      if (kt >= 2 * qb) {
#pragma unroll
        for (int kb = 0; kb < 2; ++kb)
#pragma unroll
          for (int r = 0; r < 16; ++r) {
            const int key = kt * 64 + kb * 32 + (r & 3) + 8 * (r >> 2) + 4 * hh;
            if (key > qpos) sc[kb][r] = -1e30f;
          }
      }
      float mx = sc[0][0];
#pragma unroll
      for (int kb = 0; kb < 2; ++kb)
#pragma unroll
        for (int r = 0; r < 16; ++r) mx = fmaxf(mx, sc[kb][r]);
      mx = fmaxf(mx, shflx(mx, 32));
      const float mn = fmaxf(m, mx);
      const float alpha = __builtin_amdgcn_exp2f(m - mn);
      m = mn;
      float ps = 0.f;
      bf16x8 pf[4];
#pragma unroll
      for (int kb = 0; kb < 2; ++kb)
#pragma unroll
        for (int s2 = 0; s2 < 2; ++s2) {
          float e[8];
#pragma unroll
          for (int j = 0; j < 8; ++j) { e[j] = __builtin_amdgcn_exp2f(sc[kb][8 * s2 + j] - mn); ps += e[j]; }
          unsigned w0 = pack_bf16(e[0], e[1]), w1 = pack_bf16(e[2], e[3]), w2 = pack_bf16(e[4], e[5]), w3 = pack_bf16(e[6], e[7]);
          u32x4 w = {w0, w1, w2, w3};
          pf[kb * 2 + s2] = *(bf16x8*)&w;
        }
      l = l * alpha + ps;
#pragma unroll
      for (int c = 0; c < 4; ++c)
#pragma unroll
        for (int r = 0; r < 16; ++r) o[c][r] *= alpha;
#pragma unroll
      for (int c = 0; c < 4; ++c)
#pragma unroll
        for (int kk = 0; kk < 4; ++kk) {
          const unsigned rbase = 32 * (kk >> 1) + 16 * (kk & 1) + 4 * hh;
          bf16x8 a = tr_frag(Vs, lane, c, rbase, rbase + 8);
          o[c] = __builtin_amdgcn_mfma_f32_32x32x16_bf16(a, pf[kk], o[c], 0, 0, 0);
        }
    }
  };
  for (int kt = 0; kt < nt; kt += 2) {
    tile_body(kt, 0);
    store_tile(1, kregB, vregB);
    if (kt + 3 < nt) load_tile(kt + 3, kregB, vregB);
    __syncthreads();
    tile_body(kt + 1, 1);
    if (kt + 2 < nt) {
      store_tile(0, kregA, vregA);
      if (kt + 4 < nt) load_tile(kt + 4, kregA, vregA);
      __syncthreads();
    }
  }
  l = l + shflx(l, 32);
  const float inv = 1.0f / l;
  u16* op = p.omla() + tq * 1024 + h * 128 + 4 * hh;
#pragma unroll
  for (int c = 0; c < 4; ++c)
#pragma unroll
    for (int rg = 0; rg < 4; ++rg) {
      u32x2 w = {pack_bf16(o[c][4 * rg] * inv, o[c][4 * rg + 1] * inv), pack_bf16(o[c][4 * rg + 2] * inv, o[c][4 * rg + 3] * inv)};
      *(u32x2*)(op + 32 * c + 8 * rg) = w;
    }
}

#define G1_LDS_BYTES 49152
__device__ __forceinline__ void gla_g1_unit(const Params& p, char* smem, int u) {
  const int tid = opaque_tid(), lane = tid & 63, wid = tid >> 6, l31 = lane & 31, hh = lane >> 5;
  const int bh = u >> 6, n = u & 63, b = bh >> 2, h = bh & 3;
  const long t0 = (long)b * SEQ_ + n * 64;
  char* Ks = smem; char* Vs = smem + 16384;
  __syncthreads();
  {
    const int ch = tid & 15;
    const float* bl = p.bcum() + (t0 + 63) * 512 + h * 128 + ch * 8;
    f32x4 bl0 = *(const f32x4*)bl, bl1 = *(const f32x4*)(bl + 4);
    if (tid < 128) p.dec()[(long)u * 128 + tid] = __expf(p.bcum()[(t0 + 63) * 512 + h * 128 + tid]);
#pragma unroll
    for (int i = 0; i < 4; ++i) {
      const int tok = (i * 256 + tid) >> 4;
      u32x4 kw = *(const u32x4*)(p.proj() + (t0 + tok) * NC_ + C_GK + h * 128 + ch * 8);
      const float* bp = p.bcum() + (t0 + tok) * 512 + h * 128 + ch * 8;
      f32x4 b0 = *(const f32x4*)bp, b1 = *(const f32x4*)(bp + 4);
      u32x4 w;
      w[0] = pack_bf16(bf_lo(kw[0]) * __expf(bl0[0] - b0[0]), bf_hi(kw[0]) * __expf(bl0[1] - b0[1]));
      w[1] = pack_bf16(bf_lo(kw[1]) * __expf(bl0[2] - b0[2]), bf_hi(kw[1]) * __expf(bl0[3] - b0[3]));
      w[2] = pack_bf16(bf_lo(kw[2]) * __expf(bl1[0] - b1[0]), bf_hi(kw[2]) * __expf(bl1[1] - b1[1]));
      w[3] = pack_bf16(bf_lo(kw[3]) * __expf(bl1[2] - b1[2]), bf_hi(kw[3]) * __expf(bl1[3] - b1[3]));
      *(u32x4*)(Ks + off_b(tok, ch)) = w;
    }
#pragma unroll
    for (int i = 0; i < 8; ++i) {
      const int pp = i * 256 + tid; const int tok = pp >> 5, c32 = pp & 31;
      u32x4 vw = *(const u32x4*)(p.proj() + (t0 + tok) * NC_ + C_GV + h * 256 + c32 * 8);
      *(u32x4*)(Vs + (c32 >> 4) * 16384 + off_b(tok, c32 & 15)) = vw;
    }
  }
  __syncthreads();
  f32x16 acc[4][2];
#pragma unroll
  for (int mb = 0; mb < 4; ++mb)
#pragma unroll
    for (int nb = 0; nb < 2; ++nb)
#pragma unroll
      for (int r = 0; r < 16; ++r) acc[mb][nb][r] = 0.f;
  const char* Vimg = Vs + (wid >> 1) * 16384;
#pragma unroll
  for (int ks = 0; ks < 4; ++ks) {
    bf16x8 af[4], bfr[2];
    const unsigned r0 = 16 * ks + 8 * hh;
#pragma unroll
    for (int mb = 0; mb < 4; ++mb) af[mb] = tr_frag(Ks, lane, mb, r0, r0 + 4);
#pragma unroll
    for (int nb = 0; nb < 2; ++nb) bfr[nb] = tr_frag(Vimg, lane, 2 * (wid & 1) + nb, r0, r0 + 4);
#pragma unroll
    for (int mb = 0; mb < 4; ++mb)
#pragma unroll
      for (int nb = 0; nb < 2; ++nb) acc[mb][nb] = __builtin_amdgcn_mfma_f32_32x32x16_bf16(af[mb], bfr[nb], acc[mb][nb], 0, 0, 0);
  }
  __syncthreads();
  {
    char* st = smem + wid * 16384;
#pragma unroll
    for (int mb = 0; mb < 4; ++mb)
#pragma unroll
      for (int r = 0; r < 16; ++r) {
        const int dk = mb * 32 + (r & 3) + 8 * (r >> 2) + 4 * hh;
        *(u16*)(st + dk * 128 + l31 * 2) = f32_to_bf16(acc[mb][0][r]);
        *(u16*)(st + dk * 128 + (32 + l31) * 2) = f32_to_bf16(acc[mb][1][r]);
      }
    u16* gb = p.kvc() + (long)u * 32768 + wid * 64;
#pragma unroll 4
    for (int it = 0; it < 16; ++it) {
      const int dk = it * 8 + (lane >> 3), ch = lane & 7;
      *(u32x4*)(gb + dk * 256 + ch * 8) = *(const u32x4*)(st + dk * 128 + ch * 16);
    }
  }
}

__device__ __forceinline__ void gla_g2_unit(const Params& p, int u) {
  const int tid = opaque_tid();
  const int bh = u >> 5, part = u & 31;
  const int dk = part * 4 + (tid >> 6), dv = (tid & 63) * 4;
  float s0 = 0.f, s1 = 0.f, s2 = 0.f, s3 = 0.f;
  const long ebase = (long)dk * 256 + dv;
#pragma unroll 8
  for (int n = 0; n < 64; ++n) {
    const long un = (long)(bh * 64 + n);
    u32x2 kw = *(const u32x2*)(p.kvc() + un * 32768 + ebase);
    const float d = p.dec()[un * 128 + dk];
    u32x2 w = {pack_bf16(s0, s1), pack_bf16(s2, s3)};
    *(u32x2*)(p.sprev() + un * 32768 + ebase) = w;
    s0 = fmaf(d, s0, bf_lo(kw[0])); s1 = fmaf(d, s1, bf_hi(kw[0]));
    s2 = fmaf(d, s2, bf_lo(kw[1])); s3 = fmaf(d, s3, bf_hi(kw[1]));
  }
}

#define G3_LDS_BYTES (16384 + 16384 + 32768 + 65536 + 1024)
__device__ __forceinline__ void gla_g3_unit(const Params& p, char* smem, int u) {
  const int tid = opaque_tid(), lane = tid & 63, wid = tid >> 6, l31 = lane & 31, hh = lane >> 5;
  const int bh = u >> 6, n = u & 63, b = bh >> 2, h = bh & 3;
  const long t0 = (long)b * SEQ_ + n * 64;
  char* Qd = smem; char* Ki = smem + 16384; char* Vs = smem + 32768; char* Sp = smem + 65536; float* red = (float*)(smem + 131072);
  __syncthreads();
  {
    const int ch = tid & 15;
    const float qs = 0.08838834764831845f;
#pragma unroll
    for (int i = 0; i < 4; ++i) {
      const int tok = (i * 256 + tid) >> 4;
      const u16* pr = p.proj() + (t0 + tok) * NC_ + h * 128 + ch * 8;
      u32x4 qw = *(const u32x4*)(pr + C_GQ), kw = *(const u32x4*)(pr + C_GK);
      const float* bp = p.bcum() + (t0 + tok) * 512 + h * 128 + ch * 8;
      f32x4 b0 = *(const f32x4*)bp, b1 = *(const f32x4*)(bp + 4);
      float e[8] = {__expf(b0[0]), __expf(b0[1]), __expf(b0[2]), __expf(b0[3]), __expf(b1[0]), __expf(b1[1]), __expf(b1[2]), __expf(b1[3])};
      u32x4 wq, wk;
#pragma unroll
      for (int k = 0; k < 4; ++k) {
        wq[k] = pack_bf16(bf_lo(qw[k]) * qs * e[2 * k], bf_hi(qw[k]) * qs * e[2 * k + 1]);
        wk[k] = pack_bf16(bf_lo(kw[k]) / e[2 * k], bf_hi(kw[k]) / e[2 * k + 1]);
      }
      *(u32x4*)(Qd + off_b(tok, ch)) = wq;
      *(u32x4*)(Ki + off_b(tok, ch)) = wk;
    }
#pragma unroll
    for (int i = 0; i < 8; ++i) {
      const int pp = i * 256 + tid; const int tok = pp >> 5, c32 = pp & 31;
      u32x4 vw = *(const u32x4*)(p.proj() + (t0 + tok) * NC_ + C_GV + h * 256 + c32 * 8);
      *(u32x4*)(Vs + (c32 >> 4) * 16384 + off_b(tok, c32 & 15)) = vw;
    }
#pragma unroll
    for (int i = 0; i < 16; ++i) {
      const int pp = i * 256 + tid; const int dk = pp >> 5, c32 = pp & 31;
      u32x4 sw = *(const u32x4*)(p.sprev() + (long)u * 32768 + dk * 256 + c32 * 8);
      *(u32x4*)(Sp + (c32 >> 4) * 32768 + off_b(dk, c32 & 15)) = sw;
    }
  }
  __syncthreads();
  const int ib = wid & 1, dvh = wid >> 1;
  f32x16 sc[2];
#pragma unroll
  for (int jb = 0; jb < 2; ++jb) {
#pragma unroll
    for (int r = 0; r < 16; ++r) sc[jb][r] = 0.f;
    if (jb <= ib) {
#pragma unroll
      for (int ks = 0; ks < 8; ++ks) {
        bf16x8 a = *(const bf16x8*)(Ki + off_b(jb * 32 + l31, 2 * ks + hh));
        bf16x8 bq = *(const bf16x8*)(Qd + off_b(ib * 32 + l31, 2 * ks + hh));
        sc[jb] = __builtin_amdgcn_mfma_f32_32x32x16_bf16(a, bq, sc[jb], 0, 0, 0);
      }
#pragma unroll
      for (int r = 0; r < 16; ++r) {
        const int j = jb * 32 + (r & 3) + 8 * (r >> 2) + 4 * hh, i = ib * 32 + l31;
        if (j > i) sc[jb][r] = 0.f;
      }
    }
  }
  bf16x8 pf[4];
#pragma unroll
  for (int jb = 0; jb < 2; ++jb)
#pragma unroll
    for (int s2 = 0; s2 < 2; ++s2) {
      u32x4 w = {pack_bf16(sc[jb][8 * s2 + 0], sc[jb][8 * s2 + 1]), pack_bf16(sc[jb][8 * s2 + 2], sc[jb][8 * s2 + 3]),
                 pack_bf16(sc[jb][8 * s2 + 4], sc[jb][8 * s2 + 5]), pack_bf16(sc[jb][8 * s2 + 6], sc[jb][8 * s2 + 7])};
      pf[jb * 2 + s2] = *(bf16x8*)&w;
    }
  f32x16 o[4];
#pragma unroll
  for (int c = 0; c < 4; ++c)
#pragma unroll
    for (int r = 0; r < 16; ++r) o[c][r] = 0.f;
  const char* Vimg = Vs + dvh * 16384;
  const char* Simg = Sp + dvh * 32768;
#pragma unroll
  for (int c = 0; c < 4; ++c) {
#pragma unroll
    for (int kk = 0; kk < 4; ++kk) {
      if ((kk >> 1) <= ib) {
        const unsigned rbase = 32 * (kk >> 1) + 16 * (kk & 1) + 4 * hh;
        bf16x8 a = tr_frag(Vimg, lane, c, rbase, rbase + 8);
        o[c] = __builtin_amdgcn_mfma_f32_32x32x16_bf16(a, pf[kk], o[c], 0, 0, 0);
      }
    }
#pragma unroll
    for (int ks = 0; ks < 8; ++ks) {
      const unsigned r0 = 16 * ks + 8 * hh;
      bf16x8 a = tr_frag(Simg, lane, c, r0, r0 + 4);
      bf16x8 bq = *(const bf16x8*)(Qd + off_b(ib * 32 + l31, 2 * ks + hh));
      o[c] = __builtin_amdgcn_mfma_f32_32x32x16_bf16(a, bq, o[c], 0, 0, 0);
    }
  }
  float ss = 0.f;
#pragma unroll
  for (int c = 0; c < 4; ++c)
#pragma unroll
    for (int r = 0; r < 16; ++r) ss += o[c][r] * o[c][r];
  ss += shflx(ss, 32);
  if (hh == 0) red[dvh * 64 + ib * 32 + l31] = ss;
  __syncthreads();
  const float tot = red[ib * 32 + l31] + red[64 + ib * 32 + l31];
  const float rn = rsqrtf(tot * (1.0f / 256.0f) + EPS_);
  const long t = t0 + ib * 32 + l31;
  const u16* grp = p.proj() + t * NC_ + C_GR + h * 256 + dvh * 128 + 4 * hh;
  u16* op = p.mix() + t * 2048 + h * 256 + dvh * 128 + 4 * hh;
  const float* gp = p.gla_out_norm + dvh * 128 + 4 * hh;
#pragma unroll
  for (int c = 0; c < 4; ++c)
#pragma unroll
    for (int rg = 0; rg < 4; ++rg) {
      u32x2 gw = *(const u32x2*)(grp + 32 * c + 8 * rg);
      f32x4 g = *(const f32x4*)(gp + 32 * c + 8 * rg);
      float gr[4] = {bf_lo(gw[0]), bf_hi(gw[0]), bf_lo(gw[1]), bf_hi(gw[1])};
      float ov[4];
#pragma unroll
      for (int k = 0; k < 4; ++k) { float si = gr[k] / (1.0f + __expf(-gr[k])); ov[k] = o[c][4 * rg + k] * rn * g[k] * si; }
#if WOUTQ
      {
        int q8 = 0;
        q8 = __builtin_amdgcn_cvt_pk_fp8_f32(ov[0], ov[1], q8, false);
        q8 = __builtin_amdgcn_cvt_pk_fp8_f32(ov[2], ov[3], q8, true);
        const int col = h * 256 + dvh * 128 + 4 * hh + 32 * c + 8 * rg;
        *(unsigned*)(p.mixq() + (t >> 1) * 4096 + (col >> 6) * 128 + (t & 1) * 64 + (col & 63)) = (unsigned)q8;
      }
#else
      u32x2 w = {pack_bf16(ov[0], ov[1]), pack_bf16(ov[2], ov[3])};
      *(u32x2*)(op + 32 * c + 8 * rg) = w;
#endif
    }
}

__device__ __forceinline__ void mla_norm_tokens(const Params& p) {
  const int tid_ = opaque_tid(); const int lane = tid_ & 63, wid = tid_ >> 6;
  for (int t = blockIdx.x * 4 + wid; t < T_; t += gridDim.x * 4) {
    const u16* src = p.omla() + (long)t * 1024;
    u32x4 a = *(const u32x4*)(src + lane * 8), b = *(const u32x4*)(src + 512 + lane * 8);
    float ss = 0.f;
#pragma unroll
    for (int k = 0; k < 4; ++k) { float x0 = bf_lo(a[k]), x1 = bf_hi(a[k]), y0 = bf_lo(b[k]), y1 = bf_hi(b[k]); ss += x0 * x0 + x1 * x1 + y0 * y0 + y1 * y1; }
    ss = wave_sum(ss);
    const float r = rsqrtf(ss * (1.0f / 1024.0f) + EPS_);
    const float* g = p.mla_out_norm;
    u32x4 wa, wb;
#pragma unroll
    for (int k = 0; k < 4; ++k) {
      wa[k] = pack_bf16(bf_lo(a[k]) * r * g[lane * 8 + 2 * k], bf_hi(a[k]) * r * g[lane * 8 + 2 * k + 1]);
      wb[k] = pack_bf16(bf_lo(b[k]) * r * g[512 + lane * 8 + 2 * k], bf_hi(b[k]) * r * g[512 + lane * 8 + 2 * k + 1]);
    }
#if WOUTQ
    {
      int qa0 = 0, qa1 = 0, qb0 = 0, qb1 = 0;
      qa0 = __builtin_amdgcn_cvt_pk_fp8_f32(bf_lo(wa[0]), bf_hi(wa[0]), qa0, false); qa0 = __builtin_amdgcn_cvt_pk_fp8_f32(bf_lo(wa[1]), bf_hi(wa[1]), qa0, true);
      qa1 = __builtin_amdgcn_cvt_pk_fp8_f32(bf_lo(wa[2]), bf_hi(wa[2]), qa1, false); qa1 = __builtin_amdgcn_cvt_pk_fp8_f32(bf_lo(wa[3]), bf_hi(wa[3]), qa1, true);
      qb0 = __builtin_amdgcn_cvt_pk_fp8_f32(bf_lo(wb[0]), bf_hi(wb[0]), qb0, false); qb0 = __builtin_amdgcn_cvt_pk_fp8_f32(bf_lo(wb[1]), bf_hi(wb[1]), qb0, true);
      qb1 = __builtin_amdgcn_cvt_pk_fp8_f32(bf_lo(wb[2]), bf_hi(wb[2]), qb1, false); qb1 = __builtin_amdgcn_cvt_pk_fp8_f32(bf_lo(wb[3]), bf_hi(wb[3]), qb1, true);
      const int ca = 1024 + lane * 8, cb = 1536 + lane * 8;
      const long tt = t;
      u32x2 va = {(unsigned)qa0, (unsigned)qa1}, vb = {(unsigned)qb0, (unsigned)qb1};
      *(u32x2*)(p.mixq() + (tt >> 1) * 4096 + (ca >> 6) * 128 + (tt & 1) * 64 + (ca & 63)) = va;
      *(u32x2*)(p.mixq() + (tt >> 1) * 4096 + (cb >> 6) * 128 + (tt & 1) * 64 + (cb & 63)) = vb;
    }
#else
    *(u32x4*)(p.mix() + (long)t * 2048 + 1024 + lane * 8) = wa;
    *(u32x4*)(p.mix() + (long)t * 2048 + 1024 + 512 + lane * 8) = wb;
#endif
  }
}
__device__ __forceinline__ void wout_tile(const Params& p, char* smem, int mt, int nt) {
  f32x16 acc[4][4];
  GemmTile t{};
  t.A = p.mix(); t.lda = 2048; t.aidx = nullptr; t.m0 = mt * 256; t.mvalid = 256;
  t.B0 = p.w_out + nt * 256; t.B1 = t.B0 + 128; t.ldb = 2048; t.nv0 = 128; t.nv1 = 128; t.kscale = nullptr; t.K = 2048;
  gemm_tile_256<4, false, false>(t, smem, acc);
  const long boff = (long)(mt * 256) * 2048 + nt * 256;
  acc_foreach_row<4>(acc, [&](int rowl, int coll, float (&v)[4]) {
    long o = boff + (long)rowl * 2048 + coll;
    OPAQUE(o);
    const float* xr = p.x + o; float* yr = p.x1() + o;
#pragma unroll
    for (int nb = 0; nb < 4; ++nb) { const int c = (nb >> 1) * 128 + (nb & 1) * 32; yr[c] = xr[c] + v[nb]; }
  });
}

#define P7_LDS_BYTES (4 * 32 * 33 * 4 + 4 * 64 * 4 + 32 * 33 * 4 + 128)
template <int DRY = 0>
__device__ __forceinline__ void ffn_prep_unit(const Params& p, char* smem, int u) {
  float* part = (float*)smem; float* ssq = part + 4 * 32 * 33; float* lg = ssq + 256; float* rs = lg + 32 * 33;
  const int tid = opaque_tid(), lane = tid & 63, wid = tid >> 6, l31 = lane & 31, hh = lane >> 5;
  __syncthreads();
  {
    const long t = (long)u * 32 + l31;
    const float* xr = p.x1() + t * 2048 + wid * 512;
    const float* gp = p.ffn_norm + wid * 512;
    const float* wp = p.router_w + (long)(wid * 512 + hh) * 32 + l31;
    f32x16 acc;
#pragma unroll
    for (int r = 0; r < 16; ++r) acc[r] = 0.f;
    float ss = 0.f;
#pragma unroll 4
    for (int m = 0; m < 128; ++m) {
      const f32x4 xv = *(const f32x4*)(xr + 4 * m);
      const f32x4 gv = *(const f32x4*)(gp + 4 * m);
      const float a0 = hh ? xv[1] : xv[0], a1 = hh ? xv[3] : xv[2];
      const float g0 = hh ? gv[1] : gv[0], g1 = hh ? gv[3] : gv[2];
      const float b0 = wp[(4 * m) * 32], b1 = wp[(4 * m + 2) * 32];
      ss += a0 * a0 + a1 * a1;
      acc = __builtin_amdgcn_mfma_f32_32x32x2f32(a0 * g0, b0, acc, 0, 0, 0);
      acc = __builtin_amdgcn_mfma_f32_32x32x2f32(a1 * g1, b1, acc, 0, 0, 0);
    }
#pragma unroll
    for (int r = 0; r < 16; ++r) part[(wid * 32 + (r & 3) + 8 * (r >> 2) + 4 * hh) * 33 + l31] = acc[r];
    ssq[wid * 64 + lane] = ss;
  }
  __syncthreads();
  {
    const int tl = tid >> 3, seg = tid & 7;
    if (seg == 0) {
      float s = 0.f;
#pragma unroll
      for (int w = 0; w < 4; ++w) s += ssq[w * 64 + tl] + ssq[w * 64 + 32 + tl];
      rs[tl] = rsqrtf(s * (1.0f / 2048.0f) + EPS_);
    }
  }
  __syncthreads();
  {
    const int tl = tid >> 3, seg = tid & 7;
    const float r = rs[tl];
#pragma unroll
    for (int c = 0; c < 4; ++c) {
      const int e = seg * 4 + c;
      const float s = part[(0 * 32 + tl) * 33 + e] + part[(1 * 32 + tl) * 33 + e] + part[(2 * 32 + tl) * 33 + e] + part[(3 * 32 + tl) * 33 + e];
      lg[tl * 33 + e] = s * r + p.router_b[e];
    }
  }
  __syncthreads();
  if (tid < 32 && !DRY) {
    const long tt = (long)u * 32 + tid;
    const float* L = lg + tid * 33;
    unsigned used = 0u; int i0 = 0, i1 = 0, i2 = 0, i3 = 0; float v0 = 0.f, v1 = 0.f, v2 = 0.f, v3 = 0.f;
#pragma unroll
    for (int k = 0; k < 4; ++k) {
      int bi = -1; float bv = 0.f;
      for (int i = 0; i < 32; ++i) {
        const float x = L[i];
        const bool take = !((used >> i) & 1u) && (bi < 0 || x > bv);
        bi = take ? i : bi; bv = take ? x : bv;
      }
      used |= 1u << bi;
      if (k == 0) { i0 = bi; v0 = bv; } else if (k == 1) { i1 = bi; v1 = bv; } else if (k == 2) { i2 = bi; v2 = bv; } else { i3 = bi; v3 = bv; }
    }
    const float e0 = 1.0f, e1 = __expf(v1 - v0), e2 = __expf(v2 - v0), e3 = __expf(v3 - v0);
    const float inv = 1.0f / (e0 + e1 + e2 + e3);
    const int s0 = atomicAdd(&p.counts()[i0], 1), s1 = atomicAdd(&p.counts()[i1], 1), s2 = atomicAdd(&p.counts()[i2], 1), s3 = atomicAdd(&p.counts()[i3], 1);
    p.list()[i0 * T_ + s0] = (int)tt; p.list()[i1 * T_ + s1] = (int)tt; p.list()[i2 * T_ + s2] = (int)tt; p.list()[i3 * T_ + s3] = (int)tt;
    p.asg_e()[tt * 4 + 0] = i0; p.asg_e()[tt * 4 + 1] = i1; p.asg_e()[tt * 4 + 2] = i2; p.asg_e()[tt * 4 + 3] = i3;
    p.asg_slot()[tt * 4 + 0] = s0; p.asg_slot()[tt * 4 + 1] = s1; p.asg_slot()[tt * 4 + 2] = s2; p.asg_slot()[tt * 4 + 3] = s3;
    p.asg_g()[tt * 4 + 0] = e0 * inv; p.asg_g()[tt * 4 + 1] = e1 * inv; p.asg_g()[tt * 4 + 2] = e2 * inv; p.asg_g()[tt * 4 + 3] = e3 * inv;
  }
  {
    const int tl = tid >> 3, seg = tid & 7;
    const long t = (long)u * 32 + tl;
    const float* xr = p.x1() + t * 2048;
    const float rr = rs[tl];
#pragma unroll 8
    for (int it = 0; it < 32; ++it) {
      const int kk = it * 64 + seg * 8;
      f32x4 v0 = *(const f32x4*)(xr + kk), v1 = *(const f32x4*)(xr + kk + 4);
      f32x4 g0 = *(const f32x4*)(p.ffn_norm + kk), g1 = *(const f32x4*)(p.ffn_norm + kk + 4);
      v0 = v0 * g0 * rr; v1 = v1 * g1 * rr;
#if MOEQ == 0
      u32x4 w = {pack_bf16(v0[0], v0[1]), pack_bf16(v0[2], v0[3]), pack_bf16(v1[0], v1[1]), pack_bf16(v1[2], v1[3])};
      *(u32x4*)(p.h2() + t * 2048 + kk) = w;
#else
      int q0 = 0, q1 = 0;
      q0 = __builtin_amdgcn_cvt_pk_fp8_f32(v0[0], v0[1], q0, false);
      q0 = __builtin_amdgcn_cvt_pk_fp8_f32(v0[2], v0[3], q0, true);
      q1 = __builtin_amdgcn_cvt_pk_fp8_f32(v1[0], v1[1], q1, false);
      q1 = __builtin_amdgcn_cvt_pk_fp8_f32(v1[2], v1[3], q1, true);
      u32x2 wq = {(unsigned)q0, (unsigned)q1};
      *(u32x2*)(p.h2q() + t * 2048 + kk) = wq;
#endif
    }
  }
}

__device__ __forceinline__ void moe_setup(const Params& p, int* mo) {
  __syncthreads();
  if (threadIdx.x == 0) {
    int s = 0;
    for (int e = 0; e < NE_; ++e) { mo[e] = s; s += (p.counts()[e] + 255) >> 8; }
    mo[NE_] = s;
  }
  __syncthreads();
}
#ifndef MAPV
#define MAPV 0
#endif
__device__ __forceinline__ int xcd_unit(int round) { return MAPV ? (round * 256 + blockIdx.x) : (round * 256 + (blockIdx.x & 7) * 32 + (blockIdx.x >> 3)); }

__device__ __forceinline__ void moe1_tile(const Params& p, char* smem, const int* mo, int e, int nt, int mt) {
  f32x16 acc[4][4];
  GemmTile t{};
  const int cnt = p.counts()[e];
  t.A = p.h2(); t.lda = 2048; t.aidx = p.list() + e * T_ + mt * 256; t.m0 = 0; t.mvalid = min(256, cnt - mt * 256);
  t.B0 = p.w_gu + (long)e * 2048 * 4096 + nt * 128; t.B1 = t.B0 + 2048; t.ldb = 4096; t.nv0 = 128; t.nv1 = 128; t.kscale = nullptr; t.K = 2048;
  gemm_tile_256<4, false, true>(t, smem, acc);
  u16* base = p.act() + (long)(mo[e] * 256 + mt * 256) * 2048 + nt * 128;
  const float* bg = p.b_gu + e * 4096 + nt * 128; const float* bu = bg + 2048;
  const int tq_ = opaque_tid(); const int cl = (tq_ >> 6 & 1) * 64 + (tq_ & 31);
  const float bgv[2] = {bg[cl], bg[cl + 32]}, buv[2] = {bu[cl], bu[cl + 32]};
  acc_foreach_row<4>(acc, [&](int rowl, int coll, float (&v)[4]) {
    u16* rp = base + (long)rowl * 2048 + coll;
    OPAQUE(rp);
#pragma unroll
    for (int nb = 0; nb < 2; ++nb) {
      const int c = nb * 32;
      float g = fminf(v[nb] + bgv[nb], 7.0f);
      float uu = fminf(fmaxf(v[nb + 2] + buv[nb], -7.0f), 7.0f);
      float a = (uu + 1.0f) * (g / (1.0f + __expf(-1.702f * g)));
      rp[c] = f32_to_bf16(a);
    }
  });
}
__device__ __forceinline__ void moe2_tile(const Params& p, char* smem, const int* mo, int e, int nt, int mt) {
  f32x16 acc[4][4];
  GemmTile t{};
  t.A = p.act(); t.lda = 2048; t.aidx = nullptr; t.m0 = mo[e] * 256 + mt * 256; t.mvalid = 256;
  t.B0 = p.w_dn + (long)e * 2048 * 2048 + nt * 256; t.B1 = t.B0 + 128; t.ldb = 2048; t.nv0 = 128; t.nv1 = 128; t.kscale = nullptr; t.K = 2048;
  gemm_tile_256<4, false, false>(t, smem, acc);
  u16* base = p.ybuf() + (long)t.m0 * 2048 + nt * 256;
  const float* bd = p.b_dn + e * 2048 + nt * 256;
  const int tq_ = opaque_tid(); const int cl = (tq_ >> 6 & 1) * 64 + (tq_ & 31);
  const float bdv[4] = {bd[cl], bd[cl + 32], bd[cl + 128], bd[cl + 160]};
  acc_foreach_row<4>(acc, [&](int rowl, int coll, float (&v)[4]) {
    u16* rp = base + (long)rowl * 2048 + coll;
    OPAQUE(rp);
#pragma unroll
    for (int nb = 0; nb < 4; ++nb) { const int c = (nb >> 1) * 128 + (nb & 1) * 32; rp[c] = f32_to_bf16(v[nb] + bdv[nb]); }
  });
}
template <int WHICH, int HALF = 0>
__device__ __forceinline__ void ph_moe(const Params& p, char* smem) {
  int* mo = (int*)(smem + G_LDS_BYTES);
  moe_setup(p, mo);
  const int NT = (WHICH == 1) ? 16 : 8;
  const int total = mo[NE_] * NT;
  if (HALF && ((blockIdx.x >> 3) & 1)) return;
  const int W = HALF ? 128 : 256;
  for (int round = 0;; ++round) {
    const int u = HALF ? (round * 128 + (blockIdx.x & 7) * 16 + (blockIdx.x >> 4)) : xcd_unit(round);
    if (round * W >= total) break;
    if (u >= total) continue;
    int e = 0;
    while (mo[e + 1] * NT <= u) ++e;
    const int local = u - mo[e] * NT, me = mo[e + 1] - mo[e];
    const int nt = local / me, mt = local - nt * me;
    if (WHICH == 1) moe1_tile(p, smem, mo, e, nt, mt); else moe2_tile(p, smem, mo, e, nt, mt);
  }
}

__device__ __forceinline__ void ph_final(const Params& p, char* smem, float dbg_scale = 1.0f) {
  int* mo = (int*)(smem + G_LDS_BYTES);
  moe_setup(p, mo);
  const int tid_ = opaque_tid(); const int lane = tid_ & 63, wid = tid_ >> 6;
  for (int t = blockIdx.x * 4 + wid; t < T_; t += gridDim.x * 4) {
    long rows[4]; float gg[4];
#pragma unroll
    for (int k = 0; k < 4; ++k) { rows[k] = (long)(mo[p.asg_e()[t * 4 + k]] * 256 + p.asg_slot()[t * 4 + k]) * 2048; gg[k] = p.asg_g()[t * 4 + k]; }
    f32x4 v[8]; float ss = 0.f;
#pragma unroll
    for (int j = 0; j < 8; ++j) {
      const int c = j * 256 + lane * 4;
      f32x4 a = __builtin_nontemporal_load((const f32x4*)(p.x1() + (long)t * 2048 + c));
#pragma unroll
      for (int k = 0; k < 4; ++k) {
        u32x2 w = __builtin_nontemporal_load((const u32x2*)(p.ybuf() + rows[k] + c));
        a[0] += gg[k] * bf_lo(w[0]); a[1] += gg[k] * bf_hi(w[0]); a[2] += gg[k] * bf_lo(w[1]); a[3] += gg[k] * bf_hi(w[1]);
      }
      v[j] = a; ss += a[0] * a[0] + a[1] * a[1] + a[2] * a[2] + a[3] * a[3];
    }
    ss = wave_sum(ss);
    const float r = rsqrtf(ss * (1.0f / 2048.0f) + EPS_);
#pragma unroll
    for (int j = 0; j < 8; ++j) {
      const int c = j * 256 + lane * 4;
      f32x4 g = *(const f32x4*)(p.final_norm + c);
      f32x4 o = {v[j][0] * r * g[0] * dbg_scale, v[j][1] * r * g[1] * dbg_scale, v[j][2] * r * g[2] * dbg_scale, v[j][3] * r * g[3] * dbg_scale};
      __builtin_nontemporal_store(o, (f32x4*)(p.out + (long)t * 2048 + c));
    }
  }
}
#define WSCALE_  128.0f
#define WISCALE_ 0.0078125f
typedef unsigned char u8;

struct CvtUnit { const float* src; u8* dst; int ldn; };
__device__ __forceinline__ CvtUnit cvt8_decode(const Params& p, int u) {
  CvtUnit c;
  if (u < 16384) {
    const int e = u >> 9, kb = (u >> 4) & 31, nt = u & 15;
    c.src = p.w_gu + (long)e * 2048 * 4096 + (long)(kb * 64) * 4096 + nt * 256; c.ldn = 4096;
    c.dst = p.wq_gu() + ((long)e * 4096 + nt * 256) * 2048 + kb * 128;
  } else {
    const int v = u - 16384; const int e = v >> 8, kb = (v >> 3) & 31, nt = v & 7;
    c.src = p.w_dn + (long)e * 2048 * 2048 + (long)(kb * 64) * 2048 + nt * 256; c.ldn = 2048;
    c.dst = p.wq_dn() + ((long)e * 2048 + nt * 256) * 2048 + kb * 128;
  }
  return c;
}
__device__ __forceinline__ void cvt8_load(const CvtUnit& c, int w, int lane, f32x4 (&v)[16]) {
  const float* src = c.src + (long)(w * 16) * c.ldn + lane * 4;
#pragma unroll
  for (int j = 0; j < 16; ++j) {
    const float* ptr = src + (long)j * c.ldn;
    asm volatile("global_load_dwordx4 %0, %1, off nt" : "=v"(v[j]) : "v"(ptr) : "memory");
  }
}
#define CVT_WAIT(N, v) asm volatile("s_waitcnt vmcnt(%16)" : "+v"(v[0]), "+v"(v[1]), "+v"(v[2]), "+v"(v[3]), "+v"(v[4]), "+v"(v[5]), "+v"(v[6]), "+v"(v[7]), \
    "+v"(v[8]), "+v"(v[9]), "+v"(v[10]), "+v"(v[11]), "+v"(v[12]), "+v"(v[13]), "+v"(v[14]), "+v"(v[15]) : "n"(N) : "memory")
__device__ __forceinline__ void cvt8_emit(const CvtUnit& c, int tid, int w, int lane, f32x4 (&v)[16], char* T) {
  __syncthreads();
#pragma unroll
  for (int cc = 0; cc < 4; ++cc) {
    u32x4 x4;
#pragma unroll
    for (int q = 0; q < 4; ++q) {
      int x = 0;
      x = __builtin_amdgcn_cvt_pk_fp8_f32(v[4 * q][cc] * WSCALE_, v[4 * q + 1][cc] * WSCALE_, x, false);
      x = __builtin_amdgcn_cvt_pk_fp8_f32(v[4 * q + 2][cc] * WSCALE_, v[4 * q + 3][cc] * WSCALE_, x, true);
      x4[q] = (unsigned)x;
    }
    *(u32x4*)(T + (lane * 4 + cc) * 64 + w * 16) = x4;
  }
  __syncthreads();
#pragma unroll
  for (int i = 0; i < 4; ++i) {
    const int n = (tid >> 2) + 64 * i, ch = tid & 3;
    __builtin_nontemporal_store(*(const u32x4*)(T + n * 64 + ch * 16), (u32x4*)(c.dst + (long)(n >> 1) * 4096 + (n & 1) * 64 + ch * 16));
  }
}
__device__ __forceinline__ void convert_units(const Params& p, char* smem, int first, int stride, int count) {
  const int tid = opaque_tid();
  const int w = tid >> 6, lane = tid & 63;
  if (count <= 0) return;
  f32x4 va[16], vb[16], vc[16];
  CvtUnit ca = cvt8_decode(p, first), cb = cvt8_decode(p, first + stride), cc = cvt8_decode(p, first + 2 * stride);
  cvt8_load(ca, w, lane, va);
  cvt8_load(cb, w, lane, vb);
  cvt8_load(cc, w, lane, vc);
  CVT_WAIT(32, va); cvt8_emit(ca, tid, w, lane, va, smem); ca = cvt8_decode(p, first + 3 * stride); cvt8_load(ca, w, lane, va);
  CVT_WAIT(36, vb); cvt8_emit(cb, tid, w, lane, vb, smem); cb = cvt8_decode(p, first + 4 * stride); cvt8_load(cb, w, lane, vb);
  CVT_WAIT(40, vc); cvt8_emit(cc, tid, w, lane, vc, smem); cc = cvt8_decode(p, first + 5 * stride); cvt8_load(cc, w, lane, vc);
  for (int i = 3; i + 3 < count; i += 3) {
    CVT_WAIT(40, va); cvt8_emit(ca, tid, w, lane, va, smem); ca = cvt8_decode(p, first + (i + 3) * stride); cvt8_load(ca, w, lane, va);
    CVT_WAIT(40, vb); cvt8_emit(cb, tid, w, lane, vb, smem); cb = cvt8_decode(p, first + (i + 4) * stride); cvt8_load(cb, w, lane, vb);
    CVT_WAIT(40, vc); cvt8_emit(cc, tid, w, lane, vc, smem); cc = cvt8_decode(p, first + (i + 5) * stride); cvt8_load(cc, w, lane, vc);
  }
  CVT_WAIT(0, va); cvt8_emit(ca, tid, w, lane, va, smem);
  CVT_WAIT(0, vb); cvt8_emit(cb, tid, w, lane, vb, smem);
  CVT_WAIT(0, vc); cvt8_emit(cc, tid, w, lane, vc, smem);
}
__device__ __forceinline__ void convert_one(const Params& p, char* smem, int u) {
  const int tid = opaque_tid();
  const int w = tid >> 6, lane = tid & 63;
  f32x4 va[16];
  CvtUnit ca = cvt8_decode(p, u);
  cvt8_load(ca, w, lane, va);
  CVT_WAIT(0, va); cvt8_emit(ca, tid, w, lane, va, smem);
}
__device__ __forceinline__ void ph_convert(const Params& p, char* smem) {
  convert_units(p, smem, blockIdx.x, gridDim.x, 24576 / 256);
}
__device__ __forceinline__ void ph_convert_gu(const Params& p, char* smem, int part, int nparts) {
  (void)part; (void)nparts;
  convert_units(p, smem, blockIdx.x, 256, 63);
  convert_one(p, smem, blockIdx.x + 63 * 256);
}
__device__ __forceinline__ void ph_convert_dn(const Params& p, char* smem) {
  convert_units(p, smem, 16384 + blockIdx.x, 256, 30);
  convert_one(p, smem, 16384 + blockIdx.x + 30 * 256);
  convert_one(p, smem, 16384 + blockIdx.x + 31 * 256);
}

#define R_STAGE 32768
struct GemmRTile {
  const u8* A; int lda; const int* aidx; int m0, mvalid;
  const u8* B; long brow0, brow1; int ldb;
  int pairb;
  int paira;
  int KB;
};
template <bool FP8, bool GATHER>
__device__ __forceinline__ void gemmr_tile_256(const GemmRTile& t, char* smem, f32x16 (&acc)[4][4]) {
  int tz0 = threadIdx.x; asm volatile("" : "+v"(tz0));
  const int tid = tz0, lane = tid & 63, wid = tid >> 6, wr = wid >> 1, wc = wid & 1;
  const int l31 = lane & 31, hh = lane >> 5;
#pragma unroll
  for (int i = 0; i < 4; ++i)
#pragma unroll
    for (int j = 0; j < 4; ++j)
#pragma unroll
      for (int r = 0; r < 16; ++r) acc[i][j][r] = 0.f;
  const int c_src = (tid & 3) ^ ((tid >> 4) & 3);
  const u8* a_src[GATHER ? 4 : 1];
  if (GATHER) {
#pragma unroll
    for (int i = 0; i < (GATHER ? 4 : 1); ++i) {
      int r = (tid >> 2) + 64 * i;
      int rr = r < t.mvalid ? r : 0;
      a_src[i] = t.A + (long)t.aidx[rr] * t.lda + c_src * 16;
    }
  } else {
    a_src[0] = t.A + (long)(t.m0 + (tid >> 2)) * t.lda + c_src * 16;
  }
  const long a_step = 64L * t.lda, b_step = 64L * t.ldb;
  const u8* b_src0 = t.B + (t.brow0 + (tid >> 2)) * t.ldb + c_src * 16;
  const u8* b_src1 = t.B + (t.brow1 + (tid >> 2)) * t.ldb + c_src * 16;
  const unsigned lds0 = (unsigned)(size_t)smem + (unsigned)__builtin_amdgcn_readfirstlane(wid) * 1024u;
  auto issue = [&](int kt, int sl, int q) {
    if (q < 4) glds16_asm((const void*)((GATHER ? a_src[GATHER ? q : 0] : a_src[0] + q * a_step) + kt * 64), lds0 + sl * R_STAGE + q * 4096);
    else { const int i = q - 4; glds16_asm((const void*)((i < 2 ? b_src0 + i * b_step : b_src1 + (i - 2) * b_step) + kt * 64), lds0 + sl * R_STAGE + 16384 + i * 4096); }
  };
  unsigned a_rd[2], b_rd[2];
#pragma unroll
  for (int s2 = 0; s2 < 2; ++s2) {
    const int ra = wr * 128 + l31, rb = wc * 64 + l31;
    a_rd[s2] = ra * 64 + (((2 * s2 + hh) ^ ((ra >> 2) & 3)) * 16);
    b_rd[s2] = rb * 64 + (((2 * s2 + hh) ^ ((rb >> 2) & 3)) * 16);
  }
  auto load_frags = [&](const char* St, int s2, u32x4 (&af)[4], u32x4 (&bf)[4]) {
#pragma unroll
    for (int mb = 0; mb < 4; ++mb) af[mb] = *(const u32x4*)(St + a_rd[s2] + mb * 2048);
#pragma unroll
    for (int nb = 0; nb < 4; ++nb) bf[nb] = *(const u32x4*)(St + 16384 + b_rd[s2] + (nb >> 1) * 8192 + (nb & 1) * 2048);
  };
  auto mma = [&](u32x4 (&ac)[4], u32x4 (&bc)[4], int nb) {
    if (FP8) {
#pragma unroll
      for (int u = 0; u < 2; ++u) {
        const long bl = (long)(((unsigned long long)bc[nb][2 * u + 1] << 32) | bc[nb][2 * u]);
#pragma unroll
        for (int mb = 0; mb < 4; ++mb) {
          const long al = (long)(((unsigned long long)ac[mb][2 * u + 1] << 32) | ac[mb][2 * u]);
          acc[mb][nb] = __builtin_amdgcn_mfma_f32_32x32x16_fp8_fp8(al, bl, acc[mb][nb], 0, 0, 0);
        }
      }
    } else {
      const bf16x8 bb = *(const bf16x8*)&bc[nb];
#pragma unroll
      for (int mb = 0; mb < 4; ++mb) acc[mb][nb] = __builtin_amdgcn_mfma_f32_32x32x16_bf16(*(const bf16x8*)&ac[mb], bb, acc[mb][nb], 0, 0, 0);
    }
  };
  u32x4 a0[4], b0[4], a1[4], b1[4];
  auto half0 = [&](int kt, bool issueA) {
    const char* St = smem + (kt & 3) * R_STAGE;
    load_frags(St, 1, a1, b1);
    __builtin_amdgcn_sched_barrier(0);
#pragma unroll
    for (int nb = 0; nb < 4; ++nb) {
      mma(a0, b0, nb);
      __builtin_amdgcn_sched_barrier(0);
      if (issueA) issue(kt + 2, (kt + 2) & 3, 4 + nb);
      __builtin_amdgcn_sched_barrier(0);
    }
  };
  auto half1 = [&](int kt, bool has1, bool issueB) {
    const char* Sn = smem + ((kt + 1) & 3) * R_STAGE;
    if (has1) load_frags(Sn, 0, a0, b0);
    __builtin_amdgcn_sched_barrier(0);
#pragma unroll
    for (int nb = 0; nb < 4; ++nb) {
      mma(a1, b1, nb);
      __builtin_amdgcn_sched_barrier(0);
      if (issueB) issue(kt + 3, (kt + 3) & 3, nb);
      __builtin_amdgcn_sched_barrier(0);
    }
  };
  const int nk = t.KB >> 6;
  __syncthreads();
#pragma unroll
  for (int q = 0; q < 8; ++q) issue(0, 0, q);
#pragma unroll
  for (int q = 0; q < 8; ++q) issue(1, 1, q);
#pragma unroll
  for (int q = 0; q < 4; ++q) issue(2, 2, q);
  asm volatile("s_waitcnt vmcnt(12)" ::: "memory");
  __syncthreads();
  load_frags(smem, 0, a0, b0);
  for (int kt = 0; kt < nk - 3; ++kt) {
    half0(kt, true);
    asm volatile("s_waitcnt vmcnt(8)" ::: "memory");
    __syncthreads();
    half1(kt, true, true);
  }
  half0(nk - 3, true);
  asm volatile("s_waitcnt vmcnt(8)" ::: "memory");
  __syncthreads();
  half1(nk - 3, true, false);
  half0(nk - 2, false);
  asm volatile("s_waitcnt vmcnt(0)" ::: "memory");
  __syncthreads();
  half1(nk - 2, true, false);
  half0(nk - 1, false);
  half1(nk - 1, false, false);
}


typedef int i32x8 __attribute__((ext_vector_type(8)));
template <bool GATHER>
__device__ __forceinline__ void gemmrs_tile_256(const GemmRTile& t, char* smem, f32x16 (&acc)[4][4]) {
  int tz0 = threadIdx.x; asm volatile("" : "+v"(tz0));
  const int tid = tz0, lane = tid & 63, wid = tid >> 6, wr = wid >> 1, wc = wid & 1;
  const int l31 = lane & 31, hh = lane >> 5;
#pragma unroll
  for (int i = 0; i < 4; ++i)
#pragma unroll
    for (int j = 0; j < 4; ++j)
#pragma unroll
      for (int r = 0; r < 16; ++r) acc[i][j][r] = 0.f;
  const int c_src = (tid & 3) ^ ((tid >> 4) & 3);
  const u8* a_src[GATHER ? 4 : 1];
  if (GATHER) {
#pragma unroll
    for (int i = 0; i < (GATHER ? 4 : 1); ++i) {
      int r = (tid >> 2) + 64 * i;
      int rr = r < t.mvalid ? r : 0;
      a_src[i] = t.A + (long)t.aidx[rr] * t.lda + c_src * 16;
    }
  } else {
    a_src[0] = t.A + ((long)(t.m0 + (tid >> 2)) >> 1) * 4096 + ((tid >> 2) & 1) * 64 + c_src * 16;
  }
  const long a_step = GATHER ? 64L * t.lda : 32L * 4096, b_step = 32L * 4096;
  const int a_kstep = GATHER ? 64 : 128;
  const int brl = tid >> 2;
  const u8* b_src0 = t.B + ((t.brow0 + brl) >> 1) * 4096 + (brl & 1) * 64 + c_src * 16;
  const u8* b_src1 = t.B + ((t.brow1 + brl) >> 1) * 4096 + (brl & 1) * 64 + c_src * 16;
  const unsigned lds0 = (unsigned)(size_t)smem + (unsigned)__builtin_amdgcn_readfirstlane(wid) * 1024u;
  auto issue = [&](int kt, int sl, int q) {
    if (q < 4) { if (ANT) glds16_asm_nt((const void*)((GATHER ? a_src[GATHER ? q : 0] : a_src[0] + q * a_step) + kt * a_kstep), lds0 + sl * R_STAGE + q * 4096);
                 else glds16_asm((const void*)((GATHER ? a_src[GATHER ? q : 0] : a_src[0] + q * a_step) + kt * a_kstep), lds0 + sl * R_STAGE + q * 4096); }
    else { const int i = q - 4;
      if (BNT) glds16_asm_nt((const void*)((i < 2 ? b_src0 + i * b_step : b_src1 + (i - 2) * b_step) + kt * 128), lds0 + sl * R_STAGE + 16384 + i * 4096);
      else glds16_asm((const void*)((i < 2 ? b_src0 + i * b_step : b_src1 + (i - 2) * b_step) + kt * 128), lds0 + sl * R_STAGE + 16384 + i * 4096); }
  };
  unsigned a_rd[2], b_rd[2];
#pragma unroll
  for (int c = 0; c < 2; ++c) {
    const int ra = wr * 128 + l31, rb = wc * 64 + l31;
    a_rd[c] = ra * 64 + (((2 * hh + c) ^ ((ra >> 2) & 3)) * 16);
    b_rd[c] = rb * 64 + (((2 * hh + c) ^ ((rb >> 2) & 3)) * 16);
  }
  auto load_a = [&](const char* St, i32x8 (&af)[4]) {
#pragma unroll
    for (int mb = 0; mb < 4; ++mb) {
      const u32x4 lo = *(const u32x4*)(St + a_rd[0] + mb * 2048), hi = *(const u32x4*)(St + a_rd[1] + mb * 2048);
      af[mb] = (i32x8){(int)lo[0], (int)lo[1], (int)lo[2], (int)lo[3], (int)hi[0], (int)hi[1], (int)hi[2], (int)hi[3]};
    }
  };
  auto load_b = [&](const char* St, int nb, i32x8& bf) {
    const char* bp = St + 16384 + (nb >> 1) * 8192 + (nb & 1) * 2048;
    const u32x4 lo = *(const u32x4*)(bp + b_rd[0]), hi = *(const u32x4*)(bp + b_rd[1]);
    bf = (i32x8){(int)lo[0], (int)lo[1], (int)lo[2], (int)lo[3], (int)hi[0], (int)hi[1], (int)hi[2], (int)hi[3]};
  };
  auto mma4 = [&](i32x8 (&af)[4], i32x8& bf, int nb) {
#pragma unroll
    for (int mb = 0; mb < 4; ++mb)
      acc[mb][nb] = __builtin_amdgcn_mfma_scale_f32_32x32x64_f8f6f4(af[mb], bf, acc[mb][nb], 0, 0, 0, 0x7f7f7f7f, 0, 0x7f7f7f7f);
  };
  i32x8 aA[4], aB[4], bq[4];
  auto half0 = [&](int kt, i32x8 (&ac)[4], bool issueA) {
    const char* St = smem + (kt & 3) * R_STAGE;
    load_b(St, 2, bq[2]); load_b(St, 3, bq[3]);
    __builtin_amdgcn_sched_barrier(0);
#pragma unroll
    for (int nb = 0; nb < 2; ++nb) {
      mma4(ac, bq[nb], nb);
      __builtin_amdgcn_sched_barrier(0);
      if (issueA) { issue(kt + 2, (kt + 2) & 3, 4 + 2 * nb); issue(kt + 2, (kt + 2) & 3, 5 + 2 * nb); }
      __builtin_amdgcn_sched_barrier(0);
    }
  };
  auto half1 = [&](int kt, i32x8 (&ac)[4], i32x8 (&an)[4], bool has1, bool issueB) {
    const char* Sn = smem + ((kt + 1) & 3) * R_STAGE;
    if (has1) { load_a(Sn, an); load_b(Sn, 0, bq[0]); load_b(Sn, 1, bq[1]); }
    __builtin_amdgcn_sched_barrier(0);
#pragma unroll
    for (int nb = 2; nb < 4; ++nb) {
      mma4(ac, bq[nb], nb);
      __builtin_amdgcn_sched_barrier(0);
      if (issueB) { issue(kt + 3, (kt + 3) & 3, 2 * (nb - 2)); issue(kt + 3, (kt + 3) & 3, 2 * (nb - 2) + 1); }
      __builtin_amdgcn_sched_barrier(0);
    }
  };
  const int nk = t.KB >> 6;
  __syncthreads();
#pragma unroll
  for (int q = 0; q < 8; ++q) issue(0, 0, q);
#pragma unroll
  for (int q = 0; q < 8; ++q) issue(1, 1, q);
#pragma unroll
  for (int q = 0; q < 4; ++q) issue(2, 2, q);
  asm volatile("s_waitcnt vmcnt(12)" ::: "memory");
  __syncthreads();
  load_a(smem, aA); load_b(smem, 0, bq[0]); load_b(smem, 1, bq[1]);
  for (int kt = 0; kt < nk - 4; kt += 2) {
    half0(kt, aA, true);
    asm volatile("s_waitcnt vmcnt(8)" ::: "memory"); __syncthreads();
    half1(kt, aA, aB, true, true);
    half0(kt + 1, aB, true);
    asm volatile("s_waitcnt vmcnt(8)" ::: "memory"); __syncthreads();
    half1(kt + 1, aB, aA, true, true);
  }
  half0(nk - 4, aA, true);
  asm volatile("s_waitcnt vmcnt(8)" ::: "memory"); __syncthreads();
  half1(nk - 4, aA, aB, true, true);
  half0(nk - 3, aB, true);
  asm volatile("s_waitcnt vmcnt(8)" ::: "memory"); __syncthreads();
  half1(nk - 3, aB, aA, true, false);
  half0(nk - 2, aA, false);
  asm volatile("s_waitcnt vmcnt(0)" ::: "memory"); __syncthreads();
  half1(nk - 2, aA, aB, true, false);
  half0(nk - 1, aB, false);
  half1(nk - 1, aB, aA, false, false);
}

template <bool GATHER>
__device__ __forceinline__ void gemmrv_tile_256(const GemmRTile& t, char* smem, f32x16 (&acc)[4][4]) {
  int tz0 = threadIdx.x; asm volatile("" : "+v"(tz0));
  const int tid = tz0, lane = tid & 63, wid = tid >> 6, wr = wid >> 1, wc = wid & 1;
  const int l31 = lane & 31, hh = lane >> 5;
#pragma unroll
  for (int i = 0; i < 4; ++i)
#pragma unroll
    for (int j = 0; j < 4; ++j)
#pragma unroll
      for (int r = 0; r < 16; ++r) acc[i][j][r] = 0.f;
  const int c_src = (tid & 3) ^ ((tid >> 4) & 3);
  const u8* a_src[GATHER ? 4 : 1];
  if (GATHER) {
#pragma unroll
    for (int i = 0; i < (GATHER ? 4 : 1); ++i) {
      int r = (tid >> 2) + 64 * i;
      int rr = r < t.mvalid ? r : 0;
      a_src[i] = t.A + (long)t.aidx[rr] * t.lda + c_src * 16;
    }
  } else {
    a_src[0] = t.A + ((long)(t.m0 + (tid >> 2)) >> 1) * 4096 + ((tid >> 2) & 1) * 64 + c_src * 16;
  }
  const long a_step = GATHER ? 64L * t.lda : 32L * 4096, b_step = 32L * 4096;
  const int a_kstep = GATHER ? 64 : 128;
  const int brl = tid >> 2;
  const u8* b_src0 = t.B + ((t.brow0 + brl) >> 1) * 4096 + (brl & 1) * 64 + c_src * 16;
  const u8* b_src1 = t.B + ((t.brow1 + brl) >> 1) * 4096 + (brl & 1) * 64 + c_src * 16;
  u32x4 rs0[8], rs1[8];
  auto ldg = [&](int kt, int q, u32x4& dst) {
    const u8* ptr = (q < 4) ? ((GATHER ? a_src[GATHER ? q : 0] : a_src[0] + q * a_step) + kt * a_kstep)
                            : (((q - 4) < 2 ? b_src0 + (q - 4) * b_step : b_src1 + (q - 6) * b_step) + kt * 128);
    asm volatile("global_load_dwordx4 %0, %1, off" : "=v"(dst) : "v"(ptr) : "memory");
  };
  auto stw = [&](int sl, int q, const u32x4& src) {
    *(u32x4*)(smem + sl * R_STAGE + (q < 4 ? q * 4096 : 16384 + (q - 4) * 4096) + tid * 16) = src;
  };
#define RV_WAIT(N, r) asm volatile("s_waitcnt vmcnt(%8)" : "+v"(r[0]), "+v"(r[1]), "+v"(r[2]), "+v"(r[3]), "+v"(r[4]), "+v"(r[5]), "+v"(r[6]), "+v"(r[7]) : "n"(N) : "memory")
  unsigned a_rd[2], b_rd[2];
#pragma unroll
  for (int c = 0; c < 2; ++c) {
    const int ra = wr * 128 + l31, rb = wc * 64 + l31;
    a_rd[c] = ra * 64 + (((2 * hh + c) ^ ((ra >> 2) & 3)) * 16);
    b_rd[c] = rb * 64 + (((2 * hh + c) ^ ((rb >> 2) & 3)) * 16);
  }
  auto load_a = [&](const char* St, i32x8 (&af)[4]) {
#pragma unroll
    for (int mb = 0; mb < 4; ++mb) {
      const u32x4 lo = *(const u32x4*)(St + a_rd[0] + mb * 2048), hi = *(const u32x4*)(St + a_rd[1] + mb * 2048);
      af[mb] = (i32x8){(int)lo[0], (int)lo[1], (int)lo[2], (int)lo[3], (int)hi[0], (int)hi[1], (int)hi[2], (int)hi[3]};
    }
  };
  auto load_b = [&](const char* St, int nb, i32x8& bf) {
    const char* bp = St + 16384 + (nb >> 1) * 8192 + (nb & 1) * 2048;
    const u32x4 lo = *(const u32x4*)(bp + b_rd[0]), hi = *(const u32x4*)(bp + b_rd[1]);
    bf = (i32x8){(int)lo[0], (int)lo[1], (int)lo[2], (int)lo[3], (int)hi[0], (int)hi[1], (int)hi[2], (int)hi[3]};
  };
  auto mma4 = [&](i32x8 (&af)[4], i32x8& bf, int nb) {
#pragma unroll
    for (int mb = 0; mb < 4; ++mb)
      acc[mb][nb] = __builtin_amdgcn_mfma_scale_f32_32x32x64_f8f6f4(af[mb], bf, acc[mb][nb], 0, 0, 0, 0x7f7f7f7f, 0, 0x7f7f7f7f);
  };
  i32x8 aA[4], aB[4], bq[4];
  auto half0 = [&](int kt, i32x8 (&ac)[4]) {
    const char* St = smem + (kt & 1) * R_STAGE;
    load_b(St, 2, bq[2]); load_b(St, 3, bq[3]);
    __builtin_amdgcn_sched_barrier(0);
    mma4(ac, bq[0], 0);
    __builtin_amdgcn_sched_barrier(0);
    mma4(ac, bq[1], 1);
    __builtin_amdgcn_sched_barrier(0);
  };
  auto commit = [&](int kt, u32x4 (&rn)[8], auto wtag, bool has1, bool has3) {
    constexpr int W = decltype(wtag)::value;
    if (has1) {
      RV_WAIT(W, rn);
#pragma unroll
      for (int q = 0; q < 8; ++q) stw((kt + 1) & 1, q, rn[q]);
      if (has3) {
#pragma unroll
        for (int q = 0; q < 8; ++q) ldg(kt + 3, q, rn[q]);
      }
      __syncthreads();
    }
  };
  auto half1 = [&](int kt, i32x8 (&ac)[4], i32x8 (&an)[4], bool has1) {
    const char* Sn = smem + ((kt + 1) & 1) * R_STAGE;
    if (has1) { load_a(Sn, an); load_b(Sn, 0, bq[0]); load_b(Sn, 1, bq[1]); }
    __builtin_amdgcn_sched_barrier(0);
    mma4(ac, bq[2], 2);
    __builtin_amdgcn_sched_barrier(0);
    mma4(ac, bq[3], 3);
    __builtin_amdgcn_sched_barrier(0);
  };
#define IC(n) std::integral_constant<int, n>{}
  const int nk = t.KB >> 6;
  __syncthreads();
#pragma unroll
  for (int q = 0; q < 8; ++q) ldg(0, q, rs0[q]);
#pragma unroll
  for (int q = 0; q < 8; ++q) ldg(1, q, rs1[q]);
  RV_WAIT(8, rs0);
#pragma unroll
  for (int q = 0; q < 8; ++q) stw(0, q, rs0[q]);
#pragma unroll
  for (int q = 0; q < 8; ++q) ldg(2, q, rs0[q]);
  __syncthreads();
  load_a(smem, aA); load_b(smem, 0, bq[0]); load_b(smem, 1, bq[1]);
  for (int kt = 0; kt < nk - 4; kt += 2) {
    half0(kt, aA);      commit(kt, rs1, IC(8), true, true);      half1(kt, aA, aB, true);
    half0(kt + 1, aB);  commit(kt + 1, rs0, IC(8), true, true);  half1(kt + 1, aB, aA, true);
  }
  half0(nk - 4, aA);  commit(nk - 4, rs1, IC(8), true, true);   half1(nk - 4, aA, aB, true);
  half0(nk - 3, aB);  commit(nk - 3, rs0, IC(8), true, false);  half1(nk - 3, aB, aA, true);
  half0(nk - 2, aA);  commit(nk - 2, rs1, IC(0), true, false);  half1(nk - 2, aA, aB, true);
  half0(nk - 1, aB);                                            half1(nk - 1, aB, aA, false);
#undef IC
#undef RV_WAIT
}

__device__ __forceinline__ void cvt16_tile(const float* W, int col0, int ldn, int nvalid  , const float* kgain,
                                           u16* out  , int ldk, char* T) {
  const int tid = opaque_tid();
  const int kq = tid & 7, n4 = tid >> 3;
  f32x4 v[16];
  const bool ok = (n4 * 4) < nvalid;
  const float* src = W + (long)(kq * 16) * ldn + (ok ? n4 * 4 : -col0);
#pragma unroll
  for (int j = 0; j < 16; ++j) v[j] = __builtin_nontemporal_load((const f32x4*)(src + (long)j * ldn));
  if (kgain) {
#pragma unroll
    for (int j = 0; j < 16; ++j) v[j] *= kgain[kq * 16 + j];
  }
  if (!ok) {
#pragma unroll
    for (int j = 0; j < 16; ++j) v[j] = (f32x4){0.f, 0.f, 0.f, 0.f};
  }
  __syncthreads();
#pragma unroll
  for (int c = 0; c < 4; ++c) {
    u32x4 w0, w1;
#pragma unroll
    for (int q = 0; q < 4; ++q) { w0[q] = pack_bf16(v[2 * q][c], v[2 * q + 1][c]); w1[q] = pack_bf16(v[8 + 2 * q][c], v[8 + 2 * q + 1][c]); }
    *(u32x4*)(T + (n4 * 4 + c) * 256 + kq * 32) = w0;
    *(u32x4*)(T + (n4 * 4 + c) * 256 + kq * 32 + 16) = w1;
  }
  __syncthreads();
#pragma unroll
  for (int i = 0; i < 8; ++i) {
    const int n = (tid >> 4) + 16 * i, ch = tid & 15;
    *(u32x4*)((char*)(out + (long)n * ldk) + ch * 16) = *(const u32x4*)(T + n * 256 + ch * 16);
  }
}
__device__ __forceinline__ void convert_one(const Params& p, char* smem, int u);
__device__ __forceinline__ void ph_convert_dense(const Params& p, char* smem) {
#if WOUTQ
  convert_one(p, smem, 24576 + blockIdx.x);
#endif
  for (int u = blockIdx.x; u < 912; u += gridDim.x) {
    if (u < 544) { const int kt = u / 34, nt = u % 34; const int nv = NC_ - nt * 128;
      cvt16_tile(p.w_in + (long)(kt * 128) * NC_ + nt * 128, nt * 128, NC_, nv < 0 ? 0 : nv, nullptr, p.wb_in() + (long)(nt * 128) * 2048 + kt * 128, 2048, smem);
    } else if (u < 592) { const int v = u - 544; const int kt = v / 12, nt = v % 12;
      cvt16_tile(p.w_uq + (long)(kt * 128) * 1536 + nt * 128, nt * 128, 1536, 128, p.q_norm + kt * 128, p.wb_uq() + (long)(nt * 128) * 512 + kt * 128, 512, smem);
    } else if (u < 656) { const int v = u - 592; const int kt = v >> 4, nt = v & 15;
      cvt16_tile(p.w_ukv + (long)(kt * 128) * 2048 + nt * 128, nt * 128, 2048, 128, p.kv_norm + kt * 128, p.wb_ukv() + (long)(nt * 128) * 512 + kt * 128, 512, smem);
    } else if (!WOUTQ) { const int v = u - 656; const int kt = v >> 4, nt = v & 15;
      cvt16_tile(p.w_out + (long)(kt * 128) * 2048 + nt * 128, nt * 128, 2048, 128, nullptr, p.wb_out() + (long)(nt * 128) * 2048 + kt * 128, 2048, smem);
    }
  }
}


template <bool NTST = false, class F>
__device__ __forceinline__ void epi_store_bf16(f32x16 (&acc)[4][4], char* smem, u16* gbase  , int ld, int ncols0, int ncols1, F f) {
  int tz = threadIdx.x; asm volatile("" : "+v"(tz));
  const int lane = tz & 63, wid = tz >> 6, wr = wid >> 1, wc = wid & 1, l31 = lane & 31, hh = lane >> 5;
  __syncthreads();
  char* st = smem + wid * 32768;
#pragma unroll
  for (int mb = 0; mb < 4; ++mb)
#pragma unroll
    for (int reg = 0; reg < 16; ++reg) {
      const int r = mb * 32 + (reg & 3) + 8 * (reg >> 2) + 4 * hh;
      float v[4] = {acc[mb][0][reg], acc[mb][1][reg], acc[mb][2][reg], acc[mb][3][reg]};
      f(wr * 128 + r, wc * 64 + l31, v);
#pragma unroll
      for (int nb = 0; nb < 4; ++nb) *(u16*)(st + r * 256 + (nb * 32 + l31) * 2) = f32_to_bf16(v[nb]);
    }
  const int ch = lane & 15, span = ch >> 3;
  const int gcol = span * 128 + wc * 64 + (ch & 7) * 8;
  const bool ok = ((wc * 64 + (ch & 7) * 8) < (span ? ncols1 : ncols0));
#pragma unroll 8
  for (int it = 0; it < 32; ++it) {
    const int r = it * 4 + (lane >> 4);
    const u32x4 w = *(const u32x4*)(st + r * 256 + ch * 16);
    if (ok) { if (NTST) __builtin_nontemporal_store(w, (u32x4*)(gbase + (long)(wr * 128 + r) * ld + gcol)); else *(u32x4*)(gbase + (long)(wr * 128 + r) * ld + gcol) = w; }
  }
}
template <class F>
__device__ __forceinline__ void epi_store_act8(f32x16 (&acc)[4][4], char* smem, u8* gbase  , long row0, int cb0, F f) {
  int tz = threadIdx.x; asm volatile("" : "+v"(tz));
  const int lane = tz & 63, wid = tz >> 6, wr = wid >> 1, wc = wid & 1, l31 = lane & 31, hh = lane >> 5;
  __syncthreads();
  char* st = smem + wid * 32768;
#pragma unroll
  for (int mb = 0; mb < 4; ++mb)
#pragma unroll
    for (int reg = 0; reg < 16; ++reg) {
      const int r = mb * 32 + (reg & 3) + 8 * (reg >> 2) + 4 * hh;
      float v[4] = {acc[mb][0][reg], acc[mb][1][reg], acc[mb][2][reg], acc[mb][3][reg]};
      f(wr * 128 + r, wc * 64 + l31, v);
      const int q = __builtin_amdgcn_cvt_pk_fp8_f32(v[0], v[1], 0, false);
      *(u8*)(st + r * 64 + l31) = (u8)(q & 0xff);
      *(u8*)(st + r * 64 + 32 + l31) = (u8)((q >> 8) & 0xff);
    }
  const int ch = lane & 3;
#pragma unroll 8
  for (int it = 0; it < 8; ++it) {
    const int r = it * 16 + (lane >> 2);
    const u32x4 w = *(const u32x4*)(st + r * 64 + ch * 16);
    const long rg = row0 + wr * 128 + r;
    *(u32x4*)(gbase + (rg >> 1) * 4096 + (long)(cb0 + wc) * 128 + (rg & 1) * 64 + ch * 16) = w;
  }
}
__device__ __forceinline__ void epi_store_f32_resid(f32x16 (&acc)[4][4], char* smem, const float* resid, float* out, int ld, float osc) {
  int tz = threadIdx.x; asm volatile("" : "+v"(tz));
  const int lane = tz & 63, wid = tz >> 6, wr = wid >> 1, wc = wid & 1, l31 = lane & 31, hh = lane >> 5;
  __syncthreads();
  char* st = smem + wid * 32768;
#pragma unroll
  for (int half = 0; half < 2; ++half) {
#pragma unroll
    for (int m2 = 0; m2 < 2; ++m2)
#pragma unroll
      for (int reg = 0; reg < 16; ++reg) {
        const int mb = half * 2 + m2;
        const int r = m2 * 32 + (reg & 3) + 8 * (reg >> 2) + 4 * hh;
#pragma unroll
        for (int nb = 0; nb < 4; ++nb) *(float*)(st + r * 512 + (nb * 32 + l31) * 4) = acc[mb][nb][reg];
      }
    const int ch = lane & 31, span = ch >> 4;
    const int gcol = span * 128 + wc * 64 + (ch & 15) * 4;
#pragma unroll 8
    for (int it = 0; it < 32; ++it) {
      const int r = it * 2 + (lane >> 5);
      const f32x4 a = *(const f32x4*)(st + r * 512 + ch * 16);
      const long o = (long)(wr * 128 + half * 64 + r) * ld + gcol;
      const f32x4 x = __builtin_nontemporal_load((const f32x4*)(resid + o));
      *(f32x4*)(out + o) = a * osc + x;
    }
  }
}

template <int NBV>
__device__ __forceinline__ void win_tile_r(const Params& p, char* smem, int mt, int nt) {
  f32x16 acc[4][4];
  GemmRTile t{};
  t.A = (const u8*)p.h1(); t.lda = 4096; t.aidx = nullptr; t.m0 = mt * 256; t.mvalid = 256;
  t.B = (const u8*)p.wb_in(); t.brow0 = nt * 256; t.brow1 = nt * 256 + 128; t.ldb = 4096; t.KB = 4096;
  gemmr_tile_256<false, false>(t, smem, acc);
  const int rem = NC_ - nt * 256;
  const int nv0 = rem >= 128 ? 128 : rem, nv1 = rem >= 256 ? 128 : (rem > 128 ? rem - 128 : 0);
  epi_store_bf16(acc, smem, p.proj() + (long)(mt * 256) * NC_ + nt * 256, NC_, nv0, nv1, [&](int, int, float (&)[4]) {});
}
__device__ __forceinline__ void ph_win_r(const Params& p, char* smem) {
  const int x = blockIdx.x & 7, slot = blockIdx.x >> 3;
  for (int j = slot; j < 68; j += 32) win_tile_r<4>(p, smem, 4 * x + (j & 3), j >> 2);
}
__device__ __forceinline__ void upq_tile_r(const Params& p, char* smem, int mt, int nt) {
  f32x16 acc[4][4];
  GemmRTile t{};
  t.A = (const u8*)(p.proj() + C_MQ); t.lda = NC_ * 2; t.aidx = nullptr; t.m0 = mt * 256; t.mvalid = 256;
  t.B = (const u8*)p.wb_uq(); t.brow0 = nt * 256; t.brow1 = nt * 256 + 128; t.ldb = 1024; t.KB = 1024;
  gemmr_tile_256<false, false>(t, smem, acc);
  const float* rq = p.rq() + mt * 256;
  epi_store_bf16(acc, smem, p.q() + (long)(mt * 256) * 1536 + nt * 256, 1536, 128, 128, [&](int rowl, int, float (&v)[4]) {
    const float s = rq[rowl] * QSCALE_;
#pragma unroll
    for (int nb = 0; nb < 4; ++nb) v[nb] *= s;
  });
}
__device__ __forceinline__ void upkv_tile_r(const Params& p, char* smem, int mt, int nt) {
  f32x16 acc[4][4];
  GemmRTile t{};
  t.A = (const u8*)(p.proj() + C_MKV); t.lda = NC_ * 2; t.aidx = nullptr; t.m0 = mt * 256; t.mvalid = 256;
  t.B = (const u8*)p.wb_ukv(); t.brow0 = nt * 256; t.brow1 = nt * 256 + 128; t.ldb = 1024; t.KB = 1024;
  gemmr_tile_256<false, false>(t, smem, acc);
  const float* rk = p.rkv() + mt * 256;
  epi_store_bf16(acc, smem, p.kv() + (long)(mt * 256) * 2048 + nt * 256, 2048, 128, 128, [&](int rowl, int, float (&v)[4]) {
    const float s = rk[rowl];
#pragma unroll
    for (int nb = 0; nb < 4; ++nb) v[nb] *= s;
  });
}
__device__ __forceinline__ void wout_tile_r(const Params& p, char* smem, int mt, int nt) {
  f32x16 acc[4][4];
  GemmRTile t{};
#if WOUTQ
  t.A = p.mixq(); t.lda = 2048; t.aidx = nullptr; t.m0 = mt * 256; t.mvalid = 256;
  t.B = p.wq_out(); t.brow0 = nt * 256; t.brow1 = nt * 256 + 128; t.ldb = 2048; t.KB = 2048;
  gemmrs_tile_256<false>(t, smem, acc);
  const float osc = WISCALE_;
#else
  t.A = (const u8*)p.mix(); t.lda = 4096; t.aidx = nullptr; t.m0 = mt * 256; t.mvalid = 256;
  t.B = (const u8*)p.wb_out(); t.brow0 = nt * 256; t.brow1 = nt * 256 + 128; t.ldb = 4096; t.KB = 4096;
  gemmr_tile_256<false, false>(t, smem, acc);
  const float osc = 1.0f;
#endif
  const long boff = (long)(mt * 256) * 2048 + nt * 256;
  epi_store_f32_resid(acc, smem, p.x + boff, p.x1() + boff, 2048, osc);
}

__device__ __forceinline__ void moe1q_tile(const Params& p, char* smem, const int* mo, int e, int nt, int mt) {
  f32x16 acc[4][4];
  GemmRTile t{};
  const int cnt = p.counts()[e];
  t.A = p.h2q(); t.lda = 2048; t.aidx = p.list() + e * T_ + mt * 256; t.m0 = 0; t.mvalid = min(256, cnt - mt * 256);
  t.B = p.wq_gu(); t.brow0 = (long)e * 4096 + nt * 128; t.brow1 = t.brow0 + 2048; t.ldb = 2048; t.KB = 2048;
#if MOEQ == 3
  gemmrv_tile_256<true>(t, smem, acc);
#elif MOEQ == 2
  gemmrs_tile_256<true>(t, smem, acc);
#else
  gemmr_tile_256<true, true>(t, smem, acc);
#endif
  const float* bg = p.b_gu + e * 4096 + nt * 128; const float* bu = bg + 2048;
  const int tq_ = opaque_tid(); const int cl = (tq_ >> 6 & 1) * 64 + (tq_ & 31);
  const float bgv[2] = {bg[cl], bg[cl + 32]}, buv[2] = {bu[cl], bu[cl + 32]};
  epi_store_act8(acc, smem, p.actq(), (long)(mo[e] * 256 + mt * 256), nt * 2, [&](int, int, float (&v)[4]) {
#pragma unroll
    for (int nb = 0; nb < 2; ++nb) {
      float g = fminf(v[nb] * WISCALE_ + bgv[nb], 7.0f);
      float uu = fminf(fmaxf(v[nb + 2] * WISCALE_ + buv[nb], -7.0f), 7.0f);
      v[nb] = (uu + 1.0f) * (g / (1.0f + __expf(-1.702f * g)));
    }
  });
}
__device__ __forceinline__ void moe2q_tile(const Params& p, char* smem, const int* mo, int e, int nt, int mt) {
  f32x16 acc[4][4];
  GemmRTile t{};
  t.A = p.actq(); t.lda = 2048; t.aidx = nullptr; t.m0 = mo[e] * 256 + mt * 256; t.mvalid = 256;
  t.B = p.wq_dn(); t.brow0 = (long)e * 2048 + nt * 256; t.brow1 = t.brow0 + 128; t.ldb = 2048; t.KB = 2048;
#if MOEQ == 3
  gemmrv_tile_256<false>(t, smem, acc);
#elif MOEQ == 2
  gemmrs_tile_256<false>(t, smem, acc);
#else
  gemmr_tile_256<true, false>(t, smem, acc);
#endif
  const float* bd = p.b_dn + e * 2048 + nt * 256;
  const int tq_ = opaque_tid(); const int cl = (tq_ >> 6 & 1) * 64 + (tq_ & 31);
  const float bdv[4] = {bd[cl], bd[cl + 32], bd[cl + 128], bd[cl + 160]};
  epi_store_bf16<YNT != 0>(acc, smem, p.ybuf() + (long)t.m0 * 2048 + nt * 256, 2048, 128, 128, [&](int, int, float (&v)[4]) {
#pragma unroll
    for (int nb = 0; nb < 4; ++nb) v[nb] = v[nb] * WISCALE_ + bdv[nb];
  });
}
template <int WHICH>
__device__ __forceinline__ void ph_moeq(const Params& p, char* smem) {
  int* mo = (int*)(smem + G_LDS_BYTES);
#if CVT_SPLIT
  const bool dn_first = ((blockIdx.x >> 3) & 1) != 0;
  if (WHICH == 1 && dn_first) ph_convert_dn(p, smem);
#endif
  moe_setup(p, mo);
  const int NT = (WHICH == 1) ? 16 : 8;
  const int total = mo[NE_] * NT;
#if SKEW
  { const int sl = (blockIdx.x >> 3) % 5; for (int i = 0; i < sl; ++i) __builtin_amdgcn_s_sleep(SKEW); }
#endif
  for (int round = 0;; ++round) {
    const int u = xcd_unit(round);
    if (round * 256 >= total) break;
    if (u >= total) continue;
    int e = 0;
    while (mo[e + 1] * NT <= u) ++e;
    const int local = u - mo[e] * NT, me = mo[e + 1] - mo[e];
    const int nt = UORD ? (local % NT) : (local / me), mt = UORD ? (local / NT) : (local - (local / me) * me);
    if (WHICH == 1) moe1q_tile(p, smem, mo, e, nt, mt); else moe2q_tile(p, smem, mo, e, nt, mt);
  }
#if CVT_SPLIT
  if (WHICH == 1 && !dn_first) ph_convert_dn(p, smem);
#endif
}
#define LDS_MAX 143360
#ifndef DUP
#define DUP 0
#endif
#ifndef MOEQ
#define MOEQ 1
#endif
#ifndef CVT_SPLIT
#define CVT_SPLIT 1
#endif
#ifndef CVT_STAGGER
#define CVT_STAGGER 1
#endif
#ifndef CVT_IN_P4
#define CVT_IN_P4 1
#endif
#ifndef TSTAMP
#define TSTAMP 0
#endif
#ifndef DENSER
#define DENSER 1
#endif
__global__ void __launch_bounds__(256, 1) mega(Params p) {
  extern __shared__ __attribute__((aligned(16))) char smem[];
  volatile LAS unsigned* xbw = (volatile LAS unsigned*)(smem + LDS_MAX - 16);
  if (threadIdx.x == 0) { xbw[0] = 0u; xbw[1] = 0u; xbw[2] = 0u; xbw[3] = 0u; }
  __syncthreads();
  (void)xcd_barrier_post(p.bar(), xbw);
#if TSTAMP
  unsigned long long ts0 = wall_clock64();
  int bar_no = 0;
#define XBAR() do { XcdBarrier bar_; bar_.bar = p.bar(); bar_.x = xb_xcc_id(); bar_.st = (volatile LAS unsigned*)(smem + LDS_MAX - 16); xcd_barrier(bar_); ++bar_no; if (bar_no == TSTAMP && blockIdx.x == 0 && threadIdx.x == 0) { ((float*)p.counts())[48] = (float)(wall_clock64() - ts0) * (1.0f / 100.0f); } } while (0)
#else
#define XBAR() do { XcdBarrier bar_; bar_.bar = p.bar(); bar_.x = xb_xcc_id(); bar_.st = (volatile LAS unsigned*)(smem + LDS_MAX - 16); xcd_barrier(bar_); } while (0)
#endif
#if DUP == 100
  for (int rep_ = 0; rep_ < 2; ++rep_) {
  if (rep_) XBAR();
#endif
  ph_prep0(p);
#if DUP == 33
  if (blockIdx.x < 192) gla_g1_unit(p, smem, blockIdx.x);
  else for (int i = 0; i < 5; ++i) gla_g1_unit(p, smem, 192 + (blockIdx.x - 192) * 5 + i);
#endif
#if DUP == 30
  ph_prep0(p);
#endif
#if DENSER
  ph_convert_dense(p, smem);
#endif
#if MOEQ >= 1 && CVT_IN_P4 == 0
  ph_convert(p, smem);
#if DUP == 20
  ph_convert(p, smem);
#endif
#endif
  XBAR();
#if DENSER
  ph_win_r(p, smem);
#else
  ph_win(p, smem);
#endif
#if DUP == 1
#if DENSER
  ph_win_r(p, smem);
#else
  ph_win(p, smem);
#endif
#endif
  XBAR();
  ph_prep1(p, smem);
#if DUP == 2
  ph_prep1(p, smem);
#endif
  XBAR();
#if DENSER
  upkv_tile_r(p, smem, blockIdx.x >> 3, blockIdx.x & 7);
  if (blockIdx.x < 192) upq_tile_r(p, smem, blockIdx.x / 6, blockIdx.x % 6);
#else
  upkv_tile(p, smem, blockIdx.x >> 3, blockIdx.x & 7);
  if (blockIdx.x < 192) upq_tile(p, smem, blockIdx.x / 6, blockIdx.x % 6);
#endif
  if (blockIdx.x < 192) gla_g1_unit(p, smem, blockIdx.x);
  else for (int i = 0; i < 4; ++i) gla_g1_unit(p, smem, 192 + (blockIdx.x - 192) * 4 + i);
  if (blockIdx.x < 64) gla_g1_unit(p, smem, 448 + blockIdx.x);
#if DUP == 3
  upkv_tile(p, smem, blockIdx.x >> 3, blockIdx.x & 7);
  if (blockIdx.x < 192) upq_tile(p, smem, blockIdx.x / 6, blockIdx.x % 6);
  if (blockIdx.x < 192) gla_g1_unit(p, smem, blockIdx.x);
  else for (int i = 0; i < 5; ++i) gla_g1_unit(p, smem, 192 + (blockIdx.x - 192) * 5 + i);
#endif
  XBAR();
  gla_g2_unit(p, blockIdx.x);
#if DUP == 31
  gla_g2_unit(p, blockIdx.x);
#endif
  {
    const int bh = blockIdx.x >> 4, qa = blockIdx.x & 15;
#if MOEQ >= 1 && CVT_IN_P4
    const bool cvt_first = CVT_STAGGER ? (((blockIdx.x >> 3) & 1) != 0) : false;
    if (cvt_first) { if (CVT_SPLIT) ph_convert_gu(p, smem, 0, 1); else ph_convert(p, smem); }
#endif
    attn_unit(p, smem, bh >> 3, bh & 7, 31 - qa);
    attn_unit(p, smem, bh >> 3, bh & 7, qa);
#if MOEQ >= 1 && CVT_IN_P4
    if (!cvt_first) { if (CVT_SPLIT) ph_convert_gu(p, smem, 0, 1); else ph_convert(p, smem); }
#endif
#if DUP == 44
    if (cvt_first) ph_convert(p, smem);
    attn_unit(p, smem, bh >> 3, bh & 7, 31 - qa);
    attn_unit(p, smem, bh >> 3, bh & 7, qa);
    if (!cvt_first) ph_convert(p, smem);
#endif
#if DUP == 4
    attn_unit(p, smem, bh >> 3, bh & 7, 31 - qa);
    attn_unit(p, smem, bh >> 3, bh & 7, qa);
#endif
  }
  XBAR();
  for (int u = blockIdx.x; u < 512; u += gridDim.x) gla_g3_unit(p, smem, u);
  mla_norm_tokens(p);
#if DUP == 5
  for (int u = blockIdx.x; u < 512; u += gridDim.x) gla_g3_unit(p, smem, u);
  mla_norm_tokens(p);
#endif
  XBAR();
#if DENSER
  wout_tile_r(p, smem, (blockIdx.x & 7) * 4 + ((blockIdx.x >> 3) & 3), blockIdx.x >> 5);
#else
  wout_tile(p, smem, blockIdx.x >> 3, blockIdx.x & 7);
#endif
#if DUP == 6
  wout_tile(p, smem, blockIdx.x >> 3, blockIdx.x & 7);
#endif
  XBAR();
  ffn_prep_unit(p, smem, blockIdx.x);
#if DUP == 7
  ffn_prep_unit<1>(p, smem, blockIdx.x);
#endif
  XBAR();
#if MOEQ >= 1
  ph_moeq<1>(p, smem);
#if DUP == 8
  ph_moeq<1>(p, smem);
#endif
#else
  ph_moe<1>(p, smem);
#endif
  XBAR();
#if MOEQ >= 1
  ph_moeq<2>(p, smem);
#else
  ph_moe<2>(p, smem);
#endif
#if DUP == 9
  ph_moeq<2>(p, smem);
#endif
#if DUP == 89
  XBAR();
  ph_moeq<1>(p, smem);
  XBAR();
  ph_moeq<2>(p, smem);
#endif
#if DUP == 19
  ph_moe<2, 1>(p, smem);
#endif
  XBAR();
#if DUP == 100
  ph_final(p, smem);
  }
#endif
#if TSTAMP
  {
    const float us = ((const float*)p.counts())[48];
    const float scl = 1.0f + us * (1.0f / 4000.0f);
    ph_final(p, smem, scl);
  }
#else
  ph_final(p, smem);
#endif
#if DUP == 10
  ph_final(p, smem);
#endif
#if DUP == 11
  for (int i = 0; i < 10; ++i) XBAR();
#endif
}

extern "C" void kernel_launch(void* const* d_in, const int* in_sizes, int n_in,
                              void* d_out, int out_size, void* d_ws, size_t ws_size,
                              hipStream_t stream) {
  Params P{};
  P.x = (const float*)d_in[0]; P.pos = (const int*)d_in[1];
  P.attn_norm = (const float*)d_in[2]; P.w_in = (const float*)d_in[3]; P.gate_up = (const float*)d_in[4]; P.gate_bias = (const float*)d_in[5];
  P.gla_out_norm = (const float*)d_in[6]; P.q_norm = (const float*)d_in[7]; P.w_uq = (const float*)d_in[8]; P.kv_norm = (const float*)d_in[9];
  P.w_ukv = (const float*)d_in[10]; P.mla_out_norm = (const float*)d_in[11]; P.w_out = (const float*)d_in[12]; P.ffn_norm = (const float*)d_in[13];
  P.router_w = (const float*)d_in[14]; P.router_b = (const float*)d_in[15]; P.w_gu = (const float*)d_in[16]; P.b_gu = (const float*)d_in[17];
  P.w_dn = (const float*)d_in[18]; P.b_dn = (const float*)d_in[19]; P.final_norm = (const float*)d_in[20];
  P.out = (float*)d_out;

  P.ws = (char*)d_ws;

  hipFuncSetAttribute((const void*)mega, hipFuncAttributeMaxDynamicSharedMemorySize, LDS_MAX);
  hipMemsetAsync(d_ws, 0, XCD_BAR_WORDS * sizeof(unsigned), stream);
  mega<<<256, 256, LDS_MAX, stream>>>(P);
}
```

```cpp
#define DUP 0
#define MOEQ 2
#define TSTAMP 0
#define CVT_SPLIT 1
#define CVT_IN_P4 1
#define WIN_SPLIT 1
#define CVT_IN_ATTN 0
#define YNT 0
#define ANT 0
#define BNT 1
#define UORD 0
#define LOOK1 1
#define LOOK2 0
#define WOUTQ 0
#define SKEW 0
#define CVT_STAGGER 1
#include <hip/hip_runtime.h>
#include <hip/hip_bf16.h>
#include <stdint.h>
#include <type_traits>
#define T_      8192
#define SEQ_    4096
#define D_      2048
#define NC_     4176
#define C_GQ    0
#define C_GK    512
#define C_GV    1024
#define C_GR    2048
#define C_GD    3072
#define C_MQ    3088
#define C_MKV   3600
#define C_MKR   4112
#define NE_     32
#define DFF_    2048
#define EPS_    1e-6f
typedef short bf16x8 __attribute__((ext_vector_type(8)));
typedef short s16x4 __attribute__((ext_vector_type(4)));
typedef float f32x16 __attribute__((ext_vector_type(16)));
typedef float f32x4 __attribute__((ext_vector_type(4)));
typedef float f32x2 __attribute__((ext_vector_type(2)));
typedef unsigned short u16;
typedef unsigned u32x4 __attribute__((ext_vector_type(4)));
typedef unsigned u32x2 __attribute__((ext_vector_type(2)));
#define LAS3 __attribute__((address_space(3)))
#define OPAQUE(x) asm volatile("" : "+v"(x))
#define NTHR 256
__device__ __forceinline__ int opaque_tid() { int t = threadIdx.x; asm volatile("" : "+v"(t)); return t; }

__device__ __forceinline__ unsigned pack_bf16(float a, float b) {
  typedef __bf16 bf2 __attribute__((ext_vector_type(2)));
  typedef float f2 __attribute__((ext_vector_type(2)));
  f2 v = {a, b};
  bf2 r = __builtin_convertvector(v, bf2);
  return *(unsigned*)&r;
}
__device__ __forceinline__ float bf_lo(unsigned w) { return __uint_as_float(w << 16); }
__device__ __forceinline__ float bf_hi(unsigned w) { return __uint_as_float(w & 0xffff0000u); }
__device__ __forceinline__ float bf16_to_f32(u16 v) { return __uint_as_float(((unsigned)v) << 16); }
__device__ __forceinline__ u16 f32_to_bf16(float f) { return (u16)(pack_bf16(f, 0.f) & 0xffffu); }
__device__ __forceinline__ float shflx(float v, int k) {
  int t = threadIdx.x; asm volatile("" : "+v"(t));
  return __int_as_float(__builtin_amdgcn_ds_bpermute((((t & 63) ^ k) << 2), __float_as_int(v)));
}
__device__ __forceinline__ float wave_sum(float v) {
#pragma unroll
  for (int o = 32; o > 0; o >>= 1) v += shflx(v, o);
  return v;
}
__device__ __forceinline__ unsigned off_b(unsigned row, unsigned ch) { return 256u * row + 16u * (ch ^ (((row & 3u) << 2) | ((row >> 2) & 3u))); }
__device__ __forceinline__ unsigned tr_addr(unsigned lane, unsigned c, unsigned row0  ) {
  const unsigned blk = (lane >> 4) & 1u, q = (lane & 15u) >> 2, p = lane & 3u;
  return off_b(row0 + q, 4u * c + 2u * blk + (p >> 1)) + 8u * (p & 1u);
}
__device__ __forceinline__ bf16x8 tr_frag(const char* img, unsigned lane, unsigned c, unsigned row_a, unsigned row_b) {
  s16x4 v0 = __builtin_amdgcn_ds_read_tr16_b64_v4i16((LAS3 s16x4*)(img + tr_addr(lane, c, row_a)));
  s16x4 v1 = __builtin_amdgcn_ds_read_tr16_b64_v4i16((LAS3 s16x4*)(img + tr_addr(lane, c, row_b)));
  return (bf16x8){v0[0], v0[1], v0[2], v0[3], v1[0], v1[1], v1[2], v1[3]};
}

__device__ __forceinline__ void glds16_asm(const void* gsrc, unsigned lds_dst) {
  unsigned keep;
  asm volatile("s_mov_b32 %0, m0\n\ts_mov_b32 m0, %2\n\ts_nop 0\n\tglobal_load_lds_dwordx4 %1, off\n\ts_mov_b32 m0, %0" : "=&s"(keep) : "v"(gsrc), "s"(lds_dst) : "memory");
}
__device__ __forceinline__ void glds16_asm_nt(const void* gsrc, unsigned lds_dst) {
  unsigned keep;
  asm volatile("s_mov_b32 %0, m0\n\ts_mov_b32 m0, %2\n\ts_nop 0\n\tglobal_load_lds_dwordx4 %1, off nt\n\ts_mov_b32 m0, %0" : "=&s"(keep) : "v"(gsrc), "s"(lds_dst) : "memory");
}
struct Params {
  const float *x; const int* pos;
  const float *attn_norm, *w_in, *gate_up, *gate_bias, *gla_out_norm, *q_norm, *w_uq, *kv_norm, *w_ukv, *mla_out_norm, *w_out,
              *ffn_norm, *router_w, *router_b, *w_gu, *b_gu, *w_dn, *b_dn, *final_norm;
  float* out;
  char* ws;
  __device__ __forceinline__ unsigned* bar() const { return (unsigned*)(ws + 0ull); }
  __device__ __forceinline__ int* counts() const { return (int*)(ws + 16384ull); }
  __device__ __forceinline__ u16* h1() const { return (u16*)(ws + 16640ull); }
  __device__ __forceinline__ u16* proj() const { return (u16*)(ws + 33571072ull); }
  __device__ __forceinline__ float2* cs() const { return (float2*)(ws + 101990656ull); }
  __device__ __forceinline__ float* rq() const { return (float*)(ws + 104087808ull); }
  __device__ __forceinline__ float* rkv() const { return (float*)(ws + 104120576ull); }
  __device__ __forceinline__ float* bcum() const { return (float*)(ws + 104153344ull); }
  __device__ __forceinline__ u16* q() const { return (u16*)(ws + 120930560ull); }
  __device__ __forceinline__ u16* kv() const { return (u16*)(ws + 146096384ull); }
  __device__ __forceinline__ u16* kpe() const { return (u16*)(ws + 179650816ull); }
  __device__ __forceinline__ u16* kvc() const { return (u16*)(ws + 180699392ull); }
  __device__ __forceinline__ float* dec() const { return (float*)(ws + 214253824ull); }
  __device__ __forceinline__ u16* sprev() const { return (u16*)(ws + 214515968ull); }
  __device__ __forceinline__ u16* mix() const { return (u16*)(ws + 248070400ull); }
  __device__ __forceinline__ u16* omla() const { return (u16*)(ws + 281624832ull); }
  __device__ __forceinline__ float* x1() const { return (float*)(ws + 298402048ull); }
  __device__ __forceinline__ u16* h2() const { return (u16*)(ws + 365510912ull); }
  __device__ __forceinline__ int* list() const { return (int*)(ws + 399065344ull); }
  __device__ __forceinline__ int* asg_e() const { return (int*)(ws + 400113920ull); }
  __device__ __forceinline__ int* asg_slot() const { return (int*)(ws + 400244992ull); }
  __device__ __forceinline__ float* asg_g() const { return (float*)(ws + 400376064ull); }
  __device__ __forceinline__ u16* act() const { return (u16*)(ws + 400507136ull); }
  __device__ __forceinline__ u16* ybuf() const { return (u16*)(ws + 568279296ull); }
  __device__ __forceinline__ unsigned char* wq_gu() const { return (unsigned char*)(ws + 736051456ull); }
  __device__ __forceinline__ unsigned char* wq_dn() const { return (unsigned char*)(ws + 1004486912ull); }
  __device__ __forceinline__ unsigned char* h2q() const { return (unsigned char*)(ws + 1138704640ull); }
  __device__ __forceinline__ unsigned char* actq() const { return (unsigned char*)(ws + 1155481856ull); }
  __device__ __forceinline__ u16* wb_in() const { return (u16*)(ws + 1239367936ull); }
  __device__ __forceinline__ u16* wb_uq() const { return (u16*)(ws + 1257193728ull); }
  __device__ __forceinline__ u16* wb_ukv() const { return (u16*)(ws + 1258766592ull); }
  __device__ __forceinline__ u16* wb_out() const { return (u16*)(ws + 1260863744ull); }
  __device__ __forceinline__ unsigned char* mixq() const { return (unsigned char*)(ws + 1269252352ull); }
  __device__ __forceinline__ unsigned char* wq_out() const { return (unsigned char*)(ws + 1286029568ull); }
  __device__ __forceinline__ float* pn() const { return (float*)(ws + 1290223872ull); }
};
#define WS_BYTES_USED 1311195648ull

#define XB_TMO      128
#define XB_XCNT(j)  (256  + 64 * (j))
#define XB_XSUB(j)  (1280 + 64 * (j))
#define XB_XGEN(j)  (2304 + 64 * (j))
#define XB_TOP      3328
#define XB_TOPGEN   3392
#define XCD_BAR_WORDS 3456
#define XB_SPIN_CAP (1u << 18)
#define LAS __attribute__((address_space(3)))

__device__ __forceinline__ unsigned xb_ld(unsigned* p)              { return __hip_atomic_load(p, __ATOMIC_RELAXED, __HIP_MEMORY_SCOPE_AGENT); }
__device__ __forceinline__ unsigned xb_add(unsigned* p, unsigned v) { return __hip_atomic_fetch_add(p, v, __ATOMIC_RELAXED, __HIP_MEMORY_SCOPE_AGENT); }
__device__ __forceinline__ unsigned xb_xcc_id() { return (unsigned)__builtin_amdgcn_s_getreg((3 << 11) | 20) & 0xFu; }
#define XB_SPIN(cond, bar) do { unsigned _sp = 0; while (cond) { __builtin_amdgcn_s_sleep(1); \
    if ((++_sp & 255u) == 0u) { if (xb_ld(&(bar)[XB_TMO])) break; if (_sp > XB_SPIN_CAP) { atomicAdd(&(bar)[XB_TMO], 1u); break; } } } } while (0)

struct XcdBarrier {
    unsigned* bar; unsigned x;
    volatile LAS unsigned* st;
};

__device__ __forceinline__ XcdBarrier xcd_barrier_post(unsigned* bar, volatile LAS unsigned* st) {
    XcdBarrier b; b.bar = bar; b.x = xb_xcc_id(); b.st = st;
    if (threadIdx.x == 0) (void)xb_add(&bar[XB_XCNT(b.x)], 1u);
    return b;
}
__device__ __forceinline__ void xcd_barrier_complete(unsigned* bar, unsigned x, unsigned& nloc, unsigned& nx) {
    const unsigned G = gridDim.x * gridDim.y * gridDim.z;
    unsigned sum, cnt, mine, sp = 0u;
    for (;;) {
        sum = 0u; cnt = 0u; mine = 0u;
#pragma unroll
        for (unsigned j = 0; j < 16; ++j) { const unsigned c = xb_ld(&bar[XB_XCNT(j)]); sum += c; cnt += (c > 0u) ? 1u : 0u; mine = (j == x) ? c : mine; }
        if (sum == G) break;
        __builtin_amdgcn_s_sleep(1);
        if ((++sp & 255u) == 0u) { if (xb_ld(&bar[XB_TMO])) break; if (sp > XB_SPIN_CAP) { atomicAdd(&bar[XB_TMO], 1u); break; } }
    }
    nloc = mine > 0u ? mine : 1u; nx = cnt > 0u ? cnt : 1u;
}

__device__ __forceinline__ void xcd_barrier(const XcdBarrier& b) {
    asm volatile("s_waitcnt vmcnt(0)" ::: "memory");
    __syncthreads();
    if (threadIdx.x == 0) {
        unsigned* bar = b.bar;
        __builtin_amdgcn_s_waitcnt(0);
        unsigned nloc = b.st[0], nx = b.st[1];
        if (nloc == 0u) { xcd_barrier_complete(bar, b.x, nloc, nx); b.st[0] = nloc; b.st[1] = nx; }
        const unsigned old = xb_add(&bar[XB_XSUB(b.x)], 1u);
        const unsigned gen = old / nloc;
        if (old + 1u == (gen + 1u) * nloc) {
            __builtin_amdgcn_fence(__ATOMIC_RELEASE, "agent");
            asm volatile("s_waitcnt vmcnt(0)" ::: "memory");
            const unsigned og = xb_add(&bar[XB_TOP], 1u);
            const unsigned tg = og / nx;
            if (og + 1u == (tg + 1u) * nx) xb_add(&bar[XB_TOPGEN], 1u);
            else XB_SPIN(xb_ld(&bar[XB_TOPGEN]) == tg, bar);
            __builtin_amdgcn_fence(__ATOMIC_ACQUIRE, "agent");
            xb_add(&bar[XB_XGEN(b.x)], 1u);
            asm volatile("s_waitcnt vmcnt(0)" ::: "memory");
        } else {
            XB_SPIN(xb_ld(&bar[XB_XGEN(b.x)]) == gen, bar);
            __builtin_amdgcn_fence(__ATOMIC_ACQUIRE, "agent");
            asm volatile("s_waitcnt vmcnt(0)" ::: "memory");
        }
    }
    __syncthreads();
}

#define G_A_OFF(s)  ((s) * 65536)
#define G_B_OFF(s)  ((s) * 65536 + 32768)
#define G_LDS_BYTES 131072

struct GemmTile {
  const u16* A; int lda;
  const int* aidx;
  int m0, mvalid;
  const float* B0; const float* B1;
  int ldb; int nv0, nv1;
  const float* kscale;
  int K;
};

template <int NB, bool KSCALE, bool GATHER>
__device__ __forceinline__ void gemm_tile_256(const GemmTile& t, char* smem, f32x16 (&acc)[4][4]) {
  int tz0 = threadIdx.x; asm volatile("" : "+v"(tz0));
  const int tid = tz0, lane = tid & 63, wid = tid >> 6, wr = wid >> 1, wc = wid & 1;
  const int l31 = lane & 31, hh = lane >> 5;
#pragma unroll
  for (int i = 0; i < 4; ++i)
#pragma unroll
    for (int j = 0; j < 4; ++j)
#pragma unroll
      for (int r = 0; r < 16; ++r) acc[i][j][r] = 0.f;

  const int a_c = (tid & 7) ^ ((tid >> 4) & 7);
  const u16* a_src[GATHER ? 8 : 1];
  if (GATHER) {
#pragma unroll
    for (int i = 0; i < (GATHER ? 8 : 1); ++i) {
      int r = (tid >> 3) + 32 * i;
      int rr = r < t.mvalid ? r : 0;
      a_src[i] = t.A + (long)t.aidx[rr] * t.lda + a_c * 8;
    }
  } else {
    a_src[0] = t.A + (long)(t.m0 + (tid >> 3)) * t.lda + a_c * 8;
  }
  const long a_step = 32L * t.lda;
  const int b_n4 = tid & 63, b_k = tid >> 6;
  const int b_k_u = __builtin_amdgcn_readfirstlane(b_k);
  const int b_img = b_n4 >> 5, b_ch = (b_n4 >> 1) & 15, b_half = b_n4 & 1;
  const bool b_ok = ((b_n4 & 31) * 4) < (b_img ? t.nv1 : t.nv0);
  const int b_loff = (b_ok ? ((b_img ? (int)(t.B1 - t.B0) : 0) + (b_n4 & 31) * 4) : 0) + b_k * t.ldb;
  f32x4 breg[16];

  const unsigned a_lds0 = (unsigned)(size_t)smem + (unsigned)__builtin_amdgcn_readfirstlane(wid) * 1024u;
  auto issue_a = [&](int kt, int s, int i) {
    glds16_asm((const void*)((GATHER ? a_src[GATHER ? i : 0] : a_src[0] + i * a_step) + kt * 64), a_lds0 + G_A_OFF(s) + i * 4096);
  };
  auto issue_b = [&](int kt, int j) {
    const float* ptr = t.B0 + (long)(kt * 64 + 4 * j) * t.ldb + b_loff;
    asm volatile("global_load_dwordx4 %0, %1, off" : "=v"(breg[j]) : "v"(ptr) : "memory");
  };
  auto write_b = [&](int kt, int s, int j) {
    const int k = b_k + 4 * j;
    f32x4 v = breg[j];
    if (KSCALE) { float sc = t.kscale[kt * 64 + b_k_u + 4 * j]; v *= sc; }
    if (!b_ok) v = (f32x4){0.f, 0.f, 0.f, 0.f};
    u32x2 w = {pack_bf16(v[0], v[1]), pack_bf16(v[2], v[3])};
    *(u32x2*)(smem + G_B_OFF(s) + b_img * 16384 + off_b(k, b_ch) + 8 * b_half) = w;
  };
#define WAITQ(N, g) asm volatile("s_waitcnt vmcnt(" #N ")" : "+v"(breg[4 * (g)]), "+v"(breg[4 * (g) + 1]), "+v"(breg[4 * (g) + 2]), "+v"(breg[4 * (g) + 3]) :: "memory")

  unsigned a_rd[4], b_rd[2][2];
#pragma unroll
  for (int ks = 0; ks < 4; ++ks) { const int row = wr * 128 + l31; a_rd[ks] = row * 128 + (((2 * ks + hh) ^ ((row >> 1) & 7)) * 16); }
#pragma unroll
  for (int tt = 0; tt < 2; ++tt)
#pragma unroll
    for (int nl = 0; nl < 2; ++nl) b_rd[tt][nl] = tr_addr(lane, wc * 2 + nl, 8 * hh + 4 * tt);
  auto load_a = [&](const char* As, int ks, bf16x8 (&af)[4]) {
#pragma unroll
    for (int mb = 0; mb < 4; ++mb) af[mb] = *(const bf16x8*)(As + a_rd[ks] + mb * 4096);
  };
  auto load_b1 = [&](const char* Bs, int ks, int nb, bf16x8& bfr) {
    const char* bi = Bs + (nb >> 1) * 16384 + ks * 4096;
    s16x4 v0 = __builtin_amdgcn_ds_read_tr16_b64_v4i16((LAS3 s16x4*)(bi + b_rd[0][nb & 1]));
    s16x4 v1 = __builtin_amdgcn_ds_read_tr16_b64_v4i16((LAS3 s16x4*)(bi + b_rd[1][nb & 1]));
    bfr = (bf16x8){v0[0], v0[1], v0[2], v0[3], v1[0], v1[1], v1[2], v1[3]};
  };

  auto kstep = [&](int kt, auto mode_tag, bool has1, bool has2) {
    constexpr int MODE = decltype(mode_tag)::value;
    const int s = kt & 1;
    const char* As = smem + G_A_OFF(s);
    const char* Bs = smem + G_B_OFF(s);
    bf16x8 a0[4], a1[4], bq[NB];
    load_a(As, 0, a0);
#pragma unroll
    for (int nb = 0; nb < NB; ++nb) load_b1(Bs, 0, nb, bq[nb]);
    __builtin_amdgcn_sched_barrier(0);
#pragma unroll
    for (int g = 0; g < 4; ++g) {
      bf16x8 (&ac)[4] = (g & 1) ? a1 : a0;
      bf16x8 (&an)[4] = (g & 1) ? a0 : a1;
      if (g < 3) load_a(As, g + 1, an);
      __builtin_amdgcn_sched_barrier(0);
#pragma unroll
      for (int nb = 0; nb < NB; ++nb) {
#pragma unroll
        for (int mb = 0; mb < 4; ++mb)
          acc[mb][nb] = __builtin_amdgcn_mfma_f32_32x32x16_bf16(ac[mb], bq[nb], acc[mb][nb], 0, 0, 0);
        __builtin_amdgcn_sched_barrier(0);
        if (g < 3) load_b1(Bs, g + 1, nb, bq[nb]);
        if (nb == 0 && g < 2 && has1) { issue_a(kt + 1, s ^ 1, 4 * g + 0); issue_a(kt + 1, s ^ 1, 4 * g + 1); }
        if (nb == 1 % NB && g < 2 && has1 && NB > 1) { issue_a(kt + 1, s ^ 1, 4 * g + 2); issue_a(kt + 1, s ^ 1, 4 * g + 3); }
        if (NB == 1 && nb == 0 && g < 2 && has1) { issue_a(kt + 1, s ^ 1, 4 * g + 2); issue_a(kt + 1, s ^ 1, 4 * g + 3); }
        if (nb == NB - 1 && has1) {
          if (MODE == 2) { if (g == 0) WAITQ(20, 0); else if (g == 1) WAITQ(20, 1); else if (g == 2) WAITQ(20, 2); else WAITQ(20, 3); }
          else if (MODE == 1) { if (g == 0) WAITQ(16, 0); else if (g == 1) WAITQ(20, 1); else if (g == 2) WAITQ(20, 2); else WAITQ(20, 3); }
          else { if (g == 0) WAITQ(0, 0); else if (g == 1) WAITQ(0, 1); else if (g == 2) WAITQ(0, 2); else WAITQ(0, 3); }
#pragma unroll
          for (int i = 0; i < 4; ++i) write_b(kt + 1, s ^ 1, 4 * g + i);
          if (has2) {
#pragma unroll
            for (int i = 0; i < 4; ++i) issue_b(kt + 2, 4 * g + i);
          }
        }
        __builtin_amdgcn_sched_barrier(0);
      }
    }
    if (has1) {
      if (MODE == 0) asm volatile("s_waitcnt vmcnt(0)" ::: "memory");
      else asm volatile("s_waitcnt vmcnt(12)" ::: "memory");
      __syncthreads();
    }
  };

  const int nk = t.K >> 6;
  __syncthreads();
#pragma unroll
  for (int j = 0; j < 16; ++j) issue_b(0, j);
#pragma unroll
  for (int i = 0; i < 8; ++i) issue_a(0, 0, i);
  WAITQ(8, 0); WAITQ(8, 1); WAITQ(8, 2); WAITQ(8, 3);
#pragma unroll
  for (int j = 0; j < 16; ++j) write_b(0, 0, j);
#pragma unroll
  for (int j = 0; j < 16; ++j) issue_b(1, j);
  asm volatile("s_waitcnt vmcnt(16)" ::: "memory");
  __syncthreads();
  kstep(0, std::integral_constant<int, 1>{}, true, true);
  for (int kt = 1; kt < nk - 2; ++kt) kstep(kt, std::integral_constant<int, 2>{}, true, true);
  kstep(nk - 2, std::integral_constant<int, 0>{}, true, false);
  kstep(nk - 1, std::integral_constant<int, 0>{}, false, false);
#undef WAITQ
}
template <int NB, class F>
__device__ __forceinline__ void acc_foreach_row(f32x16 (&acc)[4][4], F f) {
  int tz = threadIdx.x; asm volatile("" : "+v"(tz));
  const int lane = tz & 63, wid = tz >> 6, wr = wid >> 1, wc = wid & 1;
  const int l31 = lane & 31, hh = lane >> 5;
#pragma unroll
  for (int mb = 0; mb < 4; ++mb)
#pragma unroll
    for (int reg = 0; reg < 16; ++reg) {
      const int rowl = wr * 128 + mb * 32 + (reg & 3) + 8 * (reg >> 2) + 4 * hh;
      float v[NB];
#pragma unroll
      for (int nb = 0; nb < NB; ++nb) v[nb] = acc[mb][nb][reg];
      f(rowl, wc * 64 + l31, v);
      asm volatile("" ::: "memory");
    }
}
__device__ __forceinline__ void ph_prep0(const Params& p) {
  const int tid_ = opaque_tid(); const int lane = tid_ & 63, wid = tid_ >> 6;
  if (blockIdx.x == 0 && tid_ < 64) p.counts()[tid_] = 0;
  for (int t = blockIdx.x * 4 + wid; t < T_; t += gridDim.x * 4) {
    const float* xr = p.x + (long)t * 2048;
    f32x4 v[8]; float ss = 0.f;
#pragma unroll
    for (int j = 0; j < 8; ++j) { v[j] = __builtin_nontemporal_load((const f32x4*)(xr + j * 256 + lane * 4)); ss += v[j][0] * v[j][0] + v[j][1] * v[j][1] + v[j][2] * v[j][2] + v[j][3] * v[j][3]; }
    ss = wave_sum(ss);
    const float r = rsqrtf(ss * (1.0f / 2048.0f) + EPS_);
#pragma unroll
    for (int j = 0; j < 8; ++j) {
      f32x4 g = *(const f32x4*)(p.attn_norm + j * 256 + lane * 4);
      u32x2 w = {pack_bf16(v[j][0] * r * g[0], v[j][1] * r * g[1]), pack_bf16(v[j][2] * r * g[2], v[j][3] * r * g[3])};
      *(u32x2*)(p.h1() + (long)t * 2048 + j * 256 + lane * 4) = w;
    }
    if (lane < 32) {
      float inv = 1.0f / powf(10000.0f, (float)(2 * lane) / 64.0f);
      float ang = (float)p.pos[t] * inv;
      double a = (double)ang;
      double k = rint(a * 0.15915494309189535);
      float rf = (float)fma(-k, 6.283185307179586, a);
      p.cs()[t * 32 + lane] = make_float2(__cosf(rf), __sinf(rf));
    }
  }
}

template <int NB>
__device__ __forceinline__ void win_tile(const Params& p, char* smem, int mt, int nt) {
  f32x16 acc[4][4];
  GemmTile t{};
  t.A = p.h1(); t.lda = 2048; t.aidx = nullptr; t.m0 = mt * 256; t.mvalid = 256;
  t.B0 = p.w_in + nt * 256; t.B1 = t.B0 + 128; t.ldb = NC_;
  const int rem = NC_ - nt * 256;
  t.nv0 = rem >= 128 ? 128 : rem; t.nv1 = rem >= 256 ? 128 : (rem > 128 ? rem - 128 : 0);
  t.kscale = nullptr; t.K = 2048;
  gemm_tile_256<NB, false, false>(t, smem, acc);
  u16* base = p.proj() + (long)(mt * 256) * NC_ + nt * 256;
  const int nv0 = t.nv0, nv1 = t.nv1;
  acc_foreach_row<NB>(acc, [&](int rowl, int coll, float (&v)[NB]) {
    u16* rp = base + (long)rowl * NC_ + coll;
    OPAQUE(rp);
#pragma unroll
    for (int nb = 0; nb < NB; ++nb) {
      const int c = (nb & 1) * 32 + coll;
      const int lim = (nb >> 1) ? nv1 : nv0;
      if (c < lim) rp[(nb >> 1) * 128 + (nb & 1) * 32] = f32_to_bf16(v[nb]);
    }
  });
}
__device__ __forceinline__ void ph_win(const Params& p, char* smem) {
  const int x = blockIdx.x & 7, slot = blockIdx.x >> 3;
  for (int j = slot; j < 64; j += 32) win_tile<4>(p, smem, 4 * x + (j & 3), j >> 2);
  if (slot < 4) win_tile<2>(p, smem, 4 * x + slot, 16);
}

__device__ __forceinline__ void ph_prep1(const Params& p, char* smem) {
  float* gds = (float*)smem;
  float* cums = (float*)(smem + 4096);
  const int tid = opaque_tid(), lane = tid & 63, wid = tid >> 6;
  for (int u = blockIdx.x; u < 512; u += gridDim.x) {
    const int ch = u >> 2, h = u & 3; const int t0 = ch * 64;
    __syncthreads();
    {
      const int tl = tid >> 2, r4 = (tid & 3) * 4;
      u32x2 w = *(const u32x2*)(p.proj() + (long)(t0 + tl) * NC_ + C_GD + r4);
      gds[tl * 16 + r4 + 0] = bf_lo(w[0]); gds[tl * 16 + r4 + 1] = bf_hi(w[0]);
      gds[tl * 16 + r4 + 2] = bf_lo(w[1]); gds[tl * 16 + r4 + 3] = bf_hi(w[1]);
    }
    const int c = tid & 127, half = tid >> 7;
    float gu[16];
#pragma unroll
    for (int r = 0; r < 16; ++r) gu[r] = p.gate_up[r * 512 + h * 128 + c];
    const float bias = p.gate_bias[h * 128 + c];
    __syncthreads();
    float run = 0.f;
    for (int i = 0; i < 32; ++i) {
      const int tl = half * 32 + i;
      float z = bias;
#pragma unroll
      for (int r = 0; r < 16; ++r) z = fmaf(gds[tl * 16 + r], gu[r], z);
      const float ls = fminf(z, 0.f) - log1pf(__expf(-fabsf(z)));
      run += ls * (1.0f / 16.0f);
      cums[tl * 128 + c] = run;
    }
    __syncthreads();
    {
      const float add = cums[31 * 128 + c];
      for (int i = 0; i < 32; ++i) {
        const int tl = half * 32 + i;
        float v = cums[tl * 128 + c] + (half ? add : 0.f);
        p.bcum()[(long)(t0 + tl) * 512 + h * 128 + c] = v;
      }
    }
    for (int i = 0; i < 4; ++i) {
      const long t = t0 + h * 16 + wid * 4 + i;
      const u16* pr = p.proj() + t * NC_;
      u32x4 a = *(const u32x4*)(pr + C_MQ + lane * 8);
      float sa = 0.f, sb = 0.f;
#pragma unroll
      for (int k = 0; k < 4; ++k) { float l = bf_lo(a[k]), hgh = bf_hi(a[k]); sa += l * l + hgh * hgh; }
#if WIN_SPLIT
      auto pn_sum = [&](int col) { float s = 0.f;
#pragma unroll
        for (int kc = 0; kc < 8; ++kc) s += p.pn()[(long)kc * (8192 * 80) + t * 80 + col];
        return s; };
      const float pv = bf16_to_f32(f32_to_bf16(pn_sum(lane)));
      u32x4 b = {0u, 0u, 0u, 0u};
      if (lane < 62) b = *(const u32x4*)(pr + C_MKV + lane * 8);
#pragma unroll
      for (int k = 0; k < 4; ++k) { float l = bf_lo(b[k]), hgh = bf_hi(b[k]); sb += l * l + hgh * hgh; }
      if (lane < 16) sb += pv * pv;
#else
      u32x4 b = *(const u32x4*)(pr + C_MKV + lane * 8);
#pragma unroll
      for (int k = 0; k < 4; ++k) { float l = bf_lo(b[k]), hgh = bf_hi(b[k]); sb += l * l + hgh * hgh; }
#endif
      sa = wave_sum(sa); sb = wave_sum(sb);
      if (lane == 0) { p.rq()[t] = rsqrtf(sa * (1.0f / 512.0f) + EPS_); p.rkv()[t] = rsqrtf(sb * (1.0f / 512.0f) + EPS_); }
#if WIN_SPLIT
      {
        const float v0 = pv;
        const float v1 = (lane < 16) ? bf16_to_f32(f32_to_bf16(pn_sum(64 + lane))) : 0.f;
        u16* pw = p.proj() + t * NC_ + 4096;
        pw[lane] = f32_to_bf16(v0);
        if (lane < 16) pw[64 + lane] = f32_to_bf16(v1);
        const float t1 = __int_as_float(__builtin_amdgcn_ds_bpermute(((lane + 16) & 63) << 2, __float_as_int(v0)));
        const float t2a = __int_as_float(__builtin_amdgcn_ds_bpermute(((lane + 48) & 63) << 2, __float_as_int(v0)));
        const float t2b = __int_as_float(__builtin_amdgcn_ds_bpermute(((lane - 16) & 63) << 2, __float_as_int(v1)));
        if (lane < 32) {
          const float t2 = (lane < 16) ? t2a : t2b;
          const float2 cs = p.cs()[t * 32 + lane];
          p.kpe()[t * 64 + lane] = f32_to_bf16(t1 * cs.x - t2 * cs.y);
          p.kpe()[t * 64 + lane + 32] = f32_to_bf16(t1 * cs.y + t2 * cs.x);
        }
      }
#else
      if (lane < 32) {
        const float t1 = bf16_to_f32(pr[C_MKR + lane]), t2 = bf16_to_f32(pr[C_MKR + lane + 32]);
        const float2 cs = p.cs()[t * 32 + lane];
        p.kpe()[t * 64 + lane] = f32_to_bf16(t1 * cs.x - t2 * cs.y);
        p.kpe()[t * 64 + lane + 32] = f32_to_bf16(t1 * cs.y + t2 * cs.x);
      }
#endif
    }
  }
}

#define QSCALE_ (0.07216878364870322f * 1.4426950408889634f)
__device__ __forceinline__ void upq_tile(const Params& p, char* smem, int mt, int nt) {
  f32x16 acc[4][4];
  GemmTile t{};
  t.A = p.proj() + C_MQ; t.lda = NC_; t.aidx = nullptr; t.m0 = mt * 256; t.mvalid = 256;
  t.B0 = p.w_uq + nt * 256; t.B1 = t.B0 + 128; t.ldb = 1536; t.nv0 = 128; t.nv1 = 128; t.kscale = p.q_norm; t.K = 512;
  gemm_tile_256<4, true, false>(t, smem, acc);
  u16* base = p.q() + (long)(mt * 256) * 1536 + nt * 256;
  const float* rq = p.rq() + mt * 256;
  acc_foreach_row<4>(acc, [&](int rowl, int coll, float (&v)[4]) {
    u16* rp = base + (long)rowl * 1536 + coll;
    OPAQUE(rp);
    const float s = rq[rowl] * QSCALE_;
#pragma unroll
    for (int nb = 0; nb < 4; ++nb) rp[(nb >> 1) * 128 + (nb & 1) * 32] = f32_to_bf16(v[nb] * s);
  });
}
__device__ __forceinline__ void upkv_tile(const Params& p, char* smem, int mt, int nt) {
  f32x16 acc[4][4];
  GemmTile t{};
  t.A = p.proj() + C_MKV; t.lda = NC_; t.aidx = nullptr; t.m0 = mt * 256; t.mvalid = 256;
  t.B0 = p.w_ukv + nt * 256; t.B1 = t.B0 + 128; t.ldb = 2048; t.nv0 = 128; t.nv1 = 128; t.kscale = p.kv_norm; t.K = 512;
  gemm_tile_256<4, true, false>(t, smem, acc);
  u16* base = p.kv() + (long)(mt * 256) * 2048 + nt * 256;
  const float* rk = p.rkv() + mt * 256;
  acc_foreach_row<4>(acc, [&](int rowl, int coll, float (&v)[4]) {
    u16* rp = base + (long)rowl * 2048 + coll;
    OPAQUE(rp);
    const float s = rk[rowl];
#pragma unroll
    for (int nb = 0; nb < 4; ++nb) rp[(nb >> 1) * 128 + (nb & 1) * 32] = f32_to_bf16(v[nb] * s);
  });
}
#define WSCALE_  128.0f
#define WISCALE_ 0.0078125f
typedef unsigned char u8;
struct CvtUnit { const float* src; u8* dst; int ldn; };
__device__ __forceinline__ CvtUnit cvt8_decode(const Params& p, int u);
#define AT_KSTRIDE 400
#define AT_KBYTES  (64 * AT_KSTRIDE)
#define AT_STAGE   (AT_KBYTES + 16384)
#define AT_LDS_BYTES (2 * AT_STAGE)

#define AT_CVT_T(par) (smem + AT_LDS_BYTES + (par) * 16384)
__device__ __forceinline__ void attn_unit(const Params& p, char* smem, int b, int h, int qb, int& ci) {
  const int tid = opaque_tid(), lane = tid & 63, wid = tid >> 6, l31 = lane & 31, hh = lane >> 5;
  const long tq = (long)b * SEQ_ + qb * 128 + wid * 32 + l31;
  bf16x8 qf[12];
  {
    const u16* qp = p.q() + (tq * 8 + h) * 192 + 8 * hh;
#pragma unroll
    for (int ks = 0; ks < 12; ++ks) qf[ks] = *(const bf16x8*)(qp + 16 * ks);
#pragma unroll
    for (int s = 0; s < 2; ++s) {
      const float2* cp = p.cs() + tq * 32 + 16 * s + 8 * hh;
      bf16x8 lo = qf[8 + s], hi = qf[10 + s], nlo, nhi;
#pragma unroll
      for (int j = 0; j < 8; j += 2) {
        float2 c0 = cp[j], c1 = cp[j + 1];
        float a0 = bf16_to_f32((u16)lo[j]), a1 = bf16_to_f32((u16)lo[j + 1]);
        float b0 = bf16_to_f32((u16)hi[j]), b1 = bf16_to_f32((u16)hi[j + 1]);
        unsigned wl = pack_bf16(a0 * c0.x - b0 * c0.y, a1 * c1.x - b1 * c1.y);
        unsigned wh = pack_bf16(a0 * c0.y + b0 * c0.x, a1 * c1.y + b1 * c1.x);
        nlo[j] = (short)(wl & 0xffff); nlo[j + 1] = (short)(wl >> 16);
        nhi[j] = (short)(wh & 0xffff); nhi[j + 1] = (short)(wh >> 16);
      }
      qf[8 + s] = nlo; qf[10 + s] = nhi;
    }
  }
  u32x4 kregA[6], vregA[4], kregB[6], vregB[4];
  const long tk0 = (long)b * SEQ_;
  auto load_tile = [&](int kt, u32x4 (&kreg)[6], u32x4 (&vreg)[4]) {
    const long tb = tk0 + kt * 64;
#pragma unroll
    for (int i = 0; i < 4; ++i) {
      const int pp = i * 256 + tid; const int key = pp >> 4, c = pp & 15;
      const u16* rowp = p.kv() + ((tb + key) * 8 + h) * 256 + c * 8;
      kreg[i] = *(const u32x4*)rowp;
      vreg[i] = *(const u32x4*)(rowp + 128);
    }
#pragma unroll
    for (int i = 0; i < 2; ++i) {
      const int pp = i * 256 + tid; const int key = pp >> 3, c = pp & 7;
      kreg[4 + i] = *(const u32x4*)(p.kpe() + (tb + key) * 64 + c * 8);
    }
  };
  auto store_tile = [&](int s, u32x4 (&kreg)[6], u32x4 (&vreg)[4]) {
    char* Ks = smem + s * AT_STAGE; char* Vs = Ks + AT_KBYTES;
#pragma unroll
    for (int i = 0; i < 4; ++i) {
      const int pp = i * 256 + tid; const int key = pp >> 4, c = pp & 15;
      *(u32x4*)(Ks + key * AT_KSTRIDE + c * 16) = kreg[i];
      *(u32x4*)(Vs + off_b(key, c)) = vreg[i];
    }
#pragma unroll
    for (int i = 0; i < 2; ++i) {
      const int pp = i * 256 + tid; const int key = pp >> 3, c = pp & 7;
      *(u32x4*)(Ks + key * AT_KSTRIDE + (16 + c) * 16) = kreg[4 + i];
    }
  };

  f32x16 o[4];
#pragma unroll
  for (int c = 0; c < 4; ++c)
#pragma unroll
    for (int r = 0; r < 16; ++r) o[c][r] = 0.f;
  float m = -1e30f, l = 0.f;
  const int nt = 2 * qb + 2;
  const int qpos = qb * 128 + wid * 32 + l31;

  __syncthreads();
  load_tile(0, kregA, vregA);
  store_tile(0, kregA, vregA);
  load_tile(1, kregB, vregB);
  if (nt > 2) load_tile(2, kregA, vregA);
  __syncthreads();
  auto tile_body = [&](int kt, int s) {
    const char* Ks = smem + s * AT_STAGE; const char* Vs = Ks + AT_KBYTES;
    const bool active = (kt * 64) <= (qb * 128 + wid * 32 + 31);
    if (active) {
      f32x16 sc[2];
#pragma unroll
      for (int kb = 0; kb < 2; ++kb) {
#pragma unroll
        for (int r = 0; r < 16; ++r) sc[kb][r] = 0.f;
#pragma unroll
        for (int ks = 0; ks < 12; ++ks) {
          bf16x8 a = *(const bf16x8*)(Ks + (kb * 32 + l31) * AT_KSTRIDE + (2 * ks + hh) * 16);
          sc[kb] = __builtin_amdgcn_mfma_f32_32x32x16_bf16(a, qf[ks], sc[kb], 0, 0, 0);
        }
      }
      if (kt >= 2 * qb) {
#pragma unroll
        for (int kb = 0; kb < 2; ++kb)
#pragma unroll
          for (int r = 0; r < 16; ++r) {
            const int key = kt * 64 + kb * 32 + (r & 3) + 8 * (r >> 2) + 4 * hh;
            if (key > qpos) sc[kb][r] = -1e30f;
          }
      }
      float mx = sc[0][0];
#pragma unroll
      for (int kb = 0; kb < 2; ++kb)
#pragma unroll
        for (int r = 0; r < 16; ++r) mx = fmaxf(mx, sc[kb][r]);
      mx = fmaxf(mx, shflx(mx, 32));
      const float mn = fmaxf(m, mx);
      const float alpha = __builtin_amdgcn_exp2f(m - mn);
      m = mn;
      float ps = 0.f;
      bf16x8 pf[4];
#pragma unroll
      for (int kb = 0; kb < 2; ++kb)
#pragma unroll
        for (int s2 = 0; s2 < 2; ++s2) {
          float e[8];
#pragma unroll
          for (int j = 0; j < 8; ++j) { e[j] = __builtin_amdgcn_exp2f(sc[kb][8 * s2 + j] - mn); ps += e[j]; }
          unsigned w0 = pack_bf16(e[0], e[1]), w1 = pack_bf16(e[2], e[3]), w2 = pack_bf16(e[4], e[5]), w3 = pack_bf16(e[6], e[7]);
          u32x4 w = {w0, w1, w2, w3};
          pf[kb * 2 + s2] = *(bf16x8*)&w;
        }
      l = l * alpha + ps;
#pragma unroll
      for (int c = 0; c < 4; ++c)
#pragma unroll
        for (int r = 0; r < 16; ++r) o[c][r] *= alpha;
#pragma unroll
      for (int c = 0; c < 4; ++c)
#pragma unroll
        for (int kk = 0; kk < 4; ++kk) {
          const unsigned rbase = 32 * (kk >> 1) + 16 * (kk & 1) + 4 * hh;
          bf16x8 a = tr_frag(Vs, lane, c, rbase, rbase + 8);
          o[c] = __builtin_amdgcn_mfma_f32_32x32x16_bf16(a, pf[kk], o[c], 0, 0, 0);
        }
    }
  };
#if CVT_IN_ATTN
  f32x4 cv[16];
  bool cv_inflight = false;
  u8* cv_dst = nullptr;
  bool cv_emitted = false;
  int cv_par = 0;
  auto cv_issue = [&]() {
    if (ci < 64) {
      const CvtUnit c = cvt8_decode(p, blockIdx.x + 256 * ci);
      const float* src = c.src + (long)(wid * 16) * c.ldn + lane * 4;
#pragma unroll
      for (int j = 0; j < 16; ++j) { const float* ptr = src + (long)j * c.ldn; asm volatile("global_load_dwordx4 %0, %1, off nt" : "=a"(cv[j]) : "v"(ptr) : "memory"); }
      cv_dst = c.dst; cv_inflight = true; ++ci;
    } else cv_inflight = false;
  };
  auto cv_emit = [&]() {
    cv_emitted = cv_inflight;
    if (cv_inflight) {
      asm volatile("s_waitcnt vmcnt(0)" : "+a"(cv[0]), "+a"(cv[1]), "+a"(cv[2]), "+a"(cv[3]), "+a"(cv[4]), "+a"(cv[5]), "+a"(cv[6]), "+a"(cv[7]),
                   "+a"(cv[8]), "+a"(cv[9]), "+a"(cv[10]), "+a"(cv[11]), "+a"(cv[12]), "+a"(cv[13]), "+a"(cv[14]), "+a"(cv[15]) :: "memory");
      char* T = AT_CVT_T(cv_par);
#pragma unroll
      for (int cc = 0; cc < 4; ++cc) {
        u32x4 x4;
#pragma unroll
        for (int q = 0; q < 4; ++q) {
          int x = 0;
          x = __builtin_amdgcn_cvt_pk_fp8_f32(cv[4 * q][cc] * WSCALE_, cv[4 * q + 1][cc] * WSCALE_, x, false);
          x = __builtin_amdgcn_cvt_pk_fp8_f32(cv[4 * q + 2][cc] * WSCALE_, cv[4 * q + 3][cc] * WSCALE_, x, true);
          x4[q] = (unsigned)x;
        }
        *(u32x4*)(T + (lane * 4 + cc) * 64 + wid * 16) = x4;
      }
    }
  };
  u8* cv_dst_e = nullptr;
  auto cv_flush = [&]() {
    if (cv_emitted) {
      const char* T = AT_CVT_T(cv_par);
#pragma unroll
      for (int i = 0; i < 4; ++i) {
        const int n = (tid >> 2) + 64 * i, ch = tid & 3;
        __builtin_nontemporal_store(*(const u32x4*)(T + n * 64 + ch * 16), (u32x4*)(cv_dst_e + (long)(n >> 1) * 4096 + (n & 1) * 64 + ch * 16));
      }
      cv_par ^= 1;
    }
  };
#define CV_BEFORE_BAR() do { cv_emit(); cv_dst_e = cv_dst; cv_issue(); } while (0)
#define CV_AFTER_BAR()  do { cv_flush(); } while (0)
  cv_issue();
#else
#define CV_BEFORE_BAR() do {} while (0)
#define CV_AFTER_BAR()  do {} while (0)
#endif
  for (int kt = 0; kt < nt; kt += 2) {
    tile_body(kt, 0);
    CV_BEFORE_BAR();
    store_tile(1, kregB, vregB);
    if (kt + 3 < nt) load_tile(kt + 3, kregB, vregB);
    __syncthreads();
    CV_AFTER_BAR();
    tile_body(kt + 1, 1);
    CV_BEFORE_BAR();
    if (kt + 2 < nt) {
      store_tile(0, kregA, vregA);
      if (kt + 4 < nt) load_tile(kt + 4, kregA, vregA);
    }
    __syncthreads();
    CV_AFTER_BAR();
  }
#if CVT_IN_ATTN
  cv_emit(); cv_dst_e = cv_dst; cv_inflight = false;
  __syncthreads();
  cv_flush();
#endif
#undef CV_BEFORE_BAR
#undef CV_AFTER_BAR
  l = l + shflx(l, 32);
  const float inv = 1.0f / l;
  u16* op = p.omla() + tq * 1024 + h * 128 + 4 * hh;
#pragma unroll
  for (int c = 0; c < 4; ++c)
#pragma unroll
    for (int rg = 0; rg < 4; ++rg) {
      u32x2 w = {pack_bf16(o[c][4 * rg] * inv, o[c][4 * rg + 1] * inv), pack_bf16(o[c][4 * rg + 2] * inv, o[c][4 * rg + 3] * inv)};
      *(u32x2*)(op + 32 * c + 8 * rg) = w;
    }
}

#define G1_LDS_BYTES 49152
__device__ __forceinline__ void gla_g1_unit(const Params& p, char* smem, int u) {
  const int tid = opaque_tid(), lane = tid & 63, wid = tid >> 6, l31 = lane & 31, hh = lane >> 5;
  const int bh = u >> 6, n = u & 63, b = bh >> 2, h = bh & 3;
  const long t0 = (long)b * SEQ_ + n * 64;
  char* Ks = smem; char* Vs = smem + 16384;
  __syncthreads();
  {
    const int ch = tid & 15;
    const float* bl = p.bcum() + (t0 + 63) * 512 + h * 128 + ch * 8;
    f32x4 bl0 = *(const f32x4*)bl, bl1 = *(const f32x4*)(bl + 4);
    if (tid < 128) p.dec()[(long)u * 128 + tid] = __expf(p.bcum()[(t0 + 63) * 512 + h * 128 + tid]);
#pragma unroll
    for (int i = 0; i < 4; ++i) {
      const int tok = (i * 256 + tid) >> 4;
      u32x4 kw = *(const u32x4*)(p.proj() + (t0 + tok) * NC_ + C_GK + h * 128 + ch * 8);
      const float* bp = p.bcum() + (t0 + tok) * 512 + h * 128 + ch * 8;
      f32x4 b0 = *(const f32x4*)bp, b1 = *(const f32x4*)(bp + 4);
      u32x4 w;
      w[0] = pack_bf16(bf_lo(kw[0]) * __expf(bl0[0] - b0[0]), bf_hi(kw[0]) * __expf(bl0[1] - b0[1]));
      w[1] = pack_bf16(bf_lo(kw[1]) * __expf(bl0[2] - b0[2]), bf_hi(kw[1]) * __expf(bl0[3] - b0[3]));
      w[2] = pack_bf16(bf_lo(kw[2]) * __expf(bl1[0] - b1[0]), bf_hi(kw[2]) * __expf(bl1[1] - b1[1]));
      w[3] = pack_bf16(bf_lo(kw[3]) * __expf(bl1[2] - b1[2]), bf_hi(kw[3]) * __expf(bl1[3] - b1[3]));
      *(u32x4*)(Ks + off_b(tok, ch)) = w;
    }
#pragma unroll
    for (int i = 0; i < 8; ++i) {
      const int pp = i * 256 + tid; const int tok = pp >> 5, c32 = pp & 31;
      u32x4 vw = *(const u32x4*)(p.proj() + (t0 + tok) * NC_ + C_GV + h * 256 + c32 * 8);
      *(u32x4*)(Vs + (c32 >> 4) * 16384 + off_b(tok, c32 & 15)) = vw;
    }
  }
  __syncthreads();
  f32x16 acc[4][2];
#pragma unroll
  for (int mb = 0; mb < 4; ++mb)
#pragma unroll
    for (int nb = 0; nb < 2; ++nb)
#pragma unroll
      for (int r = 0; r < 16; ++r) acc[mb][nb][r] = 0.f;
  const char* Vimg = Vs + (wid >> 1) * 16384;
#pragma unroll
  for (int ks = 0; ks < 4; ++ks) {
    bf16x8 af[4], bfr[2];
    const unsigned r0 = 16 * ks + 8 * hh;
#pragma unroll
    for (int mb = 0; mb < 4; ++mb) af[mb] = tr_frag(Ks, lane, mb, r0, r0 + 4);
#pragma unroll
    for (int nb = 0; nb < 2; ++nb) bfr[nb] = tr_frag(Vimg, lane, 2 * (wid & 1) + nb, r0, r0 + 4);
#pragma unroll
    for (int mb = 0; mb < 4; ++mb)
#pragma unroll
      for (int nb = 0; nb < 2; ++nb) acc[mb][nb] = __builtin_amdgcn_mfma_f32_32x32x16_bf16(af[mb], bfr[nb], acc[mb][nb], 0, 0, 0);
  }
  __syncthreads();
  {
    char* st = smem + wid * 16384;
#pragma unroll
    for (int mb = 0; mb < 4; ++mb)
#pragma unroll
      for (int r = 0; r < 16; ++r) {
        const int dk = mb * 32 + (r & 3) + 8 * (r >> 2) + 4 * hh;
        *(u16*)(st + dk * 128 + l31 * 2) = f32_to_bf16(acc[mb][0][r]);
        *(u16*)(st + dk * 128 + (32 + l31) * 2) = f32_to_bf16(acc[mb][1][r]);
      }
    u16* gb = p.kvc() + (long)u * 32768 + wid * 64;
#pragma unroll 4
    for (int it = 0; it < 16; ++it) {
      const int dk = it * 8 + (lane >> 3), ch = lane & 7;
      *(u32x4*)(gb + dk * 256 + ch * 8) = *(const u32x4*)(st + dk * 128 + ch * 16);
    }
  }
}

__device__ __forceinline__ void gla_g2_unit(const Params& p, int u) {
  const int tid = opaque_tid();
  const int bh = u >> 5, part = u & 31;
  const int dk = part * 4 + (tid >> 6), dv = (tid & 63) * 4;
  float s0 = 0.f, s1 = 0.f, s2 = 0.f, s3 = 0.f;
  const long ebase = (long)dk * 256 + dv;
#pragma unroll 8
  for (int n = 0; n < 64; ++n) {
    const long un = (long)(bh * 64 + n);
    u32x2 kw = *(const u32x2*)(p.kvc() + un * 32768 + ebase);
    const float d = p.dec()[un * 128 + dk];
    u32x2 w = {pack_bf16(s0, s1), pack_bf16(s2, s3)};
    *(u32x2*)(p.sprev() + un * 32768 + ebase) = w;
    s0 = fmaf(d, s0, bf_lo(kw[0])); s1 = fmaf(d, s1, bf_hi(kw[0]));
    s2 = fmaf(d, s2, bf_lo(kw[1])); s3 = fmaf(d, s3, bf_hi(kw[1]));
  }
}

#define G3_LDS_BYTES (16384 + 16384 + 32768 + 65536 + 1024)
__device__ __forceinline__ void gla_g3_unit(const Params& p, char* smem, int u) {
  const int tid = opaque_tid(), lane = tid & 63, wid = tid >> 6, l31 = lane & 31, hh = lane >> 5;
  const int bh = u >> 6, n = u & 63, b = bh >> 2, h = bh & 3;
  const long t0 = (long)b * SEQ_ + n * 64;
  char* Qd = smem; char* Ki = smem + 16384; char* Vs = smem + 32768; char* Sp = smem + 65536; float* red = (float*)(smem + 131072);
  __syncthreads();
  {
    const int ch = tid & 15;
    const float qs = 0.08838834764831845f;
#pragma unroll
    for (int i = 0; i < 4; ++i) {
      const int tok = (i * 256 + tid) >> 4;
      const u16* pr = p.proj() + (t0 + tok) * NC_ + h * 128 + ch * 8;
      u32x4 qw = *(const u32x4*)(pr + C_GQ), kw = *(const u32x4*)(pr + C_GK);
      const float* bp = p.bcum() + (t0 + tok) * 512 + h * 128 + ch * 8;
      f32x4 b0 = *(const f32x4*)bp, b1 = *(const f32x4*)(bp + 4);
      float e[8] = {__expf(b0[0]), __expf(b0[1]), __expf(b0[2]), __expf(b0[3]), __expf(b1[0]), __expf(b1[1]), __expf(b1[2]), __expf(b1[3])};
      u32x4 wq, wk;
#pragma unroll
      for (int k = 0; k < 4; ++k) {
        wq[k] = pack_bf16(bf_lo(qw[k]) * qs * e[2 * k], bf_hi(qw[k]) * qs * e[2 * k + 1]);
        wk[k] = pack_bf16(bf_lo(kw[k]) / e[2 * k], bf_hi(kw[k]) / e[2 * k + 1]);
      }
      *(u32x4*)(Qd + off_b(tok, ch)) = wq;
      *(u32x4*)(Ki + off_b(tok, ch)) = wk;
    }
#pragma unroll
    for (int i = 0; i < 8; ++i) {
      const int pp = i * 256 + tid; const int tok = pp >> 5, c32 = pp & 31;
      u32x4 vw = *(const u32x4*)(p.proj() + (t0 + tok) * NC_ + C_GV + h * 256 + c32 * 8);
      *(u32x4*)(Vs + (c32 >> 4) * 16384 + off_b(tok, c32 & 15)) = vw;
    }
#pragma unroll
    for (int i = 0; i < 16; ++i) {
      const int pp = i * 256 + tid; const int dk = pp >> 5, c32 = pp & 31;
      u32x4 sw = *(const u32x4*)(p.sprev() + (long)u * 32768 + dk * 256 + c32 * 8);
      *(u32x4*)(Sp + (c32 >> 4) * 32768 + off_b(dk, c32 & 15)) = sw;
    }
  }
  __syncthreads();
  const int ib = wid & 1, dvh = wid >> 1;
  f32x16 sc[2];
#pragma unroll
  for (int jb = 0; jb < 2; ++jb) {
#pragma unroll
    for (int r = 0; r < 16; ++r) sc[jb][r] = 0.f;
    if (jb <= ib) {
#pragma unroll
      for (int ks = 0; ks < 8; ++ks) {
        bf16x8 a = *(const bf16x8*)(Ki + off_b(jb * 32 + l31, 2 * ks + hh));
        bf16x8 bq = *(const bf16x8*)(Qd + off_b(ib * 32 + l31, 2 * ks + hh));
        sc[jb] = __builtin_amdgcn_mfma_f32_32x32x16_bf16(a, bq, sc[jb], 0, 0, 0);
      }
#pragma unroll
      for (int r = 0; r < 16; ++r) {
        const int j = jb * 32 + (r & 3) + 8 * (r >> 2) + 4 * hh, i = ib * 32 + l31;
        if (j > i) sc[jb][r] = 0.f;
      }
    }
  }
  bf16x8 pf[4];
#pragma unroll
  for (int jb = 0; jb < 2; ++jb)
#pragma unroll
    for (int s2 = 0; s2 < 2; ++s2) {
      u32x4 w = {pack_bf16(sc[jb][8 * s2 + 0], sc[jb][8 * s2 + 1]), pack_bf16(sc[jb][8 * s2 + 2], sc[jb][8 * s2 + 3]),
                 pack_bf16(sc[jb][8 * s2 + 4], sc[jb][8 * s2 + 5]), pack_bf16(sc[jb][8 * s2 + 6], sc[jb][8 * s2 + 7])};
      pf[jb * 2 + s2] = *(bf16x8*)&w;
    }
  f32x16 o[4];
#pragma unroll
  for (int c = 0; c < 4; ++c)
#pragma unroll
    for (int r = 0; r < 16; ++r) o[c][r] = 0.f;
  const char* Vimg = Vs + dvh * 16384;
  const char* Simg = Sp + dvh * 32768;
#pragma unroll
  for (int c = 0; c < 4; ++c) {
#pragma unroll
    for (int kk = 0; kk < 4; ++kk) {
      if ((kk >> 1) <= ib) {
        const unsigned rbase = 32 * (kk >> 1) + 16 * (kk & 1) + 4 * hh;
        bf16x8 a = tr_frag(Vimg, lane, c, rbase, rbase + 8);
        o[c] = __builtin_amdgcn_mfma_f32_32x32x16_bf16(a, pf[kk], o[c], 0, 0, 0);
      }
    }
#pragma unroll
    for (int ks = 0; ks < 8; ++ks) {
      const unsigned r0 = 16 * ks + 8 * hh;
      bf16x8 a = tr_frag(Simg, lane, c, r0, r0 + 4);
      bf16x8 bq = *(const bf16x8*)(Qd + off_b(ib * 32 + l31, 2 * ks + hh));
      o[c] = __builtin_amdgcn_mfma_f32_32x32x16_bf16(a, bq, o[c], 0, 0, 0);
    }
  }
  float ss = 0.f;
#pragma unroll
  for (int c = 0; c < 4; ++c)
#pragma unroll
    for (int r = 0; r < 16; ++r) ss += o[c][r] * o[c][r];
  ss += shflx(ss, 32);
  if (hh == 0) red[dvh * 64 + ib * 32 + l31] = ss;
  __syncthreads();
  const float tot = red[ib * 32 + l31] + red[64 + ib * 32 + l31];
  const float rn = rsqrtf(tot * (1.0f / 256.0f) + EPS_);
  const long t = t0 + ib * 32 + l31;
  const u16* grp = p.proj() + t * NC_ + C_GR + h * 256 + dvh * 128 + 4 * hh;
  u16* op = p.mix() + t * 2048 + h * 256 + dvh * 128 + 4 * hh;
  const float* gp = p.gla_out_norm + dvh * 128 + 4 * hh;
#pragma unroll
  for (int c = 0; c < 4; ++c)
#pragma unroll
    for (int rg = 0; rg < 4; ++rg) {
      u32x2 gw = *(const u32x2*)(grp + 32 * c + 8 * rg);
      f32x4 g = *(const f32x4*)(gp + 32 * c + 8 * rg);
      float gr[4] = {bf_lo(gw[0]), bf_hi(gw[0]), bf_lo(gw[1]), bf_hi(gw[1])};
      float ov[4];
#pragma unroll
      for (int k = 0; k < 4; ++k) { float si = gr[k] / (1.0f + __expf(-gr[k])); ov[k] = o[c][4 * rg + k] * rn * g[k] * si; }
#if WOUTQ
      {
        int q8 = 0;
        q8 = __builtin_amdgcn_cvt_pk_fp8_f32(ov[0], ov[1], q8, false);
        q8 = __builtin_amdgcn_cvt_pk_fp8_f32(ov[2], ov[3], q8, true);
        const int col = h * 256 + dvh * 128 + 4 * hh + 32 * c + 8 * rg;
        *(unsigned*)(p.mixq() + (t >> 1) * 4096 + (col >> 6) * 128 + (t & 1) * 64 + (col & 63)) = (unsigned)q8;
      }
#else
      u32x2 w = {pack_bf16(ov[0], ov[1]), pack_bf16(ov[2], ov[3])};
      *(u32x2*)(op + 32 * c + 8 * rg) = w;
#endif
    }
}

__device__ __forceinline__ void mla_norm_tokens(const Params& p) {
  const int tid_ = opaque_tid(); const int lane = tid_ & 63, wid = tid_ >> 6;
  for (int t = blockIdx.x * 4 + wid; t < T_; t += gridDim.x * 4) {
    const u16* src = p.omla() + (long)t * 1024;
    u32x4 a = *(const u32x4*)(src + lane * 8), b = *(const u32x4*)(src + 512 + lane * 8);
    float ss = 0.f;
#pragma unroll
    for (int k = 0; k < 4; ++k) { float x0 = bf_lo(a[k]), x1 = bf_hi(a[k]), y0 = bf_lo(b[k]), y1 = bf_hi(b[k]); ss += x0 * x0 + x1 * x1 + y0 * y0 + y1 * y1; }
    ss = wave_sum(ss);
    const float r = rsqrtf(ss * (1.0f / 1024.0f) + EPS_);
    const float* g = p.mla_out_norm;
    u32x4 wa, wb;
#pragma unroll
    for (int k = 0; k < 4; ++k) {
      wa[k] = pack_bf16(bf_lo(a[k]) * r * g[lane * 8 + 2 * k], bf_hi(a[k]) * r * g[lane * 8 + 2 * k + 1]);
      wb[k] = pack_bf16(bf_lo(b[k]) * r * g[512 + lane * 8 + 2 * k], bf_hi(b[k]) * r * g[512 + lane * 8 + 2 * k + 1]);
    }
#if WOUTQ
    {
      int qa0 = 0, qa1 = 0, qb0 = 0, qb1 = 0;
      qa0 = __builtin_amdgcn_cvt_pk_fp8_f32(bf_lo(wa[0]), bf_hi(wa[0]), qa0, false); qa0 = __builtin_amdgcn_cvt_pk_fp8_f32(bf_lo(wa[1]), bf_hi(wa[1]), qa0, true);
      qa1 = __builtin_amdgcn_cvt_pk_fp8_f32(bf_lo(wa[2]), bf_hi(wa[2]), qa1, false); qa1 = __builtin_amdgcn_cvt_pk_fp8_f32(bf_lo(wa[3]), bf_hi(wa[3]), qa1, true);
      qb0 = __builtin_amdgcn_cvt_pk_fp8_f32(bf_lo(wb[0]), bf_hi(wb[0]), qb0, false); qb0 = __builtin_amdgcn_cvt_pk_fp8_f32(bf_lo(wb[1]), bf_hi(wb[1]), qb0, true);
      qb1 = __builtin_amdgcn_cvt_pk_fp8_f32(bf_lo(wb[2]), bf_hi(wb[2]), qb1, false); qb1 = __builtin_amdgcn_cvt_pk_fp8_f32(bf_lo(wb[3]), bf_hi(wb[3]), qb1, true);
      const int ca = 1024 + lane * 8, cb = 1536 + lane * 8;
      const long tt = t;
      u32x2 va = {(unsigned)qa0, (unsigned)qa1}, vb = {(unsigned)qb0, (unsigned)qb1};
      *(u32x2*)(p.mixq() + (tt >> 1) * 4096 + (ca >> 6) * 128 + (tt & 1) * 64 + (ca & 63)) = va;
      *(u32x2*)(p.mixq() + (tt >> 1) * 4096 + (cb >> 6) * 128 + (tt & 1) * 64 + (cb & 63)) = vb;
    }
#else
    *(u32x4*)(p.mix() + (long)t * 2048 + 1024 + lane * 8) = wa;
    *(u32x4*)(p.mix() + (long)t * 2048 + 1024 + 512 + lane * 8) = wb;
#endif
  }
}
__device__ __forceinline__ void wout_tile(const Params& p, char* smem, int mt, int nt) {
  f32x16 acc[4][4];
  GemmTile t{};
  t.A = p.mix(); t.lda = 2048; t.aidx = nullptr; t.m0 = mt * 256; t.mvalid = 256;
  t.B0 = p.w_out + nt * 256; t.B1 = t.B0 + 128; t.ldb = 2048; t.nv0 = 128; t.nv1 = 128; t.kscale = nullptr; t.K = 2048;
  gemm_tile_256<4, false, false>(t, smem, acc);
  const long boff = (long)(mt * 256) * 2048 + nt * 256;
  acc_foreach_row<4>(acc, [&](int rowl, int coll, float (&v)[4]) {
    long o = boff + (long)rowl * 2048 + coll;
    OPAQUE(o);
    const float* xr = p.x + o; float* yr = p.x1() + o;
#pragma unroll
    for (int nb = 0; nb < 4; ++nb) { const int c = (nb >> 1) * 128 + (nb & 1) * 32; yr[c] = xr[c] + v[nb]; }
  });
}

#define P7_LDS_BYTES (4 * 32 * 33 * 4 + 4 * 64 * 4 + 32 * 33 * 4 + 128)
template <int DRY = 0>
__device__ __forceinline__ void ffn_prep_unit(const Params& p, char* smem, int u) {
  float* part = (float*)smem; float* ssq = part + 4 * 32 * 33; float* lg = ssq + 256; float* rs = lg + 32 * 33;
  const int tid = opaque_tid(), lane = tid & 63, wid = tid >> 6, l31 = lane & 31, hh = lane >> 5;
  __syncthreads();
  {
    const long t = (long)u * 32 + l31;
    const float* xr = p.x1() + t * 2048 + wid * 512;
    const float* gp = p.ffn_norm + wid * 512;
    const float* wp = p.router_w + (long)(wid * 512 + hh) * 32 + l31;
    f32x16 acc;
#pragma unroll
    for (int r = 0; r < 16; ++r) acc[r] = 0.f;
    float ss = 0.f;
#pragma unroll 4
    for (int m = 0; m < 128; ++m) {
      const f32x4 xv = *(const f32x4*)(xr + 4 * m);
      const f32x4 gv = *(const f32x4*)(gp + 4 * m);
      const float a0 = hh ? xv[1] : xv[0], a1 = hh ? xv[3] : xv[2];
      const float g0 = hh ? gv[1] : gv[0], g1 = hh ? gv[3] : gv[2];
      const float b0 = wp[(4 * m) * 32], b1 = wp[(4 * m + 2) * 32];
      ss += a0 * a0 + a1 * a1;
      acc = __builtin_amdgcn_mfma_f32_32x32x2f32(a0 * g0, b0, acc, 0, 0, 0);
      acc = __builtin_amdgcn_mfma_f32_32x32x2f32(a1 * g1, b1, acc, 0, 0, 0);
    }
#pragma unroll
    for (int r = 0; r < 16; ++r) part[(wid * 32 + (r & 3) + 8 * (r >> 2) + 4 * hh) * 33 + l31] = acc[r];
    ssq[wid * 64 + lane] = ss;
  }
  __syncthreads();
  {
    const int tl = tid >> 3, seg = tid & 7;
    if (seg == 0) {
      float s = 0.f;
#pragma unroll
      for (int w = 0; w < 4; ++w) s += ssq[w * 64 + tl] + ssq[w * 64 + 32 + tl];
      rs[tl] = rsqrtf(s * (1.0f / 2048.0f) + EPS_);
    }
  }
  __syncthreads();
  {
    const int tl = tid >> 3, seg = tid & 7;
    const float r = rs[tl];
#pragma unroll
    for (int c = 0; c < 4; ++c) {
      const int e = seg * 4 + c;
      const float s = part[(0 * 32 + tl) * 33 + e] + part[(1 * 32 + tl) * 33 + e] + part[(2 * 32 + tl) * 33 + e] + part[(3 * 32 + tl) * 33 + e];
      lg[tl * 33 + e] = s * r + p.router_b[e];
    }
  }
  __syncthreads();
  if (tid < 32 && !DRY) {
    const long tt = (long)u * 32 + tid;
    const float* L = lg + tid * 33;
    unsigned used = 0u; int i0 = 0, i1 = 0, i2 = 0, i3 = 0; float v0 = 0.f, v1 = 0.f, v2 = 0.f, v3 = 0.f;
#pragma unroll
    for (int k = 0; k < 4; ++k) {
      int bi = -1; float bv = 0.f;
      for (int i = 0; i < 32; ++i) {
        const float x = L[i];
        const bool take = !((used >> i) & 1u) && (bi < 0 || x > bv);
        bi = take ? i : bi; bv = take ? x : bv;
      }
      used |= 1u << bi;
      if (k == 0) { i0 = bi; v0 = bv; } else if (k == 1) { i1 = bi; v1 = bv; } else if (k == 2) { i2 = bi; v2 = bv; } else { i3 = bi; v3 = bv; }
    }
    const float e0 = 1.0f, e1 = __expf(v1 - v0), e2 = __expf(v2 - v0), e3 = __expf(v3 - v0);
    const float inv = 1.0f / (e0 + e1 + e2 + e3);
    const int s0 = atomicAdd(&p.counts()[i0], 1), s1 = atomicAdd(&p.counts()[i1], 1), s2 = atomicAdd(&p.counts()[i2], 1), s3 = atomicAdd(&p.counts()[i3], 1);
    p.list()[i0 * T_ + s0] = (int)tt; p.list()[i1 * T_ + s1] = (int)tt; p.list()[i2 * T_ + s2] = (int)tt; p.list()[i3 * T_ + s3] = (int)tt;
    p.asg_e()[tt * 4 + 0] = i0; p.asg_e()[tt * 4 + 1] = i1; p.asg_e()[tt * 4 + 2] = i2; p.asg_e()[tt * 4 + 3] = i3;
    p.asg_slot()[tt * 4 + 0] = s0; p.asg_slot()[tt * 4 + 1] = s1; p.asg_slot()[tt * 4 + 2] = s2; p.asg_slot()[tt * 4 + 3] = s3;
    p.asg_g()[tt * 4 + 0] = e0 * inv; p.asg_g()[tt * 4 + 1] = e1 * inv; p.asg_g()[tt * 4 + 2] = e2 * inv; p.asg_g()[tt * 4 + 3] = e3 * inv;
  }
  {
    const int tl = tid >> 3, seg = tid & 7;
    const long t = (long)u * 32 + tl;
    const float* xr = p.x1() + t * 2048;
    const float rr = rs[tl];
#pragma unroll 8
    for (int it = 0; it < 32; ++it) {
      const int kk = it * 64 + seg * 8;
      f32x4 v0 = *(const f32x4*)(xr + kk), v1 = *(const f32x4*)(xr + kk + 4);
      f32x4 g0 = *(const f32x4*)(p.ffn_norm + kk), g1 = *(const f32x4*)(p.ffn_norm + kk + 4);
      v0 = v0 * g0 * rr; v1 = v1 * g1 * rr;
#if MOEQ == 0
      u32x4 w = {pack_bf16(v0[0], v0[1]), pack_bf16(v0[2], v0[3]), pack_bf16(v1[0], v1[1]), pack_bf16(v1[2], v1[3])};
      *(u32x4*)(p.h2() + t * 2048 + kk) = w;
#else
      int q0 = 0, q1 = 0;
      q0 = __builtin_amdgcn_cvt_pk_fp8_f32(v0[0], v0[1], q0, false);
      q0 = __builtin_amdgcn_cvt_pk_fp8_f32(v0[2], v0[3], q0, true);
      q1 = __builtin_amdgcn_cvt_pk_fp8_f32(v1[0], v1[1], q1, false);
      q1 = __builtin_amdgcn_cvt_pk_fp8_f32(v1[2], v1[3], q1, true);
      u32x2 wq = {(unsigned)q0, (unsigned)q1};
      *(u32x2*)(p.h2q() + t * 2048 + kk) = wq;
#endif
    }
  }
}

__device__ __forceinline__ void moe_setup(const Params& p, int* mo) {
  __syncthreads();
  if (threadIdx.x == 0) {
    int s = 0;
    for (int e = 0; e < NE_; ++e) { mo[e] = s; s += (p.counts()[e] + 255) >> 8; }
    mo[NE_] = s;
  }
  __syncthreads();
}
#ifndef MAPV
#define MAPV 0
#endif
__device__ __forceinline__ int xcd_unit(int round) { return MAPV ? (round * 256 + blockIdx.x) : (round * 256 + (blockIdx.x & 7) * 32 + (blockIdx.x >> 3)); }

__device__ __forceinline__ void moe1_tile(const Params& p, char* smem, const int* mo, int e, int nt, int mt) {
  f32x16 acc[4][4];
  GemmTile t{};
  const int cnt = p.counts()[e];
  t.A = p.h2(); t.lda = 2048; t.aidx = p.list() + e * T_ + mt * 256; t.m0 = 0; t.mvalid = min(256, cnt - mt * 256);
  t.B0 = p.w_gu + (long)e * 2048 * 4096 + nt * 128; t.B1 = t.B0 + 2048; t.ldb = 4096; t.nv0 = 128; t.nv1 = 128; t.kscale = nullptr; t.K = 2048;
  gemm_tile_256<4, false, true>(t, smem, acc);
  u16* base = p.act() + (long)(mo[e] * 256 + mt * 256) * 2048 + nt * 128;
  const float* bg = p.b_gu + e * 4096 + nt * 128; const float* bu = bg + 2048;
  const int tq_ = opaque_tid(); const int cl = (tq_ >> 6 & 1) * 64 + (tq_ & 31);
  const float bgv[2] = {bg[cl], bg[cl + 32]}, buv[2] = {bu[cl], bu[cl + 32]};
  acc_foreach_row<4>(acc, [&](int rowl, int coll, float (&v)[4]) {
    u16* rp = base + (long)rowl * 2048 + coll;
    OPAQUE(rp);
#pragma unroll
    for (int nb = 0; nb < 2; ++nb) {
      const int c = nb * 32;
      float g = fminf(v[nb] + bgv[nb], 7.0f);
      float uu = fminf(fmaxf(v[nb + 2] + buv[nb], -7.0f), 7.0f);
      float a = (uu + 1.0f) * (g / (1.0f + __expf(-1.702f * g)));
      rp[c] = f32_to_bf16(a);
    }
  });
}
__device__ __forceinline__ void moe2_tile(const Params& p, char* smem, const int* mo, int e, int nt, int mt) {
  f32x16 acc[4][4];
  GemmTile t{};
  t.A = p.act(); t.lda = 2048; t.aidx = nullptr; t.m0 = mo[e] * 256 + mt * 256; t.mvalid = 256;
  t.B0 = p.w_dn + (long)e * 2048 * 2048 + nt * 256; t.B1 = t.B0 + 128; t.ldb = 2048; t.nv0 = 128; t.nv1 = 128; t.kscale = nullptr; t.K = 2048;
  gemm_tile_256<4, false, false>(t, smem, acc);
  u16* base = p.ybuf() + (long)t.m0 * 2048 + nt * 256;
  const float* bd = p.b_dn + e * 2048 + nt * 256;
  const int tq_ = opaque_tid(); const int cl = (tq_ >> 6 & 1) * 64 + (tq_ & 31);
  const float bdv[4] = {bd[cl], bd[cl + 32], bd[cl + 128], bd[cl + 160]};
  acc_foreach_row<4>(acc, [&](int rowl, int coll, float (&v)[4]) {
    u16* rp = base + (long)rowl * 2048 + coll;
    OPAQUE(rp);
#pragma unroll
    for (int nb = 0; nb < 4; ++nb) { const int c = (nb >> 1) * 128 + (nb & 1) * 32; rp[c] = f32_to_bf16(v[nb] + bdv[nb]); }
  });
}
template <int WHICH, int HALF = 0>
__device__ __forceinline__ void ph_moe(const Params& p, char* smem) {
  int* mo = (int*)(smem + G_LDS_BYTES);
  moe_setup(p, mo);
  const int NT = (WHICH == 1) ? 16 : 8;
  const int total = mo[NE_] * NT;
  if (HALF && ((blockIdx.x >> 3) & 1)) return;
  const int W = HALF ? 128 : 256;
  for (int round = 0;; ++round) {
    const int u = HALF ? (round * 128 + (blockIdx.x & 7) * 16 + (blockIdx.x >> 4)) : xcd_unit(round);
    if (round * W >= total) break;
    if (u >= total) continue;
    int e = 0;
    while (mo[e + 1] * NT <= u) ++e;
    const int local = u - mo[e] * NT, me = mo[e + 1] - mo[e];
    const int nt = local / me, mt = local - nt * me;
    if (WHICH == 1) moe1_tile(p, smem, mo, e, nt, mt); else moe2_tile(p, smem, mo, e, nt, mt);
  }
}

__device__ __forceinline__ void ph_final(const Params& p, char* smem, float dbg_scale = 1.0f) {
  int* mo = (int*)(smem + G_LDS_BYTES);
  moe_setup(p, mo);
  const int tid_ = opaque_tid(); const int lane = tid_ & 63, wid = tid_ >> 6;
  for (int t = blockIdx.x * 4 + wid; t < T_; t += gridDim.x * 4) {
    long rows[4]; float gg[4];
#pragma unroll
    for (int k = 0; k < 4; ++k) { rows[k] = (long)(mo[p.asg_e()[t * 4 + k]] * 256 + p.asg_slot()[t * 4 + k]) * 2048; gg[k] = p.asg_g()[t * 4 + k]; }
    f32x4 v[8]; float ss = 0.f;
#pragma unroll
    for (int j = 0; j < 8; ++j) {
      const int c = j * 256 + lane * 4;
      f32x4 a = __builtin_nontemporal_load((const f32x4*)(p.x1() + (long)t * 2048 + c));
#pragma unroll
      for (int k = 0; k < 4; ++k) {
        u32x2 w = __builtin_nontemporal_load((const u32x2*)(p.ybuf() + rows[k] + c));
        a[0] += gg[k] * bf_lo(w[0]); a[1] += gg[k] * bf_hi(w[0]); a[2] += gg[k] * bf_lo(w[1]); a[3] += gg[k] * bf_hi(w[1]);
      }
      v[j] = a; ss += a[0] * a[0] + a[1] * a[1] + a[2] * a[2] + a[3] * a[3];
    }
    ss = wave_sum(ss);
    const float r = rsqrtf(ss * (1.0f / 2048.0f) + EPS_);
#pragma unroll
    for (int j = 0; j < 8; ++j) {
      const int c = j * 256 + lane * 4;
      f32x4 g = *(const f32x4*)(p.final_norm + c);
      f32x4 o = {v[j][0] * r * g[0] * dbg_scale, v[j][1] * r * g[1] * dbg_scale, v[j][2] * r * g[2] * dbg_scale, v[j][3] * r * g[3] * dbg_scale};
      __builtin_nontemporal_store(o, (f32x4*)(p.out + (long)t * 2048 + c));
    }
  }
}

__device__ __forceinline__ CvtUnit cvt8_decode(const Params& p, int u) {
  CvtUnit c;
  if (u < 16384) {
    const int e = u >> 9, kb = (u >> 4) & 31, nt = u & 15;
    c.src = p.w_gu + (long)e * 2048 * 4096 + (long)(kb * 64) * 4096 + nt * 256; c.ldn = 4096;
    c.dst = p.wq_gu() + ((long)e * 4096 + nt * 256) * 2048 + kb * 128;
  } else {
    const int v = u - 16384; const int e = v >> 8, kb = (v >> 3) & 31, nt = v & 7;
    c.src = p.w_dn + (long)e * 2048 * 2048 + (long)(kb * 64) * 2048 + nt * 256; c.ldn = 2048;
    c.dst = p.wq_dn() + ((long)e * 2048 + nt * 256) * 2048 + kb * 128;
  }
  return c;
}
__device__ __forceinline__ void cvt8_load(const CvtUnit& c, int w, int lane, f32x4 (&v)[16]) {
  const float* src = c.src + (long)(w * 16) * c.ldn + lane * 4;
#pragma unroll
  for (int j = 0; j < 16; ++j) {
    const float* ptr = src + (long)j * c.ldn;
    asm volatile("global_load_dwordx4 %0, %1, off nt" : "=v"(v[j]) : "v"(ptr) : "memory");
  }
}
#define CVT_WAIT(N, v) asm volatile("s_waitcnt vmcnt(%16)" : "+v"(v[0]), "+v"(v[1]), "+v"(v[2]), "+v"(v[3]), "+v"(v[4]), "+v"(v[5]), "+v"(v[6]), "+v"(v[7]), \
    "+v"(v[8]), "+v"(v[9]), "+v"(v[10]), "+v"(v[11]), "+v"(v[12]), "+v"(v[13]), "+v"(v[14]), "+v"(v[15]) : "n"(N) : "memory")
__device__ __forceinline__ void cvt8_emit(const CvtUnit& c, int tid, int w, int lane, f32x4 (&v)[16], char* T) {
  __syncthreads();
#pragma unroll
  for (int cc = 0; cc < 4; ++cc) {
    u32x4 x4;
#pragma unroll
    for (int q = 0; q < 4; ++q) {
      int x = 0;
      x = __builtin_amdgcn_cvt_pk_fp8_f32(v[4 * q][cc] * WSCALE_, v[4 * q + 1][cc] * WSCALE_, x, false);
      x = __builtin_amdgcn_cvt_pk_fp8_f32(v[4 * q + 2][cc] * WSCALE_, v[4 * q + 3][cc] * WSCALE_, x, true);
      x4[q] = (unsigned)x;
    }
    *(u32x4*)(T + (lane * 4 + cc) * 64 + w * 16) = x4;
  }
  __syncthreads();
#pragma unroll
  for (int i = 0; i < 4; ++i) {
    const int n = (tid >> 2) + 64 * i, ch = tid & 3;
    __builtin_nontemporal_store(*(const u32x4*)(T + n * 64 + ch * 16), (u32x4*)(c.dst + (long)(n >> 1) * 4096 + (n & 1) * 64 + ch * 16));
  }
}
__device__ __forceinline__ void convert_units(const Params& p, char* smem, int first, int stride, int count) {
  const int tid = opaque_tid();
  const int w = tid >> 6, lane = tid & 63;
  if (count <= 0) return;
  f32x4 va[16], vb[16], vc[16];
  CvtUnit ca = cvt8_decode(p, first), cb = cvt8_decode(p, first + stride), cc = cvt8_decode(p, first + 2 * stride);
  cvt8_load(ca, w, lane, va);
  cvt8_load(cb, w, lane, vb);
  cvt8_load(cc, w, lane, vc);
  CVT_WAIT(32, va); cvt8_emit(ca, tid, w, lane, va, smem); ca = cvt8_decode(p, first + 3 * stride); cvt8_load(ca, w, lane, va);
  CVT_WAIT(36, vb); cvt8_emit(cb, tid, w, lane, vb, smem); cb = cvt8_decode(p, first + 4 * stride); cvt8_load(cb, w, lane, vb);
  CVT_WAIT(40, vc); cvt8_emit(cc, tid, w, lane, vc, smem); cc = cvt8_decode(p, first + 5 * stride); cvt8_load(cc, w, lane, vc);
  for (int i = 3; i + 3 < count; i += 3) {
    CVT_WAIT(40, va); cvt8_emit(ca, tid, w, lane, va, smem); ca = cvt8_decode(p, first + (i + 3) * stride); cvt8_load(ca, w, lane, va);
    CVT_WAIT(40, vb); cvt8_emit(cb, tid, w, lane, vb, smem); cb = cvt8_decode(p, first + (i + 4) * stride); cvt8_load(cb, w, lane, vb);
    CVT_WAIT(40, vc); cvt8_emit(cc, tid, w, lane, vc, smem); cc = cvt8_decode(p, first + (i + 5) * stride); cvt8_load(cc, w, lane, vc);
  }
  CVT_WAIT(0, va); cvt8_emit(ca, tid, w, lane, va, smem);
  CVT_WAIT(0, vb); cvt8_emit(cb, tid, w, lane, vb, smem);
  CVT_WAIT(0, vc); cvt8_emit(cc, tid, w, lane, vc, smem);
}
__device__ __forceinline__ void convert_one(const Params& p, char* smem, int u) {
  const int tid = opaque_tid();
  const int w = tid >> 6, lane = tid & 63;
  f32x4 va[16];
  CvtUnit ca = cvt8_decode(p, u);
  cvt8_load(ca, w, lane, va);
  CVT_WAIT(0, va); cvt8_emit(ca, tid, w, lane, va, smem);
}
__device__ __forceinline__ void ph_convert(const Params& p, char* smem) {
  convert_units(p, smem, blockIdx.x, gridDim.x, 24576 / 256);
}
__device__ __forceinline__ void ph_convert_gu(const Params& p, char* smem, int part, int nparts) {
  (void)part; (void)nparts;
  convert_units(p, smem, blockIdx.x, 256, 63);
  convert_one(p, smem, blockIdx.x + 63 * 256);
}
__device__ __forceinline__ void ph_convert_dn(const Params& p, char* smem) {
  convert_units(p, smem, 16384 + blockIdx.x, 256, 30);
  convert_one(p, smem, 16384 + blockIdx.x + 30 * 256);
  convert_one(p, smem, 16384 + blockIdx.x + 31 * 256);
}

#define R_STAGE 32768
struct GemmRTile {
  const u8* A; int lda; const int* aidx; int m0, mvalid;
  const u8* B; long brow0, brow1; int ldb;
  int pairb;
  int paira;
  int KB;
};
template <bool FP8, bool GATHER>
__device__ __forceinline__ void gemmr_tile_256(const GemmRTile& t, char* smem, f32x16 (&acc)[4][4]) {
  int tz0 = threadIdx.x; asm volatile("" : "+v"(tz0));
  const int tid = tz0, lane = tid & 63, wid = tid >> 6, wr = wid >> 1, wc = wid & 1;
  const int l31 = lane & 31, hh = lane >> 5;
#pragma unroll
  for (int i = 0; i < 4; ++i)
#pragma unroll
    for (int j = 0; j < 4; ++j)
#pragma unroll
      for (int r = 0; r < 16; ++r) acc[i][j][r] = 0.f;
  const int c_src = (tid & 3) ^ ((tid >> 4) & 3);
  const u8* a_src[GATHER ? 4 : 1];
  if (GATHER) {
#pragma unroll
    for (int i = 0; i < (GATHER ? 4 : 1); ++i) {
      int r = (tid >> 2) + 64 * i;
      int rr = r < t.mvalid ? r : 0;
      a_src[i] = t.A + (long)t.aidx[rr] * t.lda + c_src * 16;
    }
  } else {
    a_src[0] = t.A + (long)(t.m0 + (tid >> 2)) * t.lda + c_src * 16;
  }
  const long a_step = 64L * t.lda, b_step = 64L * t.ldb;
  const u8* b_src0 = t.B + (t.brow0 + (tid >> 2)) * t.ldb + c_src * 16;
  const u8* b_src1 = t.B + (t.brow1 + (tid >> 2)) * t.ldb + c_src * 16;
  const unsigned lds0 = (unsigned)(size_t)smem + (unsigned)__builtin_amdgcn_readfirstlane(wid) * 1024u;
  auto issue = [&](int kt, int sl, int q) {
    if (q < 4) glds16_asm((const void*)((GATHER ? a_src[GATHER ? q : 0] : a_src[0] + q * a_step) + kt * 64), lds0 + sl * R_STAGE + q * 4096);
    else { const int i = q - 4; glds16_asm((const void*)((i < 2 ? b_src0 + i * b_step : b_src1 + (i - 2) * b_step) + kt * 64), lds0 + sl * R_STAGE + 16384 + i * 4096); }
  };
  unsigned a_rd[2], b_rd[2];
#pragma unroll
  for (int s2 = 0; s2 < 2; ++s2) {
    const int ra = wr * 128 + l31, rb = wc * 64 + l31;
    a_rd[s2] = ra * 64 + (((2 * s2 + hh) ^ ((ra >> 2) & 3)) * 16);
    b_rd[s2] = rb * 64 + (((2 * s2 + hh) ^ ((rb >> 2) & 3)) * 16);
  }
  auto load_frags = [&](const char* St, int s2, u32x4 (&af)[4], u32x4 (&bf)[4]) {
#pragma unroll
    for (int mb = 0; mb < 4; ++mb) af[mb] = *(const u32x4*)(St + a_rd[s2] + mb * 2048);
#pragma unroll
    for (int nb = 0; nb < 4; ++nb) bf[nb] = *(const u32x4*)(St + 16384 + b_rd[s2] + (nb >> 1) * 8192 + (nb & 1) * 2048);
  };
  auto mma = [&](u32x4 (&ac)[4], u32x4 (&bc)[4], int nb) {
    if (FP8) {
#pragma unroll
      for (int u = 0; u < 2; ++u) {
        const long bl = (long)(((unsigned long long)bc[nb][2 * u + 1] << 32) | bc[nb][2 * u]);
#pragma unroll
        for (int mb = 0; mb < 4; ++mb) {
          const long al = (long)(((unsigned long long)ac[mb][2 * u + 1] << 32) | ac[mb][2 * u]);
          acc[mb][nb] = __builtin_amdgcn_mfma_f32_32x32x16_fp8_fp8(al, bl, acc[mb][nb], 0, 0, 0);
        }
      }
    } else {
      const bf16x8 bb = *(const bf16x8*)&bc[nb];
#pragma unroll
      for (int mb = 0; mb < 4; ++mb) acc[mb][nb] = __builtin_amdgcn_mfma_f32_32x32x16_bf16(*(const bf16x8*)&ac[mb], bb, acc[mb][nb], 0, 0, 0);
    }
  };
  u32x4 a0[4], b0[4], a1[4], b1[4];
  auto half0 = [&](int kt, bool issueA) {
    const char* St = smem + (kt & 3) * R_STAGE;
    load_frags(St, 1, a1, b1);
    __builtin_amdgcn_sched_barrier(0);
#pragma unroll
    for (int nb = 0; nb < 4; ++nb) {
      mma(a0, b0, nb);
      __builtin_amdgcn_sched_barrier(0);
      if (issueA) issue(kt + 2, (kt + 2) & 3, 4 + nb);
      __builtin_amdgcn_sched_barrier(0);
    }
  };
  auto half1 = [&](int kt, bool has1, bool issueB) {
    const char* Sn = smem + ((kt + 1) & 3) * R_STAGE;
    if (has1) load_frags(Sn, 0, a0, b0);
    __builtin_amdgcn_sched_barrier(0);
#pragma unroll
    for (int nb = 0; nb < 4; ++nb) {
      mma(a1, b1, nb);
      __builtin_amdgcn_sched_barrier(0);
      if (issueB) issue(kt + 3, (kt + 3) & 3, nb);
      __builtin_amdgcn_sched_barrier(0);
    }
  };
  const int nk = t.KB >> 6;
  __syncthreads();
#pragma unroll
  for (int q = 0; q < 8; ++q) issue(0, 0, q);
#pragma unroll
  for (int q = 0; q < 8; ++q) issue(1, 1, q);
#pragma unroll
  for (int q = 0; q < 4; ++q) issue(2, 2, q);
  asm volatile("s_waitcnt vmcnt(12)" ::: "memory");
  __syncthreads();
  load_frags(smem, 0, a0, b0);
  for (int kt = 0; kt < nk - 3; ++kt) {
    half0(kt, true);
    asm volatile("s_waitcnt vmcnt(8)" ::: "memory");
    __syncthreads();
    half1(kt, true, true);
  }
  half0(nk - 3, true);
  asm volatile("s_waitcnt vmcnt(8)" ::: "memory");
  __syncthreads();
  half1(nk - 3, true, false);
  half0(nk - 2, false);
  asm volatile("s_waitcnt vmcnt(0)" ::: "memory");
  __syncthreads();
  half1(nk - 2, true, false);
  half0(nk - 1, false);
  half1(nk - 1, false, false);
}


typedef int i32x8 __attribute__((ext_vector_type(8)));
template <bool GATHER>
__device__ __forceinline__ void gemmrs_tile_256(const GemmRTile& t, char* smem, f32x16 (&acc)[4][4]) {
  int tz0 = threadIdx.x; asm volatile("" : "+v"(tz0));
  const int tid = tz0, lane = tid & 63, wid = tid >> 6, wr = wid >> 1, wc = wid & 1;
  const int l31 = lane & 31, hh = lane >> 5;
#pragma unroll
  for (int i = 0; i < 4; ++i)
#pragma unroll
    for (int j = 0; j < 4; ++j)
#pragma unroll
      for (int r = 0; r < 16; ++r) acc[i][j][r] = 0.f;
  const int c_src = (tid & 3) ^ ((tid >> 4) & 3);
  const u8* a_src[GATHER ? 4 : 1];
  if (GATHER) {
#pragma unroll
    for (int i = 0; i < (GATHER ? 4 : 1); ++i) {
      int r = (tid >> 2) + 64 * i;
      int rr = r < t.mvalid ? r : 0;
      a_src[i] = t.A + (long)t.aidx[rr] * t.lda + c_src * 16;
    }
  } else {
    a_src[0] = t.A + ((long)(t.m0 + (tid >> 2)) >> 1) * 4096 + ((tid >> 2) & 1) * 64 + c_src * 16;
  }
  const long a_step = GATHER ? 64L * t.lda : 32L * 4096, b_step = 32L * 4096;
  const int a_kstep = GATHER ? 64 : 128;
  const int brl = tid >> 2;
  const u8* b_src0 = t.B + ((t.brow0 + brl) >> 1) * 4096 + (brl & 1) * 64 + c_src * 16;
  const u8* b_src1 = t.B + ((t.brow1 + brl) >> 1) * 4096 + (brl & 1) * 64 + c_src * 16;
  const unsigned lds0 = (unsigned)(size_t)smem + (unsigned)__builtin_amdgcn_readfirstlane(wid) * 1024u;
  auto issue = [&](int kt, int sl, int q) {
    if (q < 4) { if (ANT) glds16_asm_nt((const void*)((GATHER ? a_src[GATHER ? q : 0] : a_src[0] + q * a_step) + kt * a_kstep), lds0 + sl * R_STAGE + q * 4096);
                 else glds16_asm((const void*)((GATHER ? a_src[GATHER ? q : 0] : a_src[0] + q * a_step) + kt * a_kstep), lds0 + sl * R_STAGE + q * 4096); }
    else { const int i = q - 4;
      if (BNT) glds16_asm_nt((const void*)((i < 2 ? b_src0 + i * b_step : b_src1 + (i - 2) * b_step) + kt * 128), lds0 + sl * R_STAGE + 16384 + i * 4096);
      else glds16_asm((const void*)((i < 2 ? b_src0 + i * b_step : b_src1 + (i - 2) * b_step) + kt * 128), lds0 + sl * R_STAGE + 16384 + i * 4096); }
  };
  unsigned a_rd[2], b_rd[2];
#pragma unroll
  for (int c = 0; c < 2; ++c) {
    const int ra = wr * 128 + l31, rb = wc * 64 + l31;
    a_rd[c] = ra * 64 + (((2 * hh + c) ^ ((ra >> 2) & 3)) * 16);
    b_rd[c] = rb * 64 + (((2 * hh + c) ^ ((rb >> 2) & 3)) * 16);
  }
  auto load_a = [&](const char* St, i32x8 (&af)[4]) {
#pragma unroll
    for (int mb = 0; mb < 4; ++mb) {
      const u32x4 lo = *(const u32x4*)(St + a_rd[0] + mb * 2048), hi = *(const u32x4*)(St + a_rd[1] + mb * 2048);
      af[mb] = (i32x8){(int)lo[0], (int)lo[1], (int)lo[2], (int)lo[3], (int)hi[0], (int)hi[1], (int)hi[2], (int)hi[3]};
    }
  };
  auto load_b = [&](const char* St, int nb, i32x8& bf) {
    const char* bp = St + 16384 + (nb >> 1) * 8192 + (nb & 1) * 2048;
    const u32x4 lo = *(const u32x4*)(bp + b_rd[0]), hi = *(const u32x4*)(bp + b_rd[1]);
    bf = (i32x8){(int)lo[0], (int)lo[1], (int)lo[2], (int)lo[3], (int)hi[0], (int)hi[1], (int)hi[2], (int)hi[3]};
  };
  auto mma4 = [&](i32x8 (&af)[4], i32x8& bf, int nb) {
#pragma unroll
    for (int mb = 0; mb < 4; ++mb)
      acc[mb][nb] = __builtin_amdgcn_mfma_scale_f32_32x32x64_f8f6f4(af[mb], bf, acc[mb][nb], 0, 0, 0, 0x7f7f7f7f, 0, 0x7f7f7f7f);
  };
  i32x8 aA[4], aB[4], bq[4];
  auto half0 = [&](int kt, i32x8 (&ac)[4], bool issueA) {
    const char* St = smem + (kt & 3) * R_STAGE;
    load_b(St, 2, bq[2]); load_b(St, 3, bq[3]);
    __builtin_amdgcn_sched_barrier(0);
#pragma unroll
    for (int nb = 0; nb < 2; ++nb) {
      mma4(ac, bq[nb], nb);
      __builtin_amdgcn_sched_barrier(0);
      if (issueA) { issue(kt + 2, (kt + 2) & 3, 4 + 2 * nb); issue(kt + 2, (kt + 2) & 3, 5 + 2 * nb); }
      __builtin_amdgcn_sched_barrier(0);
    }
  };
  auto half1 = [&](int kt, i32x8 (&ac)[4], i32x8 (&an)[4], bool has1, bool issueB) {
    const char* Sn = smem + ((kt + 1) & 3) * R_STAGE;
    if (has1) { load_a(Sn, an); load_b(Sn, 0, bq[0]); load_b(Sn, 1, bq[1]); }
    __builtin_amdgcn_sched_barrier(0);
#pragma unroll
    for (int nb = 2; nb < 4; ++nb) {
      mma4(ac, bq[nb], nb);
      __builtin_amdgcn_sched_barrier(0);
      if (issueB) { issue(kt + 3, (kt + 3) & 3, 2 * (nb - 2)); issue(kt + 3, (kt + 3) & 3, 2 * (nb - 2) + 1); }
      __builtin_amdgcn_sched_barrier(0);
    }
  };
  const int nk = t.KB >> 6;
  __syncthreads();
#pragma unroll
  for (int q = 0; q < 8; ++q) issue(0, 0, q);
#pragma unroll
  for (int q = 0; q < 8; ++q) issue(1, 1, q);
#pragma unroll
  for (int q = 0; q < 4; ++q) issue(2, 2, q);
  asm volatile("s_waitcnt vmcnt(12)" ::: "memory");
  __syncthreads();
  load_a(smem, aA); load_b(smem, 0, bq[0]); load_b(smem, 1, bq[1]);
  for (int kt = 0; kt < nk - 4; kt += 2) {
    half0(kt, aA, true);
    asm volatile("s_waitcnt vmcnt(8)" ::: "memory"); __syncthreads();
    half1(kt, aA, aB, true, true);
    half0(kt + 1, aB, true);
    asm volatile("s_waitcnt vmcnt(8)" ::: "memory"); __syncthreads();
    half1(kt + 1, aB, aA, true, true);
  }
  half0(nk - 4, aA, true);
  asm volatile("s_waitcnt vmcnt(8)" ::: "memory"); __syncthreads();
  half1(nk - 4, aA, aB, true, true);
  half0(nk - 3, aB, true);
  asm volatile("s_waitcnt vmcnt(8)" ::: "memory"); __syncthreads();
  half1(nk - 3, aB, aA, true, false);
  half0(nk - 2, aA, false);
  asm volatile("s_waitcnt vmcnt(0)" ::: "memory"); __syncthreads();
  half1(nk - 2, aA, aB, true, false);
  half0(nk - 1, aB, false);
  half1(nk - 1, aB, aA, false, false);
}

template <bool GATHER>
__device__ __forceinline__ void gemmrv_tile_256(const GemmRTile& t, char* smem, f32x16 (&acc)[4][4]) {
  int tz0 = threadIdx.x; asm volatile("" : "+v"(tz0));
  const int tid = tz0, lane = tid & 63, wid = tid >> 6, wr = wid >> 1, wc = wid & 1;
  const int l31 = lane & 31, hh = lane >> 5;
#pragma unroll
  for (int i = 0; i < 4; ++i)
#pragma unroll
    for (int j = 0; j < 4; ++j)
#pragma unroll
      for (int r = 0; r < 16; ++r) acc[i][j][r] = 0.f;
  const int c_src = (tid & 3) ^ ((tid >> 4) & 3);
  const u8* a_src[GATHER ? 4 : 1];
  if (GATHER) {
#pragma unroll
    for (int i = 0; i < (GATHER ? 4 : 1); ++i) {
      int r = (tid >> 2) + 64 * i;
      int rr = r < t.mvalid ? r : 0;
      a_src[i] = t.A + (long)t.aidx[rr] * t.lda + c_src * 16;
    }
  } else {
    a_src[0] = t.A + ((long)(t.m0 + (tid >> 2)) >> 1) * 4096 + ((tid >> 2) & 1) * 64 + c_src * 16;
  }
  const long a_step = GATHER ? 64L * t.lda : 32L * 4096, b_step = 32L * 4096;
  const int a_kstep = GATHER ? 64 : 128;
  const int brl = tid >> 2;
  const u8* b_src0 = t.B + ((t.brow0 + brl) >> 1) * 4096 + (brl & 1) * 64 + c_src * 16;
  const u8* b_src1 = t.B + ((t.brow1 + brl) >> 1) * 4096 + (brl & 1) * 64 + c_src * 16;
  u32x4 rs0[8], rs1[8];
  auto ldg = [&](int kt, int q, u32x4& dst) {
    const u8* ptr = (q < 4) ? ((GATHER ? a_src[GATHER ? q : 0] : a_src[0] + q * a_step) + kt * a_kstep)
                            : (((q - 4) < 2 ? b_src0 + (q - 4) * b_step : b_src1 + (q - 6) * b_step) + kt * 128);
    asm volatile("global_load_dwordx4 %0, %1, off" : "=v"(dst) : "v"(ptr) : "memory");
  };
  auto stw = [&](int sl, int q, const u32x4& src) {
    *(u32x4*)(smem + sl * R_STAGE + (q < 4 ? q * 4096 : 16384 + (q - 4) * 4096) + tid * 16) = src;
  };
#define RV_WAIT(N, r) asm volatile("s_waitcnt vmcnt(%8)" : "+v"(r[0]), "+v"(r[1]), "+v"(r[2]), "+v"(r[3]), "+v"(r[4]), "+v"(r[5]), "+v"(r[6]), "+v"(r[7]) : "n"(N) : "memory")
  unsigned a_rd[2], b_rd[2];
#pragma unroll
  for (int c = 0; c < 2; ++c) {
    const int ra = wr * 128 + l31, rb = wc * 64 + l31;
    a_rd[c] = ra * 64 + (((2 * hh + c) ^ ((ra >> 2) & 3)) * 16);
    b_rd[c] = rb * 64 + (((2 * hh + c) ^ ((rb >> 2) & 3)) * 16);
  }
  auto load_a = [&](const char* St, i32x8 (&af)[4]) {
#pragma unroll
    for (int mb = 0; mb < 4; ++mb) {
      const u32x4 lo = *(const u32x4*)(St + a_rd[0] + mb * 2048), hi = *(const u32x4*)(St + a_rd[1] + mb * 2048);
      af[mb] = (i32x8){(int)lo[0], (int)lo[1], (int)lo[2], (int)lo[3], (int)hi[0], (int)hi[1], (int)hi[2], (int)hi[3]};
    }
  };
  auto load_b = [&](const char* St, int nb, i32x8& bf) {
    const char* bp = St + 16384 + (nb >> 1) * 8192 + (nb & 1) * 2048;
    const u32x4 lo = *(const u32x4*)(bp + b_rd[0]), hi = *(const u32x4*)(bp + b_rd[1]);
    bf = (i32x8){(int)lo[0], (int)lo[1], (int)lo[2], (int)lo[3], (int)hi[0], (int)hi[1], (int)hi[2], (int)hi[3]};
  };
  auto mma4 = [&](i32x8 (&af)[4], i32x8& bf, int nb) {
#pragma unroll
    for (int mb = 0; mb < 4; ++mb)
      acc[mb][nb] = __builtin_amdgcn_mfma_scale_f32_32x32x64_f8f6f4(af[mb], bf, acc[mb][nb], 0, 0, 0, 0x7f7f7f7f, 0, 0x7f7f7f7f);
  };
  i32x8 aA[4], aB[4], bq[4];
  auto half0 = [&](int kt, i32x8 (&ac)[4]) {
    const char* St = smem + (kt & 1) * R_STAGE;
    load_b(St, 2, bq[2]); load_b(St, 3, bq[3]);
    __builtin_amdgcn_sched_barrier(0);
    mma4(ac, bq[0], 0);
    __builtin_amdgcn_sched_barrier(0);
    mma4(ac, bq[1], 1);
    __builtin_amdgcn_sched_barrier(0);
  };
  auto commit = [&](int kt, u32x4 (&rn)[8], auto wtag, bool has1, bool has3) {
    constexpr int W = decltype(wtag)::value;
    if (has1) {
      RV_WAIT(W, rn);
#pragma unroll
      for (int q = 0; q < 8; ++q) stw((kt + 1) & 1, q, rn[q]);
      if (has3) {
#pragma unroll
        for (int q = 0; q < 8; ++q) ldg(kt + 3, q, rn[q]);
      }
      __syncthreads();
    }
  };
  auto half1 = [&](int kt, i32x8 (&ac)[4], i32x8 (&an)[4], bool has1) {
    const char* Sn = smem + ((kt + 1) & 1) * R_STAGE;
    if (has1) { load_a(Sn, an); load_b(Sn, 0, bq[0]); load_b(Sn, 1, bq[1]); }
    __builtin_amdgcn_sched_barrier(0);
    mma4(ac, bq[2], 2);
    __builtin_amdgcn_sched_barrier(0);
    mma4(ac, bq[3], 3);
    __builtin_amdgcn_sched_barrier(0);
  };
#define IC(n) std::integral_constant<int, n>{}
  const int nk = t.KB >> 6;
  __syncthreads();
#pragma unroll
  for (int q = 0; q < 8; ++q) ldg(0, q, rs0[q]);
#pragma unroll
  for (int q = 0; q < 8; ++q) ldg(1, q, rs1[q]);
  RV_WAIT(8, rs0);
#pragma unroll
  for (int q = 0; q < 8; ++q) stw(0, q, rs0[q]);
#pragma unroll
  for (int q = 0; q < 8; ++q) ldg(2, q, rs0[q]);
  __syncthreads();
  load_a(smem, aA); load_b(smem, 0, bq[0]); load_b(smem, 1, bq[1]);
  for (int kt = 0; kt < nk - 4; kt += 2) {
    half0(kt, aA);      commit(kt, rs1, IC(8), true, true);      half1(kt, aA, aB, true);
    half0(kt + 1, aB);  commit(kt + 1, rs0, IC(8), true, true);  half1(kt + 1, aB, aA, true);
  }
  half0(nk - 4, aA);  commit(nk - 4, rs1, IC(8), true, true);   half1(nk - 4, aA, aB, true);
  half0(nk - 3, aB);  commit(nk - 3, rs0, IC(8), true, false);  half1(nk - 3, aB, aA, true);
  half0(nk - 2, aA);  commit(nk - 2, rs1, IC(0), true, false);  half1(nk - 2, aA, aB, true);
  half0(nk - 1, aB);                                            half1(nk - 1, aB, aA, false);
#undef IC
#undef RV_WAIT
}

__device__ __forceinline__ void cvt16_tile(const float* W, int col0, int ldn, int nvalid  , const float* kgain,
                                           u16* out  , int ldk, char* T) {
  const int tid = opaque_tid();
  const int kq = tid & 7, n4 = tid >> 3;
  f32x4 v[16];
  const bool ok = (n4 * 4) < nvalid;
  const float* src = W + (long)(kq * 16) * ldn + (ok ? n4 * 4 : -col0);
#pragma unroll
  for (int j = 0; j < 16; ++j) v[j] = __builtin_nontemporal_load((const f32x4*)(src + (long)j * ldn));
  if (kgain) {
#pragma unroll
    for (int j = 0; j < 16; ++j) v[j] *= kgain[kq * 16 + j];
  }
  if (!ok) {
#pragma unroll
    for (int j = 0; j < 16; ++j) v[j] = (f32x4){0.f, 0.f, 0.f, 0.f};
  }
  __syncthreads();
#pragma unroll
  for (int c = 0; c < 4; ++c) {
    u32x4 w0, w1;
#pragma unroll
    for (int q = 0; q < 4; ++q) { w0[q] = pack_bf16(v[2 * q][c], v[2 * q + 1][c]); w1[q] = pack_bf16(v[8 + 2 * q][c], v[8 + 2 * q + 1][c]); }
    *(u32x4*)(T + (n4 * 4 + c) * 256 + kq * 32) = w0;
    *(u32x4*)(T + (n4 * 4 + c) * 256 + kq * 32 + 16) = w1;
  }
  __syncthreads();
#pragma unroll
  for (int i = 0; i < 8; ++i) {
    const int n = (tid >> 4) + 16 * i, ch = tid & 15;
    *(u32x4*)((char*)(out + (long)n * ldk) + ch * 16) = *(const u32x4*)(T + n * 256 + ch * 16);
  }
}
__device__ __forceinline__ void convert_one(const Params& p, char* smem, int u);
__device__ __forceinline__ void ph_convert_dense(const Params& p, char* smem) {
#if WOUTQ
  convert_one(p, smem, 24576 + blockIdx.x);
#endif
  for (int u = blockIdx.x; u < 912; u += gridDim.x) {
    if (u < 544) { const int kt = u / 34, nt = u % 34; const int nv = NC_ - nt * 128;
      cvt16_tile(p.w_in + (long)(kt * 128) * NC_ + nt * 128, nt * 128, NC_, nv < 0 ? 0 : nv, nullptr, p.wb_in() + (long)(nt * 128) * 2048 + kt * 128, 2048, smem);
    } else if (u < 592) { const int v = u - 544; const int kt = v / 12, nt = v % 12;
      cvt16_tile(p.w_uq + (long)(kt * 128) * 1536 + nt * 128, nt * 128, 1536, 128, p.q_norm + kt * 128, p.wb_uq() + (long)(nt * 128) * 512 + kt * 128, 512, smem);
    } else if (u < 656) { const int v = u - 592; const int kt = v >> 4, nt = v & 15;
      cvt16_tile(p.w_ukv + (long)(kt * 128) * 2048 + nt * 128, nt * 128, 2048, 128, p.kv_norm + kt * 128, p.wb_ukv() + (long)(nt * 128) * 512 + kt * 128, 512, smem);
    } else if (!WOUTQ) { const int v = u - 656; const int kt = v >> 4, nt = v & 15;
      cvt16_tile(p.w_out + (long)(kt * 128) * 2048 + nt * 128, nt * 128, 2048, 128, nullptr, p.wb_out() + (long)(nt * 128) * 2048 + kt * 128, 2048, smem);
    }
  }
}


template <bool NTST = false, class F>
__device__ __forceinline__ void epi_store_bf16(f32x16 (&acc)[4][4], char* smem, u16* gbase  , int ld, int ncols0, int ncols1, F f) {
  int tz = threadIdx.x; asm volatile("" : "+v"(tz));
  const int lane = tz & 63, wid = tz >> 6, wr = wid >> 1, wc = wid & 1, l31 = lane & 31, hh = lane >> 5;
  __syncthreads();
  char* st = smem + wid * 32768;
#pragma unroll
  for (int mb = 0; mb < 4; ++mb)
#pragma unroll
    for (int reg = 0; reg < 16; ++reg) {
      const int r = mb * 32 + (reg & 3) + 8 * (reg >> 2) + 4 * hh;
      float v[4] = {acc[mb][0][reg], acc[mb][1][reg], acc[mb][2][reg], acc[mb][3][reg]};
      f(wr * 128 + r, wc * 64 + l31, v);
#pragma unroll
      for (int nb = 0; nb < 4; ++nb) *(u16*)(st + r * 256 + (nb * 32 + l31) * 2) = f32_to_bf16(v[nb]);
    }
  const int ch = lane & 15, span = ch >> 3;
  const int gcol = span * 128 + wc * 64 + (ch & 7) * 8;
  const bool ok = ((wc * 64 + (ch & 7) * 8) < (span ? ncols1 : ncols0));
#pragma unroll 8
  for (int it = 0; it < 32; ++it) {
    const int r = it * 4 + (lane >> 4);
    const u32x4 w = *(const u32x4*)(st + r * 256 + ch * 16);
    if (ok) { if (NTST) __builtin_nontemporal_store(w, (u32x4*)(gbase + (long)(wr * 128 + r) * ld + gcol)); else *(u32x4*)(gbase + (long)(wr * 128 + r) * ld + gcol) = w; }
  }
}
template <class F>
__device__ __forceinline__ void epi_store_act8(f32x16 (&acc)[4][4], char* smem, u8* gbase  , long row0, int cb0, F f) {
  int tz = threadIdx.x; asm volatile("" : "+v"(tz));
  const int lane = tz & 63, wid = tz >> 6, wr = wid >> 1, wc = wid & 1, l31 = lane & 31, hh = lane >> 5;
  __syncthreads();
  char* st = smem + wid * 32768;
#pragma unroll
  for (int mb = 0; mb < 4; ++mb)
#pragma unroll
    for (int reg = 0; reg < 16; ++reg) {
      const int r = mb * 32 + (reg & 3) + 8 * (reg >> 2) + 4 * hh;
      float v[4] = {acc[mb][0][reg], acc[mb][1][reg], acc[mb][2][reg], acc[mb][3][reg]};
      f(wr * 128 + r, wc * 64 + l31, v);
      const int q = __builtin_amdgcn_cvt_pk_fp8_f32(v[0], v[1], 0, false);
      *(u8*)(st + r * 64 + l31) = (u8)(q & 0xff);
      *(u8*)(st + r * 64 + 32 + l31) = (u8)((q >> 8) & 0xff);
    }
  const int ch = lane & 3;
#pragma unroll 8
  for (int it = 0; it < 8; ++it) {
    const int r = it * 16 + (lane >> 2);
    const u32x4 w = *(const u32x4*)(st + r * 64 + ch * 16);
    const long rg = row0 + wr * 128 + r;
    *(u32x4*)(gbase + (rg >> 1) * 4096 + (long)(cb0 + wc) * 128 + (rg & 1) * 64 + ch * 16) = w;
  }
}
__device__ __forceinline__ void epi_store_f32_resid(f32x16 (&acc)[4][4], char* smem, const float* resid, float* out, int ld, float osc) {
  int tz = threadIdx.x; asm volatile("" : "+v"(tz));
  const int lane = tz & 63, wid = tz >> 6, wr = wid >> 1, wc = wid & 1, l31 = lane & 31, hh = lane >> 5;
  __syncthreads();
  char* st = smem + wid * 32768;
#pragma unroll
  for (int half = 0; half < 2; ++half) {
#pragma unroll
    for (int m2 = 0; m2 < 2; ++m2)
#pragma unroll
      for (int reg = 0; reg < 16; ++reg) {
        const int mb = half * 2 + m2;
        const int r = m2 * 32 + (reg & 3) + 8 * (reg >> 2) + 4 * hh;
#pragma unroll
        for (int nb = 0; nb < 4; ++nb) *(float*)(st + r * 512 + (nb * 32 + l31) * 4) = acc[mb][nb][reg];
      }
    const int ch = lane & 31, span = ch >> 4;
    const int gcol = span * 128 + wc * 64 + (ch & 15) * 4;
#pragma unroll 8
    for (int it = 0; it < 32; ++it) {
      const int r = it * 2 + (lane >> 5);
      const f32x4 a = *(const f32x4*)(st + r * 512 + ch * 16);
      const long o = (long)(wr * 128 + half * 64 + r) * ld + gcol;
      const f32x4 x = __builtin_nontemporal_load((const f32x4*)(resid + o));
      *(f32x4*)(out + o) = a * osc + x;
    }
  }
}

template <int NBV>
__device__ __forceinline__ void win_tile_r(const Params& p, char* smem, int mt, int nt) {
  f32x16 acc[4][4];
  GemmRTile t{};
  t.A = (const u8*)p.h1(); t.lda = 4096; t.aidx = nullptr; t.m0 = mt * 256; t.mvalid = 256;
  t.B = (const u8*)p.wb_in(); t.brow0 = nt * 256; t.brow1 = nt * 256 + 128; t.ldb = 4096; t.KB = 4096;
  gemmr_tile_256<false, false>(t, smem, acc);
  const int rem = NC_ - nt * 256;
  const int nv0 = rem >= 128 ? 128 : rem, nv1 = rem >= 256 ? 128 : (rem > 128 ? rem - 128 : 0);
  epi_store_bf16(acc, smem, p.proj() + (long)(mt * 256) * NC_ + nt * 256, NC_, nv0, nv1, [&](int, int, float (&)[4]) {});
}
__device__ __forceinline__ void win_narrow_split(const Params& p, char* smem, int mt, int kc) {
  f32x16 acc[4][4];
  GemmRTile t{};
  t.A = (const u8*)p.h1() + kc * 512; t.lda = 4096; t.aidx = nullptr; t.m0 = mt * 256; t.mvalid = 256;
  t.B = (const u8*)p.wb_in() + kc * 512; t.brow0 = 4096; t.brow1 = 4224; t.ldb = 4096; t.KB = 512;
  gemmr_tile_256<false, false>(t, smem, acc);
  float* base = p.pn() + (long)kc * (8192 * 80) + (long)(mt * 256) * 80;
  acc_foreach_row<4>(acc, [&](int rowl, int coll, float (&v)[4]) {
    float* rp = base + (long)rowl * 80 + coll;
    OPAQUE(rp);
    if (coll < 80) rp[0] = v[0];
    if (coll + 32 < 80) rp[32] = v[1];
  });
}
__device__ __forceinline__ void ph_win_r(const Params& p, char* smem) {
  const int x = blockIdx.x & 7, slot = blockIdx.x >> 3;
#if WIN_SPLIT
  for (int j = slot; j < 64; j += 32) win_tile_r<4>(p, smem, 4 * x + (j & 3), j >> 2);
  win_narrow_split(p, smem, 4 * x + (slot & 3), slot >> 2);
#else
  for (int j = slot; j < 68; j += 32) win_tile_r<4>(p, smem, 4 * x + (j & 3), j >> 2);
#endif
}
__device__ __forceinline__ void upq_tile_r(const Params& p, char* smem, int mt, int nt) {
  f32x16 acc[4][4];
  GemmRTile t{};
  t.A = (const u8*)(p.proj() + C_MQ); t.lda = NC_ * 2; t.aidx = nullptr; t.m0 = mt * 256; t.mvalid = 256;
  t.B = (const u8*)p.wb_uq(); t.brow0 = nt * 256; t.brow1 = nt * 256 + 128; t.ldb = 1024; t.KB = 1024;
  gemmr_tile_256<false, false>(t, smem, acc);
  const float* rq = p.rq() + mt * 256;
  epi_store_bf16(acc, smem, p.q() + (long)(mt * 256) * 1536 + nt * 256, 1536, 128, 128, [&](int rowl, int, float (&v)[4]) {
    const float s = rq[rowl] * QSCALE_;
#pragma unroll
    for (int nb = 0; nb < 4; ++nb) v[nb] *= s;
  });
}
__device__ __forceinline__ void upkv_tile_r(const Params& p, char* smem, int mt, int nt) {
  f32x16 acc[4][4];
  GemmRTile t{};
  t.A = (const u8*)(p.proj() + C_MKV); t.lda = NC_ * 2; t.aidx = nullptr; t.m0 = mt * 256; t.mvalid = 256;
  t.B = (const u8*)p.wb_ukv(); t.brow0 = nt * 256; t.brow1 = nt * 256 + 128; t.ldb = 1024; t.KB = 1024;
  gemmr_tile_256<false, false>(t, smem, acc);
  const float* rk = p.rkv() + mt * 256;
  epi_store_bf16(acc, smem, p.kv() + (long)(mt * 256) * 2048 + nt * 256, 2048, 128, 128, [&](int rowl, int, float (&v)[4]) {
    const float s = rk[rowl];
#pragma unroll
    for (int nb = 0; nb < 4; ++nb) v[nb] *= s;
  });
}
__device__ __forceinline__ void wout_tile_r(const Params& p, char* smem, int mt, int nt) {
  f32x16 acc[4][4];
  GemmRTile t{};
#if WOUTQ
  t.A = p.mixq(); t.lda = 2048; t.aidx = nullptr; t.m0 = mt * 256; t.mvalid = 256;
  t.B = p.wq_out(); t.brow0 = nt * 256; t.brow1 = nt * 256 + 128; t.ldb = 2048; t.KB = 2048;
  gemmrs_tile_256<false>(t, smem, acc);
  const float osc = WISCALE_;
#else
  t.A = (const u8*)p.mix(); t.lda = 4096; t.aidx = nullptr; t.m0 = mt * 256; t.mvalid = 256;
  t.B = (const u8*)p.wb_out(); t.brow0 = nt * 256; t.brow1 = nt * 256 + 128; t.ldb = 4096; t.KB = 4096;
  gemmr_tile_256<false, false>(t, smem, acc);
  const float osc = 1.0f;
#endif
  const long boff = (long)(mt * 256) * 2048 + nt * 256;
  epi_store_f32_resid(acc, smem, p.x + boff, p.x1() + boff, 2048, osc);
}

__device__ __forceinline__ void moe1q_tile(const Params& p, char* smem, const int* mo, int e, int nt, int mt) {
  f32x16 acc[4][4];
  GemmRTile t{};
  const int cnt = p.counts()[e];
  t.A = p.h2q(); t.lda = 2048; t.aidx = p.list() + e * T_ + mt * 256; t.m0 = 0; t.mvalid = min(256, cnt - mt * 256);
  t.B = p.wq_gu(); t.brow0 = (long)e * 4096 + nt * 128; t.brow1 = t.brow0 + 2048; t.ldb = 2048; t.KB = 2048;
#if MOEQ == 3
  gemmrv_tile_256<true>(t, smem, acc);
#elif MOEQ == 2
  gemmrs_tile_256<true>(t, smem, acc);
#else
  gemmr_tile_256<true, true>(t, smem, acc);
#endif
  const float* bg = p.b_gu + e * 4096 + nt * 128; const float* bu = bg + 2048;
  const int tq_ = opaque_tid(); const int cl = (tq_ >> 6 & 1) * 64 + (tq_ & 31);
  const float bgv[2] = {bg[cl], bg[cl + 32]}, buv[2] = {bu[cl], bu[cl + 32]};
  epi_store_act8(acc, smem, p.actq(), (long)(mo[e] * 256 + mt * 256), nt * 2, [&](int, int, float (&v)[4]) {
#pragma unroll
    for (int nb = 0; nb < 2; ++nb) {
      float g = fminf(v[nb] * WISCALE_ + bgv[nb], 7.0f);
      float uu = fminf(fmaxf(v[nb + 2] * WISCALE_ + buv[nb], -7.0f), 7.0f);
      v[nb] = (uu + 1.0f) * (g / (1.0f + __expf(-1.702f * g)));
    }
  });
}
__device__ __forceinline__ void moe2q_tile(const Params& p, char* smem, const int* mo, int e, int nt, int mt) {
  f32x16 acc[4][4];
  GemmRTile t{};
  t.A = p.actq(); t.lda = 2048; t.aidx = nullptr; t.m0 = mo[e] * 256 + mt * 256; t.mvalid = 256;
  t.B = p.wq_dn(); t.brow0 = (long)e * 2048 + nt * 256; t.brow1 = t.brow0 + 128; t.ldb = 2048; t.KB = 2048;
#if MOEQ == 3
  gemmrv_tile_256<false>(t, smem, acc);
#elif MOEQ == 2
  gemmrs_tile_256<false>(t, smem, acc);
#else
  gemmr_tile_256<true, false>(t, smem, acc);
#endif
  const float* bd = p.b_dn + e * 2048 + nt * 256;
  const int tq_ = opaque_tid(); const int cl = (tq_ >> 6 & 1) * 64 + (tq_ & 31);
  const float bdv[4] = {bd[cl], bd[cl + 32], bd[cl + 128], bd[cl + 160]};
  epi_store_bf16<YNT != 0>(acc, smem, p.ybuf() + (long)t.m0 * 2048 + nt * 256, 2048, 128, 128, [&](int, int, float (&v)[4]) {
#pragma unroll
    for (int nb = 0; nb < 4; ++nb) v[nb] = v[nb] * WISCALE_ + bdv[nb];
  });
}
template <int WHICH>
__device__ __forceinline__ void ph_moeq(const Params& p, char* smem) {
  int* mo = (int*)(smem + G_LDS_BYTES);
#if CVT_SPLIT
  const bool dn_first = ((blockIdx.x >> 3) & 1) != 0;
  if (WHICH == 1 && dn_first) ph_convert_dn(p, smem);
#endif
  moe_setup(p, mo);
  const int NT = (WHICH == 1) ? 16 : 8;
  const int total = mo[NE_] * NT;
#if SKEW
  { const int sl = (blockIdx.x >> 3) % 5; for (int i = 0; i < sl; ++i) __builtin_amdgcn_s_sleep(SKEW); }
#endif
  for (int round = 0;; ++round) {
    const int u = xcd_unit(round);
    if (round * 256 >= total) break;
    if (u >= total) continue;
    int e = 0;
    while (mo[e + 1] * NT <= u) ++e;
    const int local = u - mo[e] * NT, me = mo[e + 1] - mo[e];
    const int nt = UORD ? (local % NT) : (local / me), mt = UORD ? (local / NT) : (local - (local / me) * me);
    if (WHICH == 1) moe1q_tile(p, smem, mo, e, nt, mt); else moe2q_tile(p, smem, mo, e, nt, mt);
  }
#if CVT_SPLIT
  if (WHICH == 1 && !dn_first) ph_convert_dn(p, smem);
#endif
}
#define LDS_MAX 143360
#ifndef DUP
#define DUP 0
#endif
#ifndef MOEQ
#define MOEQ 1
#endif
#ifndef CVT_SPLIT
#define CVT_SPLIT 1
#endif
#ifndef CVT_STAGGER
#define CVT_STAGGER 1
#endif
#ifndef CVT_IN_P4
#define CVT_IN_P4 1
#endif
#ifndef TSTAMP
#define TSTAMP 0
#endif
#ifndef DENSER
#define DENSER 1
#endif
__global__ void __launch_bounds__(256, 1) mega(Params p) {
  extern __shared__ __attribute__((aligned(16))) char smem[];
  volatile LAS unsigned* xbw = (volatile LAS unsigned*)(smem + LDS_MAX - 16);
  if (threadIdx.x == 0) { xbw[0] = 0u; xbw[1] = 0u; xbw[2] = 0u; xbw[3] = 0u; }
  __syncthreads();
  (void)xcd_barrier_post(p.bar(), xbw);
#if TSTAMP
  unsigned long long ts0 = wall_clock64();
  int bar_no = 0;
#define XBAR() do { XcdBarrier bar_; bar_.bar = p.bar(); bar_.x = xb_xcc_id(); bar_.st = (volatile LAS unsigned*)(smem + LDS_MAX - 16); xcd_barrier(bar_); ++bar_no; if (bar_no == TSTAMP && blockIdx.x == 0 && threadIdx.x == 0) { ((float*)p.counts())[48] = (float)(wall_clock64() - ts0) * (1.0f / 100.0f); } } while (0)
#else
#define XBAR() do { XcdBarrier bar_; bar_.bar = p.bar(); bar_.x = xb_xcc_id(); bar_.st = (volatile LAS unsigned*)(smem + LDS_MAX - 16); xcd_barrier(bar_); } while (0)
#endif
#if DUP == 100
  for (int rep_ = 0; rep_ < 2; ++rep_) {
  if (rep_) XBAR();
#endif
  ph_prep0(p);
#if DUP == 33
  if (blockIdx.x < 192) gla_g1_unit(p, smem, blockIdx.x);
  else for (int i = 0; i < 5; ++i) gla_g1_unit(p, smem, 192 + (blockIdx.x - 192) * 5 + i);
#endif
#if DUP == 30
  ph_prep0(p);
#endif
#if DENSER
  ph_convert_dense(p, smem);
#endif
#if MOEQ >= 1 && CVT_IN_P4 == 0
  ph_convert(p, smem);
#if DUP == 20
  ph_convert(p, smem);
#endif
#endif
  XBAR();
#if DENSER
  ph_win_r(p, smem);
#else
  ph_win(p, smem);
#endif
#if DUP == 1
#if DENSER
  ph_win_r(p, smem);
#else
  ph_win(p, smem);
#endif
#endif
  XBAR();
  ph_prep1(p, smem);
#if DUP == 2
  ph_prep1(p, smem);
#endif
  XBAR();
#if DENSER
  upkv_tile_r(p, smem, blockIdx.x >> 3, blockIdx.x & 7);
  if (blockIdx.x < 192) upq_tile_r(p, smem, blockIdx.x / 6, blockIdx.x % 6);
#else
  upkv_tile(p, smem, blockIdx.x >> 3, blockIdx.x & 7);
  if (blockIdx.x < 192) upq_tile(p, smem, blockIdx.x / 6, blockIdx.x % 6);
#endif
  if (blockIdx.x < 192) gla_g1_unit(p, smem, blockIdx.x);
  else for (int i = 0; i < 4; ++i) gla_g1_unit(p, smem, 192 + (blockIdx.x - 192) * 4 + i);
  if (blockIdx.x < 64) gla_g1_unit(p, smem, 448 + blockIdx.x);
#if DUP == 3
  upkv_tile(p, smem, blockIdx.x >> 3, blockIdx.x & 7);
  if (blockIdx.x < 192) upq_tile(p, smem, blockIdx.x / 6, blockIdx.x % 6);
  if (blockIdx.x < 192) gla_g1_unit(p, smem, blockIdx.x);
  else for (int i = 0; i < 5; ++i) gla_g1_unit(p, smem, 192 + (blockIdx.x - 192) * 5 + i);
#endif
  XBAR();
  gla_g2_unit(p, blockIdx.x);
#if DUP == 31
  gla_g2_unit(p, blockIdx.x);
#endif
  {
    const int bh = blockIdx.x >> 4, qa = blockIdx.x & 15;
#if MOEQ >= 1 && CVT_IN_ATTN
    int ci = 0;
    attn_unit(p, smem, bh >> 3, bh & 7, 31 - qa, ci);
    attn_unit(p, smem, bh >> 3, bh & 7, qa, ci);
    for (; ci < 64; ++ci) convert_one(p, smem, blockIdx.x + 256 * ci);
#else
    int ci = 64;
#if MOEQ >= 1 && CVT_IN_P4
    const bool cvt_first = CVT_STAGGER ? (((blockIdx.x >> 3) & 1) != 0) : false;
    if (cvt_first) { if (CVT_SPLIT) ph_convert_gu(p, smem, 0, 1); else ph_convert(p, smem); }
#endif
    attn_unit(p, smem, bh >> 3, bh & 7, 31 - qa, ci);
    attn_unit(p, smem, bh >> 3, bh & 7, qa, ci);
#if MOEQ >= 1 && CVT_IN_P4
    if (!cvt_first) { if (CVT_SPLIT) ph_convert_gu(p, smem, 0, 1); else ph_convert(p, smem); }
#endif
#endif
#if DUP == 44
    if (cvt_first) ph_convert(p, smem);
    { int cz = 64; attn_unit(p, smem, bh >> 3, bh & 7, 31 - qa, cz); attn_unit(p, smem, bh >> 3, bh & 7, qa, cz); }
    if (!cvt_first) ph_convert(p, smem);
#endif
#if DUP == 4
    { int cz = 64; attn_unit(p, smem, bh >> 3, bh & 7, 31 - qa, cz); attn_unit(p, smem, bh >> 3, bh & 7, qa, cz); }
#endif
  }
  XBAR();
  for (int u = blockIdx.x; u < 512; u += gridDim.x) gla_g3_unit(p, smem, u);
  mla_norm_tokens(p);
#if DUP == 5
  for (int u = blockIdx.x; u < 512; u += gridDim.x) gla_g3_unit(p, smem, u);
  mla_norm_tokens(p);
#endif
  XBAR();
#if DENSER
  wout_tile_r(p, smem, (blockIdx.x & 7) * 4 + ((blockIdx.x >> 3) & 3), blockIdx.x >> 5);
#else
  wout_tile(p, smem, blockIdx.x >> 3, blockIdx.x & 7);
#endif
#if DUP == 6
  wout_tile(p, smem, blockIdx.x >> 3, blockIdx.x & 7);
#endif
  XBAR();
  ffn_prep_unit(p, smem, blockIdx.x);
#if DUP == 7
  ffn_prep_unit<1>(p, smem, blockIdx.x);
#endif
  XBAR();
#if MOEQ >= 1
  ph_moeq<1>(p, smem);
#if DUP == 8
  ph_moeq<1>(p, smem);
#endif
#else
  ph_moe<1>(p, smem);
#endif
  XBAR();
#if MOEQ >= 1
  ph_moeq<2>(p, smem);
#else
  ph_moe<2>(p, smem);
#endif
#if DUP == 9
  ph_moeq<2>(p, smem);
#endif
#if DUP == 89
  XBAR();
  ph_moeq<1>(p, smem);
  XBAR();
  ph_moeq<2>(p, smem);
#endif
#if DUP == 19
  ph_moe<2, 1>(p, smem);
#endif
  XBAR();
#if DUP == 100
  ph_final(p, smem);
  }
#endif
#if TSTAMP
  {
    const float us = ((const float*)p.counts())[48];
    const float scl = 1.0f + us * (1.0f / 4000.0f);
    ph_final(p, smem, scl);
  }
#else
  ph_final(p, smem);
#endif
#if DUP == 10
  ph_final(p, smem);
#endif
#if DUP == 11
  for (int i = 0; i < 10; ++i) XBAR();
#endif
}

extern "C" void kernel_launch(void* const* d_in, const int* in_sizes, int n_in,
                              void* d_out, int out_size, void* d_ws, size_t ws_size,
                              hipStream_t stream) {
  Params P{};
  P.x = (const float*)d_in[0]; P.pos = (const int*)d_in[1];
  P.attn_norm = (const float*)d_in[2]; P.w_in = (const float*)d_in[3]; P.gate_up = (const float*)d_in[4]; P.gate_bias = (const float*)d_in[5];
  P.gla_out_norm = (const float*)d_in[6]; P.q_norm = (const float*)d_in[7]; P.w_uq = (const float*)d_in[8]; P.kv_norm = (const float*)d_in[9];
  P.w_ukv = (const float*)d_in[10]; P.mla_out_norm = (const float*)d_in[11]; P.w_out = (const float*)d_in[12]; P.ffn_norm = (const float*)d_in[13];
  P.router_w = (const float*)d_in[14]; P.router_b = (const float*)d_in[15]; P.w_gu = (const float*)d_in[16]; P.b_gu = (const float*)d_in[17];
  P.w_dn = (const float*)d_in[18]; P.b_dn = (const float*)d_in[19]; P.final_norm = (const float*)d_in[20];
  P.out = (float*)d_out;

  P.ws = (char*)d_ws;

  hipFuncSetAttribute((const void*)mega, hipFuncAttributeMaxDynamicSharedMemorySize, LDS_MAX);
  hipMemsetAsync(d_ws, 0, XCD_BAR_WORDS * sizeof(unsigned), stream);
  mega<<<256, 256, LDS_MAX, stream>>>(P);
}
```

```cpp
#define DUP 0
#define MOEQ 2
#define TSTAMP 0
#define CVT_SPLIT 1
#define CVT_IN_P4 1
#define WIN_SPLIT 1
#define CVT_IN_ATTN 0
#define YNT 0
#define ANT 0
#define BNT 1
#define UORD 0
#define LOOK1 1
#define LOOK2 0
#define WOUTQ 0
#define SKEW 0
#define CVT_STAGGER 1
#include <hip/hip_runtime.h>
#include <hip/hip_bf16.h>
#include <stdint.h>
#include <type_traits>
#define T_      8192
#define SEQ_    4096
#define D_      2048
#define NC_     4176
#define C_GQ    0
#define C_GK    512
#define C_GV    1024
#define C_GR    2048
#define C_GD    3072
#define C_MQ    3088
#define C_MKV   3600
#define C_MKR   4112
#define NE_     32
#define DFF_    2048
#define EPS_    1e-6f
typedef short bf16x8 __attribute__((ext_vector_type(8)));
typedef short s16x4 __attribute__((ext_vector_type(4)));
typedef float f32x16 __attribute__((ext_vector_type(16)));
typedef float f32x4 __attribute__((ext_vector_type(4)));
typedef float f32x2 __attribute__((ext_vector_type(2)));
typedef unsigned short u16;
typedef unsigned u32x4 __attribute__((ext_vector_type(4)));
typedef unsigned u32x2 __attribute__((ext_vector_type(2)));
#define LAS3 __attribute__((address_space(3)))
#define OPAQUE(x) asm volatile("" : "+v"(x))
#define NTHR 256
__device__ __forceinline__ int opaque_tid() { int t = threadIdx.x; asm volatile("" : "+v"(t)); return t; }

__device__ __forceinline__ unsigned pack_bf16(float a, float b) {
  typedef __bf16 bf2 __attribute__((ext_vector_type(2)));
  typedef float f2 __attribute__((ext_vector_type(2)));
  f2 v = {a, b};
  bf2 r = __builtin_convertvector(v, bf2);
  return *(unsigned*)&r;
}
__device__ __forceinline__ float bf_lo(unsigned w) { return __uint_as_float(w << 16); }
__device__ __forceinline__ float bf_hi(unsigned w) { return __uint_as_float(w & 0xffff0000u); }
__device__ __forceinline__ float bf16_to_f32(u16 v) { return __uint_as_float(((unsigned)v) << 16); }
__device__ __forceinline__ u16 f32_to_bf16(float f) { return (u16)(pack_bf16(f, 0.f) & 0xffffu); }
__device__ __forceinline__ float shflx(float v, int k) {
  int t = threadIdx.x; asm volatile("" : "+v"(t));
  return __int_as_float(__builtin_amdgcn_ds_bpermute((((t & 63) ^ k) << 2), __float_as_int(v)));
}
__device__ __forceinline__ float wave_sum(float v) {
#pragma unroll
  for (int o = 32; o > 0; o >>= 1) v += shflx(v, o);
  return v;
}
__device__ __forceinline__ unsigned off_b(unsigned row, unsigned ch) { return 256u * row + 16u * (ch ^ (((row & 3u) << 2) | ((row >> 2) & 3u))); }
__device__ __forceinline__ unsigned tr_addr(unsigned lane, unsigned c, unsigned row0  ) {
  const unsigned blk = (lane >> 4) & 1u, q = (lane & 15u) >> 2, p = lane & 3u;
  return off_b(row0 + q, 4u * c + 2u * blk + (p >> 1)) + 8u * (p & 1u);
}
__device__ __forceinline__ bf16x8 tr_frag(const char* img, unsigned lane, unsigned c, unsigned row_a, unsigned row_b) {
  s16x4 v0 = __builtin_amdgcn_ds_read_tr16_b64_v4i16((LAS3 s16x4*)(img + tr_addr(lane, c, row_a)));
  s16x4 v1 = __builtin_amdgcn_ds_read_tr16_b64_v4i16((LAS3 s16x4*)(img + tr_addr(lane, c, row_b)));
  return (bf16x8){v0[0], v0[1], v0[2], v0[3], v1[0], v1[1], v1[2], v1[3]};
}

__device__ __forceinline__ void glds16_asm(const void* gsrc, unsigned lds_dst) {
  unsigned keep;
  asm volatile("s_mov_b32 %0, m0\n\ts_mov_b32 m0, %2\n\ts_nop 0\n\tglobal_load_lds_dwordx4 %1, off\n\ts_mov_b32 m0, %0" : "=&s"(keep) : "v"(gsrc), "s"(lds_dst) : "memory");
}
__device__ __forceinline__ void glds16_asm_nt(const void* gsrc, unsigned lds_dst) {
  unsigned keep;
  asm volatile("s_mov_b32 %0, m0\n\ts_mov_b32 m0, %2\n\ts_nop 0\n\tglobal_load_lds_dwordx4 %1, off nt\n\ts_mov_b32 m0, %0" : "=&s"(keep) : "v"(gsrc), "s"(lds_dst) : "memory");
}
struct Params {
  const float *x; const int* pos;
  const float *attn_norm, *w_in, *gate_up, *gate_bias, *gla_out_norm, *q_norm, *w_uq, *kv_norm, *w_ukv, *mla_out_norm, *w_out,
              *ffn_norm, *router_w, *router_b, *w_gu, *b_gu, *w_dn, *b_dn, *final_norm;
  float* out;
  char* ws;
  __device__ __forceinline__ unsigned* bar() const { return (unsigned*)(ws + 0ull); }
  __device__ __forceinline__ int* counts() const { return (int*)(ws + 16384ull); }
  __device__ __forceinline__ u16* h1() const { return (u16*)(ws + 16640ull); }
  __device__ __forceinline__ u16* proj() const { return (u16*)(ws + 33571072ull); }
  __device__ __forceinline__ float2* cs() const { return (float2*)(ws + 101990656ull); }
  __device__ __forceinline__ float* rq() const { return (float*)(ws + 104087808ull); }
  __device__ __forceinline__ float* rkv() const { return (float*)(ws + 104120576ull); }
  __device__ __forceinline__ float* bcum() const { return (float*)(ws + 104153344ull); }
  __device__ __forceinline__ u16* q() const { return (u16*)(ws + 120930560ull); }
  __device__ __forceinline__ u16* kv() const { return (u16*)(ws + 146096384ull); }
  __device__ __forceinline__ u16* kpe() const { return (u16*)(ws + 179650816ull); }
  __device__ __forceinline__ u16* kvc() const { return (u16*)(ws + 180699392ull); }
  __device__ __forceinline__ float* dec() const { return (float*)(ws + 214253824ull); }
  __device__ __forceinline__ u16* sprev() const { return (u16*)(ws + 214515968ull); }
  __device__ __forceinline__ u16* mix() const { return (u16*)(ws + 248070400ull); }
  __device__ __forceinline__ u16* omla() const { return (u16*)(ws + 281624832ull); }
  __device__ __forceinline__ float* x1() const { return (float*)(ws + 298402048ull); }
  __device__ __forceinline__ u16* h2() const { return (u16*)(ws + 365510912ull); }
  __device__ __forceinline__ int* list() const { return (int*)(ws + 399065344ull); }
  __device__ __forceinline__ int* asg_e() const { return (int*)(ws + 400113920ull); }
  __device__ __forceinline__ int* asg_slot() const { return (int*)(ws + 400244992ull); }
  __device__ __forceinline__ float* asg_g() const { return (float*)(ws + 400376064ull); }
  __device__ __forceinline__ u16* act() const { return (u16*)(ws + 400507136ull); }
  __device__ __forceinline__ u16* ybuf() const { return (u16*)(ws + 568279296ull); }
  __device__ __forceinline__ unsigned char* wq_gu() const { return (unsigned char*)(ws + 736051456ull); }
  __device__ __forceinline__ unsigned char* wq_dn() const { return (unsigned char*)(ws + 1004486912ull); }
  __device__ __forceinline__ unsigned char* h2q() const { return (unsigned char*)(ws + 1138704640ull); }
  __device__ __forceinline__ unsigned char* actq() const { return (unsigned char*)(ws + 1155481856ull); }
  __device__ __forceinline__ u16* wb_in() const { return (u16*)(ws + 1239367936ull); }
  __device__ __forceinline__ u16* wb_uq() const { return (u16*)(ws + 1257193728ull); }
  __device__ __forceinline__ u16* wb_ukv() const { return (u16*)(ws + 1258766592ull); }
  __device__ __forceinline__ u16* wb_out() const { return (u16*)(ws + 1260863744ull); }
  __device__ __forceinline__ unsigned char* mixq() const { return (unsigned char*)(ws + 1269252352ull); }
  __device__ __forceinline__ unsigned char* wq_out() const { return (unsigned char*)(ws + 1286029568ull); }
  __device__ __forceinline__ float* pn() const { return (float*)(ws + 1290223872ull); }
};
#define WS_BYTES_USED 1311195648ull

#define XB_TMO      128
#define XB_XCNT(j)  (256  + 64 * (j))
#define XB_XSUB(j)  (1280 + 64 * (j))
#define XB_XGEN(j)  (2304 + 64 * (j))
#define XB_TOP      3328
#define XB_TOPGEN   3392
#define XCD_BAR_WORDS 3456
#define XB_SPIN_CAP (1u << 18)
#define LAS __attribute__((address_space(3)))

__device__ __forceinline__ unsigned xb_ld(unsigned* p)              { return __hip_atomic_load(p, __ATOMIC_RELAXED, __HIP_MEMORY_SCOPE_AGENT); }
__device__ __forceinline__ unsigned xb_add(unsigned* p, unsigned v) { return __hip_atomic_fetch_add(p, v, __ATOMIC_RELAXED, __HIP_MEMORY_SCOPE_AGENT); }
__device__ __forceinline__ unsigned xb_xcc_id() { return (unsigned)__builtin_amdgcn_s_getreg((3 << 11) | 20) & 0xFu; }
#define XB_SPIN(cond, bar) do { unsigned _sp = 0; while (cond) { __builtin_amdgcn_s_sleep(1); \
    if ((++_sp & 255u) == 0u) { if (xb_ld(&(bar)[XB_TMO])) break; if (_sp > XB_SPIN_CAP) { atomicAdd(&(bar)[XB_TMO], 1u); break; } } } } while (0)

struct XcdBarrier {
    unsigned* bar; unsigned x;
    volatile LAS unsigned* st;
};

__device__ __forceinline__ XcdBarrier xcd_barrier_post(unsigned* bar, volatile LAS unsigned* st) {
    XcdBarrier b; b.bar = bar; b.x = xb_xcc_id(); b.st = st;
    if (threadIdx.x == 0) (void)xb_add(&bar[XB_XCNT(b.x)], 1u);
    return b;
}
__device__ __forceinline__ void xcd_barrier_complete(unsigned* bar, unsigned x, unsigned& nloc, unsigned& nx) {
    const unsigned G = gridDim.x * gridDim.y * gridDim.z;
    unsigned sum, cnt, mine, sp = 0u;
    for (;;) {
        sum = 0u; cnt = 0u; mine = 0u;
#pragma unroll
        for (unsigned j = 0; j < 16; ++j) { const unsigned c = xb_ld(&bar[XB_XCNT(j)]); sum += c; cnt += (c > 0u) ? 1u : 0u; mine = (j == x) ? c : mine; }
        if (sum == G) break;
        __builtin_amdgcn_s_sleep(1);
        if ((++sp & 255u) == 0u) { if (xb_ld(&bar[XB_TMO])) break; if (sp > XB_SPIN_CAP) { atomicAdd(&bar[XB_TMO], 1u); break; } }
    }
    nloc = mine > 0u ? mine : 1u; nx = cnt > 0u ? cnt : 1u;
}

__device__ __forceinline__ void xcd_barrier(const XcdBarrier& b) {
    asm volatile("s_waitcnt vmcnt(0)" ::: "memory");
    __syncthreads();
    if (threadIdx.x == 0) {
        unsigned* bar = b.bar;
        __builtin_amdgcn_s_waitcnt(0);
        unsigned nloc = b.st[0], nx = b.st[1];
        if (nloc == 0u) { xcd_barrier_complete(bar, b.x, nloc, nx); b.st[0] = nloc; b.st[1] = nx; }
        const unsigned old = xb_add(&bar[XB_XSUB(b.x)], 1u);
        const unsigned gen = old / nloc;
        if (old + 1u == (gen + 1u) * nloc) {
            __builtin_amdgcn_fence(__ATOMIC_RELEASE, "agent");
            asm volatile("s_waitcnt vmcnt(0)" ::: "memory");
            const unsigned og = xb_add(&bar[XB_TOP], 1u);
            const unsigned tg = og / nx;
            if (og + 1u == (tg + 1u) * nx) xb_add(&bar[XB_TOPGEN], 1u);
            else XB_SPIN(xb_ld(&bar[XB_TOPGEN]) == tg, bar);
            __builtin_amdgcn_fence(__ATOMIC_ACQUIRE, "agent");
            xb_add(&bar[XB_XGEN(b.x)], 1u);
            asm volatile("s_waitcnt vmcnt(0)" ::: "memory");
        } else {
            XB_SPIN(xb_ld(&bar[XB_XGEN(b.x)]) == gen, bar);
            __builtin_amdgcn_fence(__ATOMIC_ACQUIRE, "agent");
            asm volatile("s_waitcnt vmcnt(0)" ::: "memory");
        }
    }
    __syncthreads();
}

#define G_A_OFF(s)  ((s) * 65536)
#define G_B_OFF(s)  ((s) * 65536 + 32768)
#define G_LDS_BYTES 131072

struct GemmTile {
  const u16* A; int lda;
  const int* aidx;
  int m0, mvalid;
  const float* B0; const float* B1;
  int ldb; int nv0, nv1;
  const float* kscale;
  int K;
};

template <int NB, bool KSCALE, bool GATHER>
__device__ __forceinline__ void gemm_tile_256(const GemmTile& t, char* smem, f32x16 (&acc)[4][4]) {
  int tz0 = threadIdx.x; asm volatile("" : "+v"(tz0));
  const int tid = tz0, lane = tid & 63, wid = tid >> 6, wr = wid >> 1, wc = wid & 1;
  const int l31 = lane & 31, hh = lane >> 5;
#pragma unroll
  for (int i = 0; i < 4; ++i)
#pragma unroll
    for (int j = 0; j < 4; ++j)
#pragma unroll
      for (int r = 0; r < 16; ++r) acc[i][j][r] = 0.f;

  const int a_c = (tid & 7) ^ ((tid >> 4) & 7);
  const u16* a_src[GATHER ? 8 : 1];
  if (GATHER) {
#pragma unroll
    for (int i = 0; i < (GATHER ? 8 : 1); ++i) {
      int r = (tid >> 3) + 32 * i;
      int rr = r < t.mvalid ? r : 0;
      a_src[i] = t.A + (long)t.aidx[rr] * t.lda + a_c * 8;
    }
  } else {
    a_src[0] = t.A + (long)(t.m0 + (tid >> 3)) * t.lda + a_c * 8;
  }
  const long a_step = 32L * t.lda;
  const int b_n4 = tid & 63, b_k = tid >> 6;
  const int b_k_u = __builtin_amdgcn_readfirstlane(b_k);
  const int b_img = b_n4 >> 5, b_ch = (b_n4 >> 1) & 15, b_half = b_n4 & 1;
  const bool b_ok = ((b_n4 & 31) * 4) < (b_img ? t.nv1 : t.nv0);
  const int b_loff = (b_ok ? ((b_img ? (int)(t.B1 - t.B0) : 0) + (b_n4 & 31) * 4) : 0) + b_k * t.ldb;
  f32x4 breg[16];

  const unsigned a_lds0 = (unsigned)(size_t)smem + (unsigned)__builtin_amdgcn_readfirstlane(wid) * 1024u;
  auto issue_a = [&](int kt, int s, int i) {
    glds16_asm((const void*)((GATHER ? a_src[GATHER ? i : 0] : a_src[0] + i * a_step) + kt * 64), a_lds0 + G_A_OFF(s) + i * 4096);
  };
  auto issue_b = [&](int kt, int j) {
    const float* ptr = t.B0 + (long)(kt * 64 + 4 * j) * t.ldb + b_loff;
    asm volatile("global_load_dwordx4 %0, %1, off" : "=v"(breg[j]) : "v"(ptr) : "memory");
  };
  auto write_b = [&](int kt, int s, int j) {
    const int k = b_k + 4 * j;
    f32x4 v = breg[j];
    if (KSCALE) { float sc = t.kscale[kt * 64 + b_k_u + 4 * j]; v *= sc; }
    if (!b_ok) v = (f32x4){0.f, 0.f, 0.f, 0.f};
    u32x2 w = {pack_bf16(v[0], v[1]), pack_bf16(v[2], v[3])};
    *(u32x2*)(smem + G_B_OFF(s) + b_img * 16384 + off_b(k, b_ch) + 8 * b_half) = w;
  };
#define WAITQ(N, g) asm volatile("s_waitcnt vmcnt(" #N ")" : "+v"(breg[4 * (g)]), "+v"(breg[4 * (g) + 1]), "+v"(breg[4 * (g) + 2]), "+v"(breg[4 * (g) + 3]) :: "memory")

  unsigned a_rd[4], b_rd[2][2];
#pragma unroll
  for (int ks = 0; ks < 4; ++ks) { const int row = wr * 128 + l31; a_rd[ks] = row * 128 + (((2 * ks + hh) ^ ((row >> 1) & 7)) * 16); }
#pragma unroll
  for (int tt = 0; tt < 2; ++tt)
#pragma unroll
    for (int nl = 0; nl < 2; ++nl) b_rd[tt][nl] = tr_addr(lane, wc * 2 + nl, 8 * hh + 4 * tt);
  auto load_a = [&](const char* As, int ks, bf16x8 (&af)[4]) {
#pragma unroll
    for (int mb = 0; mb < 4; ++mb) af[mb] = *(const bf16x8*)(As + a_rd[ks] + mb * 4096);
  };
  auto load_b1 = [&](const char* Bs, int ks, int nb, bf16x8& bfr) {
    const char* bi = Bs + (nb >> 1) * 16384 + ks * 4096;
    s16x4 v0 = __builtin_amdgcn_ds_read_tr16_b64_v4i16((LAS3 s16x4*)(bi + b_rd[0][nb & 1]));
    s16x4 v1 = __builtin_amdgcn_ds_read_tr16_b64_v4i16((LAS3 s16x4*)(bi + b_rd[1][nb & 1]));
    bfr = (bf16x8){v0[0], v0[1], v0[2], v0[3], v1[0], v1[1], v1[2], v1[3]};
  };

  auto kstep = [&](int kt, auto mode_tag, bool has1, bool has2) {
    constexpr int MODE = decltype(mode_tag)::value;
    const int s = kt & 1;
    const char* As = smem + G_A_OFF(s);
    const char* Bs = smem + G_B_OFF(s);
    bf16x8 a0[4], a1[4], bq[NB];
    load_a(As, 0, a0);
#pragma unroll
    for (int nb = 0; nb < NB; ++nb) load_b1(Bs, 0, nb, bq[nb]);
    __builtin_amdgcn_sched_barrier(0);
#pragma unroll
    for (int g = 0; g < 4; ++g) {
      bf16x8 (&ac)[4] = (g & 1) ? a1 : a0;
      bf16x8 (&an)[4] = (g & 1) ? a0 : a1;
      if (g < 3) load_a(As, g + 1, an);
      __builtin_amdgcn_sched_barrier(0);
#pragma unroll
      for (int nb = 0; nb < NB; ++nb) {
#pragma unroll
        for (int mb = 0; mb < 4; ++mb)
          acc[mb][nb] = __builtin_amdgcn_mfma_f32_32x32x16_bf16(ac[mb], bq[nb], acc[mb][nb], 0, 0, 0);
        __builtin_amdgcn_sched_barrier(0);
        if (g < 3) load_b1(Bs, g + 1, nb, bq[nb]);
        if (nb == 0 && g < 2 && has1) { issue_a(kt + 1, s ^ 1, 4 * g + 0); issue_a(kt + 1, s ^ 1, 4 * g + 1); }
        if (nb == 1 % NB && g < 2 && has1 && NB > 1) { issue_a(kt + 1, s ^ 1, 4 * g + 2); issue_a(kt + 1, s ^ 1, 4 * g + 3); }
        if (NB == 1 && nb == 0 && g < 2 && has1) { issue_a(kt + 1, s ^ 1, 4 * g + 2); issue_a(kt + 1, s ^ 1, 4 * g + 3); }
        if (nb == NB - 1 && has1) {
          if (MODE == 2) { if (g == 0) WAITQ(20, 0); else if (g == 1) WAITQ(20, 1); else if (g == 2) WAITQ(20, 2); else WAITQ(20, 3); }
          else if (MODE == 1) { if (g == 0) WAITQ(16, 0); else if (g == 1) WAITQ(20, 1); else if (g == 2) WAITQ(20, 2); else WAITQ(20, 3); }
          else { if (g == 0) WAITQ(0, 0); else if (g == 1) WAITQ(0, 1); else if (g == 2) WAITQ(0, 2); else WAITQ(0, 3); }
#pragma unroll
          for (int i = 0; i < 4; ++i) write_b(kt + 1, s ^ 1, 4 * g + i);
          if (has2) {
#pragma unroll
            for (int i = 0; i < 4; ++i) issue_b(kt + 2, 4 * g + i);
          }
        }
        __builtin_amdgcn_sched_barrier(0);
      }
    }
    if (has1) {
      if (MODE == 0) asm volatile("s_waitcnt vmcnt(0)" ::: "memory");
      else asm volatile("s_waitcnt vmcnt(12)" ::: "memory");
      __syncthreads();
    }
  };

  const int nk = t.K >> 6;
  __syncthreads();
#pragma unroll
  for (int j = 0; j < 16; ++j) issue_b(0, j);
#pragma unroll
  for (int i = 0; i < 8; ++i) issue_a(0, 0, i);
  WAITQ(8, 0); WAITQ(8, 1); WAITQ(8, 2); WAITQ(8, 3);
#pragma unroll
  for (int j = 0; j < 16; ++j) write_b(0, 0, j);
#pragma unroll
  for (int j = 0; j < 16; ++j) issue_b(1, j);
  asm volatile("s_waitcnt vmcnt(16)" ::: "memory");
  __syncthreads();
  kstep(0, std::integral_constant<int, 1>{}, true, true);
  for (int kt = 1; kt < nk - 2; ++kt) kstep(kt, std::integral_constant<int, 2>{}, true, true);
  kstep(nk - 2, std::integral_constant<int, 0>{}, true, false);
  kstep(nk - 1, std::integral_constant<int, 0>{}, false, false);
#undef WAITQ
}
template <int NB, class F>
__device__ __forceinline__ void acc_foreach_row(f32x16 (&acc)[4][4], F f) {
  int tz = threadIdx.x; asm volatile("" : "+v"(tz));
  const int lane = tz & 63, wid = tz >> 6, wr = wid >> 1, wc = wid & 1;
  const int l31 = lane & 31, hh = lane >> 5;
#pragma unroll
  for (int mb = 0; mb < 4; ++mb)
#pragma unroll
    for (int reg = 0; reg < 16; ++reg) {
      const int rowl = wr * 128 + mb * 32 + (reg & 3) + 8 * (reg >> 2) + 4 * hh;
      float v[NB];
#pragma unroll
      for (int nb = 0; nb < NB; ++nb) v[nb] = acc[mb][nb][reg];
      f(rowl, wc * 64 + l31, v);
      asm volatile("" ::: "memory");
    }
}
__device__ __forceinline__ void ph_prep0(const Params& p) {
  const int tid_ = opaque_tid(); const int lane = tid_ & 63, wid = tid_ >> 6;
  if (blockIdx.x == 0 && tid_ < 64) p.counts()[tid_] = 0;
  for (int t = blockIdx.x * 4 + wid; t < T_; t += gridDim.x * 4) {
    const float* xr = p.x + (long)t * 2048;
    f32x4 v[8]; float ss = 0.f;
#pragma unroll
    for (int j = 0; j < 8; ++j) { v[j] = __builtin_nontemporal_load((const f32x4*)(xr + j * 256 + lane * 4)); ss += v[j][0] * v[j][0] + v[j][1] * v[j][1] + v[j][2] * v[j][2] + v[j][3] * v[j][3]; }
    ss = wave_sum(ss);
    const float r = rsqrtf(ss * (1.0f / 2048.0f) + EPS_);
#pragma unroll
    for (int j = 0; j < 8; ++j) {
      f32x4 g = *(const f32x4*)(p.attn_norm + j * 256 + lane * 4);
      u32x2 w = {pack_bf16(v[j][0] * r * g[0], v[j][1] * r * g[1]), pack_bf16(v[j][2] * r * g[2], v[j][3] * r * g[3])};
      *(u32x2*)(p.h1() + (long)t * 2048 + j * 256 + lane * 4) = w;
    }
    if (lane < 32) {
      float inv = __builtin_amdgcn_exp2f(-(float)lane * (13.287712379549449f / 32.0f));
      float ang = (float)p.pos[t] * inv;
      double a = (double)ang;
      double k = rint(a * 0.15915494309189535);
      float rf = (float)fma(-k, 6.283185307179586, a);
      p.cs()[t * 32 + lane] = make_float2(__cosf(rf), __sinf(rf));
    }
  }
}

template <int NB>
__device__ __forceinline__ void win_tile(const Params& p, char* smem, int mt, int nt) {
  f32x16 acc[4][4];
  GemmTile t{};
  t.A = p.h1(); t.lda = 2048; t.aidx = nullptr; t.m0 = mt * 256; t.mvalid = 256;
  t.B0 = p.w_in + nt * 256; t.B1 = t.B0 + 128; t.ldb = NC_;
  const int rem = NC_ - nt * 256;
  t.nv0 = rem >= 128 ? 128 : rem; t.nv1 = rem >= 256 ? 128 : (rem > 128 ? rem - 128 : 0);
  t.kscale = nullptr; t.K = 2048;
  gemm_tile_256<NB, false, false>(t, smem, acc);
  u16* base = p.proj() + (long)(mt * 256) * NC_ + nt * 256;
  const int nv0 = t.nv0, nv1 = t.nv1;
  acc_foreach_row<NB>(acc, [&](int rowl, int coll, float (&v)[NB]) {
    u16* rp = base + (long)rowl * NC_ + coll;
    OPAQUE(rp);
#pragma unroll
    for (int nb = 0; nb < NB; ++nb) {
      const int c = (nb & 1) * 32 + coll;
      const int lim = (nb >> 1) ? nv1 : nv0;
      if (c < lim) rp[(nb >> 1) * 128 + (nb & 1) * 32] = f32_to_bf16(v[nb]);
    }
  });
}
__device__ __forceinline__ void ph_win(const Params& p, char* smem) {
  const int x = blockIdx.x & 7, slot = blockIdx.x >> 3;
  for (int j = slot; j < 64; j += 32) win_tile<4>(p, smem, 4 * x + (j & 3), j >> 2);
  if (slot < 4) win_tile<2>(p, smem, 4 * x + slot, 16);
}

__device__ __forceinline__ void ph_prep1(const Params& p, char* smem) {
  float* gds = (float*)smem;
  float* cums = (float*)(smem + 4096);
  const int tid = opaque_tid(), lane = tid & 63, wid = tid >> 6;
  for (int u = blockIdx.x; u < 512; u += gridDim.x) {
    const int ch = u >> 2, h = u & 3; const int t0 = ch * 64;
    __syncthreads();
    {
      const int tl = tid >> 2, r4 = (tid & 3) * 4;
      u32x2 w = *(const u32x2*)(p.proj() + (long)(t0 + tl) * NC_ + C_GD + r4);
      gds[tl * 16 + r4 + 0] = bf_lo(w[0]); gds[tl * 16 + r4 + 1] = bf_hi(w[0]);
      gds[tl * 16 + r4 + 2] = bf_lo(w[1]); gds[tl * 16 + r4 + 3] = bf_hi(w[1]);
    }
    const int c = tid & 127, half = tid >> 7;
    float gu[16];
#pragma unroll
    for (int r = 0; r < 16; ++r) gu[r] = p.gate_up[r * 512 + h * 128 + c];
    const float bias = p.gate_bias[h * 128 + c];
    __syncthreads();
    float run = 0.f;
    for (int i = 0; i < 32; ++i) {
      const int tl = half * 32 + i;
      float z = bias;
#pragma unroll
      for (int r = 0; r < 16; ++r) z = fmaf(gds[tl * 16 + r], gu[r], z);
      const float ls = fminf(z, 0.f) - __logf(1.0f + __expf(-fabsf(z)));
      run += ls * (1.0f / 16.0f);
      cums[tl * 128 + c] = run;
    }
    __syncthreads();
    {
      const float add = cums[31 * 128 + c];
      for (int i = 0; i < 32; ++i) {
        const int tl = half * 32 + i;
        float v = cums[tl * 128 + c] + (half ? add : 0.f);
        p.bcum()[(long)(t0 + tl) * 512 + h * 128 + c] = v;
      }
    }
    for (int i = 0; i < 4; ++i) {
      const long t = t0 + h * 16 + wid * 4 + i;
      const u16* pr = p.proj() + t * NC_;
      u32x4 a = *(const u32x4*)(pr + C_MQ + lane * 8);
      float sa = 0.f, sb = 0.f;
#pragma unroll
      for (int k = 0; k < 4; ++k) { float l = bf_lo(a[k]), hgh = bf_hi(a[k]); sa += l * l + hgh * hgh; }
#if WIN_SPLIT
      auto pn_sum = [&](int col) { float s = 0.f;
#pragma unroll
        for (int kc = 0; kc < 8; ++kc) s += p.pn()[(long)kc * (8192 * 80) + t * 80 + col];
        return s; };
      const float pv = bf16_to_f32(f32_to_bf16(pn_sum(lane)));
      u32x4 b = {0u, 0u, 0u, 0u};
      if (lane < 62) b = *(const u32x4*)(pr + C_MKV + lane * 8);
#pragma unroll
      for (int k = 0; k < 4; ++k) { float l = bf_lo(b[k]), hgh = bf_hi(b[k]); sb += l * l + hgh * hgh; }
      if (lane < 16) sb += pv * pv;
#else
      u32x4 b = *(const u32x4*)(pr + C_MKV + lane * 8);
#pragma unroll
      for (int k = 0; k < 4; ++k) { float l = bf_lo(b[k]), hgh = bf_hi(b[k]); sb += l * l + hgh * hgh; }
#endif
      sa = wave_sum(sa); sb = wave_sum(sb);
      if (lane == 0) { p.rq()[t] = rsqrtf(sa * (1.0f / 512.0f) + EPS_); p.rkv()[t] = rsqrtf(sb * (1.0f / 512.0f) + EPS_); }
#if WIN_SPLIT
      {
        const float v0 = pv;
        const float v1 = (lane < 16) ? bf16_to_f32(f32_to_bf16(pn_sum(64 + lane))) : 0.f;
        u16* pw = p.proj() + t * NC_ + 4096;
        pw[lane] = f32_to_bf16(v0);
        if (lane < 16) pw[64 + lane] = f32_to_bf16(v1);
        const float t1 = __int_as_float(__builtin_amdgcn_ds_bpermute(((lane + 16) & 63) << 2, __float_as_int(v0)));
        const float t2a = __int_as_float(__builtin_amdgcn_ds_bpermute(((lane + 48) & 63) << 2, __float_as_int(v0)));
        const float t2b = __int_as_float(__builtin_amdgcn_ds_bpermute(((lane - 16) & 63) << 2, __float_as_int(v1)));
        if (lane < 32) {
          const float t2 = (lane < 16) ? t2a : t2b;
          const float2 cs = p.cs()[t * 32 + lane];
          p.kpe()[t * 64 + lane] = f32_to_bf16(t1 * cs.x - t2 * cs.y);
          p.kpe()[t * 64 + lane + 32] = f32_to_bf16(t1 * cs.y + t2 * cs.x);
        }
      }
#else
      if (lane < 32) {
        const float t1 = bf16_to_f32(pr[C_MKR + lane]), t2 = bf16_to_f32(pr[C_MKR + lane + 32]);
        const float2 cs = p.cs()[t * 32 + lane];
        p.kpe()[t * 64 + lane] = f32_to_bf16(t1 * cs.x - t2 * cs.y);
        p.kpe()[t * 64 + lane + 32] = f32_to_bf16(t1 * cs.y + t2 * cs.x);
      }
#endif
    }
  }
}

#define QSCALE_ (0.07216878364870322f * 1.4426950408889634f)
__device__ __forceinline__ void upq_tile(const Params& p, char* smem, int mt, int nt) {
  f32x16 acc[4][4];
  GemmTile t{};
  t.A = p.proj() + C_MQ; t.lda = NC_; t.aidx = nullptr; t.m0 = mt * 256; t.mvalid = 256;
  t.B0 = p.w_uq + nt * 256; t.B1 = t.B0 + 128; t.ldb = 1536; t.nv0 = 128; t.nv1 = 128; t.kscale = p.q_norm; t.K = 512;
  gemm_tile_256<4, true, false>(t, smem, acc);
  u16* base = p.q() + (long)(mt * 256) * 1536 + nt * 256;
  const float* rq = p.rq() + mt * 256;
  acc_foreach_row<4>(acc, [&](int rowl, int coll, float (&v)[4]) {
    u16* rp = base + (long)rowl * 1536 + coll;
    OPAQUE(rp);
    const float s = rq[rowl] * QSCALE_;
#pragma unroll
    for (int nb = 0; nb < 4; ++nb) rp[(nb >> 1) * 128 + (nb & 1) * 32] = f32_to_bf16(v[nb] * s);
  });
}
__device__ __forceinline__ void upkv_tile(const Params& p, char* smem, int mt, int nt) {
  f32x16 acc[4][4];
  GemmTile t{};
  t.A = p.proj() + C_MKV; t.lda = NC_; t.aidx = nullptr; t.m0 = mt * 256; t.mvalid = 256;
  t.B0 = p.w_ukv + nt * 256; t.B1 = t.B0 + 128; t.ldb = 2048; t.nv0 = 128; t.nv1 = 128; t.kscale = p.kv_norm; t.K = 512;
  gemm_tile_256<4, true, false>(t, smem, acc);
  u16* base = p.kv() + (long)(mt * 256) * 2048 + nt * 256;
  const float* rk = p.rkv() + mt * 256;
  acc_foreach_row<4>(acc, [&](int rowl, int coll, float (&v)[4]) {
    u16* rp = base + (long)rowl * 2048 + coll;
    OPAQUE(rp);
    const float s = rk[rowl];
#pragma unroll
    for (int nb = 0; nb < 4; ++nb) rp[(nb >> 1) * 128 + (nb & 1) * 32] = f32_to_bf16(v[nb] * s);
  });
}
#define WSCALE_  128.0f
#define WISCALE_ 0.0078125f
typedef unsigned char u8;
struct CvtUnit { const float* src; u8* dst; int ldn; };
__device__ __forceinline__ CvtUnit cvt8_decode(const Params& p, int u);
#define AT_KSTRIDE 400
#define AT_KBYTES  (64 * AT_KSTRIDE)
#define AT_STAGE   (AT_KBYTES + 16384)
#define AT_LDS_BYTES (2 * AT_STAGE)

#define AT_CVT_T(par) (smem + AT_LDS_BYTES + (par) * 16384)
__device__ __forceinline__ void attn_unit(const Params& p, char* smem, int b, int h, int qb, int& ci) {
  const int tid = opaque_tid(), lane = tid & 63, wid = tid >> 6, l31 = lane & 31, hh = lane >> 5;
  const long tq = (long)b * SEQ_ + qb * 128 + wid * 32 + l31;
  bf16x8 qf[12];
  {
    const u16* qp = p.q() + (tq * 8 + h) * 192 + 8 * hh;
#pragma unroll
    for (int ks = 0; ks < 12; ++ks) qf[ks] = *(const bf16x8*)(qp + 16 * ks);
#pragma unroll
    for (int s = 0; s < 2; ++s) {
      const float2* cp = p.cs() + tq * 32 + 16 * s + 8 * hh;
      bf16x8 lo = qf[8 + s], hi = qf[10 + s], nlo, nhi;
#pragma unroll
      for (int j = 0; j < 8; j += 2) {
        float2 c0 = cp[j], c1 = cp[j + 1];
        float a0 = bf16_to_f32((u16)lo[j]), a1 = bf16_to_f32((u16)lo[j + 1]);
        float b0 = bf16_to_f32((u16)hi[j]), b1 = bf16_to_f32((u16)hi[j + 1]);
        unsigned wl = pack_bf16(a0 * c0.x - b0 * c0.y, a1 * c1.x - b1 * c1.y);
        unsigned wh = pack_bf16(a0 * c0.y + b0 * c0.x, a1 * c1.y + b1 * c1.x);
        nlo[j] = (short)(wl & 0xffff); nlo[j + 1] = (short)(wl >> 16);
        nhi[j] = (short)(wh & 0xffff); nhi[j + 1] = (short)(wh >> 16);
      }
      qf[8 + s] = nlo; qf[10 + s] = nhi;
    }
  }
  u32x4 kregA[6], vregA[4], kregB[6], vregB[4];
  const long tk0 = (long)b * SEQ_;
  auto load_tile = [&](int kt, u32x4 (&kreg)[6], u32x4 (&vreg)[4]) {
    const long tb = tk0 + kt * 64;
#pragma unroll
    for (int i = 0; i < 4; ++i) {
      const int pp = i * 256 + tid; const int key = pp >> 4, c = pp & 15;
      const u16* rowp = p.kv() + ((tb + key) * 8 + h) * 256 + c * 8;
      kreg[i] = *(const u32x4*)rowp;
      vreg[i] = *(const u32x4*)(rowp + 128);
    }
#pragma unroll
    for (int i = 0; i < 2; ++i) {
      const int pp = i * 256 + tid; const int key = pp >> 3, c = pp & 7;
      kreg[4 + i] = *(const u32x4*)(p.kpe() + (tb + key) * 64 + c * 8);
    }
  };
  auto store_tile = [&](int s, u32x4 (&kreg)[6], u32x4 (&vreg)[4]) {
    char* Ks = smem + s * AT_STAGE; char* Vs = Ks + AT_KBYTES;
#pragma unroll
    for (int i = 0; i < 4; ++i) {
      const int pp = i * 256 + tid; const int key = pp >> 4, c = pp & 15;
      *(u32x4*)(Ks + key * AT_KSTRIDE + c * 16) = kreg[i];
      *(u32x4*)(Vs + off_b(key, c)) = vreg[i];
    }
#pragma unroll
    for (int i = 0; i < 2; ++i) {
      const int pp = i * 256 + tid; const int key = pp >> 3, c = pp & 7;
      *(u32x4*)(Ks + key * AT_KSTRIDE + (16 + c) * 16) = kreg[4 + i];
    }
  };

  f32x16 o[4];
#pragma unroll
  for (int c = 0; c < 4; ++c)
#pragma unroll
    for (int r = 0; r < 16; ++r) o[c][r] = 0.f;
  float m = -1e30f, l = 0.f;
  const int nt = 2 * qb + 2;
  const int qpos = qb * 128 + wid * 32 + l31;

  __syncthreads();
  load_tile(0, kregA, vregA);
  store_tile(0, kregA, vregA);
  load_tile(1, kregB, vregB);
  if (nt > 2) load_tile(2, kregA, vregA);
  __syncthreads();
  auto tile_body = [&](int kt, int s) {
    const char* Ks = smem + s * AT_STAGE; const char* Vs = Ks + AT_KBYTES;
    const bool active = (kt * 64) <= (qb * 128 + wid * 32 + 31);
    if (active) {
      f32x16 sc[2];
#pragma unroll
      for (int kb = 0; kb < 2; ++kb) {
#pragma unroll
        for (int r = 0; r < 16; ++r) sc[kb][r] = 0.f;
#pragma unroll
        for (int ks = 0; ks < 12; ++ks) {
          bf16x8 a = *(const bf16x8*)(Ks + (kb * 32 + l31) * AT_KSTRIDE + (2 * ks + hh) * 16);
          sc[kb] = __builtin_amdgcn_mfma_f32_32x32x16_bf16(a, qf[ks], sc[kb], 0, 0, 0);
        }
      }
      if (kt >= 2 * qb) {
#pragma unroll
        for (int kb = 0; kb < 2; ++kb)
#pragma unroll
          for (int r = 0; r < 16; ++r) {
            const int key = kt * 64 + kb * 32 + (r & 3) + 8 * (r >> 2) + 4 * hh;
            if (key > qpos) sc[kb][r] = -1e30f;
          }
      }
      float mx = sc[0][0];
#pragma unroll
      for (int kb = 0; kb < 2; ++kb)
#pragma unroll
        for (int r = 0; r < 16; ++r) mx = fmaxf(mx, sc[kb][r]);
      mx = fmaxf(mx, shflx(mx, 32));
      const float mn = fmaxf(m, mx);
      const float alpha = __builtin_amdgcn_exp2f(m - mn);
      m = mn;
      float ps = 0.f;
      bf16x8 pf[4];
#pragma unroll
      for (int kb = 0; kb < 2; ++kb)
#pragma unroll
        for (int s2 = 0; s2 < 2; ++s2) {
          float e[8];
#pragma unroll
          for (int j = 0; j < 8; ++j) { e[j] = __builtin_amdgcn_exp2f(sc[kb][8 * s2 + j] - mn); ps += e[j]; }
          unsigned w0 = pack_bf16(e[0], e[1]), w1 = pack_bf16(e[2], e[3]), w2 = pack_bf16(e[4], e[5]), w3 = pack_bf16(e[6], e[7]);
          u32x4 w = {w0, w1, w2, w3};
          pf[kb * 2 + s2] = *(bf16x8*)&w;
        }
      l = l * alpha + ps;
#pragma unroll
      for (int c = 0; c < 4; ++c)
#pragma unroll
        for (int r = 0; r < 16; ++r) o[c][r] *= alpha;
#pragma unroll
      for (int c = 0; c < 4; ++c)
#pragma unroll
        for (int kk = 0; kk < 4; ++kk) {
          const unsigned rbase = 32 * (kk >> 1) + 16 * (kk & 1) + 4 * hh;
          bf16x8 a = tr_frag(Vs, lane, c, rbase, rbase + 8);
          o[c] = __builtin_amdgcn_mfma_f32_32x32x16_bf16(a, pf[kk], o[c], 0, 0, 0);
        }
    }
  };
#if CVT_IN_ATTN
  f32x4 cv[16];
  bool cv_inflight = false;
  u8* cv_dst = nullptr;
  bool cv_emitted = false;
  int cv_par = 0;
  auto cv_issue = [&]() {
    if (ci < 64) {
      const CvtUnit c = cvt8_decode(p, blockIdx.x + 256 * ci);
      const float* src = c.src + (long)(wid * 16) * c.ldn + lane * 4;
#pragma unroll
      for (int j = 0; j < 16; ++j) { const float* ptr = src + (long)j * c.ldn; asm volatile("global_load_dwordx4 %0, %1, off nt" : "=a"(cv[j]) : "v"(ptr) : "memory"); }
      cv_dst = c.dst; cv_inflight = true; ++ci;
    } else cv_inflight = false;
  };
  auto cv_emit = [&]() {
    cv_emitted = cv_inflight;
    if (cv_inflight) {
      asm volatile("s_waitcnt vmcnt(0)" : "+a"(cv[0]), "+a"(cv[1]), "+a"(cv[2]), "+a"(cv[3]), "+a"(cv[4]), "+a"(cv[5]), "+a"(cv[6]), "+a"(cv[7]),
                   "+a"(cv[8]), "+a"(cv[9]), "+a"(cv[10]), "+a"(cv[11]), "+a"(cv[12]), "+a"(cv[13]), "+a"(cv[14]), "+a"(cv[15]) :: "memory");
      char* T = AT_CVT_T(cv_par);
#pragma unroll
      for (int cc = 0; cc < 4; ++cc) {
        u32x4 x4;
#pragma unroll
        for (int q = 0; q < 4; ++q) {
          int x = 0;
          x = __builtin_amdgcn_cvt_pk_fp8_f32(cv[4 * q][cc] * WSCALE_, cv[4 * q + 1][cc] * WSCALE_, x, false);
          x = __builtin_amdgcn_cvt_pk_fp8_f32(cv[4 * q + 2][cc] * WSCALE_, cv[4 * q + 3][cc] * WSCALE_, x, true);
          x4[q] = (unsigned)x;
        }
        *(u32x4*)(T + (lane * 4 + cc) * 64 + wid * 16) = x4;
      }
    }
  };
  u8* cv_dst_e = nullptr;
  auto cv_flush = [&]() {
    if (cv_emitted) {
      const char* T = AT_CVT_T(cv_par);
#pragma unroll
      for (int i = 0; i < 4; ++i) {
        const int n = (tid >> 2) + 64 * i, ch = tid & 3;
        __builtin_nontemporal_store(*(const u32x4*)(T + n * 64 + ch * 16), (u32x4*)(cv_dst_e + (long)(n >> 1) * 4096 + (n & 1) * 64 + ch * 16));
      }
      cv_par ^= 1;
    }
  };
#define CV_BEFORE_BAR() do { cv_emit(); cv_dst_e = cv_dst; cv_issue(); } while (0)
#define CV_AFTER_BAR()  do { cv_flush(); } while (0)
  cv_issue();
#else
#define CV_BEFORE_BAR() do {} while (0)
#define CV_AFTER_BAR()  do {} while (0)
#endif
  for (int kt = 0; kt < nt; kt += 2) {
    tile_body(kt, 0);
    CV_BEFORE_BAR();
    store_tile(1, kregB, vregB);
    if (kt + 3 < nt) load_tile(kt + 3, kregB, vregB);
    __syncthreads();
    CV_AFTER_BAR();
    tile_body(kt + 1, 1);
    CV_BEFORE_BAR();
    if (kt + 2 < nt) {
      store_tile(0, kregA, vregA);
      if (kt + 4 < nt) load_tile(kt + 4, kregA, vregA);
    }
    __syncthreads();
    CV_AFTER_BAR();
  }
#if CVT_IN_ATTN
  cv_emit(); cv_dst_e = cv_dst; cv_inflight = false;
  __syncthreads();
  cv_flush();
#endif
#undef CV_BEFORE_BAR
#undef CV_AFTER_BAR
  l = l + shflx(l, 32);
  const float inv = 1.0f / l;
  u16* op = p.omla() + tq * 1024 + h * 128 + 4 * hh;
#pragma unroll
  for (int c = 0; c < 4; ++c)
#pragma unroll
    for (int rg = 0; rg < 4; ++rg) {
      u32x2 w = {pack_bf16(o[c][4 * rg] * inv, o[c][4 * rg + 1] * inv), pack_bf16(o[c][4 * rg + 2] * inv, o[c][4 * rg + 3] * inv)};
      *(u32x2*)(op + 32 * c + 8 * rg) = w;
    }
}

#define G1_LDS_BYTES 49152
__device__ __forceinline__ void gla_g1_unit(const Params& p, char* smem, int u) {
  const int tid = opaque_tid(), lane = tid & 63, wid = tid >> 6, l31 = lane & 31, hh = lane >> 5;
  const int bh = u >> 6, n = u & 63, b = bh >> 2, h = bh & 3;
  const long t0 = (long)b * SEQ_ + n * 64;
  char* Ks = smem; char* Vs = smem + 16384;
  __syncthreads();
  {
    const int ch = tid & 15;
    const float* bl = p.bcum() + (t0 + 63) * 512 + h * 128 + ch * 8;
    f32x4 bl0 = *(const f32x4*)bl, bl1 = *(const f32x4*)(bl + 4);
    if (tid < 128) p.dec()[(long)u * 128 + tid] = __expf(p.bcum()[(t0 + 63) * 512 + h * 128 + tid]);
#pragma unroll
    for (int i = 0; i < 4; ++i) {
      const int tok = (i * 256 + tid) >> 4;
      u32x4 kw = *(const u32x4*)(p.proj() + (t0 + tok) * NC_ + C_GK + h * 128 + ch * 8);
      const float* bp = p.bcum() + (t0 + tok) * 512 + h * 128 + ch * 8;
      f32x4 b0 = *(const f32x4*)bp, b1 = *(const f32x4*)(bp + 4);
      u32x4 w;
      w[0] = pack_bf16(bf_lo(kw[0]) * __expf(bl0[0] - b0[0]), bf_hi(kw[0]) * __expf(bl0[1] - b0[1]));
      w[1] = pack_bf16(bf_lo(kw[1]) * __expf(bl0[2] - b0[2]), bf_hi(kw[1]) * __expf(bl0[3] - b0[3]));
      w[2] = pack_bf16(bf_lo(kw[2]) * __expf(bl1[0] - b1[0]), bf_hi(kw[2]) * __expf(bl1[1] - b1[1]));
      w[3] = pack_bf16(bf_lo(kw[3]) * __expf(bl1[2] - b1[2]), bf_hi(kw[3]) * __expf(bl1[3] - b1[3]));
      *(u32x4*)(Ks + off_b(tok, ch)) = w;
    }
#pragma unroll
    for (int i = 0; i < 8; ++i) {
      const int pp = i * 256 + tid; const int tok = pp >> 5, c32 = pp & 31;
      u32x4 vw = *(const u32x4*)(p.proj() + (t0 + tok) * NC_ + C_GV + h * 256 + c32 * 8);
      *(u32x4*)(Vs + (c32 >> 4) * 16384 + off_b(tok, c32 & 15)) = vw;
    }
  }
  __syncthreads();
  f32x16 acc[4][2];
#pragma unroll
  for (int mb = 0; mb < 4; ++mb)
#pragma unroll
    for (int nb = 0; nb < 2; ++nb)
#pragma unroll
      for (int r = 0; r < 16; ++r) acc[mb][nb][r] = 0.f;
  const char* Vimg = Vs + (wid >> 1) * 16384;
#pragma unroll
  for (int ks = 0; ks < 4; ++ks) {
    bf16x8 af[4], bfr[2];
    const unsigned r0 = 16 * ks + 8 * hh;
#pragma unroll
    for (int mb = 0; mb < 4; ++mb) af[mb] = tr_frag(Ks, lane, mb, r0, r0 + 4);
#pragma unroll
    for (int nb = 0; nb < 2; ++nb) bfr[nb] = tr_frag(Vimg, lane, 2 * (wid & 1) + nb, r0, r0 + 4);
#pragma unroll
    for (int mb = 0; mb < 4; ++mb)
#pragma unroll
      for (int nb = 0; nb < 2; ++nb) acc[mb][nb] = __builtin_amdgcn_mfma_f32_32x32x16_bf16(af[mb], bfr[nb], acc[mb][nb], 0, 0, 0);
  }
  __syncthreads();
  {
    char* st = smem + wid * 16384;
#pragma unroll
    for (int mb = 0; mb < 4; ++mb)
#pragma unroll
      for (int r = 0; r < 16; ++r) {
        const int dk = mb * 32 + (r & 3) + 8 * (r >> 2) + 4 * hh;
        *(u16*)(st + dk * 128 + l31 * 2) = f32_to_bf16(acc[mb][0][r]);
        *(u16*)(st + dk * 128 + (32 + l31) * 2) = f32_to_bf16(acc[mb][1][r]);
      }
    u16* gb = p.kvc() + (long)u * 32768 + wid * 64;
#pragma unroll 4
    for (int it = 0; it < 16; ++it) {
      const int dk = it * 8 + (lane >> 3), ch = lane & 7;
      *(u32x4*)(gb + dk * 256 + ch * 8) = *(const u32x4*)(st + dk * 128 + ch * 16);
    }
  }
}

__device__ __forceinline__ void gla_g2_unit(const Params& p, int u) {
  const int tid = opaque_tid();
  const int bh = u >> 5, part = u & 31;
  const int dk = part * 4 + (tid >> 6), dv = (tid & 63) * 4;
  float s0 = 0.f, s1 = 0.f, s2 = 0.f, s3 = 0.f;
  const long ebase = (long)dk * 256 + dv;
#pragma unroll 8
  for (int n = 0; n < 64; ++n) {
    const long un = (long)(bh * 64 + n);
    u32x2 kw = *(const u32x2*)(p.kvc() + un * 32768 + ebase);
    const float d = p.dec()[un * 128 + dk];
    u32x2 w = {pack_bf16(s0, s1), pack_bf16(s2, s3)};
    *(u32x2*)(p.sprev() + un * 32768 + ebase) = w;
    s0 = fmaf(d, s0, bf_lo(kw[0])); s1 = fmaf(d, s1, bf_hi(kw[0]));
    s2 = fmaf(d, s2, bf_lo(kw[1])); s3 = fmaf(d, s3, bf_hi(kw[1]));
  }
}

#define G3_LDS_BYTES (16384 + 16384 + 32768 + 65536 + 1024)
__device__ __forceinline__ void gla_g3_unit(const Params& p, char* smem, int u) {
  const int tid = opaque_tid(), lane = tid & 63, wid = tid >> 6, l31 = lane & 31, hh = lane >> 5;
  const int bh = u >> 6, n = u & 63, b = bh >> 2, h = bh & 3;
  const long t0 = (long)b * SEQ_ + n * 64;
  char* Qd = smem; char* Ki = smem + 16384; char* Vs = smem + 32768; char* Sp = smem + 65536; float* red = (float*)(smem + 131072);
  __syncthreads();
  {
    const int ch = tid & 15;
    const float qs = 0.08838834764831845f;
#pragma unroll
    for (int i = 0; i < 4; ++i) {
      const int tok = (i * 256 + tid) >> 4;
      const u16* pr = p.proj() + (t0 + tok) * NC_ + h * 128 + ch * 8;
      u32x4 qw = *(const u32x4*)(pr + C_GQ), kw = *(const u32x4*)(pr + C_GK);
      const float* bp = p.bcum() + (t0 + tok) * 512 + h * 128 + ch * 8;
      f32x4 b0 = *(const f32x4*)bp, b1 = *(const f32x4*)(bp + 4);
      float e[8] = {__expf(b0[0]), __expf(b0[1]), __expf(b0[2]), __expf(b0[3]), __expf(b1[0]), __expf(b1[1]), __expf(b1[2]), __expf(b1[3])};
      u32x4 wq, wk;
#pragma unroll
      for (int k = 0; k < 4; ++k) {
        wq[k] = pack_bf16(bf_lo(qw[k]) * qs * e[2 * k], bf_hi(qw[k]) * qs * e[2 * k + 1]);
        wk[k] = pack_bf16(bf_lo(kw[k]) * __builtin_amdgcn_rcpf(e[2 * k]), bf_hi(kw[k]) * __builtin_amdgcn_rcpf(e[2 * k + 1]));
      }
      *(u32x4*)(Qd + off_b(tok, ch)) = wq;
      *(u32x4*)(Ki + off_b(tok, ch)) = wk;
    }
#pragma unroll
    for (int i = 0; i < 8; ++i) {
      const int pp = i * 256 + tid; const int tok = pp >> 5, c32 = pp & 31;
      u32x4 vw = *(const u32x4*)(p.proj() + (t0 + tok) * NC_ + C_GV + h * 256 + c32 * 8);
      *(u32x4*)(Vs + (c32 >> 4) * 16384 + off_b(tok, c32 & 15)) = vw;
    }
#pragma unroll
    for (int i = 0; i < 16; ++i) {
      const int pp = i * 256 + tid; const int dk = pp >> 5, c32 = pp & 31;
      u32x4 sw = *(const u32x4*)(p.sprev() + (long)u * 32768 + dk * 256 + c32 * 8);
      *(u32x4*)(Sp + (c32 >> 4) * 32768 + off_b(dk, c32 & 15)) = sw;
    }
  }
  __syncthreads();
  const int ib = wid & 1, dvh = wid >> 1;
  f32x16 sc[2];
#pragma unroll
  for (int jb = 0; jb < 2; ++jb) {
#pragma unroll
    for (int r = 0; r < 16; ++r) sc[jb][r] = 0.f;
    if (jb <= ib) {
#pragma unroll
      for (int ks = 0; ks < 8; ++ks) {
        bf16x8 a = *(const bf16x8*)(Ki + off_b(jb * 32 + l31, 2 * ks + hh));
        bf16x8 bq = *(const bf16x8*)(Qd + off_b(ib * 32 + l31, 2 * ks + hh));
        sc[jb] = __builtin_amdgcn_mfma_f32_32x32x16_bf16(a, bq, sc[jb], 0, 0, 0);
      }
#pragma unroll
      for (int r = 0; r < 16; ++r) {
        const int j = jb * 32 + (r & 3) + 8 * (r >> 2) + 4 * hh, i = ib * 32 + l31;
        if (j > i) sc[jb][r] = 0.f;
      }
    }
  }
  bf16x8 pf[4];
#pragma unroll
  for (int jb = 0; jb < 2; ++jb)
#pragma unroll
    for (int s2 = 0; s2 < 2; ++s2) {
      u32x4 w = {pack_bf16(sc[jb][8 * s2 + 0], sc[jb][8 * s2 + 1]), pack_bf16(sc[jb][8 * s2 + 2], sc[jb][8 * s2 + 3]),
                 pack_bf16(sc[jb][8 * s2 + 4], sc[jb][8 * s2 + 5]), pack_bf16(sc[jb][8 * s2 + 6], sc[jb][8 * s2 + 7])};
      pf[jb * 2 + s2] = *(bf16x8*)&w;
    }
  f32x16 o[4];
#pragma unroll
  for (int c = 0; c < 4; ++c)
#pragma unroll
    for (int r = 0; r < 16; ++r) o[c][r] = 0.f;
  const char* Vimg = Vs + dvh * 16384;
  const char* Simg = Sp + dvh * 32768;
#pragma unroll
  for (int c = 0; c < 4; ++c) {
#pragma unroll
    for (int kk = 0; kk < 4; ++kk) {
      if ((kk >> 1) <= ib) {
        const unsigned rbase = 32 * (kk >> 1) + 16 * (kk & 1) + 4 * hh;
        bf16x8 a = tr_frag(Vimg, lane, c, rbase, rbase + 8);
        o[c] = __builtin_amdgcn_mfma_f32_32x32x16_bf16(a, pf[kk], o[c], 0, 0, 0);
      }
    }
#pragma unroll
    for (int ks = 0; ks < 8; ++ks) {
      const unsigned r0 = 16 * ks + 8 * hh;
      bf16x8 a = tr_frag(Simg, lane, c, r0, r0 + 4);
      bf16x8 bq = *(const bf16x8*)(Qd + off_b(ib * 32 + l31, 2 * ks + hh));
      o[c] = __builtin_amdgcn_mfma_f32_32x32x16_bf16(a, bq, o[c], 0, 0, 0);
    }
  }
  float ss = 0.f;
#pragma unroll
  for (int c = 0; c < 4; ++c)
#pragma unroll
    for (int r = 0; r < 16; ++r) ss += o[c][r] * o[c][r];
  ss += shflx(ss, 32);
  if (hh == 0) red[dvh * 64 + ib * 32 + l31] = ss;
  __syncthreads();
  const float tot = red[ib * 32 + l31] + red[64 + ib * 32 + l31];
  const float rn = rsqrtf(tot * (1.0f / 256.0f) + EPS_);
  const long t = t0 + ib * 32 + l31;
  const u16* grp = p.proj() + t * NC_ + C_GR + h * 256 + dvh * 128 + 4 * hh;
  u16* op = p.mix() + t * 2048 + h * 256 + dvh * 128 + 4 * hh;
  const float* gp = p.gla_out_norm + dvh * 128 + 4 * hh;
#pragma unroll
  for (int c = 0; c < 4; ++c)
#pragma unroll
    for (int rg = 0; rg < 4; ++rg) {
      u32x2 gw = *(const u32x2*)(grp + 32 * c + 8 * rg);
      f32x4 g = *(const f32x4*)(gp + 32 * c + 8 * rg);
      float gr[4] = {bf_lo(gw[0]), bf_hi(gw[0]), bf_lo(gw[1]), bf_hi(gw[1])};
      float ov[4];
#pragma unroll
      for (int k = 0; k < 4; ++k) { float si = gr[k] * __builtin_amdgcn_rcpf(1.0f + __expf(-gr[k])); ov[k] = o[c][4 * rg + k] * rn * g[k] * si; }
#if WOUTQ
      {
        int q8 = 0;
        q8 = __builtin_amdgcn_cvt_pk_fp8_f32(ov[0], ov[1], q8, false);
        q8 = __builtin_amdgcn_cvt_pk_fp8_f32(ov[2], ov[3], q8, true);
        const int col = h * 256 + dvh * 128 + 4 * hh + 32 * c + 8 * rg;
        *(unsigned*)(p.mixq() + (t >> 1) * 4096 + (col >> 6) * 128 + (t & 1) * 64 + (col & 63)) = (unsigned)q8;
      }
#else
      u32x2 w = {pack_bf16(ov[0], ov[1]), pack_bf16(ov[2], ov[3])};
      *(u32x2*)(op + 32 * c + 8 * rg) = w;
#endif
    }
}

__device__ __forceinline__ void mla_norm_tokens(const Params& p) {
  const int tid_ = opaque_tid(); const int lane = tid_ & 63, wid = tid_ >> 6;
  for (int t = blockIdx.x * 4 + wid; t < T_; t += gridDim.x * 4) {
    const u16* src = p.omla() + (long)t * 1024;
    u32x4 a = *(const u32x4*)(src + lane * 8), b = *(const u32x4*)(src + 512 + lane * 8);
    float ss = 0.f;
#pragma unroll
    for (int k = 0; k < 4; ++k) { float x0 = bf_lo(a[k]), x1 = bf_hi(a[k]), y0 = bf_lo(b[k]), y1 = bf_hi(b[k]); ss += x0 * x0 + x1 * x1 + y0 * y0 + y1 * y1; }
    ss = wave_sum(ss);
    const float r = rsqrtf(ss * (1.0f / 1024.0f) + EPS_);
    const float* g = p.mla_out_norm;
    u32x4 wa, wb;
#pragma unroll
    for (int k = 0; k < 4; ++k) {
      wa[k] = pack_bf16(bf_lo(a[k]) * r * g[lane * 8 + 2 * k], bf_hi(a[k]) * r * g[lane * 8 + 2 * k + 1]);
      wb[k] = pack_bf16(bf_lo(b[k]) * r * g[512 + lane * 8 + 2 * k], bf_hi(b[k]) * r * g[512 + lane * 8 + 2 * k + 1]);
    }
#if WOUTQ
    {
      int qa0 = 0, qa1 = 0, qb0 = 0, qb1 = 0;
      qa0 = __builtin_amdgcn_cvt_pk_fp8_f32(bf_lo(wa[0]), bf_hi(wa[0]), qa0, false); qa0 = __builtin_amdgcn_cvt_pk_fp8_f32(bf_lo(wa[1]), bf_hi(wa[1]), qa0, true);
      qa1 = __builtin_amdgcn_cvt_pk_fp8_f32(bf_lo(wa[2]), bf_hi(wa[2]), qa1, false); qa1 = __builtin_amdgcn_cvt_pk_fp8_f32(bf_lo(wa[3]), bf_hi(wa[3]), qa1, true);
      qb0 = __builtin_amdgcn_cvt_pk_fp8_f32(bf_lo(wb[0]), bf_hi(wb[0]), qb0, false); qb0 = __builtin_amdgcn_cvt_pk_fp8_f32(bf_lo(wb[1]), bf_hi(wb[1]), qb0, true);
      qb1 = __builtin_amdgcn_cvt_pk_fp8_f32(bf_lo(wb[2]), bf_hi(wb[2]), qb1, false); qb1 = __builtin_amdgcn_cvt_pk_fp8_f32(bf_lo(wb[3]), bf_hi(wb[3]), qb1, true);
      const int ca = 1024 + lane * 8, cb = 1536 + lane * 8;
      const long tt = t;
      u32x2 va = {(unsigned)qa0, (unsigned)qa1}, vb = {(unsigned)qb0, (unsigned)qb1};
      *(u32x2*)(p.mixq() + (tt >> 1) * 4096 + (ca >> 6) * 128 + (tt & 1) * 64 + (ca & 63)) = va;
      *(u32x2*)(p.mixq() + (tt >> 1) * 4096 + (cb >> 6) * 128 + (tt & 1) * 64 + (cb & 63)) = vb;
    }
#else
    *(u32x4*)(p.mix() + (long)t * 2048 + 1024 + lane * 8) = wa;
    *(u32x4*)(p.mix() + (long)t * 2048 + 1024 + 512 + lane * 8) = wb;
#endif
  }
}
__device__ __forceinline__ void wout_tile(const Params& p, char* smem, int mt, int nt) {
  f32x16 acc[4][4];
  GemmTile t{};
  t.A = p.mix(); t.lda = 2048; t.aidx = nullptr; t.m0 = mt * 256; t.mvalid = 256;
  t.B0 = p.w_out + nt * 256; t.B1 = t.B0 + 128; t.ldb = 2048; t.nv0 = 128; t.nv1 = 128; t.kscale = nullptr; t.K = 2048;
  gemm_tile_256<4, false, false>(t, smem, acc);
  const long boff = (long)(mt * 256) * 2048 + nt * 256;
  acc_foreach_row<4>(acc, [&](int rowl, int coll, float (&v)[4]) {
    long o = boff + (long)rowl * 2048 + coll;
    OPAQUE(o);
    const float* xr = p.x + o; float* yr = p.x1() + o;
#pragma unroll
    for (int nb = 0; nb < 4; ++nb) { const int c = (nb >> 1) * 128 + (nb & 1) * 32; yr[c] = xr[c] + v[nb]; }
  });
}

#define P7_LDS_BYTES (4 * 32 * 33 * 4 + 4 * 64 * 4 + 32 * 33 * 4 + 128)
template <int DRY = 0>
__device__ __forceinline__ void ffn_prep_unit(const Params& p, char* smem, int u) {
  float* part = (float*)smem; float* ssq = part + 4 * 32 * 33; float* lg = ssq + 256; float* rs = lg + 32 * 33;
  const int tid = opaque_tid(), lane = tid & 63, wid = tid >> 6, l31 = lane & 31, hh = lane >> 5;
  __syncthreads();
  {
    const long t = (long)u * 32 + l31;
    const float* xr = p.x1() + t * 2048 + wid * 512;
    const float* gp = p.ffn_norm + wid * 512;
    const float* wp = p.router_w + (long)(wid * 512 + hh) * 32 + l31;
    f32x16 acc;
#pragma unroll
    for (int r = 0; r < 16; ++r) acc[r] = 0.f;
    float ss = 0.f;
#pragma unroll 4
    for (int m = 0; m < 128; ++m) {
      const f32x4 xv = *(const f32x4*)(xr + 4 * m);
      const f32x4 gv = *(const f32x4*)(gp + 4 * m);
      const float a0 = hh ? xv[1] : xv[0], a1 = hh ? xv[3] : xv[2];
      const float g0 = hh ? gv[1] : gv[0], g1 = hh ? gv[3] : gv[2];
      const float b0 = wp[(4 * m) * 32], b1 = wp[(4 * m + 2) * 32];
      ss += a0 * a0 + a1 * a1;
      acc = __builtin_amdgcn_mfma_f32_32x32x2f32(a0 * g0, b0, acc, 0, 0, 0);
      acc = __builtin_amdgcn_mfma_f32_32x32x2f32(a1 * g1, b1, acc, 0, 0, 0);
    }
#pragma unroll
    for (int r = 0; r < 16; ++r) part[(wid * 32 + (r & 3) + 8 * (r >> 2) + 4 * hh) * 33 + l31] = acc[r];
    ssq[wid * 64 + lane] = ss;
  }
  __syncthreads();
  {
    const int tl = tid >> 3, seg = tid & 7;
    if (seg == 0) {
      float s = 0.f;
#pragma unroll
      for (int w = 0; w < 4; ++w) s += ssq[w * 64 + tl] + ssq[w * 64 + 32 + tl];
      rs[tl] = rsqrtf(s * (1.0f / 2048.0f) + EPS_);
    }
  }
  __syncthreads();
  {
    const int tl = tid >> 3, seg = tid & 7;
    const float r = rs[tl];
#pragma unroll
    for (int c = 0; c < 4; ++c) {
      const int e = seg * 4 + c;
      const float s = part[(0 * 32 + tl) * 33 + e] + part[(1 * 32 + tl) * 33 + e] + part[(2 * 32 + tl) * 33 + e] + part[(3 * 32 + tl) * 33 + e];
      lg[tl * 33 + e] = s * r + p.router_b[e];
    }
  }
  __syncthreads();
  if (tid < 32 && !DRY) {
    const long tt = (long)u * 32 + tid;
    const float* L = lg + tid * 33;
    unsigned used = 0u; int i0 = 0, i1 = 0, i2 = 0, i3 = 0; float v0 = 0.f, v1 = 0.f, v2 = 0.f, v3 = 0.f;
#pragma unroll
    for (int k = 0; k < 4; ++k) {
      int bi = -1; float bv = 0.f;
      for (int i = 0; i < 32; ++i) {
        const float x = L[i];
        const bool take = !((used >> i) & 1u) && (bi < 0 || x > bv);
        bi = take ? i : bi; bv = take ? x : bv;
      }
      used |= 1u << bi;
      if (k == 0) { i0 = bi; v0 = bv; } else if (k == 1) { i1 = bi; v1 = bv; } else if (k == 2) { i2 = bi; v2 = bv; } else { i3 = bi; v3 = bv; }
    }
    const float e0 = 1.0f, e1 = __expf(v1 - v0), e2 = __expf(v2 - v0), e3 = __expf(v3 - v0);
    const float inv = 1.0f / (e0 + e1 + e2 + e3);
    const int s0 = atomicAdd(&p.counts()[i0], 1), s1 = atomicAdd(&p.counts()[i1], 1), s2 = atomicAdd(&p.counts()[i2], 1), s3 = atomicAdd(&p.counts()[i3], 1);
    p.list()[i0 * T_ + s0] = (int)tt; p.list()[i1 * T_ + s1] = (int)tt; p.list()[i2 * T_ + s2] = (int)tt; p.list()[i3 * T_ + s3] = (int)tt;
    p.asg_e()[tt * 4 + 0] = i0; p.asg_e()[tt * 4 + 1] = i1; p.asg_e()[tt * 4 + 2] = i2; p.asg_e()[tt * 4 + 3] = i3;
    p.asg_slot()[tt * 4 + 0] = s0; p.asg_slot()[tt * 4 + 1] = s1; p.asg_slot()[tt * 4 + 2] = s2; p.asg_slot()[tt * 4 + 3] = s3;
    p.asg_g()[tt * 4 + 0] = e0 * inv; p.asg_g()[tt * 4 + 1] = e1 * inv; p.asg_g()[tt * 4 + 2] = e2 * inv; p.asg_g()[tt * 4 + 3] = e3 * inv;
  }
  {
    const int tl = tid >> 3, seg = tid & 7;
    const long t = (long)u * 32 + tl;
    const float* xr = p.x1() + t * 2048;
    const float rr = rs[tl];
#pragma unroll 8
    for (int it = 0; it < 32; ++it) {
      const int kk = it * 64 + seg * 8;
      f32x4 v0 = *(const f32x4*)(xr + kk), v1 = *(const f32x4*)(xr + kk + 4);
      f32x4 g0 = *(const f32x4*)(p.ffn_norm + kk), g1 = *(const f32x4*)(p.ffn_norm + kk + 4);
      v0 = v0 * g0 * rr; v1 = v1 * g1 * rr;
#if MOEQ == 0
      u32x4 w = {pack_bf16(v0[0], v0[1]), pack_bf16(v0[2], v0[3]), pack_bf16(v1[0], v1[1]), pack_bf16(v1[2], v1[3])};
      *(u32x4*)(p.h2() + t * 2048 + kk) = w;
#else
      int q0 = 0, q1 = 0;
      q0 = __builtin_amdgcn_cvt_pk_fp8_f32(v0[0], v0[1], q0, false);
      q0 = __builtin_amdgcn_cvt_pk_fp8_f32(v0[2], v0[3], q0, true);
      q1 = __builtin_amdgcn_cvt_pk_fp8_f32(v1[0], v1[1], q1, false);
      q1 = __builtin_amdgcn_cvt_pk_fp8_f32(v1[2], v1[3], q1, true);
      u32x2 wq = {(unsigned)q0, (unsigned)q1};
      *(u32x2*)(p.h2q() + t * 2048 + kk) = wq;
#endif
    }
  }
}

__device__ __forceinline__ void moe_setup(const Params& p, int* mo) {
  __syncthreads();
  if (threadIdx.x == 0) {
    int s = 0;
    for (int e = 0; e < NE_; ++e) { mo[e] = s; s += (p.counts()[e] + 255) >> 8; }
    mo[NE_] = s;
  }
  __syncthreads();
}
#ifndef MAPV
#define MAPV 0
#endif
__device__ __forceinline__ int xcd_unit(int round) { return MAPV ? (round * 256 + blockIdx.x) : (round * 256 + (blockIdx.x & 7) * 32 + (blockIdx.x >> 3)); }

__device__ __forceinline__ void moe1_tile(const Params& p, char* smem, const int* mo, int e, int nt, int mt) {
  f32x16 acc[4][4];
  GemmTile t{};
  const int cnt = p.counts()[e];
  t.A = p.h2(); t.lda = 2048; t.aidx = p.list() + e * T_ + mt * 256; t.m0 = 0; t.mvalid = min(256, cnt - mt * 256);
  t.B0 = p.w_gu + (long)e * 2048 * 4096 + nt * 128; t.B1 = t.B0 + 2048; t.ldb = 4096; t.nv0 = 128; t.nv1 = 128; t.kscale = nullptr; t.K = 2048;
  gemm_tile_256<4, false, true>(t, smem, acc);
  u16* base = p.act() + (long)(mo[e] * 256 + mt * 256) * 2048 + nt * 128;
  const float* bg = p.b_gu + e * 4096 + nt * 128; const float* bu = bg + 2048;
  const int tq_ = opaque_tid(); const int cl = (tq_ >> 6 & 1) * 64 + (tq_ & 31);
  const float bgv[2] = {bg[cl], bg[cl + 32]}, buv[2] = {bu[cl], bu[cl + 32]};
  acc_foreach_row<4>(acc, [&](int rowl, int coll, float (&v)[4]) {
    u16* rp = base + (long)rowl * 2048 + coll;
    OPAQUE(rp);
#pragma unroll
    for (int nb = 0; nb < 2; ++nb) {
      const int c = nb * 32;
      float g = fminf(v[nb] + bgv[nb], 7.0f);
      float uu = fminf(fmaxf(v[nb + 2] + buv[nb], -7.0f), 7.0f);
      float a = (uu + 1.0f) * (g * __builtin_amdgcn_rcpf(1.0f + __expf(-1.702f * g)));
      rp[c] = f32_to_bf16(a);
    }
  });
}
__device__ __forceinline__ void moe2_tile(const Params& p, char* smem, const int* mo, int e, int nt, int mt) {
  f32x16 acc[4][4];
  GemmTile t{};
  t.A = p.act(); t.lda = 2048; t.aidx = nullptr; t.m0 = mo[e] * 256 + mt * 256; t.mvalid = 256;
  t.B0 = p.w_dn + (long)e * 2048 * 2048 + nt * 256; t.B1 = t.B0 + 128; t.ldb = 2048; t.nv0 = 128; t.nv1 = 128; t.kscale = nullptr; t.K = 2048;
  gemm_tile_256<4, false, false>(t, smem, acc);
  u16* base = p.ybuf() + (long)t.m0 * 2048 + nt * 256;
  const float* bd = p.b_dn + e * 2048 + nt * 256;
  const int tq_ = opaque_tid(); const int cl = (tq_ >> 6 & 1) * 64 + (tq_ & 31);
  const float bdv[4] = {bd[cl], bd[cl + 32], bd[cl + 128], bd[cl + 160]};
  acc_foreach_row<4>(acc, [&](int rowl, int coll, float (&v)[4]) {
    u16* rp = base + (long)rowl * 2048 + coll;
    OPAQUE(rp);
#pragma unroll
    for (int nb = 0; nb < 4; ++nb) { const int c = (nb >> 1) * 128 + (nb & 1) * 32; rp[c] = f32_to_bf16(v[nb] + bdv[nb]); }
  });
}
template <int WHICH, int HALF = 0>
__device__ __forceinline__ void ph_moe(const Params& p, char* smem) {
  int* mo = (int*)(smem + G_LDS_BYTES);
  moe_setup(p, mo);
  const int NT = (WHICH == 1) ? 16 : 8;
  const int total = mo[NE_] * NT;
  if (HALF && ((blockIdx.x >> 3) & 1)) return;
  const int W = HALF ? 128 : 256;
  for (int round = 0;; ++round) {
    const int u = HALF ? (round * 128 + (blockIdx.x & 7) * 16 + (blockIdx.x >> 4)) : xcd_unit(round);
    if (round * W >= total) break;
    if (u >= total) continue;
    int e = 0;
    while (mo[e + 1] * NT <= u) ++e;
    const int local = u - mo[e] * NT, me = mo[e + 1] - mo[e];
    const int nt = local / me, mt = local - nt * me;
    if (WHICH == 1) moe1_tile(p, smem, mo, e, nt, mt); else moe2_tile(p, smem, mo, e, nt, mt);
  }
}

__device__ __forceinline__ void ph_final(const Params& p, char* smem, float dbg_scale = 1.0f) {
  int* mo = (int*)(smem + G_LDS_BYTES);
  moe_setup(p, mo);
  const int tid_ = opaque_tid(); const int lane = tid_ & 63, wid = tid_ >> 6;
  for (int t = blockIdx.x * 4 + wid; t < T_; t += gridDim.x * 4) {
    long rows[4]; float gg[4];
#pragma unroll
    for (int k = 0; k < 4; ++k) { rows[k] = (long)(mo[p.asg_e()[t * 4 + k]] * 256 + p.asg_slot()[t * 4 + k]) * 2048; gg[k] = p.asg_g()[t * 4 + k]; }
    f32x4 v[8]; float ss = 0.f;
#pragma unroll
    for (int j = 0; j < 8; ++j) {
      const int c = j * 256 + lane * 4;
      f32x4 a = __builtin_nontemporal_load((const f32x4*)(p.x1() + (long)t * 2048 + c));
#pragma unroll
      for (int k = 0; k < 4; ++k) {
        u32x2 w = __builtin_nontemporal_load((const u32x2*)(p.ybuf() + rows[k] + c));
        a[0] += gg[k] * bf_lo(w[0]); a[1] += gg[k] * bf_hi(w[0]); a[2] += gg[k] * bf_lo(w[1]); a[3] += gg[k] * bf_hi(w[1]);
      }
      v[j] = a; ss += a[0] * a[0] + a[1] * a[1] + a[2] * a[2] + a[3] * a[3];
    }
    ss = wave_sum(ss);
    const float r = rsqrtf(ss * (1.0f / 2048.0f) + EPS_);
#pragma unroll
    for (int j = 0; j < 8; ++j) {
      const int c = j * 256 + lane * 4;
      f32x4 g = *(const f32x4*)(p.final_norm + c);
      f32x4 o = {v[j][0] * r * g[0] * dbg_scale, v[j][1] * r * g[1] * dbg_scale, v[j][2] * r * g[2] * dbg_scale, v[j][3] * r * g[3] * dbg_scale};
      __builtin_nontemporal_store(o, (f32x4*)(p.out + (long)t * 2048 + c));
    }
  }
}

__device__ __forceinline__ CvtUnit cvt8_decode(const Params& p, int u) {
  CvtUnit c;
  if (u < 16384) {
    const int e = u >> 9, kb = (u >> 4) & 31, nt = u & 15;
    c.src = p.w_gu + (long)e * 2048 * 4096 + (long)(kb * 64) * 4096 + nt * 256; c.ldn = 4096;
    c.dst = p.wq_gu() + ((long)e * 4096 + nt * 256) * 2048 + kb * 128;
  } else {
    const int v = u - 16384; const int e = v >> 8, kb = (v >> 3) & 31, nt = v & 7;
    c.src = p.w_dn + (long)e * 2048 * 2048 + (long)(kb * 64) * 2048 + nt * 256; c.ldn = 2048;
    c.dst = p.wq_dn() + ((long)e * 2048 + nt * 256) * 2048 + kb * 128;
  }
  return c;
}
__device__ __forceinline__ void cvt8_load(const CvtUnit& c, int w, int lane, f32x4 (&v)[16]) {
  const float* src = c.src + (long)(w * 16) * c.ldn + lane * 4;
#pragma unroll
  for (int j = 0; j < 16; ++j) {
    const float* ptr = src + (long)j * c.ldn;
    asm volatile("global_load_dwordx4 %0, %1, off nt" : "=v"(v[j]) : "v"(ptr) : "memory");
  }
}
#define CVT_WAIT(N, v) asm volatile("s_waitcnt vmcnt(%16)" : "+v"(v[0]), "+v"(v[1]), "+v"(v[2]), "+v"(v[3]), "+v"(v[4]), "+v"(v[5]), "+v"(v[6]), "+v"(v[7]), \
    "+v"(v[8]), "+v"(v[9]), "+v"(v[10]), "+v"(v[11]), "+v"(v[12]), "+v"(v[13]), "+v"(v[14]), "+v"(v[15]) : "n"(N) : "memory")
__device__ __forceinline__ void cvt8_emit(const CvtUnit& c, int tid, int w, int lane, f32x4 (&v)[16], char* T) {
  __syncthreads();
#pragma unroll
  for (int cc = 0; cc < 4; ++cc) {
    u32x4 x4;
#pragma unroll
    for (int q = 0; q < 4; ++q) {
      int x = 0;
      x = __builtin_amdgcn_cvt_pk_fp8_f32(v[4 * q][cc] * WSCALE_, v[4 * q + 1][cc] * WSCALE_, x, false);
      x = __builtin_amdgcn_cvt_pk_fp8_f32(v[4 * q + 2][cc] * WSCALE_, v[4 * q + 3][cc] * WSCALE_, x, true);
      x4[q] = (unsigned)x;
    }
    *(u32x4*)(T + (lane * 4 + cc) * 64 + w * 16) = x4;
  }
  __syncthreads();
#pragma unroll
  for (int i = 0; i < 4; ++i) {
    const int n = (tid >> 2) + 64 * i, ch = tid & 3;
    __builtin_nontemporal_store(*(const u32x4*)(T + n * 64 + ch * 16), (u32x4*)(c.dst + (long)(n >> 1) * 4096 + (n & 1) * 64 + ch * 16));
  }
}
__device__ __forceinline__ void convert_units(const Params& p, char* smem, int first, int stride, int count) {
  const int tid = opaque_tid();
  const int w = tid >> 6, lane = tid & 63;
  if (count <= 0) return;
  f32x4 va[16], vb[16], vc[16];
  CvtUnit ca = cvt8_decode(p, first), cb = cvt8_decode(p, first + stride), cc = cvt8_decode(p, first + 2 * stride);
  cvt8_load(ca, w, lane, va);
  cvt8_load(cb, w, lane, vb);
  cvt8_load(cc, w, lane, vc);
  CVT_WAIT(32, va); cvt8_emit(ca, tid, w, lane, va, smem); ca = cvt8_decode(p, first + 3 * stride); cvt8_load(ca, w, lane, va);
  CVT_WAIT(36, vb); cvt8_emit(cb, tid, w, lane, vb, smem); cb = cvt8_decode(p, first + 4 * stride); cvt8_load(cb, w, lane, vb);
  CVT_WAIT(40, vc); cvt8_emit(cc, tid, w, lane, vc, smem); cc = cvt8_decode(p, first + 5 * stride); cvt8_load(cc, w, lane, vc);
  for (int i = 3; i + 3 < count; i += 3) {
    CVT_WAIT(40, va); cvt8_emit(ca, tid, w, lane, va, smem); ca = cvt8_decode(p, first + (i + 3) * stride); cvt8_load(ca, w, lane, va);
    CVT_WAIT(40, vb); cvt8_emit(cb, tid, w, lane, vb, smem); cb = cvt8_decode(p, first + (i + 4) * stride); cvt8_load(cb, w, lane, vb);
    CVT_WAIT(40, vc); cvt8_emit(cc, tid, w, lane, vc, smem); cc = cvt8_decode(p, first + (i + 5) * stride); cvt8_load(cc, w, lane, vc);
  }
  CVT_WAIT(0, va); cvt8_emit(ca, tid, w, lane, va, smem);
  CVT_WAIT(0, vb); cvt8_emit(cb, tid, w, lane, vb, smem);
  CVT_WAIT(0, vc); cvt8_emit(cc, tid, w, lane, vc, smem);
}
__device__ __forceinline__ void convert_one(const Params& p, char* smem, int u) {
  const int tid = opaque_tid();
  const int w = tid >> 6, lane = tid & 63;
  f32x4 va[16];
  CvtUnit ca = cvt8_decode(p, u);
  cvt8_load(ca, w, lane, va);
  CVT_WAIT(0, va); cvt8_emit(ca, tid, w, lane, va, smem);
}
__device__ __forceinline__ void ph_convert(const Params& p, char* smem) {
  convert_units(p, smem, blockIdx.x, gridDim.x, 24576 / 256);
}
__device__ __forceinline__ void ph_convert_gu(const Params& p, char* smem, int part, int nparts) {
  (void)part; (void)nparts;
  convert_units(p, smem, blockIdx.x, 256, 63);
  convert_one(p, smem, blockIdx.x + 63 * 256);
}
__device__ __forceinline__ void ph_convert_dn(const Params& p, char* smem) {
  convert_units(p, smem, 16384 + blockIdx.x, 256, 30);
  convert_one(p, smem, 16384 + blockIdx.x + 30 * 256);
  convert_one(p, smem, 16384 + blockIdx.x + 31 * 256);
}

#define R_STAGE 32768
struct GemmRTile {
  const u8* A; int lda; const int* aidx; int m0, mvalid;
  const u8* B; long brow0, brow1; int ldb;
  int pairb;
  int paira;
  int KB;
};
template <bool FP8, bool GATHER>
__device__ __forceinline__ void gemmr_tile_256(const GemmRTile& t, char* smem, f32x16 (&acc)[4][4]) {
  int tz0 = threadIdx.x; asm volatile("" : "+v"(tz0));
  const int tid = tz0, lane = tid & 63, wid = tid >> 6, wr = wid >> 1, wc = wid & 1;
  const int l31 = lane & 31, hh = lane >> 5;
#pragma unroll
  for (int i = 0; i < 4; ++i)
#pragma unroll
    for (int j = 0; j < 4; ++j)
#pragma unroll
      for (int r = 0; r < 16; ++r) acc[i][j][r] = 0.f;
  const int c_src = (tid & 3) ^ ((tid >> 4) & 3);
  const u8* a_src[GATHER ? 4 : 1];
  if (GATHER) {
#pragma unroll
    for (int i = 0; i < (GATHER ? 4 : 1); ++i) {
      int r = (tid >> 2) + 64 * i;
      int rr = r < t.mvalid ? r : 0;
      a_src[i] = t.A + (long)t.aidx[rr] * t.lda + c_src * 16;
    }
  } else {
    a_src[0] = t.A + (long)(t.m0 + (tid >> 2)) * t.lda + c_src * 16;
  }
  const long a_step = 64L * t.lda, b_step = 64L * t.ldb;
  const u8* b_src0 = t.B + (t.brow0 + (tid >> 2)) * t.ldb + c_src * 16;
  const u8* b_src1 = t.B + (t.brow1 + (tid >> 2)) * t.ldb + c_src * 16;
  const unsigned lds0 = (unsigned)(size_t)smem + (unsigned)__builtin_amdgcn_readfirstlane(wid) * 1024u;
  auto issue = [&](int kt, int sl, int q) {
    if (q < 4) glds16_asm((const void*)((GATHER ? a_src[GATHER ? q : 0] : a_src[0] + q * a_step) + kt * 64), lds0 + sl * R_STAGE + q * 4096);
    else { const int i = q - 4; glds16_asm((const void*)((i < 2 ? b_src0 + i * b_step : b_src1 + (i - 2) * b_step) + kt * 64), lds0 + sl * R_STAGE + 16384 + i * 4096); }
  };
  unsigned a_rd[2], b_rd[2];
#pragma unroll
  for (int s2 = 0; s2 < 2; ++s2) {
    const int ra = wr * 128 + l31, rb = wc * 64 + l31;
    a_rd[s2] = ra * 64 + (((2 * s2 + hh) ^ ((ra >> 2) & 3)) * 16);
    b_rd[s2] = rb * 64 + (((2 * s2 + hh) ^ ((rb >> 2) & 3)) * 16);
  }
  auto load_frags = [&](const char* St, int s2, u32x4 (&af)[4], u32x4 (&bf)[4]) {
#pragma unroll
    for (int mb = 0; mb < 4; ++mb) af[mb] = *(const u32x4*)(St + a_rd[s2] + mb * 2048);
#pragma unroll
    for (int nb = 0; nb < 4; ++nb) bf[nb] = *(const u32x4*)(St + 16384 + b_rd[s2] + (nb >> 1) * 8192 + (nb & 1) * 2048);
  };
  auto mma = [&](u32x4 (&ac)[4], u32x4 (&bc)[4], int nb) {
    if (FP8) {
#pragma unroll
      for (int u = 0; u < 2; ++u) {
        const long bl = (long)(((unsigned long long)bc[nb][2 * u + 1] << 32) | bc[nb][2 * u]);
#pragma unroll
        for (int mb = 0; mb < 4; ++mb) {
          const long al = (long)(((unsigned long long)ac[mb][2 * u + 1] << 32) | ac[mb][2 * u]);
          acc[mb][nb] = __builtin_amdgcn_mfma_f32_32x32x16_fp8_fp8(al, bl, acc[mb][nb], 0, 0, 0);
        }
      }
    } else {
      const bf16x8 bb = *(const bf16x8*)&bc[nb];
#pragma unroll
      for (int mb = 0; mb < 4; ++mb) acc[mb][nb] = __builtin_amdgcn_mfma_f32_32x32x16_bf16(*(const bf16x8*)&ac[mb], bb, acc[mb][nb], 0, 0, 0);
    }
  };
  u32x4 a0[4], b0[4], a1[4], b1[4];
  auto half0 = [&](int kt, bool issueA) {
    const char* St = smem + (kt & 3) * R_STAGE;
    load_frags(St, 1, a1, b1);
    __builtin_amdgcn_sched_barrier(0);
#pragma unroll
    for (int nb = 0; nb < 4; ++nb) {
      mma(a0, b0, nb);
      __builtin_amdgcn_sched_barrier(0);
      if (issueA) issue(kt + 2, (kt + 2) & 3, 4 + nb);
      __builtin_amdgcn_sched_barrier(0);
    }
  };
  auto half1 = [&](int kt, bool has1, bool issueB) {
    const char* Sn = smem + ((kt + 1) & 3) * R_STAGE;
    if (has1) load_frags(Sn, 0, a0, b0);
    __builtin_amdgcn_sched_barrier(0);
#pragma unroll
    for (int nb = 0; nb < 4; ++nb) {
      mma(a1, b1, nb);
      __builtin_amdgcn_sched_barrier(0);
      if (issueB) issue(kt + 3, (kt + 3) & 3, nb);
      __builtin_amdgcn_sched_barrier(0);
    }
  };
  const int nk = t.KB >> 6;
  __syncthreads();
#pragma unroll
  for (int q = 0; q < 8; ++q) issue(0, 0, q);
#pragma unroll
  for (int q = 0; q < 8; ++q) issue(1, 1, q);
#pragma unroll
  for (int q = 0; q < 4; ++q) issue(2, 2, q);
  asm volatile("s_waitcnt vmcnt(12)" ::: "memory");
  __syncthreads();
  load_frags(smem, 0, a0, b0);
  for (int kt = 0; kt < nk - 3; ++kt) {
    half0(kt, true);
    asm volatile("s_waitcnt vmcnt(8)" ::: "memory");
    __syncthreads();
    half1(kt, true, true);
  }
  half0(nk - 3, true);
  asm volatile("s_waitcnt vmcnt(8)" ::: "memory");
  __syncthreads();
  half1(nk - 3, true, false);
  half0(nk - 2, false);
  asm volatile("s_waitcnt vmcnt(0)" ::: "memory");
  __syncthreads();
  half1(nk - 2, true, false);
  half0(nk - 1, false);
  half1(nk - 1, false, false);
}


typedef int i32x8 __attribute__((ext_vector_type(8)));
template <bool GATHER>
__device__ __forceinline__ void gemmrs_tile_256(const GemmRTile& t, char* smem, f32x16 (&acc)[4][4]) {
  int tz0 = threadIdx.x; asm volatile("" : "+v"(tz0));
  const int tid = tz0, lane = tid & 63, wid = tid >> 6, wr = wid >> 1, wc = wid & 1;
  const int l31 = lane & 31, hh = lane >> 5;
#pragma unroll
  for (int i = 0; i < 4; ++i)
#pragma unroll
    for (int j = 0; j < 4; ++j)
#pragma unroll
      for (int r = 0; r < 16; ++r) acc[i][j][r] = 0.f;
  const int c_src = (tid & 3) ^ ((tid >> 4) & 3);
  const u8* a_src[GATHER ? 4 : 1];
  if (GATHER) {
#pragma unroll
    for (int i = 0; i < (GATHER ? 4 : 1); ++i) {
      int r = (tid >> 2) + 64 * i;
      int rr = r < t.mvalid ? r : 0;
      a_src[i] = t.A + (long)t.aidx[rr] * t.lda + c_src * 16;
    }
  } else {
    a_src[0] = t.A + ((long)(t.m0 + (tid >> 2)) >> 1) * 4096 + ((tid >> 2) & 1) * 64 + c_src * 16;
  }
  const long a_step = GATHER ? 64L * t.lda : 32L * 4096, b_step = 32L * 4096;
  const int a_kstep = GATHER ? 64 : 128;
  const int brl = tid >> 2;
  const u8* b_src0 = t.B + ((t.brow0 + brl) >> 1) * 4096 + (brl & 1) * 64 + c_src * 16;
  const u8* b_src1 = t.B + ((t.brow1 + brl) >> 1) * 4096 + (brl & 1) * 64 + c_src * 16;
  const unsigned lds0 = (unsigned)(size_t)smem + (unsigned)__builtin_amdgcn_readfirstlane(wid) * 1024u;
  auto issue = [&](int kt, int sl, int q) {
    if (q < 4) { if (ANT) glds16_asm_nt((const void*)((GATHER ? a_src[GATHER ? q : 0] : a_src[0] + q * a_step) + kt * a_kstep), lds0 + sl * R_STAGE + q * 4096);
                 else glds16_asm((const void*)((GATHER ? a_src[GATHER ? q : 0] : a_src[0] + q * a_step) + kt * a_kstep), lds0 + sl * R_STAGE + q * 4096); }
    else { const int i = q - 4;
      if (BNT) glds16_asm_nt((const void*)((i < 2 ? b_src0 + i * b_step : b_src1 + (i - 2) * b_step) + kt * 128), lds0 + sl * R_STAGE + 16384 + i * 4096);
      else glds16_asm((const void*)((i < 2 ? b_src0 + i * b_step : b_src1 + (i - 2) * b_step) + kt * 128), lds0 + sl * R_STAGE + 16384 + i * 4096); }
  };
  unsigned a_rd[2], b_rd[2];
#pragma unroll
  for (int c = 0; c < 2; ++c) {
    const int ra = wr * 128 + l31, rb = wc * 64 + l31;
    a_rd[c] = ra * 64 + (((2 * hh + c) ^ ((ra >> 2) & 3)) * 16);
    b_rd[c] = rb * 64 + (((2 * hh + c) ^ ((rb >> 2) & 3)) * 16);
  }
  auto load_a = [&](const char* St, i32x8 (&af)[4]) {
#pragma unroll
    for (int mb = 0; mb < 4; ++mb) {
      const u32x4 lo = *(const u32x4*)(St + a_rd[0] + mb * 2048), hi = *(const u32x4*)(St + a_rd[1] + mb * 2048);
      af[mb] = (i32x8){(int)lo[0], (int)lo[1], (int)lo[2], (int)lo[3], (int)hi[0], (int)hi[1], (int)hi[2], (int)hi[3]};
    }
  };
  auto load_b = [&](const char* St, int nb, i32x8& bf) {
    const char* bp = St + 16384 + (nb >> 1) * 8192 + (nb & 1) * 2048;
    const u32x4 lo = *(const u32x4*)(bp + b_rd[0]), hi = *(const u32x4*)(bp + b_rd[1]);
    bf = (i32x8){(int)lo[0], (int)lo[1], (int)lo[2], (int)lo[3], (int)hi[0], (int)hi[1], (int)hi[2], (int)hi[3]};
  };
  auto mma4 = [&](i32x8 (&af)[4], i32x8& bf, int nb) {
#pragma unroll
    for (int mb = 0; mb < 4; ++mb)
      acc[mb][nb] = __builtin_amdgcn_mfma_scale_f32_32x32x64_f8f6f4(af[mb], bf, acc[mb][nb], 0, 0, 0, 0x7f7f7f7f, 0, 0x7f7f7f7f);
  };
  i32x8 aA[4], aB[4], bq[4];
  auto half0 = [&](int kt, i32x8 (&ac)[4], bool issueA) {
    const char* St = smem + (kt & 3) * R_STAGE;
    load_b(St, 2, bq[2]); load_b(St, 3, bq[3]);
    __builtin_amdgcn_sched_barrier(0);
#pragma unroll
    for (int nb = 0; nb < 2; ++nb) {
      mma4(ac, bq[nb], nb);
      __builtin_amdgcn_sched_barrier(0);
      if (issueA) { issue(kt + 2, (kt + 2) & 3, 4 + 2 * nb); issue(kt + 2, (kt + 2) & 3, 5 + 2 * nb); }
      __builtin_amdgcn_sched_barrier(0);
    }
  };
  auto half1 = [&](int kt, i32x8 (&ac)[4], i32x8 (&an)[4], bool has1, bool issueB) {
    const char* Sn = smem + ((kt + 1) & 3) * R_STAGE;
    if (has1) { load_a(Sn, an); load_b(Sn, 0, bq[0]); load_b(Sn, 1, bq[1]); }
    __builtin_amdgcn_sched_barrier(0);
#pragma unroll
    for (int nb = 2; nb < 4; ++nb) {
      mma4(ac, bq[nb], nb);
      __builtin_amdgcn_sched_barrier(0);
      if (issueB) { issue(kt + 3, (kt + 3) & 3, 2 * (nb - 2)); issue(kt + 3, (kt + 3) & 3, 2 * (nb - 2) + 1); }
      __builtin_amdgcn_sched_barrier(0);
    }
  };
  const int nk = t.KB >> 6;
  __syncthreads();
#pragma unroll
  for (int q = 0; q < 8; ++q) issue(0, 0, q);
#pragma unroll
  for (int q = 0; q < 8; ++q) issue(1, 1, q);
#pragma unroll
  for (int q = 0; q < 4; ++q) issue(2, 2, q);
  asm volatile("s_waitcnt vmcnt(12)" ::: "memory");
  __syncthreads();
  load_a(smem, aA); load_b(smem, 0, bq[0]); load_b(smem, 1, bq[1]);
  for (int kt = 0; kt < nk - 4; kt += 2) {
    half0(kt, aA, true);
    asm volatile("s_waitcnt vmcnt(8)" ::: "memory"); __syncthreads();
    half1(kt, aA, aB, true, true);
    half0(kt + 1, aB, true);
    asm volatile("s_waitcnt vmcnt(8)" ::: "memory"); __syncthreads();
    half1(kt + 1, aB, aA, true, true);
  }
  half0(nk - 4, aA, true);
  asm volatile("s_waitcnt vmcnt(8)" ::: "memory"); __syncthreads();
  half1(nk - 4, aA, aB, true, true);
  half0(nk - 3, aB, true);
  asm volatile("s_waitcnt vmcnt(8)" ::: "memory"); __syncthreads();
  half1(nk - 3, aB, aA, true, false);
  half0(nk - 2, aA, false);
  asm volatile("s_waitcnt vmcnt(0)" ::: "memory"); __syncthreads();
  half1(nk - 2, aA, aB, true, false);
  half0(nk - 1, aB, false);
  half1(nk - 1, aB, aA, false, false);
}

template <bool GATHER>
__device__ __forceinline__ void gemmrv_tile_256(const GemmRTile& t, char* smem, f32x16 (&acc)[4][4]) {
  int tz0 = threadIdx.x; asm volatile("" : "+v"(tz0));
  const int tid = tz0, lane = tid & 63, wid = tid >> 6, wr = wid >> 1, wc = wid & 1;
  const int l31 = lane & 31, hh = lane >> 5;
#pragma unroll
  for (int i = 0; i < 4; ++i)
#pragma unroll
    for (int j = 0; j < 4; ++j)
#pragma unroll
      for (int r = 0; r < 16; ++r) acc[i][j][r] = 0.f;
  const int c_src = (tid & 3) ^ ((tid >> 4) & 3);
  const u8* a_src[GATHER ? 4 : 1];
  if (GATHER) {
#pragma unroll
    for (int i = 0; i < (GATHER ? 4 : 1); ++i) {
      int r = (tid >> 2) + 64 * i;
      int rr = r < t.mvalid ? r : 0;
      a_src[i] = t.A + (long)t.aidx[rr] * t.lda + c_src * 16;
    }
  } else {
    a_src[0] = t.A + ((long)(t.m0 + (tid >> 2)) >> 1) * 4096 + ((tid >> 2) & 1) * 64 + c_src * 16;
  }
  const long a_step = GATHER ? 64L * t.lda : 32L * 4096, b_step = 32L * 4096;
  const int a_kstep = GATHER ? 64 : 128;
  const int brl = tid >> 2;
  const u8* b_src0 = t.B + ((t.brow0 + brl) >> 1) * 4096 + (brl & 1) * 64 + c_src * 16;
  const u8* b_src1 = t.B + ((t.brow1 + brl) >> 1) * 4096 + (brl & 1) * 64 + c_src * 16;
  u32x4 rs0[8], rs1[8];
  auto ldg = [&](int kt, int q, u32x4& dst) {
    const u8* ptr = (q < 4) ? ((GATHER ? a_src[GATHER ? q : 0] : a_src[0] + q * a_step) + kt * a_kstep)
                            : (((q - 4) < 2 ? b_src0 + (q - 4) * b_step : b_src1 + (q - 6) * b_step) + kt * 128);
    asm volatile("global_load_dwordx4 %0, %1, off" : "=v"(dst) : "v"(ptr) : "memory");
  };
  auto stw = [&](int sl, int q, const u32x4& src) {
    *(u32x4*)(smem + sl * R_STAGE + (q < 4 ? q * 4096 : 16384 + (q - 4) * 4096) + tid * 16) = src;
  };
#define RV_WAIT(N, r) asm volatile("s_waitcnt vmcnt(%8)" : "+v"(r[0]), "+v"(r[1]), "+v"(r[2]), "+v"(r[3]), "+v"(r[4]), "+v"(r[5]), "+v"(r[6]), "+v"(r[7]) : "n"(N) : "memory")
  unsigned a_rd[2], b_rd[2];
#pragma unroll
  for (int c = 0; c < 2; ++c) {
    const int ra = wr * 128 + l31, rb = wc * 64 + l31;
    a_rd[c] = ra * 64 + (((2 * hh + c) ^ ((ra >> 2) & 3)) * 16);
    b_rd[c] = rb * 64 + (((2 * hh + c) ^ ((rb >> 2) & 3)) * 16);
  }
  auto load_a = [&](const char* St, i32x8 (&af)[4]) {
#pragma unroll
    for (int mb = 0; mb < 4; ++mb) {
      const u32x4 lo = *(const u32x4*)(St + a_rd[0] + mb * 2048), hi = *(const u32x4*)(St + a_rd[1] + mb * 2048);
      af[mb] = (i32x8){(int)lo[0], (int)lo[1], (int)lo[2], (int)lo[3], (int)hi[0], (int)hi[1], (int)hi[2], (int)hi[3]};
    }
  };
  auto load_b = [&](const char* St, int nb, i32x8& bf) {
    const char* bp = St + 16384 + (nb >> 1) * 8192 + (nb & 1) * 2048;
    const u32x4 lo = *(const u32x4*)(bp + b_rd[0]), hi = *(const u32x4*)(bp + b_rd[1]);
    bf = (i32x8){(int)lo[0], (int)lo[1], (int)lo[2], (int)lo[3], (int)hi[0], (int)hi[1], (int)hi[2], (int)hi[3]};
  };
  auto mma4 = [&](i32x8 (&af)[4], i32x8& bf, int nb) {
#pragma unroll
    for (int mb = 0; mb < 4; ++mb)
      acc[mb][nb] = __builtin_amdgcn_mfma_scale_f32_32x32x64_f8f6f4(af[mb], bf, acc[mb][nb], 0, 0, 0, 0x7f7f7f7f, 0, 0x7f7f7f7f);
  };
  i32x8 aA[4], aB[4], bq[4];
  auto half0 = [&](int kt, i32x8 (&ac)[4]) {
    const char* St = smem + (kt & 1) * R_STAGE;
    load_b(St, 2, bq[2]); load_b(St, 3, bq[3]);
    __builtin_amdgcn_sched_barrier(0);
    mma4(ac, bq[0], 0);
    __builtin_amdgcn_sched_barrier(0);
    mma4(ac, bq[1], 1);
    __builtin_amdgcn_sched_barrier(0);
  };
  auto commit = [&](int kt, u32x4 (&rn)[8], auto wtag, bool has1, bool has3) {
    constexpr int W = decltype(wtag)::value;
    if (has1) {
      RV_WAIT(W, rn);
#pragma unroll
      for (int q = 0; q < 8; ++q) stw((kt + 1) & 1, q, rn[q]);
      if (has3) {
#pragma unroll
        for (int q = 0; q < 8; ++q) ldg(kt + 3, q, rn[q]);
      }
      __syncthreads();
    }
  };
  auto half1 = [&](int kt, i32x8 (&ac)[4], i32x8 (&an)[4], bool has1) {
    const char* Sn = smem + ((kt + 1) & 1) * R_STAGE;
    if (has1) { load_a(Sn, an); load_b(Sn, 0, bq[0]); load_b(Sn, 1, bq[1]); }
    __builtin_amdgcn_sched_barrier(0);
    mma4(ac, bq[2], 2);
    __builtin_amdgcn_sched_barrier(0);
    mma4(ac, bq[3], 3);
    __builtin_amdgcn_sched_barrier(0);
  };
#define IC(n) std::integral_constant<int, n>{}
  const int nk = t.KB >> 6;
  __syncthreads();
#pragma unroll
  for (int q = 0; q < 8; ++q) ldg(0, q, rs0[q]);
#pragma unroll
  for (int q = 0; q < 8; ++q) ldg(1, q, rs1[q]);
  RV_WAIT(8, rs0);
#pragma unroll
  for (int q = 0; q < 8; ++q) stw(0, q, rs0[q]);
#pragma unroll
  for (int q = 0; q < 8; ++q) ldg(2, q, rs0[q]);
  __syncthreads();
  load_a(smem, aA); load_b(smem, 0, bq[0]); load_b(smem, 1, bq[1]);
  for (int kt = 0; kt < nk - 4; kt += 2) {
    half0(kt, aA);      commit(kt, rs1, IC(8), true, true);      half1(kt, aA, aB, true);
    half0(kt + 1, aB);  commit(kt + 1, rs0, IC(8), true, true);  half1(kt + 1, aB, aA, true);
  }
  half0(nk - 4, aA);  commit(nk - 4, rs1, IC(8), true, true);   half1(nk - 4, aA, aB, true);
  half0(nk - 3, aB);  commit(nk - 3, rs0, IC(8), true, false);  half1(nk - 3, aB, aA, true);
  half0(nk - 2, aA);  commit(nk - 2, rs1, IC(0), true, false);  half1(nk - 2, aA, aB, true);
  half0(nk - 1, aB);                                            half1(nk - 1, aB, aA, false);
#undef IC
#undef RV_WAIT
}

__device__ __forceinline__ void cvt16_tile(const float* W, int col0, int ldn, int nvalid  , const float* kgain,
                                           u16* out  , int ldk, char* T) {
  const int tid = opaque_tid();
  const int kq = tid & 7, n4 = tid >> 3;
  f32x4 v[16];
  const bool ok = (n4 * 4) < nvalid;
  const float* src = W + (long)(kq * 16) * ldn + (ok ? n4 * 4 : -col0);
#pragma unroll
  for (int j = 0; j < 16; ++j) v[j] = __builtin_nontemporal_load((const f32x4*)(src + (long)j * ldn));
  if (kgain) {
#pragma unroll
    for (int j = 0; j < 16; ++j) v[j] *= kgain[kq * 16 + j];
  }
  if (!ok) {
#pragma unroll
    for (int j = 0; j < 16; ++j) v[j] = (f32x4){0.f, 0.f, 0.f, 0.f};
  }
  __syncthreads();
#pragma unroll
  for (int c = 0; c < 4; ++c) {
    u32x4 w0, w1;
#pragma unroll
    for (int q = 0; q < 4; ++q) { w0[q] = pack_bf16(v[2 * q][c], v[2 * q + 1][c]); w1[q] = pack_bf16(v[8 + 2 * q][c], v[8 + 2 * q + 1][c]); }
    *(u32x4*)(T + (n4 * 4 + c) * 256 + kq * 32) = w0;
    *(u32x4*)(T + (n4 * 4 + c) * 256 + kq * 32 + 16) = w1;
  }
  __syncthreads();
#pragma unroll
  for (int i = 0; i < 8; ++i) {
    const int n = (tid >> 4) + 16 * i, ch = tid & 15;
    *(u32x4*)((char*)(out + (long)n * ldk) + ch * 16) = *(const u32x4*)(T + n * 256 + ch * 16);
  }
}
__device__ __forceinline__ void convert_one(const Params& p, char* smem, int u);
__device__ __forceinline__ void ph_convert_dense(const Params& p, char* smem) {
#if WOUTQ
  convert_one(p, smem, 24576 + blockIdx.x);
#endif
  for (int u = blockIdx.x; u < 912; u += gridDim.x) {
    if (u < 544) { const int kt = u / 34, nt = u % 34; const int nv = NC_ - nt * 128;
      cvt16_tile(p.w_in + (long)(kt * 128) * NC_ + nt * 128, nt * 128, NC_, nv < 0 ? 0 : nv, nullptr, p.wb_in() + (long)(nt * 128) * 2048 + kt * 128, 2048, smem);
    } else if (u < 592) { const int v = u - 544; const int kt = v / 12, nt = v % 12;
      cvt16_tile(p.w_uq + (long)(kt * 128) * 1536 + nt * 128, nt * 128, 1536, 128, p.q_norm + kt * 128, p.wb_uq() + (long)(nt * 128) * 512 + kt * 128, 512, smem);
    } else if (u < 656) { const int v = u - 592; const int kt = v >> 4, nt = v & 15;
      cvt16_tile(p.w_ukv + (long)(kt * 128) * 2048 + nt * 128, nt * 128, 2048, 128, p.kv_norm + kt * 128, p.wb_ukv() + (long)(nt * 128) * 512 + kt * 128, 512, smem);
    } else if (!WOUTQ) { const int v = u - 656; const int kt = v >> 4, nt = v & 15;
      cvt16_tile(p.w_out + (long)(kt * 128) * 2048 + nt * 128, nt * 128, 2048, 128, nullptr, p.wb_out() + (long)(nt * 128) * 2048 + kt * 128, 2048, smem);
    }
  }
}


template <bool NTST = false, class F>
__device__ __forceinline__ void epi_store_bf16(f32x16 (&acc)[4][4], char* smem, u16* gbase  , int ld, int ncols0, int ncols1, F f) {
  int tz = threadIdx.x; asm volatile("" : "+v"(tz));
  const int lane = tz & 63, wid = tz >> 6, wr = wid >> 1, wc = wid & 1, l31 = lane & 31, hh = lane >> 5;
  __syncthreads();
  char* st = smem + wid * 32768;
#pragma unroll
  for (int mb = 0; mb < 4; ++mb)
#pragma unroll
    for (int reg = 0; reg < 16; ++reg) {
      const int r = mb * 32 + (reg & 3) + 8 * (reg >> 2) + 4 * hh;
      float v[4] = {acc[mb][0][reg], acc[mb][1][reg], acc[mb][2][reg], acc[mb][3][reg]};
      f(wr * 128 + r, wc * 64 + l31, v);
#pragma unroll
      for (int nb = 0; nb < 4; ++nb) *(u16*)(st + r * 256 + (nb * 32 + l31) * 2) = f32_to_bf16(v[nb]);
    }
  const int ch = lane & 15, span = ch >> 3;
  const int gcol = span * 128 + wc * 64 + (ch & 7) * 8;
  const bool ok = ((wc * 64 + (ch & 7) * 8) < (span ? ncols1 : ncols0));
#pragma unroll 8
  for (int it = 0; it < 32; ++it) {
    const int r = it * 4 + (lane >> 4);
    const u32x4 w = *(const u32x4*)(st + r * 256 + ch * 16);
    if (ok) { if (NTST) __builtin_nontemporal_store(w, (u32x4*)(gbase + (long)(wr * 128 + r) * ld + gcol)); else *(u32x4*)(gbase + (long)(wr * 128 + r) * ld + gcol) = w; }
  }
}
template <class F>
__device__ __forceinline__ void epi_store_act8(f32x16 (&acc)[4][4], char* smem, u8* gbase  , long row0, int cb0, F f) {
  int tz = threadIdx.x; asm volatile("" : "+v"(tz));
  const int lane = tz & 63, wid = tz >> 6, wr = wid >> 1, wc = wid & 1, l31 = lane & 31, hh = lane >> 5;
  __syncthreads();
  char* st = smem + wid * 32768;
#pragma unroll
  for (int mb = 0; mb < 4; ++mb)
#pragma unroll
    for (int reg = 0; reg < 16; ++reg) {
      const int r = mb * 32 + (reg & 3) + 8 * (reg >> 2) + 4 * hh;
      float v[4] = {acc[mb][0][reg], acc[mb][1][reg], acc[mb][2][reg], acc[mb][3][reg]};
      f(wr * 128 + r, wc * 64 + l31, v);
      const int q = __builtin_amdgcn_cvt_pk_fp8_f32(v[0], v[1], 0, false);
      *(u8*)(st + r * 64 + l31) = (u8)(q & 0xff);
      *(u8*)(st + r * 64 + 32 + l31) = (u8)((q >> 8) & 0xff);
    }
  const int ch = lane & 3;
#pragma unroll 8
  for (int it = 0; it < 8; ++it) {
    const int r = it * 16 + (lane >> 2);
    const u32x4 w = *(const u32x4*)(st + r * 64 + ch * 16);
    const long rg = row0 + wr * 128 + r;
    *(u32x4*)(gbase + (rg >> 1) * 4096 + (long)(cb0 + wc) * 128 + (rg & 1) * 64 + ch * 16) = w;
  }
}
__device__ __forceinline__ void epi_store_f32_resid(f32x16 (&acc)[4][4], char* smem, const float* resid, float* out, int ld, float osc) {
  int tz = threadIdx.x; asm volatile("" : "+v"(tz));
  const int lane = tz & 63, wid = tz >> 6, wr = wid >> 1, wc = wid & 1, l31 = lane & 31, hh = lane >> 5;
  __syncthreads();
  char* st = smem + wid * 32768;
#pragma unroll
  for (int half = 0; half < 2; ++half) {
#pragma unroll
    for (int m2 = 0; m2 < 2; ++m2)
#pragma unroll
      for (int reg = 0; reg < 16; ++reg) {
        const int mb = half * 2 + m2;
        const int r = m2 * 32 + (reg & 3) + 8 * (reg >> 2) + 4 * hh;
#pragma unroll
        for (int nb = 0; nb < 4; ++nb) *(float*)(st + r * 512 + (nb * 32 + l31) * 4) = acc[mb][nb][reg];
      }
    const int ch = lane & 31, span = ch >> 4;
    const int gcol = span * 128 + wc * 64 + (ch & 15) * 4;
#pragma unroll 8
    for (int it = 0; it < 32; ++it) {
      const int r = it * 2 + (lane >> 5);
      const f32x4 a = *(const f32x4*)(st + r * 512 + ch * 16);
      const long o = (long)(wr * 128 + half * 64 + r) * ld + gcol;
      const f32x4 x = __builtin_nontemporal_load((const f32x4*)(resid + o));
      *(f32x4*)(out + o) = a * osc + x;
    }
  }
}

template <int NBV>
__device__ __forceinline__ void win_tile_r(const Params& p, char* smem, int mt, int nt) {
  f32x16 acc[4][4];
  GemmRTile t{};
  t.A = (const u8*)p.h1(); t.lda = 4096; t.aidx = nullptr; t.m0 = mt * 256; t.mvalid = 256;
  t.B = (const u8*)p.wb_in(); t.brow0 = nt * 256; t.brow1 = nt * 256 + 128; t.ldb = 4096; t.KB = 4096;
  gemmr_tile_256<false, false>(t, smem, acc);
  const int rem = NC_ - nt * 256;
  const int nv0 = rem >= 128 ? 128 : rem, nv1 = rem >= 256 ? 128 : (rem > 128 ? rem - 128 : 0);
  epi_store_bf16(acc, smem, p.proj() + (long)(mt * 256) * NC_ + nt * 256, NC_, nv0, nv1, [&](int, int, float (&)[4]) {});
}
__device__ __forceinline__ void win_narrow_split(const Params& p, char* smem, int mt, int kc) {
  f32x16 acc[4][4];
  GemmRTile t{};
  t.A = (const u8*)p.h1() + kc * 512; t.lda = 4096; t.aidx = nullptr; t.m0 = mt * 256; t.mvalid = 256;
  t.B = (const u8*)p.wb_in() + kc * 512; t.brow0 = 4096; t.brow1 = 4224; t.ldb = 4096; t.KB = 512;
  gemmr_tile_256<false, false>(t, smem, acc);
  float* base = p.pn() + (long)kc * (8192 * 80) + (long)(mt * 256) * 80;
  acc_foreach_row<4>(acc, [&](int rowl, int coll, float (&v)[4]) {
    float* rp = base + (long)rowl * 80 + coll;
    OPAQUE(rp);
    if (coll < 80) rp[0] = v[0];
    if (coll + 32 < 80) rp[32] = v[1];
  });
}
__device__ __forceinline__ void ph_win_r(const Params& p, char* smem) {
  const int x = blockIdx.x & 7, slot = blockIdx.x >> 3;
#if WIN_SPLIT
  for (int j = slot; j < 64; j += 32) win_tile_r<4>(p, smem, 4 * x + (j & 3), j >> 2);
  win_narrow_split(p, smem, 4 * x + (slot & 3), slot >> 2);
#else
  for (int j = slot; j < 68; j += 32) win_tile_r<4>(p, smem, 4 * x + (j & 3), j >> 2);
#endif
}
__device__ __forceinline__ void upq_tile_r(const Params& p, char* smem, int mt, int nt) {
  f32x16 acc[4][4];
  GemmRTile t{};
  t.A = (const u8*)(p.proj() + C_MQ); t.lda = NC_ * 2; t.aidx = nullptr; t.m0 = mt * 256; t.mvalid = 256;
  t.B = (const u8*)p.wb_uq(); t.brow0 = nt * 256; t.brow1 = nt * 256 + 128; t.ldb = 1024; t.KB = 1024;
  gemmr_tile_256<false, false>(t, smem, acc);
  const float* rq = p.rq() + mt * 256;
  epi_store_bf16(acc, smem, p.q() + (long)(mt * 256) * 1536 + nt * 256, 1536, 128, 128, [&](int rowl, int, float (&v)[4]) {
    const float s = rq[rowl] * QSCALE_;
#pragma unroll
    for (int nb = 0; nb < 4; ++nb) v[nb] *= s;
  });
}
__device__ __forceinline__ void upkv_tile_r(const Params& p, char* smem, int mt, int nt) {
  f32x16 acc[4][4];
  GemmRTile t{};
  t.A = (const u8*)(p.proj() + C_MKV); t.lda = NC_ * 2; t.aidx = nullptr; t.m0 = mt * 256; t.mvalid = 256;
  t.B = (const u8*)p.wb_ukv(); t.brow0 = nt * 256; t.brow1 = nt * 256 + 128; t.ldb = 1024; t.KB = 1024;
  gemmr_tile_256<false, false>(t, smem, acc);
  const float* rk = p.rkv() + mt * 256;
  epi_store_bf16(acc, smem, p.kv() + (long)(mt * 256) * 2048 + nt * 256, 2048, 128, 128, [&](int rowl, int, float (&v)[4]) {
    const float s = rk[rowl];
#pragma unroll
    for (int nb = 0; nb < 4; ++nb) v[nb] *= s;
  });
}
__device__ __forceinline__ void wout_tile_r(const Params& p, char* smem, int mt, int nt) {
  f32x16 acc[4][4];
  GemmRTile t{};
#if WOUTQ
  t.A = p.mixq(); t.lda = 2048; t.aidx = nullptr; t.m0 = mt * 256; t.mvalid = 256;
  t.B = p.wq_out(); t.brow0 = nt * 256; t.brow1 = nt * 256 + 128; t.ldb = 2048; t.KB = 2048;
  gemmrs_tile_256<false>(t, smem, acc);
  const float osc = WISCALE_;
#else
  t.A = (const u8*)p.mix(); t.lda = 4096; t.aidx = nullptr; t.m0 = mt * 256; t.mvalid = 256;
  t.B = (const u8*)p.wb_out(); t.brow0 = nt * 256; t.brow1 = nt * 256 + 128; t.ldb = 4096; t.KB = 4096;
  gemmr_tile_256<false, false>(t, smem, acc);
  const float osc = 1.0f;
#endif
  const long boff = (long)(mt * 256) * 2048 + nt * 256;
  epi_store_f32_resid(acc, smem, p.x + boff, p.x1() + boff, 2048, osc);
}

__device__ __forceinline__ void moe1q_tile(const Params& p, char* smem, const int* mo, int e, int nt, int mt) {
  f32x16 acc[4][4];
  GemmRTile t{};
  const int cnt = p.counts()[e];
  t.A = p.h2q(); t.lda = 2048; t.aidx = p.list() + e * T_ + mt * 256; t.m0 = 0; t.mvalid = min(256, cnt - mt * 256);
  t.B = p.wq_gu(); t.brow0 = (long)e * 4096 + nt * 128; t.brow1 = t.brow0 + 2048; t.ldb = 2048; t.KB = 2048;
#if MOEQ == 3
  gemmrv_tile_256<true>(t, smem, acc);
#elif MOEQ == 2
  gemmrs_tile_256<true>(t, smem, acc);
#else
  gemmr_tile_256<true, true>(t, smem, acc);
#endif
  const float* bg = p.b_gu + e * 4096 + nt * 128; const float* bu = bg + 2048;
  const int tq_ = opaque_tid(); const int cl = (tq_ >> 6 & 1) * 64 + (tq_ & 31);
  const float bgv[2] = {bg[cl], bg[cl + 32]}, buv[2] = {bu[cl], bu[cl + 32]};
  epi_store_act8(acc, smem, p.actq(), (long)(mo[e] * 256 + mt * 256), nt * 2, [&](int, int, float (&v)[4]) {
#pragma unroll
    for (int nb = 0; nb < 2; ++nb) {
      float g = fminf(v[nb] * WISCALE_ + bgv[nb], 7.0f);
      float uu = fminf(fmaxf(v[nb + 2] * WISCALE_ + buv[nb], -7.0f), 7.0f);
      v[nb] = (uu + 1.0f) * (g * __builtin_amdgcn_rcpf(1.0f + __expf(-1.702f * g)));
    }
  });
}
__device__ __forceinline__ void moe2q_tile(const Params& p, char* smem, const int* mo, int e, int nt, int mt) {
  f32x16 acc[4][4];
  GemmRTile t{};
  t.A = p.actq(); t.lda = 2048; t.aidx = nullptr; t.m0 = mo[e] * 256 + mt * 256; t.mvalid = 256;
  t.B = p.wq_dn(); t.brow0 = (long)e * 2048 + nt * 256; t.brow1 = t.brow0 + 128; t.ldb = 2048; t.KB = 2048;
#if MOEQ == 3
  gemmrv_tile_256<false>(t, smem, acc);
#elif MOEQ == 2
  gemmrs_tile_256<false>(t, smem, acc);
#else
  gemmr_tile_256<true, false>(t, smem, acc);
#endif
  const float* bd = p.b_dn + e * 2048 + nt * 256;
  const int tq_ = opaque_tid(); const int cl = (tq_ >> 6 & 1) * 64 + (tq_ & 31);
  const float bdv[4] = {bd[cl], bd[cl + 32], bd[cl + 128], bd[cl + 160]};
  epi_store_bf16<YNT != 0>(acc, smem, p.ybuf() + (long)t.m0 * 2048 + nt * 256, 2048, 128, 128, [&](int, int, float (&v)[4]) {
#pragma unroll
    for (int nb = 0; nb < 4; ++nb) v[nb] = v[nb] * WISCALE_ + bdv[nb];
  });
}
template <int WHICH>
__device__ __forceinline__ void ph_moeq(const Params& p, char* smem) {
  int* mo = (int*)(smem + G_LDS_BYTES);
#if CVT_SPLIT
  const bool dn_first = ((blockIdx.x >> 3) & 1) != 0;
  if (WHICH == 1 && dn_first) ph_convert_dn(p, smem);
#endif
  moe_setup(p, mo);
  const int NT = (WHICH == 1) ? 16 : 8;
  const int total = mo[NE_] * NT;
#if SKEW
  { const int sl = (blockIdx.x >> 3) % 5; for (int i = 0; i < sl; ++i) __builtin_amdgcn_s_sleep(SKEW); }
#endif
  for (int round = 0;; ++round) {
    const int u = xcd_unit(round);
    if (round * 256 >= total) break;
    if (u >= total) continue;
    int e = 0;
    while (mo[e + 1] * NT <= u) ++e;
    const int local = u - mo[e] * NT, me = mo[e + 1] - mo[e];
    const int nt = UORD ? (local % NT) : (local / me), mt = UORD ? (local / NT) : (local - (local / me) * me);
    if (WHICH == 1) moe1q_tile(p, smem, mo, e, nt, mt); else moe2q_tile(p, smem, mo, e, nt, mt);
  }
#if CVT_SPLIT
  if (WHICH == 1 && !dn_first) ph_convert_dn(p, smem);
#endif
}
#define LDS_MAX 143360
#ifndef DUP
#define DUP 0
#endif
#ifndef MOEQ
#define MOEQ 1
#endif
#ifndef CVT_SPLIT
#define CVT_SPLIT 1
#endif
#ifndef CVT_STAGGER
#define CVT_STAGGER 1
#endif
#ifndef CVT_IN_P4
#define CVT_IN_P4 1
#endif
#ifndef TSTAMP
#define TSTAMP 0
#endif
#ifndef DENSER
#define DENSER 1
#endif
__global__ void __launch_bounds__(256, 1) mega(Params p) {
  extern __shared__ __attribute__((aligned(16))) char smem[];
  volatile LAS unsigned* xbw = (volatile LAS unsigned*)(smem + LDS_MAX - 16);
  if (threadIdx.x == 0) { xbw[0] = 0u; xbw[1] = 0u; xbw[2] = 0u; xbw[3] = 0u; }
  __syncthreads();
  (void)xcd_barrier_post(p.bar(), xbw);
#if TSTAMP
  unsigned long long ts0 = wall_clock64();
  int bar_no = 0;
#define XBAR() do { XcdBarrier bar_; bar_.bar = p.bar(); bar_.x = xb_xcc_id(); bar_.st = (volatile LAS unsigned*)(smem + LDS_MAX - 16); xcd_barrier(bar_); ++bar_no; if (bar_no == TSTAMP && blockIdx.x == 0 && threadIdx.x == 0) { ((float*)p.counts())[48] = (float)(wall_clock64() - ts0) * (1.0f / 100.0f); } } while (0)
#else
#define XBAR() do { XcdBarrier bar_; bar_.bar = p.bar(); bar_.x = xb_xcc_id(); bar_.st = (volatile LAS unsigned*)(smem + LDS_MAX - 16); xcd_barrier(bar_); } while (0)
#endif
#if DUP == 100
  for (int rep_ = 0; rep_ < 2; ++rep_) {
  if (rep_) XBAR();
#endif
  ph_prep0(p);
#if DUP == 33
  if (blockIdx.x < 192) gla_g1_unit(p, smem, blockIdx.x);
  else for (int i = 0; i < 5; ++i) gla_g1_unit(p, smem, 192 + (blockIdx.x - 192) * 5 + i);
#endif
#if DUP == 30
  ph_prep0(p);
#endif
#if DENSER
  ph_convert_dense(p, smem);
#endif
#if MOEQ >= 1 && CVT_IN_P4 == 0
  ph_convert(p, smem);
#if DUP == 20
  ph_convert(p, smem);
#endif
#endif
  XBAR();
#if DENSER
  ph_win_r(p, smem);
#else
  ph_win(p, smem);
#endif
#if DUP == 1
#if DENSER
  ph_win_r(p, smem);
#else
  ph_win(p, smem);
#endif
#endif
  XBAR();
  ph_prep1(p, smem);
#if DUP == 2
  ph_prep1(p, smem);
#endif
  XBAR();
#if DENSER
  upkv_tile_r(p, smem, blockIdx.x >> 3, blockIdx.x & 7);
  if (blockIdx.x < 192) upq_tile_r(p, smem, blockIdx.x / 6, blockIdx.x % 6);
#else
  upkv_tile(p, smem, blockIdx.x >> 3, blockIdx.x & 7);
  if (blockIdx.x < 192) upq_tile(p, smem, blockIdx.x / 6, blockIdx.x % 6);
#endif
  if (blockIdx.x < 192) gla_g1_unit(p, smem, blockIdx.x);
  else for (int i = 0; i < 4; ++i) gla_g1_unit(p, smem, 192 + (blockIdx.x - 192) * 4 + i);
  if (blockIdx.x < 64) gla_g1_unit(p, smem, 448 + blockIdx.x);
#if DUP == 3
  upkv_tile(p, smem, blockIdx.x >> 3, blockIdx.x & 7);
  if (blockIdx.x < 192) upq_tile(p, smem, blockIdx.x / 6, blockIdx.x % 6);
  if (blockIdx.x < 192) gla_g1_unit(p, smem, blockIdx.x);
  else for (int i = 0; i < 5; ++i) gla_g1_unit(p, smem, 192 + (blockIdx.x - 192) * 5 + i);
#endif
  XBAR();
  gla_g2_unit(p, blockIdx.x);
#if DUP == 31
  gla_g2_unit(p, blockIdx.x);
#endif
  {
    const int bh = blockIdx.x >> 4, qa = blockIdx.x & 15;
#if MOEQ >= 1 && CVT_IN_ATTN
    int ci = 0;
    attn_unit(p, smem, bh >> 3, bh & 7, 31 - qa, ci);
    attn_unit(p, smem, bh >> 3, bh & 7, qa, ci);
    for (; ci < 64; ++ci) convert_one(p, smem, blockIdx.x + 256 * ci);
#else
    int ci = 64;
#if MOEQ >= 1 && CVT_IN_P4
    const bool cvt_first = CVT_STAGGER ? (((blockIdx.x >> 3) & 1) != 0) : false;
    if (cvt_first) { if (CVT_SPLIT) ph_convert_gu(p, smem, 0, 1); else ph_convert(p, smem); }
#endif
    attn_unit(p, smem, bh >> 3, bh & 7, 31 - qa, ci);
    attn_unit(p, smem, bh >> 3, bh & 7, qa, ci);
#if MOEQ >= 1 && CVT_IN_P4
    if (!cvt_first) { if (CVT_SPLIT) ph_convert_gu(p, smem, 0, 1); else ph_convert(p, smem); }
#endif
#endif
#if DUP == 44
    if (cvt_first) ph_convert(p, smem);
    { int cz = 64; attn_unit(p, smem, bh >> 3, bh & 7, 31 - qa, cz); attn_unit(p, smem, bh >> 3, bh & 7, qa, cz); }
    if (!cvt_first) ph_convert(p, smem);
#endif
#if DUP == 4
    { int cz = 64; attn_unit(p, smem, bh >> 3, bh & 7, 31 - qa, cz); attn_unit(p, smem, bh >> 3, bh & 7, qa, cz); }
#endif
  }
  XBAR();
  for (int u = blockIdx.x; u < 512; u += gridDim.x) gla_g3_unit(p, smem, u);
  mla_norm_tokens(p);
#if DUP == 5
  for (int u = blockIdx.x; u < 512; u += gridDim.x) gla_g3_unit(p, smem, u);
  mla_norm_tokens(p);
#endif
  XBAR();
#if DENSER
  wout_tile_r(p, smem, (blockIdx.x & 7) * 4 + ((blockIdx.x >> 3) & 3), blockIdx.x >> 5);
#else
  wout_tile(p, smem, blockIdx.x >> 3, blockIdx.x & 7);
#endif
#if DUP == 6
  wout_tile(p, smem, blockIdx.x >> 3, blockIdx.x & 7);
#endif
  XBAR();
  ffn_prep_unit(p, smem, blockIdx.x);
#if DUP == 7
  ffn_prep_unit<1>(p, smem, blockIdx.x);
#endif
  XBAR();
#if MOEQ >= 1
  ph_moeq<1>(p, smem);
#if DUP == 8
  ph_moeq<1>(p, smem);
#endif
#else
  ph_moe<1>(p, smem);
#endif
  XBAR();
#if MOEQ >= 1
  ph_moeq<2>(p, smem);
#else
  ph_moe<2>(p, smem);
#endif
#if DUP == 9
  ph_moeq<2>(p, smem);
#endif
#if DUP == 89
  XBAR();
  ph_moeq<1>(p, smem);
  XBAR();
  ph_moeq<2>(p, smem);
#endif
#if DUP == 19
  ph_moe<2, 1>(p, smem);
#endif
  XBAR();
#if DUP == 100
  ph_final(p, smem);
  }
#endif
#if TSTAMP
  {
    const float us = ((const float*)p.counts())[48];
    const float scl = 1.0f + us * (1.0f / 4000.0f);
    ph_final(p, smem, scl);
  }
#else
  ph_final(p, smem);
#endif
#if DUP == 10
  ph_final(p, smem);
#endif
#if DUP == 11
  for (int i = 0; i < 10; ++i) XBAR();
#endif
}

extern "C" void kernel_launch(void* const* d_in, const int* in_sizes, int n_in,
                              void* d_out, int out_size, void* d_ws, size_t ws_size,
                              hipStream_t stream) {
  Params P{};
  P.x = (const float*)d_in[0]; P.pos = (const int*)d_in[1];
  P.attn_norm = (const float*)d_in[2]; P.w_in = (const float*)d_in[3]; P.gate_up = (const float*)d_in[4]; P.gate_bias = (const float*)d_in[5];
  P.gla_out_norm = (const float*)d_in[6]; P.q_norm = (const float*)d_in[7]; P.w_uq = (const float*)d_in[8]; P.kv_norm = (const float*)d_in[9];
  P.w_ukv = (const float*)d_in[10]; P.mla_out_norm = (const float*)d_in[11]; P.w_out = (const float*)d_in[12]; P.ffn_norm = (const float*)d_in[13];
  P.router_w = (const float*)d_in[14]; P.router_b = (const float*)d_in[15]; P.w_gu = (const float*)d_in[16]; P.b_gu = (const float*)d_in[17];
  P.w_dn = (const float*)d_in[18]; P.b_dn = (const float*)d_in[19]; P.final_norm = (const float*)d_in[20];
  P.out = (float*)d_out;

  P.ws = (char*)d_ws;

  hipFuncSetAttribute((const void*)mega, hipFuncAttributeMaxDynamicSharedMemorySize, LDS_MAX);
  hipMemsetAsync(d_ws, 0, XCD_BAR_WORDS * sizeof(unsigned), stream);
  mega<<<256, 256, LDS_MAX, stream>>>(P);
}
```

```cpp
#define DUP 0
#define MOEQ 2
#define TSTAMP 0
#define CVT_SPLIT 1
#define CVT_IN_P4 1
#define STAG4 0
#define STAGX 0
#define WIN_SPLIT 1
#define CVT_IN_ATTN 0
#define YNT 0
#define ANT 0
#define BNT 1
#define UORD 0
#define LOOK1 1
#define LOOK2 0
#define WOUTQ 0
#define SKEW 0
#define PFW 0
#define MF16 0
#define EPI2 1
#define PFD 8
#define CVT_STAGGER 1
#include <hip/hip_runtime.h>
#include <hip/hip_bf16.h>
#include <stdint.h>
#include <type_traits>
#define T_      8192
#define SEQ_    4096
#define D_      2048
#define NC_     4176
#define C_GQ    0
#define C_GK    512
#define C_GV    1024
#define C_GR    2048
#define C_GD    3072
#define C_MQ    3088
#define C_MKV   3600
#define C_MKR   4112
#define NE_     32
#define DFF_    2048
#define EPS_    1e-6f
typedef short bf16x8 __attribute__((ext_vector_type(8)));
typedef short s16x4 __attribute__((ext_vector_type(4)));
typedef float f32x16 __attribute__((ext_vector_type(16)));
typedef float f32x4 __attribute__((ext_vector_type(4)));
typedef float f32x2 __attribute__((ext_vector_type(2)));
typedef unsigned short u16;
typedef unsigned u32x4 __attribute__((ext_vector_type(4)));
typedef unsigned u32x2 __attribute__((ext_vector_type(2)));
#define LAS3 __attribute__((address_space(3)))
#define OPAQUE(x) asm volatile("" : "+v"(x))
#define NTHR 256
__device__ __forceinline__ int opaque_tid() { int t = threadIdx.x; asm volatile("" : "+v"(t)); return t; }

__device__ __forceinline__ unsigned pack_bf16(float a, float b) {
  typedef __bf16 bf2 __attribute__((ext_vector_type(2)));
  typedef float f2 __attribute__((ext_vector_type(2)));
  f2 v = {a, b};
  bf2 r = __builtin_convertvector(v, bf2);
  return *(unsigned*)&r;
}
__device__ __forceinline__ float bf_lo(unsigned w) { return __uint_as_float(w << 16); }
__device__ __forceinline__ float bf_hi(unsigned w) { return __uint_as_float(w & 0xffff0000u); }
__device__ __forceinline__ float bf16_to_f32(u16 v) { return __uint_as_float(((unsigned)v) << 16); }
__device__ __forceinline__ u16 f32_to_bf16(float f) { return (u16)(pack_bf16(f, 0.f) & 0xffffu); }
__device__ __forceinline__ float shflx(float v, int k) {
  int t = threadIdx.x; asm volatile("" : "+v"(t));
  return __int_as_float(__builtin_amdgcn_ds_bpermute((((t & 63) ^ k) << 2), __float_as_int(v)));
}
__device__ __forceinline__ float wave_sum(float v) {
#pragma unroll
  for (int o = 32; o > 0; o >>= 1) v += shflx(v, o);
  return v;
}
__device__ __forceinline__ unsigned off_b(unsigned row, unsigned ch) { return 256u * row + 16u * (ch ^ (((row & 3u) << 2) | ((row >> 2) & 3u))); }
__device__ __forceinline__ unsigned tr_addr(unsigned lane, unsigned c, unsigned row0  ) {
  const unsigned blk = (lane >> 4) & 1u, q = (lane & 15u) >> 2, p = lane & 3u;
  return off_b(row0 + q, 4u * c + 2u * blk + (p >> 1)) + 8u * (p & 1u);
}
__device__ __forceinline__ bf16x8 tr_frag(const char* img, unsigned lane, unsigned c, unsigned row_a, unsigned row_b) {
  s16x4 v0 = __builtin_amdgcn_ds_read_tr16_b64_v4i16((LAS3 s16x4*)(img + tr_addr(lane, c, row_a)));
  s16x4 v1 = __builtin_amdgcn_ds_read_tr16_b64_v4i16((LAS3 s16x4*)(img + tr_addr(lane, c, row_b)));
  return (bf16x8){v0[0], v0[1], v0[2], v0[3], v1[0], v1[1], v1[2], v1[3]};
}

__device__ __forceinline__ void glds16_asm(const void* gsrc, unsigned lds_dst) {
  unsigned keep;
  asm volatile("s_mov_b32 %0, m0\n\ts_mov_b32 m0, %2\n\ts_nop 0\n\tglobal_load_lds_dwordx4 %1, off\n\ts_mov_b32 m0, %0" : "=&s"(keep) : "v"(gsrc), "s"(lds_dst) : "memory");
}
__device__ __forceinline__ void glds16_asm_nt(const void* gsrc, unsigned lds_dst) {
  unsigned keep;
  asm volatile("s_mov_b32 %0, m0\n\ts_mov_b32 m0, %2\n\ts_nop 0\n\tglobal_load_lds_dwordx4 %1, off nt\n\ts_mov_b32 m0, %0" : "=&s"(keep) : "v"(gsrc), "s"(lds_dst) : "memory");
}
__device__ __forceinline__ void glds4_asm(const void* gsrc, unsigned lds_dst) {
  unsigned keep;
  asm volatile("s_mov_b32 %0, m0\n\ts_mov_b32 m0, %2\n\ts_nop 0\n\tglobal_load_lds_dword %1, off\n\ts_mov_b32 m0, %0" : "=&s"(keep) : "v"(gsrc), "s"(lds_dst) : "memory");
}
struct Params {
  const float *x; const int* pos;
  const float *attn_norm, *w_in, *gate_up, *gate_bias, *gla_out_norm, *q_norm, *w_uq, *kv_norm, *w_ukv, *mla_out_norm, *w_out,
              *ffn_norm, *router_w, *router_b, *w_gu, *b_gu, *w_dn, *b_dn, *final_norm;
  float* out;
  char* ws;
  __device__ __forceinline__ unsigned* bar() const { return (unsigned*)(ws + 0ull); }
  __device__ __forceinline__ int* counts() const { return (int*)(ws + 16384ull); }
  __device__ __forceinline__ u16* h1() const { return (u16*)(ws + 16640ull); }
  __device__ __forceinline__ u16* proj() const { return (u16*)(ws + 33571072ull); }
  __device__ __forceinline__ float2* cs() const { return (float2*)(ws + 101990656ull); }
  __device__ __forceinline__ float* rq() const { return (float*)(ws + 104087808ull); }
  __device__ __forceinline__ float* rkv() const { return (float*)(ws + 104120576ull); }
  __device__ __forceinline__ float* bcum() const { return (float*)(ws + 104153344ull); }
  __device__ __forceinline__ u16* q() const { return (u16*)(ws + 120930560ull); }
  __device__ __forceinline__ u16* kv() const { return (u16*)(ws + 146096384ull); }
  __device__ __forceinline__ u16* kpe() const { return (u16*)(ws + 179650816ull); }
  __device__ __forceinline__ u16* kvc() const { return (u16*)(ws + 180699392ull); }
  __device__ __forceinline__ float* dec() const { return (float*)(ws + 214253824ull); }
  __device__ __forceinline__ u16* sprev() const { return (u16*)(ws + 214515968ull); }
  __device__ __forceinline__ u16* mix() const { return (u16*)(ws + 248070400ull); }
  __device__ __forceinline__ u16* omla() const { return (u16*)(ws + 281624832ull); }
  __device__ __forceinline__ float* x1() const { return (float*)(ws + 298402048ull); }
  __device__ __forceinline__ u16* h2() const { return (u16*)(ws + 365510912ull); }
  __device__ __forceinline__ int* list() const { return (int*)(ws + 399065344ull); }
  __device__ __forceinline__ int* asg_e() const { return (int*)(ws + 400113920ull); }
  __device__ __forceinline__ int* asg_slot() const { return (int*)(ws + 400244992ull); }
  __device__ __forceinline__ float* asg_g() const { return (float*)(ws + 400376064ull); }
  __device__ __forceinline__ u16* act() const { return (u16*)(ws + 400507136ull); }
  __device__ __forceinline__ u16* ybuf() const { return (u16*)(ws + 568279296ull); }
  __device__ __forceinline__ unsigned char* wq_gu() const { return (unsigned char*)(ws + 736051456ull); }
  __device__ __forceinline__ unsigned char* wq_dn() const { return (unsigned char*)(ws + 1004486912ull); }
  __device__ __forceinline__ unsigned char* h2q() const { return (unsigned char*)(ws + 1138704640ull); }
  __device__ __forceinline__ unsigned char* actq() const { return (unsigned char*)(ws + 1155481856ull); }
  __device__ __forceinline__ u16* wb_in() const { return (u16*)(ws + 1239367936ull); }
  __device__ __forceinline__ u16* wb_uq() const { return (u16*)(ws + 1257193728ull); }
  __device__ __forceinline__ u16* wb_ukv() const { return (u16*)(ws + 1258766592ull); }
  __device__ __forceinline__ u16* wb_out() const { return (u16*)(ws + 1260863744ull); }
  __device__ __forceinline__ unsigned char* mixq() const { return (unsigned char*)(ws + 1269252352ull); }
  __device__ __forceinline__ unsigned char* wq_out() const { return (unsigned char*)(ws + 1286029568ull); }
  __device__ __forceinline__ float* pn() const { return (float*)(ws + 1290223872ull); }
  __device__ __forceinline__ u32x4* dummy() const { return (u32x4*)(ws + 1311195648ull); }
};
#define WS_BYTES_USED 1312244480ull

#define XB_TMO      128
#define XB_XCNT(j)  (256  + 64 * (j))
#define XB_XSUB(j)  (1280 + 64 * (j))
#define XB_XGEN(j)  (2304 + 64 * (j))
#define XB_TOP      3328
#define XB_TOPGEN   3392
#define XCD_BAR_WORDS 3456
#define XB_SPIN_CAP (1u << 18)
#define LAS __attribute__((address_space(3)))

__device__ __forceinline__ unsigned xb_ld(unsigned* p)              { return __hip_atomic_load(p, __ATOMIC_RELAXED, __HIP_MEMORY_SCOPE_AGENT); }
__device__ __forceinline__ unsigned xb_add(unsigned* p, unsigned v) { return __hip_atomic_fetch_add(p, v, __ATOMIC_RELAXED, __HIP_MEMORY_SCOPE_AGENT); }
__device__ __forceinline__ unsigned xb_xcc_id() { return (unsigned)__builtin_amdgcn_s_getreg((3 << 11) | 20) & 0xFu; }
#define XB_SPIN(cond, bar) do { unsigned _sp = 0; while (cond) { __builtin_amdgcn_s_sleep(1); \
    if ((++_sp & 255u) == 0u) { if (xb_ld(&(bar)[XB_TMO])) break; if (_sp > XB_SPIN_CAP) { atomicAdd(&(bar)[XB_TMO], 1u); break; } } } } while (0)

struct XcdBarrier {
    unsigned* bar; unsigned x;
    volatile LAS unsigned* st;
};

__device__ __forceinline__ XcdBarrier xcd_barrier_post(unsigned* bar, volatile LAS unsigned* st) {
    XcdBarrier b; b.bar = bar; b.x = xb_xcc_id(); b.st = st;
    if (threadIdx.x == 0) (void)xb_add(&bar[XB_XCNT(b.x)], 1u);
    return b;
}
__device__ __forceinline__ void xcd_barrier_complete(unsigned* bar, unsigned x, unsigned& nloc, unsigned& nx) {
    const unsigned G = gridDim.x * gridDim.y * gridDim.z;
    unsigned sum, cnt, mine, sp = 0u;
    for (;;) {
        sum = 0u; cnt = 0u; mine = 0u;
#pragma unroll
        for (unsigned j = 0; j < 16; ++j) { const unsigned c = xb_ld(&bar[XB_XCNT(j)]); sum += c; cnt += (c > 0u) ? 1u : 0u; mine = (j == x) ? c : mine; }
        if (sum == G) break;
        __builtin_amdgcn_s_sleep(1);
        if ((++sp & 255u) == 0u) { if (xb_ld(&bar[XB_TMO])) break; if (sp > XB_SPIN_CAP) { atomicAdd(&bar[XB_TMO], 1u); break; } }
    }
    nloc = mine > 0u ? mine : 1u; nx = cnt > 0u ? cnt : 1u;
}

__device__ __forceinline__ void xcd_barrier(const XcdBarrier& b) {
    asm volatile("s_waitcnt vmcnt(0)" ::: "memory");
    __syncthreads();
    if (threadIdx.x == 0) {
        unsigned* bar = b.bar;
        __builtin_amdgcn_s_waitcnt(0);
        unsigned nloc = b.st[0], nx = b.st[1];
        if (nloc == 0u) { xcd_barrier_complete(bar, b.x, nloc, nx); b.st[0] = nloc; b.st[1] = nx; }
        const unsigned old = xb_add(&bar[XB_XSUB(b.x)], 1u);
        const unsigned gen = old / nloc;
        if (old + 1u == (gen + 1u) * nloc) {
            __builtin_amdgcn_fence(__ATOMIC_RELEASE, "agent");
            asm volatile("s_waitcnt vmcnt(0)" ::: "memory");
            const unsigned og = xb_add(&bar[XB_TOP], 1u);
            const unsigned tg = og / nx;
            if (og + 1u == (tg + 1u) * nx) xb_add(&bar[XB_TOPGEN], 1u);
            else XB_SPIN(xb_ld(&bar[XB_TOPGEN]) == tg, bar);
            __builtin_amdgcn_fence(__ATOMIC_ACQUIRE, "agent");
            xb_add(&bar[XB_XGEN(b.x)], 1u);
            asm volatile("s_waitcnt vmcnt(0)" ::: "memory");
        } else {
            XB_SPIN(xb_ld(&bar[XB_XGEN(b.x)]) == gen, bar);
            __builtin_amdgcn_fence(__ATOMIC_ACQUIRE, "agent");
            asm volatile("s_waitcnt vmcnt(0)" ::: "memory");
        }
    }
    __syncthreads();
}

#define G_A_OFF(s)  ((s) * 65536)
#define G_B_OFF(s)  ((s) * 65536 + 32768)
#define G_LDS_BYTES 131072

struct GemmTile {
  const u16* A; int lda;
  const int* aidx;
  int m0, mvalid;
  const float* B0; const float* B1;
  int ldb; int nv0, nv1;
  const float* kscale;
  int K;
};

template <int NB, bool KSCALE, bool GATHER>
__device__ __forceinline__ void gemm_tile_256(const GemmTile& t, char* smem, f32x16 (&acc)[4][4]) {
  int tz0 = threadIdx.x; asm volatile("" : "+v"(tz0));
  const int tid = tz0, lane = tid & 63, wid = tid >> 6, wr = wid >> 1, wc = wid & 1;
  const int l31 = lane & 31, hh = lane >> 5;
#pragma unroll
  for (int i = 0; i < 4; ++i)
#pragma unroll
    for (int j = 0; j < 4; ++j)
#pragma unroll
      for (int r = 0; r < 16; ++r) acc[i][j][r] = 0.f;

  const int a_c = (tid & 7) ^ ((tid >> 4) & 7);
  const u16* a_src[GATHER ? 8 : 1];
  if (GATHER) {
#pragma unroll
    for (int i = 0; i < (GATHER ? 8 : 1); ++i) {
      int r = (tid >> 3) + 32 * i;
      int rr = r < t.mvalid ? r : 0;
      a_src[i] = t.A + (long)t.aidx[rr] * t.lda + a_c * 8;
    }
  } else {
    a_src[0] = t.A + (long)(t.m0 + (tid >> 3)) * t.lda + a_c * 8;
  }
  const long a_step = 32L * t.lda;
  const int b_n4 = tid & 63, b_k = tid >> 6;
  const int b_k_u = __builtin_amdgcn_readfirstlane(b_k);
  const int b_img = b_n4 >> 5, b_ch = (b_n4 >> 1) & 15, b_half = b_n4 & 1;
  const bool b_ok = ((b_n4 & 31) * 4) < (b_img ? t.nv1 : t.nv0);
  const int b_loff = (b_ok ? ((b_img ? (int)(t.B1 - t.B0) : 0) + (b_n4 & 31) * 4) : 0) + b_k * t.ldb;
  f32x4 breg[16];

  const unsigned a_lds0 = (unsigned)(size_t)smem + (unsigned)__builtin_amdgcn_readfirstlane(wid) * 1024u;
  auto issue_a = [&](int kt, int s, int i) {
    glds16_asm((const void*)((GATHER ? a_src[GATHER ? i : 0] : a_src[0] + i * a_step) + kt * 64), a_lds0 + G_A_OFF(s) + i * 4096);
  };
  auto issue_b = [&](int kt, int j) {
    const float* ptr = t.B0 + (long)(kt * 64 + 4 * j) * t.ldb + b_loff;
    asm volatile("global_load_dwordx4 %0, %1, off" : "=v"(breg[j]) : "v"(ptr) : "memory");
  };
  auto write_b = [&](int kt, int s, int j) {
    const int k = b_k + 4 * j;
    f32x4 v = breg[j];
    if (KSCALE) { float sc = t.kscale[kt * 64 + b_k_u + 4 * j]; v *= sc; }
    if (!b_ok) v = (f32x4){0.f, 0.f, 0.f, 0.f};
    u32x2 w = {pack_bf16(v[0], v[1]), pack_bf16(v[2], v[3])};
    *(u32x2*)(smem + G_B_OFF(s) + b_img * 16384 + off_b(k, b_ch) + 8 * b_half) = w;
  };
#define WAITQ(N, g) asm volatile("s_waitcnt vmcnt(" #N ")" : "+v"(breg[4 * (g)]), "+v"(breg[4 * (g) + 1]), "+v"(breg[4 * (g) + 2]), "+v"(breg[4 * (g) + 3]) :: "memory")

  unsigned a_rd[4], b_rd[2][2];
#pragma unroll
  for (int ks = 0; ks < 4; ++ks) { const int row = wr * 128 + l31; a_rd[ks] = row * 128 + (((2 * ks + hh) ^ ((row >> 1) & 7)) * 16); }
#pragma unroll
  for (int tt = 0; tt < 2; ++tt)
#pragma unroll
    for (int nl = 0; nl < 2; ++nl) b_rd[tt][nl] = tr_addr(lane, wc * 2 + nl, 8 * hh + 4 * tt);
  auto load_a = [&](const char* As, int ks, bf16x8 (&af)[4]) {
#pragma unroll
    for (int mb = 0; mb < 4; ++mb) af[mb] = *(const bf16x8*)(As + a_rd[ks] + mb * 4096);
  };
  auto load_b1 = [&](const char* Bs, int ks, int nb, bf16x8& bfr) {
    const char* bi = Bs + (nb >> 1) * 16384 + ks * 4096;
    s16x4 v0 = __builtin_amdgcn_ds_read_tr16_b64_v4i16((LAS3 s16x4*)(bi + b_rd[0][nb & 1]));
    s16x4 v1 = __builtin_amdgcn_ds_read_tr16_b64_v4i16((LAS3 s16x4*)(bi + b_rd[1][nb & 1]));
    bfr = (bf16x8){v0[0], v0[1], v0[2], v0[3], v1[0], v1[1], v1[2], v1[3]};
  };

  auto kstep = [&](int kt, auto mode_tag, bool has1, bool has2) {
    constexpr int MODE = decltype(mode_tag)::value;
    const int s = kt & 1;
    const char* As = smem + G_A_OFF(s);
    const char* Bs = smem + G_B_OFF(s);
    bf16x8 a0[4], a1[4], bq[NB];
    load_a(As, 0, a0);
#pragma unroll
    for (int nb = 0; nb < NB; ++nb) load_b1(Bs, 0, nb, bq[nb]);
    __builtin_amdgcn_sched_barrier(0);
#pragma unroll
    for (int g = 0; g < 4; ++g) {
      bf16x8 (&ac)[4] = (g & 1) ? a1 : a0;
      bf16x8 (&an)[4] = (g & 1) ? a0 : a1;
      if (g < 3) load_a(As, g + 1, an);
      __builtin_amdgcn_sched_barrier(0);
#pragma unroll
      for (int nb = 0; nb < NB; ++nb) {
#pragma unroll
        for (int mb = 0; mb < 4; ++mb)
          acc[mb][nb] = __builtin_amdgcn_mfma_f32_32x32x16_bf16(ac[mb], bq[nb], acc[mb][nb], 0, 0, 0);
        __builtin_amdgcn_sched_barrier(0);
        if (g < 3) load_b1(Bs, g + 1, nb, bq[nb]);
        if (nb == 0 && g < 2 && has1) { issue_a(kt + 1, s ^ 1, 4 * g + 0); issue_a(kt + 1, s ^ 1, 4 * g + 1); }
        if (nb == 1 % NB && g < 2 && has1 && NB > 1) { issue_a(kt + 1, s ^ 1, 4 * g + 2); issue_a(kt + 1, s ^ 1, 4 * g + 3); }
        if (NB == 1 && nb == 0 && g < 2 && has1) { issue_a(kt + 1, s ^ 1, 4 * g + 2); issue_a(kt + 1, s ^ 1, 4 * g + 3); }
        if (nb == NB - 1 && has1) {
          if (MODE == 2) { if (g == 0) WAITQ(20, 0); else if (g == 1) WAITQ(20, 1); else if (g == 2) WAITQ(20, 2); else WAITQ(20, 3); }
          else if (MODE == 1) { if (g == 0) WAITQ(16, 0); else if (g == 1) WAITQ(20, 1); else if (g == 2) WAITQ(20, 2); else WAITQ(20, 3); }
          else { if (g == 0) WAITQ(0, 0); else if (g == 1) WAITQ(0, 1); else if (g == 2) WAITQ(0, 2); else WAITQ(0, 3); }
#pragma unroll
          for (int i = 0; i < 4; ++i) write_b(kt + 1, s ^ 1, 4 * g + i);
          if (has2) {
#pragma unroll
            for (int i = 0; i < 4; ++i) issue_b(kt + 2, 4 * g + i);
          }
        }
        __builtin_amdgcn_sched_barrier(0);
      }
    }
    if (has1) {
      if (MODE == 0) asm volatile("s_waitcnt vmcnt(0)" ::: "memory");
      else asm volatile("s_waitcnt vmcnt(12)" ::: "memory");
      __syncthreads();
    }
  };

  const int nk = t.K >> 6;
  __syncthreads();
#pragma unroll
  for (int j = 0; j < 16; ++j) issue_b(0, j);
#pragma unroll
  for (int i = 0; i < 8; ++i) issue_a(0, 0, i);
  WAITQ(8, 0); WAITQ(8, 1); WAITQ(8, 2); WAITQ(8, 3);
#pragma unroll
  for (int j = 0; j < 16; ++j) write_b(0, 0, j);
#pragma unroll
  for (int j = 0; j < 16; ++j) issue_b(1, j);
  asm volatile("s_waitcnt vmcnt(16)" ::: "memory");
  __syncthreads();
  kstep(0, std::integral_constant<int, 1>{}, true, true);
  for (int kt = 1; kt < nk - 2; ++kt) kstep(kt, std::integral_constant<int, 2>{}, true, true);
  kstep(nk - 2, std::integral_constant<int, 0>{}, true, false);
  kstep(nk - 1, std::integral_constant<int, 0>{}, false, false);
#undef WAITQ
}
template <int NB, class F>
__device__ __forceinline__ void acc_foreach_row(f32x16 (&acc)[4][4], F f) {
  int tz = threadIdx.x; asm volatile("" : "+v"(tz));
  const int lane = tz & 63, wid = tz >> 6, wr = wid >> 1, wc = wid & 1;
  const int l31 = lane & 31, hh = lane >> 5;
#pragma unroll
  for (int mb = 0; mb < 4; ++mb)
#pragma unroll
    for (int reg = 0; reg < 16; ++reg) {
      const int rowl = wr * 128 + mb * 32 + (reg & 3) + 8 * (reg >> 2) + 4 * hh;
      float v[NB];
#pragma unroll
      for (int nb = 0; nb < NB; ++nb) v[nb] = acc[mb][nb][reg];
      f(rowl, wc * 64 + l31, v);
      asm volatile("" ::: "memory");
    }
}
__device__ __forceinline__ void ph_prep0(const Params& p) {
  const int tid_ = opaque_tid(); const int lane = tid_ & 63, wid = tid_ >> 6;
  if (blockIdx.x == 0 && tid_ < 64) p.counts()[tid_] = 0;
  for (int t = blockIdx.x * 4 + wid; t < T_; t += gridDim.x * 4) {
    const float* xr = p.x + (long)t * 2048;
    f32x4 v[8]; float ss = 0.f;
#pragma unroll
    for (int j = 0; j < 8; ++j) { v[j] = __builtin_nontemporal_load((const f32x4*)(xr + j * 256 + lane * 4)); ss += v[j][0] * v[j][0] + v[j][1] * v[j][1] + v[j][2] * v[j][2] + v[j][3] * v[j][3]; }
    ss = wave_sum(ss);
    const float r = rsqrtf(ss * (1.0f / 2048.0f) + EPS_);
#pragma unroll
    for (int j = 0; j < 8; ++j) {
      f32x4 g = *(const f32x4*)(p.attn_norm + j * 256 + lane * 4);
      u32x2 w = {pack_bf16(v[j][0] * r * g[0], v[j][1] * r * g[1]), pack_bf16(v[j][2] * r * g[2], v[j][3] * r * g[3])};
      *(u32x2*)(p.h1() + (long)t * 2048 + j * 256 + lane * 4) = w;
    }
    if (lane < 32) {
      float inv = __builtin_amdgcn_exp2f(-(float)lane * (13.287712379549449f / 32.0f));
      float ang = (float)p.pos[t] * inv;
      double a = (double)ang;
      double k = rint(a * 0.15915494309189535);
      float rf = (float)fma(-k, 6.283185307179586, a);
      p.cs()[t * 32 + lane] = make_float2(__cosf(rf), __sinf(rf));
    }
  }
}

template <int NB>
__device__ __forceinline__ void win_tile(const Params& p, char* smem, int mt, int nt) {
  f32x16 acc[4][4];
  GemmTile t{};
  t.A = p.h1(); t.lda = 2048; t.aidx = nullptr; t.m0 = mt * 256; t.mvalid = 256;
  t.B0 = p.w_in + nt * 256; t.B1 = t.B0 + 128; t.ldb = NC_;
  const int rem = NC_ - nt * 256;
  t.nv0 = rem >= 128 ? 128 : rem; t.nv1 = rem >= 256 ? 128 : (rem > 128 ? rem - 128 : 0);
  t.kscale = nullptr; t.K = 2048;
  gemm_tile_256<NB, false, false>(t, smem, acc);
  u16* base = p.proj() + (long)(mt * 256) * NC_ + nt * 256;
  const int nv0 = t.nv0, nv1 = t.nv1;
  acc_foreach_row<NB>(acc, [&](int rowl, int coll, float (&v)[NB]) {
    u16* rp = base + (long)rowl * NC_ + coll;
    OPAQUE(rp);
#pragma unroll
    for (int nb = 0; nb < NB; ++nb) {
      const int c = (nb & 1) * 32 + coll;
      const int lim = (nb >> 1) ? nv1 : nv0;
      if (c < lim) rp[(nb >> 1) * 128 + (nb & 1) * 32] = f32_to_bf16(v[nb]);
    }
  });
}
__device__ __forceinline__ void ph_win(const Params& p, char* smem) {
  const int x = blockIdx.x & 7, slot = blockIdx.x >> 3;
  for (int j = slot; j < 64; j += 32) win_tile<4>(p, smem, 4 * x + (j & 3), j >> 2);
  if (slot < 4) win_tile<2>(p, smem, 4 * x + slot, 16);
}

__device__ __forceinline__ void ph_prep1(const Params& p, char* smem) {
  float* gds = (float*)smem;
  float* cums = (float*)(smem + 4096);
  const int tid = opaque_tid(), lane = tid & 63, wid = tid >> 6;
  for (int u = blockIdx.x; u < 512; u += gridDim.x) {
    const int ch = u >> 2, h = u & 3; const int t0 = ch * 64;
    __syncthreads();
    {
      const int tl = tid >> 2, r4 = (tid & 3) * 4;
      u32x2 w = *(const u32x2*)(p.proj() + (long)(t0 + tl) * NC_ + C_GD + r4);
      gds[tl * 16 + r4 + 0] = bf_lo(w[0]); gds[tl * 16 + r4 + 1] = bf_hi(w[0]);
      gds[tl * 16 + r4 + 2] = bf_lo(w[1]); gds[tl * 16 + r4 + 3] = bf_hi(w[1]);
    }
    const int c = tid & 127, half = tid >> 7;
    float gu[16];
#pragma unroll
    for (int r = 0; r < 16; ++r) gu[r] = p.gate_up[r * 512 + h * 128 + c];
    const float bias = p.gate_bias[h * 128 + c];
    __syncthreads();
    float run = 0.f;
    for (int i = 0; i < 32; ++i) {
      const int tl = half * 32 + i;
      float z = bias;
#pragma unroll
      for (int r = 0; r < 16; ++r) z = fmaf(gds[tl * 16 + r], gu[r], z);
      const float ls = fminf(z, 0.f) - __logf(1.0f + __expf(-fabsf(z)));
      run += ls * (1.0f / 16.0f);
      cums[tl * 128 + c] = run;
    }
    __syncthreads();
    {
      const float add = cums[31 * 128 + c];
      for (int i = 0; i < 32; ++i) {
        const int tl = half * 32 + i;
        float v = cums[tl * 128 + c] + (half ? add : 0.f);
        p.bcum()[(long)(t0 + tl) * 512 + h * 128 + c] = v;
      }
    }
    for (int i = 0; i < 4; ++i) {
      const long t = t0 + h * 16 + wid * 4 + i;
      const u16* pr = p.proj() + t * NC_;
      u32x4 a = *(const u32x4*)(pr + C_MQ + lane * 8);
      float sa = 0.f, sb = 0.f;
#pragma unroll
      for (int k = 0; k < 4; ++k) { float l = bf_lo(a[k]), hgh = bf_hi(a[k]); sa += l * l + hgh * hgh; }
#if WIN_SPLIT
      auto pn_sum = [&](int col) { float s = 0.f;
#pragma unroll
        for (int kc = 0; kc < 8; ++kc) s += p.pn()[(long)kc * (8192 * 80) + t * 80 + col];
        return s; };
      const float pv = bf16_to_f32(f32_to_bf16(pn_sum(lane)));
      u32x4 b = {0u, 0u, 0u, 0u};
      if (lane < 62) b = *(const u32x4*)(pr + C_MKV + lane * 8);
#pragma unroll
      for (int k = 0; k < 4; ++k) { float l = bf_lo(b[k]), hgh = bf_hi(b[k]); sb += l * l + hgh * hgh; }
      if (lane < 16) sb += pv * pv;
#else
      u32x4 b = *(const u32x4*)(pr + C_MKV + lane * 8);
#pragma unroll
      for (int k = 0; k < 4; ++k) { float l = bf_lo(b[k]), hgh = bf_hi(b[k]); sb += l * l + hgh * hgh; }
#endif
      sa = wave_sum(sa); sb = wave_sum(sb);
      if (lane == 0) { p.rq()[t] = rsqrtf(sa * (1.0f / 512.0f) + EPS_); p.rkv()[t] = rsqrtf(sb * (1.0f / 512.0f) + EPS_); }
#if WIN_SPLIT
      {
        const float v0 = pv;
        const float v1 = (lane < 16) ? bf16_to_f32(f32_to_bf16(pn_sum(64 + lane))) : 0.f;
        u16* pw = p.proj() + t * NC_ + 4096;
        pw[lane] = f32_to_bf16(v0);
        if (lane < 16) pw[64 + lane] = f32_to_bf16(v1);
        const float t1 = __int_as_float(__builtin_amdgcn_ds_bpermute(((lane + 16) & 63) << 2, __float_as_int(v0)));
        const float t2a = __int_as_float(__builtin_amdgcn_ds_bpermute(((lane + 48) & 63) << 2, __float_as_int(v0)));
        const float t2b = __int_as_float(__builtin_amdgcn_ds_bpermute(((lane - 16) & 63) << 2, __float_as_int(v1)));
        if (lane < 32) {
          const float t2 = (lane < 16) ? t2a : t2b;
          const float2 cs = p.cs()[t * 32 + lane];
          p.kpe()[t * 64 + lane] = f32_to_bf16(t1 * cs.x - t2 * cs.y);
          p.kpe()[t * 64 + lane + 32] = f32_to_bf16(t1 * cs.y + t2 * cs.x);
        }
      }
#else
      if (lane < 32) {
        const float t1 = bf16_to_f32(pr[C_MKR + lane]), t2 = bf16_to_f32(pr[C_MKR + lane + 32]);
        const float2 cs = p.cs()[t * 32 + lane];
        p.kpe()[t * 64 + lane] = f32_to_bf16(t1 * cs.x - t2 * cs.y);
        p.kpe()[t * 64 + lane + 32] = f32_to_bf16(t1 * cs.y + t2 * cs.x);
      }
#endif
    }
  }
}

#define QSCALE_ (0.07216878364870322f * 1.4426950408889634f)
__device__ __forceinline__ void upq_tile(const Params& p, char* smem, int mt, int nt) {
  f32x16 acc[4][4];
  GemmTile t{};
  t.A = p.proj() + C_MQ; t.lda = NC_; t.aidx = nullptr; t.m0 = mt * 256; t.mvalid = 256;
  t.B0 = p.w_uq + nt * 256; t.B1 = t.B0 + 128; t.ldb = 1536; t.nv0 = 128; t.nv1 = 128; t.kscale = p.q_norm; t.K = 512;
  gemm_tile_256<4, true, false>(t, smem, acc);
  u16* base = p.q() + (long)(mt * 256) * 1536 + nt * 256;
  const float* rq = p.rq() + mt * 256;
  acc_foreach_row<4>(acc, [&](int rowl, int coll, float (&v)[4]) {
    u16* rp = base + (long)rowl * 1536 + coll;
    OPAQUE(rp);
    const float s = rq[rowl] * QSCALE_;
#pragma unroll
    for (int nb = 0; nb < 4; ++nb) rp[(nb >> 1) * 128 + (nb & 1) * 32] = f32_to_bf16(v[nb] * s);
  });
}
__device__ __forceinline__ void upkv_tile(const Params& p, char* smem, int mt, int nt) {
  f32x16 acc[4][4];
  GemmTile t{};
  t.A = p.proj() + C_MKV; t.lda = NC_; t.aidx = nullptr; t.m0 = mt * 256; t.mvalid = 256;
  t.B0 = p.w_ukv + nt * 256; t.B1 = t.B0 + 128; t.ldb = 2048; t.nv0 = 128; t.nv1 = 128; t.kscale = p.kv_norm; t.K = 512;
  gemm_tile_256<4, true, false>(t, smem, acc);
  u16* base = p.kv() + (long)(mt * 256) * 2048 + nt * 256;
  const float* rk = p.rkv() + mt * 256;
  acc_foreach_row<4>(acc, [&](int rowl, int coll, float (&v)[4]) {
    u16* rp = base + (long)rowl * 2048 + coll;
    OPAQUE(rp);
    const float s = rk[rowl];
#pragma unroll
    for (int nb = 0; nb < 4; ++nb) rp[(nb >> 1) * 128 + (nb & 1) * 32] = f32_to_bf16(v[nb] * s);
  });
}
#define WSCALE_  128.0f
#define WISCALE_ 0.0078125f
typedef unsigned char u8;
struct CvtUnit { const float* src; u8* dst; int ldn; };
__device__ __forceinline__ CvtUnit cvt8_decode(const Params& p, int u);
#define AT_KSTRIDE 400
#define AT_KBYTES  (64 * AT_KSTRIDE)
#define AT_STAGE   (AT_KBYTES + 16384)
#define AT_LDS_BYTES (2 * AT_STAGE)

#define AT_CVT_T(par) (smem + AT_LDS_BYTES + (par) * 16384)
__device__ __forceinline__ void attn_unit(const Params& p, char* smem, int b, int h, int qb, int& ci) {
  const int tid = opaque_tid(), lane = tid & 63, wid = tid >> 6, l31 = lane & 31, hh = lane >> 5;
  const long tq = (long)b * SEQ_ + qb * 128 + wid * 32 + l31;
  bf16x8 qf[12];
  {
    const u16* qp = p.q() + (tq * 8 + h) * 192 + 8 * hh;
#pragma unroll
    for (int ks = 0; ks < 12; ++ks) qf[ks] = *(const bf16x8*)(qp + 16 * ks);
#pragma unroll
    for (int s = 0; s < 2; ++s) {
      const float2* cp = p.cs() + tq * 32 + 16 * s + 8 * hh;
      bf16x8 lo = qf[8 + s], hi = qf[10 + s], nlo, nhi;
#pragma unroll
      for (int j = 0; j < 8; j += 2) {
        float2 c0 = cp[j], c1 = cp[j + 1];
        float a0 = bf16_to_f32((u16)lo[j]), a1 = bf16_to_f32((u16)lo[j + 1]);
        float b0 = bf16_to_f32((u16)hi[j]), b1 = bf16_to_f32((u16)hi[j + 1]);
        unsigned wl = pack_bf16(a0 * c0.x - b0 * c0.y, a1 * c1.x - b1 * c1.y);
        unsigned wh = pack_bf16(a0 * c0.y + b0 * c0.x, a1 * c1.y + b1 * c1.x);
        nlo[j] = (short)(wl & 0xffff); nlo[j + 1] = (short)(wl >> 16);
        nhi[j] = (short)(wh & 0xffff); nhi[j + 1] = (short)(wh >> 16);
      }
      qf[8 + s] = nlo; qf[10 + s] = nhi;
    }
  }
  u32x4 kregA[6], vregA[4], kregB[6], vregB[4];
  const long tk0 = (long)b * SEQ_;
  auto load_tile = [&](int kt, u32x4 (&kreg)[6], u32x4 (&vreg)[4]) {
    const long tb = tk0 + kt * 64;
#pragma unroll
    for (int i = 0; i < 4; ++i) {
      const int pp = i * 256 + tid; const int key = pp >> 4, c = pp & 15;
      const u16* rowp = p.kv() + ((tb + key) * 8 + h) * 256 + c * 8;
      kreg[i] = *(const u32x4*)rowp;
      vreg[i] = *(const u32x4*)(rowp + 128);
    }
#pragma unroll
    for (int i = 0; i < 2; ++i) {
      const int pp = i * 256 + tid; const int key = pp >> 3, c = pp & 7;
      kreg[4 + i] = *(const u32x4*)(p.kpe() + (tb + key) * 64 + c * 8);
    }
  };
  auto store_tile = [&](int s, u32x4 (&kreg)[6], u32x4 (&vreg)[4]) {
    char* Ks = smem + s * AT_STAGE; char* Vs = Ks + AT_KBYTES;
#pragma unroll
    for (int i = 0; i < 4; ++i) {
      const int pp = i * 256 + tid; const int key = pp >> 4, c = pp & 15;
      *(u32x4*)(Ks + key * AT_KSTRIDE + c * 16) = kreg[i];
      *(u32x4*)(Vs + off_b(key, c)) = vreg[i];
    }
#pragma unroll
    for (int i = 0; i < 2; ++i) {
      const int pp = i * 256 + tid; const int key = pp >> 3, c = pp & 7;
      *(u32x4*)(Ks + key * AT_KSTRIDE + (16 + c) * 16) = kreg[4 + i];
    }
  };

  f32x16 o[4];
#pragma unroll
  for (int c = 0; c < 4; ++c)
#pragma unroll
    for (int r = 0; r < 16; ++r) o[c][r] = 0.f;
  float m = -1e30f, l = 0.f;
  const int nt = 2 * qb + 2;
  const int qpos = qb * 128 + wid * 32 + l31;

  __syncthreads();
  load_tile(0, kregA, vregA);
  store_tile(0, kregA, vregA);
  load_tile(1, kregB, vregB);
  if (nt > 2) load_tile(2, kregA, vregA);
  __syncthreads();
  auto tile_body = [&](int kt, int s) {
    const char* Ks = smem + s * AT_STAGE; const char* Vs = Ks + AT_KBYTES;
    const bool active = (kt * 64) <= (qb * 128 + wid * 32 + 31);
    if (active) {
      f32x16 sc[2];
#pragma unroll
      for (int kb = 0; kb < 2; ++kb) {
#pragma unroll
        for (int r = 0; r < 16; ++r) sc[kb][r] = 0.f;
#pragma unroll
        for (int ks = 0; ks < 12; ++ks) {
          bf16x8 a = *(const bf16x8*)(Ks + (kb * 32 + l31) * AT_KSTRIDE + (2 * ks + hh) * 16);
          sc[kb] = __builtin_amdgcn_mfma_f32_32x32x16_bf16(a, qf[ks], sc[kb], 0, 0, 0);
        }
      }
      if (kt >= 2 * qb) {
#pragma unroll
        for (int kb = 0; kb < 2; ++kb)
#pragma unroll
          for (int r = 0; r < 16; ++r) {
            const int key = kt * 64 + kb * 32 + (r & 3) + 8 * (r >> 2) + 4 * hh;
            if (key > qpos) sc[kb][r] = -1e30f;
          }
      }
      float mx = sc[0][0];
#pragma unroll
      for (int kb = 0; kb < 2; ++kb)
#pragma unroll
        for (int r = 0; r < 16; ++r) mx = fmaxf(mx, sc[kb][r]);
      mx = fmaxf(mx, shflx(mx, 32));
      const float mn = fmaxf(m, mx);
      const float alpha = __builtin_amdgcn_exp2f(m - mn);
      m = mn;
      float ps = 0.f;
      bf16x8 pf[4];
#pragma unroll
      for (int kb = 0; kb < 2; ++kb)
#pragma unroll
        for (int s2 = 0; s2 < 2; ++s2) {
          float e[8];
#pragma unroll
          for (int j = 0; j < 8; ++j) { e[j] = __builtin_amdgcn_exp2f(sc[kb][8 * s2 + j] - mn); ps += e[j]; }
          unsigned w0 = pack_bf16(e[0], e[1]), w1 = pack_bf16(e[2], e[3]), w2 = pack_bf16(e[4], e[5]), w3 = pack_bf16(e[6], e[7]);
          u32x4 w = {w0, w1, w2, w3};
          pf[kb * 2 + s2] = *(bf16x8*)&w;
        }
      l = l * alpha + ps;
#pragma unroll
      for (int c = 0; c < 4; ++c)
#pragma unroll
        for (int r = 0; r < 16; ++r) o[c][r] *= alpha;
#pragma unroll
      for (int c = 0; c < 4; ++c)
#pragma unroll
        for (int kk = 0; kk < 4; ++kk) {
          const unsigned rbase = 32 * (kk >> 1) + 16 * (kk & 1) + 4 * hh;
          bf16x8 a = tr_frag(Vs, lane, c, rbase, rbase + 8);
          o[c] = __builtin_amdgcn_mfma_f32_32x32x16_bf16(a, pf[kk], o[c], 0, 0, 0);
        }
    }
  };
#if CVT_IN_ATTN
  f32x4 cv[16];
  bool cv_inflight = false;
  u8* cv_dst = nullptr;
  bool cv_emitted = false;
  int cv_par = 0;
  auto cv_issue = [&]() {
    if (ci < 64) {
      const CvtUnit c = cvt8_decode(p, blockIdx.x + 256 * ci);
      const float* src = c.src + (long)(wid * 16) * c.ldn + lane * 4;
#pragma unroll
      for (int j = 0; j < 16; ++j) { const float* ptr = src + (long)j * c.ldn; asm volatile("global_load_dwordx4 %0, %1, off nt" : "=a"(cv[j]) : "v"(ptr) : "memory"); }
      cv_dst = c.dst; cv_inflight = true; ++ci;
    } else cv_inflight = false;
  };
  auto cv_emit = [&]() {
    cv_emitted = cv_inflight;
    if (cv_inflight) {
      asm volatile("s_waitcnt vmcnt(0)" : "+a"(cv[0]), "+a"(cv[1]), "+a"(cv[2]), "+a"(cv[3]), "+a"(cv[4]), "+a"(cv[5]), "+a"(cv[6]), "+a"(cv[7]),
                   "+a"(cv[8]), "+a"(cv[9]), "+a"(cv[10]), "+a"(cv[11]), "+a"(cv[12]), "+a"(cv[13]), "+a"(cv[14]), "+a"(cv[15]) :: "memory");
      char* T = AT_CVT_T(cv_par);
#pragma unroll
      for (int cc = 0; cc < 4; ++cc) {
        u32x4 x4;
#pragma unroll
        for (int q = 0; q < 4; ++q) {
          int x = 0;
          x = __builtin_amdgcn_cvt_pk_fp8_f32(cv[4 * q][cc] * WSCALE_, cv[4 * q + 1][cc] * WSCALE_, x, false);
          x = __builtin_amdgcn_cvt_pk_fp8_f32(cv[4 * q + 2][cc] * WSCALE_, cv[4 * q + 3][cc] * WSCALE_, x, true);
          x4[q] = (unsigned)x;
        }
        *(u32x4*)(T + (lane * 4 + cc) * 64 + wid * 16) = x4;
      }
    }
  };
  u8* cv_dst_e = nullptr;
  auto cv_flush = [&]() {
    if (cv_emitted) {
      const char* T = AT_CVT_T(cv_par);
#pragma unroll
      for (int i = 0; i < 4; ++i) {
        const int n = (tid >> 2) + 64 * i, ch = tid & 3;
        __builtin_nontemporal_store(*(const u32x4*)(T + n * 64 + ch * 16), (u32x4*)(cv_dst_e + (long)(n >> 1) * 4096 + (n & 1) * 64 + ch * 16));
      }
      cv_par ^= 1;
    }
  };
#define CV_BEFORE_BAR() do { cv_emit(); cv_dst_e = cv_dst; cv_issue(); } while (0)
#define CV_AFTER_BAR()  do { cv_flush(); } while (0)
  cv_issue();
#else
#define CV_BEFORE_BAR() do {} while (0)
#define CV_AFTER_BAR()  do {} while (0)
#endif
  for (int kt = 0; kt < nt; kt += 2) {
    tile_body(kt, 0);
    CV_BEFORE_BAR();
    store_tile(1, kregB, vregB);
    if (kt + 3 < nt) load_tile(kt + 3, kregB, vregB);
    __syncthreads();
    CV_AFTER_BAR();
    tile_body(kt + 1, 1);
    CV_BEFORE_BAR();
    if (kt + 2 < nt) {
      store_tile(0, kregA, vregA);
      if (kt + 4 < nt) load_tile(kt + 4, kregA, vregA);
    }
    __syncthreads();
    CV_AFTER_BAR();
  }
#if CVT_IN_ATTN
  cv_emit(); cv_dst_e = cv_dst; cv_inflight = false;
  __syncthreads();
  cv_flush();
#endif
#undef CV_BEFORE_BAR
#undef CV_AFTER_BAR
  l = l + shflx(l, 32);
  const float inv = 1.0f / l;
  u16* op = p.omla() + tq * 1024 + h * 128 + 4 * hh;
#pragma unroll
  for (int c = 0; c < 4; ++c)
#pragma unroll
    for (int rg = 0; rg < 4; ++rg) {
      u32x2 w = {pack_bf16(o[c][4 * rg] * inv, o[c][4 * rg + 1] * inv), pack_bf16(o[c][4 * rg + 2] * inv, o[c][4 * rg + 3] * inv)};
      *(u32x2*)(op + 32 * c + 8 * rg) = w;
    }
}

#define G1_LDS_BYTES 49152
__device__ __forceinline__ void gla_g1_unit(const Params& p, char* smem, int u) {
  const int tid = opaque_tid(), lane = tid & 63, wid = tid >> 6, l31 = lane & 31, hh = lane >> 5;
  const int bh = u >> 6, n = u & 63, b = bh >> 2, h = bh & 3;
  const long t0 = (long)b * SEQ_ + n * 64;
  char* Ks = smem; char* Vs = smem + 16384;
  __syncthreads();
  {
    const int ch = tid & 15;
    const float* bl = p.bcum() + (t0 + 63) * 512 + h * 128 + ch * 8;
    f32x4 bl0 = *(const f32x4*)bl, bl1 = *(const f32x4*)(bl + 4);
    if (tid < 128) p.dec()[(long)u * 128 + tid] = __expf(p.bcum()[(t0 + 63) * 512 + h * 128 + tid]);
#pragma unroll
    for (int i = 0; i < 4; ++i) {
      const int tok = (i * 256 + tid) >> 4;
      u32x4 kw = *(const u32x4*)(p.proj() + (t0 + tok) * NC_ + C_GK + h * 128 + ch * 8);
      const float* bp = p.bcum() + (t0 + tok) * 512 + h * 128 + ch * 8;
      f32x4 b0 = *(const f32x4*)bp, b1 = *(const f32x4*)(bp + 4);
      u32x4 w;
      w[0] = pack_bf16(bf_lo(kw[0]) * __expf(bl0[0] - b0[0]), bf_hi(kw[0]) * __expf(bl0[1] - b0[1]));
      w[1] = pack_bf16(bf_lo(kw[1]) * __expf(bl0[2] - b0[2]), bf_hi(kw[1]) * __expf(bl0[3] - b0[3]));
      w[2] = pack_bf16(bf_lo(kw[2]) * __expf(bl1[0] - b1[0]), bf_hi(kw[2]) * __expf(bl1[1] - b1[1]));
      w[3] = pack_bf16(bf_lo(kw[3]) * __expf(bl1[2] - b1[2]), bf_hi(kw[3]) * __expf(bl1[3] - b1[3]));
      *(u32x4*)(Ks + off_b(tok, ch)) = w;
    }
#pragma unroll
    for (int i = 0; i < 8; ++i) {
      const int pp = i * 256 + tid; const int tok = pp >> 5, c32 = pp & 31;
      u32x4 vw = *(const u32x4*)(p.proj() + (t0 + tok) * NC_ + C_GV + h * 256 + c32 * 8);
      *(u32x4*)(Vs + (c32 >> 4) * 16384 + off_b(tok, c32 & 15)) = vw;
    }
  }
  __syncthreads();
  f32x16 acc[4][2];
#pragma unroll
  for (int mb = 0; mb < 4; ++mb)
#pragma unroll
    for (int nb = 0; nb < 2; ++nb)
#pragma unroll
      for (int r = 0; r < 16; ++r) acc[mb][nb][r] = 0.f;
  const char* Vimg = Vs + (wid >> 1) * 16384;
#pragma unroll
  for (int ks = 0; ks < 4; ++ks) {
    bf16x8 af[4], bfr[2];
    const unsigned r0 = 16 * ks + 8 * hh;
#pragma unroll
    for (int mb = 0; mb < 4; ++mb) af[mb] = tr_frag(Ks, lane, mb, r0, r0 + 4);
#pragma unroll
    for (int nb = 0; nb < 2; ++nb) bfr[nb] = tr_frag(Vimg, lane, 2 * (wid & 1) + nb, r0, r0 + 4);
#pragma unroll
    for (int mb = 0; mb < 4; ++mb)
#pragma unroll
      for (int nb = 0; nb < 2; ++nb) acc[mb][nb] = __builtin_amdgcn_mfma_f32_32x32x16_bf16(af[mb], bfr[nb], acc[mb][nb], 0, 0, 0);
  }
  __syncthreads();
  {
    char* st = smem + wid * 16384;
#pragma unroll
    for (int mb = 0; mb < 4; ++mb)
#pragma unroll
      for (int r = 0; r < 16; ++r) {
        const int dk = mb * 32 + (r & 3) + 8 * (r >> 2) + 4 * hh;
        *(u16*)(st + dk * 128 + l31 * 2) = f32_to_bf16(acc[mb][0][r]);
        *(u16*)(st + dk * 128 + (32 + l31) * 2) = f32_to_bf16(acc[mb][1][r]);
      }
    u16* gb = p.kvc() + (long)u * 32768 + wid * 64;
#pragma unroll 4
    for (int it = 0; it < 16; ++it) {
      const int dk = it * 8 + (lane >> 3), ch = lane & 7;
      *(u32x4*)(gb + dk * 256 + ch * 8) = *(const u32x4*)(st + dk * 128 + ch * 16);
    }
  }
}

__device__ __forceinline__ void gla_g2_unit(const Params& p, int u) {
  const int tid = opaque_tid();
  const int bh = u >> 5, part = u & 31;
  const int dk = part * 4 + (tid >> 6), dv = (tid & 63) * 4;
  float s0 = 0.f, s1 = 0.f, s2 = 0.f, s3 = 0.f;
  const long ebase = (long)dk * 256 + dv;
#pragma unroll 8
  for (int n = 0; n < 64; ++n) {
    const long un = (long)(bh * 64 + n);
    u32x2 kw = *(const u32x2*)(p.kvc() + un * 32768 + ebase);
    const float d = p.dec()[un * 128 + dk];
    u32x2 w = {pack_bf16(s0, s1), pack_bf16(s2, s3)};
    *(u32x2*)(p.sprev() + un * 32768 + ebase) = w;
    s0 = fmaf(d, s0, bf_lo(kw[0])); s1 = fmaf(d, s1, bf_hi(kw[0]));
    s2 = fmaf(d, s2, bf_lo(kw[1])); s3 = fmaf(d, s3, bf_hi(kw[1]));
  }
}

#define G3_LDS_BYTES (16384 + 16384 + 32768 + 65536 + 1024)
__device__ __forceinline__ void gla_g3_unit(const Params& p, char* smem, int u) {
  const int tid = opaque_tid(), lane = tid & 63, wid = tid >> 6, l31 = lane & 31, hh = lane >> 5;
  const int bh = u >> 6, n = u & 63, b = bh >> 2, h = bh & 3;
  const long t0 = (long)b * SEQ_ + n * 64;
  char* Qd = smem; char* Ki = smem + 16384; char* Vs = smem + 32768; char* Sp = smem + 65536; float* red = (float*)(smem + 131072);
  __syncthreads();
  {
    const int ch = tid & 15;
    const float qs = 0.08838834764831845f;
#pragma unroll
    for (int i = 0; i < 4; ++i) {
      const int tok = (i * 256 + tid) >> 4;
      const u16* pr = p.proj() + (t0 + tok) * NC_ + h * 128 + ch * 8;
      u32x4 qw = *(const u32x4*)(pr + C_GQ), kw = *(const u32x4*)(pr + C_GK);
      const float* bp = p.bcum() + (t0 + tok) * 512 + h * 128 + ch * 8;
      f32x4 b0 = *(const f32x4*)bp, b1 = *(const f32x4*)(bp + 4);
      float e[8] = {__expf(b0[0]), __expf(b0[1]), __expf(b0[2]), __expf(b0[3]), __expf(b1[0]), __expf(b1[1]), __expf(b1[2]), __expf(b1[3])};
      u32x4 wq, wk;
#pragma unroll
      for (int k = 0; k < 4; ++k) {
        wq[k] = pack_bf16(bf_lo(qw[k]) * qs * e[2 * k], bf_hi(qw[k]) * qs * e[2 * k + 1]);
        wk[k] = pack_bf16(bf_lo(kw[k]) * __builtin_amdgcn_rcpf(e[2 * k]), bf_hi(kw[k]) * __builtin_amdgcn_rcpf(e[2 * k + 1]));
      }
      *(u32x4*)(Qd + off_b(tok, ch)) = wq;
      *(u32x4*)(Ki + off_b(tok, ch)) = wk;
    }
#pragma unroll
    for (int i = 0; i < 8; ++i) {
      const int pp = i * 256 + tid; const int tok = pp >> 5, c32 = pp & 31;
      u32x4 vw = *(const u32x4*)(p.proj() + (t0 + tok) * NC_ + C_GV + h * 256 + c32 * 8);
      *(u32x4*)(Vs + (c32 >> 4) * 16384 + off_b(tok, c32 & 15)) = vw;
    }
#pragma unroll
    for (int i = 0; i < 16; ++i) {
      const int pp = i * 256 + tid; const int dk = pp >> 5, c32 = pp & 31;
      u32x4 sw = *(const u32x4*)(p.sprev() + (long)u * 32768 + dk * 256 + c32 * 8);
      *(u32x4*)(Sp + (c32 >> 4) * 32768 + off_b(dk, c32 & 15)) = sw;
    }
  }
  __syncthreads();
  const int ib = wid & 1, dvh = wid >> 1;
  f32x16 sc[2];
#pragma unroll
  for (int jb = 0; jb < 2; ++jb) {
#pragma unroll
    for (int r = 0; r < 16; ++r) sc[jb][r] = 0.f;
    if (jb <= ib) {
#pragma unroll
      for (int ks = 0; ks < 8; ++ks) {
        bf16x8 a = *(const bf16x8*)(Ki + off_b(jb * 32 + l31, 2 * ks + hh));
        bf16x8 bq = *(const bf16x8*)(Qd + off_b(ib * 32 + l31, 2 * ks + hh));
        sc[jb] = __builtin_amdgcn_mfma_f32_32x32x16_bf16(a, bq, sc[jb], 0, 0, 0);
      }
#pragma unroll
      for (int r = 0; r < 16; ++r) {
        const int j = jb * 32 + (r & 3) + 8 * (r >> 2) + 4 * hh, i = ib * 32 + l31;
        if (j > i) sc[jb][r] = 0.f;
      }
    }
  }
  bf16x8 pf[4];
#pragma unroll
  for (int jb = 0; jb < 2; ++jb)
#pragma unroll
    for (int s2 = 0; s2 < 2; ++s2) {
      u32x4 w = {pack_bf16(sc[jb][8 * s2 + 0], sc[jb][8 * s2 + 1]), pack_bf16(sc[jb][8 * s2 + 2], sc[jb][8 * s2 + 3]),
                 pack_bf16(sc[jb][8 * s2 + 4], sc[jb][8 * s2 + 5]), pack_bf16(sc[jb][8 * s2 + 6], sc[jb][8 * s2 + 7])};
      pf[jb * 2 + s2] = *(bf16x8*)&w;
    }
  f32x16 o[4];
#pragma unroll
  for (int c = 0; c < 4; ++c)
#pragma unroll
    for (int r = 0; r < 16; ++r) o[c][r] = 0.f;
  const char* Vimg = Vs + dvh * 16384;
  const char* Simg = Sp + dvh * 32768;
#pragma unroll
  for (int c = 0; c < 4; ++c) {
#pragma unroll
    for (int kk = 0; kk < 4; ++kk) {
      if ((kk >> 1) <= ib) {
        const unsigned rbase = 32 * (kk >> 1) + 16 * (kk & 1) + 4 * hh;
        bf16x8 a = tr_frag(Vimg, lane, c, rbase, rbase + 8);
        o[c] = __builtin_amdgcn_mfma_f32_32x32x16_bf16(a, pf[kk], o[c], 0, 0, 0);
      }
    }
#pragma unroll
    for (int ks = 0; ks < 8; ++ks) {
      const unsigned r0 = 16 * ks + 8 * hh;
      bf16x8 a = tr_frag(Simg, lane, c, r0, r0 + 4);
      bf16x8 bq = *(const bf16x8*)(Qd + off_b(ib * 32 + l31, 2 * ks + hh));
      o[c] = __builtin_amdgcn_mfma_f32_32x32x16_bf16(a, bq, o[c], 0, 0, 0);
    }
  }
  float ss = 0.f;
#pragma unroll
  for (int c = 0; c < 4; ++c)
#pragma unroll
    for (int r = 0; r < 16; ++r) ss += o[c][r] * o[c][r];
  ss += shflx(ss, 32);
  if (hh == 0) red[dvh * 64 + ib * 32 + l31] = ss;
  __syncthreads();
  const float tot = red[ib * 32 + l31] + red[64 + ib * 32 + l31];
  const float rn = rsqrtf(tot * (1.0f / 256.0f) + EPS_);
  const long t = t0 + ib * 32 + l31;
  const u16* grp = p.proj() + t * NC_ + C_GR + h * 256 + dvh * 128 + 4 * hh;
  u16* op = p.mix() + t * 2048 + h * 256 + dvh * 128 + 4 * hh;
  const float* gp = p.gla_out_norm + dvh * 128 + 4 * hh;
#pragma unroll
  for (int c = 0; c < 4; ++c)
#pragma unroll
    for (int rg = 0; rg < 4; ++rg) {
      u32x2 gw = *(const u32x2*)(grp + 32 * c + 8 * rg);
      f32x4 g = *(const f32x4*)(gp + 32 * c + 8 * rg);
      float gr[4] = {bf_lo(gw[0]), bf_hi(gw[0]), bf_lo(gw[1]), bf_hi(gw[1])};
      float ov[4];
#pragma unroll
      for (int k = 0; k < 4; ++k) { float si = gr[k] * __builtin_amdgcn_rcpf(1.0f + __expf(-gr[k])); ov[k] = o[c][4 * rg + k] * rn * g[k] * si; }
#if WOUTQ
      {
        int q8 = 0;
        q8 = __builtin_amdgcn_cvt_pk_fp8_f32(ov[0], ov[1], q8, false);
        q8 = __builtin_amdgcn_cvt_pk_fp8_f32(ov[2], ov[3], q8, true);
        const int col = h * 256 + dvh * 128 + 4 * hh + 32 * c + 8 * rg;
        *(unsigned*)(p.mixq() + (t >> 1) * 4096 + (col >> 6) * 128 + (t & 1) * 64 + (col & 63)) = (unsigned)q8;
      }
#else
      u32x2 w = {pack_bf16(ov[0], ov[1]), pack_bf16(ov[2], ov[3])};
      *(u32x2*)(op + 32 * c + 8 * rg) = w;
#endif
    }
}

__device__ __forceinline__ void mla_norm_tokens(const Params& p) {
  const int tid_ = opaque_tid(); const int lane = tid_ & 63, wid = tid_ >> 6;
  for (int t = blockIdx.x * 4 + wid; t < T_; t += gridDim.x * 4) {
    const u16* src = p.omla() + (long)t * 1024;
    u32x4 a = *(const u32x4*)(src + lane * 8), b = *(const u32x4*)(src + 512 + lane * 8);
    float ss = 0.f;
#pragma unroll
    for (int k = 0; k < 4; ++k) { float x0 = bf_lo(a[k]), x1 = bf_hi(a[k]), y0 = bf_lo(b[k]), y1 = bf_hi(b[k]); ss += x0 * x0 + x1 * x1 + y0 * y0 + y1 * y1; }
    ss = wave_sum(ss);
    const float r = rsqrtf(ss * (1.0f / 1024.0f) + EPS_);
    const float* g = p.mla_out_norm;
    u32x4 wa, wb;
#pragma unroll
    for (int k = 0; k < 4; ++k) {
      wa[k] = pack_bf16(bf_lo(a[k]) * r * g[lane * 8 + 2 * k], bf_hi(a[k]) * r * g[lane * 8 + 2 * k + 1]);
      wb[k] = pack_bf16(bf_lo(b[k]) * r * g[512 + lane * 8 + 2 * k], bf_hi(b[k]) * r * g[512 + lane * 8 + 2 * k + 1]);
    }
#if WOUTQ
    {
      int qa0 = 0, qa1 = 0, qb0 = 0, qb1 = 0;
      qa0 = __builtin_amdgcn_cvt_pk_fp8_f32(bf_lo(wa[0]), bf_hi(wa[0]), qa0, false); qa0 = __builtin_amdgcn_cvt_pk_fp8_f32(bf_lo(wa[1]), bf_hi(wa[1]), qa0, true);
      qa1 = __builtin_amdgcn_cvt_pk_fp8_f32(bf_lo(wa[2]), bf_hi(wa[2]), qa1, false); qa1 = __builtin_amdgcn_cvt_pk_fp8_f32(bf_lo(wa[3]), bf_hi(wa[3]), qa1, true);
      qb0 = __builtin_amdgcn_cvt_pk_fp8_f32(bf_lo(wb[0]), bf_hi(wb[0]), qb0, false); qb0 = __builtin_amdgcn_cvt_pk_fp8_f32(bf_lo(wb[1]), bf_hi(wb[1]), qb0, true);
      qb1 = __builtin_amdgcn_cvt_pk_fp8_f32(bf_lo(wb[2]), bf_hi(wb[2]), qb1, false); qb1 = __builtin_amdgcn_cvt_pk_fp8_f32(bf_lo(wb[3]), bf_hi(wb[3]), qb1, true);
      const int ca = 1024 + lane * 8, cb = 1536 + lane * 8;
      const long tt = t;
      u32x2 va = {(unsigned)qa0, (unsigned)qa1}, vb = {(unsigned)qb0, (unsigned)qb1};
      *(u32x2*)(p.mixq() + (tt >> 1) * 4096 + (ca >> 6) * 128 + (tt & 1) * 64 + (ca & 63)) = va;
      *(u32x2*)(p.mixq() + (tt >> 1) * 4096 + (cb >> 6) * 128 + (tt & 1) * 64 + (cb & 63)) = vb;
    }
#else
    *(u32x4*)(p.mix() + (long)t * 2048 + 1024 + lane * 8) = wa;
    *(u32x4*)(p.mix() + (long)t * 2048 + 1024 + 512 + lane * 8) = wb;
#endif
  }
}
__device__ __forceinline__ void wout_tile(const Params& p, char* smem, int mt, int nt) {
  f32x16 acc[4][4];
  GemmTile t{};
  t.A = p.mix(); t.lda = 2048; t.aidx = nullptr; t.m0 = mt * 256; t.mvalid = 256;
  t.B0 = p.w_out + nt * 256; t.B1 = t.B0 + 128; t.ldb = 2048; t.nv0 = 128; t.nv1 = 128; t.kscale = nullptr; t.K = 2048;
  gemm_tile_256<4, false, false>(t, smem, acc);
  const long boff = (long)(mt * 256) * 2048 + nt * 256;
  acc_foreach_row<4>(acc, [&](int rowl, int coll, float (&v)[4]) {
    long o = boff + (long)rowl * 2048 + coll;
    OPAQUE(o);
    const float* xr = p.x + o; float* yr = p.x1() + o;
#pragma unroll
    for (int nb = 0; nb < 4; ++nb) { const int c = (nb >> 1) * 128 + (nb & 1) * 32; yr[c] = xr[c] + v[nb]; }
  });
}

#define P7_LDS_BYTES (4 * 32 * 33 * 4 + 4 * 64 * 4 + 32 * 33 * 4 + 128)
template <int DRY = 0>
__device__ __forceinline__ void ffn_prep_unit(const Params& p, char* smem, int u) {
  float* part = (float*)smem; float* ssq = part + 4 * 32 * 33; float* lg = ssq + 256; float* rs = lg + 32 * 33;
  const int tid = opaque_tid(), lane = tid & 63, wid = tid >> 6, l31 = lane & 31, hh = lane >> 5;
  __syncthreads();
  {
    const long t = (long)u * 32 + l31;
    const float* xr = p.x1() + t * 2048 + wid * 512;
    const float* gp = p.ffn_norm + wid * 512;
    const float* wp = p.router_w + (long)(wid * 512 + hh) * 32 + l31;
    f32x16 acc;
#pragma unroll
    for (int r = 0; r < 16; ++r) acc[r] = 0.f;
    float ss = 0.f;
#pragma unroll 4
    for (int m = 0; m < 128; ++m) {
      const f32x4 xv = *(const f32x4*)(xr + 4 * m);
      const f32x4 gv = *(const f32x4*)(gp + 4 * m);
      const float a0 = hh ? xv[1] : xv[0], a1 = hh ? xv[3] : xv[2];
      const float g0 = hh ? gv[1] : gv[0], g1 = hh ? gv[3] : gv[2];
      const float b0 = wp[(4 * m) * 32], b1 = wp[(4 * m + 2) * 32];
      ss += a0 * a0 + a1 * a1;
      acc = __builtin_amdgcn_mfma_f32_32x32x2f32(a0 * g0, b0, acc, 0, 0, 0);
      acc = __builtin_amdgcn_mfma_f32_32x32x2f32(a1 * g1, b1, acc, 0, 0, 0);
    }
#pragma unroll
    for (int r = 0; r < 16; ++r) part[(wid * 32 + (r & 3) + 8 * (r >> 2) + 4 * hh) * 33 + l31] = acc[r];
    ssq[wid * 64 + lane] = ss;
  }
  __syncthreads();
  {
    const int tl = tid >> 3, seg = tid & 7;
    if (seg == 0) {
      float s = 0.f;
#pragma unroll
      for (int w = 0; w < 4; ++w) s += ssq[w * 64 + tl] + ssq[w * 64 + 32 + tl];
      rs[tl] = rsqrtf(s * (1.0f / 2048.0f) + EPS_);
    }
  }
  __syncthreads();
  {
    const int tl = tid >> 3, seg = tid & 7;
    const float r = rs[tl];
#pragma unroll
    for (int c = 0; c < 4; ++c) {
      const int e = seg * 4 + c;
      const float s = part[(0 * 32 + tl) * 33 + e] + part[(1 * 32 + tl) * 33 + e] + part[(2 * 32 + tl) * 33 + e] + part[(3 * 32 + tl) * 33 + e];
      lg[tl * 33 + e] = s * r + p.router_b[e];
    }
  }
  __syncthreads();
  if (tid < 32 && !DRY) {
    const long tt = (long)u * 32 + tid;
    const float* L = lg + tid * 33;
    unsigned used = 0u; int i0 = 0, i1 = 0, i2 = 0, i3 = 0; float v0 = 0.f, v1 = 0.f, v2 = 0.f, v3 = 0.f;
#pragma unroll
    for (int k = 0; k < 4; ++k) {
      int bi = -1; float bv = 0.f;
      for (int i = 0; i < 32; ++i) {
        const float x = L[i];
        const bool take = !((used >> i) & 1u) && (bi < 0 || x > bv);
        bi = take ? i : bi; bv = take ? x : bv;
      }
      used |= 1u << bi;
      if (k == 0) { i0 = bi; v0 = bv; } else if (k == 1) { i1 = bi; v1 = bv; } else if (k == 2) { i2 = bi; v2 = bv; } else { i3 = bi; v3 = bv; }
    }
    const float e0 = 1.0f, e1 = __expf(v1 - v0), e2 = __expf(v2 - v0), e3 = __expf(v3 - v0);
    const float inv = 1.0f / (e0 + e1 + e2 + e3);
    const int s0 = atomicAdd(&p.counts()[i0], 1), s1 = atomicAdd(&p.counts()[i1], 1), s2 = atomicAdd(&p.counts()[i2], 1), s3 = atomicAdd(&p.counts()[i3], 1);
    p.list()[i0 * T_ + s0] = (int)tt; p.list()[i1 * T_ + s1] = (int)tt; p.list()[i2 * T_ + s2] = (int)tt; p.list()[i3 * T_ + s3] = (int)tt;
    p.asg_e()[tt * 4 + 0] = i0; p.asg_e()[tt * 4 + 1] = i1; p.asg_e()[tt * 4 + 2] = i2; p.asg_e()[tt * 4 + 3] = i3;
    p.asg_slot()[tt * 4 + 0] = s0; p.asg_slot()[tt * 4 + 1] = s1; p.asg_slot()[tt * 4 + 2] = s2; p.asg_slot()[tt * 4 + 3] = s3;
    p.asg_g()[tt * 4 + 0] = e0 * inv; p.asg_g()[tt * 4 + 1] = e1 * inv; p.asg_g()[tt * 4 + 2] = e2 * inv; p.asg_g()[tt * 4 + 3] = e3 * inv;
  }
  {
    const int tl = tid >> 3, seg = tid & 7;
    const long t = (long)u * 32 + tl;
    const float* xr = p.x1() + t * 2048;
    const float rr = rs[tl];
#pragma unroll 8
    for (int it = 0; it < 32; ++it) {
      const int kk = it * 64 + seg * 8;
      f32x4 v0 = *(const f32x4*)(xr + kk), v1 = *(const f32x4*)(xr + kk + 4);
      f32x4 g0 = *(const f32x4*)(p.ffn_norm + kk), g1 = *(const f32x4*)(p.ffn_norm + kk + 4);
      v0 = v0 * g0 * rr; v1 = v1 * g1 * rr;
#if MOEQ == 0
      u32x4 w = {pack_bf16(v0[0], v0[1]), pack_bf16(v0[2], v0[3]), pack_bf16(v1[0], v1[1]), pack_bf16(v1[2], v1[3])};
      *(u32x4*)(p.h2() + t * 2048 + kk) = w;
#else
      int q0 = 0, q1 = 0;
      q0 = __builtin_amdgcn_cvt_pk_fp8_f32(v0[0], v0[1], q0, false);
      q0 = __builtin_amdgcn_cvt_pk_fp8_f32(v0[2], v0[3], q0, true);
      q1 = __builtin_amdgcn_cvt_pk_fp8_f32(v1[0], v1[1], q1, false);
      q1 = __builtin_amdgcn_cvt_pk_fp8_f32(v1[2], v1[3], q1, true);
      u32x2 wq = {(unsigned)q0, (unsigned)q1};
      *(u32x2*)(p.h2q() + t * 2048 + kk) = wq;
#endif
    }
  }
}

__device__ __forceinline__ void moe_setup(const Params& p, int* mo) {
  __syncthreads();
  if (threadIdx.x == 0) {
    int s = 0;
    for (int e = 0; e < NE_; ++e) { mo[e] = s; s += (p.counts()[e] + 255) >> 8; }
    mo[NE_] = s;
  }
  __syncthreads();
}
#ifndef MAPV
#define MAPV 0
#endif
__device__ __forceinline__ int xcd_unit(int round) { return MAPV ? (round * 256 + blockIdx.x) : (round * 256 + (blockIdx.x & 7) * 32 + (blockIdx.x >> 3)); }

__device__ __forceinline__ void moe1_tile(const Params& p, char* smem, const int* mo, int e, int nt, int mt) {
  f32x16 acc[4][4];
  GemmTile t{};
  const int cnt = p.counts()[e];
  t.A = p.h2(); t.lda = 2048; t.aidx = p.list() + e * T_ + mt * 256; t.m0 = 0; t.mvalid = min(256, cnt - mt * 256);
  t.B0 = p.w_gu + (long)e * 2048 * 4096 + nt * 128; t.B1 = t.B0 + 2048; t.ldb = 4096; t.nv0 = 128; t.nv1 = 128; t.kscale = nullptr; t.K = 2048;
  gemm_tile_256<4, false, true>(t, smem, acc);
  u16* base = p.act() + (long)(mo[e] * 256 + mt * 256) * 2048 + nt * 128;
  const float* bg = p.b_gu + e * 4096 + nt * 128; const float* bu = bg + 2048;
  const int tq_ = opaque_tid(); const int cl = (tq_ >> 6 & 1) * 64 + (tq_ & 31);
  const float bgv[2] = {bg[cl], bg[cl + 32]}, buv[2] = {bu[cl], bu[cl + 32]};
  acc_foreach_row<4>(acc, [&](int rowl, int coll, float (&v)[4]) {
    u16* rp = base + (long)rowl * 2048 + coll;
    OPAQUE(rp);
#pragma unroll
    for (int nb = 0; nb < 2; ++nb) {
      const int c = nb * 32;
      float g = fminf(v[nb] + bgv[nb], 7.0f);
      float uu = fminf(fmaxf(v[nb + 2] + buv[nb], -7.0f), 7.0f);
      float a = (uu + 1.0f) * (g * __builtin_amdgcn_rcpf(1.0f + __expf(-1.702f * g)));
      rp[c] = f32_to_bf16(a);
    }
  });
}
__device__ __forceinline__ void moe2_tile(const Params& p, char* smem, const int* mo, int e, int nt, int mt) {
  f32x16 acc[4][4];
  GemmTile t{};
  t.A = p.act(); t.lda = 2048; t.aidx = nullptr; t.m0 = mo[e] * 256 + mt * 256; t.mvalid = 256;
  t.B0 = p.w_dn + (long)e * 2048 * 2048 + nt * 256; t.B1 = t.B0 + 128; t.ldb = 2048; t.nv0 = 128; t.nv1 = 128; t.kscale = nullptr; t.K = 2048;
  gemm_tile_256<4, false, false>(t, smem, acc);
  u16* base = p.ybuf() + (long)t.m0 * 2048 + nt * 256;
  const float* bd = p.b_dn + e * 2048 + nt * 256;
  const int tq_ = opaque_tid(); const int cl = (tq_ >> 6 & 1) * 64 + (tq_ & 31);
  const float bdv[4] = {bd[cl], bd[cl + 32], bd[cl + 128], bd[cl + 160]};
  acc_foreach_row<4>(acc, [&](int rowl, int coll, float (&v)[4]) {
    u16* rp = base + (long)rowl * 2048 + coll;
    OPAQUE(rp);
#pragma unroll
    for (int nb = 0; nb < 4; ++nb) { const int c = (nb >> 1) * 128 + (nb & 1) * 32; rp[c] = f32_to_bf16(v[nb] + bdv[nb]); }
  });
}
template <int WHICH, int HALF = 0>
__device__ __forceinline__ void ph_moe(const Params& p, char* smem) {
  int* mo = (int*)(smem + G_LDS_BYTES);
  moe_setup(p, mo);
  const int NT = (WHICH == 1) ? 16 : 8;
  const int total = mo[NE_] * NT;
  if (HALF && ((blockIdx.x >> 3) & 1)) return;
  const int W = HALF ? 128 : 256;
  for (int round = 0;; ++round) {
    const int u = HALF ? (round * 128 + (blockIdx.x & 7) * 16 + (blockIdx.x >> 4)) : xcd_unit(round);
    if (round * W >= total) break;
    if (u >= total) continue;
    int e = 0;
    while (mo[e + 1] * NT <= u) ++e;
    const int local = u - mo[e] * NT, me = mo[e + 1] - mo[e];
    const int nt = local / me, mt = local - nt * me;
    if (WHICH == 1) moe1_tile(p, smem, mo, e, nt, mt); else moe2_tile(p, smem, mo, e, nt, mt);
  }
}

__device__ __forceinline__ void ph_final(const Params& p, char* smem, float dbg_scale = 1.0f) {
  int* mo = (int*)(smem + G_LDS_BYTES);
  moe_setup(p, mo);
  const int tid_ = opaque_tid(); const int lane = tid_ & 63, wid = tid_ >> 6;
  for (int t = blockIdx.x * 4 + wid; t < T_; t += gridDim.x * 4) {
    long rows[4]; float gg[4];
#pragma unroll
    for (int k = 0; k < 4; ++k) { rows[k] = (long)(mo[p.asg_e()[t * 4 + k]] * 256 + p.asg_slot()[t * 4 + k]) * 2048; gg[k] = p.asg_g()[t * 4 + k]; }
    f32x4 v[8]; float ss = 0.f;
#pragma unroll
    for (int j = 0; j < 8; ++j) {
      const int c = j * 256 + lane * 4;
      f32x4 a = __builtin_nontemporal_load((const f32x4*)(p.x1() + (long)t * 2048 + c));
#pragma unroll
      for (int k = 0; k < 4; ++k) {
        u32x2 w = __builtin_nontemporal_load((const u32x2*)(p.ybuf() + rows[k] + c));
        a[0] += gg[k] * bf_lo(w[0]); a[1] += gg[k] * bf_hi(w[0]); a[2] += gg[k] * bf_lo(w[1]); a[3] += gg[k] * bf_hi(w[1]);
      }
      v[j] = a; ss += a[0] * a[0] + a[1] * a[1] + a[2] * a[2] + a[3] * a[3];
    }
    ss = wave_sum(ss);
    const float r = rsqrtf(ss * (1.0f / 2048.0f) + EPS_);
#pragma unroll
    for (int j = 0; j < 8; ++j) {
      const int c = j * 256 + lane * 4;
      f32x4 g = *(const f32x4*)(p.final_norm + c);
      f32x4 o = {v[j][0] * r * g[0] * dbg_scale, v[j][1] * r * g[1] * dbg_scale, v[j][2] * r * g[2] * dbg_scale, v[j][3] * r * g[3] * dbg_scale};
      __builtin_nontemporal_store(o, (f32x4*)(p.out + (long)t * 2048 + c));
    }
  }
}

__device__ __forceinline__ CvtUnit cvt8_decode(const Params& p, int u) {
  CvtUnit c;
  if (u < 16384) {
    const int e = u >> 9, kb = (u >> 4) & 31, nt = u & 15;
    c.src = p.w_gu + (long)e * 2048 * 4096 + (long)(kb * 64) * 4096 + nt * 256; c.ldn = 4096;
    c.dst = p.wq_gu() + ((long)e * 4096 + nt * 256) * 2048 + kb * 128;
  } else {
    const int v = u - 16384; const int e = v >> 8, kb = (v >> 3) & 31, nt = v & 7;
    c.src = p.w_dn + (long)e * 2048 * 2048 + (long)(kb * 64) * 2048 + nt * 256; c.ldn = 2048;
    c.dst = p.wq_dn() + ((long)e * 2048 + nt * 256) * 2048 + kb * 128;
  }
  return c;
}
__device__ __forceinline__ void cvt8_load(const CvtUnit& c, int w, int lane, f32x4 (&v)[16]) {
  const float* src = c.src + (long)(w * 16) * c.ldn + lane * 4;
#pragma unroll
  for (int j = 0; j < 16; ++j) {
    const float* ptr = src + (long)j * c.ldn;
    asm volatile("global_load_dwordx4 %0, %1, off nt" : "=v"(v[j]) : "v"(ptr) : "memory");
  }
}
#define CVT_WAIT(N, v) asm volatile("s_waitcnt vmcnt(%16)" : "+v"(v[0]), "+v"(v[1]), "+v"(v[2]), "+v"(v[3]), "+v"(v[4]), "+v"(v[5]), "+v"(v[6]), "+v"(v[7]), \
    "+v"(v[8]), "+v"(v[9]), "+v"(v[10]), "+v"(v[11]), "+v"(v[12]), "+v"(v[13]), "+v"(v[14]), "+v"(v[15]) : "n"(N) : "memory")
__device__ __forceinline__ void cvt8_emit(const CvtUnit& c, int tid, int w, int lane, f32x4 (&v)[16], char* T) {
  __syncthreads();
#pragma unroll
  for (int cc = 0; cc < 4; ++cc) {
    u32x4 x4;
#pragma unroll
    for (int q = 0; q < 4; ++q) {
      int x = 0;
      x = __builtin_amdgcn_cvt_pk_fp8_f32(v[4 * q][cc] * WSCALE_, v[4 * q + 1][cc] * WSCALE_, x, false);
      x = __builtin_amdgcn_cvt_pk_fp8_f32(v[4 * q + 2][cc] * WSCALE_, v[4 * q + 3][cc] * WSCALE_, x, true);
      x4[q] = (unsigned)x;
    }
    *(u32x4*)(T + (lane * 4 + cc) * 64 + w * 16) = x4;
  }
  __syncthreads();
#pragma unroll
  for (int i = 0; i < 4; ++i) {
    const int n = (tid >> 2) + 64 * i, ch = tid & 3;
    __builtin_nontemporal_store(*(const u32x4*)(T + n * 64 + ch * 16), (u32x4*)(c.dst + (long)(n >> 1) * 4096 + (n & 1) * 64 + ch * 16));
  }
}
__device__ __forceinline__ void convert_units(const Params& p, char* smem, int first, int stride, int count) {
  const int tid = opaque_tid();
  const int w = tid >> 6, lane = tid & 63;
  if (count <= 0) return;
  f32x4 va[16], vb[16], vc[16];
  CvtUnit ca = cvt8_decode(p, first), cb = cvt8_decode(p, first + stride), cc = cvt8_decode(p, first + 2 * stride);
  cvt8_load(ca, w, lane, va);
  cvt8_load(cb, w, lane, vb);
  cvt8_load(cc, w, lane, vc);
  CVT_WAIT(32, va); cvt8_emit(ca, tid, w, lane, va, smem); ca = cvt8_decode(p, first + 3 * stride); cvt8_load(ca, w, lane, va);
  CVT_WAIT(36, vb); cvt8_emit(cb, tid, w, lane, vb, smem); cb = cvt8_decode(p, first + 4 * stride); cvt8_load(cb, w, lane, vb);
  CVT_WAIT(40, vc); cvt8_emit(cc, tid, w, lane, vc, smem); cc = cvt8_decode(p, first + 5 * stride); cvt8_load(cc, w, lane, vc);
  for (int i = 3; i + 3 < count; i += 3) {
    CVT_WAIT(40, va); cvt8_emit(ca, tid, w, lane, va, smem); ca = cvt8_decode(p, first + (i + 3) * stride); cvt8_load(ca, w, lane, va);
    CVT_WAIT(40, vb); cvt8_emit(cb, tid, w, lane, vb, smem); cb = cvt8_decode(p, first + (i + 4) * stride); cvt8_load(cb, w, lane, vb);
    CVT_WAIT(40, vc); cvt8_emit(cc, tid, w, lane, vc, smem); cc = cvt8_decode(p, first + (i + 5) * stride); cvt8_load(cc, w, lane, vc);
  }
  CVT_WAIT(0, va); cvt8_emit(ca, tid, w, lane, va, smem);
  CVT_WAIT(0, vb); cvt8_emit(cb, tid, w, lane, vb, smem);
  CVT_WAIT(0, vc); cvt8_emit(cc, tid, w, lane, vc, smem);
}
__device__ __forceinline__ void convert_one(const Params& p, char* smem, int u) {
  const int tid = opaque_tid();
  const int w = tid >> 6, lane = tid & 63;
  f32x4 va[16];
  CvtUnit ca = cvt8_decode(p, u);
  cvt8_load(ca, w, lane, va);
  CVT_WAIT(0, va); cvt8_emit(ca, tid, w, lane, va, smem);
}
__device__ __forceinline__ void ph_convert(const Params& p, char* smem) {
  convert_units(p, smem, blockIdx.x, gridDim.x, 24576 / 256);
}
__device__ __forceinline__ void ph_convert_gu(const Params& p, char* smem, int part, int nparts) {
  if (nparts == 1) {
    convert_units(p, smem, blockIdx.x, 256, 63);
    convert_one(p, smem, blockIdx.x + 63 * 256);
  } else if (part == 0) {
    convert_units(p, smem, blockIdx.x, 256, 33);
  } else {
    convert_units(p, smem, blockIdx.x + 33 * 256, 256, 30);
    convert_one(p, smem, blockIdx.x + 63 * 256);
  }
}
__device__ __forceinline__ void ph_convert_dn(const Params& p, char* smem) {
  convert_units(p, smem, 16384 + blockIdx.x, 256, 30);
  convert_one(p, smem, 16384 + blockIdx.x + 30 * 256);
  convert_one(p, smem, 16384 + blockIdx.x + 31 * 256);
}

#define R_STAGE 32768
struct GemmRTile {
  const u8* A; int lda; const int* aidx; int m0, mvalid;
  const u8* B; long brow0, brow1; int ldb;
  int pairb;
  int paira;
  int KB;
  int pa0, pan, pb0, pbn;
};
#ifndef PFD
#define PFD 8
#endif
template <bool FP8, bool GATHER, bool PF = false>
__device__ __forceinline__ void gemmr_tile_256(const GemmRTile& t, char* smem, f32x16 (&acc)[4][4]) {
  int tz0 = threadIdx.x; asm volatile("" : "+v"(tz0));
  const int tid = tz0, lane = tid & 63, wid = tid >> 6, wr = wid >> 1, wc = wid & 1;
  const int l31 = lane & 31, hh = lane >> 5;
#pragma unroll
  for (int i = 0; i < 4; ++i)
#pragma unroll
    for (int j = 0; j < 4; ++j)
#pragma unroll
      for (int r = 0; r < 16; ++r) acc[i][j][r] = 0.f;
  const int c_src = (tid & 3) ^ ((tid >> 4) & 3);
  const u8* a_src[GATHER ? 4 : 1];
  if (GATHER) {
#pragma unroll
    for (int i = 0; i < (GATHER ? 4 : 1); ++i) {
      int r = (tid >> 2) + 64 * i;
      int rr = r < t.mvalid ? r : 0;
      a_src[i] = t.A + (long)t.aidx[rr] * t.lda + c_src * 16;
    }
  } else {
    a_src[0] = t.A + (long)(t.m0 + (tid >> 2)) * t.lda + c_src * 16;
  }
  const long a_step = 64L * t.lda, b_step = 64L * t.ldb;
  const u8* b_src0 = t.B + (t.brow0 + (tid >> 2)) * t.ldb + c_src * 16;
  const u8* b_src1 = t.B + (t.brow1 + (tid >> 2)) * t.ldb + c_src * 16;
  const unsigned lds0 = (unsigned)(size_t)smem + (unsigned)__builtin_amdgcn_readfirstlane(wid) * 1024u;
  const u8* pf_src = nullptr; int pf_par = 0;
  const unsigned pf_lds = (unsigned)(size_t)smem + 131072u + 4096u + (unsigned)__builtin_amdgcn_readfirstlane(wid) * 256u;
  const int pf_ncol = t.KB >> 7;
  if (PF) {
    if (lane < 32) { const int n = t.pan >> 3; const int r = t.pa0 + wid * n + (lane & (n - 1)); pf_src = t.A + (long)(t.m0 + r) * t.lda; pf_par = (t.pan >> 1) * t.lda; }
    else { const int n = t.pbn >> 3; const int r = t.pb0 + wid * n + (lane & (n - 1)); pf_src = t.B + (r < 128 ? t.brow0 + r : t.brow1 + r - 128) * t.ldb; pf_par = (t.pbn >> 1) * t.ldb; }
  }
  auto pf_issue = [&](int kt) {
    if (PF) { const int col = min((kt >> 1) + PFD / 2, pf_ncol - 1); glds4_asm((const void*)(pf_src + ((kt & 1) ? pf_par : 0) + col * 128), pf_lds); }
  };
  auto issue = [&](int kt, int sl, int q) {
    if (q < 4) glds16_asm((const void*)((GATHER ? a_src[GATHER ? q : 0] : a_src[0] + q * a_step) + kt * 64), lds0 + sl * R_STAGE + q * 4096);
    else { const int i = q - 4; glds16_asm((const void*)((i < 2 ? b_src0 + i * b_step : b_src1 + (i - 2) * b_step) + kt * 64), lds0 + sl * R_STAGE + 16384 + i * 4096); }
  };
  unsigned a_rd[2], b_rd[2];
#pragma unroll
  for (int s2 = 0; s2 < 2; ++s2) {
    const int ra = wr * 128 + l31, rb = wc * 64 + l31;
    a_rd[s2] = ra * 64 + (((2 * s2 + hh) ^ ((ra >> 2) & 3)) * 16);
    b_rd[s2] = rb * 64 + (((2 * s2 + hh) ^ ((rb >> 2) & 3)) * 16);
  }
  auto load_frags = [&](const char* St, int s2, u32x4 (&af)[4], u32x4 (&bf)[4]) {
#pragma unroll
    for (int mb = 0; mb < 4; ++mb) af[mb] = *(const u32x4*)(St + a_rd[s2] + mb * 2048);
#pragma unroll
    for (int nb = 0; nb < 4; ++nb) bf[nb] = *(const u32x4*)(St + 16384 + b_rd[s2] + (nb >> 1) * 8192 + (nb & 1) * 2048);
  };
  auto mma = [&](u32x4 (&ac)[4], u32x4 (&bc)[4], int nb) {
    if (FP8) {
#pragma unroll
      for (int u = 0; u < 2; ++u) {
        const long bl = (long)(((unsigned long long)bc[nb][2 * u + 1] << 32) | bc[nb][2 * u]);
#pragma unroll
        for (int mb = 0; mb < 4; ++mb) {
          const long al = (long)(((unsigned long long)ac[mb][2 * u + 1] << 32) | ac[mb][2 * u]);
          acc[mb][nb] = __builtin_amdgcn_mfma_f32_32x32x16_fp8_fp8(al, bl, acc[mb][nb], 0, 0, 0);
        }
      }
    } else {
      const bf16x8 bb = *(const bf16x8*)&bc[nb];
#pragma unroll
      for (int mb = 0; mb < 4; ++mb) acc[mb][nb] = __builtin_amdgcn_mfma_f32_32x32x16_bf16(*(const bf16x8*)&ac[mb], bb, acc[mb][nb], 0, 0, 0);
    }
  };
  u32x4 a0[4], b0[4], a1[4], b1[4];
  auto half0 = [&](int kt, bool issueA) {
    const char* St = smem + (kt & 3) * R_STAGE;
    load_frags(St, 1, a1, b1);
    __builtin_amdgcn_sched_barrier(0);
#pragma unroll
    for (int nb = 0; nb < 4; ++nb) {
      mma(a0, b0, nb);
      __builtin_amdgcn_sched_barrier(0);
      if (issueA) issue(kt + 2, (kt + 2) & 3, 4 + nb);
      __builtin_amdgcn_sched_barrier(0);
    }
  };
  auto half1 = [&](int kt, bool has1, bool issueB) {
    const char* Sn = smem + ((kt + 1) & 3) * R_STAGE;
    if (has1) load_frags(Sn, 0, a0, b0);
    __builtin_amdgcn_sched_barrier(0);
#pragma unroll
    for (int nb = 0; nb < 4; ++nb) {
      mma(a1, b1, nb);
      __builtin_amdgcn_sched_barrier(0);
      if (issueB) issue(kt + 3, (kt + 3) & 3, nb);
      if (issueB && nb == 3) pf_issue(kt + 1);
      __builtin_amdgcn_sched_barrier(0);
    }
  };
  const int nk = t.KB >> 6;
  __syncthreads();
#pragma unroll
  for (int q = 0; q < 8; ++q) issue(0, 0, q);
#pragma unroll
  for (int q = 0; q < 8; ++q) issue(1, 1, q);
#pragma unroll
  for (int q = 0; q < 4; ++q) issue(2, 2, q);
  pf_issue(0);
  if (PF) asm volatile("s_waitcnt vmcnt(13)" ::: "memory"); else
  asm volatile("s_waitcnt vmcnt(12)" ::: "memory");
  __syncthreads();
  load_frags(smem, 0, a0, b0);
#pragma nounroll
  for (int kt = 0; kt < nk - 3; ++kt) {
    half0(kt, true);
    if (PF) asm volatile("s_waitcnt vmcnt(9)" ::: "memory"); else
    asm volatile("s_waitcnt vmcnt(8)" ::: "memory");
    __syncthreads();
    half1(kt, true, true);
  }
  half0(nk - 3, true);
  if (PF) asm volatile("s_waitcnt vmcnt(9)" ::: "memory"); else
  asm volatile("s_waitcnt vmcnt(8)" ::: "memory");
  __syncthreads();
  half1(nk - 3, true, false);
  half0(nk - 2, false);
  asm volatile("s_waitcnt vmcnt(0)" ::: "memory");
  __syncthreads();
  half1(nk - 2, true, false);
  half0(nk - 1, false);
  half1(nk - 1, false, false);
}


__device__ __forceinline__ void gemmr16_tile_256(const GemmRTile& t, char* smem, f32x4 (&acc)[8][8]) {
  int tz0 = threadIdx.x; asm volatile("" : "+v"(tz0));
  const int tid = tz0, lane = tid & 63, wid = tid >> 6, wr = wid >> 1, wc = wid & 1;
  const int r15 = lane & 15, kq = lane >> 4;
#pragma unroll
  for (int i = 0; i < 8; ++i)
#pragma unroll
    for (int j = 0; j < 8; ++j) acc[i][j] = (f32x4){0.f, 0.f, 0.f, 0.f};
  const int c_src = (tid & 3) ^ ((tid >> 4) & 3);
  const u8* a_src = t.A + (long)(t.m0 + (tid >> 2)) * t.lda + c_src * 16;
  const long a_step = 64L * t.lda, b_step = 64L * t.ldb;
  const u8* b_src0 = t.B + (t.brow0 + (tid >> 2)) * t.ldb + c_src * 16;
  const u8* b_src1 = t.B + (t.brow1 + (tid >> 2)) * t.ldb + c_src * 16;
  const unsigned lds0 = (unsigned)(size_t)smem + (unsigned)__builtin_amdgcn_readfirstlane(wid) * 1024u;
  auto issue = [&](int kt, int sl, int q) {
    if (q < 4) glds16_asm((const void*)(a_src + q * a_step + kt * 64), lds0 + sl * R_STAGE + q * 4096);
    else { const int i = q - 4; glds16_asm((const void*)((i < 2 ? b_src0 + i * b_step : b_src1 + (i - 2) * b_step) + kt * 64), lds0 + sl * R_STAGE + 16384 + i * 4096); }
  };
  const int ra = wr * 128 + r15, rb = wc * 64 + r15;
  const unsigned a_rd = ra * 64 + ((kq ^ ((ra >> 2) & 3)) * 16);
  const unsigned b_rd = 16384 + rb * 64 + ((kq ^ ((rb >> 2) & 3)) * 16);
  auto load_a = [&](const char* St, u32x4 (&af)[8]) {
#pragma unroll
    for (int mb = 0; mb < 8; ++mb) af[mb] = *(const u32x4*)(St + a_rd + mb * 1024);
  };
  auto load_b = [&](const char* St, int img, u32x4 (&bf)[4]) {
#pragma unroll
    for (int j = 0; j < 4; ++j) bf[j] = *(const u32x4*)(St + b_rd + img * 8192 + j * 1024);
  };
  u32x4 aF[8], b0[4], b1[4];
  auto half0 = [&](int kt, bool issueA) {
    const char* St = smem + (kt & 3) * R_STAGE;
    load_b(St, 1, b1);
    __builtin_amdgcn_sched_barrier(0);
#pragma unroll
    for (int mb = 0; mb < 8; ++mb) {
#pragma unroll
      for (int nb = 0; nb < 4; ++nb) asm volatile("v_mfma_f32_16x16x32_bf16 %0, %1, %2, %0" : "+a"(acc[mb][nb]) : "v"(aF[mb]), "v"(b0[nb]));
      __builtin_amdgcn_sched_barrier(0);
      if (issueA && (mb & 1)) issue(kt + 2, (kt + 2) & 3, 4 + (mb >> 1));
      __builtin_amdgcn_sched_barrier(0);
    }
  };
  auto half1 = [&](int kt, bool has1, bool issueB) {
    const char* Sn = smem + ((kt + 1) & 3) * R_STAGE;
    if (has1) load_b(Sn, 0, b0);
    __builtin_amdgcn_sched_barrier(0);
#pragma unroll
    for (int mb = 0; mb < 8; ++mb) {
#pragma unroll
      for (int nb = 0; nb < 4; ++nb) asm volatile("v_mfma_f32_16x16x32_bf16 %0, %1, %2, %0" : "+a"(acc[mb][4 + nb]) : "v"(aF[mb]), "v"(b1[nb]));
      __builtin_amdgcn_sched_barrier(0);
      if (has1) aF[mb] = *(const u32x4*)(Sn + a_rd + mb * 1024);
      if (issueB && (mb & 1)) issue(kt + 3, (kt + 3) & 3, mb >> 1);
      __builtin_amdgcn_sched_barrier(0);
    }
  };
  const int nk = t.KB >> 6;
  __syncthreads();
#pragma unroll
  for (int q = 0; q < 8; ++q) issue(0, 0, q);
#pragma unroll
  for (int q = 0; q < 8; ++q) issue(1, 1, q);
#pragma unroll
  for (int q = 0; q < 4; ++q) issue(2, 2, q);
  asm volatile("s_waitcnt vmcnt(12)" ::: "memory");
  __syncthreads();
  load_a(smem, aF); load_b(smem, 0, b0);
  for (int kt = 0; kt < nk - 3; ++kt) {
    half0(kt, true);
    asm volatile("s_waitcnt vmcnt(8)" ::: "memory"); __syncthreads();
    half1(kt, true, true);
  }
  half0(nk - 3, true);
  asm volatile("s_waitcnt vmcnt(8)" ::: "memory"); __syncthreads();
  half1(nk - 3, true, false);
  half0(nk - 2, false);
  asm volatile("s_waitcnt vmcnt(0)" ::: "memory"); __syncthreads();
  half1(nk - 2, true, false);
  half0(nk - 1, false);
  half1(nk - 1, false, false);
  asm volatile("s_nop 15\n\ts_nop 15" ::: "memory");
#pragma unroll
  for (int mb = 0; mb < 8; ++mb)
    asm volatile("" : "+a"(acc[mb][0]), "+a"(acc[mb][1]), "+a"(acc[mb][2]), "+a"(acc[mb][3]), "+a"(acc[mb][4]), "+a"(acc[mb][5]), "+a"(acc[mb][6]), "+a"(acc[mb][7]));
}

typedef int i32x8 __attribute__((ext_vector_type(8)));
template <bool GATHER>
__device__ __forceinline__ void gemmrs_tile_256(const GemmRTile& t, char* smem, f32x16 (&acc)[4][4]) {
  int tz0 = threadIdx.x; asm volatile("" : "+v"(tz0));
  const int tid = tz0, lane = tid & 63, wid = tid >> 6, wr = wid >> 1, wc = wid & 1;
  const int l31 = lane & 31, hh = lane >> 5;
#pragma unroll
  for (int i = 0; i < 4; ++i)
#pragma unroll
    for (int j = 0; j < 4; ++j)
#pragma unroll
      for (int r = 0; r < 16; ++r) acc[i][j][r] = 0.f;
  const int c_src = (tid & 3) ^ ((tid >> 4) & 3);
  const u8* a_src[GATHER ? 4 : 1];
  if (GATHER) {
#pragma unroll
    for (int i = 0; i < (GATHER ? 4 : 1); ++i) {
      int r = (tid >> 2) + 64 * i;
      int rr = r < t.mvalid ? r : 0;
      a_src[i] = t.A + (long)t.aidx[rr] * t.lda + c_src * 16;
    }
  } else {
    a_src[0] = t.A + ((long)(t.m0 + (tid >> 2)) >> 1) * 4096 + ((tid >> 2) & 1) * 64 + c_src * 16;
  }
  const long a_step = GATHER ? 64L * t.lda : 32L * 4096, b_step = 32L * 4096;
  const int a_kstep = GATHER ? 64 : 128;
  const int brl = tid >> 2;
  const u8* b_src0 = t.B + ((t.brow0 + brl) >> 1) * 4096 + (brl & 1) * 64 + c_src * 16;
  const u8* b_src1 = t.B + ((t.brow1 + brl) >> 1) * 4096 + (brl & 1) * 64 + c_src * 16;
  const unsigned lds0 = (unsigned)(size_t)smem + (unsigned)__builtin_amdgcn_readfirstlane(wid) * 1024u;
  auto issue = [&](int kt, int sl, int q) {
    if (q < 4) { if (ANT) glds16_asm_nt((const void*)((GATHER ? a_src[GATHER ? q : 0] : a_src[0] + q * a_step) + kt * a_kstep), lds0 + sl * R_STAGE + q * 4096);
                 else glds16_asm((const void*)((GATHER ? a_src[GATHER ? q : 0] : a_src[0] + q * a_step) + kt * a_kstep), lds0 + sl * R_STAGE + q * 4096); }
    else { const int i = q - 4;
      if (BNT) glds16_asm_nt((const void*)((i < 2 ? b_src0 + i * b_step : b_src1 + (i - 2) * b_step) + kt * 128), lds0 + sl * R_STAGE + 16384 + i * 4096);
      else glds16_asm((const void*)((i < 2 ? b_src0 + i * b_step : b_src1 + (i - 2) * b_step) + kt * 128), lds0 + sl * R_STAGE + 16384 + i * 4096); }
  };
  unsigned a_rd[2], b_rd[2];
#pragma unroll
  for (int c = 0; c < 2; ++c) {
    const int ra = wr * 128 + l31, rb = wc * 64 + l31;
    a_rd[c] = ra * 64 + (((2 * hh + c) ^ ((ra >> 2) & 3)) * 16);
    b_rd[c] = rb * 64 + (((2 * hh + c) ^ ((rb >> 2) & 3)) * 16);
  }
  auto load_a = [&](const char* St, i32x8 (&af)[4]) {
#pragma unroll
    for (int mb = 0; mb < 4; ++mb) {
      const u32x4 lo = *(const u32x4*)(St + a_rd[0] + mb * 2048), hi = *(const u32x4*)(St + a_rd[1] + mb * 2048);
      af[mb] = (i32x8){(int)lo[0], (int)lo[1], (int)lo[2], (int)lo[3], (int)hi[0], (int)hi[1], (int)hi[2], (int)hi[3]};
    }
  };
  auto load_b = [&](const char* St, int nb, i32x8& bf) {
    const char* bp = St + 16384 + (nb >> 1) * 8192 + (nb & 1) * 2048;
    const u32x4 lo = *(const u32x4*)(bp + b_rd[0]), hi = *(const u32x4*)(bp + b_rd[1]);
    bf = (i32x8){(int)lo[0], (int)lo[1], (int)lo[2], (int)lo[3], (int)hi[0], (int)hi[1], (int)hi[2], (int)hi[3]};
  };
  auto mma4 = [&](i32x8 (&af)[4], i32x8& bf, int nb) {
#pragma unroll
    for (int mb = 0; mb < 4; ++mb)
      acc[mb][nb] = __builtin_amdgcn_mfma_scale_f32_32x32x64_f8f6f4(af[mb], bf, acc[mb][nb], 0, 0, 0, 0x7f7f7f7f, 0, 0x7f7f7f7f);
  };
  i32x8 aA[4], aB[4], bq[4];
  auto half0 = [&](int kt, i32x8 (&ac)[4], bool issueA) {
    const char* St = smem + (kt & 3) * R_STAGE;
    load_b(St, 2, bq[2]); load_b(St, 3, bq[3]);
    __builtin_amdgcn_sched_barrier(0);
#pragma unroll
    for (int nb = 0; nb < 2; ++nb) {
      mma4(ac, bq[nb], nb);
      __builtin_amdgcn_sched_barrier(0);
      if (issueA) { issue(kt + 2, (kt + 2) & 3, 4 + 2 * nb); issue(kt + 2, (kt + 2) & 3, 5 + 2 * nb); }
      __builtin_amdgcn_sched_barrier(0);
    }
  };
  auto half1 = [&](int kt, i32x8 (&ac)[4], i32x8 (&an)[4], bool has1, bool issueB) {
    const char* Sn = smem + ((kt + 1) & 3) * R_STAGE;
    if (has1) { load_a(Sn, an); load_b(Sn, 0, bq[0]); load_b(Sn, 1, bq[1]); }
    __builtin_amdgcn_sched_barrier(0);
#pragma unroll
    for (int nb = 2; nb < 4; ++nb) {
      mma4(ac, bq[nb], nb);
      __builtin_amdgcn_sched_barrier(0);
      if (issueB) { issue(kt + 3, (kt + 3) & 3, 2 * (nb - 2)); issue(kt + 3, (kt + 3) & 3, 2 * (nb - 2) + 1); }
      __builtin_amdgcn_sched_barrier(0);
    }
  };
  const int nk = t.KB >> 6;
  __syncthreads();
#pragma unroll
  for (int q = 0; q < 8; ++q) issue(0, 0, q);
#pragma unroll
  for (int q = 0; q < 8; ++q) issue(1, 1, q);
#pragma unroll
  for (int q = 0; q < 4; ++q) issue(2, 2, q);
  asm volatile("s_waitcnt vmcnt(12)" ::: "memory");
  __syncthreads();
  load_a(smem, aA); load_b(smem, 0, bq[0]); load_b(smem, 1, bq[1]);
  for (int kt = 0; kt < nk - 4; kt += 2) {
    half0(kt, aA, true);
    asm volatile("s_waitcnt vmcnt(8)" ::: "memory"); __syncthreads();
    half1(kt, aA, aB, true, true);
    half0(kt + 1, aB, true);
    asm volatile("s_waitcnt vmcnt(8)" ::: "memory"); __syncthreads();
    half1(kt + 1, aB, aA, true, true);
  }
  half0(nk - 4, aA, true);
  asm volatile("s_waitcnt vmcnt(8)" ::: "memory"); __syncthreads();
  half1(nk - 4, aA, aB, true, true);
  half0(nk - 3, aB, true);
  asm volatile("s_waitcnt vmcnt(8)" ::: "memory"); __syncthreads();
  half1(nk - 3, aB, aA, true, false);
  half0(nk - 2, aA, false);
  asm volatile("s_waitcnt vmcnt(0)" ::: "memory"); __syncthreads();
  half1(nk - 2, aA, aB, true, false);
  half0(nk - 1, aB, false);
  half1(nk - 1, aB, aA, false, false);
}

template <bool GATHER>
__device__ __forceinline__ void gemmrv_tile_256(const GemmRTile& t, char* smem, f32x16 (&acc)[4][4]) {
  int tz0 = threadIdx.x; asm volatile("" : "+v"(tz0));
  const int tid = tz0, lane = tid & 63, wid = tid >> 6, wr = wid >> 1, wc = wid & 1;
  const int l31 = lane & 31, hh = lane >> 5;
#pragma unroll
  for (int i = 0; i < 4; ++i)
#pragma unroll
    for (int j = 0; j < 4; ++j)
#pragma unroll
      for (int r = 0; r < 16; ++r) acc[i][j][r] = 0.f;
  const int c_src = (tid & 3) ^ ((tid >> 4) & 3);
  const u8* a_src[GATHER ? 4 : 1];
  if (GATHER) {
#pragma unroll
    for (int i = 0; i < (GATHER ? 4 : 1); ++i) {
      int r = (tid >> 2) + 64 * i;
      int rr = r < t.mvalid ? r : 0;
      a_src[i] = t.A + (long)t.aidx[rr] * t.lda + c_src * 16;
    }
  } else {
    a_src[0] = t.A + ((long)(t.m0 + (tid >> 2)) >> 1) * 4096 + ((tid >> 2) & 1) * 64 + c_src * 16;
  }
  const long a_step = GATHER ? 64L * t.lda : 32L * 4096, b_step = 32L * 4096;
  const int a_kstep = GATHER ? 64 : 128;
  const int brl = tid >> 2;
  const u8* b_src0 = t.B + ((t.brow0 + brl) >> 1) * 4096 + (brl & 1) * 64 + c_src * 16;
  const u8* b_src1 = t.B + ((t.brow1 + brl) >> 1) * 4096 + (brl & 1) * 64 + c_src * 16;
  u32x4 rs0[8], rs1[8];
  auto ldg = [&](int kt, int q, u32x4& dst) {
    const u8* ptr = (q < 4) ? ((GATHER ? a_src[GATHER ? q : 0] : a_src[0] + q * a_step) + kt * a_kstep)
                            : (((q - 4) < 2 ? b_src0 + (q - 4) * b_step : b_src1 + (q - 6) * b_step) + kt * 128);
    asm volatile("global_load_dwordx4 %0, %1, off" : "=v"(dst) : "v"(ptr) : "memory");
  };
  auto stw = [&](int sl, int q, const u32x4& src) {
    *(u32x4*)(smem + sl * R_STAGE + (q < 4 ? q * 4096 : 16384 + (q - 4) * 4096) + tid * 16) = src;
  };
#define RV_WAIT(N, r) asm volatile("s_waitcnt vmcnt(%8)" : "+v"(r[0]), "+v"(r[1]), "+v"(r[2]), "+v"(r[3]), "+v"(r[4]), "+v"(r[5]), "+v"(r[6]), "+v"(r[7]) : "n"(N) : "memory")
  unsigned a_rd[2], b_rd[2];
#pragma unroll
  for (int c = 0; c < 2; ++c) {
    const int ra = wr * 128 + l31, rb = wc * 64 + l31;
    a_rd[c] = ra * 64 + (((2 * hh + c) ^ ((ra >> 2) & 3)) * 16);
    b_rd[c] = rb * 64 + (((2 * hh + c) ^ ((rb >> 2) & 3)) * 16);
  }
  auto load_a = [&](const char* St, i32x8 (&af)[4]) {
#pragma unroll
    for (int mb = 0; mb < 4; ++mb) {
      const u32x4 lo = *(const u32x4*)(St + a_rd[0] + mb * 2048), hi = *(const u32x4*)(St + a_rd[1] + mb * 2048);
      af[mb] = (i32x8){(int)lo[0], (int)lo[1], (int)lo[2], (int)lo[3], (int)hi[0], (int)hi[1], (int)hi[2], (int)hi[3]};
    }
  };
  auto load_b = [&](const char* St, int nb, i32x8& bf) {
    const char* bp = St + 16384 + (nb >> 1) * 8192 + (nb & 1) * 2048;
    const u32x4 lo = *(const u32x4*)(bp + b_rd[0]), hi = *(const u32x4*)(bp + b_rd[1]);
    bf = (i32x8){(int)lo[0], (int)lo[1], (int)lo[2], (int)lo[3], (int)hi[0], (int)hi[1], (int)hi[2], (int)hi[3]};
  };
  auto mma4 = [&](i32x8 (&af)[4], i32x8& bf, int nb) {
#pragma unroll
    for (int mb = 0; mb < 4; ++mb)
      acc[mb][nb] = __builtin_amdgcn_mfma_scale_f32_32x32x64_f8f6f4(af[mb], bf, acc[mb][nb], 0, 0, 0, 0x7f7f7f7f, 0, 0x7f7f7f7f);
  };
  i32x8 aA[4], aB[4], bq[4];
  auto half0 = [&](int kt, i32x8 (&ac)[4]) {
    const char* St = smem + (kt & 1) * R_STAGE;
    load_b(St, 2, bq[2]); load_b(St, 3, bq[3]);
    __builtin_amdgcn_sched_barrier(0);
    mma4(ac, bq[0], 0);
    __builtin_amdgcn_sched_barrier(0);
    mma4(ac, bq[1], 1);
    __builtin_amdgcn_sched_barrier(0);
  };
  auto commit = [&](int kt, u32x4 (&rn)[8], auto wtag, bool has1, bool has3) {
    constexpr int W = decltype(wtag)::value;
    if (has1) {
      RV_WAIT(W, rn);
#pragma unroll
      for (int q = 0; q < 8; ++q) stw((kt + 1) & 1, q, rn[q]);
      if (has3) {
#pragma unroll
        for (int q = 0; q < 8; ++q) ldg(kt + 3, q, rn[q]);
      }
      __syncthreads();
    }
  };
  auto half1 = [&](int kt, i32x8 (&ac)[4], i32x8 (&an)[4], bool has1) {
    const char* Sn = smem + ((kt + 1) & 1) * R_STAGE;
    if (has1) { load_a(Sn, an); load_b(Sn, 0, bq[0]); load_b(Sn, 1, bq[1]); }
    __builtin_amdgcn_sched_barrier(0);
    mma4(ac, bq[2], 2);
    __builtin_amdgcn_sched_barrier(0);
    mma4(ac, bq[3], 3);
    __builtin_amdgcn_sched_barrier(0);
  };
#define IC(n) std::integral_constant<int, n>{}
  const int nk = t.KB >> 6;
  __syncthreads();
#pragma unroll
  for (int q = 0; q < 8; ++q) ldg(0, q, rs0[q]);
#pragma unroll
  for (int q = 0; q < 8; ++q) ldg(1, q, rs1[q]);
  RV_WAIT(8, rs0);
#pragma unroll
  for (int q = 0; q < 8; ++q) stw(0, q, rs0[q]);
#pragma unroll
  for (int q = 0; q < 8; ++q) ldg(2, q, rs0[q]);
  __syncthreads();
  load_a(smem, aA); load_b(smem, 0, bq[0]); load_b(smem, 1, bq[1]);
  for (int kt = 0; kt < nk - 4; kt += 2) {
    half0(kt, aA);      commit(kt, rs1, IC(8), true, true);      half1(kt, aA, aB, true);
    half0(kt + 1, aB);  commit(kt + 1, rs0, IC(8), true, true);  half1(kt + 1, aB, aA, true);
  }
  half0(nk - 4, aA);  commit(nk - 4, rs1, IC(8), true, true);   half1(nk - 4, aA, aB, true);
  half0(nk - 3, aB);  commit(nk - 3, rs0, IC(8), true, false);  half1(nk - 3, aB, aA, true);
  half0(nk - 2, aA);  commit(nk - 2, rs1, IC(0), true, false);  half1(nk - 2, aA, aB, true);
  half0(nk - 1, aB);                                            half1(nk - 1, aB, aA, false);
#undef IC
#undef RV_WAIT
}

__device__ __forceinline__ void cvt16_tile(const float* W, int col0, int ldn, int nvalid  , const float* kgain,
                                           u16* out  , int ldk, char* T) {
  const int tid = opaque_tid();
  const int kq = tid & 7, n4 = tid >> 3;
  f32x4 v[16];
  const bool ok = (n4 * 4) < nvalid;
  const float* src = W + (long)(kq * 16) * ldn + (ok ? n4 * 4 : -col0);
#pragma unroll
  for (int j = 0; j < 16; ++j) v[j] = __builtin_nontemporal_load((const f32x4*)(src + (long)j * ldn));
  if (kgain) {
#pragma unroll
    for (int j = 0; j < 16; ++j) v[j] *= kgain[kq * 16 + j];
  }
  if (!ok) {
#pragma unroll
    for (int j = 0; j < 16; ++j) v[j] = (f32x4){0.f, 0.f, 0.f, 0.f};
  }
  __syncthreads();
#pragma unroll
  for (int c = 0; c < 4; ++c) {
    u32x4 w0, w1;
#pragma unroll
    for (int q = 0; q < 4; ++q) { w0[q] = pack_bf16(v[2 * q][c], v[2 * q + 1][c]); w1[q] = pack_bf16(v[8 + 2 * q][c], v[8 + 2 * q + 1][c]); }
    *(u32x4*)(T + (n4 * 4 + c) * 256 + kq * 32) = w0;
    *(u32x4*)(T + (n4 * 4 + c) * 256 + kq * 32 + 16) = w1;
  }
  __syncthreads();
#pragma unroll
  for (int i = 0; i < 8; ++i) {
    const int n = (tid >> 4) + 16 * i, ch = tid & 15;
    *(u32x4*)((char*)(out + (long)n * ldk) + ch * 16) = *(const u32x4*)(T + n * 256 + ch * 16);
  }
}
__device__ __forceinline__ void convert_one(const Params& p, char* smem, int u);
__device__ __forceinline__ void ph_convert_dense(const Params& p, char* smem) {
#if WOUTQ
  convert_one(p, smem, 24576 + blockIdx.x);
#endif
  for (int u = blockIdx.x; u < 912; u += gridDim.x) {
    if (u < 544) { const int kt = u / 34, nt = u % 34; const int nv = NC_ - nt * 128;
      cvt16_tile(p.w_in + (long)(kt * 128) * NC_ + nt * 128, nt * 128, NC_, nv < 0 ? 0 : nv, nullptr, p.wb_in() + (long)(nt * 128) * 2048 + kt * 128, 2048, smem);
    } else if (u < 592) { const int v = u - 544; const int kt = v / 12, nt = v % 12;
      cvt16_tile(p.w_uq + (long)(kt * 128) * 1536 + nt * 128, nt * 128, 1536, 128, p.q_norm + kt * 128, p.wb_uq() + (long)(nt * 128) * 512 + kt * 128, 512, smem);
    } else if (u < 656) { const int v = u - 592; const int kt = v >> 4, nt = v & 15;
      cvt16_tile(p.w_ukv + (long)(kt * 128) * 2048 + nt * 128, nt * 128, 2048, 128, p.kv_norm + kt * 128, p.wb_ukv() + (long)(nt * 128) * 512 + kt * 128, 512, smem);
    } else if (!WOUTQ) { const int v = u - 656; const int kt = v >> 4, nt = v & 15;
      cvt16_tile(p.w_out + (long)(kt * 128) * 2048 + nt * 128, nt * 128, 2048, 128, nullptr, p.wb_out() + (long)(nt * 128) * 2048 + kt * 128, 2048, smem);
    }
  }
}


template <bool NTST = false, class F>
__device__ __forceinline__ void epi_store_bf16(f32x16 (&acc)[4][4], char* smem, u16* gbase  , int ld, int ncols0, int ncols1, F f) {
  int tz = threadIdx.x; asm volatile("" : "+v"(tz));
  const int lane = tz & 63, wid = tz >> 6, wr = wid >> 1, wc = wid & 1, l31 = lane & 31, hh = lane >> 5;
  __syncthreads();
  char* st = smem + wid * 32768;
#pragma unroll
  for (int mb = 0; mb < 4; ++mb)
#pragma unroll
    for (int reg = 0; reg < 16; ++reg) {
      const int r = mb * 32 + (reg & 3) + 8 * (reg >> 2) + 4 * hh;
      float v[4] = {acc[mb][0][reg], acc[mb][1][reg], acc[mb][2][reg], acc[mb][3][reg]};
      f(wr * 128 + r, wc * 64 + l31, v);
#pragma unroll
      for (int nb = 0; nb < 4; ++nb) *(u16*)(st + r * 256 + (nb * 32 + l31) * 2) = f32_to_bf16(v[nb]);
    }
  const int ch = lane & 15, span = ch >> 3;
  const int gcol = span * 128 + wc * 64 + (ch & 7) * 8;
  const bool ok = ((wc * 64 + (ch & 7) * 8) < (span ? ncols1 : ncols0));
#pragma unroll 8
  for (int it = 0; it < 32; ++it) {
    const int r = it * 4 + (lane >> 4);
    const u32x4 w = *(const u32x4*)(st + r * 256 + ch * 16);
    if (ok) { if (NTST) __builtin_nontemporal_store(w, (u32x4*)(gbase + (long)(wr * 128 + r) * ld + gcol)); else *(u32x4*)(gbase + (long)(wr * 128 + r) * ld + gcol) = w; }
  }
}
template <class F>
__device__ __forceinline__ void epi_store_act8(f32x16 (&acc)[4][4], char* smem, u8* gbase  , long row0, int cb0, F f) {
  int tz = threadIdx.x; asm volatile("" : "+v"(tz));
  const int lane = tz & 63, wid = tz >> 6, wr = wid >> 1, wc = wid & 1, l31 = lane & 31, hh = lane >> 5;
  __syncthreads();
  char* st = smem + wid * 32768;
#pragma unroll
  for (int mb = 0; mb < 4; ++mb)
#pragma unroll
    for (int reg = 0; reg < 16; ++reg) {
      const int r = mb * 32 + (reg & 3) + 8 * (reg >> 2) + 4 * hh;
      float v[4] = {acc[mb][0][reg], acc[mb][1][reg], acc[mb][2][reg], acc[mb][3][reg]};
      f(wr * 128 + r, wc * 64 + l31, v);
      const int q = __builtin_amdgcn_cvt_pk_fp8_f32(v[0], v[1], 0, false);
      *(u8*)(st + r * 64 + l31) = (u8)(q & 0xff);
      *(u8*)(st + r * 64 + 32 + l31) = (u8)((q >> 8) & 0xff);
    }
  const int ch = lane & 3;
#pragma unroll 8
  for (int it = 0; it < 8; ++it) {
    const int r = it * 16 + (lane >> 2);
    const u32x4 w = *(const u32x4*)(st + r * 64 + ch * 16);
    const long rg = row0 + wr * 128 + r;
    *(u32x4*)(gbase + (rg >> 1) * 4096 + (long)(cb0 + wc) * 128 + (rg & 1) * 64 + ch * 16) = w;
  }
}
__device__ __forceinline__ void epi_store_f32_resid(f32x16 (&acc)[4][4], char* smem, const float* resid, float* out, int ld, float osc) {
  int tz = threadIdx.x; asm volatile("" : "+v"(tz));
  const int lane = tz & 63, wid = tz >> 6, wr = wid >> 1, wc = wid & 1, l31 = lane & 31, hh = lane >> 5;
  __syncthreads();
  char* st = smem + wid * 32768;
  const int ch = lane & 31, span = ch >> 4;
  const int gcol = span * 128 + wc * 64 + (ch & 15) * 4;
#if EPI2
  const long o0 = (long)(wr * 128 + (lane >> 5)) * ld + gcol;
  f32x4 xa[16], xb[16];
  auto ldb = [&](int b, f32x4 (&x)[16]) {
#pragma unroll
    for (int i = 0; i < 16; ++i) x[i] = __builtin_nontemporal_load((const f32x4*)(resid + o0 + (long)(b * 32 + i * 2) * ld));
  };
  auto stage = [&](int half) {
#pragma unroll
    for (int m2 = 0; m2 < 2; ++m2)
#pragma unroll
      for (int reg = 0; reg < 16; ++reg) {
        const int mb = half * 2 + m2;
        const int r = m2 * 32 + (reg & 3) + 8 * (reg >> 2) + 4 * hh;
#pragma unroll
        for (int nb = 0; nb < 4; ++nb) *(float*)(st + r * 512 + (nb * 32 + l31) * 4) = acc[mb][nb][reg];
      }
  };
  auto proc = [&](int b, f32x4 (&x)[16]) {
#pragma unroll
    for (int i = 0; i < 16; ++i) {
      const int r = (b & 1) * 32 + i * 2 + (lane >> 5);
      const f32x4 a = *(const f32x4*)(st + r * 512 + ch * 16);
      *(f32x4*)(out + o0 + (long)(b * 32 + i * 2) * ld) = a * osc + x[i];
    }
  };
  ldb(0, xa);
  __builtin_amdgcn_sched_barrier(0);
  stage(0);
  ldb(1, xb);
  __builtin_amdgcn_sched_barrier(0);
  proc(0, xa);
  ldb(2, xa);
  __builtin_amdgcn_sched_barrier(0);
  proc(1, xb);
  stage(1);
  ldb(3, xb);
  __builtin_amdgcn_sched_barrier(0);
  proc(2, xa);
  proc(3, xb);
#else
#pragma unroll
  for (int half = 0; half < 2; ++half) {
#pragma unroll
    for (int m2 = 0; m2 < 2; ++m2)
#pragma unroll
      for (int reg = 0; reg < 16; ++reg) {
        const int mb = half * 2 + m2;
        const int r = m2 * 32 + (reg & 3) + 8 * (reg >> 2) + 4 * hh;
#pragma unroll
        for (int nb = 0; nb < 4; ++nb) *(float*)(st + r * 512 + (nb * 32 + l31) * 4) = acc[mb][nb][reg];
      }
#pragma unroll 8
    for (int it = 0; it < 32; ++it) {
      const int r = it * 2 + (lane >> 5);
      const f32x4 a = *(const f32x4*)(st + r * 512 + ch * 16);
      const long o = (long)(wr * 128 + half * 64 + r) * ld + gcol;
      const f32x4 x = __builtin_nontemporal_load((const f32x4*)(resid + o));
      *(f32x4*)(out + o) = a * osc + x;
    }
  }
#endif
}

template <bool NTST = false>
__device__ __forceinline__ void epi16_store_bf16(f32x4 (&acc)[8][8], char* smem, u16* gbase, int ld, int ncols0, int ncols1, const float* rscale, float mul) {
  int tz = threadIdx.x; asm volatile("" : "+v"(tz));
  const int lane = tz & 63, wid = tz >> 6, wr = wid >> 1, wc = wid & 1, l15 = lane & 15, kq = lane >> 4;
  __syncthreads();
  char* st = smem + wid * 32768;
#pragma unroll
  for (int mb = 0; mb < 8; ++mb)
#pragma unroll
    for (int reg = 0; reg < 4; ++reg) {
      const int r = mb * 16 + 4 * kq + reg;
      const float sc = rscale ? rscale[wr * 128 + r] * mul : 1.0f;
#pragma unroll
      for (int nb = 0; nb < 8; ++nb) *(u16*)(st + r * 256 + ((nb >> 2) * 64 + (nb & 3) * 16 + l15) * 2) = f32_to_bf16(acc[mb][nb][reg] * sc);
    }
  const int ch = lane & 15, span = ch >> 3;
  const int gcol = span * 128 + wc * 64 + (ch & 7) * 8;
  const bool ok = ((wc * 64 + (ch & 7) * 8) < (span ? ncols1 : ncols0));
#pragma unroll 8
  for (int it = 0; it < 32; ++it) {
    const int r = it * 4 + (lane >> 4);
    const u32x4 w = *(const u32x4*)(st + r * 256 + ch * 16);
    if (ok) { if (NTST) __builtin_nontemporal_store(w, (u32x4*)(gbase + (long)(wr * 128 + r) * ld + gcol)); else *(u32x4*)(gbase + (long)(wr * 128 + r) * ld + gcol) = w; }
  }
}
__device__ __forceinline__ void epi16_store_f32_resid(f32x4 (&acc)[8][8], char* smem, const float* resid, float* out, int ld) {
  int tz = threadIdx.x; asm volatile("" : "+v"(tz));
  const int lane = tz & 63, wid = tz >> 6, wr = wid >> 1, wc = wid & 1, l15 = lane & 15, kq = lane >> 4;
  __syncthreads();
  char* st = smem + wid * 32768;
#pragma unroll
  for (int half = 0; half < 2; ++half) {
#pragma unroll
    for (int m4 = 0; m4 < 4; ++m4)
#pragma unroll
      for (int reg = 0; reg < 4; ++reg) {
        const int mb = half * 4 + m4;
        const int r = m4 * 16 + 4 * kq + reg;
#pragma unroll
        for (int nb = 0; nb < 8; ++nb) *(float*)(st + r * 512 + ((nb >> 2) * 64 + (nb & 3) * 16 + l15) * 4) = acc[mb][nb][reg];
      }
    const int ch = lane & 31, span = ch >> 4;
    const int gcol = span * 128 + wc * 64 + (ch & 15) * 4;
#pragma unroll 8
    for (int it = 0; it < 32; ++it) {
      const int r = it * 2 + (lane >> 5);
      const f32x4 a = *(const f32x4*)(st + r * 512 + ch * 16);
      const long o = (long)(wr * 128 + half * 64 + r) * ld + gcol;
      const f32x4 x = __builtin_nontemporal_load((const f32x4*)(resid + o));
      *(f32x4*)(out + o) = a + x;
    }
  }
}

template <int NBV>
__device__ __forceinline__ void win_tile_r(const Params& p, char* smem, int mt, int nt) {
  GemmRTile t{};
  t.A = (const u8*)p.h1(); t.lda = 4096; t.aidx = nullptr; t.m0 = mt * 256; t.mvalid = 256;
  t.B = (const u8*)p.wb_in(); t.brow0 = nt * 256; t.brow1 = nt * 256 + 128; t.ldb = 4096; t.KB = 4096;
  const int rem = NC_ - nt * 256;
  const int nv0 = rem >= 128 ? 128 : rem, nv1 = rem >= 256 ? 128 : (rem > 128 ? rem - 128 : 0);
#if (MF16 & 1)
  f32x4 acc6[8][8];
  gemmr16_tile_256(t, smem, acc6);
  epi16_store_bf16(acc6, smem, p.proj() + (long)(mt * 256) * NC_ + nt * 256, NC_, nv0, nv1, nullptr, 1.0f);
#else
  f32x16 acc[4][4];
  gemmr_tile_256<false, false>(t, smem, acc);
  epi_store_bf16(acc, smem, p.proj() + (long)(mt * 256) * NC_ + nt * 256, NC_, nv0, nv1, [&](int, int, float (&)[4]) {});
#endif
}
__device__ __forceinline__ void win_narrow_split(const Params& p, char* smem, int mt, int kc) {
  GemmRTile t{};
  t.A = (const u8*)p.h1() + kc * 512; t.lda = 4096; t.aidx = nullptr; t.m0 = mt * 256; t.mvalid = 256;
  t.B = (const u8*)p.wb_in() + kc * 512; t.brow0 = 4096; t.brow1 = 4224; t.ldb = 4096; t.KB = 512;
  float* base = p.pn() + (long)kc * (8192 * 80) + (long)(mt * 256) * 80;
#if (MF16 & 2)
  f32x4 acc6[8][8];
  gemmr16_tile_256(t, smem, acc6);
  {
    const int tq = opaque_tid(); const int lane = tq & 63, wid = tq >> 6, wr = wid >> 1, wc = wid & 1;
#pragma unroll
    for (int mb = 0; mb < 8; ++mb)
#pragma unroll
      for (int reg = 0; reg < 4; ++reg) {
        const int rowl = wr * 128 + mb * 16 + 4 * (lane >> 4) + reg;
        float* rp = base + (long)rowl * 80 + wc * 64 + (lane & 15);
        OPAQUE(rp);
#pragma unroll
        for (int nb = 0; nb < 4; ++nb) if (wc * 64 + nb * 16 + (lane & 15) < 80) rp[nb * 16] = acc6[mb][nb][reg];
      }
  }
  return;
#endif
  f32x16 acc[4][4];
  gemmr_tile_256<false, false>(t, smem, acc);
  acc_foreach_row<4>(acc, [&](int rowl, int coll, float (&v)[4]) {
    float* rp = base + (long)rowl * 80 + coll;
    OPAQUE(rp);
    if (coll < 80) rp[0] = v[0];
    if (coll + 32 < 80) rp[32] = v[1];
  });
}
__device__ __forceinline__ void ph_win_r(const Params& p, char* smem) {
  const int x = blockIdx.x & 7, slot = blockIdx.x >> 3;
#if WIN_SPLIT
  for (int j = slot; j < 64; j += 32) win_tile_r<4>(p, smem, 4 * x + (j & 3), j >> 2);
  win_narrow_split(p, smem, 4 * x + (slot & 3), slot >> 2);
#else
  for (int j = slot; j < 68; j += 32) win_tile_r<4>(p, smem, 4 * x + (j & 3), j >> 2);
#endif
}
__device__ __forceinline__ void upq_tile_r(const Params& p, char* smem, int mt, int nt) {
  GemmRTile t{};
  t.A = (const u8*)(p.proj() + C_MQ); t.lda = NC_ * 2; t.aidx = nullptr; t.m0 = mt * 256; t.mvalid = 256;
  t.B = (const u8*)p.wb_uq(); t.brow0 = nt * 256; t.brow1 = nt * 256 + 128; t.ldb = 1024; t.KB = 1024;
  const float* rq = p.rq() + mt * 256;
#if (MF16 & 4)
  f32x4 acc6[8][8];
  gemmr16_tile_256(t, smem, acc6);
  epi16_store_bf16(acc6, smem, p.q() + (long)(mt * 256) * 1536 + nt * 256, 1536, 128, 128, rq, QSCALE_);
  return;
#endif
  f32x16 acc[4][4];
  gemmr_tile_256<false, false>(t, smem, acc);
  epi_store_bf16(acc, smem, p.q() + (long)(mt * 256) * 1536 + nt * 256, 1536, 128, 128, [&](int rowl, int, float (&v)[4]) {
    const float s = rq[rowl] * QSCALE_;
#pragma unroll
    for (int nb = 0; nb < 4; ++nb) v[nb] *= s;
  });
}
__device__ __forceinline__ void upkv_tile_r(const Params& p, char* smem, int mt, int nt) {
  GemmRTile t{};
  t.A = (const u8*)(p.proj() + C_MKV); t.lda = NC_ * 2; t.aidx = nullptr; t.m0 = mt * 256; t.mvalid = 256;
  t.B = (const u8*)p.wb_ukv(); t.brow0 = nt * 256; t.brow1 = nt * 256 + 128; t.ldb = 1024; t.KB = 1024;
  const float* rk = p.rkv() + mt * 256;
#if (MF16 & 8)
  f32x4 acc6[8][8];
  gemmr16_tile_256(t, smem, acc6);
  epi16_store_bf16(acc6, smem, p.kv() + (long)(mt * 256) * 2048 + nt * 256, 2048, 128, 128, rk, 1.0f);
  return;
#endif
  f32x16 acc[4][4];
  gemmr_tile_256<false, false>(t, smem, acc);
  epi_store_bf16(acc, smem, p.kv() + (long)(mt * 256) * 2048 + nt * 256, 2048, 128, 128, [&](int rowl, int, float (&v)[4]) {
    const float s = rk[rowl];
#pragma unroll
    for (int nb = 0; nb < 4; ++nb) v[nb] *= s;
  });
}
template <int hot = 0>
__device__ __forceinline__ void wout_tile_r(const Params& p, char* smem, int mt, int nt) {
  f32x16 acc[4][4];
  GemmRTile t{};
  const int smt = mt, snt = nt;
  if (hot == 1) { mt = 0; nt = 0; }
#if WOUTQ
  t.A = p.mixq(); t.lda = 2048; t.aidx = nullptr; t.m0 = mt * 256; t.mvalid = 256;
  t.B = p.wq_out(); t.brow0 = nt * 256; t.brow1 = nt * 256 + 128; t.ldb = 2048; t.KB = 2048;
  gemmrs_tile_256<false>(t, smem, acc);
  const float osc = WISCALE_;
#else
  t.A = (const u8*)p.mix(); t.lda = 4096; t.aidx = nullptr; t.m0 = mt * 256; t.mvalid = 256;
  t.B = (const u8*)p.wb_out(); t.brow0 = nt * 256; t.brow1 = nt * 256 + 128; t.ldb = 4096; t.KB = 4096;
  if (hot == 2) t.KB = 512;
#if (MF16 & 16)
  {
    f32x4 acc6[8][8];
    gemmr16_tile_256(t, smem, acc6);
    const long boff6 = (long)(smt * 256) * 2048 + snt * 256;
    epi16_store_f32_resid(acc6, smem, p.x + boff6, p.x1() + boff6, 2048);
    return;
  }
#endif
  gemmr_tile_256<false, false>(t, smem, acc);
  const float osc = 1.0f;
#endif
  const long boff = (long)(smt * 256) * 2048 + snt * 256;
  epi_store_f32_resid(acc, smem, p.x + boff, p.x1() + boff, 2048, osc);
}

__device__ __forceinline__ void moe1q_tile(const Params& p, char* smem, const int* mo, int e, int nt, int mt) {
  f32x16 acc[4][4];
  GemmRTile t{};
  const int cnt = p.counts()[e];
  t.A = p.h2q(); t.lda = 2048; t.aidx = p.list() + e * T_ + mt * 256; t.m0 = 0; t.mvalid = min(256, cnt - mt * 256);
  t.B = p.wq_gu(); t.brow0 = (long)e * 4096 + nt * 128; t.brow1 = t.brow0 + 2048; t.ldb = 2048; t.KB = 2048;
#if MOEQ == 3
  gemmrv_tile_256<true>(t, smem, acc);
#elif MOEQ == 2
  gemmrs_tile_256<true>(t, smem, acc);
#else
  gemmr_tile_256<true, true>(t, smem, acc);
#endif
  const float* bg = p.b_gu + e * 4096 + nt * 128; const float* bu = bg + 2048;
  const int tq_ = opaque_tid(); const int cl = (tq_ >> 6 & 1) * 64 + (tq_ & 31);
  const float bgv[2] = {bg[cl], bg[cl + 32]}, buv[2] = {bu[cl], bu[cl + 32]};
  epi_store_act8(acc, smem, p.actq(), (long)(mo[e] * 256 + mt * 256), nt * 2, [&](int, int, float (&v)[4]) {
#pragma unroll
    for (int nb = 0; nb < 2; ++nb) {
      float g = fminf(v[nb] * WISCALE_ + bgv[nb], 7.0f);
      float uu = fminf(fmaxf(v[nb + 2] * WISCALE_ + buv[nb], -7.0f), 7.0f);
      v[nb] = (uu + 1.0f) * (g * __builtin_amdgcn_rcpf(1.0f + __expf(-1.702f * g)));
    }
  });
}
__device__ __forceinline__ void moe2q_tile(const Params& p, char* smem, const int* mo, int e, int nt, int mt) {
  f32x16 acc[4][4];
  GemmRTile t{};
  t.A = p.actq(); t.lda = 2048; t.aidx = nullptr; t.m0 = mo[e] * 256 + mt * 256; t.mvalid = 256;
  t.B = p.wq_dn(); t.brow0 = (long)e * 2048 + nt * 256; t.brow1 = t.brow0 + 128; t.ldb = 2048; t.KB = 2048;
#if MOEQ == 3
  gemmrv_tile_256<false>(t, smem, acc);
#elif MOEQ == 2
  gemmrs_tile_256<false>(t, smem, acc);
#else
  gemmr_tile_256<true, false>(t, smem, acc);
#endif
  const float* bd = p.b_dn + e * 2048 + nt * 256;
  const int tq_ = opaque_tid(); const int cl = (tq_ >> 6 & 1) * 64 + (tq_ & 31);
  const float bdv[4] = {bd[cl], bd[cl + 32], bd[cl + 128], bd[cl + 160]};
  epi_store_bf16<YNT != 0>(acc, smem, p.ybuf() + (long)t.m0 * 2048 + nt * 256, 2048, 128, 128, [&](int, int, float (&v)[4]) {
#pragma unroll
    for (int nb = 0; nb < 4; ++nb) v[nb] = v[nb] * WISCALE_ + bdv[nb];
  });
}
template <int WHICH>
__device__ __forceinline__ void ph_moeq(const Params& p, char* smem) {
  int* mo = (int*)(smem + G_LDS_BYTES);
#if CVT_SPLIT
  const bool dn_first = ((blockIdx.x >> 3) & 1) != 0;
  if (WHICH == 1 && dn_first) ph_convert_dn(p, smem);
#endif
  moe_setup(p, mo);
  const int NT = (WHICH == 1) ? 16 : 8;
  const int total = mo[NE_] * NT;
#if SKEW
  { const int sl = (blockIdx.x >> 3) % 5; for (int i = 0; i < sl; ++i) __builtin_amdgcn_s_sleep(SKEW); }
#endif
  for (int round = 0;; ++round) {
    const int u = xcd_unit(round);
    if (round * 256 >= total) break;
    if (u >= total) continue;
    int e = 0;
    while (mo[e + 1] * NT <= u) ++e;
    const int local = u - mo[e] * NT, me = mo[e + 1] - mo[e];
    const int nt = UORD ? (local % NT) : (local / me), mt = UORD ? (local / NT) : (local - (local / me) * me);
    if (WHICH == 1) moe1q_tile(p, smem, mo, e, nt, mt); else moe2q_tile(p, smem, mo, e, nt, mt);
  }
#if CVT_SPLIT
  if (WHICH == 1 && !dn_first) ph_convert_dn(p, smem);
#endif
}
#define LDS_MAX 143360
#ifndef DUP
#define DUP 0
#endif
#ifndef MOEQ
#define MOEQ 1
#endif
#ifndef CVT_SPLIT
#define CVT_SPLIT 1
#endif
#ifndef CVT_STAGGER
#define CVT_STAGGER 1
#endif
#ifndef CVT_IN_P4
#define CVT_IN_P4 1
#endif
#ifndef TSTAMP
#define TSTAMP 0
#endif
#ifndef DENSER
#define DENSER 1
#endif
__global__ void __launch_bounds__(256, 1) mega(Params p) {
  extern __shared__ __attribute__((aligned(16))) char smem[];
  volatile LAS unsigned* xbw = (volatile LAS unsigned*)(smem + LDS_MAX - 16);
  if (threadIdx.x == 0) { xbw[0] = 0u; xbw[1] = 0u; xbw[2] = 0u; xbw[3] = 0u; }
  __syncthreads();
  (void)xcd_barrier_post(p.bar(), xbw);
#if TSTAMP
  unsigned long long ts0 = wall_clock64();
  int bar_no = 0;
#define XBAR() do { XcdBarrier bar_; bar_.bar = p.bar(); bar_.x = xb_xcc_id(); bar_.st = (volatile LAS unsigned*)(smem + LDS_MAX - 16); xcd_barrier(bar_); ++bar_no; if (bar_no == TSTAMP && blockIdx.x == 0 && threadIdx.x == 0) { ((float*)p.counts())[48] = (float)(wall_clock64() - ts0) * (1.0f / 100.0f); } } while (0)
#else
#define XBAR() do { XcdBarrier bar_; bar_.bar = p.bar(); bar_.x = xb_xcc_id(); bar_.st = (volatile LAS unsigned*)(smem + LDS_MAX - 16); xcd_barrier(bar_); } while (0)
#endif
#if DUP == 100
  for (int rep_ = 0; rep_ < 2; ++rep_) {
  if (rep_) XBAR();
#endif
  ph_prep0(p);
#if DUP == 33
  if (blockIdx.x < 192) gla_g1_unit(p, smem, blockIdx.x);
  else for (int i = 0; i < 5; ++i) gla_g1_unit(p, smem, 192 + (blockIdx.x - 192) * 5 + i);
#endif
#if DUP == 30
  ph_prep0(p);
#endif
#if DENSER
  ph_convert_dense(p, smem);
#endif
#if MOEQ >= 1 && CVT_IN_P4 == 0
  ph_convert(p, smem);
#if DUP == 20
  ph_convert(p, smem);
#endif
#endif
  XBAR();
#if DENSER
  ph_win_r(p, smem);
#else
  ph_win(p, smem);
#endif
#if DUP == 1
#if DENSER
  ph_win_r(p, smem);
#else
  ph_win(p, smem);
#endif
#endif
  XBAR();
  ph_prep1(p, smem);
#if DUP == 2
  ph_prep1(p, smem);
#endif
  XBAR();
#if DENSER
  upkv_tile_r(p, smem, blockIdx.x >> 3, blockIdx.x & 7);
  if (blockIdx.x < 192) upq_tile_r(p, smem, blockIdx.x / 6, blockIdx.x % 6);
#else
  upkv_tile(p, smem, blockIdx.x >> 3, blockIdx.x & 7);
  if (blockIdx.x < 192) upq_tile(p, smem, blockIdx.x / 6, blockIdx.x % 6);
#endif
  if (blockIdx.x < 192) gla_g1_unit(p, smem, blockIdx.x);
  else for (int i = 0; i < 4; ++i) gla_g1_unit(p, smem, 192 + (blockIdx.x - 192) * 4 + i);
  if (blockIdx.x < 64) gla_g1_unit(p, smem, 448 + blockIdx.x);
#if DUP == 3
  upkv_tile_r(p, smem, blockIdx.x >> 3, blockIdx.x & 7);
  if (blockIdx.x < 192) upq_tile_r(p, smem, blockIdx.x / 6, blockIdx.x % 6);
  if (blockIdx.x < 192) gla_g1_unit(p, smem, blockIdx.x);
  else for (int i = 0; i < 5; ++i) gla_g1_unit(p, smem, 192 + (blockIdx.x - 192) * 5 + i);
#endif
  XBAR();
  gla_g2_unit(p, blockIdx.x);
#if DUP == 31
  gla_g2_unit(p, blockIdx.x);
#endif
  {
    const int bh = blockIdx.x >> 4, qa = blockIdx.x & 15;
#if MOEQ >= 1 && CVT_IN_ATTN
    int ci = 0;
    attn_unit(p, smem, bh >> 3, bh & 7, 31 - qa, ci);
    attn_unit(p, smem, bh >> 3, bh & 7, qa, ci);
    for (; ci < 64; ++ci) convert_one(p, smem, blockIdx.x + 256 * ci);
#else
    int ci = 64;
#if MOEQ >= 1 && CVT_IN_P4 && STAG4
    const int sg = (blockIdx.x >> 3) & 3;
    if (sg == 0) ph_convert_gu(p, smem, 0, 1);
    if (sg == 3) ph_convert_gu(p, smem, 0, 2);
    attn_unit(p, smem, bh >> 3, bh & 7, 31 - qa, ci);
    if (sg == 1) ph_convert_gu(p, smem, 0, 1);
    attn_unit(p, smem, bh >> 3, bh & 7, qa, ci);
    if (sg == 2) ph_convert_gu(p, smem, 0, 1);
    if (sg == 3) ph_convert_gu(p, smem, 1, 2);
#else
#if MOEQ >= 1 && CVT_IN_P4
    const bool cvt_first = CVT_STAGGER ? (((STAGX ? blockIdx.x : (blockIdx.x >> 3)) & 1) != 0) : false;
    if (cvt_first) { if (CVT_SPLIT) ph_convert_gu(p, smem, 0, 1); else ph_convert(p, smem); }
#endif
    attn_unit(p, smem, bh >> 3, bh & 7, 31 - qa, ci);
    attn_unit(p, smem, bh >> 3, bh & 7, qa, ci);
#if MOEQ >= 1 && CVT_IN_P4
    if (!cvt_first) { if (CVT_SPLIT) ph_convert_gu(p, smem, 0, 1); else ph_convert(p, smem); }
#endif
#endif
#endif
#if DUP == 44
    if (cvt_first) ph_convert(p, smem);
    { int cz = 64; attn_unit(p, smem, bh >> 3, bh & 7, 31 - qa, cz); attn_unit(p, smem, bh >> 3, bh & 7, qa, cz); }
    if (!cvt_first) ph_convert(p, smem);
#endif
#if DUP == 47
    if (cvt_first) ph_convert_gu(p, smem, 0, 1);
    { int cz = 64; attn_unit(p, smem, bh >> 3, bh & 7, 31 - qa, cz); attn_unit(p, smem, bh >> 3, bh & 7, qa, cz); }
    if (!cvt_first) ph_convert_gu(p, smem, 0, 1);
#endif
#if DUP == 4
    { int cz = 64; attn_unit(p, smem, bh >> 3, bh & 7, 31 - qa, cz); attn_unit(p, smem, bh >> 3, bh & 7, qa, cz); }
#endif
  }
  XBAR();
#if DUP == 45
  if ((blockIdx.x >> 3) & 1) ph_convert_gu(p, smem, 0, 1);
  XBAR();
#endif
#if DUP == 46
  ph_convert_gu(p, smem, 0, 1);
  XBAR();
#endif
  for (int u = blockIdx.x; u < 512; u += gridDim.x) gla_g3_unit(p, smem, u);
  mla_norm_tokens(p);
#if DUP == 5
  for (int u = blockIdx.x; u < 512; u += gridDim.x) gla_g3_unit(p, smem, u);
  mla_norm_tokens(p);
#endif
  XBAR();
#if DUP == 62
  wout_tile_r<2>(p, smem, (blockIdx.x & 7) * 4 + ((blockIdx.x >> 3) & 3), blockIdx.x >> 5);
#endif
#if DENSER
  wout_tile_r(p, smem, (blockIdx.x & 7) * 4 + ((blockIdx.x >> 3) & 3), blockIdx.x >> 5);
#else
  wout_tile(p, smem, blockIdx.x >> 3, blockIdx.x & 7);
#endif
#if DUP == 6
  wout_tile_r(p, smem, (blockIdx.x & 7) * 4 + ((blockIdx.x >> 3) & 3), blockIdx.x >> 5);
#endif
#if DUP == 61
  wout_tile_r<1>(p, smem, (blockIdx.x & 7) * 4 + ((blockIdx.x >> 3) & 3), blockIdx.x >> 5);
  wout_tile_r(p, smem, (blockIdx.x & 7) * 4 + ((blockIdx.x >> 3) & 3), blockIdx.x >> 5);
#endif
  XBAR();
  ffn_prep_unit(p, smem, blockIdx.x);
#if DUP == 7
  ffn_prep_unit<1>(p, smem, blockIdx.x);
#endif
  XBAR();
#if MOEQ >= 1
  ph_moeq<1>(p, smem);
#if DUP == 8
  ph_moeq<1>(p, smem);
#endif
#else
  ph_moe<1>(p, smem);
#endif
  XBAR();
#if MOEQ >= 1
  ph_moeq<2>(p, smem);
#else
  ph_moe<2>(p, smem);
#endif
#if DUP == 9
  ph_moeq<2>(p, smem);
#endif
#if DUP == 89
  XBAR();
  ph_moeq<1>(p, smem);
  XBAR();
  ph_moeq<2>(p, smem);
#endif
#if DUP == 19
  ph_moe<2, 1>(p, smem);
#endif
  XBAR();
#if DUP == 100
  ph_final(p, smem);
  }
#endif
#if TSTAMP
  {
    const float us = ((const float*)p.counts())[48];
    const float scl = 1.0f + us * (1.0f / 4000.0f);
    ph_final(p, smem, scl);
  }
#else
  ph_final(p, smem);
#endif
#if DUP == 10
  ph_final(p, smem);
#endif
#if DUP == 11
  for (int i = 0; i < 10; ++i) XBAR();
#endif
}

extern "C" void kernel_launch(void* const* d_in, const int* in_sizes, int n_in,
                              void* d_out, int out_size, void* d_ws, size_t ws_size,
                              hipStream_t stream) {
  Params P{};
  P.x = (const float*)d_in[0]; P.pos = (const int*)d_in[1];
  P.attn_norm = (const float*)d_in[2]; P.w_in = (const float*)d_in[3]; P.gate_up = (const float*)d_in[4]; P.gate_bias = (const float*)d_in[5];
  P.gla_out_norm = (const float*)d_in[6]; P.q_norm = (const float*)d_in[7]; P.w_uq = (const float*)d_in[8]; P.kv_norm = (const float*)d_in[9];
  P.w_ukv = (const float*)d_in[10]; P.mla_out_norm = (const float*)d_in[11]; P.w_out = (const float*)d_in[12]; P.ffn_norm = (const float*)d_in[13];
  P.router_w = (const float*)d_in[14]; P.router_b = (const float*)d_in[15]; P.w_gu = (const float*)d_in[16]; P.b_gu = (const float*)d_in[17];
  P.w_dn = (const float*)d_in[18]; P.b_dn = (const float*)d_in[19]; P.final_norm = (const float*)d_in[20];
  P.out = (float*)d_out;

  P.ws = (char*)d_ws;

  hipFuncSetAttribute((const void*)mega, hipFuncAttributeMaxDynamicSharedMemorySize, LDS_MAX);
  hipMemsetAsync(d_ws, 0, XCD_BAR_WORDS * sizeof(unsigned), stream);
  mega<<<256, 256, LDS_MAX, stream>>>(P);
}
```

```cpp
#define DUP 0
#define MOEQ 2
#define TSTAMP 0
#define CVT_SPLIT 1
#define CVT_IN_P4 1
#define STAG4 0
#define STAGX 0
#define WIN_SPLIT 1
#define CVT_IN_ATTN 0
#define YNT 0
#define ANT 0
#define BNT 1
#define UORD 0
#define LOOK1 1
#define LOOK2 0
#define WOUTQ 0
#define SKEW 0
#define PFW 0
#define MF16 0
#define EPI2 1
#define DEEP 0
#define PRE1 1
#define STREAM 3
#define CVTSW 0
#define PFD 8
#define CVT_STAGGER 1
#include <hip/hip_runtime.h>
#include <hip/hip_bf16.h>
#include <stdint.h>
#include <type_traits>
#define T_      8192
#define SEQ_    4096
#define D_      2048
#define NC_     4176
#define C_GQ    0
#define C_GK    512
#define C_GV    1024
#define C_GR    2048
#define C_GD    3072
#define C_MQ    3088
#define C_MKV   3600
#define C_MKR   4112
#define NE_     32
#define DFF_    2048
#define EPS_    1e-6f
typedef short bf16x8 __attribute__((ext_vector_type(8)));
typedef short s16x4 __attribute__((ext_vector_type(4)));
typedef float f32x16 __attribute__((ext_vector_type(16)));
typedef float f32x4 __attribute__((ext_vector_type(4)));
typedef float f32x2 __attribute__((ext_vector_type(2)));
typedef unsigned short u16;
typedef unsigned u32x4 __attribute__((ext_vector_type(4)));
typedef unsigned u32x2 __attribute__((ext_vector_type(2)));
#define LAS3 __attribute__((address_space(3)))
#define OPAQUE(x) asm volatile("" : "+v"(x))
#define NTHR 256
__device__ __forceinline__ int opaque_tid() { int t = threadIdx.x; asm volatile("" : "+v"(t)); return t; }

__device__ __forceinline__ unsigned pack_bf16(float a, float b) {
  typedef __bf16 bf2 __attribute__((ext_vector_type(2)));
  typedef float f2 __attribute__((ext_vector_type(2)));
  f2 v = {a, b};
  bf2 r = __builtin_convertvector(v, bf2);
  return *(unsigned*)&r;
}
__device__ __forceinline__ float bf_lo(unsigned w) { return __uint_as_float(w << 16); }
__device__ __forceinline__ float bf_hi(unsigned w) { return __uint_as_float(w & 0xffff0000u); }
__device__ __forceinline__ float bf16_to_f32(u16 v) { return __uint_as_float(((unsigned)v) << 16); }
__device__ __forceinline__ u16 f32_to_bf16(float f) { return (u16)(pack_bf16(f, 0.f) & 0xffffu); }
__device__ __forceinline__ float shflx(float v, int k) {
  int t = threadIdx.x; asm volatile("" : "+v"(t));
  return __int_as_float(__builtin_amdgcn_ds_bpermute((((t & 63) ^ k) << 2), __float_as_int(v)));
}
__device__ __forceinline__ float wave_sum(float v) {
#pragma unroll
  for (int o = 32; o > 0; o >>= 1) v += shflx(v, o);
  return v;
}
__device__ __forceinline__ unsigned off_b(unsigned row, unsigned ch) { return 256u * row + 16u * (ch ^ (((row & 3u) << 2) | ((row >> 2) & 3u))); }
__device__ __forceinline__ unsigned tr_addr(unsigned lane, unsigned c, unsigned row0  ) {
  const unsigned blk = (lane >> 4) & 1u, q = (lane & 15u) >> 2, p = lane & 3u;
  return off_b(row0 + q, 4u * c + 2u * blk + (p >> 1)) + 8u * (p & 1u);
}
__device__ __forceinline__ bf16x8 tr_frag(const char* img, unsigned lane, unsigned c, unsigned row_a, unsigned row_b) {
  s16x4 v0 = __builtin_amdgcn_ds_read_tr16_b64_v4i16((LAS3 s16x4*)(img + tr_addr(lane, c, row_a)));
  s16x4 v1 = __builtin_amdgcn_ds_read_tr16_b64_v4i16((LAS3 s16x4*)(img + tr_addr(lane, c, row_b)));
  return (bf16x8){v0[0], v0[1], v0[2], v0[3], v1[0], v1[1], v1[2], v1[3]};
}

__device__ __forceinline__ void glds16_asm(const void* gsrc, unsigned lds_dst) {
  unsigned keep;
  asm volatile("s_mov_b32 %0, m0\n\ts_mov_b32 m0, %2\n\ts_nop 0\n\tglobal_load_lds_dwordx4 %1, off\n\ts_mov_b32 m0, %0" : "=&s"(keep) : "v"(gsrc), "s"(lds_dst) : "memory");
}
__device__ __forceinline__ void glds16_asm_nt(const void* gsrc, unsigned lds_dst) {
  unsigned keep;
  asm volatile("s_mov_b32 %0, m0\n\ts_mov_b32 m0, %2\n\ts_nop 0\n\tglobal_load_lds_dwordx4 %1, off nt\n\ts_mov_b32 m0, %0" : "=&s"(keep) : "v"(gsrc), "s"(lds_dst) : "memory");
}
__device__ __forceinline__ void glds4_asm(const void* gsrc, unsigned lds_dst) {
  unsigned keep;
  asm volatile("s_mov_b32 %0, m0\n\ts_mov_b32 m0, %2\n\ts_nop 0\n\tglobal_load_lds_dword %1, off\n\ts_mov_b32 m0, %0" : "=&s"(keep) : "v"(gsrc), "s"(lds_dst) : "memory");
}
struct Params {
  const float *x; const int* pos;
  const float *attn_norm, *w_in, *gate_up, *gate_bias, *gla_out_norm, *q_norm, *w_uq, *kv_norm, *w_ukv, *mla_out_norm, *w_out,
              *ffn_norm, *router_w, *router_b, *w_gu, *b_gu, *w_dn, *b_dn, *final_norm;
  float* out;
  char* ws;
  __device__ __forceinline__ unsigned* bar() const { return (unsigned*)(ws + 0ull); }
  __device__ __forceinline__ int* counts() const { return (int*)(ws + 16384ull); }
  __device__ __forceinline__ u16* h1() const { return (u16*)(ws + 16640ull); }
  __device__ __forceinline__ u16* proj() const { return (u16*)(ws + 33571072ull); }
  __device__ __forceinline__ float2* cs() const { return (float2*)(ws + 101990656ull); }
  __device__ __forceinline__ float* rq() const { return (float*)(ws + 104087808ull); }
  __device__ __forceinline__ float* rkv() const { return (float*)(ws + 104120576ull); }
  __device__ __forceinline__ float* bcum() const { return (float*)(ws + 104153344ull); }
  __device__ __forceinline__ u16* q() const { return (u16*)(ws + 120930560ull); }
  __device__ __forceinline__ u16* kv() const { return (u16*)(ws + 146096384ull); }
  __device__ __forceinline__ u16* kpe() const { return (u16*)(ws + 179650816ull); }
  __device__ __forceinline__ u16* kvc() const { return (u16*)(ws + 180699392ull); }
  __device__ __forceinline__ float* dec() const { return (float*)(ws + 214253824ull); }
  __device__ __forceinline__ u16* sprev() const { return (u16*)(ws + 214515968ull); }
  __device__ __forceinline__ u16* mix() const { return (u16*)(ws + 248070400ull); }
  __device__ __forceinline__ u16* omla() const { return (u16*)(ws + 281624832ull); }
  __device__ __forceinline__ float* x1() const { return (float*)(ws + 298402048ull); }
  __device__ __forceinline__ u16* h2() const { return (u16*)(ws + 365510912ull); }
  __device__ __forceinline__ int* list() const { return (int*)(ws + 399065344ull); }
  __device__ __forceinline__ int* asg_e() const { return (int*)(ws + 400113920ull); }
  __device__ __forceinline__ int* asg_slot() const { return (int*)(ws + 400244992ull); }
  __device__ __forceinline__ float* asg_g() const { return (float*)(ws + 400376064ull); }
  __device__ __forceinline__ u16* act() const { return (u16*)(ws + 400507136ull); }
  __device__ __forceinline__ u16* ybuf() const { return (u16*)(ws + 568279296ull); }
  __device__ __forceinline__ unsigned char* wq_gu() const { return (unsigned char*)(ws + 736051456ull); }
  __device__ __forceinline__ unsigned char* wq_dn() const { return (unsigned char*)(ws + 1004486912ull); }
  __device__ __forceinline__ unsigned char* h2q() const { return (unsigned char*)(ws + 1138704640ull); }
  __device__ __forceinline__ unsigned char* actq() const { return (unsigned char*)(ws + 1155481856ull); }
  __device__ __forceinline__ u16* wb_in() const { return (u16*)(ws + 1239367936ull); }
  __device__ __forceinline__ u16* wb_uq() const { return (u16*)(ws + 1257193728ull); }
  __device__ __forceinline__ u16* wb_ukv() const { return (u16*)(ws + 1258766592ull); }
  __device__ __forceinline__ u16* wb_out() const { return (u16*)(ws + 1260863744ull); }
  __device__ __forceinline__ unsigned char* mixq() const { return (unsigned char*)(ws + 1269252352ull); }
  __device__ __forceinline__ unsigned char* wq_out() const { return (unsigned char*)(ws + 1286029568ull); }
  __device__ __forceinline__ float* pn() const { return (float*)(ws + 1290223872ull); }
  __device__ __forceinline__ u32x4* dummy() const { return (u32x4*)(ws + 1311195648ull); }
};
#define WS_BYTES_USED 1312244480ull

#define XB_TMO      128
#define XB_XCNT(j)  (256  + 64 * (j))
#define XB_XSUB(j)  (1280 + 64 * (j))
#define XB_XGEN(j)  (2304 + 64 * (j))
#define XB_TOP      3328
#define XB_TOPGEN   3392
#define XCD_BAR_WORDS 3456
#define XB_SPIN_CAP (1u << 18)
#define LAS __attribute__((address_space(3)))

__device__ __forceinline__ unsigned xb_ld(unsigned* p)              { return __hip_atomic_load(p, __ATOMIC_RELAXED, __HIP_MEMORY_SCOPE_AGENT); }
__device__ __forceinline__ unsigned xb_add(unsigned* p, unsigned v) { return __hip_atomic_fetch_add(p, v, __ATOMIC_RELAXED, __HIP_MEMORY_SCOPE_AGENT); }
__device__ __forceinline__ unsigned xb_xcc_id() { return (unsigned)__builtin_amdgcn_s_getreg((3 << 11) | 20) & 0xFu; }
#define XB_SPIN(cond, bar) do { unsigned _sp = 0; while (cond) { __builtin_amdgcn_s_sleep(1); \
    if ((++_sp & 255u) == 0u) { if (xb_ld(&(bar)[XB_TMO])) break; if (_sp > XB_SPIN_CAP) { atomicAdd(&(bar)[XB_TMO], 1u); break; } } } } while (0)

struct XcdBarrier {
    unsigned* bar; unsigned x;
    volatile LAS unsigned* st;
};

__device__ __forceinline__ XcdBarrier xcd_barrier_post(unsigned* bar, volatile LAS unsigned* st) {
    XcdBarrier b; b.bar = bar; b.x = xb_xcc_id(); b.st = st;
    if (threadIdx.x == 0) (void)xb_add(&bar[XB_XCNT(b.x)], 1u);
    return b;
}
__device__ __forceinline__ void xcd_barrier_complete(unsigned* bar, unsigned x, unsigned& nloc, unsigned& nx) {
    const unsigned G = gridDim.x * gridDim.y * gridDim.z;
    unsigned sum, cnt, mine, sp = 0u;
    for (;;) {
        sum = 0u; cnt = 0u; mine = 0u;
#pragma unroll
        for (unsigned j = 0; j < 16; ++j) { const unsigned c = xb_ld(&bar[XB_XCNT(j)]); sum += c; cnt += (c > 0u) ? 1u : 0u; mine = (j == x) ? c : mine; }
        if (sum == G) break;
        __builtin_amdgcn_s_sleep(1);
        if ((++sp & 255u) == 0u) { if (xb_ld(&bar[XB_TMO])) break; if (sp > XB_SPIN_CAP) { atomicAdd(&bar[XB_TMO], 1u); break; } }
    }
    nloc = mine > 0u ? mine : 1u; nx = cnt > 0u ? cnt : 1u;
}

__device__ __forceinline__ void xcd_barrier(const XcdBarrier& b) {
    asm volatile("s_waitcnt vmcnt(0)" ::: "memory");
    __syncthreads();
    if (threadIdx.x == 0) {
        unsigned* bar = b.bar;
        __builtin_amdgcn_s_waitcnt(0);
        unsigned nloc = b.st[0], nx = b.st[1];
        if (nloc == 0u) { xcd_barrier_complete(bar, b.x, nloc, nx); b.st[0] = nloc; b.st[1] = nx; }
        const unsigned old = xb_add(&bar[XB_XSUB(b.x)], 1u);
        const unsigned gen = old / nloc;
        if (old + 1u == (gen + 1u) * nloc) {
            __builtin_amdgcn_fence(__ATOMIC_RELEASE, "agent");
            asm volatile("s_waitcnt vmcnt(0)" ::: "memory");
            const unsigned og = xb_add(&bar[XB_TOP], 1u);
            const unsigned tg = og / nx;
            if (og + 1u == (tg + 1u) * nx) xb_add(&bar[XB_TOPGEN], 1u);
            else XB_SPIN(xb_ld(&bar[XB_TOPGEN]) == tg, bar);
            __builtin_amdgcn_fence(__ATOMIC_ACQUIRE, "agent");
            xb_add(&bar[XB_XGEN(b.x)], 1u);
            asm volatile("s_waitcnt vmcnt(0)" ::: "memory");
        } else {
            XB_SPIN(xb_ld(&bar[XB_XGEN(b.x)]) == gen, bar);
            __builtin_amdgcn_fence(__ATOMIC_ACQUIRE, "agent");
            asm volatile("s_waitcnt vmcnt(0)" ::: "memory");
        }
    }
    __syncthreads();
}

#define G_A_OFF(s)  ((s) * 65536)
#define G_B_OFF(s)  ((s) * 65536 + 32768)
#define G_LDS_BYTES 131072

struct GemmTile {
  const u16* A; int lda;
  const int* aidx;
  int m0, mvalid;
  const float* B0; const float* B1;
  int ldb; int nv0, nv1;
  const float* kscale;
  int K;
};

template <int NB, bool KSCALE, bool GATHER>
__device__ __forceinline__ void gemm_tile_256(const GemmTile& t, char* smem, f32x16 (&acc)[4][4]) {
  int tz0 = threadIdx.x; asm volatile("" : "+v"(tz0));
  const int tid = tz0, lane = tid & 63, wid = tid >> 6, wr = wid >> 1, wc = wid & 1;
  const int l31 = lane & 31, hh = lane >> 5;
#pragma unroll
  for (int i = 0; i < 4; ++i)
#pragma unroll
    for (int j = 0; j < 4; ++j)
#pragma unroll
      for (int r = 0; r < 16; ++r) acc[i][j][r] = 0.f;

  const int a_c = (tid & 7) ^ ((tid >> 4) & 7);
  const u16* a_src[GATHER ? 8 : 1];
  if (GATHER) {
#pragma unroll
    for (int i = 0; i < (GATHER ? 8 : 1); ++i) {
      int r = (tid >> 3) + 32 * i;
      int rr = r < t.mvalid ? r : 0;
      a_src[i] = t.A + (long)t.aidx[rr] * t.lda + a_c * 8;
    }
  } else {
    a_src[0] = t.A + (long)(t.m0 + (tid >> 3)) * t.lda + a_c * 8;
  }
  const long a_step = 32L * t.lda;
  const int b_n4 = tid & 63, b_k = tid >> 6;
  const int b_k_u = __builtin_amdgcn_readfirstlane(b_k);
  const int b_img = b_n4 >> 5, b_ch = (b_n4 >> 1) & 15, b_half = b_n4 & 1;
  const bool b_ok = ((b_n4 & 31) * 4) < (b_img ? t.nv1 : t.nv0);
  const int b_loff = (b_ok ? ((b_img ? (int)(t.B1 - t.B0) : 0) + (b_n4 & 31) * 4) : 0) + b_k * t.ldb;
  f32x4 breg[16];

  const unsigned a_lds0 = (unsigned)(size_t)smem + (unsigned)__builtin_amdgcn_readfirstlane(wid) * 1024u;
  auto issue_a = [&](int kt, int s, int i) {
    glds16_asm((const void*)((GATHER ? a_src[GATHER ? i : 0] : a_src[0] + i * a_step) + kt * 64), a_lds0 + G_A_OFF(s) + i * 4096);
  };
  auto issue_b = [&](int kt, int j) {
    const float* ptr = t.B0 + (long)(kt * 64 + 4 * j) * t.ldb + b_loff;
    asm volatile("global_load_dwordx4 %0, %1, off" : "=v"(breg[j]) : "v"(ptr) : "memory");
  };
  auto write_b = [&](int kt, int s, int j) {
    const int k = b_k + 4 * j;
    f32x4 v = breg[j];
    if (KSCALE) { float sc = t.kscale[kt * 64 + b_k_u + 4 * j]; v *= sc; }
    if (!b_ok) v = (f32x4){0.f, 0.f, 0.f, 0.f};
    u32x2 w = {pack_bf16(v[0], v[1]), pack_bf16(v[2], v[3])};
    *(u32x2*)(smem + G_B_OFF(s) + b_img * 16384 + off_b(k, b_ch) + 8 * b_half) = w;
  };
#define WAITQ(N, g) asm volatile("s_waitcnt vmcnt(" #N ")" : "+v"(breg[4 * (g)]), "+v"(breg[4 * (g) + 1]), "+v"(breg[4 * (g) + 2]), "+v"(breg[4 * (g) + 3]) :: "memory")

  unsigned a_rd[4], b_rd[2][2];
#pragma unroll
  for (int ks = 0; ks < 4; ++ks) { const int row = wr * 128 + l31; a_rd[ks] = row * 128 + (((2 * ks + hh) ^ ((row >> 1) & 7)) * 16); }
#pragma unroll
  for (int tt = 0; tt < 2; ++tt)
#pragma unroll
    for (int nl = 0; nl < 2; ++nl) b_rd[tt][nl] = tr_addr(lane, wc * 2 + nl, 8 * hh + 4 * tt);
  auto load_a = [&](const char* As, int ks, bf16x8 (&af)[4]) {
#pragma unroll
    for (int mb = 0; mb < 4; ++mb) af[mb] = *(const bf16x8*)(As + a_rd[ks] + mb * 4096);
  };
  auto load_b1 = [&](const char* Bs, int ks, int nb, bf16x8& bfr) {
    const char* bi = Bs + (nb >> 1) * 16384 + ks * 4096;
    s16x4 v0 = __builtin_amdgcn_ds_read_tr16_b64_v4i16((LAS3 s16x4*)(bi + b_rd[0][nb & 1]));
    s16x4 v1 = __builtin_amdgcn_ds_read_tr16_b64_v4i16((LAS3 s16x4*)(bi + b_rd[1][nb & 1]));
    bfr = (bf16x8){v0[0], v0[1], v0[2], v0[3], v1[0], v1[1], v1[2], v1[3]};
  };

  auto kstep = [&](int kt, auto mode_tag, bool has1, bool has2) {
    constexpr int MODE = decltype(mode_tag)::value;
    const int s = kt & 1;
    const char* As = smem + G_A_OFF(s);
    const char* Bs = smem + G_B_OFF(s);
    bf16x8 a0[4], a1[4], bq[NB];
    load_a(As, 0, a0);
#pragma unroll
    for (int nb = 0; nb < NB; ++nb) load_b1(Bs, 0, nb, bq[nb]);
    __builtin_amdgcn_sched_barrier(0);
#pragma unroll
    for (int g = 0; g < 4; ++g) {
      bf16x8 (&ac)[4] = (g & 1) ? a1 : a0;
      bf16x8 (&an)[4] = (g & 1) ? a0 : a1;
      if (g < 3) load_a(As, g + 1, an);
      __builtin_amdgcn_sched_barrier(0);
#pragma unroll
      for (int nb = 0; nb < NB; ++nb) {
#pragma unroll
        for (int mb = 0; mb < 4; ++mb)
          acc[mb][nb] = __builtin_amdgcn_mfma_f32_32x32x16_bf16(ac[mb], bq[nb], acc[mb][nb], 0, 0, 0);
        __builtin_amdgcn_sched_barrier(0);
        if (g < 3) load_b1(Bs, g + 1, nb, bq[nb]);
        if (nb == 0 && g < 2 && has1) { issue_a(kt + 1, s ^ 1, 4 * g + 0); issue_a(kt + 1, s ^ 1, 4 * g + 1); }
        if (nb == 1 % NB && g < 2 && has1 && NB > 1) { issue_a(kt + 1, s ^ 1, 4 * g + 2); issue_a(kt + 1, s ^ 1, 4 * g + 3); }
        if (NB == 1 && nb == 0 && g < 2 && has1) { issue_a(kt + 1, s ^ 1, 4 * g + 2); issue_a(kt + 1, s ^ 1, 4 * g + 3); }
        if (nb == NB - 1 && has1) {
          if (MODE == 2) { if (g == 0) WAITQ(20, 0); else if (g == 1) WAITQ(20, 1); else if (g == 2) WAITQ(20, 2); else WAITQ(20, 3); }
          else if (MODE == 1) { if (g == 0) WAITQ(16, 0); else if (g == 1) WAITQ(20, 1); else if (g == 2) WAITQ(20, 2); else WAITQ(20, 3); }
          else { if (g == 0) WAITQ(0, 0); else if (g == 1) WAITQ(0, 1); else if (g == 2) WAITQ(0, 2); else WAITQ(0, 3); }
#pragma unroll
          for (int i = 0; i < 4; ++i) write_b(kt + 1, s ^ 1, 4 * g + i);
          if (has2) {
#pragma unroll
            for (int i = 0; i < 4; ++i) issue_b(kt + 2, 4 * g + i);
          }
        }
        __builtin_amdgcn_sched_barrier(0);
      }
    }
    if (has1) {
      if (MODE == 0) asm volatile("s_waitcnt vmcnt(0)" ::: "memory");
      else asm volatile("s_waitcnt vmcnt(12)" ::: "memory");
      __syncthreads();
    }
  };

  const int nk = t.K >> 6;
  __syncthreads();
#pragma unroll
  for (int j = 0; j < 16; ++j) issue_b(0, j);
#pragma unroll
  for (int i = 0; i < 8; ++i) issue_a(0, 0, i);
  WAITQ(8, 0); WAITQ(8, 1); WAITQ(8, 2); WAITQ(8, 3);
#pragma unroll
  for (int j = 0; j < 16; ++j) write_b(0, 0, j);
#pragma unroll
  for (int j = 0; j < 16; ++j) issue_b(1, j);
  asm volatile("s_waitcnt vmcnt(16)" ::: "memory");
  __syncthreads();
  kstep(0, std::integral_constant<int, 1>{}, true, true);
  for (int kt = 1; kt < nk - 2; ++kt) kstep(kt, std::integral_constant<int, 2>{}, true, true);
  kstep(nk - 2, std::integral_constant<int, 0>{}, true, false);
  kstep(nk - 1, std::integral_constant<int, 0>{}, false, false);
#undef WAITQ
}
template <int NB, class F>
__device__ __forceinline__ void acc_foreach_row(f32x16 (&acc)[4][4], F f) {
  int tz = threadIdx.x; asm volatile("" : "+v"(tz));
  const int lane = tz & 63, wid = tz >> 6, wr = wid >> 1, wc = wid & 1;
  const int l31 = lane & 31, hh = lane >> 5;
#pragma unroll
  for (int mb = 0; mb < 4; ++mb)
#pragma unroll
    for (int reg = 0; reg < 16; ++reg) {
      const int rowl = wr * 128 + mb * 32 + (reg & 3) + 8 * (reg >> 2) + 4 * hh;
      float v[NB];
#pragma unroll
      for (int nb = 0; nb < NB; ++nb) v[nb] = acc[mb][nb][reg];
      f(rowl, wc * 64 + l31, v);
      asm volatile("" ::: "memory");
    }
}
__device__ __forceinline__ void ph_prep0(const Params& p) {
  const int tid_ = opaque_tid(); const int lane = tid_ & 63, wid = tid_ >> 6;
  if (blockIdx.x == 0 && tid_ < 64) p.counts()[tid_] = 0;
  for (int t = blockIdx.x * 4 + wid; t < T_; t += gridDim.x * 4) {
    const float* xr = p.x + (long)t * 2048;
    f32x4 v[8]; float ss = 0.f;
#pragma unroll
    for (int j = 0; j < 8; ++j) { v[j] = __builtin_nontemporal_load((const f32x4*)(xr + j * 256 + lane * 4)); ss += v[j][0] * v[j][0] + v[j][1] * v[j][1] + v[j][2] * v[j][2] + v[j][3] * v[j][3]; }
    ss = wave_sum(ss);
    const float r = rsqrtf(ss * (1.0f / 2048.0f) + EPS_);
#pragma unroll
    for (int j = 0; j < 8; ++j) {
      f32x4 g = *(const f32x4*)(p.attn_norm + j * 256 + lane * 4);
      u32x2 w = {pack_bf16(v[j][0] * r * g[0], v[j][1] * r * g[1]), pack_bf16(v[j][2] * r * g[2], v[j][3] * r * g[3])};
      *(u32x2*)(p.h1() + (long)t * 2048 + j * 256 + lane * 4) = w;
    }
    if (lane < 32) {
      float inv = __builtin_amdgcn_exp2f(-(float)lane * (13.287712379549449f / 32.0f));
      float ang = (float)p.pos[t] * inv;
      double a = (double)ang;
      double k = rint(a * 0.15915494309189535);
      float rf = (float)fma(-k, 6.283185307179586, a);
      p.cs()[t * 32 + lane] = make_float2(__cosf(rf), __sinf(rf));
    }
  }
}

template <int NB>
__device__ __forceinline__ void win_tile(const Params& p, char* smem, int mt, int nt) {
  f32x16 acc[4][4];
  GemmTile t{};
  t.A = p.h1(); t.lda = 2048; t.aidx = nullptr; t.m0 = mt * 256; t.mvalid = 256;
  t.B0 = p.w_in + nt * 256; t.B1 = t.B0 + 128; t.ldb = NC_;
  const int rem = NC_ - nt * 256;
  t.nv0 = rem >= 128 ? 128 : rem; t.nv1 = rem >= 256 ? 128 : (rem > 128 ? rem - 128 : 0);
  t.kscale = nullptr; t.K = 2048;
  gemm_tile_256<NB, false, false>(t, smem, acc);
  u16* base = p.proj() + (long)(mt * 256) * NC_ + nt * 256;
  const int nv0 = t.nv0, nv1 = t.nv1;
  acc_foreach_row<NB>(acc, [&](int rowl, int coll, float (&v)[NB]) {
    u16* rp = base + (long)rowl * NC_ + coll;
    OPAQUE(rp);
#pragma unroll
    for (int nb = 0; nb < NB; ++nb) {
      const int c = (nb & 1) * 32 + coll;
      const int lim = (nb >> 1) ? nv1 : nv0;
      if (c < lim) rp[(nb >> 1) * 128 + (nb & 1) * 32] = f32_to_bf16(v[nb]);
    }
  });
}
__device__ __forceinline__ void ph_win(const Params& p, char* smem) {
  const int x = blockIdx.x & 7, slot = blockIdx.x >> 3;
  for (int j = slot; j < 64; j += 32) win_tile<4>(p, smem, 4 * x + (j & 3), j >> 2);
  if (slot < 4) win_tile<2>(p, smem, 4 * x + slot, 16);
}

__device__ __forceinline__ void ph_prep1(const Params& p, char* smem) {
  float* gds = (float*)smem;
  float* cums = (float*)(smem + 4096);
  const int tid = opaque_tid(), lane = tid & 63, wid = tid >> 6;
  for (int u = blockIdx.x; u < 512; u += gridDim.x) {
    const int ch = u >> 2, h = u & 3; const int t0 = ch * 64;
    __syncthreads();
    {
      const int tl = tid >> 2, r4 = (tid & 3) * 4;
      u32x2 w = *(const u32x2*)(p.proj() + (long)(t0 + tl) * NC_ + C_GD + r4);
      gds[tl * 16 + r4 + 0] = bf_lo(w[0]); gds[tl * 16 + r4 + 1] = bf_hi(w[0]);
      gds[tl * 16 + r4 + 2] = bf_lo(w[1]); gds[tl * 16 + r4 + 3] = bf_hi(w[1]);
    }
    const int c = tid & 127, half = tid >> 7;
    float gu[16];
#pragma unroll
    for (int r = 0; r < 16; ++r) gu[r] = p.gate_up[r * 512 + h * 128 + c];
    const float bias = p.gate_bias[h * 128 + c];
    __syncthreads();
    float run = 0.f;
    for (int i = 0; i < 32; ++i) {
      const int tl = half * 32 + i;
      float z = bias;
#pragma unroll
      for (int r = 0; r < 16; ++r) z = fmaf(gds[tl * 16 + r], gu[r], z);
      const float ls = fminf(z, 0.f) - __logf(1.0f + __expf(-fabsf(z)));
      run += ls * (1.0f / 16.0f);
      cums[tl * 128 + c] = run;
    }
    __syncthreads();
    {
      const float add = cums[31 * 128 + c];
      for (int i = 0; i < 32; ++i) {
        const int tl = half * 32 + i;
        float v = cums[tl * 128 + c] + (half ? add : 0.f);
        p.bcum()[(long)(t0 + tl) * 512 + h * 128 + c] = v;
      }
    }
    for (int i = 0; i < 4; ++i) {
      const long t = t0 + h * 16 + wid * 4 + i;
      const u16* pr = p.proj() + t * NC_;
      u32x4 a = *(const u32x4*)(pr + C_MQ + lane * 8);
      float sa = 0.f, sb = 0.f;
#pragma unroll
      for (int k = 0; k < 4; ++k) { float l = bf_lo(a[k]), hgh = bf_hi(a[k]); sa += l * l + hgh * hgh; }
#if WIN_SPLIT
      auto pn_sum = [&](int col) { float s = 0.f;
#pragma unroll
        for (int kc = 0; kc < 8; ++kc) s += p.pn()[(long)kc * (8192 * 80) + t * 80 + col];
        return s; };
      const float pv = bf16_to_f32(f32_to_bf16(pn_sum(lane)));
      u32x4 b = {0u, 0u, 0u, 0u};
      if (lane < 62) b = *(const u32x4*)(pr + C_MKV + lane * 8);
#pragma unroll
      for (int k = 0; k < 4; ++k) { float l = bf_lo(b[k]), hgh = bf_hi(b[k]); sb += l * l + hgh * hgh; }
      if (lane < 16) sb += pv * pv;
#else
      u32x4 b = *(const u32x4*)(pr + C_MKV + lane * 8);
#pragma unroll
      for (int k = 0; k < 4; ++k) { float l = bf_lo(b[k]), hgh = bf_hi(b[k]); sb += l * l + hgh * hgh; }
#endif
      sa = wave_sum(sa); sb = wave_sum(sb);
      if (lane == 0) { p.rq()[t] = rsqrtf(sa * (1.0f / 512.0f) + EPS_); p.rkv()[t] = rsqrtf(sb * (1.0f / 512.0f) + EPS_); }
#if WIN_SPLIT
      {
        const float v0 = pv;
        const float v1 = (lane < 16) ? bf16_to_f32(f32_to_bf16(pn_sum(64 + lane))) : 0.f;
        u16* pw = p.proj() + t * NC_ + 4096;
        pw[lane] = f32_to_bf16(v0);
        if (lane < 16) pw[64 + lane] = f32_to_bf16(v1);
        const float t1 = __int_as_float(__builtin_amdgcn_ds_bpermute(((lane + 16) & 63) << 2, __float_as_int(v0)));
        const float t2a = __int_as_float(__builtin_amdgcn_ds_bpermute(((lane + 48) & 63) << 2, __float_as_int(v0)));
        const float t2b = __int_as_float(__builtin_amdgcn_ds_bpermute(((lane - 16) & 63) << 2, __float_as_int(v1)));
        if (lane < 32) {
          const float t2 = (lane < 16) ? t2a : t2b;
          const float2 cs = p.cs()[t * 32 + lane];
          p.kpe()[t * 64 + lane] = f32_to_bf16(t1 * cs.x - t2 * cs.y);
          p.kpe()[t * 64 + lane + 32] = f32_to_bf16(t1 * cs.y + t2 * cs.x);
        }
      }
#else
      if (lane < 32) {
        const float t1 = bf16_to_f32(pr[C_MKR + lane]), t2 = bf16_to_f32(pr[C_MKR + lane + 32]);
        const float2 cs = p.cs()[t * 32 + lane];
        p.kpe()[t * 64 + lane] = f32_to_bf16(t1 * cs.x - t2 * cs.y);
        p.kpe()[t * 64 + lane + 32] = f32_to_bf16(t1 * cs.y + t2 * cs.x);
      }
#endif
    }
  }
}

#define QSCALE_ (0.07216878364870322f * 1.4426950408889634f)
__device__ __forceinline__ void upq_tile(const Params& p, char* smem, int mt, int nt) {
  f32x16 acc[4][4];
  GemmTile t{};
  t.A = p.proj() + C_MQ; t.lda = NC_; t.aidx = nullptr; t.m0 = mt * 256; t.mvalid = 256;
  t.B0 = p.w_uq + nt * 256; t.B1 = t.B0 + 128; t.ldb = 1536; t.nv0 = 128; t.nv1 = 128; t.kscale = p.q_norm; t.K = 512;
  gemm_tile_256<4, true, false>(t, smem, acc);
  u16* base = p.q() + (long)(mt * 256) * 1536 + nt * 256;
  const float* rq = p.rq() + mt * 256;
  acc_foreach_row<4>(acc, [&](int rowl, int coll, float (&v)[4]) {
    u16* rp = base + (long)rowl * 1536 + coll;
    OPAQUE(rp);
    const float s = rq[rowl] * QSCALE_;
#pragma unroll
    for (int nb = 0; nb < 4; ++nb) rp[(nb >> 1) * 128 + (nb & 1) * 32] = f32_to_bf16(v[nb] * s);
  });
}
__device__ __forceinline__ void upkv_tile(const Params& p, char* smem, int mt, int nt) {
  f32x16 acc[4][4];
  GemmTile t{};
  t.A = p.proj() + C_MKV; t.lda = NC_; t.aidx = nullptr; t.m0 = mt * 256; t.mvalid = 256;
  t.B0 = p.w_ukv + nt * 256; t.B1 = t.B0 + 128; t.ldb = 2048; t.nv0 = 128; t.nv1 = 128; t.kscale = p.kv_norm; t.K = 512;
  gemm_tile_256<4, true, false>(t, smem, acc);
  u16* base = p.kv() + (long)(mt * 256) * 2048 + nt * 256;
  const float* rk = p.rkv() + mt * 256;
  acc_foreach_row<4>(acc, [&](int rowl, int coll, float (&v)[4]) {
    u16* rp = base + (long)rowl * 2048 + coll;
    OPAQUE(rp);
    const float s = rk[rowl];
#pragma unroll
    for (int nb = 0; nb < 4; ++nb) rp[(nb >> 1) * 128 + (nb & 1) * 32] = f32_to_bf16(v[nb] * s);
  });
}
#define WSCALE_  128.0f
#define WISCALE_ 0.0078125f
typedef unsigned char u8;
struct CvtUnit { const float* src; u8* dst; int ldn; };
__device__ __forceinline__ CvtUnit cvt8_decode(const Params& p, int u);
#define AT_KSTRIDE 400
#define AT_KBYTES  (64 * AT_KSTRIDE)
#define AT_STAGE   (AT_KBYTES + 16384)
#define AT_LDS_BYTES (2 * AT_STAGE)

#define AT_CVT_T(par) (smem + AT_LDS_BYTES + (par) * 16384)
__device__ __forceinline__ void attn_unit(const Params& p, char* smem, int b, int h, int qb, int& ci) {
  const int tid = opaque_tid(), lane = tid & 63, wid = tid >> 6, l31 = lane & 31, hh = lane >> 5;
  const long tq = (long)b * SEQ_ + qb * 128 + wid * 32 + l31;
  bf16x8 qf[12];
  {
    const u16* qp = p.q() + (tq * 8 + h) * 192 + 8 * hh;
#pragma unroll
    for (int ks = 0; ks < 12; ++ks) qf[ks] = *(const bf16x8*)(qp + 16 * ks);
#pragma unroll
    for (int s = 0; s < 2; ++s) {
      const float2* cp = p.cs() + tq * 32 + 16 * s + 8 * hh;
      bf16x8 lo = qf[8 + s], hi = qf[10 + s], nlo, nhi;
#pragma unroll
      for (int j = 0; j < 8; j += 2) {
        float2 c0 = cp[j], c1 = cp[j + 1];
        float a0 = bf16_to_f32((u16)lo[j]), a1 = bf16_to_f32((u16)lo[j + 1]);
        float b0 = bf16_to_f32((u16)hi[j]), b1 = bf16_to_f32((u16)hi[j + 1]);
        unsigned wl = pack_bf16(a0 * c0.x - b0 * c0.y, a1 * c1.x - b1 * c1.y);
        unsigned wh = pack_bf16(a0 * c0.y + b0 * c0.x, a1 * c1.y + b1 * c1.x);
        nlo[j] = (short)(wl & 0xffff); nlo[j + 1] = (short)(wl >> 16);
        nhi[j] = (short)(wh & 0xffff); nhi[j + 1] = (short)(wh >> 16);
      }
      qf[8 + s] = nlo; qf[10 + s] = nhi;
    }
  }
  u32x4 kregA[6], vregA[4], kregB[6], vregB[4];
  const long tk0 = (long)b * SEQ_;
  auto load_tile = [&](int kt, u32x4 (&kreg)[6], u32x4 (&vreg)[4]) {
    const long tb = tk0 + kt * 64;
#pragma unroll
    for (int i = 0; i < 4; ++i) {
      const int pp = i * 256 + tid; const int key = pp >> 4, c = pp & 15;
      const u16* rowp = p.kv() + ((tb + key) * 8 + h) * 256 + c * 8;
      kreg[i] = *(const u32x4*)rowp;
      vreg[i] = *(const u32x4*)(rowp + 128);
    }
#pragma unroll
    for (int i = 0; i < 2; ++i) {
      const int pp = i * 256 + tid; const int key = pp >> 3, c = pp & 7;
      kreg[4 + i] = *(const u32x4*)(p.kpe() + (tb + key) * 64 + c * 8);
    }
  };
  auto store_tile = [&](int s, u32x4 (&kreg)[6], u32x4 (&vreg)[4]) {
    char* Ks = smem + s * AT_STAGE; char* Vs = Ks + AT_KBYTES;
#pragma unroll
    for (int i = 0; i < 4; ++i) {
      const int pp = i * 256 + tid; const int key = pp >> 4, c = pp & 15;
      *(u32x4*)(Ks + key * AT_KSTRIDE + c * 16) = kreg[i];
      *(u32x4*)(Vs + off_b(key, c)) = vreg[i];
    }
#pragma unroll
    for (int i = 0; i < 2; ++i) {
      const int pp = i * 256 + tid; const int key = pp >> 3, c = pp & 7;
      *(u32x4*)(Ks + key * AT_KSTRIDE + (16 + c) * 16) = kreg[4 + i];
    }
  };

  f32x16 o[4];
#pragma unroll
  for (int c = 0; c < 4; ++c)
#pragma unroll
    for (int r = 0; r < 16; ++r) o[c][r] = 0.f;
  float m = -1e30f, l = 0.f;
  const int nt = 2 * qb + 2;
  const int qpos = qb * 128 + wid * 32 + l31;

  __syncthreads();
  load_tile(0, kregA, vregA);
  store_tile(0, kregA, vregA);
  load_tile(1, kregB, vregB);
  if (nt > 2) load_tile(2, kregA, vregA);
  __syncthreads();
  auto tile_body = [&](int kt, int s) {
    const char* Ks = smem + s * AT_STAGE; const char* Vs = Ks + AT_KBYTES;
    const bool active = (kt * 64) <= (qb * 128 + wid * 32 + 31);
    if (active) {
      f32x16 sc[2];
#pragma unroll
      for (int kb = 0; kb < 2; ++kb) {
#pragma unroll
        for (int r = 0; r < 16; ++r) sc[kb][r] = 0.f;
#pragma unroll
        for (int ks = 0; ks < 12; ++ks) {
          bf16x8 a = *(const bf16x8*)(Ks + (kb * 32 + l31) * AT_KSTRIDE + (2 * ks + hh) * 16);
          sc[kb] = __builtin_amdgcn_mfma_f32_32x32x16_bf16(a, qf[ks], sc[kb], 0, 0, 0);
        }
      }
      if (kt >= 2 * qb) {
#pragma unroll
        for (int kb = 0; kb < 2; ++kb)
#pragma unroll
          for (int r = 0; r < 16; ++r) {
            const int key = kt * 64 + kb * 32 + (r & 3) + 8 * (r >> 2) + 4 * hh;
            if (key > qpos) sc[kb][r] = -1e30f;
          }
      }
      float mx = sc[0][0];
#pragma unroll
      for (int kb = 0; kb < 2; ++kb)
#pragma unroll
        for (int r = 0; r < 16; ++r) mx = fmaxf(mx, sc[kb][r]);
      mx = fmaxf(mx, shflx(mx, 32));
      const float mn = fmaxf(m, mx);
      const float alpha = __builtin_amdgcn_exp2f(m - mn);
      m = mn;
      float ps = 0.f;
      bf16x8 pf[4];
#pragma unroll
      for (int kb = 0; kb < 2; ++kb)
#pragma unroll
        for (int s2 = 0; s2 < 2; ++s2) {
          float e[8];
#pragma unroll
          for (int j = 0; j < 8; ++j) { e[j] = __builtin_amdgcn_exp2f(sc[kb][8 * s2 + j] - mn); ps += e[j]; }
          unsigned w0 = pack_bf16(e[0], e[1]), w1 = pack_bf16(e[2], e[3]), w2 = pack_bf16(e[4], e[5]), w3 = pack_bf16(e[6], e[7]);
          u32x4 w = {w0, w1, w2, w3};
          pf[kb * 2 + s2] = *(bf16x8*)&w;
        }
      l = l * alpha + ps;
#pragma unroll
      for (int c = 0; c < 4; ++c)
#pragma unroll
        for (int r = 0; r < 16; ++r) o[c][r] *= alpha;
#pragma unroll
      for (int c = 0; c < 4; ++c)
#pragma unroll
        for (int kk = 0; kk < 4; ++kk) {
          const unsigned rbase = 32 * (kk >> 1) + 16 * (kk & 1) + 4 * hh;
          bf16x8 a = tr_frag(Vs, lane, c, rbase, rbase + 8);
          o[c] = __builtin_amdgcn_mfma_f32_32x32x16_bf16(a, pf[kk], o[c], 0, 0, 0);
        }
    }
  };
#if CVT_IN_ATTN
  f32x4 cv[16];
  bool cv_inflight = false;
  u8* cv_dst = nullptr;
  bool cv_emitted = false;
  int cv_par = 0;
  auto cv_issue = [&]() {
    if (ci < 64) {
      const CvtUnit c = cvt8_decode(p, blockIdx.x + 256 * ci);
      const float* src = c.src + (long)(wid * 16) * c.ldn + lane * 4;
#pragma unroll
      for (int j = 0; j < 16; ++j) { const float* ptr = src + (long)j * c.ldn; asm volatile("global_load_dwordx4 %0, %1, off nt" : "=a"(cv[j]) : "v"(ptr) : "memory"); }
      cv_dst = c.dst; cv_inflight = true; ++ci;
    } else cv_inflight = false;
  };
  auto cv_emit = [&]() {
    cv_emitted = cv_inflight;
    if (cv_inflight) {
      asm volatile("s_waitcnt vmcnt(0)" : "+a"(cv[0]), "+a"(cv[1]), "+a"(cv[2]), "+a"(cv[3]), "+a"(cv[4]), "+a"(cv[5]), "+a"(cv[6]), "+a"(cv[7]),
                   "+a"(cv[8]), "+a"(cv[9]), "+a"(cv[10]), "+a"(cv[11]), "+a"(cv[12]), "+a"(cv[13]), "+a"(cv[14]), "+a"(cv[15]) :: "memory");
      char* T = AT_CVT_T(cv_par);
#pragma unroll
      for (int cc = 0; cc < 4; ++cc) {
        u32x4 x4;
#pragma unroll
        for (int q = 0; q < 4; ++q) {
          int x = 0;
          x = __builtin_amdgcn_cvt_pk_fp8_f32(cv[4 * q][cc] * WSCALE_, cv[4 * q + 1][cc] * WSCALE_, x, false);
          x = __builtin_amdgcn_cvt_pk_fp8_f32(cv[4 * q + 2][cc] * WSCALE_, cv[4 * q + 3][cc] * WSCALE_, x, true);
          x4[q] = (unsigned)x;
        }
        *(u32x4*)(T + (lane * 4 + cc) * 64 + wid * 16) = x4;
      }
    }
  };
  u8* cv_dst_e = nullptr;
  auto cv_flush = [&]() {
    if (cv_emitted) {
      const char* T = AT_CVT_T(cv_par);
#pragma unroll
      for (int i = 0; i < 4; ++i) {
        const int n = (tid >> 2) + 64 * i, ch = tid & 3;
        __builtin_nontemporal_store(*(const u32x4*)(T + n * 64 + ch * 16), (u32x4*)(cv_dst_e + (long)(n >> 1) * 4096 + (n & 1) * 64 + ch * 16));
      }
      cv_par ^= 1;
    }
  };
#define CV_BEFORE_BAR() do { cv_emit(); cv_dst_e = cv_dst; cv_issue(); } while (0)
#define CV_AFTER_BAR()  do { cv_flush(); } while (0)
  cv_issue();
#else
#define CV_BEFORE_BAR() do {} while (0)
#define CV_AFTER_BAR()  do {} while (0)
#endif
  for (int kt = 0; kt < nt; kt += 2) {
    tile_body(kt, 0);
    CV_BEFORE_BAR();
    store_tile(1, kregB, vregB);
    if (kt + 3 < nt) load_tile(kt + 3, kregB, vregB);
    __syncthreads();
    CV_AFTER_BAR();
    tile_body(kt + 1, 1);
    CV_BEFORE_BAR();
    if (kt + 2 < nt) {
      store_tile(0, kregA, vregA);
      if (kt + 4 < nt) load_tile(kt + 4, kregA, vregA);
    }
    __syncthreads();
    CV_AFTER_BAR();
  }
#if CVT_IN_ATTN
  cv_emit(); cv_dst_e = cv_dst; cv_inflight = false;
  __syncthreads();
  cv_flush();
#endif
#undef CV_BEFORE_BAR
#undef CV_AFTER_BAR
  l = l + shflx(l, 32);
  const float inv = 1.0f / l;
  u16* op = p.omla() + tq * 1024 + h * 128 + 4 * hh;
#pragma unroll
  for (int c = 0; c < 4; ++c)
#pragma unroll
    for (int rg = 0; rg < 4; ++rg) {
      u32x2 w = {pack_bf16(o[c][4 * rg] * inv, o[c][4 * rg + 1] * inv), pack_bf16(o[c][4 * rg + 2] * inv, o[c][4 * rg + 3] * inv)};
      *(u32x2*)(op + 32 * c + 8 * rg) = w;
    }
}

#define G1_LDS_BYTES 49152
__device__ __forceinline__ void gla_g1_unit(const Params& p, char* smem, int u) {
  const int tid = opaque_tid(), lane = tid & 63, wid = tid >> 6, l31 = lane & 31, hh = lane >> 5;
  const int bh = u >> 6, n = u & 63, b = bh >> 2, h = bh & 3;
  const long t0 = (long)b * SEQ_ + n * 64;
  char* Ks = smem; char* Vs = smem + 16384;
  __syncthreads();
  {
    const int ch = tid & 15;
    const float* bl = p.bcum() + (t0 + 63) * 512 + h * 128 + ch * 8;
    f32x4 bl0 = *(const f32x4*)bl, bl1 = *(const f32x4*)(bl + 4);
    if (tid < 128) p.dec()[(long)u * 128 + tid] = __expf(p.bcum()[(t0 + 63) * 512 + h * 128 + tid]);
#pragma unroll
    for (int i = 0; i < 4; ++i) {
      const int tok = (i * 256 + tid) >> 4;
      u32x4 kw = *(const u32x4*)(p.proj() + (t0 + tok) * NC_ + C_GK + h * 128 + ch * 8);
      const float* bp = p.bcum() + (t0 + tok) * 512 + h * 128 + ch * 8;
      f32x4 b0 = *(const f32x4*)bp, b1 = *(const f32x4*)(bp + 4);
      u32x4 w;
      w[0] = pack_bf16(bf_lo(kw[0]) * __expf(bl0[0] - b0[0]), bf_hi(kw[0]) * __expf(bl0[1] - b0[1]));
      w[1] = pack_bf16(bf_lo(kw[1]) * __expf(bl0[2] - b0[2]), bf_hi(kw[1]) * __expf(bl0[3] - b0[3]));
      w[2] = pack_bf16(bf_lo(kw[2]) * __expf(bl1[0] - b1[0]), bf_hi(kw[2]) * __expf(bl1[1] - b1[1]));
      w[3] = pack_bf16(bf_lo(kw[3]) * __expf(bl1[2] - b1[2]), bf_hi(kw[3]) * __expf(bl1[3] - b1[3]));
      *(u32x4*)(Ks + off_b(tok, ch)) = w;
    }
#pragma unroll
    for (int i = 0; i < 8; ++i) {
      const int pp = i * 256 + tid; const int tok = pp >> 5, c32 = pp & 31;
      u32x4 vw = *(const u32x4*)(p.proj() + (t0 + tok) * NC_ + C_GV + h * 256 + c32 * 8);
      *(u32x4*)(Vs + (c32 >> 4) * 16384 + off_b(tok, c32 & 15)) = vw;
    }
  }
  __syncthreads();
  f32x16 acc[4][2];
#pragma unroll
  for (int mb = 0; mb < 4; ++mb)
#pragma unroll
    for (int nb = 0; nb < 2; ++nb)
#pragma unroll
      for (int r = 0; r < 16; ++r) acc[mb][nb][r] = 0.f;
  const char* Vimg = Vs + (wid >> 1) * 16384;
#pragma unroll
  for (int ks = 0; ks < 4; ++ks) {
    bf16x8 af[4], bfr[2];
    const unsigned r0 = 16 * ks + 8 * hh;
#pragma unroll
    for (int mb = 0; mb < 4; ++mb) af[mb] = tr_frag(Ks, lane, mb, r0, r0 + 4);
#pragma unroll
    for (int nb = 0; nb < 2; ++nb) bfr[nb] = tr_frag(Vimg, lane, 2 * (wid & 1) + nb, r0, r0 + 4);
#pragma unroll
    for (int mb = 0; mb < 4; ++mb)
#pragma unroll
      for (int nb = 0; nb < 2; ++nb) acc[mb][nb] = __builtin_amdgcn_mfma_f32_32x32x16_bf16(af[mb], bfr[nb], acc[mb][nb], 0, 0, 0);
  }
  __syncthreads();
  {
    char* st = smem + wid * 16384;
#pragma unroll
    for (int mb = 0; mb < 4; ++mb)
#pragma unroll
      for (int r = 0; r < 16; ++r) {
        const int dk = mb * 32 + (r & 3) + 8 * (r >> 2) + 4 * hh;
        *(u16*)(st + dk * 128 + l31 * 2) = f32_to_bf16(acc[mb][0][r]);
        *(u16*)(st + dk * 128 + (32 + l31) * 2) = f32_to_bf16(acc[mb][1][r]);
      }
    u16* gb = p.kvc() + (long)u * 32768 + wid * 64;
#pragma unroll 4
    for (int it = 0; it < 16; ++it) {
      const int dk = it * 8 + (lane >> 3), ch = lane & 7;
      *(u32x4*)(gb + dk * 256 + ch * 8) = *(const u32x4*)(st + dk * 128 + ch * 16);
    }
  }
}

__device__ __forceinline__ void gla_g2_unit(const Params& p, int u) {
  const int tid = opaque_tid();
  const int bh = u >> 5, part = u & 31;
  const int dk = part * 4 + (tid >> 6), dv = (tid & 63) * 4;
  float s0 = 0.f, s1 = 0.f, s2 = 0.f, s3 = 0.f;
  const long ebase = (long)dk * 256 + dv;
#pragma unroll 8
  for (int n = 0; n < 64; ++n) {
    const long un = (long)(bh * 64 + n);
    u32x2 kw = *(const u32x2*)(p.kvc() + un * 32768 + ebase);
    const float d = p.dec()[un * 128 + dk];
    u32x2 w = {pack_bf16(s0, s1), pack_bf16(s2, s3)};
    *(u32x2*)(p.sprev() + un * 32768 + ebase) = w;
    s0 = fmaf(d, s0, bf_lo(kw[0])); s1 = fmaf(d, s1, bf_hi(kw[0]));
    s2 = fmaf(d, s2, bf_lo(kw[1])); s3 = fmaf(d, s3, bf_hi(kw[1]));
  }
}

#define G3_LDS_BYTES (16384 + 16384 + 32768 + 65536 + 1024)
__device__ __forceinline__ void gla_g3_unit(const Params& p, char* smem, int u) {
  const int tid = opaque_tid(), lane = tid & 63, wid = tid >> 6, l31 = lane & 31, hh = lane >> 5;
  const int bh = u >> 6, n = u & 63, b = bh >> 2, h = bh & 3;
  const long t0 = (long)b * SEQ_ + n * 64;
  char* Qd = smem; char* Ki = smem + 16384; char* Vs = smem + 32768; char* Sp = smem + 65536; float* red = (float*)(smem + 131072);
  __syncthreads();
  {
    const int ch = tid & 15;
    const float qs = 0.08838834764831845f;
#pragma unroll
    for (int i = 0; i < 4; ++i) {
      const int tok = (i * 256 + tid) >> 4;
      const u16* pr = p.proj() + (t0 + tok) * NC_ + h * 128 + ch * 8;
      u32x4 qw = *(const u32x4*)(pr + C_GQ), kw = *(const u32x4*)(pr + C_GK);
      const float* bp = p.bcum() + (t0 + tok) * 512 + h * 128 + ch * 8;
      f32x4 b0 = *(const f32x4*)bp, b1 = *(const f32x4*)(bp + 4);
      float e[8] = {__expf(b0[0]), __expf(b0[1]), __expf(b0[2]), __expf(b0[3]), __expf(b1[0]), __expf(b1[1]), __expf(b1[2]), __expf(b1[3])};
      u32x4 wq, wk;
#pragma unroll
      for (int k = 0; k < 4; ++k) {
        wq[k] = pack_bf16(bf_lo(qw[k]) * qs * e[2 * k], bf_hi(qw[k]) * qs * e[2 * k + 1]);
        wk[k] = pack_bf16(bf_lo(kw[k]) * __builtin_amdgcn_rcpf(e[2 * k]), bf_hi(kw[k]) * __builtin_amdgcn_rcpf(e[2 * k + 1]));
      }
      *(u32x4*)(Qd + off_b(tok, ch)) = wq;
      *(u32x4*)(Ki + off_b(tok, ch)) = wk;
    }
#pragma unroll
    for (int i = 0; i < 8; ++i) {
      const int pp = i * 256 + tid; const int tok = pp >> 5, c32 = pp & 31;
      u32x4 vw = *(const u32x4*)(p.proj() + (t0 + tok) * NC_ + C_GV + h * 256 + c32 * 8);
      *(u32x4*)(Vs + (c32 >> 4) * 16384 + off_b(tok, c32 & 15)) = vw;
    }
#pragma unroll
    for (int i = 0; i < 16; ++i) {
      const int pp = i * 256 + tid; const int dk = pp >> 5, c32 = pp & 31;
      u32x4 sw = *(const u32x4*)(p.sprev() + (long)u * 32768 + dk * 256 + c32 * 8);
      *(u32x4*)(Sp + (c32 >> 4) * 32768 + off_b(dk, c32 & 15)) = sw;
    }
  }
  __syncthreads();
  const int ib = wid & 1, dvh = wid >> 1;
  f32x16 sc[2];
#pragma unroll
  for (int jb = 0; jb < 2; ++jb) {
#pragma unroll
    for (int r = 0; r < 16; ++r) sc[jb][r] = 0.f;
    if (jb <= ib) {
#pragma unroll
      for (int ks = 0; ks < 8; ++ks) {
        bf16x8 a = *(const bf16x8*)(Ki + off_b(jb * 32 + l31, 2 * ks + hh));
        bf16x8 bq = *(const bf16x8*)(Qd + off_b(ib * 32 + l31, 2 * ks + hh));
        sc[jb] = __builtin_amdgcn_mfma_f32_32x32x16_bf16(a, bq, sc[jb], 0, 0, 0);
      }
#pragma unroll
      for (int r = 0; r < 16; ++r) {
        const int j = jb * 32 + (r & 3) + 8 * (r >> 2) + 4 * hh, i = ib * 32 + l31;
        if (j > i) sc[jb][r] = 0.f;
      }
    }
  }
  bf16x8 pf[4];
#pragma unroll
  for (int jb = 0; jb < 2; ++jb)
#pragma unroll
    for (int s2 = 0; s2 < 2; ++s2) {
      u32x4 w = {pack_bf16(sc[jb][8 * s2 + 0], sc[jb][8 * s2 + 1]), pack_bf16(sc[jb][8 * s2 + 2], sc[jb][8 * s2 + 3]),
                 pack_bf16(sc[jb][8 * s2 + 4], sc[jb][8 * s2 + 5]), pack_bf16(sc[jb][8 * s2 + 6], sc[jb][8 * s2 + 7])};
      pf[jb * 2 + s2] = *(bf16x8*)&w;
    }
  f32x16 o[4];
#pragma unroll
  for (int c = 0; c < 4; ++c)
#pragma unroll
    for (int r = 0; r < 16; ++r) o[c][r] = 0.f;
  const char* Vimg = Vs + dvh * 16384;
  const char* Simg = Sp + dvh * 32768;
#pragma unroll
  for (int c = 0; c < 4; ++c) {
#pragma unroll
    for (int kk = 0; kk < 4; ++kk) {
      if ((kk >> 1) <= ib) {
        const unsigned rbase = 32 * (kk >> 1) + 16 * (kk & 1) + 4 * hh;
        bf16x8 a = tr_frag(Vimg, lane, c, rbase, rbase + 8);
        o[c] = __builtin_amdgcn_mfma_f32_32x32x16_bf16(a, pf[kk], o[c], 0, 0, 0);
      }
    }
#pragma unroll
    for (int ks = 0; ks < 8; ++ks) {
      const unsigned r0 = 16 * ks + 8 * hh;
      bf16x8 a = tr_frag(Simg, lane, c, r0, r0 + 4);
      bf16x8 bq = *(const bf16x8*)(Qd + off_b(ib * 32 + l31, 2 * ks + hh));
      o[c] = __builtin_amdgcn_mfma_f32_32x32x16_bf16(a, bq, o[c], 0, 0, 0);
    }
  }
  float ss = 0.f;
#pragma unroll
  for (int c = 0; c < 4; ++c)
#pragma unroll
    for (int r = 0; r < 16; ++r) ss += o[c][r] * o[c][r];
  ss += shflx(ss, 32);
  if (hh == 0) red[dvh * 64 + ib * 32 + l31] = ss;
  __syncthreads();
  const float tot = red[ib * 32 + l31] + red[64 + ib * 32 + l31];
  const float rn = rsqrtf(tot * (1.0f / 256.0f) + EPS_);
  const long t = t0 + ib * 32 + l31;
  const u16* grp = p.proj() + t * NC_ + C_GR + h * 256 + dvh * 128 + 4 * hh;
  u16* op = p.mix() + t * 2048 + h * 256 + dvh * 128 + 4 * hh;
  const float* gp = p.gla_out_norm + dvh * 128 + 4 * hh;
#pragma unroll
  for (int c = 0; c < 4; ++c)
#pragma unroll
    for (int rg = 0; rg < 4; ++rg) {
      u32x2 gw = *(const u32x2*)(grp + 32 * c + 8 * rg);
      f32x4 g = *(const f32x4*)(gp + 32 * c + 8 * rg);
      float gr[4] = {bf_lo(gw[0]), bf_hi(gw[0]), bf_lo(gw[1]), bf_hi(gw[1])};
      float ov[4];
#pragma unroll
      for (int k = 0; k < 4; ++k) { float si = gr[k] * __builtin_amdgcn_rcpf(1.0f + __expf(-gr[k])); ov[k] = o[c][4 * rg + k] * rn * g[k] * si; }
#if WOUTQ
      {
        int q8 = 0;
        q8 = __builtin_amdgcn_cvt_pk_fp8_f32(ov[0], ov[1], q8, false);
        q8 = __builtin_amdgcn_cvt_pk_fp8_f32(ov[2], ov[3], q8, true);
        const int col = h * 256 + dvh * 128 + 4 * hh + 32 * c + 8 * rg;
        *(unsigned*)(p.mixq() + (t >> 1) * 4096 + (col >> 6) * 128 + (t & 1) * 64 + (col & 63)) = (unsigned)q8;
      }
#else
      u32x2 w = {pack_bf16(ov[0], ov[1]), pack_bf16(ov[2], ov[3])};
      *(u32x2*)(op + 32 * c + 8 * rg) = w;
#endif
    }
}

__device__ __forceinline__ void mla_norm_tokens(const Params& p) {
  const int tid_ = opaque_tid(); const int lane = tid_ & 63, wid = tid_ >> 6;
  for (int t = blockIdx.x * 4 + wid; t < T_; t += gridDim.x * 4) {
    const u16* src = p.omla() + (long)t * 1024;
    u32x4 a = *(const u32x4*)(src + lane * 8), b = *(const u32x4*)(src + 512 + lane * 8);
    float ss = 0.f;
#pragma unroll
    for (int k = 0; k < 4; ++k) { float x0 = bf_lo(a[k]), x1 = bf_hi(a[k]), y0 = bf_lo(b[k]), y1 = bf_hi(b[k]); ss += x0 * x0 + x1 * x1 + y0 * y0 + y1 * y1; }
    ss = wave_sum(ss);
    const float r = rsqrtf(ss * (1.0f / 1024.0f) + EPS_);
    const float* g = p.mla_out_norm;
    u32x4 wa, wb;
#pragma unroll
    for (int k = 0; k < 4; ++k) {
      wa[k] = pack_bf16(bf_lo(a[k]) * r * g[lane * 8 + 2 * k], bf_hi(a[k]) * r * g[lane * 8 + 2 * k + 1]);
      wb[k] = pack_bf16(bf_lo(b[k]) * r * g[512 + lane * 8 + 2 * k], bf_hi(b[k]) * r * g[512 + lane * 8 + 2 * k + 1]);
    }
#if WOUTQ
    {
      int qa0 = 0, qa1 = 0, qb0 = 0, qb1 = 0;
      qa0 = __builtin_amdgcn_cvt_pk_fp8_f32(bf_lo(wa[0]), bf_hi(wa[0]), qa0, false); qa0 = __builtin_amdgcn_cvt_pk_fp8_f32(bf_lo(wa[1]), bf_hi(wa[1]), qa0, true);
      qa1 = __builtin_amdgcn_cvt_pk_fp8_f32(bf_lo(wa[2]), bf_hi(wa[2]), qa1, false); qa1 = __builtin_amdgcn_cvt_pk_fp8_f32(bf_lo(wa[3]), bf_hi(wa[3]), qa1, true);
      qb0 = __builtin_amdgcn_cvt_pk_fp8_f32(bf_lo(wb[0]), bf_hi(wb[0]), qb0, false); qb0 = __builtin_amdgcn_cvt_pk_fp8_f32(bf_lo(wb[1]), bf_hi(wb[1]), qb0, true);
      qb1 = __builtin_amdgcn_cvt_pk_fp8_f32(bf_lo(wb[2]), bf_hi(wb[2]), qb1, false); qb1 = __builtin_amdgcn_cvt_pk_fp8_f32(bf_lo(wb[3]), bf_hi(wb[3]), qb1, true);
      const int ca = 1024 + lane * 8, cb = 1536 + lane * 8;
      const long tt = t;
      u32x2 va = {(unsigned)qa0, (unsigned)qa1}, vb = {(unsigned)qb0, (unsigned)qb1};
      *(u32x2*)(p.mixq() + (tt >> 1) * 4096 + (ca >> 6) * 128 + (tt & 1) * 64 + (ca & 63)) = va;
      *(u32x2*)(p.mixq() + (tt >> 1) * 4096 + (cb >> 6) * 128 + (tt & 1) * 64 + (cb & 63)) = vb;
    }
#else
    *(u32x4*)(p.mix() + (long)t * 2048 + 1024 + lane * 8) = wa;
    *(u32x4*)(p.mix() + (long)t * 2048 + 1024 + 512 + lane * 8) = wb;
#endif
  }
}
__device__ __forceinline__ void wout_tile(const Params& p, char* smem, int mt, int nt) {
  f32x16 acc[4][4];
  GemmTile t{};
  t.A = p.mix(); t.lda = 2048; t.aidx = nullptr; t.m0 = mt * 256; t.mvalid = 256;
  t.B0 = p.w_out + nt * 256; t.B1 = t.B0 + 128; t.ldb = 2048; t.nv0 = 128; t.nv1 = 128; t.kscale = nullptr; t.K = 2048;
  gemm_tile_256<4, false, false>(t, smem, acc);
  const long boff = (long)(mt * 256) * 2048 + nt * 256;
  acc_foreach_row<4>(acc, [&](int rowl, int coll, float (&v)[4]) {
    long o = boff + (long)rowl * 2048 + coll;
    OPAQUE(o);
    const float* xr = p.x + o; float* yr = p.x1() + o;
#pragma unroll
    for (int nb = 0; nb < 4; ++nb) { const int c = (nb >> 1) * 128 + (nb & 1) * 32; yr[c] = xr[c] + v[nb]; }
  });
}

#define P7_LDS_BYTES (4 * 32 * 33 * 4 + 4 * 64 * 4 + 32 * 33 * 4 + 128)
template <int DRY = 0>
__device__ __forceinline__ void ffn_prep_unit(const Params& p, char* smem, int u) {
  float* part = (float*)smem; float* ssq = part + 4 * 32 * 33; float* lg = ssq + 256; float* rs = lg + 32 * 33;
  const int tid = opaque_tid(), lane = tid & 63, wid = tid >> 6, l31 = lane & 31, hh = lane >> 5;
  __syncthreads();
  {
    const long t = (long)u * 32 + l31;
    const float* xr = p.x1() + t * 2048 + wid * 512;
    const float* gp = p.ffn_norm + wid * 512;
    const float* wp = p.router_w + (long)(wid * 512 + hh) * 32 + l31;
    f32x16 acc;
#pragma unroll
    for (int r = 0; r < 16; ++r) acc[r] = 0.f;
    float ss = 0.f;
#pragma unroll 4
    for (int m = 0; m < 128; ++m) {
      const f32x4 xv = *(const f32x4*)(xr + 4 * m);
      const f32x4 gv = *(const f32x4*)(gp + 4 * m);
      const float a0 = hh ? xv[1] : xv[0], a1 = hh ? xv[3] : xv[2];
      const float g0 = hh ? gv[1] : gv[0], g1 = hh ? gv[3] : gv[2];
      const float b0 = wp[(4 * m) * 32], b1 = wp[(4 * m + 2) * 32];
      ss += a0 * a0 + a1 * a1;
      acc = __builtin_amdgcn_mfma_f32_32x32x2f32(a0 * g0, b0, acc, 0, 0, 0);
      acc = __builtin_amdgcn_mfma_f32_32x32x2f32(a1 * g1, b1, acc, 0, 0, 0);
    }
#pragma unroll
    for (int r = 0; r < 16; ++r) part[(wid * 32 + (r & 3) + 8 * (r >> 2) + 4 * hh) * 33 + l31] = acc[r];
    ssq[wid * 64 + lane] = ss;
  }
  __syncthreads();
  {
    const int tl = tid >> 3, seg = tid & 7;
    if (seg == 0) {
      float s = 0.f;
#pragma unroll
      for (int w = 0; w < 4; ++w) s += ssq[w * 64 + tl] + ssq[w * 64 + 32 + tl];
      rs[tl] = rsqrtf(s * (1.0f / 2048.0f) + EPS_);
    }
  }
  __syncthreads();
  {
    const int tl = tid >> 3, seg = tid & 7;
    const float r = rs[tl];
#pragma unroll
    for (int c = 0; c < 4; ++c) {
      const int e = seg * 4 + c;
      const float s = part[(0 * 32 + tl) * 33 + e] + part[(1 * 32 + tl) * 33 + e] + part[(2 * 32 + tl) * 33 + e] + part[(3 * 32 + tl) * 33 + e];
      lg[tl * 33 + e] = s * r + p.router_b[e];
    }
  }
  __syncthreads();
  if (tid < 32 && !DRY) {
    const long tt = (long)u * 32 + tid;
    const float* L = lg + tid * 33;
    unsigned used = 0u; int i0 = 0, i1 = 0, i2 = 0, i3 = 0; float v0 = 0.f, v1 = 0.f, v2 = 0.f, v3 = 0.f;
#pragma unroll
    for (int k = 0; k < 4; ++k) {
      int bi = -1; float bv = 0.f;
      for (int i = 0; i < 32; ++i) {
        const float x = L[i];
        const bool take = !((used >> i) & 1u) && (bi < 0 || x > bv);
        bi = take ? i : bi; bv = take ? x : bv;
      }
      used |= 1u << bi;
      if (k == 0) { i0 = bi; v0 = bv; } else if (k == 1) { i1 = bi; v1 = bv; } else if (k == 2) { i2 = bi; v2 = bv; } else { i3 = bi; v3 = bv; }
    }
    const float e0 = 1.0f, e1 = __expf(v1 - v0), e2 = __expf(v2 - v0), e3 = __expf(v3 - v0);
    const float inv = 1.0f / (e0 + e1 + e2 + e3);
    const int s0 = atomicAdd(&p.counts()[i0], 1), s1 = atomicAdd(&p.counts()[i1], 1), s2 = atomicAdd(&p.counts()[i2], 1), s3 = atomicAdd(&p.counts()[i3], 1);
    p.list()[i0 * T_ + s0] = (int)tt; p.list()[i1 * T_ + s1] = (int)tt; p.list()[i2 * T_ + s2] = (int)tt; p.list()[i3 * T_ + s3] = (int)tt;
    p.asg_e()[tt * 4 + 0] = i0; p.asg_e()[tt * 4 + 1] = i1; p.asg_e()[tt * 4 + 2] = i2; p.asg_e()[tt * 4 + 3] = i3;
    p.asg_slot()[tt * 4 + 0] = s0; p.asg_slot()[tt * 4 + 1] = s1; p.asg_slot()[tt * 4 + 2] = s2; p.asg_slot()[tt * 4 + 3] = s3;
    p.asg_g()[tt * 4 + 0] = e0 * inv; p.asg_g()[tt * 4 + 1] = e1 * inv; p.asg_g()[tt * 4 + 2] = e2 * inv; p.asg_g()[tt * 4 + 3] = e3 * inv;
  }
  {
    const int tl = tid >> 3, seg = tid & 7;
    const long t = (long)u * 32 + tl;
    const float* xr = p.x1() + t * 2048;
    const float rr = rs[tl];
#pragma unroll 8
    for (int it = 0; it < 32; ++it) {
      const int kk = it * 64 + seg * 8;
      f32x4 v0 = *(const f32x4*)(xr + kk), v1 = *(const f32x4*)(xr + kk + 4);
      f32x4 g0 = *(const f32x4*)(p.ffn_norm + kk), g1 = *(const f32x4*)(p.ffn_norm + kk + 4);
      v0 = v0 * g0 * rr; v1 = v1 * g1 * rr;
#if MOEQ == 0
      u32x4 w = {pack_bf16(v0[0], v0[1]), pack_bf16(v0[2], v0[3]), pack_bf16(v1[0], v1[1]), pack_bf16(v1[2], v1[3])};
      *(u32x4*)(p.h2() + t * 2048 + kk) = w;
#else
      int q0 = 0, q1 = 0;
      q0 = __builtin_amdgcn_cvt_pk_fp8_f32(v0[0], v0[1], q0, false);
      q0 = __builtin_amdgcn_cvt_pk_fp8_f32(v0[2], v0[3], q0, true);
      q1 = __builtin_amdgcn_cvt_pk_fp8_f32(v1[0], v1[1], q1, false);
      q1 = __builtin_amdgcn_cvt_pk_fp8_f32(v1[2], v1[3], q1, true);
      u32x2 wq = {(unsigned)q0, (unsigned)q1};
      *(u32x2*)(p.h2q() + t * 2048 + kk) = wq;
#endif
    }
  }
}

__device__ __forceinline__ void moe_setup(const Params& p, int* mo) {
  __syncthreads();
  if (threadIdx.x == 0) {
    int s = 0;
    for (int e = 0; e < NE_; ++e) { const int c = p.counts()[e]; mo[e] = s; mo[40 + e] = c; s += (c + 255) >> 8; }
    mo[NE_] = s;
  }
  __syncthreads();
}
#ifndef MAPV
#define MAPV 0
#endif
__device__ __forceinline__ int xcd_unit(int round) { return MAPV ? (round * 256 + blockIdx.x) : (round * 256 + (blockIdx.x & 7) * 32 + (blockIdx.x >> 3)); }

__device__ __forceinline__ void moe1_tile(const Params& p, char* smem, const int* mo, int e, int nt, int mt) {
  f32x16 acc[4][4];
  GemmTile t{};
  const int cnt = p.counts()[e];
  t.A = p.h2(); t.lda = 2048; t.aidx = p.list() + e * T_ + mt * 256; t.m0 = 0; t.mvalid = min(256, cnt - mt * 256);
  t.B0 = p.w_gu + (long)e * 2048 * 4096 + nt * 128; t.B1 = t.B0 + 2048; t.ldb = 4096; t.nv0 = 128; t.nv1 = 128; t.kscale = nullptr; t.K = 2048;
  gemm_tile_256<4, false, true>(t, smem, acc);
  u16* base = p.act() + (long)(mo[e] * 256 + mt * 256) * 2048 + nt * 128;
  const float* bg = p.b_gu + e * 4096 + nt * 128; const float* bu = bg + 2048;
  const int tq_ = opaque_tid(); const int cl = (tq_ >> 6 & 1) * 64 + (tq_ & 31);
  const float bgv[2] = {bg[cl], bg[cl + 32]}, buv[2] = {bu[cl], bu[cl + 32]};
  acc_foreach_row<4>(acc, [&](int rowl, int coll, float (&v)[4]) {
    u16* rp = base + (long)rowl * 2048 + coll;
    OPAQUE(rp);
#pragma unroll
    for (int nb = 0; nb < 2; ++nb) {
      const int c = nb * 32;
      float g = fminf(v[nb] + bgv[nb], 7.0f);
      float uu = fminf(fmaxf(v[nb + 2] + buv[nb], -7.0f), 7.0f);
      float a = (uu + 1.0f) * (g * __builtin_amdgcn_rcpf(1.0f + __expf(-1.702f * g)));
      rp[c] = f32_to_bf16(a);
    }
  });
}
__device__ __forceinline__ void moe2_tile(const Params& p, char* smem, const int* mo, int e, int nt, int mt) {
  f32x16 acc[4][4];
  GemmTile t{};
  t.A = p.act(); t.lda = 2048; t.aidx = nullptr; t.m0 = mo[e] * 256 + mt * 256; t.mvalid = 256;
  t.B0 = p.w_dn + (long)e * 2048 * 2048 + nt * 256; t.B1 = t.B0 + 128; t.ldb = 2048; t.nv0 = 128; t.nv1 = 128; t.kscale = nullptr; t.K = 2048;
  gemm_tile_256<4, false, false>(t, smem, acc);
  u16* base = p.ybuf() + (long)t.m0 * 2048 + nt * 256;
  const float* bd = p.b_dn + e * 2048 + nt * 256;
  const int tq_ = opaque_tid(); const int cl = (tq_ >> 6 & 1) * 64 + (tq_ & 31);
  const float bdv[4] = {bd[cl], bd[cl + 32], bd[cl + 128], bd[cl + 160]};
  acc_foreach_row<4>(acc, [&](int rowl, int coll, float (&v)[4]) {
    u16* rp = base + (long)rowl * 2048 + coll;
    OPAQUE(rp);
#pragma unroll
    for (int nb = 0; nb < 4; ++nb) { const int c = (nb >> 1) * 128 + (nb & 1) * 32; rp[c] = f32_to_bf16(v[nb] + bdv[nb]); }
  });
}
template <int WHICH, int HALF = 0>
__device__ __forceinline__ void ph_moe(const Params& p, char* smem) {
  int* mo = (int*)(smem + G_LDS_BYTES);
  moe_setup(p, mo);
  const int NT = (WHICH == 1) ? 16 : 8;
  const int total = mo[NE_] * NT;
  if (HALF && ((blockIdx.x >> 3) & 1)) return;
  const int W = HALF ? 128 : 256;
  for (int round = 0;; ++round) {
    const int u = HALF ? (round * 128 + (blockIdx.x & 7) * 16 + (blockIdx.x >> 4)) : xcd_unit(round);
    if (round * W >= total) break;
    if (u >= total) continue;
    int e = 0;
    while (mo[e + 1] * NT <= u) ++e;
    const int local = u - mo[e] * NT, me = mo[e + 1] - mo[e];
    const int nt = local / me, mt = local - nt * me;
    if (WHICH == 1) moe1_tile(p, smem, mo, e, nt, mt); else moe2_tile(p, smem, mo, e, nt, mt);
  }
}

__device__ __forceinline__ void ph_final(const Params& p, char* smem, float dbg_scale = 1.0f) {
  int* mo = (int*)(smem + G_LDS_BYTES);
  moe_setup(p, mo);
  const int tid_ = opaque_tid(); const int lane = tid_ & 63, wid = tid_ >> 6;
  for (int t = blockIdx.x * 4 + wid; t < T_; t += gridDim.x * 4) {
    long rows[4]; float gg[4];
#pragma unroll
    for (int k = 0; k < 4; ++k) { rows[k] = (long)(mo[p.asg_e()[t * 4 + k]] * 256 + p.asg_slot()[t * 4 + k]) * 2048; gg[k] = p.asg_g()[t * 4 + k]; }
    f32x4 v[8]; float ss = 0.f;
#pragma unroll
    for (int j = 0; j < 8; ++j) {
      const int c = j * 256 + lane * 4;
      f32x4 a = __builtin_nontemporal_load((const f32x4*)(p.x1() + (long)t * 2048 + c));
#pragma unroll
      for (int k = 0; k < 4; ++k) {
        u32x2 w = __builtin_nontemporal_load((const u32x2*)(p.ybuf() + rows[k] + c));
        a[0] += gg[k] * bf_lo(w[0]); a[1] += gg[k] * bf_hi(w[0]); a[2] += gg[k] * bf_lo(w[1]); a[3] += gg[k] * bf_hi(w[1]);
      }
      v[j] = a; ss += a[0] * a[0] + a[1] * a[1] + a[2] * a[2] + a[3] * a[3];
    }
    ss = wave_sum(ss);
    const float r = rsqrtf(ss * (1.0f / 2048.0f) + EPS_);
#pragma unroll
    for (int j = 0; j < 8; ++j) {
      const int c = j * 256 + lane * 4;
      f32x4 g = *(const f32x4*)(p.final_norm + c);
      f32x4 o = {v[j][0] * r * g[0] * dbg_scale, v[j][1] * r * g[1] * dbg_scale, v[j][2] * r * g[2] * dbg_scale, v[j][3] * r * g[3] * dbg_scale};
      __builtin_nontemporal_store(o, (f32x4*)(p.out + (long)t * 2048 + c));
    }
  }
}

__device__ __forceinline__ CvtUnit cvt8_decode(const Params& p, int u) {
  CvtUnit c;
  if (u < 16384) {
    const int e = u >> 9, kb = (u >> 4) & 31, nt = u & 15;
    c.src = p.w_gu + (long)e * 2048 * 4096 + (long)(kb * 64) * 4096 + nt * 256; c.ldn = 4096;
    c.dst = p.wq_gu() + ((long)e * 4096 + nt * 256) * 2048 + kb * 128;
  } else {
    const int v = u - 16384; const int e = v >> 8, kb = (v >> 3) & 31, nt = v & 7;
    c.src = p.w_dn + (long)e * 2048 * 2048 + (long)(kb * 64) * 2048 + nt * 256; c.ldn = 2048;
    c.dst = p.wq_dn() + ((long)e * 2048 + nt * 256) * 2048 + kb * 128;
  }
  return c;
}
__device__ __forceinline__ void cvt8_load(const CvtUnit& c, int w, int lane, f32x4 (&v)[16]) {
  const float* src = c.src + (long)(w * 16) * c.ldn + lane * 4;
#pragma unroll
  for (int j = 0; j < 16; ++j) {
    const float* ptr = src + (long)j * c.ldn;
    asm volatile("global_load_dwordx4 %0, %1, off nt" : "=v"(v[j]) : "v"(ptr) : "memory");
  }
}
#define CVT_WAIT(N, v) asm volatile("s_waitcnt vmcnt(%16)" : "+v"(v[0]), "+v"(v[1]), "+v"(v[2]), "+v"(v[3]), "+v"(v[4]), "+v"(v[5]), "+v"(v[6]), "+v"(v[7]), \
    "+v"(v[8]), "+v"(v[9]), "+v"(v[10]), "+v"(v[11]), "+v"(v[12]), "+v"(v[13]), "+v"(v[14]), "+v"(v[15]) : "n"(N) : "memory")
__device__ __forceinline__ void cvt8_emit(const CvtUnit& c, int tid, int w, int lane, f32x4 (&v)[16], char* T) {
  __syncthreads();
#pragma unroll
  for (int cc = 0; cc < 4; ++cc) {
    u32x4 x4;
#pragma unroll
    for (int q = 0; q < 4; ++q) {
      int x = 0;
      x = __builtin_amdgcn_cvt_pk_fp8_f32(v[4 * q][cc] * WSCALE_, v[4 * q + 1][cc] * WSCALE_, x, false);
      x = __builtin_amdgcn_cvt_pk_fp8_f32(v[4 * q + 2][cc] * WSCALE_, v[4 * q + 3][cc] * WSCALE_, x, true);
      x4[q] = (unsigned)x;
    }
#if CVTSW
    *(u32x4*)(T + cc * 4096 + w * 1024 + ((lane + 4 * w + 2 * cc) & 63) * 16) = x4;
#else
    *(u32x4*)(T + (lane * 4 + cc) * 64 + w * 16) = x4;
#endif
  }
  __syncthreads();
#pragma unroll
  for (int i = 0; i < 4; ++i) {
    const int n = (tid >> 2) + 64 * i, ch = tid & 3;
#if CVTSW
    __builtin_nontemporal_store(*(const u32x4*)(T + (n & 3) * 4096 + ch * 1024 + (((n >> 2) + 4 * ch + 2 * (n & 3)) & 63) * 16), (u32x4*)(c.dst + (long)(n >> 1) * 4096 + (n & 1) * 64 + ch * 16));
#else
    __builtin_nontemporal_store(*(const u32x4*)(T + n * 64 + ch * 16), (u32x4*)(c.dst + (long)(n >> 1) * 4096 + (n & 1) * 64 + ch * 16));
#endif
  }
}
__device__ __forceinline__ void convert_units(const Params& p, char* smem, int first, int stride, int count) {
  const int tid = opaque_tid();
  const int w = tid >> 6, lane = tid & 63;
  if (count <= 0) return;
  f32x4 va[16], vb[16], vc[16];
  CvtUnit ca = cvt8_decode(p, first), cb = cvt8_decode(p, first + stride), cc = cvt8_decode(p, first + 2 * stride);
  cvt8_load(ca, w, lane, va);
  cvt8_load(cb, w, lane, vb);
  cvt8_load(cc, w, lane, vc);
  CVT_WAIT(32, va); cvt8_emit(ca, tid, w, lane, va, smem); ca = cvt8_decode(p, first + 3 * stride); cvt8_load(ca, w, lane, va);
  CVT_WAIT(36, vb); cvt8_emit(cb, tid, w, lane, vb, smem); cb = cvt8_decode(p, first + 4 * stride); cvt8_load(cb, w, lane, vb);
  CVT_WAIT(40, vc); cvt8_emit(cc, tid, w, lane, vc, smem); cc = cvt8_decode(p, first + 5 * stride); cvt8_load(cc, w, lane, vc);
  for (int i = 3; i + 3 < count; i += 3) {
    CVT_WAIT(40, va); cvt8_emit(ca, tid, w, lane, va, smem); ca = cvt8_decode(p, first + (i + 3) * stride); cvt8_load(ca, w, lane, va);
    CVT_WAIT(40, vb); cvt8_emit(cb, tid, w, lane, vb, smem); cb = cvt8_decode(p, first + (i + 4) * stride); cvt8_load(cb, w, lane, vb);
    CVT_WAIT(40, vc); cvt8_emit(cc, tid, w, lane, vc, smem); cc = cvt8_decode(p, first + (i + 5) * stride); cvt8_load(cc, w, lane, vc);
  }
  CVT_WAIT(0, va); cvt8_emit(ca, tid, w, lane, va, smem);
  CVT_WAIT(0, vb); cvt8_emit(cb, tid, w, lane, vb, smem);
  CVT_WAIT(0, vc); cvt8_emit(cc, tid, w, lane, vc, smem);
}
__device__ __forceinline__ void convert_one(const Params& p, char* smem, int u) {
  const int tid = opaque_tid();
  const int w = tid >> 6, lane = tid & 63;
  f32x4 va[16];
  CvtUnit ca = cvt8_decode(p, u);
  cvt8_load(ca, w, lane, va);
  CVT_WAIT(0, va); cvt8_emit(ca, tid, w, lane, va, smem);
}
__device__ __forceinline__ void ph_convert(const Params& p, char* smem) {
  convert_units(p, smem, blockIdx.x, gridDim.x, 24576 / 256);
}
__device__ __forceinline__ void ph_convert_gu(const Params& p, char* smem, int part, int nparts) {
  if (nparts == 1) {
    convert_units(p, smem, blockIdx.x, 256, 63);
    convert_one(p, smem, blockIdx.x + 63 * 256);
  } else if (part == 0) {
    convert_units(p, smem, blockIdx.x, 256, 33);
  } else {
    convert_units(p, smem, blockIdx.x + 33 * 256, 256, 30);
    convert_one(p, smem, blockIdx.x + 63 * 256);
  }
}
__device__ __forceinline__ void ph_convert_dn(const Params& p, char* smem) {
  convert_units(p, smem, 16384 + blockIdx.x, 256, 30);
  convert_one(p, smem, 16384 + blockIdx.x + 30 * 256);
  convert_one(p, smem, 16384 + blockIdx.x + 31 * 256);
}

#define R_STAGE 32768
struct GemmRTile {
  const u8* A; int lda; const int* aidx; int m0, mvalid;
  const u8* B; long brow0, brow1; int ldb;
  int pairb;
  int paira;
  int KB;
  int pa0, pan, pb0, pbn;
};
#ifndef PFD
#define PFD 8
#endif
template <bool FP8, bool GATHER, bool PF = false>
__device__ __forceinline__ void gemmr_tile_256(const GemmRTile& t, char* smem, f32x16 (&acc)[4][4]) {
  int tz0 = threadIdx.x; asm volatile("" : "+v"(tz0));
  const int tid = tz0, lane = tid & 63, wid = tid >> 6, wr = wid >> 1, wc = wid & 1;
  const int l31 = lane & 31, hh = lane >> 5;
#pragma unroll
  for (int i = 0; i < 4; ++i)
#pragma unroll
    for (int j = 0; j < 4; ++j)
#pragma unroll
      for (int r = 0; r < 16; ++r) acc[i][j][r] = 0.f;
  const int c_src = (tid & 3) ^ ((tid >> 4) & 3);
  const u8* a_src[GATHER ? 4 : 1];
  if (GATHER) {
#pragma unroll
    for (int i = 0; i < (GATHER ? 4 : 1); ++i) {
      int r = (tid >> 2) + 64 * i;
      int rr = r < t.mvalid ? r : 0;
      a_src[i] = t.A + (long)t.aidx[rr] * t.lda + c_src * 16;
    }
  } else {
    a_src[0] = t.A + (long)(t.m0 + (tid >> 2)) * t.lda + c_src * 16;
  }
  const long a_step = 64L * t.lda, b_step = 64L * t.ldb;
  const u8* b_src0 = t.B + (t.brow0 + (tid >> 2)) * t.ldb + c_src * 16;
  const u8* b_src1 = t.B + (t.brow1 + (tid >> 2)) * t.ldb + c_src * 16;
  const unsigned lds0 = (unsigned)(size_t)smem + (unsigned)__builtin_amdgcn_readfirstlane(wid) * 1024u;
  const u8* pf_src = nullptr; int pf_par = 0;
  const unsigned pf_lds = (unsigned)(size_t)smem + 131072u + 4096u + (unsigned)__builtin_amdgcn_readfirstlane(wid) * 256u;
  const int pf_ncol = t.KB >> 7;
  if (PF) {
    if (lane < 32) { const int n = t.pan >> 3; const int r = t.pa0 + wid * n + (lane & (n - 1)); pf_src = t.A + (long)(t.m0 + r) * t.lda; pf_par = (t.pan >> 1) * t.lda; }
    else { const int n = t.pbn >> 3; const int r = t.pb0 + wid * n + (lane & (n - 1)); pf_src = t.B + (r < 128 ? t.brow0 + r : t.brow1 + r - 128) * t.ldb; pf_par = (t.pbn >> 1) * t.ldb; }
  }
  auto pf_issue = [&](int kt) {
    if (PF) { const int col = min((kt >> 1) + PFD / 2, pf_ncol - 1); glds4_asm((const void*)(pf_src + ((kt & 1) ? pf_par : 0) + col * 128), pf_lds); }
  };
  auto issue = [&](int kt, int sl, int q) {
    if (q < 4) glds16_asm((const void*)((GATHER ? a_src[GATHER ? q : 0] : a_src[0] + q * a_step) + kt * 64), lds0 + sl * R_STAGE + q * 4096);
    else { const int i = q - 4; glds16_asm((const void*)((i < 2 ? b_src0 + i * b_step : b_src1 + (i - 2) * b_step) + kt * 64), lds0 + sl * R_STAGE + 16384 + i * 4096); }
  };
  unsigned a_rd[2], b_rd[2];
#pragma unroll
  for (int s2 = 0; s2 < 2; ++s2) {
    const int ra = wr * 128 + l31, rb = wc * 64 + l31;
    a_rd[s2] = ra * 64 + (((2 * s2 + hh) ^ ((ra >> 2) & 3)) * 16);
    b_rd[s2] = rb * 64 + (((2 * s2 + hh) ^ ((rb >> 2) & 3)) * 16);
  }
  auto load_frags = [&](const char* St, int s2, u32x4 (&af)[4], u32x4 (&bf)[4]) {
#pragma unroll
    for (int mb = 0; mb < 4; ++mb) af[mb] = *(const u32x4*)(St + a_rd[s2] + mb * 2048);
#pragma unroll
    for (int nb = 0; nb < 4; ++nb) bf[nb] = *(const u32x4*)(St + 16384 + b_rd[s2] + (nb >> 1) * 8192 + (nb & 1) * 2048);
  };
  auto mma = [&](u32x4 (&ac)[4], u32x4 (&bc)[4], int nb) {
    if (FP8) {
#pragma unroll
      for (int u = 0; u < 2; ++u) {
        const long bl = (long)(((unsigned long long)bc[nb][2 * u + 1] << 32) | bc[nb][2 * u]);
#pragma unroll
        for (int mb = 0; mb < 4; ++mb) {
          const long al = (long)(((unsigned long long)ac[mb][2 * u + 1] << 32) | ac[mb][2 * u]);
          acc[mb][nb] = __builtin_amdgcn_mfma_f32_32x32x16_fp8_fp8(al, bl, acc[mb][nb], 0, 0, 0);
        }
      }
    } else {
      const bf16x8 bb = *(const bf16x8*)&bc[nb];
#pragma unroll
      for (int mb = 0; mb < 4; ++mb) acc[mb][nb] = __builtin_amdgcn_mfma_f32_32x32x16_bf16(*(const bf16x8*)&ac[mb], bb, acc[mb][nb], 0, 0, 0);
    }
  };
  u32x4 a0[4], b0[4], a1[4], b1[4];
  auto half0 = [&](int kt, bool issueA) {
    const char* St = smem + (kt & 3) * R_STAGE;
    load_frags(St, 1, a1, b1);
    __builtin_amdgcn_sched_barrier(0);
#pragma unroll
    for (int nb = 0; nb < 4; ++nb) {
      mma(a0, b0, nb);
      __builtin_amdgcn_sched_barrier(0);
      if (issueA) issue(kt + 2 + DEEP, (kt + 2 + DEEP) & 3, 4 + nb);
      __builtin_amdgcn_sched_barrier(0);
    }
  };
  auto half1 = [&](int kt, bool has1, bool issueB) {
    const char* Sn = smem + ((kt + 1) & 3) * R_STAGE;
    if (has1) load_frags(Sn, 0, a0, b0);
    __builtin_amdgcn_sched_barrier(0);
#pragma unroll
    for (int nb = 0; nb < 4; ++nb) {
      mma(a1, b1, nb);
      __builtin_amdgcn_sched_barrier(0);
      if (issueB) issue(kt + 3 + DEEP, (kt + 3 + DEEP) & 3, nb);
      if (issueB && nb == 3) pf_issue(kt + 1);
      __builtin_amdgcn_sched_barrier(0);
    }
  };
  const int nk = t.KB >> 6;
  __syncthreads();
#pragma unroll
  for (int q = 0; q < 8; ++q) issue(0, 0, q);
#pragma unroll
  for (int q = 0; q < 8; ++q) issue(1, 1, q);
#pragma unroll
  for (int q = 0; q < 4; ++q) issue(2, 2, q);
#if DEEP
#pragma unroll
  for (int q = 4; q < 8; ++q) issue(2, 2, q);
#pragma unroll
  for (int q = 0; q < 4; ++q) issue(3, 3, q);
  asm volatile("s_waitcnt vmcnt(20)" ::: "memory");
  __syncthreads();
  load_frags(smem, 0, a0, b0);
#pragma nounroll
  for (int kt = 0; kt < nk - 4; ++kt) {
    half0(kt, true);
    asm volatile("s_waitcnt vmcnt(16)" ::: "memory");
    __syncthreads();
    half1(kt, true, true);
  }
  half0(nk - 4, true);
  asm volatile("s_waitcnt vmcnt(16)" ::: "memory");
  __syncthreads();
  half1(nk - 4, true, false);
  half0(nk - 3, false);
  asm volatile("s_waitcnt vmcnt(8)" ::: "memory");
  __syncthreads();
  half1(nk - 3, true, false);
  half0(nk - 2, false);
#else
  pf_issue(0);
  if (PF) asm volatile("s_waitcnt vmcnt(13)" ::: "memory"); else
  asm volatile("s_waitcnt vmcnt(12)" ::: "memory");
  __syncthreads();
  load_frags(smem, 0, a0, b0);
#pragma nounroll
  for (int kt = 0; kt < nk - 3; ++kt) {
    half0(kt, true);
    if (PF) asm volatile("s_waitcnt vmcnt(9)" ::: "memory"); else
    asm volatile("s_waitcnt vmcnt(8)" ::: "memory");
    __syncthreads();
    half1(kt, true, true);
  }
  half0(nk - 3, true);
  if (PF) asm volatile("s_waitcnt vmcnt(9)" ::: "memory"); else
  asm volatile("s_waitcnt vmcnt(8)" ::: "memory");
  __syncthreads();
  half1(nk - 3, true, false);
  half0(nk - 2, false);
#endif
  asm volatile("s_waitcnt vmcnt(0)" ::: "memory");
  __syncthreads();
  half1(nk - 2, true, false);
  half0(nk - 1, false);
  half1(nk - 1, false, false);
}


__device__ __forceinline__ void gemmr16_tile_256(const GemmRTile& t, char* smem, f32x4 (&acc)[8][8]) {
  int tz0 = threadIdx.x; asm volatile("" : "+v"(tz0));
  const int tid = tz0, lane = tid & 63, wid = tid >> 6, wr = wid >> 1, wc = wid & 1;
  const int r15 = lane & 15, kq = lane >> 4;
#pragma unroll
  for (int i = 0; i < 8; ++i)
#pragma unroll
    for (int j = 0; j < 8; ++j) acc[i][j] = (f32x4){0.f, 0.f, 0.f, 0.f};
  const int c_src = (tid & 3) ^ ((tid >> 4) & 3);
  const u8* a_src = t.A + (long)(t.m0 + (tid >> 2)) * t.lda + c_src * 16;
  const long a_step = 64L * t.lda, b_step = 64L * t.ldb;
  const u8* b_src0 = t.B + (t.brow0 + (tid >> 2)) * t.ldb + c_src * 16;
  const u8* b_src1 = t.B + (t.brow1 + (tid >> 2)) * t.ldb + c_src * 16;
  const unsigned lds0 = (unsigned)(size_t)smem + (unsigned)__builtin_amdgcn_readfirstlane(wid) * 1024u;
  auto issue = [&](int kt, int sl, int q) {
    if (q < 4) glds16_asm((const void*)(a_src + q * a_step + kt * 64), lds0 + sl * R_STAGE + q * 4096);
    else { const int i = q - 4; glds16_asm((const void*)((i < 2 ? b_src0 + i * b_step : b_src1 + (i - 2) * b_step) + kt * 64), lds0 + sl * R_STAGE + 16384 + i * 4096); }
  };
  const int ra = wr * 128 + r15, rb = wc * 64 + r15;
  const unsigned a_rd = ra * 64 + ((kq ^ ((ra >> 2) & 3)) * 16);
  const unsigned b_rd = 16384 + rb * 64 + ((kq ^ ((rb >> 2) & 3)) * 16);
  auto load_a = [&](const char* St, u32x4 (&af)[8]) {
#pragma unroll
    for (int mb = 0; mb < 8; ++mb) af[mb] = *(const u32x4*)(St + a_rd + mb * 1024);
  };
  auto load_b = [&](const char* St, int img, u32x4 (&bf)[4]) {
#pragma unroll
    for (int j = 0; j < 4; ++j) bf[j] = *(const u32x4*)(St + b_rd + img * 8192 + j * 1024);
  };
  u32x4 aF[8], b0[4], b1[4];
  auto half0 = [&](int kt, bool issueA) {
    const char* St = smem + (kt & 3) * R_STAGE;
    load_b(St, 1, b1);
    __builtin_amdgcn_sched_barrier(0);
#pragma unroll
    for (int mb = 0; mb < 8; ++mb) {
#pragma unroll
      for (int nb = 0; nb < 4; ++nb) asm volatile("v_mfma_f32_16x16x32_bf16 %0, %1, %2, %0" : "+a"(acc[mb][nb]) : "v"(aF[mb]), "v"(b0[nb]));
      __builtin_amdgcn_sched_barrier(0);
      if (issueA && (mb & 1)) issue(kt + 2, (kt + 2) & 3, 4 + (mb >> 1));
      __builtin_amdgcn_sched_barrier(0);
    }
  };
  auto half1 = [&](int kt, bool has1, bool issueB) {
    const char* Sn = smem + ((kt + 1) & 3) * R_STAGE;
    if (has1) load_b(Sn, 0, b0);
    __builtin_amdgcn_sched_barrier(0);
#pragma unroll
    for (int mb = 0; mb < 8; ++mb) {
#pragma unroll
      for (int nb = 0; nb < 4; ++nb) asm volatile("v_mfma_f32_16x16x32_bf16 %0, %1, %2, %0" : "+a"(acc[mb][4 + nb]) : "v"(aF[mb]), "v"(b1[nb]));
      __builtin_amdgcn_sched_barrier(0);
      if (has1) aF[mb] = *(const u32x4*)(Sn + a_rd + mb * 1024);
      if (issueB && (mb & 1)) issue(kt + 3, (kt + 3) & 3, mb >> 1);
      __builtin_amdgcn_sched_barrier(0);
    }
  };
  const int nk = t.KB >> 6;
  __syncthreads();
#pragma unroll
  for (int q = 0; q < 8; ++q) issue(0, 0, q);
#pragma unroll
  for (int q = 0; q < 8; ++q) issue(1, 1, q);
#pragma unroll
  for (int q = 0; q < 4; ++q) issue(2, 2, q);
  asm volatile("s_waitcnt vmcnt(12)" ::: "memory");
  __syncthreads();
  load_a(smem, aF); load_b(smem, 0, b0);
  for (int kt = 0; kt < nk - 3; ++kt) {
    half0(kt, true);
    asm volatile("s_waitcnt vmcnt(8)" ::: "memory"); __syncthreads();
    half1(kt, true, true);
  }
  half0(nk - 3, true);
  asm volatile("s_waitcnt vmcnt(8)" ::: "memory"); __syncthreads();
  half1(nk - 3, true, false);
  half0(nk - 2, false);
  asm volatile("s_waitcnt vmcnt(0)" ::: "memory"); __syncthreads();
  half1(nk - 2, true, false);
  half0(nk - 1, false);
  half1(nk - 1, false, false);
  asm volatile("s_nop 15\n\ts_nop 15" ::: "memory");
#pragma unroll
  for (int mb = 0; mb < 8; ++mb)
    asm volatile("" : "+a"(acc[mb][0]), "+a"(acc[mb][1]), "+a"(acc[mb][2]), "+a"(acc[mb][3]), "+a"(acc[mb][4]), "+a"(acc[mb][5]), "+a"(acc[mb][6]), "+a"(acc[mb][7]));
}

typedef int i32x8 __attribute__((ext_vector_type(8)));
template <bool GATHER>
__device__ __forceinline__ void gemmrs_tile_256(const GemmRTile& t, char* smem, f32x16 (&acc)[4][4]) {
  int tz0 = threadIdx.x; asm volatile("" : "+v"(tz0));
  const int tid = tz0, lane = tid & 63, wid = tid >> 6, wr = wid >> 1, wc = wid & 1;
  const int l31 = lane & 31, hh = lane >> 5;
#pragma unroll
  for (int i = 0; i < 4; ++i)
#pragma unroll
    for (int j = 0; j < 4; ++j)
#pragma unroll
      for (int r = 0; r < 16; ++r) acc[i][j][r] = 0.f;
  const int c_src = (tid & 3) ^ ((tid >> 4) & 3);
  const u8* a_src[GATHER ? 4 : 1];
  if (GATHER) {
#pragma unroll
    for (int i = 0; i < (GATHER ? 4 : 1); ++i) {
      int r = (tid >> 2) + 64 * i;
      int rr = r < t.mvalid ? r : 0;
      a_src[i] = t.A + (long)t.aidx[rr] * t.lda + c_src * 16;
    }
  } else {
    a_src[0] = t.A + ((long)(t.m0 + (tid >> 2)) >> 1) * 4096 + ((tid >> 2) & 1) * 64 + c_src * 16;
  }
  const long a_step = GATHER ? 64L * t.lda : 32L * 4096, b_step = 32L * 4096;
  const int a_kstep = GATHER ? 64 : 128;
  const int brl = tid >> 2;
  const u8* b_src0 = t.B + ((t.brow0 + brl) >> 1) * 4096 + (brl & 1) * 64 + c_src * 16;
  const u8* b_src1 = t.B + ((t.brow1 + brl) >> 1) * 4096 + (brl & 1) * 64 + c_src * 16;
  const unsigned lds0 = (unsigned)(size_t)smem + (unsigned)__builtin_amdgcn_readfirstlane(wid) * 1024u;
  auto issue = [&](int kt, int sl, int q) {
    if (q < 4) { if (ANT) glds16_asm_nt((const void*)((GATHER ? a_src[GATHER ? q : 0] : a_src[0] + q * a_step) + kt * a_kstep), lds0 + sl * R_STAGE + q * 4096);
                 else glds16_asm((const void*)((GATHER ? a_src[GATHER ? q : 0] : a_src[0] + q * a_step) + kt * a_kstep), lds0 + sl * R_STAGE + q * 4096); }
    else { const int i = q - 4;
      if (BNT) glds16_asm_nt((const void*)((i < 2 ? b_src0 + i * b_step : b_src1 + (i - 2) * b_step) + kt * 128), lds0 + sl * R_STAGE + 16384 + i * 4096);
      else glds16_asm((const void*)((i < 2 ? b_src0 + i * b_step : b_src1 + (i - 2) * b_step) + kt * 128), lds0 + sl * R_STAGE + 16384 + i * 4096); }
  };
  unsigned a_rd[2], b_rd[2];
#pragma unroll
  for (int c = 0; c < 2; ++c) {
    const int ra = wr * 128 + l31, rb = wc * 64 + l31;
    a_rd[c] = ra * 64 + (((2 * hh + c) ^ ((ra >> 2) & 3)) * 16);
    b_rd[c] = rb * 64 + (((2 * hh + c) ^ ((rb >> 2) & 3)) * 16);
  }
  auto load_a = [&](const char* St, i32x8 (&af)[4]) {
#pragma unroll
    for (int mb = 0; mb < 4; ++mb) {
      const u32x4 lo = *(const u32x4*)(St + a_rd[0] + mb * 2048), hi = *(const u32x4*)(St + a_rd[1] + mb * 2048);
      af[mb] = (i32x8){(int)lo[0], (int)lo[1], (int)lo[2], (int)lo[3], (int)hi[0], (int)hi[1], (int)hi[2], (int)hi[3]};
    }
  };
  auto load_b = [&](const char* St, int nb, i32x8& bf) {
    const char* bp = St + 16384 + (nb >> 1) * 8192 + (nb & 1) * 2048;
    const u32x4 lo = *(const u32x4*)(bp + b_rd[0]), hi = *(const u32x4*)(bp + b_rd[1]);
    bf = (i32x8){(int)lo[0], (int)lo[1], (int)lo[2], (int)lo[3], (int)hi[0], (int)hi[1], (int)hi[2], (int)hi[3]};
  };
  auto mma4 = [&](i32x8 (&af)[4], i32x8& bf, int nb) {
#pragma unroll
    for (int mb = 0; mb < 4; ++mb)
      acc[mb][nb] = __builtin_amdgcn_mfma_scale_f32_32x32x64_f8f6f4(af[mb], bf, acc[mb][nb], 0, 0, 0, 0x7f7f7f7f, 0, 0x7f7f7f7f);
  };
  i32x8 aA[4], aB[4], bq[4];
  auto half0 = [&](int kt, i32x8 (&ac)[4], bool issueA) {
    const char* St = smem + (kt & 3) * R_STAGE;
    load_b(St, 2, bq[2]); load_b(St, 3, bq[3]);
    __builtin_amdgcn_sched_barrier(0);
#pragma unroll
    for (int nb = 0; nb < 2; ++nb) {
      mma4(ac, bq[nb], nb);
      __builtin_amdgcn_sched_barrier(0);
      if (issueA) { issue(kt + 2 + DEEP, (kt + 2 + DEEP) & 3, 4 + 2 * nb); issue(kt + 2 + DEEP, (kt + 2 + DEEP) & 3, 5 + 2 * nb); }
      __builtin_amdgcn_sched_barrier(0);
    }
  };
  auto half1 = [&](int kt, i32x8 (&ac)[4], i32x8 (&an)[4], bool has1, bool issueB) {
    const char* Sn = smem + ((kt + 1) & 3) * R_STAGE;
    if (has1) { load_a(Sn, an); load_b(Sn, 0, bq[0]); load_b(Sn, 1, bq[1]); }
    __builtin_amdgcn_sched_barrier(0);
#pragma unroll
    for (int nb = 2; nb < 4; ++nb) {
      mma4(ac, bq[nb], nb);
      __builtin_amdgcn_sched_barrier(0);
      if (issueB) { issue(kt + 3 + DEEP, (kt + 3 + DEEP) & 3, 2 * (nb - 2)); issue(kt + 3 + DEEP, (kt + 3 + DEEP) & 3, 2 * (nb - 2) + 1); }
      __builtin_amdgcn_sched_barrier(0);
    }
  };
  const int nk = t.KB >> 6;
  __syncthreads();
#pragma unroll
  for (int q = 0; q < 8; ++q) issue(0, 0, q);
#pragma unroll
  for (int q = 0; q < 8; ++q) issue(1, 1, q);
#pragma unroll
  for (int q = 0; q < 4; ++q) issue(2, 2, q);
#if DEEP
#pragma unroll
  for (int q = 4; q < 8; ++q) issue(2, 2, q);
#pragma unroll
  for (int q = 0; q < 4; ++q) issue(3, 3, q);
  asm volatile("s_waitcnt vmcnt(20)" ::: "memory");
  __syncthreads();
  load_a(smem, aA); load_b(smem, 0, bq[0]); load_b(smem, 1, bq[1]);
#pragma nounroll
  for (int kt = 0; kt < nk - 4; kt += 2) {
    half0(kt, aA, true);
    asm volatile("s_waitcnt vmcnt(16)" ::: "memory"); __syncthreads();
    half1(kt, aA, aB, true, true);
    half0(kt + 1, aB, true);
    asm volatile("s_waitcnt vmcnt(16)" ::: "memory"); __syncthreads();
    half1(kt + 1, aB, aA, true, true);
  }
  half0(nk - 4, aA, true);
  asm volatile("s_waitcnt vmcnt(16)" ::: "memory"); __syncthreads();
  half1(nk - 4, aA, aB, true, false);
  half0(nk - 3, aB, false);
  asm volatile("s_waitcnt vmcnt(8)" ::: "memory"); __syncthreads();
  half1(nk - 3, aB, aA, true, false);
#else
  asm volatile("s_waitcnt vmcnt(12)" ::: "memory");
  __syncthreads();
  load_a(smem, aA); load_b(smem, 0, bq[0]); load_b(smem, 1, bq[1]);
#pragma nounroll
  for (int kt = 0; kt < nk - 4; kt += 2) {
    half0(kt, aA, true);
    asm volatile("s_waitcnt vmcnt(8)" ::: "memory"); __syncthreads();
    half1(kt, aA, aB, true, true);
    half0(kt + 1, aB, true);
    asm volatile("s_waitcnt vmcnt(8)" ::: "memory"); __syncthreads();
    half1(kt + 1, aB, aA, true, true);
  }
  half0(nk - 4, aA, true);
  asm volatile("s_waitcnt vmcnt(8)" ::: "memory"); __syncthreads();
  half1(nk - 4, aA, aB, true, true);
  half0(nk - 3, aB, true);
  asm volatile("s_waitcnt vmcnt(8)" ::: "memory"); __syncthreads();
  half1(nk - 3, aB, aA, true, false);
#endif
  half0(nk - 2, aA, false);
  asm volatile("s_waitcnt vmcnt(0)" ::: "memory"); __syncthreads();
  half1(nk - 2, aA, aB, true, false);
  half0(nk - 1, aB, false);
  half1(nk - 1, aB, aA, false, false);
}

template <bool GATHER>
__device__ __forceinline__ void gemmrv_tile_256(const GemmRTile& t, char* smem, f32x16 (&acc)[4][4]) {
  int tz0 = threadIdx.x; asm volatile("" : "+v"(tz0));
  const int tid = tz0, lane = tid & 63, wid = tid >> 6, wr = wid >> 1, wc = wid & 1;
  const int l31 = lane & 31, hh = lane >> 5;
#pragma unroll
  for (int i = 0; i < 4; ++i)
#pragma unroll
    for (int j = 0; j < 4; ++j)
#pragma unroll
      for (int r = 0; r < 16; ++r) acc[i][j][r] = 0.f;
  const int c_src = (tid & 3) ^ ((tid >> 4) & 3);
  const u8* a_src[GATHER ? 4 : 1];
  if (GATHER) {
#pragma unroll
    for (int i = 0; i < (GATHER ? 4 : 1); ++i) {
      int r = (tid >> 2) + 64 * i;
      int rr = r < t.mvalid ? r : 0;
      a_src[i] = t.A + (long)t.aidx[rr] * t.lda + c_src * 16;
    }
  } else {
    a_src[0] = t.A + ((long)(t.m0 + (tid >> 2)) >> 1) * 4096 + ((tid >> 2) & 1) * 64 + c_src * 16;
  }
  const long a_step = GATHER ? 64L * t.lda : 32L * 4096, b_step = 32L * 4096;
  const int a_kstep = GATHER ? 64 : 128;
  const int brl = tid >> 2;
  const u8* b_src0 = t.B + ((t.brow0 + brl) >> 1) * 4096 + (brl & 1) * 64 + c_src * 16;
  const u8* b_src1 = t.B + ((t.brow1 + brl) >> 1) * 4096 + (brl & 1) * 64 + c_src * 16;
  u32x4 rs0[8], rs1[8];
  auto ldg = [&](int kt, int q, u32x4& dst) {
    const u8* ptr = (q < 4) ? ((GATHER ? a_src[GATHER ? q : 0] : a_src[0] + q * a_step) + kt * a_kstep)
                            : (((q - 4) < 2 ? b_src0 + (q - 4) * b_step : b_src1 + (q - 6) * b_step) + kt * 128);
    asm volatile("global_load_dwordx4 %0, %1, off" : "=v"(dst) : "v"(ptr) : "memory");
  };
  auto stw = [&](int sl, int q, const u32x4& src) {
    *(u32x4*)(smem + sl * R_STAGE + (q < 4 ? q * 4096 : 16384 + (q - 4) * 4096) + tid * 16) = src;
  };
#define RV_WAIT(N, r) asm volatile("s_waitcnt vmcnt(%8)" : "+v"(r[0]), "+v"(r[1]), "+v"(r[2]), "+v"(r[3]), "+v"(r[4]), "+v"(r[5]), "+v"(r[6]), "+v"(r[7]) : "n"(N) : "memory")
  unsigned a_rd[2], b_rd[2];
#pragma unroll
  for (int c = 0; c < 2; ++c) {
    const int ra = wr * 128 + l31, rb = wc * 64 + l31;
    a_rd[c] = ra * 64 + (((2 * hh + c) ^ ((ra >> 2) & 3)) * 16);
    b_rd[c] = rb * 64 + (((2 * hh + c) ^ ((rb >> 2) & 3)) * 16);
  }
  auto load_a = [&](const char* St, i32x8 (&af)[4]) {
#pragma unroll
    for (int mb = 0; mb < 4; ++mb) {
      const u32x4 lo = *(const u32x4*)(St + a_rd[0] + mb * 2048), hi = *(const u32x4*)(St + a_rd[1] + mb * 2048);
      af[mb] = (i32x8){(int)lo[0], (int)lo[1], (int)lo[2], (int)lo[3], (int)hi[0], (int)hi[1], (int)hi[2], (int)hi[3]};
    }
  };
  auto load_b = [&](const char* St, int nb, i32x8& bf) {
    const char* bp = St + 16384 + (nb >> 1) * 8192 + (nb & 1) * 2048;
    const u32x4 lo = *(const u32x4*)(bp + b_rd[0]), hi = *(const u32x4*)(bp + b_rd[1]);
    bf = (i32x8){(int)lo[0], (int)lo[1], (int)lo[2], (int)lo[3], (int)hi[0], (int)hi[1], (int)hi[2], (int)hi[3]};
  };
  auto mma4 = [&](i32x8 (&af)[4], i32x8& bf, int nb) {
#pragma unroll
    for (int mb = 0; mb < 4; ++mb)
      acc[mb][nb] = __builtin_amdgcn_mfma_scale_f32_32x32x64_f8f6f4(af[mb], bf, acc[mb][nb], 0, 0, 0, 0x7f7f7f7f, 0, 0x7f7f7f7f);
  };
  i32x8 aA[4], aB[4], bq[4];
  auto half0 = [&](int kt, i32x8 (&ac)[4]) {
    const char* St = smem + (kt & 1) * R_STAGE;
    load_b(St, 2, bq[2]); load_b(St, 3, bq[3]);
    __builtin_amdgcn_sched_barrier(0);
    mma4(ac, bq[0], 0);
    __builtin_amdgcn_sched_barrier(0);
    mma4(ac, bq[1], 1);
    __builtin_amdgcn_sched_barrier(0);
  };
  auto commit = [&](int kt, u32x4 (&rn)[8], auto wtag, bool has1, bool has3) {
    constexpr int W = decltype(wtag)::value;
    if (has1) {
      RV_WAIT(W, rn);
#pragma unroll
      for (int q = 0; q < 8; ++q) stw((kt + 1) & 1, q, rn[q]);
      if (has3) {
#pragma unroll
        for (int q = 0; q < 8; ++q) ldg(kt + 3, q, rn[q]);
      }
      __syncthreads();
    }
  };
  auto half1 = [&](int kt, i32x8 (&ac)[4], i32x8 (&an)[4], bool has1) {
    const char* Sn = smem + ((kt + 1) & 1) * R_STAGE;
    if (has1) { load_a(Sn, an); load_b(Sn, 0, bq[0]); load_b(Sn, 1, bq[1]); }
    __builtin_amdgcn_sched_barrier(0);
    mma4(ac, bq[2], 2);
    __builtin_amdgcn_sched_barrier(0);
    mma4(ac, bq[3], 3);
    __builtin_amdgcn_sched_barrier(0);
  };
#define IC(n) std::integral_constant<int, n>{}
  const int nk = t.KB >> 6;
  __syncthreads();
#pragma unroll
  for (int q = 0; q < 8; ++q) ldg(0, q, rs0[q]);
#pragma unroll
  for (int q = 0; q < 8; ++q) ldg(1, q, rs1[q]);
  RV_WAIT(8, rs0);
#pragma unroll
  for (int q = 0; q < 8; ++q) stw(0, q, rs0[q]);
#pragma unroll
  for (int q = 0; q < 8; ++q) ldg(2, q, rs0[q]);
  __syncthreads();
  load_a(smem, aA); load_b(smem, 0, bq[0]); load_b(smem, 1, bq[1]);
  for (int kt = 0; kt < nk - 4; kt += 2) {
    half0(kt, aA);      commit(kt, rs1, IC(8), true, true);      half1(kt, aA, aB, true);
    half0(kt + 1, aB);  commit(kt + 1, rs0, IC(8), true, true);  half1(kt + 1, aB, aA, true);
  }
  half0(nk - 4, aA);  commit(nk - 4, rs1, IC(8), true, true);   half1(nk - 4, aA, aB, true);
  half0(nk - 3, aB);  commit(nk - 3, rs0, IC(8), true, false);  half1(nk - 3, aB, aA, true);
  half0(nk - 2, aA);  commit(nk - 2, rs1, IC(0), true, false);  half1(nk - 2, aA, aB, true);
  half0(nk - 1, aB);                                            half1(nk - 1, aB, aA, false);
#undef IC
#undef RV_WAIT
}

__device__ __forceinline__ void cvt16_tile(const float* W, int col0, int ldn, int nvalid  , const float* kgain,
                                           u16* out  , int ldk, char* T) {
  const int tid = opaque_tid();
  const int kq = tid & 7, n4 = tid >> 3;
  f32x4 v[16];
  const bool ok = (n4 * 4) < nvalid;
  const float* src = W + (long)(kq * 16) * ldn + (ok ? n4 * 4 : -col0);
#pragma unroll
  for (int j = 0; j < 16; ++j) v[j] = __builtin_nontemporal_load((const f32x4*)(src + (long)j * ldn));
  if (kgain) {
#pragma unroll
    for (int j = 0; j < 16; ++j) v[j] *= kgain[kq * 16 + j];
  }
  if (!ok) {
#pragma unroll
    for (int j = 0; j < 16; ++j) v[j] = (f32x4){0.f, 0.f, 0.f, 0.f};
  }
  __syncthreads();
#pragma unroll
  for (int c = 0; c < 4; ++c) {
    u32x4 w0, w1;
#pragma unroll
    for (int q = 0; q < 4; ++q) { w0[q] = pack_bf16(v[2 * q][c], v[2 * q + 1][c]); w1[q] = pack_bf16(v[8 + 2 * q][c], v[8 + 2 * q + 1][c]); }
    *(u32x4*)(T + (n4 * 4 + c) * 256 + kq * 32) = w0;
    *(u32x4*)(T + (n4 * 4 + c) * 256 + kq * 32 + 16) = w1;
  }
  __syncthreads();
#pragma unroll
  for (int i = 0; i < 8; ++i) {
    const int n = (tid >> 4) + 16 * i, ch = tid & 15;
    *(u32x4*)((char*)(out + (long)n * ldk) + ch * 16) = *(const u32x4*)(T + n * 256 + ch * 16);
  }
}
__device__ __forceinline__ void convert_one(const Params& p, char* smem, int u);
__device__ __forceinline__ void ph_convert_dense(const Params& p, char* smem) {
#if WOUTQ
  convert_one(p, smem, 24576 + blockIdx.x);
#endif
  for (int u = blockIdx.x; u < 912; u += gridDim.x) {
    if (u < 544) { const int kt = u / 34, nt = u % 34; const int nv = NC_ - nt * 128;
      cvt16_tile(p.w_in + (long)(kt * 128) * NC_ + nt * 128, nt * 128, NC_, nv < 0 ? 0 : nv, nullptr, p.wb_in() + (long)(nt * 128) * 2048 + kt * 128, 2048, smem);
    } else if (u < 592) { const int v = u - 544; const int kt = v / 12, nt = v % 12;
      cvt16_tile(p.w_uq + (long)(kt * 128) * 1536 + nt * 128, nt * 128, 1536, 128, p.q_norm + kt * 128, p.wb_uq() + (long)(nt * 128) * 512 + kt * 128, 512, smem);
    } else if (u < 656) { const int v = u - 592; const int kt = v >> 4, nt = v & 15;
      cvt16_tile(p.w_ukv + (long)(kt * 128) * 2048 + nt * 128, nt * 128, 2048, 128, p.kv_norm + kt * 128, p.wb_ukv() + (long)(nt * 128) * 512 + kt * 128, 512, smem);
    } else if (!WOUTQ) { const int v = u - 656; const int kt = v >> 4, nt = v & 15;
      cvt16_tile(p.w_out + (long)(kt * 128) * 2048 + nt * 128, nt * 128, 2048, 128, nullptr, p.wb_out() + (long)(nt * 128) * 2048 + kt * 128, 2048, smem);
    }
  }
}


template <bool NTST = false, class F>
__device__ __forceinline__ void epi_store_bf16(f32x16 (&acc)[4][4], char* smem, u16* gbase  , int ld, int ncols0, int ncols1, F f) {
  int tz = threadIdx.x; asm volatile("" : "+v"(tz));
  const int lane = tz & 63, wid = tz >> 6, wr = wid >> 1, wc = wid & 1, l31 = lane & 31, hh = lane >> 5;
  __syncthreads();
  char* st = smem + wid * 32768;
#pragma unroll
  for (int mb = 0; mb < 4; ++mb)
#pragma unroll
    for (int reg = 0; reg < 16; ++reg) {
      const int r = mb * 32 + (reg & 3) + 8 * (reg >> 2) + 4 * hh;
      float v[4] = {acc[mb][0][reg], acc[mb][1][reg], acc[mb][2][reg], acc[mb][3][reg]};
      f(wr * 128 + r, wc * 64 + l31, v);
#pragma unroll
      for (int nb = 0; nb < 4; ++nb) *(u16*)(st + r * 256 + (nb * 32 + l31) * 2) = f32_to_bf16(v[nb]);
    }
  const int ch = lane & 15, span = ch >> 3;
  const int gcol = span * 128 + wc * 64 + (ch & 7) * 8;
  const bool ok = ((wc * 64 + (ch & 7) * 8) < (span ? ncols1 : ncols0));
#pragma unroll 8
  for (int it = 0; it < 32; ++it) {
    const int r = it * 4 + (lane >> 4);
    const u32x4 w = *(const u32x4*)(st + r * 256 + ch * 16);
    if (ok) { if (NTST) __builtin_nontemporal_store(w, (u32x4*)(gbase + (long)(wr * 128 + r) * ld + gcol)); else *(u32x4*)(gbase + (long)(wr * 128 + r) * ld + gcol) = w; }
  }
}
template <class F>
__device__ __forceinline__ void epi_store_act8(f32x16 (&acc)[4][4], char* smem, u8* gbase  , long row0, int cb0, F f) {
  int tz = threadIdx.x; asm volatile("" : "+v"(tz));
  const int lane = tz & 63, wid = tz >> 6, wr = wid >> 1, wc = wid & 1, l31 = lane & 31, hh = lane >> 5;
  __syncthreads();
  char* st = smem + wid * 32768;
#pragma unroll
  for (int mb = 0; mb < 4; ++mb)
#pragma unroll
    for (int reg = 0; reg < 16; ++reg) {
      const int r = mb * 32 + (reg & 3) + 8 * (reg >> 2) + 4 * hh;
      float v[4] = {acc[mb][0][reg], acc[mb][1][reg], acc[mb][2][reg], acc[mb][3][reg]};
      f(wr * 128 + r, wc * 64 + l31, v);
      const int q = __builtin_amdgcn_cvt_pk_fp8_f32(v[0], v[1], 0, false);
      *(u8*)(st + r * 64 + l31) = (u8)(q & 0xff);
      *(u8*)(st + r * 64 + 32 + l31) = (u8)((q >> 8) & 0xff);
    }
  const int ch = lane & 3;
#pragma unroll 8
  for (int it = 0; it < 8; ++it) {
    const int r = it * 16 + (lane >> 2);
    const u32x4 w = *(const u32x4*)(st + r * 64 + ch * 16);
    const long rg = row0 + wr * 128 + r;
    *(u32x4*)(gbase + (rg >> 1) * 4096 + (long)(cb0 + wc) * 128 + (rg & 1) * 64 + ch * 16) = w;
  }
}
__device__ __forceinline__ void epi_store_f32_resid(f32x16 (&acc)[4][4], char* smem, const float* resid, float* out, int ld, float osc) {
  int tz = threadIdx.x; asm volatile("" : "+v"(tz));
  const int lane = tz & 63, wid = tz >> 6, wr = wid >> 1, wc = wid & 1, l31 = lane & 31, hh = lane >> 5;
  __syncthreads();
  char* st = smem + wid * 32768;
  const int ch = lane & 31, span = ch >> 4;
  const int gcol = span * 128 + wc * 64 + (ch & 15) * 4;
#if EPI2
  const long o0 = (long)(wr * 128 + (lane >> 5)) * ld + gcol;
  f32x4 xa[16], xb[16];
  auto ldb = [&](int b, f32x4 (&x)[16]) {
#pragma unroll
    for (int i = 0; i < 16; ++i) x[i] = __builtin_nontemporal_load((const f32x4*)(resid + o0 + (long)(b * 32 + i * 2) * ld));
  };
  auto stage = [&](int half) {
#pragma unroll
    for (int m2 = 0; m2 < 2; ++m2)
#pragma unroll
      for (int reg = 0; reg < 16; ++reg) {
        const int mb = half * 2 + m2;
        const int r = m2 * 32 + (reg & 3) + 8 * (reg >> 2) + 4 * hh;
#pragma unroll
        for (int nb = 0; nb < 4; ++nb) *(float*)(st + r * 512 + (nb * 32 + l31) * 4) = acc[mb][nb][reg];
      }
  };
  auto proc = [&](int b, f32x4 (&x)[16]) {
#pragma unroll
    for (int i = 0; i < 16; ++i) {
      const int r = (b & 1) * 32 + i * 2 + (lane >> 5);
      const f32x4 a = *(const f32x4*)(st + r * 512 + ch * 16);
      *(f32x4*)(out + o0 + (long)(b * 32 + i * 2) * ld) = a * osc + x[i];
    }
  };
  ldb(0, xa);
  __builtin_amdgcn_sched_barrier(0);
  stage(0);
  ldb(1, xb);
  __builtin_amdgcn_sched_barrier(0);
  proc(0, xa);
  ldb(2, xa);
  __builtin_amdgcn_sched_barrier(0);
  proc(1, xb);
  stage(1);
  ldb(3, xb);
  __builtin_amdgcn_sched_barrier(0);
  proc(2, xa);
  proc(3, xb);
#else
#pragma unroll
  for (int half = 0; half < 2; ++half) {
#pragma unroll
    for (int m2 = 0; m2 < 2; ++m2)
#pragma unroll
      for (int reg = 0; reg < 16; ++reg) {
        const int mb = half * 2 + m2;
        const int r = m2 * 32 + (reg & 3) + 8 * (reg >> 2) + 4 * hh;
#pragma unroll
        for (int nb = 0; nb < 4; ++nb) *(float*)(st + r * 512 + (nb * 32 + l31) * 4) = acc[mb][nb][reg];
      }
#pragma unroll 8
    for (int it = 0; it < 32; ++it) {
      const int r = it * 2 + (lane >> 5);
      const f32x4 a = *(const f32x4*)(st + r * 512 + ch * 16);
      const long o = (long)(wr * 128 + half * 64 + r) * ld + gcol;
      const f32x4 x = __builtin_nontemporal_load((const f32x4*)(resid + o));
      *(f32x4*)(out + o) = a * osc + x;
    }
  }
#endif
}

template <bool NTST = false>
__device__ __forceinline__ void epi16_store_bf16(f32x4 (&acc)[8][8], char* smem, u16* gbase, int ld, int ncols0, int ncols1, const float* rscale, float mul) {
  int tz = threadIdx.x; asm volatile("" : "+v"(tz));
  const int lane = tz & 63, wid = tz >> 6, wr = wid >> 1, wc = wid & 1, l15 = lane & 15, kq = lane >> 4;
  __syncthreads();
  char* st = smem + wid * 32768;
#pragma unroll
  for (int mb = 0; mb < 8; ++mb)
#pragma unroll
    for (int reg = 0; reg < 4; ++reg) {
      const int r = mb * 16 + 4 * kq + reg;
      const float sc = rscale ? rscale[wr * 128 + r] * mul : 1.0f;
#pragma unroll
      for (int nb = 0; nb < 8; ++nb) *(u16*)(st + r * 256 + ((nb >> 2) * 64 + (nb & 3) * 16 + l15) * 2) = f32_to_bf16(acc[mb][nb][reg] * sc);
    }
  const int ch = lane & 15, span = ch >> 3;
  const int gcol = span * 128 + wc * 64 + (ch & 7) * 8;
  const bool ok = ((wc * 64 + (ch & 7) * 8) < (span ? ncols1 : ncols0));
#pragma unroll 8
  for (int it = 0; it < 32; ++it) {
    const int r = it * 4 + (lane >> 4);
    const u32x4 w = *(const u32x4*)(st + r * 256 + ch * 16);
    if (ok) { if (NTST) __builtin_nontemporal_store(w, (u32x4*)(gbase + (long)(wr * 128 + r) * ld + gcol)); else *(u32x4*)(gbase + (long)(wr * 128 + r) * ld + gcol) = w; }
  }
}
__device__ __forceinline__ void epi16_store_f32_resid(f32x4 (&acc)[8][8], char* smem, const float* resid, float* out, int ld) {
  int tz = threadIdx.x; asm volatile("" : "+v"(tz));
  const int lane = tz & 63, wid = tz >> 6, wr = wid >> 1, wc = wid & 1, l15 = lane & 15, kq = lane >> 4;
  __syncthreads();
  char* st = smem + wid * 32768;
#pragma unroll
  for (int half = 0; half < 2; ++half) {
#pragma unroll
    for (int m4 = 0; m4 < 4; ++m4)
#pragma unroll
      for (int reg = 0; reg < 4; ++reg) {
        const int mb = half * 4 + m4;
        const int r = m4 * 16 + 4 * kq + reg;
#pragma unroll
        for (int nb = 0; nb < 8; ++nb) *(float*)(st + r * 512 + ((nb >> 2) * 64 + (nb & 3) * 16 + l15) * 4) = acc[mb][nb][reg];
      }
    const int ch = lane & 31, span = ch >> 4;
    const int gcol = span * 128 + wc * 64 + (ch & 15) * 4;
#pragma unroll 8
    for (int it = 0; it < 32; ++it) {
      const int r = it * 2 + (lane >> 5);
      const f32x4 a = *(const f32x4*)(st + r * 512 + ch * 16);
      const long o = (long)(wr * 128 + half * 64 + r) * ld + gcol;
      const f32x4 x = __builtin_nontemporal_load((const f32x4*)(resid + o));
      *(f32x4*)(out + o) = a + x;
    }
  }
}

template <int NBV>
__device__ __forceinline__ void win_tile_r(const Params& p, char* smem, int mt, int nt) {
  GemmRTile t{};
  t.A = (const u8*)p.h1(); t.lda = 4096; t.aidx = nullptr; t.m0 = mt * 256; t.mvalid = 256;
  t.B = (const u8*)p.wb_in(); t.brow0 = nt * 256; t.brow1 = nt * 256 + 128; t.ldb = 4096; t.KB = 4096;
  const int rem = NC_ - nt * 256;
  const int nv0 = rem >= 128 ? 128 : rem, nv1 = rem >= 256 ? 128 : (rem > 128 ? rem - 128 : 0);
#if (MF16 & 1)
  f32x4 acc6[8][8];
  gemmr16_tile_256(t, smem, acc6);
  epi16_store_bf16(acc6, smem, p.proj() + (long)(mt * 256) * NC_ + nt * 256, NC_, nv0, nv1, nullptr, 1.0f);
#else
  f32x16 acc[4][4];
  gemmr_tile_256<false, false>(t, smem, acc);
  epi_store_bf16(acc, smem, p.proj() + (long)(mt * 256) * NC_ + nt * 256, NC_, nv0, nv1, [&](int, int, float (&)[4]) {});
#endif
}
__device__ __forceinline__ void win_narrow_split(const Params& p, char* smem, int mt, int kc) {
  GemmRTile t{};
  t.A = (const u8*)p.h1() + kc * 512; t.lda = 4096; t.aidx = nullptr; t.m0 = mt * 256; t.mvalid = 256;
  t.B = (const u8*)p.wb_in() + kc * 512; t.brow0 = 4096; t.brow1 = 4224; t.ldb = 4096; t.KB = 512;
  float* base = p.pn() + (long)kc * (8192 * 80) + (long)(mt * 256) * 80;
#if (MF16 & 2)
  f32x4 acc6[8][8];
  gemmr16_tile_256(t, smem, acc6);
  {
    const int tq = opaque_tid(); const int lane = tq & 63, wid = tq >> 6, wr = wid >> 1, wc = wid & 1;
#pragma unroll
    for (int mb = 0; mb < 8; ++mb)
#pragma unroll
      for (int reg = 0; reg < 4; ++reg) {
        const int rowl = wr * 128 + mb * 16 + 4 * (lane >> 4) + reg;
        float* rp = base + (long)rowl * 80 + wc * 64 + (lane & 15);
        OPAQUE(rp);
#pragma unroll
        for (int nb = 0; nb < 4; ++nb) if (wc * 64 + nb * 16 + (lane & 15) < 80) rp[nb * 16] = acc6[mb][nb][reg];
      }
  }
  return;
#endif
  f32x16 acc[4][4];
  gemmr_tile_256<false, false>(t, smem, acc);
  acc_foreach_row<4>(acc, [&](int rowl, int coll, float (&v)[4]) {
    float* rp = base + (long)rowl * 80 + coll;
    OPAQUE(rp);
    if (coll < 80) rp[0] = v[0];
    if (coll + 32 < 80) rp[32] = v[1];
  });
}
__device__ __forceinline__ void ph_win_r(const Params& p, char* smem) {
  const int x = blockIdx.x & 7, slot = blockIdx.x >> 3;
#if WIN_SPLIT
  for (int j = slot; j < 64; j += 32) win_tile_r<4>(p, smem, 4 * x + (j & 3), j >> 2);
  win_narrow_split(p, smem, 4 * x + (slot & 3), slot >> 2);
#else
  for (int j = slot; j < 68; j += 32) win_tile_r<4>(p, smem, 4 * x + (j & 3), j >> 2);
#endif
}
__device__ __forceinline__ void upq_tile_r(const Params& p, char* smem, int mt, int nt) {
  GemmRTile t{};
  t.A = (const u8*)(p.proj() + C_MQ); t.lda = NC_ * 2; t.aidx = nullptr; t.m0 = mt * 256; t.mvalid = 256;
  t.B = (const u8*)p.wb_uq(); t.brow0 = nt * 256; t.brow1 = nt * 256 + 128; t.ldb = 1024; t.KB = 1024;
  const float* rq = p.rq() + mt * 256;
#if (MF16 & 4)
  f32x4 acc6[8][8];
  gemmr16_tile_256(t, smem, acc6);
  epi16_store_bf16(acc6, smem, p.q() + (long)(mt * 256) * 1536 + nt * 256, 1536, 128, 128, rq, QSCALE_);
  return;
#endif
  f32x16 acc[4][4];
  gemmr_tile_256<false, false>(t, smem, acc);
  epi_store_bf16(acc, smem, p.q() + (long)(mt * 256) * 1536 + nt * 256, 1536, 128, 128, [&](int rowl, int, float (&v)[4]) {
    const float s = rq[rowl] * QSCALE_;
#pragma unroll
    for (int nb = 0; nb < 4; ++nb) v[nb] *= s;
  });
}
__device__ __forceinline__ void upkv_tile_r(const Params& p, char* smem, int mt, int nt) {
  GemmRTile t{};
  t.A = (const u8*)(p.proj() + C_MKV); t.lda = NC_ * 2; t.aidx = nullptr; t.m0 = mt * 256; t.mvalid = 256;
  t.B = (const u8*)p.wb_ukv(); t.brow0 = nt * 256; t.brow1 = nt * 256 + 128; t.ldb = 1024; t.KB = 1024;
  const float* rk = p.rkv() + mt * 256;
#if (MF16 & 8)
  f32x4 acc6[8][8];
  gemmr16_tile_256(t, smem, acc6);
  epi16_store_bf16(acc6, smem, p.kv() + (long)(mt * 256) * 2048 + nt * 256, 2048, 128, 128, rk, 1.0f);
  return;
#endif
  f32x16 acc[4][4];
  gemmr_tile_256<false, false>(t, smem, acc);
  epi_store_bf16(acc, smem, p.kv() + (long)(mt * 256) * 2048 + nt * 256, 2048, 128, 128, [&](int rowl, int, float (&v)[4]) {
    const float s = rk[rowl];
#pragma unroll
    for (int nb = 0; nb < 4; ++nb) v[nb] *= s;
  });
}
template <int hot = 0>
__device__ __forceinline__ void wout_tile_r(const Params& p, char* smem, int mt, int nt) {
  f32x16 acc[4][4];
  GemmRTile t{};
  const int smt = mt, snt = nt;
  if (hot == 1) { mt = 0; nt = 0; }
#if WOUTQ
  t.A = p.mixq(); t.lda = 2048; t.aidx = nullptr; t.m0 = mt * 256; t.mvalid = 256;
  t.B = p.wq_out(); t.brow0 = nt * 256; t.brow1 = nt * 256 + 128; t.ldb = 2048; t.KB = 2048;
  gemmrs_tile_256<false>(t, smem, acc);
  const float osc = WISCALE_;
#else
  t.A = (const u8*)p.mix(); t.lda = 4096; t.aidx = nullptr; t.m0 = mt * 256; t.mvalid = 256;
  t.B = (const u8*)p.wb_out(); t.brow0 = nt * 256; t.brow1 = nt * 256 + 128; t.ldb = 4096; t.KB = 4096;
  if (hot == 2) t.KB = 512;
#if (MF16 & 16)
  {
    f32x4 acc6[8][8];
    gemmr16_tile_256(t, smem, acc6);
    const long boff6 = (long)(smt * 256) * 2048 + snt * 256;
    epi16_store_f32_resid(acc6, smem, p.x + boff6, p.x1() + boff6, 2048);
    return;
  }
#endif
  gemmr_tile_256<false, false>(t, smem, acc);
  const float osc = 1.0f;
#endif
  const long boff = (long)(smt * 256) * 2048 + snt * 256;
  epi_store_f32_resid(acc, smem, p.x + boff, p.x1() + boff, 2048, osc);
}

__device__ __forceinline__ void moe1q_tile(const Params& p, char* smem, const int* mo, int e, int nt, int mt) {
  f32x16 acc[4][4];
  GemmRTile t{};
#if PRE1
  const int cnt = mo[40 + e];
  const float* bg = p.b_gu + e * 4096 + nt * 128; const float* bu = bg + 2048;
  const int tq_ = opaque_tid(); const int cl = (tq_ >> 6 & 1) * 64 + (tq_ & 31);
  const float bgv[2] = {bg[cl], bg[cl + 32]}, buv[2] = {bu[cl], bu[cl + 32]};
#else
  const int cnt = p.counts()[e];
#endif
  t.A = p.h2q(); t.lda = 2048; t.aidx = p.list() + e * T_ + mt * 256; t.m0 = 0; t.mvalid = min(256, cnt - mt * 256);
  t.B = p.wq_gu(); t.brow0 = (long)e * 4096 + nt * 128; t.brow1 = t.brow0 + 2048; t.ldb = 2048; t.KB = 2048;
#if MOEQ == 3
  gemmrv_tile_256<true>(t, smem, acc);
#elif MOEQ == 2
  gemmrs_tile_256<true>(t, smem, acc);
#else
  gemmr_tile_256<true, true>(t, smem, acc);
#endif
#if !PRE1
  const float* bg = p.b_gu + e * 4096 + nt * 128; const float* bu = bg + 2048;
  const int tq_ = opaque_tid(); const int cl = (tq_ >> 6 & 1) * 64 + (tq_ & 31);
  const float bgv[2] = {bg[cl], bg[cl + 32]}, buv[2] = {bu[cl], bu[cl + 32]};
#endif
  epi_store_act8(acc, smem, p.actq(), (long)(mo[e] * 256 + mt * 256), nt * 2, [&](int, int, float (&v)[4]) {
#pragma unroll
    for (int nb = 0; nb < 2; ++nb) {
      float g = fminf(v[nb] * WISCALE_ + bgv[nb], 7.0f);
      float uu = fminf(fmaxf(v[nb + 2] * WISCALE_ + buv[nb], -7.0f), 7.0f);
      v[nb] = (uu + 1.0f) * (g * __builtin_amdgcn_rcpf(1.0f + __expf(-1.702f * g)));
    }
  });
}
template <int KBV = 2048>
__device__ __forceinline__ void moe2q_tile(const Params& p, char* smem, const int* mo, int e, int nt, int mt) {
  f32x16 acc[4][4];
  GemmRTile t{};
  t.A = p.actq(); t.lda = 2048; t.aidx = nullptr; t.m0 = mo[e] * 256 + mt * 256; t.mvalid = 256;
  t.B = p.wq_dn(); t.brow0 = (long)e * 2048 + nt * 256; t.brow1 = t.brow0 + 128; t.ldb = 2048; t.KB = KBV;
#if PRE1
  const float* bd = p.b_dn + e * 2048 + nt * 256;
  const int tq_ = opaque_tid(); const int cl = (tq_ >> 6 & 1) * 64 + (tq_ & 31);
  const float bdv[4] = {bd[cl], bd[cl + 32], bd[cl + 128], bd[cl + 160]};
#endif
#if MOEQ == 3
  gemmrv_tile_256<false>(t, smem, acc);
#elif MOEQ == 2
  gemmrs_tile_256<false>(t, smem, acc);
#else
  gemmr_tile_256<true, false>(t, smem, acc);
#endif
#if !PRE1
  const float* bd = p.b_dn + e * 2048 + nt * 256;
  const int tq_ = opaque_tid(); const int cl = (tq_ >> 6 & 1) * 64 + (tq_ & 31);
  const float bdv[4] = {bd[cl], bd[cl + 32], bd[cl + 128], bd[cl + 160]};
#endif
  epi_store_bf16<YNT != 0>(acc, smem, p.ybuf() + (long)t.m0 * 2048 + nt * 256, 2048, 128, 128, [&](int, int, float (&v)[4]) {
#pragma unroll
    for (int nb = 0; nb < 4; ++nb) v[nb] = v[nb] * WISCALE_ + bdv[nb];
  });
}

template <int WHICH>
__device__ __forceinline__ void moe_stream(const Params& p, char* smem, const int* mo) {
  constexpr bool GATHER = (WHICH == 1);
  constexpr int NT = GATHER ? 16 : 8;
  constexpr int nk = 32;
  const int total = mo[NE_] * NT;
  int tz0 = threadIdx.x; asm volatile("" : "+v"(tz0));
  const int tid = tz0, lane = tid & 63, wid = tid >> 6, wr = wid >> 1, wc = wid & 1;
  const int l31 = lane & 31, hh = lane >> 5;
  const int c_src = (tid & 3) ^ ((tid >> 4) & 3);
  const unsigned lds0 = (unsigned)(size_t)smem + (unsigned)__builtin_amdgcn_readfirstlane(wid) * 1024u;
  const u8* a_src[GATHER ? 4 : 1]; const u8* b_src0; const u8* b_src1;
  const long a_step = 32L * 4096, b_step = 32L * 4096;
  constexpr int a_kstep = GATHER ? 64 : 128;
  auto decode = [&](int round, int& e, int& nt, int& mt) -> bool {
    const int u = xcd_unit(round);
    if (u >= total) return false;
    e = 0;
    while (mo[e + 1] * NT <= u) ++e;
    const int local = u - mo[e] * NT, me = mo[e + 1] - mo[e];
    nt = local / me; mt = local - nt * me;
    return true;
  };
  auto load_idx = [&](int e, int mt, int (&ix)[4]) {
    const int cnt = mo[40 + e];
    const int mvalid = min(256, cnt - mt * 256);
    const int* aidx = p.list() + e * T_ + mt * 256;
#pragma unroll
    for (int i = 0; i < 4; ++i) { const int r = (tid >> 2) + 64 * i; ix[i] = aidx[r < mvalid ? r : 0]; }
  };
  auto set_a = [&](int e, int mt, const int (&ix)[4], long back) {
    if (GATHER) {
#pragma unroll
      for (int i = 0; i < (GATHER ? 4 : 1); ++i) a_src[i] = p.h2q() + (long)ix[i] * 2048 + c_src * 16 - back;
    } else {
      const long m0 = (long)mo[e] * 256 + mt * 256;
      a_src[0] = p.actq() + ((m0 + (tid >> 2)) >> 1) * 4096 + ((tid >> 2) & 1) * 64 + c_src * 16 - back;
    }
  };
  auto set_b = [&](int e, int nt, long back) {
    const int brl = tid >> 2;
    const u8* W = GATHER ? p.wq_gu() : p.wq_dn();
    const long brow0 = GATHER ? ((long)e * 4096 + nt * 128) : ((long)e * 2048 + nt * 256), brow1 = brow0 + (GATHER ? 2048 : 128);
    b_src0 = W + ((brow0 + brl) >> 1) * 4096 + (brl & 1) * 64 + c_src * 16 - back;
    b_src1 = W + ((brow1 + brl) >> 1) * 4096 + (brl & 1) * 64 + c_src * 16 - back;
  };
  auto issue = [&](int kt, int sl, int q) {
    if (q < 4) glds16_asm((const void*)((GATHER ? a_src[GATHER ? q : 0] : a_src[0] + q * a_step) + kt * a_kstep), lds0 + sl * R_STAGE + q * 4096);
    else { const int i = q - 4;
      glds16_asm_nt((const void*)((i < 2 ? b_src0 + i * b_step : b_src1 + (i - 2) * b_step) + kt * 128), lds0 + sl * R_STAGE + 16384 + i * 4096); }
  };
  unsigned a_rd[2], b_rd[2];
#pragma unroll
  for (int c = 0; c < 2; ++c) {
    const int ra = wr * 128 + l31, rb = wc * 64 + l31;
    a_rd[c] = ra * 64 + (((2 * hh + c) ^ ((ra >> 2) & 3)) * 16);
    b_rd[c] = rb * 64 + (((2 * hh + c) ^ ((rb >> 2) & 3)) * 16);
  }
  int e, nt, mt;
  bool valid = decode(0, e, nt, mt);
  if (!valid) return;
  {
    int ix0[4] = {0, 0, 0, 0};
    if (GATHER) load_idx(e, mt, ix0);
    __syncthreads();
    set_a(e, mt, ix0, 0); set_b(e, nt, 0);
#pragma unroll
    for (int q = 0; q < 8; ++q) issue(0, 0, q);
#pragma unroll
    for (int q = 0; q < 8; ++q) issue(1, 1, q);
#pragma unroll
    for (int q = 0; q < 4; ++q) issue(2, 2, q);
  }
  i32x8 aA[4], aB[4], bq[4];
  asm volatile("s_waitcnt vmcnt(12)" ::: "memory");
  __syncthreads();
  {
#pragma unroll
    for (int mb = 0; mb < 4; ++mb) {
      const u32x4 lo = *(const u32x4*)(smem + a_rd[0] + mb * 2048), hi = *(const u32x4*)(smem + a_rd[1] + mb * 2048);
      aA[mb] = (i32x8){(int)lo[0], (int)lo[1], (int)lo[2], (int)lo[3], (int)hi[0], (int)hi[1], (int)hi[2], (int)hi[3]};
    }
#pragma unroll
    for (int nb = 0; nb < 2; ++nb) {
      const char* bp = smem + 16384 + (nb & 1) * 2048;
      const u32x4 lo = *(const u32x4*)(bp + b_rd[0]), hi = *(const u32x4*)(bp + b_rd[1]);
      bq[nb] = (i32x8){(int)lo[0], (int)lo[1], (int)lo[2], (int)lo[3], (int)hi[0], (int)hi[1], (int)hi[2], (int)hi[3]};
    }
  }
  for (int round = 0; valid; ++round) {
    f32x16 acc[4][4];
#pragma unroll
    for (int i = 0; i < 4; ++i)
#pragma unroll
      for (int j = 0; j < 4; ++j)
#pragma unroll
        for (int r = 0; r < 16; ++r) acc[i][j][r] = 0.f;
    int ne = e, nnt = nt, nmt = mt;
    const bool nvalid = decode(round + 1, ne, nnt, nmt);
    int nix[4] = {0, 0, 0, 0};
    if (GATHER) { if (nvalid) load_idx(ne, nmt, nix); }
    const int cl = wc * 64 + l31;
    float bv[4];
    if (GATHER) { const float* bg = p.b_gu + e * 4096 + nt * 128; bv[0] = bg[cl]; bv[1] = bg[cl + 32]; bv[2] = bg[2048 + cl]; bv[3] = bg[2048 + cl + 32]; }
    else { const float* bd = p.b_dn + e * 2048 + nt * 256; bv[0] = bd[cl]; bv[1] = bd[cl + 32]; bv[2] = bd[cl + 128]; bv[3] = bd[cl + 160]; }
#pragma unroll
    for (int i = 0; i < 4; ++i) asm volatile("" : "+v"(bv[i]), "+v"(nix[i]));
    auto load_a = [&](const char* St, i32x8 (&af)[4]) {
#pragma unroll
      for (int mb = 0; mb < 4; ++mb) {
        const u32x4 lo = *(const u32x4*)(St + a_rd[0] + mb * 2048), hi = *(const u32x4*)(St + a_rd[1] + mb * 2048);
        af[mb] = (i32x8){(int)lo[0], (int)lo[1], (int)lo[2], (int)lo[3], (int)hi[0], (int)hi[1], (int)hi[2], (int)hi[3]};
      }
    };
    auto load_b = [&](const char* St, int nb, i32x8& bf) {
      const char* bp = St + 16384 + (nb >> 1) * 8192 + (nb & 1) * 2048;
      const u32x4 lo = *(const u32x4*)(bp + b_rd[0]), hi = *(const u32x4*)(bp + b_rd[1]);
      bf = (i32x8){(int)lo[0], (int)lo[1], (int)lo[2], (int)lo[3], (int)hi[0], (int)hi[1], (int)hi[2], (int)hi[3]};
    };
    auto mma4 = [&](i32x8 (&af)[4], i32x8& bf, int nb) {
#pragma unroll
      for (int mb = 0; mb < 4; ++mb)
        acc[mb][nb] = __builtin_amdgcn_mfma_scale_f32_32x32x64_f8f6f4(af[mb], bf, acc[mb][nb], 0, 0, 0, 0x7f7f7f7f, 0, 0x7f7f7f7f);
    };
    auto half0 = [&](int kt, i32x8 (&ac)[4]) {
      const char* St = smem + (kt & 3) * R_STAGE;
      load_b(St, 2, bq[2]); load_b(St, 3, bq[3]);
      __builtin_amdgcn_sched_barrier(0);
#pragma unroll
      for (int nb = 0; nb < 2; ++nb) {
        mma4(ac, bq[nb], nb);
        __builtin_amdgcn_sched_barrier(0);
        issue(kt + 2, (kt + 2) & 3, 4 + 2 * nb); issue(kt + 2, (kt + 2) & 3, 5 + 2 * nb);
        __builtin_amdgcn_sched_barrier(0);
      }
    };
    auto half1 = [&](int kt, i32x8 (&ac)[4], i32x8 (&an)[4], bool has1) {
      const char* Sn = smem + ((kt + 1) & 3) * R_STAGE;
      if (has1) { load_a(Sn, an); load_b(Sn, 0, bq[0]); load_b(Sn, 1, bq[1]); }
      __builtin_amdgcn_sched_barrier(0);
#pragma unroll
      for (int nb = 2; nb < 4; ++nb) {
        mma4(ac, bq[nb], nb);
        __builtin_amdgcn_sched_barrier(0);
        issue(kt + 3, (kt + 3) & 3, 2 * (nb - 2)); issue(kt + 3, (kt + 3) & 3, 2 * (nb - 2) + 1);
        __builtin_amdgcn_sched_barrier(0);
      }
    };
#pragma nounroll
    for (int kt = 0; kt < nk; kt += 2) {
      half0(kt, aA);
      asm volatile("s_waitcnt vmcnt(8)" ::: "memory"); __syncthreads();
      half1(kt, aA, aB, true);
      if (kt == nk - 4) set_a(ne, nmt, nix, (long)nk * a_kstep);
      half0(kt + 1, aB);
      if (kt == nk - 4) set_b(ne, nnt, (long)nk * 128);
      asm volatile("s_waitcnt vmcnt(8)" ::: "memory"); __syncthreads();
      half1(kt + 1, aB, aA, true);
    }
    __builtin_amdgcn_sched_barrier(0);
#pragma unroll
    for (int i = 0; i < 4; ++i) {
      asm volatile("" : "+a"(acc[i][0]), "+a"(acc[i][1]), "+a"(acc[i][2]), "+a"(acc[i][3]));
      asm volatile("" : "+v"(aA[i]));
    }
    asm volatile("" : "+v"(bq[0]), "+v"(bq[1]));
    __syncthreads();
    __builtin_amdgcn_sched_barrier(0);
    int tze = threadIdx.x; asm volatile("" : "+v"(tze));
    const int laneE = tze & 63, widE = tze >> 6, wrE = widE >> 1, wcE = widE & 1, l31E = laneE & 31, hhE = laneE >> 5;
    char* st = smem + 3 * R_STAGE + widE * 8192;
    if (GATHER) {
      const long row0 = (long)(mo[e] * 256 + mt * 256);
#pragma unroll
      for (int mb = 0; mb < 4; ++mb)
#pragma unroll
        for (int reg = 0; reg < 16; ++reg) {
          const int r = mb * 32 + (reg & 3) + 8 * (reg >> 2) + 4 * hhE;
          float v[2];
#pragma unroll
          for (int nb = 0; nb < 2; ++nb) {
            float g = fminf(acc[mb][nb][reg] * WISCALE_ + bv[nb], 7.0f);
            float uu = fminf(fmaxf(acc[mb][nb + 2][reg] * WISCALE_ + bv[2 + nb], -7.0f), 7.0f);
            v[nb] = (uu + 1.0f) * (g * __builtin_amdgcn_rcpf(1.0f + __expf(-1.702f * g)));
          }
          const int q = __builtin_amdgcn_cvt_pk_fp8_f32(v[0], v[1], 0, false);
          *(u8*)(st + r * 64 + l31E) = (u8)(q & 0xff);
          *(u8*)(st + r * 64 + 32 + l31E) = (u8)((q >> 8) & 0xff);
        }
      const int ch = laneE & 3;
#pragma unroll 8
      for (int it = 0; it < 8; ++it) {
        const int r = it * 16 + (laneE >> 2);
        const u32x4 w = *(const u32x4*)(st + r * 64 + ch * 16);
        const long rg = row0 + wrE * 128 + r;
        *(u32x4*)(p.actq() + (rg >> 1) * 4096 + (long)(nt * 2 + wcE) * 128 + (rg & 1) * 64 + ch * 16) = w;
      }
    } else {
      u16* gbase = p.ybuf() + ((long)mo[e] * 256 + mt * 256) * 2048 + nt * 256;
      const int ch = laneE & 15, span = ch >> 3;
      const int gcol = span * 128 + wcE * 64 + (ch & 7) * 8;
#pragma unroll
      for (int mb = 0; mb < 4; ++mb) {
#pragma unroll
        for (int reg = 0; reg < 16; ++reg) {
          const int r = (reg & 3) + 8 * (reg >> 2) + 4 * hhE;
#pragma unroll
          for (int nb = 0; nb < 4; ++nb) *(u16*)(st + r * 256 + (nb * 32 + l31E) * 2) = f32_to_bf16(acc[mb][nb][reg] * WISCALE_ + bv[nb]);
        }
#pragma unroll
        for (int it = 0; it < 8; ++it) {
          const int r = it * 4 + (laneE >> 4);
          const u32x4 w = *(const u32x4*)(st + r * 256 + ch * 16);
          *(u32x4*)(gbase + (long)(wrE * 128 + mb * 32 + r) * 2048 + gcol) = w;
        }
      }
    }
    valid = nvalid; e = ne; nt = nnt; mt = nmt;
#pragma unroll
    for (int i = 0; i < (GATHER ? 4 : 1); ++i) a_src[i] += (long)nk * a_kstep;
    b_src0 += (long)nk * 128; b_src1 += (long)nk * 128;
  }
  asm volatile("s_waitcnt vmcnt(0)" ::: "memory");
  __syncthreads();
}

template <int WHICH, int KBV = 2048>
__device__ __forceinline__ void ph_moeq(const Params& p, char* smem) {
  int* mo = (int*)(smem + G_LDS_BYTES);
#if CVT_SPLIT
  const bool dn_first = ((blockIdx.x >> 3) & 1) != 0;
  if (WHICH == 1 && dn_first) ph_convert_dn(p, smem);
#endif
  moe_setup(p, mo);
  const int NT = (WHICH == 1) ? 16 : 8;
  const int total = mo[NE_] * NT;
#if SKEW
  { const int sl = (blockIdx.x >> 3) % 5; for (int i = 0; i < sl; ++i) __builtin_amdgcn_s_sleep(SKEW); }
#endif
#if STREAM
  if (KBV == 2048 && ((STREAM >> (WHICH - 1)) & 1)) moe_stream<WHICH>(p, smem, mo); else
#endif
  for (int round = 0;; ++round) {
    const int u = xcd_unit(round);
    if (round * 256 >= total) break;
    if (u >= total) continue;
    int e = 0;
    while (mo[e + 1] * NT <= u) ++e;
    const int local = u - mo[e] * NT, me = mo[e + 1] - mo[e];
    const int nt = UORD ? (local % NT) : (local / me), mt = UORD ? (local / NT) : (local - (local / me) * me);
    if (WHICH == 1) moe1q_tile(p, smem, mo, e, nt, mt); else moe2q_tile<KBV>(p, smem, mo, e, nt, mt);
  }
#if CVT_SPLIT
  if (WHICH == 1 && !dn_first) ph_convert_dn(p, smem);
#endif
}
#define LDS_MAX 143360
#ifndef DUP
#define DUP 0
#endif
#ifndef MOEQ
#define MOEQ 1
#endif
#ifndef CVT_SPLIT
#define CVT_SPLIT 1
#endif
#ifndef CVT_STAGGER
#define CVT_STAGGER 1
#endif
#ifndef CVT_IN_P4
#define CVT_IN_P4 1
#endif
#ifndef TSTAMP
#define TSTAMP 0
#endif
#ifndef DENSER
#define DENSER 1
#endif
__global__ void __launch_bounds__(256, 1) mega(Params p) {
  extern __shared__ __attribute__((aligned(16))) char smem[];
  volatile LAS unsigned* xbw = (volatile LAS unsigned*)(smem + LDS_MAX - 16);
  if (threadIdx.x == 0) { xbw[0] = 0u; xbw[1] = 0u; xbw[2] = 0u; xbw[3] = 0u; }
  __syncthreads();
  (void)xcd_barrier_post(p.bar(), xbw);
#if TSTAMP
  unsigned long long ts0 = wall_clock64();
  int bar_no = 0;
#define XBAR() do { XcdBarrier bar_; bar_.bar = p.bar(); bar_.x = xb_xcc_id(); bar_.st = (volatile LAS unsigned*)(smem + LDS_MAX - 16); xcd_barrier(bar_); ++bar_no; if (bar_no == TSTAMP && blockIdx.x == 0 && threadIdx.x == 0) { ((float*)p.counts())[48] = (float)(wall_clock64() - ts0) * (1.0f / 100.0f); } } while (0)
#else
#define XBAR() do { XcdBarrier bar_; bar_.bar = p.bar(); bar_.x = xb_xcc_id(); bar_.st = (volatile LAS unsigned*)(smem + LDS_MAX - 16); xcd_barrier(bar_); } while (0)
#endif
#if DUP == 100
  for (int rep_ = 0; rep_ < 2; ++rep_) {
  if (rep_) XBAR();
#endif
  ph_prep0(p);
#if DUP == 33
  if (blockIdx.x < 192) gla_g1_unit(p, smem, blockIdx.x);
  else for (int i = 0; i < 5; ++i) gla_g1_unit(p, smem, 192 + (blockIdx.x - 192) * 5 + i);
#endif
#if DUP == 30
  ph_prep0(p);
#endif
#if DENSER
  ph_convert_dense(p, smem);
#endif
#if MOEQ >= 1 && CVT_IN_P4 == 0
  ph_convert(p, smem);
#if DUP == 20
  ph_convert(p, smem);
#endif
#endif
  XBAR();
#if DENSER
  ph_win_r(p, smem);
#else
  ph_win(p, smem);
#endif
#if DUP == 1
#if DENSER
  ph_win_r(p, smem);
#else
  ph_win(p, smem);
#endif
#endif
  XBAR();
  ph_prep1(p, smem);
#if DUP == 2
  ph_prep1(p, smem);
#endif
  XBAR();
#if DENSER
  upkv_tile_r(p, smem, blockIdx.x >> 3, blockIdx.x & 7);
  if (blockIdx.x < 192) upq_tile_r(p, smem, blockIdx.x / 6, blockIdx.x % 6);
#else
  upkv_tile(p, smem, blockIdx.x >> 3, blockIdx.x & 7);
  if (blockIdx.x < 192) upq_tile(p, smem, blockIdx.x / 6, blockIdx.x % 6);
#endif
  if (blockIdx.x < 192) gla_g1_unit(p, smem, blockIdx.x);
  else for (int i = 0; i < 4; ++i) gla_g1_unit(p, smem, 192 + (blockIdx.x - 192) * 4 + i);
  if (blockIdx.x < 64) gla_g1_unit(p, smem, 448 + blockIdx.x);
#if DUP == 3
  upkv_tile_r(p, smem, blockIdx.x >> 3, blockIdx.x & 7);
  if (blockIdx.x < 192) upq_tile_r(p, smem, blockIdx.x / 6, blockIdx.x % 6);
  if (blockIdx.x < 192) gla_g1_unit(p, smem, blockIdx.x);
  else for (int i = 0; i < 5; ++i) gla_g1_unit(p, smem, 192 + (blockIdx.x - 192) * 5 + i);
#endif
  XBAR();
  gla_g2_unit(p, blockIdx.x);
#if DUP == 31
  gla_g2_unit(p, blockIdx.x);
#endif
  {
    const int bh = blockIdx.x >> 4, qa = blockIdx.x & 15;
#if MOEQ >= 1 && CVT_IN_ATTN
    int ci = 0;
    attn_unit(p, smem, bh >> 3, bh & 7, 31 - qa, ci);
    attn_unit(p, smem, bh >> 3, bh & 7, qa, ci);
    for (; ci < 64; ++ci) convert_one(p, smem, blockIdx.x + 256 * ci);
#else
    int ci = 64;
#if MOEQ >= 1 && CVT_IN_P4 && STAG4
    const int sg = (blockIdx.x >> 3) & 3;
    if (sg == 0) ph_convert_gu(p, smem, 0, 1);
    if (sg == 3) ph_convert_gu(p, smem, 0, 2);
    attn_unit(p, smem, bh >> 3, bh & 7, 31 - qa, ci);
    if (sg == 1) ph_convert_gu(p, smem, 0, 1);
    attn_unit(p, smem, bh >> 3, bh & 7, qa, ci);
    if (sg == 2) ph_convert_gu(p, smem, 0, 1);
    if (sg == 3) ph_convert_gu(p, smem, 1, 2);
#else
#if MOEQ >= 1 && CVT_IN_P4
    const bool cvt_first = CVT_STAGGER ? (((STAGX ? blockIdx.x : (blockIdx.x >> 3)) & 1) != 0) : false;
    if (cvt_first) { if (CVT_SPLIT) ph_convert_gu(p, smem, 0, 1); else ph_convert(p, smem); }
#endif
    attn_unit(p, smem, bh >> 3, bh & 7, 31 - qa, ci);
    attn_unit(p, smem, bh >> 3, bh & 7, qa, ci);
#if MOEQ >= 1 && CVT_IN_P4
    if (!cvt_first) { if (CVT_SPLIT) ph_convert_gu(p, smem, 0, 1); else ph_convert(p, smem); }
#endif
#endif
#endif
#if DUP == 44
    if (cvt_first) ph_convert(p, smem);
    { int cz = 64; attn_unit(p, smem, bh >> 3, bh & 7, 31 - qa, cz); attn_unit(p, smem, bh >> 3, bh & 7, qa, cz); }
    if (!cvt_first) ph_convert(p, smem);
#endif
#if DUP == 47
    if (cvt_first) ph_convert_gu(p, smem, 0, 1);
    { int cz = 64; attn_unit(p, smem, bh >> 3, bh & 7, 31 - qa, cz); attn_unit(p, smem, bh >> 3, bh & 7, qa, cz); }
    if (!cvt_first) ph_convert_gu(p, smem, 0, 1);
#endif
#if DUP == 4
    { int cz = 64; attn_unit(p, smem, bh >> 3, bh & 7, 31 - qa, cz); attn_unit(p, smem, bh >> 3, bh & 7, qa, cz); }
#endif
  }
  XBAR();
#if DUP == 45
  if ((blockIdx.x >> 3) & 1) ph_convert_gu(p, smem, 0, 1);
  XBAR();
#endif
#if DUP == 46
  ph_convert_gu(p, smem, 0, 1);
  XBAR();
#endif
  for (int u = blockIdx.x; u < 512; u += gridDim.x) gla_g3_unit(p, smem, u);
  mla_norm_tokens(p);
#if DUP == 5
  for (int u = blockIdx.x; u < 512; u += gridDim.x) gla_g3_unit(p, smem, u);
  mla_norm_tokens(p);
#endif
  XBAR();
#if DUP == 62
  wout_tile_r<2>(p, smem, (blockIdx.x & 7) * 4 + ((blockIdx.x >> 3) & 3), blockIdx.x >> 5);
#endif
#if DENSER
  wout_tile_r(p, smem, (blockIdx.x & 7) * 4 + ((blockIdx.x >> 3) & 3), blockIdx.x >> 5);
#else
  wout_tile(p, smem, blockIdx.x >> 3, blockIdx.x & 7);
#endif
#if DUP == 6
  wout_tile_r(p, smem, (blockIdx.x & 7) * 4 + ((blockIdx.x >> 3) & 3), blockIdx.x >> 5);
#endif
#if DUP == 61
  wout_tile_r<1>(p, smem, (blockIdx.x & 7) * 4 + ((blockIdx.x >> 3) & 3), blockIdx.x >> 5);
  wout_tile_r(p, smem, (blockIdx.x & 7) * 4 + ((blockIdx.x >> 3) & 3), blockIdx.x >> 5);
#endif
  XBAR();
  ffn_prep_unit(p, smem, blockIdx.x);
#if DUP == 7
  ffn_prep_unit<1>(p, smem, blockIdx.x);
#endif
  XBAR();
#if MOEQ >= 1
  ph_moeq<1>(p, smem);
#if DUP == 8
  ph_moeq<1>(p, smem);
#endif
#else
  ph_moe<1>(p, smem);
#endif
  XBAR();
#if MOEQ >= 1
#if DUP == 92
  ph_moeq<2, 256>(p, smem);
#endif
  ph_moeq<2>(p, smem);
#else
  ph_moe<2>(p, smem);
#endif
#if DUP == 9
  ph_moeq<2>(p, smem);
#endif
#if DUP == 89
  XBAR();
  ph_moeq<1>(p, smem);
  XBAR();
  ph_moeq<2>(p, smem);
#endif
#if DUP == 19
  ph_moe<2, 1>(p, smem);
#endif
  XBAR();
#if DUP == 100
  ph_final(p, smem);
  }
#endif
#if TSTAMP
  {
    const float us = ((const float*)p.counts())[48];
    const float scl = 1.0f + us * (1.0f / 4000.0f);
    ph_final(p, smem, scl);
  }
#else
  ph_final(p, smem);
#endif
#if DUP == 10
  ph_final(p, smem);
#endif
#if DUP == 11
  for (int i = 0; i < 10; ++i) XBAR();
#endif
}

extern "C" void kernel_launch(void* const* d_in, const int* in_sizes, int n_in,
                              void* d_out, int out_size, void* d_ws, size_t ws_size,
                              hipStream_t stream) {
  Params P{};
  P.x = (const float*)d_in[0]; P.pos = (const int*)d_in[1];
  P.attn_norm = (const float*)d_in[2]; P.w_in = (const float*)d_in[3]; P.gate_up = (const float*)d_in[4]; P.gate_bias = (const float*)d_in[5];
  P.gla_out_norm = (const float*)d_in[6]; P.q_norm = (const float*)d_in[7]; P.w_uq = (const float*)d_in[8]; P.kv_norm = (const float*)d_in[9];
  P.w_ukv = (const float*)d_in[10]; P.mla_out_norm = (const float*)d_in[11]; P.w_out = (const float*)d_in[12]; P.ffn_norm = (const float*)d_in[13];
  P.router_w = (const float*)d_in[14]; P.router_b = (const float*)d_in[15]; P.w_gu = (const float*)d_in[16]; P.b_gu = (const float*)d_in[17];
  P.w_dn = (const float*)d_in[18]; P.b_dn = (const float*)d_in[19]; P.final_norm = (const float*)d_in[20];
  P.out = (float*)d_out;

  P.ws = (char*)d_ws;

  hipFuncSetAttribute((const void*)mega, hipFuncAttributeMaxDynamicSharedMemorySize, LDS_MAX);
  hipMemsetAsync(d_ws, 0, XCD_BAR_WORDS * sizeof(unsigned), stream);
  mega<<<256, 256, LDS_MAX, stream>>>(P);
}
```

```cpp
#define DUP 0
#define MOEQ 2
#define TSTAMP 0
#define CVT_SPLIT 1
#define CVT_IN_P4 1
#define STAG4 0
#define STAGX 0
#define WIN_SPLIT 1
#define CVT_IN_ATTN 0
#define YNT 0
#define ANT 0
#define BNT 1
#define UORD 0
#define LOOK1 1
#define LOOK2 0
#define WOUTQ 0
#define SKEW 0
#define PFW 0
#define MF16 0
#define EPI2 1
#define DEEP 0
#define PRE1 1
#define STREAM 3
#define STREAM_META 0
#define ATT_ILV 0
#define PKMATH 0
#define DNBAL 0
#define P0PF 1
#define P10PF 0
#define CVTSW 0
#define PFD 8
#define CVT_STAGGER 1
#include <hip/hip_runtime.h>
#include <hip/hip_bf16.h>
#include <stdint.h>
#include <type_traits>
#define T_      8192
#define SEQ_    4096
#define D_      2048
#define NC_     4176
#define C_GQ    0
#define C_GK    512
#define C_GV    1024
#define C_GR    2048
#define C_GD    3072
#define C_MQ    3088
#define C_MKV   3600
#define C_MKR   4112
#define NE_     32
#define DFF_    2048
#define EPS_    1e-6f
typedef short bf16x8 __attribute__((ext_vector_type(8)));
typedef short s16x4 __attribute__((ext_vector_type(4)));
typedef float f32x16 __attribute__((ext_vector_type(16)));
typedef float f32x4 __attribute__((ext_vector_type(4)));
typedef float f32x2 __attribute__((ext_vector_type(2)));
typedef unsigned short u16;
typedef unsigned u32x4 __attribute__((ext_vector_type(4)));
typedef unsigned u32x2 __attribute__((ext_vector_type(2)));
#define LAS3 __attribute__((address_space(3)))
#define OPAQUE(x) asm volatile("" : "+v"(x))
#define NTHR 256
__device__ __forceinline__ int opaque_tid() { int t = threadIdx.x; asm volatile("" : "+v"(t)); return t; }

__device__ __forceinline__ unsigned pack_bf16(float a, float b) {
  typedef __bf16 bf2 __attribute__((ext_vector_type(2)));
  typedef float f2 __attribute__((ext_vector_type(2)));
  f2 v = {a, b};
  bf2 r = __builtin_convertvector(v, bf2);
  return *(unsigned*)&r;
}
__device__ __forceinline__ float bf_lo(unsigned w) { return __uint_as_float(w << 16); }
__device__ __forceinline__ float bf_hi(unsigned w) { return __uint_as_float(w & 0xffff0000u); }
__device__ __forceinline__ float bf16_to_f32(u16 v) { return __uint_as_float(((unsigned)v) << 16); }
__device__ __forceinline__ u16 f32_to_bf16(float f) { return (u16)(pack_bf16(f, 0.f) & 0xffffu); }
__device__ __forceinline__ float shflx(float v, int k) {
  int t = threadIdx.x; asm volatile("" : "+v"(t));
  return __int_as_float(__builtin_amdgcn_ds_bpermute((((t & 63) ^ k) << 2), __float_as_int(v)));
}
__device__ __forceinline__ float wave_sum(float v) {
#pragma unroll
  for (int o = 32; o > 0; o >>= 1) v += shflx(v, o);
  return v;
}
__device__ __forceinline__ unsigned off_b(unsigned row, unsigned ch) { return 256u * row + 16u * (ch ^ (((row & 3u) << 2) | ((row >> 2) & 3u))); }
__device__ __forceinline__ unsigned tr_addr(unsigned lane, unsigned c, unsigned row0  ) {
  const unsigned blk = (lane >> 4) & 1u, q = (lane & 15u) >> 2, p = lane & 3u;
  return off_b(row0 + q, 4u * c + 2u * blk + (p >> 1)) + 8u * (p & 1u);
}
__device__ __forceinline__ bf16x8 tr_frag(const char* img, unsigned lane, unsigned c, unsigned row_a, unsigned row_b) {
  s16x4 v0 = __builtin_amdgcn_ds_read_tr16_b64_v4i16((LAS3 s16x4*)(img + tr_addr(lane, c, row_a)));
  s16x4 v1 = __builtin_amdgcn_ds_read_tr16_b64_v4i16((LAS3 s16x4*)(img + tr_addr(lane, c, row_b)));
  return (bf16x8){v0[0], v0[1], v0[2], v0[3], v1[0], v1[1], v1[2], v1[3]};
}

__device__ __forceinline__ void glds16_asm(const void* gsrc, unsigned lds_dst) {
  unsigned keep;
  asm volatile("s_mov_b32 %0, m0\n\ts_mov_b32 m0, %2\n\ts_nop 0\n\tglobal_load_lds_dwordx4 %1, off\n\ts_mov_b32 m0, %0" : "=&s"(keep) : "v"(gsrc), "s"(lds_dst) : "memory");
}
__device__ __forceinline__ void glds16_asm_nt(const void* gsrc, unsigned lds_dst) {
  unsigned keep;
  asm volatile("s_mov_b32 %0, m0\n\ts_mov_b32 m0, %2\n\ts_nop 0\n\tglobal_load_lds_dwordx4 %1, off nt\n\ts_mov_b32 m0, %0" : "=&s"(keep) : "v"(gsrc), "s"(lds_dst) : "memory");
}
__device__ __forceinline__ void glds4_asm(const void* gsrc, unsigned lds_dst) {
  unsigned keep;
  asm volatile("s_mov_b32 %0, m0\n\ts_mov_b32 m0, %2\n\ts_nop 0\n\tglobal_load_lds_dword %1, off\n\ts_mov_b32 m0, %0" : "=&s"(keep) : "v"(gsrc), "s"(lds_dst) : "memory");
}
struct Params {
  const float *x; const int* pos;
  const float *attn_norm, *w_in, *gate_up, *gate_bias, *gla_out_norm, *q_norm, *w_uq, *kv_norm, *w_ukv, *mla_out_norm, *w_out,
              *ffn_norm, *router_w, *router_b, *w_gu, *b_gu, *w_dn, *b_dn, *final_norm;
  float* out;
  char* ws;
  __device__ __forceinline__ unsigned* bar() const { return (unsigned*)(ws + 0ull); }
  __device__ __forceinline__ int* counts() const { return (int*)(ws + 16384ull); }
  __device__ __forceinline__ u16* h1() const { return (u16*)(ws + 16640ull); }
  __device__ __forceinline__ u16* proj() const { return (u16*)(ws + 33571072ull); }
  __device__ __forceinline__ float2* cs() const { return (float2*)(ws + 101990656ull); }
  __device__ __forceinline__ float* rq() const { return (float*)(ws + 104087808ull); }
  __device__ __forceinline__ float* rkv() const { return (float*)(ws + 104120576ull); }
  __device__ __forceinline__ float* bcum() const { return (float*)(ws + 104153344ull); }
  __device__ __forceinline__ u16* q() const { return (u16*)(ws + 120930560ull); }
  __device__ __forceinline__ u16* kv() const { return (u16*)(ws + 146096384ull); }
  __device__ __forceinline__ u16* kpe() const { return (u16*)(ws + 179650816ull); }
  __device__ __forceinline__ u16* kvc() const { return (u16*)(ws + 180699392ull); }
  __device__ __forceinline__ float* dec() const { return (float*)(ws + 214253824ull); }
  __device__ __forceinline__ u16* sprev() const { return (u16*)(ws + 214515968ull); }
  __device__ __forceinline__ u16* mix() const { return (u16*)(ws + 248070400ull); }
  __device__ __forceinline__ u16* omla() const { return (u16*)(ws + 281624832ull); }
  __device__ __forceinline__ float* x1() const { return (float*)(ws + 298402048ull); }
  __device__ __forceinline__ u16* h2() const { return (u16*)(ws + 365510912ull); }
  __device__ __forceinline__ int* list() const { return (int*)(ws + 399065344ull); }
  __device__ __forceinline__ int* asg_e() const { return (int*)(ws + 400113920ull); }
  __device__ __forceinline__ int* asg_slot() const { return (int*)(ws + 400244992ull); }
  __device__ __forceinline__ float* asg_g() const { return (float*)(ws + 400376064ull); }
  __device__ __forceinline__ u16* act() const { return (u16*)(ws + 400507136ull); }
  __device__ __forceinline__ u16* ybuf() const { return (u16*)(ws + 568279296ull); }
  __device__ __forceinline__ unsigned char* wq_gu() const { return (unsigned char*)(ws + 736051456ull); }
  __device__ __forceinline__ unsigned char* wq_dn() const { return (unsigned char*)(ws + 1004486912ull); }
  __device__ __forceinline__ unsigned char* h2q() const { return (unsigned char*)(ws + 1138704640ull); }
  __device__ __forceinline__ unsigned char* actq() const { return (unsigned char*)(ws + 1155481856ull); }
  __device__ __forceinline__ u16* wb_in() const { return (u16*)(ws + 1239367936ull); }
  __device__ __forceinline__ u16* wb_uq() const { return (u16*)(ws + 1257193728ull); }
  __device__ __forceinline__ u16* wb_ukv() const { return (u16*)(ws + 1258766592ull); }
  __device__ __forceinline__ u16* wb_out() const { return (u16*)(ws + 1260863744ull); }
  __device__ __forceinline__ unsigned char* mixq() const { return (unsigned char*)(ws + 1269252352ull); }
  __device__ __forceinline__ unsigned char* wq_out() const { return (unsigned char*)(ws + 1286029568ull); }
  __device__ __forceinline__ float* pn() const { return (float*)(ws + 1290223872ull); }
  __device__ __forceinline__ u32x4* dummy() const { return (u32x4*)(ws + 1311195648ull); }
};
#define WS_BYTES_USED 1312244480ull

#define XB_TMO      128
#define XB_XCNT(j)  (256  + 64 * (j))
#define XB_XSUB(j)  (1280 + 64 * (j))
#define XB_XGEN(j)  (2304 + 64 * (j))
#define XB_TOP      3328
#define XB_TOPGEN   3392
#define XCD_BAR_WORDS 3456
#define XB_SPIN_CAP (1u << 18)
#define LAS __attribute__((address_space(3)))

__device__ __forceinline__ unsigned xb_ld(unsigned* p)              { return __hip_atomic_load(p, __ATOMIC_RELAXED, __HIP_MEMORY_SCOPE_AGENT); }
__device__ __forceinline__ unsigned xb_add(unsigned* p, unsigned v) { return __hip_atomic_fetch_add(p, v, __ATOMIC_RELAXED, __HIP_MEMORY_SCOPE_AGENT); }
__device__ __forceinline__ unsigned xb_xcc_id() { return (unsigned)__builtin_amdgcn_s_getreg((3 << 11) | 20) & 0xFu; }
#define XB_SPIN(cond, bar) do { unsigned _sp = 0; while (cond) { __builtin_amdgcn_s_sleep(1); \
    if ((++_sp & 255u) == 0u) { if (xb_ld(&(bar)[XB_TMO])) break; if (_sp > XB_SPIN_CAP) { atomicAdd(&(bar)[XB_TMO], 1u); break; } } } } while (0)

struct XcdBarrier {
    unsigned* bar; unsigned x;
    volatile LAS unsigned* st;
};

__device__ __forceinline__ XcdBarrier xcd_barrier_post(unsigned* bar, volatile LAS unsigned* st) {
    XcdBarrier b; b.bar = bar; b.x = xb_xcc_id(); b.st = st;
    if (threadIdx.x == 0) (void)xb_add(&bar[XB_XCNT(b.x)], 1u);
    return b;
}
__device__ __forceinline__ void xcd_barrier_complete(unsigned* bar, unsigned x, unsigned& nloc, unsigned& nx) {
    const unsigned G = gridDim.x * gridDim.y * gridDim.z;
    unsigned sum, cnt, mine, sp = 0u;
    for (;;) {
        sum = 0u; cnt = 0u; mine = 0u;
#pragma unroll
        for (unsigned j = 0; j < 16; ++j) { const unsigned c = xb_ld(&bar[XB_XCNT(j)]); sum += c; cnt += (c > 0u) ? 1u : 0u; mine = (j == x) ? c : mine; }
        if (sum == G) break;
        __builtin_amdgcn_s_sleep(1);
        if ((++sp & 255u) == 0u) { if (xb_ld(&bar[XB_TMO])) break; if (sp > XB_SPIN_CAP) { atomicAdd(&bar[XB_TMO], 1u); break; } }
    }
    nloc = mine > 0u ? mine : 1u; nx = cnt > 0u ? cnt : 1u;
}

__device__ __forceinline__ void xcd_barrier(const XcdBarrier& b) {
    asm volatile("s_waitcnt vmcnt(0)" ::: "memory");
    __syncthreads();
    if (threadIdx.x == 0) {
        unsigned* bar = b.bar;
        __builtin_amdgcn_s_waitcnt(0);
        unsigned nloc = b.st[0], nx = b.st[1];
        if (nloc == 0u) { xcd_barrier_complete(bar, b.x, nloc, nx); b.st[0] = nloc; b.st[1] = nx; }
        const unsigned old = xb_add(&bar[XB_XSUB(b.x)], 1u);
        const unsigned gen = old / nloc;
        if (old + 1u == (gen + 1u) * nloc) {
            __builtin_amdgcn_fence(__ATOMIC_RELEASE, "agent");
            asm volatile("s_waitcnt vmcnt(0)" ::: "memory");
            const unsigned og = xb_add(&bar[XB_TOP], 1u);
            const unsigned tg = og / nx;
            if (og + 1u == (tg + 1u) * nx) xb_add(&bar[XB_TOPGEN], 1u);
            else XB_SPIN(xb_ld(&bar[XB_TOPGEN]) == tg, bar);
            __builtin_amdgcn_fence(__ATOMIC_ACQUIRE, "agent");
            xb_add(&bar[XB_XGEN(b.x)], 1u);
            asm volatile("s_waitcnt vmcnt(0)" ::: "memory");
        } else {
            XB_SPIN(xb_ld(&bar[XB_XGEN(b.x)]) == gen, bar);
            __builtin_amdgcn_fence(__ATOMIC_ACQUIRE, "agent");
            asm volatile("s_waitcnt vmcnt(0)" ::: "memory");
        }
    }
    __syncthreads();
}

#define G_A_OFF(s)  ((s) * 65536)
#define G_B_OFF(s)  ((s) * 65536 + 32768)
#define G_LDS_BYTES 131072

struct GemmTile {
  const u16* A; int lda;
  const int* aidx;
  int m0, mvalid;
  const float* B0; const float* B1;
  int ldb; int nv0, nv1;
  const float* kscale;
  int K;
};

template <int NB, bool KSCALE, bool GATHER>
__device__ __forceinline__ void gemm_tile_256(const GemmTile& t, char* smem, f32x16 (&acc)[4][4]) {
  int tz0 = threadIdx.x; asm volatile("" : "+v"(tz0));
  const int tid = tz0, lane = tid & 63, wid = tid >> 6, wr = wid >> 1, wc = wid & 1;
  const int l31 = lane & 31, hh = lane >> 5;
#pragma unroll
  for (int i = 0; i < 4; ++i)
#pragma unroll
    for (int j = 0; j < 4; ++j)
#pragma unroll
      for (int r = 0; r < 16; ++r) acc[i][j][r] = 0.f;

  const int a_c = (tid & 7) ^ ((tid >> 4) & 7);
  const u16* a_src[GATHER ? 8 : 1];
  if (GATHER) {
#pragma unroll
    for (int i = 0; i < (GATHER ? 8 : 1); ++i) {
      int r = (tid >> 3) + 32 * i;
      int rr = r < t.mvalid ? r : 0;
      a_src[i] = t.A + (long)t.aidx[rr] * t.lda + a_c * 8;
    }
  } else {
    a_src[0] = t.A + (long)(t.m0 + (tid >> 3)) * t.lda + a_c * 8;
  }
  const long a_step = 32L * t.lda;
  const int b_n4 = tid & 63, b_k = tid >> 6;
  const int b_k_u = __builtin_amdgcn_readfirstlane(b_k);
  const int b_img = b_n4 >> 5, b_ch = (b_n4 >> 1) & 15, b_half = b_n4 & 1;
  const bool b_ok = ((b_n4 & 31) * 4) < (b_img ? t.nv1 : t.nv0);
  const int b_loff = (b_ok ? ((b_img ? (int)(t.B1 - t.B0) : 0) + (b_n4 & 31) * 4) : 0) + b_k * t.ldb;
  f32x4 breg[16];

  const unsigned a_lds0 = (unsigned)(size_t)smem + (unsigned)__builtin_amdgcn_readfirstlane(wid) * 1024u;
  auto issue_a = [&](int kt, int s, int i) {
    glds16_asm((const void*)((GATHER ? a_src[GATHER ? i : 0] : a_src[0] + i * a_step) + kt * 64), a_lds0 + G_A_OFF(s) + i * 4096);
  };
  auto issue_b = [&](int kt, int j) {
    const float* ptr = t.B0 + (long)(kt * 64 + 4 * j) * t.ldb + b_loff;
    asm volatile("global_load_dwordx4 %0, %1, off" : "=v"(breg[j]) : "v"(ptr) : "memory");
  };
  auto write_b = [&](int kt, int s, int j) {
    const int k = b_k + 4 * j;
    f32x4 v = breg[j];
    if (KSCALE) { float sc = t.kscale[kt * 64 + b_k_u + 4 * j]; v *= sc; }
    if (!b_ok) v = (f32x4){0.f, 0.f, 0.f, 0.f};
    u32x2 w = {pack_bf16(v[0], v[1]), pack_bf16(v[2], v[3])};
    *(u32x2*)(smem + G_B_OFF(s) + b_img * 16384 + off_b(k, b_ch) + 8 * b_half) = w;
  };
#define WAITQ(N, g) asm volatile("s_waitcnt vmcnt(" #N ")" : "+v"(breg[4 * (g)]), "+v"(breg[4 * (g) + 1]), "+v"(breg[4 * (g) + 2]), "+v"(breg[4 * (g) + 3]) :: "memory")

  unsigned a_rd[4], b_rd[2][2];
#pragma unroll
  for (int ks = 0; ks < 4; ++ks) { const int row = wr * 128 + l31; a_rd[ks] = row * 128 + (((2 * ks + hh) ^ ((row >> 1) & 7)) * 16); }
#pragma unroll
  for (int tt = 0; tt < 2; ++tt)
#pragma unroll
    for (int nl = 0; nl < 2; ++nl) b_rd[tt][nl] = tr_addr(lane, wc * 2 + nl, 8 * hh + 4 * tt);
  auto load_a = [&](const char* As, int ks, bf16x8 (&af)[4]) {
#pragma unroll
    for (int mb = 0; mb < 4; ++mb) af[mb] = *(const bf16x8*)(As + a_rd[ks] + mb * 4096);
  };
  auto load_b1 = [&](const char* Bs, int ks, int nb, bf16x8& bfr) {
    const char* bi = Bs + (nb >> 1) * 16384 + ks * 4096;
    s16x4 v0 = __builtin_amdgcn_ds_read_tr16_b64_v4i16((LAS3 s16x4*)(bi + b_rd[0][nb & 1]));
    s16x4 v1 = __builtin_amdgcn_ds_read_tr16_b64_v4i16((LAS3 s16x4*)(bi + b_rd[1][nb & 1]));
    bfr = (bf16x8){v0[0], v0[1], v0[2], v0[3], v1[0], v1[1], v1[2], v1[3]};
  };

  auto kstep = [&](int kt, auto mode_tag, bool has1, bool has2) {
    constexpr int MODE = decltype(mode_tag)::value;
    const int s = kt & 1;
    const char* As = smem + G_A_OFF(s);
    const char* Bs = smem + G_B_OFF(s);
    bf16x8 a0[4], a1[4], bq[NB];
    load_a(As, 0, a0);
#pragma unroll
    for (int nb = 0; nb < NB; ++nb) load_b1(Bs, 0, nb, bq[nb]);
    __builtin_amdgcn_sched_barrier(0);
#pragma unroll
    for (int g = 0; g < 4; ++g) {
      bf16x8 (&ac)[4] = (g & 1) ? a1 : a0;
      bf16x8 (&an)[4] = (g & 1) ? a0 : a1;
      if (g < 3) load_a(As, g + 1, an);
      __builtin_amdgcn_sched_barrier(0);
#pragma unroll
      for (int nb = 0; nb < NB; ++nb) {
#pragma unroll
        for (int mb = 0; mb < 4; ++mb)
          acc[mb][nb] = __builtin_amdgcn_mfma_f32_32x32x16_bf16(ac[mb], bq[nb], acc[mb][nb], 0, 0, 0);
        __builtin_amdgcn_sched_barrier(0);
        if (g < 3) load_b1(Bs, g + 1, nb, bq[nb]);
        if (nb == 0 && g < 2 && has1) { issue_a(kt + 1, s ^ 1, 4 * g + 0); issue_a(kt + 1, s ^ 1, 4 * g + 1); }
        if (nb == 1 % NB && g < 2 && has1 && NB > 1) { issue_a(kt + 1, s ^ 1, 4 * g + 2); issue_a(kt + 1, s ^ 1, 4 * g + 3); }
        if (NB == 1 && nb == 0 && g < 2 && has1) { issue_a(kt + 1, s ^ 1, 4 * g + 2); issue_a(kt + 1, s ^ 1, 4 * g + 3); }
        if (nb == NB - 1 && has1) {
          if (MODE == 2) { if (g == 0) WAITQ(20, 0); else if (g == 1) WAITQ(20, 1); else if (g == 2) WAITQ(20, 2); else WAITQ(20, 3); }
          else if (MODE == 1) { if (g == 0) WAITQ(16, 0); else if (g == 1) WAITQ(20, 1); else if (g == 2) WAITQ(20, 2); else WAITQ(20, 3); }
          else { if (g == 0) WAITQ(0, 0); else if (g == 1) WAITQ(0, 1); else if (g == 2) WAITQ(0, 2); else WAITQ(0, 3); }
#pragma unroll
          for (int i = 0; i < 4; ++i) write_b(kt + 1, s ^ 1, 4 * g + i);
          if (has2) {
#pragma unroll
            for (int i = 0; i < 4; ++i) issue_b(kt + 2, 4 * g + i);
          }
        }
        __builtin_amdgcn_sched_barrier(0);
      }
    }
    if (has1) {
      if (MODE == 0) asm volatile("s_waitcnt vmcnt(0)" ::: "memory");
      else asm volatile("s_waitcnt vmcnt(12)" ::: "memory");
      __syncthreads();
    }
  };

  const int nk = t.K >> 6;
  __syncthreads();
#pragma unroll
  for (int j = 0; j < 16; ++j) issue_b(0, j);
#pragma unroll
  for (int i = 0; i < 8; ++i) issue_a(0, 0, i);
  WAITQ(8, 0); WAITQ(8, 1); WAITQ(8, 2); WAITQ(8, 3);
#pragma unroll
  for (int j = 0; j < 16; ++j) write_b(0, 0, j);
#pragma unroll
  for (int j = 0; j < 16; ++j) issue_b(1, j);
  asm volatile("s_waitcnt vmcnt(16)" ::: "memory");
  __syncthreads();
  kstep(0, std::integral_constant<int, 1>{}, true, true);
  for (int kt = 1; kt < nk - 2; ++kt) kstep(kt, std::integral_constant<int, 2>{}, true, true);
  kstep(nk - 2, std::integral_constant<int, 0>{}, true, false);
  kstep(nk - 1, std::integral_constant<int, 0>{}, false, false);
#undef WAITQ
}
template <int NB, class F>
__device__ __forceinline__ void acc_foreach_row(f32x16 (&acc)[4][4], F f) {
  int tz = threadIdx.x; asm volatile("" : "+v"(tz));
  const int lane = tz & 63, wid = tz >> 6, wr = wid >> 1, wc = wid & 1;
  const int l31 = lane & 31, hh = lane >> 5;
#pragma unroll
  for (int mb = 0; mb < 4; ++mb)
#pragma unroll
    for (int reg = 0; reg < 16; ++reg) {
      const int rowl = wr * 128 + mb * 32 + (reg & 3) + 8 * (reg >> 2) + 4 * hh;
      float v[NB];
#pragma unroll
      for (int nb = 0; nb < NB; ++nb) v[nb] = acc[mb][nb][reg];
      f(rowl, wc * 64 + l31, v);
      asm volatile("" ::: "memory");
    }
}
__device__ __forceinline__ void ph_prep0(const Params& p) {
  const int tid_ = opaque_tid(); const int lane = tid_ & 63, wid = tid_ >> 6;
  if (blockIdx.x == 0 && tid_ < 64) p.counts()[tid_] = 0;
#if P0PF
  f32x4 nv[8];
  {
    const float* xr0 = p.x + (long)(blockIdx.x * 4 + wid) * 2048;
#pragma unroll
    for (int j = 0; j < 8; ++j) nv[j] = __builtin_nontemporal_load((const f32x4*)(xr0 + j * 256 + lane * 4));
  }
#endif
  for (int t = blockIdx.x * 4 + wid; t < T_; t += gridDim.x * 4) {
    const float* xr = p.x + (long)t * 2048;
    f32x4 v[8]; float ss = 0.f;
#if P0PF
#pragma unroll
    for (int j = 0; j < 8; ++j) v[j] = nv[j];
    {
      const int tn = t + gridDim.x * 4;
      const float* xn = p.x + (long)(tn < T_ ? tn : t) * 2048;
#pragma unroll
      for (int j = 0; j < 8; ++j) nv[j] = __builtin_nontemporal_load((const f32x4*)(xn + j * 256 + lane * 4));
    }
#pragma unroll
    for (int j = 0; j < 8; ++j) ss += v[j][0] * v[j][0] + v[j][1] * v[j][1] + v[j][2] * v[j][2] + v[j][3] * v[j][3];
#else
#pragma unroll
    for (int j = 0; j < 8; ++j) { v[j] = __builtin_nontemporal_load((const f32x4*)(xr + j * 256 + lane * 4)); ss += v[j][0] * v[j][0] + v[j][1] * v[j][1] + v[j][2] * v[j][2] + v[j][3] * v[j][3]; }
#endif
    ss = wave_sum(ss);
    const float r = rsqrtf(ss * (1.0f / 2048.0f) + EPS_);
#pragma unroll
    for (int j = 0; j < 8; ++j) {
      f32x4 g = *(const f32x4*)(p.attn_norm + j * 256 + lane * 4);
      u32x2 w = {pack_bf16(v[j][0] * r * g[0], v[j][1] * r * g[1]), pack_bf16(v[j][2] * r * g[2], v[j][3] * r * g[3])};
      *(u32x2*)(p.h1() + (long)t * 2048 + j * 256 + lane * 4) = w;
    }
    if (lane < 32) {
      float inv = __builtin_amdgcn_exp2f(-(float)lane * (13.287712379549449f / 32.0f));
      float ang = (float)p.pos[t] * inv;
      double a = (double)ang;
      double k = rint(a * 0.15915494309189535);
      float rf = (float)fma(-k, 6.283185307179586, a);
      p.cs()[t * 32 + lane] = make_float2(__cosf(rf), __sinf(rf));
    }
  }
}

template <int NB>
__device__ __forceinline__ void win_tile(const Params& p, char* smem, int mt, int nt) {
  f32x16 acc[4][4];
  GemmTile t{};
  t.A = p.h1(); t.lda = 2048; t.aidx = nullptr; t.m0 = mt * 256; t.mvalid = 256;
  t.B0 = p.w_in + nt * 256; t.B1 = t.B0 + 128; t.ldb = NC_;
  const int rem = NC_ - nt * 256;
  t.nv0 = rem >= 128 ? 128 : rem; t.nv1 = rem >= 256 ? 128 : (rem > 128 ? rem - 128 : 0);
  t.kscale = nullptr; t.K = 2048;
  gemm_tile_256<NB, false, false>(t, smem, acc);
  u16* base = p.proj() + (long)(mt * 256) * NC_ + nt * 256;
  const int nv0 = t.nv0, nv1 = t.nv1;
  acc_foreach_row<NB>(acc, [&](int rowl, int coll, float (&v)[NB]) {
    u16* rp = base + (long)rowl * NC_ + coll;
    OPAQUE(rp);
#pragma unroll
    for (int nb = 0; nb < NB; ++nb) {
      const int c = (nb & 1) * 32 + coll;
      const int lim = (nb >> 1) ? nv1 : nv0;
      if (c < lim) rp[(nb >> 1) * 128 + (nb & 1) * 32] = f32_to_bf16(v[nb]);
    }
  });
}
__device__ __forceinline__ void ph_win(const Params& p, char* smem) {
  const int x = blockIdx.x & 7, slot = blockIdx.x >> 3;
  for (int j = slot; j < 64; j += 32) win_tile<4>(p, smem, 4 * x + (j & 3), j >> 2);
  if (slot < 4) win_tile<2>(p, smem, 4 * x + slot, 16);
}

__device__ __forceinline__ void ph_prep1(const Params& p, char* smem) {
  float* gds = (float*)smem;
  float* cums = (float*)(smem + 4096);
  const int tid = opaque_tid(), lane = tid & 63, wid = tid >> 6;
  for (int u = blockIdx.x; u < 512; u += gridDim.x) {
    const int ch = u >> 2, h = u & 3; const int t0 = ch * 64;
    __syncthreads();
    {
      const int tl = tid >> 2, r4 = (tid & 3) * 4;
      u32x2 w = *(const u32x2*)(p.proj() + (long)(t0 + tl) * NC_ + C_GD + r4);
      gds[tl * 16 + r4 + 0] = bf_lo(w[0]); gds[tl * 16 + r4 + 1] = bf_hi(w[0]);
      gds[tl * 16 + r4 + 2] = bf_lo(w[1]); gds[tl * 16 + r4 + 3] = bf_hi(w[1]);
    }
    const int c = tid & 127, half = tid >> 7;
    float gu[16];
#pragma unroll
    for (int r = 0; r < 16; ++r) gu[r] = p.gate_up[r * 512 + h * 128 + c];
    const float bias = p.gate_bias[h * 128 + c];
    __syncthreads();
    float run = 0.f;
    for (int i = 0; i < 32; ++i) {
      const int tl = half * 32 + i;
      float z = bias;
#pragma unroll
      for (int r = 0; r < 16; ++r) z = fmaf(gds[tl * 16 + r], gu[r], z);
      const float ls = fminf(z, 0.f) - __logf(1.0f + __expf(-fabsf(z)));
      run += ls * (1.0f / 16.0f);
      cums[tl * 128 + c] = run;
    }
    __syncthreads();
    {
      const float add = cums[31 * 128 + c];
      for (int i = 0; i < 32; ++i) {
        const int tl = half * 32 + i;
        float v = cums[tl * 128 + c] + (half ? add : 0.f);
        p.bcum()[(long)(t0 + tl) * 512 + h * 128 + c] = v;
      }
    }
    for (int i = 0; i < 4; ++i) {
      const long t = t0 + h * 16 + wid * 4 + i;
      const u16* pr = p.proj() + t * NC_;
      u32x4 a = *(const u32x4*)(pr + C_MQ + lane * 8);
      float sa = 0.f, sb = 0.f;
#pragma unroll
      for (int k = 0; k < 4; ++k) { float l = bf_lo(a[k]), hgh = bf_hi(a[k]); sa += l * l + hgh * hgh; }
#if WIN_SPLIT
      auto pn_sum = [&](int col) { float s = 0.f;
#pragma unroll
        for (int kc = 0; kc < 8; ++kc) s += p.pn()[(long)kc * (8192 * 80) + t * 80 + col];
        return s; };
      const float pv = bf16_to_f32(f32_to_bf16(pn_sum(lane)));
      u32x4 b = {0u, 0u, 0u, 0u};
      if (lane < 62) b = *(const u32x4*)(pr + C_MKV + lane * 8);
#pragma unroll
      for (int k = 0; k < 4; ++k) { float l = bf_lo(b[k]), hgh = bf_hi(b[k]); sb += l * l + hgh * hgh; }
      if (lane < 16) sb += pv * pv;
#else
      u32x4 b = *(const u32x4*)(pr + C_MKV + lane * 8);
#pragma unroll
      for (int k = 0; k < 4; ++k) { float l = bf_lo(b[k]), hgh = bf_hi(b[k]); sb += l * l + hgh * hgh; }
#endif
      sa = wave_sum(sa); sb = wave_sum(sb);
      if (lane == 0) { p.rq()[t] = rsqrtf(sa * (1.0f / 512.0f) + EPS_); p.rkv()[t] = rsqrtf(sb * (1.0f / 512.0f) + EPS_); }
#if WIN_SPLIT
      {
        const float v0 = pv;
        const float v1 = (lane < 16) ? bf16_to_f32(f32_to_bf16(pn_sum(64 + lane))) : 0.f;
        u16* pw = p.proj() + t * NC_ + 4096;
        pw[lane] = f32_to_bf16(v0);
        if (lane < 16) pw[64 + lane] = f32_to_bf16(v1);
        const float t1 = __int_as_float(__builtin_amdgcn_ds_bpermute(((lane + 16) & 63) << 2, __float_as_int(v0)));
        const float t2a = __int_as_float(__builtin_amdgcn_ds_bpermute(((lane + 48) & 63) << 2, __float_as_int(v0)));
        const float t2b = __int_as_float(__builtin_amdgcn_ds_bpermute(((lane - 16) & 63) << 2, __float_as_int(v1)));
        if (lane < 32) {
          const float t2 = (lane < 16) ? t2a : t2b;
          const float2 cs = p.cs()[t * 32 + lane];
          p.kpe()[t * 64 + lane] = f32_to_bf16(t1 * cs.x - t2 * cs.y);
          p.kpe()[t * 64 + lane + 32] = f32_to_bf16(t1 * cs.y + t2 * cs.x);
        }
      }
#else
      if (lane < 32) {
        const float t1 = bf16_to_f32(pr[C_MKR + lane]), t2 = bf16_to_f32(pr[C_MKR + lane + 32]);
        const float2 cs = p.cs()[t * 32 + lane];
        p.kpe()[t * 64 + lane] = f32_to_bf16(t1 * cs.x - t2 * cs.y);
        p.kpe()[t * 64 + lane + 32] = f32_to_bf16(t1 * cs.y + t2 * cs.x);
      }
#endif
    }
  }
}

#define QSCALE_ (0.07216878364870322f * 1.4426950408889634f)
__device__ __forceinline__ void upq_tile(const Params& p, char* smem, int mt, int nt) {
  f32x16 acc[4][4];
  GemmTile t{};
  t.A = p.proj() + C_MQ; t.lda = NC_; t.aidx = nullptr; t.m0 = mt * 256; t.mvalid = 256;
  t.B0 = p.w_uq + nt * 256; t.B1 = t.B0 + 128; t.ldb = 1536; t.nv0 = 128; t.nv1 = 128; t.kscale = p.q_norm; t.K = 512;
  gemm_tile_256<4, true, false>(t, smem, acc);
  u16* base = p.q() + (long)(mt * 256) * 1536 + nt * 256;
  const float* rq = p.rq() + mt * 256;
  acc_foreach_row<4>(acc, [&](int rowl, int coll, float (&v)[4]) {
    u16* rp = base + (long)rowl * 1536 + coll;
    OPAQUE(rp);
    const float s = rq[rowl] * QSCALE_;
#pragma unroll
    for (int nb = 0; nb < 4; ++nb) rp[(nb >> 1) * 128 + (nb & 1) * 32] = f32_to_bf16(v[nb] * s);
  });
}
__device__ __forceinline__ void upkv_tile(const Params& p, char* smem, int mt, int nt) {
  f32x16 acc[4][4];
  GemmTile t{};
  t.A = p.proj() + C_MKV; t.lda = NC_; t.aidx = nullptr; t.m0 = mt * 256; t.mvalid = 256;
  t.B0 = p.w_ukv + nt * 256; t.B1 = t.B0 + 128; t.ldb = 2048; t.nv0 = 128; t.nv1 = 128; t.kscale = p.kv_norm; t.K = 512;
  gemm_tile_256<4, true, false>(t, smem, acc);
  u16* base = p.kv() + (long)(mt * 256) * 2048 + nt * 256;
  const float* rk = p.rkv() + mt * 256;
  acc_foreach_row<4>(acc, [&](int rowl, int coll, float (&v)[4]) {
    u16* rp = base + (long)rowl * 2048 + coll;
    OPAQUE(rp);
    const float s = rk[rowl];
#pragma unroll
    for (int nb = 0; nb < 4; ++nb) rp[(nb >> 1) * 128 + (nb & 1) * 32] = f32_to_bf16(v[nb] * s);
  });
}
#define WSCALE_  128.0f
#define WISCALE_ 0.0078125f
typedef unsigned char u8;
struct CvtUnit { const float* src; u8* dst; int ldn; };
__device__ __forceinline__ CvtUnit cvt8_decode(const Params& p, int u);
#define AT_KSTRIDE 400
#define AT_KBYTES  (64 * AT_KSTRIDE)
#define AT_STAGE   (AT_KBYTES + 16384)
#define AT_LDS_BYTES (2 * AT_STAGE)

#define AT_CVT_T(par) (smem + AT_LDS_BYTES + (par) * 16384)
__device__ __forceinline__ void attn_unit(const Params& p, char* smem, int b, int h, int qb, int& ci) {
  const int tid = opaque_tid(), lane = tid & 63, wid = tid >> 6, l31 = lane & 31, hh = lane >> 5;
  const long tq = (long)b * SEQ_ + qb * 128 + wid * 32 + l31;
  bf16x8 qf[12];
  {
    const u16* qp = p.q() + (tq * 8 + h) * 192 + 8 * hh;
#pragma unroll
    for (int ks = 0; ks < 12; ++ks) qf[ks] = *(const bf16x8*)(qp + 16 * ks);
#pragma unroll
    for (int s = 0; s < 2; ++s) {
      const float2* cp = p.cs() + tq * 32 + 16 * s + 8 * hh;
      bf16x8 lo = qf[8 + s], hi = qf[10 + s], nlo, nhi;
#pragma unroll
      for (int j = 0; j < 8; j += 2) {
        float2 c0 = cp[j], c1 = cp[j + 1];
        float a0 = bf16_to_f32((u16)lo[j]), a1 = bf16_to_f32((u16)lo[j + 1]);
        float b0 = bf16_to_f32((u16)hi[j]), b1 = bf16_to_f32((u16)hi[j + 1]);
        unsigned wl = pack_bf16(a0 * c0.x - b0 * c0.y, a1 * c1.x - b1 * c1.y);
        unsigned wh = pack_bf16(a0 * c0.y + b0 * c0.x, a1 * c1.y + b1 * c1.x);
        nlo[j] = (short)(wl & 0xffff); nlo[j + 1] = (short)(wl >> 16);
        nhi[j] = (short)(wh & 0xffff); nhi[j + 1] = (short)(wh >> 16);
      }
      qf[8 + s] = nlo; qf[10 + s] = nhi;
    }
  }
  u32x4 kregA[6], vregA[4], kregB[6], vregB[4];
  const long tk0 = (long)b * SEQ_;
  auto load_tile = [&](int kt, u32x4 (&kreg)[6], u32x4 (&vreg)[4]) {
    const long tb = tk0 + kt * 64;
#pragma unroll
    for (int i = 0; i < 4; ++i) {
      const int pp = i * 256 + tid; const int key = pp >> 4, c = pp & 15;
      const u16* rowp = p.kv() + ((tb + key) * 8 + h) * 256 + c * 8;
      kreg[i] = *(const u32x4*)rowp;
      vreg[i] = *(const u32x4*)(rowp + 128);
    }
#pragma unroll
    for (int i = 0; i < 2; ++i) {
      const int pp = i * 256 + tid; const int key = pp >> 3, c = pp & 7;
      kreg[4 + i] = *(const u32x4*)(p.kpe() + (tb + key) * 64 + c * 8);
    }
  };
  auto store_tile = [&](int s, u32x4 (&kreg)[6], u32x4 (&vreg)[4]) {
    char* Ks = smem + s * AT_STAGE; char* Vs = Ks + AT_KBYTES;
#pragma unroll
    for (int i = 0; i < 4; ++i) {
      const int pp = i * 256 + tid; const int key = pp >> 4, c = pp & 15;
      *(u32x4*)(Ks + key * AT_KSTRIDE + c * 16) = kreg[i];
      *(u32x4*)(Vs + off_b(key, c)) = vreg[i];
    }
#pragma unroll
    for (int i = 0; i < 2; ++i) {
      const int pp = i * 256 + tid; const int key = pp >> 3, c = pp & 7;
      *(u32x4*)(Ks + key * AT_KSTRIDE + (16 + c) * 16) = kreg[4 + i];
    }
  };

  f32x16 o[4];
#pragma unroll
  for (int c = 0; c < 4; ++c)
#pragma unroll
    for (int r = 0; r < 16; ++r) o[c][r] = 0.f;
  float m = -1e30f, l = 0.f;
  const int nt = 2 * qb + 2;
  const int qpos = qb * 128 + wid * 32 + l31;

  __syncthreads();
  load_tile(0, kregA, vregA);
  store_tile(0, kregA, vregA);
  load_tile(1, kregB, vregB);
  if (nt > 2) load_tile(2, kregA, vregA);
  __syncthreads();
  auto tile_body = [&](int kt, int s) {
    const char* Ks = smem + s * AT_STAGE; const char* Vs = Ks + AT_KBYTES;
    const bool active = (kt * 64) <= (qb * 128 + wid * 32 + 31);
    if (active) {
      f32x16 sc[2];
#if ATT_ILV
#pragma unroll
      for (int kb = 0; kb < 2; ++kb)
#pragma unroll
        for (int r = 0; r < 16; ++r) sc[kb][r] = 0.f;
#pragma unroll
      for (int ks = 0; ks < 12; ++ks) {
#pragma unroll
        for (int kb = 0; kb < 2; ++kb) {
          bf16x8 a = *(const bf16x8*)(Ks + (kb * 32 + l31) * AT_KSTRIDE + (2 * ks + hh) * 16);
          sc[kb] = __builtin_amdgcn_mfma_f32_32x32x16_bf16(a, qf[ks], sc[kb], 0, 0, 0);
        }
      }
#else
#pragma unroll
      for (int kb = 0; kb < 2; ++kb) {
#pragma unroll
        for (int r = 0; r < 16; ++r) sc[kb][r] = 0.f;
#pragma unroll
        for (int ks = 0; ks < 12; ++ks) {
          bf16x8 a = *(const bf16x8*)(Ks + (kb * 32 + l31) * AT_KSTRIDE + (2 * ks + hh) * 16);
          sc[kb] = __builtin_amdgcn_mfma_f32_32x32x16_bf16(a, qf[ks], sc[kb], 0, 0, 0);
        }
      }
#endif
      if (kt >= 2 * qb) {
#pragma unroll
        for (int kb = 0; kb < 2; ++kb)
#pragma unroll
          for (int r = 0; r < 16; ++r) {
            const int key = kt * 64 + kb * 32 + (r & 3) + 8 * (r >> 2) + 4 * hh;
            if (key > qpos) sc[kb][r] = -1e30f;
          }
      }
      float mx = sc[0][0];
#pragma unroll
      for (int kb = 0; kb < 2; ++kb)
#pragma unroll
        for (int r = 0; r < 16; ++r) mx = fmaxf(mx, sc[kb][r]);
      mx = fmaxf(mx, shflx(mx, 32));
      const float mn = fmaxf(m, mx);
      const float alpha = __builtin_amdgcn_exp2f(m - mn);
      m = mn;
      float ps = 0.f;
      bf16x8 pf[4];
#pragma unroll
      for (int kb = 0; kb < 2; ++kb)
#pragma unroll
        for (int s2 = 0; s2 < 2; ++s2) {
          float e[8];
#pragma unroll
          for (int j = 0; j < 8; ++j) { e[j] = __builtin_amdgcn_exp2f(sc[kb][8 * s2 + j] - mn); ps += e[j]; }
          unsigned w0 = pack_bf16(e[0], e[1]), w1 = pack_bf16(e[2], e[3]), w2 = pack_bf16(e[4], e[5]), w3 = pack_bf16(e[6], e[7]);
          u32x4 w = {w0, w1, w2, w3};
          pf[kb * 2 + s2] = *(bf16x8*)&w;
        }
      l = l * alpha + ps;
#pragma unroll
      for (int c = 0; c < 4; ++c)
#pragma unroll
        for (int r = 0; r < 16; ++r) o[c][r] *= alpha;
#if ATT_ILV
#pragma unroll
      for (int kk = 0; kk < 4; ++kk)
#pragma unroll
        for (int c = 0; c < 4; ++c) {
          const unsigned rbase = 32 * (kk >> 1) + 16 * (kk & 1) + 4 * hh;
          bf16x8 a = tr_frag(Vs, lane, c, rbase, rbase + 8);
          o[c] = __builtin_amdgcn_mfma_f32_32x32x16_bf16(a, pf[kk], o[c], 0, 0, 0);
        }
#else
#pragma unroll
      for (int c = 0; c < 4; ++c)
#pragma unroll
        for (int kk = 0; kk < 4; ++kk) {
          const unsigned rbase = 32 * (kk >> 1) + 16 * (kk & 1) + 4 * hh;
          bf16x8 a = tr_frag(Vs, lane, c, rbase, rbase + 8);
          o[c] = __builtin_amdgcn_mfma_f32_32x32x16_bf16(a, pf[kk], o[c], 0, 0, 0);
        }
#endif
    }
  };
#if CVT_IN_ATTN
  f32x4 cv[16];
  bool cv_inflight = false;
  u8* cv_dst = nullptr;
  bool cv_emitted = false;
  int cv_par = 0;
  auto cv_issue = [&]() {
    if (ci < 64) {
      const CvtUnit c = cvt8_decode(p, blockIdx.x + 256 * ci);
      const float* src = c.src + (long)(wid * 16) * c.ldn + lane * 4;
#pragma unroll
      for (int j = 0; j < 16; ++j) { const float* ptr = src + (long)j * c.ldn; asm volatile("global_load_dwordx4 %0, %1, off nt" : "=a"(cv[j]) : "v"(ptr) : "memory"); }
      cv_dst = c.dst; cv_inflight = true; ++ci;
    } else cv_inflight = false;
  };
  auto cv_emit = [&]() {
    cv_emitted = cv_inflight;
    if (cv_inflight) {
      asm volatile("s_waitcnt vmcnt(0)" : "+a"(cv[0]), "+a"(cv[1]), "+a"(cv[2]), "+a"(cv[3]), "+a"(cv[4]), "+a"(cv[5]), "+a"(cv[6]), "+a"(cv[7]),
                   "+a"(cv[8]), "+a"(cv[9]), "+a"(cv[10]), "+a"(cv[11]), "+a"(cv[12]), "+a"(cv[13]), "+a"(cv[14]), "+a"(cv[15]) :: "memory");
      char* T = AT_CVT_T(cv_par);
#pragma unroll
      for (int cc = 0; cc < 4; ++cc) {
        u32x4 x4;
#pragma unroll
        for (int q = 0; q < 4; ++q) {
          int x = 0;
          x = __builtin_amdgcn_cvt_pk_fp8_f32(cv[4 * q][cc] * WSCALE_, cv[4 * q + 1][cc] * WSCALE_, x, false);
          x = __builtin_amdgcn_cvt_pk_fp8_f32(cv[4 * q + 2][cc] * WSCALE_, cv[4 * q + 3][cc] * WSCALE_, x, true);
          x4[q] = (unsigned)x;
        }
        *(u32x4*)(T + (lane * 4 + cc) * 64 + wid * 16) = x4;
      }
    }
  };
  u8* cv_dst_e = nullptr;
  auto cv_flush = [&]() {
    if (cv_emitted) {
      const char* T = AT_CVT_T(cv_par);
#pragma unroll
      for (int i = 0; i < 4; ++i) {
        const int n = (tid >> 2) + 64 * i, ch = tid & 3;
        __builtin_nontemporal_store(*(const u32x4*)(T + n * 64 + ch * 16), (u32x4*)(cv_dst_e + (long)(n >> 1) * 4096 + (n & 1) * 64 + ch * 16));
      }
      cv_par ^= 1;
    }
  };
#define CV_BEFORE_BAR() do { cv_emit(); cv_dst_e = cv_dst; cv_issue(); } while (0)
#define CV_AFTER_BAR()  do { cv_flush(); } while (0)
  cv_issue();
#else
#define CV_BEFORE_BAR() do {} while (0)
#define CV_AFTER_BAR()  do {} while (0)
#endif
  for (int kt = 0; kt < nt; kt += 2) {
    tile_body(kt, 0);
    CV_BEFORE_BAR();
    store_tile(1, kregB, vregB);
    if (kt + 3 < nt) load_tile(kt + 3, kregB, vregB);
    __syncthreads();
    CV_AFTER_BAR();
    tile_body(kt + 1, 1);
    CV_BEFORE_BAR();
    if (kt + 2 < nt) {
      store_tile(0, kregA, vregA);
      if (kt + 4 < nt) load_tile(kt + 4, kregA, vregA);
    }
    __syncthreads();
    CV_AFTER_BAR();
  }
#if CVT_IN_ATTN
  cv_emit(); cv_dst_e = cv_dst; cv_inflight = false;
  __syncthreads();
  cv_flush();
#endif
#undef CV_BEFORE_BAR
#undef CV_AFTER_BAR
  l = l + shflx(l, 32);
  const float inv = 1.0f / l;
  u16* op = p.omla() + tq * 1024 + h * 128 + 4 * hh;
#pragma unroll
  for (int c = 0; c < 4; ++c)
#pragma unroll
    for (int rg = 0; rg < 4; ++rg) {
      u32x2 w = {pack_bf16(o[c][4 * rg] * inv, o[c][4 * rg + 1] * inv), pack_bf16(o[c][4 * rg + 2] * inv, o[c][4 * rg + 3] * inv)};
      *(u32x2*)(op + 32 * c + 8 * rg) = w;
    }
}

#define G1_LDS_BYTES 49152
__device__ __forceinline__ void gla_g1_unit(const Params& p, char* smem, int u) {
  const int tid = opaque_tid(), lane = tid & 63, wid = tid >> 6, l31 = lane & 31, hh = lane >> 5;
  const int bh = u >> 6, n = u & 63, b = bh >> 2, h = bh & 3;
  const long t0 = (long)b * SEQ_ + n * 64;
  char* Ks = smem; char* Vs = smem + 16384;
  __syncthreads();
  {
    const int ch = tid & 15;
    const float* bl = p.bcum() + (t0 + 63) * 512 + h * 128 + ch * 8;
    f32x4 bl0 = *(const f32x4*)bl, bl1 = *(const f32x4*)(bl + 4);
    if (tid < 128) p.dec()[(long)u * 128 + tid] = __expf(p.bcum()[(t0 + 63) * 512 + h * 128 + tid]);
#pragma unroll
    for (int i = 0; i < 4; ++i) {
      const int tok = (i * 256 + tid) >> 4;
      u32x4 kw = *(const u32x4*)(p.proj() + (t0 + tok) * NC_ + C_GK + h * 128 + ch * 8);
      const float* bp = p.bcum() + (t0 + tok) * 512 + h * 128 + ch * 8;
      f32x4 b0 = *(const f32x4*)bp, b1 = *(const f32x4*)(bp + 4);
      u32x4 w;
      w[0] = pack_bf16(bf_lo(kw[0]) * __expf(bl0[0] - b0[0]), bf_hi(kw[0]) * __expf(bl0[1] - b0[1]));
      w[1] = pack_bf16(bf_lo(kw[1]) * __expf(bl0[2] - b0[2]), bf_hi(kw[1]) * __expf(bl0[3] - b0[3]));
      w[2] = pack_bf16(bf_lo(kw[2]) * __expf(bl1[0] - b1[0]), bf_hi(kw[2]) * __expf(bl1[1] - b1[1]));
      w[3] = pack_bf16(bf_lo(kw[3]) * __expf(bl1[2] - b1[2]), bf_hi(kw[3]) * __expf(bl1[3] - b1[3]));
      *(u32x4*)(Ks + off_b(tok, ch)) = w;
    }
#pragma unroll
    for (int i = 0; i < 8; ++i) {
      const int pp = i * 256 + tid; const int tok = pp >> 5, c32 = pp & 31;
      u32x4 vw = *(const u32x4*)(p.proj() + (t0 + tok) * NC_ + C_GV + h * 256 + c32 * 8);
      *(u32x4*)(Vs + (c32 >> 4) * 16384 + off_b(tok, c32 & 15)) = vw;
    }
  }
  __syncthreads();
  f32x16 acc[4][2];
#pragma unroll
  for (int mb = 0; mb < 4; ++mb)
#pragma unroll
    for (int nb = 0; nb < 2; ++nb)
#pragma unroll
      for (int r = 0; r < 16; ++r) acc[mb][nb][r] = 0.f;
  const char* Vimg = Vs + (wid >> 1) * 16384;
#pragma unroll
  for (int ks = 0; ks < 4; ++ks) {
    bf16x8 af[4], bfr[2];
    const unsigned r0 = 16 * ks + 8 * hh;
#pragma unroll
    for (int mb = 0; mb < 4; ++mb) af[mb] = tr_frag(Ks, lane, mb, r0, r0 + 4);
#pragma unroll
    for (int nb = 0; nb < 2; ++nb) bfr[nb] = tr_frag(Vimg, lane, 2 * (wid & 1) + nb, r0, r0 + 4);
#pragma unroll
    for (int mb = 0; mb < 4; ++mb)
#pragma unroll
      for (int nb = 0; nb < 2; ++nb) acc[mb][nb] = __builtin_amdgcn_mfma_f32_32x32x16_bf16(af[mb], bfr[nb], acc[mb][nb], 0, 0, 0);
  }
  __syncthreads();
  {
    char* st = smem + wid * 16384;
#pragma unroll
    for (int mb = 0; mb < 4; ++mb)
#pragma unroll
      for (int r = 0; r < 16; ++r) {
        const int dk = mb * 32 + (r & 3) + 8 * (r >> 2) + 4 * hh;
        *(u16*)(st + dk * 128 + l31 * 2) = f32_to_bf16(acc[mb][0][r]);
        *(u16*)(st + dk * 128 + (32 + l31) * 2) = f32_to_bf16(acc[mb][1][r]);
      }
    u16* gb = p.kvc() + (long)u * 32768 + wid * 64;
#pragma unroll 4
    for (int it = 0; it < 16; ++it) {
      const int dk = it * 8 + (lane >> 3), ch = lane & 7;
      *(u32x4*)(gb + dk * 256 + ch * 8) = *(const u32x4*)(st + dk * 128 + ch * 16);
    }
  }
}

__device__ __forceinline__ void gla_g2_unit(const Params& p, int u) {
  const int tid = opaque_tid();
  const int bh = u >> 5, part = u & 31;
  const int dk = part * 4 + (tid >> 6), dv = (tid & 63) * 4;
  float s0 = 0.f, s1 = 0.f, s2 = 0.f, s3 = 0.f;
  const long ebase = (long)dk * 256 + dv;
#pragma unroll 8
  for (int n = 0; n < 64; ++n) {
    const long un = (long)(bh * 64 + n);
    u32x2 kw = *(const u32x2*)(p.kvc() + un * 32768 + ebase);
    const float d = p.dec()[un * 128 + dk];
    u32x2 w = {pack_bf16(s0, s1), pack_bf16(s2, s3)};
    *(u32x2*)(p.sprev() + un * 32768 + ebase) = w;
    s0 = fmaf(d, s0, bf_lo(kw[0])); s1 = fmaf(d, s1, bf_hi(kw[0]));
    s2 = fmaf(d, s2, bf_lo(kw[1])); s3 = fmaf(d, s3, bf_hi(kw[1]));
  }
}

#define G3_LDS_BYTES (16384 + 16384 + 32768 + 65536 + 1024)
__device__ __forceinline__ void gla_g3_unit(const Params& p, char* smem, int u) {
  const int tid = opaque_tid(), lane = tid & 63, wid = tid >> 6, l31 = lane & 31, hh = lane >> 5;
  const int bh = u >> 6, n = u & 63, b = bh >> 2, h = bh & 3;
  const long t0 = (long)b * SEQ_ + n * 64;
  char* Qd = smem; char* Ki = smem + 16384; char* Vs = smem + 32768; char* Sp = smem + 65536; float* red = (float*)(smem + 131072);
  __syncthreads();
  {
    const int ch = tid & 15;
    const float qs = 0.08838834764831845f;
#pragma unroll
    for (int i = 0; i < 4; ++i) {
      const int tok = (i * 256 + tid) >> 4;
      const u16* pr = p.proj() + (t0 + tok) * NC_ + h * 128 + ch * 8;
      u32x4 qw = *(const u32x4*)(pr + C_GQ), kw = *(const u32x4*)(pr + C_GK);
      const float* bp = p.bcum() + (t0 + tok) * 512 + h * 128 + ch * 8;
      f32x4 b0 = *(const f32x4*)bp, b1 = *(const f32x4*)(bp + 4);
      float e[8] = {__expf(b0[0]), __expf(b0[1]), __expf(b0[2]), __expf(b0[3]), __expf(b1[0]), __expf(b1[1]), __expf(b1[2]), __expf(b1[3])};
      u32x4 wq, wk;
#pragma unroll
      for (int k = 0; k < 4; ++k) {
        wq[k] = pack_bf16(bf_lo(qw[k]) * qs * e[2 * k], bf_hi(qw[k]) * qs * e[2 * k + 1]);
        wk[k] = pack_bf16(bf_lo(kw[k]) * __builtin_amdgcn_rcpf(e[2 * k]), bf_hi(kw[k]) * __builtin_amdgcn_rcpf(e[2 * k + 1]));
      }
      *(u32x4*)(Qd + off_b(tok, ch)) = wq;
      *(u32x4*)(Ki + off_b(tok, ch)) = wk;
    }
#pragma unroll
    for (int i = 0; i < 8; ++i) {
      const int pp = i * 256 + tid; const int tok = pp >> 5, c32 = pp & 31;
      u32x4 vw = *(const u32x4*)(p.proj() + (t0 + tok) * NC_ + C_GV + h * 256 + c32 * 8);
      *(u32x4*)(Vs + (c32 >> 4) * 16384 + off_b(tok, c32 & 15)) = vw;
    }
#pragma unroll
    for (int i = 0; i < 16; ++i) {
      const int pp = i * 256 + tid; const int dk = pp >> 5, c32 = pp & 31;
      u32x4 sw = *(const u32x4*)(p.sprev() + (long)u * 32768 + dk * 256 + c32 * 8);
      *(u32x4*)(Sp + (c32 >> 4) * 32768 + off_b(dk, c32 & 15)) = sw;
    }
  }
  __syncthreads();
  const int ib = wid & 1, dvh = wid >> 1;
  f32x16 sc[2];
#pragma unroll
  for (int jb = 0; jb < 2; ++jb) {
#pragma unroll
    for (int r = 0; r < 16; ++r) sc[jb][r] = 0.f;
    if (jb <= ib) {
#pragma unroll
      for (int ks = 0; ks < 8; ++ks) {
        bf16x8 a = *(const bf16x8*)(Ki + off_b(jb * 32 + l31, 2 * ks + hh));
        bf16x8 bq = *(const bf16x8*)(Qd + off_b(ib * 32 + l31, 2 * ks + hh));
        sc[jb] = __builtin_amdgcn_mfma_f32_32x32x16_bf16(a, bq, sc[jb], 0, 0, 0);
      }
#pragma unroll
      for (int r = 0; r < 16; ++r) {
        const int j = jb * 32 + (r & 3) + 8 * (r >> 2) + 4 * hh, i = ib * 32 + l31;
        if (j > i) sc[jb][r] = 0.f;
      }
    }
  }
  bf16x8 pf[4];
#pragma unroll
  for (int jb = 0; jb < 2; ++jb)
#pragma unroll
    for (int s2 = 0; s2 < 2; ++s2) {
      u32x4 w = {pack_bf16(sc[jb][8 * s2 + 0], sc[jb][8 * s2 + 1]), pack_bf16(sc[jb][8 * s2 + 2], sc[jb][8 * s2 + 3]),
                 pack_bf16(sc[jb][8 * s2 + 4], sc[jb][8 * s2 + 5]), pack_bf16(sc[jb][8 * s2 + 6], sc[jb][8 * s2 + 7])};
      pf[jb * 2 + s2] = *(bf16x8*)&w;
    }
  f32x16 o[4];
#pragma unroll
  for (int c = 0; c < 4; ++c)
#pragma unroll
    for (int r = 0; r < 16; ++r) o[c][r] = 0.f;
  const char* Vimg = Vs + dvh * 16384;
  const char* Simg = Sp + dvh * 32768;
#pragma unroll
  for (int c = 0; c < 4; ++c) {
#pragma unroll
    for (int kk = 0; kk < 4; ++kk) {
      if ((kk >> 1) <= ib) {
        const unsigned rbase = 32 * (kk >> 1) + 16 * (kk & 1) + 4 * hh;
        bf16x8 a = tr_frag(Vimg, lane, c, rbase, rbase + 8);
        o[c] = __builtin_amdgcn_mfma_f32_32x32x16_bf16(a, pf[kk], o[c], 0, 0, 0);
      }
    }
#pragma unroll
    for (int ks = 0; ks < 8; ++ks) {
      const unsigned r0 = 16 * ks + 8 * hh;
      bf16x8 a = tr_frag(Simg, lane, c, r0, r0 + 4);
      bf16x8 bq = *(const bf16x8*)(Qd + off_b(ib * 32 + l31, 2 * ks + hh));
      o[c] = __builtin_amdgcn_mfma_f32_32x32x16_bf16(a, bq, o[c], 0, 0, 0);
    }
  }
  float ss = 0.f;
#pragma unroll
  for (int c = 0; c < 4; ++c)
#pragma unroll
    for (int r = 0; r < 16; ++r) ss += o[c][r] * o[c][r];
  ss += shflx(ss, 32);
  if (hh == 0) red[dvh * 64 + ib * 32 + l31] = ss;
  __syncthreads();
  const float tot = red[ib * 32 + l31] + red[64 + ib * 32 + l31];
  const float rn = rsqrtf(tot * (1.0f / 256.0f) + EPS_);
  const long t = t0 + ib * 32 + l31;
  const u16* grp = p.proj() + t * NC_ + C_GR + h * 256 + dvh * 128 + 4 * hh;
  u16* op = p.mix() + t * 2048 + h * 256 + dvh * 128 + 4 * hh;
  const float* gp = p.gla_out_norm + dvh * 128 + 4 * hh;
#pragma unroll
  for (int c = 0; c < 4; ++c)
#pragma unroll
    for (int rg = 0; rg < 4; ++rg) {
      u32x2 gw = *(const u32x2*)(grp + 32 * c + 8 * rg);
      f32x4 g = *(const f32x4*)(gp + 32 * c + 8 * rg);
      float gr[4] = {bf_lo(gw[0]), bf_hi(gw[0]), bf_lo(gw[1]), bf_hi(gw[1])};
      float ov[4];
#pragma unroll
      for (int k = 0; k < 4; ++k) { float si = gr[k] * __builtin_amdgcn_rcpf(1.0f + __expf(-gr[k])); ov[k] = o[c][4 * rg + k] * rn * g[k] * si; }
#if WOUTQ
      {
        int q8 = 0;
        q8 = __builtin_amdgcn_cvt_pk_fp8_f32(ov[0], ov[1], q8, false);
        q8 = __builtin_amdgcn_cvt_pk_fp8_f32(ov[2], ov[3], q8, true);
        const int col = h * 256 + dvh * 128 + 4 * hh + 32 * c + 8 * rg;
        *(unsigned*)(p.mixq() + (t >> 1) * 4096 + (col >> 6) * 128 + (t & 1) * 64 + (col & 63)) = (unsigned)q8;
      }
#else
      u32x2 w = {pack_bf16(ov[0], ov[1]), pack_bf16(ov[2], ov[3])};
      *(u32x2*)(op + 32 * c + 8 * rg) = w;
#endif
    }
}

__device__ __forceinline__ void mla_norm_tokens(const Params& p) {
  const int tid_ = opaque_tid(); const int lane = tid_ & 63, wid = tid_ >> 6;
#if P10PF
  u32x4 na_, nb_;
  { const u16* s0 = p.omla() + (long)(blockIdx.x * 4 + wid) * 1024; na_ = *(const u32x4*)(s0 + lane * 8); nb_ = *(const u32x4*)(s0 + 512 + lane * 8); }
#endif
  for (int t = blockIdx.x * 4 + wid; t < T_; t += gridDim.x * 4) {
    const u16* src = p.omla() + (long)t * 1024;
#if P10PF
    u32x4 a = na_, b = nb_;
    { const int tn = (t + gridDim.x * 4 < T_) ? t + gridDim.x * 4 : t; const u16* sn = p.omla() + (long)tn * 1024; na_ = *(const u32x4*)(sn + lane * 8); nb_ = *(const u32x4*)(sn + 512 + lane * 8); }
#else
    u32x4 a = *(const u32x4*)(src + lane * 8), b = *(const u32x4*)(src + 512 + lane * 8);
#endif
    float ss = 0.f;
#pragma unroll
    for (int k = 0; k < 4; ++k) { float x0 = bf_lo(a[k]), x1 = bf_hi(a[k]), y0 = bf_lo(b[k]), y1 = bf_hi(b[k]); ss += x0 * x0 + x1 * x1 + y0 * y0 + y1 * y1; }
    ss = wave_sum(ss);
    const float r = rsqrtf(ss * (1.0f / 1024.0f) + EPS_);
    const float* g = p.mla_out_norm;
    u32x4 wa, wb;
#pragma unroll
    for (int k = 0; k < 4; ++k) {
      wa[k] = pack_bf16(bf_lo(a[k]) * r * g[lane * 8 + 2 * k], bf_hi(a[k]) * r * g[lane * 8 + 2 * k + 1]);
      wb[k] = pack_bf16(bf_lo(b[k]) * r * g[512 + lane * 8 + 2 * k], bf_hi(b[k]) * r * g[512 + lane * 8 + 2 * k + 1]);
    }
#if WOUTQ
    {
      int qa0 = 0, qa1 = 0, qb0 = 0, qb1 = 0;
      qa0 = __builtin_amdgcn_cvt_pk_fp8_f32(bf_lo(wa[0]), bf_hi(wa[0]), qa0, false); qa0 = __builtin_amdgcn_cvt_pk_fp8_f32(bf_lo(wa[1]), bf_hi(wa[1]), qa0, true);
      qa1 = __builtin_amdgcn_cvt_pk_fp8_f32(bf_lo(wa[2]), bf_hi(wa[2]), qa1, false); qa1 = __builtin_amdgcn_cvt_pk_fp8_f32(bf_lo(wa[3]), bf_hi(wa[3]), qa1, true);
      qb0 = __builtin_amdgcn_cvt_pk_fp8_f32(bf_lo(wb[0]), bf_hi(wb[0]), qb0, false); qb0 = __builtin_amdgcn_cvt_pk_fp8_f32(bf_lo(wb[1]), bf_hi(wb[1]), qb0, true);
      qb1 = __builtin_amdgcn_cvt_pk_fp8_f32(bf_lo(wb[2]), bf_hi(wb[2]), qb1, false); qb1 = __builtin_amdgcn_cvt_pk_fp8_f32(bf_lo(wb[3]), bf_hi(wb[3]), qb1, true);
      const int ca = 1024 + lane * 8, cb = 1536 + lane * 8;
      const long tt = t;
      u32x2 va = {(unsigned)qa0, (unsigned)qa1}, vb = {(unsigned)qb0, (unsigned)qb1};
      *(u32x2*)(p.mixq() + (tt >> 1) * 4096 + (ca >> 6) * 128 + (tt & 1) * 64 + (ca & 63)) = va;
      *(u32x2*)(p.mixq() + (tt >> 1) * 4096 + (cb >> 6) * 128 + (tt & 1) * 64 + (cb & 63)) = vb;
    }
#else
    *(u32x4*)(p.mix() + (long)t * 2048 + 1024 + lane * 8) = wa;
    *(u32x4*)(p.mix() + (long)t * 2048 + 1024 + 512 + lane * 8) = wb;
#endif
  }
}
__device__ __forceinline__ void wout_tile(const Params& p, char* smem, int mt, int nt) {
  f32x16 acc[4][4];
  GemmTile t{};
  t.A = p.mix(); t.lda = 2048; t.aidx = nullptr; t.m0 = mt * 256; t.mvalid = 256;
  t.B0 = p.w_out + nt * 256; t.B1 = t.B0 + 128; t.ldb = 2048; t.nv0 = 128; t.nv1 = 128; t.kscale = nullptr; t.K = 2048;
  gemm_tile_256<4, false, false>(t, smem, acc);
  const long boff = (long)(mt * 256) * 2048 + nt * 256;
  acc_foreach_row<4>(acc, [&](int rowl, int coll, float (&v)[4]) {
    long o = boff + (long)rowl * 2048 + coll;
    OPAQUE(o);
    const float* xr = p.x + o; float* yr = p.x1() + o;
#pragma unroll
    for (int nb = 0; nb < 4; ++nb) { const int c = (nb >> 1) * 128 + (nb & 1) * 32; yr[c] = xr[c] + v[nb]; }
  });
}

#define P7_LDS_BYTES (4 * 32 * 33 * 4 + 4 * 64 * 4 + 32 * 33 * 4 + 128)
template <int DRY = 0>
__device__ __forceinline__ void ffn_prep_unit(const Params& p, char* smem, int u) {
  float* part = (float*)smem; float* ssq = part + 4 * 32 * 33; float* lg = ssq + 256; float* rs = lg + 32 * 33;
  const int tid = opaque_tid(), lane = tid & 63, wid = tid >> 6, l31 = lane & 31, hh = lane >> 5;
  __syncthreads();
  {
    const long t = (long)u * 32 + l31;
    const float* xr = p.x1() + t * 2048 + wid * 512;
    const float* gp = p.ffn_norm + wid * 512;
    const float* wp = p.router_w + (long)(wid * 512 + hh) * 32 + l31;
    f32x16 acc;
#pragma unroll
    for (int r = 0; r < 16; ++r) acc[r] = 0.f;
    float ss = 0.f;
#pragma unroll 4
    for (int m = 0; m < 128; ++m) {
      const f32x4 xv = *(const f32x4*)(xr + 4 * m);
      const f32x4 gv = *(const f32x4*)(gp + 4 * m);
      const float a0 = hh ? xv[1] : xv[0], a1 = hh ? xv[3] : xv[2];
      const float g0 = hh ? gv[1] : gv[0], g1 = hh ? gv[3] : gv[2];
      const float b0 = wp[(4 * m) * 32], b1 = wp[(4 * m + 2) * 32];
      ss += a0 * a0 + a1 * a1;
      acc = __builtin_amdgcn_mfma_f32_32x32x2f32(a0 * g0, b0, acc, 0, 0, 0);
      acc = __builtin_amdgcn_mfma_f32_32x32x2f32(a1 * g1, b1, acc, 0, 0, 0);
    }
#pragma unroll
    for (int r = 0; r < 16; ++r) part[(wid * 32 + (r & 3) + 8 * (r >> 2) + 4 * hh) * 33 + l31] = acc[r];
    ssq[wid * 64 + lane] = ss;
  }
  __syncthreads();
  {
    const int tl = tid >> 3, seg = tid & 7;
    if (seg == 0) {
      float s = 0.f;
#pragma unroll
      for (int w = 0; w < 4; ++w) s += ssq[w * 64 + tl] + ssq[w * 64 + 32 + tl];
      rs[tl] = rsqrtf(s * (1.0f / 2048.0f) + EPS_);
    }
  }
  __syncthreads();
  {
    const int tl = tid >> 3, seg = tid & 7;
    const float r = rs[tl];
#pragma unroll
    for (int c = 0; c < 4; ++c) {
      const int e = seg * 4 + c;
      const float s = part[(0 * 32 + tl) * 33 + e] + part[(1 * 32 + tl) * 33 + e] + part[(2 * 32 + tl) * 33 + e] + part[(3 * 32 + tl) * 33 + e];
      lg[tl * 33 + e] = s * r + p.router_b[e];
    }
  }
  __syncthreads();
  if (tid < 32 && !DRY) {
    const long tt = (long)u * 32 + tid;
    const float* L = lg + tid * 33;
    unsigned used = 0u; int i0 = 0, i1 = 0, i2 = 0, i3 = 0; float v0 = 0.f, v1 = 0.f, v2 = 0.f, v3 = 0.f;
#pragma unroll
    for (int k = 0; k < 4; ++k) {
      int bi = -1; float bv = 0.f;
      for (int i = 0; i < 32; ++i) {
        const float x = L[i];
        const bool take = !((used >> i) & 1u) && (bi < 0 || x > bv);
        bi = take ? i : bi; bv = take ? x : bv;
      }
      used |= 1u << bi;
      if (k == 0) { i0 = bi; v0 = bv; } else if (k == 1) { i1 = bi; v1 = bv; } else if (k == 2) { i2 = bi; v2 = bv; } else { i3 = bi; v3 = bv; }
    }
    const float e0 = 1.0f, e1 = __expf(v1 - v0), e2 = __expf(v2 - v0), e3 = __expf(v3 - v0);
    const float inv = 1.0f / (e0 + e1 + e2 + e3);
    const int s0 = atomicAdd(&p.counts()[i0], 1), s1 = atomicAdd(&p.counts()[i1], 1), s2 = atomicAdd(&p.counts()[i2], 1), s3 = atomicAdd(&p.counts()[i3], 1);
    p.list()[i0 * T_ + s0] = (int)tt; p.list()[i1 * T_ + s1] = (int)tt; p.list()[i2 * T_ + s2] = (int)tt; p.list()[i3 * T_ + s3] = (int)tt;
    p.asg_e()[tt * 4 + 0] = i0; p.asg_e()[tt * 4 + 1] = i1; p.asg_e()[tt * 4 + 2] = i2; p.asg_e()[tt * 4 + 3] = i3;
    p.asg_slot()[tt * 4 + 0] = s0; p.asg_slot()[tt * 4 + 1] = s1; p.asg_slot()[tt * 4 + 2] = s2; p.asg_slot()[tt * 4 + 3] = s3;
    p.asg_g()[tt * 4 + 0] = e0 * inv; p.asg_g()[tt * 4 + 1] = e1 * inv; p.asg_g()[tt * 4 + 2] = e2 * inv; p.asg_g()[tt * 4 + 3] = e3 * inv;
  }
  {
    const int tl = tid >> 3, seg = tid & 7;
    const long t = (long)u * 32 + tl;
    const float* xr = p.x1() + t * 2048;
    const float rr = rs[tl];
#pragma unroll 8
    for (int it = 0; it < 32; ++it) {
      const int kk = it * 64 + seg * 8;
      f32x4 v0 = *(const f32x4*)(xr + kk), v1 = *(const f32x4*)(xr + kk + 4);
      f32x4 g0 = *(const f32x4*)(p.ffn_norm + kk), g1 = *(const f32x4*)(p.ffn_norm + kk + 4);
      v0 = v0 * g0 * rr; v1 = v1 * g1 * rr;
#if MOEQ == 0
      u32x4 w = {pack_bf16(v0[0], v0[1]), pack_bf16(v0[2], v0[3]), pack_bf16(v1[0], v1[1]), pack_bf16(v1[2], v1[3])};
      *(u32x4*)(p.h2() + t * 2048 + kk) = w;
#else
      int q0 = 0, q1 = 0;
      q0 = __builtin_amdgcn_cvt_pk_fp8_f32(v0[0], v0[1], q0, false);
      q0 = __builtin_amdgcn_cvt_pk_fp8_f32(v0[2], v0[3], q0, true);
      q1 = __builtin_amdgcn_cvt_pk_fp8_f32(v1[0], v1[1], q1, false);
      q1 = __builtin_amdgcn_cvt_pk_fp8_f32(v1[2], v1[3], q1, true);
      u32x2 wq = {(unsigned)q0, (unsigned)q1};
      *(u32x2*)(p.h2q() + t * 2048 + kk) = wq;
#endif
    }
  }
}

__device__ __forceinline__ void moe_setup(const Params& p, int* mo) {
  __syncthreads();
  if (threadIdx.x == 0) {
    int s = 0;
    for (int e = 0; e < NE_; ++e) { const int c = p.counts()[e]; mo[e] = s; mo[40 + e] = c; s += (c + 255) >> 8; }
    mo[NE_] = s;
  }
  __syncthreads();
}
#ifndef MAPV
#define MAPV 0
#endif
__device__ __forceinline__ int xcd_unit(int round) { return MAPV ? (round * 256 + blockIdx.x) : (round * 256 + (blockIdx.x & 7) * 32 + (blockIdx.x >> 3)); }

__device__ __forceinline__ void moe1_tile(const Params& p, char* smem, const int* mo, int e, int nt, int mt) {
  f32x16 acc[4][4];
  GemmTile t{};
  const int cnt = p.counts()[e];
  t.A = p.h2(); t.lda = 2048; t.aidx = p.list() + e * T_ + mt * 256; t.m0 = 0; t.mvalid = min(256, cnt - mt * 256);
  t.B0 = p.w_gu + (long)e * 2048 * 4096 + nt * 128; t.B1 = t.B0 + 2048; t.ldb = 4096; t.nv0 = 128; t.nv1 = 128; t.kscale = nullptr; t.K = 2048;
  gemm_tile_256<4, false, true>(t, smem, acc);
  u16* base = p.act() + (long)(mo[e] * 256 + mt * 256) * 2048 + nt * 128;
  const float* bg = p.b_gu + e * 4096 + nt * 128; const float* bu = bg + 2048;
  const int tq_ = opaque_tid(); const int cl = (tq_ >> 6 & 1) * 64 + (tq_ & 31);
  const float bgv[2] = {bg[cl], bg[cl + 32]}, buv[2] = {bu[cl], bu[cl + 32]};
  acc_foreach_row<4>(acc, [&](int rowl, int coll, float (&v)[4]) {
    u16* rp = base + (long)rowl * 2048 + coll;
    OPAQUE(rp);
#pragma unroll
    for (int nb = 0; nb < 2; ++nb) {
      const int c = nb * 32;
      float g = fminf(v[nb] + bgv[nb], 7.0f);
      float uu = fminf(fmaxf(v[nb + 2] + buv[nb], -7.0f), 7.0f);
      float a = (uu + 1.0f) * (g * __builtin_amdgcn_rcpf(1.0f + __expf(-1.702f * g)));
      rp[c] = f32_to_bf16(a);
    }
  });
}
__device__ __forceinline__ void moe2_tile(const Params& p, char* smem, const int* mo, int e, int nt, int mt) {
  f32x16 acc[4][4];
  GemmTile t{};
  t.A = p.act(); t.lda = 2048; t.aidx = nullptr; t.m0 = mo[e] * 256 + mt * 256; t.mvalid = 256;
  t.B0 = p.w_dn + (long)e * 2048 * 2048 + nt * 256; t.B1 = t.B0 + 128; t.ldb = 2048; t.nv0 = 128; t.nv1 = 128; t.kscale = nullptr; t.K = 2048;
  gemm_tile_256<4, false, false>(t, smem, acc);
  u16* base = p.ybuf() + (long)t.m0 * 2048 + nt * 256;
  const float* bd = p.b_dn + e * 2048 + nt * 256;
  const int tq_ = opaque_tid(); const int cl = (tq_ >> 6 & 1) * 64 + (tq_ & 31);
  const float bdv[4] = {bd[cl], bd[cl + 32], bd[cl + 128], bd[cl + 160]};
  acc_foreach_row<4>(acc, [&](int rowl, int coll, float (&v)[4]) {
    u16* rp = base + (long)rowl * 2048 + coll;
    OPAQUE(rp);
#pragma unroll
    for (int nb = 0; nb < 4; ++nb) { const int c = (nb >> 1) * 128 + (nb & 1) * 32; rp[c] = f32_to_bf16(v[nb] + bdv[nb]); }
  });
}
template <int WHICH, int HALF = 0>
__device__ __forceinline__ void ph_moe(const Params& p, char* smem) {
  int* mo = (int*)(smem + G_LDS_BYTES);
  moe_setup(p, mo);
  const int NT = (WHICH == 1) ? 16 : 8;
  const int total = mo[NE_] * NT;
  if (HALF && ((blockIdx.x >> 3) & 1)) return;
  const int W = HALF ? 128 : 256;
  for (int round = 0;; ++round) {
    const int u = HALF ? (round * 128 + (blockIdx.x & 7) * 16 + (blockIdx.x >> 4)) : xcd_unit(round);
    if (round * W >= total) break;
    if (u >= total) continue;
    int e = 0;
    while (mo[e + 1] * NT <= u) ++e;
    const int local = u - mo[e] * NT, me = mo[e + 1] - mo[e];
    const int nt = local / me, mt = local - nt * me;
    if (WHICH == 1) moe1_tile(p, smem, mo, e, nt, mt); else moe2_tile(p, smem, mo, e, nt, mt);
  }
}

__device__ __forceinline__ void ph_final(const Params& p, char* smem, float dbg_scale = 1.0f) {
  int* mo = (int*)(smem + G_LDS_BYTES);
  moe_setup(p, mo);
  const int tid_ = opaque_tid(); const int lane = tid_ & 63, wid = tid_ >> 6;
#if P10PF
  int ne_[4], ns_[4]; float ng_[4];
  {
    const int t0 = blockIdx.x * 4 + wid;
#pragma unroll
    for (int k = 0; k < 4; ++k) { ne_[k] = p.asg_e()[t0 * 4 + k]; ns_[k] = p.asg_slot()[t0 * 4 + k]; ng_[k] = p.asg_g()[t0 * 4 + k]; }
  }
#endif
  for (int t = blockIdx.x * 4 + wid; t < T_; t += gridDim.x * 4) {
    long rows[4]; float gg[4];
#if P10PF
#pragma unroll
    for (int k = 0; k < 4; ++k) { rows[k] = (long)(mo[ne_[k]] * 256 + ns_[k]) * 2048; gg[k] = ng_[k]; }
    {
      const int tn = (t + gridDim.x * 4 < T_) ? t + gridDim.x * 4 : t;
#pragma unroll
      for (int k = 0; k < 4; ++k) { ne_[k] = p.asg_e()[tn * 4 + k]; ns_[k] = p.asg_slot()[tn * 4 + k]; ng_[k] = p.asg_g()[tn * 4 + k]; }
    }
#else
#pragma unroll
    for (int k = 0; k < 4; ++k) { rows[k] = (long)(mo[p.asg_e()[t * 4 + k]] * 256 + p.asg_slot()[t * 4 + k]) * 2048; gg[k] = p.asg_g()[t * 4 + k]; }
#endif
    f32x4 v[8]; float ss = 0.f;
#pragma unroll
    for (int j = 0; j < 8; ++j) {
      const int c = j * 256 + lane * 4;
      f32x4 a = __builtin_nontemporal_load((const f32x4*)(p.x1() + (long)t * 2048 + c));
#pragma unroll
      for (int k = 0; k < 4; ++k) {
        u32x2 w = __builtin_nontemporal_load((const u32x2*)(p.ybuf() + rows[k] + c));
        a[0] += gg[k] * bf_lo(w[0]); a[1] += gg[k] * bf_hi(w[0]); a[2] += gg[k] * bf_lo(w[1]); a[3] += gg[k] * bf_hi(w[1]);
      }
      v[j] = a; ss += a[0] * a[0] + a[1] * a[1] + a[2] * a[2] + a[3] * a[3];
    }
    ss = wave_sum(ss);
    const float r = rsqrtf(ss * (1.0f / 2048.0f) + EPS_);
#pragma unroll
    for (int j = 0; j < 8; ++j) {
      const int c = j * 256 + lane * 4;
      f32x4 g = *(const f32x4*)(p.final_norm + c);
      f32x4 o = {v[j][0] * r * g[0] * dbg_scale, v[j][1] * r * g[1] * dbg_scale, v[j][2] * r * g[2] * dbg_scale, v[j][3] * r * g[3] * dbg_scale};
      __builtin_nontemporal_store(o, (f32x4*)(p.out + (long)t * 2048 + c));
    }
  }
}

__device__ __forceinline__ CvtUnit cvt8_decode(const Params& p, int u) {
  CvtUnit c;
  if (u < 16384) {
    const int e = u >> 9, kb = (u >> 4) & 31, nt = u & 15;
    c.src = p.w_gu + (long)e * 2048 * 4096 + (long)(kb * 64) * 4096 + nt * 256; c.ldn = 4096;
    c.dst = p.wq_gu() + ((long)e * 4096 + nt * 256) * 2048 + kb * 128;
  } else {
    const int v = u - 16384; const int e = v >> 8, kb = (v >> 3) & 31, nt = v & 7;
    c.src = p.w_dn + (long)e * 2048 * 2048 + (long)(kb * 64) * 2048 + nt * 256; c.ldn = 2048;
    c.dst = p.wq_dn() + ((long)e * 2048 + nt * 256) * 2048 + kb * 128;
  }
  return c;
}
__device__ __forceinline__ void cvt8_load(const CvtUnit& c, int w, int lane, f32x4 (&v)[16]) {
  const float* src = c.src + (long)(w * 16) * c.ldn + lane * 4;
#pragma unroll
  for (int j = 0; j < 16; ++j) {
    const float* ptr = src + (long)j * c.ldn;
    asm volatile("global_load_dwordx4 %0, %1, off nt" : "=v"(v[j]) : "v"(ptr) : "memory");
  }
}
#define CVT_WAIT(N, v) asm volatile("s_waitcnt vmcnt(%16)" : "+v"(v[0]), "+v"(v[1]), "+v"(v[2]), "+v"(v[3]), "+v"(v[4]), "+v"(v[5]), "+v"(v[6]), "+v"(v[7]), \
    "+v"(v[8]), "+v"(v[9]), "+v"(v[10]), "+v"(v[11]), "+v"(v[12]), "+v"(v[13]), "+v"(v[14]), "+v"(v[15]) : "n"(N) : "memory")
__device__ __forceinline__ void cvt8_emit(const CvtUnit& c, int tid, int w, int lane, f32x4 (&v)[16], char* T) {
  __syncthreads();
#pragma unroll
  for (int cc = 0; cc < 4; ++cc) {
    u32x4 x4;
#pragma unroll
    for (int q = 0; q < 4; ++q) {
      int x = 0;
      x = __builtin_amdgcn_cvt_pk_fp8_f32(v[4 * q][cc] * WSCALE_, v[4 * q + 1][cc] * WSCALE_, x, false);
      x = __builtin_amdgcn_cvt_pk_fp8_f32(v[4 * q + 2][cc] * WSCALE_, v[4 * q + 3][cc] * WSCALE_, x, true);
      x4[q] = (unsigned)x;
    }
#if CVTSW
    *(u32x4*)(T + cc * 4096 + w * 1024 + ((lane + 4 * w + 2 * cc) & 63) * 16) = x4;
#else
    *(u32x4*)(T + (lane * 4 + cc) * 64 + w * 16) = x4;
#endif
  }
  __syncthreads();
#pragma unroll
  for (int i = 0; i < 4; ++i) {
    const int n = (tid >> 2) + 64 * i, ch = tid & 3;
#if CVTSW
    __builtin_nontemporal_store(*(const u32x4*)(T + (n & 3) * 4096 + ch * 1024 + (((n >> 2) + 4 * ch + 2 * (n & 3)) & 63) * 16), (u32x4*)(c.dst + (long)(n >> 1) * 4096 + (n & 1) * 64 + ch * 16));
#else
    __builtin_nontemporal_store(*(const u32x4*)(T + n * 64 + ch * 16), (u32x4*)(c.dst + (long)(n >> 1) * 4096 + (n & 1) * 64 + ch * 16));
#endif
  }
}
__device__ __forceinline__ void convert_units(const Params& p, char* smem, int first, int stride, int count) {
  const int tid = opaque_tid();
  const int w = tid >> 6, lane = tid & 63;
  if (count <= 0) return;
  f32x4 va[16], vb[16], vc[16];
  CvtUnit ca = cvt8_decode(p, first), cb = cvt8_decode(p, first + stride), cc = cvt8_decode(p, first + 2 * stride);
  cvt8_load(ca, w, lane, va);
  cvt8_load(cb, w, lane, vb);
  cvt8_load(cc, w, lane, vc);
  CVT_WAIT(32, va); cvt8_emit(ca, tid, w, lane, va, smem); ca = cvt8_decode(p, first + 3 * stride); cvt8_load(ca, w, lane, va);
  CVT_WAIT(36, vb); cvt8_emit(cb, tid, w, lane, vb, smem); cb = cvt8_decode(p, first + 4 * stride); cvt8_load(cb, w, lane, vb);
  CVT_WAIT(40, vc); cvt8_emit(cc, tid, w, lane, vc, smem); cc = cvt8_decode(p, first + 5 * stride); cvt8_load(cc, w, lane, vc);
  for (int i = 3; i + 3 < count; i += 3) {
    CVT_WAIT(40, va); cvt8_emit(ca, tid, w, lane, va, smem); ca = cvt8_decode(p, first + (i + 3) * stride); cvt8_load(ca, w, lane, va);
    CVT_WAIT(40, vb); cvt8_emit(cb, tid, w, lane, vb, smem); cb = cvt8_decode(p, first + (i + 4) * stride); cvt8_load(cb, w, lane, vb);
    CVT_WAIT(40, vc); cvt8_emit(cc, tid, w, lane, vc, smem); cc = cvt8_decode(p, first + (i + 5) * stride); cvt8_load(cc, w, lane, vc);
  }
  CVT_WAIT(0, va); cvt8_emit(ca, tid, w, lane, va, smem);
  CVT_WAIT(0, vb); cvt8_emit(cb, tid, w, lane, vb, smem);
  CVT_WAIT(0, vc); cvt8_emit(cc, tid, w, lane, vc, smem);
}
__device__ __forceinline__ void convert_one(const Params& p, char* smem, int u) {
  const int tid = opaque_tid();
  const int w = tid >> 6, lane = tid & 63;
  f32x4 va[16];
  CvtUnit ca = cvt8_decode(p, u);
  cvt8_load(ca, w, lane, va);
  CVT_WAIT(0, va); cvt8_emit(ca, tid, w, lane, va, smem);
}
__device__ __forceinline__ void ph_convert(const Params& p, char* smem) {
  convert_units(p, smem, blockIdx.x, gridDim.x, 24576 / 256);
}
__device__ __forceinline__ void ph_convert_gu(const Params& p, char* smem, int part, int nparts) {
  if (nparts == 1) {
    convert_units(p, smem, blockIdx.x, 256, 63);
    convert_one(p, smem, blockIdx.x + 63 * 256);
  } else if (part == 0) {
    convert_units(p, smem, blockIdx.x, 256, 33);
  } else {
    convert_units(p, smem, blockIdx.x + 33 * 256, 256, 30);
    convert_one(p, smem, blockIdx.x + 63 * 256);
  }
}
__device__ __forceinline__ void ph_convert_dn(const Params& p, char* smem) {
  convert_units(p, smem, 16384 + blockIdx.x, 256, 30);
  convert_one(p, smem, 16384 + blockIdx.x + 30 * 256);
  convert_one(p, smem, 16384 + blockIdx.x + 31 * 256);
}

#define R_STAGE 32768
struct GemmRTile {
  const u8* A; int lda; const int* aidx; int m0, mvalid;
  const u8* B; long brow0, brow1; int ldb;
  int pairb;
  int paira;
  int KB;
  int pa0, pan, pb0, pbn;
};
#ifndef PFD
#define PFD 8
#endif
template <bool FP8, bool GATHER, bool PF = false>
__device__ __forceinline__ void gemmr_tile_256(const GemmRTile& t, char* smem, f32x16 (&acc)[4][4]) {
  int tz0 = threadIdx.x; asm volatile("" : "+v"(tz0));
  const int tid = tz0, lane = tid & 63, wid = tid >> 6, wr = wid >> 1, wc = wid & 1;
  const int l31 = lane & 31, hh = lane >> 5;
#pragma unroll
  for (int i = 0; i < 4; ++i)
#pragma unroll
    for (int j = 0; j < 4; ++j)
#pragma unroll
      for (int r = 0; r < 16; ++r) acc[i][j][r] = 0.f;
  const int c_src = (tid & 3) ^ ((tid >> 4) & 3);
  const u8* a_src[GATHER ? 4 : 1];
  if (GATHER) {
#pragma unroll
    for (int i = 0; i < (GATHER ? 4 : 1); ++i) {
      int r = (tid >> 2) + 64 * i;
      int rr = r < t.mvalid ? r : 0;
      a_src[i] = t.A + (long)t.aidx[rr] * t.lda + c_src * 16;
    }
  } else {
    a_src[0] = t.A + (long)(t.m0 + (tid >> 2)) * t.lda + c_src * 16;
  }
  const long a_step = 64L * t.lda, b_step = 64L * t.ldb;
  const u8* b_src0 = t.B + (t.brow0 + (tid >> 2)) * t.ldb + c_src * 16;
  const u8* b_src1 = t.B + (t.brow1 + (tid >> 2)) * t.ldb + c_src * 16;
  const unsigned lds0 = (unsigned)(size_t)smem + (unsigned)__builtin_amdgcn_readfirstlane(wid) * 1024u;
  const u8* pf_src = nullptr; int pf_par = 0;
  const unsigned pf_lds = (unsigned)(size_t)smem + 131072u + 4096u + (unsigned)__builtin_amdgcn_readfirstlane(wid) * 256u;
  const int pf_ncol = t.KB >> 7;
  if (PF) {
    if (lane < 32) { const int n = t.pan >> 3; const int r = t.pa0 + wid * n + (lane & (n - 1)); pf_src = t.A + (long)(t.m0 + r) * t.lda; pf_par = (t.pan >> 1) * t.lda; }
    else { const int n = t.pbn >> 3; const int r = t.pb0 + wid * n + (lane & (n - 1)); pf_src = t.B + (r < 128 ? t.brow0 + r : t.brow1 + r - 128) * t.ldb; pf_par = (t.pbn >> 1) * t.ldb; }
  }
  auto pf_issue = [&](int kt) {
    if (PF) { const int col = min((kt >> 1) + PFD / 2, pf_ncol - 1); glds4_asm((const void*)(pf_src + ((kt & 1) ? pf_par : 0) + col * 128), pf_lds); }
  };
  auto issue = [&](int kt, int sl, int q) {
    if (q < 4) glds16_asm((const void*)((GATHER ? a_src[GATHER ? q : 0] : a_src[0] + q * a_step) + kt * 64), lds0 + sl * R_STAGE + q * 4096);
    else { const int i = q - 4; glds16_asm((const void*)((i < 2 ? b_src0 + i * b_step : b_src1 + (i - 2) * b_step) + kt * 64), lds0 + sl * R_STAGE + 16384 + i * 4096); }
  };
  unsigned a_rd[2], b_rd[2];
#pragma unroll
  for (int s2 = 0; s2 < 2; ++s2) {
    const int ra = wr * 128 + l31, rb = wc * 64 + l31;
    a_rd[s2] = ra * 64 + (((2 * s2 + hh) ^ ((ra >> 2) & 3)) * 16);
    b_rd[s2] = rb * 64 + (((2 * s2 + hh) ^ ((rb >> 2) & 3)) * 16);
  }
  auto load_frags = [&](const char* St, int s2, u32x4 (&af)[4], u32x4 (&bf)[4]) {
#pragma unroll
    for (int mb = 0; mb < 4; ++mb) af[mb] = *(const u32x4*)(St + a_rd[s2] + mb * 2048);
#pragma unroll
    for (int nb = 0; nb < 4; ++nb) bf[nb] = *(const u32x4*)(St + 16384 + b_rd[s2] + (nb >> 1) * 8192 + (nb & 1) * 2048);
  };
  auto mma = [&](u32x4 (&ac)[4], u32x4 (&bc)[4], int nb) {
    if (FP8) {
#pragma unroll
      for (int u = 0; u < 2; ++u) {
        const long bl = (long)(((unsigned long long)bc[nb][2 * u + 1] << 32) | bc[nb][2 * u]);
#pragma unroll
        for (int mb = 0; mb < 4; ++mb) {
          const long al = (long)(((unsigned long long)ac[mb][2 * u + 1] << 32) | ac[mb][2 * u]);
          acc[mb][nb] = __builtin_amdgcn_mfma_f32_32x32x16_fp8_fp8(al, bl, acc[mb][nb], 0, 0, 0);
        }
      }
    } else {
      const bf16x8 bb = *(const bf16x8*)&bc[nb];
#pragma unroll
      for (int mb = 0; mb < 4; ++mb) acc[mb][nb] = __builtin_amdgcn_mfma_f32_32x32x16_bf16(*(const bf16x8*)&ac[mb], bb, acc[mb][nb], 0, 0, 0);
    }
  };
  u32x4 a0[4], b0[4], a1[4], b1[4];
  auto half0 = [&](int kt, bool issueA) {
    const char* St = smem + (kt & 3) * R_STAGE;
    load_frags(St, 1, a1, b1);
    __builtin_amdgcn_sched_barrier(0);
#pragma unroll
    for (int nb = 0; nb < 4; ++nb) {
      mma(a0, b0, nb);
      __builtin_amdgcn_sched_barrier(0);
      if (issueA) issue(kt + 2 + DEEP, (kt + 2 + DEEP) & 3, 4 + nb);
      __builtin_amdgcn_sched_barrier(0);
    }
  };
  auto half1 = [&](int kt, bool has1, bool issueB) {
    const char* Sn = smem + ((kt + 1) & 3) * R_STAGE;
    if (has1) load_frags(Sn, 0, a0, b0);
    __builtin_amdgcn_sched_barrier(0);
#pragma unroll
    for (int nb = 0; nb < 4; ++nb) {
      mma(a1, b1, nb);
      __builtin_amdgcn_sched_barrier(0);
      if (issueB) issue(kt + 3 + DEEP, (kt + 3 + DEEP) & 3, nb);
      if (issueB && nb == 3) pf_issue(kt + 1);
      __builtin_amdgcn_sched_barrier(0);
    }
  };
  const int nk = t.KB >> 6;
  __syncthreads();
#pragma unroll
  for (int q = 0; q < 8; ++q) issue(0, 0, q);
#pragma unroll
  for (int q = 0; q < 8; ++q) issue(1, 1, q);
#pragma unroll
  for (int q = 0; q < 4; ++q) issue(2, 2, q);
#if DEEP
#pragma unroll
  for (int q = 4; q < 8; ++q) issue(2, 2, q);
#pragma unroll
  for (int q = 0; q < 4; ++q) issue(3, 3, q);
  asm volatile("s_waitcnt vmcnt(20)" ::: "memory");
  __syncthreads();
  load_frags(smem, 0, a0, b0);
#pragma nounroll
  for (int kt = 0; kt < nk - 4; ++kt) {
    half0(kt, true);
    asm volatile("s_waitcnt vmcnt(16)" ::: "memory");
    __syncthreads();
    half1(kt, true, true);
  }
  half0(nk - 4, true);
  asm volatile("s_waitcnt vmcnt(16)" ::: "memory");
  __syncthreads();
  half1(nk - 4, true, false);
  half0(nk - 3, false);
  asm volatile("s_waitcnt vmcnt(8)" ::: "memory");
  __syncthreads();
  half1(nk - 3, true, false);
  half0(nk - 2, false);
#else
  pf_issue(0);
  if (PF) asm volatile("s_waitcnt vmcnt(13)" ::: "memory"); else
  asm volatile("s_waitcnt vmcnt(12)" ::: "memory");
  __syncthreads();
  load_frags(smem, 0, a0, b0);
#pragma nounroll
  for (int kt = 0; kt < nk - 3; ++kt) {
    half0(kt, true);
    if (PF) asm volatile("s_waitcnt vmcnt(9)" ::: "memory"); else
    asm volatile("s_waitcnt vmcnt(8)" ::: "memory");
    __syncthreads();
    half1(kt, true, true);
  }
  half0(nk - 3, true);
  if (PF) asm volatile("s_waitcnt vmcnt(9)" ::: "memory"); else
  asm volatile("s_waitcnt vmcnt(8)" ::: "memory");
  __syncthreads();
  half1(nk - 3, true, false);
  half0(nk - 2, false);
#endif
  asm volatile("s_waitcnt vmcnt(0)" ::: "memory");
  __syncthreads();
  half1(nk - 2, true, false);
  half0(nk - 1, false);
  half1(nk - 1, false, false);
}


__device__ __forceinline__ void gemmr16_tile_256(const GemmRTile& t, char* smem, f32x4 (&acc)[8][8]) {
  int tz0 = threadIdx.x; asm volatile("" : "+v"(tz0));
  const int tid = tz0, lane = tid & 63, wid = tid >> 6, wr = wid >> 1, wc = wid & 1;
  const int r15 = lane & 15, kq = lane >> 4;
#pragma unroll
  for (int i = 0; i < 8; ++i)
#pragma unroll
    for (int j = 0; j < 8; ++j) acc[i][j] = (f32x4){0.f, 0.f, 0.f, 0.f};
  const int c_src = (tid & 3) ^ ((tid >> 4) & 3);
  const u8* a_src = t.A + (long)(t.m0 + (tid >> 2)) * t.lda + c_src * 16;
  const long a_step = 64L * t.lda, b_step = 64L * t.ldb;
  const u8* b_src0 = t.B + (t.brow0 + (tid >> 2)) * t.ldb + c_src * 16;
  const u8* b_src1 = t.B + (t.brow1 + (tid >> 2)) * t.ldb + c_src * 16;
  const unsigned lds0 = (unsigned)(size_t)smem + (unsigned)__builtin_amdgcn_readfirstlane(wid) * 1024u;
  auto issue = [&](int kt, int sl, int q) {
    if (q < 4) glds16_asm((const void*)(a_src + q * a_step + kt * 64), lds0 + sl * R_STAGE + q * 4096);
    else { const int i = q - 4; glds16_asm((const void*)((i < 2 ? b_src0 + i * b_step : b_src1 + (i - 2) * b_step) + kt * 64), lds0 + sl * R_STAGE + 16384 + i * 4096); }
  };
  const int ra = wr * 128 + r15, rb = wc * 64 + r15;
  const unsigned a_rd = ra * 64 + ((kq ^ ((ra >> 2) & 3)) * 16);
  const unsigned b_rd = 16384 + rb * 64 + ((kq ^ ((rb >> 2) & 3)) * 16);
  auto load_a = [&](const char* St, u32x4 (&af)[8]) {
#pragma unroll
    for (int mb = 0; mb < 8; ++mb) af[mb] = *(const u32x4*)(St + a_rd + mb * 1024);
  };
  auto load_b = [&](const char* St, int img, u32x4 (&bf)[4]) {
#pragma unroll
    for (int j = 0; j < 4; ++j) bf[j] = *(const u32x4*)(St + b_rd + img * 8192 + j * 1024);
  };
  u32x4 aF[8], b0[4], b1[4];
  auto half0 = [&](int kt, bool issueA) {
    const char* St = smem + (kt & 3) * R_STAGE;
    load_b(St, 1, b1);
    __builtin_amdgcn_sched_barrier(0);
#pragma unroll
    for (int mb = 0; mb < 8; ++mb) {
#pragma unroll
      for (int nb = 0; nb < 4; ++nb) asm volatile("v_mfma_f32_16x16x32_bf16 %0, %1, %2, %0" : "+a"(acc[mb][nb]) : "v"(aF[mb]), "v"(b0[nb]));
      __builtin_amdgcn_sched_barrier(0);
      if (issueA && (mb & 1)) issue(kt + 2, (kt + 2) & 3, 4 + (mb >> 1));
      __builtin_amdgcn_sched_barrier(0);
    }
  };
  auto half1 = [&](int kt, bool has1, bool issueB) {
    const char* Sn = smem + ((kt + 1) & 3) * R_STAGE;
    if (has1) load_b(Sn, 0, b0);
    __builtin_amdgcn_sched_barrier(0);
#pragma unroll
    for (int mb = 0; mb < 8; ++mb) {
#pragma unroll
      for (int nb = 0; nb < 4; ++nb) asm volatile("v_mfma_f32_16x16x32_bf16 %0, %1, %2, %0" : "+a"(acc[mb][4 + nb]) : "v"(aF[mb]), "v"(b1[nb]));
      __builtin_amdgcn_sched_barrier(0);
      if (has1) aF[mb] = *(const u32x4*)(Sn + a_rd + mb * 1024);
      if (issueB && (mb & 1)) issue(kt + 3, (kt + 3) & 3, mb >> 1);
      __builtin_amdgcn_sched_barrier(0);
    }
  };
  const int nk = t.KB >> 6;
  __syncthreads();
#pragma unroll
  for (int q = 0; q < 8; ++q) issue(0, 0, q);
#pragma unroll
  for (int q = 0; q < 8; ++q) issue(1, 1, q);
#pragma unroll
  for (int q = 0; q < 4; ++q) issue(2, 2, q);
  asm volatile("s_waitcnt vmcnt(12)" ::: "memory");
  __syncthreads();
  load_a(smem, aF); load_b(smem, 0, b0);
  for (int kt = 0; kt < nk - 3; ++kt) {
    half0(kt, true);
    asm volatile("s_waitcnt vmcnt(8)" ::: "memory"); __syncthreads();
    half1(kt, true, true);
  }
  half0(nk - 3, true);
  asm volatile("s_waitcnt vmcnt(8)" ::: "memory"); __syncthreads();
  half1(nk - 3, true, false);
  half0(nk - 2, false);
  asm volatile("s_waitcnt vmcnt(0)" ::: "memory"); __syncthreads();
  half1(nk - 2, true, false);
  half0(nk - 1, false);
  half1(nk - 1, false, false);
  asm volatile("s_nop 15\n\ts_nop 15" ::: "memory");
#pragma unroll
  for (int mb = 0; mb < 8; ++mb)
    asm volatile("" : "+a"(acc[mb][0]), "+a"(acc[mb][1]), "+a"(acc[mb][2]), "+a"(acc[mb][3]), "+a"(acc[mb][4]), "+a"(acc[mb][5]), "+a"(acc[mb][6]), "+a"(acc[mb][7]));
}

typedef int i32x8 __attribute__((ext_vector_type(8)));
template <bool GATHER>
__device__ __forceinline__ void gemmrs_tile_256(const GemmRTile& t, char* smem, f32x16 (&acc)[4][4]) {
  int tz0 = threadIdx.x; asm volatile("" : "+v"(tz0));
  const int tid = tz0, lane = tid & 63, wid = tid >> 6, wr = wid >> 1, wc = wid & 1;
  const int l31 = lane & 31, hh = lane >> 5;
#pragma unroll
  for (int i = 0; i < 4; ++i)
#pragma unroll
    for (int j = 0; j < 4; ++j)
#pragma unroll
      for (int r = 0; r < 16; ++r) acc[i][j][r] = 0.f;
  const int c_src = (tid & 3) ^ ((tid >> 4) & 3);
  const u8* a_src[GATHER ? 4 : 1];
  if (GATHER) {
#pragma unroll
    for (int i = 0; i < (GATHER ? 4 : 1); ++i) {
      int r = (tid >> 2) + 64 * i;
      int rr = r < t.mvalid ? r : 0;
      a_src[i] = t.A + (long)t.aidx[rr] * t.lda + c_src * 16;
    }
  } else {
    a_src[0] = t.A + ((long)(t.m0 + (tid >> 2)) >> 1) * 4096 + ((tid >> 2) & 1) * 64 + c_src * 16;
  }
  const long a_step = GATHER ? 64L * t.lda : 32L * 4096, b_step = 32L * 4096;
  const int a_kstep = GATHER ? 64 : 128;
  const int brl = tid >> 2;
  const u8* b_src0 = t.B + ((t.brow0 + brl) >> 1) * 4096 + (brl & 1) * 64 + c_src * 16;
  const u8* b_src1 = t.B + ((t.brow1 + brl) >> 1) * 4096 + (brl & 1) * 64 + c_src * 16;
  const unsigned lds0 = (unsigned)(size_t)smem + (unsigned)__builtin_amdgcn_readfirstlane(wid) * 1024u;
  auto issue = [&](int kt, int sl, int q) {
    if (q < 4) { if (ANT) glds16_asm_nt((const void*)((GATHER ? a_src[GATHER ? q : 0] : a_src[0] + q * a_step) + kt * a_kstep), lds0 + sl * R_STAGE + q * 4096);
                 else glds16_asm((const void*)((GATHER ? a_src[GATHER ? q : 0] : a_src[0] + q * a_step) + kt * a_kstep), lds0 + sl * R_STAGE + q * 4096); }
    else { const int i = q - 4;
      if (BNT) glds16_asm_nt((const void*)((i < 2 ? b_src0 + i * b_step : b_src1 + (i - 2) * b_step) + kt * 128), lds0 + sl * R_STAGE + 16384 + i * 4096);
      else glds16_asm((const void*)((i < 2 ? b_src0 + i * b_step : b_src1 + (i - 2) * b_step) + kt * 128), lds0 + sl * R_STAGE + 16384 + i * 4096); }
  };
  unsigned a_rd[2], b_rd[2];
#pragma unroll
  for (int c = 0; c < 2; ++c) {
    const int ra = wr * 128 + l31, rb = wc * 64 + l31;
    a_rd[c] = ra * 64 + (((2 * hh + c) ^ ((ra >> 2) & 3)) * 16);
    b_rd[c] = rb * 64 + (((2 * hh + c) ^ ((rb >> 2) & 3)) * 16);
  }
  auto load_a = [&](const char* St, i32x8 (&af)[4]) {
#pragma unroll
    for (int mb = 0; mb < 4; ++mb) {
      const u32x4 lo = *(const u32x4*)(St + a_rd[0] + mb * 2048), hi = *(const u32x4*)(St + a_rd[1] + mb * 2048);
      af[mb] = (i32x8){(int)lo[0], (int)lo[1], (int)lo[2], (int)lo[3], (int)hi[0], (int)hi[1], (int)hi[2], (int)hi[3]};
    }
  };
  auto load_b = [&](const char* St, int nb, i32x8& bf) {
    const char* bp = St + 16384 + (nb >> 1) * 8192 + (nb & 1) * 2048;
    const u32x4 lo = *(const u32x4*)(bp + b_rd[0]), hi = *(const u32x4*)(bp + b_rd[1]);
    bf = (i32x8){(int)lo[0], (int)lo[1], (int)lo[2], (int)lo[3], (int)hi[0], (int)hi[1], (int)hi[2], (int)hi[3]};
  };
  auto mma4 = [&](i32x8 (&af)[4], i32x8& bf, int nb) {
#pragma unroll
    for (int mb = 0; mb < 4; ++mb)
      acc[mb][nb] = __builtin_amdgcn_mfma_scale_f32_32x32x64_f8f6f4(af[mb], bf, acc[mb][nb], 0, 0, 0, 0x7f7f7f7f, 0, 0x7f7f7f7f);
  };
  i32x8 aA[4], aB[4], bq[4];
  auto half0 = [&](int kt, i32x8 (&ac)[4], bool issueA) {
    const char* St = smem + (kt & 3) * R_STAGE;
    load_b(St, 2, bq[2]); load_b(St, 3, bq[3]);
    __builtin_amdgcn_sched_barrier(0);
#pragma unroll
    for (int nb = 0; nb < 2; ++nb) {
      mma4(ac, bq[nb], nb);
      __builtin_amdgcn_sched_barrier(0);
      if (issueA) { issue(kt + 2 + DEEP, (kt + 2 + DEEP) & 3, 4 + 2 * nb); issue(kt + 2 + DEEP, (kt + 2 + DEEP) & 3, 5 + 2 * nb); }
      __builtin_amdgcn_sched_barrier(0);
    }
  };
  auto half1 = [&](int kt, i32x8 (&ac)[4], i32x8 (&an)[4], bool has1, bool issueB) {
    const char* Sn = smem + ((kt + 1) & 3) * R_STAGE;
    if (has1) { load_a(Sn, an); load_b(Sn, 0, bq[0]); load_b(Sn, 1, bq[1]); }
    __builtin_amdgcn_sched_barrier(0);
#pragma unroll
    for (int nb = 2; nb < 4; ++nb) {
      mma4(ac, bq[nb], nb);
      __builtin_amdgcn_sched_barrier(0);
      if (issueB) { issue(kt + 3 + DEEP, (kt + 3 + DEEP) & 3, 2 * (nb - 2)); issue(kt + 3 + DEEP, (kt + 3 + DEEP) & 3, 2 * (nb - 2) + 1); }
      __builtin_amdgcn_sched_barrier(0);
    }
  };
  const int nk = t.KB >> 6;
  __syncthreads();
#pragma unroll
  for (int q = 0; q < 8; ++q) issue(0, 0, q);
#pragma unroll
  for (int q = 0; q < 8; ++q) issue(1, 1, q);
#pragma unroll
  for (int q = 0; q < 4; ++q) issue(2, 2, q);
#if DEEP
#pragma unroll
  for (int q = 4; q < 8; ++q) issue(2, 2, q);
#pragma unroll
  for (int q = 0; q < 4; ++q) issue(3, 3, q);
  asm volatile("s_waitcnt vmcnt(20)" ::: "memory");
  __syncthreads();
  load_a(smem, aA); load_b(smem, 0, bq[0]); load_b(smem, 1, bq[1]);
#pragma nounroll
  for (int kt = 0; kt < nk - 4; kt += 2) {
    half0(kt, aA, true);
    asm volatile("s_waitcnt vmcnt(16)" ::: "memory"); __syncthreads();
    half1(kt, aA, aB, true, true);
    half0(kt + 1, aB, true);
    asm volatile("s_waitcnt vmcnt(16)" ::: "memory"); __syncthreads();
    half1(kt + 1, aB, aA, true, true);
  }
  half0(nk - 4, aA, true);
  asm volatile("s_waitcnt vmcnt(16)" ::: "memory"); __syncthreads();
  half1(nk - 4, aA, aB, true, false);
  half0(nk - 3, aB, false);
  asm volatile("s_waitcnt vmcnt(8)" ::: "memory"); __syncthreads();
  half1(nk - 3, aB, aA, true, false);
#else
  asm volatile("s_waitcnt vmcnt(12)" ::: "memory");
  __syncthreads();
  load_a(smem, aA); load_b(smem, 0, bq[0]); load_b(smem, 1, bq[1]);
#pragma nounroll
  for (int kt = 0; kt < nk - 4; kt += 2) {
    half0(kt, aA, true);
    asm volatile("s_waitcnt vmcnt(8)" ::: "memory"); __syncthreads();
    half1(kt, aA, aB, true, true);
    half0(kt + 1, aB, true);
    asm volatile("s_waitcnt vmcnt(8)" ::: "memory"); __syncthreads();
    half1(kt + 1, aB, aA, true, true);
  }
  half0(nk - 4, aA, true);
  asm volatile("s_waitcnt vmcnt(8)" ::: "memory"); __syncthreads();
  half1(nk - 4, aA, aB, true, true);
  half0(nk - 3, aB, true);
  asm volatile("s_waitcnt vmcnt(8)" ::: "memory"); __syncthreads();
  half1(nk - 3, aB, aA, true, false);
#endif
  half0(nk - 2, aA, false);
  asm volatile("s_waitcnt vmcnt(0)" ::: "memory"); __syncthreads();
  half1(nk - 2, aA, aB, true, false);
  half0(nk - 1, aB, false);
  half1(nk - 1, aB, aA, false, false);
}

template <bool GATHER>
__device__ __forceinline__ void gemmrv_tile_256(const GemmRTile& t, char* smem, f32x16 (&acc)[4][4]) {
  int tz0 = threadIdx.x; asm volatile("" : "+v"(tz0));
  const int tid = tz0, lane = tid & 63, wid = tid >> 6, wr = wid >> 1, wc = wid & 1;
  const int l31 = lane & 31, hh = lane >> 5;
#pragma unroll
  for (int i = 0; i < 4; ++i)
#pragma unroll
    for (int j = 0; j < 4; ++j)
#pragma unroll
      for (int r = 0; r < 16; ++r) acc[i][j][r] = 0.f;
  const int c_src = (tid & 3) ^ ((tid >> 4) & 3);
  const u8* a_src[GATHER ? 4 : 1];
  if (GATHER) {
#pragma unroll
    for (int i = 0; i < (GATHER ? 4 : 1); ++i) {
      int r = (tid >> 2) + 64 * i;
      int rr = r < t.mvalid ? r : 0;
      a_src[i] = t.A + (long)t.aidx[rr] * t.lda + c_src * 16;
    }
  } else {
    a_src[0] = t.A + ((long)(t.m0 + (tid >> 2)) >> 1) * 4096 + ((tid >> 2) & 1) * 64 + c_src * 16;
  }
  const long a_step = GATHER ? 64L * t.lda : 32L * 4096, b_step = 32L * 4096;
  const int a_kstep = GATHER ? 64 : 128;
  const int brl = tid >> 2;
  const u8* b_src0 = t.B + ((t.brow0 + brl) >> 1) * 4096 + (brl & 1) * 64 + c_src * 16;
  const u8* b_src1 = t.B + ((t.brow1 + brl) >> 1) * 4096 + (brl & 1) * 64 + c_src * 16;
  u32x4 rs0[8], rs1[8];
  auto ldg = [&](int kt, int q, u32x4& dst) {
    const u8* ptr = (q < 4) ? ((GATHER ? a_src[GATHER ? q : 0] : a_src[0] + q * a_step) + kt * a_kstep)
                            : (((q - 4) < 2 ? b_src0 + (q - 4) * b_step : b_src1 + (q - 6) * b_step) + kt * 128);
    asm volatile("global_load_dwordx4 %0, %1, off" : "=v"(dst) : "v"(ptr) : "memory");
  };
  auto stw = [&](int sl, int q, const u32x4& src) {
    *(u32x4*)(smem + sl * R_STAGE + (q < 4 ? q * 4096 : 16384 + (q - 4) * 4096) + tid * 16) = src;
  };
#define RV_WAIT(N, r) asm volatile("s_waitcnt vmcnt(%8)" : "+v"(r[0]), "+v"(r[1]), "+v"(r[2]), "+v"(r[3]), "+v"(r[4]), "+v"(r[5]), "+v"(r[6]), "+v"(r[7]) : "n"(N) : "memory")
  unsigned a_rd[2], b_rd[2];
#pragma unroll
  for (int c = 0; c < 2; ++c) {
    const int ra = wr * 128 + l31, rb = wc * 64 + l31;
    a_rd[c] = ra * 64 + (((2 * hh + c) ^ ((ra >> 2) & 3)) * 16);
    b_rd[c] = rb * 64 + (((2 * hh + c) ^ ((rb >> 2) & 3)) * 16);
  }
  auto load_a = [&](const char* St, i32x8 (&af)[4]) {
#pragma unroll
    for (int mb = 0; mb < 4; ++mb) {
      const u32x4 lo = *(const u32x4*)(St + a_rd[0] + mb * 2048), hi = *(const u32x4*)(St + a_rd[1] + mb * 2048);
      af[mb] = (i32x8){(int)lo[0], (int)lo[1], (int)lo[2], (int)lo[3], (int)hi[0], (int)hi[1], (int)hi[2], (int)hi[3]};
    }
  };
  auto load_b = [&](const char* St, int nb, i32x8& bf) {
    const char* bp = St + 16384 + (nb >> 1) * 8192 + (nb & 1) * 2048;
    const u32x4 lo = *(const u32x4*)(bp + b_rd[0]), hi = *(const u32x4*)(bp + b_rd[1]);
    bf = (i32x8){(int)lo[0], (int)lo[1], (int)lo[2], (int)lo[3], (int)hi[0], (int)hi[1], (int)hi[2], (int)hi[3]};
  };
  auto mma4 = [&](i32x8 (&af)[4], i32x8& bf, int nb) {
#pragma unroll
    for (int mb = 0; mb < 4; ++mb)
      acc[mb][nb] = __builtin_amdgcn_mfma_scale_f32_32x32x64_f8f6f4(af[mb], bf, acc[mb][nb], 0, 0, 0, 0x7f7f7f7f, 0, 0x7f7f7f7f);
  };
  i32x8 aA[4], aB[4], bq[4];
  auto half0 = [&](int kt, i32x8 (&ac)[4]) {
    const char* St = smem + (kt & 1) * R_STAGE;
    load_b(St, 2, bq[2]); load_b(St, 3, bq[3]);
    __builtin_amdgcn_sched_barrier(0);
    mma4(ac, bq[0], 0);
    __builtin_amdgcn_sched_barrier(0);
    mma4(ac, bq[1], 1);
    __builtin_amdgcn_sched_barrier(0);
  };
  auto commit = [&](int kt, u32x4 (&rn)[8], auto wtag, bool has1, bool has3) {
    constexpr int W = decltype(wtag)::value;
    if (has1) {
      RV_WAIT(W, rn);
#pragma unroll
      for (int q = 0; q < 8; ++q) stw((kt + 1) & 1, q, rn[q]);
      if (has3) {
#pragma unroll
        for (int q = 0; q < 8; ++q) ldg(kt + 3, q, rn[q]);
      }
      __syncthreads();
    }
  };
  auto half1 = [&](int kt, i32x8 (&ac)[4], i32x8 (&an)[4], bool has1) {
    const char* Sn = smem + ((kt + 1) & 1) * R_STAGE;
    if (has1) { load_a(Sn, an); load_b(Sn, 0, bq[0]); load_b(Sn, 1, bq[1]); }
    __builtin_amdgcn_sched_barrier(0);
    mma4(ac, bq[2], 2);
    __builtin_amdgcn_sched_barrier(0);
    mma4(ac, bq[3], 3);
    __builtin_amdgcn_sched_barrier(0);
  };
#define IC(n) std::integral_constant<int, n>{}
  const int nk = t.KB >> 6;
  __syncthreads();
#pragma unroll
  for (int q = 0; q < 8; ++q) ldg(0, q, rs0[q]);
#pragma unroll
  for (int q = 0; q < 8; ++q) ldg(1, q, rs1[q]);
  RV_WAIT(8, rs0);
#pragma unroll
  for (int q = 0; q < 8; ++q) stw(0, q, rs0[q]);
#pragma unroll
  for (int q = 0; q < 8; ++q) ldg(2, q, rs0[q]);
  __syncthreads();
  load_a(smem, aA); load_b(smem, 0, bq[0]); load_b(smem, 1, bq[1]);
  for (int kt = 0; kt < nk - 4; kt += 2) {
    half0(kt, aA);      commit(kt, rs1, IC(8), true, true);      half1(kt, aA, aB, true);
    half0(kt + 1, aB);  commit(kt + 1, rs0, IC(8), true, true);  half1(kt + 1, aB, aA, true);
  }
  half0(nk - 4, aA);  commit(nk - 4, rs1, IC(8), true, true);   half1(nk - 4, aA, aB, true);
  half0(nk - 3, aB);  commit(nk - 3, rs0, IC(8), true, false);  half1(nk - 3, aB, aA, true);
  half0(nk - 2, aA);  commit(nk - 2, rs1, IC(0), true, false);  half1(nk - 2, aA, aB, true);
  half0(nk - 1, aB);                                            half1(nk - 1, aB, aA, false);
#undef IC
#undef RV_WAIT
}

__device__ __forceinline__ void cvt16_tile(const float* W, int col0, int ldn, int nvalid  , const float* kgain,
                                           u16* out  , int ldk, char* T) {
  const int tid = opaque_tid();
  const int kq = tid & 7, n4 = tid >> 3;
  f32x4 v[16];
  const bool ok = (n4 * 4) < nvalid;
  const float* src = W + (long)(kq * 16) * ldn + (ok ? n4 * 4 : -col0);
#pragma unroll
  for (int j = 0; j < 16; ++j) v[j] = __builtin_nontemporal_load((const f32x4*)(src + (long)j * ldn));
  if (kgain) {
#pragma unroll
    for (int j = 0; j < 16; ++j) v[j] *= kgain[kq * 16 + j];
  }
  if (!ok) {
#pragma unroll
    for (int j = 0; j < 16; ++j) v[j] = (f32x4){0.f, 0.f, 0.f, 0.f};
  }
  __syncthreads();
#pragma unroll
  for (int c = 0; c < 4; ++c) {
    u32x4 w0, w1;
#pragma unroll
    for (int q = 0; q < 4; ++q) { w0[q] = pack_bf16(v[2 * q][c], v[2 * q + 1][c]); w1[q] = pack_bf16(v[8 + 2 * q][c], v[8 + 2 * q + 1][c]); }
    *(u32x4*)(T + (n4 * 4 + c) * 256 + kq * 32) = w0;
    *(u32x4*)(T + (n4 * 4 + c) * 256 + kq * 32 + 16) = w1;
  }
  __syncthreads();
#pragma unroll
  for (int i = 0; i < 8; ++i) {
    const int n = (tid >> 4) + 16 * i, ch = tid & 15;
    *(u32x4*)((char*)(out + (long)n * ldk) + ch * 16) = *(const u32x4*)(T + n * 256 + ch * 16);
  }
}
__device__ __forceinline__ void convert_one(const Params& p, char* smem, int u);
__device__ __forceinline__ void ph_convert_dense(const Params& p, char* smem) {
#if WOUTQ
  convert_one(p, smem, 24576 + blockIdx.x);
#endif
  for (int u = blockIdx.x; u < 912; u += gridDim.x) {
    if (u < 544) { const int kt = u / 34, nt = u % 34; const int nv = NC_ - nt * 128;
      cvt16_tile(p.w_in + (long)(kt * 128) * NC_ + nt * 128, nt * 128, NC_, nv < 0 ? 0 : nv, nullptr, p.wb_in() + (long)(nt * 128) * 2048 + kt * 128, 2048, smem);
    } else if (u < 592) { const int v = u - 544; const int kt = v / 12, nt = v % 12;
      cvt16_tile(p.w_uq + (long)(kt * 128) * 1536 + nt * 128, nt * 128, 1536, 128, p.q_norm + kt * 128, p.wb_uq() + (long)(nt * 128) * 512 + kt * 128, 512, smem);
    } else if (u < 656) { const int v = u - 592; const int kt = v >> 4, nt = v & 15;
      cvt16_tile(p.w_ukv + (long)(kt * 128) * 2048 + nt * 128, nt * 128, 2048, 128, p.kv_norm + kt * 128, p.wb_ukv() + (long)(nt * 128) * 512 + kt * 128, 512, smem);
    } else if (!WOUTQ) { const int v = u - 656; const int kt = v >> 4, nt = v & 15;
      cvt16_tile(p.w_out + (long)(kt * 128) * 2048 + nt * 128, nt * 128, 2048, 128, nullptr, p.wb_out() + (long)(nt * 128) * 2048 + kt * 128, 2048, smem);
    }
  }
}


template <bool NTST = false, class F>
__device__ __forceinline__ void epi_store_bf16(f32x16 (&acc)[4][4], char* smem, u16* gbase  , int ld, int ncols0, int ncols1, F f) {
  int tz = threadIdx.x; asm volatile("" : "+v"(tz));
  const int lane = tz & 63, wid = tz >> 6, wr = wid >> 1, wc = wid & 1, l31 = lane & 31, hh = lane >> 5;
  __syncthreads();
  char* st = smem + wid * 32768;
#pragma unroll
  for (int mb = 0; mb < 4; ++mb)
#pragma unroll
    for (int reg = 0; reg < 16; ++reg) {
      const int r = mb * 32 + (reg & 3) + 8 * (reg >> 2) + 4 * hh;
      float v[4] = {acc[mb][0][reg], acc[mb][1][reg], acc[mb][2][reg], acc[mb][3][reg]};
      f(wr * 128 + r, wc * 64 + l31, v);
#pragma unroll
      for (int nb = 0; nb < 4; ++nb) *(u16*)(st + r * 256 + (nb * 32 + l31) * 2) = f32_to_bf16(v[nb]);
    }
  const int ch = lane & 15, span = ch >> 3;
  const int gcol = span * 128 + wc * 64 + (ch & 7) * 8;
  const bool ok = ((wc * 64 + (ch & 7) * 8) < (span ? ncols1 : ncols0));
#pragma unroll 8
  for (int it = 0; it < 32; ++it) {
    const int r = it * 4 + (lane >> 4);
    const u32x4 w = *(const u32x4*)(st + r * 256 + ch * 16);
    if (ok) { if (NTST) __builtin_nontemporal_store(w, (u32x4*)(gbase + (long)(wr * 128 + r) * ld + gcol)); else *(u32x4*)(gbase + (long)(wr * 128 + r) * ld + gcol) = w; }
  }
}
template <class F>
__device__ __forceinline__ void epi_store_act8(f32x16 (&acc)[4][4], char* smem, u8* gbase  , long row0, int cb0, F f) {
  int tz = threadIdx.x; asm volatile("" : "+v"(tz));
  const int lane = tz & 63, wid = tz >> 6, wr = wid >> 1, wc = wid & 1, l31 = lane & 31, hh = lane >> 5;
  __syncthreads();
  char* st = smem + wid * 32768;
#pragma unroll
  for (int mb = 0; mb < 4; ++mb)
#pragma unroll
    for (int reg = 0; reg < 16; ++reg) {
      const int r = mb * 32 + (reg & 3) + 8 * (reg >> 2) + 4 * hh;
      float v[4] = {acc[mb][0][reg], acc[mb][1][reg], acc[mb][2][reg], acc[mb][3][reg]};
      f(wr * 128 + r, wc * 64 + l31, v);
      const int q = __builtin_amdgcn_cvt_pk_fp8_f32(v[0], v[1], 0, false);
      *(u8*)(st + r * 64 + l31) = (u8)(q & 0xff);
      *(u8*)(st + r * 64 + 32 + l31) = (u8)((q >> 8) & 0xff);
    }
  const int ch = lane & 3;
#pragma unroll 8
  for (int it = 0; it < 8; ++it) {
    const int r = it * 16 + (lane >> 2);
    const u32x4 w = *(const u32x4*)(st + r * 64 + ch * 16);
    const long rg = row0 + wr * 128 + r;
    *(u32x4*)(gbase + (rg >> 1) * 4096 + (long)(cb0 + wc) * 128 + (rg & 1) * 64 + ch * 16) = w;
  }
}
__device__ __forceinline__ void epi_store_f32_resid(f32x16 (&acc)[4][4], char* smem, const float* resid, float* out, int ld, float osc) {
  int tz = threadIdx.x; asm volatile("" : "+v"(tz));
  const int lane = tz & 63, wid = tz >> 6, wr = wid >> 1, wc = wid & 1, l31 = lane & 31, hh = lane >> 5;
  __syncthreads();
  char* st = smem + wid * 32768;
  const int ch = lane & 31, span = ch >> 4;
  const int gcol = span * 128 + wc * 64 + (ch & 15) * 4;
#if EPI2
  const long o0 = (long)(wr * 128 + (lane >> 5)) * ld + gcol;
  f32x4 xa[16], xb[16];
  auto ldb = [&](int b, f32x4 (&x)[16]) {
#pragma unroll
    for (int i = 0; i < 16; ++i) x[i] = __builtin_nontemporal_load((const f32x4*)(resid + o0 + (long)(b * 32 + i * 2) * ld));
  };
  auto stage = [&](int half) {
#pragma unroll
    for (int m2 = 0; m2 < 2; ++m2)
#pragma unroll
      for (int reg = 0; reg < 16; ++reg) {
        const int mb = half * 2 + m2;
        const int r = m2 * 32 + (reg & 3) + 8 * (reg >> 2) + 4 * hh;
#pragma unroll
        for (int nb = 0; nb < 4; ++nb) *(float*)(st + r * 512 + (nb * 32 + l31) * 4) = acc[mb][nb][reg];
      }
  };
  auto proc = [&](int b, f32x4 (&x)[16]) {
#pragma unroll
    for (int i = 0; i < 16; ++i) {
      const int r = (b & 1) * 32 + i * 2 + (lane >> 5);
      const f32x4 a = *(const f32x4*)(st + r * 512 + ch * 16);
      *(f32x4*)(out + o0 + (long)(b * 32 + i * 2) * ld) = a * osc + x[i];
    }
  };
  ldb(0, xa);
  __builtin_amdgcn_sched_barrier(0);
  stage(0);
  ldb(1, xb);
  __builtin_amdgcn_sched_barrier(0);
  proc(0, xa);
  ldb(2, xa);
  __builtin_amdgcn_sched_barrier(0);
  proc(1, xb);
  stage(1);
  ldb(3, xb);
  __builtin_amdgcn_sched_barrier(0);
  proc(2, xa);
  proc(3, xb);
#else
#pragma unroll
  for (int half = 0; half < 2; ++half) {
#pragma unroll
    for (int m2 = 0; m2 < 2; ++m2)
#pragma unroll
      for (int reg = 0; reg < 16; ++reg) {
        const int mb = half * 2 + m2;
        const int r = m2 * 32 + (reg & 3) + 8 * (reg >> 2) + 4 * hh;
#pragma unroll
        for (int nb = 0; nb < 4; ++nb) *(float*)(st + r * 512 + (nb * 32 + l31) * 4) = acc[mb][nb][reg];
      }
#pragma unroll 8
    for (int it = 0; it < 32; ++it) {
      const int r = it * 2 + (lane >> 5);
      const f32x4 a = *(const f32x4*)(st + r * 512 + ch * 16);
      const long o = (long)(wr * 128 + half * 64 + r) * ld + gcol;
      const f32x4 x = __builtin_nontemporal_load((const f32x4*)(resid + o));
      *(f32x4*)(out + o) = a * osc + x;
    }
  }
#endif
}

template <bool NTST = false>
__device__ __forceinline__ void epi16_store_bf16(f32x4 (&acc)[8][8], char* smem, u16* gbase, int ld, int ncols0, int ncols1, const float* rscale, float mul) {
  int tz = threadIdx.x; asm volatile("" : "+v"(tz));
  const int lane = tz & 63, wid = tz >> 6, wr = wid >> 1, wc = wid & 1, l15 = lane & 15, kq = lane >> 4;
  __syncthreads();
  char* st = smem + wid * 32768;
#pragma unroll
  for (int mb = 0; mb < 8; ++mb)
#pragma unroll
    for (int reg = 0; reg < 4; ++reg) {
      const int r = mb * 16 + 4 * kq + reg;
      const float sc = rscale ? rscale[wr * 128 + r] * mul : 1.0f;
#pragma unroll
      for (int nb = 0; nb < 8; ++nb) *(u16*)(st + r * 256 + ((nb >> 2) * 64 + (nb & 3) * 16 + l15) * 2) = f32_to_bf16(acc[mb][nb][reg] * sc);
    }
  const int ch = lane & 15, span = ch >> 3;
  const int gcol = span * 128 + wc * 64 + (ch & 7) * 8;
  const bool ok = ((wc * 64 + (ch & 7) * 8) < (span ? ncols1 : ncols0));
#pragma unroll 8
  for (int it = 0; it < 32; ++it) {
    const int r = it * 4 + (lane >> 4);
    const u32x4 w = *(const u32x4*)(st + r * 256 + ch * 16);
    if (ok) { if (NTST) __builtin_nontemporal_store(w, (u32x4*)(gbase + (long)(wr * 128 + r) * ld + gcol)); else *(u32x4*)(gbase + (long)(wr * 128 + r) * ld + gcol) = w; }
  }
}
__device__ __forceinline__ void epi16_store_f32_resid(f32x4 (&acc)[8][8], char* smem, const float* resid, float* out, int ld) {
  int tz = threadIdx.x; asm volatile("" : "+v"(tz));
  const int lane = tz & 63, wid = tz >> 6, wr = wid >> 1, wc = wid & 1, l15 = lane & 15, kq = lane >> 4;
  __syncthreads();
  char* st = smem + wid * 32768;
#pragma unroll
  for (int half = 0; half < 2; ++half) {
#pragma unroll
    for (int m4 = 0; m4 < 4; ++m4)
#pragma unroll
      for (int reg = 0; reg < 4; ++reg) {
        const int mb = half * 4 + m4;
        const int r = m4 * 16 + 4 * kq + reg;
#pragma unroll
        for (int nb = 0; nb < 8; ++nb) *(float*)(st + r * 512 + ((nb >> 2) * 64 + (nb & 3) * 16 + l15) * 4) = acc[mb][nb][reg];
      }
    const int ch = lane & 31, span = ch >> 4;
    const int gcol = span * 128 + wc * 64 + (ch & 15) * 4;
#pragma unroll 8
    for (int it = 0; it < 32; ++it) {
      const int r = it * 2 + (lane >> 5);
      const f32x4 a = *(const f32x4*)(st + r * 512 + ch * 16);
      const long o = (long)(wr * 128 + half * 64 + r) * ld + gcol;
      const f32x4 x = __builtin_nontemporal_load((const f32x4*)(resid + o));
      *(f32x4*)(out + o) = a + x;
    }
  }
}

template <int NBV>
__device__ __forceinline__ void win_tile_r(const Params& p, char* smem, int mt, int nt) {
  GemmRTile t{};
  t.A = (const u8*)p.h1(); t.lda = 4096; t.aidx = nullptr; t.m0 = mt * 256; t.mvalid = 256;
  t.B = (const u8*)p.wb_in(); t.brow0 = nt * 256; t.brow1 = nt * 256 + 128; t.ldb = 4096; t.KB = 4096;
  const int rem = NC_ - nt * 256;
  const int nv0 = rem >= 128 ? 128 : rem, nv1 = rem >= 256 ? 128 : (rem > 128 ? rem - 128 : 0);
#if (MF16 & 1)
  f32x4 acc6[8][8];
  gemmr16_tile_256(t, smem, acc6);
  epi16_store_bf16(acc6, smem, p.proj() + (long)(mt * 256) * NC_ + nt * 256, NC_, nv0, nv1, nullptr, 1.0f);
#else
  f32x16 acc[4][4];
  gemmr_tile_256<false, false>(t, smem, acc);
  epi_store_bf16(acc, smem, p.proj() + (long)(mt * 256) * NC_ + nt * 256, NC_, nv0, nv1, [&](int, int, float (&)[4]) {});
#endif
}
__device__ __forceinline__ void win_narrow_split(const Params& p, char* smem, int mt, int kc) {
  GemmRTile t{};
  t.A = (const u8*)p.h1() + kc * 512; t.lda = 4096; t.aidx = nullptr; t.m0 = mt * 256; t.mvalid = 256;
  t.B = (const u8*)p.wb_in() + kc * 512; t.brow0 = 4096; t.brow1 = 4224; t.ldb = 4096; t.KB = 512;
  float* base = p.pn() + (long)kc * (8192 * 80) + (long)(mt * 256) * 80;
#if (MF16 & 2)
  f32x4 acc6[8][8];
  gemmr16_tile_256(t, smem, acc6);
  {
    const int tq = opaque_tid(); const int lane = tq & 63, wid = tq >> 6, wr = wid >> 1, wc = wid & 1;
#pragma unroll
    for (int mb = 0; mb < 8; ++mb)
#pragma unroll
      for (int reg = 0; reg < 4; ++reg) {
        const int rowl = wr * 128 + mb * 16 + 4 * (lane >> 4) + reg;
        float* rp = base + (long)rowl * 80 + wc * 64 + (lane & 15);
        OPAQUE(rp);
#pragma unroll
        for (int nb = 0; nb < 4; ++nb) if (wc * 64 + nb * 16 + (lane & 15) < 80) rp[nb * 16] = acc6[mb][nb][reg];
      }
  }
  return;
#endif
  f32x16 acc[4][4];
  gemmr_tile_256<false, false>(t, smem, acc);
  acc_foreach_row<4>(acc, [&](int rowl, int coll, float (&v)[4]) {
    float* rp = base + (long)rowl * 80 + coll;
    OPAQUE(rp);
    if (coll < 80) rp[0] = v[0];
    if (coll + 32 < 80) rp[32] = v[1];
  });
}
__device__ __forceinline__ void ph_win_r(const Params& p, char* smem) {
  const int x = blockIdx.x & 7, slot = blockIdx.x >> 3;
#if WIN_SPLIT
  for (int j = slot; j < 64; j += 32) win_tile_r<4>(p, smem, 4 * x + (j & 3), j >> 2);
  win_narrow_split(p, smem, 4 * x + (slot & 3), slot >> 2);
#else
  for (int j = slot; j < 68; j += 32) win_tile_r<4>(p, smem, 4 * x + (j & 3), j >> 2);
#endif
}
__device__ __forceinline__ void upq_tile_r(const Params& p, char* smem, int mt, int nt) {
  GemmRTile t{};
  t.A = (const u8*)(p.proj() + C_MQ); t.lda = NC_ * 2; t.aidx = nullptr; t.m0 = mt * 256; t.mvalid = 256;
  t.B = (const u8*)p.wb_uq(); t.brow0 = nt * 256; t.brow1 = nt * 256 + 128; t.ldb = 1024; t.KB = 1024;
  const float* rq = p.rq() + mt * 256;
#if (MF16 & 4)
  f32x4 acc6[8][8];
  gemmr16_tile_256(t, smem, acc6);
  epi16_store_bf16(acc6, smem, p.q() + (long)(mt * 256) * 1536 + nt * 256, 1536, 128, 128, rq, QSCALE_);
  return;
#endif
  f32x16 acc[4][4];
  gemmr_tile_256<false, false>(t, smem, acc);
  epi_store_bf16(acc, smem, p.q() + (long)(mt * 256) * 1536 + nt * 256, 1536, 128, 128, [&](int rowl, int, float (&v)[4]) {
    const float s = rq[rowl] * QSCALE_;
#pragma unroll
    for (int nb = 0; nb < 4; ++nb) v[nb] *= s;
  });
}
__device__ __forceinline__ void upkv_tile_r(const Params& p, char* smem, int mt, int nt) {
  GemmRTile t{};
  t.A = (const u8*)(p.proj() + C_MKV); t.lda = NC_ * 2; t.aidx = nullptr; t.m0 = mt * 256; t.mvalid = 256;
  t.B = (const u8*)p.wb_ukv(); t.brow0 = nt * 256; t.brow1 = nt * 256 + 128; t.ldb = 1024; t.KB = 1024;
  const float* rk = p.rkv() + mt * 256;
#if (MF16 & 8)
  f32x4 acc6[8][8];
  gemmr16_tile_256(t, smem, acc6);
  epi16_store_bf16(acc6, smem, p.kv() + (long)(mt * 256) * 2048 + nt * 256, 2048, 128, 128, rk, 1.0f);
  return;
#endif
  f32x16 acc[4][4];
  gemmr_tile_256<false, false>(t, smem, acc);
  epi_store_bf16(acc, smem, p.kv() + (long)(mt * 256) * 2048 + nt * 256, 2048, 128, 128, [&](int rowl, int, float (&v)[4]) {
    const float s = rk[rowl];
#pragma unroll
    for (int nb = 0; nb < 4; ++nb) v[nb] *= s;
  });
}
template <int hot = 0>
__device__ __forceinline__ void wout_tile_r(const Params& p, char* smem, int mt, int nt) {
  f32x16 acc[4][4];
  GemmRTile t{};
  const int smt = mt, snt = nt;
  if (hot == 1) { mt = 0; nt = 0; }
#if WOUTQ
  t.A = p.mixq(); t.lda = 2048; t.aidx = nullptr; t.m0 = mt * 256; t.mvalid = 256;
  t.B = p.wq_out(); t.brow0 = nt * 256; t.brow1 = nt * 256 + 128; t.ldb = 2048; t.KB = 2048;
  gemmrs_tile_256<false>(t, smem, acc);
  const float osc = WISCALE_;
#else
  t.A = (const u8*)p.mix(); t.lda = 4096; t.aidx = nullptr; t.m0 = mt * 256; t.mvalid = 256;
  t.B = (const u8*)p.wb_out(); t.brow0 = nt * 256; t.brow1 = nt * 256 + 128; t.ldb = 4096; t.KB = 4096;
  if (hot == 2) t.KB = 512;
#if (MF16 & 16)
  {
    f32x4 acc6[8][8];
    gemmr16_tile_256(t, smem, acc6);
    const long boff6 = (long)(smt * 256) * 2048 + snt * 256;
    epi16_store_f32_resid(acc6, smem, p.x + boff6, p.x1() + boff6, 2048);
    return;
  }
#endif
  gemmr_tile_256<false, false>(t, smem, acc);
  const float osc = 1.0f;
#endif
  const long boff = (long)(smt * 256) * 2048 + snt * 256;
  epi_store_f32_resid(acc, smem, p.x + boff, p.x1() + boff, 2048, osc);
}

__device__ __forceinline__ void moe1q_tile(const Params& p, char* smem, const int* mo, int e, int nt, int mt) {
  f32x16 acc[4][4];
  GemmRTile t{};
#if PRE1
  const int cnt = mo[40 + e];
  const float* bg = p.b_gu + e * 4096 + nt * 128; const float* bu = bg + 2048;
  const int tq_ = opaque_tid(); const int cl = (tq_ >> 6 & 1) * 64 + (tq_ & 31);
  const float bgv[2] = {bg[cl], bg[cl + 32]}, buv[2] = {bu[cl], bu[cl + 32]};
#else
  const int cnt = p.counts()[e];
#endif
  t.A = p.h2q(); t.lda = 2048; t.aidx = p.list() + e * T_ + mt * 256; t.m0 = 0; t.mvalid = min(256, cnt - mt * 256);
  t.B = p.wq_gu(); t.brow0 = (long)e * 4096 + nt * 128; t.brow1 = t.brow0 + 2048; t.ldb = 2048; t.KB = 2048;
#if MOEQ == 3
  gemmrv_tile_256<true>(t, smem, acc);
#elif MOEQ == 2
  gemmrs_tile_256<true>(t, smem, acc);
#else
  gemmr_tile_256<true, true>(t, smem, acc);
#endif
#if !PRE1
  const float* bg = p.b_gu + e * 4096 + nt * 128; const float* bu = bg + 2048;
  const int tq_ = opaque_tid(); const int cl = (tq_ >> 6 & 1) * 64 + (tq_ & 31);
  const float bgv[2] = {bg[cl], bg[cl + 32]}, buv[2] = {bu[cl], bu[cl + 32]};
#endif
  epi_store_act8(acc, smem, p.actq(), (long)(mo[e] * 256 + mt * 256), nt * 2, [&](int, int, float (&v)[4]) {
#pragma unroll
    for (int nb = 0; nb < 2; ++nb) {
      float g = fminf(v[nb] * WISCALE_ + bgv[nb], 7.0f);
      float uu = fminf(fmaxf(v[nb + 2] * WISCALE_ + buv[nb], -7.0f), 7.0f);
      v[nb] = (uu + 1.0f) * (g * __builtin_amdgcn_rcpf(1.0f + __expf(-1.702f * g)));
    }
  });
}
template <int KBV = 2048>
__device__ __forceinline__ void moe2q_tile(const Params& p, char* smem, const int* mo, int e, int nt, int mt) {
  f32x16 acc[4][4];
  GemmRTile t{};
  t.A = p.actq(); t.lda = 2048; t.aidx = nullptr; t.m0 = mo[e] * 256 + mt * 256; t.mvalid = 256;
  t.B = p.wq_dn(); t.brow0 = (long)e * 2048 + nt * 256; t.brow1 = t.brow0 + 128; t.ldb = 2048; t.KB = KBV;
#if PRE1
  const float* bd = p.b_dn + e * 2048 + nt * 256;
  const int tq_ = opaque_tid(); const int cl = (tq_ >> 6 & 1) * 64 + (tq_ & 31);
  const float bdv[4] = {bd[cl], bd[cl + 32], bd[cl + 128], bd[cl + 160]};
#endif
#if MOEQ == 3
  gemmrv_tile_256<false>(t, smem, acc);
#elif MOEQ == 2
  gemmrs_tile_256<false>(t, smem, acc);
#else
  gemmr_tile_256<true, false>(t, smem, acc);
#endif
#if !PRE1
  const float* bd = p.b_dn + e * 2048 + nt * 256;
  const int tq_ = opaque_tid(); const int cl = (tq_ >> 6 & 1) * 64 + (tq_ & 31);
  const float bdv[4] = {bd[cl], bd[cl + 32], bd[cl + 128], bd[cl + 160]};
#endif
  epi_store_bf16<YNT != 0>(acc, smem, p.ybuf() + (long)t.m0 * 2048 + nt * 256, 2048, 128, 128, [&](int, int, float (&v)[4]) {
#pragma unroll
    for (int nb = 0; nb < 4; ++nb) v[nb] = v[nb] * WISCALE_ + bdv[nb];
  });
}

template <int WHICH>
__device__ __forceinline__ void moe_stream(const Params& p, char* smem, const int* mo) {
  constexpr bool GATHER = (WHICH == 1);
  constexpr int NT = GATHER ? 16 : 8;
  constexpr int nk = 32;
  const int total = mo[NE_] * NT;
  int tz0 = threadIdx.x; asm volatile("" : "+v"(tz0));
  const int tid = tz0, lane = tid & 63, wid = tid >> 6, wr = wid >> 1, wc = wid & 1;
  const int l31 = lane & 31, hh = lane >> 5;
  const int c_src = (tid & 3) ^ ((tid >> 4) & 3);
  const unsigned lds0 = (unsigned)(size_t)smem + (unsigned)__builtin_amdgcn_readfirstlane(wid) * 1024u;
  const u8* a_src[GATHER ? 4 : 1]; const u8* b_src0; const u8* b_src1;
  const long a_step = 32L * 4096, b_step = 32L * 4096;
  constexpr int a_kstep = GATHER ? 64 : 128;
  auto decode = [&](int round, int& e, int& nt, int& mt) -> bool {
    const int u = xcd_unit(round);
    if (u >= total) return false;
    e = 0;
    while (mo[e + 1] * NT <= u) ++e;
    const int local = u - mo[e] * NT, me = mo[e + 1] - mo[e];
    nt = local / me; mt = local - nt * me;
    return true;
  };
  auto load_idx = [&](int e, int mt, int (&ix)[4]) {
    const int cnt = mo[40 + e];
    const int mvalid = min(256, cnt - mt * 256);
    const int* aidx = p.list() + e * T_ + mt * 256;
#pragma unroll
    for (int i = 0; i < 4; ++i) { const int r = (tid >> 2) + 64 * i; ix[i] = aidx[r < mvalid ? r : 0]; }
  };
  auto set_a = [&](int e, int mt, const int (&ix)[4], long back) {
    if (GATHER) {
#pragma unroll
      for (int i = 0; i < (GATHER ? 4 : 1); ++i) a_src[i] = p.h2q() + (long)ix[i] * 2048 + c_src * 16 - back;
    } else {
      const long m0 = (long)mo[e] * 256 + mt * 256;
      a_src[0] = p.actq() + ((m0 + (tid >> 2)) >> 1) * 4096 + ((tid >> 2) & 1) * 64 + c_src * 16 - back;
    }
  };
  auto set_b = [&](int e, int nt, long back) {
    const int brl = tid >> 2;
    const u8* W = GATHER ? p.wq_gu() : p.wq_dn();
    const long brow0 = GATHER ? ((long)e * 4096 + nt * 128) : ((long)e * 2048 + nt * 256), brow1 = brow0 + (GATHER ? 2048 : 128);
    b_src0 = W + ((brow0 + brl) >> 1) * 4096 + (brl & 1) * 64 + c_src * 16 - back;
    b_src1 = W + ((brow1 + brl) >> 1) * 4096 + (brl & 1) * 64 + c_src * 16 - back;
  };
  auto issue = [&](int kt, int sl, int q) {
    if (q < 4) glds16_asm((const void*)((GATHER ? a_src[GATHER ? q : 0] : a_src[0] + q * a_step) + kt * a_kstep), lds0 + sl * R_STAGE + q * 4096);
    else { const int i = q - 4;
      glds16_asm_nt((const void*)((i < 2 ? b_src0 + i * b_step : b_src1 + (i - 2) * b_step) + kt * 128), lds0 + sl * R_STAGE + 16384 + i * 4096); }
  };
  unsigned a_rd[2], b_rd[2];
#pragma unroll
  for (int c = 0; c < 2; ++c) {
    const int ra = wr * 128 + l31, rb = wc * 64 + l31;
    a_rd[c] = ra * 64 + (((2 * hh + c) ^ ((ra >> 2) & 3)) * 16);
    b_rd[c] = rb * 64 + (((2 * hh + c) ^ ((rb >> 2) & 3)) * 16);
  }
  int e, nt, mt;
  bool valid = decode(0, e, nt, mt);
  if (!valid) return;
  {
    int ix0[4] = {0, 0, 0, 0};
    if (GATHER) load_idx(e, mt, ix0);
    __syncthreads();
    set_a(e, mt, ix0, 0); set_b(e, nt, 0);
#pragma unroll
    for (int q = 0; q < 8; ++q) issue(0, 0, q);
#pragma unroll
    for (int q = 0; q < 8; ++q) issue(1, 1, q);
#pragma unroll
    for (int q = 0; q < 4; ++q) issue(2, 2, q);
  }
  i32x8 aA[4], aB[4], bq[4];
  bool first = true;
  asm volatile("s_waitcnt vmcnt(12)" ::: "memory");
  __syncthreads();
  {
#pragma unroll
    for (int mb = 0; mb < 4; ++mb) {
      const u32x4 lo = *(const u32x4*)(smem + a_rd[0] + mb * 2048), hi = *(const u32x4*)(smem + a_rd[1] + mb * 2048);
      aA[mb] = (i32x8){(int)lo[0], (int)lo[1], (int)lo[2], (int)lo[3], (int)hi[0], (int)hi[1], (int)hi[2], (int)hi[3]};
    }
#pragma unroll
    for (int nb = 0; nb < 2; ++nb) {
      const char* bp = smem + 16384 + (nb & 1) * 2048;
      const u32x4 lo = *(const u32x4*)(bp + b_rd[0]), hi = *(const u32x4*)(bp + b_rd[1]);
      bq[nb] = (i32x8){(int)lo[0], (int)lo[1], (int)lo[2], (int)lo[3], (int)hi[0], (int)hi[1], (int)hi[2], (int)hi[3]};
    }
  }
  for (int round = 0; valid; ++round) {
    f32x16 acc[4][4];
#pragma unroll
    for (int i = 0; i < 4; ++i)
#pragma unroll
      for (int j = 0; j < 4; ++j)
#pragma unroll
        for (int r = 0; r < 16; ++r) acc[i][j][r] = 0.f;
    int ne = e, nnt = nt, nmt = mt;
    const bool nvalid = decode(round + 1, ne, nnt, nmt);
#if STREAM_META
    {
      const int cl = wc * 64 + l31;
      const float* bb = GATHER ? (p.b_gu + e * 4096 + nt * 128 + cl) : (p.b_dn + e * 2048 + nt * 256 + cl);
      const unsigned mb_ = (unsigned)(size_t)smem + 131072u + 1024u + (unsigned)__builtin_amdgcn_readfirstlane(wid) * 256u;
      glds4_asm((const void*)(bb), mb_);
      glds4_asm((const void*)(bb + 32), mb_ + 1024u);
      glds4_asm((const void*)(bb + (GATHER ? 2048 : 128)), mb_ + 2048u);
      glds4_asm((const void*)(bb + (GATHER ? 2048 + 32 : 160)), mb_ + 3072u);
      if (GATHER) {
        const int cntn = mo[40 + ne];
        const int mvn = min(256, cntn - nmt * 256);
        const int* aidx = p.list() + ne * T_ + nmt * 256;
#pragma unroll
        for (int i = 0; i < 4; ++i) { const int r = (tid >> 2) + 64 * i; glds4_asm((const void*)(aidx + (r < mvn ? r : 0)), mb_ + 4096u + i * 1024u); }
      }
    }
#else
    int nix[4] = {0, 0, 0, 0};
    if (GATHER) { if (nvalid) load_idx(ne, nmt, nix); }
    const int cl = wc * 64 + l31;
    float bv[4];
    if (GATHER) { const float* bg = p.b_gu + e * 4096 + nt * 128; bv[0] = bg[cl]; bv[1] = bg[cl + 32]; bv[2] = bg[2048 + cl]; bv[3] = bg[2048 + cl + 32]; }
    else { const float* bd = p.b_dn + e * 2048 + nt * 256; bv[0] = bd[cl]; bv[1] = bd[cl + 32]; bv[2] = bd[cl + 128]; bv[3] = bd[cl + 160]; }
#pragma unroll
    for (int i = 0; i < 4; ++i) asm volatile("" : "+v"(bv[i]), "+v"(nix[i]));
#endif
    auto load_a = [&](const char* St, i32x8 (&af)[4]) {
#pragma unroll
      for (int mb = 0; mb < 4; ++mb) {
        const u32x4 lo = *(const u32x4*)(St + a_rd[0] + mb * 2048), hi = *(const u32x4*)(St + a_rd[1] + mb * 2048);
        af[mb] = (i32x8){(int)lo[0], (int)lo[1], (int)lo[2], (int)lo[3], (int)hi[0], (int)hi[1], (int)hi[2], (int)hi[3]};
      }
    };
    auto load_b = [&](const char* St, int nb, i32x8& bf) {
      const char* bp = St + 16384 + (nb >> 1) * 8192 + (nb & 1) * 2048;
      const u32x4 lo = *(const u32x4*)(bp + b_rd[0]), hi = *(const u32x4*)(bp + b_rd[1]);
      bf = (i32x8){(int)lo[0], (int)lo[1], (int)lo[2], (int)lo[3], (int)hi[0], (int)hi[1], (int)hi[2], (int)hi[3]};
    };
    auto mma4 = [&](i32x8 (&af)[4], i32x8& bf, int nb) {
#pragma unroll
      for (int mb = 0; mb < 4; ++mb)
        acc[mb][nb] = __builtin_amdgcn_mfma_scale_f32_32x32x64_f8f6f4(af[mb], bf, acc[mb][nb], 0, 0, 0, 0x7f7f7f7f, 0, 0x7f7f7f7f);
    };
    auto half0 = [&](int kt, i32x8 (&ac)[4]) {
      const char* St = smem + (kt & 3) * R_STAGE;
      load_b(St, 2, bq[2]); load_b(St, 3, bq[3]);
      __builtin_amdgcn_sched_barrier(0);
#pragma unroll
      for (int nb = 0; nb < 2; ++nb) {
        mma4(ac, bq[nb], nb);
        __builtin_amdgcn_sched_barrier(0);
        issue(kt + 2, (kt + 2) & 3, 4 + 2 * nb); issue(kt + 2, (kt + 2) & 3, 5 + 2 * nb);
        __builtin_amdgcn_sched_barrier(0);
      }
    };
    auto half1 = [&](int kt, i32x8 (&ac)[4], i32x8 (&an)[4], bool has1) {
      const char* Sn = smem + ((kt + 1) & 3) * R_STAGE;
      if (has1) { load_a(Sn, an); load_b(Sn, 0, bq[0]); load_b(Sn, 1, bq[1]); }
      __builtin_amdgcn_sched_barrier(0);
#pragma unroll
      for (int nb = 2; nb < 4; ++nb) {
        mma4(ac, bq[nb], nb);
        __builtin_amdgcn_sched_barrier(0);
        issue(kt + 3, (kt + 3) & 3, 2 * (nb - 2)); issue(kt + 3, (kt + 3) & 3, 2 * (nb - 2) + 1);
        __builtin_amdgcn_sched_barrier(0);
      }
    };
#pragma nounroll
    for (int kt = 0; kt < nk; kt += 2) {
      half0(kt, aA);
#if STREAM_META
      if (kt == 0) {
        if (first) { if (GATHER) asm volatile("s_waitcnt vmcnt(16)" ::: "memory"); else asm volatile("s_waitcnt vmcnt(12)" ::: "memory"); }
        else { if (GATHER) asm volatile("s_waitcnt vmcnt(24)" ::: "memory"); else asm volatile("s_waitcnt vmcnt(44)" ::: "memory"); }
      } else
#endif
      asm volatile("s_waitcnt vmcnt(8)" ::: "memory");
      __syncthreads();
      half1(kt, aA, aB, true);
#if STREAM_META
      int nix[4] = {0, 0, 0, 0};
      if (GATHER && kt == nk - 4) {
#pragma unroll
        for (int i = 0; i < 4; ++i) nix[i] = *(const int*)(smem + 131072 + 1024 + 4096 + i * 1024 + tid * 4);
      }
#endif
      if (kt == nk - 4) set_a(ne, nmt, nix, (long)nk * a_kstep);
      half0(kt + 1, aB);
      if (kt == nk - 4) set_b(ne, nnt, (long)nk * 128);
      asm volatile("s_waitcnt vmcnt(8)" ::: "memory"); __syncthreads();
      half1(kt + 1, aB, aA, true);
    }
    __builtin_amdgcn_sched_barrier(0);
#pragma unroll
    for (int i = 0; i < 4; ++i) {
      asm volatile("" : "+a"(acc[i][0]), "+a"(acc[i][1]), "+a"(acc[i][2]), "+a"(acc[i][3]));
      asm volatile("" : "+v"(aA[i]));
    }
    asm volatile("" : "+v"(bq[0]), "+v"(bq[1]));
    __syncthreads();
    __builtin_amdgcn_sched_barrier(0);
    int tze = threadIdx.x; asm volatile("" : "+v"(tze));
    const int laneE = tze & 63, widE = tze >> 6, wrE = widE >> 1, wcE = widE & 1, l31E = laneE & 31, hhE = laneE >> 5;
    char* st = smem + 3 * R_STAGE + widE * 8192;
#if STREAM_META
    float bv[4];
#pragma unroll
    for (int k = 0; k < 4; ++k) bv[k] = *(const float*)(smem + 131072 + 1024 + k * 1024 + tze * 4);
    first = false;
#endif
    if (GATHER) {
      const long row0 = (long)(mo[e] * 256 + mt * 256);
#pragma unroll
      for (int mb = 0; mb < 4; ++mb)
#pragma unroll
        for (int reg = 0; reg < 16; ++reg) {
          const int r = mb * 32 + (reg & 3) + 8 * (reg >> 2) + 4 * hhE;
          float v[2];
#if PKMATH
          {
            typedef float f32x2_ __attribute__((ext_vector_type(2)));
            f32x2_ g = (f32x2_){acc[mb][0][reg], acc[mb][1][reg]} * WISCALE_ + (f32x2_){bv[0], bv[1]};
            f32x2_ uu = (f32x2_){acc[mb][2][reg], acc[mb][3][reg]} * WISCALE_ + (f32x2_){bv[2], bv[3]};
            g = (f32x2_){fminf(g[0], 7.0f), fminf(g[1], 7.0f)};
            uu = (f32x2_){fminf(fmaxf(uu[0], -7.0f), 7.0f), fminf(fmaxf(uu[1], -7.0f), 7.0f)};
            const f32x2_ t = g * (-1.702f * 1.44269504089f);
            const f32x2_ d = (f32x2_){__builtin_amdgcn_exp2f(t[0]), __builtin_amdgcn_exp2f(t[1])} + 1.0f;
            const f32x2_ rr = (f32x2_){__builtin_amdgcn_rcpf(d[0]), __builtin_amdgcn_rcpf(d[1])};
            const f32x2_ y = (uu + 1.0f) * (g * rr);
            v[0] = y[0]; v[1] = y[1];
            if ((reg & 3) == 3) __builtin_amdgcn_sched_barrier(0);
          }
#else
#pragma unroll
          for (int nb = 0; nb < 2; ++nb) {
            float g = fminf(acc[mb][nb][reg] * WISCALE_ + bv[nb], 7.0f);
            float uu = fminf(fmaxf(acc[mb][nb + 2][reg] * WISCALE_ + bv[2 + nb], -7.0f), 7.0f);
            v[nb] = (uu + 1.0f) * (g * __builtin_amdgcn_rcpf(1.0f + __expf(-1.702f * g)));
          }
#endif
          const int q = __builtin_amdgcn_cvt_pk_fp8_f32(v[0], v[1], 0, false);
          *(u8*)(st + r * 64 + l31E) = (u8)(q & 0xff);
          *(u8*)(st + r * 64 + 32 + l31E) = (u8)((q >> 8) & 0xff);
        }
      const int ch = laneE & 3;
#pragma unroll 8
      for (int it = 0; it < 8; ++it) {
        const int r = it * 16 + (laneE >> 2);
        const u32x4 w = *(const u32x4*)(st + r * 64 + ch * 16);
        const long rg = row0 + wrE * 128 + r;
        *(u32x4*)(p.actq() + (rg >> 1) * 4096 + (long)(nt * 2 + wcE) * 128 + (rg & 1) * 64 + ch * 16) = w;
      }
    } else {
      u16* gbase = p.ybuf() + ((long)mo[e] * 256 + mt * 256) * 2048 + nt * 256;
      const int ch = laneE & 15, span = ch >> 3;
      const int gcol = span * 128 + wcE * 64 + (ch & 7) * 8;
#pragma unroll
      for (int mb = 0; mb < 4; ++mb) {
#pragma unroll
        for (int reg = 0; reg < 16; ++reg) {
          const int r = (reg & 3) + 8 * (reg >> 2) + 4 * hhE;
#pragma unroll
          for (int nb = 0; nb < 4; ++nb) *(u16*)(st + r * 256 + (nb * 32 + l31E) * 2) = f32_to_bf16(acc[mb][nb][reg] * WISCALE_ + bv[nb]);
        }
#pragma unroll
        for (int it = 0; it < 8; ++it) {
          const int r = it * 4 + (laneE >> 4);
          const u32x4 w = *(const u32x4*)(st + r * 256 + ch * 16);
          *(u32x4*)(gbase + (long)(wrE * 128 + mb * 32 + r) * 2048 + gcol) = w;
        }
      }
    }
    valid = nvalid; e = ne; nt = nnt; mt = nmt;
#pragma unroll
    for (int i = 0; i < (GATHER ? 4 : 1); ++i) a_src[i] += (long)nk * a_kstep;
    b_src0 += (long)nk * 128; b_src1 += (long)nk * 128;
  }
  asm volatile("s_waitcnt vmcnt(0)" ::: "memory");
  __syncthreads();
}

__device__ __forceinline__ void convert_dn_range(const Params& p, char* smem, int u0, int n) {
  const int n3 = (n >= 6) ? (n / 3) * 3 : 0;
  if (n3) convert_units(p, smem, 16384 + u0, 1, n3);
  for (int i = n3; i < n; ++i) convert_one(p, smem, 16384 + u0 + i);
}
template <int WHICH, int KBV = 2048>
__device__ __forceinline__ void ph_moeq(const Params& p, char* smem) {
  int* mo = (int*)(smem + G_LDS_BYTES);
#if CVT_SPLIT
  const bool dn_first = ((blockIdx.x >> 3) & 1) != 0;
#if DNBAL
  int dn_u0 = 0, dn_n = 0;
  if (WHICH == 1) {
    moe_setup(p, mo);
    const int tot1 = mo[NE_] * 16;
    const int n_hi = tot1 & 255, n_lo = 256 - n_hi;
    const int v = (blockIdx.x & 7) * 32 + (blockIdx.x >> 3);
    int u_hi = (8192 - DNBAL * n_lo) / 256; if (u_hi < 0) u_hi = 0;
    const int tot_lo = 8192 - n_hi * u_hi;
    const int base = tot_lo / n_lo, rem = tot_lo - base * n_lo;
    if (v < n_hi) { dn_u0 = v * u_hi; dn_n = u_hi; }
    else { const int w = v - n_hi; dn_u0 = n_hi * u_hi + w * base + min(w, rem); dn_n = base + (w < rem ? 1 : 0); }
    if (dn_first) convert_dn_range(p, smem, dn_u0, dn_n);
  }
#else
  if (WHICH == 1 && dn_first) ph_convert_dn(p, smem);
#endif
#endif
  moe_setup(p, mo);
  const int NT = (WHICH == 1) ? 16 : 8;
  const int total = mo[NE_] * NT;
#if SKEW
  { const int sl = (blockIdx.x >> 3) % 5; for (int i = 0; i < sl; ++i) __builtin_amdgcn_s_sleep(SKEW); }
#endif
#if STREAM
  if (KBV == 2048 && ((STREAM >> (WHICH - 1)) & 1)) moe_stream<WHICH>(p, smem, mo); else
#endif
  for (int round = 0;; ++round) {
    const int u = xcd_unit(round);
    if (round * 256 >= total) break;
    if (u >= total) continue;
    int e = 0;
    while (mo[e + 1] * NT <= u) ++e;
    const int local = u - mo[e] * NT, me = mo[e + 1] - mo[e];
    const int nt = UORD ? (local % NT) : (local / me), mt = UORD ? (local / NT) : (local - (local / me) * me);
    if (WHICH == 1) moe1q_tile(p, smem, mo, e, nt, mt); else moe2q_tile<KBV>(p, smem, mo, e, nt, mt);
  }
#if CVT_SPLIT
#if DNBAL
  if (WHICH == 1 && !dn_first) convert_dn_range(p, smem, dn_u0, dn_n);
#else
  if (WHICH == 1 && !dn_first) ph_convert_dn(p, smem);
#endif
#endif
}
#define LDS_MAX 143360
#ifndef DUP
#define DUP 0
#endif
#ifndef MOEQ
#define MOEQ 1
#endif
#ifndef CVT_SPLIT
#define CVT_SPLIT 1
#endif
#ifndef CVT_STAGGER
#define CVT_STAGGER 1
#endif
#ifndef CVT_IN_P4
#define CVT_IN_P4 1
#endif
#ifndef TSTAMP
#define TSTAMP 0
#endif
#ifndef DENSER
#define DENSER 1
#endif
__global__ void __launch_bounds__(256, 1) mega(Params p) {
  extern __shared__ __attribute__((aligned(16))) char smem[];
  volatile LAS unsigned* xbw = (volatile LAS unsigned*)(smem + LDS_MAX - 16);
  if (threadIdx.x == 0) { xbw[0] = 0u; xbw[1] = 0u; xbw[2] = 0u; xbw[3] = 0u; }
  __syncthreads();
  (void)xcd_barrier_post(p.bar(), xbw);
#if TSTAMP
  unsigned long long ts0 = wall_clock64();
  int bar_no = 0;
#define XBAR() do { XcdBarrier bar_; bar_.bar = p.bar(); bar_.x = xb_xcc_id(); bar_.st = (volatile LAS unsigned*)(smem + LDS_MAX - 16); xcd_barrier(bar_); ++bar_no; if (bar_no == TSTAMP && blockIdx.x == 0 && threadIdx.x == 0) { ((float*)p.counts())[48] = (float)(wall_clock64() - ts0) * (1.0f / 100.0f); } } while (0)
#else
#define XBAR() do { XcdBarrier bar_; bar_.bar = p.bar(); bar_.x = xb_xcc_id(); bar_.st = (volatile LAS unsigned*)(smem + LDS_MAX - 16); xcd_barrier(bar_); } while (0)
#endif
#if DUP == 100
  for (int rep_ = 0; rep_ < 2; ++rep_) {
  if (rep_) XBAR();
#endif
  ph_prep0(p);
#if DUP == 33
  if (blockIdx.x < 192) gla_g1_unit(p, smem, blockIdx.x);
  else for (int i = 0; i < 5; ++i) gla_g1_unit(p, smem, 192 + (blockIdx.x - 192) * 5 + i);
#endif
#if DUP == 30
  ph_prep0(p);
#endif
#if DENSER
  ph_convert_dense(p, smem);
#endif
#if MOEQ >= 1 && CVT_IN_P4 == 0
  ph_convert(p, smem);
#if DUP == 20
  ph_convert(p, smem);
#endif
#endif
  XBAR();
#if DENSER
  ph_win_r(p, smem);
#else
  ph_win(p, smem);
#endif
#if DUP == 1
#if DENSER
  ph_win_r(p, smem);
#else
  ph_win(p, smem);
#endif
#endif
  XBAR();
  ph_prep1(p, smem);
#if DUP == 2
  ph_prep1(p, smem);
#endif
  XBAR();
#if DENSER
  upkv_tile_r(p, smem, blockIdx.x >> 3, blockIdx.x & 7);
  if (blockIdx.x < 192) upq_tile_r(p, smem, blockIdx.x / 6, blockIdx.x % 6);
#else
  upkv_tile(p, smem, blockIdx.x >> 3, blockIdx.x & 7);
  if (blockIdx.x < 192) upq_tile(p, smem, blockIdx.x / 6, blockIdx.x % 6);
#endif
  if (blockIdx.x < 192) gla_g1_unit(p, smem, blockIdx.x);
  else for (int i = 0; i < 4; ++i) gla_g1_unit(p, smem, 192 + (blockIdx.x - 192) * 4 + i);
  if (blockIdx.x < 64) gla_g1_unit(p, smem, 448 + blockIdx.x);
#if DUP == 3
  upkv_tile_r(p, smem, blockIdx.x >> 3, blockIdx.x & 7);
  if (blockIdx.x < 192) upq_tile_r(p, smem, blockIdx.x / 6, blockIdx.x % 6);
  if (blockIdx.x < 192) gla_g1_unit(p, smem, blockIdx.x);
  else for (int i = 0; i < 5; ++i) gla_g1_unit(p, smem, 192 + (blockIdx.x - 192) * 5 + i);
#endif
  XBAR();
  gla_g2_unit(p, blockIdx.x);
#if DUP == 31
  gla_g2_unit(p, blockIdx.x);
#endif
  {
    const int bh = blockIdx.x >> 4, qa = blockIdx.x & 15;
#if MOEQ >= 1 && CVT_IN_ATTN
    int ci = 0;
    attn_unit(p, smem, bh >> 3, bh & 7, 31 - qa, ci);
    attn_unit(p, smem, bh >> 3, bh & 7, qa, ci);
    for (; ci < 64; ++ci) convert_one(p, smem, blockIdx.x + 256 * ci);
#else
    int ci = 64;
#if MOEQ >= 1 && CVT_IN_P4 && STAG4
    const int sg = (blockIdx.x >> 3) & 3;
    if (sg == 0) ph_convert_gu(p, smem, 0, 1);
    if (sg == 3) ph_convert_gu(p, smem, 0, 2);
    attn_unit(p, smem, bh >> 3, bh & 7, 31 - qa, ci);
    if (sg == 1) ph_convert_gu(p, smem, 0, 1);
    attn_unit(p, smem, bh >> 3, bh & 7, qa, ci);
    if (sg == 2) ph_convert_gu(p, smem, 0, 1);
    if (sg == 3) ph_convert_gu(p, smem, 1, 2);
#else
#if MOEQ >= 1 && CVT_IN_P4
    const bool cvt_first = CVT_STAGGER ? (((STAGX ? blockIdx.x : (blockIdx.x >> 3)) & 1) != 0) : false;
    if (cvt_first) { if (CVT_SPLIT) ph_convert_gu(p, smem, 0, 1); else ph_convert(p, smem); }
#endif
    attn_unit(p, smem, bh >> 3, bh & 7, 31 - qa, ci);
    attn_unit(p, smem, bh >> 3, bh & 7, qa, ci);
#if MOEQ >= 1 && CVT_IN_P4
    if (!cvt_first) { if (CVT_SPLIT) ph_convert_gu(p, smem, 0, 1); else ph_convert(p, smem); }
#endif
#endif
#endif
#if DUP == 44
    if (cvt_first) ph_convert(p, smem);
    { int cz = 64; attn_unit(p, smem, bh >> 3, bh & 7, 31 - qa, cz); attn_unit(p, smem, bh >> 3, bh & 7, qa, cz); }
    if (!cvt_first) ph_convert(p, smem);
#endif
#if DUP == 47
    if (cvt_first) ph_convert_gu(p, smem, 0, 1);
    { int cz = 64; attn_unit(p, smem, bh >> 3, bh & 7, 31 - qa, cz); attn_unit(p, smem, bh >> 3, bh & 7, qa, cz); }
    if (!cvt_first) ph_convert_gu(p, smem, 0, 1);
#endif
#if DUP == 4
    { int cz = 64; attn_unit(p, smem, bh >> 3, bh & 7, 31 - qa, cz); attn_unit(p, smem, bh >> 3, bh & 7, qa, cz); }
#endif
  }
  XBAR();
#if DUP == 45
  if ((blockIdx.x >> 3) & 1) ph_convert_gu(p, smem, 0, 1);
  XBAR();
#endif
#if DUP == 46
  ph_convert_gu(p, smem, 0, 1);
  XBAR();
#endif
  for (int u = blockIdx.x; u < 512; u += gridDim.x) gla_g3_unit(p, smem, u);
  mla_norm_tokens(p);
#if DUP == 5
  for (int u = blockIdx.x; u < 512; u += gridDim.x) gla_g3_unit(p, smem, u);
  mla_norm_tokens(p);
#endif
  XBAR();
#if DUP == 62
  wout_tile_r<2>(p, smem, (blockIdx.x & 7) * 4 + ((blockIdx.x >> 3) & 3), blockIdx.x >> 5);
#endif
#if DENSER
  wout_tile_r(p, smem, (blockIdx.x & 7) * 4 + ((blockIdx.x >> 3) & 3), blockIdx.x >> 5);
#else
  wout_tile(p, smem, blockIdx.x >> 3, blockIdx.x & 7);
#endif
#if DUP == 6
  wout_tile_r(p, smem, (blockIdx.x & 7) * 4 + ((blockIdx.x >> 3) & 3), blockIdx.x >> 5);
#endif
#if DUP == 61
  wout_tile_r<1>(p, smem, (blockIdx.x & 7) * 4 + ((blockIdx.x >> 3) & 3), blockIdx.x >> 5);
  wout_tile_r(p, smem, (blockIdx.x & 7) * 4 + ((blockIdx.x >> 3) & 3), blockIdx.x >> 5);
#endif
  XBAR();
  ffn_prep_unit(p, smem, blockIdx.x);
#if DUP == 7
  ffn_prep_unit<1>(p, smem, blockIdx.x);
#endif
  XBAR();
#if MOEQ >= 1
  ph_moeq<1>(p, smem);
#if DUP == 8
  ph_moeq<1>(p, smem);
#endif
#else
  ph_moe<1>(p, smem);
#endif
  XBAR();
#if MOEQ >= 1
#if DUP == 92
  ph_moeq<2, 256>(p, smem);
#endif
  ph_moeq<2>(p, smem);
#else
  ph_moe<2>(p, smem);
#endif
#if DUP == 9
  ph_moeq<2>(p, smem);
#endif
#if DUP == 89
  XBAR();
  ph_moeq<1>(p, smem);
  XBAR();
  ph_moeq<2>(p, smem);
#endif
#if DUP == 19
  ph_moe<2, 1>(p, smem);
#endif
  XBAR();
#if DUP == 100
  ph_final(p, smem);
  }
#endif
#if TSTAMP
  {
    const float us = ((const float*)p.counts())[48];
    const float scl = 1.0f + us * (1.0f / 4000.0f);
    ph_final(p, smem, scl);
  }
#else
  ph_final(p, smem);
#endif
#if DUP == 10
  ph_final(p, smem);
#endif
#if DUP == 11
  for (int i = 0; i < 10; ++i) XBAR();
#endif
}

extern "C" void kernel_launch(void* const* d_in, const int* in_sizes, int n_in,
                              void* d_out, int out_size, void* d_ws, size_t ws_size,
                              hipStream_t stream) {
  Params P{};
  P.x = (const float*)d_in[0]; P.pos = (const int*)d_in[1];
  P.attn_norm = (const float*)d_in[2]; P.w_in = (const float*)d_in[3]; P.gate_up = (const float*)d_in[4]; P.gate_bias = (const float*)d_in[5];
  P.gla_out_norm = (const float*)d_in[6]; P.q_norm = (const float*)d_in[7]; P.w_uq = (const float*)d_in[8]; P.kv_norm = (const float*)d_in[9];
  P.w_ukv = (const float*)d_in[10]; P.mla_out_norm = (const float*)d_in[11]; P.w_out = (const float*)d_in[12]; P.ffn_norm = (const float*)d_in[13];
  P.router_w = (const float*)d_in[14]; P.router_b = (const float*)d_in[15]; P.w_gu = (const float*)d_in[16]; P.b_gu = (const float*)d_in[17];
  P.w_dn = (const float*)d_in[18]; P.b_dn = (const float*)d_in[19]; P.final_norm = (const float*)d_in[20];
  P.out = (float*)d_out;

  P.ws = (char*)d_ws;

  hipFuncSetAttribute((const void*)mega, hipFuncAttributeMaxDynamicSharedMemorySize, LDS_MAX);
  hipMemsetAsync(d_ws, 0, XCD_BAR_WORDS * sizeof(unsigned), stream);
  mega<<<256, 256, LDS_MAX, stream>>>(P);
}
```
